# Optimizing an MI355X kernel written in HIP

```python
import jax
import jax.numpy as jnp
from jax import lax
import numpy as np

D_MODEL = 1024
BATCH = 16
SEQ = 256
DEPTH = 4
DEC_BATCH = 8
DEC_SEQ = 4096
PAST_LEN = 256

GRID_W = 64
EPS = 1e-6
ROPE_BASE = 10000.0
BLOCK = 128
NEG_INF = -1e30
D_RNN = 1024
RNN_BLOCKS = 8
RNN_BW = D_RNN // RNN_BLOCKS
CONV_W = 4
CONV_LEFT = (CONV_W - 1) // 2
LRU_C = 8.0
MLA_HEADS = 8
MLA_NOPE = 64
MLA_ROPE = 32
MLA_V = 64
Q_LORA = 384
KV_LORA = 256
MLA_WIDTH = MLA_HEADS * MLA_V
SWA_HEADS = 8
SWA_KV_HEADS = 2
SWA_GROUPS = SWA_HEADS // SWA_KV_HEADS
SWA_HD = 64
WINDOW = 128
SWA_WIDTH = SWA_HEADS * SWA_HD
N_BRANCH = 3
D_IN = (2 * D_RNN + Q_LORA + KV_LORA + MLA_ROPE + MLA_WIDTH
        + SWA_HEADS * SWA_HD + 2 * SWA_KV_HEADS * SWA_HD + SWA_WIDTH + N_BRANCH * D_MODEL)

kernel_name = "hybrid_flow_backbone_step"


def _in_split_points():
    sizes = (D_RNN, D_RNN, Q_LORA, KV_LORA, MLA_ROPE, MLA_WIDTH, SWA_HEADS * SWA_HD,
             SWA_KV_HEADS * SWA_HD, SWA_KV_HEADS * SWA_HD, SWA_WIDTH, N_BRANCH * D_MODEL)
    pts, acc = [], 0
    for s in sizes[:-1]:
        acc += s
        pts.append(acc)
    return pts


def rmsnorm(x, g):
    xf = x.astype(jnp.float32)
    y = xf * lax.rsqrt(jnp.mean(xf * xf, axis=-1, keepdims=True) + EPS)
    return (y * g.astype(jnp.float32)).astype(x.dtype)


def axial_rope_tables(n_tok, rot_dim):
    rows = n_tok // GRID_W
    row = jnp.repeat(jnp.arange(rows, dtype=jnp.float32), GRID_W)
    col = jnp.tile(jnp.arange(GRID_W, dtype=jnp.float32), rows)
    half = rot_dim // 2
    freqs = ROPE_BASE ** (-jnp.arange(0, half, 2, dtype=jnp.float32) / half)
    ang_r = row[:, None] * freqs[None, :]
    ang_c = col[:, None] * freqs[None, :]
    ang = jnp.concatenate([ang_r, ang_r, ang_c, ang_c], axis=-1)
    return jnp.cos(ang), jnp.sin(ang)


def apply_rope(x, cos, sin):
    r = x.shape[-1]
    q = r // 4
    rot = jnp.concatenate([-x[..., q:2 * q], x[..., :q], -x[..., 3 * q:], x[..., 2 * q:3 * q]], axis=-1)
    shape = (1, x.shape[1]) + (1,) * (x.ndim - 3) + (r,)
    return x * cos.reshape(shape).astype(x.dtype) + rot * sin.reshape(shape).astype(x.dtype)


def centred_conv(x, w, b):
    L = x.shape[1]
    xp = jnp.pad(x, ((0, 0), (CONV_LEFT, CONV_W - 1 - CONV_LEFT), (0, 0)))
    acc = xp[:, 0:L] * w[0]
    for k in range(1, CONV_W):
        acc = acc + xp[:, k:k + L] * w[k]
    return acc + b


def rglru_scan(x, h0, w_a, b_a, w_i, b_i, lam, reverse):
    B, L, _ = x.shape
    xb = x.reshape(B, L, RNN_BLOCKS, RNN_BW)
    r = jax.nn.sigmoid((jnp.einsum("blnc,ncd->blnd", xb, w_a).reshape(B, L, D_RNN) + b_a).astype(jnp.float32))
    i = jax.nn.sigmoid((jnp.einsum("blnc,ncd->blnd", xb, w_i).reshape(B, L, D_RNN) + b_i).astype(jnp.float32))
    log_a = LRU_C * r * jax.nn.log_sigmoid(lam.astype(jnp.float32))
    a = jnp.exp(log_a)
    u = jnp.sqrt(-jnp.expm1(2.0 * log_a)) * i * x.astype(jnp.float32)

    def combine(e1, e2):
        return (e1[0] * e2[0], e2[0] * e1[1] + e2[1])

    a_cum, h = lax.associative_scan(combine, (a, u), reverse=reverse, axis=1)
    return (h + a_cum * h0.astype(jnp.float32)[:, None, :]).astype(x.dtype)


def rglru_branch(x_rnn, h0_f, h0_b, p):
    xc = centred_conv(x_rnn, p["conv_w"], p["conv_b"])
    h_f = rglru_scan(xc, h0_f, p["lru_wa"][0], p["lru_ba"][0], p["lru_wi"][0], p["lru_bi"][0], p["lru_lam"][0], False)
    h_b = rglru_scan(xc, h0_b, p["lru_wa"][1], p["lru_ba"][1], p["lru_wi"][1], p["lru_bi"][1], p["lru_lam"][1], True)
    return h_f, h_b


def mla_q(c_q, p):
    B, L = c_q.shape[:2]
    q = (rmsnorm(c_q, p["mla_q_norm"]) @ p["mla_w_uq"]).reshape(B, L, MLA_HEADS, MLA_NOPE + MLA_ROPE)
    return q[..., :MLA_NOPE], q[..., MLA_NOPE:]


def mla_kv_up(ckv, p):
    B, L = ckv.shape[:2]
    kv = (ckv @ p["mla_w_ukv"]).reshape(B, L, MLA_HEADS, MLA_NOPE + MLA_V)
    return kv[..., :MLA_NOPE], kv[..., MLA_NOPE:]


def mla_attend(q_nope, q_rope, k_nope, k_rope, v):
    B, Lq = q_nope.shape[:2]
    nb = Lq // BLOCK
    scale = (MLA_NOPE + MLA_ROPE) ** -0.5
    qn = q_nope.reshape(B, nb, BLOCK, MLA_HEADS, MLA_NOPE).swapaxes(0, 1)
    qr = q_rope.reshape(B, nb, BLOCK, MLA_HEADS, MLA_ROPE).swapaxes(0, 1)

    def block(args):
        qn_b, qr_b = args
        s = jnp.einsum("bqhd,bkhd->bhqk", qn_b, k_nope) + jnp.einsum("bqhr,bkr->bhqk", qr_b, k_rope)
        pr = jax.nn.softmax(s.astype(jnp.float32) * scale, axis=-1).astype(v.dtype)
        return jnp.einsum("bhqk,bkhd->bqhd", pr, v)

    o = lax.map(block, (qn, qr))
    return o.swapaxes(0, 1).reshape(B, Lq, MLA_WIDTH)


def sink_softmax(s, sink):
    sk = jnp.broadcast_to(sink.astype(jnp.float32).reshape(1, SWA_KV_HEADS, SWA_GROUPS, 1, 1), s.shape[:-1] + (1,))
    return jax.nn.softmax(jnp.concatenate([s, sk], axis=-1), axis=-1)[..., :-1]


def swa_context(q, k, v, sink):
    B, L = q.shape[:2]
    nb = L // BLOCK
    scale = SWA_HD ** -0.5
    qb = q.reshape(B, nb, BLOCK, SWA_KV_HEADS, SWA_GROUPS, SWA_HD).swapaxes(0, 1)

    def block(q_b):
        s = jnp.einsum("bqhgd,bkhd->bhgqk", q_b, k).astype(jnp.float32) * scale
        pr = sink_softmax(s, sink).astype(v.dtype)
        return jnp.einsum("bhgqk,bkhd->bqhgd", pr, v)

    o = lax.map(block, qb)
    return o.swapaxes(0, 1).reshape(B, L, SWA_WIDTH)


def swa_latent(q, k, v, k_ctx, v_ctx, sink):
    B, N = q.shape[:2]
    Lc = k_ctx.shape[1]
    nb = N // BLOCK
    scale = SWA_HD ** -0.5
    pad = ((0, 0), (BLOCK, BLOCK), (0, 0), (0, 0))
    kp = jnp.pad(k, pad)
    vp = jnp.pad(v, pad)
    qb = q.reshape(B, nb, BLOCK, SWA_KV_HEADS, SWA_GROUPS, SWA_HD).swapaxes(0, 1)
    offs = jnp.arange(3 * BLOCK)
    band = jnp.abs(jnp.arange(BLOCK)[:, None] + BLOCK - offs[None, :]) <= WINDOW
    ctx_ok = jnp.ones((BLOCK, Lc), dtype=bool)

    def block(args):
        n, q_b = args
        start = n * BLOCK
        k_b = lax.dynamic_slice_in_dim(kp, start, 3 * BLOCK, axis=1)
        v_b = lax.dynamic_slice_in_dim(vp, start, 3 * BLOCK, axis=1)
        kpos = start - BLOCK + offs
        valid = jnp.concatenate([band & ((kpos >= 0) & (kpos < N))[None, :], ctx_ok], axis=1)
        k_all = jnp.concatenate([k_b, k_ctx], axis=1)
        v_all = jnp.concatenate([v_b, v_ctx], axis=1)
        s = jnp.einsum("bqhgd,bkhd->bhgqk", q_b, k_all).astype(jnp.float32) * scale
        s = jnp.where(valid, s, NEG_INF)
        pr = sink_softmax(s, sink).astype(v.dtype)
        return jnp.einsum("bhgqk,bkhd->bqhgd", pr, v_all)

    o = lax.map(block, (jnp.arange(nb), qb))
    return o.swapaxes(0, 1).reshape(B, N, SWA_WIDTH)


def mix_inputs(x, cond, p):
    mod = jax.nn.silu(cond) @ p["w_mod"] + p["b_mod"]
    shift, scale, gate = jnp.split(mod, 3, axis=-1)
    h = rmsnorm(x, p["g_norm"]) * (1 + scale[:, None, :]) + shift[:, None, :]
    parts = jnp.split(h @ p["w_in"], _in_split_points(), axis=-1)
    return gate, parts


def merge_branches(y_rnn, y_mla, y_swa, g_rnn, g_mla, g_swa, merge_logits, p):
    B, L, _ = y_rnn.shape
    m = jax.nn.sigmoid(merge_logits.astype(jnp.float32)).astype(y_rnn.dtype).reshape(B, L, N_BRANCH, D_MODEL)
    u = (m[:, :, 0] * ((y_rnn * jax.nn.silu(g_rnn)) @ p["w_br_rnn"])
         + m[:, :, 1] * ((y_mla * jax.nn.silu(g_mla)) @ p["w_br_mla"])
         + m[:, :, 2] * ((y_swa * jax.nn.silu(g_swa)) @ p["w_br_swa"]))
    return u @ p["w_out"]


def context_layer(x, cond, p):
    B, L, _ = x.shape
    gate, (x_rnn, g_rnn, c_q, c_kv, k_rope, g_mla, q_s, k_s, v_s, g_swa, merge_logits) = mix_inputs(x, cond, p)
    zeros = jnp.zeros((B, D_RNN), x.dtype)
    h_f, h_b = rglru_branch(x_rnn, zeros, zeros, p)
    y_rnn = h_f + h_b
    ckv = rmsnorm(c_kv, p["mla_kv_norm"])
    q_nope, q_rope = mla_q(c_q, p)
    k_nope, v_m = mla_kv_up(ckv, p)
    y_mla = mla_attend(q_nope, q_rope, k_nope, k_rope, v_m)
    q = q_s.reshape(B, L, SWA_KV_HEADS, SWA_GROUPS, SWA_HD)
    k = k_s.reshape(B, L, SWA_KV_HEADS, SWA_HD)
    v = v_s.reshape(B, L, SWA_KV_HEADS, SWA_HD)
    y_swa = swa_context(q, k, v, p["swa_sink"])
    out = merge_branches(y_rnn, y_mla, y_swa, g_rnn, g_mla, g_swa, merge_logits, p)
    x = x + gate[:, None, :] * out
    h_state = jnp.stack([h_f[:, -1], h_b[:, 0]], axis=1)
    return x, ckv, k_rope, k, v, h_state


def latent_layer(x, cond, ckv_ctx, krope_ctx, k_ctx, v_ctx, h_ctx, cos_m, sin_m, cos_s, sin_s, p):
    B, N, _ = x.shape
    gate, (x_rnn, g_rnn, c_q, c_kv, k_rope, g_mla, q_s, k_s, v_s, g_swa, merge_logits) = mix_inputs(x, cond, p)
    h_f, h_b = rglru_branch(x_rnn, h_ctx[:, 0], h_ctx[:, 1], p)
    y_rnn = h_f + h_b
    ckv = rmsnorm(c_kv, p["mla_kv_norm"])
    q_nope, q_rope = mla_q(c_q, p)
    q_rope = apply_rope(q_rope, cos_m, sin_m)
    k_rope_l = apply_rope(k_rope, cos_m, sin_m)
    k_nope_l, v_l = mla_kv_up(ckv, p)
    k_nope_c, v_c = mla_kv_up(ckv_ctx, p)
    y_mla = mla_attend(q_nope, q_rope,
                       jnp.concatenate([k_nope_c, k_nope_l], axis=1),
                       jnp.concatenate([krope_ctx, k_rope_l], axis=1),
                       jnp.concatenate([v_c, v_l], axis=1))
    q = apply_rope(q_s.reshape(B, N, SWA_KV_HEADS, SWA_GROUPS, SWA_HD), cos_s, sin_s)
    k = apply_rope(k_s.reshape(B, N, SWA_KV_HEADS, SWA_HD), cos_s, sin_s)
    v = v_s.reshape(B, N, SWA_KV_HEADS, SWA_HD)
    y_swa = swa_latent(q, k, v, k_ctx, v_ctx, p["swa_sink"])
    out = merge_branches(y_rnn, y_mla, y_swa, g_rnn, g_mla, g_swa, merge_logits, p)
    return x + gate[:, None, :] * out


def setup_inputs(seed: int = 0) -> dict:
    key = jax.random.key(seed)
    ks = iter(jax.random.split(key, 40))

    def nrm(shape, scale=1.0):
        return jax.random.normal(next(ks), shape, jnp.float32) * scale

    def gain(shape):
        return 1.0 + nrm(shape, 0.02)

    a8 = jax.random.uniform(next(ks), (DEPTH, 2, D_RNN), jnp.float32, minval=0.9, maxval=0.999)
    a = a8 ** (1.0 / LRU_C)
    lam = jnp.log(a) - jnp.log1p(-a)
    return {
        "x_prompt": nrm((BATCH, SEQ, D_MODEL)),
        "x_sample": nrm((DEC_BATCH, DEC_SEQ, D_MODEL)),
        "cache_mla_ckv": nrm((DEC_BATCH, DEPTH, PAST_LEN, KV_LORA)),
        "cache_mla_krope": nrm((DEC_BATCH, DEPTH, PAST_LEN, MLA_ROPE)),
        "cache_swa_k": nrm((DEC_BATCH, DEPTH, PAST_LEN, SWA_KV_HEADS, SWA_HD)),
        "cache_swa_v": nrm((DEC_BATCH, DEPTH, PAST_LEN, SWA_KV_HEADS, SWA_HD)),
        "state_rglru": nrm((DEC_BATCH, DEPTH, 2, D_RNN), 0.5),
        "c": nrm((DEC_BATCH, D_MODEL)),
        "c_ctx": nrm((D_MODEL,)),
        "w_mod": nrm((DEPTH, D_MODEL, 3 * D_MODEL), 0.5 * D_MODEL ** -0.5),
        "b_mod": nrm((DEPTH, 3 * D_MODEL), 0.02),
        "g_norm": gain((DEPTH, D_MODEL)),
        "w_in": nrm((DEPTH, D_MODEL, D_IN), D_MODEL ** -0.5),
        "conv_w": nrm((DEPTH, CONV_W, D_RNN), CONV_W ** -0.5),
        "conv_b": nrm((DEPTH, D_RNN), 0.02),
        "lru_wa": nrm((DEPTH, 2, RNN_BLOCKS, RNN_BW, RNN_BW), RNN_BW ** -0.5),
        "lru_ba": nrm((DEPTH, 2, D_RNN), 0.02),
        "lru_wi": nrm((DEPTH, 2, RNN_BLOCKS, RNN_BW, RNN_BW), RNN_BW ** -0.5),
        "lru_bi": nrm((DEPTH, 2, D_RNN), 0.02),
        "lru_lam": lam,
        "mla_q_norm": gain((DEPTH, Q_LORA)),
        "mla_w_uq": nrm((DEPTH, Q_LORA, MLA_HEADS * (MLA_NOPE + MLA_ROPE)), Q_LORA ** -0.5),
        "mla_kv_norm": gain((DEPTH, KV_LORA)),
        "mla_w_ukv": nrm((DEPTH, KV_LORA, MLA_HEADS * (MLA_NOPE + MLA_V)), KV_LORA ** -0.5),
        "swa_sink": nrm((DEPTH, SWA_HEADS), 0.5),
        "w_br_rnn": nrm((DEPTH, D_RNN, D_MODEL), D_RNN ** -0.5),
        "w_br_mla": nrm((DEPTH, MLA_WIDTH, D_MODEL), MLA_WIDTH ** -0.5),
        "w_br_swa": nrm((DEPTH, SWA_WIDTH, D_MODEL), SWA_WIDTH ** -0.5),
        "w_out": nrm((DEPTH, D_MODEL, D_MODEL), D_MODEL ** -0.5),
        "final_norm": gain((D_MODEL,)),
    }


def reference(x_prompt, x_sample, cache_mla_ckv, cache_mla_krope, cache_swa_k, cache_swa_v, state_rglru,
              c, c_ctx, w_mod, b_mod, g_norm, w_in, conv_w, conv_b, lru_wa, lru_ba, lru_wi, lru_bi, lru_lam,
              mla_q_norm, mla_w_uq, mla_kv_norm, mla_w_ukv, swa_sink, w_br_rnn, w_br_mla, w_br_swa, w_out,
              final_norm):
    layers = [dict(w_mod=w_mod[l], b_mod=b_mod[l], g_norm=g_norm[l], w_in=w_in[l], conv_w=conv_w[l],
                   conv_b=conv_b[l], lru_wa=lru_wa[l], lru_ba=lru_ba[l], lru_wi=lru_wi[l], lru_bi=lru_bi[l],
                   lru_lam=lru_lam[l], mla_q_norm=mla_q_norm[l], mla_w_uq=mla_w_uq[l],
                   mla_kv_norm=mla_kv_norm[l], mla_w_ukv=mla_w_ukv[l], swa_sink=swa_sink[l],
                   w_br_rnn=w_br_rnn[l], w_br_mla=w_br_mla[l], w_br_swa=w_br_swa[l], w_out=w_out[l])
              for l in range(DEPTH)]

    xp = x_prompt
    cond_p = jnp.broadcast_to(c_ctx, (x_prompt.shape[0], D_MODEL))
    ckvs, krs, sks, svs, hs = [], [], [], [], []
    for l in range(DEPTH):
        xp, ckv, kr, sk, sv, hst = context_layer(xp, cond_p, layers[l])
        ckvs.append(ckv)
        krs.append(kr)
        sks.append(sk)
        svs.append(sv)
        hs.append(hst)
    y_prompt = rmsnorm(xp, final_norm)
    new_mla_ckv = jnp.stack(ckvs, axis=1)
    new_mla_krope = jnp.stack(krs, axis=1)
    new_swa_k = jnp.stack(sks, axis=1)
    new_swa_v = jnp.stack(svs, axis=1)
    new_rglru = jnp.stack(hs, axis=1)

    n_lat = x_sample.shape[1]
    cos_m, sin_m = axial_rope_tables(n_lat, MLA_ROPE)
    cos_s, sin_s = axial_rope_tables(n_lat, SWA_HD)
    xs = x_sample
    for l in range(DEPTH):
        xs = latent_layer(xs, c, cache_mla_ckv[:, l], cache_mla_krope[:, l], cache_swa_k[:, l], cache_swa_v[:, l],
                          state_rglru[:, l], cos_m, sin_m, cos_s, sin_s, layers[l])
    y_sample = rmsnorm(xs, final_norm)
    return (y_prompt, y_sample, new_mla_ckv, new_mla_krope, new_swa_k, new_swa_v, new_rglru)
```

```cpp
#include <hip/hip_runtime.h>
#include <hip/hip_cooperative_groups.h>
#include <cstdio>
#include <cstdint>
namespace cg = cooperative_groups;

#ifndef MEGA
#define MEGA 1
#endif

typedef unsigned short u16;
using bf16x8 = __attribute__((ext_vector_type(8))) short;
using f32x4 = __attribute__((ext_vector_type(4))) float;
using f32x16 = __attribute__((ext_vector_type(16))) float;
typedef __bf16 bf2_t __attribute__((ext_vector_type(2)));
typedef float f2_t __attribute__((ext_vector_type(2)));
#define DI __device__ __forceinline__

__device__ const float TAB_M[1024] = {
  1.00000000e+00f, 0.00000000e+00f, 1.00000000e+00f, 0.00000000e+00f, 1.00000000e+00f, 0.00000000e+00f, 1.00000000e+00f, 0.00000000e+00f,
  1.00000000e+00f, 0.00000000e+00f, 1.00000000e+00f, 0.00000000e+00f, 1.00000000e+00f, 0.00000000e+00f, 1.00000000e+00f, 0.00000000e+00f,
  5.40302277e-01f, 8.41470957e-01f, 9.50415254e-01f, 3.10983598e-01f, 9.95004177e-01f, 9.98334214e-02f, 9.99500036e-01f, 3.16175036e-02f,
  9.99949992e-01f, 9.99983307e-03f, 9.99994993e-01f, 3.16227227e-03f, 9.99999523e-01f, 9.99999931e-04f, 9.99999940e-01f, 3.16227757e-04f,
  -4.16146845e-01f, 9.09297407e-01f, 8.06578398e-01f, 5.91127098e-01f, 9.80066597e-01f, 1.98669329e-01f, 9.98000681e-01f, 6.32033944e-02f,
  9.99800026e-01f, 1.99986659e-02f, 9.99979973e-01f, 6.32451288e-03f, 9.99997973e-01f, 1.99999870e-03f, 9.99999821e-01f, 6.32455456e-04f,
  -9.89992499e-01f, 1.41120002e-01f, 5.82753658e-01f, 8.12648892e-01f, 9.55336511e-01f, 2.95520216e-01f, 9.95503366e-01f, 9.47260857e-02f,
  9.99550045e-01f, 2.99954992e-02f, 9.99954998e-01f, 9.48669016e-03f, 9.99995530e-01f, 2.99999560e-03f, 9.99999523e-01f, 9.48683126e-04f,
  -6.53643608e-01f, -7.56802499e-01f, 3.01137477e-01f, 9.53580737e-01f, 9.21060979e-01f, 3.89418334e-01f, 9.92010653e-01f, 1.26154065e-01f,
  9.99200106e-01f, 3.99893336e-02f, 9.99920011e-01f, 1.26487734e-02f, 9.99992013e-01f, 3.99998948e-03f, 9.99999225e-01f, 1.26491068e-03f,
  2.83662200e-01f, -9.58924294e-01f, -1.03423381e-02f, 9.99946535e-01f, 8.77582550e-01f, 4.79425550e-01f, 9.87526000e-01f, 1.57455876e-01f,
  9.98750269e-01f, 4.99791652e-02f, 9.99875009e-01f, 1.58107281e-02f, 9.99987483e-01f, 4.99997940e-03f, 9.99998748e-01f, 1.58113812e-03f,
  9.60170269e-01f, -2.79415488e-01f, -3.20796400e-01f, 9.47148204e-01f, 8.25335622e-01f, 5.64642489e-01f, 9.82053936e-01f, 1.88600272e-01f,
  9.98200536e-01f, 5.99640049e-02f, 9.99819994e-01f, 1.89725272e-02f, 9.99981999e-01f, 5.99996420e-03f, 9.99998212e-01f, 1.89736532e-03f,
  7.53902256e-01f, 6.56986594e-01f, -5.99437475e-01f, 8.00421596e-01f, 7.64842212e-01f, 6.44217670e-01f, 9.75599885e-01f, 2.19556093e-01f,
  9.97551024e-01f, 6.99428469e-02f, 9.99755025e-01f, 2.21341345e-02f, 9.99975502e-01f, 6.99994294e-03f, 9.99997556e-01f, 2.21359241e-03f,
  -1.45500034e-01f, 9.89358246e-01f, -8.18632424e-01f, 5.74317753e-01f, 6.96706712e-01f, 7.17356086e-01f, 9.68170285e-01f, 2.50292331e-01f,
  9.96801734e-01f, 7.99146891e-02f, 9.99680042e-01f, 2.52955221e-02f, 9.99967992e-01f, 7.99991470e-03f, 9.99996781e-01f, 2.52981926e-03f,
  -9.11130250e-01f, 4.12118495e-01f, -9.56644177e-01f, 2.91259229e-01f, 6.21609926e-01f, 7.83326924e-01f, 9.59772646e-01f, 2.80778319e-01f,
  9.95952725e-01f, 8.98785442e-02f, 9.99595046e-01f, 2.84566563e-02f, 9.99959528e-01f, 8.99987947e-03f, 9.99995947e-01f, 2.84604589e-03f,
  -8.39071512e-01f, -5.44021130e-01f, -9.99786079e-01f, -2.06835698e-02f, 5.40302277e-01f, 8.41470957e-01f, 9.50415313e-01f, 3.10983568e-01f,
  9.95004177e-01f, 9.98334140e-02f, 9.99500036e-01f, 3.16175036e-02f, 9.99949992e-01f, 9.99983400e-03f, 9.99994993e-01f, 3.16227227e-03f,
  4.42569796e-03f, -9.99990225e-01f, -9.43779767e-01f, -3.30574960e-01f, 4.53596085e-01f, 8.91207397e-01f, 9.40107584e-01f, 3.40877861e-01f,
  9.93956089e-01f, 1.09778300e-01f, 9.99395072e-01f, 3.47780399e-02f, 9.99939501e-01f, 1.09997792e-02f, 9.99993920e-01f, 3.47849843e-03f,
  8.43853951e-01f, -5.36572933e-01f, -7.94179380e-01f, -6.07683420e-01f, 3.62357706e-01f, 9.32039082e-01f, 9.28859890e-01f, 3.70431304e-01f,
  9.92808640e-01f, 1.19712204e-01f, 9.99280095e-01f, 3.79382223e-02f, 9.99927998e-01f, 1.19997123e-02f, 9.99992788e-01f, 3.79472389e-03f,
  9.07446802e-01f, 4.20167029e-01f, -5.65820515e-01f, -8.24528456e-01f, 2.67498761e-01f, 9.63558197e-01f, 9.16683376e-01f, 3.99614304e-01f,
  9.91561890e-01f, 1.29634142e-01f, 9.99155104e-01f, 4.10980321e-02f, 9.99915481e-01f, 1.29996343e-02f, 9.99991536e-01f, 4.11094911e-03f,
  1.36737213e-01f, 9.90607381e-01f, -2.81349480e-01f, -9.59605396e-01f, 1.69967160e-01f, 9.85449731e-01f, 9.03590262e-01f, 4.28397775e-01f,
  9.90216017e-01f, 1.39543116e-01f, 9.99020159e-01f, 4.42574248e-02f, 9.99902010e-01f, 1.39995432e-02f, 9.99990225e-01f, 4.42717411e-03f,
  -7.59687901e-01f, 6.50287867e-01f, 3.10223512e-02f, -9.99518692e-01f, 7.07371980e-02f, 9.97494996e-01f, 8.89593601e-01f, 4.56752867e-01f,
  9.88771081e-01f, 1.49438128e-01f, 9.98875201e-01f, 4.74163815e-02f, 9.99887526e-01f, 1.49994381e-02f, 9.99988735e-01f, 4.74339863e-03f,
  -9.57659483e-01f, -2.87903309e-01f, 3.40318173e-01f, -9.40310359e-01f, -2.91995462e-02f, 9.99573588e-01f, 8.74707460e-01f, 4.84651238e-01f,
  9.87227261e-01f, 1.59318209e-01f, 9.98720288e-01f, 5.05748577e-02f, 9.99872029e-01f, 1.59993190e-02f, 9.99987185e-01f, 5.05962269e-03f,
  -2.75163352e-01f, -9.61397469e-01f, 6.15864813e-01f, -7.87851870e-01f, -1.28844544e-01f, 9.91664827e-01f, 8.58946681e-01f, 5.12064993e-01f,
  9.85584795e-01f, 1.69182345e-01f, 9.98555362e-01f, 5.37328273e-02f, 9.99855518e-01f, 1.69991814e-02f, 9.99985576e-01f, 5.37584582e-03f,
  6.60316706e-01f, -7.50987232e-01f, 8.30336154e-01f, -5.57262897e-01f, -2.27202162e-01f, 9.73847628e-01f, 8.42327058e-01f, 5.38966715e-01f,
  9.83843684e-01f, 1.79029569e-01f, 9.98380423e-01f, 5.68902642e-02f, 9.99837995e-01f, 1.79990288e-02f, 9.99983788e-01f, 5.69206895e-03f,
  9.88704622e-01f, 1.49877205e-01f, 9.62463796e-01f, -2.71410108e-01f, -3.23289543e-01f, 9.46300089e-01f, 8.24865162e-01f, 5.65329552e-01f,
  9.82004225e-01f, 1.88858896e-01f, 9.98195529e-01f, 6.00471310e-02f, 9.99819517e-01f, 1.89988576e-02f, 9.99981940e-01f, 6.00829115e-03f,
  4.08082068e-01f, 9.12945271e-01f, 9.99144375e-01f, 4.13582884e-02f, -4.16146845e-01f, 9.09297407e-01f, 8.06578457e-01f, 5.91127038e-01f,
  9.80066597e-01f, 1.98669314e-01f, 9.98000681e-01f, 6.32033944e-02f, 9.99800026e-01f, 1.99986678e-02f, 9.99979973e-01f, 6.32451288e-03f,
  -5.47729254e-01f, 8.36655617e-01f, 9.36740458e-01f, 3.50024760e-01f, -5.04846215e-01f, 8.63209307e-01f, 7.87485182e-01f, 6.16333544e-01f,
  9.78030920e-01f, 2.08459899e-01f, 9.97795820e-01f, 6.63590282e-02f, 9.99779522e-01f, 2.09984574e-02f, 9.99977946e-01f, 6.64073415e-03f,
  -9.99960840e-01f, -8.85130931e-03f, 7.81440377e-01f, 6.23979926e-01f, -5.88501155e-01f, 8.08496356e-01f, 7.67604589e-01f, 6.40923738e-01f,
  9.75897431e-01f, 2.18229622e-01f, 9.97581005e-01f, 6.95140064e-02f, 9.99758005e-01f, 2.19982266e-02f, 9.99975801e-01f, 6.95695449e-03f,
  -5.32833040e-01f, -8.46220434e-01f, 5.48645258e-01f, 8.36055279e-01f, -6.66275978e-01f, 7.45705247e-01f, 7.46956408e-01f, 6.64873064e-01f,
  9.73666370e-01f, 2.27977514e-01f, 9.97356176e-01f, 7.26682767e-02f, 9.99735534e-01f, 2.29979735e-02f, 9.99973536e-01f, 7.27317436e-03f,
  4.24179018e-01f, -9.05578375e-01f, 2.61441678e-01f, 9.65219259e-01f, -7.37393796e-01f, 6.75463140e-01f, 7.25561321e-01f, 6.88157499e-01f,
  9.71337974e-01f, 2.37702623e-01f, 9.97121394e-01f, 7.58218244e-02f, 9.99711990e-01f, 2.39976961e-02f, 9.99971211e-01f, 7.58939330e-03f,
  9.91202831e-01f, -1.32351756e-01f, -5.16893305e-02f, 9.98663187e-01f, -8.01143587e-01f, 5.98472118e-01f, 7.03440726e-01f, 7.10753918e-01f,
  9.68912423e-01f, 2.47403964e-01f, 9.96876657e-01f, 7.89746121e-02f, 9.99687493e-01f, 2.49973964e-02f, 9.99968767e-01f, 7.90561177e-03f,
  6.46919310e-01f, 7.62558460e-01f, -3.59694332e-01f, 9.33070183e-01f, -8.56888831e-01f, 5.15501261e-01f, 6.80616796e-01f, 7.32639611e-01f,
  9.66389954e-01f, 2.57080555e-01f, 9.96621907e-01f, 8.21266174e-02f, 9.99662042e-01f, 2.59970706e-02f, 9.99966204e-01f, 8.22182931e-03f,
  -2.92138815e-01f, 9.56375957e-01f, -6.32028639e-01f, 7.74945021e-01f, -9.04072165e-01f, 4.27379847e-01f, 6.57112300e-01f, 7.53792703e-01f,
  9.63770926e-01f, 2.66731411e-01f, 9.96357203e-01f, 8.52777958e-02f, 9.99635518e-01f, 2.69967206e-02f, 9.99963522e-01f, 8.53804592e-03f,
  -9.62605894e-01f, 2.70905793e-01f, -8.41684937e-01f, 5.39968967e-01f, -9.42222297e-01f, 3.34988207e-01f, 6.32950664e-01f, 7.74192095e-01f,
  9.61055458e-01f, 2.76355654e-01f, 9.96082544e-01f, 8.84281173e-02f, 9.99608040e-01f, 2.79963426e-02f, 9.99960780e-01f, 8.85426160e-03f,
  -7.48057544e-01f, -6.63633883e-01f, -9.67871487e-01f, 2.51445323e-01f, -9.70958173e-01f, 2.39249229e-01f, 6.08156204e-01f, 7.93817401e-01f,
  9.58243906e-01f, 2.85952210e-01f, 9.95797932e-01f, 9.15775672e-02f, 9.99579549e-01f, 2.89959367e-02f, 9.99957979e-01f, 9.17047635e-03f,
  1.54251456e-01f, -9.88031626e-01f, -9.98075247e-01f, -6.20148405e-02f, -9.89992499e-01f, 1.41120002e-01f, 5.82753658e-01f, 8.12648892e-01f,
  9.55336511e-01f, 2.95520186e-01f, 9.95503366e-01f, 9.47260931e-02f, 9.99550045e-01f, 2.99955010e-02f, 9.99954998e-01f, 9.48669016e-03f,
  9.14742351e-01f, -4.04037654e-01f, -9.29300308e-01f, -3.69325012e-01f, -9.99135137e-01f, 4.15805206e-02f, 5.56768358e-01f, 8.30667794e-01f,
  9.52333570e-01f, 3.05058628e-01f, 9.95198846e-01f, 9.78736654e-02f, 9.99519527e-01f, 3.09950355e-02f, 9.99951959e-01f, 9.80290305e-03f,
  8.34223390e-01f, 5.51426709e-01f, -7.68367112e-01f, -6.40009403e-01f, -9.98294771e-01f, -5.83741926e-02f, 5.30226350e-01f, 8.47856104e-01f,
  9.49235439e-01f, 3.14566553e-01f, 9.94884372e-01f, 1.01020269e-01f, 9.99488056e-01f, 3.19945402e-02f, 9.99948800e-01f, 1.01191159e-02f,
  -1.32767474e-02f, 9.99911845e-01f, -5.31235278e-01f, -8.47224355e-01f, -9.87479806e-01f, -1.57745644e-01f, 5.03154159e-01f, 8.64196658e-01f,
  9.46042359e-01f, 3.24043006e-01f, 9.94559944e-01f, 1.04165860e-01f, 9.99455571e-01f, 3.29940096e-02f, 9.99945521e-01f, 1.04353270e-02f,
  -8.48570287e-01f, 5.29082716e-01f, -2.41421118e-01f, -9.70420420e-01f, -9.66798186e-01f, -2.55541205e-01f, 4.75578904e-01f, 8.79673064e-01f,
  9.42754686e-01f, 3.33487093e-01f, 9.94225562e-01f, 1.07310407e-01f, 9.99422073e-01f, 3.39934528e-02f, 9.99942183e-01f, 1.07515370e-02f,
  -9.03692186e-01f, -4.28182662e-01f, 7.23346695e-02f, -9.97380435e-01f, -9.36456680e-01f, -3.50783229e-01f, 4.47528064e-01f, 8.94269884e-01f,
  9.39372718e-01f, 3.42897803e-01f, 9.93881226e-01f, 1.10453881e-01f, 9.99387562e-01f, 3.49928550e-02f, 9.99938726e-01f, 1.10677453e-02f,
  -1.27963692e-01f, -9.91778851e-01f, 3.78916174e-01f, -9.25431013e-01f, -8.96758378e-01f, -4.42520559e-01f, 4.19029742e-01f, 9.07972515e-01f,
  9.35896814e-01f, 3.52274209e-01f, 9.93526995e-01f, 1.13596253e-01f, 9.99352098e-01f, 3.59922275e-02f, 9.99935210e-01f, 1.13839535e-02f,
  7.65414059e-01f, -6.43538117e-01f, 6.47921681e-01f, -7.61706948e-01f, -8.48100007e-01f, -5.29836178e-01f, 3.90112430e-01f, 9.20767248e-01f,
  9.32327330e-01f, 3.61615449e-01f, 9.93162811e-01f, 1.16737492e-01f, 9.99315560e-01f, 3.69915590e-02f, 9.99931574e-01f, 1.17001599e-02f,
  9.55073655e-01f, 2.96368569e-01f, 8.52673113e-01f, -5.22444785e-01f, -7.90967762e-01f, -6.11857831e-01f, 3.60805035e-01f, 9.32641268e-01f,
  9.28664625e-01f, 3.70920479e-01f, 9.92788672e-01f, 1.19877554e-01f, 9.99278069e-01f, 3.79908569e-02f, 9.99927819e-01f, 1.20163653e-02f,
  2.66642928e-01f, 9.63795364e-01f, 9.72865343e-01f, -2.31372014e-01f, -7.25932240e-01f, -6.87766254e-01f, 3.31136853e-01f, 9.43582714e-01f,
  9.24909055e-01f, 3.80188406e-01f, 9.92404640e-01f, 1.23016424e-01f, 9.99239624e-01f, 3.89901139e-02f, 9.99923944e-01f, 1.23325698e-02f,
  -6.66938066e-01f, 7.45113134e-01f, 9.96578991e-01f, 8.26458037e-02f, -6.53643608e-01f, -7.56802499e-01f, 3.01137596e-01f, 9.53580678e-01f,
  9.21060979e-01f, 3.89418334e-01f, 9.92010653e-01f, 1.26154065e-01f, 9.99200106e-01f, 3.99893373e-02f, 9.99920011e-01f, 1.26487734e-02f,
  -9.87339258e-01f, -1.58622667e-01f, 9.21462357e-01f, 3.88467699e-01f, -5.74824035e-01f, -8.18277061e-01f, 2.70837069e-01f, 9.62625206e-01f,
  9.17120814e-01f, 3.98609310e-01f, 9.91606772e-01f, 1.29290432e-01f, 9.99159634e-01f, 4.09885161e-02f, 9.99915957e-01f, 1.29649751e-02f,
  -3.99985313e-01f, -9.16521549e-01f, 7.54965365e-01f, 6.55764699e-01f, -4.90260571e-01f, -8.71575892e-01f, 2.40265876e-01f, 9.70707119e-01f,
  9.13088918e-01f, 4.07760441e-01f, 9.91192937e-01f, 1.32425532e-01f, 9.99118149e-01f, 4.19876575e-02f, 9.99911785e-01f, 1.32811759e-02f,
  5.55113316e-01f, -8.31774771e-01f, 5.13598442e-01f, 8.58030677e-01f, -4.00799006e-01f, -9.16166008e-01f, 2.09454417e-01f, 9.77818429e-01f,
  9.08965766e-01f, 4.16870773e-01f, 9.90769207e-01f, 1.35559291e-01f, 9.99075651e-01f, 4.29867506e-02f, 9.99907553e-01f, 1.35973748e-02f,
  9.99843299e-01f, 1.77019257e-02f, 2.21298173e-01f, 9.75206196e-01f, -3.07332784e-01f, -9.51602101e-01f, 1.78433523e-01f, 9.83951986e-01f,
  9.04751658e-01f, 4.25939471e-01f, 9.90335584e-01f, 1.38691694e-01f, 9.99032140e-01f, 4.39858064e-02f, 9.99903202e-01f, 1.39135728e-02f,
  5.25321960e-01f, 8.50903511e-01f, -9.29481089e-02f, 9.95670974e-01f, -2.10795805e-01f, -9.77530122e-01f, 1.47234216e-01f, 9.89101648e-01f,
  9.00447130e-01f, 4.34965521e-01f, 9.89892066e-01f, 1.41822711e-01f, 9.98987675e-01f, 4.49848175e-02f, 9.99898732e-01f, 1.42297689e-02f,
  -4.32177931e-01f, 9.01788354e-01f, -3.97976756e-01f, 9.17395473e-01f, -1.12152621e-01f, -9.93690968e-01f, 1.15887694e-01f, 9.93262351e-01f,
  8.96052480e-01f, 4.43948090e-01f, 9.89438653e-01f, 1.44952312e-01f, 9.98942196e-01f, 4.59837839e-02f, 9.99894202e-01f, 1.45459641e-02f,
  -9.92335498e-01f, 1.23573124e-01f, -6.63538277e-01f, 7.48142362e-01f, -1.23883775e-02f, -9.99923289e-01f, 8.44252855e-02f, 9.96429801e-01f,
  8.91568303e-01f, 4.52886283e-01f, 9.88975346e-01f, 1.48080453e-01f, 9.98895705e-01f, 4.69827019e-02f, 9.99889553e-01f, 1.48621574e-02f,
  -6.40144348e-01f, -7.68254638e-01f, -8.63296509e-01f, 5.04697084e-01f, 8.74991715e-02f, -9.96164620e-01f, 5.28784581e-02f, 9.98600960e-01f,
  8.86994898e-01f, 4.61779177e-01f, 9.88502085e-01f, 1.51207119e-01f, 9.98848200e-01f, 4.79815714e-02f, 9.99884784e-01f, 1.51783489e-02f,
  3.00592542e-01f, -9.53752637e-01f, -9.77442741e-01f, 2.11200655e-01f, 1.86512470e-01f, -9.82452571e-01f, 2.12787576e-02f, 9.99773562e-01f,
  8.82332861e-01f, 4.70625877e-01f, 9.88018990e-01f, 1.54332280e-01f, 9.98799741e-01f, 4.89803962e-02f, 9.99879956e-01f, 1.54945394e-02f,
  9.64965999e-01f, -2.62374848e-01f, -9.94656444e-01f, -1.03240460e-01f, 2.83662200e-01f, -9.58924294e-01f, -1.03422189e-02f, 9.99946535e-01f,
  8.77582550e-01f, 4.79425550e-01f, 9.87526000e-01f, 1.57455891e-01f, 9.98750269e-01f, 4.99791689e-02f, 9.99875009e-01f, 1.58107281e-02f,
  7.42154181e-01f, 6.70229197e-01f, -9.13230121e-01f, -4.07444149e-01f, 3.77977669e-01f, -9.25814748e-01f, -4.19528559e-02f, 9.99119580e-01f,
  8.72744501e-01f, 4.88177240e-01f, 9.87023175e-01f, 1.60577938e-01f, 9.98699784e-01f, 5.09778969e-02f, 9.99869943e-01f, 1.61269177e-02f,
  -1.62990779e-01f, 9.86627579e-01f, -7.41239965e-01f, -6.71240151e-01f, 4.68516916e-01f, -8.83454502e-01f, -7.35215396e-02f, 9.97293651e-01f,
  8.67819190e-01f, 4.96880114e-01f, 9.86510456e-01f, 1.63698375e-01f, 9.98648286e-01f, 5.19765690e-02f, 9.99864817e-01f, 1.64431017e-02f,
  -9.18282807e-01f, 3.95925164e-01f, -4.95741814e-01f, -8.68469954e-01f, 5.54374516e-01f, -8.32267344e-01f, -1.05016708e-01f, 9.94470477e-01f,
  8.62807095e-01f, 5.05533338e-01f, 9.85987842e-01f, 1.66817173e-01f, 9.98595834e-01f, 5.29751927e-02f, 9.99859571e-01f, 1.67592876e-02f,
  -8.29309821e-01f, -5.58789074e-01f, -2.01079622e-01f, -9.79574919e-01f, 6.34692967e-01f, -7.72764444e-01f, -1.36406869e-01f, 9.90652919e-01f,
  8.57708693e-01f, 5.14135957e-01f, 9.85455394e-01f, 1.69934288e-01f, 9.98542368e-01f, 5.39737605e-02f, 9.99854207e-01f, 1.70754679e-02f,
  2.21267566e-02f, -9.99755144e-01f, 1.13521777e-01f, -9.93535519e-01f, 7.08669782e-01f, -7.05540299e-01f, -1.67660639e-01f, 9.85844791e-01f,
  8.52524519e-01f, 5.22687256e-01f, 9.84913111e-01f, 1.73049718e-01f, 9.98487890e-01f, 5.49722798e-02f, 9.99848783e-01f, 1.73916500e-02f,
  8.53220105e-01f, -5.21551013e-01f, 4.16867077e-01f, -9.08967435e-01f, 7.75565803e-01f, -6.31266713e-01f, -1.98746875e-01f, 9.80050862e-01f,
  8.47255111e-01f, 5.31186223e-01f, 9.84360933e-01f, 1.76163420e-01f, 9.98432398e-01f, 5.59707358e-02f, 9.99843180e-01f, 1.77078284e-02f,
  8.99866819e-01f, 4.36164767e-01f, 6.78870201e-01f, -7.34258294e-01f, 8.34712923e-01f, -5.50685287e-01f, -2.29634270e-01f, 9.73276973e-01f,
  8.41901004e-01f, 5.39632022e-01f, 9.83798921e-01f, 1.79275364e-01f, 9.98375952e-01f, 5.69691435e-02f, 9.99837577e-01f, 1.80240069e-02f,
  1.19180135e-01f, 9.92872655e-01f, 8.73550534e-01f, -4.86733496e-01f, 8.85519624e-01f, -4.64602023e-01f, -2.60292053e-01f, 9.65529919e-01f,
  8.36462677e-01f, 5.48023939e-01f, 9.83227074e-01f, 1.82385504e-01f, 9.98318493e-01f, 5.79674877e-02f, 9.99831796e-01f, 1.83401816e-02f,
  -7.71080196e-01f, 6.36738002e-01f, 9.81602073e-01f, -1.90938011e-01f, 9.27478492e-01f, -3.73876572e-01f, -2.90689558e-01f, 9.56817448e-01f,
  8.30940723e-01f, 5.56361020e-01f, 9.82645452e-01f, 1.85493827e-01f, 9.98260021e-01f, 5.89657798e-02f, 9.99825954e-01f, 1.86563563e-02f,
  -9.52412963e-01f, -3.04810613e-01f, 9.92308319e-01f, 1.23790950e-01f, 9.60170269e-01f, -2.79415488e-01f, -3.20796400e-01f, 9.47148204e-01f,
  8.25335622e-01f, 5.64642429e-01f, 9.82053936e-01f, 1.88600287e-01f, 9.98200536e-01f, 5.99640086e-02f, 9.99819994e-01f, 1.89725272e-02f,
  -2.58101642e-01f, -9.66117799e-01f, 9.04607594e-01f, 4.26245421e-01f, 9.83268440e-01f, -1.82162598e-01f, -3.50582451e-01f, 9.36531842e-01f,
  8.19648027e-01f, 5.72867453e-01f, 9.81452644e-01f, 1.91704854e-01f, 9.98140097e-01f, 6.09621815e-02f, 9.99813974e-01f, 1.92886982e-02f,
  6.73507154e-01f, -7.39180684e-01f, 7.27198064e-01f, 6.86427653e-01f, 9.96542096e-01f, -8.30891207e-02f, -3.80017966e-01f, 9.24979091e-01f,
  8.13878477e-01f, 5.81035137e-01f, 9.80841517e-01f, 1.94807529e-01f, 9.98078644e-01f, 6.19602874e-02f, 9.99807835e-01f, 1.96048655e-02f,
  9.85896587e-01f, 1.67355701e-01f, 4.77671444e-01f, 8.78538549e-01f, 9.99858618e-01f, 1.68140903e-02f, -4.09073502e-01f, 9.12501454e-01f,
  8.08027506e-01f, 5.89144766e-01f, 9.80220556e-01f, 1.97908238e-01f, 9.98016179e-01f, 6.29583374e-02f, 9.99801576e-01f, 1.99210308e-02f,
};
__device__ const float TAB_S[2048] = {
  1.00000000e+00f, 0.00000000e+00f, 1.00000000e+00f, 0.00000000e+00f, 1.00000000e+00f, 0.00000000e+00f, 1.00000000e+00f, 0.00000000e+00f,
  1.00000000e+00f, 0.00000000e+00f, 1.00000000e+00f, 0.00000000e+00f, 1.00000000e+00f, 0.00000000e+00f, 1.00000000e+00f, 0.00000000e+00f,
  1.00000000e+00f, 0.00000000e+00f, 1.00000000e+00f, 0.00000000e+00f, 1.00000000e+00f, 0.00000000e+00f, 1.00000000e+00f, 0.00000000e+00f,
  1.00000000e+00f, 0.00000000e+00f, 1.00000000e+00f, 0.00000000e+00f, 1.00000000e+00f, 0.00000000e+00f, 1.00000000e+00f, 0.00000000e+00f,
  5.40302277e-01f, 8.41470957e-01f, 8.46009135e-01f, 5.33168435e-01f, 9.50415254e-01f, 3.10983598e-01f, 9.84230220e-01f, 1.76892191e-01f,
  9.95004177e-01f, 9.98334214e-02f, 9.98419285e-01f, 5.62044978e-02f, 9.99500036e-01f, 3.16175036e-02f, 9.99841869e-01f, 1.77818574e-02f,
  9.99949992e-01f, 9.99983307e-03f, 9.99984205e-01f, 5.62338345e-03f, 9.99994993e-01f, 3.16227227e-03f, 9.99998391e-01f, 1.77827850e-03f,
  9.99999523e-01f, 9.99999931e-04f, 9.99999821e-01f, 5.62341243e-04f, 9.99999940e-01f, 3.16227757e-04f, 1.00000000e+00f, 1.77827940e-04f,
  -4.16146845e-01f, 9.09297407e-01f, 4.31462824e-01f, 9.02130723e-01f, 8.06578398e-01f, 5.91127098e-01f, 9.37418282e-01f, 3.48205268e-01f,
  9.80066597e-01f, 1.98669329e-01f, 9.93682086e-01f, 1.12231314e-01f, 9.98000681e-01f, 6.32033944e-02f, 9.99367595e-01f, 3.55580896e-02f,
  9.99800026e-01f, 1.99986659e-02f, 9.99936759e-01f, 1.12465890e-02f, 9.99979973e-01f, 6.32451288e-03f, 9.99993682e-01f, 3.55655141e-03f,
  9.99997973e-01f, 1.99999870e-03f, 9.99999344e-01f, 1.12468237e-03f, 9.99999821e-01f, 6.32455456e-04f, 9.99999940e-01f, 3.55655880e-04f,
  -9.89992499e-01f, 1.41120002e-01f, -1.15966164e-01f, 9.93253171e-01f, 5.82753658e-01f, 8.12648892e-01f, 8.61040652e-01f, 5.08536100e-01f,
  9.55336511e-01f, 2.95520216e-01f, 9.85803485e-01f, 1.67903304e-01f, 9.95503366e-01f, 9.47260857e-02f, 9.98577297e-01f, 5.33230826e-02f,
  9.99550045e-01f, 2.99954992e-02f, 9.99857724e-01f, 1.68694388e-02f, 9.99954998e-01f, 9.48669016e-03f, 9.99985754e-01f, 5.33481315e-03f,
  9.99995530e-01f, 2.99999560e-03f, 9.99998569e-01f, 1.68702309e-03f, 9.99999523e-01f, 9.48683126e-04f, 9.99999881e-01f, 5.33483806e-04f,
  -6.53643608e-01f, -7.56802499e-01f, -6.27679706e-01f, 7.78471708e-01f, 3.01137477e-01f, 9.53580737e-01f, 7.57506192e-01f, 6.52827978e-01f,
  9.21060979e-01f, 3.89418334e-01f, 9.74808276e-01f, 2.23044485e-01f, 9.92010653e-01f, 1.26154065e-01f, 9.97471273e-01f, 7.10712075e-02f,
  9.99200106e-01f, 3.99893336e-02f, 9.99747038e-01f, 2.24917568e-02f, 9.99920011e-01f, 1.26487734e-02f, 9.99974728e-01f, 7.11305765e-03f,
  9.99992013e-01f, 3.99998948e-03f, 9.99997497e-01f, 2.24936334e-03f, 9.99999225e-01f, 1.26491068e-03f, 9.99999762e-01f, 7.11311703e-04f,
  2.83662200e-01f, -9.58924294e-01f, -9.46079254e-01f, 3.23935270e-01f, -1.03423381e-02f, 9.99946535e-01f, 6.30080283e-01f, 7.76529968e-01f,
  8.77582550e-01f, 4.79425550e-01f, 9.60731268e-01f, 2.77480543e-01f, 9.87526000e-01f, 1.57455876e-01f, 9.96049762e-01f, 8.87968615e-02f,
  9.98750269e-01f, 4.99791652e-02f, 9.99604762e-01f, 2.81133614e-02f, 9.99875009e-01f, 1.58107281e-02f, 9.99960482e-01f, 8.89127981e-03f,
  9.99987483e-01f, 4.99997940e-03f, 9.99996066e-01f, 2.81170290e-03f, 9.99998748e-01f, 1.58113812e-03f, 9.99999583e-01f, 8.89139599e-04f,
  9.60170269e-01f, -2.79415488e-01f, -9.73103702e-01f, -2.30367512e-01f, -3.20796400e-01f, 9.47148204e-01f, 4.82782036e-01f, 8.75740528e-01f,
  8.25335622e-01f, 5.64642489e-01f, 9.43616986e-01f, 3.31039310e-01f, 9.82053936e-01f, 1.88600272e-01f, 9.94313300e-01f, 1.06494442e-01f,
  9.98200536e-01f, 5.99640049e-02f, 9.99430835e-01f, 3.37340795e-02f, 9.99819994e-01f, 1.89725272e-02f, 9.99943078e-01f, 1.06694745e-02f,
  9.99981999e-01f, 5.99996420e-03f, 9.99994338e-01f, 3.37404152e-03f, 9.99998212e-01f, 1.89736532e-03f, 9.99999404e-01f, 1.06696738e-03f,
  7.53902256e-01f, 6.56986594e-01f, -7.00429797e-01f, -7.13721275e-01f, -5.99437475e-01f, 8.00421596e-01f, 3.20257008e-01f, 9.47330713e-01f,
  7.64842212e-01f, 6.44217670e-01f, 9.23519433e-01f, 3.83551568e-01f, 9.75599885e-01f, 2.19556093e-01f, 9.92262423e-01f, 1.24158338e-01f,
  9.97551024e-01f, 6.99428469e-02f, 9.99225318e-01f, 3.93537246e-02f, 9.99755025e-01f, 2.21341345e-02f, 9.99922514e-01f, 1.24476347e-02f,
  9.99975502e-01f, 6.99994294e-03f, 9.99992251e-01f, 3.93637875e-03f, 9.99997556e-01f, 2.21359241e-03f, 9.99999225e-01f, 1.24479528e-03f,
  -1.45500034e-01f, 9.89358246e-01f, -2.12036446e-01f, -9.77261782e-01f, -8.18632424e-01f, 5.74317753e-01f, 1.47631213e-01f, 9.89042461e-01f,
  6.96706712e-01f, 7.17356086e-01f, 9.00502324e-01f, 4.34851229e-01f, 9.68170285e-01f, 2.50292331e-01f, 9.89897788e-01f, 1.41782969e-01f,
  9.96801734e-01f, 7.99146891e-02f, 9.98988271e-01f, 4.49721329e-02f, 9.99680042e-01f, 2.52955221e-02f, 9.99898791e-01f, 1.42257558e-02f,
  9.99967992e-01f, 7.99991470e-03f, 9.99989867e-01f, 4.49871505e-03f, 9.99996781e-01f, 2.52981926e-03f, 9.99998987e-01f, 1.42262306e-03f,
  -9.11130250e-01f, 4.12118495e-01f, 3.41660261e-01f, -9.39823508e-01f, -9.56644177e-01f, 2.91259229e-01f, -2.96507962e-02f, 9.99560297e-01f,
  6.21609926e-01f, 7.83326924e-01f, 8.74638259e-01f, 4.84776139e-01f, 9.59772646e-01f, 2.80778319e-01f, 9.87220109e-01f, 1.59362778e-01f,
  9.95952725e-01f, 8.98785442e-02f, 9.98719573e-01f, 5.05891182e-02f, 9.99595046e-01f, 2.84566563e-02f, 9.99871910e-01f, 1.60038304e-02f,
  9.99959528e-01f, 8.99987947e-03f, 9.99987185e-01f, 5.06105041e-03f, 9.99995947e-01f, 2.84604589e-03f, 9.99998748e-01f, 1.60045072e-03f,
  -8.39071512e-01f, -5.44021130e-01f, 7.90131867e-01f, -6.12936914e-01f, -9.99786079e-01f, -2.06835698e-02f, -2.05997631e-01f, 9.78552461e-01f,
  5.40302277e-01f, 8.41470957e-01f, 8.46009135e-01f, 5.33168435e-01f, 9.50415313e-01f, 3.10983568e-01f, 9.84230220e-01f, 1.76892191e-01f,
  9.95004177e-01f, 9.98334140e-02f, 9.98419285e-01f, 5.62044978e-02f, 9.99500036e-01f, 3.16175036e-02f, 9.99841869e-01f, 1.77818574e-02f,
  9.99949992e-01f, 9.99983400e-03f, 9.99984205e-01f, 5.62338345e-03f, 9.99994993e-01f, 3.16227227e-03f, 9.99998391e-01f, 1.77827850e-03f,
  4.42569796e-03f, -9.99990225e-01f, 9.95257378e-01f, -9.72764567e-02f, -9.43779767e-01f, -3.30574960e-01f, -3.75847399e-01f, 9.26681578e-01f,
  4.53596085e-01f, 8.91207397e-01f, 8.14705312e-01f, 5.79875171e-01f, 9.40107584e-01f, 3.40877861e-01f, 9.80929136e-01f, 1.94365650e-01f,
  9.93956089e-01f, 1.09778300e-01f, 9.98087406e-01f, 6.18181042e-02f, 9.99395072e-01f, 3.47780399e-02f, 9.99808669e-01f, 1.95598267e-02f,
  9.99939501e-01f, 1.09997792e-02f, 9.99980867e-01f, 6.18571462e-03f, 9.99993920e-01f, 3.47849843e-03f, 9.99998093e-01f, 1.95610616e-03f,
  8.43853951e-01f, -5.36572933e-01f, 8.93861592e-01f, 4.48342979e-01f, -7.94179380e-01f, -6.07683420e-01f, -5.33843040e-01f, 8.45583618e-01f,
  3.62357706e-01f, 9.32039082e-01f, 7.80825913e-01f, 6.24748647e-01f, 9.28859890e-01f, 3.70431304e-01f, 9.77317870e-01f, 2.11777672e-01f,
  9.92808640e-01f, 1.19712204e-01f, 9.97723997e-01f, 6.74297586e-02f, 9.99280095e-01f, 3.79382223e-02f, 9.99772310e-01f, 2.13377345e-02f,
  9.99927998e-01f, 1.19997123e-02f, 9.99977231e-01f, 6.74804440e-03f, 9.99992788e-01f, 3.79472389e-03f, 9.99997735e-01f, 2.13393359e-03f,
  9.07446802e-01f, 4.20167029e-01f, 5.17172873e-01f, 8.55880976e-01f, -5.65820515e-01f, -8.24528456e-01f, -6.75001681e-01f, 7.37816215e-01f,
  2.67498761e-01f, 9.63558197e-01f, 7.44477987e-01f, 6.67647004e-01f, 9.16683376e-01f, 3.99614304e-01f, 9.73397553e-01f, 2.29122713e-01f,
  9.91561890e-01f, 1.29634142e-01f, 9.97329056e-01f, 7.30392784e-02f, 9.99155104e-01f, 4.10980321e-02f, 9.99732792e-01f, 2.31155735e-02f,
  9.99915481e-01f, 1.29996343e-02f, 9.99973297e-01f, 7.31037185e-03f, 9.99991536e-01f, 4.11094911e-03f, 9.99997318e-01f, 2.31176103e-03f,
  1.36737213e-01f, 9.90607381e-01f, -1.87961515e-02f, 9.99823332e-01f, -2.81349480e-01f, -9.59605396e-01f, -7.94870913e-01f, 6.06778562e-01f,
  1.69967160e-01f, 9.85449731e-01f, 7.05776393e-01f, 7.08434701e-01f, 9.03590262e-01f, 4.28397775e-01f, 9.69169438e-01f, 2.46395305e-01f,
  9.90216017e-01f, 1.39543116e-01f, 9.96902585e-01f, 7.86464810e-02f, 9.99020159e-01f, 4.42574248e-02f, 9.99690115e-01f, 2.48933397e-02f,
  9.99902010e-01f, 1.39995432e-02f, 9.99969006e-01f, 7.87269697e-03f, 9.99990225e-01f, 4.42717411e-03f, 9.99996901e-01f, 2.48958869e-03f,
  -7.59687901e-01f, 6.50287867e-01f, -5.48975468e-01f, 8.35838437e-01f, 3.10223512e-02f, -9.99518692e-01f, -8.89670432e-01f, 4.56603259e-01f,
  7.07371980e-02f, 9.97494996e-01f, 6.64843500e-01f, 7.46982634e-01f, 8.89593601e-01f, 4.56752867e-01f, 9.64634836e-01f, 2.63589978e-01f,
  9.88771081e-01f, 1.49438128e-01f, 9.96444523e-01f, 8.42512026e-02f, 9.98875201e-01f, 4.74163815e-02f, 9.99644279e-01f, 2.66710296e-02f,
  9.99887526e-01f, 1.49994381e-02f, 9.99964416e-01f, 8.43502022e-03f, 9.99988735e-01f, 4.74339863e-03f, 9.99996424e-01f, 2.66741589e-03f,
  -9.57659483e-01f, -2.87903309e-01f, -9.10081089e-01f, 4.14430231e-01f, 3.40318173e-01f, -9.40310359e-01f, -9.56410050e-01f, 2.92027086e-01f,
  -2.91995462e-02f, 9.99573588e-01f, 6.21808827e-01f, 7.83169091e-01f, 8.74707460e-01f, 4.84651238e-01f, 9.59795177e-01f, 2.80701309e-01f,
  9.87227261e-01f, 1.59318209e-01f, 9.95954990e-01f, 8.98532644e-02f, 9.98720288e-01f, 5.05748577e-02f, 9.99595284e-01f, 2.84486320e-02f,
  9.99872029e-01f, 1.59993190e-02f, 9.99959528e-01f, 8.99733976e-03f, 9.99987185e-01f, 5.05962269e-03f, 9.99995947e-01f, 2.84524332e-03f,
  -2.75163352e-01f, -9.61397469e-01f, -9.90897954e-01f, -1.34615138e-01f, 6.15864813e-01f, -7.87851870e-01f, -9.92985010e-01f, 1.18240520e-01f,
  -1.28844544e-01f, 9.91664827e-01f, 5.76808274e-01f, 8.16879570e-01f, 8.58946681e-01f, 5.12064993e-01f, 9.54652011e-01f, 2.97723860e-01f,
  9.85584795e-01f, 1.69182345e-01f, 9.95433986e-01f, 9.54524800e-02f, 9.98555362e-01f, 5.37328273e-02f, 9.99543071e-01f, 3.02261449e-02f,
  9.99855518e-01f, 1.69991814e-02f, 9.99954283e-01f, 9.55965649e-03f, 9.99985576e-01f, 5.37584582e-03f, 9.99995410e-01f, 3.02307028e-03f,
  6.60316706e-01f, -7.50987232e-01f, -7.66536534e-01f, -6.42200708e-01f, 8.30336154e-01f, -5.57262897e-01f, -9.98241663e-01f, -5.92755191e-02f,
  -2.27202162e-01f, 9.73847628e-01f, 5.29984176e-01f, 8.48007560e-01f, 8.42327058e-01f, 5.38966715e-01f, 9.49207008e-01f, 3.14652264e-01f,
  9.83843684e-01f, 1.79029569e-01f, 9.94881511e-01f, 1.01048686e-01f, 9.98380423e-01f, 5.68902642e-02f, 9.99487758e-01f, 3.20035629e-02f,
  9.99837995e-01f, 1.79990288e-02f, 9.99948800e-01f, 1.01219704e-02f, 9.99983788e-01f, 5.69206895e-03f, 9.99994874e-01f, 3.20089748e-03f,
  9.88704622e-01f, 1.49877205e-01f, -3.06095392e-01f, -9.52000856e-01f, 9.62463796e-01f, -2.71410108e-01f, -9.72014248e-01f, -2.34921798e-01f,
  -3.23289543e-01f, 9.46300089e-01f, 4.81484592e-01f, 8.76454532e-01f, 8.24865162e-01f, 5.65329552e-01f, 9.43461835e-01f, 3.31481189e-01f,
  9.82004225e-01f, 1.88858896e-01f, 9.94297504e-01f, 1.06641680e-01f, 9.98195529e-01f, 6.00471310e-02f, 9.99429286e-01f, 3.37808803e-02f,
  9.99819517e-01f, 1.89988576e-02f, 9.99942899e-01f, 1.06842816e-02f, 9.99981940e-01f, 6.00829115e-03f, 9.99994278e-01f, 3.37872445e-03f,
  4.08082068e-01f, 9.12945271e-01f, 2.48616725e-01f, -9.68601942e-01f, 9.99144375e-01f, 4.13582884e-02f, -9.15129960e-01f, -4.03158993e-01f,
  -4.16146845e-01f, 9.09297407e-01f, 4.31462824e-01f, 9.02130723e-01f, 8.06578457e-01f, 5.91127038e-01f, 9.37418282e-01f, 3.48205268e-01f,
  9.80066597e-01f, 1.98669314e-01f, 9.93682086e-01f, 1.12231314e-01f, 9.98000681e-01f, 6.32033944e-02f, 9.99367595e-01f, 3.55580896e-02f,
  9.99800026e-01f, 1.99986678e-02f, 9.99936759e-01f, 1.12465890e-02f, 9.99979973e-01f, 6.32451288e-03f, 9.99993682e-01f, 3.55655141e-03f,
  -5.47729254e-01f, 8.36655617e-01f, 7.26760268e-01f, -6.86891198e-01f, 9.36740458e-01f, 3.50024760e-01f, -8.29382956e-01f, -5.58680534e-01f,
  -5.04846215e-01f, 8.63209307e-01f, 3.80077004e-01f, 9.24954832e-01f, 7.87485182e-01f, 6.16333544e-01f, 9.31078374e-01f, 3.64819258e-01f,
  9.78030920e-01f, 2.08459899e-01f, 9.93035257e-01f, 1.17817394e-01f, 9.97795820e-01f, 6.63590282e-02f, 9.99302804e-01f, 3.73351872e-02f,
  9.99779522e-01f, 2.09984574e-02f, 9.99930263e-01f, 1.18088927e-02f, 9.99977946e-01f, 6.64073415e-03f, 9.99993026e-01f, 3.73437814e-03f,
  -9.99960840e-01f, -8.85130931e-03f, 9.81074572e-01f, -1.93630233e-01f, 7.81440377e-01f, 6.23979926e-01f, -7.17477441e-01f, -6.96581721e-01f,
  -5.88501155e-01f, 8.08496356e-01f, 3.27489585e-01f, 9.44854796e-01f, 7.67604589e-01f, 6.40923738e-01f, 9.24443960e-01f, 3.81317884e-01f,
  9.75897431e-01f, 2.18229622e-01f, 9.92357016e-01f, 1.23399742e-01f, 9.97581005e-01f, 6.95140064e-02f, 9.99234855e-01f, 3.91121693e-02f,
  9.99758005e-01f, 2.19982266e-02f, 9.99923468e-01f, 1.23711927e-02f, 9.99975801e-01f, 6.95695449e-03f, 9.99992371e-01f, 3.91220488e-03f,
  -5.32833040e-01f, -8.46220434e-01f, 9.33235765e-01f, 3.59264523e-01f, 5.48645258e-01f, 8.36055279e-01f, -5.82943261e-01f, -8.12512875e-01f,
  -6.66275978e-01f, 7.45705247e-01f, 2.73866832e-01f, 9.61767614e-01f, 7.46956408e-01f, 6.64873064e-01f, 9.17517304e-01f, 3.97695929e-01f,
  9.73666370e-01f, 2.27977514e-01f, 9.91647422e-01f, 1.28978193e-01f, 9.97356176e-01f, 7.26682767e-02f, 9.99163687e-01f, 4.08890247e-02f,
  9.99735534e-01f, 2.29979735e-02f, 9.99916375e-01f, 1.29334899e-02f, 9.99973536e-01f, 7.27317436e-03f, 9.99991655e-01f, 4.09003161e-03f,
  4.24179018e-01f, -9.05578375e-01f, 5.97977161e-01f, 8.01513135e-01f, 2.61441678e-01f, 9.65219259e-01f, -4.30023283e-01f, -9.02817786e-01f,
  -7.37393796e-01f, 6.75463140e-01f, 2.19378278e-01f, 9.75639880e-01f, 7.25561321e-01f, 6.88157499e-01f, 9.10300434e-01f, 4.13948208e-01f,
  9.71337974e-01f, 2.37702623e-01f, 9.90906477e-01f, 1.34552568e-01f, 9.97121394e-01f, 7.58218244e-02f, 9.99089420e-01f, 4.26657498e-02f,
  9.99711990e-01f, 2.39976961e-02f, 9.99908924e-01f, 1.34957815e-02f, 9.99971211e-01f, 7.58939330e-03f, 9.99990880e-01f, 4.26785741e-03f,
  9.91202831e-01f, -1.32351756e-01f, 7.85522610e-02f, 9.96909976e-01f, -5.16893305e-02f, 9.98663187e-01f, -2.63540596e-01f, -9.64648306e-01f,
  -8.01143587e-01f, 5.98472118e-01f, 1.64196163e-01f, 9.86427724e-01f, 7.03440726e-01f, 7.10753918e-01f, 9.02795732e-01f, 4.30069596e-01f,
  9.68912423e-01f, 2.47403964e-01f, 9.90134120e-01f, 1.40122697e-01f, 9.96876657e-01f, 7.89746121e-02f, 9.99011934e-01f, 4.44423407e-02f,
  9.99687493e-01f, 2.49973964e-02f, 9.99901175e-01f, 1.40580693e-02f, 9.99968767e-01f, 7.90561177e-03f, 9.99990106e-01f, 4.44568414e-03f,
  6.46919310e-01f, 7.62558460e-01f, -4.65064496e-01f, 8.85276794e-01f, -3.59694332e-01f, 9.33070183e-01f, -8.87455046e-02f, -9.96054351e-01f,
  -8.56888831e-01f, 5.15501261e-01f, 1.08494945e-01f, 9.94096994e-01f, 6.80616796e-01f, 7.32639611e-01f, 8.95005584e-01f, 4.46054995e-01f,
  9.66389954e-01f, 2.57080555e-01f, 9.89330530e-01f, 1.45688385e-01f, 9.96621907e-01f, 8.21266174e-02f, 9.98931348e-01f, 4.62187938e-02f,
  9.99662042e-01f, 2.59970706e-02f, 9.99893129e-01f, 1.46203535e-02f, 9.99966204e-01f, 8.22182931e-03f, 9.99989331e-01f, 4.62350994e-03f,
  -2.92138815e-01f, 9.56375957e-01f, -8.65450621e-01f, 5.00994205e-01f, -6.32028639e-01f, 7.74945021e-01f, 8.88481140e-02f, -9.96045172e-01f,
  -9.04072165e-01f, 4.27379847e-01f, 5.24506159e-02f, 9.98623490e-01f, 6.57112300e-01f, 7.53792703e-01f, 8.86932373e-01f, 4.61899310e-01f,
  9.63770926e-01f, 2.66731411e-01f, 9.88495648e-01f, 1.51249468e-01f, 9.96357203e-01f, 8.52777958e-02f, 9.98847544e-01f, 4.79951017e-02f,
  9.99635518e-01f, 2.69967206e-02f, 9.99884725e-01f, 1.51826320e-02f, 9.99963522e-01f, 8.53804592e-03f, 9.99988496e-01f, 4.80133574e-03f,
  -9.62605894e-01f, 2.70905793e-01f, -9.99293387e-01f, -3.75856608e-02f, -8.41684937e-01f, 5.39968967e-01f, 2.63639510e-01f, -9.64621305e-01f,
  -9.42222297e-01f, 3.34988207e-01f, -3.75941908e-03f, 9.99992907e-01f, 6.32950664e-01f, 7.74192095e-01f, 8.78578722e-01f, 4.77597594e-01f,
  9.61055458e-01f, 2.76355654e-01f, 9.87629473e-01f, 1.56805754e-01f, 9.96082544e-01f, 8.84281173e-02f, 9.98760641e-01f, 4.97712530e-02f,
  9.99608040e-01f, 2.79963426e-02f, 9.99876022e-01f, 1.57449059e-02f, 9.99960780e-01f, 8.85426160e-03f, 9.99987602e-01f, 4.97916201e-03f,
  -7.48057544e-01f, -6.63633883e-01f, -8.25371623e-01f, -5.64589798e-01f, -9.67871487e-01f, 2.51445323e-01f, 4.30115849e-01f, -9.02773678e-01f,
  -9.70958173e-01f, 2.39249229e-01f, -5.99575676e-02f, 9.98200953e-01f, 6.08156204e-01f, 7.93817401e-01f, 8.69947195e-01f, 4.93144840e-01f,
  9.58243906e-01f, 2.85952210e-01f, 9.86732066e-01f, 1.62357092e-01f, 9.95797932e-01f, 9.15775672e-02f, 9.98670578e-01f, 5.15472479e-02f,
  9.99579549e-01f, 2.89959367e-02f, 9.99867022e-01f, 1.63071752e-02f, 9.99957979e-01f, 9.17047635e-03f, 9.99986708e-01f, 5.15698735e-03f,
  1.54251456e-01f, -9.88031626e-01f, -3.97251874e-01f, -9.17709649e-01f, -9.98075247e-01f, -6.20148405e-02f, 5.83026946e-01f, -8.12452853e-01f,
  -9.89992499e-01f, 1.41120002e-01f, -1.15966164e-01f, 9.93253171e-01f, 5.82753658e-01f, 8.12648892e-01f, 8.61040652e-01f, 5.08536100e-01f,
  9.55336511e-01f, 2.95520186e-01f, 9.85803485e-01f, 1.67903304e-01f, 9.95503366e-01f, 9.47260931e-02f, 9.98577297e-01f, 5.33230826e-02f,
  9.99550045e-01f, 2.99955010e-02f, 9.99857724e-01f, 1.68694388e-02f, 9.99954998e-01f, 9.48669016e-03f, 9.99985754e-01f, 5.33481315e-03f,
  9.14742351e-01f, -4.04037654e-01f, 1.53215483e-01f, -9.88192797e-01f, -9.29300308e-01f, -3.69325012e-01f, 7.17549205e-01f, -6.96507812e-01f,
  -9.99135137e-01f, 4.15805206e-02f, -1.71608135e-01f, 9.85165298e-01f, 5.56768358e-01f, 8.30667794e-01f, 8.51861775e-01f, 5.23766637e-01f,
  9.52333570e-01f, 3.05058628e-01f, 9.84843671e-01f, 1.73444211e-01f, 9.95198846e-01f, 9.78736654e-02f, 9.98480916e-01f, 5.50987460e-02f,
  9.99519527e-01f, 3.09950355e-02f, 9.99848068e-01f, 1.74316969e-02f, 9.99951959e-01f, 9.80290305e-03f, 9.99984801e-01f, 5.51263802e-03f,
  8.34223390e-01f, 5.51426709e-01f, 6.56495154e-01f, -7.54330218e-01f, -7.68367112e-01f, -6.40009403e-01f, 8.29440355e-01f, -5.58595300e-01f,
  -9.98294771e-01f, -5.83741926e-02f, -2.26707578e-01f, 9.73962843e-01f, 5.30226350e-01f, 8.47856104e-01f, 8.42413545e-01f, 5.38831532e-01f,
  9.49235439e-01f, 3.14566553e-01f, 9.83852804e-01f, 1.78979620e-01f, 9.94884372e-01f, 1.01020269e-01f, 9.98381376e-01f, 5.68742342e-02f,
  9.99488056e-01f, 3.19945402e-02f, 9.99838114e-01f, 1.79939512e-02f, 9.99948800e-01f, 1.01191159e-02f, 9.99983788e-01f, 5.69046335e-03f,
  -1.32767474e-02f, 9.99911845e-01f, 9.57586050e-01f, -2.88147390e-01f, -5.31235278e-01f, -8.47224355e-01f, 9.15171385e-01f, -4.03064936e-01f,
  -9.87479806e-01f, -1.57745644e-01f, -2.81090319e-01f, 9.59681332e-01f, 5.03154159e-01f, 8.64196658e-01f, 8.32698941e-01f, 5.53726017e-01f,
  9.46042359e-01f, 3.24043006e-01f, 9.82830763e-01f, 1.84509367e-01f, 9.94559944e-01f, 1.04165860e-01f, 9.98278618e-01f, 5.86495437e-02f,
  9.99455571e-01f, 3.29940096e-02f, 9.99827802e-01f, 1.85561981e-02f, 9.99945521e-01f, 1.04353270e-02f, 9.99982774e-01f, 5.86828869e-03f,
  -8.48570287e-01f, 5.29082716e-01f, 9.63757515e-01f, 2.66779721e-01f, -2.41421118e-01f, -9.70420420e-01f, 9.72038329e-01f, -2.34822124e-01f,
  -9.66798186e-01f, -2.55541205e-01f, -3.34584385e-01f, 9.42365825e-01f, 4.75578904e-01f, 8.79673064e-01f, 8.22721004e-01f, 5.68445385e-01f,
  9.42754686e-01f, 3.33487093e-01f, 9.81777668e-01f, 1.90033287e-01f, 9.94225562e-01f, 1.07310407e-01f, 9.98172760e-01f, 6.04246669e-02f,
  9.99422073e-01f, 3.39934528e-02f, 9.99817252e-01f, 1.91184394e-02f, 9.99942183e-01f, 1.07515370e-02f, 9.99981701e-01f, 6.04611309e-03f,
  -9.03692186e-01f, -4.28182662e-01f, 6.73110247e-01f, 7.39542127e-01f, 7.23346695e-02f, -9.97380435e-01f, 9.98247743e-01f, -5.91726787e-02f,
  -9.36456680e-01f, -3.50783229e-01f, -3.87020677e-01f, 9.22071040e-01f, 4.47528064e-01f, 8.94269884e-01f, 8.12482953e-01f, 5.82984984e-01f,
  9.39372718e-01f, 3.42897803e-01f, 9.80693519e-01f, 1.95551202e-01f, 9.93881226e-01f, 1.10453881e-01f, 9.98063743e-01f, 6.21996038e-02f,
  9.99387562e-01f, 3.49928550e-02f, 9.99806345e-01f, 1.96806751e-02f, 9.99938726e-01f, 1.10677453e-02f, 9.99980628e-01f, 6.22393796e-03f,
  -1.27963692e-01f, -9.91778851e-01f, 1.75156534e-01f, 9.84540582e-01f, 3.78916174e-01f, -9.25431013e-01f, 9.92972851e-01f, 1.18342586e-01f,
  -8.96758378e-01f, -4.42520559e-01f, -4.38233554e-01f, 8.98861170e-01f, 4.19029742e-01f, 9.07972515e-01f, 8.01987886e-01f, 5.97340286e-01f,
  9.35896814e-01f, 3.52274209e-01f, 9.79578316e-01f, 2.01062918e-01f, 9.93526995e-01f, 1.13596253e-01f, 9.97951567e-01f, 6.39743358e-02f,
  9.99352098e-01f, 3.59922275e-02f, 9.99795079e-01f, 2.02429052e-02f, 9.99935210e-01f, 1.13839535e-02f, 9.99979496e-01f, 6.40176190e-03f,
  7.65414059e-01f, -6.43538117e-01f, -3.76742303e-01f, 9.26318109e-01f, 6.47921681e-01f, -7.61706948e-01f, 9.56380010e-01f, 2.92125374e-01f,
  -8.48100007e-01f, -5.29836178e-01f, -4.88060862e-01f, 8.72809589e-01f, 3.90112430e-01f, 9.20767248e-01f, 7.91239262e-01f, 6.11506701e-01f,
  9.32327330e-01f, 3.61615449e-01f, 9.78432178e-01f, 2.06568271e-01f, 9.93162811e-01f, 1.16737492e-01f, 9.97836173e-01f, 6.57488778e-02f,
  9.99315560e-01f, 3.69915590e-02f, 9.99783576e-01f, 2.08051261e-02f, 9.99931574e-01f, 1.17001599e-02f, 9.99978364e-01f, 6.57958630e-03f,
  9.55073655e-01f, 2.96368569e-01f, -8.12611222e-01f, 5.82806170e-01f, 8.52673113e-01f, -5.22444785e-01f, 8.89623463e-01f, 4.56694692e-01f,
  -7.90967762e-01f, -6.11857831e-01f, -5.36345184e-01f, 8.43998730e-01f, 3.60805035e-01f, 9.32641268e-01f, 7.80240417e-01f, 6.25479698e-01f,
  9.28664625e-01f, 3.70920479e-01f, 9.77255106e-01f, 2.12067112e-01f, 9.92788672e-01f, 1.19877554e-01f, 9.97717679e-01f, 6.75232038e-02f,
  9.99278069e-01f, 3.79908569e-02f, 9.99771714e-01f, 2.13673431e-02f, 9.99927819e-01f, 1.20163653e-02f, 9.99977171e-01f, 6.75741071e-03f,
  2.66642928e-01f, 9.63795364e-01f, -9.98210371e-01f, 5.98003156e-02f, 9.72865343e-01f, -2.31372014e-01f, 7.94808388e-01f, 6.06860459e-01f,
  -7.25932240e-01f, -6.87766254e-01f, -5.82933903e-01f, 8.12519610e-01f, 3.31136853e-01f, 9.43582714e-01f, 7.68994927e-01f, 6.39254928e-01f,
  9.24909055e-01f, 3.80188406e-01f, 9.76047099e-01f, 2.17559248e-01f, 9.92404640e-01f, 1.23016424e-01f, 9.97596025e-01f, 6.92973137e-02f,
  9.99239624e-01f, 3.89901139e-02f, 9.99759495e-01f, 2.19295528e-02f, 9.99923944e-01f, 1.23325698e-02f, 9.99975979e-01f, 6.93523418e-03f,
  -6.66938066e-01f, 7.45113134e-01f, -8.76379430e-01f, -4.81621295e-01f, 9.96578991e-01f, 8.26458037e-02f, 6.74925625e-01f, 7.37885714e-01f,
  -6.53643608e-01f, -7.56802499e-01f, -6.27679706e-01f, 7.78471708e-01f, 3.01137596e-01f, 9.53580678e-01f, 7.57506192e-01f, 6.52827978e-01f,
  9.21060979e-01f, 3.89418334e-01f, 9.74808276e-01f, 2.23044485e-01f, 9.92010653e-01f, 1.26154065e-01f, 9.97471273e-01f, 7.10712075e-02f,
  9.99200106e-01f, 3.99893373e-02f, 9.99747038e-01f, 2.24917568e-02f, 9.99920011e-01f, 1.26487734e-02f, 9.99974728e-01f, 7.11305765e-03f,
  -9.87339258e-01f, -1.58622667e-01f, -4.84639406e-01f, -8.74714017e-01f, 9.21462357e-01f, 3.88467699e-01f, 5.33756077e-01f, 8.45638454e-01f,
  -5.74824035e-01f, -8.18277061e-01f, -6.70441091e-01f, 7.41962790e-01f, 2.70837069e-01f, 9.62625206e-01f, 7.45777905e-01f, 6.66194677e-01f,
  9.17120814e-01f, 3.98609310e-01f, 9.73538578e-01f, 2.28522688e-01f, 9.91606772e-01f, 1.29290432e-01f, 9.97343302e-01f, 7.28448778e-02f,
  9.99159634e-01f, 4.09885161e-02f, 9.99734223e-01f, 2.30539497e-02f, 9.99915957e-01f, 1.29649751e-02f, 9.99973416e-01f, 7.29088066e-03f,
  -3.99985313e-01f, -9.16521549e-01f, 5.63609414e-02f, -9.98410463e-01f, 7.54965365e-01f, 6.55764699e-01f, 3.75752151e-01f, 9.26720202e-01f,
  -4.90260571e-01f, -8.71575892e-01f, -7.11082935e-01f, 7.03108132e-01f, 2.40265876e-01f, 9.70707119e-01f, 7.33813822e-01f, 6.79350674e-01f,
  9.13088918e-01f, 4.07760441e-01f, 9.72238123e-01f, 2.33993664e-01f, 9.91192937e-01f, 1.32425532e-01f, 9.97212172e-01f, 7.46183172e-02f,
  9.99118149e-01f, 4.19876575e-02f, 9.99721110e-01f, 2.36161388e-02f, 9.99911785e-01f, 1.32811759e-02f, 9.99972105e-01f, 7.46870413e-03f,
  5.55113316e-01f, -8.31774771e-01f, 5.80003142e-01f, -8.14614236e-01f, 5.13598442e-01f, 8.58030677e-01f, 2.05897167e-01f, 9.78573620e-01f,
  -4.00799006e-01f, -9.16166008e-01f, -7.49476731e-01f, 6.62030637e-01f, 2.09454417e-01f, 9.77818429e-01f, 7.21617639e-01f, 6.92291796e-01f,
  9.08965766e-01f, 4.16870773e-01f, 9.70906913e-01f, 2.39457220e-01f, 9.90769207e-01f, 1.35559291e-01f, 9.97077882e-01f, 7.63915181e-02f,
  9.99075651e-01f, 4.29867506e-02f, 9.99707639e-01f, 2.41783205e-02f, 9.99907553e-01f, 1.35973748e-02f, 9.99970794e-01f, 7.64652714e-03f,
  9.99843299e-01f, 1.77019257e-02f, 9.25014675e-01f, -3.79931390e-01f, 2.21298173e-01f, 9.75206196e-01f, 2.95478199e-02f, 9.99563396e-01f,
  -3.07332784e-01f, -9.51602101e-01f, -7.85501122e-01f, 6.18860185e-01f, 1.78433523e-01f, 9.83951986e-01f, 7.09193349e-01f, 7.05014050e-01f,
  9.04751658e-01f, 4.25939471e-01f, 9.69545007e-01f, 2.44913206e-01f, 9.90335584e-01f, 1.38691694e-01f, 9.96940494e-01f, 7.81644881e-02f,
  9.99032140e-01f, 4.39858064e-02f, 9.99693930e-01f, 2.47404929e-02f, 9.99903202e-01f, 1.39135728e-02f, 9.99969363e-01f, 7.82434922e-03f,
  5.25321960e-01f, 8.50903511e-01f, 9.85138178e-01f, 1.71763569e-01f, -9.29481089e-02f, 9.95670974e-01f, -1.47732988e-01f, 9.89027262e-01f,
  -2.10795805e-01f, -9.77530122e-01f, -8.19042206e-01f, 5.73733270e-01f, 1.47234216e-01f, 9.89101648e-01f, 6.96544766e-01f, 7.17513323e-01f,
  9.00447130e-01f, 4.34965521e-01f, 9.68152404e-01f, 2.50361472e-01f, 9.89892066e-01f, 1.41822711e-01f, 9.96799886e-01f, 7.99371973e-02f,
  9.98987675e-01f, 4.49848175e-02f, 9.99679863e-01f, 2.53026579e-02f, 9.99898732e-01f, 1.42297689e-02f, 9.99967992e-01f, 8.00217129e-03f,
  -4.32177931e-01f, 9.01788354e-01f, 7.41858006e-01f, 6.70557022e-01f, -3.97976756e-01f, 9.17395473e-01f, -3.20354372e-01f, 9.47297752e-01f,
  -1.12152621e-01f, -9.93690968e-01f, -8.49993885e-01f, 5.26792526e-01f, 1.15887694e-01f, 9.93262351e-01f, 6.83675885e-01f, 7.29785740e-01f,
  8.96052480e-01f, 4.43948090e-01f, 9.66729224e-01f, 2.55801797e-01f, 9.89438653e-01f, 1.44952312e-01f, 9.96656179e-01f, 8.17096606e-02f,
  9.98942196e-01f, 4.59837839e-02f, 9.99665439e-01f, 2.58648153e-02f, 9.99894202e-01f, 1.45459641e-02f, 9.99966562e-01f, 8.17999430e-03f,
  -9.92335498e-01f, 1.23573124e-01f, 2.70098448e-01f, 9.62832689e-01f, -6.63538277e-01f, 7.48142362e-01f, -4.82871950e-01f, 8.75690997e-01f,
  -1.23883775e-02f, -9.99923289e-01f, -8.78258407e-01f, 4.78186339e-01f, 8.44252855e-02f, 9.96429801e-01f, 6.70590878e-01f, 7.41827428e-01f,
  8.91568303e-01f, 4.52886283e-01f, 9.65275466e-01f, 2.61234075e-01f, 9.88975346e-01f, 1.48080453e-01f, 9.96509314e-01f, 8.34818557e-02f,
  9.98895705e-01f, 4.69827019e-02f, 9.99650776e-01f, 2.64269635e-02f, 9.99889553e-01f, 1.48621574e-02f, 9.99965072e-01f, 8.35781638e-03f,
  -6.40144348e-01f, -7.68254638e-01f, -2.84846604e-01f, 9.58573103e-01f, -8.63296509e-01f, 5.04697084e-01f, -6.30159974e-01f, 7.76465356e-01f,
  8.74991715e-02f, -9.96164620e-01f, -9.03746367e-01f, 4.28068399e-01f, 5.28784581e-02f, 9.98600960e-01f, 6.57293737e-01f, 7.53634512e-01f,
  8.86994898e-01f, 4.61779177e-01f, 9.63791192e-01f, 2.66658038e-01f, 9.88502085e-01f, 1.51207119e-01f, 9.96359289e-01f, 8.52537975e-02f,
  9.98848200e-01f, 4.79815714e-02f, 9.99635756e-01f, 2.69891042e-02f, 9.99884784e-01f, 1.51783489e-02f, 9.99963582e-01f, 8.53563752e-03f,
  3.00592542e-01f, -9.53752637e-01f, -7.52063990e-01f, 6.59090102e-01f, -9.77442741e-01f, 2.11200655e-01f, -7.57573068e-01f, 6.52750373e-01f,
  1.86512470e-01f, -9.82452571e-01f, -9.26377118e-01f, 3.76597136e-01f, 2.12787576e-02f, 9.99773562e-01f, 6.43788815e-01f, 7.65203178e-01f,
  8.82332861e-01f, 4.70625877e-01f, 9.62276459e-01f, 2.72073567e-01f, 9.88018990e-01f, 1.54332280e-01f, 9.96206105e-01f, 8.70254710e-02f,
  9.98799741e-01f, 4.89803962e-02f, 9.99620378e-01f, 2.75512375e-02f, 9.99879956e-01f, 1.54945394e-02f, 9.99962032e-01f, 8.71345960e-03f,
  9.64965999e-01f, -2.62374848e-01f, -9.87659097e-01f, 1.56619072e-01f, -9.94656444e-01f, -1.03240460e-01f, -8.61092687e-01f, 5.08447945e-01f,
  2.83662200e-01f, -9.58924294e-01f, -9.46079254e-01f, 3.23935270e-01f, -1.03422189e-02f, 9.99946535e-01f, 6.30080283e-01f, 7.76529968e-01f,
  8.77582550e-01f, 4.79425550e-01f, 9.60731268e-01f, 2.77480543e-01f, 9.87526000e-01f, 1.57455891e-01f, 9.96049762e-01f, 8.87968615e-02f,
  9.98750269e-01f, 4.99791689e-02f, 9.99604762e-01f, 2.81133596e-02f, 9.99875009e-01f, 1.58107281e-02f, 9.99960482e-01f, 8.89127981e-03f,
  7.42154181e-01f, 6.70229197e-01f, -9.19073522e-01f, -3.94086063e-01f, -9.13230121e-01f, -4.07444149e-01f, -9.37454224e-01f, 3.48108500e-01f,
  3.77977669e-01f, -9.25814748e-01f, -9.62790370e-01f, 2.70249337e-01f, -4.19528559e-02f, 9.99119580e-01f, 6.16172493e-01f, 7.87611187e-01f,
  8.72744501e-01f, 4.88177240e-01f, 9.59155679e-01f, 2.82878697e-01f, 9.87023175e-01f, 1.60577938e-01f, 9.95890260e-01f, 9.05679762e-02f,
  9.98699784e-01f, 5.09778969e-02f, 9.99588788e-01f, 2.86754742e-02f, 9.99869943e-01f, 1.61269177e-02f, 9.99958873e-01f, 9.06910095e-03f,
  -1.62990779e-01f, 9.86627579e-01f, -5.67430019e-01f, -8.23421597e-01f, -7.41239965e-01f, -6.71240151e-01f, -9.84248459e-01f, 1.76790684e-01f,
  4.68516916e-01f, -8.83454502e-01f, -9.76457715e-01f, 2.15709001e-01f, -7.35215396e-02f, 9.97293651e-01f, 6.02069914e-01f, 7.98443377e-01f,
  8.67819190e-01f, 4.96880114e-01f, 9.57549810e-01f, 2.88267940e-01f, 9.86510456e-01f, 1.63698375e-01f, 9.95727658e-01f, 9.23388004e-02f,
  9.98648286e-01f, 5.19765690e-02f, 9.99572515e-01f, 2.92375814e-02f, 9.99864817e-01f, 1.64431017e-02f, 9.99957263e-01f, 9.24692024e-03f,
  -9.18282807e-01f, 3.95925164e-01f, -4.10281904e-02f, -9.99157965e-01f, -4.95741814e-01f, -8.68469954e-01f, -1.00000000e+00f, -1.03020677e-04f,
  5.54374516e-01f, -8.32267344e-01f, -9.87038016e-01f, 1.60486728e-01f, -1.05016708e-01f, 9.94470477e-01f, 5.87776959e-01f, 8.09023023e-01f,
  8.62807095e-01f, 5.05533338e-01f, 9.55913603e-01f, 2.93648034e-01f, 9.85987842e-01f, 1.66817173e-01f, 9.95561838e-01f, 9.41093415e-02f,
  9.98595834e-01f, 5.29751927e-02f, 9.99555886e-01f, 2.97996756e-02f, 9.99859571e-01f, 1.67592876e-02f, 9.99955595e-01f, 9.42474138e-03f,
  -8.29309821e-01f, -5.58789074e-01f, 4.98009592e-01f, -8.67171526e-01f, -2.01079622e-01f, -9.79574919e-01f, -9.84212041e-01f, -1.76993474e-01f,
  6.34692967e-01f, -7.72764444e-01f, -9.94497895e-01f, 1.04756832e-01f, -1.36406869e-01f, 9.90652919e-01f, 5.73298037e-01f, 8.19346905e-01f,
  8.57708693e-01f, 5.14135957e-01f, 9.54247177e-01f, 2.99018890e-01f, 9.85455394e-01f, 1.69934288e-01f, 9.95392919e-01f, 9.58795771e-02f,
  9.98542368e-01f, 5.39737605e-02f, 9.99538958e-01f, 3.03617641e-02f, 9.99854207e-01f, 1.70754679e-02f, 9.99953866e-01f, 9.60256159e-03f,
  2.21267566e-02f, -9.99755144e-01f, 8.83669317e-01f, -4.68111664e-01f, 1.13521777e-01f, -9.93535519e-01f, -9.37382519e-01f, -3.48301649e-01f,
  7.08669782e-01f, -7.05540299e-01f, -9.98813629e-01f, 4.86960001e-02f, -1.67660639e-01f, 9.85844791e-01f, 5.58637917e-01f, 8.29411685e-01f,
  8.52524519e-01f, 5.22687256e-01f, 9.52550590e-01f, 3.04380238e-01f, 9.84913111e-01f, 1.73049718e-01f, 9.95220840e-01f, 9.76495072e-02f,
  9.98487890e-01f, 5.49722798e-02f, 9.99521732e-01f, 3.09238415e-02f, 9.99848783e-01f, 1.73916500e-02f, 9.99952197e-01f, 9.78038087e-03f,
  8.53220105e-01f, -5.21551013e-01f, 9.97174621e-01f, 7.51182064e-02f, 4.16867077e-01f, -9.08967435e-01f, -8.60988438e-01f, -5.08624554e-01f,
  7.75565803e-01f, -6.31266713e-01f, -9.99971747e-01f, -7.51878507e-03f, -1.98746875e-01f, 9.80050862e-01f, 5.43801069e-01f, 8.39214146e-01f,
  8.47255111e-01f, 5.31186223e-01f, 9.50823903e-01f, 3.09731960e-01f, 9.84360933e-01f, 1.76163420e-01f, 9.95045662e-01f, 9.94191393e-02f,
  9.98432398e-01f, 5.59707358e-02f, 9.99504209e-01f, 3.14859077e-02f, 9.99843180e-01f, 1.77078284e-02f, 9.99950409e-01f, 9.95820016e-03f,
  8.99866819e-01f, 4.36164767e-01f, 8.03569078e-01f, 5.95211506e-01f, 6.78870201e-01f, -7.34258294e-01f, -7.57439196e-01f, -6.52905703e-01f,
  8.34712923e-01f, -5.50685287e-01f, -9.97968495e-01f, -6.37097955e-02f, -2.29634270e-01f, 9.73276973e-01f, 5.28792322e-01f, 8.48751247e-01f,
  8.41901004e-01f, 5.39632022e-01f, 9.49067116e-01f, 3.15073937e-01f, 9.83798921e-01f, 1.79275364e-01f, 9.94867265e-01f, 1.01188451e-01f,
  9.98375952e-01f, 5.69691435e-02f, 9.99486327e-01f, 3.20479684e-02f, 9.99837577e-01f, 1.80240069e-02f, 9.99948621e-01f, 1.01360194e-02f,
  1.19180135e-01f, 9.92872655e-01f, 3.62476677e-01f, 9.31992829e-01f, 8.73550534e-01f, -4.86733496e-01f, -6.30000710e-01f, -7.76594579e-01f,
  8.85519624e-01f, -4.64602023e-01f, -9.92810190e-01f, -1.19699396e-01f, -2.60292053e-01f, 9.65529919e-01f, 5.13616323e-01f, 8.58020008e-01f,
  8.36462677e-01f, 5.48023939e-01f, 9.47280347e-01f, 3.20405900e-01f, 9.83227074e-01f, 1.82385504e-01f, 9.94685769e-01f, 1.02957435e-01f,
  9.98318493e-01f, 5.79674877e-02f, 9.99468148e-01f, 3.26100141e-02f, 9.99831796e-01f, 1.83401816e-02f, 9.99946833e-01f, 1.03138378e-02f,
  -7.71080196e-01f, 6.36738002e-01f, -1.90249100e-01f, 9.81735826e-01f, 9.81602073e-01f, -1.90938011e-01f, -4.82692331e-01f, -8.75790000e-01f,
  9.27478492e-01f, -3.73876572e-01f, -9.84513164e-01f, -1.75310582e-01f, -2.90689558e-01f, 9.56817448e-01f, 4.98277903e-01f, 8.67017388e-01f,
  8.30940723e-01f, 5.56361020e-01f, 9.45463598e-01f, 3.25727791e-01f, 9.82645452e-01f, 1.85493827e-01f, 9.94501114e-01f, 1.04726106e-01f,
  9.98260021e-01f, 5.89657798e-02f, 9.99449670e-01f, 3.31720486e-02f, 9.99825954e-01f, 1.86563563e-02f, 9.99944985e-01f, 1.04916561e-02f,
  -9.52412963e-01f, -3.04810613e-01f, -6.84381902e-01f, 7.29123712e-01f, 9.92308319e-01f, 1.23790950e-01f, -3.20159167e-01f, -9.47363734e-01f,
  9.60170269e-01f, -2.79415488e-01f, -9.73103702e-01f, -2.30367512e-01f, -3.20796400e-01f, 9.47148204e-01f, 4.82782036e-01f, 8.75740528e-01f,
  8.25335622e-01f, 5.64642429e-01f, 9.43616986e-01f, 3.31039310e-01f, 9.82053936e-01f, 1.88600287e-01f, 9.94313300e-01f, 1.06494442e-01f,
  9.98200536e-01f, 5.99640086e-02f, 9.99430835e-01f, 3.37340795e-02f, 9.99819994e-01f, 1.89725272e-02f, 9.99943078e-01f, 1.06694745e-02f,
  -2.58101642e-01f, -9.66117799e-01f, -9.67739642e-01f, 2.51952261e-01f, 9.04607594e-01f, 4.26245421e-01f, -1.47529200e-01f, -9.89057720e-01f,
  9.83268440e-01f, -1.82162598e-01f, -9.58617806e-01f, -2.84696162e-01f, -3.50582451e-01f, 9.36531842e-01f, 4.67133403e-01f, 8.84186864e-01f,
  8.19648027e-01f, 5.72867453e-01f, 9.41740453e-01f, 3.36340427e-01f, 9.81452644e-01f, 1.91704854e-01f, 9.94122326e-01f, 1.08262435e-01f,
  9.98140097e-01f, 6.09621815e-02f, 9.99411702e-01f, 3.42960916e-02f, 9.99813974e-01f, 1.92886982e-02f, 9.99941170e-01f, 1.08472919e-02f,
  6.73507154e-01f, -7.39180684e-01f, -9.53050017e-01f, -3.02812874e-01f, 7.27198064e-01f, 6.86427653e-01f, 2.97537707e-02f, -9.99557257e-01f,
  9.96542096e-01f, -8.30891207e-02f, -9.41101313e-01f, -3.38124752e-01f, -3.80017966e-01f, 9.24979091e-01f, 4.51337039e-01f, 8.92353535e-01f,
  8.13878477e-01f, 5.81035137e-01f, 9.39834237e-01f, 3.41630876e-01f, 9.80841517e-01f, 1.94807529e-01f, 9.93928254e-01f, 1.10030092e-01f,
  9.98078644e-01f, 6.19602874e-02f, 9.99392271e-01f, 3.48580964e-02f, 9.99807835e-01f, 1.96048655e-02f, 9.99939203e-01f, 1.10251084e-02f,
  9.85896587e-01f, 1.67355701e-01f, -6.44837022e-01f, -7.64320076e-01f, 4.77671444e-01f, 8.78538549e-01f, 2.06098333e-01f, -9.78531301e-01f,
  9.99858618e-01f, 1.68140903e-02f, -9.20609534e-01f, -3.90484393e-01f, -4.09073502e-01f, 9.12501454e-01f, 4.35397953e-01f, 9.00238097e-01f,
  8.08027506e-01f, 5.89144766e-01f, 9.37898219e-01f, 3.46910536e-01f, 9.80220556e-01f, 1.97908238e-01f, 9.93731022e-01f, 1.11797392e-01f,
  9.98016179e-01f, 6.29583374e-02f, 9.99372482e-01f, 3.54200937e-02f, 9.99801576e-01f, 1.99210308e-02f, 9.99937236e-01f, 1.12029258e-02f,
};

constexpr int T_ALL = 36864, T_CTX = 4096;
constexpr int NLAYER = 4;
constexpr float EPS = 1e-6f;
constexpr int LK_LAT = 4352;

struct Params {
  const float* x_prompt; const float* x_sample; const float* cache_ckv; const float* cache_krope;
  const float* cache_k; const float* cache_v; const float* state; const float* c; const float* c_ctx;
  const float* w_mod; const float* b_mod; const float* g_norm; const float* w_in; const float* conv_w; const float* conv_b;
  const float* lru_wa; const float* lru_ba; const float* lru_wi; const float* lru_bi; const float* lru_lam;
  const float* q_norm; const float* w_uq; const float* kv_norm; const float* w_ukv; const float* sink;
  const float* w_br_rnn; const float* w_br_mla; const float* w_br_swa; const float* w_out; const float* final_norm;
  float* out; char* ws;
};

constexpr size_t AL(size_t x) { return (x + 255) & ~(size_t)255; }
constexpr size_t O_WINA = 0;
constexpr size_t O_WINB = O_WINA + AL((size_t)2560 * 1024 * 2);
constexpr size_t O_WLRU = O_WINB + AL((size_t)5120 * 1024 * 2);
constexpr size_t O_WUQ = O_WLRU + AL((size_t)4096 * 128 * 2);
constexpr size_t O_WUKVG = O_WUQ + AL((size_t)768 * 384 * 2);
constexpr size_t O_WUKVR = O_WUKVG + AL((size_t)1024 * 256 * 2);
constexpr size_t O_WBRR = O_WUKVR + AL((size_t)1024 * 256 * 2);
constexpr size_t O_WBRM = O_WBRR + AL((size_t)1024 * 1024 * 2);
constexpr size_t O_WBRS = O_WBRM + AL((size_t)1024 * 512 * 2);
constexpr size_t O_WOUT = O_WBRS + AL((size_t)1024 * 512 * 2);
constexpr size_t O_MOD = O_WOUT + AL((size_t)1024 * 1024 * 2);
constexpr size_t O_H = O_MOD + AL((size_t)4 * 9 * 3072 * 4);
constexpr size_t O_XR = O_H + AL((size_t)T_ALL * 1024 * 2);
constexpr size_t O_CQ = O_XR + AL((size_t)T_ALL * 1024 * 2);
constexpr size_t O_CKV = O_CQ + AL((size_t)T_ALL * 384 * 2);
constexpr size_t O_CKVC = O_CKV + AL((size_t)T_ALL * 256 * 2);
constexpr size_t O_KRL = O_CKVC + AL((size_t)2048 * 256 * 2);
constexpr size_t O_KRC = O_KRL + AL((size_t)8 * LK_LAT * 32 * 2);
constexpr size_t O_QS = O_KRC + AL((size_t)16 * 256 * 32 * 2);
constexpr size_t O_KS = O_QS + AL((size_t)T_ALL * 512 * 2);
constexpr size_t O_KSC = O_KS + AL((size_t)T_ALL * 128 * 2);
constexpr size_t O_VTSL = O_KSC + AL((size_t)8 * 256 * 128 * 2);
constexpr size_t O_VTSC = O_VTSL + AL((size_t)8 * 2 * 64 * 4096 * 2);
constexpr size_t O_VTSCC = O_VTSC + AL((size_t)16 * 2 * 64 * 256 * 2);
constexpr size_t O_Q = O_VTSCC + AL((size_t)8 * 2 * 64 * 256 * 2);
constexpr size_t O_KNL = O_Q + AL((size_t)T_ALL * 768 * 2);
constexpr size_t O_KNC = O_KNL + AL((size_t)8 * 8 * LK_LAT * 64 * 2);
constexpr size_t O_VTL = O_KNC + AL((size_t)16 * 8 * 256 * 64 * 2);
constexpr size_t O_VTC = O_VTL + AL((size_t)8 * 8 * 64 * LK_LAT * 2);
constexpr size_t O_YRNN = O_VTC + AL((size_t)16 * 8 * 64 * 256 * 2);
constexpr size_t WS_NEED = O_YRNN + AL((size_t)T_ALL * 1024 * 2);

constexpr size_t OUT_CKV = (size_t)T_ALL * 1024;
constexpr size_t OUT_KROPE = OUT_CKV + (size_t)16 * 4 * 256 * 256;
constexpr size_t OUT_SK = OUT_KROPE + (size_t)16 * 4 * 256 * 32;
constexpr size_t OUT_SV = OUT_SK + (size_t)16 * 4 * 256 * 128;
constexpr size_t OUT_RG = OUT_SV + (size_t)16 * 4 * 256 * 128;

#define SB() __builtin_amdgcn_sched_barrier(0)
DI int tid() { int t = threadIdx.x; asm volatile("" : "+v"(t)); return t; }
#define LANEVARS const int t = tid(), lane = t & 63, w = t >> 6, wr = w >> 1, wc = w & 1; const int c16 = lane & 15, g4 = lane >> 4; (void)wr; (void)wc; (void)c16; (void)g4;
DI float bf2f(u16 v) { return __uint_as_float(((unsigned)v) << 16); }
DI unsigned pack2(float a, float b) {
  f2_t v = {a, b};
  bf2_t r = __builtin_convertvector(v, bf2_t);
  return __builtin_bit_cast(unsigned, r);
}
DI u16 f2bf(float a) { return (u16)(pack2(a, 0.f) & 0xffffu); }
DI float sigmoidf_(float x) { return 1.f / (1.f + __expf(-x)); }
DI float wave_sum(float v) {
#pragma unroll
  for (int o = 32; o > 0; o >>= 1) v += __shfl_xor(v, o);
  return v;
}
DI int perm32(int p) { return (p & 7) | ((p & 8) << 1) | ((p & 16) >> 1); }
DI const float* xin_row(const Params& p, int l, int row) {
  if (l == 0) return row < T_CTX ? p.x_prompt + (size_t)row * 1024 : p.x_sample + (size_t)(row - T_CTX) * 1024;
  return p.out + (size_t)row * 1024;
}
template <class T> DI T* wsp(const Params& p, size_t off) { return (T*)(p.ws + off); }

template <int NJ>
DI void gemm_tile_t(const u16* __restrict__ A, int lda, const u16* __restrict__ B, int ldb, int K,
                    f32x4 (&acc)[4][NJ], char* smem) {
  constexpr int NB = NJ;
  const int t = tid(), lane = t & 63, w = t >> 6, wr = w >> 1, wc = w & 1;
  const int lr = t >> 3, lch = t & 7;
  const int c16 = lane & 15, g4 = lane >> 4;
  const u16* ap = A + (size_t)lr * lda + lch * 8;
  const u16* bp = B + (size_t)lr * ldb + lch * 8;
  const int soff = lr * 128 + ((lch ^ (lr & 7)) << 4);
  uint4 ra[4], rb[NB];
#pragma unroll
  for (int i = 0; i < 4; ++i) ra[i] = *(const uint4*)(ap + (size_t)(32 * i) * lda);
#pragma unroll
  for (int i = 0; i < NB; ++i) rb[i] = *(const uint4*)(bp + (size_t)(32 * i) * ldb);
#pragma unroll
  for (int i = 0; i < 4; ++i) *(uint4*)(smem + soff + i * 4096) = ra[i];
#pragma unroll
  for (int i = 0; i < NB; ++i) *(uint4*)(smem + 16384 + soff + i * 4096) = rb[i];
  __syncthreads();
  const int nk = K >> 6;
  const int arow = (wr * 64 + c16) * 128, brow = (wc * (16 * NJ) + c16) * 128;
  const int sw = c16 & 7;
  for (int kt = 0; kt < nk; ++kt) {
    char* cur = smem + (kt & 1) * 32768;
    const bool more = (kt + 1 < nk);
    if (more) {
      const int ko = (kt + 1) * 64;
#pragma unroll
      for (int i = 0; i < 4; ++i) ra[i] = *(const uint4*)(ap + (size_t)(32 * i) * lda + ko);
#pragma unroll
      for (int i = 0; i < NB; ++i) rb[i] = *(const uint4*)(bp + (size_t)(32 * i) * ldb + ko);
    }
#pragma unroll
    for (int ks = 0; ks < 2; ++ks) {
      bf16x8 af[4], bfr[NJ];
      const int ch = ((ks * 4 + g4) ^ sw) << 4;
#pragma unroll
      for (int i = 0; i < 4; ++i) af[i] = *(const bf16x8*)(cur + arow + i * 2048 + ch);
#pragma unroll
      for (int i = 0; i < NJ; ++i) bfr[i] = *(const bf16x8*)(cur + 16384 + brow + i * 2048 + ch);
#pragma unroll
      for (int i = 0; i < 4; ++i)
#pragma unroll
        for (int j = 0; j < NJ; ++j)
          acc[i][j] = __builtin_amdgcn_mfma_f32_16x16x32_bf16(af[i], bfr[j], acc[i][j], 0, 0, 0);
    }
    if (more) {
      char* nxt = smem + ((kt + 1) & 1) * 32768;
#pragma unroll
      for (int i = 0; i < 4; ++i) *(uint4*)(nxt + soff + i * 4096) = ra[i];
#pragma unroll
      for (int i = 0; i < NB; ++i) *(uint4*)(nxt + 16384 + soff + i * 4096) = rb[i];
    }
    __syncthreads();
  }
}
DI void gemm_tile(const u16* __restrict__ A, int lda, const u16* __restrict__ B, int ldb, int K,
                  f32x4 (&acc)[4][4], char* smem) {
  gemm_tile_t<4>(A, lda, B, ldb, K, acc, smem);
}
DI void zero_acc(f32x4 (&acc)[4][4]) {
#pragma unroll
  for (int i = 0; i < 4; ++i)
#pragma unroll
    for (int j = 0; j < 4; ++j) acc[i][j] = f32x4{0.f, 0.f, 0.f, 0.f};
}

struct TokTile { int g0; int is_ctx; int b; int p0; };
DI TokTile tok_tile(int mt) {
  TokTile r; r.g0 = mt * 128;
  if (r.g0 < T_CTX) { r.is_ctx = 1; r.b = r.g0 >> 8; r.p0 = r.g0 & 255; }
  else { r.is_ctx = 0; r.b = (r.g0 - T_CTX) >> 12; r.p0 = (r.g0 - T_CTX) & 4095; }
  return r;
}

DI void phase_mod(const Params& p, char* smem) {
  float* s_silu = (float*)smem;
  float* s_part = (float*)(smem + 36864);
  float* MOD = wsp<float>(p, O_MOD);
  const int t = tid();
  for (int i = t; i < 9 * 1024; i += 256) {
    float v = (i < 8192) ? p.c[i] : p.c_ctx[i - 8192];
    s_silu[i] = v * sigmoidf_(v);
  }
  __syncthreads();
  const int kg = t >> 6, cl = t & 63;
  for (int u = blockIdx.x; u < 4 * 48; u += gridDim.x) {
    const int l = u / 48, cb = u % 48;
    const int n = cb * 64 + cl;
    float acc[9];
#pragma unroll
    for (int ci = 0; ci < 9; ++ci) acc[ci] = 0.f;
    const float* wp = p.w_mod + ((size_t)l * 1024 + kg * 256) * 3072 + n;
    for (int k = 0; k < 256; ++k) {
      float wv = wp[(size_t)k * 3072];
#pragma unroll
      for (int ci = 0; ci < 9; ++ci) acc[ci] += s_silu[ci * 1024 + kg * 256 + k] * wv;
    }
#pragma unroll
    for (int ci = 0; ci < 9; ++ci) s_part[(kg * 9 + ci) * 64 + cl] = acc[ci];
    __syncthreads();
    for (int idx = t; idx < 9 * 64; idx += 256) {
      int ci = idx >> 6, c2 = idx & 63;
      float s = s_part[(0 * 9 + ci) * 64 + c2] + s_part[(1 * 9 + ci) * 64 + c2] + s_part[(2 * 9 + ci) * 64 + c2] +
                s_part[(3 * 9 + ci) * 64 + c2];
      MOD[((size_t)l * 9 + ci) * 3072 + cb * 64 + c2] = s + p.b_mod[l * 3072 + cb * 64 + c2];
    }
    __syncthreads();
  }
}

template <class F> DI void conv_job(u16* dst, int N, int K, F src) {
  const int total = N * (K >> 3);
  for (int idx = blockIdx.x * 256 + tid(); idx < total; idx += gridDim.x * 256) {
    const int n = idx % N, kb = idx / N;
    float v[8];
#pragma unroll
    for (int j = 0; j < 8; ++j) v[j] = src(kb * 8 + j, n);
    uint4 o;
    o.x = pack2(v[0], v[1]); o.y = pack2(v[2], v[3]); o.z = pack2(v[4], v[5]); o.w = pack2(v[6], v[7]);
    *(uint4*)(dst + (size_t)n * K + kb * 8) = o;
  }
}

DI void phase_prep(const Params& p, int l) {
  const int t = tid(), lane = t & 63, w = t >> 6;
  const float* MOD = wsp<float>(p, O_MOD) + (size_t)l * 9 * 3072;
  u16* H = wsp<u16>(p, O_H);
  for (int row = blockIdx.x * 4 + w; row < T_ALL; row += gridDim.x * 4) {
    const float* x = xin_row(p, l, row);
    const int ci = row < T_CTX ? 8 : ((row - T_CTX) >> 12);
    const float* md = MOD + ci * 3072;
    float4 v[4];
    float ss = 0.f;
#pragma unroll
    for (int i = 0; i < 4; ++i) {
      v[i] = *(const float4*)(x + i * 256 + lane * 4);
      ss += v[i].x * v[i].x + v[i].y * v[i].y + v[i].z * v[i].z + v[i].w * v[i].w;
    }
    ss = wave_sum(ss);
    const float rs = rsqrtf(ss * (1.f / 1024.f) + EPS);
#pragma unroll
    for (int i = 0; i < 4; ++i) {
      const int c = i * 256 + lane * 4;
      const float4 g = *(const float4*)(p.g_norm + l * 1024 + c);
      const float4 sh = *(const float4*)(md + c);
      const float4 sc = *(const float4*)(md + 1024 + c);
      float h0 = v[i].x * rs * g.x * (1.f + sc.x) + sh.x;
      float h1 = v[i].y * rs * g.y * (1.f + sc.y) + sh.y;
      float h2 = v[i].z * rs * g.z * (1.f + sc.z) + sh.z;
      float h3 = v[i].w * rs * g.w * (1.f + sc.w) + sh.w;
      uint2 o; o.x = pack2(h0, h1); o.y = pack2(h2, h3);
      *(uint2*)(H + (size_t)row * 1024 + c) = o;
    }
  }
  {
    const float* win = p.w_in + (size_t)l * 1024 * 7584;
    conv_job(wsp<u16>(p, O_WINA), 2560, 1024, [&](int k, int n) -> float {
      int col;
      if (n < 1024) col = n;
      else if (n < 1408) col = 2048 + (n - 1024);
      else if (n < 1664) col = 2432 + (n - 1408);
      else if (n < 1792) { int pp = n - 1664; col = pp < 32 ? 2688 + perm32(pp) : -1; }
      else if (n < 2304) col = 3232 + (n - 1792);
      else if (n < 2432) col = 3744 + (n - 2304);
      else col = 3872 + (n - 2432);
      return col < 0 ? 0.f : win[(size_t)k * 7584 + col];
    });
    conv_job(wsp<u16>(p, O_WINB), 5120, 1024, [&](int k, int n) -> float {
      int col;
      if (n < 1024) col = 1024 + n;
      else if (n < 1536) col = 2720 + (n - 1024);
      else if (n < 2048) col = 4000 + (n - 1536);
      else col = 4512 + (n - 2048);
      return win[(size_t)k * 7584 + col];
    });
    const float* wa = p.lru_wa + (size_t)l * 2 * 8 * 128 * 128;
    const float* wi = p.lru_wi + (size_t)l * 2 * 8 * 128 * 128;
    conv_job(wsp<u16>(p, O_WLRU), 4096, 128, [&](int k, int n) -> float {
      int db = n >> 8, nn = n & 255;
      return nn < 128 ? wa[((size_t)db * 128 + k) * 128 + nn] : wi[((size_t)db * 128 + k) * 128 + (nn - 128)];
    });
    const float* wuq = p.w_uq + (size_t)l * 384 * 768;
    const float* gq = p.q_norm + l * 384;
    conv_job(wsp<u16>(p, O_WUQ), 768, 384, [&](int k, int n) -> float {
      int col;
      if (n < 512) col = (n >> 6) * 96 + (n & 63);
      else { int hh = (n - 512) >> 5, pp = (n - 512) & 31; col = hh * 96 + 64 + perm32(pp); }
      return gq[k] * wuq[(size_t)k * 768 + col];
    });
    const float* wukv = p.w_ukv + (size_t)l * 256 * 1024;
    const float* gkv = p.kv_norm + l * 256;
    conv_job(wsp<u16>(p, O_WUKVG), 1024, 256, [&](int k, int n) -> float { return gkv[k] * wukv[(size_t)k * 1024 + n]; });
    conv_job(wsp<u16>(p, O_WUKVR), 1024, 256, [&](int k, int n) -> float { return wukv[(size_t)k * 1024 + n]; });
    const float* w1 = p.w_br_rnn + (size_t)l * 1024 * 1024;
    conv_job(wsp<u16>(p, O_WBRR), 1024, 1024, [&](int k, int n) -> float { return w1[(size_t)k * 1024 + n]; });
    const float* w2 = p.w_br_mla + (size_t)l * 512 * 1024;
    conv_job(wsp<u16>(p, O_WBRM), 1024, 512, [&](int k, int n) -> float { return w2[(size_t)k * 1024 + n]; });
    const float* w3 = p.w_br_swa + (size_t)l * 512 * 1024;
    conv_job(wsp<u16>(p, O_WBRS), 1024, 512, [&](int k, int n) -> float { return w3[(size_t)k * 1024 + n]; });
    const float* w4 = p.w_out + (size_t)l * 1024 * 1024;
    conv_job(wsp<u16>(p, O_WOUT), 1024, 1024, [&](int k, int n) -> float { return w4[(size_t)k * 1024 + n]; });
  }
  {
    const int gt = blockIdx.x * 256 + t, gs = gridDim.x * 256;
    u16* ckvc = wsp<u16>(p, O_CKVC);
    for (int i = gt; i < 2048 * 256; i += gs) {
      int r = i >> 8, k = i & 255, b = r >> 8, pos = r & 255;
      ckvc[i] = f2bf(p.cache_ckv[(((size_t)b * 4 + l) * 256 + pos) * 256 + k]);
    }
    u16* krl = wsp<u16>(p, O_KRL);
    for (int i = gt; i < 8 * 256 * 32; i += gs) {
      int pp = i & 31, pos = (i >> 5) & 255, b = i >> 13;
      krl[((size_t)b * LK_LAT + pos) * 32 + pp] = f2bf(p.cache_krope[(((size_t)b * 4 + l) * 256 + pos) * 32 + perm32(pp)]);
    }
    u16* ksc = wsp<u16>(p, O_KSC);
    for (int i = gt; i < 8 * 256 * 128; i += gs) {
      int c = i & 127, pos = (i >> 7) & 255, b = i >> 15;
      ksc[i] = f2bf(p.cache_k[(((size_t)b * 4 + l) * 256 + pos) * 128 + c]);
    }
    u16* vtc = wsp<u16>(p, O_VTSCC);
    for (int i = gt; i < 8 * 2 * 64 * 256; i += gs) {
      int pos = i & 255, dv = (i >> 8) & 63, kvh = (i >> 14) & 1, b = i >> 15;
      vtc[i] = f2bf(p.cache_v[(((size_t)b * 4 + l) * 256 + pos) * 128 + kvh * 64 + dv]);
    }
  }
}

DI void phase_gemmA(const Params& p, int l, char* smem) {
  const u16* H = wsp<u16>(p, O_H);
  const u16* W = wsp<u16>(p, O_WINA);
  for (int tile = blockIdx.x; tile < 288 * 20; tile += gridDim.x) {
    const int mt = tile / 20, nt = tile % 20;
    const TokTile tt = tok_tile(mt);
    f32x4 acc[4][4];
    zero_acc(acc);
    gemm_tile(H + (size_t)tt.g0 * 1024, 1024, W + (size_t)nt * 128 * 1024, 1024, 1024, acc, smem);
    LANEVARS
    if (nt < 13) {
      u16* dst; int ld, cb;
      if (nt < 8) { dst = wsp<u16>(p, O_XR); ld = 1024; cb = nt * 128; }
      else if (nt < 11) { dst = wsp<u16>(p, O_CQ); ld = 384; cb = (nt - 8) * 128; }
      else { dst = wsp<u16>(p, O_CKV); ld = 256; cb = (nt - 11) * 128; }
#pragma unroll
      for (int i = 0; i < 4; ++i)
#pragma unroll
        for (int j = 0; j < 4; ++j)
#pragma unroll
          for (int e = 0; e < 4; ++e) {
            const int g = tt.g0 + wr * 64 + i * 16 + g4 * 4 + e;
            dst[(size_t)g * ld + cb + wc * 64 + j * 16 + c16] = f2bf(acc[i][j][e]);
            if (e == 3 && j == 3) SB();
          }
    } else if (nt == 13) {
      if (wc == 0) {
#pragma unroll
        for (int i = 0; i < 4; ++i)
#pragma unroll
          for (int e = 0; e < 4; ++e) {
            SB();
            const int r = wr * 64 + i * 16 + g4 * 4 + e;
            const int pos = tt.p0 + r;
            float x1 = acc[i][0][e], x2 = acc[i][1][e];
            if (tt.is_ctx) {
              u16* kr = wsp<u16>(p, O_KRC) + ((size_t)tt.b * 256 + pos) * 32;
              kr[c16] = f2bf(x1); kr[c16 + 16] = f2bf(x2);
              float* o = p.out + OUT_KROPE + (((size_t)tt.b * 4 + l) * 256 + pos) * 32;
              o[perm32(c16)] = x1; o[perm32(c16 + 16)] = x2;
            } else {
              const int pv = (c16 >= 8) ? (pos & 63) : (pos >> 6);
              const float cs = TAB_M[(pv * 8 + (c16 & 7)) * 2], sn = TAB_M[(pv * 8 + (c16 & 7)) * 2 + 1];
              u16* kr = wsp<u16>(p, O_KRL) + ((size_t)tt.b * LK_LAT + 256 + pos) * 32;
              kr[c16] = f2bf(x1 * cs - x2 * sn); kr[c16 + 16] = f2bf(x2 * cs + x1 * sn);
            }
          }
      }
    } else if (nt < 19) {
      const bool isk = (nt == 18);
      u16* dst = isk ? wsp<u16>(p, O_KS) : wsp<u16>(p, O_QS);
      const int ld = isk ? 128 : 512;
      const int cb = isk ? wc * 64 : ((nt - 14) * 2 + wc) * 64;
#pragma unroll
      for (int i = 0; i < 4; ++i)
#pragma unroll
        for (int e = 0; e < 4; ++e) {
          SB();
          const int r = wr * 64 + i * 16 + g4 * 4 + e;
          const int pos = tt.p0 + r, g = tt.g0 + r;
          float v0 = acc[i][0][e], v1 = acc[i][1][e], v2 = acc[i][2][e], v3 = acc[i][3][e];
          if (!tt.is_ctx) {
            const int pr = pos >> 6, pc = pos & 63;
            const float c0 = TAB_S[(pr * 16 + c16) * 2], s0 = TAB_S[(pr * 16 + c16) * 2 + 1];
            const float c1 = TAB_S[(pc * 16 + c16) * 2], s1 = TAB_S[(pc * 16 + c16) * 2 + 1];
            float a0 = v0 * c0 - v1 * s0, a1 = v1 * c0 + v0 * s0;
            float a2 = v2 * c1 - v3 * s1, a3 = v3 * c1 + v2 * s1;
            v0 = a0; v1 = a1; v2 = a2; v3 = a3;
          } else if (isk) {
            float* o = p.out + OUT_SK + (((size_t)tt.b * 4 + l) * 256 + pos) * 128 + cb + c16;
            o[0] = v0; o[16] = v1; o[32] = v2; o[48] = v3;
          }
          u16* d = dst + (size_t)g * ld + cb + c16;
          d[0] = f2bf(v0); d[16] = f2bf(v1); d[32] = f2bf(v2); d[48] = f2bf(v3);
        }
    } else {
      u16* vt = tt.is_ctx ? wsp<u16>(p, O_VTSC) : wsp<u16>(p, O_VTSL);
      const int L = tt.is_ctx ? 256 : 4096;
#pragma unroll
      for (int i = 0; i < 4; ++i)
#pragma unroll
        for (int j = 0; j < 4; ++j) {
          SB();
          const int r = wr * 64 + i * 16 + g4 * 4;
          const int pos = tt.p0 + r, dv = j * 16 + c16;
          uint2 o; o.x = pack2(acc[i][j][0], acc[i][j][1]); o.y = pack2(acc[i][j][2], acc[i][j][3]);
          *(uint2*)(vt + (((size_t)tt.b * 2 + wc) * 64 + dv) * L + pos) = o;
          if (tt.is_ctx) {
#pragma unroll
            for (int e = 0; e < 4; ++e)
              p.out[OUT_SV + (((size_t)tt.b * 4 + l) * 256 + pos + e) * 128 + wc * 64 + dv] = acc[i][j][e];
          }
        }
    }
  }
}

DI void row_scales(const u16* A, int K, float* s_rs) {
  const int t = tid(), row = t >> 1, half = t & 1;
  const u16* ap = A + (size_t)row * K + half * (K >> 1);
  float ss = 0.f;
  for (int c = 0; c < (K >> 4); ++c) {
    uint4 v = *(const uint4*)(ap + c * 8);
    unsigned wv[4] = {v.x, v.y, v.z, v.w};
#pragma unroll
    for (int q = 0; q < 4; ++q) {
      float a = __uint_as_float(wv[q] << 16), b = __uint_as_float(wv[q] & 0xffff0000u);
      ss += a * a + b * b;
    }
  }
  ss += __shfl_xor(ss, 1);
  if (half == 0) s_rs[row] = rsqrtf(ss / (float)K + EPS);
}

DI void phase_qkv(const Params& p, int l, char* smem) {
  float* s_rs = (float*)(smem + 65536);
  constexpr int NQ = 288 * 6, NKV = 304 * 8;
  for (int tile = blockIdx.x; tile < NQ + NKV; tile += gridDim.x) {
    f32x4 acc[4][4];
    zero_acc(acc);
    if (tile < NQ) {
      const int mt = tile / 6, nt = tile % 6;
      const TokTile tt = tok_tile(mt);
      const u16* A = wsp<u16>(p, O_CQ) + (size_t)tt.g0 * 384;
      row_scales(A, 384, s_rs);
      gemm_tile(A, 384, wsp<u16>(p, O_WUQ) + (size_t)nt * 128 * 384, 384, 384, acc, smem);
      LANEVARS
      u16* Q = wsp<u16>(p, O_Q);
#pragma unroll
      for (int i = 0; i < 4; ++i)
#pragma unroll
        for (int e = 0; e < 4; ++e) {
          SB();
          const int r = wr * 64 + i * 16 + g4 * 4 + e;
          const int pos = tt.p0 + r, g = tt.g0 + r;
          const float rs = s_rs[r];
          float v0 = acc[i][0][e] * rs, v1 = acc[i][1][e] * rs, v2 = acc[i][2][e] * rs, v3 = acc[i][3][e] * rs;
          if (nt >= 4 && !tt.is_ctx) {
            const int pv = (c16 >= 8) ? (pos & 63) : (pos >> 6);
            const float cs = TAB_M[(pv * 8 + (c16 & 7)) * 2], sn = TAB_M[(pv * 8 + (c16 & 7)) * 2 + 1];
            float a0 = v0 * cs - v1 * sn, a1 = v1 * cs + v0 * sn;
            float a2 = v2 * cs - v3 * sn, a3 = v3 * cs + v2 * sn;
            v0 = a0; v1 = a1; v2 = a2; v3 = a3;
          }
          u16* d = Q + (size_t)g * 768 + nt * 128 + wc * 64 + c16;
          d[0] = f2bf(v0); d[16] = f2bf(v1); d[32] = f2bf(v2); d[48] = f2bf(v3);
        }
    } else {
      const int t2 = tile - NQ;
      const int mt = t2 >> 3, hd = t2 & 7;
      const u16* A; const u16* Wt; int is_ctx, seq, kp0;
      if (mt < 288) {
        const TokTile tt = tok_tile(mt);
        A = wsp<u16>(p, O_CKV) + (size_t)tt.g0 * 256;
        Wt = wsp<u16>(p, O_WUKVG);
        row_scales(A, 256, s_rs);
        is_ctx = tt.is_ctx; seq = tt.b; kp0 = tt.is_ctx ? tt.p0 : 256 + tt.p0;
        if (tt.is_ctx && hd == 0) {
          __syncthreads();
          const float* gkv = p.kv_norm + l * 256;
          for (int idx = tid(); idx < 128 * 256; idx += 256) {
            const int r = idx >> 8, k = idx & 255;
            p.out[OUT_CKV + (((size_t)tt.b * 4 + l) * 256 + tt.p0 + r) * 256 + k] = bf2f(A[(size_t)r * 256 + k]) * s_rs[r] * gkv[k];
          }
        }
      } else {
        const int row0 = (mt - 288) * 128;
        A = wsp<u16>(p, O_CKVC) + (size_t)row0 * 256;
        Wt = wsp<u16>(p, O_WUKVR);
        { const int t1 = tid(); if (t1 < 128) s_rs[t1] = 1.f; }
        is_ctx = 0; seq = row0 >> 8; kp0 = row0 & 255;
      }
      gemm_tile(A, 256, Wt + (size_t)hd * 128 * 256, 256, 256, acc, smem);
      LANEVARS
      const int Lk = is_ctx ? 256 : LK_LAT;
      if (wc == 0) {
        u16* Kn = (is_ctx ? wsp<u16>(p, O_KNC) : wsp<u16>(p, O_KNL)) + ((size_t)seq * 8 + hd) * Lk * 64;
#pragma unroll
        for (int i = 0; i < 4; ++i)
#pragma unroll
          for (int j = 0; j < 4; ++j)
#pragma unroll
            for (int e = 0; e < 4; ++e) {
              const int r = wr * 64 + i * 16 + g4 * 4 + e;
              Kn[(size_t)(kp0 + r) * 64 + j * 16 + c16] = f2bf(acc[i][j][e] * s_rs[r]);
              if (e == 3) SB();
            }
      } else {
        u16* Vt = (is_ctx ? wsp<u16>(p, O_VTC) : wsp<u16>(p, O_VTL)) + ((size_t)seq * 8 + hd) * 64 * Lk;
#pragma unroll
        for (int i = 0; i < 4; ++i)
#pragma unroll
          for (int j = 0; j < 4; ++j) {
            SB();
            const int r = wr * 64 + i * 16 + g4 * 4;
            uint2 o;
            o.x = pack2(acc[i][j][0] * s_rs[r], acc[i][j][1] * s_rs[r + 1]);
            o.y = pack2(acc[i][j][2] * s_rs[r + 2], acc[i][j][3] * s_rs[r + 3]);
            *(uint2*)(Vt + (size_t)(j * 16 + c16) * Lk + kp0 + r) = o;
          }
      }
    }
    __syncthreads();
  }
}

template <int NS> DI void attn_gload(const u16* k0, int k0s, const u16* k1, const u16* vt, int vts,
                                     uint4& rk0, uint4& rk1, uint4& rk2, uint4& rv0, uint4& rv1) {
  const int t = tid();
  if (NS == 6) {
    { const int c = t, key = c / 12, ch = c % 12;
      rk0 = (ch < 8) ? *(const uint4*)(k0 + (size_t)key * k0s + ch * 8) : *(const uint4*)(k1 + (size_t)key * 32 + (ch - 8) * 8); }
    { const int c = t + 256, key = c / 12, ch = c % 12;
      rk1 = (ch < 8) ? *(const uint4*)(k0 + (size_t)key * k0s + ch * 8) : *(const uint4*)(k1 + (size_t)key * 32 + (ch - 8) * 8); }
    { const int c = t + 512, key = c / 12, ch = c % 12;
      rk2 = (ch < 8) ? *(const uint4*)(k0 + (size_t)key * k0s + ch * 8) : *(const uint4*)(k1 + (size_t)key * 32 + (ch - 8) * 8); }
  } else {
    { const int c = t, key = c >> 3, ch = c & 7; rk0 = *(const uint4*)(k0 + (size_t)key * k0s + ch * 8); }
    { const int c = t + 256, key = c >> 3, ch = c & 7; rk1 = *(const uint4*)(k0 + (size_t)key * k0s + ch * 8); }
  }
  { const int c = t, dv = c >> 3, ch = c & 7; rv0 = *(const uint4*)(vt + (size_t)dv * vts + ch * 8); }
  { const int c = t + 256, dv = c >> 3, ch = c & 7; rv1 = *(const uint4*)(vt + (size_t)dv * vts + ch * 8); }
}
template <int NS> DI void attn_sstore(char* smem, const uint4& rk0, const uint4& rk1, const uint4& rk2, const uint4& rv0, const uint4& rv1) {
  constexpr int KSTR = (NS == 6) ? 208 : 144;
  const int t = tid();
  if (NS == 6) {
    { const int c = t, key = c / 12, ch = c % 12; *(uint4*)(smem + key * KSTR + ch * 16) = rk0; }
    { const int c = t + 256, key = c / 12, ch = c % 12; *(uint4*)(smem + key * KSTR + ch * 16) = rk1; }
    { const int c = t + 512, key = c / 12, ch = c % 12; *(uint4*)(smem + key * KSTR + ch * 16) = rk2; }
  } else {
    { const int c = t, key = c >> 3, ch = c & 7; *(uint4*)(smem + key * KSTR + ch * 16) = rk0; }
    { const int c = t + 256, key = c >> 3, ch = c & 7; *(uint4*)(smem + key * KSTR + ch * 16) = rk1; }
  }
  { const int c = t, dv = c >> 3, ch = c & 7; char* d = smem + 13312 + dv * 136 + ch * 16;
    *(uint2*)d = uint2{rv0.x, rv0.y}; *(uint2*)(d + 8) = uint2{rv0.z, rv0.w}; }
  { const int c = t + 256, dv = c >> 3, ch = c & 7; char* d = smem + 13312 + dv * 136 + ch * 16;
    *(uint2*)d = uint2{rv1.x, rv1.y}; *(uint2*)(d + 8) = uint2{rv1.z, rv1.w}; }
}

#define PACK8(S, s2) __builtin_bit_cast(bf16x8, uint4{pack2(S[8 * (s2)], S[8 * (s2) + 1]), pack2(S[8 * (s2) + 2], S[8 * (s2) + 3]), \
                                                        pack2(S[8 * (s2) + 4], S[8 * (s2) + 5]), pack2(S[8 * (s2) + 6], S[8 * (s2) + 7])})

template <int NS>
DI void attn_item(const u16* kA, int kAs, const u16* krA, const u16* vtA, int vtAs, int nA, int kposA, int maskA,
                  const u16* kB, int kBs, const u16* vtB, int vtBs, int nB,
                  const u16* qa, const u16* qb, float sc2, float m0, float l0, int qpos, u16* yrow, char* smem) {
  constexpr int KSTR = (NS == 6) ? 208 : 144;
  const int lane = tid() & 63;
  const int r32 = lane & 31, hh = lane >> 5;
  bf16x8 qf0, qf1, qf2, qf3, qf4, qf5;
  qf0 = *(const bf16x8*)(qa + 0 + 8 * hh); qf1 = *(const bf16x8*)(qa + 16 + 8 * hh);
  qf2 = *(const bf16x8*)(qa + 32 + 8 * hh); qf3 = *(const bf16x8*)(qa + 48 + 8 * hh);
  if (NS == 6) { qf4 = *(const bf16x8*)(qb + 0 + 8 * hh); qf5 = *(const bf16x8*)(qb + 16 + 8 * hh); }
  else { qf4 = qf0; qf5 = qf0; }
  f32x16 O0, O1;
#pragma unroll
  for (int e = 0; e < 16; ++e) { O0[e] = 0.f; O1[e] = 0.f; }
  float m_run = m0, l_run = l0;
  uint4 rk0, rk1, rk2, rv0, rv1;
  rk2 = uint4{0, 0, 0, 0};
  const int ntiles = nA + nB;
  if (nA > 0) attn_gload<NS>(kA, kAs, krA, vtA, vtAs, rk0, rk1, rk2, rv0, rv1);
  else attn_gload<NS>(kB, kBs, nullptr, vtB, vtBs, rk0, rk1, rk2, rv0, rv1);
  for (int j = 0; j < ntiles; ++j) {
    __syncthreads();
    attn_sstore<NS>(smem, rk0, rk1, rk2, rv0, rv1);
    __syncthreads();
    const int kpos = kposA + 64 * j;
    const bool masked = maskA && (j < nA);
    if (j + 1 < ntiles) {
      const int jn = j + 1;
      if (jn < nA) attn_gload<NS>(kA + (size_t)jn * 64 * kAs, kAs, krA + (size_t)jn * 64 * 32, vtA + jn * 64, vtAs, rk0, rk1, rk2, rv0, rv1);
      else { const int jb = jn - nA; attn_gload<NS>(kB + (size_t)jb * 64 * kBs, kBs, nullptr, vtB + jb * 64, vtBs, rk0, rk1, rk2, rv0, rv1); }
    }
    f32x16 S0, S1;
#pragma unroll
    for (int e = 0; e < 16; ++e) { S0[e] = 0.f; S1[e] = 0.f; }
    const char* ka0 = smem + r32 * KSTR + 16 * hh;
    const char* ka1 = smem + (32 + r32) * KSTR + 16 * hh;
#define QK_STEP(s, qf) { bf16x8 a0 = *(const bf16x8*)(ka0 + 32 * (s)); bf16x8 a1 = *(const bf16x8*)(ka1 + 32 * (s)); \
      S0 = __builtin_amdgcn_mfma_f32_32x32x16_bf16(a0, qf, S0, 0, 0, 0); S1 = __builtin_amdgcn_mfma_f32_32x32x16_bf16(a1, qf, S1, 0, 0, 0); }
    QK_STEP(0, qf0) QK_STEP(1, qf1) QK_STEP(2, qf2) QK_STEP(3, qf3)
    if (NS == 6) { QK_STEP(4, qf4) QK_STEP(5, qf5) }
    SB();
    float mx = m_run;
#pragma unroll
    for (int e = 0; e < 16; ++e) {
      float v0 = S0[e] * sc2, v1 = S1[e] * sc2;
      if (masked) {
        const int kp = kpos + (e & 3) + 8 * (e >> 2) + 4 * hh;
        int d0 = qpos - kp; d0 = d0 < 0 ? -d0 : d0;
        int d1 = qpos - (kp + 32); d1 = d1 < 0 ? -d1 : d1;
        if (d0 > 128) v0 = -1e30f;
        if (d1 > 128) v1 = -1e30f;
      }
      S0[e] = v0; S1[e] = v1;
      mx = fmaxf(mx, fmaxf(v0, v1));
    }
    mx = fmaxf(mx, __shfl_xor(mx, 32));
    const float alpha = __builtin_amdgcn_exp2f(m_run - mx);
    m_run = mx;
    float rsum = 0.f;
#pragma unroll
    for (int e = 0; e < 16; ++e) {
      float p0 = __builtin_amdgcn_exp2f(S0[e] - mx), p1 = __builtin_amdgcn_exp2f(S1[e] - mx);
      S0[e] = p0; S1[e] = p1;
      rsum += p0 + p1;
    }
    rsum += __shfl_xor(rsum, 32);
    l_run = l_run * alpha + rsum;
#pragma unroll
    for (int e = 0; e < 16; ++e) { O0[e] *= alpha; O1[e] *= alpha; }
    const char* sv0 = smem + 13312 + r32 * 136 + 8 * hh;
    const char* sv1 = sv0 + 32 * 136;
#define PV_STEP(pb, ka) { \
      { uint2 lo = *(const uint2*)(sv0 + (ka) * 2), hi = *(const uint2*)(sv0 + (ka) * 2 + 16); \
        bf16x8 va = __builtin_bit_cast(bf16x8, uint4{lo.x, lo.y, hi.x, hi.y}); O0 = __builtin_amdgcn_mfma_f32_32x32x16_bf16(va, pb, O0, 0, 0, 0); } \
      { uint2 lo = *(const uint2*)(sv1 + (ka) * 2), hi = *(const uint2*)(sv1 + (ka) * 2 + 16); \
        bf16x8 va = __builtin_bit_cast(bf16x8, uint4{lo.x, lo.y, hi.x, hi.y}); O1 = __builtin_amdgcn_mfma_f32_32x32x16_bf16(va, pb, O1, 0, 0, 0); } }
    SB();
    { bf16x8 pb = PACK8(S0, 0); PV_STEP(pb, 0) }
    { bf16x8 pb = PACK8(S0, 1); PV_STEP(pb, 16) }
    SB();
    { bf16x8 pb = PACK8(S1, 0); PV_STEP(pb, 32) }
    { bf16x8 pb = PACK8(S1, 1); PV_STEP(pb, 48) }
    SB();
  }
  const float inv = 1.f / l_run;
#pragma unroll
  for (int e4 = 0; e4 < 4; ++e4) {
    uint2 o;
    o.x = pack2(O0[4 * e4] * inv, O0[4 * e4 + 1] * inv); o.y = pack2(O0[4 * e4 + 2] * inv, O0[4 * e4 + 3] * inv);
    *(uint2*)(yrow + 8 * e4 + 4 * hh) = o;
    o.x = pack2(O1[4 * e4] * inv, O1[4 * e4 + 1] * inv); o.y = pack2(O1[4 * e4 + 2] * inv, O1[4 * e4 + 3] * inv);
    *(uint2*)(yrow + 32 + 8 * e4 + 4 * hh) = o;
  }
}

DI void scan_item(const Params& p, int l, int seq, int blk, char* smem) {
  const int t = tid(), lane = t & 63, w = t >> 6;
  const int c16 = lane & 15, g4 = lane >> 4;
  const bool is_ctx = seq < 16;
  const int b = is_ctx ? seq : seq - 16;
  const int L = is_ctx ? 256 : 4096;
  const int gbase = is_ctx ? b * 256 : T_CTX + b * 4096;
  const u16* XR = wsp<u16>(p, O_XR);
  u16* Y = wsp<u16>(p, O_YRNN);
  char* sXc = smem;
  float* sA = (float*)(smem + 8704);
  float* sU = (float*)(smem + 8704 + 16384);
  const int cch = t & 127, th = t >> 7;
  const int chg = blk * 128 + cch;
  const float w0 = p.conv_w[(l * 4 + 0) * 1024 + chg], w1 = p.conv_w[(l * 4 + 1) * 1024 + chg];
  const float w2 = p.conv_w[(l * 4 + 2) * 1024 + chg], w3 = p.conv_w[(l * 4 + 3) * 1024 + chg];
  const float cb = p.conv_b[l * 1024 + chg];
  const int nch = L >> 5;
  for (int d = 0; d < 2; ++d) {
    const u16* WL = wsp<u16>(p, O_WLRU) + (size_t)(d * 8 + blk) * 256 * 128 + (size_t)(32 * w + c16) * 128 + g4 * 8;
    float ba[2], bi[2], cl[2];
#pragma unroll
    for (int jn = 0; jn < 2; ++jn) {
      const int ch = (l * 2 + d) * 1024 + blk * 128 + 32 * w + 16 * jn + c16;
      ba[jn] = p.lru_ba[ch]; bi[jn] = p.lru_bi[ch];
      cl[jn] = -8.f * log1pf(__expf(-p.lru_lam[ch]));
    }
    float h = 0.f;
    if (!is_ctx && t < 128) h = p.state[(((size_t)b * 4 + l) * 2 + d) * 1024 + blk * 128 + t];
    for (int ci = 0; ci < nch; ++ci) {
      const int tc0 = (d == 0 ? ci : nch - 1 - ci) * 32;
      {
        float xv[19];
#pragma unroll
        for (int q = 0; q < 19; ++q) {
          const int pos = tc0 + th * 16 - 1 + q;
          xv[q] = (pos >= 0 && pos < L) ? bf2f(XR[(size_t)(gbase + pos) * 1024 + chg]) : 0.f;
        }
#pragma unroll
        for (int q = 0; q < 16; ++q) {
          float xc = cb + w0 * xv[q] + w1 * xv[q + 1] + w2 * xv[q + 2] + w3 * xv[q + 3];
          *(u16*)(sXc + (th * 16 + q) * 272 + cch * 2) = f2bf(xc);
        }
      }
      __syncthreads();
      f32x4 aR[2][2], aI[2][2];
#pragma unroll
      for (int im = 0; im < 2; ++im)
#pragma unroll
        for (int jn = 0; jn < 2; ++jn) { aR[im][jn] = f32x4{0.f, 0.f, 0.f, 0.f}; aI[im][jn] = f32x4{0.f, 0.f, 0.f, 0.f}; }
#pragma unroll
      for (int ks = 0; ks < 4; ++ks) {
        bf16x8 bw[4];
#pragma unroll
        for (int nf = 0; nf < 4; ++nf)
          bw[nf] = *(const bf16x8*)(WL + (size_t)((nf & 1) * 16 + (nf >> 1) * 128) * 128 + ks * 32);
#pragma unroll
        for (int im = 0; im < 2; ++im) {
          bf16x8 af = *(const bf16x8*)(sXc + (16 * im + c16) * 272 + (ks * 32 + g4 * 8) * 2);
#pragma unroll
          for (int jn = 0; jn < 2; ++jn) {
            aR[im][jn] = __builtin_amdgcn_mfma_f32_16x16x32_bf16(af, bw[jn], aR[im][jn], 0, 0, 0);
            aI[im][jn] = __builtin_amdgcn_mfma_f32_16x16x32_bf16(af, bw[2 + jn], aI[im][jn], 0, 0, 0);
          }
        }
      }
#pragma unroll
      for (int im = 0; im < 2; ++im)
#pragma unroll
        for (int jn = 0; jn < 2; ++jn)
#pragma unroll
          for (int e = 0; e < 4; ++e) {
            const int tt = 16 * im + 4 * g4 + e, c = 32 * w + 16 * jn + c16;
            const float r = sigmoidf_(aR[im][jn][e] + ba[jn]);
            const float ig = sigmoidf_(aI[im][jn][e] + bi[jn]);
            const float a = __expf(cl[jn] * r);
            const float xc = bf2f(*(const u16*)(sXc + tt * 272 + c * 2));
            const float u = sqrtf(fmaxf(1.f - a * a, 0.f)) * ig * xc;
            sA[tt * 128 + c] = a; sU[tt * 128 + c] = u;
          }
      __syncthreads();
      if (t < 128) {
        if (d == 0) {
#pragma unroll 8
          for (int s = 0; s < 32; ++s) { h = sA[s * 128 + t] * h + sU[s * 128 + t]; sU[s * 128 + t] = h; }
        } else {
#pragma unroll 8
          for (int s = 31; s >= 0; --s) { h = sA[s * 128 + t] * h + sU[s * 128 + t]; sU[s * 128 + t] = h; }
        }
      }
      __syncthreads();
      {
        const int c2 = (t & 63) * 2;
#pragma unroll
        for (int i = 0; i < 8; ++i) {
          const int tt = (t >> 6) + 4 * i;
          unsigned* yp = (unsigned*)(Y + (size_t)(gbase + tc0 + tt) * 1024 + blk * 128 + c2);
          float h0 = sU[tt * 128 + c2], h1 = sU[tt * 128 + c2 + 1];
          if (d == 1) { const unsigned old = *yp; h0 += __uint_as_float(old << 16); h1 += __uint_as_float(old & 0xffff0000u); }
          *yp = pack2(h0, h1);
        }
      }
    }
    if (is_ctx && t < 128) p.out[OUT_RG + (((size_t)b * 4 + l) * 2 + d) * 1024 + blk * 128 + t] = h;
    __syncthreads();
  }
}

DI void phase_mix(const Params& p, int l, char* smem) {
  constexpr float LOG2E = 1.4426950408889634f;
  constexpr int N0 = 64, N1 = N0 + 2048, N2 = N1 + 2048, N3 = N2 + 128, N4 = N3 + 256, N5 = N4 + 256;
  for (int it = blockIdx.x; it < N5; it += gridDim.x) {
    const int t = tid(), lane = t & 63, w = t >> 6;
    const int r32 = lane & 31;
    if (it < N0 || (it >= N2 && it < N3)) {
      const int i = it < N0 ? it : it - N2;
      scan_item(p, l, (it < N0 ? 16 : 0) + (i >> 3), i & 7, smem);
    } else if (it < N1 || (it >= N3 && it < N4)) {
      const bool lat = it < N1;
      int b, h, qb;
      if (lat) { const int i = it - N0; qb = i & 31; h = (i >> 5) & 7; b = i >> 8; }
      else { const int i = it - N3; qb = i & 1; h = (i >> 1) & 7; b = i >> 4; }
      const int Lk = lat ? LK_LAT : 256;
      const int gq = (lat ? T_CTX + b * 4096 : b * 256) + qb * 128 + w * 32 + r32;
      const u16* Kn = (lat ? wsp<u16>(p, O_KNL) : wsp<u16>(p, O_KNC)) + ((size_t)b * 8 + h) * Lk * 64;
      const u16* Kr = (lat ? wsp<u16>(p, O_KRL) : wsp<u16>(p, O_KRC)) + (size_t)b * Lk * 32;
      const u16* Vt = (lat ? wsp<u16>(p, O_VTL) : wsp<u16>(p, O_VTC)) + ((size_t)b * 8 + h) * 64 * Lk;
      const u16* Q = wsp<u16>(p, O_Q) + (size_t)gq * 768;
      u16* yrow = wsp<u16>(p, O_CQ) + (size_t)gq * 512 + h * 64;
      attn_item<6>(Kn, 64, Kr, Vt, Lk, Lk >> 6, 0, 0, nullptr, 0, nullptr, 0, 0,
                   Q + h * 64, Q + 512 + h * 32, 0.10206207261596577f * LOG2E, -1e30f, 0.f, 0, yrow, smem);
    } else {
      const bool lat = it < N2;
      int b, h, qb;
      if (lat) { const int i = it - N1; qb = i & 31; h = (i >> 5) & 7; b = i >> 8; }
      else { const int i = it - N4; qb = i & 1; h = (i >> 1) & 7; b = i >> 4; }
      const int kvh = h >> 2;
      const int gseq = lat ? T_CTX + b * 4096 : b * 256;
      const int qpos = qb * 128 + w * 32 + r32;
      const int gq = gseq + qpos;
      u16* qrow = wsp<u16>(p, O_QS) + (size_t)gq * 512 + h * 64;
      const float sink2 = p.sink[l * 8 + h] * LOG2E;
      const int t0 = qb * 128;
      int jlo = 0, jhi = 6;
      if (t0 == 0) jlo = 2;
      if (t0 + 128 >= 4096) jhi = 4;
      const int ks0 = lat ? t0 - 128 + 64 * jlo : 0;
      const int nA = lat ? jhi - jlo : 4;
      const u16* KS = wsp<u16>(p, O_KS) + (size_t)(gseq + ks0) * 128 + kvh * 64;
      const u16* VT = lat ? wsp<u16>(p, O_VTSL) + ((size_t)b * 2 + kvh) * 64 * 4096 + ks0
                          : wsp<u16>(p, O_VTSC) + ((size_t)b * 2 + kvh) * 64 * 256;
      const u16* KC = wsp<u16>(p, O_KSC) + (size_t)b * 256 * 128 + kvh * 64;
      const u16* VC = wsp<u16>(p, O_VTSCC) + ((size_t)b * 2 + kvh) * 64 * 256;
      attn_item<4>(KS, 128, nullptr, VT, lat ? 4096 : 256, nA, ks0, lat ? 1 : 0, KC, 128, VC, 256, lat ? 4 : 0,
                   qrow, nullptr, 0.125f * LOG2E, sink2, 1.f, qpos, qrow, smem);
    }
    __syncthreads();
  }
}

DI void phase_gate(const Params& p, int l, char* smem) {
  const u16* H = wsp<u16>(p, O_H);
  const u16* W = wsp<u16>(p, O_WINB);
  for (int tile = blockIdx.x; tile < 288 * 16; tile += gridDim.x) {
    const int mt = tile >> 4, nt = tile & 15;
    const int g0 = mt * 128;
    f32x4 acc[4][4];
    zero_acc(acc);
    gemm_tile(H + (size_t)g0 * 1024, 1024, W + (size_t)nt * 128 * 1024, 1024, 1024, acc, smem);
    LANEVARS
    u16* dst; int ld, cb;
    if (nt < 8) { dst = wsp<u16>(p, O_YRNN); ld = 1024; cb = nt * 128; }
    else if (nt < 12) { dst = wsp<u16>(p, O_CQ); ld = 512; cb = (nt - 8) * 128; }
    else { dst = wsp<u16>(p, O_QS); ld = 512; cb = (nt - 12) * 128; }
#pragma unroll
    for (int i = 0; i < 4; ++i)
#pragma unroll
      for (int j = 0; j < 4; ++j)
#pragma unroll
        for (int e = 0; e < 4; ++e) {
          const int g = g0 + wr * 64 + i * 16 + g4 * 4 + e;
          u16* d = dst + (size_t)g * ld + cb + wc * 64 + j * 16 + c16;
          const float gv = acc[i][j][e];
          *d = f2bf(bf2f(*d) * gv * sigmoidf_(gv));
          if (e == 3) SB();
        }
  }
}

DI void phase_merge(const Params& p, int l, char* smem) {
  const u16* H = wsp<u16>(p, O_H);
  const u16* WB = wsp<u16>(p, O_WINB);
  u16* U = wsp<u16>(p, O_XR);
  for (int tile = blockIdx.x; tile < 288 * 16; tile += gridDim.x) {
    const int mt = tile >> 4, nt = tile & 15;
    const int g0 = mt * 128;
    f32x4 u[4][2];
#pragma unroll
    for (int i = 0; i < 4; ++i) { u[i][0] = f32x4{0.f, 0.f, 0.f, 0.f}; u[i][1] = f32x4{0.f, 0.f, 0.f, 0.f}; }
    for (int br = 0; br < 3; ++br) {
      f32x4 acc[4][2];
#pragma unroll
      for (int i = 0; i < 4; ++i) { acc[i][0] = f32x4{0.f, 0.f, 0.f, 0.f}; acc[i][1] = f32x4{0.f, 0.f, 0.f, 0.f}; }
      gemm_tile_t<2>(H + (size_t)g0 * 1024, 1024, WB + (size_t)(2048 + br * 1024 + nt * 64) * 1024, 1024, 1024, acc, smem);
      f32x4 sg[4][2];
#pragma unroll
      for (int i = 0; i < 4; ++i)
#pragma unroll
        for (int j = 0; j < 2; ++j) {
#pragma unroll
          for (int e = 0; e < 4; ++e) sg[i][j][e] = sigmoidf_(acc[i][j][e]);
          acc[i][j] = f32x4{0.f, 0.f, 0.f, 0.f};
        }
      const u16* Z; const u16* WT; int kz;
      if (br == 0) { Z = wsp<u16>(p, O_YRNN) + (size_t)g0 * 1024; WT = wsp<u16>(p, O_WBRR) + (size_t)nt * 64 * 1024; kz = 1024; }
      else if (br == 1) { Z = wsp<u16>(p, O_CQ) + (size_t)g0 * 512; WT = wsp<u16>(p, O_WBRM) + (size_t)nt * 64 * 512; kz = 512; }
      else { Z = wsp<u16>(p, O_QS) + (size_t)g0 * 512; WT = wsp<u16>(p, O_WBRS) + (size_t)nt * 64 * 512; kz = 512; }
      gemm_tile_t<2>(Z, kz, WT, kz, kz, acc, smem);
#pragma unroll
      for (int i = 0; i < 4; ++i)
#pragma unroll
        for (int j = 0; j < 2; ++j)
#pragma unroll
          for (int e = 0; e < 4; ++e) u[i][j][e] += sg[i][j][e] * acc[i][j][e];
    }
    LANEVARS
#pragma unroll
    for (int i = 0; i < 4; ++i)
#pragma unroll
      for (int j = 0; j < 2; ++j)
#pragma unroll
        for (int e = 0; e < 4; ++e) {
          const int g = g0 + wr * 64 + i * 16 + g4 * 4 + e;
          U[(size_t)g * 1024 + nt * 64 + wc * 32 + j * 16 + c16] = f2bf(u[i][j][e]);
        }
  }
}

DI void phase_out(const Params& p, int l, char* smem) {
  const u16* U = wsp<u16>(p, O_XR);
  const u16* W = wsp<u16>(p, O_WOUT);
  const float* MOD = wsp<float>(p, O_MOD) + (size_t)l * 9 * 3072;
  for (int tile = blockIdx.x; tile < 288 * 8; tile += gridDim.x) {
    const int mt = tile >> 3, nt = tile & 7;
    const int g0 = mt * 128;
    const int ci = g0 < T_CTX ? 8 : ((g0 - T_CTX) >> 12);
    f32x4 acc[4][4];
    zero_acc(acc);
    gemm_tile(U + (size_t)g0 * 1024, 1024, W + (size_t)nt * 128 * 1024, 1024, 1024, acc, smem);
    LANEVARS
#pragma unroll
    for (int j = 0; j < 4; ++j) {
      const int col = nt * 128 + wc * 64 + j * 16 + c16;
      const float gt = MOD[ci * 3072 + 2048 + col];
#pragma unroll
      for (int i = 0; i < 4; ++i)
#pragma unroll
        for (int e = 0; e < 4; ++e) {
          const int g = g0 + wr * 64 + i * 16 + g4 * 4 + e;
          const float xo = xin_row(p, l, g)[col];
          p.out[(size_t)g * 1024 + col] = xo + gt * acc[i][j][e];
          if (e == 3) SB();
        }
    }
  }
}

DI void phase_final(const Params& p) {
  const int t = tid(), lane = t & 63, w = t >> 6;
  for (int row = blockIdx.x * 4 + w; row < T_ALL; row += gridDim.x * 4) {
    float* x = p.out + (size_t)row * 1024;
    float4 v[4];
    float ss = 0.f;
#pragma unroll
    for (int i = 0; i < 4; ++i) {
      v[i] = *(const float4*)(x + i * 256 + lane * 4);
      ss += v[i].x * v[i].x + v[i].y * v[i].y + v[i].z * v[i].z + v[i].w * v[i].w;
    }
    ss = wave_sum(ss);
    const float rs = rsqrtf(ss * (1.f / 1024.f) + EPS);
#pragma unroll
    for (int i = 0; i < 4; ++i) {
      const int c = i * 256 + lane * 4;
      const float4 g = *(const float4*)(p.final_norm + c);
      float4 o = {v[i].x * rs * g.x, v[i].y * rs * g.y, v[i].z * rs * g.z, v[i].w * rs * g.w};
      *(float4*)(x + c) = o;
    }
  }
}

constexpr int NPHASE_PER_LAYER = 7;
DI void run_phase(const Params& p, int ph, char* smem) {
  if (ph == 0) { phase_mod(p, smem); return; }
  if (ph == 1 + NLAYER * NPHASE_PER_LAYER) { phase_final(p); return; }
  const int l = (ph - 1) / NPHASE_PER_LAYER, s = (ph - 1) % NPHASE_PER_LAYER;
  switch (s) {
    case 0: phase_prep(p, l); break;
    case 1: phase_gemmA(p, l, smem); break;
    case 2: phase_qkv(p, l, smem); break;
    case 3: phase_mix(p, l, smem); break;
    case 4: phase_gate(p, l, smem); break;
    case 5: phase_merge(p, l, smem); break;
    default: phase_out(p, l, smem); break;
  }
}
constexpr int NPHASE = 2 + NLAYER * NPHASE_PER_LAYER;

#if MEGA
DI Params launder(const Params& p) {
  char* ws_l = p.ws; float* out_l = p.out;
  asm volatile("" : "+s"(ws_l), "+s"(out_l));
  Params q = p; q.ws = ws_l; q.out = out_l;
  return q;
}
__global__ void __launch_bounds__(256, 2) mega_kernel(Params p) {
  __shared__ __attribute__((aligned(16))) char smem[66048];
  cg::grid_group grid = cg::this_grid();
  phase_mod(launder(p), smem);
  grid.sync();
  for (int l = 0; l < NLAYER; ++l) {
    phase_prep(launder(p), l);
    grid.sync();
    phase_gemmA(launder(p), l, smem);
    grid.sync();
    phase_qkv(launder(p), l, smem);
    grid.sync();
    phase_mix(launder(p), l, smem);
    grid.sync();
    phase_gate(launder(p), l, smem);
    grid.sync();
    phase_merge(launder(p), l, smem);
    grid.sync();
    phase_out(launder(p), l, smem);
    grid.sync();
  }
  phase_final(launder(p));
}

#else
__global__ void __launch_bounds__(256, 2) phase_kernel(Params p, int ph) {
  __shared__ __attribute__((aligned(16))) char smem[66048];
  run_phase(p, ph, smem);
}

#endif
extern "C" void kernel_launch(void* const* d_in, const int* in_sizes, int n_in, void* d_out, int out_size, void* d_ws,
                              size_t ws_size, hipStream_t stream) {
  Params p{};
  const float** pp = (const float**)&p;
  for (int i = 0; i < 30; ++i) pp[i] = (const float*)d_in[i];
  p.out = (float*)d_out;
  p.ws = (char*)d_ws;
  if (ws_size < WS_NEED) fprintf(stderr, "workspace too small: %zu < %zu\n", ws_size, (size_t)WS_NEED);
#if MEGA
  static int grid_blocks = 0;
  if (!grid_blocks) {
    int dev = 0, cus = 0, per_cu = 0;
    hipGetDevice(&dev);
    hipDeviceGetAttribute(&cus, hipDeviceAttributeMultiprocessorCount, dev);
    hipOccupancyMaxActiveBlocksPerMultiprocessor(&per_cu, mega_kernel, 256, 0);
    if (per_cu > 2) per_cu = 2;
    grid_blocks = cus * per_cu;
  }
  void* args[] = {&p};
  hipError_t e = hipLaunchCooperativeKernel((void*)mega_kernel, dim3(grid_blocks), dim3(256), args, 0, stream);
  if (e != hipSuccess) fprintf(stderr, "cooperative launch failed: %s (grid %d)\n", hipGetErrorString(e), grid_blocks);
#else
  for (int ph = 0; ph < NPHASE; ++ph) phase_kernel<<<512, 256, 0, stream>>>(p, ph);
#endif
}
```

```cpp
#include <hip/hip_runtime.h>
#include <hip/hip_cooperative_groups.h>
#include <cstdio>
#include <cstdint>
namespace cg = cooperative_groups;

#ifndef PROBE
#define PROBE 0
#endif
#ifndef MEGA
#define MEGA 1
#endif

typedef unsigned short u16;
using bf16x8 = __attribute__((ext_vector_type(8))) short;
using f32x4 = __attribute__((ext_vector_type(4))) float;
using f32x16 = __attribute__((ext_vector_type(16))) float;
typedef __bf16 bf2_t __attribute__((ext_vector_type(2)));
typedef float f2_t __attribute__((ext_vector_type(2)));
#define DI __device__ __forceinline__

__device__ const float TAB_M[1024] = {
  1.00000000e+00f, 0.00000000e+00f, 1.00000000e+00f, 0.00000000e+00f, 1.00000000e+00f, 0.00000000e+00f, 1.00000000e+00f, 0.00000000e+00f,
  1.00000000e+00f, 0.00000000e+00f, 1.00000000e+00f, 0.00000000e+00f, 1.00000000e+00f, 0.00000000e+00f, 1.00000000e+00f, 0.00000000e+00f,
  5.40302277e-01f, 8.41470957e-01f, 9.50415254e-01f, 3.10983598e-01f, 9.95004177e-01f, 9.98334214e-02f, 9.99500036e-01f, 3.16175036e-02f,
  9.99949992e-01f, 9.99983307e-03f, 9.99994993e-01f, 3.16227227e-03f, 9.99999523e-01f, 9.99999931e-04f, 9.99999940e-01f, 3.16227757e-04f,
  -4.16146845e-01f, 9.09297407e-01f, 8.06578398e-01f, 5.91127098e-01f, 9.80066597e-01f, 1.98669329e-01f, 9.98000681e-01f, 6.32033944e-02f,
  9.99800026e-01f, 1.99986659e-02f, 9.99979973e-01f, 6.32451288e-03f, 9.99997973e-01f, 1.99999870e-03f, 9.99999821e-01f, 6.32455456e-04f,
  -9.89992499e-01f, 1.41120002e-01f, 5.82753658e-01f, 8.12648892e-01f, 9.55336511e-01f, 2.95520216e-01f, 9.95503366e-01f, 9.47260857e-02f,
  9.99550045e-01f, 2.99954992e-02f, 9.99954998e-01f, 9.48669016e-03f, 9.99995530e-01f, 2.99999560e-03f, 9.99999523e-01f, 9.48683126e-04f,
  -6.53643608e-01f, -7.56802499e-01f, 3.01137477e-01f, 9.53580737e-01f, 9.21060979e-01f, 3.89418334e-01f, 9.92010653e-01f, 1.26154065e-01f,
  9.99200106e-01f, 3.99893336e-02f, 9.99920011e-01f, 1.26487734e-02f, 9.99992013e-01f, 3.99998948e-03f, 9.99999225e-01f, 1.26491068e-03f,
  2.83662200e-01f, -9.58924294e-01f, -1.03423381e-02f, 9.99946535e-01f, 8.77582550e-01f, 4.79425550e-01f, 9.87526000e-01f, 1.57455876e-01f,
  9.98750269e-01f, 4.99791652e-02f, 9.99875009e-01f, 1.58107281e-02f, 9.99987483e-01f, 4.99997940e-03f, 9.99998748e-01f, 1.58113812e-03f,
  9.60170269e-01f, -2.79415488e-01f, -3.20796400e-01f, 9.47148204e-01f, 8.25335622e-01f, 5.64642489e-01f, 9.82053936e-01f, 1.88600272e-01f,
  9.98200536e-01f, 5.99640049e-02f, 9.99819994e-01f, 1.89725272e-02f, 9.99981999e-01f, 5.99996420e-03f, 9.99998212e-01f, 1.89736532e-03f,
  7.53902256e-01f, 6.56986594e-01f, -5.99437475e-01f, 8.00421596e-01f, 7.64842212e-01f, 6.44217670e-01f, 9.75599885e-01f, 2.19556093e-01f,
  9.97551024e-01f, 6.99428469e-02f, 9.99755025e-01f, 2.21341345e-02f, 9.99975502e-01f, 6.99994294e-03f, 9.99997556e-01f, 2.21359241e-03f,
  -1.45500034e-01f, 9.89358246e-01f, -8.18632424e-01f, 5.74317753e-01f, 6.96706712e-01f, 7.17356086e-01f, 9.68170285e-01f, 2.50292331e-01f,
  9.96801734e-01f, 7.99146891e-02f, 9.99680042e-01f, 2.52955221e-02f, 9.99967992e-01f, 7.99991470e-03f, 9.99996781e-01f, 2.52981926e-03f,
  -9.11130250e-01f, 4.12118495e-01f, -9.56644177e-01f, 2.91259229e-01f, 6.21609926e-01f, 7.83326924e-01f, 9.59772646e-01f, 2.80778319e-01f,
  9.95952725e-01f, 8.98785442e-02f, 9.99595046e-01f, 2.84566563e-02f, 9.99959528e-01f, 8.99987947e-03f, 9.99995947e-01f, 2.84604589e-03f,
  -8.39071512e-01f, -5.44021130e-01f, -9.99786079e-01f, -2.06835698e-02f, 5.40302277e-01f, 8.41470957e-01f, 9.50415313e-01f, 3.10983568e-01f,
  9.95004177e-01f, 9.98334140e-02f, 9.99500036e-01f, 3.16175036e-02f, 9.99949992e-01f, 9.99983400e-03f, 9.99994993e-01f, 3.16227227e-03f,
  4.42569796e-03f, -9.99990225e-01f, -9.43779767e-01f, -3.30574960e-01f, 4.53596085e-01f, 8.91207397e-01f, 9.40107584e-01f, 3.40877861e-01f,
  9.93956089e-01f, 1.09778300e-01f, 9.99395072e-01f, 3.47780399e-02f, 9.99939501e-01f, 1.09997792e-02f, 9.99993920e-01f, 3.47849843e-03f,
  8.43853951e-01f, -5.36572933e-01f, -7.94179380e-01f, -6.07683420e-01f, 3.62357706e-01f, 9.32039082e-01f, 9.28859890e-01f, 3.70431304e-01f,
  9.92808640e-01f, 1.19712204e-01f, 9.99280095e-01f, 3.79382223e-02f, 9.99927998e-01f, 1.19997123e-02f, 9.99992788e-01f, 3.79472389e-03f,
  9.07446802e-01f, 4.20167029e-01f, -5.65820515e-01f, -8.24528456e-01f, 2.67498761e-01f, 9.63558197e-01f, 9.16683376e-01f, 3.99614304e-01f,
  9.91561890e-01f, 1.29634142e-01f, 9.99155104e-01f, 4.10980321e-02f, 9.99915481e-01f, 1.29996343e-02f, 9.99991536e-01f, 4.11094911e-03f,
  1.36737213e-01f, 9.90607381e-01f, -2.81349480e-01f, -9.59605396e-01f, 1.69967160e-01f, 9.85449731e-01f, 9.03590262e-01f, 4.28397775e-01f,
  9.90216017e-01f, 1.39543116e-01f, 9.99020159e-01f, 4.42574248e-02f, 9.99902010e-01f, 1.39995432e-02f, 9.99990225e-01f, 4.42717411e-03f,
  -7.59687901e-01f, 6.50287867e-01f, 3.10223512e-02f, -9.99518692e-01f, 7.07371980e-02f, 9.97494996e-01f, 8.89593601e-01f, 4.56752867e-01f,
  9.88771081e-01f, 1.49438128e-01f, 9.98875201e-01f, 4.74163815e-02f, 9.99887526e-01f, 1.49994381e-02f, 9.99988735e-01f, 4.74339863e-03f,
  -9.57659483e-01f, -2.87903309e-01f, 3.40318173e-01f, -9.40310359e-01f, -2.91995462e-02f, 9.99573588e-01f, 8.74707460e-01f, 4.84651238e-01f,
  9.87227261e-01f, 1.59318209e-01f, 9.98720288e-01f, 5.05748577e-02f, 9.99872029e-01f, 1.59993190e-02f, 9.99987185e-01f, 5.05962269e-03f,
  -2.75163352e-01f, -9.61397469e-01f, 6.15864813e-01f, -7.87851870e-01f, -1.28844544e-01f, 9.91664827e-01f, 8.58946681e-01f, 5.12064993e-01f,
  9.85584795e-01f, 1.69182345e-01f, 9.98555362e-01f, 5.37328273e-02f, 9.99855518e-01f, 1.69991814e-02f, 9.99985576e-01f, 5.37584582e-03f,
  6.60316706e-01f, -7.50987232e-01f, 8.30336154e-01f, -5.57262897e-01f, -2.27202162e-01f, 9.73847628e-01f, 8.42327058e-01f, 5.38966715e-01f,
  9.83843684e-01f, 1.79029569e-01f, 9.98380423e-01f, 5.68902642e-02f, 9.99837995e-01f, 1.79990288e-02f, 9.99983788e-01f, 5.69206895e-03f,
  9.88704622e-01f, 1.49877205e-01f, 9.62463796e-01f, -2.71410108e-01f, -3.23289543e-01f, 9.46300089e-01f, 8.24865162e-01f, 5.65329552e-01f,
  9.82004225e-01f, 1.88858896e-01f, 9.98195529e-01f, 6.00471310e-02f, 9.99819517e-01f, 1.89988576e-02f, 9.99981940e-01f, 6.00829115e-03f,
  4.08082068e-01f, 9.12945271e-01f, 9.99144375e-01f, 4.13582884e-02f, -4.16146845e-01f, 9.09297407e-01f, 8.06578457e-01f, 5.91127038e-01f,
  9.80066597e-01f, 1.98669314e-01f, 9.98000681e-01f, 6.32033944e-02f, 9.99800026e-01f, 1.99986678e-02f, 9.99979973e-01f, 6.32451288e-03f,
  -5.47729254e-01f, 8.36655617e-01f, 9.36740458e-01f, 3.50024760e-01f, -5.04846215e-01f, 8.63209307e-01f, 7.87485182e-01f, 6.16333544e-01f,
  9.78030920e-01f, 2.08459899e-01f, 9.97795820e-01f, 6.63590282e-02f, 9.99779522e-01f, 2.09984574e-02f, 9.99977946e-01f, 6.64073415e-03f,
  -9.99960840e-01f, -8.85130931e-03f, 7.81440377e-01f, 6.23979926e-01f, -5.88501155e-01f, 8.08496356e-01f, 7.67604589e-01f, 6.40923738e-01f,
  9.75897431e-01f, 2.18229622e-01f, 9.97581005e-01f, 6.95140064e-02f, 9.99758005e-01f, 2.19982266e-02f, 9.99975801e-01f, 6.95695449e-03f,
  -5.32833040e-01f, -8.46220434e-01f, 5.48645258e-01f, 8.36055279e-01f, -6.66275978e-01f, 7.45705247e-01f, 7.46956408e-01f, 6.64873064e-01f,
  9.73666370e-01f, 2.27977514e-01f, 9.97356176e-01f, 7.26682767e-02f, 9.99735534e-01f, 2.29979735e-02f, 9.99973536e-01f, 7.27317436e-03f,
  4.24179018e-01f, -9.05578375e-01f, 2.61441678e-01f, 9.65219259e-01f, -7.37393796e-01f, 6.75463140e-01f, 7.25561321e-01f, 6.88157499e-01f,
  9.71337974e-01f, 2.37702623e-01f, 9.97121394e-01f, 7.58218244e-02f, 9.99711990e-01f, 2.39976961e-02f, 9.99971211e-01f, 7.58939330e-03f,
  9.91202831e-01f, -1.32351756e-01f, -5.16893305e-02f, 9.98663187e-01f, -8.01143587e-01f, 5.98472118e-01f, 7.03440726e-01f, 7.10753918e-01f,
  9.68912423e-01f, 2.47403964e-01f, 9.96876657e-01f, 7.89746121e-02f, 9.99687493e-01f, 2.49973964e-02f, 9.99968767e-01f, 7.90561177e-03f,
  6.46919310e-01f, 7.62558460e-01f, -3.59694332e-01f, 9.33070183e-01f, -8.56888831e-01f, 5.15501261e-01f, 6.80616796e-01f, 7.32639611e-01f,
  9.66389954e-01f, 2.57080555e-01f, 9.96621907e-01f, 8.21266174e-02f, 9.99662042e-01f, 2.59970706e-02f, 9.99966204e-01f, 8.22182931e-03f,
  -2.92138815e-01f, 9.56375957e-01f, -6.32028639e-01f, 7.74945021e-01f, -9.04072165e-01f, 4.27379847e-01f, 6.57112300e-01f, 7.53792703e-01f,
  9.63770926e-01f, 2.66731411e-01f, 9.96357203e-01f, 8.52777958e-02f, 9.99635518e-01f, 2.69967206e-02f, 9.99963522e-01f, 8.53804592e-03f,
  -9.62605894e-01f, 2.70905793e-01f, -8.41684937e-01f, 5.39968967e-01f, -9.42222297e-01f, 3.34988207e-01f, 6.32950664e-01f, 7.74192095e-01f,
  9.61055458e-01f, 2.76355654e-01f, 9.96082544e-01f, 8.84281173e-02f, 9.99608040e-01f, 2.79963426e-02f, 9.99960780e-01f, 8.85426160e-03f,
  -7.48057544e-01f, -6.63633883e-01f, -9.67871487e-01f, 2.51445323e-01f, -9.70958173e-01f, 2.39249229e-01f, 6.08156204e-01f, 7.93817401e-01f,
  9.58243906e-01f, 2.85952210e-01f, 9.95797932e-01f, 9.15775672e-02f, 9.99579549e-01f, 2.89959367e-02f, 9.99957979e-01f, 9.17047635e-03f,
  1.54251456e-01f, -9.88031626e-01f, -9.98075247e-01f, -6.20148405e-02f, -9.89992499e-01f, 1.41120002e-01f, 5.82753658e-01f, 8.12648892e-01f,
  9.55336511e-01f, 2.95520186e-01f, 9.95503366e-01f, 9.47260931e-02f, 9.99550045e-01f, 2.99955010e-02f, 9.99954998e-01f, 9.48669016e-03f,
  9.14742351e-01f, -4.04037654e-01f, -9.29300308e-01f, -3.69325012e-01f, -9.99135137e-01f, 4.15805206e-02f, 5.56768358e-01f, 8.30667794e-01f,
  9.52333570e-01f, 3.05058628e-01f, 9.95198846e-01f, 9.78736654e-02f, 9.99519527e-01f, 3.09950355e-02f, 9.99951959e-01f, 9.80290305e-03f,
  8.34223390e-01f, 5.51426709e-01f, -7.68367112e-01f, -6.40009403e-01f, -9.98294771e-01f, -5.83741926e-02f, 5.30226350e-01f, 8.47856104e-01f,
  9.49235439e-01f, 3.14566553e-01f, 9.94884372e-01f, 1.01020269e-01f, 9.99488056e-01f, 3.19945402e-02f, 9.99948800e-01f, 1.01191159e-02f,
  -1.32767474e-02f, 9.99911845e-01f, -5.31235278e-01f, -8.47224355e-01f, -9.87479806e-01f, -1.57745644e-01f, 5.03154159e-01f, 8.64196658e-01f,
  9.46042359e-01f, 3.24043006e-01f, 9.94559944e-01f, 1.04165860e-01f, 9.99455571e-01f, 3.29940096e-02f, 9.99945521e-01f, 1.04353270e-02f,
  -8.48570287e-01f, 5.29082716e-01f, -2.41421118e-01f, -9.70420420e-01f, -9.66798186e-01f, -2.55541205e-01f, 4.75578904e-01f, 8.79673064e-01f,
  9.42754686e-01f, 3.33487093e-01f, 9.94225562e-01f, 1.07310407e-01f, 9.99422073e-01f, 3.39934528e-02f, 9.99942183e-01f, 1.07515370e-02f,
  -9.03692186e-01f, -4.28182662e-01f, 7.23346695e-02f, -9.97380435e-01f, -9.36456680e-01f, -3.50783229e-01f, 4.47528064e-01f, 8.94269884e-01f,
  9.39372718e-01f, 3.42897803e-01f, 9.93881226e-01f, 1.10453881e-01f, 9.99387562e-01f, 3.49928550e-02f, 9.99938726e-01f, 1.10677453e-02f,
  -1.27963692e-01f, -9.91778851e-01f, 3.78916174e-01f, -9.25431013e-01f, -8.96758378e-01f, -4.42520559e-01f, 4.19029742e-01f, 9.07972515e-01f,
  9.35896814e-01f, 3.52274209e-01f, 9.93526995e-01f, 1.13596253e-01f, 9.99352098e-01f, 3.59922275e-02f, 9.99935210e-01f, 1.13839535e-02f,
  7.65414059e-01f, -6.43538117e-01f, 6.47921681e-01f, -7.61706948e-01f, -8.48100007e-01f, -5.29836178e-01f, 3.90112430e-01f, 9.20767248e-01f,
  9.32327330e-01f, 3.61615449e-01f, 9.93162811e-01f, 1.16737492e-01f, 9.99315560e-01f, 3.69915590e-02f, 9.99931574e-01f, 1.17001599e-02f,
  9.55073655e-01f, 2.96368569e-01f, 8.52673113e-01f, -5.22444785e-01f, -7.90967762e-01f, -6.11857831e-01f, 3.60805035e-01f, 9.32641268e-01f,
  9.28664625e-01f, 3.70920479e-01f, 9.92788672e-01f, 1.19877554e-01f, 9.99278069e-01f, 3.79908569e-02f, 9.99927819e-01f, 1.20163653e-02f,
  2.66642928e-01f, 9.63795364e-01f, 9.72865343e-01f, -2.31372014e-01f, -7.25932240e-01f, -6.87766254e-01f, 3.31136853e-01f, 9.43582714e-01f,
  9.24909055e-01f, 3.80188406e-01f, 9.92404640e-01f, 1.23016424e-01f, 9.99239624e-01f, 3.89901139e-02f, 9.99923944e-01f, 1.23325698e-02f,
  -6.66938066e-01f, 7.45113134e-01f, 9.96578991e-01f, 8.26458037e-02f, -6.53643608e-01f, -7.56802499e-01f, 3.01137596e-01f, 9.53580678e-01f,
  9.21060979e-01f, 3.89418334e-01f, 9.92010653e-01f, 1.26154065e-01f, 9.99200106e-01f, 3.99893373e-02f, 9.99920011e-01f, 1.26487734e-02f,
  -9.87339258e-01f, -1.58622667e-01f, 9.21462357e-01f, 3.88467699e-01f, -5.74824035e-01f, -8.18277061e-01f, 2.70837069e-01f, 9.62625206e-01f,
  9.17120814e-01f, 3.98609310e-01f, 9.91606772e-01f, 1.29290432e-01f, 9.99159634e-01f, 4.09885161e-02f, 9.99915957e-01f, 1.29649751e-02f,
  -3.99985313e-01f, -9.16521549e-01f, 7.54965365e-01f, 6.55764699e-01f, -4.90260571e-01f, -8.71575892e-01f, 2.40265876e-01f, 9.70707119e-01f,
  9.13088918e-01f, 4.07760441e-01f, 9.91192937e-01f, 1.32425532e-01f, 9.99118149e-01f, 4.19876575e-02f, 9.99911785e-01f, 1.32811759e-02f,
  5.55113316e-01f, -8.31774771e-01f, 5.13598442e-01f, 8.58030677e-01f, -4.00799006e-01f, -9.16166008e-01f, 2.09454417e-01f, 9.77818429e-01f,
  9.08965766e-01f, 4.16870773e-01f, 9.90769207e-01f, 1.35559291e-01f, 9.99075651e-01f, 4.29867506e-02f, 9.99907553e-01f, 1.35973748e-02f,
  9.99843299e-01f, 1.77019257e-02f, 2.21298173e-01f, 9.75206196e-01f, -3.07332784e-01f, -9.51602101e-01f, 1.78433523e-01f, 9.83951986e-01f,
  9.04751658e-01f, 4.25939471e-01f, 9.90335584e-01f, 1.38691694e-01f, 9.99032140e-01f, 4.39858064e-02f, 9.99903202e-01f, 1.39135728e-02f,
  5.25321960e-01f, 8.50903511e-01f, -9.29481089e-02f, 9.95670974e-01f, -2.10795805e-01f, -9.77530122e-01f, 1.47234216e-01f, 9.89101648e-01f,
  9.00447130e-01f, 4.34965521e-01f, 9.89892066e-01f, 1.41822711e-01f, 9.98987675e-01f, 4.49848175e-02f, 9.99898732e-01f, 1.42297689e-02f,
  -4.32177931e-01f, 9.01788354e-01f, -3.97976756e-01f, 9.17395473e-01f, -1.12152621e-01f, -9.93690968e-01f, 1.15887694e-01f, 9.93262351e-01f,
  8.96052480e-01f, 4.43948090e-01f, 9.89438653e-01f, 1.44952312e-01f, 9.98942196e-01f, 4.59837839e-02f, 9.99894202e-01f, 1.45459641e-02f,
  -9.92335498e-01f, 1.23573124e-01f, -6.63538277e-01f, 7.48142362e-01f, -1.23883775e-02f, -9.99923289e-01f, 8.44252855e-02f, 9.96429801e-01f,
  8.91568303e-01f, 4.52886283e-01f, 9.88975346e-01f, 1.48080453e-01f, 9.98895705e-01f, 4.69827019e-02f, 9.99889553e-01f, 1.48621574e-02f,
  -6.40144348e-01f, -7.68254638e-01f, -8.63296509e-01f, 5.04697084e-01f, 8.74991715e-02f, -9.96164620e-01f, 5.28784581e-02f, 9.98600960e-01f,
  8.86994898e-01f, 4.61779177e-01f, 9.88502085e-01f, 1.51207119e-01f, 9.98848200e-01f, 4.79815714e-02f, 9.99884784e-01f, 1.51783489e-02f,
  3.00592542e-01f, -9.53752637e-01f, -9.77442741e-01f, 2.11200655e-01f, 1.86512470e-01f, -9.82452571e-01f, 2.12787576e-02f, 9.99773562e-01f,
  8.82332861e-01f, 4.70625877e-01f, 9.88018990e-01f, 1.54332280e-01f, 9.98799741e-01f, 4.89803962e-02f, 9.99879956e-01f, 1.54945394e-02f,
  9.64965999e-01f, -2.62374848e-01f, -9.94656444e-01f, -1.03240460e-01f, 2.83662200e-01f, -9.58924294e-01f, -1.03422189e-02f, 9.99946535e-01f,
  8.77582550e-01f, 4.79425550e-01f, 9.87526000e-01f, 1.57455891e-01f, 9.98750269e-01f, 4.99791689e-02f, 9.99875009e-01f, 1.58107281e-02f,
  7.42154181e-01f, 6.70229197e-01f, -9.13230121e-01f, -4.07444149e-01f, 3.77977669e-01f, -9.25814748e-01f, -4.19528559e-02f, 9.99119580e-01f,
  8.72744501e-01f, 4.88177240e-01f, 9.87023175e-01f, 1.60577938e-01f, 9.98699784e-01f, 5.09778969e-02f, 9.99869943e-01f, 1.61269177e-02f,
  -1.62990779e-01f, 9.86627579e-01f, -7.41239965e-01f, -6.71240151e-01f, 4.68516916e-01f, -8.83454502e-01f, -7.35215396e-02f, 9.97293651e-01f,
  8.67819190e-01f, 4.96880114e-01f, 9.86510456e-01f, 1.63698375e-01f, 9.98648286e-01f, 5.19765690e-02f, 9.99864817e-01f, 1.64431017e-02f,
  -9.18282807e-01f, 3.95925164e-01f, -4.95741814e-01f, -8.68469954e-01f, 5.54374516e-01f, -8.32267344e-01f, -1.05016708e-01f, 9.94470477e-01f,
  8.62807095e-01f, 5.05533338e-01f, 9.85987842e-01f, 1.66817173e-01f, 9.98595834e-01f, 5.29751927e-02f, 9.99859571e-01f, 1.67592876e-02f,
  -8.29309821e-01f, -5.58789074e-01f, -2.01079622e-01f, -9.79574919e-01f, 6.34692967e-01f, -7.72764444e-01f, -1.36406869e-01f, 9.90652919e-01f,
  8.57708693e-01f, 5.14135957e-01f, 9.85455394e-01f, 1.69934288e-01f, 9.98542368e-01f, 5.39737605e-02f, 9.99854207e-01f, 1.70754679e-02f,
  2.21267566e-02f, -9.99755144e-01f, 1.13521777e-01f, -9.93535519e-01f, 7.08669782e-01f, -7.05540299e-01f, -1.67660639e-01f, 9.85844791e-01f,
  8.52524519e-01f, 5.22687256e-01f, 9.84913111e-01f, 1.73049718e-01f, 9.98487890e-01f, 5.49722798e-02f, 9.99848783e-01f, 1.73916500e-02f,
  8.53220105e-01f, -5.21551013e-01f, 4.16867077e-01f, -9.08967435e-01f, 7.75565803e-01f, -6.31266713e-01f, -1.98746875e-01f, 9.80050862e-01f,
  8.47255111e-01f, 5.31186223e-01f, 9.84360933e-01f, 1.76163420e-01f, 9.98432398e-01f, 5.59707358e-02f, 9.99843180e-01f, 1.77078284e-02f,
  8.99866819e-01f, 4.36164767e-01f, 6.78870201e-01f, -7.34258294e-01f, 8.34712923e-01f, -5.50685287e-01f, -2.29634270e-01f, 9.73276973e-01f,
  8.41901004e-01f, 5.39632022e-01f, 9.83798921e-01f, 1.79275364e-01f, 9.98375952e-01f, 5.69691435e-02f, 9.99837577e-01f, 1.80240069e-02f,
  1.19180135e-01f, 9.92872655e-01f, 8.73550534e-01f, -4.86733496e-01f, 8.85519624e-01f, -4.64602023e-01f, -2.60292053e-01f, 9.65529919e-01f,
  8.36462677e-01f, 5.48023939e-01f, 9.83227074e-01f, 1.82385504e-01f, 9.98318493e-01f, 5.79674877e-02f, 9.99831796e-01f, 1.83401816e-02f,
  -7.71080196e-01f, 6.36738002e-01f, 9.81602073e-01f, -1.90938011e-01f, 9.27478492e-01f, -3.73876572e-01f, -2.90689558e-01f, 9.56817448e-01f,
  8.30940723e-01f, 5.56361020e-01f, 9.82645452e-01f, 1.85493827e-01f, 9.98260021e-01f, 5.89657798e-02f, 9.99825954e-01f, 1.86563563e-02f,
  -9.52412963e-01f, -3.04810613e-01f, 9.92308319e-01f, 1.23790950e-01f, 9.60170269e-01f, -2.79415488e-01f, -3.20796400e-01f, 9.47148204e-01f,
  8.25335622e-01f, 5.64642429e-01f, 9.82053936e-01f, 1.88600287e-01f, 9.98200536e-01f, 5.99640086e-02f, 9.99819994e-01f, 1.89725272e-02f,
  -2.58101642e-01f, -9.66117799e-01f, 9.04607594e-01f, 4.26245421e-01f, 9.83268440e-01f, -1.82162598e-01f, -3.50582451e-01f, 9.36531842e-01f,
  8.19648027e-01f, 5.72867453e-01f, 9.81452644e-01f, 1.91704854e-01f, 9.98140097e-01f, 6.09621815e-02f, 9.99813974e-01f, 1.92886982e-02f,
  6.73507154e-01f, -7.39180684e-01f, 7.27198064e-01f, 6.86427653e-01f, 9.96542096e-01f, -8.30891207e-02f, -3.80017966e-01f, 9.24979091e-01f,
  8.13878477e-01f, 5.81035137e-01f, 9.80841517e-01f, 1.94807529e-01f, 9.98078644e-01f, 6.19602874e-02f, 9.99807835e-01f, 1.96048655e-02f,
  9.85896587e-01f, 1.67355701e-01f, 4.77671444e-01f, 8.78538549e-01f, 9.99858618e-01f, 1.68140903e-02f, -4.09073502e-01f, 9.12501454e-01f,
  8.08027506e-01f, 5.89144766e-01f, 9.80220556e-01f, 1.97908238e-01f, 9.98016179e-01f, 6.29583374e-02f, 9.99801576e-01f, 1.99210308e-02f,
};
__device__ const float TAB_S[2048] = {
  1.00000000e+00f, 0.00000000e+00f, 1.00000000e+00f, 0.00000000e+00f, 1.00000000e+00f, 0.00000000e+00f, 1.00000000e+00f, 0.00000000e+00f,
  1.00000000e+00f, 0.00000000e+00f, 1.00000000e+00f, 0.00000000e+00f, 1.00000000e+00f, 0.00000000e+00f, 1.00000000e+00f, 0.00000000e+00f,
  1.00000000e+00f, 0.00000000e+00f, 1.00000000e+00f, 0.00000000e+00f, 1.00000000e+00f, 0.00000000e+00f, 1.00000000e+00f, 0.00000000e+00f,
  1.00000000e+00f, 0.00000000e+00f, 1.00000000e+00f, 0.00000000e+00f, 1.00000000e+00f, 0.00000000e+00f, 1.00000000e+00f, 0.00000000e+00f,
  5.40302277e-01f, 8.41470957e-01f, 8.46009135e-01f, 5.33168435e-01f, 9.50415254e-01f, 3.10983598e-01f, 9.84230220e-01f, 1.76892191e-01f,
  9.95004177e-01f, 9.98334214e-02f, 9.98419285e-01f, 5.62044978e-02f, 9.99500036e-01f, 3.16175036e-02f, 9.99841869e-01f, 1.77818574e-02f,
  9.99949992e-01f, 9.99983307e-03f, 9.99984205e-01f, 5.62338345e-03f, 9.99994993e-01f, 3.16227227e-03f, 9.99998391e-01f, 1.77827850e-03f,
  9.99999523e-01f, 9.99999931e-04f, 9.99999821e-01f, 5.62341243e-04f, 9.99999940e-01f, 3.16227757e-04f, 1.00000000e+00f, 1.77827940e-04f,
  -4.16146845e-01f, 9.09297407e-01f, 4.31462824e-01f, 9.02130723e-01f, 8.06578398e-01f, 5.91127098e-01f, 9.37418282e-01f, 3.48205268e-01f,
  9.80066597e-01f, 1.98669329e-01f, 9.93682086e-01f, 1.12231314e-01f, 9.98000681e-01f, 6.32033944e-02f, 9.99367595e-01f, 3.55580896e-02f,
  9.99800026e-01f, 1.99986659e-02f, 9.99936759e-01f, 1.12465890e-02f, 9.99979973e-01f, 6.32451288e-03f, 9.99993682e-01f, 3.55655141e-03f,
  9.99997973e-01f, 1.99999870e-03f, 9.99999344e-01f, 1.12468237e-03f, 9.99999821e-01f, 6.32455456e-04f, 9.99999940e-01f, 3.55655880e-04f,
  -9.89992499e-01f, 1.41120002e-01f, -1.15966164e-01f, 9.93253171e-01f, 5.82753658e-01f, 8.12648892e-01f, 8.61040652e-01f, 5.08536100e-01f,
  9.55336511e-01f, 2.95520216e-01f, 9.85803485e-01f, 1.67903304e-01f, 9.95503366e-01f, 9.47260857e-02f, 9.98577297e-01f, 5.33230826e-02f,
  9.99550045e-01f, 2.99954992e-02f, 9.99857724e-01f, 1.68694388e-02f, 9.99954998e-01f, 9.48669016e-03f, 9.99985754e-01f, 5.33481315e-03f,
  9.99995530e-01f, 2.99999560e-03f, 9.99998569e-01f, 1.68702309e-03f, 9.99999523e-01f, 9.48683126e-04f, 9.99999881e-01f, 5.33483806e-04f,
  -6.53643608e-01f, -7.56802499e-01f, -6.27679706e-01f, 7.78471708e-01f, 3.01137477e-01f, 9.53580737e-01f, 7.57506192e-01f, 6.52827978e-01f,
  9.21060979e-01f, 3.89418334e-01f, 9.74808276e-01f, 2.23044485e-01f, 9.92010653e-01f, 1.26154065e-01f, 9.97471273e-01f, 7.10712075e-02f,
  9.99200106e-01f, 3.99893336e-02f, 9.99747038e-01f, 2.24917568e-02f, 9.99920011e-01f, 1.26487734e-02f, 9.99974728e-01f, 7.11305765e-03f,
  9.99992013e-01f, 3.99998948e-03f, 9.99997497e-01f, 2.24936334e-03f, 9.99999225e-01f, 1.26491068e-03f, 9.99999762e-01f, 7.11311703e-04f,
  2.83662200e-01f, -9.58924294e-01f, -9.46079254e-01f, 3.23935270e-01f, -1.03423381e-02f, 9.99946535e-01f, 6.30080283e-01f, 7.76529968e-01f,
  8.77582550e-01f, 4.79425550e-01f, 9.60731268e-01f, 2.77480543e-01f, 9.87526000e-01f, 1.57455876e-01f, 9.96049762e-01f, 8.87968615e-02f,
  9.98750269e-01f, 4.99791652e-02f, 9.99604762e-01f, 2.81133614e-02f, 9.99875009e-01f, 1.58107281e-02f, 9.99960482e-01f, 8.89127981e-03f,
  9.99987483e-01f, 4.99997940e-03f, 9.99996066e-01f, 2.81170290e-03f, 9.99998748e-01f, 1.58113812e-03f, 9.99999583e-01f, 8.89139599e-04f,
  9.60170269e-01f, -2.79415488e-01f, -9.73103702e-01f, -2.30367512e-01f, -3.20796400e-01f, 9.47148204e-01f, 4.82782036e-01f, 8.75740528e-01f,
  8.25335622e-01f, 5.64642489e-01f, 9.43616986e-01f, 3.31039310e-01f, 9.82053936e-01f, 1.88600272e-01f, 9.94313300e-01f, 1.06494442e-01f,
  9.98200536e-01f, 5.99640049e-02f, 9.99430835e-01f, 3.37340795e-02f, 9.99819994e-01f, 1.89725272e-02f, 9.99943078e-01f, 1.06694745e-02f,
  9.99981999e-01f, 5.99996420e-03f, 9.99994338e-01f, 3.37404152e-03f, 9.99998212e-01f, 1.89736532e-03f, 9.99999404e-01f, 1.06696738e-03f,
  7.53902256e-01f, 6.56986594e-01f, -7.00429797e-01f, -7.13721275e-01f, -5.99437475e-01f, 8.00421596e-01f, 3.20257008e-01f, 9.47330713e-01f,
  7.64842212e-01f, 6.44217670e-01f, 9.23519433e-01f, 3.83551568e-01f, 9.75599885e-01f, 2.19556093e-01f, 9.92262423e-01f, 1.24158338e-01f,
  9.97551024e-01f, 6.99428469e-02f, 9.99225318e-01f, 3.93537246e-02f, 9.99755025e-01f, 2.21341345e-02f, 9.99922514e-01f, 1.24476347e-02f,
  9.99975502e-01f, 6.99994294e-03f, 9.99992251e-01f, 3.93637875e-03f, 9.99997556e-01f, 2.21359241e-03f, 9.99999225e-01f, 1.24479528e-03f,
  -1.45500034e-01f, 9.89358246e-01f, -2.12036446e-01f, -9.77261782e-01f, -8.18632424e-01f, 5.74317753e-01f, 1.47631213e-01f, 9.89042461e-01f,
  6.96706712e-01f, 7.17356086e-01f, 9.00502324e-01f, 4.34851229e-01f, 9.68170285e-01f, 2.50292331e-01f, 9.89897788e-01f, 1.41782969e-01f,
  9.96801734e-01f, 7.99146891e-02f, 9.98988271e-01f, 4.49721329e-02f, 9.99680042e-01f, 2.52955221e-02f, 9.99898791e-01f, 1.42257558e-02f,
  9.99967992e-01f, 7.99991470e-03f, 9.99989867e-01f, 4.49871505e-03f, 9.99996781e-01f, 2.52981926e-03f, 9.99998987e-01f, 1.42262306e-03f,
  -9.11130250e-01f, 4.12118495e-01f, 3.41660261e-01f, -9.39823508e-01f, -9.56644177e-01f, 2.91259229e-01f, -2.96507962e-02f, 9.99560297e-01f,
  6.21609926e-01f, 7.83326924e-01f, 8.74638259e-01f, 4.84776139e-01f, 9.59772646e-01f, 2.80778319e-01f, 9.87220109e-01f, 1.59362778e-01f,
  9.95952725e-01f, 8.98785442e-02f, 9.98719573e-01f, 5.05891182e-02f, 9.99595046e-01f, 2.84566563e-02f, 9.99871910e-01f, 1.60038304e-02f,
  9.99959528e-01f, 8.99987947e-03f, 9.99987185e-01f, 5.06105041e-03f, 9.99995947e-01f, 2.84604589e-03f, 9.99998748e-01f, 1.60045072e-03f,
  -8.39071512e-01f, -5.44021130e-01f, 7.90131867e-01f, -6.12936914e-01f, -9.99786079e-01f, -2.06835698e-02f, -2.05997631e-01f, 9.78552461e-01f,
  5.40302277e-01f, 8.41470957e-01f, 8.46009135e-01f, 5.33168435e-01f, 9.50415313e-01f, 3.10983568e-01f, 9.84230220e-01f, 1.76892191e-01f,
  9.95004177e-01f, 9.98334140e-02f, 9.98419285e-01f, 5.62044978e-02f, 9.99500036e-01f, 3.16175036e-02f, 9.99841869e-01f, 1.77818574e-02f,
  9.99949992e-01f, 9.99983400e-03f, 9.99984205e-01f, 5.62338345e-03f, 9.99994993e-01f, 3.16227227e-03f, 9.99998391e-01f, 1.77827850e-03f,
  4.42569796e-03f, -9.99990225e-01f, 9.95257378e-01f, -9.72764567e-02f, -9.43779767e-01f, -3.30574960e-01f, -3.75847399e-01f, 9.26681578e-01f,
  4.53596085e-01f, 8.91207397e-01f, 8.14705312e-01f, 5.79875171e-01f, 9.40107584e-01f, 3.40877861e-01f, 9.80929136e-01f, 1.94365650e-01f,
  9.93956089e-01f, 1.09778300e-01f, 9.98087406e-01f, 6.18181042e-02f, 9.99395072e-01f, 3.47780399e-02f, 9.99808669e-01f, 1.95598267e-02f,
  9.99939501e-01f, 1.09997792e-02f, 9.99980867e-01f, 6.18571462e-03f, 9.99993920e-01f, 3.47849843e-03f, 9.99998093e-01f, 1.95610616e-03f,
  8.43853951e-01f, -5.36572933e-01f, 8.93861592e-01f, 4.48342979e-01f, -7.94179380e-01f, -6.07683420e-01f, -5.33843040e-01f, 8.45583618e-01f,
  3.62357706e-01f, 9.32039082e-01f, 7.80825913e-01f, 6.24748647e-01f, 9.28859890e-01f, 3.70431304e-01f, 9.77317870e-01f, 2.11777672e-01f,
  9.92808640e-01f, 1.19712204e-01f, 9.97723997e-01f, 6.74297586e-02f, 9.99280095e-01f, 3.79382223e-02f, 9.99772310e-01f, 2.13377345e-02f,
  9.99927998e-01f, 1.19997123e-02f, 9.99977231e-01f, 6.74804440e-03f, 9.99992788e-01f, 3.79472389e-03f, 9.99997735e-01f, 2.13393359e-03f,
  9.07446802e-01f, 4.20167029e-01f, 5.17172873e-01f, 8.55880976e-01f, -5.65820515e-01f, -8.24528456e-01f, -6.75001681e-01f, 7.37816215e-01f,
  2.67498761e-01f, 9.63558197e-01f, 7.44477987e-01f, 6.67647004e-01f, 9.16683376e-01f, 3.99614304e-01f, 9.73397553e-01f, 2.29122713e-01f,
  9.91561890e-01f, 1.29634142e-01f, 9.97329056e-01f, 7.30392784e-02f, 9.99155104e-01f, 4.10980321e-02f, 9.99732792e-01f, 2.31155735e-02f,
  9.99915481e-01f, 1.29996343e-02f, 9.99973297e-01f, 7.31037185e-03f, 9.99991536e-01f, 4.11094911e-03f, 9.99997318e-01f, 2.31176103e-03f,
  1.36737213e-01f, 9.90607381e-01f, -1.87961515e-02f, 9.99823332e-01f, -2.81349480e-01f, -9.59605396e-01f, -7.94870913e-01f, 6.06778562e-01f,
  1.69967160e-01f, 9.85449731e-01f, 7.05776393e-01f, 7.08434701e-01f, 9.03590262e-01f, 4.28397775e-01f, 9.69169438e-01f, 2.46395305e-01f,
  9.90216017e-01f, 1.39543116e-01f, 9.96902585e-01f, 7.86464810e-02f, 9.99020159e-01f, 4.42574248e-02f, 9.99690115e-01f, 2.48933397e-02f,
  9.99902010e-01f, 1.39995432e-02f, 9.99969006e-01f, 7.87269697e-03f, 9.99990225e-01f, 4.42717411e-03f, 9.99996901e-01f, 2.48958869e-03f,
  -7.59687901e-01f, 6.50287867e-01f, -5.48975468e-01f, 8.35838437e-01f, 3.10223512e-02f, -9.99518692e-01f, -8.89670432e-01f, 4.56603259e-01f,
  7.07371980e-02f, 9.97494996e-01f, 6.64843500e-01f, 7.46982634e-01f, 8.89593601e-01f, 4.56752867e-01f, 9.64634836e-01f, 2.63589978e-01f,
  9.88771081e-01f, 1.49438128e-01f, 9.96444523e-01f, 8.42512026e-02f, 9.98875201e-01f, 4.74163815e-02f, 9.99644279e-01f, 2.66710296e-02f,
  9.99887526e-01f, 1.49994381e-02f, 9.99964416e-01f, 8.43502022e-03f, 9.99988735e-01f, 4.74339863e-03f, 9.99996424e-01f, 2.66741589e-03f,
  -9.57659483e-01f, -2.87903309e-01f, -9.10081089e-01f, 4.14430231e-01f, 3.40318173e-01f, -9.40310359e-01f, -9.56410050e-01f, 2.92027086e-01f,
  -2.91995462e-02f, 9.99573588e-01f, 6.21808827e-01f, 7.83169091e-01f, 8.74707460e-01f, 4.84651238e-01f, 9.59795177e-01f, 2.80701309e-01f,
  9.87227261e-01f, 1.59318209e-01f, 9.95954990e-01f, 8.98532644e-02f, 9.98720288e-01f, 5.05748577e-02f, 9.99595284e-01f, 2.84486320e-02f,
  9.99872029e-01f, 1.59993190e-02f, 9.99959528e-01f, 8.99733976e-03f, 9.99987185e-01f, 5.05962269e-03f, 9.99995947e-01f, 2.84524332e-03f,
  -2.75163352e-01f, -9.61397469e-01f, -9.90897954e-01f, -1.34615138e-01f, 6.15864813e-01f, -7.87851870e-01f, -9.92985010e-01f, 1.18240520e-01f,
  -1.28844544e-01f, 9.91664827e-01f, 5.76808274e-01f, 8.16879570e-01f, 8.58946681e-01f, 5.12064993e-01f, 9.54652011e-01f, 2.97723860e-01f,
  9.85584795e-01f, 1.69182345e-01f, 9.95433986e-01f, 9.54524800e-02f, 9.98555362e-01f, 5.37328273e-02f, 9.99543071e-01f, 3.02261449e-02f,
  9.99855518e-01f, 1.69991814e-02f, 9.99954283e-01f, 9.55965649e-03f, 9.99985576e-01f, 5.37584582e-03f, 9.99995410e-01f, 3.02307028e-03f,
  6.60316706e-01f, -7.50987232e-01f, -7.66536534e-01f, -6.42200708e-01f, 8.30336154e-01f, -5.57262897e-01f, -9.98241663e-01f, -5.92755191e-02f,
  -2.27202162e-01f, 9.73847628e-01f, 5.29984176e-01f, 8.48007560e-01f, 8.42327058e-01f, 5.38966715e-01f, 9.49207008e-01f, 3.14652264e-01f,
  9.83843684e-01f, 1.79029569e-01f, 9.94881511e-01f, 1.01048686e-01f, 9.98380423e-01f, 5.68902642e-02f, 9.99487758e-01f, 3.20035629e-02f,
  9.99837995e-01f, 1.79990288e-02f, 9.99948800e-01f, 1.01219704e-02f, 9.99983788e-01f, 5.69206895e-03f, 9.99994874e-01f, 3.20089748e-03f,
  9.88704622e-01f, 1.49877205e-01f, -3.06095392e-01f, -9.52000856e-01f, 9.62463796e-01f, -2.71410108e-01f, -9.72014248e-01f, -2.34921798e-01f,
  -3.23289543e-01f, 9.46300089e-01f, 4.81484592e-01f, 8.76454532e-01f, 8.24865162e-01f, 5.65329552e-01f, 9.43461835e-01f, 3.31481189e-01f,
  9.82004225e-01f, 1.88858896e-01f, 9.94297504e-01f, 1.06641680e-01f, 9.98195529e-01f, 6.00471310e-02f, 9.99429286e-01f, 3.37808803e-02f,
  9.99819517e-01f, 1.89988576e-02f, 9.99942899e-01f, 1.06842816e-02f, 9.99981940e-01f, 6.00829115e-03f, 9.99994278e-01f, 3.37872445e-03f,
  4.08082068e-01f, 9.12945271e-01f, 2.48616725e-01f, -9.68601942e-01f, 9.99144375e-01f, 4.13582884e-02f, -9.15129960e-01f, -4.03158993e-01f,
  -4.16146845e-01f, 9.09297407e-01f, 4.31462824e-01f, 9.02130723e-01f, 8.06578457e-01f, 5.91127038e-01f, 9.37418282e-01f, 3.48205268e-01f,
  9.80066597e-01f, 1.98669314e-01f, 9.93682086e-01f, 1.12231314e-01f, 9.98000681e-01f, 6.32033944e-02f, 9.99367595e-01f, 3.55580896e-02f,
  9.99800026e-01f, 1.99986678e-02f, 9.99936759e-01f, 1.12465890e-02f, 9.99979973e-01f, 6.32451288e-03f, 9.99993682e-01f, 3.55655141e-03f,
  -5.47729254e-01f, 8.36655617e-01f, 7.26760268e-01f, -6.86891198e-01f, 9.36740458e-01f, 3.50024760e-01f, -8.29382956e-01f, -5.58680534e-01f,
  -5.04846215e-01f, 8.63209307e-01f, 3.80077004e-01f, 9.24954832e-01f, 7.87485182e-01f, 6.16333544e-01f, 9.31078374e-01f, 3.64819258e-01f,
  9.78030920e-01f, 2.08459899e-01f, 9.93035257e-01f, 1.17817394e-01f, 9.97795820e-01f, 6.63590282e-02f, 9.99302804e-01f, 3.73351872e-02f,
  9.99779522e-01f, 2.09984574e-02f, 9.99930263e-01f, 1.18088927e-02f, 9.99977946e-01f, 6.64073415e-03f, 9.99993026e-01f, 3.73437814e-03f,
  -9.99960840e-01f, -8.85130931e-03f, 9.81074572e-01f, -1.93630233e-01f, 7.81440377e-01f, 6.23979926e-01f, -7.17477441e-01f, -6.96581721e-01f,
  -5.88501155e-01f, 8.08496356e-01f, 3.27489585e-01f, 9.44854796e-01f, 7.67604589e-01f, 6.40923738e-01f, 9.24443960e-01f, 3.81317884e-01f,
  9.75897431e-01f, 2.18229622e-01f, 9.92357016e-01f, 1.23399742e-01f, 9.97581005e-01f, 6.95140064e-02f, 9.99234855e-01f, 3.91121693e-02f,
  9.99758005e-01f, 2.19982266e-02f, 9.99923468e-01f, 1.23711927e-02f, 9.99975801e-01f, 6.95695449e-03f, 9.99992371e-01f, 3.91220488e-03f,
  -5.32833040e-01f, -8.46220434e-01f, 9.33235765e-01f, 3.59264523e-01f, 5.48645258e-01f, 8.36055279e-01f, -5.82943261e-01f, -8.12512875e-01f,
  -6.66275978e-01f, 7.45705247e-01f, 2.73866832e-01f, 9.61767614e-01f, 7.46956408e-01f, 6.64873064e-01f, 9.17517304e-01f, 3.97695929e-01f,
  9.73666370e-01f, 2.27977514e-01f, 9.91647422e-01f, 1.28978193e-01f, 9.97356176e-01f, 7.26682767e-02f, 9.99163687e-01f, 4.08890247e-02f,
  9.99735534e-01f, 2.29979735e-02f, 9.99916375e-01f, 1.29334899e-02f, 9.99973536e-01f, 7.27317436e-03f, 9.99991655e-01f, 4.09003161e-03f,
  4.24179018e-01f, -9.05578375e-01f, 5.97977161e-01f, 8.01513135e-01f, 2.61441678e-01f, 9.65219259e-01f, -4.30023283e-01f, -9.02817786e-01f,
  -7.37393796e-01f, 6.75463140e-01f, 2.19378278e-01f, 9.75639880e-01f, 7.25561321e-01f, 6.88157499e-01f, 9.10300434e-01f, 4.13948208e-01f,
  9.71337974e-01f, 2.37702623e-01f, 9.90906477e-01f, 1.34552568e-01f, 9.97121394e-01f, 7.58218244e-02f, 9.99089420e-01f, 4.26657498e-02f,
  9.99711990e-01f, 2.39976961e-02f, 9.99908924e-01f, 1.34957815e-02f, 9.99971211e-01f, 7.58939330e-03f, 9.99990880e-01f, 4.26785741e-03f,
  9.91202831e-01f, -1.32351756e-01f, 7.85522610e-02f, 9.96909976e-01f, -5.16893305e-02f, 9.98663187e-01f, -2.63540596e-01f, -9.64648306e-01f,
  -8.01143587e-01f, 5.98472118e-01f, 1.64196163e-01f, 9.86427724e-01f, 7.03440726e-01f, 7.10753918e-01f, 9.02795732e-01f, 4.30069596e-01f,
  9.68912423e-01f, 2.47403964e-01f, 9.90134120e-01f, 1.40122697e-01f, 9.96876657e-01f, 7.89746121e-02f, 9.99011934e-01f, 4.44423407e-02f,
  9.99687493e-01f, 2.49973964e-02f, 9.99901175e-01f, 1.40580693e-02f, 9.99968767e-01f, 7.90561177e-03f, 9.99990106e-01f, 4.44568414e-03f,
  6.46919310e-01f, 7.62558460e-01f, -4.65064496e-01f, 8.85276794e-01f, -3.59694332e-01f, 9.33070183e-01f, -8.87455046e-02f, -9.96054351e-01f,
  -8.56888831e-01f, 5.15501261e-01f, 1.08494945e-01f, 9.94096994e-01f, 6.80616796e-01f, 7.32639611e-01f, 8.95005584e-01f, 4.46054995e-01f,
  9.66389954e-01f, 2.57080555e-01f, 9.89330530e-01f, 1.45688385e-01f, 9.96621907e-01f, 8.21266174e-02f, 9.98931348e-01f, 4.62187938e-02f,
  9.99662042e-01f, 2.59970706e-02f, 9.99893129e-01f, 1.46203535e-02f, 9.99966204e-01f, 8.22182931e-03f, 9.99989331e-01f, 4.62350994e-03f,
  -2.92138815e-01f, 9.56375957e-01f, -8.65450621e-01f, 5.00994205e-01f, -6.32028639e-01f, 7.74945021e-01f, 8.88481140e-02f, -9.96045172e-01f,
  -9.04072165e-01f, 4.27379847e-01f, 5.24506159e-02f, 9.98623490e-01f, 6.57112300e-01f, 7.53792703e-01f, 8.86932373e-01f, 4.61899310e-01f,
  9.63770926e-01f, 2.66731411e-01f, 9.88495648e-01f, 1.51249468e-01f, 9.96357203e-01f, 8.52777958e-02f, 9.98847544e-01f, 4.79951017e-02f,
  9.99635518e-01f, 2.69967206e-02f, 9.99884725e-01f, 1.51826320e-02f, 9.99963522e-01f, 8.53804592e-03f, 9.99988496e-01f, 4.80133574e-03f,
  -9.62605894e-01f, 2.70905793e-01f, -9.99293387e-01f, -3.75856608e-02f, -8.41684937e-01f, 5.39968967e-01f, 2.63639510e-01f, -9.64621305e-01f,
  -9.42222297e-01f, 3.34988207e-01f, -3.75941908e-03f, 9.99992907e-01f, 6.32950664e-01f, 7.74192095e-01f, 8.78578722e-01f, 4.77597594e-01f,
  9.61055458e-01f, 2.76355654e-01f, 9.87629473e-01f, 1.56805754e-01f, 9.96082544e-01f, 8.84281173e-02f, 9.98760641e-01f, 4.97712530e-02f,
  9.99608040e-01f, 2.79963426e-02f, 9.99876022e-01f, 1.57449059e-02f, 9.99960780e-01f, 8.85426160e-03f, 9.99987602e-01f, 4.97916201e-03f,
  -7.48057544e-01f, -6.63633883e-01f, -8.25371623e-01f, -5.64589798e-01f, -9.67871487e-01f, 2.51445323e-01f, 4.30115849e-01f, -9.02773678e-01f,
  -9.70958173e-01f, 2.39249229e-01f, -5.99575676e-02f, 9.98200953e-01f, 6.08156204e-01f, 7.93817401e-01f, 8.69947195e-01f, 4.93144840e-01f,
  9.58243906e-01f, 2.85952210e-01f, 9.86732066e-01f, 1.62357092e-01f, 9.95797932e-01f, 9.15775672e-02f, 9.98670578e-01f, 5.15472479e-02f,
  9.99579549e-01f, 2.89959367e-02f, 9.99867022e-01f, 1.63071752e-02f, 9.99957979e-01f, 9.17047635e-03f, 9.99986708e-01f, 5.15698735e-03f,
  1.54251456e-01f, -9.88031626e-01f, -3.97251874e-01f, -9.17709649e-01f, -9.98075247e-01f, -6.20148405e-02f, 5.83026946e-01f, -8.12452853e-01f,
  -9.89992499e-01f, 1.41120002e-01f, -1.15966164e-01f, 9.93253171e-01f, 5.82753658e-01f, 8.12648892e-01f, 8.61040652e-01f, 5.08536100e-01f,
  9.55336511e-01f, 2.95520186e-01f, 9.85803485e-01f, 1.67903304e-01f, 9.95503366e-01f, 9.47260931e-02f, 9.98577297e-01f, 5.33230826e-02f,
  9.99550045e-01f, 2.99955010e-02f, 9.99857724e-01f, 1.68694388e-02f, 9.99954998e-01f, 9.48669016e-03f, 9.99985754e-01f, 5.33481315e-03f,
  9.14742351e-01f, -4.04037654e-01f, 1.53215483e-01f, -9.88192797e-01f, -9.29300308e-01f, -3.69325012e-01f, 7.17549205e-01f, -6.96507812e-01f,
  -9.99135137e-01f, 4.15805206e-02f, -1.71608135e-01f, 9.85165298e-01f, 5.56768358e-01f, 8.30667794e-01f, 8.51861775e-01f, 5.23766637e-01f,
  9.52333570e-01f, 3.05058628e-01f, 9.84843671e-01f, 1.73444211e-01f, 9.95198846e-01f, 9.78736654e-02f, 9.98480916e-01f, 5.50987460e-02f,
  9.99519527e-01f, 3.09950355e-02f, 9.99848068e-01f, 1.74316969e-02f, 9.99951959e-01f, 9.80290305e-03f, 9.99984801e-01f, 5.51263802e-03f,
  8.34223390e-01f, 5.51426709e-01f, 6.56495154e-01f, -7.54330218e-01f, -7.68367112e-01f, -6.40009403e-01f, 8.29440355e-01f, -5.58595300e-01f,
  -9.98294771e-01f, -5.83741926e-02f, -2.26707578e-01f, 9.73962843e-01f, 5.30226350e-01f, 8.47856104e-01f, 8.42413545e-01f, 5.38831532e-01f,
  9.49235439e-01f, 3.14566553e-01f, 9.83852804e-01f, 1.78979620e-01f, 9.94884372e-01f, 1.01020269e-01f, 9.98381376e-01f, 5.68742342e-02f,
  9.99488056e-01f, 3.19945402e-02f, 9.99838114e-01f, 1.79939512e-02f, 9.99948800e-01f, 1.01191159e-02f, 9.99983788e-01f, 5.69046335e-03f,
  -1.32767474e-02f, 9.99911845e-01f, 9.57586050e-01f, -2.88147390e-01f, -5.31235278e-01f, -8.47224355e-01f, 9.15171385e-01f, -4.03064936e-01f,
  -9.87479806e-01f, -1.57745644e-01f, -2.81090319e-01f, 9.59681332e-01f, 5.03154159e-01f, 8.64196658e-01f, 8.32698941e-01f, 5.53726017e-01f,
  9.46042359e-01f, 3.24043006e-01f, 9.82830763e-01f, 1.84509367e-01f, 9.94559944e-01f, 1.04165860e-01f, 9.98278618e-01f, 5.86495437e-02f,
  9.99455571e-01f, 3.29940096e-02f, 9.99827802e-01f, 1.85561981e-02f, 9.99945521e-01f, 1.04353270e-02f, 9.99982774e-01f, 5.86828869e-03f,
  -8.48570287e-01f, 5.29082716e-01f, 9.63757515e-01f, 2.66779721e-01f, -2.41421118e-01f, -9.70420420e-01f, 9.72038329e-01f, -2.34822124e-01f,
  -9.66798186e-01f, -2.55541205e-01f, -3.34584385e-01f, 9.42365825e-01f, 4.75578904e-01f, 8.79673064e-01f, 8.22721004e-01f, 5.68445385e-01f,
  9.42754686e-01f, 3.33487093e-01f, 9.81777668e-01f, 1.90033287e-01f, 9.94225562e-01f, 1.07310407e-01f, 9.98172760e-01f, 6.04246669e-02f,
  9.99422073e-01f, 3.39934528e-02f, 9.99817252e-01f, 1.91184394e-02f, 9.99942183e-01f, 1.07515370e-02f, 9.99981701e-01f, 6.04611309e-03f,
  -9.03692186e-01f, -4.28182662e-01f, 6.73110247e-01f, 7.39542127e-01f, 7.23346695e-02f, -9.97380435e-01f, 9.98247743e-01f, -5.91726787e-02f,
  -9.36456680e-01f, -3.50783229e-01f, -3.87020677e-01f, 9.22071040e-01f, 4.47528064e-01f, 8.94269884e-01f, 8.12482953e-01f, 5.82984984e-01f,
  9.39372718e-01f, 3.42897803e-01f, 9.80693519e-01f, 1.95551202e-01f, 9.93881226e-01f, 1.10453881e-01f, 9.98063743e-01f, 6.21996038e-02f,
  9.99387562e-01f, 3.49928550e-02f, 9.99806345e-01f, 1.96806751e-02f, 9.99938726e-01f, 1.10677453e-02f, 9.99980628e-01f, 6.22393796e-03f,
  -1.27963692e-01f, -9.91778851e-01f, 1.75156534e-01f, 9.84540582e-01f, 3.78916174e-01f, -9.25431013e-01f, 9.92972851e-01f, 1.18342586e-01f,
  -8.96758378e-01f, -4.42520559e-01f, -4.38233554e-01f, 8.98861170e-01f, 4.19029742e-01f, 9.07972515e-01f, 8.01987886e-01f, 5.97340286e-01f,
  9.35896814e-01f, 3.52274209e-01f, 9.79578316e-01f, 2.01062918e-01f, 9.93526995e-01f, 1.13596253e-01f, 9.97951567e-01f, 6.39743358e-02f,
  9.99352098e-01f, 3.59922275e-02f, 9.99795079e-01f, 2.02429052e-02f, 9.99935210e-01f, 1.13839535e-02f, 9.99979496e-01f, 6.40176190e-03f,
  7.65414059e-01f, -6.43538117e-01f, -3.76742303e-01f, 9.26318109e-01f, 6.47921681e-01f, -7.61706948e-01f, 9.56380010e-01f, 2.92125374e-01f,
  -8.48100007e-01f, -5.29836178e-01f, -4.88060862e-01f, 8.72809589e-01f, 3.90112430e-01f, 9.20767248e-01f, 7.91239262e-01f, 6.11506701e-01f,
  9.32327330e-01f, 3.61615449e-01f, 9.78432178e-01f, 2.06568271e-01f, 9.93162811e-01f, 1.16737492e-01f, 9.97836173e-01f, 6.57488778e-02f,
  9.99315560e-01f, 3.69915590e-02f, 9.99783576e-01f, 2.08051261e-02f, 9.99931574e-01f, 1.17001599e-02f, 9.99978364e-01f, 6.57958630e-03f,
  9.55073655e-01f, 2.96368569e-01f, -8.12611222e-01f, 5.82806170e-01f, 8.52673113e-01f, -5.22444785e-01f, 8.89623463e-01f, 4.56694692e-01f,
  -7.90967762e-01f, -6.11857831e-01f, -5.36345184e-01f, 8.43998730e-01f, 3.60805035e-01f, 9.32641268e-01f, 7.80240417e-01f, 6.25479698e-01f,
  9.28664625e-01f, 3.70920479e-01f, 9.77255106e-01f, 2.12067112e-01f, 9.92788672e-01f, 1.19877554e-01f, 9.97717679e-01f, 6.75232038e-02f,
  9.99278069e-01f, 3.79908569e-02f, 9.99771714e-01f, 2.13673431e-02f, 9.99927819e-01f, 1.20163653e-02f, 9.99977171e-01f, 6.75741071e-03f,
  2.66642928e-01f, 9.63795364e-01f, -9.98210371e-01f, 5.98003156e-02f, 9.72865343e-01f, -2.31372014e-01f, 7.94808388e-01f, 6.06860459e-01f,
  -7.25932240e-01f, -6.87766254e-01f, -5.82933903e-01f, 8.12519610e-01f, 3.31136853e-01f, 9.43582714e-01f, 7.68994927e-01f, 6.39254928e-01f,
  9.24909055e-01f, 3.80188406e-01f, 9.76047099e-01f, 2.17559248e-01f, 9.92404640e-01f, 1.23016424e-01f, 9.97596025e-01f, 6.92973137e-02f,
  9.99239624e-01f, 3.89901139e-02f, 9.99759495e-01f, 2.19295528e-02f, 9.99923944e-01f, 1.23325698e-02f, 9.99975979e-01f, 6.93523418e-03f,
  -6.66938066e-01f, 7.45113134e-01f, -8.76379430e-01f, -4.81621295e-01f, 9.96578991e-01f, 8.26458037e-02f, 6.74925625e-01f, 7.37885714e-01f,
  -6.53643608e-01f, -7.56802499e-01f, -6.27679706e-01f, 7.78471708e-01f, 3.01137596e-01f, 9.53580678e-01f, 7.57506192e-01f, 6.52827978e-01f,
  9.21060979e-01f, 3.89418334e-01f, 9.74808276e-01f, 2.23044485e-01f, 9.92010653e-01f, 1.26154065e-01f, 9.97471273e-01f, 7.10712075e-02f,
  9.99200106e-01f, 3.99893373e-02f, 9.99747038e-01f, 2.24917568e-02f, 9.99920011e-01f, 1.26487734e-02f, 9.99974728e-01f, 7.11305765e-03f,
  -9.87339258e-01f, -1.58622667e-01f, -4.84639406e-01f, -8.74714017e-01f, 9.21462357e-01f, 3.88467699e-01f, 5.33756077e-01f, 8.45638454e-01f,
  -5.74824035e-01f, -8.18277061e-01f, -6.70441091e-01f, 7.41962790e-01f, 2.70837069e-01f, 9.62625206e-01f, 7.45777905e-01f, 6.66194677e-01f,
  9.17120814e-01f, 3.98609310e-01f, 9.73538578e-01f, 2.28522688e-01f, 9.91606772e-01f, 1.29290432e-01f, 9.97343302e-01f, 7.28448778e-02f,
  9.99159634e-01f, 4.09885161e-02f, 9.99734223e-01f, 2.30539497e-02f, 9.99915957e-01f, 1.29649751e-02f, 9.99973416e-01f, 7.29088066e-03f,
  -3.99985313e-01f, -9.16521549e-01f, 5.63609414e-02f, -9.98410463e-01f, 7.54965365e-01f, 6.55764699e-01f, 3.75752151e-01f, 9.26720202e-01f,
  -4.90260571e-01f, -8.71575892e-01f, -7.11082935e-01f, 7.03108132e-01f, 2.40265876e-01f, 9.70707119e-01f, 7.33813822e-01f, 6.79350674e-01f,
  9.13088918e-01f, 4.07760441e-01f, 9.72238123e-01f, 2.33993664e-01f, 9.91192937e-01f, 1.32425532e-01f, 9.97212172e-01f, 7.46183172e-02f,
  9.99118149e-01f, 4.19876575e-02f, 9.99721110e-01f, 2.36161388e-02f, 9.99911785e-01f, 1.32811759e-02f, 9.99972105e-01f, 7.46870413e-03f,
  5.55113316e-01f, -8.31774771e-01f, 5.80003142e-01f, -8.14614236e-01f, 5.13598442e-01f, 8.58030677e-01f, 2.05897167e-01f, 9.78573620e-01f,
  -4.00799006e-01f, -9.16166008e-01f, -7.49476731e-01f, 6.62030637e-01f, 2.09454417e-01f, 9.77818429e-01f, 7.21617639e-01f, 6.92291796e-01f,
  9.08965766e-01f, 4.16870773e-01f, 9.70906913e-01f, 2.39457220e-01f, 9.90769207e-01f, 1.35559291e-01f, 9.97077882e-01f, 7.63915181e-02f,
  9.99075651e-01f, 4.29867506e-02f, 9.99707639e-01f, 2.41783205e-02f, 9.99907553e-01f, 1.35973748e-02f, 9.99970794e-01f, 7.64652714e-03f,
  9.99843299e-01f, 1.77019257e-02f, 9.25014675e-01f, -3.79931390e-01f, 2.21298173e-01f, 9.75206196e-01f, 2.95478199e-02f, 9.99563396e-01f,
  -3.07332784e-01f, -9.51602101e-01f, -7.85501122e-01f, 6.18860185e-01f, 1.78433523e-01f, 9.83951986e-01f, 7.09193349e-01f, 7.05014050e-01f,
  9.04751658e-01f, 4.25939471e-01f, 9.69545007e-01f, 2.44913206e-01f, 9.90335584e-01f, 1.38691694e-01f, 9.96940494e-01f, 7.81644881e-02f,
  9.99032140e-01f, 4.39858064e-02f, 9.99693930e-01f, 2.47404929e-02f, 9.99903202e-01f, 1.39135728e-02f, 9.99969363e-01f, 7.82434922e-03f,
  5.25321960e-01f, 8.50903511e-01f, 9.85138178e-01f, 1.71763569e-01f, -9.29481089e-02f, 9.95670974e-01f, -1.47732988e-01f, 9.89027262e-01f,
  -2.10795805e-01f, -9.77530122e-01f, -8.19042206e-01f, 5.73733270e-01f, 1.47234216e-01f, 9.89101648e-01f, 6.96544766e-01f, 7.17513323e-01f,
  9.00447130e-01f, 4.34965521e-01f, 9.68152404e-01f, 2.50361472e-01f, 9.89892066e-01f, 1.41822711e-01f, 9.96799886e-01f, 7.99371973e-02f,
  9.98987675e-01f, 4.49848175e-02f, 9.99679863e-01f, 2.53026579e-02f, 9.99898732e-01f, 1.42297689e-02f, 9.99967992e-01f, 8.00217129e-03f,
  -4.32177931e-01f, 9.01788354e-01f, 7.41858006e-01f, 6.70557022e-01f, -3.97976756e-01f, 9.17395473e-01f, -3.20354372e-01f, 9.47297752e-01f,
  -1.12152621e-01f, -9.93690968e-01f, -8.49993885e-01f, 5.26792526e-01f, 1.15887694e-01f, 9.93262351e-01f, 6.83675885e-01f, 7.29785740e-01f,
  8.96052480e-01f, 4.43948090e-01f, 9.66729224e-01f, 2.55801797e-01f, 9.89438653e-01f, 1.44952312e-01f, 9.96656179e-01f, 8.17096606e-02f,
  9.98942196e-01f, 4.59837839e-02f, 9.99665439e-01f, 2.58648153e-02f, 9.99894202e-01f, 1.45459641e-02f, 9.99966562e-01f, 8.17999430e-03f,
  -9.92335498e-01f, 1.23573124e-01f, 2.70098448e-01f, 9.62832689e-01f, -6.63538277e-01f, 7.48142362e-01f, -4.82871950e-01f, 8.75690997e-01f,
  -1.23883775e-02f, -9.99923289e-01f, -8.78258407e-01f, 4.78186339e-01f, 8.44252855e-02f, 9.96429801e-01f, 6.70590878e-01f, 7.41827428e-01f,
  8.91568303e-01f, 4.52886283e-01f, 9.65275466e-01f, 2.61234075e-01f, 9.88975346e-01f, 1.48080453e-01f, 9.96509314e-01f, 8.34818557e-02f,
  9.98895705e-01f, 4.69827019e-02f, 9.99650776e-01f, 2.64269635e-02f, 9.99889553e-01f, 1.48621574e-02f, 9.99965072e-01f, 8.35781638e-03f,
  -6.40144348e-01f, -7.68254638e-01f, -2.84846604e-01f, 9.58573103e-01f, -8.63296509e-01f, 5.04697084e-01f, -6.30159974e-01f, 7.76465356e-01f,
  8.74991715e-02f, -9.96164620e-01f, -9.03746367e-01f, 4.28068399e-01f, 5.28784581e-02f, 9.98600960e-01f, 6.57293737e-01f, 7.53634512e-01f,
  8.86994898e-01f, 4.61779177e-01f, 9.63791192e-01f, 2.66658038e-01f, 9.88502085e-01f, 1.51207119e-01f, 9.96359289e-01f, 8.52537975e-02f,
  9.98848200e-01f, 4.79815714e-02f, 9.99635756e-01f, 2.69891042e-02f, 9.99884784e-01f, 1.51783489e-02f, 9.99963582e-01f, 8.53563752e-03f,
  3.00592542e-01f, -9.53752637e-01f, -7.52063990e-01f, 6.59090102e-01f, -9.77442741e-01f, 2.11200655e-01f, -7.57573068e-01f, 6.52750373e-01f,
  1.86512470e-01f, -9.82452571e-01f, -9.26377118e-01f, 3.76597136e-01f, 2.12787576e-02f, 9.99773562e-01f, 6.43788815e-01f, 7.65203178e-01f,
  8.82332861e-01f, 4.70625877e-01f, 9.62276459e-01f, 2.72073567e-01f, 9.88018990e-01f, 1.54332280e-01f, 9.96206105e-01f, 8.70254710e-02f,
  9.98799741e-01f, 4.89803962e-02f, 9.99620378e-01f, 2.75512375e-02f, 9.99879956e-01f, 1.54945394e-02f, 9.99962032e-01f, 8.71345960e-03f,
  9.64965999e-01f, -2.62374848e-01f, -9.87659097e-01f, 1.56619072e-01f, -9.94656444e-01f, -1.03240460e-01f, -8.61092687e-01f, 5.08447945e-01f,
  2.83662200e-01f, -9.58924294e-01f, -9.46079254e-01f, 3.23935270e-01f, -1.03422189e-02f, 9.99946535e-01f, 6.30080283e-01f, 7.76529968e-01f,
  8.77582550e-01f, 4.79425550e-01f, 9.60731268e-01f, 2.77480543e-01f, 9.87526000e-01f, 1.57455891e-01f, 9.96049762e-01f, 8.87968615e-02f,
  9.98750269e-01f, 4.99791689e-02f, 9.99604762e-01f, 2.81133596e-02f, 9.99875009e-01f, 1.58107281e-02f, 9.99960482e-01f, 8.89127981e-03f,
  7.42154181e-01f, 6.70229197e-01f, -9.19073522e-01f, -3.94086063e-01f, -9.13230121e-01f, -4.07444149e-01f, -9.37454224e-01f, 3.48108500e-01f,
  3.77977669e-01f, -9.25814748e-01f, -9.62790370e-01f, 2.70249337e-01f, -4.19528559e-02f, 9.99119580e-01f, 6.16172493e-01f, 7.87611187e-01f,
  8.72744501e-01f, 4.88177240e-01f, 9.59155679e-01f, 2.82878697e-01f, 9.87023175e-01f, 1.60577938e-01f, 9.95890260e-01f, 9.05679762e-02f,
  9.98699784e-01f, 5.09778969e-02f, 9.99588788e-01f, 2.86754742e-02f, 9.99869943e-01f, 1.61269177e-02f, 9.99958873e-01f, 9.06910095e-03f,
  -1.62990779e-01f, 9.86627579e-01f, -5.67430019e-01f, -8.23421597e-01f, -7.41239965e-01f, -6.71240151e-01f, -9.84248459e-01f, 1.76790684e-01f,
  4.68516916e-01f, -8.83454502e-01f, -9.76457715e-01f, 2.15709001e-01f, -7.35215396e-02f, 9.97293651e-01f, 6.02069914e-01f, 7.98443377e-01f,
  8.67819190e-01f, 4.96880114e-01f, 9.57549810e-01f, 2.88267940e-01f, 9.86510456e-01f, 1.63698375e-01f, 9.95727658e-01f, 9.23388004e-02f,
  9.98648286e-01f, 5.19765690e-02f, 9.99572515e-01f, 2.92375814e-02f, 9.99864817e-01f, 1.64431017e-02f, 9.99957263e-01f, 9.24692024e-03f,
  -9.18282807e-01f, 3.95925164e-01f, -4.10281904e-02f, -9.99157965e-01f, -4.95741814e-01f, -8.68469954e-01f, -1.00000000e+00f, -1.03020677e-04f,
  5.54374516e-01f, -8.32267344e-01f, -9.87038016e-01f, 1.60486728e-01f, -1.05016708e-01f, 9.94470477e-01f, 5.87776959e-01f, 8.09023023e-01f,
  8.62807095e-01f, 5.05533338e-01f, 9.55913603e-01f, 2.93648034e-01f, 9.85987842e-01f, 1.66817173e-01f, 9.95561838e-01f, 9.41093415e-02f,
  9.98595834e-01f, 5.29751927e-02f, 9.99555886e-01f, 2.97996756e-02f, 9.99859571e-01f, 1.67592876e-02f, 9.99955595e-01f, 9.42474138e-03f,
  -8.29309821e-01f, -5.58789074e-01f, 4.98009592e-01f, -8.67171526e-01f, -2.01079622e-01f, -9.79574919e-01f, -9.84212041e-01f, -1.76993474e-01f,
  6.34692967e-01f, -7.72764444e-01f, -9.94497895e-01f, 1.04756832e-01f, -1.36406869e-01f, 9.90652919e-01f, 5.73298037e-01f, 8.19346905e-01f,
  8.57708693e-01f, 5.14135957e-01f, 9.54247177e-01f, 2.99018890e-01f, 9.85455394e-01f, 1.69934288e-01f, 9.95392919e-01f, 9.58795771e-02f,
  9.98542368e-01f, 5.39737605e-02f, 9.99538958e-01f, 3.03617641e-02f, 9.99854207e-01f, 1.70754679e-02f, 9.99953866e-01f, 9.60256159e-03f,
  2.21267566e-02f, -9.99755144e-01f, 8.83669317e-01f, -4.68111664e-01f, 1.13521777e-01f, -9.93535519e-01f, -9.37382519e-01f, -3.48301649e-01f,
  7.08669782e-01f, -7.05540299e-01f, -9.98813629e-01f, 4.86960001e-02f, -1.67660639e-01f, 9.85844791e-01f, 5.58637917e-01f, 8.29411685e-01f,
  8.52524519e-01f, 5.22687256e-01f, 9.52550590e-01f, 3.04380238e-01f, 9.84913111e-01f, 1.73049718e-01f, 9.95220840e-01f, 9.76495072e-02f,
  9.98487890e-01f, 5.49722798e-02f, 9.99521732e-01f, 3.09238415e-02f, 9.99848783e-01f, 1.73916500e-02f, 9.99952197e-01f, 9.78038087e-03f,
  8.53220105e-01f, -5.21551013e-01f, 9.97174621e-01f, 7.51182064e-02f, 4.16867077e-01f, -9.08967435e-01f, -8.60988438e-01f, -5.08624554e-01f,
  7.75565803e-01f, -6.31266713e-01f, -9.99971747e-01f, -7.51878507e-03f, -1.98746875e-01f, 9.80050862e-01f, 5.43801069e-01f, 8.39214146e-01f,
  8.47255111e-01f, 5.31186223e-01f, 9.50823903e-01f, 3.09731960e-01f, 9.84360933e-01f, 1.76163420e-01f, 9.95045662e-01f, 9.94191393e-02f,
  9.98432398e-01f, 5.59707358e-02f, 9.99504209e-01f, 3.14859077e-02f, 9.99843180e-01f, 1.77078284e-02f, 9.99950409e-01f, 9.95820016e-03f,
  8.99866819e-01f, 4.36164767e-01f, 8.03569078e-01f, 5.95211506e-01f, 6.78870201e-01f, -7.34258294e-01f, -7.57439196e-01f, -6.52905703e-01f,
  8.34712923e-01f, -5.50685287e-01f, -9.97968495e-01f, -6.37097955e-02f, -2.29634270e-01f, 9.73276973e-01f, 5.28792322e-01f, 8.48751247e-01f,
  8.41901004e-01f, 5.39632022e-01f, 9.49067116e-01f, 3.15073937e-01f, 9.83798921e-01f, 1.79275364e-01f, 9.94867265e-01f, 1.01188451e-01f,
  9.98375952e-01f, 5.69691435e-02f, 9.99486327e-01f, 3.20479684e-02f, 9.99837577e-01f, 1.80240069e-02f, 9.99948621e-01f, 1.01360194e-02f,
  1.19180135e-01f, 9.92872655e-01f, 3.62476677e-01f, 9.31992829e-01f, 8.73550534e-01f, -4.86733496e-01f, -6.30000710e-01f, -7.76594579e-01f,
  8.85519624e-01f, -4.64602023e-01f, -9.92810190e-01f, -1.19699396e-01f, -2.60292053e-01f, 9.65529919e-01f, 5.13616323e-01f, 8.58020008e-01f,
  8.36462677e-01f, 5.48023939e-01f, 9.47280347e-01f, 3.20405900e-01f, 9.83227074e-01f, 1.82385504e-01f, 9.94685769e-01f, 1.02957435e-01f,
  9.98318493e-01f, 5.79674877e-02f, 9.99468148e-01f, 3.26100141e-02f, 9.99831796e-01f, 1.83401816e-02f, 9.99946833e-01f, 1.03138378e-02f,
  -7.71080196e-01f, 6.36738002e-01f, -1.90249100e-01f, 9.81735826e-01f, 9.81602073e-01f, -1.90938011e-01f, -4.82692331e-01f, -8.75790000e-01f,
  9.27478492e-01f, -3.73876572e-01f, -9.84513164e-01f, -1.75310582e-01f, -2.90689558e-01f, 9.56817448e-01f, 4.98277903e-01f, 8.67017388e-01f,
  8.30940723e-01f, 5.56361020e-01f, 9.45463598e-01f, 3.25727791e-01f, 9.82645452e-01f, 1.85493827e-01f, 9.94501114e-01f, 1.04726106e-01f,
  9.98260021e-01f, 5.89657798e-02f, 9.99449670e-01f, 3.31720486e-02f, 9.99825954e-01f, 1.86563563e-02f, 9.99944985e-01f, 1.04916561e-02f,
  -9.52412963e-01f, -3.04810613e-01f, -6.84381902e-01f, 7.29123712e-01f, 9.92308319e-01f, 1.23790950e-01f, -3.20159167e-01f, -9.47363734e-01f,
  9.60170269e-01f, -2.79415488e-01f, -9.73103702e-01f, -2.30367512e-01f, -3.20796400e-01f, 9.47148204e-01f, 4.82782036e-01f, 8.75740528e-01f,
  8.25335622e-01f, 5.64642429e-01f, 9.43616986e-01f, 3.31039310e-01f, 9.82053936e-01f, 1.88600287e-01f, 9.94313300e-01f, 1.06494442e-01f,
  9.98200536e-01f, 5.99640086e-02f, 9.99430835e-01f, 3.37340795e-02f, 9.99819994e-01f, 1.89725272e-02f, 9.99943078e-01f, 1.06694745e-02f,
  -2.58101642e-01f, -9.66117799e-01f, -9.67739642e-01f, 2.51952261e-01f, 9.04607594e-01f, 4.26245421e-01f, -1.47529200e-01f, -9.89057720e-01f,
  9.83268440e-01f, -1.82162598e-01f, -9.58617806e-01f, -2.84696162e-01f, -3.50582451e-01f, 9.36531842e-01f, 4.67133403e-01f, 8.84186864e-01f,
  8.19648027e-01f, 5.72867453e-01f, 9.41740453e-01f, 3.36340427e-01f, 9.81452644e-01f, 1.91704854e-01f, 9.94122326e-01f, 1.08262435e-01f,
  9.98140097e-01f, 6.09621815e-02f, 9.99411702e-01f, 3.42960916e-02f, 9.99813974e-01f, 1.92886982e-02f, 9.99941170e-01f, 1.08472919e-02f,
  6.73507154e-01f, -7.39180684e-01f, -9.53050017e-01f, -3.02812874e-01f, 7.27198064e-01f, 6.86427653e-01f, 2.97537707e-02f, -9.99557257e-01f,
  9.96542096e-01f, -8.30891207e-02f, -9.41101313e-01f, -3.38124752e-01f, -3.80017966e-01f, 9.24979091e-01f, 4.51337039e-01f, 8.92353535e-01f,
  8.13878477e-01f, 5.81035137e-01f, 9.39834237e-01f, 3.41630876e-01f, 9.80841517e-01f, 1.94807529e-01f, 9.93928254e-01f, 1.10030092e-01f,
  9.98078644e-01f, 6.19602874e-02f, 9.99392271e-01f, 3.48580964e-02f, 9.99807835e-01f, 1.96048655e-02f, 9.99939203e-01f, 1.10251084e-02f,
  9.85896587e-01f, 1.67355701e-01f, -6.44837022e-01f, -7.64320076e-01f, 4.77671444e-01f, 8.78538549e-01f, 2.06098333e-01f, -9.78531301e-01f,
  9.99858618e-01f, 1.68140903e-02f, -9.20609534e-01f, -3.90484393e-01f, -4.09073502e-01f, 9.12501454e-01f, 4.35397953e-01f, 9.00238097e-01f,
  8.08027506e-01f, 5.89144766e-01f, 9.37898219e-01f, 3.46910536e-01f, 9.80220556e-01f, 1.97908238e-01f, 9.93731022e-01f, 1.11797392e-01f,
  9.98016179e-01f, 6.29583374e-02f, 9.99372482e-01f, 3.54200937e-02f, 9.99801576e-01f, 1.99210308e-02f, 9.99937236e-01f, 1.12029258e-02f,
};

constexpr int T_ALL = 36864, T_CTX = 4096;
constexpr int NLAYER = 4;
constexpr float EPS = 1e-6f;
constexpr int LK_LAT = 4352;

struct Params {
  const float* x_prompt; const float* x_sample; const float* cache_ckv; const float* cache_krope;
  const float* cache_k; const float* cache_v; const float* state; const float* c; const float* c_ctx;
  const float* w_mod; const float* b_mod; const float* g_norm; const float* w_in; const float* conv_w; const float* conv_b;
  const float* lru_wa; const float* lru_ba; const float* lru_wi; const float* lru_bi; const float* lru_lam;
  const float* q_norm; const float* w_uq; const float* kv_norm; const float* w_ukv; const float* sink;
  const float* w_br_rnn; const float* w_br_mla; const float* w_br_swa; const float* w_out; const float* final_norm;
  float* out; char* ws;
};

constexpr size_t AL(size_t x) { return (x + 255) & ~(size_t)255; }
constexpr size_t O_WINA = 0;
constexpr size_t O_WINB = O_WINA + AL((size_t)2560 * 1024 * 2);
constexpr size_t O_WLRU = O_WINB + AL((size_t)5120 * 1024 * 2);
constexpr size_t O_WUQ = O_WLRU + AL((size_t)4096 * 128 * 2);
constexpr size_t O_WUKVG = O_WUQ + AL((size_t)768 * 384 * 2);
constexpr size_t O_WUKVR = O_WUKVG + AL((size_t)1024 * 256 * 2);
constexpr size_t O_WBRR = O_WUKVR + AL((size_t)1024 * 256 * 2);
constexpr size_t O_WBRM = O_WBRR + AL((size_t)1024 * 1024 * 2);
constexpr size_t O_WBRS = O_WBRM + AL((size_t)1024 * 512 * 2);
constexpr size_t O_WOUT = O_WBRS + AL((size_t)1024 * 512 * 2);
constexpr size_t O_MOD = O_WOUT + AL((size_t)1024 * 1024 * 2);
constexpr size_t O_H = O_MOD + AL((size_t)4 * 9 * 3072 * 4);
constexpr size_t O_XR = O_H + AL((size_t)T_ALL * 1024 * 2);
constexpr size_t O_CQ = O_XR + AL((size_t)T_ALL * 1024 * 2);
constexpr size_t O_CKV = O_CQ + AL((size_t)T_ALL * 384 * 2);
constexpr size_t O_CKVC = O_CKV + AL((size_t)T_ALL * 256 * 2);
constexpr size_t O_KRL = O_CKVC + AL((size_t)2048 * 256 * 2);
constexpr size_t O_KRC = O_KRL + AL((size_t)8 * LK_LAT * 32 * 2);
constexpr size_t O_QS = O_KRC + AL((size_t)16 * 256 * 32 * 2);
constexpr size_t O_KS = O_QS + AL((size_t)T_ALL * 512 * 2);
constexpr size_t O_KSC = O_KS + AL((size_t)T_ALL * 128 * 2);
constexpr size_t O_VTSL = O_KSC + AL((size_t)8 * 256 * 128 * 2);
constexpr size_t O_VTSC = O_VTSL + AL((size_t)8 * 2 * 64 * 4096 * 2);
constexpr size_t O_VTSCC = O_VTSC + AL((size_t)16 * 2 * 64 * 256 * 2);
constexpr size_t O_Q = O_VTSCC + AL((size_t)8 * 2 * 64 * 256 * 2);
constexpr size_t O_KNL = O_Q + AL((size_t)T_ALL * 768 * 2);
constexpr size_t O_KNC = O_KNL + AL((size_t)8 * 8 * LK_LAT * 64 * 2);
constexpr size_t O_VTL = O_KNC + AL((size_t)16 * 8 * 256 * 64 * 2);
constexpr size_t O_VTC = O_VTL + AL((size_t)8 * 8 * 64 * LK_LAT * 2);
constexpr size_t O_YRNN = O_VTC + AL((size_t)16 * 8 * 64 * 256 * 2);
constexpr size_t O_SUM = O_YRNN + AL((size_t)T_ALL * 1024 * 2);
constexpr size_t WS_NEED = O_SUM + AL((size_t)8 * 8 * 2 * 16 * 256 * 4);

constexpr size_t OUT_CKV = (size_t)T_ALL * 1024;
constexpr size_t OUT_KROPE = OUT_CKV + (size_t)16 * 4 * 256 * 256;
constexpr size_t OUT_SK = OUT_KROPE + (size_t)16 * 4 * 256 * 32;
constexpr size_t OUT_SV = OUT_SK + (size_t)16 * 4 * 256 * 128;
constexpr size_t OUT_RG = OUT_SV + (size_t)16 * 4 * 256 * 128;

#define SB() __builtin_amdgcn_sched_barrier(0)
#define MB() asm volatile("" ::: "memory")
DI int tid() { int t = threadIdx.x; asm volatile("" : "+v"(t)); return t; }
#define LANEVARS const int t = tid(), lane = t & 63, w = t >> 6, wr = w >> 1, wc = w & 1; const int c16 = lane & 15, g4 = lane >> 4; (void)wr; (void)wc; (void)c16; (void)g4;
DI float bf2f(u16 v) { return __uint_as_float(((unsigned)v) << 16); }
DI unsigned pack2(float a, float b) {
  f2_t v = {a, b};
  bf2_t r = __builtin_convertvector(v, bf2_t);
  return __builtin_bit_cast(unsigned, r);
}
DI u16 f2bf(float a) { return (u16)(pack2(a, 0.f) & 0xffffu); }
DI float sigmoidf_(float x) { return 1.f / (1.f + __expf(-x)); }
DI float wave_sum(float v) {
#pragma unroll
  for (int o = 32; o > 0; o >>= 1) v += __shfl_xor(v, o);
  return v;
}
DI int perm32(int p) { return (p & 7) | ((p & 8) << 1) | ((p & 16) >> 1); }
DI const float* xin_row(const Params& p, int l, int row) {
  if (l == 0) return row < T_CTX ? p.x_prompt + (size_t)row * 1024 : p.x_sample + (size_t)(row - T_CTX) * 1024;
  return p.out + (size_t)row * 1024;
}
template <class T> DI T* wsp(const Params& p, size_t off) { return (T*)(p.ws + off); }

template <int NJ>
DI void gemm_tile_t(const u16* A, int lda, const u16* B, int ldb, int K,
                    f32x4 (&acc)[4][NJ], char* smem) {
  const int t = tid(), lane = t & 63, w = t >> 6, wr = w >> 1, wc = w & 1;
  const int lr = t >> 3, lch = t & 7;
  const int c16 = lane & 15, g4 = lane >> 4;
  const u16* ap = A + (size_t)lr * lda + lch * 8;
  const u16* bp = B + (size_t)lr * ldb + lch * 8;
  const int soff = lr * 128 + ((lch ^ ((lr >> 1) & 7)) << 4);
  uint4 ra0, ra1, ra2, ra3, rb0, rb1, rb2, rb3;
#define GLOAD(ko) { ra0 = *(const uint4*)(ap + (ko)); ra1 = *(const uint4*)(ap + (size_t)32 * lda + (ko)); \
    ra2 = *(const uint4*)(ap + (size_t)64 * lda + (ko)); ra3 = *(const uint4*)(ap + (size_t)96 * lda + (ko)); \
    rb0 = *(const uint4*)(bp + (ko)); rb1 = *(const uint4*)(bp + (size_t)32 * ldb + (ko)); \
    if (NJ > 2) { rb2 = *(const uint4*)(bp + (size_t)64 * ldb + (ko)); rb3 = *(const uint4*)(bp + (size_t)96 * ldb + (ko)); } }
#define SSTORE(base) { *(uint4*)((base) + soff) = ra0; *(uint4*)((base) + soff + 4096) = ra1; *(uint4*)((base) + soff + 8192) = ra2; \
    *(uint4*)((base) + soff + 12288) = ra3; *(uint4*)((base) + 16384 + soff) = rb0; *(uint4*)((base) + 16384 + soff + 4096) = rb1; \
    if (NJ > 2) { *(uint4*)((base) + 16384 + soff + 8192) = rb2; *(uint4*)((base) + 16384 + soff + 12288) = rb3; } }
  GLOAD(0)
  SSTORE(smem)
  __syncthreads();
  const int nk = K >> 6;
  const int arow = (wr * 64 + c16) * 128, brow = (wc * (16 * NJ) + c16) * 128;
  const int sw = (c16 >> 1) & 7;
  for (int kt = 0; kt < nk; ++kt) {
    char* cur = smem + (kt & 1) * 32768;
    {
      const int ko = (kt + 1 < nk ? kt + 1 : kt) * 64;
      GLOAD(ko)
    }
    MB();
    SB();
#pragma unroll
    for (int ks = 0; ks < 2; ++ks) {
      bf16x8 af[4], bfr[NJ];
      const int ch = ((ks * 4 + g4) ^ sw) << 4;
#pragma unroll
      for (int i = 0; i < 4; ++i) af[i] = *(const bf16x8*)(cur + arow + i * 2048 + ch);
#pragma unroll
      for (int i = 0; i < NJ; ++i) bfr[i] = *(const bf16x8*)(cur + 16384 + brow + i * 2048 + ch);
#pragma unroll
      for (int i = 0; i < 4; ++i)
#pragma unroll
        for (int j = 0; j < NJ; ++j)
          acc[i][j] = __builtin_amdgcn_mfma_f32_16x16x32_bf16(af[i], bfr[j], acc[i][j], 0, 0, 0);
    }
    SB();
    {
      char* nxt = smem + ((kt + 1) & 1) * 32768;
      SSTORE(nxt)
    }
    __syncthreads();
  }
#undef GLOAD
#undef SSTORE
}
DI void gemm_tile(const u16* A, int lda, const u16* B, int ldb, int K,
                  f32x4 (&acc)[4][4], char* smem) {
  gemm_tile_t<4>(A, lda, B, ldb, K, acc, smem);
}
DI void zero_acc(f32x4 (&acc)[4][4]) {
#pragma unroll
  for (int i = 0; i < 4; ++i)
#pragma unroll
    for (int j = 0; j < 4; ++j) acc[i][j] = f32x4{0.f, 0.f, 0.f, 0.f};
}

struct TokTile { int g0; int is_ctx; int b; int p0; };
DI TokTile tok_tile(int mt) {
  TokTile r; r.g0 = mt * 128;
  if (r.g0 < T_CTX) { r.is_ctx = 1; r.b = r.g0 >> 8; r.p0 = r.g0 & 255; }
  else { r.is_ctx = 0; r.b = (r.g0 - T_CTX) >> 12; r.p0 = (r.g0 - T_CTX) & 4095; }
  return r;
}

DI void phase_mod(const Params& p, char* smem) {
  float* s_silu = (float*)smem;
  float* s_part = (float*)(smem + 36864);
  float* MOD = wsp<float>(p, O_MOD);
  const int t = tid();
  for (int i = t; i < 9 * 1024; i += 256) {
    float v = (i < 8192) ? p.c[i] : p.c_ctx[i - 8192];
    s_silu[i] = v * sigmoidf_(v);
  }
  __syncthreads();
  const int kg = t >> 6, cl = t & 63;
  for (int u = blockIdx.x; u < 4 * 48; u += gridDim.x) {
    const int l = u / 48, cb = u % 48;
    const int n = cb * 64 + cl;
    float acc[9];
#pragma unroll
    for (int ci = 0; ci < 9; ++ci) acc[ci] = 0.f;
    const float* wp = p.w_mod + ((size_t)l * 1024 + kg * 256) * 3072 + n;
    for (int k = 0; k < 256; ++k) {
      float wv = wp[(size_t)k * 3072];
#pragma unroll
      for (int ci = 0; ci < 9; ++ci) acc[ci] += s_silu[ci * 1024 + kg * 256 + k] * wv;
    }
#pragma unroll
    for (int ci = 0; ci < 9; ++ci) s_part[(kg * 9 + ci) * 64 + cl] = acc[ci];
    __syncthreads();
    for (int idx = t; idx < 9 * 64; idx += 256) {
      int ci = idx >> 6, c2 = idx & 63;
      float s = s_part[(0 * 9 + ci) * 64 + c2] + s_part[(1 * 9 + ci) * 64 + c2] + s_part[(2 * 9 + ci) * 64 + c2] +
                s_part[(3 * 9 + ci) * 64 + c2];
      MOD[((size_t)l * 9 + ci) * 3072 + cb * 64 + c2] = s + p.b_mod[l * 3072 + cb * 64 + c2];
    }
    __syncthreads();
  }
}

template <class F> DI void conv_job(u16* dst, int N, int K, F src) {
  const int total = N * (K >> 3);
  for (int idx = blockIdx.x * 256 + tid(); idx < total; idx += gridDim.x * 256) {
    const int n = idx % N, kb = idx / N;
    float v[8];
#pragma unroll
    for (int j = 0; j < 8; ++j) v[j] = src(kb * 8 + j, n);
    uint4 o;
    o.x = pack2(v[0], v[1]); o.y = pack2(v[2], v[3]); o.z = pack2(v[4], v[5]); o.w = pack2(v[6], v[7]);
    *(uint4*)(dst + (size_t)n * K + kb * 8) = o;
  }
}

DI void phase_prep(const Params& p, int l) {
  const int t = tid(), lane = t & 63, w = t >> 6;
  const float* MOD = wsp<float>(p, O_MOD) + (size_t)l * 9 * 3072;
  u16* H = wsp<u16>(p, O_H);
  for (int row = blockIdx.x * 4 + w; row < T_ALL; row += gridDim.x * 4) {
    const float* x = xin_row(p, l, row);
    const int ci = row < T_CTX ? 8 : ((row - T_CTX) >> 12);
    const float* md = MOD + ci * 3072;
    float4 v[4];
    float ss = 0.f;
#pragma unroll
    for (int i = 0; i < 4; ++i) {
      v[i] = *(const float4*)(x + i * 256 + lane * 4);
      ss += v[i].x * v[i].x + v[i].y * v[i].y + v[i].z * v[i].z + v[i].w * v[i].w;
    }
    ss = wave_sum(ss);
    const float rs = rsqrtf(ss * (1.f / 1024.f) + EPS);
#pragma unroll
    for (int i = 0; i < 4; ++i) {
      const int c = i * 256 + lane * 4;
      const float4 g = *(const float4*)(p.g_norm + l * 1024 + c);
      const float4 sh = *(const float4*)(md + c);
      const float4 sc = *(const float4*)(md + 1024 + c);
      float h0 = v[i].x * rs * g.x * (1.f + sc.x) + sh.x;
      float h1 = v[i].y * rs * g.y * (1.f + sc.y) + sh.y;
      float h2 = v[i].z * rs * g.z * (1.f + sc.z) + sh.z;
      float h3 = v[i].w * rs * g.w * (1.f + sc.w) + sh.w;
      uint2 o; o.x = pack2(h0, h1); o.y = pack2(h2, h3);
      *(uint2*)(H + (size_t)row * 1024 + c) = o;
    }
  }
  {
    const float* win = p.w_in + (size_t)l * 1024 * 7584;
    conv_job(wsp<u16>(p, O_WINA), 2560, 1024, [&](int k, int n) -> float {
      int col;
      if (n < 1024) col = n;
      else if (n < 1408) col = 2048 + (n - 1024);
      else if (n < 1664) col = 2432 + (n - 1408);
      else if (n < 1792) { int pp = n - 1664; col = pp < 32 ? 2688 + perm32(pp) : -1; }
      else if (n < 2304) col = 3232 + (n - 1792);
      else if (n < 2432) col = 3744 + (n - 2304);
      else col = 3872 + (n - 2432);
      return col < 0 ? 0.f : win[(size_t)k * 7584 + col];
    });
    conv_job(wsp<u16>(p, O_WINB), 5120, 1024, [&](int k, int n) -> float {
      int col;
      if (n < 1024) col = 1024 + n;
      else if (n < 1536) col = 2720 + (n - 1024);
      else if (n < 2048) col = 4000 + (n - 1536);
      else col = 4512 + (n - 2048);
      return win[(size_t)k * 7584 + col];
    });
    const float* wa = p.lru_wa + (size_t)l * 2 * 8 * 128 * 128;
    const float* wi = p.lru_wi + (size_t)l * 2 * 8 * 128 * 128;
    conv_job(wsp<u16>(p, O_WLRU), 4096, 128, [&](int k, int n) -> float {
      int db = n >> 8, nn = n & 255;
      return nn < 128 ? wa[((size_t)db * 128 + k) * 128 + nn] : wi[((size_t)db * 128 + k) * 128 + (nn - 128)];
    });
    const float* wuq = p.w_uq + (size_t)l * 384 * 768;
    const float* gq = p.q_norm + l * 384;
    conv_job(wsp<u16>(p, O_WUQ), 768, 384, [&](int k, int n) -> float {
      int col;
      if (n < 512) col = (n >> 6) * 96 + (n & 63);
      else { int hh = (n - 512) >> 5, pp = (n - 512) & 31; col = hh * 96 + 64 + perm32(pp); }
      return gq[k] * wuq[(size_t)k * 768 + col];
    });
    const float* wukv = p.w_ukv + (size_t)l * 256 * 1024;
    const float* gkv = p.kv_norm + l * 256;
    conv_job(wsp<u16>(p, O_WUKVG), 1024, 256, [&](int k, int n) -> float { return gkv[k] * wukv[(size_t)k * 1024 + n]; });
    conv_job(wsp<u16>(p, O_WUKVR), 1024, 256, [&](int k, int n) -> float { return wukv[(size_t)k * 1024 + n]; });
    const float* w1 = p.w_br_rnn + (size_t)l * 1024 * 1024;
    conv_job(wsp<u16>(p, O_WBRR), 1024, 1024, [&](int k, int n) -> float { return w1[(size_t)k * 1024 + n]; });
    const float* w2 = p.w_br_mla + (size_t)l * 512 * 1024;
    conv_job(wsp<u16>(p, O_WBRM), 1024, 512, [&](int k, int n) -> float { return w2[(size_t)k * 1024 + n]; });
    const float* w3 = p.w_br_swa + (size_t)l * 512 * 1024;
    conv_job(wsp<u16>(p, O_WBRS), 1024, 512, [&](int k, int n) -> float { return w3[(size_t)k * 1024 + n]; });
    const float* w4 = p.w_out + (size_t)l * 1024 * 1024;
    conv_job(wsp<u16>(p, O_WOUT), 1024, 1024, [&](int k, int n) -> float { return w4[(size_t)k * 1024 + n]; });
  }
  {
    const int gt = blockIdx.x * 256 + t, gs = gridDim.x * 256;
    u16* ckvc = wsp<u16>(p, O_CKVC);
    for (int i = gt; i < 2048 * 256; i += gs) {
      int r = i >> 8, k = i & 255, b = r >> 8, pos = r & 255;
      ckvc[i] = f2bf(p.cache_ckv[(((size_t)b * 4 + l) * 256 + pos) * 256 + k]);
    }
    u16* krl = wsp<u16>(p, O_KRL);
    for (int i = gt; i < 8 * 256 * 32; i += gs) {
      int pp = i & 31, pos = (i >> 5) & 255, b = i >> 13;
      krl[((size_t)b * LK_LAT + pos) * 32 + pp] = f2bf(p.cache_krope[(((size_t)b * 4 + l) * 256 + pos) * 32 + perm32(pp)]);
    }
    u16* ksc = wsp<u16>(p, O_KSC);
    for (int i = gt; i < 8 * 256 * 128; i += gs) {
      int c = i & 127, pos = (i >> 7) & 255, b = i >> 15;
      ksc[i] = f2bf(p.cache_k[(((size_t)b * 4 + l) * 256 + pos) * 128 + c]);
    }
    u16* vtc = wsp<u16>(p, O_VTSCC);
    for (int i = gt; i < 8 * 2 * 64 * 256; i += gs) {
      int pos = i & 255, dv = (i >> 8) & 63, kvh = (i >> 14) & 1, b = i >> 15;
      vtc[i] = f2bf(p.cache_v[(((size_t)b * 4 + l) * 256 + pos) * 128 + kvh * 64 + dv]);
    }
  }
}

DI void phase_gemmA(const Params& p, int l, char* smem) {
  const u16* H = wsp<u16>(p, O_H);
  const u16* W = wsp<u16>(p, O_WINA);
  for (int tile = blockIdx.x; tile < 288 * 20; tile += gridDim.x) {
    const int mt = tile / 20, nt = tile % 20;
    const TokTile tt = tok_tile(mt);
    f32x4 acc[4][4];
    zero_acc(acc);
    gemm_tile(H + (size_t)tt.g0 * 1024, 1024, W + (size_t)nt * 128 * 1024, 1024, 1024, acc, smem);
    LANEVARS
    if (nt < 13) {
      u16* dst; int ld, cb;
      if (nt < 8) { dst = wsp<u16>(p, O_XR); ld = 1024; cb = nt * 128; }
      else if (nt < 11) { dst = wsp<u16>(p, O_CQ); ld = 384; cb = (nt - 8) * 128; }
      else { dst = wsp<u16>(p, O_CKV); ld = 256; cb = (nt - 11) * 128; }
#pragma unroll
      for (int i = 0; i < 4; ++i)
#pragma unroll
        for (int j = 0; j < 4; ++j)
#pragma unroll
          for (int e = 0; e < 4; ++e) {
            const int g = tt.g0 + wr * 64 + i * 16 + g4 * 4 + e;
            dst[(size_t)g * ld + cb + wc * 64 + j * 16 + c16] = f2bf(acc[i][j][e]);
            if (e == 3 && j == 3) SB();
          }
    } else if (nt == 13) {
      if (wc == 0) {
#pragma unroll
        for (int i = 0; i < 4; ++i)
#pragma unroll
          for (int e = 0; e < 4; ++e) {
            SB();
            const int r = wr * 64 + i * 16 + g4 * 4 + e;
            const int pos = tt.p0 + r;
            float x1 = acc[i][0][e], x2 = acc[i][1][e];
            if (tt.is_ctx) {
              u16* kr = wsp<u16>(p, O_KRC) + ((size_t)tt.b * 256 + pos) * 32;
              kr[c16] = f2bf(x1); kr[c16 + 16] = f2bf(x2);
              float* o = p.out + OUT_KROPE + (((size_t)tt.b * 4 + l) * 256 + pos) * 32;
              o[perm32(c16)] = x1; o[perm32(c16 + 16)] = x2;
            } else {
              const int pv = (c16 >= 8) ? (pos & 63) : (pos >> 6);
              const float cs = TAB_M[(pv * 8 + (c16 & 7)) * 2], sn = TAB_M[(pv * 8 + (c16 & 7)) * 2 + 1];
              u16* kr = wsp<u16>(p, O_KRL) + ((size_t)tt.b * LK_LAT + 256 + pos) * 32;
              kr[c16] = f2bf(x1 * cs - x2 * sn); kr[c16 + 16] = f2bf(x2 * cs + x1 * sn);
            }
          }
      }
    } else if (nt < 19) {
      const bool isk = (nt == 18);
      u16* dst = isk ? wsp<u16>(p, O_KS) : wsp<u16>(p, O_QS);
      const int ld = isk ? 128 : 512;
      const int cb = isk ? wc * 64 : ((nt - 14) * 2 + wc) * 64;
#pragma unroll
      for (int i = 0; i < 4; ++i)
#pragma unroll
        for (int e = 0; e < 4; ++e) {
          SB();
          const int r = wr * 64 + i * 16 + g4 * 4 + e;
          const int pos = tt.p0 + r, g = tt.g0 + r;
          float v0 = acc[i][0][e], v1 = acc[i][1][e], v2 = acc[i][2][e], v3 = acc[i][3][e];
          if (!tt.is_ctx) {
            const int pr = pos >> 6, pc = pos & 63;
            const float c0 = TAB_S[(pr * 16 + c16) * 2], s0 = TAB_S[(pr * 16 + c16) * 2 + 1];
            const float c1 = TAB_S[(pc * 16 + c16) * 2], s1 = TAB_S[(pc * 16 + c16) * 2 + 1];
            float a0 = v0 * c0 - v1 * s0, a1 = v1 * c0 + v0 * s0;
            float a2 = v2 * c1 - v3 * s1, a3 = v3 * c1 + v2 * s1;
            v0 = a0; v1 = a1; v2 = a2; v3 = a3;
          } else if (isk) {
            float* o = p.out + OUT_SK + (((size_t)tt.b * 4 + l) * 256 + pos) * 128 + cb + c16;
            o[0] = v0; o[16] = v1; o[32] = v2; o[48] = v3;
          }
          u16* d = dst + (size_t)g * ld + cb + c16;
          d[0] = f2bf(v0); d[16] = f2bf(v1); d[32] = f2bf(v2); d[48] = f2bf(v3);
        }
    } else {
      u16* vt = tt.is_ctx ? wsp<u16>(p, O_VTSC) : wsp<u16>(p, O_VTSL);
      const int L = tt.is_ctx ? 256 : 4096;
#pragma unroll
      for (int i = 0; i < 4; ++i)
#pragma unroll
        for (int j = 0; j < 4; ++j) {
          SB();
          const int r = wr * 64 + i * 16 + g4 * 4;
          const int pos = tt.p0 + r, dv = j * 16 + c16;
          uint2 o; o.x = pack2(acc[i][j][0], acc[i][j][1]); o.y = pack2(acc[i][j][2], acc[i][j][3]);
          *(uint2*)(vt + (((size_t)tt.b * 2 + wc) * 64 + dv) * L + pos) = o;
          if (tt.is_ctx) {
#pragma unroll
            for (int e = 0; e < 4; ++e)
              p.out[OUT_SV + (((size_t)tt.b * 4 + l) * 256 + pos + e) * 128 + wc * 64 + dv] = acc[i][j][e];
          }
        }
    }
  }
}

DI void row_scales(const u16* A, int K, float* s_rs) {
  const int t = tid(), row = t >> 1, half = t & 1;
  const u16* ap = A + (size_t)row * K + half * (K >> 1);
  float ss = 0.f;
  for (int c = 0; c < (K >> 4); ++c) {
    uint4 v = *(const uint4*)(ap + c * 8);
    unsigned wv[4] = {v.x, v.y, v.z, v.w};
#pragma unroll
    for (int q = 0; q < 4; ++q) {
      float a = __uint_as_float(wv[q] << 16), b = __uint_as_float(wv[q] & 0xffff0000u);
      ss += a * a + b * b;
    }
  }
  ss += __shfl_xor(ss, 1);
  if (half == 0) s_rs[row] = rsqrtf(ss / (float)K + EPS);
}

template <int MODE> DI void scan_seg(const Params& p, int l, int seq, int blk, int d, int seg, char* smem);
DI void phase_qkv(const Params& p, int l, char* smem) {
  float* s_rs = (float*)(smem + 65536);
  constexpr int NQ = 288 * 6, NKV = 304 * 8, NS1 = 2048;
  for (int tile0 = blockIdx.x; tile0 < NS1 + NQ + NKV; tile0 += gridDim.x) {
    if (tile0 < NS1) {
      scan_seg<0>(p, l, 16 + (tile0 >> 8), (tile0 >> 5) & 7, (tile0 >> 4) & 1, tile0 & 15, smem);
      continue;
    }
    const int tile = tile0 - NS1;
    f32x4 acc[4][4];
    zero_acc(acc);
    if (tile < NQ) {
      const int mt = tile / 6, nt = tile % 6;
      const TokTile tt = tok_tile(mt);
      const u16* A = wsp<u16>(p, O_CQ) + (size_t)tt.g0 * 384;
      row_scales(A, 384, s_rs);
      gemm_tile(A, 384, wsp<u16>(p, O_WUQ) + (size_t)nt * 128 * 384, 384, 384, acc, smem);
      LANEVARS
      u16* Q = wsp<u16>(p, O_Q);
#pragma unroll
      for (int i = 0; i < 4; ++i)
#pragma unroll
        for (int e = 0; e < 4; ++e) {
          SB();
          const int r = wr * 64 + i * 16 + g4 * 4 + e;
          const int pos = tt.p0 + r, g = tt.g0 + r;
          const float rs = s_rs[r];
          float v0 = acc[i][0][e] * rs, v1 = acc[i][1][e] * rs, v2 = acc[i][2][e] * rs, v3 = acc[i][3][e] * rs;
          if (nt >= 4 && !tt.is_ctx) {
            const int pv = (c16 >= 8) ? (pos & 63) : (pos >> 6);
            const float cs = TAB_M[(pv * 8 + (c16 & 7)) * 2], sn = TAB_M[(pv * 8 + (c16 & 7)) * 2 + 1];
            float a0 = v0 * cs - v1 * sn, a1 = v1 * cs + v0 * sn;
            float a2 = v2 * cs - v3 * sn, a3 = v3 * cs + v2 * sn;
            v0 = a0; v1 = a1; v2 = a2; v3 = a3;
          }
          u16* d = Q + (size_t)g * 768 + nt * 128 + wc * 64 + c16;
          d[0] = f2bf(v0); d[16] = f2bf(v1); d[32] = f2bf(v2); d[48] = f2bf(v3);
        }
    } else {
      const int t2 = tile - NQ;
      const int mt = t2 >> 3, hd = t2 & 7;
      const u16* A; const u16* Wt; int is_ctx, seq, kp0;
      if (mt < 288) {
        const TokTile tt = tok_tile(mt);
        A = wsp<u16>(p, O_CKV) + (size_t)tt.g0 * 256;
        Wt = wsp<u16>(p, O_WUKVG);
        row_scales(A, 256, s_rs);
        is_ctx = tt.is_ctx; seq = tt.b; kp0 = tt.is_ctx ? tt.p0 : 256 + tt.p0;
        if (tt.is_ctx && hd == 0) {
          __syncthreads();
          const float* gkv = p.kv_norm + l * 256;
          for (int idx = tid(); idx < 128 * 256; idx += 256) {
            const int r = idx >> 8, k = idx & 255;
            p.out[OUT_CKV + (((size_t)tt.b * 4 + l) * 256 + tt.p0 + r) * 256 + k] = bf2f(A[(size_t)r * 256 + k]) * s_rs[r] * gkv[k];
          }
        }
      } else {
        const int row0 = (mt - 288) * 128;
        A = wsp<u16>(p, O_CKVC) + (size_t)row0 * 256;
        Wt = wsp<u16>(p, O_WUKVR);
        { const int t1 = tid(); if (t1 < 128) s_rs[t1] = 1.f; }
        is_ctx = 0; seq = row0 >> 8; kp0 = row0 & 255;
      }
      gemm_tile(A, 256, Wt + (size_t)hd * 128 * 256, 256, 256, acc, smem);
      LANEVARS
      const int Lk = is_ctx ? 256 : LK_LAT;
      if (wc == 0) {
        u16* Kn = (is_ctx ? wsp<u16>(p, O_KNC) : wsp<u16>(p, O_KNL)) + ((size_t)seq * 8 + hd) * Lk * 64;
#pragma unroll
        for (int i = 0; i < 4; ++i)
#pragma unroll
          for (int j = 0; j < 4; ++j)
#pragma unroll
            for (int e = 0; e < 4; ++e) {
              const int r = wr * 64 + i * 16 + g4 * 4 + e;
              Kn[(size_t)(kp0 + r) * 64 + j * 16 + c16] = f2bf(acc[i][j][e] * s_rs[r]);
              if (e == 3) SB();
            }
      } else {
        u16* Vt = (is_ctx ? wsp<u16>(p, O_VTC) : wsp<u16>(p, O_VTL)) + ((size_t)seq * 8 + hd) * 64 * Lk;
#pragma unroll
        for (int i = 0; i < 4; ++i)
#pragma unroll
          for (int j = 0; j < 4; ++j) {
            SB();
            const int r = wr * 64 + i * 16 + g4 * 4;
            uint2 o;
            o.x = pack2(acc[i][j][0] * s_rs[r], acc[i][j][1] * s_rs[r + 1]);
            o.y = pack2(acc[i][j][2] * s_rs[r + 2], acc[i][j][3] * s_rs[r + 3]);
            *(uint2*)(Vt + (size_t)(j * 16 + c16) * Lk + kp0 + r) = o;
          }
      }
    }
    __syncthreads();
  }
}

template <int NS> DI void attn_gload(const u16* k0, int k0s, const u16* k1, const u16* vt, int vts,
                                     uint4& rk0, uint4& rk1, uint4& rk2, uint4& rv0, uint4& rv1) {
  const int t = tid();
  if (NS == 6) {
    { const int c = t, key = c / 12, ch = c % 12;
      rk0 = (ch < 8) ? *(const uint4*)(k0 + (size_t)key * k0s + ch * 8) : *(const uint4*)(k1 + (size_t)key * 32 + (ch - 8) * 8); }
    { const int c = t + 256, key = c / 12, ch = c % 12;
      rk1 = (ch < 8) ? *(const uint4*)(k0 + (size_t)key * k0s + ch * 8) : *(const uint4*)(k1 + (size_t)key * 32 + (ch - 8) * 8); }
    { const int c = t + 512, key = c / 12, ch = c % 12;
      rk2 = (ch < 8) ? *(const uint4*)(k0 + (size_t)key * k0s + ch * 8) : *(const uint4*)(k1 + (size_t)key * 32 + (ch - 8) * 8); }
  } else {
    { const int c = t, key = c >> 3, ch = c & 7; rk0 = *(const uint4*)(k0 + (size_t)key * k0s + ch * 8); }
    { const int c = t + 256, key = c >> 3, ch = c & 7; rk1 = *(const uint4*)(k0 + (size_t)key * k0s + ch * 8); }
  }
  { const int c = t, dv = c >> 3, ch = c & 7; rv0 = *(const uint4*)(vt + (size_t)dv * vts + ch * 8); }
  { const int c = t + 256, dv = c >> 3, ch = c & 7; rv1 = *(const uint4*)(vt + (size_t)dv * vts + ch * 8); }
}
template <int NS> DI void attn_sstore(char* smem, const uint4& rk0, const uint4& rk1, const uint4& rk2, const uint4& rv0, const uint4& rv1) {
  constexpr int KSTR = (NS == 6) ? 208 : 144;
  const int t = tid();
  if (NS == 6) {
    { const int c = t, key = c / 12, ch = c % 12; *(uint4*)(smem + key * KSTR + ch * 16) = rk0; }
    { const int c = t + 256, key = c / 12, ch = c % 12; *(uint4*)(smem + key * KSTR + ch * 16) = rk1; }
    { const int c = t + 512, key = c / 12, ch = c % 12; *(uint4*)(smem + key * KSTR + ch * 16) = rk2; }
  } else {
    { const int c = t, key = c >> 3, ch = c & 7; *(uint4*)(smem + key * KSTR + ch * 16) = rk0; }
    { const int c = t + 256, key = c >> 3, ch = c & 7; *(uint4*)(smem + key * KSTR + ch * 16) = rk1; }
  }
  { const int c = t, dv = c >> 3, ch = c & 7; char* d = smem + 13312 + dv * 136 + ch * 16;
    *(uint2*)d = uint2{rv0.x, rv0.y}; *(uint2*)(d + 8) = uint2{rv0.z, rv0.w}; }
  { const int c = t + 256, dv = c >> 3, ch = c & 7; char* d = smem + 13312 + dv * 136 + ch * 16;
    *(uint2*)d = uint2{rv1.x, rv1.y}; *(uint2*)(d + 8) = uint2{rv1.z, rv1.w}; }
}

#define PACK8(S, s2) __builtin_bit_cast(bf16x8, uint4{pack2(S[8 * (s2)], S[8 * (s2) + 1]), pack2(S[8 * (s2) + 2], S[8 * (s2) + 3]), \
                                                        pack2(S[8 * (s2) + 4], S[8 * (s2) + 5]), pack2(S[8 * (s2) + 6], S[8 * (s2) + 7])})

template <int NS>
DI void attn_item(const u16* kA, int kAs, const u16* krA, const u16* vtA, int vtAs, int nA, int kposA, int maskA,
                  const u16* kB, int kBs, const u16* vtB, int vtBs, int nB,
                  const u16* qa, const u16* qb, float sc2, float m0, float l0, int qpos, u16* yrow, char* smem) {
  constexpr int KSTR = (NS == 6) ? 208 : 144;
  const int lane = tid() & 63;
  const int r32 = lane & 31, hh = lane >> 5;
  bf16x8 qf0, qf1, qf2, qf3, qf4, qf5;
  qf0 = *(const bf16x8*)(qa + 0 + 8 * hh); qf1 = *(const bf16x8*)(qa + 16 + 8 * hh);
  qf2 = *(const bf16x8*)(qa + 32 + 8 * hh); qf3 = *(const bf16x8*)(qa + 48 + 8 * hh);
  if (NS == 6) { qf4 = *(const bf16x8*)(qb + 0 + 8 * hh); qf5 = *(const bf16x8*)(qb + 16 + 8 * hh); }
  else { qf4 = qf0; qf5 = qf0; }
  f32x16 O0, O1;
#pragma unroll
  for (int e = 0; e < 16; ++e) { O0[e] = 0.f; O1[e] = 0.f; }
  float m_run = m0, l_run = l0;
  uint4 rk0, rk1, rk2, rv0, rv1;
  rk2 = uint4{0, 0, 0, 0};
  const int ntiles = nA + nB;
  if (nA > 0) attn_gload<NS>(kA, kAs, krA, vtA, vtAs, rk0, rk1, rk2, rv0, rv1);
  else attn_gload<NS>(kB, kBs, nullptr, vtB, vtBs, rk0, rk1, rk2, rv0, rv1);
  for (int j = 0; j < ntiles; ++j) {
    __syncthreads();
    attn_sstore<NS>(smem, rk0, rk1, rk2, rv0, rv1);
    __syncthreads();
    const int kpos = kposA + 64 * j;
    const bool masked = maskA && (j < nA);
    if (j + 1 < ntiles) {
      const int jn = j + 1;
      if (jn < nA) attn_gload<NS>(kA + (size_t)jn * 64 * kAs, kAs, krA + (size_t)jn * 64 * 32, vtA + jn * 64, vtAs, rk0, rk1, rk2, rv0, rv1);
      else { const int jb = jn - nA; attn_gload<NS>(kB + (size_t)jb * 64 * kBs, kBs, nullptr, vtB + jb * 64, vtBs, rk0, rk1, rk2, rv0, rv1); }
    }
    MB();
    f32x16 S0, S1;
#pragma unroll
    for (int e = 0; e < 16; ++e) { S0[e] = 0.f; S1[e] = 0.f; }
    const char* ka0 = smem + r32 * KSTR + 16 * hh;
    const char* ka1 = smem + (32 + r32) * KSTR + 16 * hh;
#define QK_STEP(s, qf) { bf16x8 a0 = *(const bf16x8*)(ka0 + 32 * (s)); bf16x8 a1 = *(const bf16x8*)(ka1 + 32 * (s)); \
      S0 = __builtin_amdgcn_mfma_f32_32x32x16_bf16(a0, qf, S0, 0, 0, 0); S1 = __builtin_amdgcn_mfma_f32_32x32x16_bf16(a1, qf, S1, 0, 0, 0); }
    QK_STEP(0, qf0) QK_STEP(1, qf1) QK_STEP(2, qf2) QK_STEP(3, qf3)
    if (NS == 6) { QK_STEP(4, qf4) QK_STEP(5, qf5) }
    SB();
    float mx = m_run;
#pragma unroll
    for (int e = 0; e < 16; ++e) {
      float v0 = S0[e] * sc2, v1 = S1[e] * sc2;
      if (masked) {
        const int kp = kpos + (e & 3) + 8 * (e >> 2) + 4 * hh;
        int d0 = qpos - kp; d0 = d0 < 0 ? -d0 : d0;
        int d1 = qpos - (kp + 32); d1 = d1 < 0 ? -d1 : d1;
        if (d0 > 128) v0 = -1e30f;
        if (d1 > 128) v1 = -1e30f;
      }
      S0[e] = v0; S1[e] = v1;
      mx = fmaxf(mx, fmaxf(v0, v1));
    }
    mx = fmaxf(mx, __shfl_xor(mx, 32));
    const float alpha = __builtin_amdgcn_exp2f(m_run - mx);
    m_run = mx;
    float rsum = 0.f;
#pragma unroll
    for (int e = 0; e < 16; ++e) {
      float p0 = __builtin_amdgcn_exp2f(S0[e] - mx), p1 = __builtin_amdgcn_exp2f(S1[e] - mx);
      S0[e] = p0; S1[e] = p1;
      rsum += p0 + p1;
    }
    rsum += __shfl_xor(rsum, 32);
    l_run = l_run * alpha + rsum;
#pragma unroll
    for (int e = 0; e < 16; ++e) { O0[e] *= alpha; O1[e] *= alpha; }
    const char* sv0 = smem + 13312 + r32 * 136 + 8 * hh;
    const char* sv1 = sv0 + 32 * 136;
#define PV_STEP(pb, ka) { \
      { uint2 lo = *(const uint2*)(sv0 + (ka) * 2), hi = *(const uint2*)(sv0 + (ka) * 2 + 16); \
        bf16x8 va = __builtin_bit_cast(bf16x8, uint4{lo.x, lo.y, hi.x, hi.y}); O0 = __builtin_amdgcn_mfma_f32_32x32x16_bf16(va, pb, O0, 0, 0, 0); } \
      { uint2 lo = *(const uint2*)(sv1 + (ka) * 2), hi = *(const uint2*)(sv1 + (ka) * 2 + 16); \
        bf16x8 va = __builtin_bit_cast(bf16x8, uint4{lo.x, lo.y, hi.x, hi.y}); O1 = __builtin_amdgcn_mfma_f32_32x32x16_bf16(va, pb, O1, 0, 0, 0); } }
    SB();
    { bf16x8 pb = PACK8(S0, 0); PV_STEP(pb, 0) }
    { bf16x8 pb = PACK8(S0, 1); PV_STEP(pb, 16) }
    SB();
    { bf16x8 pb = PACK8(S1, 0); PV_STEP(pb, 32) }
    { bf16x8 pb = PACK8(S1, 1); PV_STEP(pb, 48) }
    SB();
  }
  const float inv = 1.f / l_run;
#pragma unroll
  for (int e4 = 0; e4 < 4; ++e4) {
    uint2 o;
    o.x = pack2(O0[4 * e4] * inv, O0[4 * e4 + 1] * inv); o.y = pack2(O0[4 * e4 + 2] * inv, O0[4 * e4 + 3] * inv);
    *(uint2*)(yrow + 8 * e4 + 4 * hh) = o;
    o.x = pack2(O1[4 * e4] * inv, O1[4 * e4 + 1] * inv); o.y = pack2(O1[4 * e4 + 2] * inv, O1[4 * e4 + 3] * inv);
    *(uint2*)(yrow + 32 + 8 * e4 + 4 * hh) = o;
  }
}

template <int MODE>
DI void scan_seg(const Params& p, int l, int seq, int blk, int d, int seg, char* smem) {
  const int t = tid(), lane = t & 63, w = t >> 6;
  const int c16 = lane & 15, g4 = lane >> 4;
  const bool is_ctx = seq < 16;
  const int b = is_ctx ? seq : seq - 16;
  const int L = is_ctx ? 256 : 4096;
  const int gbase = is_ctx ? b * 256 : T_CTX + b * 4096;
  const u16* XR = wsp<u16>(p, O_XR);
  u16* Y = wsp<u16>(p, O_YRNN);
  float* SUM = wsp<float>(p, O_SUM);
  char* sXc = smem;
  float* sA = (float*)(smem + 8704);
  float* sU = (float*)(smem + 8704 + 16384);
  const int cch = t & 127, th = t >> 7;
  const int chg = blk * 128 + cch;
  const float w0 = p.conv_w[(l * 4 + 0) * 1024 + chg], w1 = p.conv_w[(l * 4 + 1) * 1024 + chg];
  const float w2 = p.conv_w[(l * 4 + 2) * 1024 + chg], w3 = p.conv_w[(l * 4 + 3) * 1024 + chg];
  const float cb = p.conv_b[l * 1024 + chg];
  bf16x8 bw[4][4];
  {
    const u16* WL = wsp<u16>(p, O_WLRU) + (size_t)(d * 8 + blk) * 256 * 128 + (size_t)(32 * w + c16) * 128 + g4 * 8;
#pragma unroll
    for (int nf = 0; nf < 4; ++nf)
#pragma unroll
      for (int ks = 0; ks < 4; ++ks)
        bw[nf][ks] = *(const bf16x8*)(WL + (size_t)((nf & 1) * 16 + (nf >> 1) * 128) * 128 + ks * 32);
  }
  float ba[2], bi[2], cl[2];
#pragma unroll
  for (int jn = 0; jn < 2; ++jn) {
    const int ch = (l * 2 + d) * 1024 + blk * 128 + 32 * w + 16 * jn + c16;
    ba[jn] = p.lru_ba[ch]; bi[jn] = p.lru_bi[ch];
    cl[jn] = -8.f * log1pf(__expf(-p.lru_lam[ch]));
  }
  float h = 0.f, P = 1.f;
  if (MODE == 1 && !is_ctx && t < 128) {
    h = p.state[(((size_t)b * 4 + l) * 2 + d) * 1024 + blk * 128 + t];
    const float* sm = SUM + ((size_t)((b * 8 + blk) * 2 + d) * 16) * 256 + t;
    if (d == 0) { for (int s2 = 0; s2 < seg; ++s2) h = sm[s2 * 256] * h + sm[s2 * 256 + 128]; }
    else { for (int s2 = 15; s2 > seg; --s2) h = sm[s2 * 256] * h + sm[s2 * 256 + 128]; }
  }
  for (int ci = 0; ci < 8; ++ci) {
    const int tc0 = seg * 256 + (d == 0 ? ci : 7 - ci) * 32;
    {
      float xv[19];
#pragma unroll
      for (int q = 0; q < 19; ++q) {
        const int pos = tc0 + th * 16 - 1 + q;
        xv[q] = (pos >= 0 && pos < L) ? bf2f(XR[(size_t)(gbase + pos) * 1024 + chg]) : 0.f;
      }
#pragma unroll
      for (int q = 0; q < 16; ++q) {
        float xc = cb + w0 * xv[q] + w1 * xv[q + 1] + w2 * xv[q + 2] + w3 * xv[q + 3];
        *(u16*)(sXc + (th * 16 + q) * 272 + cch * 2) = f2bf(xc);
      }
    }
    __syncthreads();
    f32x4 aR[2][2], aI[2][2];
#pragma unroll
    for (int im = 0; im < 2; ++im)
#pragma unroll
      for (int jn = 0; jn < 2; ++jn) { aR[im][jn] = f32x4{0.f, 0.f, 0.f, 0.f}; aI[im][jn] = f32x4{0.f, 0.f, 0.f, 0.f}; }
#pragma unroll
    for (int ks = 0; ks < 4; ++ks)
#pragma unroll
      for (int im = 0; im < 2; ++im) {
        bf16x8 af = *(const bf16x8*)(sXc + (16 * im + c16) * 272 + (ks * 32 + g4 * 8) * 2);
#pragma unroll
        for (int jn = 0; jn < 2; ++jn) {
          aR[im][jn] = __builtin_amdgcn_mfma_f32_16x16x32_bf16(af, bw[jn][ks], aR[im][jn], 0, 0, 0);
          aI[im][jn] = __builtin_amdgcn_mfma_f32_16x16x32_bf16(af, bw[2 + jn][ks], aI[im][jn], 0, 0, 0);
        }
      }
#pragma unroll
    for (int im = 0; im < 2; ++im)
#pragma unroll
      for (int jn = 0; jn < 2; ++jn)
#pragma unroll
        for (int e = 0; e < 4; ++e) {
          const int tt = 16 * im + 4 * g4 + e, c = 32 * w + 16 * jn + c16;
          const float r = sigmoidf_(aR[im][jn][e] + ba[jn]);
          const float ig = sigmoidf_(aI[im][jn][e] + bi[jn]);
          const float a = __expf(cl[jn] * r);
          const float xc = bf2f(*(const u16*)(sXc + tt * 272 + c * 2));
          const float u = sqrtf(fmaxf(1.f - a * a, 0.f)) * ig * xc;
          sA[tt * 128 + c] = a; sU[tt * 128 + c] = u;
        }
    __syncthreads();
    if (t < 128) {
      if (d == 0) {
#pragma unroll 8
        for (int s = 0; s < 32; ++s) {
          const float a = sA[s * 128 + t];
          h = a * h + sU[s * 128 + t];
          if (MODE == 0) P *= a; else sU[s * 128 + t] = h;
        }
      } else {
#pragma unroll 8
        for (int s = 31; s >= 0; --s) {
          const float a = sA[s * 128 + t];
          h = a * h + sU[s * 128 + t];
          if (MODE == 0) P *= a; else sU[s * 128 + t] = h;
        }
      }
    }
    __syncthreads();
    if (MODE == 1) {
      const int c2 = (t & 63) * 2;
#pragma unroll
      for (int i = 0; i < 8; ++i) {
        const int tt = (t >> 6) + 4 * i;
        unsigned* yp = (unsigned*)(Y + (size_t)(gbase + tc0 + tt) * 1024 + blk * 128 + c2);
        float h0 = sU[tt * 128 + c2], h1 = sU[tt * 128 + c2 + 1];
        if (d == 1) { const unsigned old = *yp; h0 += __uint_as_float(old << 16); h1 += __uint_as_float(old & 0xffff0000u); }
        *yp = pack2(h0, h1);
      }
    }
  }
  if (MODE == 0) {
    if (t < 128) {
      float* sm = SUM + ((size_t)(((b * 8 + blk) * 2 + d) * 16 + seg)) * 256 + t;
      sm[0] = P; sm[128] = h;
    }
  } else if (is_ctx && t < 128) {
    p.out[OUT_RG + (((size_t)b * 4 + l) * 2 + d) * 1024 + blk * 128 + t] = h;
  }
  __syncthreads();
}

DI void phase_mix(const Params& p, int l, char* smem) {
  constexpr float LOG2E = 1.4426950408889634f;
  constexpr int N0 = 1024, N1 = N0 + 2048, N2 = N1 + 2048, N3 = N2 + 128, N4 = N3 + 256, N5 = N4 + 256;
  for (int it = blockIdx.x; it < N5; it += gridDim.x) {
    const int t = tid(), lane = t & 63, w = t >> 6;
    const int r32 = lane & 31;
    if (it < N0 || (it >= N2 && it < N3)) {
      int seq, blk, seg;
      if (it < N0) { seg = it & 15; blk = (it >> 4) & 7; seq = 16 + (it >> 7); }
      else { const int i = it - N2; seg = 0; blk = i & 7; seq = i >> 3; }
      scan_seg<1>(p, l, seq, blk, 0, seg, smem);
      scan_seg<1>(p, l, seq, blk, 1, seg, smem);
    } else if (it < N1 || (it >= N3 && it < N4)) {
      const bool lat = it < N1;
      int b, h, qb;
      if (lat) { const int i = it - N0; qb = i & 31; h = (i >> 5) & 7; b = i >> 8; }
      else { const int i = it - N3; qb = i & 1; h = (i >> 1) & 7; b = i >> 4; }
      const int Lk = lat ? LK_LAT : 256;
      const int gq = (lat ? T_CTX + b * 4096 : b * 256) + qb * 128 + w * 32 + r32;
      const u16* Kn = (lat ? wsp<u16>(p, O_KNL) : wsp<u16>(p, O_KNC)) + ((size_t)b * 8 + h) * Lk * 64;
      const u16* Kr = (lat ? wsp<u16>(p, O_KRL) : wsp<u16>(p, O_KRC)) + (size_t)b * Lk * 32;
      const u16* Vt = (lat ? wsp<u16>(p, O_VTL) : wsp<u16>(p, O_VTC)) + ((size_t)b * 8 + h) * 64 * Lk;
      const u16* Q = wsp<u16>(p, O_Q) + (size_t)gq * 768;
      u16* yrow = wsp<u16>(p, O_CQ) + (size_t)gq * 512 + h * 64;
      attn_item<6>(Kn, 64, Kr, Vt, Lk, Lk >> 6, 0, 0, nullptr, 0, nullptr, 0, 0,
                   Q + h * 64, Q + 512 + h * 32, 0.10206207261596577f * LOG2E, -1e30f, 0.f, 0, yrow, smem);
#if PROBE == 5
      __syncthreads();
      attn_item<6>(Kn, 64, Kr, Vt, Lk, Lk >> 6, 0, 0, nullptr, 0, nullptr, 0, 0,
                   Q + h * 64, Q + 512 + h * 32, 0.10206207261596577f * LOG2E, -1e30f, 0.f, 0, yrow, smem);
#endif
    } else {
      const bool lat = it < N2;
      int b, h, qb;
      if (lat) { const int i = it - N1; qb = i & 31; h = (i >> 5) & 7; b = i >> 8; }
      else { const int i = it - N4; qb = i & 1; h = (i >> 1) & 7; b = i >> 4; }
      const int kvh = h >> 2;
      const int gseq = lat ? T_CTX + b * 4096 : b * 256;
      const int qpos = qb * 128 + w * 32 + r32;
      const int gq = gseq + qpos;
      u16* qrow = wsp<u16>(p, O_QS) + (size_t)gq * 512 + h * 64;
      const float sink2 = p.sink[l * 8 + h] * LOG2E;
      const int t0 = qb * 128;
      int jlo = 0, jhi = 6;
      if (t0 == 0) jlo = 2;
      if (t0 + 128 >= 4096) jhi = 4;
      const int ks0 = lat ? t0 - 128 + 64 * jlo : 0;
      const int nA = lat ? jhi - jlo : 4;
      const u16* KS = wsp<u16>(p, O_KS) + (size_t)(gseq + ks0) * 128 + kvh * 64;
      const u16* VT = lat ? wsp<u16>(p, O_VTSL) + ((size_t)b * 2 + kvh) * 64 * 4096 + ks0
                          : wsp<u16>(p, O_VTSC) + ((size_t)b * 2 + kvh) * 64 * 256;
      const u16* KC = wsp<u16>(p, O_KSC) + (size_t)b * 256 * 128 + kvh * 64;
      const u16* VC = wsp<u16>(p, O_VTSCC) + ((size_t)b * 2 + kvh) * 64 * 256;
      attn_item<4>(KS, 128, nullptr, VT, lat ? 4096 : 256, nA, ks0, lat ? 1 : 0, KC, 128, VC, 256, lat ? 4 : 0,
                   qrow, nullptr, 0.125f * LOG2E, sink2, 1.f, qpos, qrow, smem);
    }
    __syncthreads();
  }
}

DI void phase_gate(const Params& p, int l, char* smem) {
  const u16* H = wsp<u16>(p, O_H);
  const u16* W = wsp<u16>(p, O_WINB);
  for (int tile = blockIdx.x; tile < 288 * 16; tile += gridDim.x) {
    const int mt = tile >> 4, nt = tile & 15;
    const int g0 = mt * 128;
    f32x4 acc[4][4];
    zero_acc(acc);
    gemm_tile(H + (size_t)g0 * 1024, 1024, W + (size_t)nt * 128 * 1024, 1024, 1024, acc, smem);
    LANEVARS
    u16* dst; int ld, cb;
    if (nt < 8) { dst = wsp<u16>(p, O_YRNN); ld = 1024; cb = nt * 128; }
    else if (nt < 12) { dst = wsp<u16>(p, O_CQ); ld = 512; cb = (nt - 8) * 128; }
    else { dst = wsp<u16>(p, O_QS); ld = 512; cb = (nt - 12) * 128; }
#pragma unroll
    for (int i = 0; i < 4; ++i)
#pragma unroll
      for (int j = 0; j < 4; ++j)
#pragma unroll
        for (int e = 0; e < 4; ++e) {
          const int g = g0 + wr * 64 + i * 16 + g4 * 4 + e;
          u16* d = dst + (size_t)g * ld + cb + wc * 64 + j * 16 + c16;
          const float gv = acc[i][j][e];
          *d = f2bf(bf2f(*d) * gv * sigmoidf_(gv));
          if (e == 3) SB();
        }
  }
}

DI void phase_merge(const Params& p, int l, char* smem) {
  const u16* H = wsp<u16>(p, O_H);
  const u16* WB = wsp<u16>(p, O_WINB);
  u16* U = wsp<u16>(p, O_XR);
  for (int tile = blockIdx.x; tile < 288 * 16; tile += gridDim.x) {
    const int mt = tile >> 4, nt = tile & 15;
    const int g0 = mt * 128;
    f32x4 u[4][2];
#pragma unroll
    for (int i = 0; i < 4; ++i) { u[i][0] = f32x4{0.f, 0.f, 0.f, 0.f}; u[i][1] = f32x4{0.f, 0.f, 0.f, 0.f}; }
    for (int br = 0; br < 3; ++br) {
      f32x4 acc[4][2];
#pragma unroll
      for (int i = 0; i < 4; ++i) { acc[i][0] = f32x4{0.f, 0.f, 0.f, 0.f}; acc[i][1] = f32x4{0.f, 0.f, 0.f, 0.f}; }
      gemm_tile_t<2>(H + (size_t)g0 * 1024, 1024, WB + (size_t)(2048 + br * 1024 + nt * 64) * 1024, 1024, 1024, acc, smem);
      f32x4 sg[4][2];
#pragma unroll
      for (int i = 0; i < 4; ++i)
#pragma unroll
        for (int j = 0; j < 2; ++j) {
#pragma unroll
          for (int e = 0; e < 4; ++e) sg[i][j][e] = sigmoidf_(acc[i][j][e]);
          acc[i][j] = f32x4{0.f, 0.f, 0.f, 0.f};
        }
      const u16* Z; const u16* WT; int kz;
      if (br == 0) { Z = wsp<u16>(p, O_YRNN) + (size_t)g0 * 1024; WT = wsp<u16>(p, O_WBRR) + (size_t)nt * 64 * 1024; kz = 1024; }
      else if (br == 1) { Z = wsp<u16>(p, O_CQ) + (size_t)g0 * 512; WT = wsp<u16>(p, O_WBRM) + (size_t)nt * 64 * 512; kz = 512; }
      else { Z = wsp<u16>(p, O_QS) + (size_t)g0 * 512; WT = wsp<u16>(p, O_WBRS) + (size_t)nt * 64 * 512; kz = 512; }
      gemm_tile_t<2>(Z, kz, WT, kz, kz, acc, smem);
#pragma unroll
      for (int i = 0; i < 4; ++i)
#pragma unroll
        for (int j = 0; j < 2; ++j)
#pragma unroll
          for (int e = 0; e < 4; ++e) u[i][j][e] += sg[i][j][e] * acc[i][j][e];
    }
    LANEVARS
#pragma unroll
    for (int i = 0; i < 4; ++i)
#pragma unroll
      for (int j = 0; j < 2; ++j)
#pragma unroll
        for (int e = 0; e < 4; ++e) {
          const int g = g0 + wr * 64 + i * 16 + g4 * 4 + e;
          U[(size_t)g * 1024 + nt * 64 + wc * 32 + j * 16 + c16] = f2bf(u[i][j][e]);
        }
  }
}

DI void phase_out(const Params& p, int l, char* smem) {
  const u16* U = wsp<u16>(p, O_XR);
  const u16* W = wsp<u16>(p, O_WOUT);
  const float* MOD = wsp<float>(p, O_MOD) + (size_t)l * 9 * 3072;
  for (int tile = blockIdx.x; tile < 288 * 8; tile += gridDim.x) {
    const int mt = tile >> 3, nt = tile & 7;
    const int g0 = mt * 128;
    const int ci = g0 < T_CTX ? 8 : ((g0 - T_CTX) >> 12);
    f32x4 acc[4][4];
    zero_acc(acc);
    gemm_tile(U + (size_t)g0 * 1024, 1024, W + (size_t)nt * 128 * 1024, 1024, 1024, acc, smem);
    LANEVARS
#pragma unroll
    for (int j = 0; j < 4; ++j) {
      const int col = nt * 128 + wc * 64 + j * 16 + c16;
      const float gt = MOD[ci * 3072 + 2048 + col];
#pragma unroll
      for (int i = 0; i < 4; ++i)
#pragma unroll
        for (int e = 0; e < 4; ++e) {
          const int g = g0 + wr * 64 + i * 16 + g4 * 4 + e;
          const float xo = xin_row(p, l, g)[col];
          p.out[(size_t)g * 1024 + col] = xo + gt * acc[i][j][e];
          if (e == 3) SB();
        }
    }
  }
}

DI void phase_final(const Params& p) {
  const int t = tid(), lane = t & 63, w = t >> 6;
  for (int row = blockIdx.x * 4 + w; row < T_ALL; row += gridDim.x * 4) {
    float* x = p.out + (size_t)row * 1024;
    float4 v[4];
    float ss = 0.f;
#pragma unroll
    for (int i = 0; i < 4; ++i) {
      v[i] = *(const float4*)(x + i * 256 + lane * 4);
      ss += v[i].x * v[i].x + v[i].y * v[i].y + v[i].z * v[i].z + v[i].w * v[i].w;
    }
    ss = wave_sum(ss);
    const float rs = rsqrtf(ss * (1.f / 1024.f) + EPS);
#pragma unroll
    for (int i = 0; i < 4; ++i) {
      const int c = i * 256 + lane * 4;
      const float4 g = *(const float4*)(p.final_norm + c);
      float4 o = {v[i].x * rs * g.x, v[i].y * rs * g.y, v[i].z * rs * g.z, v[i].w * rs * g.w};
      *(float4*)(x + c) = o;
    }
  }
}

constexpr int NPHASE_PER_LAYER = 7;
DI void run_phase(const Params& p, int ph, char* smem) {
  if (ph == 0) { phase_mod(p, smem); return; }
  if (ph == 1 + NLAYER * NPHASE_PER_LAYER) { phase_final(p); return; }
  const int l = (ph - 1) / NPHASE_PER_LAYER, s = (ph - 1) % NPHASE_PER_LAYER;
  switch (s) {
    case 0: phase_prep(p, l); break;
    case 1: phase_gemmA(p, l, smem); break;
    case 2: phase_qkv(p, l, smem); break;
    case 3: phase_mix(p, l, smem); break;
    case 4: phase_gate(p, l, smem); break;
    case 5: phase_merge(p, l, smem); break;
    default: phase_out(p, l, smem); break;
  }
}
constexpr int NPHASE = 2 + NLAYER * NPHASE_PER_LAYER;

#if MEGA
DI Params launder(const Params& p) {
  size_t z = 0;
  asm volatile("" : "+s"(z));
  Params q = p; q.ws = p.ws + z; q.out = p.out + z;
  return q;
}
__global__ void __launch_bounds__(256, 2) mega_kernel(Params p) {
  __shared__ __attribute__((aligned(16))) char smem[66048];
  cg::grid_group grid = cg::this_grid();
  phase_mod(launder(p), smem);
  grid.sync();
  for (int l = 0; l < NLAYER; ++l) {
    phase_prep(launder(p), l);
    grid.sync();
#if PROBE == 1
    phase_prep(launder(p), l);
    grid.sync();
#endif
    phase_gemmA(launder(p), l, smem);
    grid.sync();
#if PROBE == 2
    phase_gemmA(launder(p), l, smem);
    grid.sync();
#endif
    phase_qkv(launder(p), l, smem);
    grid.sync();
    phase_mix(launder(p), l, smem);
    grid.sync();
    phase_gate(launder(p), l, smem);
    grid.sync();
    phase_merge(launder(p), l, smem);
    grid.sync();
#if PROBE == 3
    phase_merge(launder(p), l, smem);
    grid.sync();
#endif
    phase_out(launder(p), l, smem);
    grid.sync();
  }
  phase_final(launder(p));
}

#else
__global__ void __launch_bounds__(256, 2) phase_kernel(Params p, int ph) {
  __shared__ __attribute__((aligned(16))) char smem[66048];
  run_phase(p, ph, smem);
}

#endif
extern "C" void kernel_launch(void* const* d_in, const int* in_sizes, int n_in, void* d_out, int out_size, void* d_ws,
                              size_t ws_size, hipStream_t stream) {
  Params p{};
  const float** pp = (const float**)&p;
  for (int i = 0; i < 30; ++i) pp[i] = (const float*)d_in[i];
  p.out = (float*)d_out;
  p.ws = (char*)d_ws;
  if (ws_size < WS_NEED) fprintf(stderr, "workspace too small: %zu < %zu\n", ws_size, (size_t)WS_NEED);
#if MEGA
  static int grid_blocks = 0;
  if (!grid_blocks) {
    int dev = 0, cus = 0, per_cu = 0;
    hipGetDevice(&dev);
    hipDeviceGetAttribute(&cus, hipDeviceAttributeMultiprocessorCount, dev);
    hipOccupancyMaxActiveBlocksPerMultiprocessor(&per_cu, mega_kernel, 256, 0);
    if (per_cu > 2) per_cu = 2;
    grid_blocks = cus * per_cu;
  }
  void* args[] = {&p};
  hipError_t e = hipLaunchCooperativeKernel((void*)mega_kernel, dim3(grid_blocks), dim3(256), args, 0, stream);
  if (e != hipSuccess) fprintf(stderr, "cooperative launch failed: %s (grid %d)\n", hipGetErrorString(e), grid_blocks);
#else
  for (int ph = 0; ph < NPHASE; ++ph) phase_kernel<<<512, 256, 0, stream>>>(p, ph);
#endif
}
```

```cpp
#include <hip/hip_runtime.h>
#include <hip/hip_cooperative_groups.h>
#include <cstdio>
#include <cstdint>
namespace cg = cooperative_groups;

#ifndef PROBE
#define PROBE 0
#endif
#ifndef MEGA
#define MEGA 1
#endif

typedef unsigned short u16;
using bf16x8 = __attribute__((ext_vector_type(8))) short;
using f32x4 = __attribute__((ext_vector_type(4))) float;
using f32x16 = __attribute__((ext_vector_type(16))) float;
typedef __bf16 bf2_t __attribute__((ext_vector_type(2)));
typedef float f2_t __attribute__((ext_vector_type(2)));
#define DI __device__ __forceinline__

__device__ const float TAB_M[1024] = {
  1.00000000e+00f, 0.00000000e+00f, 1.00000000e+00f, 0.00000000e+00f, 1.00000000e+00f, 0.00000000e+00f, 1.00000000e+00f, 0.00000000e+00f,
  1.00000000e+00f, 0.00000000e+00f, 1.00000000e+00f, 0.00000000e+00f, 1.00000000e+00f, 0.00000000e+00f, 1.00000000e+00f, 0.00000000e+00f,
  5.40302277e-01f, 8.41470957e-01f, 9.50415254e-01f, 3.10983598e-01f, 9.95004177e-01f, 9.98334214e-02f, 9.99500036e-01f, 3.16175036e-02f,
  9.99949992e-01f, 9.99983307e-03f, 9.99994993e-01f, 3.16227227e-03f, 9.99999523e-01f, 9.99999931e-04f, 9.99999940e-01f, 3.16227757e-04f,
  -4.16146845e-01f, 9.09297407e-01f, 8.06578398e-01f, 5.91127098e-01f, 9.80066597e-01f, 1.98669329e-01f, 9.98000681e-01f, 6.32033944e-02f,
  9.99800026e-01f, 1.99986659e-02f, 9.99979973e-01f, 6.32451288e-03f, 9.99997973e-01f, 1.99999870e-03f, 9.99999821e-01f, 6.32455456e-04f,
  -9.89992499e-01f, 1.41120002e-01f, 5.82753658e-01f, 8.12648892e-01f, 9.55336511e-01f, 2.95520216e-01f, 9.95503366e-01f, 9.47260857e-02f,
  9.99550045e-01f, 2.99954992e-02f, 9.99954998e-01f, 9.48669016e-03f, 9.99995530e-01f, 2.99999560e-03f, 9.99999523e-01f, 9.48683126e-04f,
  -6.53643608e-01f, -7.56802499e-01f, 3.01137477e-01f, 9.53580737e-01f, 9.21060979e-01f, 3.89418334e-01f, 9.92010653e-01f, 1.26154065e-01f,
  9.99200106e-01f, 3.99893336e-02f, 9.99920011e-01f, 1.26487734e-02f, 9.99992013e-01f, 3.99998948e-03f, 9.99999225e-01f, 1.26491068e-03f,
  2.83662200e-01f, -9.58924294e-01f, -1.03423381e-02f, 9.99946535e-01f, 8.77582550e-01f, 4.79425550e-01f, 9.87526000e-01f, 1.57455876e-01f,
  9.98750269e-01f, 4.99791652e-02f, 9.99875009e-01f, 1.58107281e-02f, 9.99987483e-01f, 4.99997940e-03f, 9.99998748e-01f, 1.58113812e-03f,
  9.60170269e-01f, -2.79415488e-01f, -3.20796400e-01f, 9.47148204e-01f, 8.25335622e-01f, 5.64642489e-01f, 9.82053936e-01f, 1.88600272e-01f,
  9.98200536e-01f, 5.99640049e-02f, 9.99819994e-01f, 1.89725272e-02f, 9.99981999e-01f, 5.99996420e-03f, 9.99998212e-01f, 1.89736532e-03f,
  7.53902256e-01f, 6.56986594e-01f, -5.99437475e-01f, 8.00421596e-01f, 7.64842212e-01f, 6.44217670e-01f, 9.75599885e-01f, 2.19556093e-01f,
  9.97551024e-01f, 6.99428469e-02f, 9.99755025e-01f, 2.21341345e-02f, 9.99975502e-01f, 6.99994294e-03f, 9.99997556e-01f, 2.21359241e-03f,
  -1.45500034e-01f, 9.89358246e-01f, -8.18632424e-01f, 5.74317753e-01f, 6.96706712e-01f, 7.17356086e-01f, 9.68170285e-01f, 2.50292331e-01f,
  9.96801734e-01f, 7.99146891e-02f, 9.99680042e-01f, 2.52955221e-02f, 9.99967992e-01f, 7.99991470e-03f, 9.99996781e-01f, 2.52981926e-03f,
  -9.11130250e-01f, 4.12118495e-01f, -9.56644177e-01f, 2.91259229e-01f, 6.21609926e-01f, 7.83326924e-01f, 9.59772646e-01f, 2.80778319e-01f,
  9.95952725e-01f, 8.98785442e-02f, 9.99595046e-01f, 2.84566563e-02f, 9.99959528e-01f, 8.99987947e-03f, 9.99995947e-01f, 2.84604589e-03f,
  -8.39071512e-01f, -5.44021130e-01f, -9.99786079e-01f, -2.06835698e-02f, 5.40302277e-01f, 8.41470957e-01f, 9.50415313e-01f, 3.10983568e-01f,
  9.95004177e-01f, 9.98334140e-02f, 9.99500036e-01f, 3.16175036e-02f, 9.99949992e-01f, 9.99983400e-03f, 9.99994993e-01f, 3.16227227e-03f,
  4.42569796e-03f, -9.99990225e-01f, -9.43779767e-01f, -3.30574960e-01f, 4.53596085e-01f, 8.91207397e-01f, 9.40107584e-01f, 3.40877861e-01f,
  9.93956089e-01f, 1.09778300e-01f, 9.99395072e-01f, 3.47780399e-02f, 9.99939501e-01f, 1.09997792e-02f, 9.99993920e-01f, 3.47849843e-03f,
  8.43853951e-01f, -5.36572933e-01f, -7.94179380e-01f, -6.07683420e-01f, 3.62357706e-01f, 9.32039082e-01f, 9.28859890e-01f, 3.70431304e-01f,
  9.92808640e-01f, 1.19712204e-01f, 9.99280095e-01f, 3.79382223e-02f, 9.99927998e-01f, 1.19997123e-02f, 9.99992788e-01f, 3.79472389e-03f,
  9.07446802e-01f, 4.20167029e-01f, -5.65820515e-01f, -8.24528456e-01f, 2.67498761e-01f, 9.63558197e-01f, 9.16683376e-01f, 3.99614304e-01f,
  9.91561890e-01f, 1.29634142e-01f, 9.99155104e-01f, 4.10980321e-02f, 9.99915481e-01f, 1.29996343e-02f, 9.99991536e-01f, 4.11094911e-03f,
  1.36737213e-01f, 9.90607381e-01f, -2.81349480e-01f, -9.59605396e-01f, 1.69967160e-01f, 9.85449731e-01f, 9.03590262e-01f, 4.28397775e-01f,
  9.90216017e-01f, 1.39543116e-01f, 9.99020159e-01f, 4.42574248e-02f, 9.99902010e-01f, 1.39995432e-02f, 9.99990225e-01f, 4.42717411e-03f,
  -7.59687901e-01f, 6.50287867e-01f, 3.10223512e-02f, -9.99518692e-01f, 7.07371980e-02f, 9.97494996e-01f, 8.89593601e-01f, 4.56752867e-01f,
  9.88771081e-01f, 1.49438128e-01f, 9.98875201e-01f, 4.74163815e-02f, 9.99887526e-01f, 1.49994381e-02f, 9.99988735e-01f, 4.74339863e-03f,
  -9.57659483e-01f, -2.87903309e-01f, 3.40318173e-01f, -9.40310359e-01f, -2.91995462e-02f, 9.99573588e-01f, 8.74707460e-01f, 4.84651238e-01f,
  9.87227261e-01f, 1.59318209e-01f, 9.98720288e-01f, 5.05748577e-02f, 9.99872029e-01f, 1.59993190e-02f, 9.99987185e-01f, 5.05962269e-03f,
  -2.75163352e-01f, -9.61397469e-01f, 6.15864813e-01f, -7.87851870e-01f, -1.28844544e-01f, 9.91664827e-01f, 8.58946681e-01f, 5.12064993e-01f,
  9.85584795e-01f, 1.69182345e-01f, 9.98555362e-01f, 5.37328273e-02f, 9.99855518e-01f, 1.69991814e-02f, 9.99985576e-01f, 5.37584582e-03f,
  6.60316706e-01f, -7.50987232e-01f, 8.30336154e-01f, -5.57262897e-01f, -2.27202162e-01f, 9.73847628e-01f, 8.42327058e-01f, 5.38966715e-01f,
  9.83843684e-01f, 1.79029569e-01f, 9.98380423e-01f, 5.68902642e-02f, 9.99837995e-01f, 1.79990288e-02f, 9.99983788e-01f, 5.69206895e-03f,
  9.88704622e-01f, 1.49877205e-01f, 9.62463796e-01f, -2.71410108e-01f, -3.23289543e-01f, 9.46300089e-01f, 8.24865162e-01f, 5.65329552e-01f,
  9.82004225e-01f, 1.88858896e-01f, 9.98195529e-01f, 6.00471310e-02f, 9.99819517e-01f, 1.89988576e-02f, 9.99981940e-01f, 6.00829115e-03f,
  4.08082068e-01f, 9.12945271e-01f, 9.99144375e-01f, 4.13582884e-02f, -4.16146845e-01f, 9.09297407e-01f, 8.06578457e-01f, 5.91127038e-01f,
  9.80066597e-01f, 1.98669314e-01f, 9.98000681e-01f, 6.32033944e-02f, 9.99800026e-01f, 1.99986678e-02f, 9.99979973e-01f, 6.32451288e-03f,
  -5.47729254e-01f, 8.36655617e-01f, 9.36740458e-01f, 3.50024760e-01f, -5.04846215e-01f, 8.63209307e-01f, 7.87485182e-01f, 6.16333544e-01f,
  9.78030920e-01f, 2.08459899e-01f, 9.97795820e-01f, 6.63590282e-02f, 9.99779522e-01f, 2.09984574e-02f, 9.99977946e-01f, 6.64073415e-03f,
  -9.99960840e-01f, -8.85130931e-03f, 7.81440377e-01f, 6.23979926e-01f, -5.88501155e-01f, 8.08496356e-01f, 7.67604589e-01f, 6.40923738e-01f,
  9.75897431e-01f, 2.18229622e-01f, 9.97581005e-01f, 6.95140064e-02f, 9.99758005e-01f, 2.19982266e-02f, 9.99975801e-01f, 6.95695449e-03f,
  -5.32833040e-01f, -8.46220434e-01f, 5.48645258e-01f, 8.36055279e-01f, -6.66275978e-01f, 7.45705247e-01f, 7.46956408e-01f, 6.64873064e-01f,
  9.73666370e-01f, 2.27977514e-01f, 9.97356176e-01f, 7.26682767e-02f, 9.99735534e-01f, 2.29979735e-02f, 9.99973536e-01f, 7.27317436e-03f,
  4.24179018e-01f, -9.05578375e-01f, 2.61441678e-01f, 9.65219259e-01f, -7.37393796e-01f, 6.75463140e-01f, 7.25561321e-01f, 6.88157499e-01f,
  9.71337974e-01f, 2.37702623e-01f, 9.97121394e-01f, 7.58218244e-02f, 9.99711990e-01f, 2.39976961e-02f, 9.99971211e-01f, 7.58939330e-03f,
  9.91202831e-01f, -1.32351756e-01f, -5.16893305e-02f, 9.98663187e-01f, -8.01143587e-01f, 5.98472118e-01f, 7.03440726e-01f, 7.10753918e-01f,
  9.68912423e-01f, 2.47403964e-01f, 9.96876657e-01f, 7.89746121e-02f, 9.99687493e-01f, 2.49973964e-02f, 9.99968767e-01f, 7.90561177e-03f,
  6.46919310e-01f, 7.62558460e-01f, -3.59694332e-01f, 9.33070183e-01f, -8.56888831e-01f, 5.15501261e-01f, 6.80616796e-01f, 7.32639611e-01f,
  9.66389954e-01f, 2.57080555e-01f, 9.96621907e-01f, 8.21266174e-02f, 9.99662042e-01f, 2.59970706e-02f, 9.99966204e-01f, 8.22182931e-03f,
  -2.92138815e-01f, 9.56375957e-01f, -6.32028639e-01f, 7.74945021e-01f, -9.04072165e-01f, 4.27379847e-01f, 6.57112300e-01f, 7.53792703e-01f,
  9.63770926e-01f, 2.66731411e-01f, 9.96357203e-01f, 8.52777958e-02f, 9.99635518e-01f, 2.69967206e-02f, 9.99963522e-01f, 8.53804592e-03f,
  -9.62605894e-01f, 2.70905793e-01f, -8.41684937e-01f, 5.39968967e-01f, -9.42222297e-01f, 3.34988207e-01f, 6.32950664e-01f, 7.74192095e-01f,
  9.61055458e-01f, 2.76355654e-01f, 9.96082544e-01f, 8.84281173e-02f, 9.99608040e-01f, 2.79963426e-02f, 9.99960780e-01f, 8.85426160e-03f,
  -7.48057544e-01f, -6.63633883e-01f, -9.67871487e-01f, 2.51445323e-01f, -9.70958173e-01f, 2.39249229e-01f, 6.08156204e-01f, 7.93817401e-01f,
  9.58243906e-01f, 2.85952210e-01f, 9.95797932e-01f, 9.15775672e-02f, 9.99579549e-01f, 2.89959367e-02f, 9.99957979e-01f, 9.17047635e-03f,
  1.54251456e-01f, -9.88031626e-01f, -9.98075247e-01f, -6.20148405e-02f, -9.89992499e-01f, 1.41120002e-01f, 5.82753658e-01f, 8.12648892e-01f,
  9.55336511e-01f, 2.95520186e-01f, 9.95503366e-01f, 9.47260931e-02f, 9.99550045e-01f, 2.99955010e-02f, 9.99954998e-01f, 9.48669016e-03f,
  9.14742351e-01f, -4.04037654e-01f, -9.29300308e-01f, -3.69325012e-01f, -9.99135137e-01f, 4.15805206e-02f, 5.56768358e-01f, 8.30667794e-01f,
  9.52333570e-01f, 3.05058628e-01f, 9.95198846e-01f, 9.78736654e-02f, 9.99519527e-01f, 3.09950355e-02f, 9.99951959e-01f, 9.80290305e-03f,
  8.34223390e-01f, 5.51426709e-01f, -7.68367112e-01f, -6.40009403e-01f, -9.98294771e-01f, -5.83741926e-02f, 5.30226350e-01f, 8.47856104e-01f,
  9.49235439e-01f, 3.14566553e-01f, 9.94884372e-01f, 1.01020269e-01f, 9.99488056e-01f, 3.19945402e-02f, 9.99948800e-01f, 1.01191159e-02f,
  -1.32767474e-02f, 9.99911845e-01f, -5.31235278e-01f, -8.47224355e-01f, -9.87479806e-01f, -1.57745644e-01f, 5.03154159e-01f, 8.64196658e-01f,
  9.46042359e-01f, 3.24043006e-01f, 9.94559944e-01f, 1.04165860e-01f, 9.99455571e-01f, 3.29940096e-02f, 9.99945521e-01f, 1.04353270e-02f,
  -8.48570287e-01f, 5.29082716e-01f, -2.41421118e-01f, -9.70420420e-01f, -9.66798186e-01f, -2.55541205e-01f, 4.75578904e-01f, 8.79673064e-01f,
  9.42754686e-01f, 3.33487093e-01f, 9.94225562e-01f, 1.07310407e-01f, 9.99422073e-01f, 3.39934528e-02f, 9.99942183e-01f, 1.07515370e-02f,
  -9.03692186e-01f, -4.28182662e-01f, 7.23346695e-02f, -9.97380435e-01f, -9.36456680e-01f, -3.50783229e-01f, 4.47528064e-01f, 8.94269884e-01f,
  9.39372718e-01f, 3.42897803e-01f, 9.93881226e-01f, 1.10453881e-01f, 9.99387562e-01f, 3.49928550e-02f, 9.99938726e-01f, 1.10677453e-02f,
  -1.27963692e-01f, -9.91778851e-01f, 3.78916174e-01f, -9.25431013e-01f, -8.96758378e-01f, -4.42520559e-01f, 4.19029742e-01f, 9.07972515e-01f,
  9.35896814e-01f, 3.52274209e-01f, 9.93526995e-01f, 1.13596253e-01f, 9.99352098e-01f, 3.59922275e-02f, 9.99935210e-01f, 1.13839535e-02f,
  7.65414059e-01f, -6.43538117e-01f, 6.47921681e-01f, -7.61706948e-01f, -8.48100007e-01f, -5.29836178e-01f, 3.90112430e-01f, 9.20767248e-01f,
  9.32327330e-01f, 3.61615449e-01f, 9.93162811e-01f, 1.16737492e-01f, 9.99315560e-01f, 3.69915590e-02f, 9.99931574e-01f, 1.17001599e-02f,
  9.55073655e-01f, 2.96368569e-01f, 8.52673113e-01f, -5.22444785e-01f, -7.90967762e-01f, -6.11857831e-01f, 3.60805035e-01f, 9.32641268e-01f,
  9.28664625e-01f, 3.70920479e-01f, 9.92788672e-01f, 1.19877554e-01f, 9.99278069e-01f, 3.79908569e-02f, 9.99927819e-01f, 1.20163653e-02f,
  2.66642928e-01f, 9.63795364e-01f, 9.72865343e-01f, -2.31372014e-01f, -7.25932240e-01f, -6.87766254e-01f, 3.31136853e-01f, 9.43582714e-01f,
  9.24909055e-01f, 3.80188406e-01f, 9.92404640e-01f, 1.23016424e-01f, 9.99239624e-01f, 3.89901139e-02f, 9.99923944e-01f, 1.23325698e-02f,
  -6.66938066e-01f, 7.45113134e-01f, 9.96578991e-01f, 8.26458037e-02f, -6.53643608e-01f, -7.56802499e-01f, 3.01137596e-01f, 9.53580678e-01f,
  9.21060979e-01f, 3.89418334e-01f, 9.92010653e-01f, 1.26154065e-01f, 9.99200106e-01f, 3.99893373e-02f, 9.99920011e-01f, 1.26487734e-02f,
  -9.87339258e-01f, -1.58622667e-01f, 9.21462357e-01f, 3.88467699e-01f, -5.74824035e-01f, -8.18277061e-01f, 2.70837069e-01f, 9.62625206e-01f,
  9.17120814e-01f, 3.98609310e-01f, 9.91606772e-01f, 1.29290432e-01f, 9.99159634e-01f, 4.09885161e-02f, 9.99915957e-01f, 1.29649751e-02f,
  -3.99985313e-01f, -9.16521549e-01f, 7.54965365e-01f, 6.55764699e-01f, -4.90260571e-01f, -8.71575892e-01f, 2.40265876e-01f, 9.70707119e-01f,
  9.13088918e-01f, 4.07760441e-01f, 9.91192937e-01f, 1.32425532e-01f, 9.99118149e-01f, 4.19876575e-02f, 9.99911785e-01f, 1.32811759e-02f,
  5.55113316e-01f, -8.31774771e-01f, 5.13598442e-01f, 8.58030677e-01f, -4.00799006e-01f, -9.16166008e-01f, 2.09454417e-01f, 9.77818429e-01f,
  9.08965766e-01f, 4.16870773e-01f, 9.90769207e-01f, 1.35559291e-01f, 9.99075651e-01f, 4.29867506e-02f, 9.99907553e-01f, 1.35973748e-02f,
  9.99843299e-01f, 1.77019257e-02f, 2.21298173e-01f, 9.75206196e-01f, -3.07332784e-01f, -9.51602101e-01f, 1.78433523e-01f, 9.83951986e-01f,
  9.04751658e-01f, 4.25939471e-01f, 9.90335584e-01f, 1.38691694e-01f, 9.99032140e-01f, 4.39858064e-02f, 9.99903202e-01f, 1.39135728e-02f,
  5.25321960e-01f, 8.50903511e-01f, -9.29481089e-02f, 9.95670974e-01f, -2.10795805e-01f, -9.77530122e-01f, 1.47234216e-01f, 9.89101648e-01f,
  9.00447130e-01f, 4.34965521e-01f, 9.89892066e-01f, 1.41822711e-01f, 9.98987675e-01f, 4.49848175e-02f, 9.99898732e-01f, 1.42297689e-02f,
  -4.32177931e-01f, 9.01788354e-01f, -3.97976756e-01f, 9.17395473e-01f, -1.12152621e-01f, -9.93690968e-01f, 1.15887694e-01f, 9.93262351e-01f,
  8.96052480e-01f, 4.43948090e-01f, 9.89438653e-01f, 1.44952312e-01f, 9.98942196e-01f, 4.59837839e-02f, 9.99894202e-01f, 1.45459641e-02f,
  -9.92335498e-01f, 1.23573124e-01f, -6.63538277e-01f, 7.48142362e-01f, -1.23883775e-02f, -9.99923289e-01f, 8.44252855e-02f, 9.96429801e-01f,
  8.91568303e-01f, 4.52886283e-01f, 9.88975346e-01f, 1.48080453e-01f, 9.98895705e-01f, 4.69827019e-02f, 9.99889553e-01f, 1.48621574e-02f,
  -6.40144348e-01f, -7.68254638e-01f, -8.63296509e-01f, 5.04697084e-01f, 8.74991715e-02f, -9.96164620e-01f, 5.28784581e-02f, 9.98600960e-01f,
  8.86994898e-01f, 4.61779177e-01f, 9.88502085e-01f, 1.51207119e-01f, 9.98848200e-01f, 4.79815714e-02f, 9.99884784e-01f, 1.51783489e-02f,
  3.00592542e-01f, -9.53752637e-01f, -9.77442741e-01f, 2.11200655e-01f, 1.86512470e-01f, -9.82452571e-01f, 2.12787576e-02f, 9.99773562e-01f,
  8.82332861e-01f, 4.70625877e-01f, 9.88018990e-01f, 1.54332280e-01f, 9.98799741e-01f, 4.89803962e-02f, 9.99879956e-01f, 1.54945394e-02f,
  9.64965999e-01f, -2.62374848e-01f, -9.94656444e-01f, -1.03240460e-01f, 2.83662200e-01f, -9.58924294e-01f, -1.03422189e-02f, 9.99946535e-01f,
  8.77582550e-01f, 4.79425550e-01f, 9.87526000e-01f, 1.57455891e-01f, 9.98750269e-01f, 4.99791689e-02f, 9.99875009e-01f, 1.58107281e-02f,
  7.42154181e-01f, 6.70229197e-01f, -9.13230121e-01f, -4.07444149e-01f, 3.77977669e-01f, -9.25814748e-01f, -4.19528559e-02f, 9.99119580e-01f,
  8.72744501e-01f, 4.88177240e-01f, 9.87023175e-01f, 1.60577938e-01f, 9.98699784e-01f, 5.09778969e-02f, 9.99869943e-01f, 1.61269177e-02f,
  -1.62990779e-01f, 9.86627579e-01f, -7.41239965e-01f, -6.71240151e-01f, 4.68516916e-01f, -8.83454502e-01f, -7.35215396e-02f, 9.97293651e-01f,
  8.67819190e-01f, 4.96880114e-01f, 9.86510456e-01f, 1.63698375e-01f, 9.98648286e-01f, 5.19765690e-02f, 9.99864817e-01f, 1.64431017e-02f,
  -9.18282807e-01f, 3.95925164e-01f, -4.95741814e-01f, -8.68469954e-01f, 5.54374516e-01f, -8.32267344e-01f, -1.05016708e-01f, 9.94470477e-01f,
  8.62807095e-01f, 5.05533338e-01f, 9.85987842e-01f, 1.66817173e-01f, 9.98595834e-01f, 5.29751927e-02f, 9.99859571e-01f, 1.67592876e-02f,
  -8.29309821e-01f, -5.58789074e-01f, -2.01079622e-01f, -9.79574919e-01f, 6.34692967e-01f, -7.72764444e-01f, -1.36406869e-01f, 9.90652919e-01f,
  8.57708693e-01f, 5.14135957e-01f, 9.85455394e-01f, 1.69934288e-01f, 9.98542368e-01f, 5.39737605e-02f, 9.99854207e-01f, 1.70754679e-02f,
  2.21267566e-02f, -9.99755144e-01f, 1.13521777e-01f, -9.93535519e-01f, 7.08669782e-01f, -7.05540299e-01f, -1.67660639e-01f, 9.85844791e-01f,
  8.52524519e-01f, 5.22687256e-01f, 9.84913111e-01f, 1.73049718e-01f, 9.98487890e-01f, 5.49722798e-02f, 9.99848783e-01f, 1.73916500e-02f,
  8.53220105e-01f, -5.21551013e-01f, 4.16867077e-01f, -9.08967435e-01f, 7.75565803e-01f, -6.31266713e-01f, -1.98746875e-01f, 9.80050862e-01f,
  8.47255111e-01f, 5.31186223e-01f, 9.84360933e-01f, 1.76163420e-01f, 9.98432398e-01f, 5.59707358e-02f, 9.99843180e-01f, 1.77078284e-02f,
  8.99866819e-01f, 4.36164767e-01f, 6.78870201e-01f, -7.34258294e-01f, 8.34712923e-01f, -5.50685287e-01f, -2.29634270e-01f, 9.73276973e-01f,
  8.41901004e-01f, 5.39632022e-01f, 9.83798921e-01f, 1.79275364e-01f, 9.98375952e-01f, 5.69691435e-02f, 9.99837577e-01f, 1.80240069e-02f,
  1.19180135e-01f, 9.92872655e-01f, 8.73550534e-01f, -4.86733496e-01f, 8.85519624e-01f, -4.64602023e-01f, -2.60292053e-01f, 9.65529919e-01f,
  8.36462677e-01f, 5.48023939e-01f, 9.83227074e-01f, 1.82385504e-01f, 9.98318493e-01f, 5.79674877e-02f, 9.99831796e-01f, 1.83401816e-02f,
  -7.71080196e-01f, 6.36738002e-01f, 9.81602073e-01f, -1.90938011e-01f, 9.27478492e-01f, -3.73876572e-01f, -2.90689558e-01f, 9.56817448e-01f,
  8.30940723e-01f, 5.56361020e-01f, 9.82645452e-01f, 1.85493827e-01f, 9.98260021e-01f, 5.89657798e-02f, 9.99825954e-01f, 1.86563563e-02f,
  -9.52412963e-01f, -3.04810613e-01f, 9.92308319e-01f, 1.23790950e-01f, 9.60170269e-01f, -2.79415488e-01f, -3.20796400e-01f, 9.47148204e-01f,
  8.25335622e-01f, 5.64642429e-01f, 9.82053936e-01f, 1.88600287e-01f, 9.98200536e-01f, 5.99640086e-02f, 9.99819994e-01f, 1.89725272e-02f,
  -2.58101642e-01f, -9.66117799e-01f, 9.04607594e-01f, 4.26245421e-01f, 9.83268440e-01f, -1.82162598e-01f, -3.50582451e-01f, 9.36531842e-01f,
  8.19648027e-01f, 5.72867453e-01f, 9.81452644e-01f, 1.91704854e-01f, 9.98140097e-01f, 6.09621815e-02f, 9.99813974e-01f, 1.92886982e-02f,
  6.73507154e-01f, -7.39180684e-01f, 7.27198064e-01f, 6.86427653e-01f, 9.96542096e-01f, -8.30891207e-02f, -3.80017966e-01f, 9.24979091e-01f,
  8.13878477e-01f, 5.81035137e-01f, 9.80841517e-01f, 1.94807529e-01f, 9.98078644e-01f, 6.19602874e-02f, 9.99807835e-01f, 1.96048655e-02f,
  9.85896587e-01f, 1.67355701e-01f, 4.77671444e-01f, 8.78538549e-01f, 9.99858618e-01f, 1.68140903e-02f, -4.09073502e-01f, 9.12501454e-01f,
  8.08027506e-01f, 5.89144766e-01f, 9.80220556e-01f, 1.97908238e-01f, 9.98016179e-01f, 6.29583374e-02f, 9.99801576e-01f, 1.99210308e-02f,
};
__device__ const float TAB_S[2048] = {
  1.00000000e+00f, 0.00000000e+00f, 1.00000000e+00f, 0.00000000e+00f, 1.00000000e+00f, 0.00000000e+00f, 1.00000000e+00f, 0.00000000e+00f,
  1.00000000e+00f, 0.00000000e+00f, 1.00000000e+00f, 0.00000000e+00f, 1.00000000e+00f, 0.00000000e+00f, 1.00000000e+00f, 0.00000000e+00f,
  1.00000000e+00f, 0.00000000e+00f, 1.00000000e+00f, 0.00000000e+00f, 1.00000000e+00f, 0.00000000e+00f, 1.00000000e+00f, 0.00000000e+00f,
  1.00000000e+00f, 0.00000000e+00f, 1.00000000e+00f, 0.00000000e+00f, 1.00000000e+00f, 0.00000000e+00f, 1.00000000e+00f, 0.00000000e+00f,
  5.40302277e-01f, 8.41470957e-01f, 8.46009135e-01f, 5.33168435e-01f, 9.50415254e-01f, 3.10983598e-01f, 9.84230220e-01f, 1.76892191e-01f,
  9.95004177e-01f, 9.98334214e-02f, 9.98419285e-01f, 5.62044978e-02f, 9.99500036e-01f, 3.16175036e-02f, 9.99841869e-01f, 1.77818574e-02f,
  9.99949992e-01f, 9.99983307e-03f, 9.99984205e-01f, 5.62338345e-03f, 9.99994993e-01f, 3.16227227e-03f, 9.99998391e-01f, 1.77827850e-03f,
  9.99999523e-01f, 9.99999931e-04f, 9.99999821e-01f, 5.62341243e-04f, 9.99999940e-01f, 3.16227757e-04f, 1.00000000e+00f, 1.77827940e-04f,
  -4.16146845e-01f, 9.09297407e-01f, 4.31462824e-01f, 9.02130723e-01f, 8.06578398e-01f, 5.91127098e-01f, 9.37418282e-01f, 3.48205268e-01f,
  9.80066597e-01f, 1.98669329e-01f, 9.93682086e-01f, 1.12231314e-01f, 9.98000681e-01f, 6.32033944e-02f, 9.99367595e-01f, 3.55580896e-02f,
  9.99800026e-01f, 1.99986659e-02f, 9.99936759e-01f, 1.12465890e-02f, 9.99979973e-01f, 6.32451288e-03f, 9.99993682e-01f, 3.55655141e-03f,
  9.99997973e-01f, 1.99999870e-03f, 9.99999344e-01f, 1.12468237e-03f, 9.99999821e-01f, 6.32455456e-04f, 9.99999940e-01f, 3.55655880e-04f,
  -9.89992499e-01f, 1.41120002e-01f, -1.15966164e-01f, 9.93253171e-01f, 5.82753658e-01f, 8.12648892e-01f, 8.61040652e-01f, 5.08536100e-01f,
  9.55336511e-01f, 2.95520216e-01f, 9.85803485e-01f, 1.67903304e-01f, 9.95503366e-01f, 9.47260857e-02f, 9.98577297e-01f, 5.33230826e-02f,
  9.99550045e-01f, 2.99954992e-02f, 9.99857724e-01f, 1.68694388e-02f, 9.99954998e-01f, 9.48669016e-03f, 9.99985754e-01f, 5.33481315e-03f,
  9.99995530e-01f, 2.99999560e-03f, 9.99998569e-01f, 1.68702309e-03f, 9.99999523e-01f, 9.48683126e-04f, 9.99999881e-01f, 5.33483806e-04f,
  -6.53643608e-01f, -7.56802499e-01f, -6.27679706e-01f, 7.78471708e-01f, 3.01137477e-01f, 9.53580737e-01f, 7.57506192e-01f, 6.52827978e-01f,
  9.21060979e-01f, 3.89418334e-01f, 9.74808276e-01f, 2.23044485e-01f, 9.92010653e-01f, 1.26154065e-01f, 9.97471273e-01f, 7.10712075e-02f,
  9.99200106e-01f, 3.99893336e-02f, 9.99747038e-01f, 2.24917568e-02f, 9.99920011e-01f, 1.26487734e-02f, 9.99974728e-01f, 7.11305765e-03f,
  9.99992013e-01f, 3.99998948e-03f, 9.99997497e-01f, 2.24936334e-03f, 9.99999225e-01f, 1.26491068e-03f, 9.99999762e-01f, 7.11311703e-04f,
  2.83662200e-01f, -9.58924294e-01f, -9.46079254e-01f, 3.23935270e-01f, -1.03423381e-02f, 9.99946535e-01f, 6.30080283e-01f, 7.76529968e-01f,
  8.77582550e-01f, 4.79425550e-01f, 9.60731268e-01f, 2.77480543e-01f, 9.87526000e-01f, 1.57455876e-01f, 9.96049762e-01f, 8.87968615e-02f,
  9.98750269e-01f, 4.99791652e-02f, 9.99604762e-01f, 2.81133614e-02f, 9.99875009e-01f, 1.58107281e-02f, 9.99960482e-01f, 8.89127981e-03f,
  9.99987483e-01f, 4.99997940e-03f, 9.99996066e-01f, 2.81170290e-03f, 9.99998748e-01f, 1.58113812e-03f, 9.99999583e-01f, 8.89139599e-04f,
  9.60170269e-01f, -2.79415488e-01f, -9.73103702e-01f, -2.30367512e-01f, -3.20796400e-01f, 9.47148204e-01f, 4.82782036e-01f, 8.75740528e-01f,
  8.25335622e-01f, 5.64642489e-01f, 9.43616986e-01f, 3.31039310e-01f, 9.82053936e-01f, 1.88600272e-01f, 9.94313300e-01f, 1.06494442e-01f,
  9.98200536e-01f, 5.99640049e-02f, 9.99430835e-01f, 3.37340795e-02f, 9.99819994e-01f, 1.89725272e-02f, 9.99943078e-01f, 1.06694745e-02f,
  9.99981999e-01f, 5.99996420e-03f, 9.99994338e-01f, 3.37404152e-03f, 9.99998212e-01f, 1.89736532e-03f, 9.99999404e-01f, 1.06696738e-03f,
  7.53902256e-01f, 6.56986594e-01f, -7.00429797e-01f, -7.13721275e-01f, -5.99437475e-01f, 8.00421596e-01f, 3.20257008e-01f, 9.47330713e-01f,
  7.64842212e-01f, 6.44217670e-01f, 9.23519433e-01f, 3.83551568e-01f, 9.75599885e-01f, 2.19556093e-01f, 9.92262423e-01f, 1.24158338e-01f,
  9.97551024e-01f, 6.99428469e-02f, 9.99225318e-01f, 3.93537246e-02f, 9.99755025e-01f, 2.21341345e-02f, 9.99922514e-01f, 1.24476347e-02f,
  9.99975502e-01f, 6.99994294e-03f, 9.99992251e-01f, 3.93637875e-03f, 9.99997556e-01f, 2.21359241e-03f, 9.99999225e-01f, 1.24479528e-03f,
  -1.45500034e-01f, 9.89358246e-01f, -2.12036446e-01f, -9.77261782e-01f, -8.18632424e-01f, 5.74317753e-01f, 1.47631213e-01f, 9.89042461e-01f,
  6.96706712e-01f, 7.17356086e-01f, 9.00502324e-01f, 4.34851229e-01f, 9.68170285e-01f, 2.50292331e-01f, 9.89897788e-01f, 1.41782969e-01f,
  9.96801734e-01f, 7.99146891e-02f, 9.98988271e-01f, 4.49721329e-02f, 9.99680042e-01f, 2.52955221e-02f, 9.99898791e-01f, 1.42257558e-02f,
  9.99967992e-01f, 7.99991470e-03f, 9.99989867e-01f, 4.49871505e-03f, 9.99996781e-01f, 2.52981926e-03f, 9.99998987e-01f, 1.42262306e-03f,
  -9.11130250e-01f, 4.12118495e-01f, 3.41660261e-01f, -9.39823508e-01f, -9.56644177e-01f, 2.91259229e-01f, -2.96507962e-02f, 9.99560297e-01f,
  6.21609926e-01f, 7.83326924e-01f, 8.74638259e-01f, 4.84776139e-01f, 9.59772646e-01f, 2.80778319e-01f, 9.87220109e-01f, 1.59362778e-01f,
  9.95952725e-01f, 8.98785442e-02f, 9.98719573e-01f, 5.05891182e-02f, 9.99595046e-01f, 2.84566563e-02f, 9.99871910e-01f, 1.60038304e-02f,
  9.99959528e-01f, 8.99987947e-03f, 9.99987185e-01f, 5.06105041e-03f, 9.99995947e-01f, 2.84604589e-03f, 9.99998748e-01f, 1.60045072e-03f,
  -8.39071512e-01f, -5.44021130e-01f, 7.90131867e-01f, -6.12936914e-01f, -9.99786079e-01f, -2.06835698e-02f, -2.05997631e-01f, 9.78552461e-01f,
  5.40302277e-01f, 8.41470957e-01f, 8.46009135e-01f, 5.33168435e-01f, 9.50415313e-01f, 3.10983568e-01f, 9.84230220e-01f, 1.76892191e-01f,
  9.95004177e-01f, 9.98334140e-02f, 9.98419285e-01f, 5.62044978e-02f, 9.99500036e-01f, 3.16175036e-02f, 9.99841869e-01f, 1.77818574e-02f,
  9.99949992e-01f, 9.99983400e-03f, 9.99984205e-01f, 5.62338345e-03f, 9.99994993e-01f, 3.16227227e-03f, 9.99998391e-01f, 1.77827850e-03f,
  4.42569796e-03f, -9.99990225e-01f, 9.95257378e-01f, -9.72764567e-02f, -9.43779767e-01f, -3.30574960e-01f, -3.75847399e-01f, 9.26681578e-01f,
  4.53596085e-01f, 8.91207397e-01f, 8.14705312e-01f, 5.79875171e-01f, 9.40107584e-01f, 3.40877861e-01f, 9.80929136e-01f, 1.94365650e-01f,
  9.93956089e-01f, 1.09778300e-01f, 9.98087406e-01f, 6.18181042e-02f, 9.99395072e-01f, 3.47780399e-02f, 9.99808669e-01f, 1.95598267e-02f,
  9.99939501e-01f, 1.09997792e-02f, 9.99980867e-01f, 6.18571462e-03f, 9.99993920e-01f, 3.47849843e-03f, 9.99998093e-01f, 1.95610616e-03f,
  8.43853951e-01f, -5.36572933e-01f, 8.93861592e-01f, 4.48342979e-01f, -7.94179380e-01f, -6.07683420e-01f, -5.33843040e-01f, 8.45583618e-01f,
  3.62357706e-01f, 9.32039082e-01f, 7.80825913e-01f, 6.24748647e-01f, 9.28859890e-01f, 3.70431304e-01f, 9.77317870e-01f, 2.11777672e-01f,
  9.92808640e-01f, 1.19712204e-01f, 9.97723997e-01f, 6.74297586e-02f, 9.99280095e-01f, 3.79382223e-02f, 9.99772310e-01f, 2.13377345e-02f,
  9.99927998e-01f, 1.19997123e-02f, 9.99977231e-01f, 6.74804440e-03f, 9.99992788e-01f, 3.79472389e-03f, 9.99997735e-01f, 2.13393359e-03f,
  9.07446802e-01f, 4.20167029e-01f, 5.17172873e-01f, 8.55880976e-01f, -5.65820515e-01f, -8.24528456e-01f, -6.75001681e-01f, 7.37816215e-01f,
  2.67498761e-01f, 9.63558197e-01f, 7.44477987e-01f, 6.67647004e-01f, 9.16683376e-01f, 3.99614304e-01f, 9.73397553e-01f, 2.29122713e-01f,
  9.91561890e-01f, 1.29634142e-01f, 9.97329056e-01f, 7.30392784e-02f, 9.99155104e-01f, 4.10980321e-02f, 9.99732792e-01f, 2.31155735e-02f,
  9.99915481e-01f, 1.29996343e-02f, 9.99973297e-01f, 7.31037185e-03f, 9.99991536e-01f, 4.11094911e-03f, 9.99997318e-01f, 2.31176103e-03f,
  1.36737213e-01f, 9.90607381e-01f, -1.87961515e-02f, 9.99823332e-01f, -2.81349480e-01f, -9.59605396e-01f, -7.94870913e-01f, 6.06778562e-01f,
  1.69967160e-01f, 9.85449731e-01f, 7.05776393e-01f, 7.08434701e-01f, 9.03590262e-01f, 4.28397775e-01f, 9.69169438e-01f, 2.46395305e-01f,
  9.90216017e-01f, 1.39543116e-01f, 9.96902585e-01f, 7.86464810e-02f, 9.99020159e-01f, 4.42574248e-02f, 9.99690115e-01f, 2.48933397e-02f,
  9.99902010e-01f, 1.39995432e-02f, 9.99969006e-01f, 7.87269697e-03f, 9.99990225e-01f, 4.42717411e-03f, 9.99996901e-01f, 2.48958869e-03f,
  -7.59687901e-01f, 6.50287867e-01f, -5.48975468e-01f, 8.35838437e-01f, 3.10223512e-02f, -9.99518692e-01f, -8.89670432e-01f, 4.56603259e-01f,
  7.07371980e-02f, 9.97494996e-01f, 6.64843500e-01f, 7.46982634e-01f, 8.89593601e-01f, 4.56752867e-01f, 9.64634836e-01f, 2.63589978e-01f,
  9.88771081e-01f, 1.49438128e-01f, 9.96444523e-01f, 8.42512026e-02f, 9.98875201e-01f, 4.74163815e-02f, 9.99644279e-01f, 2.66710296e-02f,
  9.99887526e-01f, 1.49994381e-02f, 9.99964416e-01f, 8.43502022e-03f, 9.99988735e-01f, 4.74339863e-03f, 9.99996424e-01f, 2.66741589e-03f,
  -9.57659483e-01f, -2.87903309e-01f, -9.10081089e-01f, 4.14430231e-01f, 3.40318173e-01f, -9.40310359e-01f, -9.56410050e-01f, 2.92027086e-01f,
  -2.91995462e-02f, 9.99573588e-01f, 6.21808827e-01f, 7.83169091e-01f, 8.74707460e-01f, 4.84651238e-01f, 9.59795177e-01f, 2.80701309e-01f,
  9.87227261e-01f, 1.59318209e-01f, 9.95954990e-01f, 8.98532644e-02f, 9.98720288e-01f, 5.05748577e-02f, 9.99595284e-01f, 2.84486320e-02f,
  9.99872029e-01f, 1.59993190e-02f, 9.99959528e-01f, 8.99733976e-03f, 9.99987185e-01f, 5.05962269e-03f, 9.99995947e-01f, 2.84524332e-03f,
  -2.75163352e-01f, -9.61397469e-01f, -9.90897954e-01f, -1.34615138e-01f, 6.15864813e-01f, -7.87851870e-01f, -9.92985010e-01f, 1.18240520e-01f,
  -1.28844544e-01f, 9.91664827e-01f, 5.76808274e-01f, 8.16879570e-01f, 8.58946681e-01f, 5.12064993e-01f, 9.54652011e-01f, 2.97723860e-01f,
  9.85584795e-01f, 1.69182345e-01f, 9.95433986e-01f, 9.54524800e-02f, 9.98555362e-01f, 5.37328273e-02f, 9.99543071e-01f, 3.02261449e-02f,
  9.99855518e-01f, 1.69991814e-02f, 9.99954283e-01f, 9.55965649e-03f, 9.99985576e-01f, 5.37584582e-03f, 9.99995410e-01f, 3.02307028e-03f,
  6.60316706e-01f, -7.50987232e-01f, -7.66536534e-01f, -6.42200708e-01f, 8.30336154e-01f, -5.57262897e-01f, -9.98241663e-01f, -5.92755191e-02f,
  -2.27202162e-01f, 9.73847628e-01f, 5.29984176e-01f, 8.48007560e-01f, 8.42327058e-01f, 5.38966715e-01f, 9.49207008e-01f, 3.14652264e-01f,
  9.83843684e-01f, 1.79029569e-01f, 9.94881511e-01f, 1.01048686e-01f, 9.98380423e-01f, 5.68902642e-02f, 9.99487758e-01f, 3.20035629e-02f,
  9.99837995e-01f, 1.79990288e-02f, 9.99948800e-01f, 1.01219704e-02f, 9.99983788e-01f, 5.69206895e-03f, 9.99994874e-01f, 3.20089748e-03f,
  9.88704622e-01f, 1.49877205e-01f, -3.06095392e-01f, -9.52000856e-01f, 9.62463796e-01f, -2.71410108e-01f, -9.72014248e-01f, -2.34921798e-01f,
  -3.23289543e-01f, 9.46300089e-01f, 4.81484592e-01f, 8.76454532e-01f, 8.24865162e-01f, 5.65329552e-01f, 9.43461835e-01f, 3.31481189e-01f,
  9.82004225e-01f, 1.88858896e-01f, 9.94297504e-01f, 1.06641680e-01f, 9.98195529e-01f, 6.00471310e-02f, 9.99429286e-01f, 3.37808803e-02f,
  9.99819517e-01f, 1.89988576e-02f, 9.99942899e-01f, 1.06842816e-02f, 9.99981940e-01f, 6.00829115e-03f, 9.99994278e-01f, 3.37872445e-03f,
  4.08082068e-01f, 9.12945271e-01f, 2.48616725e-01f, -9.68601942e-01f, 9.99144375e-01f, 4.13582884e-02f, -9.15129960e-01f, -4.03158993e-01f,
  -4.16146845e-01f, 9.09297407e-01f, 4.31462824e-01f, 9.02130723e-01f, 8.06578457e-01f, 5.91127038e-01f, 9.37418282e-01f, 3.48205268e-01f,
  9.80066597e-01f, 1.98669314e-01f, 9.93682086e-01f, 1.12231314e-01f, 9.98000681e-01f, 6.32033944e-02f, 9.99367595e-01f, 3.55580896e-02f,
  9.99800026e-01f, 1.99986678e-02f, 9.99936759e-01f, 1.12465890e-02f, 9.99979973e-01f, 6.32451288e-03f, 9.99993682e-01f, 3.55655141e-03f,
  -5.47729254e-01f, 8.36655617e-01f, 7.26760268e-01f, -6.86891198e-01f, 9.36740458e-01f, 3.50024760e-01f, -8.29382956e-01f, -5.58680534e-01f,
  -5.04846215e-01f, 8.63209307e-01f, 3.80077004e-01f, 9.24954832e-01f, 7.87485182e-01f, 6.16333544e-01f, 9.31078374e-01f, 3.64819258e-01f,
  9.78030920e-01f, 2.08459899e-01f, 9.93035257e-01f, 1.17817394e-01f, 9.97795820e-01f, 6.63590282e-02f, 9.99302804e-01f, 3.73351872e-02f,
  9.99779522e-01f, 2.09984574e-02f, 9.99930263e-01f, 1.18088927e-02f, 9.99977946e-01f, 6.64073415e-03f, 9.99993026e-01f, 3.73437814e-03f,
  -9.99960840e-01f, -8.85130931e-03f, 9.81074572e-01f, -1.93630233e-01f, 7.81440377e-01f, 6.23979926e-01f, -7.17477441e-01f, -6.96581721e-01f,
  -5.88501155e-01f, 8.08496356e-01f, 3.27489585e-01f, 9.44854796e-01f, 7.67604589e-01f, 6.40923738e-01f, 9.24443960e-01f, 3.81317884e-01f,
  9.75897431e-01f, 2.18229622e-01f, 9.92357016e-01f, 1.23399742e-01f, 9.97581005e-01f, 6.95140064e-02f, 9.99234855e-01f, 3.91121693e-02f,
  9.99758005e-01f, 2.19982266e-02f, 9.99923468e-01f, 1.23711927e-02f, 9.99975801e-01f, 6.95695449e-03f, 9.99992371e-01f, 3.91220488e-03f,
  -5.32833040e-01f, -8.46220434e-01f, 9.33235765e-01f, 3.59264523e-01f, 5.48645258e-01f, 8.36055279e-01f, -5.82943261e-01f, -8.12512875e-01f,
  -6.66275978e-01f, 7.45705247e-01f, 2.73866832e-01f, 9.61767614e-01f, 7.46956408e-01f, 6.64873064e-01f, 9.17517304e-01f, 3.97695929e-01f,
  9.73666370e-01f, 2.27977514e-01f, 9.91647422e-01f, 1.28978193e-01f, 9.97356176e-01f, 7.26682767e-02f, 9.99163687e-01f, 4.08890247e-02f,
  9.99735534e-01f, 2.29979735e-02f, 9.99916375e-01f, 1.29334899e-02f, 9.99973536e-01f, 7.27317436e-03f, 9.99991655e-01f, 4.09003161e-03f,
  4.24179018e-01f, -9.05578375e-01f, 5.97977161e-01f, 8.01513135e-01f, 2.61441678e-01f, 9.65219259e-01f, -4.30023283e-01f, -9.02817786e-01f,
  -7.37393796e-01f, 6.75463140e-01f, 2.19378278e-01f, 9.75639880e-01f, 7.25561321e-01f, 6.88157499e-01f, 9.10300434e-01f, 4.13948208e-01f,
  9.71337974e-01f, 2.37702623e-01f, 9.90906477e-01f, 1.34552568e-01f, 9.97121394e-01f, 7.58218244e-02f, 9.99089420e-01f, 4.26657498e-02f,
  9.99711990e-01f, 2.39976961e-02f, 9.99908924e-01f, 1.34957815e-02f, 9.99971211e-01f, 7.58939330e-03f, 9.99990880e-01f, 4.26785741e-03f,
  9.91202831e-01f, -1.32351756e-01f, 7.85522610e-02f, 9.96909976e-01f, -5.16893305e-02f, 9.98663187e-01f, -2.63540596e-01f, -9.64648306e-01f,
  -8.01143587e-01f, 5.98472118e-01f, 1.64196163e-01f, 9.86427724e-01f, 7.03440726e-01f, 7.10753918e-01f, 9.02795732e-01f, 4.30069596e-01f,
  9.68912423e-01f, 2.47403964e-01f, 9.90134120e-01f, 1.40122697e-01f, 9.96876657e-01f, 7.89746121e-02f, 9.99011934e-01f, 4.44423407e-02f,
  9.99687493e-01f, 2.49973964e-02f, 9.99901175e-01f, 1.40580693e-02f, 9.99968767e-01f, 7.90561177e-03f, 9.99990106e-01f, 4.44568414e-03f,
  6.46919310e-01f, 7.62558460e-01f, -4.65064496e-01f, 8.85276794e-01f, -3.59694332e-01f, 9.33070183e-01f, -8.87455046e-02f, -9.96054351e-01f,
  -8.56888831e-01f, 5.15501261e-01f, 1.08494945e-01f, 9.94096994e-01f, 6.80616796e-01f, 7.32639611e-01f, 8.95005584e-01f, 4.46054995e-01f,
  9.66389954e-01f, 2.57080555e-01f, 9.89330530e-01f, 1.45688385e-01f, 9.96621907e-01f, 8.21266174e-02f, 9.98931348e-01f, 4.62187938e-02f,
  9.99662042e-01f, 2.59970706e-02f, 9.99893129e-01f, 1.46203535e-02f, 9.99966204e-01f, 8.22182931e-03f, 9.99989331e-01f, 4.62350994e-03f,
  -2.92138815e-01f, 9.56375957e-01f, -8.65450621e-01f, 5.00994205e-01f, -6.32028639e-01f, 7.74945021e-01f, 8.88481140e-02f, -9.96045172e-01f,
  -9.04072165e-01f, 4.27379847e-01f, 5.24506159e-02f, 9.98623490e-01f, 6.57112300e-01f, 7.53792703e-01f, 8.86932373e-01f, 4.61899310e-01f,
  9.63770926e-01f, 2.66731411e-01f, 9.88495648e-01f, 1.51249468e-01f, 9.96357203e-01f, 8.52777958e-02f, 9.98847544e-01f, 4.79951017e-02f,
  9.99635518e-01f, 2.69967206e-02f, 9.99884725e-01f, 1.51826320e-02f, 9.99963522e-01f, 8.53804592e-03f, 9.99988496e-01f, 4.80133574e-03f,
  -9.62605894e-01f, 2.70905793e-01f, -9.99293387e-01f, -3.75856608e-02f, -8.41684937e-01f, 5.39968967e-01f, 2.63639510e-01f, -9.64621305e-01f,
  -9.42222297e-01f, 3.34988207e-01f, -3.75941908e-03f, 9.99992907e-01f, 6.32950664e-01f, 7.74192095e-01f, 8.78578722e-01f, 4.77597594e-01f,
  9.61055458e-01f, 2.76355654e-01f, 9.87629473e-01f, 1.56805754e-01f, 9.96082544e-01f, 8.84281173e-02f, 9.98760641e-01f, 4.97712530e-02f,
  9.99608040e-01f, 2.79963426e-02f, 9.99876022e-01f, 1.57449059e-02f, 9.99960780e-01f, 8.85426160e-03f, 9.99987602e-01f, 4.97916201e-03f,
  -7.48057544e-01f, -6.63633883e-01f, -8.25371623e-01f, -5.64589798e-01f, -9.67871487e-01f, 2.51445323e-01f, 4.30115849e-01f, -9.02773678e-01f,
  -9.70958173e-01f, 2.39249229e-01f, -5.99575676e-02f, 9.98200953e-01f, 6.08156204e-01f, 7.93817401e-01f, 8.69947195e-01f, 4.93144840e-01f,
  9.58243906e-01f, 2.85952210e-01f, 9.86732066e-01f, 1.62357092e-01f, 9.95797932e-01f, 9.15775672e-02f, 9.98670578e-01f, 5.15472479e-02f,
  9.99579549e-01f, 2.89959367e-02f, 9.99867022e-01f, 1.63071752e-02f, 9.99957979e-01f, 9.17047635e-03f, 9.99986708e-01f, 5.15698735e-03f,
  1.54251456e-01f, -9.88031626e-01f, -3.97251874e-01f, -9.17709649e-01f, -9.98075247e-01f, -6.20148405e-02f, 5.83026946e-01f, -8.12452853e-01f,
  -9.89992499e-01f, 1.41120002e-01f, -1.15966164e-01f, 9.93253171e-01f, 5.82753658e-01f, 8.12648892e-01f, 8.61040652e-01f, 5.08536100e-01f,
  9.55336511e-01f, 2.95520186e-01f, 9.85803485e-01f, 1.67903304e-01f, 9.95503366e-01f, 9.47260931e-02f, 9.98577297e-01f, 5.33230826e-02f,
  9.99550045e-01f, 2.99955010e-02f, 9.99857724e-01f, 1.68694388e-02f, 9.99954998e-01f, 9.48669016e-03f, 9.99985754e-01f, 5.33481315e-03f,
  9.14742351e-01f, -4.04037654e-01f, 1.53215483e-01f, -9.88192797e-01f, -9.29300308e-01f, -3.69325012e-01f, 7.17549205e-01f, -6.96507812e-01f,
  -9.99135137e-01f, 4.15805206e-02f, -1.71608135e-01f, 9.85165298e-01f, 5.56768358e-01f, 8.30667794e-01f, 8.51861775e-01f, 5.23766637e-01f,
  9.52333570e-01f, 3.05058628e-01f, 9.84843671e-01f, 1.73444211e-01f, 9.95198846e-01f, 9.78736654e-02f, 9.98480916e-01f, 5.50987460e-02f,
  9.99519527e-01f, 3.09950355e-02f, 9.99848068e-01f, 1.74316969e-02f, 9.99951959e-01f, 9.80290305e-03f, 9.99984801e-01f, 5.51263802e-03f,
  8.34223390e-01f, 5.51426709e-01f, 6.56495154e-01f, -7.54330218e-01f, -7.68367112e-01f, -6.40009403e-01f, 8.29440355e-01f, -5.58595300e-01f,
  -9.98294771e-01f, -5.83741926e-02f, -2.26707578e-01f, 9.73962843e-01f, 5.30226350e-01f, 8.47856104e-01f, 8.42413545e-01f, 5.38831532e-01f,
  9.49235439e-01f, 3.14566553e-01f, 9.83852804e-01f, 1.78979620e-01f, 9.94884372e-01f, 1.01020269e-01f, 9.98381376e-01f, 5.68742342e-02f,
  9.99488056e-01f, 3.19945402e-02f, 9.99838114e-01f, 1.79939512e-02f, 9.99948800e-01f, 1.01191159e-02f, 9.99983788e-01f, 5.69046335e-03f,
  -1.32767474e-02f, 9.99911845e-01f, 9.57586050e-01f, -2.88147390e-01f, -5.31235278e-01f, -8.47224355e-01f, 9.15171385e-01f, -4.03064936e-01f,
  -9.87479806e-01f, -1.57745644e-01f, -2.81090319e-01f, 9.59681332e-01f, 5.03154159e-01f, 8.64196658e-01f, 8.32698941e-01f, 5.53726017e-01f,
  9.46042359e-01f, 3.24043006e-01f, 9.82830763e-01f, 1.84509367e-01f, 9.94559944e-01f, 1.04165860e-01f, 9.98278618e-01f, 5.86495437e-02f,
  9.99455571e-01f, 3.29940096e-02f, 9.99827802e-01f, 1.85561981e-02f, 9.99945521e-01f, 1.04353270e-02f, 9.99982774e-01f, 5.86828869e-03f,
  -8.48570287e-01f, 5.29082716e-01f, 9.63757515e-01f, 2.66779721e-01f, -2.41421118e-01f, -9.70420420e-01f, 9.72038329e-01f, -2.34822124e-01f,
  -9.66798186e-01f, -2.55541205e-01f, -3.34584385e-01f, 9.42365825e-01f, 4.75578904e-01f, 8.79673064e-01f, 8.22721004e-01f, 5.68445385e-01f,
  9.42754686e-01f, 3.33487093e-01f, 9.81777668e-01f, 1.90033287e-01f, 9.94225562e-01f, 1.07310407e-01f, 9.98172760e-01f, 6.04246669e-02f,
  9.99422073e-01f, 3.39934528e-02f, 9.99817252e-01f, 1.91184394e-02f, 9.99942183e-01f, 1.07515370e-02f, 9.99981701e-01f, 6.04611309e-03f,
  -9.03692186e-01f, -4.28182662e-01f, 6.73110247e-01f, 7.39542127e-01f, 7.23346695e-02f, -9.97380435e-01f, 9.98247743e-01f, -5.91726787e-02f,
  -9.36456680e-01f, -3.50783229e-01f, -3.87020677e-01f, 9.22071040e-01f, 4.47528064e-01f, 8.94269884e-01f, 8.12482953e-01f, 5.82984984e-01f,
  9.39372718e-01f, 3.42897803e-01f, 9.80693519e-01f, 1.95551202e-01f, 9.93881226e-01f, 1.10453881e-01f, 9.98063743e-01f, 6.21996038e-02f,
  9.99387562e-01f, 3.49928550e-02f, 9.99806345e-01f, 1.96806751e-02f, 9.99938726e-01f, 1.10677453e-02f, 9.99980628e-01f, 6.22393796e-03f,
  -1.27963692e-01f, -9.91778851e-01f, 1.75156534e-01f, 9.84540582e-01f, 3.78916174e-01f, -9.25431013e-01f, 9.92972851e-01f, 1.18342586e-01f,
  -8.96758378e-01f, -4.42520559e-01f, -4.38233554e-01f, 8.98861170e-01f, 4.19029742e-01f, 9.07972515e-01f, 8.01987886e-01f, 5.97340286e-01f,
  9.35896814e-01f, 3.52274209e-01f, 9.79578316e-01f, 2.01062918e-01f, 9.93526995e-01f, 1.13596253e-01f, 9.97951567e-01f, 6.39743358e-02f,
  9.99352098e-01f, 3.59922275e-02f, 9.99795079e-01f, 2.02429052e-02f, 9.99935210e-01f, 1.13839535e-02f, 9.99979496e-01f, 6.40176190e-03f,
  7.65414059e-01f, -6.43538117e-01f, -3.76742303e-01f, 9.26318109e-01f, 6.47921681e-01f, -7.61706948e-01f, 9.56380010e-01f, 2.92125374e-01f,
  -8.48100007e-01f, -5.29836178e-01f, -4.88060862e-01f, 8.72809589e-01f, 3.90112430e-01f, 9.20767248e-01f, 7.91239262e-01f, 6.11506701e-01f,
  9.32327330e-01f, 3.61615449e-01f, 9.78432178e-01f, 2.06568271e-01f, 9.93162811e-01f, 1.16737492e-01f, 9.97836173e-01f, 6.57488778e-02f,
  9.99315560e-01f, 3.69915590e-02f, 9.99783576e-01f, 2.08051261e-02f, 9.99931574e-01f, 1.17001599e-02f, 9.99978364e-01f, 6.57958630e-03f,
  9.55073655e-01f, 2.96368569e-01f, -8.12611222e-01f, 5.82806170e-01f, 8.52673113e-01f, -5.22444785e-01f, 8.89623463e-01f, 4.56694692e-01f,
  -7.90967762e-01f, -6.11857831e-01f, -5.36345184e-01f, 8.43998730e-01f, 3.60805035e-01f, 9.32641268e-01f, 7.80240417e-01f, 6.25479698e-01f,
  9.28664625e-01f, 3.70920479e-01f, 9.77255106e-01f, 2.12067112e-01f, 9.92788672e-01f, 1.19877554e-01f, 9.97717679e-01f, 6.75232038e-02f,
  9.99278069e-01f, 3.79908569e-02f, 9.99771714e-01f, 2.13673431e-02f, 9.99927819e-01f, 1.20163653e-02f, 9.99977171e-01f, 6.75741071e-03f,
  2.66642928e-01f, 9.63795364e-01f, -9.98210371e-01f, 5.98003156e-02f, 9.72865343e-01f, -2.31372014e-01f, 7.94808388e-01f, 6.06860459e-01f,
  -7.25932240e-01f, -6.87766254e-01f, -5.82933903e-01f, 8.12519610e-01f, 3.31136853e-01f, 9.43582714e-01f, 7.68994927e-01f, 6.39254928e-01f,
  9.24909055e-01f, 3.80188406e-01f, 9.76047099e-01f, 2.17559248e-01f, 9.92404640e-01f, 1.23016424e-01f, 9.97596025e-01f, 6.92973137e-02f,
  9.99239624e-01f, 3.89901139e-02f, 9.99759495e-01f, 2.19295528e-02f, 9.99923944e-01f, 1.23325698e-02f, 9.99975979e-01f, 6.93523418e-03f,
  -6.66938066e-01f, 7.45113134e-01f, -8.76379430e-01f, -4.81621295e-01f, 9.96578991e-01f, 8.26458037e-02f, 6.74925625e-01f, 7.37885714e-01f,
  -6.53643608e-01f, -7.56802499e-01f, -6.27679706e-01f, 7.78471708e-01f, 3.01137596e-01f, 9.53580678e-01f, 7.57506192e-01f, 6.52827978e-01f,
  9.21060979e-01f, 3.89418334e-01f, 9.74808276e-01f, 2.23044485e-01f, 9.92010653e-01f, 1.26154065e-01f, 9.97471273e-01f, 7.10712075e-02f,
  9.99200106e-01f, 3.99893373e-02f, 9.99747038e-01f, 2.24917568e-02f, 9.99920011e-01f, 1.26487734e-02f, 9.99974728e-01f, 7.11305765e-03f,
  -9.87339258e-01f, -1.58622667e-01f, -4.84639406e-01f, -8.74714017e-01f, 9.21462357e-01f, 3.88467699e-01f, 5.33756077e-01f, 8.45638454e-01f,
  -5.74824035e-01f, -8.18277061e-01f, -6.70441091e-01f, 7.41962790e-01f, 2.70837069e-01f, 9.62625206e-01f, 7.45777905e-01f, 6.66194677e-01f,
  9.17120814e-01f, 3.98609310e-01f, 9.73538578e-01f, 2.28522688e-01f, 9.91606772e-01f, 1.29290432e-01f, 9.97343302e-01f, 7.28448778e-02f,
  9.99159634e-01f, 4.09885161e-02f, 9.99734223e-01f, 2.30539497e-02f, 9.99915957e-01f, 1.29649751e-02f, 9.99973416e-01f, 7.29088066e-03f,
  -3.99985313e-01f, -9.16521549e-01f, 5.63609414e-02f, -9.98410463e-01f, 7.54965365e-01f, 6.55764699e-01f, 3.75752151e-01f, 9.26720202e-01f,
  -4.90260571e-01f, -8.71575892e-01f, -7.11082935e-01f, 7.03108132e-01f, 2.40265876e-01f, 9.70707119e-01f, 7.33813822e-01f, 6.79350674e-01f,
  9.13088918e-01f, 4.07760441e-01f, 9.72238123e-01f, 2.33993664e-01f, 9.91192937e-01f, 1.32425532e-01f, 9.97212172e-01f, 7.46183172e-02f,
  9.99118149e-01f, 4.19876575e-02f, 9.99721110e-01f, 2.36161388e-02f, 9.99911785e-01f, 1.32811759e-02f, 9.99972105e-01f, 7.46870413e-03f,
  5.55113316e-01f, -8.31774771e-01f, 5.80003142e-01f, -8.14614236e-01f, 5.13598442e-01f, 8.58030677e-01f, 2.05897167e-01f, 9.78573620e-01f,
  -4.00799006e-01f, -9.16166008e-01f, -7.49476731e-01f, 6.62030637e-01f, 2.09454417e-01f, 9.77818429e-01f, 7.21617639e-01f, 6.92291796e-01f,
  9.08965766e-01f, 4.16870773e-01f, 9.70906913e-01f, 2.39457220e-01f, 9.90769207e-01f, 1.35559291e-01f, 9.97077882e-01f, 7.63915181e-02f,
  9.99075651e-01f, 4.29867506e-02f, 9.99707639e-01f, 2.41783205e-02f, 9.99907553e-01f, 1.35973748e-02f, 9.99970794e-01f, 7.64652714e-03f,
  9.99843299e-01f, 1.77019257e-02f, 9.25014675e-01f, -3.79931390e-01f, 2.21298173e-01f, 9.75206196e-01f, 2.95478199e-02f, 9.99563396e-01f,
  -3.07332784e-01f, -9.51602101e-01f, -7.85501122e-01f, 6.18860185e-01f, 1.78433523e-01f, 9.83951986e-01f, 7.09193349e-01f, 7.05014050e-01f,
  9.04751658e-01f, 4.25939471e-01f, 9.69545007e-01f, 2.44913206e-01f, 9.90335584e-01f, 1.38691694e-01f, 9.96940494e-01f, 7.81644881e-02f,
  9.99032140e-01f, 4.39858064e-02f, 9.99693930e-01f, 2.47404929e-02f, 9.99903202e-01f, 1.39135728e-02f, 9.99969363e-01f, 7.82434922e-03f,
  5.25321960e-01f, 8.50903511e-01f, 9.85138178e-01f, 1.71763569e-01f, -9.29481089e-02f, 9.95670974e-01f, -1.47732988e-01f, 9.89027262e-01f,
  -2.10795805e-01f, -9.77530122e-01f, -8.19042206e-01f, 5.73733270e-01f, 1.47234216e-01f, 9.89101648e-01f, 6.96544766e-01f, 7.17513323e-01f,
  9.00447130e-01f, 4.34965521e-01f, 9.68152404e-01f, 2.50361472e-01f, 9.89892066e-01f, 1.41822711e-01f, 9.96799886e-01f, 7.99371973e-02f,
  9.98987675e-01f, 4.49848175e-02f, 9.99679863e-01f, 2.53026579e-02f, 9.99898732e-01f, 1.42297689e-02f, 9.99967992e-01f, 8.00217129e-03f,
  -4.32177931e-01f, 9.01788354e-01f, 7.41858006e-01f, 6.70557022e-01f, -3.97976756e-01f, 9.17395473e-01f, -3.20354372e-01f, 9.47297752e-01f,
  -1.12152621e-01f, -9.93690968e-01f, -8.49993885e-01f, 5.26792526e-01f, 1.15887694e-01f, 9.93262351e-01f, 6.83675885e-01f, 7.29785740e-01f,
  8.96052480e-01f, 4.43948090e-01f, 9.66729224e-01f, 2.55801797e-01f, 9.89438653e-01f, 1.44952312e-01f, 9.96656179e-01f, 8.17096606e-02f,
  9.98942196e-01f, 4.59837839e-02f, 9.99665439e-01f, 2.58648153e-02f, 9.99894202e-01f, 1.45459641e-02f, 9.99966562e-01f, 8.17999430e-03f,
  -9.92335498e-01f, 1.23573124e-01f, 2.70098448e-01f, 9.62832689e-01f, -6.63538277e-01f, 7.48142362e-01f, -4.82871950e-01f, 8.75690997e-01f,
  -1.23883775e-02f, -9.99923289e-01f, -8.78258407e-01f, 4.78186339e-01f, 8.44252855e-02f, 9.96429801e-01f, 6.70590878e-01f, 7.41827428e-01f,
  8.91568303e-01f, 4.52886283e-01f, 9.65275466e-01f, 2.61234075e-01f, 9.88975346e-01f, 1.48080453e-01f, 9.96509314e-01f, 8.34818557e-02f,
  9.98895705e-01f, 4.69827019e-02f, 9.99650776e-01f, 2.64269635e-02f, 9.99889553e-01f, 1.48621574e-02f, 9.99965072e-01f, 8.35781638e-03f,
  -6.40144348e-01f, -7.68254638e-01f, -2.84846604e-01f, 9.58573103e-01f, -8.63296509e-01f, 5.04697084e-01f, -6.30159974e-01f, 7.76465356e-01f,
  8.74991715e-02f, -9.96164620e-01f, -9.03746367e-01f, 4.28068399e-01f, 5.28784581e-02f, 9.98600960e-01f, 6.57293737e-01f, 7.53634512e-01f,
  8.86994898e-01f, 4.61779177e-01f, 9.63791192e-01f, 2.66658038e-01f, 9.88502085e-01f, 1.51207119e-01f, 9.96359289e-01f, 8.52537975e-02f,
  9.98848200e-01f, 4.79815714e-02f, 9.99635756e-01f, 2.69891042e-02f, 9.99884784e-01f, 1.51783489e-02f, 9.99963582e-01f, 8.53563752e-03f,
  3.00592542e-01f, -9.53752637e-01f, -7.52063990e-01f, 6.59090102e-01f, -9.77442741e-01f, 2.11200655e-01f, -7.57573068e-01f, 6.52750373e-01f,
  1.86512470e-01f, -9.82452571e-01f, -9.26377118e-01f, 3.76597136e-01f, 2.12787576e-02f, 9.99773562e-01f, 6.43788815e-01f, 7.65203178e-01f,
  8.82332861e-01f, 4.70625877e-01f, 9.62276459e-01f, 2.72073567e-01f, 9.88018990e-01f, 1.54332280e-01f, 9.96206105e-01f, 8.70254710e-02f,
  9.98799741e-01f, 4.89803962e-02f, 9.99620378e-01f, 2.75512375e-02f, 9.99879956e-01f, 1.54945394e-02f, 9.99962032e-01f, 8.71345960e-03f,
  9.64965999e-01f, -2.62374848e-01f, -9.87659097e-01f, 1.56619072e-01f, -9.94656444e-01f, -1.03240460e-01f, -8.61092687e-01f, 5.08447945e-01f,
  2.83662200e-01f, -9.58924294e-01f, -9.46079254e-01f, 3.23935270e-01f, -1.03422189e-02f, 9.99946535e-01f, 6.30080283e-01f, 7.76529968e-01f,
  8.77582550e-01f, 4.79425550e-01f, 9.60731268e-01f, 2.77480543e-01f, 9.87526000e-01f, 1.57455891e-01f, 9.96049762e-01f, 8.87968615e-02f,
  9.98750269e-01f, 4.99791689e-02f, 9.99604762e-01f, 2.81133596e-02f, 9.99875009e-01f, 1.58107281e-02f, 9.99960482e-01f, 8.89127981e-03f,
  7.42154181e-01f, 6.70229197e-01f, -9.19073522e-01f, -3.94086063e-01f, -9.13230121e-01f, -4.07444149e-01f, -9.37454224e-01f, 3.48108500e-01f,
  3.77977669e-01f, -9.25814748e-01f, -9.62790370e-01f, 2.70249337e-01f, -4.19528559e-02f, 9.99119580e-01f, 6.16172493e-01f, 7.87611187e-01f,
  8.72744501e-01f, 4.88177240e-01f, 9.59155679e-01f, 2.82878697e-01f, 9.87023175e-01f, 1.60577938e-01f, 9.95890260e-01f, 9.05679762e-02f,
  9.98699784e-01f, 5.09778969e-02f, 9.99588788e-01f, 2.86754742e-02f, 9.99869943e-01f, 1.61269177e-02f, 9.99958873e-01f, 9.06910095e-03f,
  -1.62990779e-01f, 9.86627579e-01f, -5.67430019e-01f, -8.23421597e-01f, -7.41239965e-01f, -6.71240151e-01f, -9.84248459e-01f, 1.76790684e-01f,
  4.68516916e-01f, -8.83454502e-01f, -9.76457715e-01f, 2.15709001e-01f, -7.35215396e-02f, 9.97293651e-01f, 6.02069914e-01f, 7.98443377e-01f,
  8.67819190e-01f, 4.96880114e-01f, 9.57549810e-01f, 2.88267940e-01f, 9.86510456e-01f, 1.63698375e-01f, 9.95727658e-01f, 9.23388004e-02f,
  9.98648286e-01f, 5.19765690e-02f, 9.99572515e-01f, 2.92375814e-02f, 9.99864817e-01f, 1.64431017e-02f, 9.99957263e-01f, 9.24692024e-03f,
  -9.18282807e-01f, 3.95925164e-01f, -4.10281904e-02f, -9.99157965e-01f, -4.95741814e-01f, -8.68469954e-01f, -1.00000000e+00f, -1.03020677e-04f,
  5.54374516e-01f, -8.32267344e-01f, -9.87038016e-01f, 1.60486728e-01f, -1.05016708e-01f, 9.94470477e-01f, 5.87776959e-01f, 8.09023023e-01f,
  8.62807095e-01f, 5.05533338e-01f, 9.55913603e-01f, 2.93648034e-01f, 9.85987842e-01f, 1.66817173e-01f, 9.95561838e-01f, 9.41093415e-02f,
  9.98595834e-01f, 5.29751927e-02f, 9.99555886e-01f, 2.97996756e-02f, 9.99859571e-01f, 1.67592876e-02f, 9.99955595e-01f, 9.42474138e-03f,
  -8.29309821e-01f, -5.58789074e-01f, 4.98009592e-01f, -8.67171526e-01f, -2.01079622e-01f, -9.79574919e-01f, -9.84212041e-01f, -1.76993474e-01f,
  6.34692967e-01f, -7.72764444e-01f, -9.94497895e-01f, 1.04756832e-01f, -1.36406869e-01f, 9.90652919e-01f, 5.73298037e-01f, 8.19346905e-01f,
  8.57708693e-01f, 5.14135957e-01f, 9.54247177e-01f, 2.99018890e-01f, 9.85455394e-01f, 1.69934288e-01f, 9.95392919e-01f, 9.58795771e-02f,
  9.98542368e-01f, 5.39737605e-02f, 9.99538958e-01f, 3.03617641e-02f, 9.99854207e-01f, 1.70754679e-02f, 9.99953866e-01f, 9.60256159e-03f,
  2.21267566e-02f, -9.99755144e-01f, 8.83669317e-01f, -4.68111664e-01f, 1.13521777e-01f, -9.93535519e-01f, -9.37382519e-01f, -3.48301649e-01f,
  7.08669782e-01f, -7.05540299e-01f, -9.98813629e-01f, 4.86960001e-02f, -1.67660639e-01f, 9.85844791e-01f, 5.58637917e-01f, 8.29411685e-01f,
  8.52524519e-01f, 5.22687256e-01f, 9.52550590e-01f, 3.04380238e-01f, 9.84913111e-01f, 1.73049718e-01f, 9.95220840e-01f, 9.76495072e-02f,
  9.98487890e-01f, 5.49722798e-02f, 9.99521732e-01f, 3.09238415e-02f, 9.99848783e-01f, 1.73916500e-02f, 9.99952197e-01f, 9.78038087e-03f,
  8.53220105e-01f, -5.21551013e-01f, 9.97174621e-01f, 7.51182064e-02f, 4.16867077e-01f, -9.08967435e-01f, -8.60988438e-01f, -5.08624554e-01f,
  7.75565803e-01f, -6.31266713e-01f, -9.99971747e-01f, -7.51878507e-03f, -1.98746875e-01f, 9.80050862e-01f, 5.43801069e-01f, 8.39214146e-01f,
  8.47255111e-01f, 5.31186223e-01f, 9.50823903e-01f, 3.09731960e-01f, 9.84360933e-01f, 1.76163420e-01f, 9.95045662e-01f, 9.94191393e-02f,
  9.98432398e-01f, 5.59707358e-02f, 9.99504209e-01f, 3.14859077e-02f, 9.99843180e-01f, 1.77078284e-02f, 9.99950409e-01f, 9.95820016e-03f,
  8.99866819e-01f, 4.36164767e-01f, 8.03569078e-01f, 5.95211506e-01f, 6.78870201e-01f, -7.34258294e-01f, -7.57439196e-01f, -6.52905703e-01f,
  8.34712923e-01f, -5.50685287e-01f, -9.97968495e-01f, -6.37097955e-02f, -2.29634270e-01f, 9.73276973e-01f, 5.28792322e-01f, 8.48751247e-01f,
  8.41901004e-01f, 5.39632022e-01f, 9.49067116e-01f, 3.15073937e-01f, 9.83798921e-01f, 1.79275364e-01f, 9.94867265e-01f, 1.01188451e-01f,
  9.98375952e-01f, 5.69691435e-02f, 9.99486327e-01f, 3.20479684e-02f, 9.99837577e-01f, 1.80240069e-02f, 9.99948621e-01f, 1.01360194e-02f,
  1.19180135e-01f, 9.92872655e-01f, 3.62476677e-01f, 9.31992829e-01f, 8.73550534e-01f, -4.86733496e-01f, -6.30000710e-01f, -7.76594579e-01f,
  8.85519624e-01f, -4.64602023e-01f, -9.92810190e-01f, -1.19699396e-01f, -2.60292053e-01f, 9.65529919e-01f, 5.13616323e-01f, 8.58020008e-01f,
  8.36462677e-01f, 5.48023939e-01f, 9.47280347e-01f, 3.20405900e-01f, 9.83227074e-01f, 1.82385504e-01f, 9.94685769e-01f, 1.02957435e-01f,
  9.98318493e-01f, 5.79674877e-02f, 9.99468148e-01f, 3.26100141e-02f, 9.99831796e-01f, 1.83401816e-02f, 9.99946833e-01f, 1.03138378e-02f,
  -7.71080196e-01f, 6.36738002e-01f, -1.90249100e-01f, 9.81735826e-01f, 9.81602073e-01f, -1.90938011e-01f, -4.82692331e-01f, -8.75790000e-01f,
  9.27478492e-01f, -3.73876572e-01f, -9.84513164e-01f, -1.75310582e-01f, -2.90689558e-01f, 9.56817448e-01f, 4.98277903e-01f, 8.67017388e-01f,
  8.30940723e-01f, 5.56361020e-01f, 9.45463598e-01f, 3.25727791e-01f, 9.82645452e-01f, 1.85493827e-01f, 9.94501114e-01f, 1.04726106e-01f,
  9.98260021e-01f, 5.89657798e-02f, 9.99449670e-01f, 3.31720486e-02f, 9.99825954e-01f, 1.86563563e-02f, 9.99944985e-01f, 1.04916561e-02f,
  -9.52412963e-01f, -3.04810613e-01f, -6.84381902e-01f, 7.29123712e-01f, 9.92308319e-01f, 1.23790950e-01f, -3.20159167e-01f, -9.47363734e-01f,
  9.60170269e-01f, -2.79415488e-01f, -9.73103702e-01f, -2.30367512e-01f, -3.20796400e-01f, 9.47148204e-01f, 4.82782036e-01f, 8.75740528e-01f,
  8.25335622e-01f, 5.64642429e-01f, 9.43616986e-01f, 3.31039310e-01f, 9.82053936e-01f, 1.88600287e-01f, 9.94313300e-01f, 1.06494442e-01f,
  9.98200536e-01f, 5.99640086e-02f, 9.99430835e-01f, 3.37340795e-02f, 9.99819994e-01f, 1.89725272e-02f, 9.99943078e-01f, 1.06694745e-02f,
  -2.58101642e-01f, -9.66117799e-01f, -9.67739642e-01f, 2.51952261e-01f, 9.04607594e-01f, 4.26245421e-01f, -1.47529200e-01f, -9.89057720e-01f,
  9.83268440e-01f, -1.82162598e-01f, -9.58617806e-01f, -2.84696162e-01f, -3.50582451e-01f, 9.36531842e-01f, 4.67133403e-01f, 8.84186864e-01f,
  8.19648027e-01f, 5.72867453e-01f, 9.41740453e-01f, 3.36340427e-01f, 9.81452644e-01f, 1.91704854e-01f, 9.94122326e-01f, 1.08262435e-01f,
  9.98140097e-01f, 6.09621815e-02f, 9.99411702e-01f, 3.42960916e-02f, 9.99813974e-01f, 1.92886982e-02f, 9.99941170e-01f, 1.08472919e-02f,
  6.73507154e-01f, -7.39180684e-01f, -9.53050017e-01f, -3.02812874e-01f, 7.27198064e-01f, 6.86427653e-01f, 2.97537707e-02f, -9.99557257e-01f,
  9.96542096e-01f, -8.30891207e-02f, -9.41101313e-01f, -3.38124752e-01f, -3.80017966e-01f, 9.24979091e-01f, 4.51337039e-01f, 8.92353535e-01f,
  8.13878477e-01f, 5.81035137e-01f, 9.39834237e-01f, 3.41630876e-01f, 9.80841517e-01f, 1.94807529e-01f, 9.93928254e-01f, 1.10030092e-01f,
  9.98078644e-01f, 6.19602874e-02f, 9.99392271e-01f, 3.48580964e-02f, 9.99807835e-01f, 1.96048655e-02f, 9.99939203e-01f, 1.10251084e-02f,
  9.85896587e-01f, 1.67355701e-01f, -6.44837022e-01f, -7.64320076e-01f, 4.77671444e-01f, 8.78538549e-01f, 2.06098333e-01f, -9.78531301e-01f,
  9.99858618e-01f, 1.68140903e-02f, -9.20609534e-01f, -3.90484393e-01f, -4.09073502e-01f, 9.12501454e-01f, 4.35397953e-01f, 9.00238097e-01f,
  8.08027506e-01f, 5.89144766e-01f, 9.37898219e-01f, 3.46910536e-01f, 9.80220556e-01f, 1.97908238e-01f, 9.93731022e-01f, 1.11797392e-01f,
  9.98016179e-01f, 6.29583374e-02f, 9.99372482e-01f, 3.54200937e-02f, 9.99801576e-01f, 1.99210308e-02f, 9.99937236e-01f, 1.12029258e-02f,
};

constexpr int T_ALL = 36864, T_CTX = 4096;
constexpr int NLAYER = 4;
constexpr float EPS = 1e-6f;
constexpr int LK_LAT = 4352;

struct Params {
  const float* x_prompt; const float* x_sample; const float* cache_ckv; const float* cache_krope;
  const float* cache_k; const float* cache_v; const float* state; const float* c; const float* c_ctx;
  const float* w_mod; const float* b_mod; const float* g_norm; const float* w_in; const float* conv_w; const float* conv_b;
  const float* lru_wa; const float* lru_ba; const float* lru_wi; const float* lru_bi; const float* lru_lam;
  const float* q_norm; const float* w_uq; const float* kv_norm; const float* w_ukv; const float* sink;
  const float* w_br_rnn; const float* w_br_mla; const float* w_br_swa; const float* w_out; const float* final_norm;
  float* out; char* ws;
};

constexpr size_t AL(size_t x) { return (x + 255) & ~(size_t)255; }
constexpr size_t O_WINA = 0;
constexpr size_t O_WINB = O_WINA + AL((size_t)2560 * 1024 * 2);
constexpr size_t O_WLRU = O_WINB + AL((size_t)5120 * 1024 * 2);
constexpr size_t O_WUQ = O_WLRU + AL((size_t)4096 * 128 * 2);
constexpr size_t O_WUKVG = O_WUQ + AL((size_t)768 * 384 * 2);
constexpr size_t O_WUKVR = O_WUKVG + AL((size_t)1024 * 256 * 2);
constexpr size_t O_WBRR = O_WUKVR + AL((size_t)1024 * 256 * 2);
constexpr size_t O_WBRM = O_WBRR + AL((size_t)1024 * 1024 * 2);
constexpr size_t O_WBRS = O_WBRM + AL((size_t)1024 * 512 * 2);
constexpr size_t O_WOUT = O_WBRS + AL((size_t)1024 * 512 * 2);
constexpr size_t O_MOD = O_WOUT + AL((size_t)1024 * 1024 * 2);
constexpr size_t O_H = O_MOD + AL((size_t)4 * 9 * 3072 * 4);
constexpr size_t O_XR = O_H + AL((size_t)T_ALL * 1024 * 2);
constexpr size_t O_CQ = O_XR + AL((size_t)T_ALL * 1024 * 2);
constexpr size_t O_CKV = O_CQ + AL((size_t)T_ALL * 384 * 2);
constexpr size_t O_CKVC = O_CKV + AL((size_t)T_ALL * 256 * 2);
constexpr size_t O_KRL = O_CKVC + AL((size_t)2048 * 256 * 2);
constexpr size_t O_KRC = O_KRL + AL((size_t)8 * LK_LAT * 32 * 2);
constexpr size_t O_QS = O_KRC + AL((size_t)16 * 256 * 32 * 2);
constexpr size_t O_KS = O_QS + AL((size_t)T_ALL * 512 * 2);
constexpr size_t O_KSC = O_KS + AL((size_t)T_ALL * 128 * 2);
constexpr size_t O_VTSL = O_KSC + AL((size_t)8 * 256 * 128 * 2);
constexpr size_t O_VTSC = O_VTSL + AL((size_t)8 * 2 * 64 * 4096 * 2);
constexpr size_t O_VTSCC = O_VTSC + AL((size_t)16 * 2 * 64 * 256 * 2);
constexpr size_t O_Q = O_VTSCC + AL((size_t)8 * 2 * 64 * 256 * 2);
constexpr size_t O_KNL = O_Q + AL((size_t)T_ALL * 768 * 2);
constexpr size_t O_KNC = O_KNL + AL((size_t)8 * 8 * LK_LAT * 64 * 2);
constexpr size_t O_VTL = O_KNC + AL((size_t)16 * 8 * 256 * 64 * 2);
constexpr size_t O_VTC = O_VTL + AL((size_t)8 * 8 * 64 * LK_LAT * 2);
constexpr size_t O_YRNN = O_VTC + AL((size_t)16 * 8 * 64 * 256 * 2);
static_assert(O_YRNN - O_KS >= (size_t)2 * T_ALL * 1024 * 2, "merge-gate buffers do not fit");
constexpr size_t O_SUM = O_YRNN + AL((size_t)T_ALL * 1024 * 2);
constexpr size_t WS_NEED = O_SUM + AL((size_t)8 * 8 * 2 * 16 * 256 * 4);

constexpr size_t OUT_CKV = (size_t)T_ALL * 1024;
constexpr size_t OUT_KROPE = OUT_CKV + (size_t)16 * 4 * 256 * 256;
constexpr size_t OUT_SK = OUT_KROPE + (size_t)16 * 4 * 256 * 32;
constexpr size_t OUT_SV = OUT_SK + (size_t)16 * 4 * 256 * 128;
constexpr size_t OUT_RG = OUT_SV + (size_t)16 * 4 * 256 * 128;

#define SB() __builtin_amdgcn_sched_barrier(0)
#define MB() asm volatile("" ::: "memory")
DI int tid() { int t = threadIdx.x; asm volatile("" : "+v"(t)); return t; }
DI int xcd_map(int base) {
  const int g = gridDim.x;
  if (g & 7) return base + blockIdx.x;
  return base + (blockIdx.x & 7) * (g >> 3) + (blockIdx.x >> 3);
}
#define LANEVARS const int t = tid(), lane = t & 63, w = t >> 6, wr = w >> 1, wc = w & 1; const int c16 = lane & 15, g4 = lane >> 4; (void)wr; (void)wc; (void)c16; (void)g4;
DI float bf2f(u16 v) { return __uint_as_float(((unsigned)v) << 16); }
DI unsigned pack2(float a, float b) {
  f2_t v = {a, b};
  bf2_t r = __builtin_convertvector(v, bf2_t);
  return __builtin_bit_cast(unsigned, r);
}
DI u16 f2bf(float a) { return (u16)(pack2(a, 0.f) & 0xffffu); }
DI float sigmoidf_(float x) { return 1.f / (1.f + __expf(-x)); }
DI float wave_sum(float v) {
#pragma unroll
  for (int o = 32; o > 0; o >>= 1) v += __shfl_xor(v, o);
  return v;
}
DI int perm32(int p) { return (p & 7) | ((p & 8) << 1) | ((p & 16) >> 1); }
DI const float* xin_row(const Params& p, int l, int row) {
  if (l == 0) return row < T_CTX ? p.x_prompt + (size_t)row * 1024 : p.x_sample + (size_t)(row - T_CTX) * 1024;
  return p.out + (size_t)row * 1024;
}
template <class T> DI T* wsp(const Params& p, size_t off) { return (T*)(p.ws + off); }

template <int NJ>
DI void gemm_tile_t(const u16* A, int lda, const u16* B, int ldb, int K,
                    f32x4 (&acc)[4][NJ], char* smem) {
  const int t = tid(), lane = t & 63, w = t >> 6, wr = w >> 1, wc = w & 1;
  const int lr = t >> 3, slot = t & 7;
  const int c16 = lane & 15, g4 = lane >> 4;
  const int gch = slot ^ ((lr >> 1) & 7);
  const u16* ap = A + (size_t)lr * lda + gch * 8;
  const u16* bp = B + (size_t)lr * ldb + gch * 8;
  char* sdst = smem + t * 16;
#define DMA16(gp, lp) __builtin_amdgcn_global_load_lds((const unsigned*)(gp), (unsigned*)(lp), 16, 0, 0)
#define STAGE(base, ko) { DMA16(ap + (ko), (base)); DMA16(ap + (size_t)32 * lda + (ko), (base) + 4096); \
    DMA16(ap + (size_t)64 * lda + (ko), (base) + 8192); DMA16(ap + (size_t)96 * lda + (ko), (base) + 12288); \
    DMA16(bp + (ko), (base) + 16384); DMA16(bp + (size_t)32 * ldb + (ko), (base) + 16384 + 4096); \
    if (NJ > 2) { DMA16(bp + (size_t)64 * ldb + (ko), (base) + 16384 + 8192); DMA16(bp + (size_t)96 * ldb + (ko), (base) + 16384 + 12288); } }
  const int nk = K >> 6;
  const int arow = (wr * 64 + c16) * 128, brow = (wc * (16 * NJ) + c16) * 128;
  const int sw = (c16 >> 1) & 7;
  int kk = (int)((blockIdx.x * 5u + (blockIdx.x >> 3)) % (unsigned)nk);
  STAGE(sdst, kk * 64)
  __syncthreads();
  for (int kt = 0; kt < nk; ++kt) {
    char* cur = smem + (kt & 1) * 32768;
    kk = (kk + 1 == nk) ? 0 : kk + 1;
    if (kt + 1 < nk) { char* nxt = sdst + ((kt + 1) & 1) * 32768; STAGE(nxt, kk * 64) }
#pragma unroll
    for (int ks = 0; ks < 2; ++ks) {
      bf16x8 af[4], bfr[NJ];
      const int ch = ((ks * 4 + g4) ^ sw) << 4;
#pragma unroll
      for (int i = 0; i < 4; ++i) af[i] = *(const bf16x8*)(cur + arow + i * 2048 + ch);
#pragma unroll
      for (int i = 0; i < NJ; ++i) bfr[i] = *(const bf16x8*)(cur + 16384 + brow + i * 2048 + ch);
#pragma unroll
      for (int i = 0; i < 4; ++i)
#pragma unroll
        for (int j = 0; j < NJ; ++j)
          acc[i][j] = __builtin_amdgcn_mfma_f32_16x16x32_bf16(af[i], bfr[j], acc[i][j], 0, 0, 0);
    }
    __syncthreads();
  }
#undef STAGE
#undef DMA16
}
DI void gemm_tile(const u16* A, int lda, const u16* B, int ldb, int K,
                  f32x4 (&acc)[4][4], char* smem) {
  gemm_tile_t<4>(A, lda, B, ldb, K, acc, smem);
}
DI void zero_acc(f32x4 (&acc)[4][4]) {
#pragma unroll
  for (int i = 0; i < 4; ++i)
#pragma unroll
    for (int j = 0; j < 4; ++j) acc[i][j] = f32x4{0.f, 0.f, 0.f, 0.f};
}

struct TokTile { int g0; int is_ctx; int b; int p0; };
DI TokTile tok_tile(int mt) {
  TokTile r; r.g0 = mt * 128;
  if (r.g0 < T_CTX) { r.is_ctx = 1; r.b = r.g0 >> 8; r.p0 = r.g0 & 255; }
  else { r.is_ctx = 0; r.b = (r.g0 - T_CTX) >> 12; r.p0 = (r.g0 - T_CTX) & 4095; }
  return r;
}

DI void phase_mod(const Params& p, char* smem) {
  float* s_silu = (float*)smem;
  float* s_part = (float*)(smem + 36864);
  float* MOD = wsp<float>(p, O_MOD);
  const int t = tid();
  for (int i = t; i < 9 * 1024; i += 256) {
    float v = (i < 8192) ? p.c[i] : p.c_ctx[i - 8192];
    s_silu[i] = v * sigmoidf_(v);
  }
  __syncthreads();
  const int kg = t >> 6, cl = t & 63;
  for (int u = blockIdx.x; u < 4 * 48; u += gridDim.x) {
    const int l = u / 48, cb = u % 48;
    const int n = cb * 64 + cl;
    float acc[9];
#pragma unroll
    for (int ci = 0; ci < 9; ++ci) acc[ci] = 0.f;
    const float* wp = p.w_mod + ((size_t)l * 1024 + kg * 256) * 3072 + n;
    for (int k = 0; k < 256; ++k) {
      float wv = wp[(size_t)k * 3072];
#pragma unroll
      for (int ci = 0; ci < 9; ++ci) acc[ci] += s_silu[ci * 1024 + kg * 256 + k] * wv;
    }
#pragma unroll
    for (int ci = 0; ci < 9; ++ci) s_part[(kg * 9 + ci) * 64 + cl] = acc[ci];
    __syncthreads();
    for (int idx = t; idx < 9 * 64; idx += 256) {
      int ci = idx >> 6, c2 = idx & 63;
      float s = s_part[(0 * 9 + ci) * 64 + c2] + s_part[(1 * 9 + ci) * 64 + c2] + s_part[(2 * 9 + ci) * 64 + c2] +
                s_part[(3 * 9 + ci) * 64 + c2];
      MOD[((size_t)l * 9 + ci) * 3072 + cb * 64 + c2] = s + p.b_mod[l * 3072 + cb * 64 + c2];
    }
    __syncthreads();
  }
}

template <class F> DI void conv_job(u16* dst, int N, int K, F src) {
  const int total = N * (K >> 3);
  for (int idx = blockIdx.x * 256 + tid(); idx < total; idx += gridDim.x * 256) {
    const int n = idx % N, kb = idx / N;
    float v[8];
#pragma unroll
    for (int j = 0; j < 8; ++j) v[j] = src(kb * 8 + j, n);
    uint4 o;
    o.x = pack2(v[0], v[1]); o.y = pack2(v[2], v[3]); o.z = pack2(v[4], v[5]); o.w = pack2(v[6], v[7]);
    *(uint4*)(dst + (size_t)n * K + kb * 8) = o;
  }
}

DI void phase_prep(const Params& p, int l) {
  const int t = tid(), lane = t & 63, w = t >> 6;
  const float* MOD = wsp<float>(p, O_MOD) + (size_t)l * 9 * 3072;
  u16* H = wsp<u16>(p, O_H);
  for (int row = blockIdx.x * 4 + w; row < T_ALL; row += gridDim.x * 4) {
    const float* x = xin_row(p, l, row);
    const int ci = row < T_CTX ? 8 : ((row - T_CTX) >> 12);
    const float* md = MOD + ci * 3072;
    float4 v[4];
    float ss = 0.f;
#pragma unroll
    for (int i = 0; i < 4; ++i) {
      v[i] = *(const float4*)(x + i * 256 + lane * 4);
      ss += v[i].x * v[i].x + v[i].y * v[i].y + v[i].z * v[i].z + v[i].w * v[i].w;
    }
    ss = wave_sum(ss);
    const float rs = rsqrtf(ss * (1.f / 1024.f) + EPS);
#pragma unroll
    for (int i = 0; i < 4; ++i) {
      const int c = i * 256 + lane * 4;
      const float4 g = *(const float4*)(p.g_norm + l * 1024 + c);
      const float4 sh = *(const float4*)(md + c);
      const float4 sc = *(const float4*)(md + 1024 + c);
      float h0 = v[i].x * rs * g.x * (1.f + sc.x) + sh.x;
      float h1 = v[i].y * rs * g.y * (1.f + sc.y) + sh.y;
      float h2 = v[i].z * rs * g.z * (1.f + sc.z) + sh.z;
      float h3 = v[i].w * rs * g.w * (1.f + sc.w) + sh.w;
      uint2 o; o.x = pack2(h0, h1); o.y = pack2(h2, h3);
      *(uint2*)(H + (size_t)row * 1024 + c) = o;
    }
  }
  {
    const float* win = p.w_in + (size_t)l * 1024 * 7584;
    conv_job(wsp<u16>(p, O_WINA), 2560, 1024, [&](int k, int n) -> float {
      int col;
      if (n < 1024) col = n;
      else if (n < 1408) col = 2048 + (n - 1024);
      else if (n < 1664) col = 2432 + (n - 1408);
      else if (n < 1792) { int pp = n - 1664; col = pp < 32 ? 2688 + perm32(pp) : -1; }
      else if (n < 2304) col = 3232 + (n - 1792);
      else if (n < 2432) col = 3744 + (n - 2304);
      else col = 3872 + (n - 2432);
      return col < 0 ? 0.f : win[(size_t)k * 7584 + col];
    });
    conv_job(wsp<u16>(p, O_WINB), 5120, 1024, [&](int k, int n) -> float {
      int col;
      if (n < 1024) col = 1024 + n;
      else if (n < 1536) col = 2720 + (n - 1024);
      else if (n < 2048) col = 4000 + (n - 1536);
      else col = 4512 + (n - 2048);
      return win[(size_t)k * 7584 + col];
    });
    const float* wa = p.lru_wa + (size_t)l * 2 * 8 * 128 * 128;
    const float* wi = p.lru_wi + (size_t)l * 2 * 8 * 128 * 128;
    conv_job(wsp<u16>(p, O_WLRU), 4096, 128, [&](int k, int n) -> float {
      int db = n >> 8, nn = n & 255;
      return nn < 128 ? wa[((size_t)db * 128 + k) * 128 + nn] : wi[((size_t)db * 128 + k) * 128 + (nn - 128)];
    });
    const float* wuq = p.w_uq + (size_t)l * 384 * 768;
    const float* gq = p.q_norm + l * 384;
    conv_job(wsp<u16>(p, O_WUQ), 768, 384, [&](int k, int n) -> float {
      int col;
      if (n < 512) col = (n >> 6) * 96 + (n & 63);
      else { int hh = (n - 512) >> 5, pp = (n - 512) & 31; col = hh * 96 + 64 + perm32(pp); }
      return gq[k] * wuq[(size_t)k * 768 + col];
    });
    const float* wukv = p.w_ukv + (size_t)l * 256 * 1024;
    const float* gkv = p.kv_norm + l * 256;
    conv_job(wsp<u16>(p, O_WUKVG), 1024, 256, [&](int k, int n) -> float { return gkv[k] * wukv[(size_t)k * 1024 + n]; });
    conv_job(wsp<u16>(p, O_WUKVR), 1024, 256, [&](int k, int n) -> float { return wukv[(size_t)k * 1024 + n]; });
    const float* w1 = p.w_br_rnn + (size_t)l * 1024 * 1024;
    conv_job(wsp<u16>(p, O_WBRR), 1024, 1024, [&](int k, int n) -> float { return w1[(size_t)k * 1024 + n]; });
    const float* w2 = p.w_br_mla + (size_t)l * 512 * 1024;
    conv_job(wsp<u16>(p, O_WBRM), 1024, 512, [&](int k, int n) -> float { return w2[(size_t)k * 1024 + n]; });
    const float* w3 = p.w_br_swa + (size_t)l * 512 * 1024;
    conv_job(wsp<u16>(p, O_WBRS), 1024, 512, [&](int k, int n) -> float { return w3[(size_t)k * 1024 + n]; });
    const float* w4 = p.w_out + (size_t)l * 1024 * 1024;
    conv_job(wsp<u16>(p, O_WOUT), 1024, 1024, [&](int k, int n) -> float { return w4[(size_t)k * 1024 + n]; });
  }
  {
    const int gt = blockIdx.x * 256 + t, gs = gridDim.x * 256;
    u16* ckvc = wsp<u16>(p, O_CKVC);
    for (int i = gt; i < 2048 * 256; i += gs) {
      int r = i >> 8, k = i & 255, b = r >> 8, pos = r & 255;
      ckvc[i] = f2bf(p.cache_ckv[(((size_t)b * 4 + l) * 256 + pos) * 256 + k]);
    }
    u16* krl = wsp<u16>(p, O_KRL);
    for (int i = gt; i < 8 * 256 * 32; i += gs) {
      int pp = i & 31, pos = (i >> 5) & 255, b = i >> 13;
      krl[((size_t)b * LK_LAT + pos) * 32 + pp] = f2bf(p.cache_krope[(((size_t)b * 4 + l) * 256 + pos) * 32 + perm32(pp)]);
    }
    u16* ksc = wsp<u16>(p, O_KSC);
    for (int i = gt; i < 8 * 256 * 128; i += gs) {
      int c = i & 127, pos = (i >> 7) & 255, b = i >> 15;
      ksc[i] = f2bf(p.cache_k[(((size_t)b * 4 + l) * 256 + pos) * 128 + c]);
    }
    u16* vtc = wsp<u16>(p, O_VTSCC);
    for (int i = gt; i < 8 * 2 * 64 * 256; i += gs) {
      int pos = i & 255, dv = (i >> 8) & 63, kvh = (i >> 14) & 1, b = i >> 15;
      vtc[i] = f2bf(p.cache_v[(((size_t)b * 4 + l) * 256 + pos) * 128 + kvh * 64 + dv]);
    }
  }
}

DI void phase_gemmA(const Params& p, int l, char* smem) {
  const u16* H = wsp<u16>(p, O_H);
  const u16* W = wsp<u16>(p, O_WINA);
  for (int base = 0; base < 288 * 20; base += gridDim.x) {
    const int tile = xcd_map(base);
    if (tile >= 288 * 20) continue;
    const int mt = tile / 20, nt = tile % 20;
    const TokTile tt = tok_tile(mt);
    f32x4 acc[4][4];
    zero_acc(acc);
    gemm_tile(H + (size_t)tt.g0 * 1024, 1024, W + (size_t)nt * 128 * 1024, 1024, 1024, acc, smem);
    LANEVARS
    if (nt < 13) {
      u16* dst; int ld, cb;
      if (nt < 8) { dst = wsp<u16>(p, O_XR); ld = 1024; cb = nt * 128; }
      else if (nt < 11) { dst = wsp<u16>(p, O_CQ); ld = 384; cb = (nt - 8) * 128; }
      else { dst = wsp<u16>(p, O_CKV); ld = 256; cb = (nt - 11) * 128; }
#pragma unroll
      for (int i = 0; i < 4; ++i)
#pragma unroll
        for (int j = 0; j < 4; ++j)
#pragma unroll
          for (int e = 0; e < 4; ++e) {
            const int g = tt.g0 + wr * 64 + i * 16 + g4 * 4 + e;
            dst[(size_t)g * ld + cb + wc * 64 + j * 16 + c16] = f2bf(acc[i][j][e]);
            if (e == 3 && j == 3) SB();
          }
    } else if (nt == 13) {
      if (wc == 0) {
#pragma unroll
        for (int i = 0; i < 4; ++i)
#pragma unroll
          for (int e = 0; e < 4; ++e) {
            SB();
            const int r = wr * 64 + i * 16 + g4 * 4 + e;
            const int pos = tt.p0 + r;
            float x1 = acc[i][0][e], x2 = acc[i][1][e];
            if (tt.is_ctx) {
              u16* kr = wsp<u16>(p, O_KRC) + ((size_t)tt.b * 256 + pos) * 32;
              kr[c16] = f2bf(x1); kr[c16 + 16] = f2bf(x2);
              float* o = p.out + OUT_KROPE + (((size_t)tt.b * 4 + l) * 256 + pos) * 32;
              o[perm32(c16)] = x1; o[perm32(c16 + 16)] = x2;
            } else {
              const int pv = (c16 >= 8) ? (pos & 63) : (pos >> 6);
              const float cs = TAB_M[(pv * 8 + (c16 & 7)) * 2], sn = TAB_M[(pv * 8 + (c16 & 7)) * 2 + 1];
              u16* kr = wsp<u16>(p, O_KRL) + ((size_t)tt.b * LK_LAT + 256 + pos) * 32;
              kr[c16] = f2bf(x1 * cs - x2 * sn); kr[c16 + 16] = f2bf(x2 * cs + x1 * sn);
            }
          }
      }
    } else if (nt < 19) {
      const bool isk = (nt == 18);
      u16* dst = isk ? wsp<u16>(p, O_KS) : wsp<u16>(p, O_QS);
      const int ld = isk ? 128 : 512;
      const int cb = isk ? wc * 64 : ((nt - 14) * 2 + wc) * 64;
#pragma unroll
      for (int i = 0; i < 4; ++i)
#pragma unroll
        for (int e = 0; e < 4; ++e) {
          SB();
          const int r = wr * 64 + i * 16 + g4 * 4 + e;
          const int pos = tt.p0 + r, g = tt.g0 + r;
          float v0 = acc[i][0][e], v1 = acc[i][1][e], v2 = acc[i][2][e], v3 = acc[i][3][e];
          if (!tt.is_ctx) {
            const int pr = pos >> 6, pc = pos & 63;
            const float c0 = TAB_S[(pr * 16 + c16) * 2], s0 = TAB_S[(pr * 16 + c16) * 2 + 1];
            const float c1 = TAB_S[(pc * 16 + c16) * 2], s1 = TAB_S[(pc * 16 + c16) * 2 + 1];
            float a0 = v0 * c0 - v1 * s0, a1 = v1 * c0 + v0 * s0;
            float a2 = v2 * c1 - v3 * s1, a3 = v3 * c1 + v2 * s1;
            v0 = a0; v1 = a1; v2 = a2; v3 = a3;
          } else if (isk) {
            float* o = p.out + OUT_SK + (((size_t)tt.b * 4 + l) * 256 + pos) * 128 + cb + c16;
            o[0] = v0; o[16] = v1; o[32] = v2; o[48] = v3;
          }
          u16* d = dst + (size_t)g * ld + cb + c16;
          d[0] = f2bf(v0); d[16] = f2bf(v1); d[32] = f2bf(v2); d[48] = f2bf(v3);
        }
    } else {
      u16* vt = tt.is_ctx ? wsp<u16>(p, O_VTSC) : wsp<u16>(p, O_VTSL);
      const int L = tt.is_ctx ? 256 : 4096;
#pragma unroll
      for (int i = 0; i < 4; ++i)
#pragma unroll
        for (int j = 0; j < 4; ++j) {
          SB();
          const int r = wr * 64 + i * 16 + g4 * 4;
          const int pos = tt.p0 + r, dv = j * 16 + c16;
          uint2 o; o.x = pack2(acc[i][j][0], acc[i][j][1]); o.y = pack2(acc[i][j][2], acc[i][j][3]);
          *(uint2*)(vt + (((size_t)tt.b * 2 + wc) * 64 + dv) * L + pos) = o;
          if (tt.is_ctx) {
#pragma unroll
            for (int e = 0; e < 4; ++e)
              p.out[OUT_SV + (((size_t)tt.b * 4 + l) * 256 + pos + e) * 128 + wc * 64 + dv] = acc[i][j][e];
          }
        }
    }
  }
}

DI void row_scales(const u16* A, int K, float* s_rs) {
  const int t = tid(), row = t >> 1, half = t & 1;
  const u16* ap = A + (size_t)row * K + half * (K >> 1);
  float ss = 0.f;
  for (int c = 0; c < (K >> 4); ++c) {
    uint4 v = *(const uint4*)(ap + c * 8);
    unsigned wv[4] = {v.x, v.y, v.z, v.w};
#pragma unroll
    for (int q = 0; q < 4; ++q) {
      float a = __uint_as_float(wv[q] << 16), b = __uint_as_float(wv[q] & 0xffff0000u);
      ss += a * a + b * b;
    }
  }
  ss += __shfl_xor(ss, 1);
  if (half == 0) s_rs[row] = rsqrtf(ss / (float)K + EPS);
}

template <int MODE> DI void scan_seg(const Params& p, int l, int seq, int blk, int d, int seg, char* smem);
DI void phase_qkv(const Params& p, int l, char* smem) {
  float* s_rs = (float*)(smem + 65536);
  constexpr int NQ = 288 * 6, NKV = 304 * 8, NS1 = 2048;
  for (int base = 0; base < NS1 + NQ + NKV; base += gridDim.x) {
    const int tile0 = xcd_map(base);
    if (tile0 >= NS1 + NQ + NKV) continue;
    if (tile0 < NS1) {
      scan_seg<0>(p, l, 16 + (tile0 >> 8), (tile0 >> 5) & 7, (tile0 >> 4) & 1, tile0 & 15, smem);
#if PROBE == 4
      scan_seg<0>(p, l, 16 + (tile0 >> 8), (tile0 >> 5) & 7, (tile0 >> 4) & 1, tile0 & 15, smem);
#endif
      continue;
    }
    const int tile = tile0 - NS1;
    f32x4 acc[4][4];
    zero_acc(acc);
    if (tile < NQ) {
      const int mt = tile / 6, nt = tile % 6;
      const TokTile tt = tok_tile(mt);
      const u16* A = wsp<u16>(p, O_CQ) + (size_t)tt.g0 * 384;
      row_scales(A, 384, s_rs);
      gemm_tile(A, 384, wsp<u16>(p, O_WUQ) + (size_t)nt * 128 * 384, 384, 384, acc, smem);
      LANEVARS
      u16* Q = wsp<u16>(p, O_Q);
#pragma unroll
      for (int i = 0; i < 4; ++i)
#pragma unroll
        for (int e = 0; e < 4; ++e) {
          SB();
          const int r = wr * 64 + i * 16 + g4 * 4 + e;
          const int pos = tt.p0 + r, g = tt.g0 + r;
          const float rs = s_rs[r];
          float v0 = acc[i][0][e] * rs, v1 = acc[i][1][e] * rs, v2 = acc[i][2][e] * rs, v3 = acc[i][3][e] * rs;
          if (nt >= 4 && !tt.is_ctx) {
            const int pv = (c16 >= 8) ? (pos & 63) : (pos >> 6);
            const float cs = TAB_M[(pv * 8 + (c16 & 7)) * 2], sn = TAB_M[(pv * 8 + (c16 & 7)) * 2 + 1];
            float a0 = v0 * cs - v1 * sn, a1 = v1 * cs + v0 * sn;
            float a2 = v2 * cs - v3 * sn, a3 = v3 * cs + v2 * sn;
            v0 = a0; v1 = a1; v2 = a2; v3 = a3;
          }
          u16* d = Q + (size_t)g * 768 + nt * 128 + wc * 64 + c16;
          d[0] = f2bf(v0); d[16] = f2bf(v1); d[32] = f2bf(v2); d[48] = f2bf(v3);
        }
    } else {
      const int t2 = tile - NQ;
      const int mt = t2 >> 3, hd = t2 & 7;
      const u16* A; const u16* Wt; int is_ctx, seq, kp0;
      if (mt < 288) {
        const TokTile tt = tok_tile(mt);
        A = wsp<u16>(p, O_CKV) + (size_t)tt.g0 * 256;
        Wt = wsp<u16>(p, O_WUKVG);
        row_scales(A, 256, s_rs);
        is_ctx = tt.is_ctx; seq = tt.b; kp0 = tt.is_ctx ? tt.p0 : 256 + tt.p0;
        if (tt.is_ctx && hd == 0) {
          __syncthreads();
          const float* gkv = p.kv_norm + l * 256;
          for (int idx = tid(); idx < 128 * 256; idx += 256) {
            const int r = idx >> 8, k = idx & 255;
            p.out[OUT_CKV + (((size_t)tt.b * 4 + l) * 256 + tt.p0 + r) * 256 + k] = bf2f(A[(size_t)r * 256 + k]) * s_rs[r] * gkv[k];
          }
        }
      } else {
        const int row0 = (mt - 288) * 128;
        A = wsp<u16>(p, O_CKVC) + (size_t)row0 * 256;
        Wt = wsp<u16>(p, O_WUKVR);
        { const int t1 = tid(); if (t1 < 128) s_rs[t1] = 1.f; }
        is_ctx = 0; seq = row0 >> 8; kp0 = row0 & 255;
      }
      gemm_tile(A, 256, Wt + (size_t)hd * 128 * 256, 256, 256, acc, smem);
      LANEVARS
      const int Lk = is_ctx ? 256 : LK_LAT;
      if (wc == 0) {
        u16* Kn = (is_ctx ? wsp<u16>(p, O_KNC) : wsp<u16>(p, O_KNL)) + ((size_t)seq * 8 + hd) * Lk * 64;
#pragma unroll
        for (int i = 0; i < 4; ++i)
#pragma unroll
          for (int j = 0; j < 4; ++j)
#pragma unroll
            for (int e = 0; e < 4; ++e) {
              const int r = wr * 64 + i * 16 + g4 * 4 + e;
              Kn[(size_t)(kp0 + r) * 64 + j * 16 + c16] = f2bf(acc[i][j][e] * s_rs[r]);
              if (e == 3) SB();
            }
      } else {
        u16* Vt = (is_ctx ? wsp<u16>(p, O_VTC) : wsp<u16>(p, O_VTL)) + ((size_t)seq * 8 + hd) * 64 * Lk;
#pragma unroll
        for (int i = 0; i < 4; ++i)
#pragma unroll
          for (int j = 0; j < 4; ++j) {
            SB();
            const int r = wr * 64 + i * 16 + g4 * 4;
            uint2 o;
            o.x = pack2(acc[i][j][0] * s_rs[r], acc[i][j][1] * s_rs[r + 1]);
            o.y = pack2(acc[i][j][2] * s_rs[r + 2], acc[i][j][3] * s_rs[r + 3]);
            *(uint2*)(Vt + (size_t)(j * 16 + c16) * Lk + kp0 + r) = o;
          }
      }
    }
    __syncthreads();
  }
}

template <int NS> DI void attn_gload(const u16* k0, int k0s, const u16* k1, const u16* vt, int vts,
                                     uint4& rk0, uint4& rk1, uint4& rk2, uint4& rv0, uint4& rv1) {
  const int t = tid();
  if (NS == 6) {
    { const int c = t, key = c / 12, ch = c % 12;
      rk0 = (ch < 8) ? *(const uint4*)(k0 + (size_t)key * k0s + ch * 8) : *(const uint4*)(k1 + (size_t)key * 32 + (ch - 8) * 8); }
    { const int c = t + 256, key = c / 12, ch = c % 12;
      rk1 = (ch < 8) ? *(const uint4*)(k0 + (size_t)key * k0s + ch * 8) : *(const uint4*)(k1 + (size_t)key * 32 + (ch - 8) * 8); }
    { const int c = t + 512, key = c / 12, ch = c % 12;
      rk2 = (ch < 8) ? *(const uint4*)(k0 + (size_t)key * k0s + ch * 8) : *(const uint4*)(k1 + (size_t)key * 32 + (ch - 8) * 8); }
  } else {
    { const int c = t, key = c >> 3, ch = c & 7; rk0 = *(const uint4*)(k0 + (size_t)key * k0s + ch * 8); }
    { const int c = t + 256, key = c >> 3, ch = c & 7; rk1 = *(const uint4*)(k0 + (size_t)key * k0s + ch * 8); }
  }
  { const int c = t, dv = c >> 3, ch = c & 7; rv0 = *(const uint4*)(vt + (size_t)dv * vts + ch * 8); }
  { const int c = t + 256, dv = c >> 3, ch = c & 7; rv1 = *(const uint4*)(vt + (size_t)dv * vts + ch * 8); }
}
template <int NS> DI void attn_sstore(char* smem, const uint4& rk0, const uint4& rk1, const uint4& rk2, const uint4& rv0, const uint4& rv1) {
  constexpr int KSTR = (NS == 6) ? 208 : 144;
  const int t = tid();
  if (NS == 6) {
    { const int c = t, key = c / 12, ch = c % 12; *(uint4*)(smem + key * KSTR + ch * 16) = rk0; }
    { const int c = t + 256, key = c / 12, ch = c % 12; *(uint4*)(smem + key * KSTR + ch * 16) = rk1; }
    { const int c = t + 512, key = c / 12, ch = c % 12; *(uint4*)(smem + key * KSTR + ch * 16) = rk2; }
  } else {
    { const int c = t, key = c >> 3, ch = c & 7; *(uint4*)(smem + key * KSTR + ch * 16) = rk0; }
    { const int c = t + 256, key = c >> 3, ch = c & 7; *(uint4*)(smem + key * KSTR + ch * 16) = rk1; }
  }
  { const int c = t, dv = c >> 3, ch = c & 7; char* d = smem + 13312 + dv * 136 + ch * 16;
    *(uint2*)d = uint2{rv0.x, rv0.y}; *(uint2*)(d + 8) = uint2{rv0.z, rv0.w}; }
  { const int c = t + 256, dv = c >> 3, ch = c & 7; char* d = smem + 13312 + dv * 136 + ch * 16;
    *(uint2*)d = uint2{rv1.x, rv1.y}; *(uint2*)(d + 8) = uint2{rv1.z, rv1.w}; }
}

#define PACK8(S, s2) __builtin_bit_cast(bf16x8, uint4{pack2(S[8 * (s2)], S[8 * (s2) + 1]), pack2(S[8 * (s2) + 2], S[8 * (s2) + 3]), \
                                                        pack2(S[8 * (s2) + 4], S[8 * (s2) + 5]), pack2(S[8 * (s2) + 6], S[8 * (s2) + 7])})

template <int NS>
DI void attn_item(const u16* kA, int kAs, const u16* krA, const u16* vtA, int vtAs, int nA, int kposA, int maskA,
                  const u16* kB, int kBs, const u16* vtB, int vtBs, int nB,
                  const u16* qa, const u16* qb, float sc2, float m0, float l0, int qpos, u16* yrow, char* smem) {
  constexpr int KSTR = (NS == 6) ? 208 : 144;
  const int lane = tid() & 63;
  const int r32 = lane & 31, hh = lane >> 5;
  bf16x8 qf0, qf1, qf2, qf3, qf4, qf5;
  qf0 = *(const bf16x8*)(qa + 0 + 8 * hh); qf1 = *(const bf16x8*)(qa + 16 + 8 * hh);
  qf2 = *(const bf16x8*)(qa + 32 + 8 * hh); qf3 = *(const bf16x8*)(qa + 48 + 8 * hh);
  if (NS == 6) { qf4 = *(const bf16x8*)(qb + 0 + 8 * hh); qf5 = *(const bf16x8*)(qb + 16 + 8 * hh); }
  else { qf4 = qf0; qf5 = qf0; }
  f32x16 O0, O1;
#pragma unroll
  for (int e = 0; e < 16; ++e) { O0[e] = 0.f; O1[e] = 0.f; }
  float m_run = m0, l_run = l0;
  uint4 rk0, rk1, rk2, rv0, rv1;
  rk2 = uint4{0, 0, 0, 0};
  const int ntiles = nA + nB;
  if (nA > 0) attn_gload<NS>(kA, kAs, krA, vtA, vtAs, rk0, rk1, rk2, rv0, rv1);
  else attn_gload<NS>(kB, kBs, nullptr, vtB, vtBs, rk0, rk1, rk2, rv0, rv1);
  for (int j = 0; j < ntiles; ++j) {
    __syncthreads();
    attn_sstore<NS>(smem, rk0, rk1, rk2, rv0, rv1);
    __syncthreads();
    const int kpos = kposA + 64 * j;
    const bool masked = maskA && (j < nA);
    if (j + 1 < ntiles) {
      const int jn = j + 1;
      if (jn < nA) attn_gload<NS>(kA + (size_t)jn * 64 * kAs, kAs, krA + (size_t)jn * 64 * 32, vtA + jn * 64, vtAs, rk0, rk1, rk2, rv0, rv1);
      else { const int jb = jn - nA; attn_gload<NS>(kB + (size_t)jb * 64 * kBs, kBs, nullptr, vtB + jb * 64, vtBs, rk0, rk1, rk2, rv0, rv1); }
    }
    MB();
    f32x16 S0, S1;
#pragma unroll
    for (int e = 0; e < 16; ++e) { S0[e] = 0.f; S1[e] = 0.f; }
    const char* ka0 = smem + r32 * KSTR + 16 * hh;
    const char* ka1 = smem + (32 + r32) * KSTR + 16 * hh;
#define QK_STEP(s, qf) { bf16x8 a0 = *(const bf16x8*)(ka0 + 32 * (s)); bf16x8 a1 = *(const bf16x8*)(ka1 + 32 * (s)); \
      S0 = __builtin_amdgcn_mfma_f32_32x32x16_bf16(a0, qf, S0, 0, 0, 0); S1 = __builtin_amdgcn_mfma_f32_32x32x16_bf16(a1, qf, S1, 0, 0, 0); }
    QK_STEP(0, qf0) QK_STEP(1, qf1) QK_STEP(2, qf2) QK_STEP(3, qf3)
    if (NS == 6) { QK_STEP(4, qf4) QK_STEP(5, qf5) }
    SB();
    float mx = m_run;
#pragma unroll
    for (int e = 0; e < 16; ++e) {
      float v0 = S0[e] * sc2, v1 = S1[e] * sc2;
      if (masked) {
        const int kp = kpos + (e & 3) + 8 * (e >> 2) + 4 * hh;
        int d0 = qpos - kp; d0 = d0 < 0 ? -d0 : d0;
        int d1 = qpos - (kp + 32); d1 = d1 < 0 ? -d1 : d1;
        if (d0 > 128) v0 = -1e30f;
        if (d1 > 128) v1 = -1e30f;
      }
      S0[e] = v0; S1[e] = v1;
      mx = fmaxf(mx, fmaxf(v0, v1));
    }
    mx = fmaxf(mx, __shfl_xor(mx, 32));
    const float alpha = __builtin_amdgcn_exp2f(m_run - mx);
    m_run = mx;
    float rsum = 0.f;
#pragma unroll
    for (int e = 0; e < 16; ++e) {
      float p0 = __builtin_amdgcn_exp2f(S0[e] - mx), p1 = __builtin_amdgcn_exp2f(S1[e] - mx);
      S0[e] = p0; S1[e] = p1;
      rsum += p0 + p1;
    }
    rsum += __shfl_xor(rsum, 32);
    l_run = l_run * alpha + rsum;
#pragma unroll
    for (int e = 0; e < 16; ++e) { O0[e] *= alpha; O1[e] *= alpha; }
    const char* sv0 = smem + 13312 + r32 * 136 + 8 * hh;
    const char* sv1 = sv0 + 32 * 136;
#define PV_STEP(pb, ka) { \
      { uint2 lo = *(const uint2*)(sv0 + (ka) * 2), hi = *(const uint2*)(sv0 + (ka) * 2 + 16); \
        bf16x8 va = __builtin_bit_cast(bf16x8, uint4{lo.x, lo.y, hi.x, hi.y}); O0 = __builtin_amdgcn_mfma_f32_32x32x16_bf16(va, pb, O0, 0, 0, 0); } \
      { uint2 lo = *(const uint2*)(sv1 + (ka) * 2), hi = *(const uint2*)(sv1 + (ka) * 2 + 16); \
        bf16x8 va = __builtin_bit_cast(bf16x8, uint4{lo.x, lo.y, hi.x, hi.y}); O1 = __builtin_amdgcn_mfma_f32_32x32x16_bf16(va, pb, O1, 0, 0, 0); } }
    SB();
    { bf16x8 pb = PACK8(S0, 0); PV_STEP(pb, 0) }
    { bf16x8 pb = PACK8(S0, 1); PV_STEP(pb, 16) }
    SB();
    { bf16x8 pb = PACK8(S1, 0); PV_STEP(pb, 32) }
    { bf16x8 pb = PACK8(S1, 1); PV_STEP(pb, 48) }
    SB();
  }
  const float inv = 1.f / l_run;
#pragma unroll
  for (int e4 = 0; e4 < 4; ++e4) {
    uint2 o;
    o.x = pack2(O0[4 * e4] * inv, O0[4 * e4 + 1] * inv); o.y = pack2(O0[4 * e4 + 2] * inv, O0[4 * e4 + 3] * inv);
    *(uint2*)(yrow + 8 * e4 + 4 * hh) = o;
    o.x = pack2(O1[4 * e4] * inv, O1[4 * e4 + 1] * inv); o.y = pack2(O1[4 * e4 + 2] * inv, O1[4 * e4 + 3] * inv);
    *(uint2*)(yrow + 32 + 8 * e4 + 4 * hh) = o;
  }
}

template <int MODE>
DI void scan_seg(const Params& p, int l, int seq, int blk, int d, int seg, char* smem) {
  const int t = tid(), lane = t & 63, w = t >> 6;
  const int c16 = lane & 15, g4 = lane >> 4;
  const bool is_ctx = seq < 16;
  const int b = is_ctx ? seq : seq - 16;
  const int L = is_ctx ? 256 : 4096;
  const int gbase = is_ctx ? b * 256 : T_CTX + b * 4096;
  const u16* XR = wsp<u16>(p, O_XR);
  u16* Y = wsp<u16>(p, O_YRNN);
  float* SUM = wsp<float>(p, O_SUM);
  char* sXc = smem;
  float* sA = (float*)(smem + 8704);
  float* sU = (float*)(smem + 8704 + 16384);
  const int cch = t & 127, th = t >> 7;
  const int chg = blk * 128 + cch;
  const float w0 = p.conv_w[(l * 4 + 0) * 1024 + chg], w1 = p.conv_w[(l * 4 + 1) * 1024 + chg];
  const float w2 = p.conv_w[(l * 4 + 2) * 1024 + chg], w3 = p.conv_w[(l * 4 + 3) * 1024 + chg];
  const float cb = p.conv_b[l * 1024 + chg];
  bf16x8 bw[4][4];
  {
    const u16* WL = wsp<u16>(p, O_WLRU) + (size_t)(d * 8 + blk) * 256 * 128 + (size_t)(32 * w + c16) * 128 + g4 * 8;
#pragma unroll
    for (int nf = 0; nf < 4; ++nf)
#pragma unroll
      for (int ks = 0; ks < 4; ++ks)
        bw[nf][ks] = *(const bf16x8*)(WL + (size_t)((nf & 1) * 16 + (nf >> 1) * 128) * 128 + ks * 32);
  }
  float ba[2], bi[2], cl[2];
#pragma unroll
  for (int jn = 0; jn < 2; ++jn) {
    const int ch = (l * 2 + d) * 1024 + blk * 128 + 32 * w + 16 * jn + c16;
    ba[jn] = p.lru_ba[ch]; bi[jn] = p.lru_bi[ch];
    cl[jn] = -8.f * log1pf(__expf(-p.lru_lam[ch]));
  }
  float h = 0.f, P = 1.f;
  if (MODE == 1 && !is_ctx && t < 128) {
    h = p.state[(((size_t)b * 4 + l) * 2 + d) * 1024 + blk * 128 + t];
    const float* sm = SUM + ((size_t)((b * 8 + blk) * 2 + d) * 16) * 256 + t;
    if (d == 0) { for (int s2 = 0; s2 < seg; ++s2) h = sm[s2 * 256] * h + sm[s2 * 256 + 128]; }
    else { for (int s2 = 15; s2 > seg; --s2) h = sm[s2 * 256] * h + sm[s2 * 256 + 128]; }
  }
#define X19(F) F(0) F(1) F(2) F(3) F(4) F(5) F(6) F(7) F(8) F(9) F(10) F(11) F(12) F(13) F(14) F(15) F(16) F(17) F(18)
#define XDECL(q) u16 xr##q = 0;
#define XLOAD(q) { const int pos = tcn + th * 16 - 1 + (q); xr##q = (pos >= 0 && pos < L) ? XR[(size_t)(gbase + pos) * 1024 + chg] : (u16)0; }
#define XCVT(q) xv[q] = bf2f(xr##q);
  X19(XDECL)
  { const int tcn = seg * 256 + (d == 0 ? 0 : 7) * 32; X19(XLOAD) }
  for (int ci = 0; ci < 8; ++ci) {
    const int tc0 = seg * 256 + (d == 0 ? ci : 7 - ci) * 32;
    {
      float xv[19];
      X19(XCVT)
#pragma unroll
      for (int q = 0; q < 16; ++q) {
        float xc = cb + w0 * xv[q] + w1 * xv[q + 1] + w2 * xv[q + 2] + w3 * xv[q + 3];
        *(u16*)(sXc + (th * 16 + q) * 272 + cch * 2) = f2bf(xc);
      }
    }
    unsigned yold0 = 0, yold1 = 0, yold2 = 0, yold3 = 0, yold4 = 0, yold5 = 0, yold6 = 0, yold7 = 0;
    {
      const int cn = ci < 7 ? ci + 1 : ci;
      const int tcn = seg * 256 + (d == 0 ? cn : 7 - cn) * 32;
      X19(XLOAD)
      if (MODE == 1 && d == 1) {
        const unsigned* yb = (const unsigned*)(Y + (size_t)(gbase + tc0 + (t >> 6)) * 1024 + blk * 128 + (t & 63) * 2);
        yold0 = yb[0]; yold1 = yb[4 * 512]; yold2 = yb[8 * 512]; yold3 = yb[12 * 512];
        yold4 = yb[16 * 512]; yold5 = yb[20 * 512]; yold6 = yb[24 * 512]; yold7 = yb[28 * 512];
      }
    }
    MB();
    __syncthreads();
    f32x4 aR[2][2], aI[2][2];
#pragma unroll
    for (int im = 0; im < 2; ++im)
#pragma unroll
      for (int jn = 0; jn < 2; ++jn) { aR[im][jn] = f32x4{0.f, 0.f, 0.f, 0.f}; aI[im][jn] = f32x4{0.f, 0.f, 0.f, 0.f}; }
#pragma unroll
    for (int ks = 0; ks < 4; ++ks)
#pragma unroll
      for (int im = 0; im < 2; ++im) {
        bf16x8 af = *(const bf16x8*)(sXc + (16 * im + c16) * 272 + (ks * 32 + g4 * 8) * 2);
#pragma unroll
        for (int jn = 0; jn < 2; ++jn) {
          aR[im][jn] = __builtin_amdgcn_mfma_f32_16x16x32_bf16(af, bw[jn][ks], aR[im][jn], 0, 0, 0);
          aI[im][jn] = __builtin_amdgcn_mfma_f32_16x16x32_bf16(af, bw[2 + jn][ks], aI[im][jn], 0, 0, 0);
        }
      }
#pragma unroll
    for (int im = 0; im < 2; ++im)
#pragma unroll
      for (int jn = 0; jn < 2; ++jn)
#pragma unroll
        for (int e = 0; e < 4; ++e) {
          const int tt = 16 * im + 4 * g4 + e, c = 32 * w + 16 * jn + c16;
          const float r = sigmoidf_(aR[im][jn][e] + ba[jn]);
          const float ig = sigmoidf_(aI[im][jn][e] + bi[jn]);
          const float a = __expf(cl[jn] * r);
          const float xc = bf2f(*(const u16*)(sXc + tt * 272 + c * 2));
          const float u = sqrtf(fmaxf(1.f - a * a, 0.f)) * ig * xc;
          sA[tt * 128 + c] = a; sU[tt * 128 + c] = u;
        }
    __syncthreads();
    if (t < 128) {
      if (d == 0) {
#pragma unroll 8
        for (int s = 0; s < 32; ++s) {
          const float a = sA[s * 128 + t];
          h = a * h + sU[s * 128 + t];
          if (MODE == 0) P *= a; else sU[s * 128 + t] = h;
        }
      } else {
#pragma unroll 8
        for (int s = 31; s >= 0; --s) {
          const float a = sA[s * 128 + t];
          h = a * h + sU[s * 128 + t];
          if (MODE == 0) P *= a; else sU[s * 128 + t] = h;
        }
      }
    }
    __syncthreads();
    if (MODE == 1) {
      const int c2 = (t & 63) * 2;
      unsigned* yb = (unsigned*)(Y + (size_t)(gbase + tc0 + (t >> 6)) * 1024 + blk * 128 + c2);
      const float* su = sU + (t >> 6) * 128 + c2;
#define YOUT(i, yo) { float h0 = su[(4 * (i)) * 128], h1 = su[(4 * (i)) * 128 + 1]; \
        if (d == 1) { h0 += __uint_as_float((yo) << 16); h1 += __uint_as_float((yo) & 0xffff0000u); } \
        yb[(size_t)(4 * (i)) * 512] = pack2(h0, h1); }
      YOUT(0, yold0) YOUT(1, yold1) YOUT(2, yold2) YOUT(3, yold3) YOUT(4, yold4) YOUT(5, yold5) YOUT(6, yold6) YOUT(7, yold7)
#undef YOUT
    }
  }
#undef X19
#undef XDECL
#undef XLOAD
#undef XCVT
  if (MODE == 0) {
    if (t < 128) {
      float* sm = SUM + ((size_t)(((b * 8 + blk) * 2 + d) * 16 + seg)) * 256 + t;
      sm[0] = P; sm[128] = h;
    }
  } else if (is_ctx && t < 128) {
    p.out[OUT_RG + (((size_t)b * 4 + l) * 2 + d) * 1024 + blk * 128 + t] = h;
  }
  __syncthreads();
}

DI void phase_mix(const Params& p, int l, char* smem) {
  constexpr float LOG2E = 1.4426950408889634f;
  constexpr int N0 = 1024, N1 = N0 + 2048, N2 = N1 + 2048, N3 = N2 + 128, N4 = N3 + 256, N5 = N4 + 256;
  for (int base = 0; base < N5; base += gridDim.x) {
    const int it = xcd_map(base);
    if (it >= N5) continue;
    const int t = tid(), lane = t & 63, w = t >> 6;
    const int r32 = lane & 31;
    if (it < N0 || (it >= N2 && it < N3)) {
      int seq, blk, seg;
      if (it < N0) { seg = it & 15; blk = (it >> 4) & 7; seq = 16 + (it >> 7); }
      else { const int i = it - N2; seg = 0; blk = i & 7; seq = i >> 3; }
      scan_seg<1>(p, l, seq, blk, 0, seg, smem);
      scan_seg<1>(p, l, seq, blk, 1, seg, smem);
#if PROBE == 4
      scan_seg<1>(p, l, seq, blk, 0, seg, smem);
      scan_seg<1>(p, l, seq, blk, 1, seg, smem);
#endif
    } else if (it < N1 || (it >= N3 && it < N4)) {
      const bool lat = it < N1;
      int b, h, qb;
      if (lat) { const int i = it - N0; qb = i & 31; h = (i >> 5) & 7; b = i >> 8; }
      else { const int i = it - N3; qb = i & 1; h = (i >> 1) & 7; b = i >> 4; }
      const int Lk = lat ? LK_LAT : 256;
      const int gq = (lat ? T_CTX + b * 4096 : b * 256) + qb * 128 + w * 32 + r32;
      const u16* Kn = (lat ? wsp<u16>(p, O_KNL) : wsp<u16>(p, O_KNC)) + ((size_t)b * 8 + h) * Lk * 64;
      const u16* Kr = (lat ? wsp<u16>(p, O_KRL) : wsp<u16>(p, O_KRC)) + (size_t)b * Lk * 32;
      const u16* Vt = (lat ? wsp<u16>(p, O_VTL) : wsp<u16>(p, O_VTC)) + ((size_t)b * 8 + h) * 64 * Lk;
      const u16* Q = wsp<u16>(p, O_Q) + (size_t)gq * 768;
      u16* yrow = wsp<u16>(p, O_CQ) + (size_t)gq * 512 + h * 64;
      attn_item<6>(Kn, 64, Kr, Vt, Lk, Lk >> 6, 0, 0, nullptr, 0, nullptr, 0, 0,
                   Q + h * 64, Q + 512 + h * 32, 0.10206207261596577f * LOG2E, -1e30f, 0.f, 0, yrow, smem);
#if PROBE == 5
      __syncthreads();
      attn_item<6>(Kn, 64, Kr, Vt, Lk, Lk >> 6, 0, 0, nullptr, 0, nullptr, 0, 0,
                   Q + h * 64, Q + 512 + h * 32, 0.10206207261596577f * LOG2E, -1e30f, 0.f, 0, yrow, smem);
#endif
    } else {
      const bool lat = it < N2;
      int b, h, qb;
      if (lat) { const int i = it - N1; qb = i & 31; h = (i >> 5) & 7; b = i >> 8; }
      else { const int i = it - N4; qb = i & 1; h = (i >> 1) & 7; b = i >> 4; }
      const int kvh = h >> 2;
      const int gseq = lat ? T_CTX + b * 4096 : b * 256;
      const int qpos = qb * 128 + w * 32 + r32;
      const int gq = gseq + qpos;
      u16* qrow = wsp<u16>(p, O_QS) + (size_t)gq * 512 + h * 64;
      const float sink2 = p.sink[l * 8 + h] * LOG2E;
      const int t0 = qb * 128;
      int jlo = 0, jhi = 6;
      if (t0 == 0) jlo = 2;
      if (t0 + 128 >= 4096) jhi = 4;
      const int ks0 = lat ? t0 - 128 + 64 * jlo : 0;
      const int nA = lat ? jhi - jlo : 4;
      const u16* KS = wsp<u16>(p, O_KS) + (size_t)(gseq + ks0) * 128 + kvh * 64;
      const u16* VT = lat ? wsp<u16>(p, O_VTSL) + ((size_t)b * 2 + kvh) * 64 * 4096 + ks0
                          : wsp<u16>(p, O_VTSC) + ((size_t)b * 2 + kvh) * 64 * 256;
      const u16* KC = wsp<u16>(p, O_KSC) + (size_t)b * 256 * 128 + kvh * 64;
      const u16* VC = wsp<u16>(p, O_VTSCC) + ((size_t)b * 2 + kvh) * 64 * 256;
      attn_item<4>(KS, 128, nullptr, VT, lat ? 4096 : 256, nA, ks0, lat ? 1 : 0, KC, 128, VC, 256, lat ? 4 : 0,
                   qrow, nullptr, 0.125f * LOG2E, sink2, 1.f, qpos, qrow, smem);
    }
    __syncthreads();
  }
}

DI void phase_gate(const Params& p, int l, char* smem) {
  const u16* H = wsp<u16>(p, O_H);
  const u16* W = wsp<u16>(p, O_WINB);
  for (int base = 0; base < 288 * 40; base += gridDim.x) {
    const int tile = xcd_map(base);
    if (tile >= 288 * 40) continue;
    const int mt = tile / 40, nt = tile % 40;
    const int g0 = mt * 128;
    f32x4 acc[4][4];
    zero_acc(acc);
    gemm_tile(H + (size_t)g0 * 1024, 1024, W + (size_t)nt * 128 * 1024, 1024, 1024, acc, smem);
    LANEVARS
    if (nt < 16) {
      u16* dst; int ld, cb;
      if (nt < 8) { dst = wsp<u16>(p, O_YRNN); ld = 1024; cb = nt * 128; }
      else if (nt < 12) { dst = wsp<u16>(p, O_CQ); ld = 512; cb = (nt - 8) * 128; }
      else { dst = wsp<u16>(p, O_QS); ld = 512; cb = (nt - 12) * 128; }
#pragma unroll
      for (int i = 0; i < 4; ++i)
#pragma unroll
        for (int j = 0; j < 4; ++j)
#pragma unroll
          for (int e = 0; e < 4; ++e) {
            const int g = g0 + wr * 64 + i * 16 + g4 * 4 + e;
            u16* d = dst + (size_t)g * ld + cb + wc * 64 + j * 16 + c16;
            const float gv = acc[i][j][e];
            *d = f2bf(bf2f(*d) * gv * sigmoidf_(gv));
            if (e == 3) SB();
          }
    } else {
      const int br = (nt - 16) >> 3, cb = ((nt - 16) & 7) * 128;
      u16* dst = br == 0 ? wsp<u16>(p, O_XR) : wsp<u16>(p, O_KS) + (size_t)(br - 1) * T_ALL * 1024;
#pragma unroll
      for (int i = 0; i < 4; ++i)
#pragma unroll
        for (int j = 0; j < 4; ++j)
#pragma unroll
          for (int e = 0; e < 4; ++e) {
            const int g = g0 + wr * 64 + i * 16 + g4 * 4 + e;
            dst[(size_t)g * 1024 + cb + wc * 64 + j * 16 + c16] = f2bf(sigmoidf_(acc[i][j][e]));
            if (e == 3) SB();
          }
    }
  }
}

DI void phase_merge(const Params& p, int l, char* smem) {
  u16* U = wsp<u16>(p, O_H);
  for (int base = 0; base < 288 * 8; base += gridDim.x) {
    const int tile = xcd_map(base);
    if (tile >= 288 * 8) continue;
    const int mt = tile >> 3, nt = tile & 7;
    const int g0 = mt * 128;
    f32x4 u[4][4];
    zero_acc(u);
    for (int br = 0; br < 3; ++br) {
      f32x4 acc[4][4];
      zero_acc(acc);
      const u16* Z; const u16* WT; int kz; const u16* M;
      if (br == 0) { Z = wsp<u16>(p, O_YRNN) + (size_t)g0 * 1024; WT = wsp<u16>(p, O_WBRR) + (size_t)nt * 128 * 1024; kz = 1024; M = wsp<u16>(p, O_XR); }
      else if (br == 1) { Z = wsp<u16>(p, O_CQ) + (size_t)g0 * 512; WT = wsp<u16>(p, O_WBRM) + (size_t)nt * 128 * 512; kz = 512; M = wsp<u16>(p, O_KS); }
      else { Z = wsp<u16>(p, O_QS) + (size_t)g0 * 512; WT = wsp<u16>(p, O_WBRS) + (size_t)nt * 128 * 512; kz = 512; M = wsp<u16>(p, O_KS) + (size_t)T_ALL * 1024; }
      gemm_tile(Z, kz, WT, kz, kz, acc, smem);
      LANEVARS
#pragma unroll
      for (int i = 0; i < 4; ++i)
#pragma unroll
        for (int j = 0; j < 4; ++j)
#pragma unroll
          for (int e = 0; e < 4; ++e) {
            const int g = g0 + wr * 64 + i * 16 + g4 * 4 + e;
            u[i][j][e] += bf2f(M[(size_t)g * 1024 + nt * 128 + wc * 64 + j * 16 + c16]) * acc[i][j][e];
            if (e == 3) SB();
          }
    }
    LANEVARS
#pragma unroll
    for (int i = 0; i < 4; ++i)
#pragma unroll
      for (int j = 0; j < 4; ++j)
#pragma unroll
        for (int e = 0; e < 4; ++e) {
          const int g = g0 + wr * 64 + i * 16 + g4 * 4 + e;
          U[(size_t)g * 1024 + nt * 128 + wc * 64 + j * 16 + c16] = f2bf(u[i][j][e]);
        }
  }
}

DI void phase_out(const Params& p, int l, char* smem) {
  const u16* U = wsp<u16>(p, O_H);
  const u16* W = wsp<u16>(p, O_WOUT);
  const float* MOD = wsp<float>(p, O_MOD) + (size_t)l * 9 * 3072;
  for (int base = 0; base < 288 * 8; base += gridDim.x) {
    const int tile = xcd_map(base);
    if (tile >= 288 * 8) continue;
    const int mt = tile >> 3, nt = tile & 7;
    const int g0 = mt * 128;
    const int ci = g0 < T_CTX ? 8 : ((g0 - T_CTX) >> 12);
    f32x4 acc[4][4];
    zero_acc(acc);
    gemm_tile(U + (size_t)g0 * 1024, 1024, W + (size_t)nt * 128 * 1024, 1024, 1024, acc, smem);
    LANEVARS
#pragma unroll
    for (int j = 0; j < 4; ++j) {
      const int col = nt * 128 + wc * 64 + j * 16 + c16;
      const float gt = MOD[ci * 3072 + 2048 + col];
#pragma unroll
      for (int i = 0; i < 4; ++i)
#pragma unroll
        for (int e = 0; e < 4; ++e) {
          const int g = g0 + wr * 64 + i * 16 + g4 * 4 + e;
          const float xo = xin_row(p, l, g)[col];
          p.out[(size_t)g * 1024 + col] = xo + gt * acc[i][j][e];
          if (e == 3) SB();
        }
    }
  }
}

DI void phase_final(const Params& p) {
  const int t = tid(), lane = t & 63, w = t >> 6;
  for (int row = blockIdx.x * 4 + w; row < T_ALL; row += gridDim.x * 4) {
    float* x = p.out + (size_t)row * 1024;
    float4 v[4];
    float ss = 0.f;
#pragma unroll
    for (int i = 0; i < 4; ++i) {
      v[i] = *(const float4*)(x + i * 256 + lane * 4);
      ss += v[i].x * v[i].x + v[i].y * v[i].y + v[i].z * v[i].z + v[i].w * v[i].w;
    }
    ss = wave_sum(ss);
    const float rs = rsqrtf(ss * (1.f / 1024.f) + EPS);
#pragma unroll
    for (int i = 0; i < 4; ++i) {
      const int c = i * 256 + lane * 4;
      const float4 g = *(const float4*)(p.final_norm + c);
      float4 o = {v[i].x * rs * g.x, v[i].y * rs * g.y, v[i].z * rs * g.z, v[i].w * rs * g.w};
      *(float4*)(x + c) = o;
    }
  }
}

constexpr int NPHASE_PER_LAYER = 7;
DI void run_phase(const Params& p, int ph, char* smem) {
  if (ph == 0) { phase_mod(p, smem); return; }
  if (ph == 1 + NLAYER * NPHASE_PER_LAYER) { phase_final(p); return; }
  const int l = (ph - 1) / NPHASE_PER_LAYER, s = (ph - 1) % NPHASE_PER_LAYER;
  switch (s) {
    case 0: phase_prep(p, l); break;
    case 1: phase_gemmA(p, l, smem); break;
    case 2: phase_qkv(p, l, smem); break;
    case 3: phase_mix(p, l, smem); break;
    case 4: phase_gate(p, l, smem); break;
    case 5: phase_merge(p, l, smem); break;
    default: phase_out(p, l, smem); break;
  }
}
constexpr int NPHASE = 2 + NLAYER * NPHASE_PER_LAYER;

#if MEGA
DI Params launder(const Params& p) {
  size_t z = 0;
  asm volatile("" : "+s"(z));
  Params q = p; q.ws = p.ws + z; q.out = p.out + z;
  return q;
}
__global__ void __launch_bounds__(256, 2) mega_kernel(Params p) {
  __shared__ __attribute__((aligned(16))) char smem[66048];
  cg::grid_group grid = cg::this_grid();
  phase_mod(launder(p), smem);
  grid.sync();
  for (int l = 0; l < NLAYER; ++l) {
    phase_prep(launder(p), l);
    grid.sync();
#if PROBE == 1
    phase_prep(launder(p), l);
    grid.sync();
#endif
    phase_gemmA(launder(p), l, smem);
    grid.sync();
#if PROBE == 2
    phase_gemmA(launder(p), l, smem);
    grid.sync();
#endif
    phase_qkv(launder(p), l, smem);
    grid.sync();
    phase_mix(launder(p), l, smem);
    grid.sync();
    phase_gate(launder(p), l, smem);
    grid.sync();
    phase_merge(launder(p), l, smem);
    grid.sync();
#if PROBE == 3
    phase_merge(launder(p), l, smem);
    grid.sync();
#endif
    phase_out(launder(p), l, smem);
    grid.sync();
  }
  phase_final(launder(p));
}

#else
__global__ void __launch_bounds__(256, 2) phase_kernel(Params p, int ph) {
  __shared__ __attribute__((aligned(16))) char smem[66048];
  run_phase(p, ph, smem);
}

#endif
extern "C" void kernel_launch(void* const* d_in, const int* in_sizes, int n_in, void* d_out, int out_size, void* d_ws,
                              size_t ws_size, hipStream_t stream) {
  Params p{};
  const float** pp = (const float**)&p;
  for (int i = 0; i < 30; ++i) pp[i] = (const float*)d_in[i];
  p.out = (float*)d_out;
  p.ws = (char*)d_ws;
  if (ws_size < WS_NEED) fprintf(stderr, "workspace too small: %zu < %zu\n", ws_size, (size_t)WS_NEED);
#if MEGA
  static int grid_blocks = 0;
  if (!grid_blocks) {
    int dev = 0, cus = 0, per_cu = 0;
    hipGetDevice(&dev);
    hipDeviceGetAttribute(&cus, hipDeviceAttributeMultiprocessorCount, dev);
    hipOccupancyMaxActiveBlocksPerMultiprocessor(&per_cu, mega_kernel, 256, 0);
    if (per_cu > 2) per_cu = 2;
    grid_blocks = cus * per_cu;
  }
  void* args[] = {&p};
  hipError_t e = hipLaunchCooperativeKernel((void*)mega_kernel, dim3(grid_blocks), dim3(256), args, 0, stream);
  if (e != hipSuccess) fprintf(stderr, "cooperative launch failed: %s (grid %d)\n", hipGetErrorString(e), grid_blocks);
#else
  for (int ph = 0; ph < NPHASE; ++ph) phase_kernel<<<512, 256, 0, stream>>>(p, ph);
#endif
}
```

```cpp
#include <hip/hip_runtime.h>
#include <hip/hip_cooperative_groups.h>
#include <cstdio>
#include <cstdint>
namespace cg = cooperative_groups;

#ifndef PROBE
#define PROBE 0
#endif
#ifndef MEGA
#define MEGA 1
#endif

typedef unsigned short u16;
using bf16x8 = __attribute__((ext_vector_type(8))) short;
using f32x4 = __attribute__((ext_vector_type(4))) float;
using f32x16 = __attribute__((ext_vector_type(16))) float;
typedef __bf16 bf2_t __attribute__((ext_vector_type(2)));
typedef float f2_t __attribute__((ext_vector_type(2)));
#define DI __device__ __forceinline__

__device__ const float TAB_M[1024] = {
  1.00000000e+00f, 0.00000000e+00f, 1.00000000e+00f, 0.00000000e+00f, 1.00000000e+00f, 0.00000000e+00f, 1.00000000e+00f, 0.00000000e+00f,
  1.00000000e+00f, 0.00000000e+00f, 1.00000000e+00f, 0.00000000e+00f, 1.00000000e+00f, 0.00000000e+00f, 1.00000000e+00f, 0.00000000e+00f,
  5.40302277e-01f, 8.41470957e-01f, 9.50415254e-01f, 3.10983598e-01f, 9.95004177e-01f, 9.98334214e-02f, 9.99500036e-01f, 3.16175036e-02f,
  9.99949992e-01f, 9.99983307e-03f, 9.99994993e-01f, 3.16227227e-03f, 9.99999523e-01f, 9.99999931e-04f, 9.99999940e-01f, 3.16227757e-04f,
  -4.16146845e-01f, 9.09297407e-01f, 8.06578398e-01f, 5.91127098e-01f, 9.80066597e-01f, 1.98669329e-01f, 9.98000681e-01f, 6.32033944e-02f,
  9.99800026e-01f, 1.99986659e-02f, 9.99979973e-01f, 6.32451288e-03f, 9.99997973e-01f, 1.99999870e-03f, 9.99999821e-01f, 6.32455456e-04f,
  -9.89992499e-01f, 1.41120002e-01f, 5.82753658e-01f, 8.12648892e-01f, 9.55336511e-01f, 2.95520216e-01f, 9.95503366e-01f, 9.47260857e-02f,
  9.99550045e-01f, 2.99954992e-02f, 9.99954998e-01f, 9.48669016e-03f, 9.99995530e-01f, 2.99999560e-03f, 9.99999523e-01f, 9.48683126e-04f,
  -6.53643608e-01f, -7.56802499e-01f, 3.01137477e-01f, 9.53580737e-01f, 9.21060979e-01f, 3.89418334e-01f, 9.92010653e-01f, 1.26154065e-01f,
  9.99200106e-01f, 3.99893336e-02f, 9.99920011e-01f, 1.26487734e-02f, 9.99992013e-01f, 3.99998948e-03f, 9.99999225e-01f, 1.26491068e-03f,
  2.83662200e-01f, -9.58924294e-01f, -1.03423381e-02f, 9.99946535e-01f, 8.77582550e-01f, 4.79425550e-01f, 9.87526000e-01f, 1.57455876e-01f,
  9.98750269e-01f, 4.99791652e-02f, 9.99875009e-01f, 1.58107281e-02f, 9.99987483e-01f, 4.99997940e-03f, 9.99998748e-01f, 1.58113812e-03f,
  9.60170269e-01f, -2.79415488e-01f, -3.20796400e-01f, 9.47148204e-01f, 8.25335622e-01f, 5.64642489e-01f, 9.82053936e-01f, 1.88600272e-01f,
  9.98200536e-01f, 5.99640049e-02f, 9.99819994e-01f, 1.89725272e-02f, 9.99981999e-01f, 5.99996420e-03f, 9.99998212e-01f, 1.89736532e-03f,
  7.53902256e-01f, 6.56986594e-01f, -5.99437475e-01f, 8.00421596e-01f, 7.64842212e-01f, 6.44217670e-01f, 9.75599885e-01f, 2.19556093e-01f,
  9.97551024e-01f, 6.99428469e-02f, 9.99755025e-01f, 2.21341345e-02f, 9.99975502e-01f, 6.99994294e-03f, 9.99997556e-01f, 2.21359241e-03f,
  -1.45500034e-01f, 9.89358246e-01f, -8.18632424e-01f, 5.74317753e-01f, 6.96706712e-01f, 7.17356086e-01f, 9.68170285e-01f, 2.50292331e-01f,
  9.96801734e-01f, 7.99146891e-02f, 9.99680042e-01f, 2.52955221e-02f, 9.99967992e-01f, 7.99991470e-03f, 9.99996781e-01f, 2.52981926e-03f,
  -9.11130250e-01f, 4.12118495e-01f, -9.56644177e-01f, 2.91259229e-01f, 6.21609926e-01f, 7.83326924e-01f, 9.59772646e-01f, 2.80778319e-01f,
  9.95952725e-01f, 8.98785442e-02f, 9.99595046e-01f, 2.84566563e-02f, 9.99959528e-01f, 8.99987947e-03f, 9.99995947e-01f, 2.84604589e-03f,
  -8.39071512e-01f, -5.44021130e-01f, -9.99786079e-01f, -2.06835698e-02f, 5.40302277e-01f, 8.41470957e-01f, 9.50415313e-01f, 3.10983568e-01f,
  9.95004177e-01f, 9.98334140e-02f, 9.99500036e-01f, 3.16175036e-02f, 9.99949992e-01f, 9.99983400e-03f, 9.99994993e-01f, 3.16227227e-03f,
  4.42569796e-03f, -9.99990225e-01f, -9.43779767e-01f, -3.30574960e-01f, 4.53596085e-01f, 8.91207397e-01f, 9.40107584e-01f, 3.40877861e-01f,
  9.93956089e-01f, 1.09778300e-01f, 9.99395072e-01f, 3.47780399e-02f, 9.99939501e-01f, 1.09997792e-02f, 9.99993920e-01f, 3.47849843e-03f,
  8.43853951e-01f, -5.36572933e-01f, -7.94179380e-01f, -6.07683420e-01f, 3.62357706e-01f, 9.32039082e-01f, 9.28859890e-01f, 3.70431304e-01f,
  9.92808640e-01f, 1.19712204e-01f, 9.99280095e-01f, 3.79382223e-02f, 9.99927998e-01f, 1.19997123e-02f, 9.99992788e-01f, 3.79472389e-03f,
  9.07446802e-01f, 4.20167029e-01f, -5.65820515e-01f, -8.24528456e-01f, 2.67498761e-01f, 9.63558197e-01f, 9.16683376e-01f, 3.99614304e-01f,
  9.91561890e-01f, 1.29634142e-01f, 9.99155104e-01f, 4.10980321e-02f, 9.99915481e-01f, 1.29996343e-02f, 9.99991536e-01f, 4.11094911e-03f,
  1.36737213e-01f, 9.90607381e-01f, -2.81349480e-01f, -9.59605396e-01f, 1.69967160e-01f, 9.85449731e-01f, 9.03590262e-01f, 4.28397775e-01f,
  9.90216017e-01f, 1.39543116e-01f, 9.99020159e-01f, 4.42574248e-02f, 9.99902010e-01f, 1.39995432e-02f, 9.99990225e-01f, 4.42717411e-03f,
  -7.59687901e-01f, 6.50287867e-01f, 3.10223512e-02f, -9.99518692e-01f, 7.07371980e-02f, 9.97494996e-01f, 8.89593601e-01f, 4.56752867e-01f,
  9.88771081e-01f, 1.49438128e-01f, 9.98875201e-01f, 4.74163815e-02f, 9.99887526e-01f, 1.49994381e-02f, 9.99988735e-01f, 4.74339863e-03f,
  -9.57659483e-01f, -2.87903309e-01f, 3.40318173e-01f, -9.40310359e-01f, -2.91995462e-02f, 9.99573588e-01f, 8.74707460e-01f, 4.84651238e-01f,
  9.87227261e-01f, 1.59318209e-01f, 9.98720288e-01f, 5.05748577e-02f, 9.99872029e-01f, 1.59993190e-02f, 9.99987185e-01f, 5.05962269e-03f,
  -2.75163352e-01f, -9.61397469e-01f, 6.15864813e-01f, -7.87851870e-01f, -1.28844544e-01f, 9.91664827e-01f, 8.58946681e-01f, 5.12064993e-01f,
  9.85584795e-01f, 1.69182345e-01f, 9.98555362e-01f, 5.37328273e-02f, 9.99855518e-01f, 1.69991814e-02f, 9.99985576e-01f, 5.37584582e-03f,
  6.60316706e-01f, -7.50987232e-01f, 8.30336154e-01f, -5.57262897e-01f, -2.27202162e-01f, 9.73847628e-01f, 8.42327058e-01f, 5.38966715e-01f,
  9.83843684e-01f, 1.79029569e-01f, 9.98380423e-01f, 5.68902642e-02f, 9.99837995e-01f, 1.79990288e-02f, 9.99983788e-01f, 5.69206895e-03f,
  9.88704622e-01f, 1.49877205e-01f, 9.62463796e-01f, -2.71410108e-01f, -3.23289543e-01f, 9.46300089e-01f, 8.24865162e-01f, 5.65329552e-01f,
  9.82004225e-01f, 1.88858896e-01f, 9.98195529e-01f, 6.00471310e-02f, 9.99819517e-01f, 1.89988576e-02f, 9.99981940e-01f, 6.00829115e-03f,
  4.08082068e-01f, 9.12945271e-01f, 9.99144375e-01f, 4.13582884e-02f, -4.16146845e-01f, 9.09297407e-01f, 8.06578457e-01f, 5.91127038e-01f,
  9.80066597e-01f, 1.98669314e-01f, 9.98000681e-01f, 6.32033944e-02f, 9.99800026e-01f, 1.99986678e-02f, 9.99979973e-01f, 6.32451288e-03f,
  -5.47729254e-01f, 8.36655617e-01f, 9.36740458e-01f, 3.50024760e-01f, -5.04846215e-01f, 8.63209307e-01f, 7.87485182e-01f, 6.16333544e-01f,
  9.78030920e-01f, 2.08459899e-01f, 9.97795820e-01f, 6.63590282e-02f, 9.99779522e-01f, 2.09984574e-02f, 9.99977946e-01f, 6.64073415e-03f,
  -9.99960840e-01f, -8.85130931e-03f, 7.81440377e-01f, 6.23979926e-01f, -5.88501155e-01f, 8.08496356e-01f, 7.67604589e-01f, 6.40923738e-01f,
  9.75897431e-01f, 2.18229622e-01f, 9.97581005e-01f, 6.95140064e-02f, 9.99758005e-01f, 2.19982266e-02f, 9.99975801e-01f, 6.95695449e-03f,
  -5.32833040e-01f, -8.46220434e-01f, 5.48645258e-01f, 8.36055279e-01f, -6.66275978e-01f, 7.45705247e-01f, 7.46956408e-01f, 6.64873064e-01f,
  9.73666370e-01f, 2.27977514e-01f, 9.97356176e-01f, 7.26682767e-02f, 9.99735534e-01f, 2.29979735e-02f, 9.99973536e-01f, 7.27317436e-03f,
  4.24179018e-01f, -9.05578375e-01f, 2.61441678e-01f, 9.65219259e-01f, -7.37393796e-01f, 6.75463140e-01f, 7.25561321e-01f, 6.88157499e-01f,
  9.71337974e-01f, 2.37702623e-01f, 9.97121394e-01f, 7.58218244e-02f, 9.99711990e-01f, 2.39976961e-02f, 9.99971211e-01f, 7.58939330e-03f,
  9.91202831e-01f, -1.32351756e-01f, -5.16893305e-02f, 9.98663187e-01f, -8.01143587e-01f, 5.98472118e-01f, 7.03440726e-01f, 7.10753918e-01f,
  9.68912423e-01f, 2.47403964e-01f, 9.96876657e-01f, 7.89746121e-02f, 9.99687493e-01f, 2.49973964e-02f, 9.99968767e-01f, 7.90561177e-03f,
  6.46919310e-01f, 7.62558460e-01f, -3.59694332e-01f, 9.33070183e-01f, -8.56888831e-01f, 5.15501261e-01f, 6.80616796e-01f, 7.32639611e-01f,
  9.66389954e-01f, 2.57080555e-01f, 9.96621907e-01f, 8.21266174e-02f, 9.99662042e-01f, 2.59970706e-02f, 9.99966204e-01f, 8.22182931e-03f,
  -2.92138815e-01f, 9.56375957e-01f, -6.32028639e-01f, 7.74945021e-01f, -9.04072165e-01f, 4.27379847e-01f, 6.57112300e-01f, 7.53792703e-01f,
  9.63770926e-01f, 2.66731411e-01f, 9.96357203e-01f, 8.52777958e-02f, 9.99635518e-01f, 2.69967206e-02f, 9.99963522e-01f, 8.53804592e-03f,
  -9.62605894e-01f, 2.70905793e-01f, -8.41684937e-01f, 5.39968967e-01f, -9.42222297e-01f, 3.34988207e-01f, 6.32950664e-01f, 7.74192095e-01f,
  9.61055458e-01f, 2.76355654e-01f, 9.96082544e-01f, 8.84281173e-02f, 9.99608040e-01f, 2.79963426e-02f, 9.99960780e-01f, 8.85426160e-03f,
  -7.48057544e-01f, -6.63633883e-01f, -9.67871487e-01f, 2.51445323e-01f, -9.70958173e-01f, 2.39249229e-01f, 6.08156204e-01f, 7.93817401e-01f,
  9.58243906e-01f, 2.85952210e-01f, 9.95797932e-01f, 9.15775672e-02f, 9.99579549e-01f, 2.89959367e-02f, 9.99957979e-01f, 9.17047635e-03f,
  1.54251456e-01f, -9.88031626e-01f, -9.98075247e-01f, -6.20148405e-02f, -9.89992499e-01f, 1.41120002e-01f, 5.82753658e-01f, 8.12648892e-01f,
  9.55336511e-01f, 2.95520186e-01f, 9.95503366e-01f, 9.47260931e-02f, 9.99550045e-01f, 2.99955010e-02f, 9.99954998e-01f, 9.48669016e-03f,
  9.14742351e-01f, -4.04037654e-01f, -9.29300308e-01f, -3.69325012e-01f, -9.99135137e-01f, 4.15805206e-02f, 5.56768358e-01f, 8.30667794e-01f,
  9.52333570e-01f, 3.05058628e-01f, 9.95198846e-01f, 9.78736654e-02f, 9.99519527e-01f, 3.09950355e-02f, 9.99951959e-01f, 9.80290305e-03f,
  8.34223390e-01f, 5.51426709e-01f, -7.68367112e-01f, -6.40009403e-01f, -9.98294771e-01f, -5.83741926e-02f, 5.30226350e-01f, 8.47856104e-01f,
  9.49235439e-01f, 3.14566553e-01f, 9.94884372e-01f, 1.01020269e-01f, 9.99488056e-01f, 3.19945402e-02f, 9.99948800e-01f, 1.01191159e-02f,
  -1.32767474e-02f, 9.99911845e-01f, -5.31235278e-01f, -8.47224355e-01f, -9.87479806e-01f, -1.57745644e-01f, 5.03154159e-01f, 8.64196658e-01f,
  9.46042359e-01f, 3.24043006e-01f, 9.94559944e-01f, 1.04165860e-01f, 9.99455571e-01f, 3.29940096e-02f, 9.99945521e-01f, 1.04353270e-02f,
  -8.48570287e-01f, 5.29082716e-01f, -2.41421118e-01f, -9.70420420e-01f, -9.66798186e-01f, -2.55541205e-01f, 4.75578904e-01f, 8.79673064e-01f,
  9.42754686e-01f, 3.33487093e-01f, 9.94225562e-01f, 1.07310407e-01f, 9.99422073e-01f, 3.39934528e-02f, 9.99942183e-01f, 1.07515370e-02f,
  -9.03692186e-01f, -4.28182662e-01f, 7.23346695e-02f, -9.97380435e-01f, -9.36456680e-01f, -3.50783229e-01f, 4.47528064e-01f, 8.94269884e-01f,
  9.39372718e-01f, 3.42897803e-01f, 9.93881226e-01f, 1.10453881e-01f, 9.99387562e-01f, 3.49928550e-02f, 9.99938726e-01f, 1.10677453e-02f,
  -1.27963692e-01f, -9.91778851e-01f, 3.78916174e-01f, -9.25431013e-01f, -8.96758378e-01f, -4.42520559e-01f, 4.19029742e-01f, 9.07972515e-01f,
  9.35896814e-01f, 3.52274209e-01f, 9.93526995e-01f, 1.13596253e-01f, 9.99352098e-01f, 3.59922275e-02f, 9.99935210e-01f, 1.13839535e-02f,
  7.65414059e-01f, -6.43538117e-01f, 6.47921681e-01f, -7.61706948e-01f, -8.48100007e-01f, -5.29836178e-01f, 3.90112430e-01f, 9.20767248e-01f,
  9.32327330e-01f, 3.61615449e-01f, 9.93162811e-01f, 1.16737492e-01f, 9.99315560e-01f, 3.69915590e-02f, 9.99931574e-01f, 1.17001599e-02f,
  9.55073655e-01f, 2.96368569e-01f, 8.52673113e-01f, -5.22444785e-01f, -7.90967762e-01f, -6.11857831e-01f, 3.60805035e-01f, 9.32641268e-01f,
  9.28664625e-01f, 3.70920479e-01f, 9.92788672e-01f, 1.19877554e-01f, 9.99278069e-01f, 3.79908569e-02f, 9.99927819e-01f, 1.20163653e-02f,
  2.66642928e-01f, 9.63795364e-01f, 9.72865343e-01f, -2.31372014e-01f, -7.25932240e-01f, -6.87766254e-01f, 3.31136853e-01f, 9.43582714e-01f,
  9.24909055e-01f, 3.80188406e-01f, 9.92404640e-01f, 1.23016424e-01f, 9.99239624e-01f, 3.89901139e-02f, 9.99923944e-01f, 1.23325698e-02f,
  -6.66938066e-01f, 7.45113134e-01f, 9.96578991e-01f, 8.26458037e-02f, -6.53643608e-01f, -7.56802499e-01f, 3.01137596e-01f, 9.53580678e-01f,
  9.21060979e-01f, 3.89418334e-01f, 9.92010653e-01f, 1.26154065e-01f, 9.99200106e-01f, 3.99893373e-02f, 9.99920011e-01f, 1.26487734e-02f,
  -9.87339258e-01f, -1.58622667e-01f, 9.21462357e-01f, 3.88467699e-01f, -5.74824035e-01f, -8.18277061e-01f, 2.70837069e-01f, 9.62625206e-01f,
  9.17120814e-01f, 3.98609310e-01f, 9.91606772e-01f, 1.29290432e-01f, 9.99159634e-01f, 4.09885161e-02f, 9.99915957e-01f, 1.29649751e-02f,
  -3.99985313e-01f, -9.16521549e-01f, 7.54965365e-01f, 6.55764699e-01f, -4.90260571e-01f, -8.71575892e-01f, 2.40265876e-01f, 9.70707119e-01f,
  9.13088918e-01f, 4.07760441e-01f, 9.91192937e-01f, 1.32425532e-01f, 9.99118149e-01f, 4.19876575e-02f, 9.99911785e-01f, 1.32811759e-02f,
  5.55113316e-01f, -8.31774771e-01f, 5.13598442e-01f, 8.58030677e-01f, -4.00799006e-01f, -9.16166008e-01f, 2.09454417e-01f, 9.77818429e-01f,
  9.08965766e-01f, 4.16870773e-01f, 9.90769207e-01f, 1.35559291e-01f, 9.99075651e-01f, 4.29867506e-02f, 9.99907553e-01f, 1.35973748e-02f,
  9.99843299e-01f, 1.77019257e-02f, 2.21298173e-01f, 9.75206196e-01f, -3.07332784e-01f, -9.51602101e-01f, 1.78433523e-01f, 9.83951986e-01f,
  9.04751658e-01f, 4.25939471e-01f, 9.90335584e-01f, 1.38691694e-01f, 9.99032140e-01f, 4.39858064e-02f, 9.99903202e-01f, 1.39135728e-02f,
  5.25321960e-01f, 8.50903511e-01f, -9.29481089e-02f, 9.95670974e-01f, -2.10795805e-01f, -9.77530122e-01f, 1.47234216e-01f, 9.89101648e-01f,
  9.00447130e-01f, 4.34965521e-01f, 9.89892066e-01f, 1.41822711e-01f, 9.98987675e-01f, 4.49848175e-02f, 9.99898732e-01f, 1.42297689e-02f,
  -4.32177931e-01f, 9.01788354e-01f, -3.97976756e-01f, 9.17395473e-01f, -1.12152621e-01f, -9.93690968e-01f, 1.15887694e-01f, 9.93262351e-01f,
  8.96052480e-01f, 4.43948090e-01f, 9.89438653e-01f, 1.44952312e-01f, 9.98942196e-01f, 4.59837839e-02f, 9.99894202e-01f, 1.45459641e-02f,
  -9.92335498e-01f, 1.23573124e-01f, -6.63538277e-01f, 7.48142362e-01f, -1.23883775e-02f, -9.99923289e-01f, 8.44252855e-02f, 9.96429801e-01f,
  8.91568303e-01f, 4.52886283e-01f, 9.88975346e-01f, 1.48080453e-01f, 9.98895705e-01f, 4.69827019e-02f, 9.99889553e-01f, 1.48621574e-02f,
  -6.40144348e-01f, -7.68254638e-01f, -8.63296509e-01f, 5.04697084e-01f, 8.74991715e-02f, -9.96164620e-01f, 5.28784581e-02f, 9.98600960e-01f,
  8.86994898e-01f, 4.61779177e-01f, 9.88502085e-01f, 1.51207119e-01f, 9.98848200e-01f, 4.79815714e-02f, 9.99884784e-01f, 1.51783489e-02f,
  3.00592542e-01f, -9.53752637e-01f, -9.77442741e-01f, 2.11200655e-01f, 1.86512470e-01f, -9.82452571e-01f, 2.12787576e-02f, 9.99773562e-01f,
  8.82332861e-01f, 4.70625877e-01f, 9.88018990e-01f, 1.54332280e-01f, 9.98799741e-01f, 4.89803962e-02f, 9.99879956e-01f, 1.54945394e-02f,
  9.64965999e-01f, -2.62374848e-01f, -9.94656444e-01f, -1.03240460e-01f, 2.83662200e-01f, -9.58924294e-01f, -1.03422189e-02f, 9.99946535e-01f,
  8.77582550e-01f, 4.79425550e-01f, 9.87526000e-01f, 1.57455891e-01f, 9.98750269e-01f, 4.99791689e-02f, 9.99875009e-01f, 1.58107281e-02f,
  7.42154181e-01f, 6.70229197e-01f, -9.13230121e-01f, -4.07444149e-01f, 3.77977669e-01f, -9.25814748e-01f, -4.19528559e-02f, 9.99119580e-01f,
  8.72744501e-01f, 4.88177240e-01f, 9.87023175e-01f, 1.60577938e-01f, 9.98699784e-01f, 5.09778969e-02f, 9.99869943e-01f, 1.61269177e-02f,
  -1.62990779e-01f, 9.86627579e-01f, -7.41239965e-01f, -6.71240151e-01f, 4.68516916e-01f, -8.83454502e-01f, -7.35215396e-02f, 9.97293651e-01f,
  8.67819190e-01f, 4.96880114e-01f, 9.86510456e-01f, 1.63698375e-01f, 9.98648286e-01f, 5.19765690e-02f, 9.99864817e-01f, 1.64431017e-02f,
  -9.18282807e-01f, 3.95925164e-01f, -4.95741814e-01f, -8.68469954e-01f, 5.54374516e-01f, -8.32267344e-01f, -1.05016708e-01f, 9.94470477e-01f,
  8.62807095e-01f, 5.05533338e-01f, 9.85987842e-01f, 1.66817173e-01f, 9.98595834e-01f, 5.29751927e-02f, 9.99859571e-01f, 1.67592876e-02f,
  -8.29309821e-01f, -5.58789074e-01f, -2.01079622e-01f, -9.79574919e-01f, 6.34692967e-01f, -7.72764444e-01f, -1.36406869e-01f, 9.90652919e-01f,
  8.57708693e-01f, 5.14135957e-01f, 9.85455394e-01f, 1.69934288e-01f, 9.98542368e-01f, 5.39737605e-02f, 9.99854207e-01f, 1.70754679e-02f,
  2.21267566e-02f, -9.99755144e-01f, 1.13521777e-01f, -9.93535519e-01f, 7.08669782e-01f, -7.05540299e-01f, -1.67660639e-01f, 9.85844791e-01f,
  8.52524519e-01f, 5.22687256e-01f, 9.84913111e-01f, 1.73049718e-01f, 9.98487890e-01f, 5.49722798e-02f, 9.99848783e-01f, 1.73916500e-02f,
  8.53220105e-01f, -5.21551013e-01f, 4.16867077e-01f, -9.08967435e-01f, 7.75565803e-01f, -6.31266713e-01f, -1.98746875e-01f, 9.80050862e-01f,
  8.47255111e-01f, 5.31186223e-01f, 9.84360933e-01f, 1.76163420e-01f, 9.98432398e-01f, 5.59707358e-02f, 9.99843180e-01f, 1.77078284e-02f,
  8.99866819e-01f, 4.36164767e-01f, 6.78870201e-01f, -7.34258294e-01f, 8.34712923e-01f, -5.50685287e-01f, -2.29634270e-01f, 9.73276973e-01f,
  8.41901004e-01f, 5.39632022e-01f, 9.83798921e-01f, 1.79275364e-01f, 9.98375952e-01f, 5.69691435e-02f, 9.99837577e-01f, 1.80240069e-02f,
  1.19180135e-01f, 9.92872655e-01f, 8.73550534e-01f, -4.86733496e-01f, 8.85519624e-01f, -4.64602023e-01f, -2.60292053e-01f, 9.65529919e-01f,
  8.36462677e-01f, 5.48023939e-01f, 9.83227074e-01f, 1.82385504e-01f, 9.98318493e-01f, 5.79674877e-02f, 9.99831796e-01f, 1.83401816e-02f,
  -7.71080196e-01f, 6.36738002e-01f, 9.81602073e-01f, -1.90938011e-01f, 9.27478492e-01f, -3.73876572e-01f, -2.90689558e-01f, 9.56817448e-01f,
  8.30940723e-01f, 5.56361020e-01f, 9.82645452e-01f, 1.85493827e-01f, 9.98260021e-01f, 5.89657798e-02f, 9.99825954e-01f, 1.86563563e-02f,
  -9.52412963e-01f, -3.04810613e-01f, 9.92308319e-01f, 1.23790950e-01f, 9.60170269e-01f, -2.79415488e-01f, -3.20796400e-01f, 9.47148204e-01f,
  8.25335622e-01f, 5.64642429e-01f, 9.82053936e-01f, 1.88600287e-01f, 9.98200536e-01f, 5.99640086e-02f, 9.99819994e-01f, 1.89725272e-02f,
  -2.58101642e-01f, -9.66117799e-01f, 9.04607594e-01f, 4.26245421e-01f, 9.83268440e-01f, -1.82162598e-01f, -3.50582451e-01f, 9.36531842e-01f,
  8.19648027e-01f, 5.72867453e-01f, 9.81452644e-01f, 1.91704854e-01f, 9.98140097e-01f, 6.09621815e-02f, 9.99813974e-01f, 1.92886982e-02f,
  6.73507154e-01f, -7.39180684e-01f, 7.27198064e-01f, 6.86427653e-01f, 9.96542096e-01f, -8.30891207e-02f, -3.80017966e-01f, 9.24979091e-01f,
  8.13878477e-01f, 5.81035137e-01f, 9.80841517e-01f, 1.94807529e-01f, 9.98078644e-01f, 6.19602874e-02f, 9.99807835e-01f, 1.96048655e-02f,
  9.85896587e-01f, 1.67355701e-01f, 4.77671444e-01f, 8.78538549e-01f, 9.99858618e-01f, 1.68140903e-02f, -4.09073502e-01f, 9.12501454e-01f,
  8.08027506e-01f, 5.89144766e-01f, 9.80220556e-01f, 1.97908238e-01f, 9.98016179e-01f, 6.29583374e-02f, 9.99801576e-01f, 1.99210308e-02f,
};
__device__ const float TAB_S[2048] = {
  1.00000000e+00f, 0.00000000e+00f, 1.00000000e+00f, 0.00000000e+00f, 1.00000000e+00f, 0.00000000e+00f, 1.00000000e+00f, 0.00000000e+00f,
  1.00000000e+00f, 0.00000000e+00f, 1.00000000e+00f, 0.00000000e+00f, 1.00000000e+00f, 0.00000000e+00f, 1.00000000e+00f, 0.00000000e+00f,
  1.00000000e+00f, 0.00000000e+00f, 1.00000000e+00f, 0.00000000e+00f, 1.00000000e+00f, 0.00000000e+00f, 1.00000000e+00f, 0.00000000e+00f,
  1.00000000e+00f, 0.00000000e+00f, 1.00000000e+00f, 0.00000000e+00f, 1.00000000e+00f, 0.00000000e+00f, 1.00000000e+00f, 0.00000000e+00f,
  5.40302277e-01f, 8.41470957e-01f, 8.46009135e-01f, 5.33168435e-01f, 9.50415254e-01f, 3.10983598e-01f, 9.84230220e-01f, 1.76892191e-01f,
  9.95004177e-01f, 9.98334214e-02f, 9.98419285e-01f, 5.62044978e-02f, 9.99500036e-01f, 3.16175036e-02f, 9.99841869e-01f, 1.77818574e-02f,
  9.99949992e-01f, 9.99983307e-03f, 9.99984205e-01f, 5.62338345e-03f, 9.99994993e-01f, 3.16227227e-03f, 9.99998391e-01f, 1.77827850e-03f,
  9.99999523e-01f, 9.99999931e-04f, 9.99999821e-01f, 5.62341243e-04f, 9.99999940e-01f, 3.16227757e-04f, 1.00000000e+00f, 1.77827940e-04f,
  -4.16146845e-01f, 9.09297407e-01f, 4.31462824e-01f, 9.02130723e-01f, 8.06578398e-01f, 5.91127098e-01f, 9.37418282e-01f, 3.48205268e-01f,
  9.80066597e-01f, 1.98669329e-01f, 9.93682086e-01f, 1.12231314e-01f, 9.98000681e-01f, 6.32033944e-02f, 9.99367595e-01f, 3.55580896e-02f,
  9.99800026e-01f, 1.99986659e-02f, 9.99936759e-01f, 1.12465890e-02f, 9.99979973e-01f, 6.32451288e-03f, 9.99993682e-01f, 3.55655141e-03f,
  9.99997973e-01f, 1.99999870e-03f, 9.99999344e-01f, 1.12468237e-03f, 9.99999821e-01f, 6.32455456e-04f, 9.99999940e-01f, 3.55655880e-04f,
  -9.89992499e-01f, 1.41120002e-01f, -1.15966164e-01f, 9.93253171e-01f, 5.82753658e-01f, 8.12648892e-01f, 8.61040652e-01f, 5.08536100e-01f,
  9.55336511e-01f, 2.95520216e-01f, 9.85803485e-01f, 1.67903304e-01f, 9.95503366e-01f, 9.47260857e-02f, 9.98577297e-01f, 5.33230826e-02f,
  9.99550045e-01f, 2.99954992e-02f, 9.99857724e-01f, 1.68694388e-02f, 9.99954998e-01f, 9.48669016e-03f, 9.99985754e-01f, 5.33481315e-03f,
  9.99995530e-01f, 2.99999560e-03f, 9.99998569e-01f, 1.68702309e-03f, 9.99999523e-01f, 9.48683126e-04f, 9.99999881e-01f, 5.33483806e-04f,
  -6.53643608e-01f, -7.56802499e-01f, -6.27679706e-01f, 7.78471708e-01f, 3.01137477e-01f, 9.53580737e-01f, 7.57506192e-01f, 6.52827978e-01f,
  9.21060979e-01f, 3.89418334e-01f, 9.74808276e-01f, 2.23044485e-01f, 9.92010653e-01f, 1.26154065e-01f, 9.97471273e-01f, 7.10712075e-02f,
  9.99200106e-01f, 3.99893336e-02f, 9.99747038e-01f, 2.24917568e-02f, 9.99920011e-01f, 1.26487734e-02f, 9.99974728e-01f, 7.11305765e-03f,
  9.99992013e-01f, 3.99998948e-03f, 9.99997497e-01f, 2.24936334e-03f, 9.99999225e-01f, 1.26491068e-03f, 9.99999762e-01f, 7.11311703e-04f,
  2.83662200e-01f, -9.58924294e-01f, -9.46079254e-01f, 3.23935270e-01f, -1.03423381e-02f, 9.99946535e-01f, 6.30080283e-01f, 7.76529968e-01f,
  8.77582550e-01f, 4.79425550e-01f, 9.60731268e-01f, 2.77480543e-01f, 9.87526000e-01f, 1.57455876e-01f, 9.96049762e-01f, 8.87968615e-02f,
  9.98750269e-01f, 4.99791652e-02f, 9.99604762e-01f, 2.81133614e-02f, 9.99875009e-01f, 1.58107281e-02f, 9.99960482e-01f, 8.89127981e-03f,
  9.99987483e-01f, 4.99997940e-03f, 9.99996066e-01f, 2.81170290e-03f, 9.99998748e-01f, 1.58113812e-03f, 9.99999583e-01f, 8.89139599e-04f,
  9.60170269e-01f, -2.79415488e-01f, -9.73103702e-01f, -2.30367512e-01f, -3.20796400e-01f, 9.47148204e-01f, 4.82782036e-01f, 8.75740528e-01f,
  8.25335622e-01f, 5.64642489e-01f, 9.43616986e-01f, 3.31039310e-01f, 9.82053936e-01f, 1.88600272e-01f, 9.94313300e-01f, 1.06494442e-01f,
  9.98200536e-01f, 5.99640049e-02f, 9.99430835e-01f, 3.37340795e-02f, 9.99819994e-01f, 1.89725272e-02f, 9.99943078e-01f, 1.06694745e-02f,
  9.99981999e-01f, 5.99996420e-03f, 9.99994338e-01f, 3.37404152e-03f, 9.99998212e-01f, 1.89736532e-03f, 9.99999404e-01f, 1.06696738e-03f,
  7.53902256e-01f, 6.56986594e-01f, -7.00429797e-01f, -7.13721275e-01f, -5.99437475e-01f, 8.00421596e-01f, 3.20257008e-01f, 9.47330713e-01f,
  7.64842212e-01f, 6.44217670e-01f, 9.23519433e-01f, 3.83551568e-01f, 9.75599885e-01f, 2.19556093e-01f, 9.92262423e-01f, 1.24158338e-01f,
  9.97551024e-01f, 6.99428469e-02f, 9.99225318e-01f, 3.93537246e-02f, 9.99755025e-01f, 2.21341345e-02f, 9.99922514e-01f, 1.24476347e-02f,
  9.99975502e-01f, 6.99994294e-03f, 9.99992251e-01f, 3.93637875e-03f, 9.99997556e-01f, 2.21359241e-03f, 9.99999225e-01f, 1.24479528e-03f,
  -1.45500034e-01f, 9.89358246e-01f, -2.12036446e-01f, -9.77261782e-01f, -8.18632424e-01f, 5.74317753e-01f, 1.47631213e-01f, 9.89042461e-01f,
  6.96706712e-01f, 7.17356086e-01f, 9.00502324e-01f, 4.34851229e-01f, 9.68170285e-01f, 2.50292331e-01f, 9.89897788e-01f, 1.41782969e-01f,
  9.96801734e-01f, 7.99146891e-02f, 9.98988271e-01f, 4.49721329e-02f, 9.99680042e-01f, 2.52955221e-02f, 9.99898791e-01f, 1.42257558e-02f,
  9.99967992e-01f, 7.99991470e-03f, 9.99989867e-01f, 4.49871505e-03f, 9.99996781e-01f, 2.52981926e-03f, 9.99998987e-01f, 1.42262306e-03f,
  -9.11130250e-01f, 4.12118495e-01f, 3.41660261e-01f, -9.39823508e-01f, -9.56644177e-01f, 2.91259229e-01f, -2.96507962e-02f, 9.99560297e-01f,
  6.21609926e-01f, 7.83326924e-01f, 8.74638259e-01f, 4.84776139e-01f, 9.59772646e-01f, 2.80778319e-01f, 9.87220109e-01f, 1.59362778e-01f,
  9.95952725e-01f, 8.98785442e-02f, 9.98719573e-01f, 5.05891182e-02f, 9.99595046e-01f, 2.84566563e-02f, 9.99871910e-01f, 1.60038304e-02f,
  9.99959528e-01f, 8.99987947e-03f, 9.99987185e-01f, 5.06105041e-03f, 9.99995947e-01f, 2.84604589e-03f, 9.99998748e-01f, 1.60045072e-03f,
  -8.39071512e-01f, -5.44021130e-01f, 7.90131867e-01f, -6.12936914e-01f, -9.99786079e-01f, -2.06835698e-02f, -2.05997631e-01f, 9.78552461e-01f,
  5.40302277e-01f, 8.41470957e-01f, 8.46009135e-01f, 5.33168435e-01f, 9.50415313e-01f, 3.10983568e-01f, 9.84230220e-01f, 1.76892191e-01f,
  9.95004177e-01f, 9.98334140e-02f, 9.98419285e-01f, 5.62044978e-02f, 9.99500036e-01f, 3.16175036e-02f, 9.99841869e-01f, 1.77818574e-02f,
  9.99949992e-01f, 9.99983400e-03f, 9.99984205e-01f, 5.62338345e-03f, 9.99994993e-01f, 3.16227227e-03f, 9.99998391e-01f, 1.77827850e-03f,
  4.42569796e-03f, -9.99990225e-01f, 9.95257378e-01f, -9.72764567e-02f, -9.43779767e-01f, -3.30574960e-01f, -3.75847399e-01f, 9.26681578e-01f,
  4.53596085e-01f, 8.91207397e-01f, 8.14705312e-01f, 5.79875171e-01f, 9.40107584e-01f, 3.40877861e-01f, 9.80929136e-01f, 1.94365650e-01f,
  9.93956089e-01f, 1.09778300e-01f, 9.98087406e-01f, 6.18181042e-02f, 9.99395072e-01f, 3.47780399e-02f, 9.99808669e-01f, 1.95598267e-02f,
  9.99939501e-01f, 1.09997792e-02f, 9.99980867e-01f, 6.18571462e-03f, 9.99993920e-01f, 3.47849843e-03f, 9.99998093e-01f, 1.95610616e-03f,
  8.43853951e-01f, -5.36572933e-01f, 8.93861592e-01f, 4.48342979e-01f, -7.94179380e-01f, -6.07683420e-01f, -5.33843040e-01f, 8.45583618e-01f,
  3.62357706e-01f, 9.32039082e-01f, 7.80825913e-01f, 6.24748647e-01f, 9.28859890e-01f, 3.70431304e-01f, 9.77317870e-01f, 2.11777672e-01f,
  9.92808640e-01f, 1.19712204e-01f, 9.97723997e-01f, 6.74297586e-02f, 9.99280095e-01f, 3.79382223e-02f, 9.99772310e-01f, 2.13377345e-02f,
  9.99927998e-01f, 1.19997123e-02f, 9.99977231e-01f, 6.74804440e-03f, 9.99992788e-01f, 3.79472389e-03f, 9.99997735e-01f, 2.13393359e-03f,
  9.07446802e-01f, 4.20167029e-01f, 5.17172873e-01f, 8.55880976e-01f, -5.65820515e-01f, -8.24528456e-01f, -6.75001681e-01f, 7.37816215e-01f,
  2.67498761e-01f, 9.63558197e-01f, 7.44477987e-01f, 6.67647004e-01f, 9.16683376e-01f, 3.99614304e-01f, 9.73397553e-01f, 2.29122713e-01f,
  9.91561890e-01f, 1.29634142e-01f, 9.97329056e-01f, 7.30392784e-02f, 9.99155104e-01f, 4.10980321e-02f, 9.99732792e-01f, 2.31155735e-02f,
  9.99915481e-01f, 1.29996343e-02f, 9.99973297e-01f, 7.31037185e-03f, 9.99991536e-01f, 4.11094911e-03f, 9.99997318e-01f, 2.31176103e-03f,
  1.36737213e-01f, 9.90607381e-01f, -1.87961515e-02f, 9.99823332e-01f, -2.81349480e-01f, -9.59605396e-01f, -7.94870913e-01f, 6.06778562e-01f,
  1.69967160e-01f, 9.85449731e-01f, 7.05776393e-01f, 7.08434701e-01f, 9.03590262e-01f, 4.28397775e-01f, 9.69169438e-01f, 2.46395305e-01f,
  9.90216017e-01f, 1.39543116e-01f, 9.96902585e-01f, 7.86464810e-02f, 9.99020159e-01f, 4.42574248e-02f, 9.99690115e-01f, 2.48933397e-02f,
  9.99902010e-01f, 1.39995432e-02f, 9.99969006e-01f, 7.87269697e-03f, 9.99990225e-01f, 4.42717411e-03f, 9.99996901e-01f, 2.48958869e-03f,
  -7.59687901e-01f, 6.50287867e-01f, -5.48975468e-01f, 8.35838437e-01f, 3.10223512e-02f, -9.99518692e-01f, -8.89670432e-01f, 4.56603259e-01f,
  7.07371980e-02f, 9.97494996e-01f, 6.64843500e-01f, 7.46982634e-01f, 8.89593601e-01f, 4.56752867e-01f, 9.64634836e-01f, 2.63589978e-01f,
  9.88771081e-01f, 1.49438128e-01f, 9.96444523e-01f, 8.42512026e-02f, 9.98875201e-01f, 4.74163815e-02f, 9.99644279e-01f, 2.66710296e-02f,
  9.99887526e-01f, 1.49994381e-02f, 9.99964416e-01f, 8.43502022e-03f, 9.99988735e-01f, 4.74339863e-03f, 9.99996424e-01f, 2.66741589e-03f,
  -9.57659483e-01f, -2.87903309e-01f, -9.10081089e-01f, 4.14430231e-01f, 3.40318173e-01f, -9.40310359e-01f, -9.56410050e-01f, 2.92027086e-01f,
  -2.91995462e-02f, 9.99573588e-01f, 6.21808827e-01f, 7.83169091e-01f, 8.74707460e-01f, 4.84651238e-01f, 9.59795177e-01f, 2.80701309e-01f,
  9.87227261e-01f, 1.59318209e-01f, 9.95954990e-01f, 8.98532644e-02f, 9.98720288e-01f, 5.05748577e-02f, 9.99595284e-01f, 2.84486320e-02f,
  9.99872029e-01f, 1.59993190e-02f, 9.99959528e-01f, 8.99733976e-03f, 9.99987185e-01f, 5.05962269e-03f, 9.99995947e-01f, 2.84524332e-03f,
  -2.75163352e-01f, -9.61397469e-01f, -9.90897954e-01f, -1.34615138e-01f, 6.15864813e-01f, -7.87851870e-01f, -9.92985010e-01f, 1.18240520e-01f,
  -1.28844544e-01f, 9.91664827e-01f, 5.76808274e-01f, 8.16879570e-01f, 8.58946681e-01f, 5.12064993e-01f, 9.54652011e-01f, 2.97723860e-01f,
  9.85584795e-01f, 1.69182345e-01f, 9.95433986e-01f, 9.54524800e-02f, 9.98555362e-01f, 5.37328273e-02f, 9.99543071e-01f, 3.02261449e-02f,
  9.99855518e-01f, 1.69991814e-02f, 9.99954283e-01f, 9.55965649e-03f, 9.99985576e-01f, 5.37584582e-03f, 9.99995410e-01f, 3.02307028e-03f,
  6.60316706e-01f, -7.50987232e-01f, -7.66536534e-01f, -6.42200708e-01f, 8.30336154e-01f, -5.57262897e-01f, -9.98241663e-01f, -5.92755191e-02f,
  -2.27202162e-01f, 9.73847628e-01f, 5.29984176e-01f, 8.48007560e-01f, 8.42327058e-01f, 5.38966715e-01f, 9.49207008e-01f, 3.14652264e-01f,
  9.83843684e-01f, 1.79029569e-01f, 9.94881511e-01f, 1.01048686e-01f, 9.98380423e-01f, 5.68902642e-02f, 9.99487758e-01f, 3.20035629e-02f,
  9.99837995e-01f, 1.79990288e-02f, 9.99948800e-01f, 1.01219704e-02f, 9.99983788e-01f, 5.69206895e-03f, 9.99994874e-01f, 3.20089748e-03f,
  9.88704622e-01f, 1.49877205e-01f, -3.06095392e-01f, -9.52000856e-01f, 9.62463796e-01f, -2.71410108e-01f, -9.72014248e-01f, -2.34921798e-01f,
  -3.23289543e-01f, 9.46300089e-01f, 4.81484592e-01f, 8.76454532e-01f, 8.24865162e-01f, 5.65329552e-01f, 9.43461835e-01f, 3.31481189e-01f,
  9.82004225e-01f, 1.88858896e-01f, 9.94297504e-01f, 1.06641680e-01f, 9.98195529e-01f, 6.00471310e-02f, 9.99429286e-01f, 3.37808803e-02f,
  9.99819517e-01f, 1.89988576e-02f, 9.99942899e-01f, 1.06842816e-02f, 9.99981940e-01f, 6.00829115e-03f, 9.99994278e-01f, 3.37872445e-03f,
  4.08082068e-01f, 9.12945271e-01f, 2.48616725e-01f, -9.68601942e-01f, 9.99144375e-01f, 4.13582884e-02f, -9.15129960e-01f, -4.03158993e-01f,
  -4.16146845e-01f, 9.09297407e-01f, 4.31462824e-01f, 9.02130723e-01f, 8.06578457e-01f, 5.91127038e-01f, 9.37418282e-01f, 3.48205268e-01f,
  9.80066597e-01f, 1.98669314e-01f, 9.93682086e-01f, 1.12231314e-01f, 9.98000681e-01f, 6.32033944e-02f, 9.99367595e-01f, 3.55580896e-02f,
  9.99800026e-01f, 1.99986678e-02f, 9.99936759e-01f, 1.12465890e-02f, 9.99979973e-01f, 6.32451288e-03f, 9.99993682e-01f, 3.55655141e-03f,
  -5.47729254e-01f, 8.36655617e-01f, 7.26760268e-01f, -6.86891198e-01f, 9.36740458e-01f, 3.50024760e-01f, -8.29382956e-01f, -5.58680534e-01f,
  -5.04846215e-01f, 8.63209307e-01f, 3.80077004e-01f, 9.24954832e-01f, 7.87485182e-01f, 6.16333544e-01f, 9.31078374e-01f, 3.64819258e-01f,
  9.78030920e-01f, 2.08459899e-01f, 9.93035257e-01f, 1.17817394e-01f, 9.97795820e-01f, 6.63590282e-02f, 9.99302804e-01f, 3.73351872e-02f,
  9.99779522e-01f, 2.09984574e-02f, 9.99930263e-01f, 1.18088927e-02f, 9.99977946e-01f, 6.64073415e-03f, 9.99993026e-01f, 3.73437814e-03f,
  -9.99960840e-01f, -8.85130931e-03f, 9.81074572e-01f, -1.93630233e-01f, 7.81440377e-01f, 6.23979926e-01f, -7.17477441e-01f, -6.96581721e-01f,
  -5.88501155e-01f, 8.08496356e-01f, 3.27489585e-01f, 9.44854796e-01f, 7.67604589e-01f, 6.40923738e-01f, 9.24443960e-01f, 3.81317884e-01f,
  9.75897431e-01f, 2.18229622e-01f, 9.92357016e-01f, 1.23399742e-01f, 9.97581005e-01f, 6.95140064e-02f, 9.99234855e-01f, 3.91121693e-02f,
  9.99758005e-01f, 2.19982266e-02f, 9.99923468e-01f, 1.23711927e-02f, 9.99975801e-01f, 6.95695449e-03f, 9.99992371e-01f, 3.91220488e-03f,
  -5.32833040e-01f, -8.46220434e-01f, 9.33235765e-01f, 3.59264523e-01f, 5.48645258e-01f, 8.36055279e-01f, -5.82943261e-01f, -8.12512875e-01f,
  -6.66275978e-01f, 7.45705247e-01f, 2.73866832e-01f, 9.61767614e-01f, 7.46956408e-01f, 6.64873064e-01f, 9.17517304e-01f, 3.97695929e-01f,
  9.73666370e-01f, 2.27977514e-01f, 9.91647422e-01f, 1.28978193e-01f, 9.97356176e-01f, 7.26682767e-02f, 9.99163687e-01f, 4.08890247e-02f,
  9.99735534e-01f, 2.29979735e-02f, 9.99916375e-01f, 1.29334899e-02f, 9.99973536e-01f, 7.27317436e-03f, 9.99991655e-01f, 4.09003161e-03f,
  4.24179018e-01f, -9.05578375e-01f, 5.97977161e-01f, 8.01513135e-01f, 2.61441678e-01f, 9.65219259e-01f, -4.30023283e-01f, -9.02817786e-01f,
  -7.37393796e-01f, 6.75463140e-01f, 2.19378278e-01f, 9.75639880e-01f, 7.25561321e-01f, 6.88157499e-01f, 9.10300434e-01f, 4.13948208e-01f,
  9.71337974e-01f, 2.37702623e-01f, 9.90906477e-01f, 1.34552568e-01f, 9.97121394e-01f, 7.58218244e-02f, 9.99089420e-01f, 4.26657498e-02f,
  9.99711990e-01f, 2.39976961e-02f, 9.99908924e-01f, 1.34957815e-02f, 9.99971211e-01f, 7.58939330e-03f, 9.99990880e-01f, 4.26785741e-03f,
  9.91202831e-01f, -1.32351756e-01f, 7.85522610e-02f, 9.96909976e-01f, -5.16893305e-02f, 9.98663187e-01f, -2.63540596e-01f, -9.64648306e-01f,
  -8.01143587e-01f, 5.98472118e-01f, 1.64196163e-01f, 9.86427724e-01f, 7.03440726e-01f, 7.10753918e-01f, 9.02795732e-01f, 4.30069596e-01f,
  9.68912423e-01f, 2.47403964e-01f, 9.90134120e-01f, 1.40122697e-01f, 9.96876657e-01f, 7.89746121e-02f, 9.99011934e-01f, 4.44423407e-02f,
  9.99687493e-01f, 2.49973964e-02f, 9.99901175e-01f, 1.40580693e-02f, 9.99968767e-01f, 7.90561177e-03f, 9.99990106e-01f, 4.44568414e-03f,
  6.46919310e-01f, 7.62558460e-01f, -4.65064496e-01f, 8.85276794e-01f, -3.59694332e-01f, 9.33070183e-01f, -8.87455046e-02f, -9.96054351e-01f,
  -8.56888831e-01f, 5.15501261e-01f, 1.08494945e-01f, 9.94096994e-01f, 6.80616796e-01f, 7.32639611e-01f, 8.95005584e-01f, 4.46054995e-01f,
  9.66389954e-01f, 2.57080555e-01f, 9.89330530e-01f, 1.45688385e-01f, 9.96621907e-01f, 8.21266174e-02f, 9.98931348e-01f, 4.62187938e-02f,
  9.99662042e-01f, 2.59970706e-02f, 9.99893129e-01f, 1.46203535e-02f, 9.99966204e-01f, 8.22182931e-03f, 9.99989331e-01f, 4.62350994e-03f,
  -2.92138815e-01f, 9.56375957e-01f, -8.65450621e-01f, 5.00994205e-01f, -6.32028639e-01f, 7.74945021e-01f, 8.88481140e-02f, -9.96045172e-01f,
  -9.04072165e-01f, 4.27379847e-01f, 5.24506159e-02f, 9.98623490e-01f, 6.57112300e-01f, 7.53792703e-01f, 8.86932373e-01f, 4.61899310e-01f,
  9.63770926e-01f, 2.66731411e-01f, 9.88495648e-01f, 1.51249468e-01f, 9.96357203e-01f, 8.52777958e-02f, 9.98847544e-01f, 4.79951017e-02f,
  9.99635518e-01f, 2.69967206e-02f, 9.99884725e-01f, 1.51826320e-02f, 9.99963522e-01f, 8.53804592e-03f, 9.99988496e-01f, 4.80133574e-03f,
  -9.62605894e-01f, 2.70905793e-01f, -9.99293387e-01f, -3.75856608e-02f, -8.41684937e-01f, 5.39968967e-01f, 2.63639510e-01f, -9.64621305e-01f,
  -9.42222297e-01f, 3.34988207e-01f, -3.75941908e-03f, 9.99992907e-01f, 6.32950664e-01f, 7.74192095e-01f, 8.78578722e-01f, 4.77597594e-01f,
  9.61055458e-01f, 2.76355654e-01f, 9.87629473e-01f, 1.56805754e-01f, 9.96082544e-01f, 8.84281173e-02f, 9.98760641e-01f, 4.97712530e-02f,
  9.99608040e-01f, 2.79963426e-02f, 9.99876022e-01f, 1.57449059e-02f, 9.99960780e-01f, 8.85426160e-03f, 9.99987602e-01f, 4.97916201e-03f,
  -7.48057544e-01f, -6.63633883e-01f, -8.25371623e-01f, -5.64589798e-01f, -9.67871487e-01f, 2.51445323e-01f, 4.30115849e-01f, -9.02773678e-01f,
  -9.70958173e-01f, 2.39249229e-01f, -5.99575676e-02f, 9.98200953e-01f, 6.08156204e-01f, 7.93817401e-01f, 8.69947195e-01f, 4.93144840e-01f,
  9.58243906e-01f, 2.85952210e-01f, 9.86732066e-01f, 1.62357092e-01f, 9.95797932e-01f, 9.15775672e-02f, 9.98670578e-01f, 5.15472479e-02f,
  9.99579549e-01f, 2.89959367e-02f, 9.99867022e-01f, 1.63071752e-02f, 9.99957979e-01f, 9.17047635e-03f, 9.99986708e-01f, 5.15698735e-03f,
  1.54251456e-01f, -9.88031626e-01f, -3.97251874e-01f, -9.17709649e-01f, -9.98075247e-01f, -6.20148405e-02f, 5.83026946e-01f, -8.12452853e-01f,
  -9.89992499e-01f, 1.41120002e-01f, -1.15966164e-01f, 9.93253171e-01f, 5.82753658e-01f, 8.12648892e-01f, 8.61040652e-01f, 5.08536100e-01f,
  9.55336511e-01f, 2.95520186e-01f, 9.85803485e-01f, 1.67903304e-01f, 9.95503366e-01f, 9.47260931e-02f, 9.98577297e-01f, 5.33230826e-02f,
  9.99550045e-01f, 2.99955010e-02f, 9.99857724e-01f, 1.68694388e-02f, 9.99954998e-01f, 9.48669016e-03f, 9.99985754e-01f, 5.33481315e-03f,
  9.14742351e-01f, -4.04037654e-01f, 1.53215483e-01f, -9.88192797e-01f, -9.29300308e-01f, -3.69325012e-01f, 7.17549205e-01f, -6.96507812e-01f,
  -9.99135137e-01f, 4.15805206e-02f, -1.71608135e-01f, 9.85165298e-01f, 5.56768358e-01f, 8.30667794e-01f, 8.51861775e-01f, 5.23766637e-01f,
  9.52333570e-01f, 3.05058628e-01f, 9.84843671e-01f, 1.73444211e-01f, 9.95198846e-01f, 9.78736654e-02f, 9.98480916e-01f, 5.50987460e-02f,
  9.99519527e-01f, 3.09950355e-02f, 9.99848068e-01f, 1.74316969e-02f, 9.99951959e-01f, 9.80290305e-03f, 9.99984801e-01f, 5.51263802e-03f,
  8.34223390e-01f, 5.51426709e-01f, 6.56495154e-01f, -7.54330218e-01f, -7.68367112e-01f, -6.40009403e-01f, 8.29440355e-01f, -5.58595300e-01f,
  -9.98294771e-01f, -5.83741926e-02f, -2.26707578e-01f, 9.73962843e-01f, 5.30226350e-01f, 8.47856104e-01f, 8.42413545e-01f, 5.38831532e-01f,
  9.49235439e-01f, 3.14566553e-01f, 9.83852804e-01f, 1.78979620e-01f, 9.94884372e-01f, 1.01020269e-01f, 9.98381376e-01f, 5.68742342e-02f,
  9.99488056e-01f, 3.19945402e-02f, 9.99838114e-01f, 1.79939512e-02f, 9.99948800e-01f, 1.01191159e-02f, 9.99983788e-01f, 5.69046335e-03f,
  -1.32767474e-02f, 9.99911845e-01f, 9.57586050e-01f, -2.88147390e-01f, -5.31235278e-01f, -8.47224355e-01f, 9.15171385e-01f, -4.03064936e-01f,
  -9.87479806e-01f, -1.57745644e-01f, -2.81090319e-01f, 9.59681332e-01f, 5.03154159e-01f, 8.64196658e-01f, 8.32698941e-01f, 5.53726017e-01f,
  9.46042359e-01f, 3.24043006e-01f, 9.82830763e-01f, 1.84509367e-01f, 9.94559944e-01f, 1.04165860e-01f, 9.98278618e-01f, 5.86495437e-02f,
  9.99455571e-01f, 3.29940096e-02f, 9.99827802e-01f, 1.85561981e-02f, 9.99945521e-01f, 1.04353270e-02f, 9.99982774e-01f, 5.86828869e-03f,
  -8.48570287e-01f, 5.29082716e-01f, 9.63757515e-01f, 2.66779721e-01f, -2.41421118e-01f, -9.70420420e-01f, 9.72038329e-01f, -2.34822124e-01f,
  -9.66798186e-01f, -2.55541205e-01f, -3.34584385e-01f, 9.42365825e-01f, 4.75578904e-01f, 8.79673064e-01f, 8.22721004e-01f, 5.68445385e-01f,
  9.42754686e-01f, 3.33487093e-01f, 9.81777668e-01f, 1.90033287e-01f, 9.94225562e-01f, 1.07310407e-01f, 9.98172760e-01f, 6.04246669e-02f,
  9.99422073e-01f, 3.39934528e-02f, 9.99817252e-01f, 1.91184394e-02f, 9.99942183e-01f, 1.07515370e-02f, 9.99981701e-01f, 6.04611309e-03f,
  -9.03692186e-01f, -4.28182662e-01f, 6.73110247e-01f, 7.39542127e-01f, 7.23346695e-02f, -9.97380435e-01f, 9.98247743e-01f, -5.91726787e-02f,
  -9.36456680e-01f, -3.50783229e-01f, -3.87020677e-01f, 9.22071040e-01f, 4.47528064e-01f, 8.94269884e-01f, 8.12482953e-01f, 5.82984984e-01f,
  9.39372718e-01f, 3.42897803e-01f, 9.80693519e-01f, 1.95551202e-01f, 9.93881226e-01f, 1.10453881e-01f, 9.98063743e-01f, 6.21996038e-02f,
  9.99387562e-01f, 3.49928550e-02f, 9.99806345e-01f, 1.96806751e-02f, 9.99938726e-01f, 1.10677453e-02f, 9.99980628e-01f, 6.22393796e-03f,
  -1.27963692e-01f, -9.91778851e-01f, 1.75156534e-01f, 9.84540582e-01f, 3.78916174e-01f, -9.25431013e-01f, 9.92972851e-01f, 1.18342586e-01f,
  -8.96758378e-01f, -4.42520559e-01f, -4.38233554e-01f, 8.98861170e-01f, 4.19029742e-01f, 9.07972515e-01f, 8.01987886e-01f, 5.97340286e-01f,
  9.35896814e-01f, 3.52274209e-01f, 9.79578316e-01f, 2.01062918e-01f, 9.93526995e-01f, 1.13596253e-01f, 9.97951567e-01f, 6.39743358e-02f,
  9.99352098e-01f, 3.59922275e-02f, 9.99795079e-01f, 2.02429052e-02f, 9.99935210e-01f, 1.13839535e-02f, 9.99979496e-01f, 6.40176190e-03f,
  7.65414059e-01f, -6.43538117e-01f, -3.76742303e-01f, 9.26318109e-01f, 6.47921681e-01f, -7.61706948e-01f, 9.56380010e-01f, 2.92125374e-01f,
  -8.48100007e-01f, -5.29836178e-01f, -4.88060862e-01f, 8.72809589e-01f, 3.90112430e-01f, 9.20767248e-01f, 7.91239262e-01f, 6.11506701e-01f,
  9.32327330e-01f, 3.61615449e-01f, 9.78432178e-01f, 2.06568271e-01f, 9.93162811e-01f, 1.16737492e-01f, 9.97836173e-01f, 6.57488778e-02f,
  9.99315560e-01f, 3.69915590e-02f, 9.99783576e-01f, 2.08051261e-02f, 9.99931574e-01f, 1.17001599e-02f, 9.99978364e-01f, 6.57958630e-03f,
  9.55073655e-01f, 2.96368569e-01f, -8.12611222e-01f, 5.82806170e-01f, 8.52673113e-01f, -5.22444785e-01f, 8.89623463e-01f, 4.56694692e-01f,
  -7.90967762e-01f, -6.11857831e-01f, -5.36345184e-01f, 8.43998730e-01f, 3.60805035e-01f, 9.32641268e-01f, 7.80240417e-01f, 6.25479698e-01f,
  9.28664625e-01f, 3.70920479e-01f, 9.77255106e-01f, 2.12067112e-01f, 9.92788672e-01f, 1.19877554e-01f, 9.97717679e-01f, 6.75232038e-02f,
  9.99278069e-01f, 3.79908569e-02f, 9.99771714e-01f, 2.13673431e-02f, 9.99927819e-01f, 1.20163653e-02f, 9.99977171e-01f, 6.75741071e-03f,
  2.66642928e-01f, 9.63795364e-01f, -9.98210371e-01f, 5.98003156e-02f, 9.72865343e-01f, -2.31372014e-01f, 7.94808388e-01f, 6.06860459e-01f,
  -7.25932240e-01f, -6.87766254e-01f, -5.82933903e-01f, 8.12519610e-01f, 3.31136853e-01f, 9.43582714e-01f, 7.68994927e-01f, 6.39254928e-01f,
  9.24909055e-01f, 3.80188406e-01f, 9.76047099e-01f, 2.17559248e-01f, 9.92404640e-01f, 1.23016424e-01f, 9.97596025e-01f, 6.92973137e-02f,
  9.99239624e-01f, 3.89901139e-02f, 9.99759495e-01f, 2.19295528e-02f, 9.99923944e-01f, 1.23325698e-02f, 9.99975979e-01f, 6.93523418e-03f,
  -6.66938066e-01f, 7.45113134e-01f, -8.76379430e-01f, -4.81621295e-01f, 9.96578991e-01f, 8.26458037e-02f, 6.74925625e-01f, 7.37885714e-01f,
  -6.53643608e-01f, -7.56802499e-01f, -6.27679706e-01f, 7.78471708e-01f, 3.01137596e-01f, 9.53580678e-01f, 7.57506192e-01f, 6.52827978e-01f,
  9.21060979e-01f, 3.89418334e-01f, 9.74808276e-01f, 2.23044485e-01f, 9.92010653e-01f, 1.26154065e-01f, 9.97471273e-01f, 7.10712075e-02f,
  9.99200106e-01f, 3.99893373e-02f, 9.99747038e-01f, 2.24917568e-02f, 9.99920011e-01f, 1.26487734e-02f, 9.99974728e-01f, 7.11305765e-03f,
  -9.87339258e-01f, -1.58622667e-01f, -4.84639406e-01f, -8.74714017e-01f, 9.21462357e-01f, 3.88467699e-01f, 5.33756077e-01f, 8.45638454e-01f,
  -5.74824035e-01f, -8.18277061e-01f, -6.70441091e-01f, 7.41962790e-01f, 2.70837069e-01f, 9.62625206e-01f, 7.45777905e-01f, 6.66194677e-01f,
  9.17120814e-01f, 3.98609310e-01f, 9.73538578e-01f, 2.28522688e-01f, 9.91606772e-01f, 1.29290432e-01f, 9.97343302e-01f, 7.28448778e-02f,
  9.99159634e-01f, 4.09885161e-02f, 9.99734223e-01f, 2.30539497e-02f, 9.99915957e-01f, 1.29649751e-02f, 9.99973416e-01f, 7.29088066e-03f,
  -3.99985313e-01f, -9.16521549e-01f, 5.63609414e-02f, -9.98410463e-01f, 7.54965365e-01f, 6.55764699e-01f, 3.75752151e-01f, 9.26720202e-01f,
  -4.90260571e-01f, -8.71575892e-01f, -7.11082935e-01f, 7.03108132e-01f, 2.40265876e-01f, 9.70707119e-01f, 7.33813822e-01f, 6.79350674e-01f,
  9.13088918e-01f, 4.07760441e-01f, 9.72238123e-01f, 2.33993664e-01f, 9.91192937e-01f, 1.32425532e-01f, 9.97212172e-01f, 7.46183172e-02f,
  9.99118149e-01f, 4.19876575e-02f, 9.99721110e-01f, 2.36161388e-02f, 9.99911785e-01f, 1.32811759e-02f, 9.99972105e-01f, 7.46870413e-03f,
  5.55113316e-01f, -8.31774771e-01f, 5.80003142e-01f, -8.14614236e-01f, 5.13598442e-01f, 8.58030677e-01f, 2.05897167e-01f, 9.78573620e-01f,
  -4.00799006e-01f, -9.16166008e-01f, -7.49476731e-01f, 6.62030637e-01f, 2.09454417e-01f, 9.77818429e-01f, 7.21617639e-01f, 6.92291796e-01f,
  9.08965766e-01f, 4.16870773e-01f, 9.70906913e-01f, 2.39457220e-01f, 9.90769207e-01f, 1.35559291e-01f, 9.97077882e-01f, 7.63915181e-02f,
  9.99075651e-01f, 4.29867506e-02f, 9.99707639e-01f, 2.41783205e-02f, 9.99907553e-01f, 1.35973748e-02f, 9.99970794e-01f, 7.64652714e-03f,
  9.99843299e-01f, 1.77019257e-02f, 9.25014675e-01f, -3.79931390e-01f, 2.21298173e-01f, 9.75206196e-01f, 2.95478199e-02f, 9.99563396e-01f,
  -3.07332784e-01f, -9.51602101e-01f, -7.85501122e-01f, 6.18860185e-01f, 1.78433523e-01f, 9.83951986e-01f, 7.09193349e-01f, 7.05014050e-01f,
  9.04751658e-01f, 4.25939471e-01f, 9.69545007e-01f, 2.44913206e-01f, 9.90335584e-01f, 1.38691694e-01f, 9.96940494e-01f, 7.81644881e-02f,
  9.99032140e-01f, 4.39858064e-02f, 9.99693930e-01f, 2.47404929e-02f, 9.99903202e-01f, 1.39135728e-02f, 9.99969363e-01f, 7.82434922e-03f,
  5.25321960e-01f, 8.50903511e-01f, 9.85138178e-01f, 1.71763569e-01f, -9.29481089e-02f, 9.95670974e-01f, -1.47732988e-01f, 9.89027262e-01f,
  -2.10795805e-01f, -9.77530122e-01f, -8.19042206e-01f, 5.73733270e-01f, 1.47234216e-01f, 9.89101648e-01f, 6.96544766e-01f, 7.17513323e-01f,
  9.00447130e-01f, 4.34965521e-01f, 9.68152404e-01f, 2.50361472e-01f, 9.89892066e-01f, 1.41822711e-01f, 9.96799886e-01f, 7.99371973e-02f,
  9.98987675e-01f, 4.49848175e-02f, 9.99679863e-01f, 2.53026579e-02f, 9.99898732e-01f, 1.42297689e-02f, 9.99967992e-01f, 8.00217129e-03f,
  -4.32177931e-01f, 9.01788354e-01f, 7.41858006e-01f, 6.70557022e-01f, -3.97976756e-01f, 9.17395473e-01f, -3.20354372e-01f, 9.47297752e-01f,
  -1.12152621e-01f, -9.93690968e-01f, -8.49993885e-01f, 5.26792526e-01f, 1.15887694e-01f, 9.93262351e-01f, 6.83675885e-01f, 7.29785740e-01f,
  8.96052480e-01f, 4.43948090e-01f, 9.66729224e-01f, 2.55801797e-01f, 9.89438653e-01f, 1.44952312e-01f, 9.96656179e-01f, 8.17096606e-02f,
  9.98942196e-01f, 4.59837839e-02f, 9.99665439e-01f, 2.58648153e-02f, 9.99894202e-01f, 1.45459641e-02f, 9.99966562e-01f, 8.17999430e-03f,
  -9.92335498e-01f, 1.23573124e-01f, 2.70098448e-01f, 9.62832689e-01f, -6.63538277e-01f, 7.48142362e-01f, -4.82871950e-01f, 8.75690997e-01f,
  -1.23883775e-02f, -9.99923289e-01f, -8.78258407e-01f, 4.78186339e-01f, 8.44252855e-02f, 9.96429801e-01f, 6.70590878e-01f, 7.41827428e-01f,
  8.91568303e-01f, 4.52886283e-01f, 9.65275466e-01f, 2.61234075e-01f, 9.88975346e-01f, 1.48080453e-01f, 9.96509314e-01f, 8.34818557e-02f,
  9.98895705e-01f, 4.69827019e-02f, 9.99650776e-01f, 2.64269635e-02f, 9.99889553e-01f, 1.48621574e-02f, 9.99965072e-01f, 8.35781638e-03f,
  -6.40144348e-01f, -7.68254638e-01f, -2.84846604e-01f, 9.58573103e-01f, -8.63296509e-01f, 5.04697084e-01f, -6.30159974e-01f, 7.76465356e-01f,
  8.74991715e-02f, -9.96164620e-01f, -9.03746367e-01f, 4.28068399e-01f, 5.28784581e-02f, 9.98600960e-01f, 6.57293737e-01f, 7.53634512e-01f,
  8.86994898e-01f, 4.61779177e-01f, 9.63791192e-01f, 2.66658038e-01f, 9.88502085e-01f, 1.51207119e-01f, 9.96359289e-01f, 8.52537975e-02f,
  9.98848200e-01f, 4.79815714e-02f, 9.99635756e-01f, 2.69891042e-02f, 9.99884784e-01f, 1.51783489e-02f, 9.99963582e-01f, 8.53563752e-03f,
  3.00592542e-01f, -9.53752637e-01f, -7.52063990e-01f, 6.59090102e-01f, -9.77442741e-01f, 2.11200655e-01f, -7.57573068e-01f, 6.52750373e-01f,
  1.86512470e-01f, -9.82452571e-01f, -9.26377118e-01f, 3.76597136e-01f, 2.12787576e-02f, 9.99773562e-01f, 6.43788815e-01f, 7.65203178e-01f,
  8.82332861e-01f, 4.70625877e-01f, 9.62276459e-01f, 2.72073567e-01f, 9.88018990e-01f, 1.54332280e-01f, 9.96206105e-01f, 8.70254710e-02f,
  9.98799741e-01f, 4.89803962e-02f, 9.99620378e-01f, 2.75512375e-02f, 9.99879956e-01f, 1.54945394e-02f, 9.99962032e-01f, 8.71345960e-03f,
  9.64965999e-01f, -2.62374848e-01f, -9.87659097e-01f, 1.56619072e-01f, -9.94656444e-01f, -1.03240460e-01f, -8.61092687e-01f, 5.08447945e-01f,
  2.83662200e-01f, -9.58924294e-01f, -9.46079254e-01f, 3.23935270e-01f, -1.03422189e-02f, 9.99946535e-01f, 6.30080283e-01f, 7.76529968e-01f,
  8.77582550e-01f, 4.79425550e-01f, 9.60731268e-01f, 2.77480543e-01f, 9.87526000e-01f, 1.57455891e-01f, 9.96049762e-01f, 8.87968615e-02f,
  9.98750269e-01f, 4.99791689e-02f, 9.99604762e-01f, 2.81133596e-02f, 9.99875009e-01f, 1.58107281e-02f, 9.99960482e-01f, 8.89127981e-03f,
  7.42154181e-01f, 6.70229197e-01f, -9.19073522e-01f, -3.94086063e-01f, -9.13230121e-01f, -4.07444149e-01f, -9.37454224e-01f, 3.48108500e-01f,
  3.77977669e-01f, -9.25814748e-01f, -9.62790370e-01f, 2.70249337e-01f, -4.19528559e-02f, 9.99119580e-01f, 6.16172493e-01f, 7.87611187e-01f,
  8.72744501e-01f, 4.88177240e-01f, 9.59155679e-01f, 2.82878697e-01f, 9.87023175e-01f, 1.60577938e-01f, 9.95890260e-01f, 9.05679762e-02f,
  9.98699784e-01f, 5.09778969e-02f, 9.99588788e-01f, 2.86754742e-02f, 9.99869943e-01f, 1.61269177e-02f, 9.99958873e-01f, 9.06910095e-03f,
  -1.62990779e-01f, 9.86627579e-01f, -5.67430019e-01f, -8.23421597e-01f, -7.41239965e-01f, -6.71240151e-01f, -9.84248459e-01f, 1.76790684e-01f,
  4.68516916e-01f, -8.83454502e-01f, -9.76457715e-01f, 2.15709001e-01f, -7.35215396e-02f, 9.97293651e-01f, 6.02069914e-01f, 7.98443377e-01f,
  8.67819190e-01f, 4.96880114e-01f, 9.57549810e-01f, 2.88267940e-01f, 9.86510456e-01f, 1.63698375e-01f, 9.95727658e-01f, 9.23388004e-02f,
  9.98648286e-01f, 5.19765690e-02f, 9.99572515e-01f, 2.92375814e-02f, 9.99864817e-01f, 1.64431017e-02f, 9.99957263e-01f, 9.24692024e-03f,
  -9.18282807e-01f, 3.95925164e-01f, -4.10281904e-02f, -9.99157965e-01f, -4.95741814e-01f, -8.68469954e-01f, -1.00000000e+00f, -1.03020677e-04f,
  5.54374516e-01f, -8.32267344e-01f, -9.87038016e-01f, 1.60486728e-01f, -1.05016708e-01f, 9.94470477e-01f, 5.87776959e-01f, 8.09023023e-01f,
  8.62807095e-01f, 5.05533338e-01f, 9.55913603e-01f, 2.93648034e-01f, 9.85987842e-01f, 1.66817173e-01f, 9.95561838e-01f, 9.41093415e-02f,
  9.98595834e-01f, 5.29751927e-02f, 9.99555886e-01f, 2.97996756e-02f, 9.99859571e-01f, 1.67592876e-02f, 9.99955595e-01f, 9.42474138e-03f,
  -8.29309821e-01f, -5.58789074e-01f, 4.98009592e-01f, -8.67171526e-01f, -2.01079622e-01f, -9.79574919e-01f, -9.84212041e-01f, -1.76993474e-01f,
  6.34692967e-01f, -7.72764444e-01f, -9.94497895e-01f, 1.04756832e-01f, -1.36406869e-01f, 9.90652919e-01f, 5.73298037e-01f, 8.19346905e-01f,
  8.57708693e-01f, 5.14135957e-01f, 9.54247177e-01f, 2.99018890e-01f, 9.85455394e-01f, 1.69934288e-01f, 9.95392919e-01f, 9.58795771e-02f,
  9.98542368e-01f, 5.39737605e-02f, 9.99538958e-01f, 3.03617641e-02f, 9.99854207e-01f, 1.70754679e-02f, 9.99953866e-01f, 9.60256159e-03f,
  2.21267566e-02f, -9.99755144e-01f, 8.83669317e-01f, -4.68111664e-01f, 1.13521777e-01f, -9.93535519e-01f, -9.37382519e-01f, -3.48301649e-01f,
  7.08669782e-01f, -7.05540299e-01f, -9.98813629e-01f, 4.86960001e-02f, -1.67660639e-01f, 9.85844791e-01f, 5.58637917e-01f, 8.29411685e-01f,
  8.52524519e-01f, 5.22687256e-01f, 9.52550590e-01f, 3.04380238e-01f, 9.84913111e-01f, 1.73049718e-01f, 9.95220840e-01f, 9.76495072e-02f,
  9.98487890e-01f, 5.49722798e-02f, 9.99521732e-01f, 3.09238415e-02f, 9.99848783e-01f, 1.73916500e-02f, 9.99952197e-01f, 9.78038087e-03f,
  8.53220105e-01f, -5.21551013e-01f, 9.97174621e-01f, 7.51182064e-02f, 4.16867077e-01f, -9.08967435e-01f, -8.60988438e-01f, -5.08624554e-01f,
  7.75565803e-01f, -6.31266713e-01f, -9.99971747e-01f, -7.51878507e-03f, -1.98746875e-01f, 9.80050862e-01f, 5.43801069e-01f, 8.39214146e-01f,
  8.47255111e-01f, 5.31186223e-01f, 9.50823903e-01f, 3.09731960e-01f, 9.84360933e-01f, 1.76163420e-01f, 9.95045662e-01f, 9.94191393e-02f,
  9.98432398e-01f, 5.59707358e-02f, 9.99504209e-01f, 3.14859077e-02f, 9.99843180e-01f, 1.77078284e-02f, 9.99950409e-01f, 9.95820016e-03f,
  8.99866819e-01f, 4.36164767e-01f, 8.03569078e-01f, 5.95211506e-01f, 6.78870201e-01f, -7.34258294e-01f, -7.57439196e-01f, -6.52905703e-01f,
  8.34712923e-01f, -5.50685287e-01f, -9.97968495e-01f, -6.37097955e-02f, -2.29634270e-01f, 9.73276973e-01f, 5.28792322e-01f, 8.48751247e-01f,
  8.41901004e-01f, 5.39632022e-01f, 9.49067116e-01f, 3.15073937e-01f, 9.83798921e-01f, 1.79275364e-01f, 9.94867265e-01f, 1.01188451e-01f,
  9.98375952e-01f, 5.69691435e-02f, 9.99486327e-01f, 3.20479684e-02f, 9.99837577e-01f, 1.80240069e-02f, 9.99948621e-01f, 1.01360194e-02f,
  1.19180135e-01f, 9.92872655e-01f, 3.62476677e-01f, 9.31992829e-01f, 8.73550534e-01f, -4.86733496e-01f, -6.30000710e-01f, -7.76594579e-01f,
  8.85519624e-01f, -4.64602023e-01f, -9.92810190e-01f, -1.19699396e-01f, -2.60292053e-01f, 9.65529919e-01f, 5.13616323e-01f, 8.58020008e-01f,
  8.36462677e-01f, 5.48023939e-01f, 9.47280347e-01f, 3.20405900e-01f, 9.83227074e-01f, 1.82385504e-01f, 9.94685769e-01f, 1.02957435e-01f,
  9.98318493e-01f, 5.79674877e-02f, 9.99468148e-01f, 3.26100141e-02f, 9.99831796e-01f, 1.83401816e-02f, 9.99946833e-01f, 1.03138378e-02f,
  -7.71080196e-01f, 6.36738002e-01f, -1.90249100e-01f, 9.81735826e-01f, 9.81602073e-01f, -1.90938011e-01f, -4.82692331e-01f, -8.75790000e-01f,
  9.27478492e-01f, -3.73876572e-01f, -9.84513164e-01f, -1.75310582e-01f, -2.90689558e-01f, 9.56817448e-01f, 4.98277903e-01f, 8.67017388e-01f,
  8.30940723e-01f, 5.56361020e-01f, 9.45463598e-01f, 3.25727791e-01f, 9.82645452e-01f, 1.85493827e-01f, 9.94501114e-01f, 1.04726106e-01f,
  9.98260021e-01f, 5.89657798e-02f, 9.99449670e-01f, 3.31720486e-02f, 9.99825954e-01f, 1.86563563e-02f, 9.99944985e-01f, 1.04916561e-02f,
  -9.52412963e-01f, -3.04810613e-01f, -6.84381902e-01f, 7.29123712e-01f, 9.92308319e-01f, 1.23790950e-01f, -3.20159167e-01f, -9.47363734e-01f,
  9.60170269e-01f, -2.79415488e-01f, -9.73103702e-01f, -2.30367512e-01f, -3.20796400e-01f, 9.47148204e-01f, 4.82782036e-01f, 8.75740528e-01f,
  8.25335622e-01f, 5.64642429e-01f, 9.43616986e-01f, 3.31039310e-01f, 9.82053936e-01f, 1.88600287e-01f, 9.94313300e-01f, 1.06494442e-01f,
  9.98200536e-01f, 5.99640086e-02f, 9.99430835e-01f, 3.37340795e-02f, 9.99819994e-01f, 1.89725272e-02f, 9.99943078e-01f, 1.06694745e-02f,
  -2.58101642e-01f, -9.66117799e-01f, -9.67739642e-01f, 2.51952261e-01f, 9.04607594e-01f, 4.26245421e-01f, -1.47529200e-01f, -9.89057720e-01f,
  9.83268440e-01f, -1.82162598e-01f, -9.58617806e-01f, -2.84696162e-01f, -3.50582451e-01f, 9.36531842e-01f, 4.67133403e-01f, 8.84186864e-01f,
  8.19648027e-01f, 5.72867453e-01f, 9.41740453e-01f, 3.36340427e-01f, 9.81452644e-01f, 1.91704854e-01f, 9.94122326e-01f, 1.08262435e-01f,
  9.98140097e-01f, 6.09621815e-02f, 9.99411702e-01f, 3.42960916e-02f, 9.99813974e-01f, 1.92886982e-02f, 9.99941170e-01f, 1.08472919e-02f,
  6.73507154e-01f, -7.39180684e-01f, -9.53050017e-01f, -3.02812874e-01f, 7.27198064e-01f, 6.86427653e-01f, 2.97537707e-02f, -9.99557257e-01f,
  9.96542096e-01f, -8.30891207e-02f, -9.41101313e-01f, -3.38124752e-01f, -3.80017966e-01f, 9.24979091e-01f, 4.51337039e-01f, 8.92353535e-01f,
  8.13878477e-01f, 5.81035137e-01f, 9.39834237e-01f, 3.41630876e-01f, 9.80841517e-01f, 1.94807529e-01f, 9.93928254e-01f, 1.10030092e-01f,
  9.98078644e-01f, 6.19602874e-02f, 9.99392271e-01f, 3.48580964e-02f, 9.99807835e-01f, 1.96048655e-02f, 9.99939203e-01f, 1.10251084e-02f,
  9.85896587e-01f, 1.67355701e-01f, -6.44837022e-01f, -7.64320076e-01f, 4.77671444e-01f, 8.78538549e-01f, 2.06098333e-01f, -9.78531301e-01f,
  9.99858618e-01f, 1.68140903e-02f, -9.20609534e-01f, -3.90484393e-01f, -4.09073502e-01f, 9.12501454e-01f, 4.35397953e-01f, 9.00238097e-01f,
  8.08027506e-01f, 5.89144766e-01f, 9.37898219e-01f, 3.46910536e-01f, 9.80220556e-01f, 1.97908238e-01f, 9.93731022e-01f, 1.11797392e-01f,
  9.98016179e-01f, 6.29583374e-02f, 9.99372482e-01f, 3.54200937e-02f, 9.99801576e-01f, 1.99210308e-02f, 9.99937236e-01f, 1.12029258e-02f,
};

constexpr int T_ALL = 36864, T_CTX = 4096;
constexpr int NLAYER = 4;
constexpr float EPS = 1e-6f;
constexpr int LK_LAT = 4352;

struct Params {
  const float* x_prompt; const float* x_sample; const float* cache_ckv; const float* cache_krope;
  const float* cache_k; const float* cache_v; const float* state; const float* c; const float* c_ctx;
  const float* w_mod; const float* b_mod; const float* g_norm; const float* w_in; const float* conv_w; const float* conv_b;
  const float* lru_wa; const float* lru_ba; const float* lru_wi; const float* lru_bi; const float* lru_lam;
  const float* q_norm; const float* w_uq; const float* kv_norm; const float* w_ukv; const float* sink;
  const float* w_br_rnn; const float* w_br_mla; const float* w_br_swa; const float* w_out; const float* final_norm;
  float* out; char* ws;
};

constexpr size_t AL(size_t x) { return (x + 255) & ~(size_t)255; }
constexpr size_t O_WINA = 0;
constexpr size_t O_WINB = O_WINA + AL((size_t)2560 * 1024 * 2);
constexpr size_t O_WLRU = O_WINB + AL((size_t)5120 * 1024 * 2);
constexpr size_t O_WUQ = O_WLRU + AL((size_t)4096 * 128 * 2);
constexpr size_t O_WUKVG = O_WUQ + AL((size_t)768 * 384 * 2);
constexpr size_t O_WUKVR = O_WUKVG + AL((size_t)1024 * 256 * 2);
constexpr size_t O_WBRR = O_WUKVR + AL((size_t)1024 * 256 * 2);
constexpr size_t O_WBRM = O_WBRR + AL((size_t)1024 * 1024 * 2);
constexpr size_t O_WBRS = O_WBRM + AL((size_t)1024 * 512 * 2);
constexpr size_t O_WOUT = O_WBRS + AL((size_t)1024 * 512 * 2);
constexpr size_t O_MOD = O_WOUT + AL((size_t)1024 * 1024 * 2);
constexpr size_t O_H = O_MOD + AL((size_t)4 * 9 * 3072 * 4);
constexpr size_t O_XR = O_H + AL((size_t)T_ALL * 1024 * 2);
constexpr size_t O_CQ = O_XR + AL((size_t)T_ALL * 1024 * 2);
constexpr size_t O_CKV = O_CQ + AL((size_t)T_ALL * 384 * 2);
constexpr size_t O_CKVC = O_CKV + AL((size_t)T_ALL * 256 * 2);
constexpr size_t O_KRL = O_CKVC + AL((size_t)2048 * 256 * 2);
constexpr size_t O_KRC = O_KRL + AL((size_t)8 * LK_LAT * 32 * 2);
constexpr size_t O_QS = O_KRC + AL((size_t)16 * 256 * 32 * 2);
constexpr size_t O_KS = O_QS + AL((size_t)T_ALL * 512 * 2);
constexpr size_t O_KSC = O_KS + AL((size_t)T_ALL * 128 * 2);
constexpr size_t O_VTSL = O_KSC + AL((size_t)8 * 256 * 128 * 2);
constexpr size_t O_VTSC = O_VTSL + AL((size_t)8 * 2 * 64 * 4096 * 2);
constexpr size_t O_VTSCC = O_VTSC + AL((size_t)16 * 2 * 64 * 256 * 2);
constexpr size_t O_Q = O_VTSCC + AL((size_t)8 * 2 * 64 * 256 * 2);
constexpr size_t O_KNL = O_Q + AL((size_t)T_ALL * 768 * 2);
constexpr size_t O_KNC = O_KNL + AL((size_t)8 * 8 * LK_LAT * 64 * 2);
constexpr size_t O_VTL = O_KNC + AL((size_t)16 * 8 * 256 * 64 * 2);
constexpr size_t O_VTC = O_VTL + AL((size_t)8 * 8 * 64 * LK_LAT * 2);
constexpr size_t O_YRNN = O_VTC + AL((size_t)16 * 8 * 64 * 256 * 2);
static_assert(O_YRNN - O_KS >= (size_t)2 * T_ALL * 1024 * 2, "merge-gate buffers do not fit");
constexpr size_t O_SUM = O_YRNN + AL((size_t)T_ALL * 1024 * 2);
constexpr size_t O_BAR = O_SUM + AL((size_t)8 * 8 * 2 * 16 * 256 * 4);
constexpr size_t WS_NEED = O_BAR + 256;

constexpr size_t OUT_CKV = (size_t)T_ALL * 1024;
constexpr size_t OUT_KROPE = OUT_CKV + (size_t)16 * 4 * 256 * 256;
constexpr size_t OUT_SK = OUT_KROPE + (size_t)16 * 4 * 256 * 32;
constexpr size_t OUT_SV = OUT_SK + (size_t)16 * 4 * 256 * 128;
constexpr size_t OUT_RG = OUT_SV + (size_t)16 * 4 * 256 * 128;

#define SB() __builtin_amdgcn_sched_barrier(0)
#define MB() asm volatile("" ::: "memory")
DI int tid() { int t = threadIdx.x; asm volatile("" : "+v"(t)); return t; }
DI int xcd_map(int base) {
  const int g = gridDim.x;
  if (g & 7) return base + blockIdx.x;
  return base + (blockIdx.x & 7) * (g >> 3) + (blockIdx.x >> 3);
}
#define LANEVARS const int t = tid(), lane = t & 63, w = t >> 6, wr = w >> 1, wc = w & 1; const int c16 = lane & 15, g4 = lane >> 4; (void)wr; (void)wc; (void)c16; (void)g4;
DI float bf2f(u16 v) { return __uint_as_float(((unsigned)v) << 16); }
DI unsigned pack2(float a, float b) {
  f2_t v = {a, b};
  bf2_t r = __builtin_convertvector(v, bf2_t);
  return __builtin_bit_cast(unsigned, r);
}
DI u16 f2bf(float a) { return (u16)(pack2(a, 0.f) & 0xffffu); }
DI float sigmoidf_(float x) { return 1.f / (1.f + __expf(-x)); }
DI float wave_sum(float v) {
#pragma unroll
  for (int o = 32; o > 0; o >>= 1) v += __shfl_xor(v, o);
  return v;
}
DI int perm32(int p) { return (p & 7) | ((p & 8) << 1) | ((p & 16) >> 1); }
DI const float* xin_row(const Params& p, int l, int row) {
  if (l == 0) return row < T_CTX ? p.x_prompt + (size_t)row * 1024 : p.x_sample + (size_t)(row - T_CTX) * 1024;
  return p.out + (size_t)row * 1024;
}
template <class T> DI T* wsp(const Params& p, size_t off) { return (T*)(p.ws + off); }

template <int NJ>
DI void gemm_tile_t(const u16* A, int lda, const u16* B, int ldb, int K,
                    f32x4 (&acc)[4][NJ], char* smem) {
  const int t = tid(), lane = t & 63, w = t >> 6, wr = w >> 1, wc = w & 1;
  const int lr = t >> 3, slot = t & 7;
  const int c16 = lane & 15, g4 = lane >> 4;
  const int gch = slot ^ ((lr >> 1) & 7);
  const u16* ap = A + (size_t)lr * lda + gch * 8;
  const u16* bp = B + (size_t)lr * ldb + gch * 8;
  char* sdst = smem + t * 16;
#define DMA16(gp, lp) __builtin_amdgcn_global_load_lds((const unsigned*)(gp), (unsigned*)(lp), 16, 0, 0)
#define STAGE(base, ko) { DMA16(ap + (ko), (base)); DMA16(ap + (size_t)32 * lda + (ko), (base) + 4096); \
    DMA16(ap + (size_t)64 * lda + (ko), (base) + 8192); DMA16(ap + (size_t)96 * lda + (ko), (base) + 12288); \
    DMA16(bp + (ko), (base) + 16384); DMA16(bp + (size_t)32 * ldb + (ko), (base) + 16384 + 4096); \
    if (NJ > 2) { DMA16(bp + (size_t)64 * ldb + (ko), (base) + 16384 + 8192); DMA16(bp + (size_t)96 * ldb + (ko), (base) + 16384 + 12288); } }
  const int nk = K >> 6;
  const int arow = (wr * 64 + c16) * 128, brow = (wc * (16 * NJ) + c16) * 128;
  const int sw = (c16 >> 1) & 7;
  int kk = (int)((blockIdx.x * 5u + (blockIdx.x >> 3)) % (unsigned)nk);
  STAGE(sdst, kk * 64)
  __syncthreads();
  for (int kt = 0; kt < nk; ++kt) {
    char* cur = smem + (kt & 1) * 32768;
    kk = (kk + 1 == nk) ? 0 : kk + 1;
    if (kt + 1 < nk) { char* nxt = sdst + ((kt + 1) & 1) * 32768; STAGE(nxt, kk * 64) }
#pragma unroll
    for (int ks = 0; ks < 2; ++ks) {
      bf16x8 af[4], bfr[NJ];
      const int ch = ((ks * 4 + g4) ^ sw) << 4;
#pragma unroll
      for (int i = 0; i < 4; ++i) af[i] = *(const bf16x8*)(cur + arow + i * 2048 + ch);
#pragma unroll
      for (int i = 0; i < NJ; ++i) bfr[i] = *(const bf16x8*)(cur + 16384 + brow + i * 2048 + ch);
#pragma unroll
      for (int i = 0; i < 4; ++i)
#pragma unroll
        for (int j = 0; j < NJ; ++j)
          acc[i][j] = __builtin_amdgcn_mfma_f32_16x16x32_bf16(af[i], bfr[j], acc[i][j], 0, 0, 0);
    }
    SB();
    __syncthreads();
  }
#undef STAGE
#undef DMA16
}
DI void gemm_tile(const u16* A, int lda, const u16* B, int ldb, int K,
                  f32x4 (&acc)[4][4], char* smem) {
  gemm_tile_t<4>(A, lda, B, ldb, K, acc, smem);
}
DI void zero_acc(f32x4 (&acc)[4][4]) {
#pragma unroll
  for (int i = 0; i < 4; ++i)
#pragma unroll
    for (int j = 0; j < 4; ++j) acc[i][j] = f32x4{0.f, 0.f, 0.f, 0.f};
}

struct TokTile { int g0; int is_ctx; int b; int p0; };
DI TokTile tok_tile(int mt) {
  TokTile r; r.g0 = mt * 128;
  if (r.g0 < T_CTX) { r.is_ctx = 1; r.b = r.g0 >> 8; r.p0 = r.g0 & 255; }
  else { r.is_ctx = 0; r.b = (r.g0 - T_CTX) >> 12; r.p0 = (r.g0 - T_CTX) & 4095; }
  return r;
}

DI void phase_mod(const Params& p, char* smem) {
  float* s_silu = (float*)smem;
  float* s_part = (float*)(smem + 36864);
  float* MOD = wsp<float>(p, O_MOD);
  const int t = tid();
  for (int i = t; i < 9 * 1024; i += 256) {
    float v = (i < 8192) ? p.c[i] : p.c_ctx[i - 8192];
    s_silu[i] = v * sigmoidf_(v);
  }
  __syncthreads();
  const int kg = t >> 6, cl = t & 63;
  for (int u = blockIdx.x; u < 4 * 48; u += gridDim.x) {
    const int l = u / 48, cb = u % 48;
    const int n = cb * 64 + cl;
    float acc[9];
#pragma unroll
    for (int ci = 0; ci < 9; ++ci) acc[ci] = 0.f;
    const float* wp = p.w_mod + ((size_t)l * 1024 + kg * 256) * 3072 + n;
    for (int k = 0; k < 256; ++k) {
      float wv = wp[(size_t)k * 3072];
#pragma unroll
      for (int ci = 0; ci < 9; ++ci) acc[ci] += s_silu[ci * 1024 + kg * 256 + k] * wv;
    }
#pragma unroll
    for (int ci = 0; ci < 9; ++ci) s_part[(kg * 9 + ci) * 64 + cl] = acc[ci];
    __syncthreads();
    for (int idx = t; idx < 9 * 64; idx += 256) {
      int ci = idx >> 6, c2 = idx & 63;
      float s = s_part[(0 * 9 + ci) * 64 + c2] + s_part[(1 * 9 + ci) * 64 + c2] + s_part[(2 * 9 + ci) * 64 + c2] +
                s_part[(3 * 9 + ci) * 64 + c2];
      MOD[((size_t)l * 9 + ci) * 3072 + cb * 64 + c2] = s + p.b_mod[l * 3072 + cb * 64 + c2];
    }
    __syncthreads();
  }
}

template <class F> DI void conv_job(u16* dst, int N, int K, F src) {
  const int total = N * (K >> 3);
  for (int idx = blockIdx.x * 256 + tid(); idx < total; idx += gridDim.x * 256) {
    const int n = idx % N, kb = idx / N;
    float v[8];
#pragma unroll
    for (int j = 0; j < 8; ++j) v[j] = src(kb * 8 + j, n);
    uint4 o;
    o.x = pack2(v[0], v[1]); o.y = pack2(v[2], v[3]); o.z = pack2(v[4], v[5]); o.w = pack2(v[6], v[7]);
    *(uint4*)(dst + (size_t)n * K + kb * 8) = o;
  }
}

DI void phase_prep(const Params& p, int l) {
  const int t = tid(), lane = t & 63, w = t >> 6;
  const float* MOD = wsp<float>(p, O_MOD) + (size_t)l * 9 * 3072;
  u16* H = wsp<u16>(p, O_H);
  for (int row = blockIdx.x * 4 + w; row < T_ALL; row += gridDim.x * 4) {
    const float* x = xin_row(p, l, row);
    const int ci = row < T_CTX ? 8 : ((row - T_CTX) >> 12);
    const float* md = MOD + ci * 3072;
    float4 v[4];
    float ss = 0.f;
#pragma unroll
    for (int i = 0; i < 4; ++i) {
      v[i] = *(const float4*)(x + i * 256 + lane * 4);
      ss += v[i].x * v[i].x + v[i].y * v[i].y + v[i].z * v[i].z + v[i].w * v[i].w;
    }
    ss = wave_sum(ss);
    const float rs = rsqrtf(ss * (1.f / 1024.f) + EPS);
#pragma unroll
    for (int i = 0; i < 4; ++i) {
      const int c = i * 256 + lane * 4;
      const float4 g = *(const float4*)(p.g_norm + l * 1024 + c);
      const float4 sh = *(const float4*)(md + c);
      const float4 sc = *(const float4*)(md + 1024 + c);
      float h0 = v[i].x * rs * g.x * (1.f + sc.x) + sh.x;
      float h1 = v[i].y * rs * g.y * (1.f + sc.y) + sh.y;
      float h2 = v[i].z * rs * g.z * (1.f + sc.z) + sh.z;
      float h3 = v[i].w * rs * g.w * (1.f + sc.w) + sh.w;
      uint2 o; o.x = pack2(h0, h1); o.y = pack2(h2, h3);
      *(uint2*)(H + (size_t)row * 1024 + c) = o;
    }
  }
  {
    const float* win = p.w_in + (size_t)l * 1024 * 7584;
    conv_job(wsp<u16>(p, O_WINA), 2560, 1024, [&](int k, int n) -> float {
      int col;
      if (n < 1024) col = n;
      else if (n < 1408) col = 2048 + (n - 1024);
      else if (n < 1664) col = 2432 + (n - 1408);
      else if (n < 1792) { int pp = n - 1664; col = pp < 32 ? 2688 + perm32(pp) : -1; }
      else if (n < 2304) col = 3232 + (n - 1792);
      else if (n < 2432) col = 3744 + (n - 2304);
      else col = 3872 + (n - 2432);
      return col < 0 ? 0.f : win[(size_t)k * 7584 + col];
    });
    conv_job(wsp<u16>(p, O_WINB), 5120, 1024, [&](int k, int n) -> float {
      int col;
      if (n < 1024) col = 1024 + n;
      else if (n < 1536) col = 2720 + (n - 1024);
      else if (n < 2048) col = 4000 + (n - 1536);
      else col = 4512 + (n - 2048);
      return win[(size_t)k * 7584 + col];
    });
    const float* wa = p.lru_wa + (size_t)l * 2 * 8 * 128 * 128;
    const float* wi = p.lru_wi + (size_t)l * 2 * 8 * 128 * 128;
    conv_job(wsp<u16>(p, O_WLRU), 4096, 128, [&](int k, int n) -> float {
      int db = n >> 8, nn = n & 255;
      return nn < 128 ? wa[((size_t)db * 128 + k) * 128 + nn] : wi[((size_t)db * 128 + k) * 128 + (nn - 128)];
    });
    const float* wuq = p.w_uq + (size_t)l * 384 * 768;
    const float* gq = p.q_norm + l * 384;
    conv_job(wsp<u16>(p, O_WUQ), 768, 384, [&](int k, int n) -> float {
      int col;
      if (n < 512) col = (n >> 6) * 96 + (n & 63);
      else { int hh = (n - 512) >> 5, pp = (n - 512) & 31; col = hh * 96 + 64 + perm32(pp); }
      return gq[k] * wuq[(size_t)k * 768 + col];
    });
    const float* wukv = p.w_ukv + (size_t)l * 256 * 1024;
    const float* gkv = p.kv_norm + l * 256;
    conv_job(wsp<u16>(p, O_WUKVG), 1024, 256, [&](int k, int n) -> float { return gkv[k] * wukv[(size_t)k * 1024 + n]; });
    conv_job(wsp<u16>(p, O_WUKVR), 1024, 256, [&](int k, int n) -> float { return wukv[(size_t)k * 1024 + n]; });
    const float* w1 = p.w_br_rnn + (size_t)l * 1024 * 1024;
    conv_job(wsp<u16>(p, O_WBRR), 1024, 1024, [&](int k, int n) -> float { return w1[(size_t)k * 1024 + n]; });
    const float* w2 = p.w_br_mla + (size_t)l * 512 * 1024;
    conv_job(wsp<u16>(p, O_WBRM), 1024, 512, [&](int k, int n) -> float { return w2[(size_t)k * 1024 + n]; });
    const float* w3 = p.w_br_swa + (size_t)l * 512 * 1024;
    conv_job(wsp<u16>(p, O_WBRS), 1024, 512, [&](int k, int n) -> float { return w3[(size_t)k * 1024 + n]; });
    const float* w4 = p.w_out + (size_t)l * 1024 * 1024;
    conv_job(wsp<u16>(p, O_WOUT), 1024, 1024, [&](int k, int n) -> float { return w4[(size_t)k * 1024 + n]; });
  }
  {
    const int gt = blockIdx.x * 256 + t, gs = gridDim.x * 256;
    u16* ckvc = wsp<u16>(p, O_CKVC);
    for (int i = gt; i < 2048 * 256; i += gs) {
      int r = i >> 8, k = i & 255, b = r >> 8, pos = r & 255;
      ckvc[i] = f2bf(p.cache_ckv[(((size_t)b * 4 + l) * 256 + pos) * 256 + k]);
    }
    u16* krl = wsp<u16>(p, O_KRL);
    for (int i = gt; i < 8 * 256 * 32; i += gs) {
      int pp = i & 31, pos = (i >> 5) & 255, b = i >> 13;
      krl[((size_t)b * LK_LAT + pos) * 32 + pp] = f2bf(p.cache_krope[(((size_t)b * 4 + l) * 256 + pos) * 32 + perm32(pp)]);
    }
    u16* ksc = wsp<u16>(p, O_KSC);
    for (int i = gt; i < 8 * 256 * 128; i += gs) {
      int c = i & 127, pos = (i >> 7) & 255, b = i >> 15;
      ksc[i] = f2bf(p.cache_k[(((size_t)b * 4 + l) * 256 + pos) * 128 + c]);
    }
    u16* vtc = wsp<u16>(p, O_VTSCC);
    for (int i = gt; i < 8 * 2 * 64 * 256; i += gs) {
      int pos = i & 255, dv = (i >> 8) & 63, kvh = (i >> 14) & 1, b = i >> 15;
      vtc[i] = f2bf(p.cache_v[(((size_t)b * 4 + l) * 256 + pos) * 128 + kvh * 64 + dv]);
    }
  }
}

DI void phase_gemmA(const Params& p, int l, char* smem) {
  const u16* H = wsp<u16>(p, O_H);
  const u16* W = wsp<u16>(p, O_WINA);
  for (int base = 0; base < 288 * 20; base += gridDim.x) {
    const int tile = xcd_map(base);
    if (tile >= 288 * 20) continue;
    const int mt = tile / 20, nt = tile % 20;
    const TokTile tt = tok_tile(mt);
    f32x4 acc[4][4];
    zero_acc(acc);
    gemm_tile(H + (size_t)tt.g0 * 1024, 1024, W + (size_t)nt * 128 * 1024, 1024, 1024, acc, smem);
    LANEVARS
    if (nt < 13) {
      u16* dst; int ld, cb;
      if (nt < 8) { dst = wsp<u16>(p, O_XR); ld = 1024; cb = nt * 128; }
      else if (nt < 11) { dst = wsp<u16>(p, O_CQ); ld = 384; cb = (nt - 8) * 128; }
      else { dst = wsp<u16>(p, O_CKV); ld = 256; cb = (nt - 11) * 128; }
#pragma unroll
      for (int i = 0; i < 4; ++i)
#pragma unroll
        for (int j = 0; j < 4; ++j)
#pragma unroll
          for (int e = 0; e < 4; ++e) {
            const int g = tt.g0 + wr * 64 + i * 16 + g4 * 4 + e;
            dst[(size_t)g * ld + cb + wc * 64 + j * 16 + c16] = f2bf(acc[i][j][e]);
            if (e == 3 && j == 3) SB();
          }
    } else if (nt == 13) {
      if (wc == 0) {
#pragma unroll
        for (int i = 0; i < 4; ++i)
#pragma unroll
          for (int e = 0; e < 4; ++e) {
            SB();
            const int r = wr * 64 + i * 16 + g4 * 4 + e;
            const int pos = tt.p0 + r;
            float x1 = acc[i][0][e], x2 = acc[i][1][e];
            if (tt.is_ctx) {
              u16* kr = wsp<u16>(p, O_KRC) + ((size_t)tt.b * 256 + pos) * 32;
              kr[c16] = f2bf(x1); kr[c16 + 16] = f2bf(x2);
              float* o = p.out + OUT_KROPE + (((size_t)tt.b * 4 + l) * 256 + pos) * 32;
              o[perm32(c16)] = x1; o[perm32(c16 + 16)] = x2;
            } else {
              const int pv = (c16 >= 8) ? (pos & 63) : (pos >> 6);
              const float cs = TAB_M[(pv * 8 + (c16 & 7)) * 2], sn = TAB_M[(pv * 8 + (c16 & 7)) * 2 + 1];
              u16* kr = wsp<u16>(p, O_KRL) + ((size_t)tt.b * LK_LAT + 256 + pos) * 32;
              kr[c16] = f2bf(x1 * cs - x2 * sn); kr[c16 + 16] = f2bf(x2 * cs + x1 * sn);
            }
          }
      }
    } else if (nt < 19) {
      const bool isk = (nt == 18);
      u16* dst = isk ? wsp<u16>(p, O_KS) : wsp<u16>(p, O_QS);
      const int ld = isk ? 128 : 512;
      const int cb = isk ? wc * 64 : ((nt - 14) * 2 + wc) * 64;
#pragma unroll
      for (int i = 0; i < 4; ++i)
#pragma unroll
        for (int e = 0; e < 4; ++e) {
          SB();
          const int r = wr * 64 + i * 16 + g4 * 4 + e;
          const int pos = tt.p0 + r, g = tt.g0 + r;
          float v0 = acc[i][0][e], v1 = acc[i][1][e], v2 = acc[i][2][e], v3 = acc[i][3][e];
          if (!tt.is_ctx) {
            const int pr = pos >> 6, pc = pos & 63;
            const float c0 = TAB_S[(pr * 16 + c16) * 2], s0 = TAB_S[(pr * 16 + c16) * 2 + 1];
            const float c1 = TAB_S[(pc * 16 + c16) * 2], s1 = TAB_S[(pc * 16 + c16) * 2 + 1];
            float a0 = v0 * c0 - v1 * s0, a1 = v1 * c0 + v0 * s0;
            float a2 = v2 * c1 - v3 * s1, a3 = v3 * c1 + v2 * s1;
            v0 = a0; v1 = a1; v2 = a2; v3 = a3;
          } else if (isk) {
            float* o = p.out + OUT_SK + (((size_t)tt.b * 4 + l) * 256 + pos) * 128 + cb + c16;
            o[0] = v0; o[16] = v1; o[32] = v2; o[48] = v3;
          }
          u16* d = dst + (size_t)g * ld + cb + c16;
          d[0] = f2bf(v0); d[16] = f2bf(v1); d[32] = f2bf(v2); d[48] = f2bf(v3);
        }
    } else {
      u16* vt = tt.is_ctx ? wsp<u16>(p, O_VTSC) : wsp<u16>(p, O_VTSL);
      const int L = tt.is_ctx ? 256 : 4096;
#pragma unroll
      for (int i = 0; i < 4; ++i)
#pragma unroll
        for (int j = 0; j < 4; ++j) {
          SB();
          const int r = wr * 64 + i * 16 + g4 * 4;
          const int pos = tt.p0 + r, dv = j * 16 + c16;
          uint2 o; o.x = pack2(acc[i][j][0], acc[i][j][1]); o.y = pack2(acc[i][j][2], acc[i][j][3]);
          *(uint2*)(vt + (((size_t)tt.b * 2 + wc) * 64 + dv) * L + pos) = o;
          if (tt.is_ctx) {
#pragma unroll
            for (int e = 0; e < 4; ++e)
              p.out[OUT_SV + (((size_t)tt.b * 4 + l) * 256 + pos + e) * 128 + wc * 64 + dv] = acc[i][j][e];
          }
        }
    }
  }
}

DI void row_scales(const u16* A, int K, float* s_rs) {
  const int t = tid(), row = t >> 1, half = t & 1;
  const u16* ap = A + (size_t)row * K + half * (K >> 1);
  float ss = 0.f;
  for (int c = 0; c < (K >> 4); ++c) {
    uint4 v = *(const uint4*)(ap + c * 8);
    unsigned wv[4] = {v.x, v.y, v.z, v.w};
#pragma unroll
    for (int q = 0; q < 4; ++q) {
      float a = __uint_as_float(wv[q] << 16), b = __uint_as_float(wv[q] & 0xffff0000u);
      ss += a * a + b * b;
    }
  }
  ss += __shfl_xor(ss, 1);
  if (half == 0) s_rs[row] = rsqrtf(ss / (float)K + EPS);
}

template <int MODE> DI void scan_seg(const Params& p, int l, int seq, int blk, int d, int seg, char* smem);
DI void phase_qkv(const Params& p, int l, char* smem) {
  float* s_rs = (float*)(smem + 65536);
  constexpr int NQ = 288 * 6, NKV = 304 * 8, NS1 = 2048;
  for (int base = 0; base < NS1 + NQ + NKV; base += gridDim.x) {
    const int tile0 = xcd_map(base);
    if (tile0 >= NS1 + NQ + NKV) continue;
    if (tile0 < NS1) {
      scan_seg<0>(p, l, 16 + (tile0 >> 8), (tile0 >> 5) & 7, (tile0 >> 4) & 1, tile0 & 15, smem);
#if PROBE == 4
      scan_seg<0>(p, l, 16 + (tile0 >> 8), (tile0 >> 5) & 7, (tile0 >> 4) & 1, tile0 & 15, smem);
#endif
      continue;
    }
    const int tile = tile0 - NS1;
    f32x4 acc[4][4];
    zero_acc(acc);
    if (tile < NQ) {
      const int mt = tile / 6, nt = tile % 6;
      const TokTile tt = tok_tile(mt);
      const u16* A = wsp<u16>(p, O_CQ) + (size_t)tt.g0 * 384;
      row_scales(A, 384, s_rs);
      gemm_tile(A, 384, wsp<u16>(p, O_WUQ) + (size_t)nt * 128 * 384, 384, 384, acc, smem);
      LANEVARS
      u16* Q = wsp<u16>(p, O_Q);
#pragma unroll
      for (int i = 0; i < 4; ++i)
#pragma unroll
        for (int e = 0; e < 4; ++e) {
          SB();
          const int r = wr * 64 + i * 16 + g4 * 4 + e;
          const int pos = tt.p0 + r, g = tt.g0 + r;
          const float rs = s_rs[r];
          float v0 = acc[i][0][e] * rs, v1 = acc[i][1][e] * rs, v2 = acc[i][2][e] * rs, v3 = acc[i][3][e] * rs;
          if (nt >= 4 && !tt.is_ctx) {
            const int pv = (c16 >= 8) ? (pos & 63) : (pos >> 6);
            const float cs = TAB_M[(pv * 8 + (c16 & 7)) * 2], sn = TAB_M[(pv * 8 + (c16 & 7)) * 2 + 1];
            float a0 = v0 * cs - v1 * sn, a1 = v1 * cs + v0 * sn;
            float a2 = v2 * cs - v3 * sn, a3 = v3 * cs + v2 * sn;
            v0 = a0; v1 = a1; v2 = a2; v3 = a3;
          }
          u16* d = Q + (size_t)g * 768 + nt * 128 + wc * 64 + c16;
          d[0] = f2bf(v0); d[16] = f2bf(v1); d[32] = f2bf(v2); d[48] = f2bf(v3);
        }
    } else {
      const int t2 = tile - NQ;
      const int mt = t2 >> 3, hd = t2 & 7;
      const u16* A; const u16* Wt; int is_ctx, seq, kp0;
      if (mt < 288) {
        const TokTile tt = tok_tile(mt);
        A = wsp<u16>(p, O_CKV) + (size_t)tt.g0 * 256;
        Wt = wsp<u16>(p, O_WUKVG);
        row_scales(A, 256, s_rs);
        is_ctx = tt.is_ctx; seq = tt.b; kp0 = tt.is_ctx ? tt.p0 : 256 + tt.p0;
        if (tt.is_ctx && hd == 0) {
          __syncthreads();
          const float* gkv = p.kv_norm + l * 256;
          for (int idx = tid(); idx < 128 * 256; idx += 256) {
            const int r = idx >> 8, k = idx & 255;
            p.out[OUT_CKV + (((size_t)tt.b * 4 + l) * 256 + tt.p0 + r) * 256 + k] = bf2f(A[(size_t)r * 256 + k]) * s_rs[r] * gkv[k];
          }
        }
      } else {
        const int row0 = (mt - 288) * 128;
        A = wsp<u16>(p, O_CKVC) + (size_t)row0 * 256;
        Wt = wsp<u16>(p, O_WUKVR);
        { const int t1 = tid(); if (t1 < 128) s_rs[t1] = 1.f; }
        is_ctx = 0; seq = row0 >> 8; kp0 = row0 & 255;
      }
      gemm_tile(A, 256, Wt + (size_t)hd * 128 * 256, 256, 256, acc, smem);
      LANEVARS
      const int Lk = is_ctx ? 256 : LK_LAT;
      if (wc == 0) {
        u16* Kn = (is_ctx ? wsp<u16>(p, O_KNC) : wsp<u16>(p, O_KNL)) + ((size_t)seq * 8 + hd) * Lk * 64;
#pragma unroll
        for (int i = 0; i < 4; ++i)
#pragma unroll
          for (int j = 0; j < 4; ++j)
#pragma unroll
            for (int e = 0; e < 4; ++e) {
              const int r = wr * 64 + i * 16 + g4 * 4 + e;
              Kn[(size_t)(kp0 + r) * 64 + j * 16 + c16] = f2bf(acc[i][j][e] * s_rs[r]);
              if (e == 3) SB();
            }
      } else {
        u16* Vt = (is_ctx ? wsp<u16>(p, O_VTC) : wsp<u16>(p, O_VTL)) + ((size_t)seq * 8 + hd) * 64 * Lk;
#pragma unroll
        for (int i = 0; i < 4; ++i)
#pragma unroll
          for (int j = 0; j < 4; ++j) {
            SB();
            const int r = wr * 64 + i * 16 + g4 * 4;
            uint2 o;
            o.x = pack2(acc[i][j][0] * s_rs[r], acc[i][j][1] * s_rs[r + 1]);
            o.y = pack2(acc[i][j][2] * s_rs[r + 2], acc[i][j][3] * s_rs[r + 3]);
            *(uint2*)(Vt + (size_t)(j * 16 + c16) * Lk + kp0 + r) = o;
          }
      }
    }
    __syncthreads();
  }
}

template <int NS> DI void attn_gload(const u16* k0, int k0s, const u16* k1, const u16* vt, int vts,
                                     uint4& rk0, uint4& rk1, uint4& rk2, uint4& rv0, uint4& rv1) {
  const int t = tid();
  if (NS == 6) {
    { const int c = t, key = c / 12, ch = c % 12;
      rk0 = (ch < 8) ? *(const uint4*)(k0 + (size_t)key * k0s + ch * 8) : *(const uint4*)(k1 + (size_t)key * 32 + (ch - 8) * 8); }
    { const int c = t + 256, key = c / 12, ch = c % 12;
      rk1 = (ch < 8) ? *(const uint4*)(k0 + (size_t)key * k0s + ch * 8) : *(const uint4*)(k1 + (size_t)key * 32 + (ch - 8) * 8); }
    { const int c = t + 512, key = c / 12, ch = c % 12;
      rk2 = (ch < 8) ? *(const uint4*)(k0 + (size_t)key * k0s + ch * 8) : *(const uint4*)(k1 + (size_t)key * 32 + (ch - 8) * 8); }
  } else {
    { const int c = t, key = c >> 3, ch = c & 7; rk0 = *(const uint4*)(k0 + (size_t)key * k0s + ch * 8); }
    { const int c = t + 256, key = c >> 3, ch = c & 7; rk1 = *(const uint4*)(k0 + (size_t)key * k0s + ch * 8); }
  }
  { const int c = t, dv = c >> 3, ch = c & 7; rv0 = *(const uint4*)(vt + (size_t)dv * vts + ch * 8); }
  { const int c = t + 256, dv = c >> 3, ch = c & 7; rv1 = *(const uint4*)(vt + (size_t)dv * vts + ch * 8); }
}
template <int NS> DI void attn_sstore(char* smem, const uint4& rk0, const uint4& rk1, const uint4& rk2, const uint4& rv0, const uint4& rv1) {
  constexpr int KSTR = (NS == 6) ? 208 : 144;
  const int t = tid();
  if (NS == 6) {
    { const int c = t, key = c / 12, ch = c % 12; *(uint4*)(smem + key * KSTR + ch * 16) = rk0; }
    { const int c = t + 256, key = c / 12, ch = c % 12; *(uint4*)(smem + key * KSTR + ch * 16) = rk1; }
    { const int c = t + 512, key = c / 12, ch = c % 12; *(uint4*)(smem + key * KSTR + ch * 16) = rk2; }
  } else {
    { const int c = t, key = c >> 3, ch = c & 7; *(uint4*)(smem + key * KSTR + ch * 16) = rk0; }
    { const int c = t + 256, key = c >> 3, ch = c & 7; *(uint4*)(smem + key * KSTR + ch * 16) = rk1; }
  }
  { const int c = t, dv = c >> 3, ch = c & 7; char* d = smem + 13312 + dv * 136 + ch * 16;
    *(uint2*)d = uint2{rv0.x, rv0.y}; *(uint2*)(d + 8) = uint2{rv0.z, rv0.w}; }
  { const int c = t + 256, dv = c >> 3, ch = c & 7; char* d = smem + 13312 + dv * 136 + ch * 16;
    *(uint2*)d = uint2{rv1.x, rv1.y}; *(uint2*)(d + 8) = uint2{rv1.z, rv1.w}; }
}

#define PACK8(S, s2) __builtin_bit_cast(bf16x8, uint4{pack2(S[8 * (s2)], S[8 * (s2) + 1]), pack2(S[8 * (s2) + 2], S[8 * (s2) + 3]), \
                                                        pack2(S[8 * (s2) + 4], S[8 * (s2) + 5]), pack2(S[8 * (s2) + 6], S[8 * (s2) + 7])})

template <int NS>
DI void attn_item(const u16* kA, int kAs, const u16* krA, const u16* vtA, int vtAs, int nA, int kposA, int maskA,
                  const u16* kB, int kBs, const u16* vtB, int vtBs, int nB,
                  const u16* qa, const u16* qb, float sc2, float m0, float l0, int qpos, u16* yrow, char* smem) {
  constexpr int KSTR = (NS == 6) ? 208 : 144;
  const int lane = tid() & 63;
  const int r32 = lane & 31, hh = lane >> 5;
  bf16x8 qf0, qf1, qf2, qf3, qf4, qf5;
  qf0 = *(const bf16x8*)(qa + 0 + 8 * hh); qf1 = *(const bf16x8*)(qa + 16 + 8 * hh);
  qf2 = *(const bf16x8*)(qa + 32 + 8 * hh); qf3 = *(const bf16x8*)(qa + 48 + 8 * hh);
  if (NS == 6) { qf4 = *(const bf16x8*)(qb + 0 + 8 * hh); qf5 = *(const bf16x8*)(qb + 16 + 8 * hh); }
  else { qf4 = qf0; qf5 = qf0; }
#define QSCALE(qf) { uint4 u_ = __builtin_bit_cast(uint4, qf); \
    u_.x = pack2(__uint_as_float(u_.x << 16) * sc2, __uint_as_float(u_.x & 0xffff0000u) * sc2); \
    u_.y = pack2(__uint_as_float(u_.y << 16) * sc2, __uint_as_float(u_.y & 0xffff0000u) * sc2); \
    u_.z = pack2(__uint_as_float(u_.z << 16) * sc2, __uint_as_float(u_.z & 0xffff0000u) * sc2); \
    u_.w = pack2(__uint_as_float(u_.w << 16) * sc2, __uint_as_float(u_.w & 0xffff0000u) * sc2); \
    qf = __builtin_bit_cast(bf16x8, u_); }
  QSCALE(qf0) QSCALE(qf1) QSCALE(qf2) QSCALE(qf3)
  if (NS == 6) { QSCALE(qf4) QSCALE(qf5) }
#undef QSCALE
  f32x16 O0, O1;
#pragma unroll
  for (int e = 0; e < 16; ++e) { O0[e] = 0.f; O1[e] = 0.f; }
  float m_run = m0, l_run = l0;
  uint4 rk0, rk1, rk2, rv0, rv1;
  rk2 = uint4{0, 0, 0, 0};
  const int ntiles = nA + nB;
#define TILE_GLOAD(jn) { if ((jn) < nA) attn_gload<NS>(kA + (size_t)(jn) * 64 * kAs, kAs, krA + (size_t)(jn) * 64 * 32, vtA + (jn) * 64, vtAs, rk0, rk1, rk2, rv0, rv1); \
    else { const int jb_ = (jn) - nA; attn_gload<NS>(kB + (size_t)jb_ * 64 * kBs, kBs, nullptr, vtB + jb_ * 64, vtBs, rk0, rk1, rk2, rv0, rv1); } }
  constexpr int STG = 22528;
  TILE_GLOAD(0)
  attn_sstore<NS>(smem, rk0, rk1, rk2, rv0, rv1);
  if (ntiles > 1) TILE_GLOAD(1)
  __syncthreads();
  for (int j = 0; j < ntiles; ++j) {
    char* sbase = smem + (j & 1) * STG;
    const int kpos = kposA + 64 * j;
    const bool masked = maskA && (j < nA);
    MB();
    f32x16 S0, S1;
#pragma unroll
    for (int e = 0; e < 16; ++e) { S0[e] = 0.f; S1[e] = 0.f; }
    const char* ka0 = sbase + r32 * KSTR + 16 * hh;
    const char* ka1 = sbase + (32 + r32) * KSTR + 16 * hh;
#define QK_STEP(s, qf) { bf16x8 a0 = *(const bf16x8*)(ka0 + 32 * (s)); bf16x8 a1 = *(const bf16x8*)(ka1 + 32 * (s)); \
      S0 = __builtin_amdgcn_mfma_f32_32x32x16_bf16(a0, qf, S0, 0, 0, 0); S1 = __builtin_amdgcn_mfma_f32_32x32x16_bf16(a1, qf, S1, 0, 0, 0); }
    QK_STEP(0, qf0) QK_STEP(1, qf1) QK_STEP(2, qf2) QK_STEP(3, qf3)
    if (NS == 6) { QK_STEP(4, qf4) QK_STEP(5, qf5) }
    SB();
    float mx = m_run;
#pragma unroll
    for (int e = 0; e < 16; ++e) {
      float v0 = S0[e], v1 = S1[e];
      if (masked) {
        const int kp = kpos + (e & 3) + 8 * (e >> 2) + 4 * hh;
        int d0 = qpos - kp; d0 = d0 < 0 ? -d0 : d0;
        int d1 = qpos - (kp + 32); d1 = d1 < 0 ? -d1 : d1;
        if (d0 > 128) v0 = -1e30f;
        if (d1 > 128) v1 = -1e30f;
      }
      S0[e] = v0; S1[e] = v1;
      mx = fmaxf(mx, fmaxf(v0, v1));
    }
    mx = fmaxf(mx, __shfl_xor(mx, 32));
    const float alpha = __builtin_amdgcn_exp2f(m_run - mx);
    m_run = mx;
    float rsum = 0.f;
#pragma unroll
    for (int e = 0; e < 16; ++e) {
      float p0 = __builtin_amdgcn_exp2f(S0[e] - mx), p1 = __builtin_amdgcn_exp2f(S1[e] - mx);
      S0[e] = p0; S1[e] = p1;
      rsum += p0 + p1;
    }
    rsum += __shfl_xor(rsum, 32);
    l_run = l_run * alpha + rsum;
#pragma unroll
    for (int e = 0; e < 16; ++e) { O0[e] *= alpha; O1[e] *= alpha; }
    const char* sv0 = sbase + 13312 + r32 * 136 + 8 * hh;
    const char* sv1 = sv0 + 32 * 136;
#define PV_STEP(pb, ka) { \
      { uint2 lo = *(const uint2*)(sv0 + (ka) * 2), hi = *(const uint2*)(sv0 + (ka) * 2 + 16); \
        bf16x8 va = __builtin_bit_cast(bf16x8, uint4{lo.x, lo.y, hi.x, hi.y}); O0 = __builtin_amdgcn_mfma_f32_32x32x16_bf16(va, pb, O0, 0, 0, 0); } \
      { uint2 lo = *(const uint2*)(sv1 + (ka) * 2), hi = *(const uint2*)(sv1 + (ka) * 2 + 16); \
        bf16x8 va = __builtin_bit_cast(bf16x8, uint4{lo.x, lo.y, hi.x, hi.y}); O1 = __builtin_amdgcn_mfma_f32_32x32x16_bf16(va, pb, O1, 0, 0, 0); } }
    SB();
    { bf16x8 pb = PACK8(S0, 0); PV_STEP(pb, 0) }
    { bf16x8 pb = PACK8(S0, 1); PV_STEP(pb, 16) }
    SB();
    { bf16x8 pb = PACK8(S1, 0); PV_STEP(pb, 32) }
    { bf16x8 pb = PACK8(S1, 1); PV_STEP(pb, 48) }
    SB();
    if (j + 1 < ntiles) {
      attn_sstore<NS>(smem + ((j + 1) & 1) * STG, rk0, rk1, rk2, rv0, rv1);
      if (j + 2 < ntiles) TILE_GLOAD(j + 2)
    }
    __syncthreads();
  }
#undef TILE_GLOAD
  const float inv = 1.f / l_run;
#pragma unroll
  for (int e4 = 0; e4 < 4; ++e4) {
    uint2 o;
    o.x = pack2(O0[4 * e4] * inv, O0[4 * e4 + 1] * inv); o.y = pack2(O0[4 * e4 + 2] * inv, O0[4 * e4 + 3] * inv);
    *(uint2*)(yrow + 8 * e4 + 4 * hh) = o;
    o.x = pack2(O1[4 * e4] * inv, O1[4 * e4 + 1] * inv); o.y = pack2(O1[4 * e4 + 2] * inv, O1[4 * e4 + 3] * inv);
    *(uint2*)(yrow + 32 + 8 * e4 + 4 * hh) = o;
  }
}

template <int MODE>
DI void scan_seg(const Params& p, int l, int seq, int blk, int d, int seg, char* smem) {
  const int t = tid(), lane = t & 63, w = t >> 6;
  const int c16 = lane & 15, g4 = lane >> 4;
  const bool is_ctx = seq < 16;
  const int b = is_ctx ? seq : seq - 16;
  const int L = is_ctx ? 256 : 4096;
  const int gbase = is_ctx ? b * 256 : T_CTX + b * 4096;
  const u16* XR = wsp<u16>(p, O_XR);
  u16* Y = wsp<u16>(p, O_YRNN);
  float* SUM = wsp<float>(p, O_SUM);
  char* sXc = smem;
  float* sA = (float*)(smem + 8704);
  float* sU = (float*)(smem + 8704 + 16384);
  const int cch = t & 127, th = t >> 7;
  const int chg = blk * 128 + cch;
  const float w0 = p.conv_w[(l * 4 + 0) * 1024 + chg], w1 = p.conv_w[(l * 4 + 1) * 1024 + chg];
  const float w2 = p.conv_w[(l * 4 + 2) * 1024 + chg], w3 = p.conv_w[(l * 4 + 3) * 1024 + chg];
  const float cb = p.conv_b[l * 1024 + chg];
  bf16x8 bw[4][4];
  {
    const u16* WL = wsp<u16>(p, O_WLRU) + (size_t)(d * 8 + blk) * 256 * 128 + (size_t)(32 * w + c16) * 128 + g4 * 8;
#pragma unroll
    for (int nf = 0; nf < 4; ++nf)
#pragma unroll
      for (int ks = 0; ks < 4; ++ks)
        bw[nf][ks] = *(const bf16x8*)(WL + (size_t)((nf & 1) * 16 + (nf >> 1) * 128) * 128 + ks * 32);
  }
  float ba[2], bi[2], cl[2];
#pragma unroll
  for (int jn = 0; jn < 2; ++jn) {
    const int ch = (l * 2 + d) * 1024 + blk * 128 + 32 * w + 16 * jn + c16;
    ba[jn] = p.lru_ba[ch]; bi[jn] = p.lru_bi[ch];
    cl[jn] = -8.f * log1pf(__expf(-p.lru_lam[ch]));
  }
  float h = 0.f, P = 1.f;
  if (MODE == 1 && !is_ctx && t < 128) {
    h = p.state[(((size_t)b * 4 + l) * 2 + d) * 1024 + blk * 128 + t];
    const float* sm = SUM + ((size_t)((b * 8 + blk) * 2 + d) * 16) * 256 + t;
    if (d == 0) { for (int s2 = 0; s2 < seg; ++s2) h = sm[s2 * 256] * h + sm[s2 * 256 + 128]; }
    else { for (int s2 = 15; s2 > seg; --s2) h = sm[s2 * 256] * h + sm[s2 * 256 + 128]; }
  }
#define X19(F) F(0) F(1) F(2) F(3) F(4) F(5) F(6) F(7) F(8) F(9) F(10) F(11) F(12) F(13) F(14) F(15) F(16) F(17) F(18)
#define XDECL(q) u16 xr##q = 0;
#define XLOAD(q) { const int pos = tcn + th * 16 - 1 + (q); xr##q = (pos >= 0 && pos < L) ? XR[(size_t)(gbase + pos) * 1024 + chg] : (u16)0; }
#define XCVT(q) xv[q] = bf2f(xr##q);
  X19(XDECL)
  { const int tcn = seg * 256 + (d == 0 ? 0 : 7) * 32; X19(XLOAD) }
  for (int ci = 0; ci < 8; ++ci) {
    const int tc0 = seg * 256 + (d == 0 ? ci : 7 - ci) * 32;
    {
      float xv[19];
      X19(XCVT)
#pragma unroll
      for (int q = 0; q < 16; ++q) {
        float xc = cb + w0 * xv[q] + w1 * xv[q + 1] + w2 * xv[q + 2] + w3 * xv[q + 3];
        *(u16*)(sXc + (th * 16 + q) * 272 + cch * 2) = f2bf(xc);
      }
    }
    unsigned yold0 = 0, yold1 = 0, yold2 = 0, yold3 = 0, yold4 = 0, yold5 = 0, yold6 = 0, yold7 = 0;
    {
      const int cn = ci < 7 ? ci + 1 : ci;
      const int tcn = seg * 256 + (d == 0 ? cn : 7 - cn) * 32;
      X19(XLOAD)
      if (MODE == 1 && d == 1) {
        const unsigned* yb = (const unsigned*)(Y + (size_t)(gbase + tc0 + (t >> 6)) * 1024 + blk * 128 + (t & 63) * 2);
        yold0 = yb[0]; yold1 = yb[4 * 512]; yold2 = yb[8 * 512]; yold3 = yb[12 * 512];
        yold4 = yb[16 * 512]; yold5 = yb[20 * 512]; yold6 = yb[24 * 512]; yold7 = yb[28 * 512];
      }
    }
    MB();
    __syncthreads();
    f32x4 aR[2][2], aI[2][2];
#pragma unroll
    for (int im = 0; im < 2; ++im)
#pragma unroll
      for (int jn = 0; jn < 2; ++jn) { aR[im][jn] = f32x4{0.f, 0.f, 0.f, 0.f}; aI[im][jn] = f32x4{0.f, 0.f, 0.f, 0.f}; }
#pragma unroll
    for (int ks = 0; ks < 4; ++ks)
#pragma unroll
      for (int im = 0; im < 2; ++im) {
        bf16x8 af = *(const bf16x8*)(sXc + (16 * im + c16) * 272 + (ks * 32 + g4 * 8) * 2);
#pragma unroll
        for (int jn = 0; jn < 2; ++jn) {
          aR[im][jn] = __builtin_amdgcn_mfma_f32_16x16x32_bf16(af, bw[jn][ks], aR[im][jn], 0, 0, 0);
          aI[im][jn] = __builtin_amdgcn_mfma_f32_16x16x32_bf16(af, bw[2 + jn][ks], aI[im][jn], 0, 0, 0);
        }
      }
#pragma unroll
    for (int im = 0; im < 2; ++im)
#pragma unroll
      for (int jn = 0; jn < 2; ++jn)
#pragma unroll
        for (int e = 0; e < 4; ++e) {
          const int tt = 16 * im + 4 * g4 + e, c = 32 * w + 16 * jn + c16;
          const float r = sigmoidf_(aR[im][jn][e] + ba[jn]);
          const float ig = sigmoidf_(aI[im][jn][e] + bi[jn]);
          const float a = __expf(cl[jn] * r);
          const float xc = bf2f(*(const u16*)(sXc + tt * 272 + c * 2));
          const float u = sqrtf(fmaxf(1.f - a * a, 0.f)) * ig * xc;
          sA[tt * 128 + c] = a; sU[tt * 128 + c] = u;
        }
    __syncthreads();
    if (t < 128) {
      if (d == 0) {
#pragma unroll 8
        for (int s = 0; s < 32; ++s) {
          const float a = sA[s * 128 + t];
          h = a * h + sU[s * 128 + t];
          if (MODE == 0) P *= a; else sU[s * 128 + t] = h;
        }
      } else {
#pragma unroll 8
        for (int s = 31; s >= 0; --s) {
          const float a = sA[s * 128 + t];
          h = a * h + sU[s * 128 + t];
          if (MODE == 0) P *= a; else sU[s * 128 + t] = h;
        }
      }
    }
    __syncthreads();
    if (MODE == 1) {
      const int c2 = (t & 63) * 2;
      unsigned* yb = (unsigned*)(Y + (size_t)(gbase + tc0 + (t >> 6)) * 1024 + blk * 128 + c2);
      const float* su = sU + (t >> 6) * 128 + c2;
#define YOUT(i, yo) { float h0 = su[(4 * (i)) * 128], h1 = su[(4 * (i)) * 128 + 1]; \
        if (d == 1) { h0 += __uint_as_float((yo) << 16); h1 += __uint_as_float((yo) & 0xffff0000u); } \
        yb[(size_t)(4 * (i)) * 512] = pack2(h0, h1); }
      YOUT(0, yold0) YOUT(1, yold1) YOUT(2, yold2) YOUT(3, yold3) YOUT(4, yold4) YOUT(5, yold5) YOUT(6, yold6) YOUT(7, yold7)
#undef YOUT
    }
  }
#undef X19
#undef XDECL
#undef XLOAD
#undef XCVT
  if (MODE == 0) {
    if (t < 128) {
      float* sm = SUM + ((size_t)(((b * 8 + blk) * 2 + d) * 16 + seg)) * 256 + t;
      sm[0] = P; sm[128] = h;
    }
  } else if (is_ctx && t < 128) {
    p.out[OUT_RG + (((size_t)b * 4 + l) * 2 + d) * 1024 + blk * 128 + t] = h;
  }
  __syncthreads();
}

DI void phase_mix(const Params& p, int l, char* smem) {
  constexpr float LOG2E = 1.4426950408889634f;
  constexpr int N0 = 1024, N1 = N0 + 2048, N2 = N1 + 2048, N3 = N2 + 128, N4 = N3 + 256, N5 = N4 + 256;
  for (int base = 0; base < N5; base += gridDim.x) {
    const int it = xcd_map(base);
    if (it >= N5) continue;
    const int t = tid(), lane = t & 63, w = t >> 6;
    const int r32 = lane & 31;
    if (it < N0 || (it >= N2 && it < N3)) {
      int seq, blk, seg;
      if (it < N0) { seg = it & 15; blk = (it >> 4) & 7; seq = 16 + (it >> 7); }
      else { const int i = it - N2; seg = 0; blk = i & 7; seq = i >> 3; }
      scan_seg<1>(p, l, seq, blk, 0, seg, smem);
      scan_seg<1>(p, l, seq, blk, 1, seg, smem);
#if PROBE == 4
      scan_seg<1>(p, l, seq, blk, 0, seg, smem);
      scan_seg<1>(p, l, seq, blk, 1, seg, smem);
#endif
    } else if (it < N1 || (it >= N3 && it < N4)) {
      const bool lat = it < N1;
      int b, h, qb;
      if (lat) { const int i = it - N0; qb = i & 31; h = (i >> 5) & 7; b = i >> 8; }
      else { const int i = it - N3; qb = i & 1; h = (i >> 1) & 7; b = i >> 4; }
      const int Lk = lat ? LK_LAT : 256;
      const int gq = (lat ? T_CTX + b * 4096 : b * 256) + qb * 128 + w * 32 + r32;
      const u16* Kn = (lat ? wsp<u16>(p, O_KNL) : wsp<u16>(p, O_KNC)) + ((size_t)b * 8 + h) * Lk * 64;
      const u16* Kr = (lat ? wsp<u16>(p, O_KRL) : wsp<u16>(p, O_KRC)) + (size_t)b * Lk * 32;
      const u16* Vt = (lat ? wsp<u16>(p, O_VTL) : wsp<u16>(p, O_VTC)) + ((size_t)b * 8 + h) * 64 * Lk;
      const u16* Q = wsp<u16>(p, O_Q) + (size_t)gq * 768;
      u16* yrow = wsp<u16>(p, O_CQ) + (size_t)gq * 512 + h * 64;
      attn_item<6>(Kn, 64, Kr, Vt, Lk, Lk >> 6, 0, 0, nullptr, 0, nullptr, 0, 0,
                   Q + h * 64, Q + 512 + h * 32, 0.10206207261596577f * LOG2E, -1e30f, 0.f, 0, yrow, smem);
#if PROBE == 5
      __syncthreads();
      attn_item<6>(Kn, 64, Kr, Vt, Lk, Lk >> 6, 0, 0, nullptr, 0, nullptr, 0, 0,
                   Q + h * 64, Q + 512 + h * 32, 0.10206207261596577f * LOG2E, -1e30f, 0.f, 0, yrow, smem);
#endif
    } else {
      const bool lat = it < N2;
      int b, h, qb;
      if (lat) { const int i = it - N1; qb = i & 31; h = (i >> 5) & 7; b = i >> 8; }
      else { const int i = it - N4; qb = i & 1; h = (i >> 1) & 7; b = i >> 4; }
      const int kvh = h >> 2;
      const int gseq = lat ? T_CTX + b * 4096 : b * 256;
      const int qpos = qb * 128 + w * 32 + r32;
      const int gq = gseq + qpos;
      u16* qrow = wsp<u16>(p, O_QS) + (size_t)gq * 512 + h * 64;
      const float sink2 = p.sink[l * 8 + h] * LOG2E;
      const int t0 = qb * 128;
      int jlo = 0, jhi = 6;
      if (t0 == 0) jlo = 2;
      if (t0 + 128 >= 4096) jhi = 4;
      const int ks0 = lat ? t0 - 128 + 64 * jlo : 0;
      const int nA = lat ? jhi - jlo : 4;
      const u16* KS = wsp<u16>(p, O_KS) + (size_t)(gseq + ks0) * 128 + kvh * 64;
      const u16* VT = lat ? wsp<u16>(p, O_VTSL) + ((size_t)b * 2 + kvh) * 64 * 4096 + ks0
                          : wsp<u16>(p, O_VTSC) + ((size_t)b * 2 + kvh) * 64 * 256;
      const u16* KC = wsp<u16>(p, O_KSC) + (size_t)b * 256 * 128 + kvh * 64;
      const u16* VC = wsp<u16>(p, O_VTSCC) + ((size_t)b * 2 + kvh) * 64 * 256;
      attn_item<4>(KS, 128, nullptr, VT, lat ? 4096 : 256, nA, ks0, lat ? 1 : 0, KC, 128, VC, 256, lat ? 4 : 0,
                   qrow, nullptr, 0.125f * LOG2E, sink2, 1.f, qpos, qrow, smem);
    }
    __syncthreads();
  }
}

DI void phase_gate(const Params& p, int l, char* smem) {
  const u16* H = wsp<u16>(p, O_H);
  const u16* W = wsp<u16>(p, O_WINB);
  for (int base = 0; base < 288 * 40; base += gridDim.x) {
    const int tile = xcd_map(base);
    if (tile >= 288 * 40) continue;
    const int mt = tile / 40, nt = tile % 40;
    const int g0 = mt * 128;
    f32x4 acc[4][4];
    zero_acc(acc);
    gemm_tile(H + (size_t)g0 * 1024, 1024, W + (size_t)nt * 128 * 1024, 1024, 1024, acc, smem);
    LANEVARS
    if (nt < 16) {
      u16* dst; int ld, cb;
      if (nt < 8) { dst = wsp<u16>(p, O_YRNN); ld = 1024; cb = nt * 128; }
      else if (nt < 12) { dst = wsp<u16>(p, O_CQ); ld = 512; cb = (nt - 8) * 128; }
      else { dst = wsp<u16>(p, O_QS); ld = 512; cb = (nt - 12) * 128; }
#pragma unroll
      for (int i = 0; i < 4; ++i)
#pragma unroll
        for (int j = 0; j < 4; ++j)
#pragma unroll
          for (int e = 0; e < 4; ++e) {
            const int g = g0 + wr * 64 + i * 16 + g4 * 4 + e;
            u16* d = dst + (size_t)g * ld + cb + wc * 64 + j * 16 + c16;
            const float gv = acc[i][j][e];
            *d = f2bf(bf2f(*d) * gv * sigmoidf_(gv));
            if (e == 3) SB();
          }
    } else {
      const int br = (nt - 16) >> 3, cb = ((nt - 16) & 7) * 128;
      u16* dst = br == 0 ? wsp<u16>(p, O_XR) : wsp<u16>(p, O_KS) + (size_t)(br - 1) * T_ALL * 1024;
#pragma unroll
      for (int i = 0; i < 4; ++i)
#pragma unroll
        for (int j = 0; j < 4; ++j)
#pragma unroll
          for (int e = 0; e < 4; ++e) {
            const int g = g0 + wr * 64 + i * 16 + g4 * 4 + e;
            dst[(size_t)g * 1024 + cb + wc * 64 + j * 16 + c16] = f2bf(sigmoidf_(acc[i][j][e]));
            if (e == 3) SB();
          }
    }
  }
}

DI void phase_merge(const Params& p, int l, char* smem) {
  u16* U = wsp<u16>(p, O_H);
  for (int base = 0; base < 288 * 8; base += gridDim.x) {
    const int tile = xcd_map(base);
    if (tile >= 288 * 8) continue;
    const int mt = tile >> 3, nt = tile & 7;
    const int g0 = mt * 128;
    f32x4 u[4][4];
    zero_acc(u);
    for (int br = 0; br < 3; ++br) {
      f32x4 acc[4][4];
      zero_acc(acc);
      const u16* Z; const u16* WT; int kz; const u16* M;
      if (br == 0) { Z = wsp<u16>(p, O_YRNN) + (size_t)g0 * 1024; WT = wsp<u16>(p, O_WBRR) + (size_t)nt * 128 * 1024; kz = 1024; M = wsp<u16>(p, O_XR); }
      else if (br == 1) { Z = wsp<u16>(p, O_CQ) + (size_t)g0 * 512; WT = wsp<u16>(p, O_WBRM) + (size_t)nt * 128 * 512; kz = 512; M = wsp<u16>(p, O_KS); }
      else { Z = wsp<u16>(p, O_QS) + (size_t)g0 * 512; WT = wsp<u16>(p, O_WBRS) + (size_t)nt * 128 * 512; kz = 512; M = wsp<u16>(p, O_KS) + (size_t)T_ALL * 1024; }
      gemm_tile(Z, kz, WT, kz, kz, acc, smem);
      LANEVARS
#pragma unroll
      for (int i = 0; i < 4; ++i)
#pragma unroll
        for (int j = 0; j < 4; ++j)
#pragma unroll
          for (int e = 0; e < 4; ++e) {
            const int g = g0 + wr * 64 + i * 16 + g4 * 4 + e;
            u[i][j][e] += bf2f(M[(size_t)g * 1024 + nt * 128 + wc * 64 + j * 16 + c16]) * acc[i][j][e];
            if (e == 3) SB();
          }
    }
    LANEVARS
#pragma unroll
    for (int i = 0; i < 4; ++i)
#pragma unroll
      for (int j = 0; j < 4; ++j)
#pragma unroll
        for (int e = 0; e < 4; ++e) {
          const int g = g0 + wr * 64 + i * 16 + g4 * 4 + e;
          U[(size_t)g * 1024 + nt * 128 + wc * 64 + j * 16 + c16] = f2bf(u[i][j][e]);
        }
  }
}

DI void phase_out(const Params& p, int l, char* smem) {
  const u16* U = wsp<u16>(p, O_H);
  const u16* W = wsp<u16>(p, O_WOUT);
  const float* MOD = wsp<float>(p, O_MOD) + (size_t)l * 9 * 3072;
  for (int base = 0; base < 288 * 8; base += gridDim.x) {
    const int tile = xcd_map(base);
    if (tile >= 288 * 8) continue;
    const int mt = tile >> 3, nt = tile & 7;
    const int g0 = mt * 128;
    const int ci = g0 < T_CTX ? 8 : ((g0 - T_CTX) >> 12);
    f32x4 acc[4][4];
    zero_acc(acc);
    gemm_tile(U + (size_t)g0 * 1024, 1024, W + (size_t)nt * 128 * 1024, 1024, 1024, acc, smem);
    LANEVARS
#pragma unroll
    for (int j = 0; j < 4; ++j) {
      const int col = nt * 128 + wc * 64 + j * 16 + c16;
      const float gt = MOD[ci * 3072 + 2048 + col];
#pragma unroll
      for (int i = 0; i < 4; ++i)
#pragma unroll
        for (int e = 0; e < 4; ++e) {
          const int g = g0 + wr * 64 + i * 16 + g4 * 4 + e;
          const float xo = xin_row(p, l, g)[col];
          p.out[(size_t)g * 1024 + col] = xo + gt * acc[i][j][e];
          if (e == 3) SB();
        }
    }
  }
}

DI void phase_final(const Params& p) {
  const int t = tid(), lane = t & 63, w = t >> 6;
  for (int row = blockIdx.x * 4 + w; row < T_ALL; row += gridDim.x * 4) {
    float* x = p.out + (size_t)row * 1024;
    float4 v[4];
    float ss = 0.f;
#pragma unroll
    for (int i = 0; i < 4; ++i) {
      v[i] = *(const float4*)(x + i * 256 + lane * 4);
      ss += v[i].x * v[i].x + v[i].y * v[i].y + v[i].z * v[i].z + v[i].w * v[i].w;
    }
    ss = wave_sum(ss);
    const float rs = rsqrtf(ss * (1.f / 1024.f) + EPS);
#pragma unroll
    for (int i = 0; i < 4; ++i) {
      const int c = i * 256 + lane * 4;
      const float4 g = *(const float4*)(p.final_norm + c);
      float4 o = {v[i].x * rs * g.x, v[i].y * rs * g.y, v[i].z * rs * g.z, v[i].w * rs * g.w};
      *(float4*)(x + c) = o;
    }
  }
}

constexpr int NPHASE_PER_LAYER = 7;
DI void run_phase(const Params& p, int ph, char* smem) {
  if (ph == 0) { phase_mod(p, smem); return; }
  if (ph == 1 + NLAYER * NPHASE_PER_LAYER) { phase_final(p); return; }
  const int l = (ph - 1) / NPHASE_PER_LAYER, s = (ph - 1) % NPHASE_PER_LAYER;
  switch (s) {
    case 0: phase_prep(p, l); break;
    case 1: phase_gemmA(p, l, smem); break;
    case 2: phase_qkv(p, l, smem); break;
    case 3: phase_mix(p, l, smem); break;
    case 4: phase_gate(p, l, smem); break;
    case 5: phase_merge(p, l, smem); break;
    default: phase_out(p, l, smem); break;
  }
}
constexpr int NPHASE = 2 + NLAYER * NPHASE_PER_LAYER;

#if MEGA
DI Params launder(const Params& p) {
  size_t z = 0;
  asm volatile("" : "+s"(z));
  Params q = p; q.ws = p.ws + z; q.out = p.out + z;
  return q;
}
DI void fast_barrier(unsigned* ctr, unsigned& epoch) {
  asm volatile("s_waitcnt vmcnt(0)" ::: "memory");
  __syncthreads();
  epoch += gridDim.x;
  if (threadIdx.x == 0) {
    __builtin_amdgcn_fence(__ATOMIC_RELEASE, "agent");
    asm volatile("s_waitcnt vmcnt(0)" ::: "memory");
    __hip_atomic_fetch_add(ctr, 1u, __ATOMIC_RELAXED, __HIP_MEMORY_SCOPE_AGENT);
    unsigned spins = 0;
    while (__hip_atomic_load(ctr, __ATOMIC_RELAXED, __HIP_MEMORY_SCOPE_AGENT) < epoch) {
      __builtin_amdgcn_s_sleep(1);
      if (++spins > (1u << 22)) break;
    }
    __builtin_amdgcn_fence(__ATOMIC_ACQUIRE, "agent");
    asm volatile("s_waitcnt vmcnt(0)" ::: "memory");
  }
  __syncthreads();
}
#define GSYNC() fast_barrier(bar_ctr, bar_epoch)
__global__ void __launch_bounds__(256, 2) mega_kernel(Params p) {
  __shared__ __attribute__((aligned(16))) char smem[66048];
  cg::grid_group grid = cg::this_grid();
  unsigned* bar_ctr = (unsigned*)(p.ws + O_BAR);
  unsigned bar_epoch = 0;
  phase_mod(launder(p), smem);
  grid.sync();
  for (int l = 0; l < NLAYER; ++l) {
    phase_prep(launder(p), l);
    GSYNC();
#if PROBE == 1
    phase_prep(launder(p), l);
    GSYNC();
#endif
    phase_gemmA(launder(p), l, smem);
    GSYNC();
#if PROBE == 2
    phase_gemmA(launder(p), l, smem);
    GSYNC();
#endif
    phase_qkv(launder(p), l, smem);
    GSYNC();
    phase_mix(launder(p), l, smem);
    GSYNC();
    phase_gate(launder(p), l, smem);
    GSYNC();
    phase_merge(launder(p), l, smem);
    GSYNC();
#if PROBE == 3
    phase_merge(launder(p), l, smem);
    GSYNC();
#endif
    phase_out(launder(p), l, smem);
    GSYNC();
  }
  phase_final(launder(p));
}

#else
__global__ void __launch_bounds__(256, 2) phase_kernel(Params p, int ph) {
  __shared__ __attribute__((aligned(16))) char smem[66048];
  run_phase(p, ph, smem);
}

#endif
extern "C" void kernel_launch(void* const* d_in, const int* in_sizes, int n_in, void* d_out, int out_size, void* d_ws,
                              size_t ws_size, hipStream_t stream) {
  Params p{};
  const float** pp = (const float**)&p;
  for (int i = 0; i < 30; ++i) pp[i] = (const float*)d_in[i];
  p.out = (float*)d_out;
  p.ws = (char*)d_ws;
  if (ws_size < WS_NEED) fprintf(stderr, "workspace too small: %zu < %zu\n", ws_size, (size_t)WS_NEED);
#if MEGA
  static int grid_blocks = 0;
  if (!grid_blocks) {
    int dev = 0, cus = 0, per_cu = 0;
    hipGetDevice(&dev);
    hipDeviceGetAttribute(&cus, hipDeviceAttributeMultiprocessorCount, dev);
    hipOccupancyMaxActiveBlocksPerMultiprocessor(&per_cu, mega_kernel, 256, 0);
    if (per_cu > 2) per_cu = 2;
    grid_blocks = cus * per_cu;
  }
  (void)hipMemsetAsync((char*)d_ws + O_BAR, 0, 256, stream);
  void* args[] = {&p};
  hipError_t e = hipLaunchCooperativeKernel((void*)mega_kernel, dim3(grid_blocks), dim3(256), args, 0, stream);
  if (e != hipSuccess) fprintf(stderr, "cooperative launch failed: %s (grid %d)\n", hipGetErrorString(e), grid_blocks);
#else
  for (int ph = 0; ph < NPHASE; ++ph) phase_kernel<<<512, 256, 0, stream>>>(p, ph);
#endif
}
```

```cpp
#include <hip/hip_runtime.h>
#include <hip/hip_cooperative_groups.h>
#include <cstdio>
#include <cstdint>
namespace cg = cooperative_groups;

#ifndef PROBE
#define PROBE 0
#endif
#ifndef MEGA
#define MEGA 1
#endif

typedef unsigned short u16;
using bf16x8 = __attribute__((ext_vector_type(8))) short;
using f32x4 = __attribute__((ext_vector_type(4))) float;
using f32x16 = __attribute__((ext_vector_type(16))) float;
typedef __bf16 bf2_t __attribute__((ext_vector_type(2)));
typedef float f2_t __attribute__((ext_vector_type(2)));
#define DI __device__ __forceinline__

__device__ const float TAB_M[1024] = {
  1.00000000e+00f, 0.00000000e+00f, 1.00000000e+00f, 0.00000000e+00f, 1.00000000e+00f, 0.00000000e+00f, 1.00000000e+00f, 0.00000000e+00f,
  1.00000000e+00f, 0.00000000e+00f, 1.00000000e+00f, 0.00000000e+00f, 1.00000000e+00f, 0.00000000e+00f, 1.00000000e+00f, 0.00000000e+00f,
  5.40302277e-01f, 8.41470957e-01f, 9.50415254e-01f, 3.10983598e-01f, 9.95004177e-01f, 9.98334214e-02f, 9.99500036e-01f, 3.16175036e-02f,
  9.99949992e-01f, 9.99983307e-03f, 9.99994993e-01f, 3.16227227e-03f, 9.99999523e-01f, 9.99999931e-04f, 9.99999940e-01f, 3.16227757e-04f,
  -4.16146845e-01f, 9.09297407e-01f, 8.06578398e-01f, 5.91127098e-01f, 9.80066597e-01f, 1.98669329e-01f, 9.98000681e-01f, 6.32033944e-02f,
  9.99800026e-01f, 1.99986659e-02f, 9.99979973e-01f, 6.32451288e-03f, 9.99997973e-01f, 1.99999870e-03f, 9.99999821e-01f, 6.32455456e-04f,
  -9.89992499e-01f, 1.41120002e-01f, 5.82753658e-01f, 8.12648892e-01f, 9.55336511e-01f, 2.95520216e-01f, 9.95503366e-01f, 9.47260857e-02f,
  9.99550045e-01f, 2.99954992e-02f, 9.99954998e-01f, 9.48669016e-03f, 9.99995530e-01f, 2.99999560e-03f, 9.99999523e-01f, 9.48683126e-04f,
  -6.53643608e-01f, -7.56802499e-01f, 3.01137477e-01f, 9.53580737e-01f, 9.21060979e-01f, 3.89418334e-01f, 9.92010653e-01f, 1.26154065e-01f,
  9.99200106e-01f, 3.99893336e-02f, 9.99920011e-01f, 1.26487734e-02f, 9.99992013e-01f, 3.99998948e-03f, 9.99999225e-01f, 1.26491068e-03f,
  2.83662200e-01f, -9.58924294e-01f, -1.03423381e-02f, 9.99946535e-01f, 8.77582550e-01f, 4.79425550e-01f, 9.87526000e-01f, 1.57455876e-01f,
  9.98750269e-01f, 4.99791652e-02f, 9.99875009e-01f, 1.58107281e-02f, 9.99987483e-01f, 4.99997940e-03f, 9.99998748e-01f, 1.58113812e-03f,
  9.60170269e-01f, -2.79415488e-01f, -3.20796400e-01f, 9.47148204e-01f, 8.25335622e-01f, 5.64642489e-01f, 9.82053936e-01f, 1.88600272e-01f,
  9.98200536e-01f, 5.99640049e-02f, 9.99819994e-01f, 1.89725272e-02f, 9.99981999e-01f, 5.99996420e-03f, 9.99998212e-01f, 1.89736532e-03f,
  7.53902256e-01f, 6.56986594e-01f, -5.99437475e-01f, 8.00421596e-01f, 7.64842212e-01f, 6.44217670e-01f, 9.75599885e-01f, 2.19556093e-01f,
  9.97551024e-01f, 6.99428469e-02f, 9.99755025e-01f, 2.21341345e-02f, 9.99975502e-01f, 6.99994294e-03f, 9.99997556e-01f, 2.21359241e-03f,
  -1.45500034e-01f, 9.89358246e-01f, -8.18632424e-01f, 5.74317753e-01f, 6.96706712e-01f, 7.17356086e-01f, 9.68170285e-01f, 2.50292331e-01f,
  9.96801734e-01f, 7.99146891e-02f, 9.99680042e-01f, 2.52955221e-02f, 9.99967992e-01f, 7.99991470e-03f, 9.99996781e-01f, 2.52981926e-03f,
  -9.11130250e-01f, 4.12118495e-01f, -9.56644177e-01f, 2.91259229e-01f, 6.21609926e-01f, 7.83326924e-01f, 9.59772646e-01f, 2.80778319e-01f,
  9.95952725e-01f, 8.98785442e-02f, 9.99595046e-01f, 2.84566563e-02f, 9.99959528e-01f, 8.99987947e-03f, 9.99995947e-01f, 2.84604589e-03f,
  -8.39071512e-01f, -5.44021130e-01f, -9.99786079e-01f, -2.06835698e-02f, 5.40302277e-01f, 8.41470957e-01f, 9.50415313e-01f, 3.10983568e-01f,
  9.95004177e-01f, 9.98334140e-02f, 9.99500036e-01f, 3.16175036e-02f, 9.99949992e-01f, 9.99983400e-03f, 9.99994993e-01f, 3.16227227e-03f,
  4.42569796e-03f, -9.99990225e-01f, -9.43779767e-01f, -3.30574960e-01f, 4.53596085e-01f, 8.91207397e-01f, 9.40107584e-01f, 3.40877861e-01f,
  9.93956089e-01f, 1.09778300e-01f, 9.99395072e-01f, 3.47780399e-02f, 9.99939501e-01f, 1.09997792e-02f, 9.99993920e-01f, 3.47849843e-03f,
  8.43853951e-01f, -5.36572933e-01f, -7.94179380e-01f, -6.07683420e-01f, 3.62357706e-01f, 9.32039082e-01f, 9.28859890e-01f, 3.70431304e-01f,
  9.92808640e-01f, 1.19712204e-01f, 9.99280095e-01f, 3.79382223e-02f, 9.99927998e-01f, 1.19997123e-02f, 9.99992788e-01f, 3.79472389e-03f,
  9.07446802e-01f, 4.20167029e-01f, -5.65820515e-01f, -8.24528456e-01f, 2.67498761e-01f, 9.63558197e-01f, 9.16683376e-01f, 3.99614304e-01f,
  9.91561890e-01f, 1.29634142e-01f, 9.99155104e-01f, 4.10980321e-02f, 9.99915481e-01f, 1.29996343e-02f, 9.99991536e-01f, 4.11094911e-03f,
  1.36737213e-01f, 9.90607381e-01f, -2.81349480e-01f, -9.59605396e-01f, 1.69967160e-01f, 9.85449731e-01f, 9.03590262e-01f, 4.28397775e-01f,
  9.90216017e-01f, 1.39543116e-01f, 9.99020159e-01f, 4.42574248e-02f, 9.99902010e-01f, 1.39995432e-02f, 9.99990225e-01f, 4.42717411e-03f,
  -7.59687901e-01f, 6.50287867e-01f, 3.10223512e-02f, -9.99518692e-01f, 7.07371980e-02f, 9.97494996e-01f, 8.89593601e-01f, 4.56752867e-01f,
  9.88771081e-01f, 1.49438128e-01f, 9.98875201e-01f, 4.74163815e-02f, 9.99887526e-01f, 1.49994381e-02f, 9.99988735e-01f, 4.74339863e-03f,
  -9.57659483e-01f, -2.87903309e-01f, 3.40318173e-01f, -9.40310359e-01f, -2.91995462e-02f, 9.99573588e-01f, 8.74707460e-01f, 4.84651238e-01f,
  9.87227261e-01f, 1.59318209e-01f, 9.98720288e-01f, 5.05748577e-02f, 9.99872029e-01f, 1.59993190e-02f, 9.99987185e-01f, 5.05962269e-03f,
  -2.75163352e-01f, -9.61397469e-01f, 6.15864813e-01f, -7.87851870e-01f, -1.28844544e-01f, 9.91664827e-01f, 8.58946681e-01f, 5.12064993e-01f,
  9.85584795e-01f, 1.69182345e-01f, 9.98555362e-01f, 5.37328273e-02f, 9.99855518e-01f, 1.69991814e-02f, 9.99985576e-01f, 5.37584582e-03f,
  6.60316706e-01f, -7.50987232e-01f, 8.30336154e-01f, -5.57262897e-01f, -2.27202162e-01f, 9.73847628e-01f, 8.42327058e-01f, 5.38966715e-01f,
  9.83843684e-01f, 1.79029569e-01f, 9.98380423e-01f, 5.68902642e-02f, 9.99837995e-01f, 1.79990288e-02f, 9.99983788e-01f, 5.69206895e-03f,
  9.88704622e-01f, 1.49877205e-01f, 9.62463796e-01f, -2.71410108e-01f, -3.23289543e-01f, 9.46300089e-01f, 8.24865162e-01f, 5.65329552e-01f,
  9.82004225e-01f, 1.88858896e-01f, 9.98195529e-01f, 6.00471310e-02f, 9.99819517e-01f, 1.89988576e-02f, 9.99981940e-01f, 6.00829115e-03f,
  4.08082068e-01f, 9.12945271e-01f, 9.99144375e-01f, 4.13582884e-02f, -4.16146845e-01f, 9.09297407e-01f, 8.06578457e-01f, 5.91127038e-01f,
  9.80066597e-01f, 1.98669314e-01f, 9.98000681e-01f, 6.32033944e-02f, 9.99800026e-01f, 1.99986678e-02f, 9.99979973e-01f, 6.32451288e-03f,
  -5.47729254e-01f, 8.36655617e-01f, 9.36740458e-01f, 3.50024760e-01f, -5.04846215e-01f, 8.63209307e-01f, 7.87485182e-01f, 6.16333544e-01f,
  9.78030920e-01f, 2.08459899e-01f, 9.97795820e-01f, 6.63590282e-02f, 9.99779522e-01f, 2.09984574e-02f, 9.99977946e-01f, 6.64073415e-03f,
  -9.99960840e-01f, -8.85130931e-03f, 7.81440377e-01f, 6.23979926e-01f, -5.88501155e-01f, 8.08496356e-01f, 7.67604589e-01f, 6.40923738e-01f,
  9.75897431e-01f, 2.18229622e-01f, 9.97581005e-01f, 6.95140064e-02f, 9.99758005e-01f, 2.19982266e-02f, 9.99975801e-01f, 6.95695449e-03f,
  -5.32833040e-01f, -8.46220434e-01f, 5.48645258e-01f, 8.36055279e-01f, -6.66275978e-01f, 7.45705247e-01f, 7.46956408e-01f, 6.64873064e-01f,
  9.73666370e-01f, 2.27977514e-01f, 9.97356176e-01f, 7.26682767e-02f, 9.99735534e-01f, 2.29979735e-02f, 9.99973536e-01f, 7.27317436e-03f,
  4.24179018e-01f, -9.05578375e-01f, 2.61441678e-01f, 9.65219259e-01f, -7.37393796e-01f, 6.75463140e-01f, 7.25561321e-01f, 6.88157499e-01f,
  9.71337974e-01f, 2.37702623e-01f, 9.97121394e-01f, 7.58218244e-02f, 9.99711990e-01f, 2.39976961e-02f, 9.99971211e-01f, 7.58939330e-03f,
  9.91202831e-01f, -1.32351756e-01f, -5.16893305e-02f, 9.98663187e-01f, -8.01143587e-01f, 5.98472118e-01f, 7.03440726e-01f, 7.10753918e-01f,
  9.68912423e-01f, 2.47403964e-01f, 9.96876657e-01f, 7.89746121e-02f, 9.99687493e-01f, 2.49973964e-02f, 9.99968767e-01f, 7.90561177e-03f,
  6.46919310e-01f, 7.62558460e-01f, -3.59694332e-01f, 9.33070183e-01f, -8.56888831e-01f, 5.15501261e-01f, 6.80616796e-01f, 7.32639611e-01f,
  9.66389954e-01f, 2.57080555e-01f, 9.96621907e-01f, 8.21266174e-02f, 9.99662042e-01f, 2.59970706e-02f, 9.99966204e-01f, 8.22182931e-03f,
  -2.92138815e-01f, 9.56375957e-01f, -6.32028639e-01f, 7.74945021e-01f, -9.04072165e-01f, 4.27379847e-01f, 6.57112300e-01f, 7.53792703e-01f,
  9.63770926e-01f, 2.66731411e-01f, 9.96357203e-01f, 8.52777958e-02f, 9.99635518e-01f, 2.69967206e-02f, 9.99963522e-01f, 8.53804592e-03f,
  -9.62605894e-01f, 2.70905793e-01f, -8.41684937e-01f, 5.39968967e-01f, -9.42222297e-01f, 3.34988207e-01f, 6.32950664e-01f, 7.74192095e-01f,
  9.61055458e-01f, 2.76355654e-01f, 9.96082544e-01f, 8.84281173e-02f, 9.99608040e-01f, 2.79963426e-02f, 9.99960780e-01f, 8.85426160e-03f,
  -7.48057544e-01f, -6.63633883e-01f, -9.67871487e-01f, 2.51445323e-01f, -9.70958173e-01f, 2.39249229e-01f, 6.08156204e-01f, 7.93817401e-01f,
  9.58243906e-01f, 2.85952210e-01f, 9.95797932e-01f, 9.15775672e-02f, 9.99579549e-01f, 2.89959367e-02f, 9.99957979e-01f, 9.17047635e-03f,
  1.54251456e-01f, -9.88031626e-01f, -9.98075247e-01f, -6.20148405e-02f, -9.89992499e-01f, 1.41120002e-01f, 5.82753658e-01f, 8.12648892e-01f,
  9.55336511e-01f, 2.95520186e-01f, 9.95503366e-01f, 9.47260931e-02f, 9.99550045e-01f, 2.99955010e-02f, 9.99954998e-01f, 9.48669016e-03f,
  9.14742351e-01f, -4.04037654e-01f, -9.29300308e-01f, -3.69325012e-01f, -9.99135137e-01f, 4.15805206e-02f, 5.56768358e-01f, 8.30667794e-01f,
  9.52333570e-01f, 3.05058628e-01f, 9.95198846e-01f, 9.78736654e-02f, 9.99519527e-01f, 3.09950355e-02f, 9.99951959e-01f, 9.80290305e-03f,
  8.34223390e-01f, 5.51426709e-01f, -7.68367112e-01f, -6.40009403e-01f, -9.98294771e-01f, -5.83741926e-02f, 5.30226350e-01f, 8.47856104e-01f,
  9.49235439e-01f, 3.14566553e-01f, 9.94884372e-01f, 1.01020269e-01f, 9.99488056e-01f, 3.19945402e-02f, 9.99948800e-01f, 1.01191159e-02f,
  -1.32767474e-02f, 9.99911845e-01f, -5.31235278e-01f, -8.47224355e-01f, -9.87479806e-01f, -1.57745644e-01f, 5.03154159e-01f, 8.64196658e-01f,
  9.46042359e-01f, 3.24043006e-01f, 9.94559944e-01f, 1.04165860e-01f, 9.99455571e-01f, 3.29940096e-02f, 9.99945521e-01f, 1.04353270e-02f,
  -8.48570287e-01f, 5.29082716e-01f, -2.41421118e-01f, -9.70420420e-01f, -9.66798186e-01f, -2.55541205e-01f, 4.75578904e-01f, 8.79673064e-01f,
  9.42754686e-01f, 3.33487093e-01f, 9.94225562e-01f, 1.07310407e-01f, 9.99422073e-01f, 3.39934528e-02f, 9.99942183e-01f, 1.07515370e-02f,
  -9.03692186e-01f, -4.28182662e-01f, 7.23346695e-02f, -9.97380435e-01f, -9.36456680e-01f, -3.50783229e-01f, 4.47528064e-01f, 8.94269884e-01f,
  9.39372718e-01f, 3.42897803e-01f, 9.93881226e-01f, 1.10453881e-01f, 9.99387562e-01f, 3.49928550e-02f, 9.99938726e-01f, 1.10677453e-02f,
  -1.27963692e-01f, -9.91778851e-01f, 3.78916174e-01f, -9.25431013e-01f, -8.96758378e-01f, -4.42520559e-01f, 4.19029742e-01f, 9.07972515e-01f,
  9.35896814e-01f, 3.52274209e-01f, 9.93526995e-01f, 1.13596253e-01f, 9.99352098e-01f, 3.59922275e-02f, 9.99935210e-01f, 1.13839535e-02f,
  7.65414059e-01f, -6.43538117e-01f, 6.47921681e-01f, -7.61706948e-01f, -8.48100007e-01f, -5.29836178e-01f, 3.90112430e-01f, 9.20767248e-01f,
  9.32327330e-01f, 3.61615449e-01f, 9.93162811e-01f, 1.16737492e-01f, 9.99315560e-01f, 3.69915590e-02f, 9.99931574e-01f, 1.17001599e-02f,
  9.55073655e-01f, 2.96368569e-01f, 8.52673113e-01f, -5.22444785e-01f, -7.90967762e-01f, -6.11857831e-01f, 3.60805035e-01f, 9.32641268e-01f,
  9.28664625e-01f, 3.70920479e-01f, 9.92788672e-01f, 1.19877554e-01f, 9.99278069e-01f, 3.79908569e-02f, 9.99927819e-01f, 1.20163653e-02f,
  2.66642928e-01f, 9.63795364e-01f, 9.72865343e-01f, -2.31372014e-01f, -7.25932240e-01f, -6.87766254e-01f, 3.31136853e-01f, 9.43582714e-01f,
  9.24909055e-01f, 3.80188406e-01f, 9.92404640e-01f, 1.23016424e-01f, 9.99239624e-01f, 3.89901139e-02f, 9.99923944e-01f, 1.23325698e-02f,
  -6.66938066e-01f, 7.45113134e-01f, 9.96578991e-01f, 8.26458037e-02f, -6.53643608e-01f, -7.56802499e-01f, 3.01137596e-01f, 9.53580678e-01f,
  9.21060979e-01f, 3.89418334e-01f, 9.92010653e-01f, 1.26154065e-01f, 9.99200106e-01f, 3.99893373e-02f, 9.99920011e-01f, 1.26487734e-02f,
  -9.87339258e-01f, -1.58622667e-01f, 9.21462357e-01f, 3.88467699e-01f, -5.74824035e-01f, -8.18277061e-01f, 2.70837069e-01f, 9.62625206e-01f,
  9.17120814e-01f, 3.98609310e-01f, 9.91606772e-01f, 1.29290432e-01f, 9.99159634e-01f, 4.09885161e-02f, 9.99915957e-01f, 1.29649751e-02f,
  -3.99985313e-01f, -9.16521549e-01f, 7.54965365e-01f, 6.55764699e-01f, -4.90260571e-01f, -8.71575892e-01f, 2.40265876e-01f, 9.70707119e-01f,
  9.13088918e-01f, 4.07760441e-01f, 9.91192937e-01f, 1.32425532e-01f, 9.99118149e-01f, 4.19876575e-02f, 9.99911785e-01f, 1.32811759e-02f,
  5.55113316e-01f, -8.31774771e-01f, 5.13598442e-01f, 8.58030677e-01f, -4.00799006e-01f, -9.16166008e-01f, 2.09454417e-01f, 9.77818429e-01f,
  9.08965766e-01f, 4.16870773e-01f, 9.90769207e-01f, 1.35559291e-01f, 9.99075651e-01f, 4.29867506e-02f, 9.99907553e-01f, 1.35973748e-02f,
  9.99843299e-01f, 1.77019257e-02f, 2.21298173e-01f, 9.75206196e-01f, -3.07332784e-01f, -9.51602101e-01f, 1.78433523e-01f, 9.83951986e-01f,
  9.04751658e-01f, 4.25939471e-01f, 9.90335584e-01f, 1.38691694e-01f, 9.99032140e-01f, 4.39858064e-02f, 9.99903202e-01f, 1.39135728e-02f,
  5.25321960e-01f, 8.50903511e-01f, -9.29481089e-02f, 9.95670974e-01f, -2.10795805e-01f, -9.77530122e-01f, 1.47234216e-01f, 9.89101648e-01f,
  9.00447130e-01f, 4.34965521e-01f, 9.89892066e-01f, 1.41822711e-01f, 9.98987675e-01f, 4.49848175e-02f, 9.99898732e-01f, 1.42297689e-02f,
  -4.32177931e-01f, 9.01788354e-01f, -3.97976756e-01f, 9.17395473e-01f, -1.12152621e-01f, -9.93690968e-01f, 1.15887694e-01f, 9.93262351e-01f,
  8.96052480e-01f, 4.43948090e-01f, 9.89438653e-01f, 1.44952312e-01f, 9.98942196e-01f, 4.59837839e-02f, 9.99894202e-01f, 1.45459641e-02f,
  -9.92335498e-01f, 1.23573124e-01f, -6.63538277e-01f, 7.48142362e-01f, -1.23883775e-02f, -9.99923289e-01f, 8.44252855e-02f, 9.96429801e-01f,
  8.91568303e-01f, 4.52886283e-01f, 9.88975346e-01f, 1.48080453e-01f, 9.98895705e-01f, 4.69827019e-02f, 9.99889553e-01f, 1.48621574e-02f,
  -6.40144348e-01f, -7.68254638e-01f, -8.63296509e-01f, 5.04697084e-01f, 8.74991715e-02f, -9.96164620e-01f, 5.28784581e-02f, 9.98600960e-01f,
  8.86994898e-01f, 4.61779177e-01f, 9.88502085e-01f, 1.51207119e-01f, 9.98848200e-01f, 4.79815714e-02f, 9.99884784e-01f, 1.51783489e-02f,
  3.00592542e-01f, -9.53752637e-01f, -9.77442741e-01f, 2.11200655e-01f, 1.86512470e-01f, -9.82452571e-01f, 2.12787576e-02f, 9.99773562e-01f,
  8.82332861e-01f, 4.70625877e-01f, 9.88018990e-01f, 1.54332280e-01f, 9.98799741e-01f, 4.89803962e-02f, 9.99879956e-01f, 1.54945394e-02f,
  9.64965999e-01f, -2.62374848e-01f, -9.94656444e-01f, -1.03240460e-01f, 2.83662200e-01f, -9.58924294e-01f, -1.03422189e-02f, 9.99946535e-01f,
  8.77582550e-01f, 4.79425550e-01f, 9.87526000e-01f, 1.57455891e-01f, 9.98750269e-01f, 4.99791689e-02f, 9.99875009e-01f, 1.58107281e-02f,
  7.42154181e-01f, 6.70229197e-01f, -9.13230121e-01f, -4.07444149e-01f, 3.77977669e-01f, -9.25814748e-01f, -4.19528559e-02f, 9.99119580e-01f,
  8.72744501e-01f, 4.88177240e-01f, 9.87023175e-01f, 1.60577938e-01f, 9.98699784e-01f, 5.09778969e-02f, 9.99869943e-01f, 1.61269177e-02f,
  -1.62990779e-01f, 9.86627579e-01f, -7.41239965e-01f, -6.71240151e-01f, 4.68516916e-01f, -8.83454502e-01f, -7.35215396e-02f, 9.97293651e-01f,
  8.67819190e-01f, 4.96880114e-01f, 9.86510456e-01f, 1.63698375e-01f, 9.98648286e-01f, 5.19765690e-02f, 9.99864817e-01f, 1.64431017e-02f,
  -9.18282807e-01f, 3.95925164e-01f, -4.95741814e-01f, -8.68469954e-01f, 5.54374516e-01f, -8.32267344e-01f, -1.05016708e-01f, 9.94470477e-01f,
  8.62807095e-01f, 5.05533338e-01f, 9.85987842e-01f, 1.66817173e-01f, 9.98595834e-01f, 5.29751927e-02f, 9.99859571e-01f, 1.67592876e-02f,
  -8.29309821e-01f, -5.58789074e-01f, -2.01079622e-01f, -9.79574919e-01f, 6.34692967e-01f, -7.72764444e-01f, -1.36406869e-01f, 9.90652919e-01f,
  8.57708693e-01f, 5.14135957e-01f, 9.85455394e-01f, 1.69934288e-01f, 9.98542368e-01f, 5.39737605e-02f, 9.99854207e-01f, 1.70754679e-02f,
  2.21267566e-02f, -9.99755144e-01f, 1.13521777e-01f, -9.93535519e-01f, 7.08669782e-01f, -7.05540299e-01f, -1.67660639e-01f, 9.85844791e-01f,
  8.52524519e-01f, 5.22687256e-01f, 9.84913111e-01f, 1.73049718e-01f, 9.98487890e-01f, 5.49722798e-02f, 9.99848783e-01f, 1.73916500e-02f,
  8.53220105e-01f, -5.21551013e-01f, 4.16867077e-01f, -9.08967435e-01f, 7.75565803e-01f, -6.31266713e-01f, -1.98746875e-01f, 9.80050862e-01f,
  8.47255111e-01f, 5.31186223e-01f, 9.84360933e-01f, 1.76163420e-01f, 9.98432398e-01f, 5.59707358e-02f, 9.99843180e-01f, 1.77078284e-02f,
  8.99866819e-01f, 4.36164767e-01f, 6.78870201e-01f, -7.34258294e-01f, 8.34712923e-01f, -5.50685287e-01f, -2.29634270e-01f, 9.73276973e-01f,
  8.41901004e-01f, 5.39632022e-01f, 9.83798921e-01f, 1.79275364e-01f, 9.98375952e-01f, 5.69691435e-02f, 9.99837577e-01f, 1.80240069e-02f,
  1.19180135e-01f, 9.92872655e-01f, 8.73550534e-01f, -4.86733496e-01f, 8.85519624e-01f, -4.64602023e-01f, -2.60292053e-01f, 9.65529919e-01f,
  8.36462677e-01f, 5.48023939e-01f, 9.83227074e-01f, 1.82385504e-01f, 9.98318493e-01f, 5.79674877e-02f, 9.99831796e-01f, 1.83401816e-02f,
  -7.71080196e-01f, 6.36738002e-01f, 9.81602073e-01f, -1.90938011e-01f, 9.27478492e-01f, -3.73876572e-01f, -2.90689558e-01f, 9.56817448e-01f,
  8.30940723e-01f, 5.56361020e-01f, 9.82645452e-01f, 1.85493827e-01f, 9.98260021e-01f, 5.89657798e-02f, 9.99825954e-01f, 1.86563563e-02f,
  -9.52412963e-01f, -3.04810613e-01f, 9.92308319e-01f, 1.23790950e-01f, 9.60170269e-01f, -2.79415488e-01f, -3.20796400e-01f, 9.47148204e-01f,
  8.25335622e-01f, 5.64642429e-01f, 9.82053936e-01f, 1.88600287e-01f, 9.98200536e-01f, 5.99640086e-02f, 9.99819994e-01f, 1.89725272e-02f,
  -2.58101642e-01f, -9.66117799e-01f, 9.04607594e-01f, 4.26245421e-01f, 9.83268440e-01f, -1.82162598e-01f, -3.50582451e-01f, 9.36531842e-01f,
  8.19648027e-01f, 5.72867453e-01f, 9.81452644e-01f, 1.91704854e-01f, 9.98140097e-01f, 6.09621815e-02f, 9.99813974e-01f, 1.92886982e-02f,
  6.73507154e-01f, -7.39180684e-01f, 7.27198064e-01f, 6.86427653e-01f, 9.96542096e-01f, -8.30891207e-02f, -3.80017966e-01f, 9.24979091e-01f,
  8.13878477e-01f, 5.81035137e-01f, 9.80841517e-01f, 1.94807529e-01f, 9.98078644e-01f, 6.19602874e-02f, 9.99807835e-01f, 1.96048655e-02f,
  9.85896587e-01f, 1.67355701e-01f, 4.77671444e-01f, 8.78538549e-01f, 9.99858618e-01f, 1.68140903e-02f, -4.09073502e-01f, 9.12501454e-01f,
  8.08027506e-01f, 5.89144766e-01f, 9.80220556e-01f, 1.97908238e-01f, 9.98016179e-01f, 6.29583374e-02f, 9.99801576e-01f, 1.99210308e-02f,
};
__device__ const float TAB_S[2048] = {
  1.00000000e+00f, 0.00000000e+00f, 1.00000000e+00f, 0.00000000e+00f, 1.00000000e+00f, 0.00000000e+00f, 1.00000000e+00f, 0.00000000e+00f,
  1.00000000e+00f, 0.00000000e+00f, 1.00000000e+00f, 0.00000000e+00f, 1.00000000e+00f, 0.00000000e+00f, 1.00000000e+00f, 0.00000000e+00f,
  1.00000000e+00f, 0.00000000e+00f, 1.00000000e+00f, 0.00000000e+00f, 1.00000000e+00f, 0.00000000e+00f, 1.00000000e+00f, 0.00000000e+00f,
  1.00000000e+00f, 0.00000000e+00f, 1.00000000e+00f, 0.00000000e+00f, 1.00000000e+00f, 0.00000000e+00f, 1.00000000e+00f, 0.00000000e+00f,
  5.40302277e-01f, 8.41470957e-01f, 8.46009135e-01f, 5.33168435e-01f, 9.50415254e-01f, 3.10983598e-01f, 9.84230220e-01f, 1.76892191e-01f,
  9.95004177e-01f, 9.98334214e-02f, 9.98419285e-01f, 5.62044978e-02f, 9.99500036e-01f, 3.16175036e-02f, 9.99841869e-01f, 1.77818574e-02f,
  9.99949992e-01f, 9.99983307e-03f, 9.99984205e-01f, 5.62338345e-03f, 9.99994993e-01f, 3.16227227e-03f, 9.99998391e-01f, 1.77827850e-03f,
  9.99999523e-01f, 9.99999931e-04f, 9.99999821e-01f, 5.62341243e-04f, 9.99999940e-01f, 3.16227757e-04f, 1.00000000e+00f, 1.77827940e-04f,
  -4.16146845e-01f, 9.09297407e-01f, 4.31462824e-01f, 9.02130723e-01f, 8.06578398e-01f, 5.91127098e-01f, 9.37418282e-01f, 3.48205268e-01f,
  9.80066597e-01f, 1.98669329e-01f, 9.93682086e-01f, 1.12231314e-01f, 9.98000681e-01f, 6.32033944e-02f, 9.99367595e-01f, 3.55580896e-02f,
  9.99800026e-01f, 1.99986659e-02f, 9.99936759e-01f, 1.12465890e-02f, 9.99979973e-01f, 6.32451288e-03f, 9.99993682e-01f, 3.55655141e-03f,
  9.99997973e-01f, 1.99999870e-03f, 9.99999344e-01f, 1.12468237e-03f, 9.99999821e-01f, 6.32455456e-04f, 9.99999940e-01f, 3.55655880e-04f,
  -9.89992499e-01f, 1.41120002e-01f, -1.15966164e-01f, 9.93253171e-01f, 5.82753658e-01f, 8.12648892e-01f, 8.61040652e-01f, 5.08536100e-01f,
  9.55336511e-01f, 2.95520216e-01f, 9.85803485e-01f, 1.67903304e-01f, 9.95503366e-01f, 9.47260857e-02f, 9.98577297e-01f, 5.33230826e-02f,
  9.99550045e-01f, 2.99954992e-02f, 9.99857724e-01f, 1.68694388e-02f, 9.99954998e-01f, 9.48669016e-03f, 9.99985754e-01f, 5.33481315e-03f,
  9.99995530e-01f, 2.99999560e-03f, 9.99998569e-01f, 1.68702309e-03f, 9.99999523e-01f, 9.48683126e-04f, 9.99999881e-01f, 5.33483806e-04f,
  -6.53643608e-01f, -7.56802499e-01f, -6.27679706e-01f, 7.78471708e-01f, 3.01137477e-01f, 9.53580737e-01f, 7.57506192e-01f, 6.52827978e-01f,
  9.21060979e-01f, 3.89418334e-01f, 9.74808276e-01f, 2.23044485e-01f, 9.92010653e-01f, 1.26154065e-01f, 9.97471273e-01f, 7.10712075e-02f,
  9.99200106e-01f, 3.99893336e-02f, 9.99747038e-01f, 2.24917568e-02f, 9.99920011e-01f, 1.26487734e-02f, 9.99974728e-01f, 7.11305765e-03f,
  9.99992013e-01f, 3.99998948e-03f, 9.99997497e-01f, 2.24936334e-03f, 9.99999225e-01f, 1.26491068e-03f, 9.99999762e-01f, 7.11311703e-04f,
  2.83662200e-01f, -9.58924294e-01f, -9.46079254e-01f, 3.23935270e-01f, -1.03423381e-02f, 9.99946535e-01f, 6.30080283e-01f, 7.76529968e-01f,
  8.77582550e-01f, 4.79425550e-01f, 9.60731268e-01f, 2.77480543e-01f, 9.87526000e-01f, 1.57455876e-01f, 9.96049762e-01f, 8.87968615e-02f,
  9.98750269e-01f, 4.99791652e-02f, 9.99604762e-01f, 2.81133614e-02f, 9.99875009e-01f, 1.58107281e-02f, 9.99960482e-01f, 8.89127981e-03f,
  9.99987483e-01f, 4.99997940e-03f, 9.99996066e-01f, 2.81170290e-03f, 9.99998748e-01f, 1.58113812e-03f, 9.99999583e-01f, 8.89139599e-04f,
  9.60170269e-01f, -2.79415488e-01f, -9.73103702e-01f, -2.30367512e-01f, -3.20796400e-01f, 9.47148204e-01f, 4.82782036e-01f, 8.75740528e-01f,
  8.25335622e-01f, 5.64642489e-01f, 9.43616986e-01f, 3.31039310e-01f, 9.82053936e-01f, 1.88600272e-01f, 9.94313300e-01f, 1.06494442e-01f,
  9.98200536e-01f, 5.99640049e-02f, 9.99430835e-01f, 3.37340795e-02f, 9.99819994e-01f, 1.89725272e-02f, 9.99943078e-01f, 1.06694745e-02f,
  9.99981999e-01f, 5.99996420e-03f, 9.99994338e-01f, 3.37404152e-03f, 9.99998212e-01f, 1.89736532e-03f, 9.99999404e-01f, 1.06696738e-03f,
  7.53902256e-01f, 6.56986594e-01f, -7.00429797e-01f, -7.13721275e-01f, -5.99437475e-01f, 8.00421596e-01f, 3.20257008e-01f, 9.47330713e-01f,
  7.64842212e-01f, 6.44217670e-01f, 9.23519433e-01f, 3.83551568e-01f, 9.75599885e-01f, 2.19556093e-01f, 9.92262423e-01f, 1.24158338e-01f,
  9.97551024e-01f, 6.99428469e-02f, 9.99225318e-01f, 3.93537246e-02f, 9.99755025e-01f, 2.21341345e-02f, 9.99922514e-01f, 1.24476347e-02f,
  9.99975502e-01f, 6.99994294e-03f, 9.99992251e-01f, 3.93637875e-03f, 9.99997556e-01f, 2.21359241e-03f, 9.99999225e-01f, 1.24479528e-03f,
  -1.45500034e-01f, 9.89358246e-01f, -2.12036446e-01f, -9.77261782e-01f, -8.18632424e-01f, 5.74317753e-01f, 1.47631213e-01f, 9.89042461e-01f,
  6.96706712e-01f, 7.17356086e-01f, 9.00502324e-01f, 4.34851229e-01f, 9.68170285e-01f, 2.50292331e-01f, 9.89897788e-01f, 1.41782969e-01f,
  9.96801734e-01f, 7.99146891e-02f, 9.98988271e-01f, 4.49721329e-02f, 9.99680042e-01f, 2.52955221e-02f, 9.99898791e-01f, 1.42257558e-02f,
  9.99967992e-01f, 7.99991470e-03f, 9.99989867e-01f, 4.49871505e-03f, 9.99996781e-01f, 2.52981926e-03f, 9.99998987e-01f, 1.42262306e-03f,
  -9.11130250e-01f, 4.12118495e-01f, 3.41660261e-01f, -9.39823508e-01f, -9.56644177e-01f, 2.91259229e-01f, -2.96507962e-02f, 9.99560297e-01f,
  6.21609926e-01f, 7.83326924e-01f, 8.74638259e-01f, 4.84776139e-01f, 9.59772646e-01f, 2.80778319e-01f, 9.87220109e-01f, 1.59362778e-01f,
  9.95952725e-01f, 8.98785442e-02f, 9.98719573e-01f, 5.05891182e-02f, 9.99595046e-01f, 2.84566563e-02f, 9.99871910e-01f, 1.60038304e-02f,
  9.99959528e-01f, 8.99987947e-03f, 9.99987185e-01f, 5.06105041e-03f, 9.99995947e-01f, 2.84604589e-03f, 9.99998748e-01f, 1.60045072e-03f,
  -8.39071512e-01f, -5.44021130e-01f, 7.90131867e-01f, -6.12936914e-01f, -9.99786079e-01f, -2.06835698e-02f, -2.05997631e-01f, 9.78552461e-01f,
  5.40302277e-01f, 8.41470957e-01f, 8.46009135e-01f, 5.33168435e-01f, 9.50415313e-01f, 3.10983568e-01f, 9.84230220e-01f, 1.76892191e-01f,
  9.95004177e-01f, 9.98334140e-02f, 9.98419285e-01f, 5.62044978e-02f, 9.99500036e-01f, 3.16175036e-02f, 9.99841869e-01f, 1.77818574e-02f,
  9.99949992e-01f, 9.99983400e-03f, 9.99984205e-01f, 5.62338345e-03f, 9.99994993e-01f, 3.16227227e-03f, 9.99998391e-01f, 1.77827850e-03f,
  4.42569796e-03f, -9.99990225e-01f, 9.95257378e-01f, -9.72764567e-02f, -9.43779767e-01f, -3.30574960e-01f, -3.75847399e-01f, 9.26681578e-01f,
  4.53596085e-01f, 8.91207397e-01f, 8.14705312e-01f, 5.79875171e-01f, 9.40107584e-01f, 3.40877861e-01f, 9.80929136e-01f, 1.94365650e-01f,
  9.93956089e-01f, 1.09778300e-01f, 9.98087406e-01f, 6.18181042e-02f, 9.99395072e-01f, 3.47780399e-02f, 9.99808669e-01f, 1.95598267e-02f,
  9.99939501e-01f, 1.09997792e-02f, 9.99980867e-01f, 6.18571462e-03f, 9.99993920e-01f, 3.47849843e-03f, 9.99998093e-01f, 1.95610616e-03f,
  8.43853951e-01f, -5.36572933e-01f, 8.93861592e-01f, 4.48342979e-01f, -7.94179380e-01f, -6.07683420e-01f, -5.33843040e-01f, 8.45583618e-01f,
  3.62357706e-01f, 9.32039082e-01f, 7.80825913e-01f, 6.24748647e-01f, 9.28859890e-01f, 3.70431304e-01f, 9.77317870e-01f, 2.11777672e-01f,
  9.92808640e-01f, 1.19712204e-01f, 9.97723997e-01f, 6.74297586e-02f, 9.99280095e-01f, 3.79382223e-02f, 9.99772310e-01f, 2.13377345e-02f,
  9.99927998e-01f, 1.19997123e-02f, 9.99977231e-01f, 6.74804440e-03f, 9.99992788e-01f, 3.79472389e-03f, 9.99997735e-01f, 2.13393359e-03f,
  9.07446802e-01f, 4.20167029e-01f, 5.17172873e-01f, 8.55880976e-01f, -5.65820515e-01f, -8.24528456e-01f, -6.75001681e-01f, 7.37816215e-01f,
  2.67498761e-01f, 9.63558197e-01f, 7.44477987e-01f, 6.67647004e-01f, 9.16683376e-01f, 3.99614304e-01f, 9.73397553e-01f, 2.29122713e-01f,
  9.91561890e-01f, 1.29634142e-01f, 9.97329056e-01f, 7.30392784e-02f, 9.99155104e-01f, 4.10980321e-02f, 9.99732792e-01f, 2.31155735e-02f,
  9.99915481e-01f, 1.29996343e-02f, 9.99973297e-01f, 7.31037185e-03f, 9.99991536e-01f, 4.11094911e-03f, 9.99997318e-01f, 2.31176103e-03f,
  1.36737213e-01f, 9.90607381e-01f, -1.87961515e-02f, 9.99823332e-01f, -2.81349480e-01f, -9.59605396e-01f, -7.94870913e-01f, 6.06778562e-01f,
  1.69967160e-01f, 9.85449731e-01f, 7.05776393e-01f, 7.08434701e-01f, 9.03590262e-01f, 4.28397775e-01f, 9.69169438e-01f, 2.46395305e-01f,
  9.90216017e-01f, 1.39543116e-01f, 9.96902585e-01f, 7.86464810e-02f, 9.99020159e-01f, 4.42574248e-02f, 9.99690115e-01f, 2.48933397e-02f,
  9.99902010e-01f, 1.39995432e-02f, 9.99969006e-01f, 7.87269697e-03f, 9.99990225e-01f, 4.42717411e-03f, 9.99996901e-01f, 2.48958869e-03f,
  -7.59687901e-01f, 6.50287867e-01f, -5.48975468e-01f, 8.35838437e-01f, 3.10223512e-02f, -9.99518692e-01f, -8.89670432e-01f, 4.56603259e-01f,
  7.07371980e-02f, 9.97494996e-01f, 6.64843500e-01f, 7.46982634e-01f, 8.89593601e-01f, 4.56752867e-01f, 9.64634836e-01f, 2.63589978e-01f,
  9.88771081e-01f, 1.49438128e-01f, 9.96444523e-01f, 8.42512026e-02f, 9.98875201e-01f, 4.74163815e-02f, 9.99644279e-01f, 2.66710296e-02f,
  9.99887526e-01f, 1.49994381e-02f, 9.99964416e-01f, 8.43502022e-03f, 9.99988735e-01f, 4.74339863e-03f, 9.99996424e-01f, 2.66741589e-03f,
  -9.57659483e-01f, -2.87903309e-01f, -9.10081089e-01f, 4.14430231e-01f, 3.40318173e-01f, -9.40310359e-01f, -9.56410050e-01f, 2.92027086e-01f,
  -2.91995462e-02f, 9.99573588e-01f, 6.21808827e-01f, 7.83169091e-01f, 8.74707460e-01f, 4.84651238e-01f, 9.59795177e-01f, 2.80701309e-01f,
  9.87227261e-01f, 1.59318209e-01f, 9.95954990e-01f, 8.98532644e-02f, 9.98720288e-01f, 5.05748577e-02f, 9.99595284e-01f, 2.84486320e-02f,
  9.99872029e-01f, 1.59993190e-02f, 9.99959528e-01f, 8.99733976e-03f, 9.99987185e-01f, 5.05962269e-03f, 9.99995947e-01f, 2.84524332e-03f,
  -2.75163352e-01f, -9.61397469e-01f, -9.90897954e-01f, -1.34615138e-01f, 6.15864813e-01f, -7.87851870e-01f, -9.92985010e-01f, 1.18240520e-01f,
  -1.28844544e-01f, 9.91664827e-01f, 5.76808274e-01f, 8.16879570e-01f, 8.58946681e-01f, 5.12064993e-01f, 9.54652011e-01f, 2.97723860e-01f,
  9.85584795e-01f, 1.69182345e-01f, 9.95433986e-01f, 9.54524800e-02f, 9.98555362e-01f, 5.37328273e-02f, 9.99543071e-01f, 3.02261449e-02f,
  9.99855518e-01f, 1.69991814e-02f, 9.99954283e-01f, 9.55965649e-03f, 9.99985576e-01f, 5.37584582e-03f, 9.99995410e-01f, 3.02307028e-03f,
  6.60316706e-01f, -7.50987232e-01f, -7.66536534e-01f, -6.42200708e-01f, 8.30336154e-01f, -5.57262897e-01f, -9.98241663e-01f, -5.92755191e-02f,
  -2.27202162e-01f, 9.73847628e-01f, 5.29984176e-01f, 8.48007560e-01f, 8.42327058e-01f, 5.38966715e-01f, 9.49207008e-01f, 3.14652264e-01f,
  9.83843684e-01f, 1.79029569e-01f, 9.94881511e-01f, 1.01048686e-01f, 9.98380423e-01f, 5.68902642e-02f, 9.99487758e-01f, 3.20035629e-02f,
  9.99837995e-01f, 1.79990288e-02f, 9.99948800e-01f, 1.01219704e-02f, 9.99983788e-01f, 5.69206895e-03f, 9.99994874e-01f, 3.20089748e-03f,
  9.88704622e-01f, 1.49877205e-01f, -3.06095392e-01f, -9.52000856e-01f, 9.62463796e-01f, -2.71410108e-01f, -9.72014248e-01f, -2.34921798e-01f,
  -3.23289543e-01f, 9.46300089e-01f, 4.81484592e-01f, 8.76454532e-01f, 8.24865162e-01f, 5.65329552e-01f, 9.43461835e-01f, 3.31481189e-01f,
  9.82004225e-01f, 1.88858896e-01f, 9.94297504e-01f, 1.06641680e-01f, 9.98195529e-01f, 6.00471310e-02f, 9.99429286e-01f, 3.37808803e-02f,
  9.99819517e-01f, 1.89988576e-02f, 9.99942899e-01f, 1.06842816e-02f, 9.99981940e-01f, 6.00829115e-03f, 9.99994278e-01f, 3.37872445e-03f,
  4.08082068e-01f, 9.12945271e-01f, 2.48616725e-01f, -9.68601942e-01f, 9.99144375e-01f, 4.13582884e-02f, -9.15129960e-01f, -4.03158993e-01f,
  -4.16146845e-01f, 9.09297407e-01f, 4.31462824e-01f, 9.02130723e-01f, 8.06578457e-01f, 5.91127038e-01f, 9.37418282e-01f, 3.48205268e-01f,
  9.80066597e-01f, 1.98669314e-01f, 9.93682086e-01f, 1.12231314e-01f, 9.98000681e-01f, 6.32033944e-02f, 9.99367595e-01f, 3.55580896e-02f,
  9.99800026e-01f, 1.99986678e-02f, 9.99936759e-01f, 1.12465890e-02f, 9.99979973e-01f, 6.32451288e-03f, 9.99993682e-01f, 3.55655141e-03f,
  -5.47729254e-01f, 8.36655617e-01f, 7.26760268e-01f, -6.86891198e-01f, 9.36740458e-01f, 3.50024760e-01f, -8.29382956e-01f, -5.58680534e-01f,
  -5.04846215e-01f, 8.63209307e-01f, 3.80077004e-01f, 9.24954832e-01f, 7.87485182e-01f, 6.16333544e-01f, 9.31078374e-01f, 3.64819258e-01f,
  9.78030920e-01f, 2.08459899e-01f, 9.93035257e-01f, 1.17817394e-01f, 9.97795820e-01f, 6.63590282e-02f, 9.99302804e-01f, 3.73351872e-02f,
  9.99779522e-01f, 2.09984574e-02f, 9.99930263e-01f, 1.18088927e-02f, 9.99977946e-01f, 6.64073415e-03f, 9.99993026e-01f, 3.73437814e-03f,
  -9.99960840e-01f, -8.85130931e-03f, 9.81074572e-01f, -1.93630233e-01f, 7.81440377e-01f, 6.23979926e-01f, -7.17477441e-01f, -6.96581721e-01f,
  -5.88501155e-01f, 8.08496356e-01f, 3.27489585e-01f, 9.44854796e-01f, 7.67604589e-01f, 6.40923738e-01f, 9.24443960e-01f, 3.81317884e-01f,
  9.75897431e-01f, 2.18229622e-01f, 9.92357016e-01f, 1.23399742e-01f, 9.97581005e-01f, 6.95140064e-02f, 9.99234855e-01f, 3.91121693e-02f,
  9.99758005e-01f, 2.19982266e-02f, 9.99923468e-01f, 1.23711927e-02f, 9.99975801e-01f, 6.95695449e-03f, 9.99992371e-01f, 3.91220488e-03f,
  -5.32833040e-01f, -8.46220434e-01f, 9.33235765e-01f, 3.59264523e-01f, 5.48645258e-01f, 8.36055279e-01f, -5.82943261e-01f, -8.12512875e-01f,
  -6.66275978e-01f, 7.45705247e-01f, 2.73866832e-01f, 9.61767614e-01f, 7.46956408e-01f, 6.64873064e-01f, 9.17517304e-01f, 3.97695929e-01f,
  9.73666370e-01f, 2.27977514e-01f, 9.91647422e-01f, 1.28978193e-01f, 9.97356176e-01f, 7.26682767e-02f, 9.99163687e-01f, 4.08890247e-02f,
  9.99735534e-01f, 2.29979735e-02f, 9.99916375e-01f, 1.29334899e-02f, 9.99973536e-01f, 7.27317436e-03f, 9.99991655e-01f, 4.09003161e-03f,
  4.24179018e-01f, -9.05578375e-01f, 5.97977161e-01f, 8.01513135e-01f, 2.61441678e-01f, 9.65219259e-01f, -4.30023283e-01f, -9.02817786e-01f,
  -7.37393796e-01f, 6.75463140e-01f, 2.19378278e-01f, 9.75639880e-01f, 7.25561321e-01f, 6.88157499e-01f, 9.10300434e-01f, 4.13948208e-01f,
  9.71337974e-01f, 2.37702623e-01f, 9.90906477e-01f, 1.34552568e-01f, 9.97121394e-01f, 7.58218244e-02f, 9.99089420e-01f, 4.26657498e-02f,
  9.99711990e-01f, 2.39976961e-02f, 9.99908924e-01f, 1.34957815e-02f, 9.99971211e-01f, 7.58939330e-03f, 9.99990880e-01f, 4.26785741e-03f,
  9.91202831e-01f, -1.32351756e-01f, 7.85522610e-02f, 9.96909976e-01f, -5.16893305e-02f, 9.98663187e-01f, -2.63540596e-01f, -9.64648306e-01f,
  -8.01143587e-01f, 5.98472118e-01f, 1.64196163e-01f, 9.86427724e-01f, 7.03440726e-01f, 7.10753918e-01f, 9.02795732e-01f, 4.30069596e-01f,
  9.68912423e-01f, 2.47403964e-01f, 9.90134120e-01f, 1.40122697e-01f, 9.96876657e-01f, 7.89746121e-02f, 9.99011934e-01f, 4.44423407e-02f,
  9.99687493e-01f, 2.49973964e-02f, 9.99901175e-01f, 1.40580693e-02f, 9.99968767e-01f, 7.90561177e-03f, 9.99990106e-01f, 4.44568414e-03f,
  6.46919310e-01f, 7.62558460e-01f, -4.65064496e-01f, 8.85276794e-01f, -3.59694332e-01f, 9.33070183e-01f, -8.87455046e-02f, -9.96054351e-01f,
  -8.56888831e-01f, 5.15501261e-01f, 1.08494945e-01f, 9.94096994e-01f, 6.80616796e-01f, 7.32639611e-01f, 8.95005584e-01f, 4.46054995e-01f,
  9.66389954e-01f, 2.57080555e-01f, 9.89330530e-01f, 1.45688385e-01f, 9.96621907e-01f, 8.21266174e-02f, 9.98931348e-01f, 4.62187938e-02f,
  9.99662042e-01f, 2.59970706e-02f, 9.99893129e-01f, 1.46203535e-02f, 9.99966204e-01f, 8.22182931e-03f, 9.99989331e-01f, 4.62350994e-03f,
  -2.92138815e-01f, 9.56375957e-01f, -8.65450621e-01f, 5.00994205e-01f, -6.32028639e-01f, 7.74945021e-01f, 8.88481140e-02f, -9.96045172e-01f,
  -9.04072165e-01f, 4.27379847e-01f, 5.24506159e-02f, 9.98623490e-01f, 6.57112300e-01f, 7.53792703e-01f, 8.86932373e-01f, 4.61899310e-01f,
  9.63770926e-01f, 2.66731411e-01f, 9.88495648e-01f, 1.51249468e-01f, 9.96357203e-01f, 8.52777958e-02f, 9.98847544e-01f, 4.79951017e-02f,
  9.99635518e-01f, 2.69967206e-02f, 9.99884725e-01f, 1.51826320e-02f, 9.99963522e-01f, 8.53804592e-03f, 9.99988496e-01f, 4.80133574e-03f,
  -9.62605894e-01f, 2.70905793e-01f, -9.99293387e-01f, -3.75856608e-02f, -8.41684937e-01f, 5.39968967e-01f, 2.63639510e-01f, -9.64621305e-01f,
  -9.42222297e-01f, 3.34988207e-01f, -3.75941908e-03f, 9.99992907e-01f, 6.32950664e-01f, 7.74192095e-01f, 8.78578722e-01f, 4.77597594e-01f,
  9.61055458e-01f, 2.76355654e-01f, 9.87629473e-01f, 1.56805754e-01f, 9.96082544e-01f, 8.84281173e-02f, 9.98760641e-01f, 4.97712530e-02f,
  9.99608040e-01f, 2.79963426e-02f, 9.99876022e-01f, 1.57449059e-02f, 9.99960780e-01f, 8.85426160e-03f, 9.99987602e-01f, 4.97916201e-03f,
  -7.48057544e-01f, -6.63633883e-01f, -8.25371623e-01f, -5.64589798e-01f, -9.67871487e-01f, 2.51445323e-01f, 4.30115849e-01f, -9.02773678e-01f,
  -9.70958173e-01f, 2.39249229e-01f, -5.99575676e-02f, 9.98200953e-01f, 6.08156204e-01f, 7.93817401e-01f, 8.69947195e-01f, 4.93144840e-01f,
  9.58243906e-01f, 2.85952210e-01f, 9.86732066e-01f, 1.62357092e-01f, 9.95797932e-01f, 9.15775672e-02f, 9.98670578e-01f, 5.15472479e-02f,
  9.99579549e-01f, 2.89959367e-02f, 9.99867022e-01f, 1.63071752e-02f, 9.99957979e-01f, 9.17047635e-03f, 9.99986708e-01f, 5.15698735e-03f,
  1.54251456e-01f, -9.88031626e-01f, -3.97251874e-01f, -9.17709649e-01f, -9.98075247e-01f, -6.20148405e-02f, 5.83026946e-01f, -8.12452853e-01f,
  -9.89992499e-01f, 1.41120002e-01f, -1.15966164e-01f, 9.93253171e-01f, 5.82753658e-01f, 8.12648892e-01f, 8.61040652e-01f, 5.08536100e-01f,
  9.55336511e-01f, 2.95520186e-01f, 9.85803485e-01f, 1.67903304e-01f, 9.95503366e-01f, 9.47260931e-02f, 9.98577297e-01f, 5.33230826e-02f,
  9.99550045e-01f, 2.99955010e-02f, 9.99857724e-01f, 1.68694388e-02f, 9.99954998e-01f, 9.48669016e-03f, 9.99985754e-01f, 5.33481315e-03f,
  9.14742351e-01f, -4.04037654e-01f, 1.53215483e-01f, -9.88192797e-01f, -9.29300308e-01f, -3.69325012e-01f, 7.17549205e-01f, -6.96507812e-01f,
  -9.99135137e-01f, 4.15805206e-02f, -1.71608135e-01f, 9.85165298e-01f, 5.56768358e-01f, 8.30667794e-01f, 8.51861775e-01f, 5.23766637e-01f,
  9.52333570e-01f, 3.05058628e-01f, 9.84843671e-01f, 1.73444211e-01f, 9.95198846e-01f, 9.78736654e-02f, 9.98480916e-01f, 5.50987460e-02f,
  9.99519527e-01f, 3.09950355e-02f, 9.99848068e-01f, 1.74316969e-02f, 9.99951959e-01f, 9.80290305e-03f, 9.99984801e-01f, 5.51263802e-03f,
  8.34223390e-01f, 5.51426709e-01f, 6.56495154e-01f, -7.54330218e-01f, -7.68367112e-01f, -6.40009403e-01f, 8.29440355e-01f, -5.58595300e-01f,
  -9.98294771e-01f, -5.83741926e-02f, -2.26707578e-01f, 9.73962843e-01f, 5.30226350e-01f, 8.47856104e-01f, 8.42413545e-01f, 5.38831532e-01f,
  9.49235439e-01f, 3.14566553e-01f, 9.83852804e-01f, 1.78979620e-01f, 9.94884372e-01f, 1.01020269e-01f, 9.98381376e-01f, 5.68742342e-02f,
  9.99488056e-01f, 3.19945402e-02f, 9.99838114e-01f, 1.79939512e-02f, 9.99948800e-01f, 1.01191159e-02f, 9.99983788e-01f, 5.69046335e-03f,
  -1.32767474e-02f, 9.99911845e-01f, 9.57586050e-01f, -2.88147390e-01f, -5.31235278e-01f, -8.47224355e-01f, 9.15171385e-01f, -4.03064936e-01f,
  -9.87479806e-01f, -1.57745644e-01f, -2.81090319e-01f, 9.59681332e-01f, 5.03154159e-01f, 8.64196658e-01f, 8.32698941e-01f, 5.53726017e-01f,
  9.46042359e-01f, 3.24043006e-01f, 9.82830763e-01f, 1.84509367e-01f, 9.94559944e-01f, 1.04165860e-01f, 9.98278618e-01f, 5.86495437e-02f,
  9.99455571e-01f, 3.29940096e-02f, 9.99827802e-01f, 1.85561981e-02f, 9.99945521e-01f, 1.04353270e-02f, 9.99982774e-01f, 5.86828869e-03f,
  -8.48570287e-01f, 5.29082716e-01f, 9.63757515e-01f, 2.66779721e-01f, -2.41421118e-01f, -9.70420420e-01f, 9.72038329e-01f, -2.34822124e-01f,
  -9.66798186e-01f, -2.55541205e-01f, -3.34584385e-01f, 9.42365825e-01f, 4.75578904e-01f, 8.79673064e-01f, 8.22721004e-01f, 5.68445385e-01f,
  9.42754686e-01f, 3.33487093e-01f, 9.81777668e-01f, 1.90033287e-01f, 9.94225562e-01f, 1.07310407e-01f, 9.98172760e-01f, 6.04246669e-02f,
  9.99422073e-01f, 3.39934528e-02f, 9.99817252e-01f, 1.91184394e-02f, 9.99942183e-01f, 1.07515370e-02f, 9.99981701e-01f, 6.04611309e-03f,
  -9.03692186e-01f, -4.28182662e-01f, 6.73110247e-01f, 7.39542127e-01f, 7.23346695e-02f, -9.97380435e-01f, 9.98247743e-01f, -5.91726787e-02f,
  -9.36456680e-01f, -3.50783229e-01f, -3.87020677e-01f, 9.22071040e-01f, 4.47528064e-01f, 8.94269884e-01f, 8.12482953e-01f, 5.82984984e-01f,
  9.39372718e-01f, 3.42897803e-01f, 9.80693519e-01f, 1.95551202e-01f, 9.93881226e-01f, 1.10453881e-01f, 9.98063743e-01f, 6.21996038e-02f,
  9.99387562e-01f, 3.49928550e-02f, 9.99806345e-01f, 1.96806751e-02f, 9.99938726e-01f, 1.10677453e-02f, 9.99980628e-01f, 6.22393796e-03f,
  -1.27963692e-01f, -9.91778851e-01f, 1.75156534e-01f, 9.84540582e-01f, 3.78916174e-01f, -9.25431013e-01f, 9.92972851e-01f, 1.18342586e-01f,
  -8.96758378e-01f, -4.42520559e-01f, -4.38233554e-01f, 8.98861170e-01f, 4.19029742e-01f, 9.07972515e-01f, 8.01987886e-01f, 5.97340286e-01f,
  9.35896814e-01f, 3.52274209e-01f, 9.79578316e-01f, 2.01062918e-01f, 9.93526995e-01f, 1.13596253e-01f, 9.97951567e-01f, 6.39743358e-02f,
  9.99352098e-01f, 3.59922275e-02f, 9.99795079e-01f, 2.02429052e-02f, 9.99935210e-01f, 1.13839535e-02f, 9.99979496e-01f, 6.40176190e-03f,
  7.65414059e-01f, -6.43538117e-01f, -3.76742303e-01f, 9.26318109e-01f, 6.47921681e-01f, -7.61706948e-01f, 9.56380010e-01f, 2.92125374e-01f,
  -8.48100007e-01f, -5.29836178e-01f, -4.88060862e-01f, 8.72809589e-01f, 3.90112430e-01f, 9.20767248e-01f, 7.91239262e-01f, 6.11506701e-01f,
  9.32327330e-01f, 3.61615449e-01f, 9.78432178e-01f, 2.06568271e-01f, 9.93162811e-01f, 1.16737492e-01f, 9.97836173e-01f, 6.57488778e-02f,
  9.99315560e-01f, 3.69915590e-02f, 9.99783576e-01f, 2.08051261e-02f, 9.99931574e-01f, 1.17001599e-02f, 9.99978364e-01f, 6.57958630e-03f,
  9.55073655e-01f, 2.96368569e-01f, -8.12611222e-01f, 5.82806170e-01f, 8.52673113e-01f, -5.22444785e-01f, 8.89623463e-01f, 4.56694692e-01f,
  -7.90967762e-01f, -6.11857831e-01f, -5.36345184e-01f, 8.43998730e-01f, 3.60805035e-01f, 9.32641268e-01f, 7.80240417e-01f, 6.25479698e-01f,
  9.28664625e-01f, 3.70920479e-01f, 9.77255106e-01f, 2.12067112e-01f, 9.92788672e-01f, 1.19877554e-01f, 9.97717679e-01f, 6.75232038e-02f,
  9.99278069e-01f, 3.79908569e-02f, 9.99771714e-01f, 2.13673431e-02f, 9.99927819e-01f, 1.20163653e-02f, 9.99977171e-01f, 6.75741071e-03f,
  2.66642928e-01f, 9.63795364e-01f, -9.98210371e-01f, 5.98003156e-02f, 9.72865343e-01f, -2.31372014e-01f, 7.94808388e-01f, 6.06860459e-01f,
  -7.25932240e-01f, -6.87766254e-01f, -5.82933903e-01f, 8.12519610e-01f, 3.31136853e-01f, 9.43582714e-01f, 7.68994927e-01f, 6.39254928e-01f,
  9.24909055e-01f, 3.80188406e-01f, 9.76047099e-01f, 2.17559248e-01f, 9.92404640e-01f, 1.23016424e-01f, 9.97596025e-01f, 6.92973137e-02f,
  9.99239624e-01f, 3.89901139e-02f, 9.99759495e-01f, 2.19295528e-02f, 9.99923944e-01f, 1.23325698e-02f, 9.99975979e-01f, 6.93523418e-03f,
  -6.66938066e-01f, 7.45113134e-01f, -8.76379430e-01f, -4.81621295e-01f, 9.96578991e-01f, 8.26458037e-02f, 6.74925625e-01f, 7.37885714e-01f,
  -6.53643608e-01f, -7.56802499e-01f, -6.27679706e-01f, 7.78471708e-01f, 3.01137596e-01f, 9.53580678e-01f, 7.57506192e-01f, 6.52827978e-01f,
  9.21060979e-01f, 3.89418334e-01f, 9.74808276e-01f, 2.23044485e-01f, 9.92010653e-01f, 1.26154065e-01f, 9.97471273e-01f, 7.10712075e-02f,
  9.99200106e-01f, 3.99893373e-02f, 9.99747038e-01f, 2.24917568e-02f, 9.99920011e-01f, 1.26487734e-02f, 9.99974728e-01f, 7.11305765e-03f,
  -9.87339258e-01f, -1.58622667e-01f, -4.84639406e-01f, -8.74714017e-01f, 9.21462357e-01f, 3.88467699e-01f, 5.33756077e-01f, 8.45638454e-01f,
  -5.74824035e-01f, -8.18277061e-01f, -6.70441091e-01f, 7.41962790e-01f, 2.70837069e-01f, 9.62625206e-01f, 7.45777905e-01f, 6.66194677e-01f,
  9.17120814e-01f, 3.98609310e-01f, 9.73538578e-01f, 2.28522688e-01f, 9.91606772e-01f, 1.29290432e-01f, 9.97343302e-01f, 7.28448778e-02f,
  9.99159634e-01f, 4.09885161e-02f, 9.99734223e-01f, 2.30539497e-02f, 9.99915957e-01f, 1.29649751e-02f, 9.99973416e-01f, 7.29088066e-03f,
  -3.99985313e-01f, -9.16521549e-01f, 5.63609414e-02f, -9.98410463e-01f, 7.54965365e-01f, 6.55764699e-01f, 3.75752151e-01f, 9.26720202e-01f,
  -4.90260571e-01f, -8.71575892e-01f, -7.11082935e-01f, 7.03108132e-01f, 2.40265876e-01f, 9.70707119e-01f, 7.33813822e-01f, 6.79350674e-01f,
  9.13088918e-01f, 4.07760441e-01f, 9.72238123e-01f, 2.33993664e-01f, 9.91192937e-01f, 1.32425532e-01f, 9.97212172e-01f, 7.46183172e-02f,
  9.99118149e-01f, 4.19876575e-02f, 9.99721110e-01f, 2.36161388e-02f, 9.99911785e-01f, 1.32811759e-02f, 9.99972105e-01f, 7.46870413e-03f,
  5.55113316e-01f, -8.31774771e-01f, 5.80003142e-01f, -8.14614236e-01f, 5.13598442e-01f, 8.58030677e-01f, 2.05897167e-01f, 9.78573620e-01f,
  -4.00799006e-01f, -9.16166008e-01f, -7.49476731e-01f, 6.62030637e-01f, 2.09454417e-01f, 9.77818429e-01f, 7.21617639e-01f, 6.92291796e-01f,
  9.08965766e-01f, 4.16870773e-01f, 9.70906913e-01f, 2.39457220e-01f, 9.90769207e-01f, 1.35559291e-01f, 9.97077882e-01f, 7.63915181e-02f,
  9.99075651e-01f, 4.29867506e-02f, 9.99707639e-01f, 2.41783205e-02f, 9.99907553e-01f, 1.35973748e-02f, 9.99970794e-01f, 7.64652714e-03f,
  9.99843299e-01f, 1.77019257e-02f, 9.25014675e-01f, -3.79931390e-01f, 2.21298173e-01f, 9.75206196e-01f, 2.95478199e-02f, 9.99563396e-01f,
  -3.07332784e-01f, -9.51602101e-01f, -7.85501122e-01f, 6.18860185e-01f, 1.78433523e-01f, 9.83951986e-01f, 7.09193349e-01f, 7.05014050e-01f,
  9.04751658e-01f, 4.25939471e-01f, 9.69545007e-01f, 2.44913206e-01f, 9.90335584e-01f, 1.38691694e-01f, 9.96940494e-01f, 7.81644881e-02f,
  9.99032140e-01f, 4.39858064e-02f, 9.99693930e-01f, 2.47404929e-02f, 9.99903202e-01f, 1.39135728e-02f, 9.99969363e-01f, 7.82434922e-03f,
  5.25321960e-01f, 8.50903511e-01f, 9.85138178e-01f, 1.71763569e-01f, -9.29481089e-02f, 9.95670974e-01f, -1.47732988e-01f, 9.89027262e-01f,
  -2.10795805e-01f, -9.77530122e-01f, -8.19042206e-01f, 5.73733270e-01f, 1.47234216e-01f, 9.89101648e-01f, 6.96544766e-01f, 7.17513323e-01f,
  9.00447130e-01f, 4.34965521e-01f, 9.68152404e-01f, 2.50361472e-01f, 9.89892066e-01f, 1.41822711e-01f, 9.96799886e-01f, 7.99371973e-02f,
  9.98987675e-01f, 4.49848175e-02f, 9.99679863e-01f, 2.53026579e-02f, 9.99898732e-01f, 1.42297689e-02f, 9.99967992e-01f, 8.00217129e-03f,
  -4.32177931e-01f, 9.01788354e-01f, 7.41858006e-01f, 6.70557022e-01f, -3.97976756e-01f, 9.17395473e-01f, -3.20354372e-01f, 9.47297752e-01f,
  -1.12152621e-01f, -9.93690968e-01f, -8.49993885e-01f, 5.26792526e-01f, 1.15887694e-01f, 9.93262351e-01f, 6.83675885e-01f, 7.29785740e-01f,
  8.96052480e-01f, 4.43948090e-01f, 9.66729224e-01f, 2.55801797e-01f, 9.89438653e-01f, 1.44952312e-01f, 9.96656179e-01f, 8.17096606e-02f,
  9.98942196e-01f, 4.59837839e-02f, 9.99665439e-01f, 2.58648153e-02f, 9.99894202e-01f, 1.45459641e-02f, 9.99966562e-01f, 8.17999430e-03f,
  -9.92335498e-01f, 1.23573124e-01f, 2.70098448e-01f, 9.62832689e-01f, -6.63538277e-01f, 7.48142362e-01f, -4.82871950e-01f, 8.75690997e-01f,
  -1.23883775e-02f, -9.99923289e-01f, -8.78258407e-01f, 4.78186339e-01f, 8.44252855e-02f, 9.96429801e-01f, 6.70590878e-01f, 7.41827428e-01f,
  8.91568303e-01f, 4.52886283e-01f, 9.65275466e-01f, 2.61234075e-01f, 9.88975346e-01f, 1.48080453e-01f, 9.96509314e-01f, 8.34818557e-02f,
  9.98895705e-01f, 4.69827019e-02f, 9.99650776e-01f, 2.64269635e-02f, 9.99889553e-01f, 1.48621574e-02f, 9.99965072e-01f, 8.35781638e-03f,
  -6.40144348e-01f, -7.68254638e-01f, -2.84846604e-01f, 9.58573103e-01f, -8.63296509e-01f, 5.04697084e-01f, -6.30159974e-01f, 7.76465356e-01f,
  8.74991715e-02f, -9.96164620e-01f, -9.03746367e-01f, 4.28068399e-01f, 5.28784581e-02f, 9.98600960e-01f, 6.57293737e-01f, 7.53634512e-01f,
  8.86994898e-01f, 4.61779177e-01f, 9.63791192e-01f, 2.66658038e-01f, 9.88502085e-01f, 1.51207119e-01f, 9.96359289e-01f, 8.52537975e-02f,
  9.98848200e-01f, 4.79815714e-02f, 9.99635756e-01f, 2.69891042e-02f, 9.99884784e-01f, 1.51783489e-02f, 9.99963582e-01f, 8.53563752e-03f,
  3.00592542e-01f, -9.53752637e-01f, -7.52063990e-01f, 6.59090102e-01f, -9.77442741e-01f, 2.11200655e-01f, -7.57573068e-01f, 6.52750373e-01f,
  1.86512470e-01f, -9.82452571e-01f, -9.26377118e-01f, 3.76597136e-01f, 2.12787576e-02f, 9.99773562e-01f, 6.43788815e-01f, 7.65203178e-01f,
  8.82332861e-01f, 4.70625877e-01f, 9.62276459e-01f, 2.72073567e-01f, 9.88018990e-01f, 1.54332280e-01f, 9.96206105e-01f, 8.70254710e-02f,
  9.98799741e-01f, 4.89803962e-02f, 9.99620378e-01f, 2.75512375e-02f, 9.99879956e-01f, 1.54945394e-02f, 9.99962032e-01f, 8.71345960e-03f,
  9.64965999e-01f, -2.62374848e-01f, -9.87659097e-01f, 1.56619072e-01f, -9.94656444e-01f, -1.03240460e-01f, -8.61092687e-01f, 5.08447945e-01f,
  2.83662200e-01f, -9.58924294e-01f, -9.46079254e-01f, 3.23935270e-01f, -1.03422189e-02f, 9.99946535e-01f, 6.30080283e-01f, 7.76529968e-01f,
  8.77582550e-01f, 4.79425550e-01f, 9.60731268e-01f, 2.77480543e-01f, 9.87526000e-01f, 1.57455891e-01f, 9.96049762e-01f, 8.87968615e-02f,
  9.98750269e-01f, 4.99791689e-02f, 9.99604762e-01f, 2.81133596e-02f, 9.99875009e-01f, 1.58107281e-02f, 9.99960482e-01f, 8.89127981e-03f,
  7.42154181e-01f, 6.70229197e-01f, -9.19073522e-01f, -3.94086063e-01f, -9.13230121e-01f, -4.07444149e-01f, -9.37454224e-01f, 3.48108500e-01f,
  3.77977669e-01f, -9.25814748e-01f, -9.62790370e-01f, 2.70249337e-01f, -4.19528559e-02f, 9.99119580e-01f, 6.16172493e-01f, 7.87611187e-01f,
  8.72744501e-01f, 4.88177240e-01f, 9.59155679e-01f, 2.82878697e-01f, 9.87023175e-01f, 1.60577938e-01f, 9.95890260e-01f, 9.05679762e-02f,
  9.98699784e-01f, 5.09778969e-02f, 9.99588788e-01f, 2.86754742e-02f, 9.99869943e-01f, 1.61269177e-02f, 9.99958873e-01f, 9.06910095e-03f,
  -1.62990779e-01f, 9.86627579e-01f, -5.67430019e-01f, -8.23421597e-01f, -7.41239965e-01f, -6.71240151e-01f, -9.84248459e-01f, 1.76790684e-01f,
  4.68516916e-01f, -8.83454502e-01f, -9.76457715e-01f, 2.15709001e-01f, -7.35215396e-02f, 9.97293651e-01f, 6.02069914e-01f, 7.98443377e-01f,
  8.67819190e-01f, 4.96880114e-01f, 9.57549810e-01f, 2.88267940e-01f, 9.86510456e-01f, 1.63698375e-01f, 9.95727658e-01f, 9.23388004e-02f,
  9.98648286e-01f, 5.19765690e-02f, 9.99572515e-01f, 2.92375814e-02f, 9.99864817e-01f, 1.64431017e-02f, 9.99957263e-01f, 9.24692024e-03f,
  -9.18282807e-01f, 3.95925164e-01f, -4.10281904e-02f, -9.99157965e-01f, -4.95741814e-01f, -8.68469954e-01f, -1.00000000e+00f, -1.03020677e-04f,
  5.54374516e-01f, -8.32267344e-01f, -9.87038016e-01f, 1.60486728e-01f, -1.05016708e-01f, 9.94470477e-01f, 5.87776959e-01f, 8.09023023e-01f,
  8.62807095e-01f, 5.05533338e-01f, 9.55913603e-01f, 2.93648034e-01f, 9.85987842e-01f, 1.66817173e-01f, 9.95561838e-01f, 9.41093415e-02f,
  9.98595834e-01f, 5.29751927e-02f, 9.99555886e-01f, 2.97996756e-02f, 9.99859571e-01f, 1.67592876e-02f, 9.99955595e-01f, 9.42474138e-03f,
  -8.29309821e-01f, -5.58789074e-01f, 4.98009592e-01f, -8.67171526e-01f, -2.01079622e-01f, -9.79574919e-01f, -9.84212041e-01f, -1.76993474e-01f,
  6.34692967e-01f, -7.72764444e-01f, -9.94497895e-01f, 1.04756832e-01f, -1.36406869e-01f, 9.90652919e-01f, 5.73298037e-01f, 8.19346905e-01f,
  8.57708693e-01f, 5.14135957e-01f, 9.54247177e-01f, 2.99018890e-01f, 9.85455394e-01f, 1.69934288e-01f, 9.95392919e-01f, 9.58795771e-02f,
  9.98542368e-01f, 5.39737605e-02f, 9.99538958e-01f, 3.03617641e-02f, 9.99854207e-01f, 1.70754679e-02f, 9.99953866e-01f, 9.60256159e-03f,
  2.21267566e-02f, -9.99755144e-01f, 8.83669317e-01f, -4.68111664e-01f, 1.13521777e-01f, -9.93535519e-01f, -9.37382519e-01f, -3.48301649e-01f,
  7.08669782e-01f, -7.05540299e-01f, -9.98813629e-01f, 4.86960001e-02f, -1.67660639e-01f, 9.85844791e-01f, 5.58637917e-01f, 8.29411685e-01f,
  8.52524519e-01f, 5.22687256e-01f, 9.52550590e-01f, 3.04380238e-01f, 9.84913111e-01f, 1.73049718e-01f, 9.95220840e-01f, 9.76495072e-02f,
  9.98487890e-01f, 5.49722798e-02f, 9.99521732e-01f, 3.09238415e-02f, 9.99848783e-01f, 1.73916500e-02f, 9.99952197e-01f, 9.78038087e-03f,
  8.53220105e-01f, -5.21551013e-01f, 9.97174621e-01f, 7.51182064e-02f, 4.16867077e-01f, -9.08967435e-01f, -8.60988438e-01f, -5.08624554e-01f,
  7.75565803e-01f, -6.31266713e-01f, -9.99971747e-01f, -7.51878507e-03f, -1.98746875e-01f, 9.80050862e-01f, 5.43801069e-01f, 8.39214146e-01f,
  8.47255111e-01f, 5.31186223e-01f, 9.50823903e-01f, 3.09731960e-01f, 9.84360933e-01f, 1.76163420e-01f, 9.95045662e-01f, 9.94191393e-02f,
  9.98432398e-01f, 5.59707358e-02f, 9.99504209e-01f, 3.14859077e-02f, 9.99843180e-01f, 1.77078284e-02f, 9.99950409e-01f, 9.95820016e-03f,
  8.99866819e-01f, 4.36164767e-01f, 8.03569078e-01f, 5.95211506e-01f, 6.78870201e-01f, -7.34258294e-01f, -7.57439196e-01f, -6.52905703e-01f,
  8.34712923e-01f, -5.50685287e-01f, -9.97968495e-01f, -6.37097955e-02f, -2.29634270e-01f, 9.73276973e-01f, 5.28792322e-01f, 8.48751247e-01f,
  8.41901004e-01f, 5.39632022e-01f, 9.49067116e-01f, 3.15073937e-01f, 9.83798921e-01f, 1.79275364e-01f, 9.94867265e-01f, 1.01188451e-01f,
  9.98375952e-01f, 5.69691435e-02f, 9.99486327e-01f, 3.20479684e-02f, 9.99837577e-01f, 1.80240069e-02f, 9.99948621e-01f, 1.01360194e-02f,
  1.19180135e-01f, 9.92872655e-01f, 3.62476677e-01f, 9.31992829e-01f, 8.73550534e-01f, -4.86733496e-01f, -6.30000710e-01f, -7.76594579e-01f,
  8.85519624e-01f, -4.64602023e-01f, -9.92810190e-01f, -1.19699396e-01f, -2.60292053e-01f, 9.65529919e-01f, 5.13616323e-01f, 8.58020008e-01f,
  8.36462677e-01f, 5.48023939e-01f, 9.47280347e-01f, 3.20405900e-01f, 9.83227074e-01f, 1.82385504e-01f, 9.94685769e-01f, 1.02957435e-01f,
  9.98318493e-01f, 5.79674877e-02f, 9.99468148e-01f, 3.26100141e-02f, 9.99831796e-01f, 1.83401816e-02f, 9.99946833e-01f, 1.03138378e-02f,
  -7.71080196e-01f, 6.36738002e-01f, -1.90249100e-01f, 9.81735826e-01f, 9.81602073e-01f, -1.90938011e-01f, -4.82692331e-01f, -8.75790000e-01f,
  9.27478492e-01f, -3.73876572e-01f, -9.84513164e-01f, -1.75310582e-01f, -2.90689558e-01f, 9.56817448e-01f, 4.98277903e-01f, 8.67017388e-01f,
  8.30940723e-01f, 5.56361020e-01f, 9.45463598e-01f, 3.25727791e-01f, 9.82645452e-01f, 1.85493827e-01f, 9.94501114e-01f, 1.04726106e-01f,
  9.98260021e-01f, 5.89657798e-02f, 9.99449670e-01f, 3.31720486e-02f, 9.99825954e-01f, 1.86563563e-02f, 9.99944985e-01f, 1.04916561e-02f,
  -9.52412963e-01f, -3.04810613e-01f, -6.84381902e-01f, 7.29123712e-01f, 9.92308319e-01f, 1.23790950e-01f, -3.20159167e-01f, -9.47363734e-01f,
  9.60170269e-01f, -2.79415488e-01f, -9.73103702e-01f, -2.30367512e-01f, -3.20796400e-01f, 9.47148204e-01f, 4.82782036e-01f, 8.75740528e-01f,
  8.25335622e-01f, 5.64642429e-01f, 9.43616986e-01f, 3.31039310e-01f, 9.82053936e-01f, 1.88600287e-01f, 9.94313300e-01f, 1.06494442e-01f,
  9.98200536e-01f, 5.99640086e-02f, 9.99430835e-01f, 3.37340795e-02f, 9.99819994e-01f, 1.89725272e-02f, 9.99943078e-01f, 1.06694745e-02f,
  -2.58101642e-01f, -9.66117799e-01f, -9.67739642e-01f, 2.51952261e-01f, 9.04607594e-01f, 4.26245421e-01f, -1.47529200e-01f, -9.89057720e-01f,
  9.83268440e-01f, -1.82162598e-01f, -9.58617806e-01f, -2.84696162e-01f, -3.50582451e-01f, 9.36531842e-01f, 4.67133403e-01f, 8.84186864e-01f,
  8.19648027e-01f, 5.72867453e-01f, 9.41740453e-01f, 3.36340427e-01f, 9.81452644e-01f, 1.91704854e-01f, 9.94122326e-01f, 1.08262435e-01f,
  9.98140097e-01f, 6.09621815e-02f, 9.99411702e-01f, 3.42960916e-02f, 9.99813974e-01f, 1.92886982e-02f, 9.99941170e-01f, 1.08472919e-02f,
  6.73507154e-01f, -7.39180684e-01f, -9.53050017e-01f, -3.02812874e-01f, 7.27198064e-01f, 6.86427653e-01f, 2.97537707e-02f, -9.99557257e-01f,
  9.96542096e-01f, -8.30891207e-02f, -9.41101313e-01f, -3.38124752e-01f, -3.80017966e-01f, 9.24979091e-01f, 4.51337039e-01f, 8.92353535e-01f,
  8.13878477e-01f, 5.81035137e-01f, 9.39834237e-01f, 3.41630876e-01f, 9.80841517e-01f, 1.94807529e-01f, 9.93928254e-01f, 1.10030092e-01f,
  9.98078644e-01f, 6.19602874e-02f, 9.99392271e-01f, 3.48580964e-02f, 9.99807835e-01f, 1.96048655e-02f, 9.99939203e-01f, 1.10251084e-02f,
  9.85896587e-01f, 1.67355701e-01f, -6.44837022e-01f, -7.64320076e-01f, 4.77671444e-01f, 8.78538549e-01f, 2.06098333e-01f, -9.78531301e-01f,
  9.99858618e-01f, 1.68140903e-02f, -9.20609534e-01f, -3.90484393e-01f, -4.09073502e-01f, 9.12501454e-01f, 4.35397953e-01f, 9.00238097e-01f,
  8.08027506e-01f, 5.89144766e-01f, 9.37898219e-01f, 3.46910536e-01f, 9.80220556e-01f, 1.97908238e-01f, 9.93731022e-01f, 1.11797392e-01f,
  9.98016179e-01f, 6.29583374e-02f, 9.99372482e-01f, 3.54200937e-02f, 9.99801576e-01f, 1.99210308e-02f, 9.99937236e-01f, 1.12029258e-02f,
};

constexpr int T_ALL = 36864, T_CTX = 4096;
constexpr int NLAYER = 4;
constexpr float EPS = 1e-6f;
constexpr int LK_LAT = 4352;

struct Params {
  const float* x_prompt; const float* x_sample; const float* cache_ckv; const float* cache_krope;
  const float* cache_k; const float* cache_v; const float* state; const float* c; const float* c_ctx;
  const float* w_mod; const float* b_mod; const float* g_norm; const float* w_in; const float* conv_w; const float* conv_b;
  const float* lru_wa; const float* lru_ba; const float* lru_wi; const float* lru_bi; const float* lru_lam;
  const float* q_norm; const float* w_uq; const float* kv_norm; const float* w_ukv; const float* sink;
  const float* w_br_rnn; const float* w_br_mla; const float* w_br_swa; const float* w_out; const float* final_norm;
  float* out; char* ws;
};

constexpr size_t AL(size_t x) { return (x + 255) & ~(size_t)255; }
constexpr size_t O_WINA = 0;
constexpr size_t O_WINB = O_WINA + AL((size_t)2560 * 1024 * 2);
constexpr size_t O_WLRU = O_WINB + AL((size_t)5120 * 1024 * 2);
constexpr size_t O_WUQ = O_WLRU + AL((size_t)4096 * 128 * 2);
constexpr size_t O_WUKVG = O_WUQ + AL((size_t)768 * 384 * 2);
constexpr size_t O_WUKVR = O_WUKVG + AL((size_t)1024 * 256 * 2);
constexpr size_t O_WBRR = O_WUKVR + AL((size_t)1024 * 256 * 2);
constexpr size_t O_WBRM = O_WBRR + AL((size_t)1024 * 1024 * 2);
constexpr size_t O_WBRS = O_WBRM + AL((size_t)1024 * 512 * 2);
constexpr size_t O_WOUT = O_WBRS + AL((size_t)1024 * 512 * 2);
constexpr size_t O_MOD = O_WOUT + AL((size_t)1024 * 1024 * 2);
constexpr size_t O_H = O_MOD + AL((size_t)4 * 9 * 3072 * 4);
constexpr size_t O_XR = O_H + AL((size_t)T_ALL * 1024 * 2);
constexpr size_t O_CQ = O_XR + AL((size_t)T_ALL * 1024 * 2);
constexpr size_t O_CKV = O_CQ + AL((size_t)T_ALL * 384 * 2);
constexpr size_t O_CKVC = O_CKV + AL((size_t)T_ALL * 256 * 2);
constexpr size_t O_KRL = O_CKVC + AL((size_t)2048 * 256 * 2);
constexpr size_t O_KRC = O_KRL + AL((size_t)8 * LK_LAT * 32 * 2);
constexpr size_t O_QS = O_KRC + AL((size_t)16 * 256 * 32 * 2);
constexpr size_t O_KS = O_QS + AL((size_t)T_ALL * 512 * 2);
constexpr size_t O_KSC = O_KS + AL((size_t)T_ALL * 128 * 2);
constexpr size_t O_VTSL = O_KSC + AL((size_t)8 * 256 * 128 * 2);
constexpr size_t O_VTSC = O_VTSL + AL((size_t)8 * 2 * 64 * 4096 * 2);
constexpr size_t O_VTSCC = O_VTSC + AL((size_t)16 * 2 * 64 * 256 * 2);
constexpr size_t O_Q = O_VTSCC + AL((size_t)8 * 2 * 64 * 256 * 2);
constexpr size_t O_KNL = O_Q + AL((size_t)T_ALL * 768 * 2);
constexpr size_t O_KNC = O_KNL + AL((size_t)8 * 8 * LK_LAT * 64 * 2);
constexpr size_t O_VTL = O_KNC + AL((size_t)16 * 8 * 256 * 64 * 2);
constexpr size_t O_VTC = O_VTL + AL((size_t)8 * 8 * 64 * LK_LAT * 2);
constexpr size_t O_YRNN = O_VTC + AL((size_t)16 * 8 * 64 * 256 * 2);
static_assert(O_YRNN - O_KS >= (size_t)2 * T_ALL * 1024 * 2, "merge-gate buffers do not fit");
constexpr size_t O_SUM = O_YRNN + AL((size_t)T_ALL * 1024 * 2);
constexpr size_t O_BAR = O_SUM + AL((size_t)8 * 8 * 2 * 16 * 256 * 4);
constexpr size_t O_W2 = O_BAR + 256;
constexpr size_t WS_NEED = O_W2 + O_MOD;

constexpr size_t OUT_CKV = (size_t)T_ALL * 1024;
constexpr size_t OUT_KROPE = OUT_CKV + (size_t)16 * 4 * 256 * 256;
constexpr size_t OUT_SK = OUT_KROPE + (size_t)16 * 4 * 256 * 32;
constexpr size_t OUT_SV = OUT_SK + (size_t)16 * 4 * 256 * 128;
constexpr size_t OUT_RG = OUT_SV + (size_t)16 * 4 * 256 * 128;

#define SB() __builtin_amdgcn_sched_barrier(0)
#define MB() asm volatile("" ::: "memory")
DI int tid() { int t = threadIdx.x; asm volatile("" : "+v"(t)); return t; }
DI int xcd_map(int base) {
  const int g = gridDim.x;
  if (g & 7) return base + blockIdx.x;
  return base + (blockIdx.x & 7) * (g >> 3) + (blockIdx.x >> 3);
}
#define LANEVARS const int t = tid(), lane = t & 63, w = t >> 6, wr = w >> 1, wc = w & 1; const int c16 = lane & 15, g4 = lane >> 4; (void)wr; (void)wc; (void)c16; (void)g4;
DI float bf2f(u16 v) { return __uint_as_float(((unsigned)v) << 16); }
DI unsigned pack2(float a, float b) {
  f2_t v = {a, b};
  bf2_t r = __builtin_convertvector(v, bf2_t);
  return __builtin_bit_cast(unsigned, r);
}
DI u16 f2bf(float a) { return (u16)(pack2(a, 0.f) & 0xffffu); }
DI float sigmoidf_(float x) { return 1.f / (1.f + __expf(-x)); }
DI float wave_sum(float v) {
#pragma unroll
  for (int o = 32; o > 0; o >>= 1) v += __shfl_xor(v, o);
  return v;
}
DI int perm32(int p) { return (p & 7) | ((p & 8) << 1) | ((p & 16) >> 1); }
DI const float* xin_row(const Params& p, int l, int row) {
  if (l == 0) return row < T_CTX ? p.x_prompt + (size_t)row * 1024 : p.x_sample + (size_t)(row - T_CTX) * 1024;
  return p.out + (size_t)row * 1024;
}
template <class T> DI T* wsp(const Params& p, size_t off) { return (T*)(p.ws + off); }
DI u16* wsw(const Params& p, int l, size_t off) { return (u16*)(p.ws + ((l & 1) ? O_W2 : 0) + off); }

template <int NJ>
DI void gemm_tile_t(const u16* A, int lda, const u16* B, int ldb, int K,
                    f32x4 (&acc)[4][NJ], char* smem) {
  const int t = tid(), lane = t & 63, w = t >> 6, wr = w >> 1, wc = w & 1;
  const int lr = t >> 3, slot = t & 7;
  const int c16 = lane & 15, g4 = lane >> 4;
  const int gch = slot ^ ((lr >> 1) & 7);
  const u16* ap = A + (size_t)lr * lda + gch * 8;
  const u16* bp = B + (size_t)lr * ldb + gch * 8;
  char* sdst = smem + t * 16;
#define DMA16(gp, lp) __builtin_amdgcn_global_load_lds((const unsigned*)(gp), (unsigned*)(lp), 16, 0, 0)
#define STAGE(base, ko) { DMA16(ap + (ko), (base)); DMA16(ap + (size_t)32 * lda + (ko), (base) + 4096); \
    DMA16(ap + (size_t)64 * lda + (ko), (base) + 8192); DMA16(ap + (size_t)96 * lda + (ko), (base) + 12288); \
    DMA16(bp + (ko), (base) + 16384); DMA16(bp + (size_t)32 * ldb + (ko), (base) + 16384 + 4096); \
    if (NJ > 2) { DMA16(bp + (size_t)64 * ldb + (ko), (base) + 16384 + 8192); DMA16(bp + (size_t)96 * ldb + (ko), (base) + 16384 + 12288); } }
  const int nk = K >> 6;
  const int arow = (wr * 64 + c16) * 128, brow = (wc * (16 * NJ) + c16) * 128;
  const int sw = (c16 >> 1) & 7;
  int kk = (int)((blockIdx.x * 5u + (blockIdx.x >> 3)) % (unsigned)nk);
  STAGE(sdst, kk * 64)
  __syncthreads();
  for (int kt = 0; kt < nk; ++kt) {
    char* cur = smem + (kt & 1) * 32768;
    kk = (kk + 1 == nk) ? 0 : kk + 1;
    if (kt + 1 < nk) { char* nxt = sdst + ((kt + 1) & 1) * 32768; STAGE(nxt, kk * 64) }
#pragma unroll
    for (int ks = 0; ks < 2; ++ks) {
      bf16x8 af[4], bfr[NJ];
      const int ch = ((ks * 4 + g4) ^ sw) << 4;
#pragma unroll
      for (int i = 0; i < 4; ++i) af[i] = *(const bf16x8*)(cur + arow + i * 2048 + ch);
#pragma unroll
      for (int i = 0; i < NJ; ++i) bfr[i] = *(const bf16x8*)(cur + 16384 + brow + i * 2048 + ch);
#pragma unroll
      for (int i = 0; i < 4; ++i)
#pragma unroll
        for (int j = 0; j < NJ; ++j)
          acc[i][j] = __builtin_amdgcn_mfma_f32_16x16x32_bf16(af[i], bfr[j], acc[i][j], 0, 0, 0);
    }
    SB();
    __syncthreads();
  }
#undef STAGE
#undef DMA16
}
DI void gemm_tile(const u16* A, int lda, const u16* B, int ldb, int K,
                  f32x4 (&acc)[4][4], char* smem) {
  gemm_tile_t<4>(A, lda, B, ldb, K, acc, smem);
}
DI void zero_acc(f32x4 (&acc)[4][4]) {
#pragma unroll
  for (int i = 0; i < 4; ++i)
#pragma unroll
    for (int j = 0; j < 4; ++j) acc[i][j] = f32x4{0.f, 0.f, 0.f, 0.f};
}

struct TokTile { int g0; int is_ctx; int b; int p0; };
DI TokTile tok_tile(int mt) {
  TokTile r; r.g0 = mt * 128;
  if (r.g0 < T_CTX) { r.is_ctx = 1; r.b = r.g0 >> 8; r.p0 = r.g0 & 255; }
  else { r.is_ctx = 0; r.b = (r.g0 - T_CTX) >> 12; r.p0 = (r.g0 - T_CTX) & 4095; }
  return r;
}

DI void phase_mod(const Params& p, char* smem) {
  float* s_silu = (float*)smem;
  float* s_part = (float*)(smem + 36864);
  float* MOD = wsp<float>(p, O_MOD);
  const int t = tid();
  for (int i = t; i < 9 * 1024; i += 256) {
    float v = (i < 8192) ? p.c[i] : p.c_ctx[i - 8192];
    s_silu[i] = v * sigmoidf_(v);
  }
  __syncthreads();
  const int kg = t >> 6, cl = t & 63;
  for (int u = blockIdx.x; u < 4 * 48; u += gridDim.x) {
    const int l = u / 48, cb = u % 48;
    const int n = cb * 64 + cl;
    float acc[9];
#pragma unroll
    for (int ci = 0; ci < 9; ++ci) acc[ci] = 0.f;
    const float* wp = p.w_mod + ((size_t)l * 1024 + kg * 256) * 3072 + n;
    for (int k = 0; k < 256; ++k) {
      float wv = wp[(size_t)k * 3072];
#pragma unroll
      for (int ci = 0; ci < 9; ++ci) acc[ci] += s_silu[ci * 1024 + kg * 256 + k] * wv;
    }
#pragma unroll
    for (int ci = 0; ci < 9; ++ci) s_part[(kg * 9 + ci) * 64 + cl] = acc[ci];
    __syncthreads();
    for (int idx = t; idx < 9 * 64; idx += 256) {
      int ci = idx >> 6, c2 = idx & 63;
      float s = s_part[(0 * 9 + ci) * 64 + c2] + s_part[(1 * 9 + ci) * 64 + c2] + s_part[(2 * 9 + ci) * 64 + c2] +
                s_part[(3 * 9 + ci) * 64 + c2];
      MOD[((size_t)l * 9 + ci) * 3072 + cb * 64 + c2] = s + p.b_mod[l * 3072 + cb * 64 + c2];
    }
    __syncthreads();
  }
}

template <class F> DI void conv_job(u16* dst, int N, int K, F src) {
  const int total = N * (K >> 3);
  for (int idx = blockIdx.x * 256 + tid(); idx < total; idx += gridDim.x * 256) {
    const int n = idx % N, kb = idx / N;
    float v[8];
#pragma unroll
    for (int j = 0; j < 8; ++j) v[j] = src(kb * 8 + j, n);
    uint4 o;
    o.x = pack2(v[0], v[1]); o.y = pack2(v[2], v[3]); o.z = pack2(v[4], v[5]); o.w = pack2(v[6], v[7]);
    *(uint4*)(dst + (size_t)n * K + kb * 8) = o;
  }
}

DI void convert_weights(const Params& p, int l) {
  {
    const float* win = p.w_in + (size_t)l * 1024 * 7584;
    conv_job(wsw(p, l, O_WINA), 2560, 1024, [&](int k, int n) -> float {
      int col;
      if (n < 1024) col = n;
      else if (n < 1408) col = 2048 + (n - 1024);
      else if (n < 1664) col = 2432 + (n - 1408);
      else if (n < 1792) { int pp = n - 1664; col = pp < 32 ? 2688 + perm32(pp) : -1; }
      else if (n < 2304) col = 3232 + (n - 1792);
      else if (n < 2432) col = 3744 + (n - 2304);
      else col = 3872 + (n - 2432);
      return col < 0 ? 0.f : win[(size_t)k * 7584 + col];
    });
    conv_job(wsw(p, l, O_WINB), 5120, 1024, [&](int k, int n) -> float {
      int col;
      if (n < 1024) col = 1024 + n;
      else if (n < 1536) col = 2720 + (n - 1024);
      else if (n < 2048) col = 4000 + (n - 1536);
      else col = 4512 + (n - 2048);
      return win[(size_t)k * 7584 + col];
    });
    const float* wa = p.lru_wa + (size_t)l * 2 * 8 * 128 * 128;
    const float* wi = p.lru_wi + (size_t)l * 2 * 8 * 128 * 128;
    conv_job(wsw(p, l, O_WLRU), 4096, 128, [&](int k, int n) -> float {
      int db = n >> 8, nn = n & 255;
      return nn < 128 ? wa[((size_t)db * 128 + k) * 128 + nn] : wi[((size_t)db * 128 + k) * 128 + (nn - 128)];
    });
    const float* wuq = p.w_uq + (size_t)l * 384 * 768;
    const float* gq = p.q_norm + l * 384;
    conv_job(wsw(p, l, O_WUQ), 768, 384, [&](int k, int n) -> float {
      int col;
      if (n < 512) col = (n >> 6) * 96 + (n & 63);
      else { int hh = (n - 512) >> 5, pp = (n - 512) & 31; col = hh * 96 + 64 + perm32(pp); }
      return gq[k] * wuq[(size_t)k * 768 + col];
    });
    const float* wukv = p.w_ukv + (size_t)l * 256 * 1024;
    const float* gkv = p.kv_norm + l * 256;
    conv_job(wsw(p, l, O_WUKVG), 1024, 256, [&](int k, int n) -> float { return gkv[k] * wukv[(size_t)k * 1024 + n]; });
    conv_job(wsw(p, l, O_WUKVR), 1024, 256, [&](int k, int n) -> float { return wukv[(size_t)k * 1024 + n]; });
    const float* w1 = p.w_br_rnn + (size_t)l * 1024 * 1024;
    conv_job(wsw(p, l, O_WBRR), 1024, 1024, [&](int k, int n) -> float { return w1[(size_t)k * 1024 + n]; });
    const float* w2 = p.w_br_mla + (size_t)l * 512 * 1024;
    conv_job(wsw(p, l, O_WBRM), 1024, 512, [&](int k, int n) -> float { return w2[(size_t)k * 1024 + n]; });
    const float* w3 = p.w_br_swa + (size_t)l * 512 * 1024;
    conv_job(wsw(p, l, O_WBRS), 1024, 512, [&](int k, int n) -> float { return w3[(size_t)k * 1024 + n]; });
    const float* w4 = p.w_out + (size_t)l * 1024 * 1024;
    conv_job(wsw(p, l, O_WOUT), 1024, 1024, [&](int k, int n) -> float { return w4[(size_t)k * 1024 + n]; });
  }
}

DI void phase_prep(const Params& p, int l) {
  const int t = tid(), lane = t & 63, w = t >> 6;
  const float* MOD = wsp<float>(p, O_MOD) + (size_t)l * 9 * 3072;
  u16* H = wsp<u16>(p, O_H);
  for (int row = blockIdx.x * 4 + w; row < T_ALL; row += gridDim.x * 4) {
    const float* x = xin_row(p, l, row);
    const int ci = row < T_CTX ? 8 : ((row - T_CTX) >> 12);
    const float* md = MOD + ci * 3072;
    float4 v[4];
    float ss = 0.f;
#pragma unroll
    for (int i = 0; i < 4; ++i) {
      v[i] = *(const float4*)(x + i * 256 + lane * 4);
      ss += v[i].x * v[i].x + v[i].y * v[i].y + v[i].z * v[i].z + v[i].w * v[i].w;
    }
    ss = wave_sum(ss);
    const float rs = rsqrtf(ss * (1.f / 1024.f) + EPS);
#pragma unroll
    for (int i = 0; i < 4; ++i) {
      const int c = i * 256 + lane * 4;
      const float4 g = *(const float4*)(p.g_norm + l * 1024 + c);
      const float4 sh = *(const float4*)(md + c);
      const float4 sc = *(const float4*)(md + 1024 + c);
      float h0 = v[i].x * rs * g.x * (1.f + sc.x) + sh.x;
      float h1 = v[i].y * rs * g.y * (1.f + sc.y) + sh.y;
      float h2 = v[i].z * rs * g.z * (1.f + sc.z) + sh.z;
      float h3 = v[i].w * rs * g.w * (1.f + sc.w) + sh.w;
      uint2 o; o.x = pack2(h0, h1); o.y = pack2(h2, h3);
      *(uint2*)(H + (size_t)row * 1024 + c) = o;
    }
  }
  {
    const int gt = blockIdx.x * 256 + t, gs = gridDim.x * 256;
    u16* ckvc = wsp<u16>(p, O_CKVC);
    for (int i = gt; i < 2048 * 256; i += gs) {
      int r = i >> 8, k = i & 255, b = r >> 8, pos = r & 255;
      ckvc[i] = f2bf(p.cache_ckv[(((size_t)b * 4 + l) * 256 + pos) * 256 + k]);
    }
    u16* krl = wsp<u16>(p, O_KRL);
    for (int i = gt; i < 8 * 256 * 32; i += gs) {
      int pp = i & 31, pos = (i >> 5) & 255, b = i >> 13;
      krl[((size_t)b * LK_LAT + pos) * 32 + pp] = f2bf(p.cache_krope[(((size_t)b * 4 + l) * 256 + pos) * 32 + perm32(pp)]);
    }
    u16* ksc = wsp<u16>(p, O_KSC);
    for (int i = gt; i < 8 * 256 * 128; i += gs) {
      int c = i & 127, pos = (i >> 7) & 255, b = i >> 15;
      ksc[i] = f2bf(p.cache_k[(((size_t)b * 4 + l) * 256 + pos) * 128 + c]);
    }
    u16* vtc = wsp<u16>(p, O_VTSCC);
    for (int i = gt; i < 8 * 2 * 64 * 256; i += gs) {
      int pos = i & 255, dv = (i >> 8) & 63, kvh = (i >> 14) & 1, b = i >> 15;
      vtc[i] = f2bf(p.cache_v[(((size_t)b * 4 + l) * 256 + pos) * 128 + kvh * 64 + dv]);
    }
  }
}

DI void phase_gemmA(const Params& p, int l, char* smem) {
  const u16* H = wsp<u16>(p, O_H);
  const u16* W = wsw(p, l, O_WINA);
  for (int base = 0; base < 288 * 20; base += gridDim.x) {
    const int tile = xcd_map(base);
    if (tile >= 288 * 20) continue;
    const int sb = tile >> 5, jj = tile & 31;
    const int mt = (sb / 5) * 8 + (jj >> 2), nt = (sb % 5) * 4 + (jj & 3);
    const TokTile tt = tok_tile(mt);
    f32x4 acc[4][4];
    zero_acc(acc);
    gemm_tile(H + (size_t)tt.g0 * 1024, 1024, W + (size_t)nt * 128 * 1024, 1024, 1024, acc, smem);
    LANEVARS
    if (nt < 13) {
      u16* dst; int ld, cb;
      if (nt < 8) { dst = wsp<u16>(p, O_XR); ld = 1024; cb = nt * 128; }
      else if (nt < 11) { dst = wsp<u16>(p, O_CQ); ld = 384; cb = (nt - 8) * 128; }
      else { dst = wsp<u16>(p, O_CKV); ld = 256; cb = (nt - 11) * 128; }
#pragma unroll
      for (int i = 0; i < 4; ++i)
#pragma unroll
        for (int j = 0; j < 4; ++j)
#pragma unroll
          for (int e = 0; e < 4; ++e) {
            const int g = tt.g0 + wr * 64 + i * 16 + g4 * 4 + e;
            dst[(size_t)g * ld + cb + wc * 64 + j * 16 + c16] = f2bf(acc[i][j][e]);
            if (e == 3 && j == 3) SB();
          }
    } else if (nt == 13) {
      if (wc == 0) {
#pragma unroll
        for (int i = 0; i < 4; ++i)
#pragma unroll
          for (int e = 0; e < 4; ++e) {
            SB();
            const int r = wr * 64 + i * 16 + g4 * 4 + e;
            const int pos = tt.p0 + r;
            float x1 = acc[i][0][e], x2 = acc[i][1][e];
            if (tt.is_ctx) {
              u16* kr = wsp<u16>(p, O_KRC) + ((size_t)tt.b * 256 + pos) * 32;
              kr[c16] = f2bf(x1); kr[c16 + 16] = f2bf(x2);
              float* o = p.out + OUT_KROPE + (((size_t)tt.b * 4 + l) * 256 + pos) * 32;
              o[perm32(c16)] = x1; o[perm32(c16 + 16)] = x2;
            } else {
              const int pv = (c16 >= 8) ? (pos & 63) : (pos >> 6);
              const float cs = TAB_M[(pv * 8 + (c16 & 7)) * 2], sn = TAB_M[(pv * 8 + (c16 & 7)) * 2 + 1];
              u16* kr = wsp<u16>(p, O_KRL) + ((size_t)tt.b * LK_LAT + 256 + pos) * 32;
              kr[c16] = f2bf(x1 * cs - x2 * sn); kr[c16 + 16] = f2bf(x2 * cs + x1 * sn);
            }
          }
      }
    } else if (nt < 19) {
      const bool isk = (nt == 18);
      u16* dst = isk ? wsp<u16>(p, O_KS) : wsp<u16>(p, O_QS);
      const int ld = isk ? 128 : 512;
      const int cb = isk ? wc * 64 : ((nt - 14) * 2 + wc) * 64;
#pragma unroll
      for (int i = 0; i < 4; ++i)
#pragma unroll
        for (int e = 0; e < 4; ++e) {
          SB();
          const int r = wr * 64 + i * 16 + g4 * 4 + e;
          const int pos = tt.p0 + r, g = tt.g0 + r;
          float v0 = acc[i][0][e], v1 = acc[i][1][e], v2 = acc[i][2][e], v3 = acc[i][3][e];
          if (!tt.is_ctx) {
            const int pr = pos >> 6, pc = pos & 63;
            const float c0 = TAB_S[(pr * 16 + c16) * 2], s0 = TAB_S[(pr * 16 + c16) * 2 + 1];
            const float c1 = TAB_S[(pc * 16 + c16) * 2], s1 = TAB_S[(pc * 16 + c16) * 2 + 1];
            float a0 = v0 * c0 - v1 * s0, a1 = v1 * c0 + v0 * s0;
            float a2 = v2 * c1 - v3 * s1, a3 = v3 * c1 + v2 * s1;
            v0 = a0; v1 = a1; v2 = a2; v3 = a3;
          } else if (isk) {
            float* o = p.out + OUT_SK + (((size_t)tt.b * 4 + l) * 256 + pos) * 128 + cb + c16;
            o[0] = v0; o[16] = v1; o[32] = v2; o[48] = v3;
          }
          u16* d = dst + (size_t)g * ld + cb + c16;
          d[0] = f2bf(v0); d[16] = f2bf(v1); d[32] = f2bf(v2); d[48] = f2bf(v3);
        }
    } else {
      u16* vt = tt.is_ctx ? wsp<u16>(p, O_VTSC) : wsp<u16>(p, O_VTSL);
      const int L = tt.is_ctx ? 256 : 4096;
#pragma unroll
      for (int i = 0; i < 4; ++i)
#pragma unroll
        for (int j = 0; j < 4; ++j) {
          SB();
          const int r = wr * 64 + i * 16 + g4 * 4;
          const int pos = tt.p0 + r, dv = j * 16 + c16;
          uint2 o; o.x = pack2(acc[i][j][0], acc[i][j][1]); o.y = pack2(acc[i][j][2], acc[i][j][3]);
          *(uint2*)(vt + (((size_t)tt.b * 2 + wc) * 64 + dv) * L + pos) = o;
          if (tt.is_ctx) {
#pragma unroll
            for (int e = 0; e < 4; ++e)
              p.out[OUT_SV + (((size_t)tt.b * 4 + l) * 256 + pos + e) * 128 + wc * 64 + dv] = acc[i][j][e];
          }
        }
    }
  }
}

DI void row_scales(const u16* A, int K, float* s_rs) {
  const int t = tid(), row = t >> 1, half = t & 1;
  const u16* ap = A + (size_t)row * K + half * (K >> 1);
  float ss = 0.f;
  for (int c = 0; c < (K >> 4); ++c) {
    uint4 v = *(const uint4*)(ap + c * 8);
    unsigned wv[4] = {v.x, v.y, v.z, v.w};
#pragma unroll
    for (int q = 0; q < 4; ++q) {
      float a = __uint_as_float(wv[q] << 16), b = __uint_as_float(wv[q] & 0xffff0000u);
      ss += a * a + b * b;
    }
  }
  ss += __shfl_xor(ss, 1);
  if (half == 0) s_rs[row] = rsqrtf(ss / (float)K + EPS);
}

template <int MODE> DI void scan_seg(const Params& p, int l, int seq, int blk, int d, int seg, char* smem);
DI void phase_qkv(const Params& p, int l, char* smem) {
  float* s_rs = (float*)(smem + 65536);
  constexpr int NQ = 288 * 6, NKV = 304 * 8, NS1 = 2048;
  for (int base = 0; base < NS1 + NQ + NKV; base += gridDim.x) {
    const int tile0 = xcd_map(base);
    if (tile0 >= NS1 + NQ + NKV) continue;
    if (tile0 < NS1) {
      scan_seg<0>(p, l, 16 + (tile0 >> 8), (tile0 >> 5) & 7, (tile0 >> 4) & 1, tile0 & 15, smem);
#if PROBE == 4
      scan_seg<0>(p, l, 16 + (tile0 >> 8), (tile0 >> 5) & 7, (tile0 >> 4) & 1, tile0 & 15, smem);
#endif
      continue;
    }
    const int tile = tile0 - NS1;
    f32x4 acc[4][4];
    zero_acc(acc);
    if (tile < NQ) {
      const int mt = tile / 6, nt = tile % 6;
      const TokTile tt = tok_tile(mt);
      const u16* A = wsp<u16>(p, O_CQ) + (size_t)tt.g0 * 384;
      row_scales(A, 384, s_rs);
      gemm_tile(A, 384, wsw(p, l, O_WUQ) + (size_t)nt * 128 * 384, 384, 384, acc, smem);
      LANEVARS
      u16* Q = wsp<u16>(p, O_Q);
#pragma unroll
      for (int i = 0; i < 4; ++i)
#pragma unroll
        for (int e = 0; e < 4; ++e) {
          SB();
          const int r = wr * 64 + i * 16 + g4 * 4 + e;
          const int pos = tt.p0 + r, g = tt.g0 + r;
          const float rs = s_rs[r];
          float v0 = acc[i][0][e] * rs, v1 = acc[i][1][e] * rs, v2 = acc[i][2][e] * rs, v3 = acc[i][3][e] * rs;
          if (nt >= 4 && !tt.is_ctx) {
            const int pv = (c16 >= 8) ? (pos & 63) : (pos >> 6);
            const float cs = TAB_M[(pv * 8 + (c16 & 7)) * 2], sn = TAB_M[(pv * 8 + (c16 & 7)) * 2 + 1];
            float a0 = v0 * cs - v1 * sn, a1 = v1 * cs + v0 * sn;
            float a2 = v2 * cs - v3 * sn, a3 = v3 * cs + v2 * sn;
            v0 = a0; v1 = a1; v2 = a2; v3 = a3;
          }
          u16* d = Q + (size_t)g * 768 + nt * 128 + wc * 64 + c16;
          d[0] = f2bf(v0); d[16] = f2bf(v1); d[32] = f2bf(v2); d[48] = f2bf(v3);
        }
    } else {
      const int t2 = tile - NQ;
      const int mt = t2 >> 3, hd = t2 & 7;
      const u16* A; const u16* Wt; int is_ctx, seq, kp0;
      if (mt < 288) {
        const TokTile tt = tok_tile(mt);
        A = wsp<u16>(p, O_CKV) + (size_t)tt.g0 * 256;
        Wt = wsw(p, l, O_WUKVG);
        row_scales(A, 256, s_rs);
        is_ctx = tt.is_ctx; seq = tt.b; kp0 = tt.is_ctx ? tt.p0 : 256 + tt.p0;
        if (tt.is_ctx && hd == 0) {
          __syncthreads();
          const float* gkv = p.kv_norm + l * 256;
          for (int idx = tid(); idx < 128 * 256; idx += 256) {
            const int r = idx >> 8, k = idx & 255;
            p.out[OUT_CKV + (((size_t)tt.b * 4 + l) * 256 + tt.p0 + r) * 256 + k] = bf2f(A[(size_t)r * 256 + k]) * s_rs[r] * gkv[k];
          }
        }
      } else {
        const int row0 = (mt - 288) * 128;
        A = wsp<u16>(p, O_CKVC) + (size_t)row0 * 256;
        Wt = wsw(p, l, O_WUKVR);
        { const int t1 = tid(); if (t1 < 128) s_rs[t1] = 1.f; }
        is_ctx = 0; seq = row0 >> 8; kp0 = row0 & 255;
      }
      gemm_tile(A, 256, Wt + (size_t)hd * 128 * 256, 256, 256, acc, smem);
      LANEVARS
      const int Lk = is_ctx ? 256 : LK_LAT;
      if (wc == 0) {
        u16* Kn = (is_ctx ? wsp<u16>(p, O_KNC) : wsp<u16>(p, O_KNL)) + ((size_t)seq * 8 + hd) * Lk * 64;
#pragma unroll
        for (int i = 0; i < 4; ++i)
#pragma unroll
          for (int j = 0; j < 4; ++j)
#pragma unroll
            for (int e = 0; e < 4; ++e) {
              const int r = wr * 64 + i * 16 + g4 * 4 + e;
              Kn[(size_t)(kp0 + r) * 64 + j * 16 + c16] = f2bf(acc[i][j][e] * s_rs[r]);
              if (e == 3) SB();
            }
      } else {
        u16* Vt = (is_ctx ? wsp<u16>(p, O_VTC) : wsp<u16>(p, O_VTL)) + ((size_t)seq * 8 + hd) * 64 * Lk;
#pragma unroll
        for (int i = 0; i < 4; ++i)
#pragma unroll
          for (int j = 0; j < 4; ++j) {
            SB();
            const int r = wr * 64 + i * 16 + g4 * 4;
            uint2 o;
            o.x = pack2(acc[i][j][0] * s_rs[r], acc[i][j][1] * s_rs[r + 1]);
            o.y = pack2(acc[i][j][2] * s_rs[r + 2], acc[i][j][3] * s_rs[r + 3]);
            *(uint2*)(Vt + (size_t)(j * 16 + c16) * Lk + kp0 + r) = o;
          }
      }
    }
    __syncthreads();
  }
}

template <int NS> DI void attn_gload(const u16* k0, int k0s, const u16* k1, const u16* vt, int vts,
                                     uint4& rk0, uint4& rk1, uint4& rk2, uint4& rv0, uint4& rv1) {
  const int t = tid();
  if (NS == 6) {
    { const int c = t, key = c / 12, ch = c % 12;
      rk0 = (ch < 8) ? *(const uint4*)(k0 + (size_t)key * k0s + ch * 8) : *(const uint4*)(k1 + (size_t)key * 32 + (ch - 8) * 8); }
    { const int c = t + 256, key = c / 12, ch = c % 12;
      rk1 = (ch < 8) ? *(const uint4*)(k0 + (size_t)key * k0s + ch * 8) : *(const uint4*)(k1 + (size_t)key * 32 + (ch - 8) * 8); }
    { const int c = t + 512, key = c / 12, ch = c % 12;
      rk2 = (ch < 8) ? *(const uint4*)(k0 + (size_t)key * k0s + ch * 8) : *(const uint4*)(k1 + (size_t)key * 32 + (ch - 8) * 8); }
  } else {
    { const int c = t, key = c >> 3, ch = c & 7; rk0 = *(const uint4*)(k0 + (size_t)key * k0s + ch * 8); }
    { const int c = t + 256, key = c >> 3, ch = c & 7; rk1 = *(const uint4*)(k0 + (size_t)key * k0s + ch * 8); }
  }
  { const int c = t, dv = c >> 3, ch = c & 7; rv0 = *(const uint4*)(vt + (size_t)dv * vts + ch * 8); }
  { const int c = t + 256, dv = c >> 3, ch = c & 7; rv1 = *(const uint4*)(vt + (size_t)dv * vts + ch * 8); }
}
template <int NS> DI void attn_sstore(char* smem, const uint4& rk0, const uint4& rk1, const uint4& rk2, const uint4& rv0, const uint4& rv1) {
  constexpr int KSTR = (NS == 6) ? 208 : 144;
  const int t = tid();
  if (NS == 6) {
    { const int c = t, key = c / 12, ch = c % 12; *(uint4*)(smem + key * KSTR + ch * 16) = rk0; }
    { const int c = t + 256, key = c / 12, ch = c % 12; *(uint4*)(smem + key * KSTR + ch * 16) = rk1; }
    { const int c = t + 512, key = c / 12, ch = c % 12; *(uint4*)(smem + key * KSTR + ch * 16) = rk2; }
  } else {
    { const int c = t, key = c >> 3, ch = c & 7; *(uint4*)(smem + key * KSTR + ch * 16) = rk0; }
    { const int c = t + 256, key = c >> 3, ch = c & 7; *(uint4*)(smem + key * KSTR + ch * 16) = rk1; }
  }
  { const int c = t, dv = c >> 3, ch = c & 7; char* d = smem + 13312 + dv * 136 + ch * 16;
    *(uint2*)d = uint2{rv0.x, rv0.y}; *(uint2*)(d + 8) = uint2{rv0.z, rv0.w}; }
  { const int c = t + 256, dv = c >> 3, ch = c & 7; char* d = smem + 13312 + dv * 136 + ch * 16;
    *(uint2*)d = uint2{rv1.x, rv1.y}; *(uint2*)(d + 8) = uint2{rv1.z, rv1.w}; }
}

#define PACK8(S, s2) __builtin_bit_cast(bf16x8, uint4{pack2(S[8 * (s2)], S[8 * (s2) + 1]), pack2(S[8 * (s2) + 2], S[8 * (s2) + 3]), \
                                                        pack2(S[8 * (s2) + 4], S[8 * (s2) + 5]), pack2(S[8 * (s2) + 6], S[8 * (s2) + 7])})

template <int NS>
DI void attn_item(const u16* kA, int kAs, const u16* krA, const u16* vtA, int vtAs, int nA, int kposA, int maskA,
                  const u16* kB, int kBs, const u16* vtB, int vtBs, int nB,
                  const u16* qa, const u16* qb, float sc2, float m0, float l0, int qpos, u16* yrow, char* smem) {
  constexpr int KSTR = (NS == 6) ? 208 : 144;
  const int lane = tid() & 63;
  const int r32 = lane & 31, hh = lane >> 5;
  bf16x8 qf0, qf1, qf2, qf3, qf4, qf5;
  qf0 = *(const bf16x8*)(qa + 0 + 8 * hh); qf1 = *(const bf16x8*)(qa + 16 + 8 * hh);
  qf2 = *(const bf16x8*)(qa + 32 + 8 * hh); qf3 = *(const bf16x8*)(qa + 48 + 8 * hh);
  if (NS == 6) { qf4 = *(const bf16x8*)(qb + 0 + 8 * hh); qf5 = *(const bf16x8*)(qb + 16 + 8 * hh); }
  else { qf4 = qf0; qf5 = qf0; }
#define QSCALE(qf) { uint4 u_ = __builtin_bit_cast(uint4, qf); \
    u_.x = pack2(__uint_as_float(u_.x << 16) * sc2, __uint_as_float(u_.x & 0xffff0000u) * sc2); \
    u_.y = pack2(__uint_as_float(u_.y << 16) * sc2, __uint_as_float(u_.y & 0xffff0000u) * sc2); \
    u_.z = pack2(__uint_as_float(u_.z << 16) * sc2, __uint_as_float(u_.z & 0xffff0000u) * sc2); \
    u_.w = pack2(__uint_as_float(u_.w << 16) * sc2, __uint_as_float(u_.w & 0xffff0000u) * sc2); \
    qf = __builtin_bit_cast(bf16x8, u_); }
  QSCALE(qf0) QSCALE(qf1) QSCALE(qf2) QSCALE(qf3)
  if (NS == 6) { QSCALE(qf4) QSCALE(qf5) }
#undef QSCALE
  f32x16 O0, O1;
#pragma unroll
  for (int e = 0; e < 16; ++e) { O0[e] = 0.f; O1[e] = 0.f; }
  float m_run = m0, l_run = l0;
  uint4 rk0, rk1, rk2, rv0, rv1;
  rk2 = uint4{0, 0, 0, 0};
  const int ntiles = nA + nB;
#define TILE_GLOAD(jn) { if ((jn) < nA) attn_gload<NS>(kA + (size_t)(jn) * 64 * kAs, kAs, krA + (size_t)(jn) * 64 * 32, vtA + (jn) * 64, vtAs, rk0, rk1, rk2, rv0, rv1); \
    else { const int jb_ = (jn) - nA; attn_gload<NS>(kB + (size_t)jb_ * 64 * kBs, kBs, nullptr, vtB + jb_ * 64, vtBs, rk0, rk1, rk2, rv0, rv1); } }
  constexpr int STG = 22528;
  TILE_GLOAD(0)
  attn_sstore<NS>(smem, rk0, rk1, rk2, rv0, rv1);
  if (ntiles > 1) TILE_GLOAD(1)
  __syncthreads();
  for (int j = 0; j < ntiles; ++j) {
    char* sbase = smem + (j & 1) * STG;
    const int kpos = kposA + 64 * j;
    const bool masked = maskA && (j < nA);
    MB();
    f32x16 S0, S1;
#pragma unroll
    for (int e = 0; e < 16; ++e) { S0[e] = 0.f; S1[e] = 0.f; }
    const char* ka0 = sbase + r32 * KSTR + 16 * hh;
    const char* ka1 = sbase + (32 + r32) * KSTR + 16 * hh;
#define QK_STEP(s, qf) { bf16x8 a0 = *(const bf16x8*)(ka0 + 32 * (s)); bf16x8 a1 = *(const bf16x8*)(ka1 + 32 * (s)); \
      S0 = __builtin_amdgcn_mfma_f32_32x32x16_bf16(a0, qf, S0, 0, 0, 0); S1 = __builtin_amdgcn_mfma_f32_32x32x16_bf16(a1, qf, S1, 0, 0, 0); }
    QK_STEP(0, qf0) QK_STEP(1, qf1) QK_STEP(2, qf2) QK_STEP(3, qf3)
    if (NS == 6) { QK_STEP(4, qf4) QK_STEP(5, qf5) }
    SB();
    float mx = m_run;
#pragma unroll
    for (int e = 0; e < 16; ++e) {
      float v0 = S0[e], v1 = S1[e];
      if (masked) {
        const int kp = kpos + (e & 3) + 8 * (e >> 2) + 4 * hh;
        int d0 = qpos - kp; d0 = d0 < 0 ? -d0 : d0;
        int d1 = qpos - (kp + 32); d1 = d1 < 0 ? -d1 : d1;
        if (d0 > 128) v0 = -1e30f;
        if (d1 > 128) v1 = -1e30f;
      }
      S0[e] = v0; S1[e] = v1;
      mx = fmaxf(mx, fmaxf(v0, v1));
    }
    mx = fmaxf(mx, __shfl_xor(mx, 32));
    const float alpha = __builtin_amdgcn_exp2f(m_run - mx);
    m_run = mx;
    float rsum = 0.f;
#pragma unroll
    for (int e = 0; e < 16; ++e) {
      float p0 = __builtin_amdgcn_exp2f(S0[e] - mx), p1 = __builtin_amdgcn_exp2f(S1[e] - mx);
      S0[e] = p0; S1[e] = p1;
      rsum += p0 + p1;
    }
    rsum += __shfl_xor(rsum, 32);
    l_run = l_run * alpha + rsum;
#pragma unroll
    for (int e = 0; e < 16; ++e) { O0[e] *= alpha; O1[e] *= alpha; }
    const char* sv0 = sbase + 13312 + r32 * 136 + 8 * hh;
    const char* sv1 = sv0 + 32 * 136;
#define PV_STEP(pb, ka) { \
      { uint2 lo = *(const uint2*)(sv0 + (ka) * 2), hi = *(const uint2*)(sv0 + (ka) * 2 + 16); \
        bf16x8 va = __builtin_bit_cast(bf16x8, uint4{lo.x, lo.y, hi.x, hi.y}); O0 = __builtin_amdgcn_mfma_f32_32x32x16_bf16(va, pb, O0, 0, 0, 0); } \
      { uint2 lo = *(const uint2*)(sv1 + (ka) * 2), hi = *(const uint2*)(sv1 + (ka) * 2 + 16); \
        bf16x8 va = __builtin_bit_cast(bf16x8, uint4{lo.x, lo.y, hi.x, hi.y}); O1 = __builtin_amdgcn_mfma_f32_32x32x16_bf16(va, pb, O1, 0, 0, 0); } }
    SB();
    { bf16x8 pb = PACK8(S0, 0); PV_STEP(pb, 0) }
    { bf16x8 pb = PACK8(S0, 1); PV_STEP(pb, 16) }
    SB();
    { bf16x8 pb = PACK8(S1, 0); PV_STEP(pb, 32) }
    { bf16x8 pb = PACK8(S1, 1); PV_STEP(pb, 48) }
    SB();
    if (j + 1 < ntiles) {
      attn_sstore<NS>(smem + ((j + 1) & 1) * STG, rk0, rk1, rk2, rv0, rv1);
      if (j + 2 < ntiles) TILE_GLOAD(j + 2)
    }
    __syncthreads();
  }
#undef TILE_GLOAD
  const float inv = 1.f / l_run;
#pragma unroll
  for (int e4 = 0; e4 < 4; ++e4) {
    uint2 o;
    o.x = pack2(O0[4 * e4] * inv, O0[4 * e4 + 1] * inv); o.y = pack2(O0[4 * e4 + 2] * inv, O0[4 * e4 + 3] * inv);
    *(uint2*)(yrow + 8 * e4 + 4 * hh) = o;
    o.x = pack2(O1[4 * e4] * inv, O1[4 * e4 + 1] * inv); o.y = pack2(O1[4 * e4 + 2] * inv, O1[4 * e4 + 3] * inv);
    *(uint2*)(yrow + 32 + 8 * e4 + 4 * hh) = o;
  }
}

template <int MODE>
DI void scan_seg(const Params& p, int l, int seq, int blk, int d, int seg, char* smem) {
  const int t = tid(), lane = t & 63, w = t >> 6;
  const int c16 = lane & 15, g4 = lane >> 4;
  const bool is_ctx = seq < 16;
  const int b = is_ctx ? seq : seq - 16;
  const int L = is_ctx ? 256 : 4096;
  const int gbase = is_ctx ? b * 256 : T_CTX + b * 4096;
  const u16* XR = wsp<u16>(p, O_XR);
  u16* Y = wsp<u16>(p, O_YRNN);
  float* SUM = wsp<float>(p, O_SUM);
  char* sXc = smem;
  float* sA = (float*)(smem + 8704);
  float* sU = (float*)(smem + 8704 + 16384);
  const int cch = t & 127, th = t >> 7;
  const int chg = blk * 128 + cch;
  const float w0 = p.conv_w[(l * 4 + 0) * 1024 + chg], w1 = p.conv_w[(l * 4 + 1) * 1024 + chg];
  const float w2 = p.conv_w[(l * 4 + 2) * 1024 + chg], w3 = p.conv_w[(l * 4 + 3) * 1024 + chg];
  const float cb = p.conv_b[l * 1024 + chg];
  bf16x8 bw[4][4];
  {
    const u16* WL = wsw(p, l, O_WLRU) + (size_t)(d * 8 + blk) * 256 * 128 + (size_t)(32 * w + c16) * 128 + g4 * 8;
#pragma unroll
    for (int nf = 0; nf < 4; ++nf)
#pragma unroll
      for (int ks = 0; ks < 4; ++ks)
        bw[nf][ks] = *(const bf16x8*)(WL + (size_t)((nf & 1) * 16 + (nf >> 1) * 128) * 128 + ks * 32);
  }
  float ba[2], bi[2], cl[2];
#pragma unroll
  for (int jn = 0; jn < 2; ++jn) {
    const int ch = (l * 2 + d) * 1024 + blk * 128 + 32 * w + 16 * jn + c16;
    ba[jn] = p.lru_ba[ch]; bi[jn] = p.lru_bi[ch];
    cl[jn] = -8.f * log1pf(__expf(-p.lru_lam[ch]));
  }
  float h = 0.f, P = 1.f;
  if (MODE == 1 && !is_ctx && t < 128) {
    h = p.state[(((size_t)b * 4 + l) * 2 + d) * 1024 + blk * 128 + t];
    const float* sm = SUM + ((size_t)((b * 8 + blk) * 2 + d) * 16) * 256 + t;
    if (d == 0) { for (int s2 = 0; s2 < seg; ++s2) h = sm[s2 * 256] * h + sm[s2 * 256 + 128]; }
    else { for (int s2 = 15; s2 > seg; --s2) h = sm[s2 * 256] * h + sm[s2 * 256 + 128]; }
  }
#define X19(F) F(0) F(1) F(2) F(3) F(4) F(5) F(6) F(7) F(8) F(9) F(10) F(11) F(12) F(13) F(14) F(15) F(16) F(17) F(18)
#define XDECL(q) u16 xr##q = 0;
#define XLOAD(q) { const int pos = tcn + th * 16 - 1 + (q); xr##q = (pos >= 0 && pos < L) ? XR[(size_t)(gbase + pos) * 1024 + chg] : (u16)0; }
#define XCVT(q) xv[q] = bf2f(xr##q);
  X19(XDECL)
  { const int tcn = seg * 256 + (d == 0 ? 0 : 7) * 32; X19(XLOAD) }
  for (int ci = 0; ci < 8; ++ci) {
    const int tc0 = seg * 256 + (d == 0 ? ci : 7 - ci) * 32;
    {
      float xv[19];
      X19(XCVT)
#pragma unroll
      for (int q = 0; q < 16; ++q) {
        float xc = cb + w0 * xv[q] + w1 * xv[q + 1] + w2 * xv[q + 2] + w3 * xv[q + 3];
        *(u16*)(sXc + (th * 16 + q) * 272 + cch * 2) = f2bf(xc);
      }
    }
    unsigned yold0 = 0, yold1 = 0, yold2 = 0, yold3 = 0, yold4 = 0, yold5 = 0, yold6 = 0, yold7 = 0;
    {
      const int cn = ci < 7 ? ci + 1 : ci;
      const int tcn = seg * 256 + (d == 0 ? cn : 7 - cn) * 32;
      X19(XLOAD)
      if (MODE == 1 && d == 1) {
        const unsigned* yb = (const unsigned*)(Y + (size_t)(gbase + tc0 + (t >> 6)) * 1024 + blk * 128 + (t & 63) * 2);
        yold0 = yb[0]; yold1 = yb[4 * 512]; yold2 = yb[8 * 512]; yold3 = yb[12 * 512];
        yold4 = yb[16 * 512]; yold5 = yb[20 * 512]; yold6 = yb[24 * 512]; yold7 = yb[28 * 512];
      }
    }
    MB();
    __syncthreads();
    f32x4 aR[2][2], aI[2][2];
#pragma unroll
    for (int im = 0; im < 2; ++im)
#pragma unroll
      for (int jn = 0; jn < 2; ++jn) { aR[im][jn] = f32x4{0.f, 0.f, 0.f, 0.f}; aI[im][jn] = f32x4{0.f, 0.f, 0.f, 0.f}; }
#pragma unroll
    for (int ks = 0; ks < 4; ++ks)
#pragma unroll
      for (int im = 0; im < 2; ++im) {
        bf16x8 af = *(const bf16x8*)(sXc + (16 * im + c16) * 272 + (ks * 32 + g4 * 8) * 2);
#pragma unroll
        for (int jn = 0; jn < 2; ++jn) {
          aR[im][jn] = __builtin_amdgcn_mfma_f32_16x16x32_bf16(af, bw[jn][ks], aR[im][jn], 0, 0, 0);
          aI[im][jn] = __builtin_amdgcn_mfma_f32_16x16x32_bf16(af, bw[2 + jn][ks], aI[im][jn], 0, 0, 0);
        }
      }
#pragma unroll
    for (int im = 0; im < 2; ++im)
#pragma unroll
      for (int jn = 0; jn < 2; ++jn)
#pragma unroll
        for (int e = 0; e < 4; ++e) {
          const int tt = 16 * im + 4 * g4 + e, c = 32 * w + 16 * jn + c16;
          const float r = sigmoidf_(aR[im][jn][e] + ba[jn]);
          const float ig = sigmoidf_(aI[im][jn][e] + bi[jn]);
          const float a = __expf(cl[jn] * r);
          const float xc = bf2f(*(const u16*)(sXc + tt * 272 + c * 2));
          const float u = sqrtf(fmaxf(1.f - a * a, 0.f)) * ig * xc;
          sA[tt * 128 + c] = a; sU[tt * 128 + c] = u;
        }
    __syncthreads();
    if (t < 128) {
      if (d == 0) {
#pragma unroll 8
        for (int s = 0; s < 32; ++s) {
          const float a = sA[s * 128 + t];
          h = a * h + sU[s * 128 + t];
          if (MODE == 0) P *= a; else sU[s * 128 + t] = h;
        }
      } else {
#pragma unroll 8
        for (int s = 31; s >= 0; --s) {
          const float a = sA[s * 128 + t];
          h = a * h + sU[s * 128 + t];
          if (MODE == 0) P *= a; else sU[s * 128 + t] = h;
        }
      }
    }
    __syncthreads();
    if (MODE == 1) {
      const int c2 = (t & 63) * 2;
      unsigned* yb = (unsigned*)(Y + (size_t)(gbase + tc0 + (t >> 6)) * 1024 + blk * 128 + c2);
      const float* su = sU + (t >> 6) * 128 + c2;
#define YOUT(i, yo) { float h0 = su[(4 * (i)) * 128], h1 = su[(4 * (i)) * 128 + 1]; \
        if (d == 1) { h0 += __uint_as_float((yo) << 16); h1 += __uint_as_float((yo) & 0xffff0000u); } \
        yb[(size_t)(4 * (i)) * 512] = pack2(h0, h1); }
      YOUT(0, yold0) YOUT(1, yold1) YOUT(2, yold2) YOUT(3, yold3) YOUT(4, yold4) YOUT(5, yold5) YOUT(6, yold6) YOUT(7, yold7)
#undef YOUT
    }
  }
#undef X19
#undef XDECL
#undef XLOAD
#undef XCVT
  if (MODE == 0) {
    if (t < 128) {
      float* sm = SUM + ((size_t)(((b * 8 + blk) * 2 + d) * 16 + seg)) * 256 + t;
      sm[0] = P; sm[128] = h;
    }
  } else if (is_ctx && t < 128) {
    p.out[OUT_RG + (((size_t)b * 4 + l) * 2 + d) * 1024 + blk * 128 + t] = h;
  }
  __syncthreads();
}

DI void phase_mix(const Params& p, int l, char* smem) {
  constexpr float LOG2E = 1.4426950408889634f;
  constexpr int N0 = 1024, N1 = N0 + 2048, N2 = N1 + 2048, N3 = N2 + 128, N4 = N3 + 256, N5 = N4 + 256;
  for (int base = 0; base < N5; base += gridDim.x) {
    const int it = xcd_map(base);
    if (it >= N5) continue;
    const int t = tid(), lane = t & 63, w = t >> 6;
    const int r32 = lane & 31;
    if (it < N0 || (it >= N2 && it < N3)) {
      int seq, blk, seg;
      if (it < N0) { seg = it & 15; blk = (it >> 4) & 7; seq = 16 + (it >> 7); }
      else { const int i = it - N2; seg = 0; blk = i & 7; seq = i >> 3; }
      scan_seg<1>(p, l, seq, blk, 0, seg, smem);
      scan_seg<1>(p, l, seq, blk, 1, seg, smem);
#if PROBE == 4
      scan_seg<1>(p, l, seq, blk, 0, seg, smem);
      scan_seg<1>(p, l, seq, blk, 1, seg, smem);
#endif
    } else if (it < N1 || (it >= N3 && it < N4)) {
      const bool lat = it < N1;
      int b, h, qb;
      if (lat) { const int i = it - N0; qb = i & 31; h = (i >> 5) & 7; b = i >> 8; }
      else { const int i = it - N3; qb = i & 1; h = (i >> 1) & 7; b = i >> 4; }
      const int Lk = lat ? LK_LAT : 256;
      const int gq = (lat ? T_CTX + b * 4096 : b * 256) + qb * 128 + w * 32 + r32;
      const u16* Kn = (lat ? wsp<u16>(p, O_KNL) : wsp<u16>(p, O_KNC)) + ((size_t)b * 8 + h) * Lk * 64;
      const u16* Kr = (lat ? wsp<u16>(p, O_KRL) : wsp<u16>(p, O_KRC)) + (size_t)b * Lk * 32;
      const u16* Vt = (lat ? wsp<u16>(p, O_VTL) : wsp<u16>(p, O_VTC)) + ((size_t)b * 8 + h) * 64 * Lk;
      const u16* Q = wsp<u16>(p, O_Q) + (size_t)gq * 768;
      u16* yrow = wsp<u16>(p, O_CQ) + (size_t)gq * 512 + h * 64;
      attn_item<6>(Kn, 64, Kr, Vt, Lk, Lk >> 6, 0, 0, nullptr, 0, nullptr, 0, 0,
                   Q + h * 64, Q + 512 + h * 32, 0.10206207261596577f * LOG2E, -1e30f, 0.f, 0, yrow, smem);
#if PROBE == 5
      __syncthreads();
      attn_item<6>(Kn, 64, Kr, Vt, Lk, Lk >> 6, 0, 0, nullptr, 0, nullptr, 0, 0,
                   Q + h * 64, Q + 512 + h * 32, 0.10206207261596577f * LOG2E, -1e30f, 0.f, 0, yrow, smem);
#endif
    } else {
      const bool lat = it < N2;
      int b, h, qb;
      if (lat) { const int i = it - N1; qb = i & 31; h = (i >> 5) & 7; b = i >> 8; }
      else { const int i = it - N4; qb = i & 1; h = (i >> 1) & 7; b = i >> 4; }
      const int kvh = h >> 2;
      const int gseq = lat ? T_CTX + b * 4096 : b * 256;
      const int qpos = qb * 128 + w * 32 + r32;
      const int gq = gseq + qpos;
      u16* qrow = wsp<u16>(p, O_QS) + (size_t)gq * 512 + h * 64;
      const float sink2 = p.sink[l * 8 + h] * LOG2E;
      const int t0 = qb * 128;
      int jlo = 0, jhi = 6;
      if (t0 == 0) jlo = 2;
      if (t0 + 128 >= 4096) jhi = 4;
      const int ks0 = lat ? t0 - 128 + 64 * jlo : 0;
      const int nA = lat ? jhi - jlo : 4;
      const u16* KS = wsp<u16>(p, O_KS) + (size_t)(gseq + ks0) * 128 + kvh * 64;
      const u16* VT = lat ? wsp<u16>(p, O_VTSL) + ((size_t)b * 2 + kvh) * 64 * 4096 + ks0
                          : wsp<u16>(p, O_VTSC) + ((size_t)b * 2 + kvh) * 64 * 256;
      const u16* KC = wsp<u16>(p, O_KSC) + (size_t)b * 256 * 128 + kvh * 64;
      const u16* VC = wsp<u16>(p, O_VTSCC) + ((size_t)b * 2 + kvh) * 64 * 256;
      attn_item<4>(KS, 128, nullptr, VT, lat ? 4096 : 256, nA, ks0, lat ? 1 : 0, KC, 128, VC, 256, lat ? 4 : 0,
                   qrow, nullptr, 0.125f * LOG2E, sink2, 1.f, qpos, qrow, smem);
    }
    __syncthreads();
  }
}

DI void phase_gate(const Params& p, int l, char* smem) {
  const u16* H = wsp<u16>(p, O_H);
  const u16* W = wsw(p, l, O_WINB);
  for (int base = 0; base < 288 * 40; base += gridDim.x) {
    const int tile = xcd_map(base);
    if (tile >= 288 * 40) continue;
    const int sb = tile >> 6, jj = tile & 63;
    const int mt = (sb / 5) * 8 + (jj >> 3), nt = (sb % 5) * 8 + (jj & 7);
    const int g0 = mt * 128;
    f32x4 acc[4][4];
    zero_acc(acc);
    gemm_tile(H + (size_t)g0 * 1024, 1024, W + (size_t)nt * 128 * 1024, 1024, 1024, acc, smem);
    LANEVARS
    if (nt < 16) {
      u16* dst; int ld, cb;
      if (nt < 8) { dst = wsp<u16>(p, O_YRNN); ld = 1024; cb = nt * 128; }
      else if (nt < 12) { dst = wsp<u16>(p, O_CQ); ld = 512; cb = (nt - 8) * 128; }
      else { dst = wsp<u16>(p, O_QS); ld = 512; cb = (nt - 12) * 128; }
#pragma unroll
      for (int i = 0; i < 4; ++i)
#pragma unroll
        for (int j = 0; j < 4; ++j)
#pragma unroll
          for (int e = 0; e < 4; ++e) {
            const int g = g0 + wr * 64 + i * 16 + g4 * 4 + e;
            u16* d = dst + (size_t)g * ld + cb + wc * 64 + j * 16 + c16;
            const float gv = acc[i][j][e];
            *d = f2bf(bf2f(*d) * gv * sigmoidf_(gv));
            if (e == 3) SB();
          }
    } else {
      const int br = (nt - 16) >> 3, cb = ((nt - 16) & 7) * 128;
      u16* dst = br == 0 ? wsp<u16>(p, O_XR) : wsp<u16>(p, O_KS) + (size_t)(br - 1) * T_ALL * 1024;
#pragma unroll
      for (int i = 0; i < 4; ++i)
#pragma unroll
        for (int j = 0; j < 4; ++j)
#pragma unroll
          for (int e = 0; e < 4; ++e) {
            const int g = g0 + wr * 64 + i * 16 + g4 * 4 + e;
            dst[(size_t)g * 1024 + cb + wc * 64 + j * 16 + c16] = f2bf(sigmoidf_(acc[i][j][e]));
            if (e == 3) SB();
          }
    }
  }
}

DI void phase_merge(const Params& p, int l, char* smem) {
  u16* U = wsp<u16>(p, O_H);
  for (int base = 0; base < 288 * 8; base += gridDim.x) {
    const int tile = xcd_map(base);
    if (tile >= 288 * 8) continue;
    const int mt = tile >> 3, nt = tile & 7;
    const int g0 = mt * 128;
    f32x4 u[4][4];
    zero_acc(u);
    for (int br = 0; br < 3; ++br) {
      f32x4 acc[4][4];
      zero_acc(acc);
      const u16* Z; const u16* WT; int kz; const u16* M;
      if (br == 0) { Z = wsp<u16>(p, O_YRNN) + (size_t)g0 * 1024; WT = wsw(p, l, O_WBRR) + (size_t)nt * 128 * 1024; kz = 1024; M = wsp<u16>(p, O_XR); }
      else if (br == 1) { Z = wsp<u16>(p, O_CQ) + (size_t)g0 * 512; WT = wsw(p, l, O_WBRM) + (size_t)nt * 128 * 512; kz = 512; M = wsp<u16>(p, O_KS); }
      else { Z = wsp<u16>(p, O_QS) + (size_t)g0 * 512; WT = wsw(p, l, O_WBRS) + (size_t)nt * 128 * 512; kz = 512; M = wsp<u16>(p, O_KS) + (size_t)T_ALL * 1024; }
      gemm_tile(Z, kz, WT, kz, kz, acc, smem);
      LANEVARS
#pragma unroll
      for (int i = 0; i < 4; ++i)
#pragma unroll
        for (int j = 0; j < 4; ++j)
#pragma unroll
          for (int e = 0; e < 4; ++e) {
            const int g = g0 + wr * 64 + i * 16 + g4 * 4 + e;
            u[i][j][e] += bf2f(M[(size_t)g * 1024 + nt * 128 + wc * 64 + j * 16 + c16]) * acc[i][j][e];
            if (e == 3) SB();
          }
    }
    LANEVARS
#pragma unroll
    for (int i = 0; i < 4; ++i)
#pragma unroll
      for (int j = 0; j < 4; ++j)
#pragma unroll
        for (int e = 0; e < 4; ++e) {
          const int g = g0 + wr * 64 + i * 16 + g4 * 4 + e;
          U[(size_t)g * 1024 + nt * 128 + wc * 64 + j * 16 + c16] = f2bf(u[i][j][e]);
        }
  }
}

DI void phase_out(const Params& p, int l, char* smem) {
  const u16* U = wsp<u16>(p, O_H);
  const u16* W = wsw(p, l, O_WOUT);
  const float* MOD = wsp<float>(p, O_MOD) + (size_t)l * 9 * 3072;
  for (int base = 0; base < 288 * 8; base += gridDim.x) {
    const int tile = xcd_map(base);
    if (tile >= 288 * 8) continue;
    const int mt = tile >> 3, nt = tile & 7;
    const int g0 = mt * 128;
    const int ci = g0 < T_CTX ? 8 : ((g0 - T_CTX) >> 12);
    f32x4 acc[4][4];
    zero_acc(acc);
    gemm_tile(U + (size_t)g0 * 1024, 1024, W + (size_t)nt * 128 * 1024, 1024, 1024, acc, smem);
    LANEVARS
#pragma unroll
    for (int j = 0; j < 4; ++j) {
      const int col = nt * 128 + wc * 64 + j * 16 + c16;
      const float gt = MOD[ci * 3072 + 2048 + col];
#pragma unroll
      for (int i = 0; i < 4; ++i)
#pragma unroll
        for (int e = 0; e < 4; ++e) {
          const int g = g0 + wr * 64 + i * 16 + g4 * 4 + e;
          const float xo = xin_row(p, l, g)[col];
          p.out[(size_t)g * 1024 + col] = xo + gt * acc[i][j][e];
          if (e == 3) SB();
        }
    }
  }
}

DI void phase_final(const Params& p) {
  const int t = tid(), lane = t & 63, w = t >> 6;
  for (int row = blockIdx.x * 4 + w; row < T_ALL; row += gridDim.x * 4) {
    float* x = p.out + (size_t)row * 1024;
    float4 v[4];
    float ss = 0.f;
#pragma unroll
    for (int i = 0; i < 4; ++i) {
      v[i] = *(const float4*)(x + i * 256 + lane * 4);
      ss += v[i].x * v[i].x + v[i].y * v[i].y + v[i].z * v[i].z + v[i].w * v[i].w;
    }
    ss = wave_sum(ss);
    const float rs = rsqrtf(ss * (1.f / 1024.f) + EPS);
#pragma unroll
    for (int i = 0; i < 4; ++i) {
      const int c = i * 256 + lane * 4;
      const float4 g = *(const float4*)(p.final_norm + c);
      float4 o = {v[i].x * rs * g.x, v[i].y * rs * g.y, v[i].z * rs * g.z, v[i].w * rs * g.w};
      *(float4*)(x + c) = o;
    }
  }
}

constexpr int NPHASE_PER_LAYER = 7;
DI void run_phase(const Params& p, int ph, char* smem) {
  if (ph == 0) { phase_mod(p, smem); return; }
  if (ph == 1 + NLAYER * NPHASE_PER_LAYER) { phase_final(p); return; }
  const int l = (ph - 1) / NPHASE_PER_LAYER, s = (ph - 1) % NPHASE_PER_LAYER;
  switch (s) {
    case 0: phase_prep(p, l); break;
    case 1: phase_gemmA(p, l, smem); break;
    case 2: phase_qkv(p, l, smem); break;
    case 3: phase_mix(p, l, smem); break;
    case 4: phase_gate(p, l, smem); break;
    case 5: phase_merge(p, l, smem); break;
    default: phase_out(p, l, smem); break;
  }
}
constexpr int NPHASE = 2 + NLAYER * NPHASE_PER_LAYER;

#if MEGA
DI Params launder(const Params& p) {
  size_t z = 0;
  asm volatile("" : "+s"(z));
  Params q = p; q.ws = p.ws + z; q.out = p.out + z;
  return q;
}
DI void fast_barrier(unsigned* ctr, unsigned& epoch) {
  asm volatile("s_waitcnt vmcnt(0)" ::: "memory");
  __syncthreads();
  epoch += gridDim.x;
  if (threadIdx.x == 0) {
    __builtin_amdgcn_fence(__ATOMIC_RELEASE, "agent");
    asm volatile("s_waitcnt vmcnt(0)" ::: "memory");
    __hip_atomic_fetch_add(ctr, 1u, __ATOMIC_RELAXED, __HIP_MEMORY_SCOPE_AGENT);
    unsigned spins = 0;
    while (__hip_atomic_load(ctr, __ATOMIC_RELAXED, __HIP_MEMORY_SCOPE_AGENT) < epoch) {
      __builtin_amdgcn_s_sleep(1);
      if (++spins > (1u << 22)) break;
    }
    __builtin_amdgcn_fence(__ATOMIC_ACQUIRE, "agent");
    asm volatile("s_waitcnt vmcnt(0)" ::: "memory");
  }
  __syncthreads();
}
#define GSYNC() fast_barrier(bar_ctr, bar_epoch)
__global__ void __launch_bounds__(256, 2) mega_kernel(Params p) {
  __shared__ __attribute__((aligned(16))) char smem[66048];
  cg::grid_group grid = cg::this_grid();
  unsigned* bar_ctr = (unsigned*)(p.ws + O_BAR);
  unsigned bar_epoch = 0;
  phase_mod(launder(p), smem);
  convert_weights(launder(p), 0);
  grid.sync();
  for (int l = 0; l < NLAYER; ++l) {
    phase_prep(launder(p), l);
    GSYNC();
#if PROBE == 1
    phase_prep(launder(p), l);
    GSYNC();
#endif
    phase_gemmA(launder(p), l, smem);
    GSYNC();
#if PROBE == 2
    phase_gemmA(launder(p), l, smem);
    GSYNC();
#endif
    phase_qkv(launder(p), l, smem);
    GSYNC();
    phase_mix(launder(p), l, smem);
    if (l + 1 < NLAYER) convert_weights(launder(p), l + 1);
    GSYNC();
    phase_gate(launder(p), l, smem);
    GSYNC();
    phase_merge(launder(p), l, smem);
    GSYNC();
#if PROBE == 3
    phase_merge(launder(p), l, smem);
    GSYNC();
#endif
    phase_out(launder(p), l, smem);
    GSYNC();
  }
  phase_final(launder(p));
}

#else
__global__ void __launch_bounds__(256, 2) phase_kernel(Params p, int ph) {
  __shared__ __attribute__((aligned(16))) char smem[66048];
  run_phase(p, ph, smem);
}

#endif
extern "C" void kernel_launch(void* const* d_in, const int* in_sizes, int n_in, void* d_out, int out_size, void* d_ws,
                              size_t ws_size, hipStream_t stream) {
  Params p{};
  const float** pp = (const float**)&p;
  for (int i = 0; i < 30; ++i) pp[i] = (const float*)d_in[i];
  p.out = (float*)d_out;
  p.ws = (char*)d_ws;
  if (ws_size < WS_NEED) fprintf(stderr, "workspace too small: %zu < %zu\n", ws_size, (size_t)WS_NEED);
#if MEGA
  static int grid_blocks = 0;
  if (!grid_blocks) {
    int dev = 0, cus = 0, per_cu = 0;
    hipGetDevice(&dev);
    hipDeviceGetAttribute(&cus, hipDeviceAttributeMultiprocessorCount, dev);
    hipOccupancyMaxActiveBlocksPerMultiprocessor(&per_cu, mega_kernel, 256, 0);
    if (per_cu > 2) per_cu = 2;
    grid_blocks = cus * per_cu;
  }
  (void)hipMemsetAsync((char*)d_ws + O_BAR, 0, 256, stream);
  void* args[] = {&p};
  hipError_t e = hipLaunchCooperativeKernel((void*)mega_kernel, dim3(grid_blocks), dim3(256), args, 0, stream);
  if (e != hipSuccess) fprintf(stderr, "cooperative launch failed: %s (grid %d)\n", hipGetErrorString(e), grid_blocks);
#else
  for (int ph = 0; ph < NPHASE; ++ph) phase_kernel<<<512, 256, 0, stream>>>(p, ph);
#endif
}
```

```cpp
#include <hip/hip_runtime.h>
#include <hip/hip_cooperative_groups.h>
#include <cstdio>
#include <cstdint>
namespace cg = cooperative_groups;

#ifndef PROBE
#define PROBE 0
#endif
#ifndef MEGA
#define MEGA 1
#endif

typedef unsigned short u16;
using bf16x8 = __attribute__((ext_vector_type(8))) short;
using f32x4 = __attribute__((ext_vector_type(4))) float;
using f32x16 = __attribute__((ext_vector_type(16))) float;
typedef __bf16 bf2_t __attribute__((ext_vector_type(2)));
typedef float f2_t __attribute__((ext_vector_type(2)));
#define DI __device__ __forceinline__

__device__ const float TAB_M[1024] = {
  1.00000000e+00f, 0.00000000e+00f, 1.00000000e+00f, 0.00000000e+00f, 1.00000000e+00f, 0.00000000e+00f, 1.00000000e+00f, 0.00000000e+00f,
  1.00000000e+00f, 0.00000000e+00f, 1.00000000e+00f, 0.00000000e+00f, 1.00000000e+00f, 0.00000000e+00f, 1.00000000e+00f, 0.00000000e+00f,
  5.40302277e-01f, 8.41470957e-01f, 9.50415254e-01f, 3.10983598e-01f, 9.95004177e-01f, 9.98334214e-02f, 9.99500036e-01f, 3.16175036e-02f,
  9.99949992e-01f, 9.99983307e-03f, 9.99994993e-01f, 3.16227227e-03f, 9.99999523e-01f, 9.99999931e-04f, 9.99999940e-01f, 3.16227757e-04f,
  -4.16146845e-01f, 9.09297407e-01f, 8.06578398e-01f, 5.91127098e-01f, 9.80066597e-01f, 1.98669329e-01f, 9.98000681e-01f, 6.32033944e-02f,
  9.99800026e-01f, 1.99986659e-02f, 9.99979973e-01f, 6.32451288e-03f, 9.99997973e-01f, 1.99999870e-03f, 9.99999821e-01f, 6.32455456e-04f,
  -9.89992499e-01f, 1.41120002e-01f, 5.82753658e-01f, 8.12648892e-01f, 9.55336511e-01f, 2.95520216e-01f, 9.95503366e-01f, 9.47260857e-02f,
  9.99550045e-01f, 2.99954992e-02f, 9.99954998e-01f, 9.48669016e-03f, 9.99995530e-01f, 2.99999560e-03f, 9.99999523e-01f, 9.48683126e-04f,
  -6.53643608e-01f, -7.56802499e-01f, 3.01137477e-01f, 9.53580737e-01f, 9.21060979e-01f, 3.89418334e-01f, 9.92010653e-01f, 1.26154065e-01f,
  9.99200106e-01f, 3.99893336e-02f, 9.99920011e-01f, 1.26487734e-02f, 9.99992013e-01f, 3.99998948e-03f, 9.99999225e-01f, 1.26491068e-03f,
  2.83662200e-01f, -9.58924294e-01f, -1.03423381e-02f, 9.99946535e-01f, 8.77582550e-01f, 4.79425550e-01f, 9.87526000e-01f, 1.57455876e-01f,
  9.98750269e-01f, 4.99791652e-02f, 9.99875009e-01f, 1.58107281e-02f, 9.99987483e-01f, 4.99997940e-03f, 9.99998748e-01f, 1.58113812e-03f,
  9.60170269e-01f, -2.79415488e-01f, -3.20796400e-01f, 9.47148204e-01f, 8.25335622e-01f, 5.64642489e-01f, 9.82053936e-01f, 1.88600272e-01f,
  9.98200536e-01f, 5.99640049e-02f, 9.99819994e-01f, 1.89725272e-02f, 9.99981999e-01f, 5.99996420e-03f, 9.99998212e-01f, 1.89736532e-03f,
  7.53902256e-01f, 6.56986594e-01f, -5.99437475e-01f, 8.00421596e-01f, 7.64842212e-01f, 6.44217670e-01f, 9.75599885e-01f, 2.19556093e-01f,
  9.97551024e-01f, 6.99428469e-02f, 9.99755025e-01f, 2.21341345e-02f, 9.99975502e-01f, 6.99994294e-03f, 9.99997556e-01f, 2.21359241e-03f,
  -1.45500034e-01f, 9.89358246e-01f, -8.18632424e-01f, 5.74317753e-01f, 6.96706712e-01f, 7.17356086e-01f, 9.68170285e-01f, 2.50292331e-01f,
  9.96801734e-01f, 7.99146891e-02f, 9.99680042e-01f, 2.52955221e-02f, 9.99967992e-01f, 7.99991470e-03f, 9.99996781e-01f, 2.52981926e-03f,
  -9.11130250e-01f, 4.12118495e-01f, -9.56644177e-01f, 2.91259229e-01f, 6.21609926e-01f, 7.83326924e-01f, 9.59772646e-01f, 2.80778319e-01f,
  9.95952725e-01f, 8.98785442e-02f, 9.99595046e-01f, 2.84566563e-02f, 9.99959528e-01f, 8.99987947e-03f, 9.99995947e-01f, 2.84604589e-03f,
  -8.39071512e-01f, -5.44021130e-01f, -9.99786079e-01f, -2.06835698e-02f, 5.40302277e-01f, 8.41470957e-01f, 9.50415313e-01f, 3.10983568e-01f,
  9.95004177e-01f, 9.98334140e-02f, 9.99500036e-01f, 3.16175036e-02f, 9.99949992e-01f, 9.99983400e-03f, 9.99994993e-01f, 3.16227227e-03f,
  4.42569796e-03f, -9.99990225e-01f, -9.43779767e-01f, -3.30574960e-01f, 4.53596085e-01f, 8.91207397e-01f, 9.40107584e-01f, 3.40877861e-01f,
  9.93956089e-01f, 1.09778300e-01f, 9.99395072e-01f, 3.47780399e-02f, 9.99939501e-01f, 1.09997792e-02f, 9.99993920e-01f, 3.47849843e-03f,
  8.43853951e-01f, -5.36572933e-01f, -7.94179380e-01f, -6.07683420e-01f, 3.62357706e-01f, 9.32039082e-01f, 9.28859890e-01f, 3.70431304e-01f,
  9.92808640e-01f, 1.19712204e-01f, 9.99280095e-01f, 3.79382223e-02f, 9.99927998e-01f, 1.19997123e-02f, 9.99992788e-01f, 3.79472389e-03f,
  9.07446802e-01f, 4.20167029e-01f, -5.65820515e-01f, -8.24528456e-01f, 2.67498761e-01f, 9.63558197e-01f, 9.16683376e-01f, 3.99614304e-01f,
  9.91561890e-01f, 1.29634142e-01f, 9.99155104e-01f, 4.10980321e-02f, 9.99915481e-01f, 1.29996343e-02f, 9.99991536e-01f, 4.11094911e-03f,
  1.36737213e-01f, 9.90607381e-01f, -2.81349480e-01f, -9.59605396e-01f, 1.69967160e-01f, 9.85449731e-01f, 9.03590262e-01f, 4.28397775e-01f,
  9.90216017e-01f, 1.39543116e-01f, 9.99020159e-01f, 4.42574248e-02f, 9.99902010e-01f, 1.39995432e-02f, 9.99990225e-01f, 4.42717411e-03f,
  -7.59687901e-01f, 6.50287867e-01f, 3.10223512e-02f, -9.99518692e-01f, 7.07371980e-02f, 9.97494996e-01f, 8.89593601e-01f, 4.56752867e-01f,
  9.88771081e-01f, 1.49438128e-01f, 9.98875201e-01f, 4.74163815e-02f, 9.99887526e-01f, 1.49994381e-02f, 9.99988735e-01f, 4.74339863e-03f,
  -9.57659483e-01f, -2.87903309e-01f, 3.40318173e-01f, -9.40310359e-01f, -2.91995462e-02f, 9.99573588e-01f, 8.74707460e-01f, 4.84651238e-01f,
  9.87227261e-01f, 1.59318209e-01f, 9.98720288e-01f, 5.05748577e-02f, 9.99872029e-01f, 1.59993190e-02f, 9.99987185e-01f, 5.05962269e-03f,
  -2.75163352e-01f, -9.61397469e-01f, 6.15864813e-01f, -7.87851870e-01f, -1.28844544e-01f, 9.91664827e-01f, 8.58946681e-01f, 5.12064993e-01f,
  9.85584795e-01f, 1.69182345e-01f, 9.98555362e-01f, 5.37328273e-02f, 9.99855518e-01f, 1.69991814e-02f, 9.99985576e-01f, 5.37584582e-03f,
  6.60316706e-01f, -7.50987232e-01f, 8.30336154e-01f, -5.57262897e-01f, -2.27202162e-01f, 9.73847628e-01f, 8.42327058e-01f, 5.38966715e-01f,
  9.83843684e-01f, 1.79029569e-01f, 9.98380423e-01f, 5.68902642e-02f, 9.99837995e-01f, 1.79990288e-02f, 9.99983788e-01f, 5.69206895e-03f,
  9.88704622e-01f, 1.49877205e-01f, 9.62463796e-01f, -2.71410108e-01f, -3.23289543e-01f, 9.46300089e-01f, 8.24865162e-01f, 5.65329552e-01f,
  9.82004225e-01f, 1.88858896e-01f, 9.98195529e-01f, 6.00471310e-02f, 9.99819517e-01f, 1.89988576e-02f, 9.99981940e-01f, 6.00829115e-03f,
  4.08082068e-01f, 9.12945271e-01f, 9.99144375e-01f, 4.13582884e-02f, -4.16146845e-01f, 9.09297407e-01f, 8.06578457e-01f, 5.91127038e-01f,
  9.80066597e-01f, 1.98669314e-01f, 9.98000681e-01f, 6.32033944e-02f, 9.99800026e-01f, 1.99986678e-02f, 9.99979973e-01f, 6.32451288e-03f,
  -5.47729254e-01f, 8.36655617e-01f, 9.36740458e-01f, 3.50024760e-01f, -5.04846215e-01f, 8.63209307e-01f, 7.87485182e-01f, 6.16333544e-01f,
  9.78030920e-01f, 2.08459899e-01f, 9.97795820e-01f, 6.63590282e-02f, 9.99779522e-01f, 2.09984574e-02f, 9.99977946e-01f, 6.64073415e-03f,
  -9.99960840e-01f, -8.85130931e-03f, 7.81440377e-01f, 6.23979926e-01f, -5.88501155e-01f, 8.08496356e-01f, 7.67604589e-01f, 6.40923738e-01f,
  9.75897431e-01f, 2.18229622e-01f, 9.97581005e-01f, 6.95140064e-02f, 9.99758005e-01f, 2.19982266e-02f, 9.99975801e-01f, 6.95695449e-03f,
  -5.32833040e-01f, -8.46220434e-01f, 5.48645258e-01f, 8.36055279e-01f, -6.66275978e-01f, 7.45705247e-01f, 7.46956408e-01f, 6.64873064e-01f,
  9.73666370e-01f, 2.27977514e-01f, 9.97356176e-01f, 7.26682767e-02f, 9.99735534e-01f, 2.29979735e-02f, 9.99973536e-01f, 7.27317436e-03f,
  4.24179018e-01f, -9.05578375e-01f, 2.61441678e-01f, 9.65219259e-01f, -7.37393796e-01f, 6.75463140e-01f, 7.25561321e-01f, 6.88157499e-01f,
  9.71337974e-01f, 2.37702623e-01f, 9.97121394e-01f, 7.58218244e-02f, 9.99711990e-01f, 2.39976961e-02f, 9.99971211e-01f, 7.58939330e-03f,
  9.91202831e-01f, -1.32351756e-01f, -5.16893305e-02f, 9.98663187e-01f, -8.01143587e-01f, 5.98472118e-01f, 7.03440726e-01f, 7.10753918e-01f,
  9.68912423e-01f, 2.47403964e-01f, 9.96876657e-01f, 7.89746121e-02f, 9.99687493e-01f, 2.49973964e-02f, 9.99968767e-01f, 7.90561177e-03f,
  6.46919310e-01f, 7.62558460e-01f, -3.59694332e-01f, 9.33070183e-01f, -8.56888831e-01f, 5.15501261e-01f, 6.80616796e-01f, 7.32639611e-01f,
  9.66389954e-01f, 2.57080555e-01f, 9.96621907e-01f, 8.21266174e-02f, 9.99662042e-01f, 2.59970706e-02f, 9.99966204e-01f, 8.22182931e-03f,
  -2.92138815e-01f, 9.56375957e-01f, -6.32028639e-01f, 7.74945021e-01f, -9.04072165e-01f, 4.27379847e-01f, 6.57112300e-01f, 7.53792703e-01f,
  9.63770926e-01f, 2.66731411e-01f, 9.96357203e-01f, 8.52777958e-02f, 9.99635518e-01f, 2.69967206e-02f, 9.99963522e-01f, 8.53804592e-03f,
  -9.62605894e-01f, 2.70905793e-01f, -8.41684937e-01f, 5.39968967e-01f, -9.42222297e-01f, 3.34988207e-01f, 6.32950664e-01f, 7.74192095e-01f,
  9.61055458e-01f, 2.76355654e-01f, 9.96082544e-01f, 8.84281173e-02f, 9.99608040e-01f, 2.79963426e-02f, 9.99960780e-01f, 8.85426160e-03f,
  -7.48057544e-01f, -6.63633883e-01f, -9.67871487e-01f, 2.51445323e-01f, -9.70958173e-01f, 2.39249229e-01f, 6.08156204e-01f, 7.93817401e-01f,
  9.58243906e-01f, 2.85952210e-01f, 9.95797932e-01f, 9.15775672e-02f, 9.99579549e-01f, 2.89959367e-02f, 9.99957979e-01f, 9.17047635e-03f,
  1.54251456e-01f, -9.88031626e-01f, -9.98075247e-01f, -6.20148405e-02f, -9.89992499e-01f, 1.41120002e-01f, 5.82753658e-01f, 8.12648892e-01f,
  9.55336511e-01f, 2.95520186e-01f, 9.95503366e-01f, 9.47260931e-02f, 9.99550045e-01f, 2.99955010e-02f, 9.99954998e-01f, 9.48669016e-03f,
  9.14742351e-01f, -4.04037654e-01f, -9.29300308e-01f, -3.69325012e-01f, -9.99135137e-01f, 4.15805206e-02f, 5.56768358e-01f, 8.30667794e-01f,
  9.52333570e-01f, 3.05058628e-01f, 9.95198846e-01f, 9.78736654e-02f, 9.99519527e-01f, 3.09950355e-02f, 9.99951959e-01f, 9.80290305e-03f,
  8.34223390e-01f, 5.51426709e-01f, -7.68367112e-01f, -6.40009403e-01f, -9.98294771e-01f, -5.83741926e-02f, 5.30226350e-01f, 8.47856104e-01f,
  9.49235439e-01f, 3.14566553e-01f, 9.94884372e-01f, 1.01020269e-01f, 9.99488056e-01f, 3.19945402e-02f, 9.99948800e-01f, 1.01191159e-02f,
  -1.32767474e-02f, 9.99911845e-01f, -5.31235278e-01f, -8.47224355e-01f, -9.87479806e-01f, -1.57745644e-01f, 5.03154159e-01f, 8.64196658e-01f,
  9.46042359e-01f, 3.24043006e-01f, 9.94559944e-01f, 1.04165860e-01f, 9.99455571e-01f, 3.29940096e-02f, 9.99945521e-01f, 1.04353270e-02f,
  -8.48570287e-01f, 5.29082716e-01f, -2.41421118e-01f, -9.70420420e-01f, -9.66798186e-01f, -2.55541205e-01f, 4.75578904e-01f, 8.79673064e-01f,
  9.42754686e-01f, 3.33487093e-01f, 9.94225562e-01f, 1.07310407e-01f, 9.99422073e-01f, 3.39934528e-02f, 9.99942183e-01f, 1.07515370e-02f,
  -9.03692186e-01f, -4.28182662e-01f, 7.23346695e-02f, -9.97380435e-01f, -9.36456680e-01f, -3.50783229e-01f, 4.47528064e-01f, 8.94269884e-01f,
  9.39372718e-01f, 3.42897803e-01f, 9.93881226e-01f, 1.10453881e-01f, 9.99387562e-01f, 3.49928550e-02f, 9.99938726e-01f, 1.10677453e-02f,
  -1.27963692e-01f, -9.91778851e-01f, 3.78916174e-01f, -9.25431013e-01f, -8.96758378e-01f, -4.42520559e-01f, 4.19029742e-01f, 9.07972515e-01f,
  9.35896814e-01f, 3.52274209e-01f, 9.93526995e-01f, 1.13596253e-01f, 9.99352098e-01f, 3.59922275e-02f, 9.99935210e-01f, 1.13839535e-02f,
  7.65414059e-01f, -6.43538117e-01f, 6.47921681e-01f, -7.61706948e-01f, -8.48100007e-01f, -5.29836178e-01f, 3.90112430e-01f, 9.20767248e-01f,
  9.32327330e-01f, 3.61615449e-01f, 9.93162811e-01f, 1.16737492e-01f, 9.99315560e-01f, 3.69915590e-02f, 9.99931574e-01f, 1.17001599e-02f,
  9.55073655e-01f, 2.96368569e-01f, 8.52673113e-01f, -5.22444785e-01f, -7.90967762e-01f, -6.11857831e-01f, 3.60805035e-01f, 9.32641268e-01f,
  9.28664625e-01f, 3.70920479e-01f, 9.92788672e-01f, 1.19877554e-01f, 9.99278069e-01f, 3.79908569e-02f, 9.99927819e-01f, 1.20163653e-02f,
  2.66642928e-01f, 9.63795364e-01f, 9.72865343e-01f, -2.31372014e-01f, -7.25932240e-01f, -6.87766254e-01f, 3.31136853e-01f, 9.43582714e-01f,
  9.24909055e-01f, 3.80188406e-01f, 9.92404640e-01f, 1.23016424e-01f, 9.99239624e-01f, 3.89901139e-02f, 9.99923944e-01f, 1.23325698e-02f,
  -6.66938066e-01f, 7.45113134e-01f, 9.96578991e-01f, 8.26458037e-02f, -6.53643608e-01f, -7.56802499e-01f, 3.01137596e-01f, 9.53580678e-01f,
  9.21060979e-01f, 3.89418334e-01f, 9.92010653e-01f, 1.26154065e-01f, 9.99200106e-01f, 3.99893373e-02f, 9.99920011e-01f, 1.26487734e-02f,
  -9.87339258e-01f, -1.58622667e-01f, 9.21462357e-01f, 3.88467699e-01f, -5.74824035e-01f, -8.18277061e-01f, 2.70837069e-01f, 9.62625206e-01f,
  9.17120814e-01f, 3.98609310e-01f, 9.91606772e-01f, 1.29290432e-01f, 9.99159634e-01f, 4.09885161e-02f, 9.99915957e-01f, 1.29649751e-02f,
  -3.99985313e-01f, -9.16521549e-01f, 7.54965365e-01f, 6.55764699e-01f, -4.90260571e-01f, -8.71575892e-01f, 2.40265876e-01f, 9.70707119e-01f,
  9.13088918e-01f, 4.07760441e-01f, 9.91192937e-01f, 1.32425532e-01f, 9.99118149e-01f, 4.19876575e-02f, 9.99911785e-01f, 1.32811759e-02f,
  5.55113316e-01f, -8.31774771e-01f, 5.13598442e-01f, 8.58030677e-01f, -4.00799006e-01f, -9.16166008e-01f, 2.09454417e-01f, 9.77818429e-01f,
  9.08965766e-01f, 4.16870773e-01f, 9.90769207e-01f, 1.35559291e-01f, 9.99075651e-01f, 4.29867506e-02f, 9.99907553e-01f, 1.35973748e-02f,
  9.99843299e-01f, 1.77019257e-02f, 2.21298173e-01f, 9.75206196e-01f, -3.07332784e-01f, -9.51602101e-01f, 1.78433523e-01f, 9.83951986e-01f,
  9.04751658e-01f, 4.25939471e-01f, 9.90335584e-01f, 1.38691694e-01f, 9.99032140e-01f, 4.39858064e-02f, 9.99903202e-01f, 1.39135728e-02f,
  5.25321960e-01f, 8.50903511e-01f, -9.29481089e-02f, 9.95670974e-01f, -2.10795805e-01f, -9.77530122e-01f, 1.47234216e-01f, 9.89101648e-01f,
  9.00447130e-01f, 4.34965521e-01f, 9.89892066e-01f, 1.41822711e-01f, 9.98987675e-01f, 4.49848175e-02f, 9.99898732e-01f, 1.42297689e-02f,
  -4.32177931e-01f, 9.01788354e-01f, -3.97976756e-01f, 9.17395473e-01f, -1.12152621e-01f, -9.93690968e-01f, 1.15887694e-01f, 9.93262351e-01f,
  8.96052480e-01f, 4.43948090e-01f, 9.89438653e-01f, 1.44952312e-01f, 9.98942196e-01f, 4.59837839e-02f, 9.99894202e-01f, 1.45459641e-02f,
  -9.92335498e-01f, 1.23573124e-01f, -6.63538277e-01f, 7.48142362e-01f, -1.23883775e-02f, -9.99923289e-01f, 8.44252855e-02f, 9.96429801e-01f,
  8.91568303e-01f, 4.52886283e-01f, 9.88975346e-01f, 1.48080453e-01f, 9.98895705e-01f, 4.69827019e-02f, 9.99889553e-01f, 1.48621574e-02f,
  -6.40144348e-01f, -7.68254638e-01f, -8.63296509e-01f, 5.04697084e-01f, 8.74991715e-02f, -9.96164620e-01f, 5.28784581e-02f, 9.98600960e-01f,
  8.86994898e-01f, 4.61779177e-01f, 9.88502085e-01f, 1.51207119e-01f, 9.98848200e-01f, 4.79815714e-02f, 9.99884784e-01f, 1.51783489e-02f,
  3.00592542e-01f, -9.53752637e-01f, -9.77442741e-01f, 2.11200655e-01f, 1.86512470e-01f, -9.82452571e-01f, 2.12787576e-02f, 9.99773562e-01f,
  8.82332861e-01f, 4.70625877e-01f, 9.88018990e-01f, 1.54332280e-01f, 9.98799741e-01f, 4.89803962e-02f, 9.99879956e-01f, 1.54945394e-02f,
  9.64965999e-01f, -2.62374848e-01f, -9.94656444e-01f, -1.03240460e-01f, 2.83662200e-01f, -9.58924294e-01f, -1.03422189e-02f, 9.99946535e-01f,
  8.77582550e-01f, 4.79425550e-01f, 9.87526000e-01f, 1.57455891e-01f, 9.98750269e-01f, 4.99791689e-02f, 9.99875009e-01f, 1.58107281e-02f,
  7.42154181e-01f, 6.70229197e-01f, -9.13230121e-01f, -4.07444149e-01f, 3.77977669e-01f, -9.25814748e-01f, -4.19528559e-02f, 9.99119580e-01f,
  8.72744501e-01f, 4.88177240e-01f, 9.87023175e-01f, 1.60577938e-01f, 9.98699784e-01f, 5.09778969e-02f, 9.99869943e-01f, 1.61269177e-02f,
  -1.62990779e-01f, 9.86627579e-01f, -7.41239965e-01f, -6.71240151e-01f, 4.68516916e-01f, -8.83454502e-01f, -7.35215396e-02f, 9.97293651e-01f,
  8.67819190e-01f, 4.96880114e-01f, 9.86510456e-01f, 1.63698375e-01f, 9.98648286e-01f, 5.19765690e-02f, 9.99864817e-01f, 1.64431017e-02f,
  -9.18282807e-01f, 3.95925164e-01f, -4.95741814e-01f, -8.68469954e-01f, 5.54374516e-01f, -8.32267344e-01f, -1.05016708e-01f, 9.94470477e-01f,
  8.62807095e-01f, 5.05533338e-01f, 9.85987842e-01f, 1.66817173e-01f, 9.98595834e-01f, 5.29751927e-02f, 9.99859571e-01f, 1.67592876e-02f,
  -8.29309821e-01f, -5.58789074e-01f, -2.01079622e-01f, -9.79574919e-01f, 6.34692967e-01f, -7.72764444e-01f, -1.36406869e-01f, 9.90652919e-01f,
  8.57708693e-01f, 5.14135957e-01f, 9.85455394e-01f, 1.69934288e-01f, 9.98542368e-01f, 5.39737605e-02f, 9.99854207e-01f, 1.70754679e-02f,
  2.21267566e-02f, -9.99755144e-01f, 1.13521777e-01f, -9.93535519e-01f, 7.08669782e-01f, -7.05540299e-01f, -1.67660639e-01f, 9.85844791e-01f,
  8.52524519e-01f, 5.22687256e-01f, 9.84913111e-01f, 1.73049718e-01f, 9.98487890e-01f, 5.49722798e-02f, 9.99848783e-01f, 1.73916500e-02f,
  8.53220105e-01f, -5.21551013e-01f, 4.16867077e-01f, -9.08967435e-01f, 7.75565803e-01f, -6.31266713e-01f, -1.98746875e-01f, 9.80050862e-01f,
  8.47255111e-01f, 5.31186223e-01f, 9.84360933e-01f, 1.76163420e-01f, 9.98432398e-01f, 5.59707358e-02f, 9.99843180e-01f, 1.77078284e-02f,
  8.99866819e-01f, 4.36164767e-01f, 6.78870201e-01f, -7.34258294e-01f, 8.34712923e-01f, -5.50685287e-01f, -2.29634270e-01f, 9.73276973e-01f,
  8.41901004e-01f, 5.39632022e-01f, 9.83798921e-01f, 1.79275364e-01f, 9.98375952e-01f, 5.69691435e-02f, 9.99837577e-01f, 1.80240069e-02f,
  1.19180135e-01f, 9.92872655e-01f, 8.73550534e-01f, -4.86733496e-01f, 8.85519624e-01f, -4.64602023e-01f, -2.60292053e-01f, 9.65529919e-01f,
  8.36462677e-01f, 5.48023939e-01f, 9.83227074e-01f, 1.82385504e-01f, 9.98318493e-01f, 5.79674877e-02f, 9.99831796e-01f, 1.83401816e-02f,
  -7.71080196e-01f, 6.36738002e-01f, 9.81602073e-01f, -1.90938011e-01f, 9.27478492e-01f, -3.73876572e-01f, -2.90689558e-01f, 9.56817448e-01f,
  8.30940723e-01f, 5.56361020e-01f, 9.82645452e-01f, 1.85493827e-01f, 9.98260021e-01f, 5.89657798e-02f, 9.99825954e-01f, 1.86563563e-02f,
  -9.52412963e-01f, -3.04810613e-01f, 9.92308319e-01f, 1.23790950e-01f, 9.60170269e-01f, -2.79415488e-01f, -3.20796400e-01f, 9.47148204e-01f,
  8.25335622e-01f, 5.64642429e-01f, 9.82053936e-01f, 1.88600287e-01f, 9.98200536e-01f, 5.99640086e-02f, 9.99819994e-01f, 1.89725272e-02f,
  -2.58101642e-01f, -9.66117799e-01f, 9.04607594e-01f, 4.26245421e-01f, 9.83268440e-01f, -1.82162598e-01f, -3.50582451e-01f, 9.36531842e-01f,
  8.19648027e-01f, 5.72867453e-01f, 9.81452644e-01f, 1.91704854e-01f, 9.98140097e-01f, 6.09621815e-02f, 9.99813974e-01f, 1.92886982e-02f,
  6.73507154e-01f, -7.39180684e-01f, 7.27198064e-01f, 6.86427653e-01f, 9.96542096e-01f, -8.30891207e-02f, -3.80017966e-01f, 9.24979091e-01f,
  8.13878477e-01f, 5.81035137e-01f, 9.80841517e-01f, 1.94807529e-01f, 9.98078644e-01f, 6.19602874e-02f, 9.99807835e-01f, 1.96048655e-02f,
  9.85896587e-01f, 1.67355701e-01f, 4.77671444e-01f, 8.78538549e-01f, 9.99858618e-01f, 1.68140903e-02f, -4.09073502e-01f, 9.12501454e-01f,
  8.08027506e-01f, 5.89144766e-01f, 9.80220556e-01f, 1.97908238e-01f, 9.98016179e-01f, 6.29583374e-02f, 9.99801576e-01f, 1.99210308e-02f,
};
__device__ const float TAB_S[2048] = {
  1.00000000e+00f, 0.00000000e+00f, 1.00000000e+00f, 0.00000000e+00f, 1.00000000e+00f, 0.00000000e+00f, 1.00000000e+00f, 0.00000000e+00f,
  1.00000000e+00f, 0.00000000e+00f, 1.00000000e+00f, 0.00000000e+00f, 1.00000000e+00f, 0.00000000e+00f, 1.00000000e+00f, 0.00000000e+00f,
  1.00000000e+00f, 0.00000000e+00f, 1.00000000e+00f, 0.00000000e+00f, 1.00000000e+00f, 0.00000000e+00f, 1.00000000e+00f, 0.00000000e+00f,
  1.00000000e+00f, 0.00000000e+00f, 1.00000000e+00f, 0.00000000e+00f, 1.00000000e+00f, 0.00000000e+00f, 1.00000000e+00f, 0.00000000e+00f,
  5.40302277e-01f, 8.41470957e-01f, 8.46009135e-01f, 5.33168435e-01f, 9.50415254e-01f, 3.10983598e-01f, 9.84230220e-01f, 1.76892191e-01f,
  9.95004177e-01f, 9.98334214e-02f, 9.98419285e-01f, 5.62044978e-02f, 9.99500036e-01f, 3.16175036e-02f, 9.99841869e-01f, 1.77818574e-02f,
  9.99949992e-01f, 9.99983307e-03f, 9.99984205e-01f, 5.62338345e-03f, 9.99994993e-01f, 3.16227227e-03f, 9.99998391e-01f, 1.77827850e-03f,
  9.99999523e-01f, 9.99999931e-04f, 9.99999821e-01f, 5.62341243e-04f, 9.99999940e-01f, 3.16227757e-04f, 1.00000000e+00f, 1.77827940e-04f,
  -4.16146845e-01f, 9.09297407e-01f, 4.31462824e-01f, 9.02130723e-01f, 8.06578398e-01f, 5.91127098e-01f, 9.37418282e-01f, 3.48205268e-01f,
  9.80066597e-01f, 1.98669329e-01f, 9.93682086e-01f, 1.12231314e-01f, 9.98000681e-01f, 6.32033944e-02f, 9.99367595e-01f, 3.55580896e-02f,
  9.99800026e-01f, 1.99986659e-02f, 9.99936759e-01f, 1.12465890e-02f, 9.99979973e-01f, 6.32451288e-03f, 9.99993682e-01f, 3.55655141e-03f,
  9.99997973e-01f, 1.99999870e-03f, 9.99999344e-01f, 1.12468237e-03f, 9.99999821e-01f, 6.32455456e-04f, 9.99999940e-01f, 3.55655880e-04f,
  -9.89992499e-01f, 1.41120002e-01f, -1.15966164e-01f, 9.93253171e-01f, 5.82753658e-01f, 8.12648892e-01f, 8.61040652e-01f, 5.08536100e-01f,
  9.55336511e-01f, 2.95520216e-01f, 9.85803485e-01f, 1.67903304e-01f, 9.95503366e-01f, 9.47260857e-02f, 9.98577297e-01f, 5.33230826e-02f,
  9.99550045e-01f, 2.99954992e-02f, 9.99857724e-01f, 1.68694388e-02f, 9.99954998e-01f, 9.48669016e-03f, 9.99985754e-01f, 5.33481315e-03f,
  9.99995530e-01f, 2.99999560e-03f, 9.99998569e-01f, 1.68702309e-03f, 9.99999523e-01f, 9.48683126e-04f, 9.99999881e-01f, 5.33483806e-04f,
  -6.53643608e-01f, -7.56802499e-01f, -6.27679706e-01f, 7.78471708e-01f, 3.01137477e-01f, 9.53580737e-01f, 7.57506192e-01f, 6.52827978e-01f,
  9.21060979e-01f, 3.89418334e-01f, 9.74808276e-01f, 2.23044485e-01f, 9.92010653e-01f, 1.26154065e-01f, 9.97471273e-01f, 7.10712075e-02f,
  9.99200106e-01f, 3.99893336e-02f, 9.99747038e-01f, 2.24917568e-02f, 9.99920011e-01f, 1.26487734e-02f, 9.99974728e-01f, 7.11305765e-03f,
  9.99992013e-01f, 3.99998948e-03f, 9.99997497e-01f, 2.24936334e-03f, 9.99999225e-01f, 1.26491068e-03f, 9.99999762e-01f, 7.11311703e-04f,
  2.83662200e-01f, -9.58924294e-01f, -9.46079254e-01f, 3.23935270e-01f, -1.03423381e-02f, 9.99946535e-01f, 6.30080283e-01f, 7.76529968e-01f,
  8.77582550e-01f, 4.79425550e-01f, 9.60731268e-01f, 2.77480543e-01f, 9.87526000e-01f, 1.57455876e-01f, 9.96049762e-01f, 8.87968615e-02f,
  9.98750269e-01f, 4.99791652e-02f, 9.99604762e-01f, 2.81133614e-02f, 9.99875009e-01f, 1.58107281e-02f, 9.99960482e-01f, 8.89127981e-03f,
  9.99987483e-01f, 4.99997940e-03f, 9.99996066e-01f, 2.81170290e-03f, 9.99998748e-01f, 1.58113812e-03f, 9.99999583e-01f, 8.89139599e-04f,
  9.60170269e-01f, -2.79415488e-01f, -9.73103702e-01f, -2.30367512e-01f, -3.20796400e-01f, 9.47148204e-01f, 4.82782036e-01f, 8.75740528e-01f,
  8.25335622e-01f, 5.64642489e-01f, 9.43616986e-01f, 3.31039310e-01f, 9.82053936e-01f, 1.88600272e-01f, 9.94313300e-01f, 1.06494442e-01f,
  9.98200536e-01f, 5.99640049e-02f, 9.99430835e-01f, 3.37340795e-02f, 9.99819994e-01f, 1.89725272e-02f, 9.99943078e-01f, 1.06694745e-02f,
  9.99981999e-01f, 5.99996420e-03f, 9.99994338e-01f, 3.37404152e-03f, 9.99998212e-01f, 1.89736532e-03f, 9.99999404e-01f, 1.06696738e-03f,
  7.53902256e-01f, 6.56986594e-01f, -7.00429797e-01f, -7.13721275e-01f, -5.99437475e-01f, 8.00421596e-01f, 3.20257008e-01f, 9.47330713e-01f,
  7.64842212e-01f, 6.44217670e-01f, 9.23519433e-01f, 3.83551568e-01f, 9.75599885e-01f, 2.19556093e-01f, 9.92262423e-01f, 1.24158338e-01f,
  9.97551024e-01f, 6.99428469e-02f, 9.99225318e-01f, 3.93537246e-02f, 9.99755025e-01f, 2.21341345e-02f, 9.99922514e-01f, 1.24476347e-02f,
  9.99975502e-01f, 6.99994294e-03f, 9.99992251e-01f, 3.93637875e-03f, 9.99997556e-01f, 2.21359241e-03f, 9.99999225e-01f, 1.24479528e-03f,
  -1.45500034e-01f, 9.89358246e-01f, -2.12036446e-01f, -9.77261782e-01f, -8.18632424e-01f, 5.74317753e-01f, 1.47631213e-01f, 9.89042461e-01f,
  6.96706712e-01f, 7.17356086e-01f, 9.00502324e-01f, 4.34851229e-01f, 9.68170285e-01f, 2.50292331e-01f, 9.89897788e-01f, 1.41782969e-01f,
  9.96801734e-01f, 7.99146891e-02f, 9.98988271e-01f, 4.49721329e-02f, 9.99680042e-01f, 2.52955221e-02f, 9.99898791e-01f, 1.42257558e-02f,
  9.99967992e-01f, 7.99991470e-03f, 9.99989867e-01f, 4.49871505e-03f, 9.99996781e-01f, 2.52981926e-03f, 9.99998987e-01f, 1.42262306e-03f,
  -9.11130250e-01f, 4.12118495e-01f, 3.41660261e-01f, -9.39823508e-01f, -9.56644177e-01f, 2.91259229e-01f, -2.96507962e-02f, 9.99560297e-01f,
  6.21609926e-01f, 7.83326924e-01f, 8.74638259e-01f, 4.84776139e-01f, 9.59772646e-01f, 2.80778319e-01f, 9.87220109e-01f, 1.59362778e-01f,
  9.95952725e-01f, 8.98785442e-02f, 9.98719573e-01f, 5.05891182e-02f, 9.99595046e-01f, 2.84566563e-02f, 9.99871910e-01f, 1.60038304e-02f,
  9.99959528e-01f, 8.99987947e-03f, 9.99987185e-01f, 5.06105041e-03f, 9.99995947e-01f, 2.84604589e-03f, 9.99998748e-01f, 1.60045072e-03f,
  -8.39071512e-01f, -5.44021130e-01f, 7.90131867e-01f, -6.12936914e-01f, -9.99786079e-01f, -2.06835698e-02f, -2.05997631e-01f, 9.78552461e-01f,
  5.40302277e-01f, 8.41470957e-01f, 8.46009135e-01f, 5.33168435e-01f, 9.50415313e-01f, 3.10983568e-01f, 9.84230220e-01f, 1.76892191e-01f,
  9.95004177e-01f, 9.98334140e-02f, 9.98419285e-01f, 5.62044978e-02f, 9.99500036e-01f, 3.16175036e-02f, 9.99841869e-01f, 1.77818574e-02f,
  9.99949992e-01f, 9.99983400e-03f, 9.99984205e-01f, 5.62338345e-03f, 9.99994993e-01f, 3.16227227e-03f, 9.99998391e-01f, 1.77827850e-03f,
  4.42569796e-03f, -9.99990225e-01f, 9.95257378e-01f, -9.72764567e-02f, -9.43779767e-01f, -3.30574960e-01f, -3.75847399e-01f, 9.26681578e-01f,
  4.53596085e-01f, 8.91207397e-01f, 8.14705312e-01f, 5.79875171e-01f, 9.40107584e-01f, 3.40877861e-01f, 9.80929136e-01f, 1.94365650e-01f,
  9.93956089e-01f, 1.09778300e-01f, 9.98087406e-01f, 6.18181042e-02f, 9.99395072e-01f, 3.47780399e-02f, 9.99808669e-01f, 1.95598267e-02f,
  9.99939501e-01f, 1.09997792e-02f, 9.99980867e-01f, 6.18571462e-03f, 9.99993920e-01f, 3.47849843e-03f, 9.99998093e-01f, 1.95610616e-03f,
  8.43853951e-01f, -5.36572933e-01f, 8.93861592e-01f, 4.48342979e-01f, -7.94179380e-01f, -6.07683420e-01f, -5.33843040e-01f, 8.45583618e-01f,
  3.62357706e-01f, 9.32039082e-01f, 7.80825913e-01f, 6.24748647e-01f, 9.28859890e-01f, 3.70431304e-01f, 9.77317870e-01f, 2.11777672e-01f,
  9.92808640e-01f, 1.19712204e-01f, 9.97723997e-01f, 6.74297586e-02f, 9.99280095e-01f, 3.79382223e-02f, 9.99772310e-01f, 2.13377345e-02f,
  9.99927998e-01f, 1.19997123e-02f, 9.99977231e-01f, 6.74804440e-03f, 9.99992788e-01f, 3.79472389e-03f, 9.99997735e-01f, 2.13393359e-03f,
  9.07446802e-01f, 4.20167029e-01f, 5.17172873e-01f, 8.55880976e-01f, -5.65820515e-01f, -8.24528456e-01f, -6.75001681e-01f, 7.37816215e-01f,
  2.67498761e-01f, 9.63558197e-01f, 7.44477987e-01f, 6.67647004e-01f, 9.16683376e-01f, 3.99614304e-01f, 9.73397553e-01f, 2.29122713e-01f,
  9.91561890e-01f, 1.29634142e-01f, 9.97329056e-01f, 7.30392784e-02f, 9.99155104e-01f, 4.10980321e-02f, 9.99732792e-01f, 2.31155735e-02f,
  9.99915481e-01f, 1.29996343e-02f, 9.99973297e-01f, 7.31037185e-03f, 9.99991536e-01f, 4.11094911e-03f, 9.99997318e-01f, 2.31176103e-03f,
  1.36737213e-01f, 9.90607381e-01f, -1.87961515e-02f, 9.99823332e-01f, -2.81349480e-01f, -9.59605396e-01f, -7.94870913e-01f, 6.06778562e-01f,
  1.69967160e-01f, 9.85449731e-01f, 7.05776393e-01f, 7.08434701e-01f, 9.03590262e-01f, 4.28397775e-01f, 9.69169438e-01f, 2.46395305e-01f,
  9.90216017e-01f, 1.39543116e-01f, 9.96902585e-01f, 7.86464810e-02f, 9.99020159e-01f, 4.42574248e-02f, 9.99690115e-01f, 2.48933397e-02f,
  9.99902010e-01f, 1.39995432e-02f, 9.99969006e-01f, 7.87269697e-03f, 9.99990225e-01f, 4.42717411e-03f, 9.99996901e-01f, 2.48958869e-03f,
  -7.59687901e-01f, 6.50287867e-01f, -5.48975468e-01f, 8.35838437e-01f, 3.10223512e-02f, -9.99518692e-01f, -8.89670432e-01f, 4.56603259e-01f,
  7.07371980e-02f, 9.97494996e-01f, 6.64843500e-01f, 7.46982634e-01f, 8.89593601e-01f, 4.56752867e-01f, 9.64634836e-01f, 2.63589978e-01f,
  9.88771081e-01f, 1.49438128e-01f, 9.96444523e-01f, 8.42512026e-02f, 9.98875201e-01f, 4.74163815e-02f, 9.99644279e-01f, 2.66710296e-02f,
  9.99887526e-01f, 1.49994381e-02f, 9.99964416e-01f, 8.43502022e-03f, 9.99988735e-01f, 4.74339863e-03f, 9.99996424e-01f, 2.66741589e-03f,
  -9.57659483e-01f, -2.87903309e-01f, -9.10081089e-01f, 4.14430231e-01f, 3.40318173e-01f, -9.40310359e-01f, -9.56410050e-01f, 2.92027086e-01f,
  -2.91995462e-02f, 9.99573588e-01f, 6.21808827e-01f, 7.83169091e-01f, 8.74707460e-01f, 4.84651238e-01f, 9.59795177e-01f, 2.80701309e-01f,
  9.87227261e-01f, 1.59318209e-01f, 9.95954990e-01f, 8.98532644e-02f, 9.98720288e-01f, 5.05748577e-02f, 9.99595284e-01f, 2.84486320e-02f,
  9.99872029e-01f, 1.59993190e-02f, 9.99959528e-01f, 8.99733976e-03f, 9.99987185e-01f, 5.05962269e-03f, 9.99995947e-01f, 2.84524332e-03f,
  -2.75163352e-01f, -9.61397469e-01f, -9.90897954e-01f, -1.34615138e-01f, 6.15864813e-01f, -7.87851870e-01f, -9.92985010e-01f, 1.18240520e-01f,
  -1.28844544e-01f, 9.91664827e-01f, 5.76808274e-01f, 8.16879570e-01f, 8.58946681e-01f, 5.12064993e-01f, 9.54652011e-01f, 2.97723860e-01f,
  9.85584795e-01f, 1.69182345e-01f, 9.95433986e-01f, 9.54524800e-02f, 9.98555362e-01f, 5.37328273e-02f, 9.99543071e-01f, 3.02261449e-02f,
  9.99855518e-01f, 1.69991814e-02f, 9.99954283e-01f, 9.55965649e-03f, 9.99985576e-01f, 5.37584582e-03f, 9.99995410e-01f, 3.02307028e-03f,
  6.60316706e-01f, -7.50987232e-01f, -7.66536534e-01f, -6.42200708e-01f, 8.30336154e-01f, -5.57262897e-01f, -9.98241663e-01f, -5.92755191e-02f,
  -2.27202162e-01f, 9.73847628e-01f, 5.29984176e-01f, 8.48007560e-01f, 8.42327058e-01f, 5.38966715e-01f, 9.49207008e-01f, 3.14652264e-01f,
  9.83843684e-01f, 1.79029569e-01f, 9.94881511e-01f, 1.01048686e-01f, 9.98380423e-01f, 5.68902642e-02f, 9.99487758e-01f, 3.20035629e-02f,
  9.99837995e-01f, 1.79990288e-02f, 9.99948800e-01f, 1.01219704e-02f, 9.99983788e-01f, 5.69206895e-03f, 9.99994874e-01f, 3.20089748e-03f,
  9.88704622e-01f, 1.49877205e-01f, -3.06095392e-01f, -9.52000856e-01f, 9.62463796e-01f, -2.71410108e-01f, -9.72014248e-01f, -2.34921798e-01f,
  -3.23289543e-01f, 9.46300089e-01f, 4.81484592e-01f, 8.76454532e-01f, 8.24865162e-01f, 5.65329552e-01f, 9.43461835e-01f, 3.31481189e-01f,
  9.82004225e-01f, 1.88858896e-01f, 9.94297504e-01f, 1.06641680e-01f, 9.98195529e-01f, 6.00471310e-02f, 9.99429286e-01f, 3.37808803e-02f,
  9.99819517e-01f, 1.89988576e-02f, 9.99942899e-01f, 1.06842816e-02f, 9.99981940e-01f, 6.00829115e-03f, 9.99994278e-01f, 3.37872445e-03f,
  4.08082068e-01f, 9.12945271e-01f, 2.48616725e-01f, -9.68601942e-01f, 9.99144375e-01f, 4.13582884e-02f, -9.15129960e-01f, -4.03158993e-01f,
  -4.16146845e-01f, 9.09297407e-01f, 4.31462824e-01f, 9.02130723e-01f, 8.06578457e-01f, 5.91127038e-01f, 9.37418282e-01f, 3.48205268e-01f,
  9.80066597e-01f, 1.98669314e-01f, 9.93682086e-01f, 1.12231314e-01f, 9.98000681e-01f, 6.32033944e-02f, 9.99367595e-01f, 3.55580896e-02f,
  9.99800026e-01f, 1.99986678e-02f, 9.99936759e-01f, 1.12465890e-02f, 9.99979973e-01f, 6.32451288e-03f, 9.99993682e-01f, 3.55655141e-03f,
  -5.47729254e-01f, 8.36655617e-01f, 7.26760268e-01f, -6.86891198e-01f, 9.36740458e-01f, 3.50024760e-01f, -8.29382956e-01f, -5.58680534e-01f,
  -5.04846215e-01f, 8.63209307e-01f, 3.80077004e-01f, 9.24954832e-01f, 7.87485182e-01f, 6.16333544e-01f, 9.31078374e-01f, 3.64819258e-01f,
  9.78030920e-01f, 2.08459899e-01f, 9.93035257e-01f, 1.17817394e-01f, 9.97795820e-01f, 6.63590282e-02f, 9.99302804e-01f, 3.73351872e-02f,
  9.99779522e-01f, 2.09984574e-02f, 9.99930263e-01f, 1.18088927e-02f, 9.99977946e-01f, 6.64073415e-03f, 9.99993026e-01f, 3.73437814e-03f,
  -9.99960840e-01f, -8.85130931e-03f, 9.81074572e-01f, -1.93630233e-01f, 7.81440377e-01f, 6.23979926e-01f, -7.17477441e-01f, -6.96581721e-01f,
  -5.88501155e-01f, 8.08496356e-01f, 3.27489585e-01f, 9.44854796e-01f, 7.67604589e-01f, 6.40923738e-01f, 9.24443960e-01f, 3.81317884e-01f,
  9.75897431e-01f, 2.18229622e-01f, 9.92357016e-01f, 1.23399742e-01f, 9.97581005e-01f, 6.95140064e-02f, 9.99234855e-01f, 3.91121693e-02f,
  9.99758005e-01f, 2.19982266e-02f, 9.99923468e-01f, 1.23711927e-02f, 9.99975801e-01f, 6.95695449e-03f, 9.99992371e-01f, 3.91220488e-03f,
  -5.32833040e-01f, -8.46220434e-01f, 9.33235765e-01f, 3.59264523e-01f, 5.48645258e-01f, 8.36055279e-01f, -5.82943261e-01f, -8.12512875e-01f,
  -6.66275978e-01f, 7.45705247e-01f, 2.73866832e-01f, 9.61767614e-01f, 7.46956408e-01f, 6.64873064e-01f, 9.17517304e-01f, 3.97695929e-01f,
  9.73666370e-01f, 2.27977514e-01f, 9.91647422e-01f, 1.28978193e-01f, 9.97356176e-01f, 7.26682767e-02f, 9.99163687e-01f, 4.08890247e-02f,
  9.99735534e-01f, 2.29979735e-02f, 9.99916375e-01f, 1.29334899e-02f, 9.99973536e-01f, 7.27317436e-03f, 9.99991655e-01f, 4.09003161e-03f,
  4.24179018e-01f, -9.05578375e-01f, 5.97977161e-01f, 8.01513135e-01f, 2.61441678e-01f, 9.65219259e-01f, -4.30023283e-01f, -9.02817786e-01f,
  -7.37393796e-01f, 6.75463140e-01f, 2.19378278e-01f, 9.75639880e-01f, 7.25561321e-01f, 6.88157499e-01f, 9.10300434e-01f, 4.13948208e-01f,
  9.71337974e-01f, 2.37702623e-01f, 9.90906477e-01f, 1.34552568e-01f, 9.97121394e-01f, 7.58218244e-02f, 9.99089420e-01f, 4.26657498e-02f,
  9.99711990e-01f, 2.39976961e-02f, 9.99908924e-01f, 1.34957815e-02f, 9.99971211e-01f, 7.58939330e-03f, 9.99990880e-01f, 4.26785741e-03f,
  9.91202831e-01f, -1.32351756e-01f, 7.85522610e-02f, 9.96909976e-01f, -5.16893305e-02f, 9.98663187e-01f, -2.63540596e-01f, -9.64648306e-01f,
  -8.01143587e-01f, 5.98472118e-01f, 1.64196163e-01f, 9.86427724e-01f, 7.03440726e-01f, 7.10753918e-01f, 9.02795732e-01f, 4.30069596e-01f,
  9.68912423e-01f, 2.47403964e-01f, 9.90134120e-01f, 1.40122697e-01f, 9.96876657e-01f, 7.89746121e-02f, 9.99011934e-01f, 4.44423407e-02f,
  9.99687493e-01f, 2.49973964e-02f, 9.99901175e-01f, 1.40580693e-02f, 9.99968767e-01f, 7.90561177e-03f, 9.99990106e-01f, 4.44568414e-03f,
  6.46919310e-01f, 7.62558460e-01f, -4.65064496e-01f, 8.85276794e-01f, -3.59694332e-01f, 9.33070183e-01f, -8.87455046e-02f, -9.96054351e-01f,
  -8.56888831e-01f, 5.15501261e-01f, 1.08494945e-01f, 9.94096994e-01f, 6.80616796e-01f, 7.32639611e-01f, 8.95005584e-01f, 4.46054995e-01f,
  9.66389954e-01f, 2.57080555e-01f, 9.89330530e-01f, 1.45688385e-01f, 9.96621907e-01f, 8.21266174e-02f, 9.98931348e-01f, 4.62187938e-02f,
  9.99662042e-01f, 2.59970706e-02f, 9.99893129e-01f, 1.46203535e-02f, 9.99966204e-01f, 8.22182931e-03f, 9.99989331e-01f, 4.62350994e-03f,
  -2.92138815e-01f, 9.56375957e-01f, -8.65450621e-01f, 5.00994205e-01f, -6.32028639e-01f, 7.74945021e-01f, 8.88481140e-02f, -9.96045172e-01f,
  -9.04072165e-01f, 4.27379847e-01f, 5.24506159e-02f, 9.98623490e-01f, 6.57112300e-01f, 7.53792703e-01f, 8.86932373e-01f, 4.61899310e-01f,
  9.63770926e-01f, 2.66731411e-01f, 9.88495648e-01f, 1.51249468e-01f, 9.96357203e-01f, 8.52777958e-02f, 9.98847544e-01f, 4.79951017e-02f,
  9.99635518e-01f, 2.69967206e-02f, 9.99884725e-01f, 1.51826320e-02f, 9.99963522e-01f, 8.53804592e-03f, 9.99988496e-01f, 4.80133574e-03f,
  -9.62605894e-01f, 2.70905793e-01f, -9.99293387e-01f, -3.75856608e-02f, -8.41684937e-01f, 5.39968967e-01f, 2.63639510e-01f, -9.64621305e-01f,
  -9.42222297e-01f, 3.34988207e-01f, -3.75941908e-03f, 9.99992907e-01f, 6.32950664e-01f, 7.74192095e-01f, 8.78578722e-01f, 4.77597594e-01f,
  9.61055458e-01f, 2.76355654e-01f, 9.87629473e-01f, 1.56805754e-01f, 9.96082544e-01f, 8.84281173e-02f, 9.98760641e-01f, 4.97712530e-02f,
  9.99608040e-01f, 2.79963426e-02f, 9.99876022e-01f, 1.57449059e-02f, 9.99960780e-01f, 8.85426160e-03f, 9.99987602e-01f, 4.97916201e-03f,
  -7.48057544e-01f, -6.63633883e-01f, -8.25371623e-01f, -5.64589798e-01f, -9.67871487e-01f, 2.51445323e-01f, 4.30115849e-01f, -9.02773678e-01f,
  -9.70958173e-01f, 2.39249229e-01f, -5.99575676e-02f, 9.98200953e-01f, 6.08156204e-01f, 7.93817401e-01f, 8.69947195e-01f, 4.93144840e-01f,
  9.58243906e-01f, 2.85952210e-01f, 9.86732066e-01f, 1.62357092e-01f, 9.95797932e-01f, 9.15775672e-02f, 9.98670578e-01f, 5.15472479e-02f,
  9.99579549e-01f, 2.89959367e-02f, 9.99867022e-01f, 1.63071752e-02f, 9.99957979e-01f, 9.17047635e-03f, 9.99986708e-01f, 5.15698735e-03f,
  1.54251456e-01f, -9.88031626e-01f, -3.97251874e-01f, -9.17709649e-01f, -9.98075247e-01f, -6.20148405e-02f, 5.83026946e-01f, -8.12452853e-01f,
  -9.89992499e-01f, 1.41120002e-01f, -1.15966164e-01f, 9.93253171e-01f, 5.82753658e-01f, 8.12648892e-01f, 8.61040652e-01f, 5.08536100e-01f,
  9.55336511e-01f, 2.95520186e-01f, 9.85803485e-01f, 1.67903304e-01f, 9.95503366e-01f, 9.47260931e-02f, 9.98577297e-01f, 5.33230826e-02f,
  9.99550045e-01f, 2.99955010e-02f, 9.99857724e-01f, 1.68694388e-02f, 9.99954998e-01f, 9.48669016e-03f, 9.99985754e-01f, 5.33481315e-03f,
  9.14742351e-01f, -4.04037654e-01f, 1.53215483e-01f, -9.88192797e-01f, -9.29300308e-01f, -3.69325012e-01f, 7.17549205e-01f, -6.96507812e-01f,
  -9.99135137e-01f, 4.15805206e-02f, -1.71608135e-01f, 9.85165298e-01f, 5.56768358e-01f, 8.30667794e-01f, 8.51861775e-01f, 5.23766637e-01f,
  9.52333570e-01f, 3.05058628e-01f, 9.84843671e-01f, 1.73444211e-01f, 9.95198846e-01f, 9.78736654e-02f, 9.98480916e-01f, 5.50987460e-02f,
  9.99519527e-01f, 3.09950355e-02f, 9.99848068e-01f, 1.74316969e-02f, 9.99951959e-01f, 9.80290305e-03f, 9.99984801e-01f, 5.51263802e-03f,
  8.34223390e-01f, 5.51426709e-01f, 6.56495154e-01f, -7.54330218e-01f, -7.68367112e-01f, -6.40009403e-01f, 8.29440355e-01f, -5.58595300e-01f,
  -9.98294771e-01f, -5.83741926e-02f, -2.26707578e-01f, 9.73962843e-01f, 5.30226350e-01f, 8.47856104e-01f, 8.42413545e-01f, 5.38831532e-01f,
  9.49235439e-01f, 3.14566553e-01f, 9.83852804e-01f, 1.78979620e-01f, 9.94884372e-01f, 1.01020269e-01f, 9.98381376e-01f, 5.68742342e-02f,
  9.99488056e-01f, 3.19945402e-02f, 9.99838114e-01f, 1.79939512e-02f, 9.99948800e-01f, 1.01191159e-02f, 9.99983788e-01f, 5.69046335e-03f,
  -1.32767474e-02f, 9.99911845e-01f, 9.57586050e-01f, -2.88147390e-01f, -5.31235278e-01f, -8.47224355e-01f, 9.15171385e-01f, -4.03064936e-01f,
  -9.87479806e-01f, -1.57745644e-01f, -2.81090319e-01f, 9.59681332e-01f, 5.03154159e-01f, 8.64196658e-01f, 8.32698941e-01f, 5.53726017e-01f,
  9.46042359e-01f, 3.24043006e-01f, 9.82830763e-01f, 1.84509367e-01f, 9.94559944e-01f, 1.04165860e-01f, 9.98278618e-01f, 5.86495437e-02f,
  9.99455571e-01f, 3.29940096e-02f, 9.99827802e-01f, 1.85561981e-02f, 9.99945521e-01f, 1.04353270e-02f, 9.99982774e-01f, 5.86828869e-03f,
  -8.48570287e-01f, 5.29082716e-01f, 9.63757515e-01f, 2.66779721e-01f, -2.41421118e-01f, -9.70420420e-01f, 9.72038329e-01f, -2.34822124e-01f,
  -9.66798186e-01f, -2.55541205e-01f, -3.34584385e-01f, 9.42365825e-01f, 4.75578904e-01f, 8.79673064e-01f, 8.22721004e-01f, 5.68445385e-01f,
  9.42754686e-01f, 3.33487093e-01f, 9.81777668e-01f, 1.90033287e-01f, 9.94225562e-01f, 1.07310407e-01f, 9.98172760e-01f, 6.04246669e-02f,
  9.99422073e-01f, 3.39934528e-02f, 9.99817252e-01f, 1.91184394e-02f, 9.99942183e-01f, 1.07515370e-02f, 9.99981701e-01f, 6.04611309e-03f,
  -9.03692186e-01f, -4.28182662e-01f, 6.73110247e-01f, 7.39542127e-01f, 7.23346695e-02f, -9.97380435e-01f, 9.98247743e-01f, -5.91726787e-02f,
  -9.36456680e-01f, -3.50783229e-01f, -3.87020677e-01f, 9.22071040e-01f, 4.47528064e-01f, 8.94269884e-01f, 8.12482953e-01f, 5.82984984e-01f,
  9.39372718e-01f, 3.42897803e-01f, 9.80693519e-01f, 1.95551202e-01f, 9.93881226e-01f, 1.10453881e-01f, 9.98063743e-01f, 6.21996038e-02f,
  9.99387562e-01f, 3.49928550e-02f, 9.99806345e-01f, 1.96806751e-02f, 9.99938726e-01f, 1.10677453e-02f, 9.99980628e-01f, 6.22393796e-03f,
  -1.27963692e-01f, -9.91778851e-01f, 1.75156534e-01f, 9.84540582e-01f, 3.78916174e-01f, -9.25431013e-01f, 9.92972851e-01f, 1.18342586e-01f,
  -8.96758378e-01f, -4.42520559e-01f, -4.38233554e-01f, 8.98861170e-01f, 4.19029742e-01f, 9.07972515e-01f, 8.01987886e-01f, 5.97340286e-01f,
  9.35896814e-01f, 3.52274209e-01f, 9.79578316e-01f, 2.01062918e-01f, 9.93526995e-01f, 1.13596253e-01f, 9.97951567e-01f, 6.39743358e-02f,
  9.99352098e-01f, 3.59922275e-02f, 9.99795079e-01f, 2.02429052e-02f, 9.99935210e-01f, 1.13839535e-02f, 9.99979496e-01f, 6.40176190e-03f,
  7.65414059e-01f, -6.43538117e-01f, -3.76742303e-01f, 9.26318109e-01f, 6.47921681e-01f, -7.61706948e-01f, 9.56380010e-01f, 2.92125374e-01f,
  -8.48100007e-01f, -5.29836178e-01f, -4.88060862e-01f, 8.72809589e-01f, 3.90112430e-01f, 9.20767248e-01f, 7.91239262e-01f, 6.11506701e-01f,
  9.32327330e-01f, 3.61615449e-01f, 9.78432178e-01f, 2.06568271e-01f, 9.93162811e-01f, 1.16737492e-01f, 9.97836173e-01f, 6.57488778e-02f,
  9.99315560e-01f, 3.69915590e-02f, 9.99783576e-01f, 2.08051261e-02f, 9.99931574e-01f, 1.17001599e-02f, 9.99978364e-01f, 6.57958630e-03f,
  9.55073655e-01f, 2.96368569e-01f, -8.12611222e-01f, 5.82806170e-01f, 8.52673113e-01f, -5.22444785e-01f, 8.89623463e-01f, 4.56694692e-01f,
  -7.90967762e-01f, -6.11857831e-01f, -5.36345184e-01f, 8.43998730e-01f, 3.60805035e-01f, 9.32641268e-01f, 7.80240417e-01f, 6.25479698e-01f,
  9.28664625e-01f, 3.70920479e-01f, 9.77255106e-01f, 2.12067112e-01f, 9.92788672e-01f, 1.19877554e-01f, 9.97717679e-01f, 6.75232038e-02f,
  9.99278069e-01f, 3.79908569e-02f, 9.99771714e-01f, 2.13673431e-02f, 9.99927819e-01f, 1.20163653e-02f, 9.99977171e-01f, 6.75741071e-03f,
  2.66642928e-01f, 9.63795364e-01f, -9.98210371e-01f, 5.98003156e-02f, 9.72865343e-01f, -2.31372014e-01f, 7.94808388e-01f, 6.06860459e-01f,
  -7.25932240e-01f, -6.87766254e-01f, -5.82933903e-01f, 8.12519610e-01f, 3.31136853e-01f, 9.43582714e-01f, 7.68994927e-01f, 6.39254928e-01f,
  9.24909055e-01f, 3.80188406e-01f, 9.76047099e-01f, 2.17559248e-01f, 9.92404640e-01f, 1.23016424e-01f, 9.97596025e-01f, 6.92973137e-02f,
  9.99239624e-01f, 3.89901139e-02f, 9.99759495e-01f, 2.19295528e-02f, 9.99923944e-01f, 1.23325698e-02f, 9.99975979e-01f, 6.93523418e-03f,
  -6.66938066e-01f, 7.45113134e-01f, -8.76379430e-01f, -4.81621295e-01f, 9.96578991e-01f, 8.26458037e-02f, 6.74925625e-01f, 7.37885714e-01f,
  -6.53643608e-01f, -7.56802499e-01f, -6.27679706e-01f, 7.78471708e-01f, 3.01137596e-01f, 9.53580678e-01f, 7.57506192e-01f, 6.52827978e-01f,
  9.21060979e-01f, 3.89418334e-01f, 9.74808276e-01f, 2.23044485e-01f, 9.92010653e-01f, 1.26154065e-01f, 9.97471273e-01f, 7.10712075e-02f,
  9.99200106e-01f, 3.99893373e-02f, 9.99747038e-01f, 2.24917568e-02f, 9.99920011e-01f, 1.26487734e-02f, 9.99974728e-01f, 7.11305765e-03f,
  -9.87339258e-01f, -1.58622667e-01f, -4.84639406e-01f, -8.74714017e-01f, 9.21462357e-01f, 3.88467699e-01f, 5.33756077e-01f, 8.45638454e-01f,
  -5.74824035e-01f, -8.18277061e-01f, -6.70441091e-01f, 7.41962790e-01f, 2.70837069e-01f, 9.62625206e-01f, 7.45777905e-01f, 6.66194677e-01f,
  9.17120814e-01f, 3.98609310e-01f, 9.73538578e-01f, 2.28522688e-01f, 9.91606772e-01f, 1.29290432e-01f, 9.97343302e-01f, 7.28448778e-02f,
  9.99159634e-01f, 4.09885161e-02f, 9.99734223e-01f, 2.30539497e-02f, 9.99915957e-01f, 1.29649751e-02f, 9.99973416e-01f, 7.29088066e-03f,
  -3.99985313e-01f, -9.16521549e-01f, 5.63609414e-02f, -9.98410463e-01f, 7.54965365e-01f, 6.55764699e-01f, 3.75752151e-01f, 9.26720202e-01f,
  -4.90260571e-01f, -8.71575892e-01f, -7.11082935e-01f, 7.03108132e-01f, 2.40265876e-01f, 9.70707119e-01f, 7.33813822e-01f, 6.79350674e-01f,
  9.13088918e-01f, 4.07760441e-01f, 9.72238123e-01f, 2.33993664e-01f, 9.91192937e-01f, 1.32425532e-01f, 9.97212172e-01f, 7.46183172e-02f,
  9.99118149e-01f, 4.19876575e-02f, 9.99721110e-01f, 2.36161388e-02f, 9.99911785e-01f, 1.32811759e-02f, 9.99972105e-01f, 7.46870413e-03f,
  5.55113316e-01f, -8.31774771e-01f, 5.80003142e-01f, -8.14614236e-01f, 5.13598442e-01f, 8.58030677e-01f, 2.05897167e-01f, 9.78573620e-01f,
  -4.00799006e-01f, -9.16166008e-01f, -7.49476731e-01f, 6.62030637e-01f, 2.09454417e-01f, 9.77818429e-01f, 7.21617639e-01f, 6.92291796e-01f,
  9.08965766e-01f, 4.16870773e-01f, 9.70906913e-01f, 2.39457220e-01f, 9.90769207e-01f, 1.35559291e-01f, 9.97077882e-01f, 7.63915181e-02f,
  9.99075651e-01f, 4.29867506e-02f, 9.99707639e-01f, 2.41783205e-02f, 9.99907553e-01f, 1.35973748e-02f, 9.99970794e-01f, 7.64652714e-03f,
  9.99843299e-01f, 1.77019257e-02f, 9.25014675e-01f, -3.79931390e-01f, 2.21298173e-01f, 9.75206196e-01f, 2.95478199e-02f, 9.99563396e-01f,
  -3.07332784e-01f, -9.51602101e-01f, -7.85501122e-01f, 6.18860185e-01f, 1.78433523e-01f, 9.83951986e-01f, 7.09193349e-01f, 7.05014050e-01f,
  9.04751658e-01f, 4.25939471e-01f, 9.69545007e-01f, 2.44913206e-01f, 9.90335584e-01f, 1.38691694e-01f, 9.96940494e-01f, 7.81644881e-02f,
  9.99032140e-01f, 4.39858064e-02f, 9.99693930e-01f, 2.47404929e-02f, 9.99903202e-01f, 1.39135728e-02f, 9.99969363e-01f, 7.82434922e-03f,
  5.25321960e-01f, 8.50903511e-01f, 9.85138178e-01f, 1.71763569e-01f, -9.29481089e-02f, 9.95670974e-01f, -1.47732988e-01f, 9.89027262e-01f,
  -2.10795805e-01f, -9.77530122e-01f, -8.19042206e-01f, 5.73733270e-01f, 1.47234216e-01f, 9.89101648e-01f, 6.96544766e-01f, 7.17513323e-01f,
  9.00447130e-01f, 4.34965521e-01f, 9.68152404e-01f, 2.50361472e-01f, 9.89892066e-01f, 1.41822711e-01f, 9.96799886e-01f, 7.99371973e-02f,
  9.98987675e-01f, 4.49848175e-02f, 9.99679863e-01f, 2.53026579e-02f, 9.99898732e-01f, 1.42297689e-02f, 9.99967992e-01f, 8.00217129e-03f,
  -4.32177931e-01f, 9.01788354e-01f, 7.41858006e-01f, 6.70557022e-01f, -3.97976756e-01f, 9.17395473e-01f, -3.20354372e-01f, 9.47297752e-01f,
  -1.12152621e-01f, -9.93690968e-01f, -8.49993885e-01f, 5.26792526e-01f, 1.15887694e-01f, 9.93262351e-01f, 6.83675885e-01f, 7.29785740e-01f,
  8.96052480e-01f, 4.43948090e-01f, 9.66729224e-01f, 2.55801797e-01f, 9.89438653e-01f, 1.44952312e-01f, 9.96656179e-01f, 8.17096606e-02f,
  9.98942196e-01f, 4.59837839e-02f, 9.99665439e-01f, 2.58648153e-02f, 9.99894202e-01f, 1.45459641e-02f, 9.99966562e-01f, 8.17999430e-03f,
  -9.92335498e-01f, 1.23573124e-01f, 2.70098448e-01f, 9.62832689e-01f, -6.63538277e-01f, 7.48142362e-01f, -4.82871950e-01f, 8.75690997e-01f,
  -1.23883775e-02f, -9.99923289e-01f, -8.78258407e-01f, 4.78186339e-01f, 8.44252855e-02f, 9.96429801e-01f, 6.70590878e-01f, 7.41827428e-01f,
  8.91568303e-01f, 4.52886283e-01f, 9.65275466e-01f, 2.61234075e-01f, 9.88975346e-01f, 1.48080453e-01f, 9.96509314e-01f, 8.34818557e-02f,
  9.98895705e-01f, 4.69827019e-02f, 9.99650776e-01f, 2.64269635e-02f, 9.99889553e-01f, 1.48621574e-02f, 9.99965072e-01f, 8.35781638e-03f,
  -6.40144348e-01f, -7.68254638e-01f, -2.84846604e-01f, 9.58573103e-01f, -8.63296509e-01f, 5.04697084e-01f, -6.30159974e-01f, 7.76465356e-01f,
  8.74991715e-02f, -9.96164620e-01f, -9.03746367e-01f, 4.28068399e-01f, 5.28784581e-02f, 9.98600960e-01f, 6.57293737e-01f, 7.53634512e-01f,
  8.86994898e-01f, 4.61779177e-01f, 9.63791192e-01f, 2.66658038e-01f, 9.88502085e-01f, 1.51207119e-01f, 9.96359289e-01f, 8.52537975e-02f,
  9.98848200e-01f, 4.79815714e-02f, 9.99635756e-01f, 2.69891042e-02f, 9.99884784e-01f, 1.51783489e-02f, 9.99963582e-01f, 8.53563752e-03f,
  3.00592542e-01f, -9.53752637e-01f, -7.52063990e-01f, 6.59090102e-01f, -9.77442741e-01f, 2.11200655e-01f, -7.57573068e-01f, 6.52750373e-01f,
  1.86512470e-01f, -9.82452571e-01f, -9.26377118e-01f, 3.76597136e-01f, 2.12787576e-02f, 9.99773562e-01f, 6.43788815e-01f, 7.65203178e-01f,
  8.82332861e-01f, 4.70625877e-01f, 9.62276459e-01f, 2.72073567e-01f, 9.88018990e-01f, 1.54332280e-01f, 9.96206105e-01f, 8.70254710e-02f,
  9.98799741e-01f, 4.89803962e-02f, 9.99620378e-01f, 2.75512375e-02f, 9.99879956e-01f, 1.54945394e-02f, 9.99962032e-01f, 8.71345960e-03f,
  9.64965999e-01f, -2.62374848e-01f, -9.87659097e-01f, 1.56619072e-01f, -9.94656444e-01f, -1.03240460e-01f, -8.61092687e-01f, 5.08447945e-01f,
  2.83662200e-01f, -9.58924294e-01f, -9.46079254e-01f, 3.23935270e-01f, -1.03422189e-02f, 9.99946535e-01f, 6.30080283e-01f, 7.76529968e-01f,
  8.77582550e-01f, 4.79425550e-01f, 9.60731268e-01f, 2.77480543e-01f, 9.87526000e-01f, 1.57455891e-01f, 9.96049762e-01f, 8.87968615e-02f,
  9.98750269e-01f, 4.99791689e-02f, 9.99604762e-01f, 2.81133596e-02f, 9.99875009e-01f, 1.58107281e-02f, 9.99960482e-01f, 8.89127981e-03f,
  7.42154181e-01f, 6.70229197e-01f, -9.19073522e-01f, -3.94086063e-01f, -9.13230121e-01f, -4.07444149e-01f, -9.37454224e-01f, 3.48108500e-01f,
  3.77977669e-01f, -9.25814748e-01f, -9.62790370e-01f, 2.70249337e-01f, -4.19528559e-02f, 9.99119580e-01f, 6.16172493e-01f, 7.87611187e-01f,
  8.72744501e-01f, 4.88177240e-01f, 9.59155679e-01f, 2.82878697e-01f, 9.87023175e-01f, 1.60577938e-01f, 9.95890260e-01f, 9.05679762e-02f,
  9.98699784e-01f, 5.09778969e-02f, 9.99588788e-01f, 2.86754742e-02f, 9.99869943e-01f, 1.61269177e-02f, 9.99958873e-01f, 9.06910095e-03f,
  -1.62990779e-01f, 9.86627579e-01f, -5.67430019e-01f, -8.23421597e-01f, -7.41239965e-01f, -6.71240151e-01f, -9.84248459e-01f, 1.76790684e-01f,
  4.68516916e-01f, -8.83454502e-01f, -9.76457715e-01f, 2.15709001e-01f, -7.35215396e-02f, 9.97293651e-01f, 6.02069914e-01f, 7.98443377e-01f,
  8.67819190e-01f, 4.96880114e-01f, 9.57549810e-01f, 2.88267940e-01f, 9.86510456e-01f, 1.63698375e-01f, 9.95727658e-01f, 9.23388004e-02f,
  9.98648286e-01f, 5.19765690e-02f, 9.99572515e-01f, 2.92375814e-02f, 9.99864817e-01f, 1.64431017e-02f, 9.99957263e-01f, 9.24692024e-03f,
  -9.18282807e-01f, 3.95925164e-01f, -4.10281904e-02f, -9.99157965e-01f, -4.95741814e-01f, -8.68469954e-01f, -1.00000000e+00f, -1.03020677e-04f,
  5.54374516e-01f, -8.32267344e-01f, -9.87038016e-01f, 1.60486728e-01f, -1.05016708e-01f, 9.94470477e-01f, 5.87776959e-01f, 8.09023023e-01f,
  8.62807095e-01f, 5.05533338e-01f, 9.55913603e-01f, 2.93648034e-01f, 9.85987842e-01f, 1.66817173e-01f, 9.95561838e-01f, 9.41093415e-02f,
  9.98595834e-01f, 5.29751927e-02f, 9.99555886e-01f, 2.97996756e-02f, 9.99859571e-01f, 1.67592876e-02f, 9.99955595e-01f, 9.42474138e-03f,
  -8.29309821e-01f, -5.58789074e-01f, 4.98009592e-01f, -8.67171526e-01f, -2.01079622e-01f, -9.79574919e-01f, -9.84212041e-01f, -1.76993474e-01f,
  6.34692967e-01f, -7.72764444e-01f, -9.94497895e-01f, 1.04756832e-01f, -1.36406869e-01f, 9.90652919e-01f, 5.73298037e-01f, 8.19346905e-01f,
  8.57708693e-01f, 5.14135957e-01f, 9.54247177e-01f, 2.99018890e-01f, 9.85455394e-01f, 1.69934288e-01f, 9.95392919e-01f, 9.58795771e-02f,
  9.98542368e-01f, 5.39737605e-02f, 9.99538958e-01f, 3.03617641e-02f, 9.99854207e-01f, 1.70754679e-02f, 9.99953866e-01f, 9.60256159e-03f,
  2.21267566e-02f, -9.99755144e-01f, 8.83669317e-01f, -4.68111664e-01f, 1.13521777e-01f, -9.93535519e-01f, -9.37382519e-01f, -3.48301649e-01f,
  7.08669782e-01f, -7.05540299e-01f, -9.98813629e-01f, 4.86960001e-02f, -1.67660639e-01f, 9.85844791e-01f, 5.58637917e-01f, 8.29411685e-01f,
  8.52524519e-01f, 5.22687256e-01f, 9.52550590e-01f, 3.04380238e-01f, 9.84913111e-01f, 1.73049718e-01f, 9.95220840e-01f, 9.76495072e-02f,
  9.98487890e-01f, 5.49722798e-02f, 9.99521732e-01f, 3.09238415e-02f, 9.99848783e-01f, 1.73916500e-02f, 9.99952197e-01f, 9.78038087e-03f,
  8.53220105e-01f, -5.21551013e-01f, 9.97174621e-01f, 7.51182064e-02f, 4.16867077e-01f, -9.08967435e-01f, -8.60988438e-01f, -5.08624554e-01f,
  7.75565803e-01f, -6.31266713e-01f, -9.99971747e-01f, -7.51878507e-03f, -1.98746875e-01f, 9.80050862e-01f, 5.43801069e-01f, 8.39214146e-01f,
  8.47255111e-01f, 5.31186223e-01f, 9.50823903e-01f, 3.09731960e-01f, 9.84360933e-01f, 1.76163420e-01f, 9.95045662e-01f, 9.94191393e-02f,
  9.98432398e-01f, 5.59707358e-02f, 9.99504209e-01f, 3.14859077e-02f, 9.99843180e-01f, 1.77078284e-02f, 9.99950409e-01f, 9.95820016e-03f,
  8.99866819e-01f, 4.36164767e-01f, 8.03569078e-01f, 5.95211506e-01f, 6.78870201e-01f, -7.34258294e-01f, -7.57439196e-01f, -6.52905703e-01f,
  8.34712923e-01f, -5.50685287e-01f, -9.97968495e-01f, -6.37097955e-02f, -2.29634270e-01f, 9.73276973e-01f, 5.28792322e-01f, 8.48751247e-01f,
  8.41901004e-01f, 5.39632022e-01f, 9.49067116e-01f, 3.15073937e-01f, 9.83798921e-01f, 1.79275364e-01f, 9.94867265e-01f, 1.01188451e-01f,
  9.98375952e-01f, 5.69691435e-02f, 9.99486327e-01f, 3.20479684e-02f, 9.99837577e-01f, 1.80240069e-02f, 9.99948621e-01f, 1.01360194e-02f,
  1.19180135e-01f, 9.92872655e-01f, 3.62476677e-01f, 9.31992829e-01f, 8.73550534e-01f, -4.86733496e-01f, -6.30000710e-01f, -7.76594579e-01f,
  8.85519624e-01f, -4.64602023e-01f, -9.92810190e-01f, -1.19699396e-01f, -2.60292053e-01f, 9.65529919e-01f, 5.13616323e-01f, 8.58020008e-01f,
  8.36462677e-01f, 5.48023939e-01f, 9.47280347e-01f, 3.20405900e-01f, 9.83227074e-01f, 1.82385504e-01f, 9.94685769e-01f, 1.02957435e-01f,
  9.98318493e-01f, 5.79674877e-02f, 9.99468148e-01f, 3.26100141e-02f, 9.99831796e-01f, 1.83401816e-02f, 9.99946833e-01f, 1.03138378e-02f,
  -7.71080196e-01f, 6.36738002e-01f, -1.90249100e-01f, 9.81735826e-01f, 9.81602073e-01f, -1.90938011e-01f, -4.82692331e-01f, -8.75790000e-01f,
  9.27478492e-01f, -3.73876572e-01f, -9.84513164e-01f, -1.75310582e-01f, -2.90689558e-01f, 9.56817448e-01f, 4.98277903e-01f, 8.67017388e-01f,
  8.30940723e-01f, 5.56361020e-01f, 9.45463598e-01f, 3.25727791e-01f, 9.82645452e-01f, 1.85493827e-01f, 9.94501114e-01f, 1.04726106e-01f,
  9.98260021e-01f, 5.89657798e-02f, 9.99449670e-01f, 3.31720486e-02f, 9.99825954e-01f, 1.86563563e-02f, 9.99944985e-01f, 1.04916561e-02f,
  -9.52412963e-01f, -3.04810613e-01f, -6.84381902e-01f, 7.29123712e-01f, 9.92308319e-01f, 1.23790950e-01f, -3.20159167e-01f, -9.47363734e-01f,
  9.60170269e-01f, -2.79415488e-01f, -9.73103702e-01f, -2.30367512e-01f, -3.20796400e-01f, 9.47148204e-01f, 4.82782036e-01f, 8.75740528e-01f,
  8.25335622e-01f, 5.64642429e-01f, 9.43616986e-01f, 3.31039310e-01f, 9.82053936e-01f, 1.88600287e-01f, 9.94313300e-01f, 1.06494442e-01f,
  9.98200536e-01f, 5.99640086e-02f, 9.99430835e-01f, 3.37340795e-02f, 9.99819994e-01f, 1.89725272e-02f, 9.99943078e-01f, 1.06694745e-02f,
  -2.58101642e-01f, -9.66117799e-01f, -9.67739642e-01f, 2.51952261e-01f, 9.04607594e-01f, 4.26245421e-01f, -1.47529200e-01f, -9.89057720e-01f,
  9.83268440e-01f, -1.82162598e-01f, -9.58617806e-01f, -2.84696162e-01f, -3.50582451e-01f, 9.36531842e-01f, 4.67133403e-01f, 8.84186864e-01f,
  8.19648027e-01f, 5.72867453e-01f, 9.41740453e-01f, 3.36340427e-01f, 9.81452644e-01f, 1.91704854e-01f, 9.94122326e-01f, 1.08262435e-01f,
  9.98140097e-01f, 6.09621815e-02f, 9.99411702e-01f, 3.42960916e-02f, 9.99813974e-01f, 1.92886982e-02f, 9.99941170e-01f, 1.08472919e-02f,
  6.73507154e-01f, -7.39180684e-01f, -9.53050017e-01f, -3.02812874e-01f, 7.27198064e-01f, 6.86427653e-01f, 2.97537707e-02f, -9.99557257e-01f,
  9.96542096e-01f, -8.30891207e-02f, -9.41101313e-01f, -3.38124752e-01f, -3.80017966e-01f, 9.24979091e-01f, 4.51337039e-01f, 8.92353535e-01f,
  8.13878477e-01f, 5.81035137e-01f, 9.39834237e-01f, 3.41630876e-01f, 9.80841517e-01f, 1.94807529e-01f, 9.93928254e-01f, 1.10030092e-01f,
  9.98078644e-01f, 6.19602874e-02f, 9.99392271e-01f, 3.48580964e-02f, 9.99807835e-01f, 1.96048655e-02f, 9.99939203e-01f, 1.10251084e-02f,
  9.85896587e-01f, 1.67355701e-01f, -6.44837022e-01f, -7.64320076e-01f, 4.77671444e-01f, 8.78538549e-01f, 2.06098333e-01f, -9.78531301e-01f,
  9.99858618e-01f, 1.68140903e-02f, -9.20609534e-01f, -3.90484393e-01f, -4.09073502e-01f, 9.12501454e-01f, 4.35397953e-01f, 9.00238097e-01f,
  8.08027506e-01f, 5.89144766e-01f, 9.37898219e-01f, 3.46910536e-01f, 9.80220556e-01f, 1.97908238e-01f, 9.93731022e-01f, 1.11797392e-01f,
  9.98016179e-01f, 6.29583374e-02f, 9.99372482e-01f, 3.54200937e-02f, 9.99801576e-01f, 1.99210308e-02f, 9.99937236e-01f, 1.12029258e-02f,
};

constexpr int T_ALL = 36864, T_CTX = 4096;
constexpr int NLAYER = 4;
constexpr float EPS = 1e-6f;
constexpr int LK_LAT = 4352;

struct Params {
  const float* x_prompt; const float* x_sample; const float* cache_ckv; const float* cache_krope;
  const float* cache_k; const float* cache_v; const float* state; const float* c; const float* c_ctx;
  const float* w_mod; const float* b_mod; const float* g_norm; const float* w_in; const float* conv_w; const float* conv_b;
  const float* lru_wa; const float* lru_ba; const float* lru_wi; const float* lru_bi; const float* lru_lam;
  const float* q_norm; const float* w_uq; const float* kv_norm; const float* w_ukv; const float* sink;
  const float* w_br_rnn; const float* w_br_mla; const float* w_br_swa; const float* w_out; const float* final_norm;
  float* out; char* ws;
};

constexpr size_t AL(size_t x) { return (x + 255) & ~(size_t)255; }
constexpr size_t O_WINA = 0;
constexpr size_t O_WINB = O_WINA + AL((size_t)2560 * 1024 * 2);
constexpr size_t O_WLRU = O_WINB + AL((size_t)5120 * 1024 * 2);
constexpr size_t O_WUQ = O_WLRU + AL((size_t)4096 * 128 * 2);
constexpr size_t O_WUKVG = O_WUQ + AL((size_t)768 * 384 * 2);
constexpr size_t O_WUKVR = O_WUKVG + AL((size_t)1024 * 256 * 2);
constexpr size_t O_WBRR = O_WUKVR + AL((size_t)1024 * 256 * 2);
constexpr size_t O_WBRM = O_WBRR + AL((size_t)1024 * 1024 * 2);
constexpr size_t O_WBRS = O_WBRM + AL((size_t)1024 * 512 * 2);
constexpr size_t O_WOUT = O_WBRS + AL((size_t)1024 * 512 * 2);
constexpr size_t O_MOD = O_WOUT + AL((size_t)1024 * 1024 * 2);
constexpr size_t O_H = O_MOD + AL((size_t)4 * 9 * 3072 * 4);
constexpr size_t O_XR = O_H + AL((size_t)T_ALL * 1024 * 2);
constexpr size_t O_CQ = O_XR + AL((size_t)T_ALL * 1024 * 2);
constexpr size_t O_CKV = O_CQ + AL((size_t)T_ALL * 384 * 2);
constexpr size_t O_CKVC = O_CKV + AL((size_t)T_ALL * 256 * 2);
constexpr size_t O_KRL = O_CKVC + AL((size_t)2048 * 256 * 2);
constexpr size_t O_KRC = O_KRL + AL((size_t)8 * LK_LAT * 32 * 2);
constexpr size_t O_QS = O_KRC + AL((size_t)16 * 256 * 32 * 2);
constexpr size_t O_KS = O_QS + AL((size_t)T_ALL * 512 * 2);
constexpr size_t O_KSC = O_KS + AL((size_t)T_ALL * 128 * 2);
constexpr size_t O_VTSL = O_KSC + AL((size_t)8 * 256 * 128 * 2);
constexpr size_t O_VTSC = O_VTSL + AL((size_t)8 * 2 * 64 * 4096 * 2);
constexpr size_t O_VTSCC = O_VTSC + AL((size_t)16 * 2 * 64 * 256 * 2);
constexpr size_t O_Q = O_VTSCC + AL((size_t)8 * 2 * 64 * 256 * 2);
constexpr size_t O_KNL = O_Q + AL((size_t)T_ALL * 768 * 2);
constexpr size_t O_KNC = O_KNL + AL((size_t)8 * 8 * LK_LAT * 64 * 2);
constexpr size_t O_VTL = O_KNC + AL((size_t)16 * 8 * 256 * 64 * 2);
constexpr size_t O_VTC = O_VTL + AL((size_t)8 * 8 * 64 * LK_LAT * 2);
constexpr size_t O_YRNN = O_VTC + AL((size_t)16 * 8 * 64 * 256 * 2);
static_assert(O_YRNN - O_KS >= (size_t)2 * T_ALL * 1024 * 2, "merge-gate buffers do not fit");
constexpr size_t O_SUM = O_YRNN + AL((size_t)T_ALL * 1024 * 2);
constexpr size_t O_BAR = O_SUM + AL((size_t)8 * 8 * 2 * 16 * 256 * 4);
constexpr size_t O_W2 = O_BAR + 256;
constexpr size_t WS_NEED = O_W2 + O_MOD;

constexpr size_t OUT_CKV = (size_t)T_ALL * 1024;
constexpr size_t OUT_KROPE = OUT_CKV + (size_t)16 * 4 * 256 * 256;
constexpr size_t OUT_SK = OUT_KROPE + (size_t)16 * 4 * 256 * 32;
constexpr size_t OUT_SV = OUT_SK + (size_t)16 * 4 * 256 * 128;
constexpr size_t OUT_RG = OUT_SV + (size_t)16 * 4 * 256 * 128;

#define SB() __builtin_amdgcn_sched_barrier(0)
#define MB() asm volatile("" ::: "memory")
DI int tid() { int t = threadIdx.x; asm volatile("" : "+v"(t)); return t; }
DI int xcd_map(int base) {
  const int g = gridDim.x;
  if (g & 7) return base + blockIdx.x;
  return base + (blockIdx.x & 7) * (g >> 3) + (blockIdx.x >> 3);
}
#define LANEVARS const int t = tid(), lane = t & 63, w = t >> 6, wr = w >> 1, wc = w & 1; const int c16 = lane & 15, g4 = lane >> 4; (void)wr; (void)wc; (void)c16; (void)g4;
DI float bf2f(u16 v) { return __uint_as_float(((unsigned)v) << 16); }
DI unsigned pack2(float a, float b) {
  f2_t v = {a, b};
  bf2_t r = __builtin_convertvector(v, bf2_t);
  return __builtin_bit_cast(unsigned, r);
}
DI u16 f2bf(float a) { return (u16)(pack2(a, 0.f) & 0xffffu); }
DI float sigmoidf_(float x) { return 1.f / (1.f + __expf(-x)); }
DI float wave_sum(float v) {
#pragma unroll
  for (int o = 32; o > 0; o >>= 1) v += __shfl_xor(v, o);
  return v;
}
DI int perm32(int p) { return (p & 7) | ((p & 8) << 1) | ((p & 16) >> 1); }
DI const float* xin_row(const Params& p, int l, int row) {
  if (l == 0) return row < T_CTX ? p.x_prompt + (size_t)row * 1024 : p.x_sample + (size_t)(row - T_CTX) * 1024;
  return p.out + (size_t)row * 1024;
}
template <class T> DI T* wsp(const Params& p, size_t off) { return (T*)(p.ws + off); }
DI u16* wsw(const Params& p, int l, size_t off) { return (u16*)(p.ws + ((l & 1) ? O_W2 : 0) + off); }

template <int NJ>
DI void gemm_tile_t(const u16* A, int lda, const u16* B, int ldb, int K,
                    f32x4 (&acc)[4][NJ], char* smem) {
  const int t = tid(), lane = t & 63, w = t >> 6, wr = w >> 1, wc = w & 1;
  const int lr = t >> 3, slot = t & 7;
  const int c16 = lane & 15, g4 = lane >> 4;
  const int gch = slot ^ ((lr >> 1) & 7);
  const u16* ap = A + (size_t)lr * lda + gch * 8;
  const u16* bp = B + (size_t)lr * ldb + gch * 8;
  char* sdst = smem + t * 16;
#define DMA16(gp, lp) __builtin_amdgcn_global_load_lds((const unsigned*)(gp), (unsigned*)(lp), 16, 0, 0)
#define STAGE(base, ko) { DMA16(ap + (ko), (base)); DMA16(ap + (size_t)32 * lda + (ko), (base) + 4096); \
    DMA16(ap + (size_t)64 * lda + (ko), (base) + 8192); DMA16(ap + (size_t)96 * lda + (ko), (base) + 12288); \
    DMA16(bp + (ko), (base) + 16384); DMA16(bp + (size_t)32 * ldb + (ko), (base) + 16384 + 4096); \
    if (NJ > 2) { DMA16(bp + (size_t)64 * ldb + (ko), (base) + 16384 + 8192); DMA16(bp + (size_t)96 * ldb + (ko), (base) + 16384 + 12288); } }
  const int nk = K >> 6;
  const int arow = (wr * 64 + c16) * 128, brow = (wc * (16 * NJ) + c16) * 128;
  const int sw = (c16 >> 1) & 7;
  int kk = 0;
  STAGE(sdst, kk * 64)
  __syncthreads();
  for (int kt = 0; kt < nk; ++kt) {
    char* cur = smem + (kt & 1) * 32768;
    kk = (kk + 1 == nk) ? 0 : kk + 1;
    if (kt + 1 < nk) { char* nxt = sdst + ((kt + 1) & 1) * 32768; STAGE(nxt, kk * 64) }
#pragma unroll
    for (int ks = 0; ks < 2; ++ks) {
      bf16x8 af[4], bfr[NJ];
      const int ch = ((ks * 4 + g4) ^ sw) << 4;
#pragma unroll
      for (int i = 0; i < 4; ++i) af[i] = *(const bf16x8*)(cur + arow + i * 2048 + ch);
#pragma unroll
      for (int i = 0; i < NJ; ++i) bfr[i] = *(const bf16x8*)(cur + 16384 + brow + i * 2048 + ch);
#pragma unroll
      for (int i = 0; i < 4; ++i)
#pragma unroll
        for (int j = 0; j < NJ; ++j)
          acc[i][j] = __builtin_amdgcn_mfma_f32_16x16x32_bf16(af[i], bfr[j], acc[i][j], 0, 0, 0);
    }
    SB();
    __syncthreads();
  }
#undef STAGE
#undef DMA16
}
DI void gemm_tile(const u16* A, int lda, const u16* B, int ldb, int K,
                  f32x4 (&acc)[4][4], char* smem) {
  gemm_tile_t<4>(A, lda, B, ldb, K, acc, smem);
}
DI void zero_acc(f32x4 (&acc)[4][4]) {
#pragma unroll
  for (int i = 0; i < 4; ++i)
#pragma unroll
    for (int j = 0; j < 4; ++j) acc[i][j] = f32x4{0.f, 0.f, 0.f, 0.f};
}

struct TokTile { int g0; int is_ctx; int b; int p0; };
DI TokTile tok_tile(int mt) {
  TokTile r; r.g0 = mt * 128;
  if (r.g0 < T_CTX) { r.is_ctx = 1; r.b = r.g0 >> 8; r.p0 = r.g0 & 255; }
  else { r.is_ctx = 0; r.b = (r.g0 - T_CTX) >> 12; r.p0 = (r.g0 - T_CTX) & 4095; }
  return r;
}

DI void phase_mod(const Params& p, char* smem) {
  float* s_silu = (float*)smem;
  float* s_part = (float*)(smem + 36864);
  float* MOD = wsp<float>(p, O_MOD);
  const int t = tid();
  for (int i = t; i < 9 * 1024; i += 256) {
    float v = (i < 8192) ? p.c[i] : p.c_ctx[i - 8192];
    s_silu[i] = v * sigmoidf_(v);
  }
  __syncthreads();
  const int kg = t >> 6, cl = t & 63;
  for (int u = blockIdx.x; u < 4 * 48; u += gridDim.x) {
    const int l = u / 48, cb = u % 48;
    const int n = cb * 64 + cl;
    float acc[9];
#pragma unroll
    for (int ci = 0; ci < 9; ++ci) acc[ci] = 0.f;
    const float* wp = p.w_mod + ((size_t)l * 1024 + kg * 256) * 3072 + n;
    for (int k = 0; k < 256; ++k) {
      float wv = wp[(size_t)k * 3072];
#pragma unroll
      for (int ci = 0; ci < 9; ++ci) acc[ci] += s_silu[ci * 1024 + kg * 256 + k] * wv;
    }
#pragma unroll
    for (int ci = 0; ci < 9; ++ci) s_part[(kg * 9 + ci) * 64 + cl] = acc[ci];
    __syncthreads();
    for (int idx = t; idx < 9 * 64; idx += 256) {
      int ci = idx >> 6, c2 = idx & 63;
      float s = s_part[(0 * 9 + ci) * 64 + c2] + s_part[(1 * 9 + ci) * 64 + c2] + s_part[(2 * 9 + ci) * 64 + c2] +
                s_part[(3 * 9 + ci) * 64 + c2];
      MOD[((size_t)l * 9 + ci) * 3072 + cb * 64 + c2] = s + p.b_mod[l * 3072 + cb * 64 + c2];
    }
    __syncthreads();
  }
}

template <class F> DI void conv_job(u16* dst, int N, int K, F src) {
  const int total = N * (K >> 3);
  for (int idx = blockIdx.x * 256 + tid(); idx < total; idx += gridDim.x * 256) {
    const int n = idx % N, kb = idx / N;
    float v[8];
#pragma unroll
    for (int j = 0; j < 8; ++j) v[j] = src(kb * 8 + j, n);
    uint4 o;
    o.x = pack2(v[0], v[1]); o.y = pack2(v[2], v[3]); o.z = pack2(v[4], v[5]); o.w = pack2(v[6], v[7]);
    *(uint4*)(dst + (size_t)n * K + kb * 8) = o;
  }
}

DI void convert_weights(const Params& p, int l) {
  {
    const float* win = p.w_in + (size_t)l * 1024 * 7584;
    conv_job(wsw(p, l, O_WINA), 2560, 1024, [&](int k, int n) -> float {
      int col;
      if (n < 1024) col = n;
      else if (n < 1408) col = 2048 + (n - 1024);
      else if (n < 1664) col = 2432 + (n - 1408);
      else if (n < 1792) { int pp = n - 1664; col = pp < 32 ? 2688 + perm32(pp) : -1; }
      else if (n < 2304) col = 3232 + (n - 1792);
      else if (n < 2432) col = 3744 + (n - 2304);
      else col = 3872 + (n - 2432);
      return col < 0 ? 0.f : win[(size_t)k * 7584 + col];
    });
    conv_job(wsw(p, l, O_WINB), 5120, 1024, [&](int k, int n) -> float {
      int col;
      if (n < 1024) col = 1024 + n;
      else if (n < 1536) col = 2720 + (n - 1024);
      else if (n < 2048) col = 4000 + (n - 1536);
      else col = 4512 + (n - 2048);
      return win[(size_t)k * 7584 + col];
    });
    const float* wa = p.lru_wa + (size_t)l * 2 * 8 * 128 * 128;
    const float* wi = p.lru_wi + (size_t)l * 2 * 8 * 128 * 128;
    conv_job(wsw(p, l, O_WLRU), 4096, 128, [&](int k, int n) -> float {
      int db = n >> 8, nn = n & 255;
      return nn < 128 ? wa[((size_t)db * 128 + k) * 128 + nn] : wi[((size_t)db * 128 + k) * 128 + (nn - 128)];
    });
    const float* wuq = p.w_uq + (size_t)l * 384 * 768;
    const float* gq = p.q_norm + l * 384;
    conv_job(wsw(p, l, O_WUQ), 768, 384, [&](int k, int n) -> float {
      int col;
      if (n < 512) col = (n >> 6) * 96 + (n & 63);
      else { int hh = (n - 512) >> 5, pp = (n - 512) & 31; col = hh * 96 + 64 + perm32(pp); }
      return gq[k] * wuq[(size_t)k * 768 + col];
    });
    const float* wukv = p.w_ukv + (size_t)l * 256 * 1024;
    const float* gkv = p.kv_norm + l * 256;
    conv_job(wsw(p, l, O_WUKVG), 1024, 256, [&](int k, int n) -> float { return gkv[k] * wukv[(size_t)k * 1024 + n]; });
    conv_job(wsw(p, l, O_WUKVR), 1024, 256, [&](int k, int n) -> float { return wukv[(size_t)k * 1024 + n]; });
    const float* w1 = p.w_br_rnn + (size_t)l * 1024 * 1024;
    conv_job(wsw(p, l, O_WBRR), 1024, 1024, [&](int k, int n) -> float { return w1[(size_t)k * 1024 + n]; });
    const float* w2 = p.w_br_mla + (size_t)l * 512 * 1024;
    conv_job(wsw(p, l, O_WBRM), 1024, 512, [&](int k, int n) -> float { return w2[(size_t)k * 1024 + n]; });
    const float* w3 = p.w_br_swa + (size_t)l * 512 * 1024;
    conv_job(wsw(p, l, O_WBRS), 1024, 512, [&](int k, int n) -> float { return w3[(size_t)k * 1024 + n]; });
    const float* w4 = p.w_out + (size_t)l * 1024 * 1024;
    conv_job(wsw(p, l, O_WOUT), 1024, 1024, [&](int k, int n) -> float { return w4[(size_t)k * 1024 + n]; });
  }
}

DI void phase_prep(const Params& p, int l) {
  const int t = tid(), lane = t & 63, w = t >> 6;
  const float* MOD = wsp<float>(p, O_MOD) + (size_t)l * 9 * 3072;
  u16* H = wsp<u16>(p, O_H);
  for (int row = blockIdx.x * 4 + w; row < T_ALL; row += gridDim.x * 4) {
    const float* x = xin_row(p, l, row);
    const int ci = row < T_CTX ? 8 : ((row - T_CTX) >> 12);
    const float* md = MOD + ci * 3072;
    float4 v[4];
    float ss = 0.f;
#pragma unroll
    for (int i = 0; i < 4; ++i) {
      v[i] = *(const float4*)(x + i * 256 + lane * 4);
      ss += v[i].x * v[i].x + v[i].y * v[i].y + v[i].z * v[i].z + v[i].w * v[i].w;
    }
    ss = wave_sum(ss);
    const float rs = rsqrtf(ss * (1.f / 1024.f) + EPS);
#pragma unroll
    for (int i = 0; i < 4; ++i) {
      const int c = i * 256 + lane * 4;
      const float4 g = *(const float4*)(p.g_norm + l * 1024 + c);
      const float4 sh = *(const float4*)(md + c);
      const float4 sc = *(const float4*)(md + 1024 + c);
      float h0 = v[i].x * rs * g.x * (1.f + sc.x) + sh.x;
      float h1 = v[i].y * rs * g.y * (1.f + sc.y) + sh.y;
      float h2 = v[i].z * rs * g.z * (1.f + sc.z) + sh.z;
      float h3 = v[i].w * rs * g.w * (1.f + sc.w) + sh.w;
      uint2 o; o.x = pack2(h0, h1); o.y = pack2(h2, h3);
      *(uint2*)(H + (size_t)row * 1024 + c) = o;
    }
  }
  {
    const int gt = blockIdx.x * 256 + t, gs = gridDim.x * 256;
    u16* ckvc = wsp<u16>(p, O_CKVC);
    for (int i = gt; i < 2048 * 256; i += gs) {
      int r = i >> 8, k = i & 255, b = r >> 8, pos = r & 255;
      ckvc[i] = f2bf(p.cache_ckv[(((size_t)b * 4 + l) * 256 + pos) * 256 + k]);
    }
    u16* krl = wsp<u16>(p, O_KRL);
    for (int i = gt; i < 8 * 256 * 32; i += gs) {
      int pp = i & 31, pos = (i >> 5) & 255, b = i >> 13;
      krl[((size_t)b * LK_LAT + pos) * 32 + pp] = f2bf(p.cache_krope[(((size_t)b * 4 + l) * 256 + pos) * 32 + perm32(pp)]);
    }
    u16* ksc = wsp<u16>(p, O_KSC);
    for (int i = gt; i < 8 * 256 * 128; i += gs) {
      int c = i & 127, pos = (i >> 7) & 255, b = i >> 15;
      ksc[i] = f2bf(p.cache_k[(((size_t)b * 4 + l) * 256 + pos) * 128 + c]);
    }
    u16* vtc = wsp<u16>(p, O_VTSCC);
    for (int i = gt; i < 8 * 2 * 64 * 256; i += gs) {
      int pos = i & 255, dv = (i >> 8) & 63, kvh = (i >> 14) & 1, b = i >> 15;
      vtc[i] = f2bf(p.cache_v[(((size_t)b * 4 + l) * 256 + pos) * 128 + kvh * 64 + dv]);
    }
  }
}

DI void phase_gemmA(const Params& p, int l, char* smem) {
  const u16* H = wsp<u16>(p, O_H);
  const u16* W = wsw(p, l, O_WINA);
  for (int base = 0; base < 288 * 20; base += gridDim.x) {
    const int tile = xcd_map(base);
    if (tile >= 288 * 20) continue;
    const int sb = tile >> 5, jj = tile & 31;
    const int mt = (sb / 5) * 8 + (jj >> 2), nt = (sb % 5) * 4 + (jj & 3);
    const TokTile tt = tok_tile(mt);
    f32x4 acc[4][4];
    zero_acc(acc);
    gemm_tile(H + (size_t)tt.g0 * 1024, 1024, W + (size_t)nt * 128 * 1024, 1024, 1024, acc, smem);
    LANEVARS
    if (nt < 13) {
      u16* dst; int ld, cb;
      if (nt < 8) { dst = wsp<u16>(p, O_XR); ld = 1024; cb = nt * 128; }
      else if (nt < 11) { dst = wsp<u16>(p, O_CQ); ld = 384; cb = (nt - 8) * 128; }
      else { dst = wsp<u16>(p, O_CKV); ld = 256; cb = (nt - 11) * 128; }
#pragma unroll
      for (int i = 0; i < 4; ++i)
#pragma unroll
        for (int j = 0; j < 4; ++j)
#pragma unroll
          for (int e = 0; e < 4; ++e) {
            const int g = tt.g0 + wr * 64 + i * 16 + g4 * 4 + e;
            dst[(size_t)g * ld + cb + wc * 64 + j * 16 + c16] = f2bf(acc[i][j][e]);
            if (e == 3 && j == 3) SB();
          }
    } else if (nt == 13) {
      if (wc == 0) {
#pragma unroll
        for (int i = 0; i < 4; ++i)
#pragma unroll
          for (int e = 0; e < 4; ++e) {
            SB();
            const int r = wr * 64 + i * 16 + g4 * 4 + e;
            const int pos = tt.p0 + r;
            float x1 = acc[i][0][e], x2 = acc[i][1][e];
            if (tt.is_ctx) {
              u16* kr = wsp<u16>(p, O_KRC) + ((size_t)tt.b * 256 + pos) * 32;
              kr[c16] = f2bf(x1); kr[c16 + 16] = f2bf(x2);
              float* o = p.out + OUT_KROPE + (((size_t)tt.b * 4 + l) * 256 + pos) * 32;
              o[perm32(c16)] = x1; o[perm32(c16 + 16)] = x2;
            } else {
              const int pv = (c16 >= 8) ? (pos & 63) : (pos >> 6);
              const float cs = TAB_M[(pv * 8 + (c16 & 7)) * 2], sn = TAB_M[(pv * 8 + (c16 & 7)) * 2 + 1];
              u16* kr = wsp<u16>(p, O_KRL) + ((size_t)tt.b * LK_LAT + 256 + pos) * 32;
              kr[c16] = f2bf(x1 * cs - x2 * sn); kr[c16 + 16] = f2bf(x2 * cs + x1 * sn);
            }
          }
      }
    } else if (nt < 19) {
      const bool isk = (nt == 18);
      u16* dst = isk ? wsp<u16>(p, O_KS) : wsp<u16>(p, O_QS);
      const int ld = isk ? 128 : 512;
      const int cb = isk ? wc * 64 : ((nt - 14) * 2 + wc) * 64;
#pragma unroll
      for (int i = 0; i < 4; ++i)
#pragma unroll
        for (int e = 0; e < 4; ++e) {
          SB();
          const int r = wr * 64 + i * 16 + g4 * 4 + e;
          const int pos = tt.p0 + r, g = tt.g0 + r;
          float v0 = acc[i][0][e], v1 = acc[i][1][e], v2 = acc[i][2][e], v3 = acc[i][3][e];
          if (!tt.is_ctx) {
            const int pr = pos >> 6, pc = pos & 63;
            const float c0 = TAB_S[(pr * 16 + c16) * 2], s0 = TAB_S[(pr * 16 + c16) * 2 + 1];
            const float c1 = TAB_S[(pc * 16 + c16) * 2], s1 = TAB_S[(pc * 16 + c16) * 2 + 1];
            float a0 = v0 * c0 - v1 * s0, a1 = v1 * c0 + v0 * s0;
            float a2 = v2 * c1 - v3 * s1, a3 = v3 * c1 + v2 * s1;
            v0 = a0; v1 = a1; v2 = a2; v3 = a3;
          } else if (isk) {
            float* o = p.out + OUT_SK + (((size_t)tt.b * 4 + l) * 256 + pos) * 128 + cb + c16;
            o[0] = v0; o[16] = v1; o[32] = v2; o[48] = v3;
          }
          u16* d = dst + (size_t)g * ld + cb + c16;
          d[0] = f2bf(v0); d[16] = f2bf(v1); d[32] = f2bf(v2); d[48] = f2bf(v3);
        }
    } else {
      u16* vt = tt.is_ctx ? wsp<u16>(p, O_VTSC) : wsp<u16>(p, O_VTSL);
      const int L = tt.is_ctx ? 256 : 4096;
#pragma unroll
      for (int i = 0; i < 4; ++i)
#pragma unroll
        for (int j = 0; j < 4; ++j) {
          SB();
          const int r = wr * 64 + i * 16 + g4 * 4;
          const int pos = tt.p0 + r, dv = j * 16 + c16;
          uint2 o; o.x = pack2(acc[i][j][0], acc[i][j][1]); o.y = pack2(acc[i][j][2], acc[i][j][3]);
          *(uint2*)(vt + (((size_t)tt.b * 2 + wc) * 64 + dv) * L + pos) = o;
          if (tt.is_ctx) {
#pragma unroll
            for (int e = 0; e < 4; ++e)
              p.out[OUT_SV + (((size_t)tt.b * 4 + l) * 256 + pos + e) * 128 + wc * 64 + dv] = acc[i][j][e];
          }
        }
    }
  }
}

DI void row_scales(const u16* A, int K, float* s_rs) {
  const int t = tid(), row = t >> 1, half = t & 1;
  const u16* ap = A + (size_t)row * K + half * (K >> 1);
  float ss = 0.f;
  for (int c = 0; c < (K >> 4); ++c) {
    uint4 v = *(const uint4*)(ap + c * 8);
    unsigned wv[4] = {v.x, v.y, v.z, v.w};
#pragma unroll
    for (int q = 0; q < 4; ++q) {
      float a = __uint_as_float(wv[q] << 16), b = __uint_as_float(wv[q] & 0xffff0000u);
      ss += a * a + b * b;
    }
  }
  ss += __shfl_xor(ss, 1);
  if (half == 0) s_rs[row] = rsqrtf(ss / (float)K + EPS);
}

template <int MODE> DI void scan_seg(const Params& p, int l, int seq, int blk, int d, int seg, char* smem);
DI void phase_qkv(const Params& p, int l, char* smem) {
  float* s_rs = (float*)(smem + 65536);
  constexpr int NQ = 288 * 6, NKV = 304 * 8, NS1 = 2048;
  for (int base = 0; base < NS1 + NQ + NKV; base += gridDim.x) {
    const int tile0 = xcd_map(base);
    if (tile0 >= NS1 + NQ + NKV) continue;
    if (tile0 < NS1) {
      scan_seg<0>(p, l, 16 + (tile0 >> 8), (tile0 >> 5) & 7, (tile0 >> 4) & 1, tile0 & 15, smem);
#if PROBE == 4
      scan_seg<0>(p, l, 16 + (tile0 >> 8), (tile0 >> 5) & 7, (tile0 >> 4) & 1, tile0 & 15, smem);
#endif
      continue;
    }
    const int tile = tile0 - NS1;
    f32x4 acc[4][4];
    zero_acc(acc);
    if (tile < NQ) {
      const int mt = tile / 6, nt = tile % 6;
      const TokTile tt = tok_tile(mt);
      const u16* A = wsp<u16>(p, O_CQ) + (size_t)tt.g0 * 384;
      row_scales(A, 384, s_rs);
      gemm_tile(A, 384, wsw(p, l, O_WUQ) + (size_t)nt * 128 * 384, 384, 384, acc, smem);
      LANEVARS
      u16* Q = wsp<u16>(p, O_Q);
#pragma unroll
      for (int i = 0; i < 4; ++i)
#pragma unroll
        for (int e = 0; e < 4; ++e) {
          SB();
          const int r = wr * 64 + i * 16 + g4 * 4 + e;
          const int pos = tt.p0 + r, g = tt.g0 + r;
          const float rs = s_rs[r];
          float v0 = acc[i][0][e] * rs, v1 = acc[i][1][e] * rs, v2 = acc[i][2][e] * rs, v3 = acc[i][3][e] * rs;
          if (nt >= 4 && !tt.is_ctx) {
            const int pv = (c16 >= 8) ? (pos & 63) : (pos >> 6);
            const float cs = TAB_M[(pv * 8 + (c16 & 7)) * 2], sn = TAB_M[(pv * 8 + (c16 & 7)) * 2 + 1];
            float a0 = v0 * cs - v1 * sn, a1 = v1 * cs + v0 * sn;
            float a2 = v2 * cs - v3 * sn, a3 = v3 * cs + v2 * sn;
            v0 = a0; v1 = a1; v2 = a2; v3 = a3;
          }
          u16* d = Q + (size_t)g * 768 + nt * 128 + wc * 64 + c16;
          d[0] = f2bf(v0); d[16] = f2bf(v1); d[32] = f2bf(v2); d[48] = f2bf(v3);
        }
    } else {
      const int t2 = tile - NQ;
      const int mt = t2 >> 3, hd = t2 & 7;
      const u16* A; const u16* Wt; int is_ctx, seq, kp0;
      if (mt < 288) {
        const TokTile tt = tok_tile(mt);
        A = wsp<u16>(p, O_CKV) + (size_t)tt.g0 * 256;
        Wt = wsw(p, l, O_WUKVG);
        row_scales(A, 256, s_rs);
        is_ctx = tt.is_ctx; seq = tt.b; kp0 = tt.is_ctx ? tt.p0 : 256 + tt.p0;
        if (tt.is_ctx && hd == 0) {
          __syncthreads();
          const float* gkv = p.kv_norm + l * 256;
          for (int idx = tid(); idx < 128 * 256; idx += 256) {
            const int r = idx >> 8, k = idx & 255;
            p.out[OUT_CKV + (((size_t)tt.b * 4 + l) * 256 + tt.p0 + r) * 256 + k] = bf2f(A[(size_t)r * 256 + k]) * s_rs[r] * gkv[k];
          }
        }
      } else {
        const int row0 = (mt - 288) * 128;
        A = wsp<u16>(p, O_CKVC) + (size_t)row0 * 256;
        Wt = wsw(p, l, O_WUKVR);
        { const int t1 = tid(); if (t1 < 128) s_rs[t1] = 1.f; }
        is_ctx = 0; seq = row0 >> 8; kp0 = row0 & 255;
      }
      gemm_tile(A, 256, Wt + (size_t)hd * 128 * 256, 256, 256, acc, smem);
      LANEVARS
      const int Lk = is_ctx ? 256 : LK_LAT;
      if (wc == 0) {
        u16* Kn = (is_ctx ? wsp<u16>(p, O_KNC) : wsp<u16>(p, O_KNL)) + ((size_t)seq * 8 + hd) * Lk * 64;
#pragma unroll
        for (int i = 0; i < 4; ++i)
#pragma unroll
          for (int j = 0; j < 4; ++j)
#pragma unroll
            for (int e = 0; e < 4; ++e) {
              const int r = wr * 64 + i * 16 + g4 * 4 + e;
              Kn[(size_t)(kp0 + r) * 64 + j * 16 + c16] = f2bf(acc[i][j][e] * s_rs[r]);
              if (e == 3) SB();
            }
      } else {
        u16* Vt = (is_ctx ? wsp<u16>(p, O_VTC) : wsp<u16>(p, O_VTL)) + ((size_t)seq * 8 + hd) * 64 * Lk;
#pragma unroll
        for (int i = 0; i < 4; ++i)
#pragma unroll
          for (int j = 0; j < 4; ++j) {
            SB();
            const int r = wr * 64 + i * 16 + g4 * 4;
            uint2 o;
            o.x = pack2(acc[i][j][0] * s_rs[r], acc[i][j][1] * s_rs[r + 1]);
            o.y = pack2(acc[i][j][2] * s_rs[r + 2], acc[i][j][3] * s_rs[r + 3]);
            *(uint2*)(Vt + (size_t)(j * 16 + c16) * Lk + kp0 + r) = o;
          }
      }
    }
    __syncthreads();
  }
}

template <int NS> DI void attn_gload(const u16* k0, int k0s, const u16* k1, const u16* vt, int vts,
                                     uint4& rk0, uint4& rk1, uint4& rk2, uint4& rv0, uint4& rv1) {
  const int t = tid();
  if (NS == 6) {
    { const int c = t, key = c / 12, ch = c % 12;
      rk0 = (ch < 8) ? *(const uint4*)(k0 + (size_t)key * k0s + ch * 8) : *(const uint4*)(k1 + (size_t)key * 32 + (ch - 8) * 8); }
    { const int c = t + 256, key = c / 12, ch = c % 12;
      rk1 = (ch < 8) ? *(const uint4*)(k0 + (size_t)key * k0s + ch * 8) : *(const uint4*)(k1 + (size_t)key * 32 + (ch - 8) * 8); }
    { const int c = t + 512, key = c / 12, ch = c % 12;
      rk2 = (ch < 8) ? *(const uint4*)(k0 + (size_t)key * k0s + ch * 8) : *(const uint4*)(k1 + (size_t)key * 32 + (ch - 8) * 8); }
  } else {
    { const int c = t, key = c >> 3, ch = c & 7; rk0 = *(const uint4*)(k0 + (size_t)key * k0s + ch * 8); }
    { const int c = t + 256, key = c >> 3, ch = c & 7; rk1 = *(const uint4*)(k0 + (size_t)key * k0s + ch * 8); }
  }
  { const int c = t, dv = c >> 3, ch = c & 7; rv0 = *(const uint4*)(vt + (size_t)dv * vts + ch * 8); }
  { const int c = t + 256, dv = c >> 3, ch = c & 7; rv1 = *(const uint4*)(vt + (size_t)dv * vts + ch * 8); }
}
template <int NS> DI void attn_sstore(char* smem, const uint4& rk0, const uint4& rk1, const uint4& rk2, const uint4& rv0, const uint4& rv1) {
  constexpr int KSTR = (NS == 6) ? 208 : 144;
  const int t = tid();
  if (NS == 6) {
    { const int c = t, key = c / 12, ch = c % 12; *(uint4*)(smem + key * KSTR + ch * 16) = rk0; }
    { const int c = t + 256, key = c / 12, ch = c % 12; *(uint4*)(smem + key * KSTR + ch * 16) = rk1; }
    { const int c = t + 512, key = c / 12, ch = c % 12; *(uint4*)(smem + key * KSTR + ch * 16) = rk2; }
  } else {
    { const int c = t, key = c >> 3, ch = c & 7; *(uint4*)(smem + key * KSTR + ch * 16) = rk0; }
    { const int c = t + 256, key = c >> 3, ch = c & 7; *(uint4*)(smem + key * KSTR + ch * 16) = rk1; }
  }
  { const int c = t, dv = c >> 3, ch = c & 7; char* d = smem + 13312 + dv * 136 + ch * 16;
    *(uint2*)d = uint2{rv0.x, rv0.y}; *(uint2*)(d + 8) = uint2{rv0.z, rv0.w}; }
  { const int c = t + 256, dv = c >> 3, ch = c & 7; char* d = smem + 13312 + dv * 136 + ch * 16;
    *(uint2*)d = uint2{rv1.x, rv1.y}; *(uint2*)(d + 8) = uint2{rv1.z, rv1.w}; }
}

#define PACK8(S, s2) __builtin_bit_cast(bf16x8, uint4{pack2(S[8 * (s2)], S[8 * (s2) + 1]), pack2(S[8 * (s2) + 2], S[8 * (s2) + 3]), \
                                                        pack2(S[8 * (s2) + 4], S[8 * (s2) + 5]), pack2(S[8 * (s2) + 6], S[8 * (s2) + 7])})

template <int NS>
DI void attn_item(const u16* kA, int kAs, const u16* krA, const u16* vtA, int vtAs, int nA, int kposA, int maskA,
                  const u16* kB, int kBs, const u16* vtB, int vtBs, int nB,
                  const u16* qa, const u16* qb, float sc2, float m0, float l0, int qpos, u16* yrow, char* smem) {
  constexpr int KSTR = (NS == 6) ? 208 : 144;
  const int lane = tid() & 63;
  const int r32 = lane & 31, hh = lane >> 5;
  bf16x8 qf0, qf1, qf2, qf3, qf4, qf5;
  qf0 = *(const bf16x8*)(qa + 0 + 8 * hh); qf1 = *(const bf16x8*)(qa + 16 + 8 * hh);
  qf2 = *(const bf16x8*)(qa + 32 + 8 * hh); qf3 = *(const bf16x8*)(qa + 48 + 8 * hh);
  if (NS == 6) { qf4 = *(const bf16x8*)(qb + 0 + 8 * hh); qf5 = *(const bf16x8*)(qb + 16 + 8 * hh); }
  else { qf4 = qf0; qf5 = qf0; }
#define QSCALE(qf) { uint4 u_ = __builtin_bit_cast(uint4, qf); \
    u_.x = pack2(__uint_as_float(u_.x << 16) * sc2, __uint_as_float(u_.x & 0xffff0000u) * sc2); \
    u_.y = pack2(__uint_as_float(u_.y << 16) * sc2, __uint_as_float(u_.y & 0xffff0000u) * sc2); \
    u_.z = pack2(__uint_as_float(u_.z << 16) * sc2, __uint_as_float(u_.z & 0xffff0000u) * sc2); \
    u_.w = pack2(__uint_as_float(u_.w << 16) * sc2, __uint_as_float(u_.w & 0xffff0000u) * sc2); \
    qf = __builtin_bit_cast(bf16x8, u_); }
  QSCALE(qf0) QSCALE(qf1) QSCALE(qf2) QSCALE(qf3)
  if (NS == 6) { QSCALE(qf4) QSCALE(qf5) }
#undef QSCALE
  f32x16 O0, O1;
#pragma unroll
  for (int e = 0; e < 16; ++e) { O0[e] = 0.f; O1[e] = 0.f; }
  float m_run = m0, l_run = l0;
  uint4 rk0, rk1, rk2, rv0, rv1;
  rk2 = uint4{0, 0, 0, 0};
  const int ntiles = nA + nB;
#define TILE_GLOAD(jn) { if ((jn) < nA) attn_gload<NS>(kA + (size_t)(jn) * 64 * kAs, kAs, krA + (size_t)(jn) * 64 * 32, vtA + (jn) * 64, vtAs, rk0, rk1, rk2, rv0, rv1); \
    else { const int jb_ = (jn) - nA; attn_gload<NS>(kB + (size_t)jb_ * 64 * kBs, kBs, nullptr, vtB + jb_ * 64, vtBs, rk0, rk1, rk2, rv0, rv1); } }
  constexpr int STG = 22528;
  TILE_GLOAD(0)
  attn_sstore<NS>(smem, rk0, rk1, rk2, rv0, rv1);
  if (ntiles > 1) TILE_GLOAD(1)
  __syncthreads();
  for (int j = 0; j < ntiles; ++j) {
    char* sbase = smem + (j & 1) * STG;
    const int kpos = kposA + 64 * j;
    const bool masked = maskA && (j < nA);
    MB();
    f32x16 S0, S1;
#pragma unroll
    for (int e = 0; e < 16; ++e) { S0[e] = 0.f; S1[e] = 0.f; }
    const char* ka0 = sbase + r32 * KSTR + 16 * hh;
    const char* ka1 = sbase + (32 + r32) * KSTR + 16 * hh;
#define QK_STEP(s, qf) { bf16x8 a0 = *(const bf16x8*)(ka0 + 32 * (s)); bf16x8 a1 = *(const bf16x8*)(ka1 + 32 * (s)); \
      S0 = __builtin_amdgcn_mfma_f32_32x32x16_bf16(a0, qf, S0, 0, 0, 0); S1 = __builtin_amdgcn_mfma_f32_32x32x16_bf16(a1, qf, S1, 0, 0, 0); }
    QK_STEP(0, qf0) QK_STEP(1, qf1) QK_STEP(2, qf2) QK_STEP(3, qf3)
    if (NS == 6) { QK_STEP(4, qf4) QK_STEP(5, qf5) }
    SB();
    float mx = m_run;
#pragma unroll
    for (int e = 0; e < 16; ++e) {
      float v0 = S0[e], v1 = S1[e];
      if (masked) {
        const int kp = kpos + (e & 3) + 8 * (e >> 2) + 4 * hh;
        int d0 = qpos - kp; d0 = d0 < 0 ? -d0 : d0;
        int d1 = qpos - (kp + 32); d1 = d1 < 0 ? -d1 : d1;
        if (d0 > 128) v0 = -1e30f;
        if (d1 > 128) v1 = -1e30f;
      }
      S0[e] = v0; S1[e] = v1;
      mx = fmaxf(mx, fmaxf(v0, v1));
    }
    mx = fmaxf(mx, __shfl_xor(mx, 32));
    const float alpha = __builtin_amdgcn_exp2f(m_run - mx);
    m_run = mx;
    float rsum = 0.f;
#pragma unroll
    for (int e = 0; e < 16; ++e) {
      float p0 = __builtin_amdgcn_exp2f(S0[e] - mx), p1 = __builtin_amdgcn_exp2f(S1[e] - mx);
      S0[e] = p0; S1[e] = p1;
      rsum += p0 + p1;
    }
    rsum += __shfl_xor(rsum, 32);
    l_run = l_run * alpha + rsum;
#pragma unroll
    for (int e = 0; e < 16; ++e) { O0[e] *= alpha; O1[e] *= alpha; }
    const char* sv0 = sbase + 13312 + r32 * 136 + 8 * hh;
    const char* sv1 = sv0 + 32 * 136;
#define PV_STEP(pb, ka) { \
      { uint2 lo = *(const uint2*)(sv0 + (ka) * 2), hi = *(const uint2*)(sv0 + (ka) * 2 + 16); \
        bf16x8 va = __builtin_bit_cast(bf16x8, uint4{lo.x, lo.y, hi.x, hi.y}); O0 = __builtin_amdgcn_mfma_f32_32x32x16_bf16(va, pb, O0, 0, 0, 0); } \
      { uint2 lo = *(const uint2*)(sv1 + (ka) * 2), hi = *(const uint2*)(sv1 + (ka) * 2 + 16); \
        bf16x8 va = __builtin_bit_cast(bf16x8, uint4{lo.x, lo.y, hi.x, hi.y}); O1 = __builtin_amdgcn_mfma_f32_32x32x16_bf16(va, pb, O1, 0, 0, 0); } }
    SB();
    { bf16x8 pb = PACK8(S0, 0); PV_STEP(pb, 0) }
    { bf16x8 pb = PACK8(S0, 1); PV_STEP(pb, 16) }
    SB();
    { bf16x8 pb = PACK8(S1, 0); PV_STEP(pb, 32) }
    { bf16x8 pb = PACK8(S1, 1); PV_STEP(pb, 48) }
    SB();
    if (j + 1 < ntiles) {
      attn_sstore<NS>(smem + ((j + 1) & 1) * STG, rk0, rk1, rk2, rv0, rv1);
      if (j + 2 < ntiles) TILE_GLOAD(j + 2)
    }
    __syncthreads();
  }
#undef TILE_GLOAD
  const float inv = 1.f / l_run;
#pragma unroll
  for (int e4 = 0; e4 < 4; ++e4) {
    uint2 o;
    o.x = pack2(O0[4 * e4] * inv, O0[4 * e4 + 1] * inv); o.y = pack2(O0[4 * e4 + 2] * inv, O0[4 * e4 + 3] * inv);
    *(uint2*)(yrow + 8 * e4 + 4 * hh) = o;
    o.x = pack2(O1[4 * e4] * inv, O1[4 * e4 + 1] * inv); o.y = pack2(O1[4 * e4 + 2] * inv, O1[4 * e4 + 3] * inv);
    *(uint2*)(yrow + 32 + 8 * e4 + 4 * hh) = o;
  }
}

template <int MODE>
DI void scan_seg(const Params& p, int l, int seq, int blk, int d, int seg, char* smem) {
  const int t = tid(), lane = t & 63, w = t >> 6;
  const int c16 = lane & 15, g4 = lane >> 4;
  const bool is_ctx = seq < 16;
  const int b = is_ctx ? seq : seq - 16;
  const int L = is_ctx ? 256 : 4096;
  const int gbase = is_ctx ? b * 256 : T_CTX + b * 4096;
  const u16* XR = wsp<u16>(p, O_XR);
  u16* Y = wsp<u16>(p, O_YRNN);
  float* SUM = wsp<float>(p, O_SUM);
  char* sXc = smem;
  float* sA = (float*)(smem + 8704);
  float* sU = (float*)(smem + 8704 + 16384);
  const int cch = t & 127, th = t >> 7;
  const int chg = blk * 128 + cch;
  const float w0 = p.conv_w[(l * 4 + 0) * 1024 + chg], w1 = p.conv_w[(l * 4 + 1) * 1024 + chg];
  const float w2 = p.conv_w[(l * 4 + 2) * 1024 + chg], w3 = p.conv_w[(l * 4 + 3) * 1024 + chg];
  const float cb = p.conv_b[l * 1024 + chg];
  bf16x8 bw[4][4];
  {
    const u16* WL = wsw(p, l, O_WLRU) + (size_t)(d * 8 + blk) * 256 * 128 + (size_t)(32 * w + c16) * 128 + g4 * 8;
#pragma unroll
    for (int nf = 0; nf < 4; ++nf)
#pragma unroll
      for (int ks = 0; ks < 4; ++ks)
        bw[nf][ks] = *(const bf16x8*)(WL + (size_t)((nf & 1) * 16 + (nf >> 1) * 128) * 128 + ks * 32);
  }
  float ba[2], bi[2], cl[2];
#pragma unroll
  for (int jn = 0; jn < 2; ++jn) {
    const int ch = (l * 2 + d) * 1024 + blk * 128 + 32 * w + 16 * jn + c16;
    ba[jn] = p.lru_ba[ch]; bi[jn] = p.lru_bi[ch];
    cl[jn] = -8.f * log1pf(__expf(-p.lru_lam[ch]));
  }
  float h = 0.f, P = 1.f;
  if (MODE == 1 && !is_ctx && t < 128) {
    h = p.state[(((size_t)b * 4 + l) * 2 + d) * 1024 + blk * 128 + t];
    const float* sm = SUM + ((size_t)((b * 8 + blk) * 2 + d) * 16) * 256 + t;
    if (d == 0) { for (int s2 = 0; s2 < seg; ++s2) h = sm[s2 * 256] * h + sm[s2 * 256 + 128]; }
    else { for (int s2 = 15; s2 > seg; --s2) h = sm[s2 * 256] * h + sm[s2 * 256 + 128]; }
  }
#define X19(F) F(0) F(1) F(2) F(3) F(4) F(5) F(6) F(7) F(8) F(9) F(10) F(11) F(12) F(13) F(14) F(15) F(16) F(17) F(18)
#define XDECL(q) u16 xr##q = 0;
#define XLOAD(q) { const int pos = tcn + th * 16 - 1 + (q); xr##q = (pos >= 0 && pos < L) ? XR[(size_t)(gbase + pos) * 1024 + chg] : (u16)0; }
#define XCVT(q) xv[q] = bf2f(xr##q);
  X19(XDECL)
  { const int tcn = seg * 256 + (d == 0 ? 0 : 7) * 32; X19(XLOAD) }
  for (int ci = 0; ci < 8; ++ci) {
    const int tc0 = seg * 256 + (d == 0 ? ci : 7 - ci) * 32;
    {
      float xv[19];
      X19(XCVT)
#pragma unroll
      for (int q = 0; q < 16; ++q) {
        float xc = cb + w0 * xv[q] + w1 * xv[q + 1] + w2 * xv[q + 2] + w3 * xv[q + 3];
        *(u16*)(sXc + (th * 16 + q) * 272 + cch * 2) = f2bf(xc);
      }
    }
    unsigned yold0 = 0, yold1 = 0, yold2 = 0, yold3 = 0, yold4 = 0, yold5 = 0, yold6 = 0, yold7 = 0;
    {
      const int cn = ci < 7 ? ci + 1 : ci;
      const int tcn = seg * 256 + (d == 0 ? cn : 7 - cn) * 32;
      X19(XLOAD)
      if (MODE == 1 && d == 1) {
        const unsigned* yb = (const unsigned*)(Y + (size_t)(gbase + tc0 + (t >> 6)) * 1024 + blk * 128 + (t & 63) * 2);
        yold0 = yb[0]; yold1 = yb[4 * 512]; yold2 = yb[8 * 512]; yold3 = yb[12 * 512];
        yold4 = yb[16 * 512]; yold5 = yb[20 * 512]; yold6 = yb[24 * 512]; yold7 = yb[28 * 512];
      }
    }
    MB();
    __syncthreads();
    f32x4 aR[2][2], aI[2][2];
#pragma unroll
    for (int im = 0; im < 2; ++im)
#pragma unroll
      for (int jn = 0; jn < 2; ++jn) { aR[im][jn] = f32x4{0.f, 0.f, 0.f, 0.f}; aI[im][jn] = f32x4{0.f, 0.f, 0.f, 0.f}; }
#pragma unroll
    for (int ks = 0; ks < 4; ++ks)
#pragma unroll
      for (int im = 0; im < 2; ++im) {
        bf16x8 af = *(const bf16x8*)(sXc + (16 * im + c16) * 272 + (ks * 32 + g4 * 8) * 2);
#pragma unroll
        for (int jn = 0; jn < 2; ++jn) {
          aR[im][jn] = __builtin_amdgcn_mfma_f32_16x16x32_bf16(af, bw[jn][ks], aR[im][jn], 0, 0, 0);
          aI[im][jn] = __builtin_amdgcn_mfma_f32_16x16x32_bf16(af, bw[2 + jn][ks], aI[im][jn], 0, 0, 0);
        }
      }
#pragma unroll
    for (int im = 0; im < 2; ++im)
#pragma unroll
      for (int jn = 0; jn < 2; ++jn)
#pragma unroll
        for (int e = 0; e < 4; ++e) {
          const int tt = 16 * im + 4 * g4 + e, c = 32 * w + 16 * jn + c16;
          const float r = sigmoidf_(aR[im][jn][e] + ba[jn]);
          const float ig = sigmoidf_(aI[im][jn][e] + bi[jn]);
          const float a = __expf(cl[jn] * r);
          const float xc = bf2f(*(const u16*)(sXc + tt * 272 + c * 2));
          const float u = sqrtf(fmaxf(1.f - a * a, 0.f)) * ig * xc;
          sA[tt * 128 + c] = a; sU[tt * 128 + c] = u;
        }
    __syncthreads();
    if (t < 128) {
      if (d == 0) {
#pragma unroll 8
        for (int s = 0; s < 32; ++s) {
          const float a = sA[s * 128 + t];
          h = a * h + sU[s * 128 + t];
          if (MODE == 0) P *= a; else sU[s * 128 + t] = h;
        }
      } else {
#pragma unroll 8
        for (int s = 31; s >= 0; --s) {
          const float a = sA[s * 128 + t];
          h = a * h + sU[s * 128 + t];
          if (MODE == 0) P *= a; else sU[s * 128 + t] = h;
        }
      }
    }
    __syncthreads();
    if (MODE == 1) {
      const int c2 = (t & 63) * 2;
      unsigned* yb = (unsigned*)(Y + (size_t)(gbase + tc0 + (t >> 6)) * 1024 + blk * 128 + c2);
      const float* su = sU + (t >> 6) * 128 + c2;
#define YOUT(i, yo) { float h0 = su[(4 * (i)) * 128], h1 = su[(4 * (i)) * 128 + 1]; \
        if (d == 1) { h0 += __uint_as_float((yo) << 16); h1 += __uint_as_float((yo) & 0xffff0000u); } \
        yb[(size_t)(4 * (i)) * 512] = pack2(h0, h1); }
      YOUT(0, yold0) YOUT(1, yold1) YOUT(2, yold2) YOUT(3, yold3) YOUT(4, yold4) YOUT(5, yold5) YOUT(6, yold6) YOUT(7, yold7)
#undef YOUT
    }
  }
#undef X19
#undef XDECL
#undef XLOAD
#undef XCVT
  if (MODE == 0) {
    if (t < 128) {
      float* sm = SUM + ((size_t)(((b * 8 + blk) * 2 + d) * 16 + seg)) * 256 + t;
      sm[0] = P; sm[128] = h;
    }
  } else if (is_ctx && t < 128) {
    p.out[OUT_RG + (((size_t)b * 4 + l) * 2 + d) * 1024 + blk * 128 + t] = h;
  }
  __syncthreads();
}

DI void phase_mix(const Params& p, int l, char* smem) {
  constexpr float LOG2E = 1.4426950408889634f;
  constexpr int N0 = 1024, N1 = N0 + 2048, N2 = N1 + 2048, N3 = N2 + 128, N4 = N3 + 256, N5 = N4 + 256;
  for (int base = 0; base < N5; base += gridDim.x) {
    const int it = xcd_map(base);
    if (it >= N5) continue;
    const int t = tid(), lane = t & 63, w = t >> 6;
    const int r32 = lane & 31;
    if (it < N0 || (it >= N2 && it < N3)) {
      int seq, blk, seg;
      if (it < N0) { seg = it & 15; blk = (it >> 4) & 7; seq = 16 + (it >> 7); }
      else { const int i = it - N2; seg = 0; blk = i & 7; seq = i >> 3; }
      scan_seg<1>(p, l, seq, blk, 0, seg, smem);
      scan_seg<1>(p, l, seq, blk, 1, seg, smem);
#if PROBE == 4
      scan_seg<1>(p, l, seq, blk, 0, seg, smem);
      scan_seg<1>(p, l, seq, blk, 1, seg, smem);
#endif
    } else if (it < N1 || (it >= N3 && it < N4)) {
      const bool lat = it < N1;
      int b, h, qb;
      if (lat) { const int i = it - N0; qb = i & 31; h = (i >> 5) & 7; b = i >> 8; }
      else { const int i = it - N3; qb = i & 1; h = (i >> 1) & 7; b = i >> 4; }
      const int Lk = lat ? LK_LAT : 256;
      const int gq = (lat ? T_CTX + b * 4096 : b * 256) + qb * 128 + w * 32 + r32;
      const u16* Kn = (lat ? wsp<u16>(p, O_KNL) : wsp<u16>(p, O_KNC)) + ((size_t)b * 8 + h) * Lk * 64;
      const u16* Kr = (lat ? wsp<u16>(p, O_KRL) : wsp<u16>(p, O_KRC)) + (size_t)b * Lk * 32;
      const u16* Vt = (lat ? wsp<u16>(p, O_VTL) : wsp<u16>(p, O_VTC)) + ((size_t)b * 8 + h) * 64 * Lk;
      const u16* Q = wsp<u16>(p, O_Q) + (size_t)gq * 768;
      u16* yrow = wsp<u16>(p, O_CQ) + (size_t)gq * 512 + h * 64;
      attn_item<6>(Kn, 64, Kr, Vt, Lk, Lk >> 6, 0, 0, nullptr, 0, nullptr, 0, 0,
                   Q + h * 64, Q + 512 + h * 32, 0.10206207261596577f * LOG2E, -1e30f, 0.f, 0, yrow, smem);
#if PROBE == 5
      __syncthreads();
      attn_item<6>(Kn, 64, Kr, Vt, Lk, Lk >> 6, 0, 0, nullptr, 0, nullptr, 0, 0,
                   Q + h * 64, Q + 512 + h * 32, 0.10206207261596577f * LOG2E, -1e30f, 0.f, 0, yrow, smem);
#endif
    } else {
      const bool lat = it < N2;
      int b, h, qb;
      if (lat) { const int i = it - N1; qb = i & 31; h = (i >> 5) & 7; b = i >> 8; }
      else { const int i = it - N4; qb = i & 1; h = (i >> 1) & 7; b = i >> 4; }
      const int kvh = h >> 2;
      const int gseq = lat ? T_CTX + b * 4096 : b * 256;
      const int qpos = qb * 128 + w * 32 + r32;
      const int gq = gseq + qpos;
      u16* qrow = wsp<u16>(p, O_QS) + (size_t)gq * 512 + h * 64;
      const float sink2 = p.sink[l * 8 + h] * LOG2E;
      const int t0 = qb * 128;
      int jlo = 0, jhi = 6;
      if (t0 == 0) jlo = 2;
      if (t0 + 128 >= 4096) jhi = 4;
      const int ks0 = lat ? t0 - 128 + 64 * jlo : 0;
      const int nA = lat ? jhi - jlo : 4;
      const u16* KS = wsp<u16>(p, O_KS) + (size_t)(gseq + ks0) * 128 + kvh * 64;
      const u16* VT = lat ? wsp<u16>(p, O_VTSL) + ((size_t)b * 2 + kvh) * 64 * 4096 + ks0
                          : wsp<u16>(p, O_VTSC) + ((size_t)b * 2 + kvh) * 64 * 256;
      const u16* KC = wsp<u16>(p, O_KSC) + (size_t)b * 256 * 128 + kvh * 64;
      const u16* VC = wsp<u16>(p, O_VTSCC) + ((size_t)b * 2 + kvh) * 64 * 256;
      attn_item<4>(KS, 128, nullptr, VT, lat ? 4096 : 256, nA, ks0, lat ? 1 : 0, KC, 128, VC, 256, lat ? 4 : 0,
                   qrow, nullptr, 0.125f * LOG2E, sink2, 1.f, qpos, qrow, smem);
    }
    __syncthreads();
  }
}

DI void phase_gate(const Params& p, int l, char* smem) {
  const u16* H = wsp<u16>(p, O_H);
  const u16* W = wsw(p, l, O_WINB);
  for (int base = 0; base < 288 * 40; base += gridDim.x) {
    const int tile = xcd_map(base);
    if (tile >= 288 * 40) continue;
    const int sb = tile >> 6, jj = tile & 63;
    const int mt = (sb / 5) * 8 + (jj >> 3), nt = (sb % 5) * 8 + (jj & 7);
    const int g0 = mt * 128;
    f32x4 acc[4][4];
    zero_acc(acc);
    gemm_tile(H + (size_t)g0 * 1024, 1024, W + (size_t)nt * 128 * 1024, 1024, 1024, acc, smem);
    LANEVARS
    if (nt < 16) {
      u16* dst; int ld, cb;
      if (nt < 8) { dst = wsp<u16>(p, O_YRNN); ld = 1024; cb = nt * 128; }
      else if (nt < 12) { dst = wsp<u16>(p, O_CQ); ld = 512; cb = (nt - 8) * 128; }
      else { dst = wsp<u16>(p, O_QS); ld = 512; cb = (nt - 12) * 128; }
#pragma unroll
      for (int i = 0; i < 4; ++i)
#pragma unroll
        for (int j = 0; j < 4; ++j)
#pragma unroll
          for (int e = 0; e < 4; ++e) {
            const int g = g0 + wr * 64 + i * 16 + g4 * 4 + e;
            u16* d = dst + (size_t)g * ld + cb + wc * 64 + j * 16 + c16;
            const float gv = acc[i][j][e];
            *d = f2bf(bf2f(*d) * gv * sigmoidf_(gv));
            if (e == 3) SB();
          }
    } else {
      const int br = (nt - 16) >> 3, cb = ((nt - 16) & 7) * 128;
      u16* dst = br == 0 ? wsp<u16>(p, O_XR) : wsp<u16>(p, O_KS) + (size_t)(br - 1) * T_ALL * 1024;
#pragma unroll
      for (int i = 0; i < 4; ++i)
#pragma unroll
        for (int j = 0; j < 4; ++j)
#pragma unroll
          for (int e = 0; e < 4; ++e) {
            const int g = g0 + wr * 64 + i * 16 + g4 * 4 + e;
            dst[(size_t)g * 1024 + cb + wc * 64 + j * 16 + c16] = f2bf(sigmoidf_(acc[i][j][e]));
            if (e == 3) SB();
          }
    }
  }
}

DI void phase_merge(const Params& p, int l, char* smem) {
  u16* U = wsp<u16>(p, O_H);
  for (int base = 0; base < 288 * 8; base += gridDim.x) {
    const int tile = xcd_map(base);
    if (tile >= 288 * 8) continue;
    const int mt = tile >> 3, nt = tile & 7;
    const int g0 = mt * 128;
    f32x4 u[4][4];
    zero_acc(u);
    for (int br = 0; br < 3; ++br) {
      f32x4 acc[4][4];
      zero_acc(acc);
      const u16* Z; const u16* WT; int kz; const u16* M;
      if (br == 0) { Z = wsp<u16>(p, O_YRNN) + (size_t)g0 * 1024; WT = wsw(p, l, O_WBRR) + (size_t)nt * 128 * 1024; kz = 1024; M = wsp<u16>(p, O_XR); }
      else if (br == 1) { Z = wsp<u16>(p, O_CQ) + (size_t)g0 * 512; WT = wsw(p, l, O_WBRM) + (size_t)nt * 128 * 512; kz = 512; M = wsp<u16>(p, O_KS); }
      else { Z = wsp<u16>(p, O_QS) + (size_t)g0 * 512; WT = wsw(p, l, O_WBRS) + (size_t)nt * 128 * 512; kz = 512; M = wsp<u16>(p, O_KS) + (size_t)T_ALL * 1024; }
      gemm_tile(Z, kz, WT, kz, kz, acc, smem);
      LANEVARS
#pragma unroll
      for (int i = 0; i < 4; ++i)
#pragma unroll
        for (int j = 0; j < 4; ++j)
#pragma unroll
          for (int e = 0; e < 4; ++e) {
            const int g = g0 + wr * 64 + i * 16 + g4 * 4 + e;
            u[i][j][e] += bf2f(M[(size_t)g * 1024 + nt * 128 + wc * 64 + j * 16 + c16]) * acc[i][j][e];
            if (e == 3) SB();
          }
    }
    LANEVARS
#pragma unroll
    for (int i = 0; i < 4; ++i)
#pragma unroll
      for (int j = 0; j < 4; ++j)
#pragma unroll
        for (int e = 0; e < 4; ++e) {
          const int g = g0 + wr * 64 + i * 16 + g4 * 4 + e;
          U[(size_t)g * 1024 + nt * 128 + wc * 64 + j * 16 + c16] = f2bf(u[i][j][e]);
        }
  }
}

DI void phase_out(const Params& p, int l, char* smem) {
  const u16* U = wsp<u16>(p, O_H);
  const u16* W = wsw(p, l, O_WOUT);
  const float* MOD = wsp<float>(p, O_MOD) + (size_t)l * 9 * 3072;
  for (int base = 0; base < 288 * 8; base += gridDim.x) {
    const int tile = xcd_map(base);
    if (tile >= 288 * 8) continue;
    const int mt = tile >> 3, nt = tile & 7;
    const int g0 = mt * 128;
    const int ci = g0 < T_CTX ? 8 : ((g0 - T_CTX) >> 12);
    f32x4 acc[4][4];
    zero_acc(acc);
    gemm_tile(U + (size_t)g0 * 1024, 1024, W + (size_t)nt * 128 * 1024, 1024, 1024, acc, smem);
    LANEVARS
#pragma unroll
    for (int j = 0; j < 4; ++j) {
      const int col = nt * 128 + wc * 64 + j * 16 + c16;
      const float gt = MOD[ci * 3072 + 2048 + col];
#pragma unroll
      for (int i = 0; i < 4; ++i)
#pragma unroll
        for (int e = 0; e < 4; ++e) {
          const int g = g0 + wr * 64 + i * 16 + g4 * 4 + e;
          const float xo = xin_row(p, l, g)[col];
          p.out[(size_t)g * 1024 + col] = xo + gt * acc[i][j][e];
          if (e == 3) SB();
        }
    }
  }
}

DI void phase_final(const Params& p) {
  const int t = tid(), lane = t & 63, w = t >> 6;
  for (int row = blockIdx.x * 4 + w; row < T_ALL; row += gridDim.x * 4) {
    float* x = p.out + (size_t)row * 1024;
    float4 v[4];
    float ss = 0.f;
#pragma unroll
    for (int i = 0; i < 4; ++i) {
      v[i] = *(const float4*)(x + i * 256 + lane * 4);
      ss += v[i].x * v[i].x + v[i].y * v[i].y + v[i].z * v[i].z + v[i].w * v[i].w;
    }
    ss = wave_sum(ss);
    const float rs = rsqrtf(ss * (1.f / 1024.f) + EPS);
#pragma unroll
    for (int i = 0; i < 4; ++i) {
      const int c = i * 256 + lane * 4;
      const float4 g = *(const float4*)(p.final_norm + c);
      float4 o = {v[i].x * rs * g.x, v[i].y * rs * g.y, v[i].z * rs * g.z, v[i].w * rs * g.w};
      *(float4*)(x + c) = o;
    }
  }
}

constexpr int NPHASE_PER_LAYER = 7;
DI void run_phase(const Params& p, int ph, char* smem) {
  if (ph == 0) { phase_mod(p, smem); return; }
  if (ph == 1 + NLAYER * NPHASE_PER_LAYER) { phase_final(p); return; }
  const int l = (ph - 1) / NPHASE_PER_LAYER, s = (ph - 1) % NPHASE_PER_LAYER;
  switch (s) {
    case 0: phase_prep(p, l); break;
    case 1: phase_gemmA(p, l, smem); break;
    case 2: phase_qkv(p, l, smem); break;
    case 3: phase_mix(p, l, smem); break;
    case 4: phase_gate(p, l, smem); break;
    case 5: phase_merge(p, l, smem); break;
    default: phase_out(p, l, smem); break;
  }
}
constexpr int NPHASE = 2 + NLAYER * NPHASE_PER_LAYER;

#if MEGA
DI Params launder(const Params& p) {
  size_t z = 0;
  asm volatile("" : "+s"(z));
  Params q = p; q.ws = p.ws + z; q.out = p.out + z;
  return q;
}
DI void fast_barrier(unsigned* ctr, unsigned& epoch) {
  asm volatile("s_waitcnt vmcnt(0)" ::: "memory");
  __syncthreads();
  epoch += gridDim.x;
  if (threadIdx.x == 0) {
    __builtin_amdgcn_fence(__ATOMIC_RELEASE, "agent");
    asm volatile("s_waitcnt vmcnt(0)" ::: "memory");
    __hip_atomic_fetch_add(ctr, 1u, __ATOMIC_RELAXED, __HIP_MEMORY_SCOPE_AGENT);
    unsigned spins = 0;
    while (__hip_atomic_load(ctr, __ATOMIC_RELAXED, __HIP_MEMORY_SCOPE_AGENT) < epoch) {
      __builtin_amdgcn_s_sleep(1);
      if (++spins > (1u << 22)) break;
    }
    __builtin_amdgcn_fence(__ATOMIC_ACQUIRE, "agent");
    asm volatile("s_waitcnt vmcnt(0)" ::: "memory");
  }
  __syncthreads();
}
#define GSYNC() fast_barrier(bar_ctr, bar_epoch)
__global__ void __launch_bounds__(256, 2) mega_kernel(Params p) {
  __shared__ __attribute__((aligned(16))) char smem[66048];
  cg::grid_group grid = cg::this_grid();
  unsigned* bar_ctr = (unsigned*)(p.ws + O_BAR);
  unsigned bar_epoch = 0;
  phase_mod(launder(p), smem);
  convert_weights(launder(p), 0);
  grid.sync();
  for (int l = 0; l < NLAYER; ++l) {
    phase_prep(launder(p), l);
    GSYNC();
#if PROBE == 1
    phase_prep(launder(p), l);
    GSYNC();
#endif
    phase_gemmA(launder(p), l, smem);
    GSYNC();
#if PROBE == 2
    phase_gemmA(launder(p), l, smem);
    GSYNC();
#endif
    phase_qkv(launder(p), l, smem);
    GSYNC();
    phase_mix(launder(p), l, smem);
    if (l + 1 < NLAYER) convert_weights(launder(p), l + 1);
    GSYNC();
    phase_gate(launder(p), l, smem);
    GSYNC();
    phase_merge(launder(p), l, smem);
    GSYNC();
#if PROBE == 3
    phase_merge(launder(p), l, smem);
    GSYNC();
#endif
    phase_out(launder(p), l, smem);
    GSYNC();
  }
  phase_final(launder(p));
}

#else
__global__ void __launch_bounds__(256, 2) phase_kernel(Params p, int ph) {
  __shared__ __attribute__((aligned(16))) char smem[66048];
  run_phase(p, ph, smem);
}

#endif
extern "C" void kernel_launch(void* const* d_in, const int* in_sizes, int n_in, void* d_out, int out_size, void* d_ws,
                              size_t ws_size, hipStream_t stream) {
  Params p{};
  const float** pp = (const float**)&p;
  for (int i = 0; i < 30; ++i) pp[i] = (const float*)d_in[i];
  p.out = (float*)d_out;
  p.ws = (char*)d_ws;
  if (ws_size < WS_NEED) fprintf(stderr, "workspace too small: %zu < %zu\n", ws_size, (size_t)WS_NEED);
#if MEGA
  static int grid_blocks = 0;
  if (!grid_blocks) {
    int dev = 0, cus = 0, per_cu = 0;
    hipGetDevice(&dev);
    hipDeviceGetAttribute(&cus, hipDeviceAttributeMultiprocessorCount, dev);
    hipOccupancyMaxActiveBlocksPerMultiprocessor(&per_cu, mega_kernel, 256, 0);
    if (per_cu > 2) per_cu = 2;
    grid_blocks = cus * per_cu;
  }
  (void)hipMemsetAsync((char*)d_ws + O_BAR, 0, 256, stream);
  void* args[] = {&p};
  hipError_t e = hipLaunchCooperativeKernel((void*)mega_kernel, dim3(grid_blocks), dim3(256), args, 0, stream);
  if (e != hipSuccess) fprintf(stderr, "cooperative launch failed: %s (grid %d)\n", hipGetErrorString(e), grid_blocks);
#else
  for (int ph = 0; ph < NPHASE; ++ph) phase_kernel<<<512, 256, 0, stream>>>(p, ph);
#endif
}
```

```cpp
#include <hip/hip_runtime.h>
#include <hip/hip_cooperative_groups.h>
#include <cstdio>
#include <cstdint>
namespace cg = cooperative_groups;

#ifndef PROBE
#define PROBE 0
#endif
#ifndef MEGA
#define MEGA 1
#endif

typedef unsigned short u16;
using bf16x8 = __attribute__((ext_vector_type(8))) short;
using f32x4 = __attribute__((ext_vector_type(4))) float;
using f32x16 = __attribute__((ext_vector_type(16))) float;
typedef __bf16 bf2_t __attribute__((ext_vector_type(2)));
typedef float f2_t __attribute__((ext_vector_type(2)));
#define DI __device__ __forceinline__

__device__ const float TAB_M[1024] = {
  1.00000000e+00f, 0.00000000e+00f, 1.00000000e+00f, 0.00000000e+00f, 1.00000000e+00f, 0.00000000e+00f, 1.00000000e+00f, 0.00000000e+00f,
  1.00000000e+00f, 0.00000000e+00f, 1.00000000e+00f, 0.00000000e+00f, 1.00000000e+00f, 0.00000000e+00f, 1.00000000e+00f, 0.00000000e+00f,
  5.40302277e-01f, 8.41470957e-01f, 9.50415254e-01f, 3.10983598e-01f, 9.95004177e-01f, 9.98334214e-02f, 9.99500036e-01f, 3.16175036e-02f,
  9.99949992e-01f, 9.99983307e-03f, 9.99994993e-01f, 3.16227227e-03f, 9.99999523e-01f, 9.99999931e-04f, 9.99999940e-01f, 3.16227757e-04f,
  -4.16146845e-01f, 9.09297407e-01f, 8.06578398e-01f, 5.91127098e-01f, 9.80066597e-01f, 1.98669329e-01f, 9.98000681e-01f, 6.32033944e-02f,
  9.99800026e-01f, 1.99986659e-02f, 9.99979973e-01f, 6.32451288e-03f, 9.99997973e-01f, 1.99999870e-03f, 9.99999821e-01f, 6.32455456e-04f,
  -9.89992499e-01f, 1.41120002e-01f, 5.82753658e-01f, 8.12648892e-01f, 9.55336511e-01f, 2.95520216e-01f, 9.95503366e-01f, 9.47260857e-02f,
  9.99550045e-01f, 2.99954992e-02f, 9.99954998e-01f, 9.48669016e-03f, 9.99995530e-01f, 2.99999560e-03f, 9.99999523e-01f, 9.48683126e-04f,
  -6.53643608e-01f, -7.56802499e-01f, 3.01137477e-01f, 9.53580737e-01f, 9.21060979e-01f, 3.89418334e-01f, 9.92010653e-01f, 1.26154065e-01f,
  9.99200106e-01f, 3.99893336e-02f, 9.99920011e-01f, 1.26487734e-02f, 9.99992013e-01f, 3.99998948e-03f, 9.99999225e-01f, 1.26491068e-03f,
  2.83662200e-01f, -9.58924294e-01f, -1.03423381e-02f, 9.99946535e-01f, 8.77582550e-01f, 4.79425550e-01f, 9.87526000e-01f, 1.57455876e-01f,
  9.98750269e-01f, 4.99791652e-02f, 9.99875009e-01f, 1.58107281e-02f, 9.99987483e-01f, 4.99997940e-03f, 9.99998748e-01f, 1.58113812e-03f,
  9.60170269e-01f, -2.79415488e-01f, -3.20796400e-01f, 9.47148204e-01f, 8.25335622e-01f, 5.64642489e-01f, 9.82053936e-01f, 1.88600272e-01f,
  9.98200536e-01f, 5.99640049e-02f, 9.99819994e-01f, 1.89725272e-02f, 9.99981999e-01f, 5.99996420e-03f, 9.99998212e-01f, 1.89736532e-03f,
  7.53902256e-01f, 6.56986594e-01f, -5.99437475e-01f, 8.00421596e-01f, 7.64842212e-01f, 6.44217670e-01f, 9.75599885e-01f, 2.19556093e-01f,
  9.97551024e-01f, 6.99428469e-02f, 9.99755025e-01f, 2.21341345e-02f, 9.99975502e-01f, 6.99994294e-03f, 9.99997556e-01f, 2.21359241e-03f,
  -1.45500034e-01f, 9.89358246e-01f, -8.18632424e-01f, 5.74317753e-01f, 6.96706712e-01f, 7.17356086e-01f, 9.68170285e-01f, 2.50292331e-01f,
  9.96801734e-01f, 7.99146891e-02f, 9.99680042e-01f, 2.52955221e-02f, 9.99967992e-01f, 7.99991470e-03f, 9.99996781e-01f, 2.52981926e-03f,
  -9.11130250e-01f, 4.12118495e-01f, -9.56644177e-01f, 2.91259229e-01f, 6.21609926e-01f, 7.83326924e-01f, 9.59772646e-01f, 2.80778319e-01f,
  9.95952725e-01f, 8.98785442e-02f, 9.99595046e-01f, 2.84566563e-02f, 9.99959528e-01f, 8.99987947e-03f, 9.99995947e-01f, 2.84604589e-03f,
  -8.39071512e-01f, -5.44021130e-01f, -9.99786079e-01f, -2.06835698e-02f, 5.40302277e-01f, 8.41470957e-01f, 9.50415313e-01f, 3.10983568e-01f,
  9.95004177e-01f, 9.98334140e-02f, 9.99500036e-01f, 3.16175036e-02f, 9.99949992e-01f, 9.99983400e-03f, 9.99994993e-01f, 3.16227227e-03f,
  4.42569796e-03f, -9.99990225e-01f, -9.43779767e-01f, -3.30574960e-01f, 4.53596085e-01f, 8.91207397e-01f, 9.40107584e-01f, 3.40877861e-01f,
  9.93956089e-01f, 1.09778300e-01f, 9.99395072e-01f, 3.47780399e-02f, 9.99939501e-01f, 1.09997792e-02f, 9.99993920e-01f, 3.47849843e-03f,
  8.43853951e-01f, -5.36572933e-01f, -7.94179380e-01f, -6.07683420e-01f, 3.62357706e-01f, 9.32039082e-01f, 9.28859890e-01f, 3.70431304e-01f,
  9.92808640e-01f, 1.19712204e-01f, 9.99280095e-01f, 3.79382223e-02f, 9.99927998e-01f, 1.19997123e-02f, 9.99992788e-01f, 3.79472389e-03f,
  9.07446802e-01f, 4.20167029e-01f, -5.65820515e-01f, -8.24528456e-01f, 2.67498761e-01f, 9.63558197e-01f, 9.16683376e-01f, 3.99614304e-01f,
  9.91561890e-01f, 1.29634142e-01f, 9.99155104e-01f, 4.10980321e-02f, 9.99915481e-01f, 1.29996343e-02f, 9.99991536e-01f, 4.11094911e-03f,
  1.36737213e-01f, 9.90607381e-01f, -2.81349480e-01f, -9.59605396e-01f, 1.69967160e-01f, 9.85449731e-01f, 9.03590262e-01f, 4.28397775e-01f,
  9.90216017e-01f, 1.39543116e-01f, 9.99020159e-01f, 4.42574248e-02f, 9.99902010e-01f, 1.39995432e-02f, 9.99990225e-01f, 4.42717411e-03f,
  -7.59687901e-01f, 6.50287867e-01f, 3.10223512e-02f, -9.99518692e-01f, 7.07371980e-02f, 9.97494996e-01f, 8.89593601e-01f, 4.56752867e-01f,
  9.88771081e-01f, 1.49438128e-01f, 9.98875201e-01f, 4.74163815e-02f, 9.99887526e-01f, 1.49994381e-02f, 9.99988735e-01f, 4.74339863e-03f,
  -9.57659483e-01f, -2.87903309e-01f, 3.40318173e-01f, -9.40310359e-01f, -2.91995462e-02f, 9.99573588e-01f, 8.74707460e-01f, 4.84651238e-01f,
  9.87227261e-01f, 1.59318209e-01f, 9.98720288e-01f, 5.05748577e-02f, 9.99872029e-01f, 1.59993190e-02f, 9.99987185e-01f, 5.05962269e-03f,
  -2.75163352e-01f, -9.61397469e-01f, 6.15864813e-01f, -7.87851870e-01f, -1.28844544e-01f, 9.91664827e-01f, 8.58946681e-01f, 5.12064993e-01f,
  9.85584795e-01f, 1.69182345e-01f, 9.98555362e-01f, 5.37328273e-02f, 9.99855518e-01f, 1.69991814e-02f, 9.99985576e-01f, 5.37584582e-03f,
  6.60316706e-01f, -7.50987232e-01f, 8.30336154e-01f, -5.57262897e-01f, -2.27202162e-01f, 9.73847628e-01f, 8.42327058e-01f, 5.38966715e-01f,
  9.83843684e-01f, 1.79029569e-01f, 9.98380423e-01f, 5.68902642e-02f, 9.99837995e-01f, 1.79990288e-02f, 9.99983788e-01f, 5.69206895e-03f,
  9.88704622e-01f, 1.49877205e-01f, 9.62463796e-01f, -2.71410108e-01f, -3.23289543e-01f, 9.46300089e-01f, 8.24865162e-01f, 5.65329552e-01f,
  9.82004225e-01f, 1.88858896e-01f, 9.98195529e-01f, 6.00471310e-02f, 9.99819517e-01f, 1.89988576e-02f, 9.99981940e-01f, 6.00829115e-03f,
  4.08082068e-01f, 9.12945271e-01f, 9.99144375e-01f, 4.13582884e-02f, -4.16146845e-01f, 9.09297407e-01f, 8.06578457e-01f, 5.91127038e-01f,
  9.80066597e-01f, 1.98669314e-01f, 9.98000681e-01f, 6.32033944e-02f, 9.99800026e-01f, 1.99986678e-02f, 9.99979973e-01f, 6.32451288e-03f,
  -5.47729254e-01f, 8.36655617e-01f, 9.36740458e-01f, 3.50024760e-01f, -5.04846215e-01f, 8.63209307e-01f, 7.87485182e-01f, 6.16333544e-01f,
  9.78030920e-01f, 2.08459899e-01f, 9.97795820e-01f, 6.63590282e-02f, 9.99779522e-01f, 2.09984574e-02f, 9.99977946e-01f, 6.64073415e-03f,
  -9.99960840e-01f, -8.85130931e-03f, 7.81440377e-01f, 6.23979926e-01f, -5.88501155e-01f, 8.08496356e-01f, 7.67604589e-01f, 6.40923738e-01f,
  9.75897431e-01f, 2.18229622e-01f, 9.97581005e-01f, 6.95140064e-02f, 9.99758005e-01f, 2.19982266e-02f, 9.99975801e-01f, 6.95695449e-03f,
  -5.32833040e-01f, -8.46220434e-01f, 5.48645258e-01f, 8.36055279e-01f, -6.66275978e-01f, 7.45705247e-01f, 7.46956408e-01f, 6.64873064e-01f,
  9.73666370e-01f, 2.27977514e-01f, 9.97356176e-01f, 7.26682767e-02f, 9.99735534e-01f, 2.29979735e-02f, 9.99973536e-01f, 7.27317436e-03f,
  4.24179018e-01f, -9.05578375e-01f, 2.61441678e-01f, 9.65219259e-01f, -7.37393796e-01f, 6.75463140e-01f, 7.25561321e-01f, 6.88157499e-01f,
  9.71337974e-01f, 2.37702623e-01f, 9.97121394e-01f, 7.58218244e-02f, 9.99711990e-01f, 2.39976961e-02f, 9.99971211e-01f, 7.58939330e-03f,
  9.91202831e-01f, -1.32351756e-01f, -5.16893305e-02f, 9.98663187e-01f, -8.01143587e-01f, 5.98472118e-01f, 7.03440726e-01f, 7.10753918e-01f,
  9.68912423e-01f, 2.47403964e-01f, 9.96876657e-01f, 7.89746121e-02f, 9.99687493e-01f, 2.49973964e-02f, 9.99968767e-01f, 7.90561177e-03f,
  6.46919310e-01f, 7.62558460e-01f, -3.59694332e-01f, 9.33070183e-01f, -8.56888831e-01f, 5.15501261e-01f, 6.80616796e-01f, 7.32639611e-01f,
  9.66389954e-01f, 2.57080555e-01f, 9.96621907e-01f, 8.21266174e-02f, 9.99662042e-01f, 2.59970706e-02f, 9.99966204e-01f, 8.22182931e-03f,
  -2.92138815e-01f, 9.56375957e-01f, -6.32028639e-01f, 7.74945021e-01f, -9.04072165e-01f, 4.27379847e-01f, 6.57112300e-01f, 7.53792703e-01f,
  9.63770926e-01f, 2.66731411e-01f, 9.96357203e-01f, 8.52777958e-02f, 9.99635518e-01f, 2.69967206e-02f, 9.99963522e-01f, 8.53804592e-03f,
  -9.62605894e-01f, 2.70905793e-01f, -8.41684937e-01f, 5.39968967e-01f, -9.42222297e-01f, 3.34988207e-01f, 6.32950664e-01f, 7.74192095e-01f,
  9.61055458e-01f, 2.76355654e-01f, 9.96082544e-01f, 8.84281173e-02f, 9.99608040e-01f, 2.79963426e-02f, 9.99960780e-01f, 8.85426160e-03f,
  -7.48057544e-01f, -6.63633883e-01f, -9.67871487e-01f, 2.51445323e-01f, -9.70958173e-01f, 2.39249229e-01f, 6.08156204e-01f, 7.93817401e-01f,
  9.58243906e-01f, 2.85952210e-01f, 9.95797932e-01f, 9.15775672e-02f, 9.99579549e-01f, 2.89959367e-02f, 9.99957979e-01f, 9.17047635e-03f,
  1.54251456e-01f, -9.88031626e-01f, -9.98075247e-01f, -6.20148405e-02f, -9.89992499e-01f, 1.41120002e-01f, 5.82753658e-01f, 8.12648892e-01f,
  9.55336511e-01f, 2.95520186e-01f, 9.95503366e-01f, 9.47260931e-02f, 9.99550045e-01f, 2.99955010e-02f, 9.99954998e-01f, 9.48669016e-03f,
  9.14742351e-01f, -4.04037654e-01f, -9.29300308e-01f, -3.69325012e-01f, -9.99135137e-01f, 4.15805206e-02f, 5.56768358e-01f, 8.30667794e-01f,
  9.52333570e-01f, 3.05058628e-01f, 9.95198846e-01f, 9.78736654e-02f, 9.99519527e-01f, 3.09950355e-02f, 9.99951959e-01f, 9.80290305e-03f,
  8.34223390e-01f, 5.51426709e-01f, -7.68367112e-01f, -6.40009403e-01f, -9.98294771e-01f, -5.83741926e-02f, 5.30226350e-01f, 8.47856104e-01f,
  9.49235439e-01f, 3.14566553e-01f, 9.94884372e-01f, 1.01020269e-01f, 9.99488056e-01f, 3.19945402e-02f, 9.99948800e-01f, 1.01191159e-02f,
  -1.32767474e-02f, 9.99911845e-01f, -5.31235278e-01f, -8.47224355e-01f, -9.87479806e-01f, -1.57745644e-01f, 5.03154159e-01f, 8.64196658e-01f,
  9.46042359e-01f, 3.24043006e-01f, 9.94559944e-01f, 1.04165860e-01f, 9.99455571e-01f, 3.29940096e-02f, 9.99945521e-01f, 1.04353270e-02f,
  -8.48570287e-01f, 5.29082716e-01f, -2.41421118e-01f, -9.70420420e-01f, -9.66798186e-01f, -2.55541205e-01f, 4.75578904e-01f, 8.79673064e-01f,
  9.42754686e-01f, 3.33487093e-01f, 9.94225562e-01f, 1.07310407e-01f, 9.99422073e-01f, 3.39934528e-02f, 9.99942183e-01f, 1.07515370e-02f,
  -9.03692186e-01f, -4.28182662e-01f, 7.23346695e-02f, -9.97380435e-01f, -9.36456680e-01f, -3.50783229e-01f, 4.47528064e-01f, 8.94269884e-01f,
  9.39372718e-01f, 3.42897803e-01f, 9.93881226e-01f, 1.10453881e-01f, 9.99387562e-01f, 3.49928550e-02f, 9.99938726e-01f, 1.10677453e-02f,
  -1.27963692e-01f, -9.91778851e-01f, 3.78916174e-01f, -9.25431013e-01f, -8.96758378e-01f, -4.42520559e-01f, 4.19029742e-01f, 9.07972515e-01f,
  9.35896814e-01f, 3.52274209e-01f, 9.93526995e-01f, 1.13596253e-01f, 9.99352098e-01f, 3.59922275e-02f, 9.99935210e-01f, 1.13839535e-02f,
  7.65414059e-01f, -6.43538117e-01f, 6.47921681e-01f, -7.61706948e-01f, -8.48100007e-01f, -5.29836178e-01f, 3.90112430e-01f, 9.20767248e-01f,
  9.32327330e-01f, 3.61615449e-01f, 9.93162811e-01f, 1.16737492e-01f, 9.99315560e-01f, 3.69915590e-02f, 9.99931574e-01f, 1.17001599e-02f,
  9.55073655e-01f, 2.96368569e-01f, 8.52673113e-01f, -5.22444785e-01f, -7.90967762e-01f, -6.11857831e-01f, 3.60805035e-01f, 9.32641268e-01f,
  9.28664625e-01f, 3.70920479e-01f, 9.92788672e-01f, 1.19877554e-01f, 9.99278069e-01f, 3.79908569e-02f, 9.99927819e-01f, 1.20163653e-02f,
  2.66642928e-01f, 9.63795364e-01f, 9.72865343e-01f, -2.31372014e-01f, -7.25932240e-01f, -6.87766254e-01f, 3.31136853e-01f, 9.43582714e-01f,
  9.24909055e-01f, 3.80188406e-01f, 9.92404640e-01f, 1.23016424e-01f, 9.99239624e-01f, 3.89901139e-02f, 9.99923944e-01f, 1.23325698e-02f,
  -6.66938066e-01f, 7.45113134e-01f, 9.96578991e-01f, 8.26458037e-02f, -6.53643608e-01f, -7.56802499e-01f, 3.01137596e-01f, 9.53580678e-01f,
  9.21060979e-01f, 3.89418334e-01f, 9.92010653e-01f, 1.26154065e-01f, 9.99200106e-01f, 3.99893373e-02f, 9.99920011e-01f, 1.26487734e-02f,
  -9.87339258e-01f, -1.58622667e-01f, 9.21462357e-01f, 3.88467699e-01f, -5.74824035e-01f, -8.18277061e-01f, 2.70837069e-01f, 9.62625206e-01f,
  9.17120814e-01f, 3.98609310e-01f, 9.91606772e-01f, 1.29290432e-01f, 9.99159634e-01f, 4.09885161e-02f, 9.99915957e-01f, 1.29649751e-02f,
  -3.99985313e-01f, -9.16521549e-01f, 7.54965365e-01f, 6.55764699e-01f, -4.90260571e-01f, -8.71575892e-01f, 2.40265876e-01f, 9.70707119e-01f,
  9.13088918e-01f, 4.07760441e-01f, 9.91192937e-01f, 1.32425532e-01f, 9.99118149e-01f, 4.19876575e-02f, 9.99911785e-01f, 1.32811759e-02f,
  5.55113316e-01f, -8.31774771e-01f, 5.13598442e-01f, 8.58030677e-01f, -4.00799006e-01f, -9.16166008e-01f, 2.09454417e-01f, 9.77818429e-01f,
  9.08965766e-01f, 4.16870773e-01f, 9.90769207e-01f, 1.35559291e-01f, 9.99075651e-01f, 4.29867506e-02f, 9.99907553e-01f, 1.35973748e-02f,
  9.99843299e-01f, 1.77019257e-02f, 2.21298173e-01f, 9.75206196e-01f, -3.07332784e-01f, -9.51602101e-01f, 1.78433523e-01f, 9.83951986e-01f,
  9.04751658e-01f, 4.25939471e-01f, 9.90335584e-01f, 1.38691694e-01f, 9.99032140e-01f, 4.39858064e-02f, 9.99903202e-01f, 1.39135728e-02f,
  5.25321960e-01f, 8.50903511e-01f, -9.29481089e-02f, 9.95670974e-01f, -2.10795805e-01f, -9.77530122e-01f, 1.47234216e-01f, 9.89101648e-01f,
  9.00447130e-01f, 4.34965521e-01f, 9.89892066e-01f, 1.41822711e-01f, 9.98987675e-01f, 4.49848175e-02f, 9.99898732e-01f, 1.42297689e-02f,
  -4.32177931e-01f, 9.01788354e-01f, -3.97976756e-01f, 9.17395473e-01f, -1.12152621e-01f, -9.93690968e-01f, 1.15887694e-01f, 9.93262351e-01f,
  8.96052480e-01f, 4.43948090e-01f, 9.89438653e-01f, 1.44952312e-01f, 9.98942196e-01f, 4.59837839e-02f, 9.99894202e-01f, 1.45459641e-02f,
  -9.92335498e-01f, 1.23573124e-01f, -6.63538277e-01f, 7.48142362e-01f, -1.23883775e-02f, -9.99923289e-01f, 8.44252855e-02f, 9.96429801e-01f,
  8.91568303e-01f, 4.52886283e-01f, 9.88975346e-01f, 1.48080453e-01f, 9.98895705e-01f, 4.69827019e-02f, 9.99889553e-01f, 1.48621574e-02f,
  -6.40144348e-01f, -7.68254638e-01f, -8.63296509e-01f, 5.04697084e-01f, 8.74991715e-02f, -9.96164620e-01f, 5.28784581e-02f, 9.98600960e-01f,
  8.86994898e-01f, 4.61779177e-01f, 9.88502085e-01f, 1.51207119e-01f, 9.98848200e-01f, 4.79815714e-02f, 9.99884784e-01f, 1.51783489e-02f,
  3.00592542e-01f, -9.53752637e-01f, -9.77442741e-01f, 2.11200655e-01f, 1.86512470e-01f, -9.82452571e-01f, 2.12787576e-02f, 9.99773562e-01f,
  8.82332861e-01f, 4.70625877e-01f, 9.88018990e-01f, 1.54332280e-01f, 9.98799741e-01f, 4.89803962e-02f, 9.99879956e-01f, 1.54945394e-02f,
  9.64965999e-01f, -2.62374848e-01f, -9.94656444e-01f, -1.03240460e-01f, 2.83662200e-01f, -9.58924294e-01f, -1.03422189e-02f, 9.99946535e-01f,
  8.77582550e-01f, 4.79425550e-01f, 9.87526000e-01f, 1.57455891e-01f, 9.98750269e-01f, 4.99791689e-02f, 9.99875009e-01f, 1.58107281e-02f,
  7.42154181e-01f, 6.70229197e-01f, -9.13230121e-01f, -4.07444149e-01f, 3.77977669e-01f, -9.25814748e-01f, -4.19528559e-02f, 9.99119580e-01f,
  8.72744501e-01f, 4.88177240e-01f, 9.87023175e-01f, 1.60577938e-01f, 9.98699784e-01f, 5.09778969e-02f, 9.99869943e-01f, 1.61269177e-02f,
  -1.62990779e-01f, 9.86627579e-01f, -7.41239965e-01f, -6.71240151e-01f, 4.68516916e-01f, -8.83454502e-01f, -7.35215396e-02f, 9.97293651e-01f,
  8.67819190e-01f, 4.96880114e-01f, 9.86510456e-01f, 1.63698375e-01f, 9.98648286e-01f, 5.19765690e-02f, 9.99864817e-01f, 1.64431017e-02f,
  -9.18282807e-01f, 3.95925164e-01f, -4.95741814e-01f, -8.68469954e-01f, 5.54374516e-01f, -8.32267344e-01f, -1.05016708e-01f, 9.94470477e-01f,
  8.62807095e-01f, 5.05533338e-01f, 9.85987842e-01f, 1.66817173e-01f, 9.98595834e-01f, 5.29751927e-02f, 9.99859571e-01f, 1.67592876e-02f,
  -8.29309821e-01f, -5.58789074e-01f, -2.01079622e-01f, -9.79574919e-01f, 6.34692967e-01f, -7.72764444e-01f, -1.36406869e-01f, 9.90652919e-01f,
  8.57708693e-01f, 5.14135957e-01f, 9.85455394e-01f, 1.69934288e-01f, 9.98542368e-01f, 5.39737605e-02f, 9.99854207e-01f, 1.70754679e-02f,
  2.21267566e-02f, -9.99755144e-01f, 1.13521777e-01f, -9.93535519e-01f, 7.08669782e-01f, -7.05540299e-01f, -1.67660639e-01f, 9.85844791e-01f,
  8.52524519e-01f, 5.22687256e-01f, 9.84913111e-01f, 1.73049718e-01f, 9.98487890e-01f, 5.49722798e-02f, 9.99848783e-01f, 1.73916500e-02f,
  8.53220105e-01f, -5.21551013e-01f, 4.16867077e-01f, -9.08967435e-01f, 7.75565803e-01f, -6.31266713e-01f, -1.98746875e-01f, 9.80050862e-01f,
  8.47255111e-01f, 5.31186223e-01f, 9.84360933e-01f, 1.76163420e-01f, 9.98432398e-01f, 5.59707358e-02f, 9.99843180e-01f, 1.77078284e-02f,
  8.99866819e-01f, 4.36164767e-01f, 6.78870201e-01f, -7.34258294e-01f, 8.34712923e-01f, -5.50685287e-01f, -2.29634270e-01f, 9.73276973e-01f,
  8.41901004e-01f, 5.39632022e-01f, 9.83798921e-01f, 1.79275364e-01f, 9.98375952e-01f, 5.69691435e-02f, 9.99837577e-01f, 1.80240069e-02f,
  1.19180135e-01f, 9.92872655e-01f, 8.73550534e-01f, -4.86733496e-01f, 8.85519624e-01f, -4.64602023e-01f, -2.60292053e-01f, 9.65529919e-01f,
  8.36462677e-01f, 5.48023939e-01f, 9.83227074e-01f, 1.82385504e-01f, 9.98318493e-01f, 5.79674877e-02f, 9.99831796e-01f, 1.83401816e-02f,
  -7.71080196e-01f, 6.36738002e-01f, 9.81602073e-01f, -1.90938011e-01f, 9.27478492e-01f, -3.73876572e-01f, -2.90689558e-01f, 9.56817448e-01f,
  8.30940723e-01f, 5.56361020e-01f, 9.82645452e-01f, 1.85493827e-01f, 9.98260021e-01f, 5.89657798e-02f, 9.99825954e-01f, 1.86563563e-02f,
  -9.52412963e-01f, -3.04810613e-01f, 9.92308319e-01f, 1.23790950e-01f, 9.60170269e-01f, -2.79415488e-01f, -3.20796400e-01f, 9.47148204e-01f,
  8.25335622e-01f, 5.64642429e-01f, 9.82053936e-01f, 1.88600287e-01f, 9.98200536e-01f, 5.99640086e-02f, 9.99819994e-01f, 1.89725272e-02f,
  -2.58101642e-01f, -9.66117799e-01f, 9.04607594e-01f, 4.26245421e-01f, 9.83268440e-01f, -1.82162598e-01f, -3.50582451e-01f, 9.36531842e-01f,
  8.19648027e-01f, 5.72867453e-01f, 9.81452644e-01f, 1.91704854e-01f, 9.98140097e-01f, 6.09621815e-02f, 9.99813974e-01f, 1.92886982e-02f,
  6.73507154e-01f, -7.39180684e-01f, 7.27198064e-01f, 6.86427653e-01f, 9.96542096e-01f, -8.30891207e-02f, -3.80017966e-01f, 9.24979091e-01f,
  8.13878477e-01f, 5.81035137e-01f, 9.80841517e-01f, 1.94807529e-01f, 9.98078644e-01f, 6.19602874e-02f, 9.99807835e-01f, 1.96048655e-02f,
  9.85896587e-01f, 1.67355701e-01f, 4.77671444e-01f, 8.78538549e-01f, 9.99858618e-01f, 1.68140903e-02f, -4.09073502e-01f, 9.12501454e-01f,
  8.08027506e-01f, 5.89144766e-01f, 9.80220556e-01f, 1.97908238e-01f, 9.98016179e-01f, 6.29583374e-02f, 9.99801576e-01f, 1.99210308e-02f,
};
__device__ const float TAB_S[2048] = {
  1.00000000e+00f, 0.00000000e+00f, 1.00000000e+00f, 0.00000000e+00f, 1.00000000e+00f, 0.00000000e+00f, 1.00000000e+00f, 0.00000000e+00f,
  1.00000000e+00f, 0.00000000e+00f, 1.00000000e+00f, 0.00000000e+00f, 1.00000000e+00f, 0.00000000e+00f, 1.00000000e+00f, 0.00000000e+00f,
  1.00000000e+00f, 0.00000000e+00f, 1.00000000e+00f, 0.00000000e+00f, 1.00000000e+00f, 0.00000000e+00f, 1.00000000e+00f, 0.00000000e+00f,
  1.00000000e+00f, 0.00000000e+00f, 1.00000000e+00f, 0.00000000e+00f, 1.00000000e+00f, 0.00000000e+00f, 1.00000000e+00f, 0.00000000e+00f,
  5.40302277e-01f, 8.41470957e-01f, 8.46009135e-01f, 5.33168435e-01f, 9.50415254e-01f, 3.10983598e-01f, 9.84230220e-01f, 1.76892191e-01f,
  9.95004177e-01f, 9.98334214e-02f, 9.98419285e-01f, 5.62044978e-02f, 9.99500036e-01f, 3.16175036e-02f, 9.99841869e-01f, 1.77818574e-02f,
  9.99949992e-01f, 9.99983307e-03f, 9.99984205e-01f, 5.62338345e-03f, 9.99994993e-01f, 3.16227227e-03f, 9.99998391e-01f, 1.77827850e-03f,
  9.99999523e-01f, 9.99999931e-04f, 9.99999821e-01f, 5.62341243e-04f, 9.99999940e-01f, 3.16227757e-04f, 1.00000000e+00f, 1.77827940e-04f,
  -4.16146845e-01f, 9.09297407e-01f, 4.31462824e-01f, 9.02130723e-01f, 8.06578398e-01f, 5.91127098e-01f, 9.37418282e-01f, 3.48205268e-01f,
  9.80066597e-01f, 1.98669329e-01f, 9.93682086e-01f, 1.12231314e-01f, 9.98000681e-01f, 6.32033944e-02f, 9.99367595e-01f, 3.55580896e-02f,
  9.99800026e-01f, 1.99986659e-02f, 9.99936759e-01f, 1.12465890e-02f, 9.99979973e-01f, 6.32451288e-03f, 9.99993682e-01f, 3.55655141e-03f,
  9.99997973e-01f, 1.99999870e-03f, 9.99999344e-01f, 1.12468237e-03f, 9.99999821e-01f, 6.32455456e-04f, 9.99999940e-01f, 3.55655880e-04f,
  -9.89992499e-01f, 1.41120002e-01f, -1.15966164e-01f, 9.93253171e-01f, 5.82753658e-01f, 8.12648892e-01f, 8.61040652e-01f, 5.08536100e-01f,
  9.55336511e-01f, 2.95520216e-01f, 9.85803485e-01f, 1.67903304e-01f, 9.95503366e-01f, 9.47260857e-02f, 9.98577297e-01f, 5.33230826e-02f,
  9.99550045e-01f, 2.99954992e-02f, 9.99857724e-01f, 1.68694388e-02f, 9.99954998e-01f, 9.48669016e-03f, 9.99985754e-01f, 5.33481315e-03f,
  9.99995530e-01f, 2.99999560e-03f, 9.99998569e-01f, 1.68702309e-03f, 9.99999523e-01f, 9.48683126e-04f, 9.99999881e-01f, 5.33483806e-04f,
  -6.53643608e-01f, -7.56802499e-01f, -6.27679706e-01f, 7.78471708e-01f, 3.01137477e-01f, 9.53580737e-01f, 7.57506192e-01f, 6.52827978e-01f,
  9.21060979e-01f, 3.89418334e-01f, 9.74808276e-01f, 2.23044485e-01f, 9.92010653e-01f, 1.26154065e-01f, 9.97471273e-01f, 7.10712075e-02f,
  9.99200106e-01f, 3.99893336e-02f, 9.99747038e-01f, 2.24917568e-02f, 9.99920011e-01f, 1.26487734e-02f, 9.99974728e-01f, 7.11305765e-03f,
  9.99992013e-01f, 3.99998948e-03f, 9.99997497e-01f, 2.24936334e-03f, 9.99999225e-01f, 1.26491068e-03f, 9.99999762e-01f, 7.11311703e-04f,
  2.83662200e-01f, -9.58924294e-01f, -9.46079254e-01f, 3.23935270e-01f, -1.03423381e-02f, 9.99946535e-01f, 6.30080283e-01f, 7.76529968e-01f,
  8.77582550e-01f, 4.79425550e-01f, 9.60731268e-01f, 2.77480543e-01f, 9.87526000e-01f, 1.57455876e-01f, 9.96049762e-01f, 8.87968615e-02f,
  9.98750269e-01f, 4.99791652e-02f, 9.99604762e-01f, 2.81133614e-02f, 9.99875009e-01f, 1.58107281e-02f, 9.99960482e-01f, 8.89127981e-03f,
  9.99987483e-01f, 4.99997940e-03f, 9.99996066e-01f, 2.81170290e-03f, 9.99998748e-01f, 1.58113812e-03f, 9.99999583e-01f, 8.89139599e-04f,
  9.60170269e-01f, -2.79415488e-01f, -9.73103702e-01f, -2.30367512e-01f, -3.20796400e-01f, 9.47148204e-01f, 4.82782036e-01f, 8.75740528e-01f,
  8.25335622e-01f, 5.64642489e-01f, 9.43616986e-01f, 3.31039310e-01f, 9.82053936e-01f, 1.88600272e-01f, 9.94313300e-01f, 1.06494442e-01f,
  9.98200536e-01f, 5.99640049e-02f, 9.99430835e-01f, 3.37340795e-02f, 9.99819994e-01f, 1.89725272e-02f, 9.99943078e-01f, 1.06694745e-02f,
  9.99981999e-01f, 5.99996420e-03f, 9.99994338e-01f, 3.37404152e-03f, 9.99998212e-01f, 1.89736532e-03f, 9.99999404e-01f, 1.06696738e-03f,
  7.53902256e-01f, 6.56986594e-01f, -7.00429797e-01f, -7.13721275e-01f, -5.99437475e-01f, 8.00421596e-01f, 3.20257008e-01f, 9.47330713e-01f,
  7.64842212e-01f, 6.44217670e-01f, 9.23519433e-01f, 3.83551568e-01f, 9.75599885e-01f, 2.19556093e-01f, 9.92262423e-01f, 1.24158338e-01f,
  9.97551024e-01f, 6.99428469e-02f, 9.99225318e-01f, 3.93537246e-02f, 9.99755025e-01f, 2.21341345e-02f, 9.99922514e-01f, 1.24476347e-02f,
  9.99975502e-01f, 6.99994294e-03f, 9.99992251e-01f, 3.93637875e-03f, 9.99997556e-01f, 2.21359241e-03f, 9.99999225e-01f, 1.24479528e-03f,
  -1.45500034e-01f, 9.89358246e-01f, -2.12036446e-01f, -9.77261782e-01f, -8.18632424e-01f, 5.74317753e-01f, 1.47631213e-01f, 9.89042461e-01f,
  6.96706712e-01f, 7.17356086e-01f, 9.00502324e-01f, 4.34851229e-01f, 9.68170285e-01f, 2.50292331e-01f, 9.89897788e-01f, 1.41782969e-01f,
  9.96801734e-01f, 7.99146891e-02f, 9.98988271e-01f, 4.49721329e-02f, 9.99680042e-01f, 2.52955221e-02f, 9.99898791e-01f, 1.42257558e-02f,
  9.99967992e-01f, 7.99991470e-03f, 9.99989867e-01f, 4.49871505e-03f, 9.99996781e-01f, 2.52981926e-03f, 9.99998987e-01f, 1.42262306e-03f,
  -9.11130250e-01f, 4.12118495e-01f, 3.41660261e-01f, -9.39823508e-01f, -9.56644177e-01f, 2.91259229e-01f, -2.96507962e-02f, 9.99560297e-01f,
  6.21609926e-01f, 7.83326924e-01f, 8.74638259e-01f, 4.84776139e-01f, 9.59772646e-01f, 2.80778319e-01f, 9.87220109e-01f, 1.59362778e-01f,
  9.95952725e-01f, 8.98785442e-02f, 9.98719573e-01f, 5.05891182e-02f, 9.99595046e-01f, 2.84566563e-02f, 9.99871910e-01f, 1.60038304e-02f,
  9.99959528e-01f, 8.99987947e-03f, 9.99987185e-01f, 5.06105041e-03f, 9.99995947e-01f, 2.84604589e-03f, 9.99998748e-01f, 1.60045072e-03f,
  -8.39071512e-01f, -5.44021130e-01f, 7.90131867e-01f, -6.12936914e-01f, -9.99786079e-01f, -2.06835698e-02f, -2.05997631e-01f, 9.78552461e-01f,
  5.40302277e-01f, 8.41470957e-01f, 8.46009135e-01f, 5.33168435e-01f, 9.50415313e-01f, 3.10983568e-01f, 9.84230220e-01f, 1.76892191e-01f,
  9.95004177e-01f, 9.98334140e-02f, 9.98419285e-01f, 5.62044978e-02f, 9.99500036e-01f, 3.16175036e-02f, 9.99841869e-01f, 1.77818574e-02f,
  9.99949992e-01f, 9.99983400e-03f, 9.99984205e-01f, 5.62338345e-03f, 9.99994993e-01f, 3.16227227e-03f, 9.99998391e-01f, 1.77827850e-03f,
  4.42569796e-03f, -9.99990225e-01f, 9.95257378e-01f, -9.72764567e-02f, -9.43779767e-01f, -3.30574960e-01f, -3.75847399e-01f, 9.26681578e-01f,
  4.53596085e-01f, 8.91207397e-01f, 8.14705312e-01f, 5.79875171e-01f, 9.40107584e-01f, 3.40877861e-01f, 9.80929136e-01f, 1.94365650e-01f,
  9.93956089e-01f, 1.09778300e-01f, 9.98087406e-01f, 6.18181042e-02f, 9.99395072e-01f, 3.47780399e-02f, 9.99808669e-01f, 1.95598267e-02f,
  9.99939501e-01f, 1.09997792e-02f, 9.99980867e-01f, 6.18571462e-03f, 9.99993920e-01f, 3.47849843e-03f, 9.99998093e-01f, 1.95610616e-03f,
  8.43853951e-01f, -5.36572933e-01f, 8.93861592e-01f, 4.48342979e-01f, -7.94179380e-01f, -6.07683420e-01f, -5.33843040e-01f, 8.45583618e-01f,
  3.62357706e-01f, 9.32039082e-01f, 7.80825913e-01f, 6.24748647e-01f, 9.28859890e-01f, 3.70431304e-01f, 9.77317870e-01f, 2.11777672e-01f,
  9.92808640e-01f, 1.19712204e-01f, 9.97723997e-01f, 6.74297586e-02f, 9.99280095e-01f, 3.79382223e-02f, 9.99772310e-01f, 2.13377345e-02f,
  9.99927998e-01f, 1.19997123e-02f, 9.99977231e-01f, 6.74804440e-03f, 9.99992788e-01f, 3.79472389e-03f, 9.99997735e-01f, 2.13393359e-03f,
  9.07446802e-01f, 4.20167029e-01f, 5.17172873e-01f, 8.55880976e-01f, -5.65820515e-01f, -8.24528456e-01f, -6.75001681e-01f, 7.37816215e-01f,
  2.67498761e-01f, 9.63558197e-01f, 7.44477987e-01f, 6.67647004e-01f, 9.16683376e-01f, 3.99614304e-01f, 9.73397553e-01f, 2.29122713e-01f,
  9.91561890e-01f, 1.29634142e-01f, 9.97329056e-01f, 7.30392784e-02f, 9.99155104e-01f, 4.10980321e-02f, 9.99732792e-01f, 2.31155735e-02f,
  9.99915481e-01f, 1.29996343e-02f, 9.99973297e-01f, 7.31037185e-03f, 9.99991536e-01f, 4.11094911e-03f, 9.99997318e-01f, 2.31176103e-03f,
  1.36737213e-01f, 9.90607381e-01f, -1.87961515e-02f, 9.99823332e-01f, -2.81349480e-01f, -9.59605396e-01f, -7.94870913e-01f, 6.06778562e-01f,
  1.69967160e-01f, 9.85449731e-01f, 7.05776393e-01f, 7.08434701e-01f, 9.03590262e-01f, 4.28397775e-01f, 9.69169438e-01f, 2.46395305e-01f,
  9.90216017e-01f, 1.39543116e-01f, 9.96902585e-01f, 7.86464810e-02f, 9.99020159e-01f, 4.42574248e-02f, 9.99690115e-01f, 2.48933397e-02f,
  9.99902010e-01f, 1.39995432e-02f, 9.99969006e-01f, 7.87269697e-03f, 9.99990225e-01f, 4.42717411e-03f, 9.99996901e-01f, 2.48958869e-03f,
  -7.59687901e-01f, 6.50287867e-01f, -5.48975468e-01f, 8.35838437e-01f, 3.10223512e-02f, -9.99518692e-01f, -8.89670432e-01f, 4.56603259e-01f,
  7.07371980e-02f, 9.97494996e-01f, 6.64843500e-01f, 7.46982634e-01f, 8.89593601e-01f, 4.56752867e-01f, 9.64634836e-01f, 2.63589978e-01f,
  9.88771081e-01f, 1.49438128e-01f, 9.96444523e-01f, 8.42512026e-02f, 9.98875201e-01f, 4.74163815e-02f, 9.99644279e-01f, 2.66710296e-02f,
  9.99887526e-01f, 1.49994381e-02f, 9.99964416e-01f, 8.43502022e-03f, 9.99988735e-01f, 4.74339863e-03f, 9.99996424e-01f, 2.66741589e-03f,
  -9.57659483e-01f, -2.87903309e-01f, -9.10081089e-01f, 4.14430231e-01f, 3.40318173e-01f, -9.40310359e-01f, -9.56410050e-01f, 2.92027086e-01f,
  -2.91995462e-02f, 9.99573588e-01f, 6.21808827e-01f, 7.83169091e-01f, 8.74707460e-01f, 4.84651238e-01f, 9.59795177e-01f, 2.80701309e-01f,
  9.87227261e-01f, 1.59318209e-01f, 9.95954990e-01f, 8.98532644e-02f, 9.98720288e-01f, 5.05748577e-02f, 9.99595284e-01f, 2.84486320e-02f,
  9.99872029e-01f, 1.59993190e-02f, 9.99959528e-01f, 8.99733976e-03f, 9.99987185e-01f, 5.05962269e-03f, 9.99995947e-01f, 2.84524332e-03f,
  -2.75163352e-01f, -9.61397469e-01f, -9.90897954e-01f, -1.34615138e-01f, 6.15864813e-01f, -7.87851870e-01f, -9.92985010e-01f, 1.18240520e-01f,
  -1.28844544e-01f, 9.91664827e-01f, 5.76808274e-01f, 8.16879570e-01f, 8.58946681e-01f, 5.12064993e-01f, 9.54652011e-01f, 2.97723860e-01f,
  9.85584795e-01f, 1.69182345e-01f, 9.95433986e-01f, 9.54524800e-02f, 9.98555362e-01f, 5.37328273e-02f, 9.99543071e-01f, 3.02261449e-02f,
  9.99855518e-01f, 1.69991814e-02f, 9.99954283e-01f, 9.55965649e-03f, 9.99985576e-01f, 5.37584582e-03f, 9.99995410e-01f, 3.02307028e-03f,
  6.60316706e-01f, -7.50987232e-01f, -7.66536534e-01f, -6.42200708e-01f, 8.30336154e-01f, -5.57262897e-01f, -9.98241663e-01f, -5.92755191e-02f,
  -2.27202162e-01f, 9.73847628e-01f, 5.29984176e-01f, 8.48007560e-01f, 8.42327058e-01f, 5.38966715e-01f, 9.49207008e-01f, 3.14652264e-01f,
  9.83843684e-01f, 1.79029569e-01f, 9.94881511e-01f, 1.01048686e-01f, 9.98380423e-01f, 5.68902642e-02f, 9.99487758e-01f, 3.20035629e-02f,
  9.99837995e-01f, 1.79990288e-02f, 9.99948800e-01f, 1.01219704e-02f, 9.99983788e-01f, 5.69206895e-03f, 9.99994874e-01f, 3.20089748e-03f,
  9.88704622e-01f, 1.49877205e-01f, -3.06095392e-01f, -9.52000856e-01f, 9.62463796e-01f, -2.71410108e-01f, -9.72014248e-01f, -2.34921798e-01f,
  -3.23289543e-01f, 9.46300089e-01f, 4.81484592e-01f, 8.76454532e-01f, 8.24865162e-01f, 5.65329552e-01f, 9.43461835e-01f, 3.31481189e-01f,
  9.82004225e-01f, 1.88858896e-01f, 9.94297504e-01f, 1.06641680e-01f, 9.98195529e-01f, 6.00471310e-02f, 9.99429286e-01f, 3.37808803e-02f,
  9.99819517e-01f, 1.89988576e-02f, 9.99942899e-01f, 1.06842816e-02f, 9.99981940e-01f, 6.00829115e-03f, 9.99994278e-01f, 3.37872445e-03f,
  4.08082068e-01f, 9.12945271e-01f, 2.48616725e-01f, -9.68601942e-01f, 9.99144375e-01f, 4.13582884e-02f, -9.15129960e-01f, -4.03158993e-01f,
  -4.16146845e-01f, 9.09297407e-01f, 4.31462824e-01f, 9.02130723e-01f, 8.06578457e-01f, 5.91127038e-01f, 9.37418282e-01f, 3.48205268e-01f,
  9.80066597e-01f, 1.98669314e-01f, 9.93682086e-01f, 1.12231314e-01f, 9.98000681e-01f, 6.32033944e-02f, 9.99367595e-01f, 3.55580896e-02f,
  9.99800026e-01f, 1.99986678e-02f, 9.99936759e-01f, 1.12465890e-02f, 9.99979973e-01f, 6.32451288e-03f, 9.99993682e-01f, 3.55655141e-03f,
  -5.47729254e-01f, 8.36655617e-01f, 7.26760268e-01f, -6.86891198e-01f, 9.36740458e-01f, 3.50024760e-01f, -8.29382956e-01f, -5.58680534e-01f,
  -5.04846215e-01f, 8.63209307e-01f, 3.80077004e-01f, 9.24954832e-01f, 7.87485182e-01f, 6.16333544e-01f, 9.31078374e-01f, 3.64819258e-01f,
  9.78030920e-01f, 2.08459899e-01f, 9.93035257e-01f, 1.17817394e-01f, 9.97795820e-01f, 6.63590282e-02f, 9.99302804e-01f, 3.73351872e-02f,
  9.99779522e-01f, 2.09984574e-02f, 9.99930263e-01f, 1.18088927e-02f, 9.99977946e-01f, 6.64073415e-03f, 9.99993026e-01f, 3.73437814e-03f,
  -9.99960840e-01f, -8.85130931e-03f, 9.81074572e-01f, -1.93630233e-01f, 7.81440377e-01f, 6.23979926e-01f, -7.17477441e-01f, -6.96581721e-01f,
  -5.88501155e-01f, 8.08496356e-01f, 3.27489585e-01f, 9.44854796e-01f, 7.67604589e-01f, 6.40923738e-01f, 9.24443960e-01f, 3.81317884e-01f,
  9.75897431e-01f, 2.18229622e-01f, 9.92357016e-01f, 1.23399742e-01f, 9.97581005e-01f, 6.95140064e-02f, 9.99234855e-01f, 3.91121693e-02f,
  9.99758005e-01f, 2.19982266e-02f, 9.99923468e-01f, 1.23711927e-02f, 9.99975801e-01f, 6.95695449e-03f, 9.99992371e-01f, 3.91220488e-03f,
  -5.32833040e-01f, -8.46220434e-01f, 9.33235765e-01f, 3.59264523e-01f, 5.48645258e-01f, 8.36055279e-01f, -5.82943261e-01f, -8.12512875e-01f,
  -6.66275978e-01f, 7.45705247e-01f, 2.73866832e-01f, 9.61767614e-01f, 7.46956408e-01f, 6.64873064e-01f, 9.17517304e-01f, 3.97695929e-01f,
  9.73666370e-01f, 2.27977514e-01f, 9.91647422e-01f, 1.28978193e-01f, 9.97356176e-01f, 7.26682767e-02f, 9.99163687e-01f, 4.08890247e-02f,
  9.99735534e-01f, 2.29979735e-02f, 9.99916375e-01f, 1.29334899e-02f, 9.99973536e-01f, 7.27317436e-03f, 9.99991655e-01f, 4.09003161e-03f,
  4.24179018e-01f, -9.05578375e-01f, 5.97977161e-01f, 8.01513135e-01f, 2.61441678e-01f, 9.65219259e-01f, -4.30023283e-01f, -9.02817786e-01f,
  -7.37393796e-01f, 6.75463140e-01f, 2.19378278e-01f, 9.75639880e-01f, 7.25561321e-01f, 6.88157499e-01f, 9.10300434e-01f, 4.13948208e-01f,
  9.71337974e-01f, 2.37702623e-01f, 9.90906477e-01f, 1.34552568e-01f, 9.97121394e-01f, 7.58218244e-02f, 9.99089420e-01f, 4.26657498e-02f,
  9.99711990e-01f, 2.39976961e-02f, 9.99908924e-01f, 1.34957815e-02f, 9.99971211e-01f, 7.58939330e-03f, 9.99990880e-01f, 4.26785741e-03f,
  9.91202831e-01f, -1.32351756e-01f, 7.85522610e-02f, 9.96909976e-01f, -5.16893305e-02f, 9.98663187e-01f, -2.63540596e-01f, -9.64648306e-01f,
  -8.01143587e-01f, 5.98472118e-01f, 1.64196163e-01f, 9.86427724e-01f, 7.03440726e-01f, 7.10753918e-01f, 9.02795732e-01f, 4.30069596e-01f,
  9.68912423e-01f, 2.47403964e-01f, 9.90134120e-01f, 1.40122697e-01f, 9.96876657e-01f, 7.89746121e-02f, 9.99011934e-01f, 4.44423407e-02f,
  9.99687493e-01f, 2.49973964e-02f, 9.99901175e-01f, 1.40580693e-02f, 9.99968767e-01f, 7.90561177e-03f, 9.99990106e-01f, 4.44568414e-03f,
  6.46919310e-01f, 7.62558460e-01f, -4.65064496e-01f, 8.85276794e-01f, -3.59694332e-01f, 9.33070183e-01f, -8.87455046e-02f, -9.96054351e-01f,
  -8.56888831e-01f, 5.15501261e-01f, 1.08494945e-01f, 9.94096994e-01f, 6.80616796e-01f, 7.32639611e-01f, 8.95005584e-01f, 4.46054995e-01f,
  9.66389954e-01f, 2.57080555e-01f, 9.89330530e-01f, 1.45688385e-01f, 9.96621907e-01f, 8.21266174e-02f, 9.98931348e-01f, 4.62187938e-02f,
  9.99662042e-01f, 2.59970706e-02f, 9.99893129e-01f, 1.46203535e-02f, 9.99966204e-01f, 8.22182931e-03f, 9.99989331e-01f, 4.62350994e-03f,
  -2.92138815e-01f, 9.56375957e-01f, -8.65450621e-01f, 5.00994205e-01f, -6.32028639e-01f, 7.74945021e-01f, 8.88481140e-02f, -9.96045172e-01f,
  -9.04072165e-01f, 4.27379847e-01f, 5.24506159e-02f, 9.98623490e-01f, 6.57112300e-01f, 7.53792703e-01f, 8.86932373e-01f, 4.61899310e-01f,
  9.63770926e-01f, 2.66731411e-01f, 9.88495648e-01f, 1.51249468e-01f, 9.96357203e-01f, 8.52777958e-02f, 9.98847544e-01f, 4.79951017e-02f,
  9.99635518e-01f, 2.69967206e-02f, 9.99884725e-01f, 1.51826320e-02f, 9.99963522e-01f, 8.53804592e-03f, 9.99988496e-01f, 4.80133574e-03f,
  -9.62605894e-01f, 2.70905793e-01f, -9.99293387e-01f, -3.75856608e-02f, -8.41684937e-01f, 5.39968967e-01f, 2.63639510e-01f, -9.64621305e-01f,
  -9.42222297e-01f, 3.34988207e-01f, -3.75941908e-03f, 9.99992907e-01f, 6.32950664e-01f, 7.74192095e-01f, 8.78578722e-01f, 4.77597594e-01f,
  9.61055458e-01f, 2.76355654e-01f, 9.87629473e-01f, 1.56805754e-01f, 9.96082544e-01f, 8.84281173e-02f, 9.98760641e-01f, 4.97712530e-02f,
  9.99608040e-01f, 2.79963426e-02f, 9.99876022e-01f, 1.57449059e-02f, 9.99960780e-01f, 8.85426160e-03f, 9.99987602e-01f, 4.97916201e-03f,
  -7.48057544e-01f, -6.63633883e-01f, -8.25371623e-01f, -5.64589798e-01f, -9.67871487e-01f, 2.51445323e-01f, 4.30115849e-01f, -9.02773678e-01f,
  -9.70958173e-01f, 2.39249229e-01f, -5.99575676e-02f, 9.98200953e-01f, 6.08156204e-01f, 7.93817401e-01f, 8.69947195e-01f, 4.93144840e-01f,
  9.58243906e-01f, 2.85952210e-01f, 9.86732066e-01f, 1.62357092e-01f, 9.95797932e-01f, 9.15775672e-02f, 9.98670578e-01f, 5.15472479e-02f,
  9.99579549e-01f, 2.89959367e-02f, 9.99867022e-01f, 1.63071752e-02f, 9.99957979e-01f, 9.17047635e-03f, 9.99986708e-01f, 5.15698735e-03f,
  1.54251456e-01f, -9.88031626e-01f, -3.97251874e-01f, -9.17709649e-01f, -9.98075247e-01f, -6.20148405e-02f, 5.83026946e-01f, -8.12452853e-01f,
  -9.89992499e-01f, 1.41120002e-01f, -1.15966164e-01f, 9.93253171e-01f, 5.82753658e-01f, 8.12648892e-01f, 8.61040652e-01f, 5.08536100e-01f,
  9.55336511e-01f, 2.95520186e-01f, 9.85803485e-01f, 1.67903304e-01f, 9.95503366e-01f, 9.47260931e-02f, 9.98577297e-01f, 5.33230826e-02f,
  9.99550045e-01f, 2.99955010e-02f, 9.99857724e-01f, 1.68694388e-02f, 9.99954998e-01f, 9.48669016e-03f, 9.99985754e-01f, 5.33481315e-03f,
  9.14742351e-01f, -4.04037654e-01f, 1.53215483e-01f, -9.88192797e-01f, -9.29300308e-01f, -3.69325012e-01f, 7.17549205e-01f, -6.96507812e-01f,
  -9.99135137e-01f, 4.15805206e-02f, -1.71608135e-01f, 9.85165298e-01f, 5.56768358e-01f, 8.30667794e-01f, 8.51861775e-01f, 5.23766637e-01f,
  9.52333570e-01f, 3.05058628e-01f, 9.84843671e-01f, 1.73444211e-01f, 9.95198846e-01f, 9.78736654e-02f, 9.98480916e-01f, 5.50987460e-02f,
  9.99519527e-01f, 3.09950355e-02f, 9.99848068e-01f, 1.74316969e-02f, 9.99951959e-01f, 9.80290305e-03f, 9.99984801e-01f, 5.51263802e-03f,
  8.34223390e-01f, 5.51426709e-01f, 6.56495154e-01f, -7.54330218e-01f, -7.68367112e-01f, -6.40009403e-01f, 8.29440355e-01f, -5.58595300e-01f,
  -9.98294771e-01f, -5.83741926e-02f, -2.26707578e-01f, 9.73962843e-01f, 5.30226350e-01f, 8.47856104e-01f, 8.42413545e-01f, 5.38831532e-01f,
  9.49235439e-01f, 3.14566553e-01f, 9.83852804e-01f, 1.78979620e-01f, 9.94884372e-01f, 1.01020269e-01f, 9.98381376e-01f, 5.68742342e-02f,
  9.99488056e-01f, 3.19945402e-02f, 9.99838114e-01f, 1.79939512e-02f, 9.99948800e-01f, 1.01191159e-02f, 9.99983788e-01f, 5.69046335e-03f,
  -1.32767474e-02f, 9.99911845e-01f, 9.57586050e-01f, -2.88147390e-01f, -5.31235278e-01f, -8.47224355e-01f, 9.15171385e-01f, -4.03064936e-01f,
  -9.87479806e-01f, -1.57745644e-01f, -2.81090319e-01f, 9.59681332e-01f, 5.03154159e-01f, 8.64196658e-01f, 8.32698941e-01f, 5.53726017e-01f,
  9.46042359e-01f, 3.24043006e-01f, 9.82830763e-01f, 1.84509367e-01f, 9.94559944e-01f, 1.04165860e-01f, 9.98278618e-01f, 5.86495437e-02f,
  9.99455571e-01f, 3.29940096e-02f, 9.99827802e-01f, 1.85561981e-02f, 9.99945521e-01f, 1.04353270e-02f, 9.99982774e-01f, 5.86828869e-03f,
  -8.48570287e-01f, 5.29082716e-01f, 9.63757515e-01f, 2.66779721e-01f, -2.41421118e-01f, -9.70420420e-01f, 9.72038329e-01f, -2.34822124e-01f,
  -9.66798186e-01f, -2.55541205e-01f, -3.34584385e-01f, 9.42365825e-01f, 4.75578904e-01f, 8.79673064e-01f, 8.22721004e-01f, 5.68445385e-01f,
  9.42754686e-01f, 3.33487093e-01f, 9.81777668e-01f, 1.90033287e-01f, 9.94225562e-01f, 1.07310407e-01f, 9.98172760e-01f, 6.04246669e-02f,
  9.99422073e-01f, 3.39934528e-02f, 9.99817252e-01f, 1.91184394e-02f, 9.99942183e-01f, 1.07515370e-02f, 9.99981701e-01f, 6.04611309e-03f,
  -9.03692186e-01f, -4.28182662e-01f, 6.73110247e-01f, 7.39542127e-01f, 7.23346695e-02f, -9.97380435e-01f, 9.98247743e-01f, -5.91726787e-02f,
  -9.36456680e-01f, -3.50783229e-01f, -3.87020677e-01f, 9.22071040e-01f, 4.47528064e-01f, 8.94269884e-01f, 8.12482953e-01f, 5.82984984e-01f,
  9.39372718e-01f, 3.42897803e-01f, 9.80693519e-01f, 1.95551202e-01f, 9.93881226e-01f, 1.10453881e-01f, 9.98063743e-01f, 6.21996038e-02f,
  9.99387562e-01f, 3.49928550e-02f, 9.99806345e-01f, 1.96806751e-02f, 9.99938726e-01f, 1.10677453e-02f, 9.99980628e-01f, 6.22393796e-03f,
  -1.27963692e-01f, -9.91778851e-01f, 1.75156534e-01f, 9.84540582e-01f, 3.78916174e-01f, -9.25431013e-01f, 9.92972851e-01f, 1.18342586e-01f,
  -8.96758378e-01f, -4.42520559e-01f, -4.38233554e-01f, 8.98861170e-01f, 4.19029742e-01f, 9.07972515e-01f, 8.01987886e-01f, 5.97340286e-01f,
  9.35896814e-01f, 3.52274209e-01f, 9.79578316e-01f, 2.01062918e-01f, 9.93526995e-01f, 1.13596253e-01f, 9.97951567e-01f, 6.39743358e-02f,
  9.99352098e-01f, 3.59922275e-02f, 9.99795079e-01f, 2.02429052e-02f, 9.99935210e-01f, 1.13839535e-02f, 9.99979496e-01f, 6.40176190e-03f,
  7.65414059e-01f, -6.43538117e-01f, -3.76742303e-01f, 9.26318109e-01f, 6.47921681e-01f, -7.61706948e-01f, 9.56380010e-01f, 2.92125374e-01f,
  -8.48100007e-01f, -5.29836178e-01f, -4.88060862e-01f, 8.72809589e-01f, 3.90112430e-01f, 9.20767248e-01f, 7.91239262e-01f, 6.11506701e-01f,
  9.32327330e-01f, 3.61615449e-01f, 9.78432178e-01f, 2.06568271e-01f, 9.93162811e-01f, 1.16737492e-01f, 9.97836173e-01f, 6.57488778e-02f,
  9.99315560e-01f, 3.69915590e-02f, 9.99783576e-01f, 2.08051261e-02f, 9.99931574e-01f, 1.17001599e-02f, 9.99978364e-01f, 6.57958630e-03f,
  9.55073655e-01f, 2.96368569e-01f, -8.12611222e-01f, 5.82806170e-01f, 8.52673113e-01f, -5.22444785e-01f, 8.89623463e-01f, 4.56694692e-01f,
  -7.90967762e-01f, -6.11857831e-01f, -5.36345184e-01f, 8.43998730e-01f, 3.60805035e-01f, 9.32641268e-01f, 7.80240417e-01f, 6.25479698e-01f,
  9.28664625e-01f, 3.70920479e-01f, 9.77255106e-01f, 2.12067112e-01f, 9.92788672e-01f, 1.19877554e-01f, 9.97717679e-01f, 6.75232038e-02f,
  9.99278069e-01f, 3.79908569e-02f, 9.99771714e-01f, 2.13673431e-02f, 9.99927819e-01f, 1.20163653e-02f, 9.99977171e-01f, 6.75741071e-03f,
  2.66642928e-01f, 9.63795364e-01f, -9.98210371e-01f, 5.98003156e-02f, 9.72865343e-01f, -2.31372014e-01f, 7.94808388e-01f, 6.06860459e-01f,
  -7.25932240e-01f, -6.87766254e-01f, -5.82933903e-01f, 8.12519610e-01f, 3.31136853e-01f, 9.43582714e-01f, 7.68994927e-01f, 6.39254928e-01f,
  9.24909055e-01f, 3.80188406e-01f, 9.76047099e-01f, 2.17559248e-01f, 9.92404640e-01f, 1.23016424e-01f, 9.97596025e-01f, 6.92973137e-02f,
  9.99239624e-01f, 3.89901139e-02f, 9.99759495e-01f, 2.19295528e-02f, 9.99923944e-01f, 1.23325698e-02f, 9.99975979e-01f, 6.93523418e-03f,
  -6.66938066e-01f, 7.45113134e-01f, -8.76379430e-01f, -4.81621295e-01f, 9.96578991e-01f, 8.26458037e-02f, 6.74925625e-01f, 7.37885714e-01f,
  -6.53643608e-01f, -7.56802499e-01f, -6.27679706e-01f, 7.78471708e-01f, 3.01137596e-01f, 9.53580678e-01f, 7.57506192e-01f, 6.52827978e-01f,
  9.21060979e-01f, 3.89418334e-01f, 9.74808276e-01f, 2.23044485e-01f, 9.92010653e-01f, 1.26154065e-01f, 9.97471273e-01f, 7.10712075e-02f,
  9.99200106e-01f, 3.99893373e-02f, 9.99747038e-01f, 2.24917568e-02f, 9.99920011e-01f, 1.26487734e-02f, 9.99974728e-01f, 7.11305765e-03f,
  -9.87339258e-01f, -1.58622667e-01f, -4.84639406e-01f, -8.74714017e-01f, 9.21462357e-01f, 3.88467699e-01f, 5.33756077e-01f, 8.45638454e-01f,
  -5.74824035e-01f, -8.18277061e-01f, -6.70441091e-01f, 7.41962790e-01f, 2.70837069e-01f, 9.62625206e-01f, 7.45777905e-01f, 6.66194677e-01f,
  9.17120814e-01f, 3.98609310e-01f, 9.73538578e-01f, 2.28522688e-01f, 9.91606772e-01f, 1.29290432e-01f, 9.97343302e-01f, 7.28448778e-02f,
  9.99159634e-01f, 4.09885161e-02f, 9.99734223e-01f, 2.30539497e-02f, 9.99915957e-01f, 1.29649751e-02f, 9.99973416e-01f, 7.29088066e-03f,
  -3.99985313e-01f, -9.16521549e-01f, 5.63609414e-02f, -9.98410463e-01f, 7.54965365e-01f, 6.55764699e-01f, 3.75752151e-01f, 9.26720202e-01f,
  -4.90260571e-01f, -8.71575892e-01f, -7.11082935e-01f, 7.03108132e-01f, 2.40265876e-01f, 9.70707119e-01f, 7.33813822e-01f, 6.79350674e-01f,
  9.13088918e-01f, 4.07760441e-01f, 9.72238123e-01f, 2.33993664e-01f, 9.91192937e-01f, 1.32425532e-01f, 9.97212172e-01f, 7.46183172e-02f,
  9.99118149e-01f, 4.19876575e-02f, 9.99721110e-01f, 2.36161388e-02f, 9.99911785e-01f, 1.32811759e-02f, 9.99972105e-01f, 7.46870413e-03f,
  5.55113316e-01f, -8.31774771e-01f, 5.80003142e-01f, -8.14614236e-01f, 5.13598442e-01f, 8.58030677e-01f, 2.05897167e-01f, 9.78573620e-01f,
  -4.00799006e-01f, -9.16166008e-01f, -7.49476731e-01f, 6.62030637e-01f, 2.09454417e-01f, 9.77818429e-01f, 7.21617639e-01f, 6.92291796e-01f,
  9.08965766e-01f, 4.16870773e-01f, 9.70906913e-01f, 2.39457220e-01f, 9.90769207e-01f, 1.35559291e-01f, 9.97077882e-01f, 7.63915181e-02f,
  9.99075651e-01f, 4.29867506e-02f, 9.99707639e-01f, 2.41783205e-02f, 9.99907553e-01f, 1.35973748e-02f, 9.99970794e-01f, 7.64652714e-03f,
  9.99843299e-01f, 1.77019257e-02f, 9.25014675e-01f, -3.79931390e-01f, 2.21298173e-01f, 9.75206196e-01f, 2.95478199e-02f, 9.99563396e-01f,
  -3.07332784e-01f, -9.51602101e-01f, -7.85501122e-01f, 6.18860185e-01f, 1.78433523e-01f, 9.83951986e-01f, 7.09193349e-01f, 7.05014050e-01f,
  9.04751658e-01f, 4.25939471e-01f, 9.69545007e-01f, 2.44913206e-01f, 9.90335584e-01f, 1.38691694e-01f, 9.96940494e-01f, 7.81644881e-02f,
  9.99032140e-01f, 4.39858064e-02f, 9.99693930e-01f, 2.47404929e-02f, 9.99903202e-01f, 1.39135728e-02f, 9.99969363e-01f, 7.82434922e-03f,
  5.25321960e-01f, 8.50903511e-01f, 9.85138178e-01f, 1.71763569e-01f, -9.29481089e-02f, 9.95670974e-01f, -1.47732988e-01f, 9.89027262e-01f,
  -2.10795805e-01f, -9.77530122e-01f, -8.19042206e-01f, 5.73733270e-01f, 1.47234216e-01f, 9.89101648e-01f, 6.96544766e-01f, 7.17513323e-01f,
  9.00447130e-01f, 4.34965521e-01f, 9.68152404e-01f, 2.50361472e-01f, 9.89892066e-01f, 1.41822711e-01f, 9.96799886e-01f, 7.99371973e-02f,
  9.98987675e-01f, 4.49848175e-02f, 9.99679863e-01f, 2.53026579e-02f, 9.99898732e-01f, 1.42297689e-02f, 9.99967992e-01f, 8.00217129e-03f,
  -4.32177931e-01f, 9.01788354e-01f, 7.41858006e-01f, 6.70557022e-01f, -3.97976756e-01f, 9.17395473e-01f, -3.20354372e-01f, 9.47297752e-01f,
  -1.12152621e-01f, -9.93690968e-01f, -8.49993885e-01f, 5.26792526e-01f, 1.15887694e-01f, 9.93262351e-01f, 6.83675885e-01f, 7.29785740e-01f,
  8.96052480e-01f, 4.43948090e-01f, 9.66729224e-01f, 2.55801797e-01f, 9.89438653e-01f, 1.44952312e-01f, 9.96656179e-01f, 8.17096606e-02f,
  9.98942196e-01f, 4.59837839e-02f, 9.99665439e-01f, 2.58648153e-02f, 9.99894202e-01f, 1.45459641e-02f, 9.99966562e-01f, 8.17999430e-03f,
  -9.92335498e-01f, 1.23573124e-01f, 2.70098448e-01f, 9.62832689e-01f, -6.63538277e-01f, 7.48142362e-01f, -4.82871950e-01f, 8.75690997e-01f,
  -1.23883775e-02f, -9.99923289e-01f, -8.78258407e-01f, 4.78186339e-01f, 8.44252855e-02f, 9.96429801e-01f, 6.70590878e-01f, 7.41827428e-01f,
  8.91568303e-01f, 4.52886283e-01f, 9.65275466e-01f, 2.61234075e-01f, 9.88975346e-01f, 1.48080453e-01f, 9.96509314e-01f, 8.34818557e-02f,
  9.98895705e-01f, 4.69827019e-02f, 9.99650776e-01f, 2.64269635e-02f, 9.99889553e-01f, 1.48621574e-02f, 9.99965072e-01f, 8.35781638e-03f,
  -6.40144348e-01f, -7.68254638e-01f, -2.84846604e-01f, 9.58573103e-01f, -8.63296509e-01f, 5.04697084e-01f, -6.30159974e-01f, 7.76465356e-01f,
  8.74991715e-02f, -9.96164620e-01f, -9.03746367e-01f, 4.28068399e-01f, 5.28784581e-02f, 9.98600960e-01f, 6.57293737e-01f, 7.53634512e-01f,
  8.86994898e-01f, 4.61779177e-01f, 9.63791192e-01f, 2.66658038e-01f, 9.88502085e-01f, 1.51207119e-01f, 9.96359289e-01f, 8.52537975e-02f,
  9.98848200e-01f, 4.79815714e-02f, 9.99635756e-01f, 2.69891042e-02f, 9.99884784e-01f, 1.51783489e-02f, 9.99963582e-01f, 8.53563752e-03f,
  3.00592542e-01f, -9.53752637e-01f, -7.52063990e-01f, 6.59090102e-01f, -9.77442741e-01f, 2.11200655e-01f, -7.57573068e-01f, 6.52750373e-01f,
  1.86512470e-01f, -9.82452571e-01f, -9.26377118e-01f, 3.76597136e-01f, 2.12787576e-02f, 9.99773562e-01f, 6.43788815e-01f, 7.65203178e-01f,
  8.82332861e-01f, 4.70625877e-01f, 9.62276459e-01f, 2.72073567e-01f, 9.88018990e-01f, 1.54332280e-01f, 9.96206105e-01f, 8.70254710e-02f,
  9.98799741e-01f, 4.89803962e-02f, 9.99620378e-01f, 2.75512375e-02f, 9.99879956e-01f, 1.54945394e-02f, 9.99962032e-01f, 8.71345960e-03f,
  9.64965999e-01f, -2.62374848e-01f, -9.87659097e-01f, 1.56619072e-01f, -9.94656444e-01f, -1.03240460e-01f, -8.61092687e-01f, 5.08447945e-01f,
  2.83662200e-01f, -9.58924294e-01f, -9.46079254e-01f, 3.23935270e-01f, -1.03422189e-02f, 9.99946535e-01f, 6.30080283e-01f, 7.76529968e-01f,
  8.77582550e-01f, 4.79425550e-01f, 9.60731268e-01f, 2.77480543e-01f, 9.87526000e-01f, 1.57455891e-01f, 9.96049762e-01f, 8.87968615e-02f,
  9.98750269e-01f, 4.99791689e-02f, 9.99604762e-01f, 2.81133596e-02f, 9.99875009e-01f, 1.58107281e-02f, 9.99960482e-01f, 8.89127981e-03f,
  7.42154181e-01f, 6.70229197e-01f, -9.19073522e-01f, -3.94086063e-01f, -9.13230121e-01f, -4.07444149e-01f, -9.37454224e-01f, 3.48108500e-01f,
  3.77977669e-01f, -9.25814748e-01f, -9.62790370e-01f, 2.70249337e-01f, -4.19528559e-02f, 9.99119580e-01f, 6.16172493e-01f, 7.87611187e-01f,
  8.72744501e-01f, 4.88177240e-01f, 9.59155679e-01f, 2.82878697e-01f, 9.87023175e-01f, 1.60577938e-01f, 9.95890260e-01f, 9.05679762e-02f,
  9.98699784e-01f, 5.09778969e-02f, 9.99588788e-01f, 2.86754742e-02f, 9.99869943e-01f, 1.61269177e-02f, 9.99958873e-01f, 9.06910095e-03f,
  -1.62990779e-01f, 9.86627579e-01f, -5.67430019e-01f, -8.23421597e-01f, -7.41239965e-01f, -6.71240151e-01f, -9.84248459e-01f, 1.76790684e-01f,
  4.68516916e-01f, -8.83454502e-01f, -9.76457715e-01f, 2.15709001e-01f, -7.35215396e-02f, 9.97293651e-01f, 6.02069914e-01f, 7.98443377e-01f,
  8.67819190e-01f, 4.96880114e-01f, 9.57549810e-01f, 2.88267940e-01f, 9.86510456e-01f, 1.63698375e-01f, 9.95727658e-01f, 9.23388004e-02f,
  9.98648286e-01f, 5.19765690e-02f, 9.99572515e-01f, 2.92375814e-02f, 9.99864817e-01f, 1.64431017e-02f, 9.99957263e-01f, 9.24692024e-03f,
  -9.18282807e-01f, 3.95925164e-01f, -4.10281904e-02f, -9.99157965e-01f, -4.95741814e-01f, -8.68469954e-01f, -1.00000000e+00f, -1.03020677e-04f,
  5.54374516e-01f, -8.32267344e-01f, -9.87038016e-01f, 1.60486728e-01f, -1.05016708e-01f, 9.94470477e-01f, 5.87776959e-01f, 8.09023023e-01f,
  8.62807095e-01f, 5.05533338e-01f, 9.55913603e-01f, 2.93648034e-01f, 9.85987842e-01f, 1.66817173e-01f, 9.95561838e-01f, 9.41093415e-02f,
  9.98595834e-01f, 5.29751927e-02f, 9.99555886e-01f, 2.97996756e-02f, 9.99859571e-01f, 1.67592876e-02f, 9.99955595e-01f, 9.42474138e-03f,
  -8.29309821e-01f, -5.58789074e-01f, 4.98009592e-01f, -8.67171526e-01f, -2.01079622e-01f, -9.79574919e-01f, -9.84212041e-01f, -1.76993474e-01f,
  6.34692967e-01f, -7.72764444e-01f, -9.94497895e-01f, 1.04756832e-01f, -1.36406869e-01f, 9.90652919e-01f, 5.73298037e-01f, 8.19346905e-01f,
  8.57708693e-01f, 5.14135957e-01f, 9.54247177e-01f, 2.99018890e-01f, 9.85455394e-01f, 1.69934288e-01f, 9.95392919e-01f, 9.58795771e-02f,
  9.98542368e-01f, 5.39737605e-02f, 9.99538958e-01f, 3.03617641e-02f, 9.99854207e-01f, 1.70754679e-02f, 9.99953866e-01f, 9.60256159e-03f,
  2.21267566e-02f, -9.99755144e-01f, 8.83669317e-01f, -4.68111664e-01f, 1.13521777e-01f, -9.93535519e-01f, -9.37382519e-01f, -3.48301649e-01f,
  7.08669782e-01f, -7.05540299e-01f, -9.98813629e-01f, 4.86960001e-02f, -1.67660639e-01f, 9.85844791e-01f, 5.58637917e-01f, 8.29411685e-01f,
  8.52524519e-01f, 5.22687256e-01f, 9.52550590e-01f, 3.04380238e-01f, 9.84913111e-01f, 1.73049718e-01f, 9.95220840e-01f, 9.76495072e-02f,
  9.98487890e-01f, 5.49722798e-02f, 9.99521732e-01f, 3.09238415e-02f, 9.99848783e-01f, 1.73916500e-02f, 9.99952197e-01f, 9.78038087e-03f,
  8.53220105e-01f, -5.21551013e-01f, 9.97174621e-01f, 7.51182064e-02f, 4.16867077e-01f, -9.08967435e-01f, -8.60988438e-01f, -5.08624554e-01f,
  7.75565803e-01f, -6.31266713e-01f, -9.99971747e-01f, -7.51878507e-03f, -1.98746875e-01f, 9.80050862e-01f, 5.43801069e-01f, 8.39214146e-01f,
  8.47255111e-01f, 5.31186223e-01f, 9.50823903e-01f, 3.09731960e-01f, 9.84360933e-01f, 1.76163420e-01f, 9.95045662e-01f, 9.94191393e-02f,
  9.98432398e-01f, 5.59707358e-02f, 9.99504209e-01f, 3.14859077e-02f, 9.99843180e-01f, 1.77078284e-02f, 9.99950409e-01f, 9.95820016e-03f,
  8.99866819e-01f, 4.36164767e-01f, 8.03569078e-01f, 5.95211506e-01f, 6.78870201e-01f, -7.34258294e-01f, -7.57439196e-01f, -6.52905703e-01f,
  8.34712923e-01f, -5.50685287e-01f, -9.97968495e-01f, -6.37097955e-02f, -2.29634270e-01f, 9.73276973e-01f, 5.28792322e-01f, 8.48751247e-01f,
  8.41901004e-01f, 5.39632022e-01f, 9.49067116e-01f, 3.15073937e-01f, 9.83798921e-01f, 1.79275364e-01f, 9.94867265e-01f, 1.01188451e-01f,
  9.98375952e-01f, 5.69691435e-02f, 9.99486327e-01f, 3.20479684e-02f, 9.99837577e-01f, 1.80240069e-02f, 9.99948621e-01f, 1.01360194e-02f,
  1.19180135e-01f, 9.92872655e-01f, 3.62476677e-01f, 9.31992829e-01f, 8.73550534e-01f, -4.86733496e-01f, -6.30000710e-01f, -7.76594579e-01f,
  8.85519624e-01f, -4.64602023e-01f, -9.92810190e-01f, -1.19699396e-01f, -2.60292053e-01f, 9.65529919e-01f, 5.13616323e-01f, 8.58020008e-01f,
  8.36462677e-01f, 5.48023939e-01f, 9.47280347e-01f, 3.20405900e-01f, 9.83227074e-01f, 1.82385504e-01f, 9.94685769e-01f, 1.02957435e-01f,
  9.98318493e-01f, 5.79674877e-02f, 9.99468148e-01f, 3.26100141e-02f, 9.99831796e-01f, 1.83401816e-02f, 9.99946833e-01f, 1.03138378e-02f,
  -7.71080196e-01f, 6.36738002e-01f, -1.90249100e-01f, 9.81735826e-01f, 9.81602073e-01f, -1.90938011e-01f, -4.82692331e-01f, -8.75790000e-01f,
  9.27478492e-01f, -3.73876572e-01f, -9.84513164e-01f, -1.75310582e-01f, -2.90689558e-01f, 9.56817448e-01f, 4.98277903e-01f, 8.67017388e-01f,
  8.30940723e-01f, 5.56361020e-01f, 9.45463598e-01f, 3.25727791e-01f, 9.82645452e-01f, 1.85493827e-01f, 9.94501114e-01f, 1.04726106e-01f,
  9.98260021e-01f, 5.89657798e-02f, 9.99449670e-01f, 3.31720486e-02f, 9.99825954e-01f, 1.86563563e-02f, 9.99944985e-01f, 1.04916561e-02f,
  -9.52412963e-01f, -3.04810613e-01f, -6.84381902e-01f, 7.29123712e-01f, 9.92308319e-01f, 1.23790950e-01f, -3.20159167e-01f, -9.47363734e-01f,
  9.60170269e-01f, -2.79415488e-01f, -9.73103702e-01f, -2.30367512e-01f, -3.20796400e-01f, 9.47148204e-01f, 4.82782036e-01f, 8.75740528e-01f,
  8.25335622e-01f, 5.64642429e-01f, 9.43616986e-01f, 3.31039310e-01f, 9.82053936e-01f, 1.88600287e-01f, 9.94313300e-01f, 1.06494442e-01f,
  9.98200536e-01f, 5.99640086e-02f, 9.99430835e-01f, 3.37340795e-02f, 9.99819994e-01f, 1.89725272e-02f, 9.99943078e-01f, 1.06694745e-02f,
  -2.58101642e-01f, -9.66117799e-01f, -9.67739642e-01f, 2.51952261e-01f, 9.04607594e-01f, 4.26245421e-01f, -1.47529200e-01f, -9.89057720e-01f,
  9.83268440e-01f, -1.82162598e-01f, -9.58617806e-01f, -2.84696162e-01f, -3.50582451e-01f, 9.36531842e-01f, 4.67133403e-01f, 8.84186864e-01f,
  8.19648027e-01f, 5.72867453e-01f, 9.41740453e-01f, 3.36340427e-01f, 9.81452644e-01f, 1.91704854e-01f, 9.94122326e-01f, 1.08262435e-01f,
  9.98140097e-01f, 6.09621815e-02f, 9.99411702e-01f, 3.42960916e-02f, 9.99813974e-01f, 1.92886982e-02f, 9.99941170e-01f, 1.08472919e-02f,
  6.73507154e-01f, -7.39180684e-01f, -9.53050017e-01f, -3.02812874e-01f, 7.27198064e-01f, 6.86427653e-01f, 2.97537707e-02f, -9.99557257e-01f,
  9.96542096e-01f, -8.30891207e-02f, -9.41101313e-01f, -3.38124752e-01f, -3.80017966e-01f, 9.24979091e-01f, 4.51337039e-01f, 8.92353535e-01f,
  8.13878477e-01f, 5.81035137e-01f, 9.39834237e-01f, 3.41630876e-01f, 9.80841517e-01f, 1.94807529e-01f, 9.93928254e-01f, 1.10030092e-01f,
  9.98078644e-01f, 6.19602874e-02f, 9.99392271e-01f, 3.48580964e-02f, 9.99807835e-01f, 1.96048655e-02f, 9.99939203e-01f, 1.10251084e-02f,
  9.85896587e-01f, 1.67355701e-01f, -6.44837022e-01f, -7.64320076e-01f, 4.77671444e-01f, 8.78538549e-01f, 2.06098333e-01f, -9.78531301e-01f,
  9.99858618e-01f, 1.68140903e-02f, -9.20609534e-01f, -3.90484393e-01f, -4.09073502e-01f, 9.12501454e-01f, 4.35397953e-01f, 9.00238097e-01f,
  8.08027506e-01f, 5.89144766e-01f, 9.37898219e-01f, 3.46910536e-01f, 9.80220556e-01f, 1.97908238e-01f, 9.93731022e-01f, 1.11797392e-01f,
  9.98016179e-01f, 6.29583374e-02f, 9.99372482e-01f, 3.54200937e-02f, 9.99801576e-01f, 1.99210308e-02f, 9.99937236e-01f, 1.12029258e-02f,
};

constexpr int T_ALL = 36864, T_CTX = 4096;
constexpr int NLAYER = 4;
constexpr float EPS = 1e-6f;
constexpr int LK_LAT = 4352;

struct Params {
  const float* x_prompt; const float* x_sample; const float* cache_ckv; const float* cache_krope;
  const float* cache_k; const float* cache_v; const float* state; const float* c; const float* c_ctx;
  const float* w_mod; const float* b_mod; const float* g_norm; const float* w_in; const float* conv_w; const float* conv_b;
  const float* lru_wa; const float* lru_ba; const float* lru_wi; const float* lru_bi; const float* lru_lam;
  const float* q_norm; const float* w_uq; const float* kv_norm; const float* w_ukv; const float* sink;
  const float* w_br_rnn; const float* w_br_mla; const float* w_br_swa; const float* w_out; const float* final_norm;
  float* out; char* ws;
};

constexpr size_t AL(size_t x) { return (x + 255) & ~(size_t)255; }
constexpr size_t O_WINA = 0;
constexpr size_t O_WINB = O_WINA + AL((size_t)2560 * 1024 * 2);
constexpr size_t O_WLRU = O_WINB + AL((size_t)5120 * 1024 * 2);
constexpr size_t O_WUQ = O_WLRU + AL((size_t)4096 * 128 * 2);
constexpr size_t O_WUKVG = O_WUQ + AL((size_t)768 * 384 * 2);
constexpr size_t O_WUKVR = O_WUKVG + AL((size_t)1024 * 256 * 2);
constexpr size_t O_WBRR = O_WUKVR + AL((size_t)1024 * 256 * 2);
constexpr size_t O_WBRM = O_WBRR + AL((size_t)1024 * 1024 * 2);
constexpr size_t O_WBRS = O_WBRM + AL((size_t)1024 * 512 * 2);
constexpr size_t O_WOUT = O_WBRS + AL((size_t)1024 * 512 * 2);
constexpr size_t O_MOD = O_WOUT + AL((size_t)1024 * 1024 * 2);
constexpr size_t O_H = O_MOD + AL((size_t)4 * 9 * 3072 * 4);
constexpr size_t O_XR = O_H + AL((size_t)T_ALL * 1024 * 2);
constexpr size_t O_CQ = O_XR + AL((size_t)T_ALL * 1024 * 2);
constexpr size_t O_CKV = O_CQ + AL((size_t)T_ALL * 384 * 2);
constexpr size_t O_CKVC = O_CKV + AL((size_t)T_ALL * 256 * 2);
constexpr size_t O_KRL = O_CKVC + AL((size_t)2048 * 256 * 2);
constexpr size_t O_KRC = O_KRL + AL((size_t)8 * LK_LAT * 32 * 2);
constexpr size_t O_QS = O_KRC + AL((size_t)16 * 256 * 32 * 2);
constexpr size_t O_KS = O_QS + AL((size_t)T_ALL * 512 * 2);
constexpr size_t O_KSC = O_KS + AL((size_t)T_ALL * 128 * 2);
constexpr size_t O_VTSL = O_KSC + AL((size_t)8 * 256 * 128 * 2);
constexpr size_t O_VTSC = O_VTSL + AL((size_t)8 * 2 * 64 * 4096 * 2);
constexpr size_t O_VTSCC = O_VTSC + AL((size_t)16 * 2 * 64 * 256 * 2);
constexpr size_t O_Q = O_VTSCC + AL((size_t)8 * 2 * 64 * 256 * 2);
constexpr size_t O_KNL = O_Q + AL((size_t)T_ALL * 768 * 2);
constexpr size_t O_KNC = O_KNL + AL((size_t)8 * 8 * LK_LAT * 64 * 2);
constexpr size_t O_VTL = O_KNC + AL((size_t)16 * 8 * 256 * 64 * 2);
constexpr size_t O_VTC = O_VTL + AL((size_t)8 * 8 * 64 * LK_LAT * 2);
constexpr size_t O_YRNN = O_VTC + AL((size_t)16 * 8 * 64 * 256 * 2);
static_assert(O_YRNN - O_KS >= (size_t)2 * T_ALL * 1024 * 2, "merge-gate buffers do not fit");
constexpr size_t O_SUM = O_YRNN + AL((size_t)T_ALL * 1024 * 2);
constexpr size_t O_BAR = O_SUM + AL((size_t)8 * 8 * 2 * 16 * 256 * 4);
constexpr size_t BAR_BYTES = 16384;
constexpr size_t O_W2 = O_BAR + BAR_BYTES;
constexpr size_t WS_NEED = O_W2 + O_MOD;

constexpr size_t OUT_CKV = (size_t)T_ALL * 1024;
constexpr size_t OUT_KROPE = OUT_CKV + (size_t)16 * 4 * 256 * 256;
constexpr size_t OUT_SK = OUT_KROPE + (size_t)16 * 4 * 256 * 32;
constexpr size_t OUT_SV = OUT_SK + (size_t)16 * 4 * 256 * 128;
constexpr size_t OUT_RG = OUT_SV + (size_t)16 * 4 * 256 * 128;

#define SB() __builtin_amdgcn_sched_barrier(0)
#define MB() asm volatile("" ::: "memory")
DI int tid() { int t = threadIdx.x; asm volatile("" : "+v"(t)); return t; }
DI int xcd_map(int base) {
  const int g = gridDim.x;
  if (g & 7) return base + blockIdx.x;
  return base + (blockIdx.x & 7) * (g >> 3) + (blockIdx.x >> 3);
}
#define LANEVARS const int t = tid(), lane = t & 63, w = t >> 6, wr = w >> 1, wc = w & 1; const int c16 = lane & 15, g4 = lane >> 4; (void)wr; (void)wc; (void)c16; (void)g4;
DI float bf2f(u16 v) { return __uint_as_float(((unsigned)v) << 16); }
DI unsigned pack2(float a, float b) {
  f2_t v = {a, b};
  bf2_t r = __builtin_convertvector(v, bf2_t);
  return __builtin_bit_cast(unsigned, r);
}
DI u16 f2bf(float a) { return (u16)(pack2(a, 0.f) & 0xffffu); }
DI float sigmoidf_(float x) { return 1.f / (1.f + __expf(-x)); }
DI float wave_sum(float v) {
#pragma unroll
  for (int o = 32; o > 0; o >>= 1) v += __shfl_xor(v, o);
  return v;
}
DI int perm32(int p) { return (p & 7) | ((p & 8) << 1) | ((p & 16) >> 1); }
DI const float* xin_row(const Params& p, int l, int row) {
  if (l == 0) return row < T_CTX ? p.x_prompt + (size_t)row * 1024 : p.x_sample + (size_t)(row - T_CTX) * 1024;
  return p.out + (size_t)row * 1024;
}
template <class T> DI T* wsp(const Params& p, size_t off) { return (T*)(p.ws + off); }
DI u16* wsw(const Params& p, int l, size_t off) { return (u16*)(p.ws + ((l & 1) ? O_W2 : 0) + off); }

template <int NJ>
DI void gemm_tile_t(const u16* A, int lda, const u16* B, int ldb, int K,
                    f32x4 (&acc)[4][NJ], char* smem) {
  const int t = tid(), lane = t & 63, w = t >> 6, wr = w >> 1, wc = w & 1;
  const int lr = t >> 3, slot = t & 7;
  const int c16 = lane & 15, g4 = lane >> 4;
  const int gch = slot ^ ((lr >> 1) & 7);
  const u16* ap = A + (size_t)lr * lda + gch * 8;
  const u16* bp = B + (size_t)lr * ldb + gch * 8;
  char* sdst = smem + t * 16;
#define DMA16(gp, lp) __builtin_amdgcn_global_load_lds((const unsigned*)(gp), (unsigned*)(lp), 16, 0, 0)
#define STAGE(base, ko) { DMA16(ap + (ko), (base)); DMA16(ap + (size_t)32 * lda + (ko), (base) + 4096); \
    DMA16(ap + (size_t)64 * lda + (ko), (base) + 8192); DMA16(ap + (size_t)96 * lda + (ko), (base) + 12288); \
    DMA16(bp + (ko), (base) + 16384); DMA16(bp + (size_t)32 * ldb + (ko), (base) + 16384 + 4096); \
    if (NJ > 2) { DMA16(bp + (size_t)64 * ldb + (ko), (base) + 16384 + 8192); DMA16(bp + (size_t)96 * ldb + (ko), (base) + 16384 + 12288); } }
  const int nk = K >> 6;
  const int arow = (wr * 64 + c16) * 128, brow = (wc * (16 * NJ) + c16) * 128;
  const int sw = (c16 >> 1) & 7;
  int kk = 0;
  STAGE(sdst, kk * 64)
  __syncthreads();
  for (int kt = 0; kt < nk; ++kt) {
    char* cur = smem + (kt & 1) * 32768;
    kk = (kk + 1 == nk) ? 0 : kk + 1;
    if (kt + 1 < nk) { char* nxt = sdst + ((kt + 1) & 1) * 32768; STAGE(nxt, kk * 64) }
#pragma unroll
    for (int ks = 0; ks < 2; ++ks) {
      bf16x8 af[4], bfr[NJ];
      const int ch = ((ks * 4 + g4) ^ sw) << 4;
#pragma unroll
      for (int i = 0; i < 4; ++i) af[i] = *(const bf16x8*)(cur + arow + i * 2048 + ch);
#pragma unroll
      for (int i = 0; i < NJ; ++i) bfr[i] = *(const bf16x8*)(cur + 16384 + brow + i * 2048 + ch);
#pragma unroll
      for (int i = 0; i < 4; ++i)
#pragma unroll
        for (int j = 0; j < NJ; ++j)
          acc[i][j] = __builtin_amdgcn_mfma_f32_16x16x32_bf16(af[i], bfr[j], acc[i][j], 0, 0, 0);
    }
    SB();
    __syncthreads();
  }
#undef STAGE
#undef DMA16
}
DI void gemm_tile(const u16* A, int lda, const u16* B, int ldb, int K,
                  f32x4 (&acc)[4][4], char* smem) {
  gemm_tile_t<4>(A, lda, B, ldb, K, acc, smem);
}
DI void zero_acc(f32x4 (&acc)[4][4]) {
#pragma unroll
  for (int i = 0; i < 4; ++i)
#pragma unroll
    for (int j = 0; j < 4; ++j) acc[i][j] = f32x4{0.f, 0.f, 0.f, 0.f};
}

struct TokTile { int g0; int is_ctx; int b; int p0; };
DI TokTile tok_tile(int mt) {
  TokTile r; r.g0 = mt * 128;
  if (r.g0 < T_CTX) { r.is_ctx = 1; r.b = r.g0 >> 8; r.p0 = r.g0 & 255; }
  else { r.is_ctx = 0; r.b = (r.g0 - T_CTX) >> 12; r.p0 = (r.g0 - T_CTX) & 4095; }
  return r;
}

DI void phase_mod(const Params& p, char* smem) {
  float* s_silu = (float*)smem;
  float* s_part = (float*)(smem + 36864);
  float* MOD = wsp<float>(p, O_MOD);
  const int t = tid();
  for (int i = t; i < 9 * 1024; i += 256) {
    float v = (i < 8192) ? p.c[i] : p.c_ctx[i - 8192];
    s_silu[i] = v * sigmoidf_(v);
  }
  __syncthreads();
  const int kg = t >> 6, cl = t & 63;
  for (int u = blockIdx.x; u < 4 * 48; u += gridDim.x) {
    const int l = u / 48, cb = u % 48;
    const int n = cb * 64 + cl;
    float acc[9];
#pragma unroll
    for (int ci = 0; ci < 9; ++ci) acc[ci] = 0.f;
    const float* wp = p.w_mod + ((size_t)l * 1024 + kg * 256) * 3072 + n;
    for (int k = 0; k < 256; ++k) {
      float wv = wp[(size_t)k * 3072];
#pragma unroll
      for (int ci = 0; ci < 9; ++ci) acc[ci] += s_silu[ci * 1024 + kg * 256 + k] * wv;
    }
#pragma unroll
    for (int ci = 0; ci < 9; ++ci) s_part[(kg * 9 + ci) * 64 + cl] = acc[ci];
    __syncthreads();
    for (int idx = t; idx < 9 * 64; idx += 256) {
      int ci = idx >> 6, c2 = idx & 63;
      float s = s_part[(0 * 9 + ci) * 64 + c2] + s_part[(1 * 9 + ci) * 64 + c2] + s_part[(2 * 9 + ci) * 64 + c2] +
                s_part[(3 * 9 + ci) * 64 + c2];
      MOD[((size_t)l * 9 + ci) * 3072 + cb * 64 + c2] = s + p.b_mod[l * 3072 + cb * 64 + c2];
    }
    __syncthreads();
  }
}

template <class F> DI void conv_job(u16* dst, int N, int K, F src) {
  const int total = N * (K >> 3);
  for (int idx = blockIdx.x * 256 + tid(); idx < total; idx += gridDim.x * 256) {
    const int n = idx % N, kb = idx / N;
    float v[8];
#pragma unroll
    for (int j = 0; j < 8; ++j) v[j] = src(kb * 8 + j, n);
    uint4 o;
    o.x = pack2(v[0], v[1]); o.y = pack2(v[2], v[3]); o.z = pack2(v[4], v[5]); o.w = pack2(v[6], v[7]);
    *(uint4*)(dst + (size_t)n * K + kb * 8) = o;
  }
}

DI void convert_weights(const Params& p, int l) {
  {
    const float* win = p.w_in + (size_t)l * 1024 * 7584;
    conv_job(wsw(p, l, O_WINA), 2560, 1024, [&](int k, int n) -> float {
      int col;
      if (n < 1024) col = n;
      else if (n < 1408) col = 2048 + (n - 1024);
      else if (n < 1664) col = 2432 + (n - 1408);
      else if (n < 1792) { int pp = n - 1664; col = pp < 32 ? 2688 + perm32(pp) : -1; }
      else if (n < 2304) col = 3232 + (n - 1792);
      else if (n < 2432) col = 3744 + (n - 2304);
      else col = 3872 + (n - 2432);
      return col < 0 ? 0.f : win[(size_t)k * 7584 + col];
    });
    conv_job(wsw(p, l, O_WINB), 5120, 1024, [&](int k, int n) -> float {
      int col;
      if (n < 1024) col = 1024 + n;
      else if (n < 1536) col = 2720 + (n - 1024);
      else if (n < 2048) col = 4000 + (n - 1536);
      else col = 4512 + (n - 2048);
      return win[(size_t)k * 7584 + col];
    });
    const float* wa = p.lru_wa + (size_t)l * 2 * 8 * 128 * 128;
    const float* wi = p.lru_wi + (size_t)l * 2 * 8 * 128 * 128;
    conv_job(wsw(p, l, O_WLRU), 4096, 128, [&](int k, int n) -> float {
      int db = n >> 8, nn = n & 255;
      return nn < 128 ? wa[((size_t)db * 128 + k) * 128 + nn] : wi[((size_t)db * 128 + k) * 128 + (nn - 128)];
    });
    const float* wuq = p.w_uq + (size_t)l * 384 * 768;
    const float* gq = p.q_norm + l * 384;
    conv_job(wsw(p, l, O_WUQ), 768, 384, [&](int k, int n) -> float {
      int col;
      if (n < 512) col = (n >> 6) * 96 + (n & 63);
      else { int hh = (n - 512) >> 5, pp = (n - 512) & 31; col = hh * 96 + 64 + perm32(pp); }
      return gq[k] * wuq[(size_t)k * 768 + col];
    });
    const float* wukv = p.w_ukv + (size_t)l * 256 * 1024;
    const float* gkv = p.kv_norm + l * 256;
    conv_job(wsw(p, l, O_WUKVG), 1024, 256, [&](int k, int n) -> float { return gkv[k] * wukv[(size_t)k * 1024 + n]; });
    conv_job(wsw(p, l, O_WUKVR), 1024, 256, [&](int k, int n) -> float { return wukv[(size_t)k * 1024 + n]; });
    const float* w1 = p.w_br_rnn + (size_t)l * 1024 * 1024;
    conv_job(wsw(p, l, O_WBRR), 1024, 1024, [&](int k, int n) -> float { return w1[(size_t)k * 1024 + n]; });
    const float* w2 = p.w_br_mla + (size_t)l * 512 * 1024;
    conv_job(wsw(p, l, O_WBRM), 1024, 512, [&](int k, int n) -> float { return w2[(size_t)k * 1024 + n]; });
    const float* w3 = p.w_br_swa + (size_t)l * 512 * 1024;
    conv_job(wsw(p, l, O_WBRS), 1024, 512, [&](int k, int n) -> float { return w3[(size_t)k * 1024 + n]; });
    const float* w4 = p.w_out + (size_t)l * 1024 * 1024;
    conv_job(wsw(p, l, O_WOUT), 1024, 1024, [&](int k, int n) -> float { return w4[(size_t)k * 1024 + n]; });
  }
}

DI void phase_prep(const Params& p, int l) {
  const int t = tid(), lane = t & 63, w = t >> 6;
  const float* MOD = wsp<float>(p, O_MOD) + (size_t)l * 9 * 3072;
  u16* H = wsp<u16>(p, O_H);
  for (int row = blockIdx.x * 4 + w; row < T_ALL; row += gridDim.x * 4) {
    const float* x = xin_row(p, l, row);
    const int ci = row < T_CTX ? 8 : ((row - T_CTX) >> 12);
    const float* md = MOD + ci * 3072;
    float4 v[4];
    float ss = 0.f;
#pragma unroll
    for (int i = 0; i < 4; ++i) {
      v[i] = *(const float4*)(x + i * 256 + lane * 4);
      ss += v[i].x * v[i].x + v[i].y * v[i].y + v[i].z * v[i].z + v[i].w * v[i].w;
    }
    ss = wave_sum(ss);
    const float rs = rsqrtf(ss * (1.f / 1024.f) + EPS);
#pragma unroll
    for (int i = 0; i < 4; ++i) {
      const int c = i * 256 + lane * 4;
      const float4 g = *(const float4*)(p.g_norm + l * 1024 + c);
      const float4 sh = *(const float4*)(md + c);
      const float4 sc = *(const float4*)(md + 1024 + c);
      float h0 = v[i].x * rs * g.x * (1.f + sc.x) + sh.x;
      float h1 = v[i].y * rs * g.y * (1.f + sc.y) + sh.y;
      float h2 = v[i].z * rs * g.z * (1.f + sc.z) + sh.z;
      float h3 = v[i].w * rs * g.w * (1.f + sc.w) + sh.w;
      uint2 o; o.x = pack2(h0, h1); o.y = pack2(h2, h3);
      *(uint2*)(H + (size_t)row * 1024 + c) = o;
    }
  }
  {
    const int gt = blockIdx.x * 256 + t, gs = gridDim.x * 256;
    u16* ckvc = wsp<u16>(p, O_CKVC);
    for (int i = gt; i < 2048 * 256; i += gs) {
      int r = i >> 8, k = i & 255, b = r >> 8, pos = r & 255;
      ckvc[i] = f2bf(p.cache_ckv[(((size_t)b * 4 + l) * 256 + pos) * 256 + k]);
    }
    u16* krl = wsp<u16>(p, O_KRL);
    for (int i = gt; i < 8 * 256 * 32; i += gs) {
      int pp = i & 31, pos = (i >> 5) & 255, b = i >> 13;
      krl[((size_t)b * LK_LAT + pos) * 32 + pp] = f2bf(p.cache_krope[(((size_t)b * 4 + l) * 256 + pos) * 32 + perm32(pp)]);
    }
    u16* ksc = wsp<u16>(p, O_KSC);
    for (int i = gt; i < 8 * 256 * 128; i += gs) {
      int c = i & 127, pos = (i >> 7) & 255, b = i >> 15;
      ksc[i] = f2bf(p.cache_k[(((size_t)b * 4 + l) * 256 + pos) * 128 + c]);
    }
    u16* vtc = wsp<u16>(p, O_VTSCC);
    for (int i = gt; i < 8 * 2 * 64 * 256; i += gs) {
      int pos = i & 255, dv = (i >> 8) & 63, kvh = (i >> 14) & 1, b = i >> 15;
      vtc[i] = f2bf(p.cache_v[(((size_t)b * 4 + l) * 256 + pos) * 128 + kvh * 64 + dv]);
    }
  }
}

DI void phase_gemmA(const Params& p, int l, char* smem) {
  const u16* H = wsp<u16>(p, O_H);
  const u16* W = wsw(p, l, O_WINA);
  for (int base = 0; base < 288 * 20; base += gridDim.x) {
    const int tile = xcd_map(base);
    if (tile >= 288 * 20) continue;
    const int sb = tile >> 5, jj = tile & 31;
    const int mt = (sb / 5) * 8 + (jj >> 2), nt = (sb % 5) * 4 + (jj & 3);
    const TokTile tt = tok_tile(mt);
    f32x4 acc[4][4];
    zero_acc(acc);
    gemm_tile(H + (size_t)tt.g0 * 1024, 1024, W + (size_t)nt * 128 * 1024, 1024, 1024, acc, smem);
    LANEVARS
    if (nt < 13) {
      u16* dst; int ld, cb;
      if (nt < 8) { dst = wsp<u16>(p, O_XR); ld = 1024; cb = nt * 128; }
      else if (nt < 11) { dst = wsp<u16>(p, O_CQ); ld = 384; cb = (nt - 8) * 128; }
      else { dst = wsp<u16>(p, O_CKV); ld = 256; cb = (nt - 11) * 128; }
#pragma unroll
      for (int i = 0; i < 4; ++i)
#pragma unroll
        for (int j = 0; j < 4; ++j)
#pragma unroll
          for (int e = 0; e < 4; ++e) {
            const int g = tt.g0 + wr * 64 + i * 16 + g4 * 4 + e;
            dst[(size_t)g * ld + cb + wc * 64 + j * 16 + c16] = f2bf(acc[i][j][e]);
            if (e == 3 && j == 3) SB();
          }
    } else if (nt == 13) {
      if (wc == 0) {
#pragma unroll
        for (int i = 0; i < 4; ++i)
#pragma unroll
          for (int e = 0; e < 4; ++e) {
            SB();
            const int r = wr * 64 + i * 16 + g4 * 4 + e;
            const int pos = tt.p0 + r;
            float x1 = acc[i][0][e], x2 = acc[i][1][e];
            if (tt.is_ctx) {
              u16* kr = wsp<u16>(p, O_KRC) + ((size_t)tt.b * 256 + pos) * 32;
              kr[c16] = f2bf(x1); kr[c16 + 16] = f2bf(x2);
              float* o = p.out + OUT_KROPE + (((size_t)tt.b * 4 + l) * 256 + pos) * 32;
              o[perm32(c16)] = x1; o[perm32(c16 + 16)] = x2;
            } else {
              const int pv = (c16 >= 8) ? (pos & 63) : (pos >> 6);
              const float cs = TAB_M[(pv * 8 + (c16 & 7)) * 2], sn = TAB_M[(pv * 8 + (c16 & 7)) * 2 + 1];
              u16* kr = wsp<u16>(p, O_KRL) + ((size_t)tt.b * LK_LAT + 256 + pos) * 32;
              kr[c16] = f2bf(x1 * cs - x2 * sn); kr[c16 + 16] = f2bf(x2 * cs + x1 * sn);
            }
          }
      }
    } else if (nt < 19) {
      const bool isk = (nt == 18);
      u16* dst = isk ? wsp<u16>(p, O_KS) : wsp<u16>(p, O_QS);
      const int ld = isk ? 128 : 512;
      const int cb = isk ? wc * 64 : ((nt - 14) * 2 + wc) * 64;
#pragma unroll
      for (int i = 0; i < 4; ++i)
#pragma unroll
        for (int e = 0; e < 4; ++e) {
          SB();
          const int r = wr * 64 + i * 16 + g4 * 4 + e;
          const int pos = tt.p0 + r, g = tt.g0 + r;
          float v0 = acc[i][0][e], v1 = acc[i][1][e], v2 = acc[i][2][e], v3 = acc[i][3][e];
          if (!tt.is_ctx) {
            const int pr = pos >> 6, pc = pos & 63;
            const float c0 = TAB_S[(pr * 16 + c16) * 2], s0 = TAB_S[(pr * 16 + c16) * 2 + 1];
            const float c1 = TAB_S[(pc * 16 + c16) * 2], s1 = TAB_S[(pc * 16 + c16) * 2 + 1];
            float a0 = v0 * c0 - v1 * s0, a1 = v1 * c0 + v0 * s0;
            float a2 = v2 * c1 - v3 * s1, a3 = v3 * c1 + v2 * s1;
            v0 = a0; v1 = a1; v2 = a2; v3 = a3;
          } else if (isk) {
            float* o = p.out + OUT_SK + (((size_t)tt.b * 4 + l) * 256 + pos) * 128 + cb + c16;
            o[0] = v0; o[16] = v1; o[32] = v2; o[48] = v3;
          }
          u16* d = dst + (size_t)g * ld + cb + c16;
          d[0] = f2bf(v0); d[16] = f2bf(v1); d[32] = f2bf(v2); d[48] = f2bf(v3);
        }
    } else {
      u16* vt = tt.is_ctx ? wsp<u16>(p, O_VTSC) : wsp<u16>(p, O_VTSL);
      const int L = tt.is_ctx ? 256 : 4096;
#pragma unroll
      for (int i = 0; i < 4; ++i)
#pragma unroll
        for (int j = 0; j < 4; ++j) {
          SB();
          const int r = wr * 64 + i * 16 + g4 * 4;
          const int pos = tt.p0 + r, dv = j * 16 + c16;
          uint2 o; o.x = pack2(acc[i][j][0], acc[i][j][1]); o.y = pack2(acc[i][j][2], acc[i][j][3]);
          *(uint2*)(vt + (((size_t)tt.b * 2 + wc) * 64 + dv) * L + pos) = o;
          if (tt.is_ctx) {
#pragma unroll
            for (int e = 0; e < 4; ++e)
              p.out[OUT_SV + (((size_t)tt.b * 4 + l) * 256 + pos + e) * 128 + wc * 64 + dv] = acc[i][j][e];
          }
        }
    }
  }
}

DI void row_scales(const u16* A, int K, float* s_rs) {
  const int t = tid(), row = t >> 1, half = t & 1;
  const u16* ap = A + (size_t)row * K + half * (K >> 1);
  float ss = 0.f;
  for (int c = 0; c < (K >> 4); ++c) {
    uint4 v = *(const uint4*)(ap + c * 8);
    unsigned wv[4] = {v.x, v.y, v.z, v.w};
#pragma unroll
    for (int q = 0; q < 4; ++q) {
      float a = __uint_as_float(wv[q] << 16), b = __uint_as_float(wv[q] & 0xffff0000u);
      ss += a * a + b * b;
    }
  }
  ss += __shfl_xor(ss, 1);
  if (half == 0) s_rs[row] = rsqrtf(ss / (float)K + EPS);
}

template <int MODE> DI void scan_seg(const Params& p, int l, int seq, int blk, int d, int seg, char* smem);
DI void phase_qkv(const Params& p, int l, char* smem) {
  float* s_rs = (float*)(smem + 65536);
  constexpr int NQ = 288 * 6, NKV = 304 * 8, NS1 = 2048;
  for (int base = 0; base < NS1 + NQ + NKV; base += gridDim.x) {
    const int tile0 = xcd_map(base);
    if (tile0 >= NS1 + NQ + NKV) continue;
    if (tile0 < NS1) {
      scan_seg<0>(p, l, 16 + (tile0 >> 8), (tile0 >> 5) & 7, (tile0 >> 4) & 1, tile0 & 15, smem);
#if PROBE == 4
      scan_seg<0>(p, l, 16 + (tile0 >> 8), (tile0 >> 5) & 7, (tile0 >> 4) & 1, tile0 & 15, smem);
#endif
      continue;
    }
    const int tile = tile0 - NS1;
    f32x4 acc[4][4];
    zero_acc(acc);
    if (tile < NQ) {
      const int mt = tile / 6, nt = tile % 6;
      const TokTile tt = tok_tile(mt);
      const u16* A = wsp<u16>(p, O_CQ) + (size_t)tt.g0 * 384;
      row_scales(A, 384, s_rs);
      gemm_tile(A, 384, wsw(p, l, O_WUQ) + (size_t)nt * 128 * 384, 384, 384, acc, smem);
      LANEVARS
      u16* Q = wsp<u16>(p, O_Q);
#pragma unroll
      for (int i = 0; i < 4; ++i)
#pragma unroll
        for (int e = 0; e < 4; ++e) {
          SB();
          const int r = wr * 64 + i * 16 + g4 * 4 + e;
          const int pos = tt.p0 + r, g = tt.g0 + r;
          const float rs = s_rs[r];
          float v0 = acc[i][0][e] * rs, v1 = acc[i][1][e] * rs, v2 = acc[i][2][e] * rs, v3 = acc[i][3][e] * rs;
          if (nt >= 4 && !tt.is_ctx) {
            const int pv = (c16 >= 8) ? (pos & 63) : (pos >> 6);
            const float cs = TAB_M[(pv * 8 + (c16 & 7)) * 2], sn = TAB_M[(pv * 8 + (c16 & 7)) * 2 + 1];
            float a0 = v0 * cs - v1 * sn, a1 = v1 * cs + v0 * sn;
            float a2 = v2 * cs - v3 * sn, a3 = v3 * cs + v2 * sn;
            v0 = a0; v1 = a1; v2 = a2; v3 = a3;
          }
          u16* d = Q + (size_t)g * 768 + nt * 128 + wc * 64 + c16;
          d[0] = f2bf(v0); d[16] = f2bf(v1); d[32] = f2bf(v2); d[48] = f2bf(v3);
        }
    } else {
      const int t2 = tile - NQ;
      const int mt = t2 >> 3, hd = t2 & 7;
      const u16* A; const u16* Wt; int is_ctx, seq, kp0;
      if (mt < 288) {
        const TokTile tt = tok_tile(mt);
        A = wsp<u16>(p, O_CKV) + (size_t)tt.g0 * 256;
        Wt = wsw(p, l, O_WUKVG);
        row_scales(A, 256, s_rs);
        is_ctx = tt.is_ctx; seq = tt.b; kp0 = tt.is_ctx ? tt.p0 : 256 + tt.p0;
        if (tt.is_ctx && hd == 0) {
          __syncthreads();
          const float* gkv = p.kv_norm + l * 256;
          for (int idx = tid(); idx < 128 * 256; idx += 256) {
            const int r = idx >> 8, k = idx & 255;
            p.out[OUT_CKV + (((size_t)tt.b * 4 + l) * 256 + tt.p0 + r) * 256 + k] = bf2f(A[(size_t)r * 256 + k]) * s_rs[r] * gkv[k];
          }
        }
      } else {
        const int row0 = (mt - 288) * 128;
        A = wsp<u16>(p, O_CKVC) + (size_t)row0 * 256;
        Wt = wsw(p, l, O_WUKVR);
        { const int t1 = tid(); if (t1 < 128) s_rs[t1] = 1.f; }
        is_ctx = 0; seq = row0 >> 8; kp0 = row0 & 255;
      }
      gemm_tile(A, 256, Wt + (size_t)hd * 128 * 256, 256, 256, acc, smem);
      LANEVARS
      const int Lk = is_ctx ? 256 : LK_LAT;
      if (wc == 0) {
        u16* Kn = (is_ctx ? wsp<u16>(p, O_KNC) : wsp<u16>(p, O_KNL)) + ((size_t)seq * 8 + hd) * Lk * 64;
#pragma unroll
        for (int i = 0; i < 4; ++i)
#pragma unroll
          for (int j = 0; j < 4; ++j)
#pragma unroll
            for (int e = 0; e < 4; ++e) {
              const int r = wr * 64 + i * 16 + g4 * 4 + e;
              Kn[(size_t)(kp0 + r) * 64 + j * 16 + c16] = f2bf(acc[i][j][e] * s_rs[r]);
              if (e == 3) SB();
            }
      } else {
        u16* Vt = (is_ctx ? wsp<u16>(p, O_VTC) : wsp<u16>(p, O_VTL)) + ((size_t)seq * 8 + hd) * 64 * Lk;
#pragma unroll
        for (int i = 0; i < 4; ++i)
#pragma unroll
          for (int j = 0; j < 4; ++j) {
            SB();
            const int r = wr * 64 + i * 16 + g4 * 4;
            uint2 o;
            o.x = pack2(acc[i][j][0] * s_rs[r], acc[i][j][1] * s_rs[r + 1]);
            o.y = pack2(acc[i][j][2] * s_rs[r + 2], acc[i][j][3] * s_rs[r + 3]);
            *(uint2*)(Vt + (size_t)(j * 16 + c16) * Lk + kp0 + r) = o;
          }
      }
    }
    __syncthreads();
  }
}

template <int NS> DI void attn_gload(const u16* k0, int k0s, const u16* k1, const u16* vt, int vts,
                                     uint4& rk0, uint4& rk1, uint4& rk2, uint4& rv0, uint4& rv1) {
  const int t = tid();
  if (NS == 6) {
    { const int c = t, key = c / 12, ch = c % 12;
      rk0 = (ch < 8) ? *(const uint4*)(k0 + (size_t)key * k0s + ch * 8) : *(const uint4*)(k1 + (size_t)key * 32 + (ch - 8) * 8); }
    { const int c = t + 256, key = c / 12, ch = c % 12;
      rk1 = (ch < 8) ? *(const uint4*)(k0 + (size_t)key * k0s + ch * 8) : *(const uint4*)(k1 + (size_t)key * 32 + (ch - 8) * 8); }
    { const int c = t + 512, key = c / 12, ch = c % 12;
      rk2 = (ch < 8) ? *(const uint4*)(k0 + (size_t)key * k0s + ch * 8) : *(const uint4*)(k1 + (size_t)key * 32 + (ch - 8) * 8); }
  } else {
    { const int c = t, key = c >> 3, ch = c & 7; rk0 = *(const uint4*)(k0 + (size_t)key * k0s + ch * 8); }
    { const int c = t + 256, key = c >> 3, ch = c & 7; rk1 = *(const uint4*)(k0 + (size_t)key * k0s + ch * 8); }
  }
  { const int c = t, dv = c >> 3, ch = c & 7; rv0 = *(const uint4*)(vt + (size_t)dv * vts + ch * 8); }
  { const int c = t + 256, dv = c >> 3, ch = c & 7; rv1 = *(const uint4*)(vt + (size_t)dv * vts + ch * 8); }
}
template <int NS> DI void attn_sstore(char* smem, const uint4& rk0, const uint4& rk1, const uint4& rk2, const uint4& rv0, const uint4& rv1) {
  constexpr int KSTR = (NS == 6) ? 208 : 144;
  const int t = tid();
  if (NS == 6) {
    { const int c = t, key = c / 12, ch = c % 12; *(uint4*)(smem + key * KSTR + ch * 16) = rk0; }
    { const int c = t + 256, key = c / 12, ch = c % 12; *(uint4*)(smem + key * KSTR + ch * 16) = rk1; }
    { const int c = t + 512, key = c / 12, ch = c % 12; *(uint4*)(smem + key * KSTR + ch * 16) = rk2; }
  } else {
    { const int c = t, key = c >> 3, ch = c & 7; *(uint4*)(smem + key * KSTR + ch * 16) = rk0; }
    { const int c = t + 256, key = c >> 3, ch = c & 7; *(uint4*)(smem + key * KSTR + ch * 16) = rk1; }
  }
  { const int c = t, dv = c >> 3, ch = c & 7; char* d = smem + 13312 + dv * 136 + ch * 16;
    *(uint2*)d = uint2{rv0.x, rv0.y}; *(uint2*)(d + 8) = uint2{rv0.z, rv0.w}; }
  { const int c = t + 256, dv = c >> 3, ch = c & 7; char* d = smem + 13312 + dv * 136 + ch * 16;
    *(uint2*)d = uint2{rv1.x, rv1.y}; *(uint2*)(d + 8) = uint2{rv1.z, rv1.w}; }
}

#define PACK8(S, s2) __builtin_bit_cast(bf16x8, uint4{pack2(S[8 * (s2)], S[8 * (s2) + 1]), pack2(S[8 * (s2) + 2], S[8 * (s2) + 3]), \
                                                        pack2(S[8 * (s2) + 4], S[8 * (s2) + 5]), pack2(S[8 * (s2) + 6], S[8 * (s2) + 7])})

template <int NS>
DI void attn_item(const u16* kA, int kAs, const u16* krA, const u16* vtA, int vtAs, int nA, int kposA, int maskA,
                  const u16* kB, int kBs, const u16* vtB, int vtBs, int nB,
                  const u16* qa, const u16* qb, float sc2, float m0, float l0, int qpos, u16* yrow, char* smem) {
  constexpr int KSTR = (NS == 6) ? 208 : 144;
  const int lane = tid() & 63;
  const int r32 = lane & 31, hh = lane >> 5;
  bf16x8 qf0, qf1, qf2, qf3, qf4, qf5;
  qf0 = *(const bf16x8*)(qa + 0 + 8 * hh); qf1 = *(const bf16x8*)(qa + 16 + 8 * hh);
  qf2 = *(const bf16x8*)(qa + 32 + 8 * hh); qf3 = *(const bf16x8*)(qa + 48 + 8 * hh);
  if (NS == 6) { qf4 = *(const bf16x8*)(qb + 0 + 8 * hh); qf5 = *(const bf16x8*)(qb + 16 + 8 * hh); }
  else { qf4 = qf0; qf5 = qf0; }
#define QSCALE(qf) { uint4 u_ = __builtin_bit_cast(uint4, qf); \
    u_.x = pack2(__uint_as_float(u_.x << 16) * sc2, __uint_as_float(u_.x & 0xffff0000u) * sc2); \
    u_.y = pack2(__uint_as_float(u_.y << 16) * sc2, __uint_as_float(u_.y & 0xffff0000u) * sc2); \
    u_.z = pack2(__uint_as_float(u_.z << 16) * sc2, __uint_as_float(u_.z & 0xffff0000u) * sc2); \
    u_.w = pack2(__uint_as_float(u_.w << 16) * sc2, __uint_as_float(u_.w & 0xffff0000u) * sc2); \
    qf = __builtin_bit_cast(bf16x8, u_); }
  QSCALE(qf0) QSCALE(qf1) QSCALE(qf2) QSCALE(qf3)
  if (NS == 6) { QSCALE(qf4) QSCALE(qf5) }
#undef QSCALE
  f32x16 O0, O1;
#pragma unroll
  for (int e = 0; e < 16; ++e) { O0[e] = 0.f; O1[e] = 0.f; }
  float m_run = m0, l_run = l0;
  uint4 rk0, rk1, rk2, rv0, rv1;
  rk2 = uint4{0, 0, 0, 0};
  const int ntiles = nA + nB;
#define TILE_GLOAD(jn) { if ((jn) < nA) attn_gload<NS>(kA + (size_t)(jn) * 64 * kAs, kAs, krA + (size_t)(jn) * 64 * 32, vtA + (jn) * 64, vtAs, rk0, rk1, rk2, rv0, rv1); \
    else { const int jb_ = (jn) - nA; attn_gload<NS>(kB + (size_t)jb_ * 64 * kBs, kBs, nullptr, vtB + jb_ * 64, vtBs, rk0, rk1, rk2, rv0, rv1); } }
  constexpr int STG = 22528;
  TILE_GLOAD(0)
  attn_sstore<NS>(smem, rk0, rk1, rk2, rv0, rv1);
  if (ntiles > 1) TILE_GLOAD(1)
  __syncthreads();
  for (int j = 0; j < ntiles; ++j) {
    char* sbase = smem + (j & 1) * STG;
    const int kpos = kposA + 64 * j;
    const bool masked = maskA && (j < nA);
    MB();
    f32x16 S0, S1;
#pragma unroll
    for (int e = 0; e < 16; ++e) { S0[e] = 0.f; S1[e] = 0.f; }
    const char* ka0 = sbase + r32 * KSTR + 16 * hh;
    const char* ka1 = sbase + (32 + r32) * KSTR + 16 * hh;
#define QK_STEP(s, qf) { bf16x8 a0 = *(const bf16x8*)(ka0 + 32 * (s)); bf16x8 a1 = *(const bf16x8*)(ka1 + 32 * (s)); \
      S0 = __builtin_amdgcn_mfma_f32_32x32x16_bf16(a0, qf, S0, 0, 0, 0); S1 = __builtin_amdgcn_mfma_f32_32x32x16_bf16(a1, qf, S1, 0, 0, 0); }
    QK_STEP(0, qf0) QK_STEP(1, qf1) QK_STEP(2, qf2) QK_STEP(3, qf3)
    if (NS == 6) { QK_STEP(4, qf4) QK_STEP(5, qf5) }
    SB();
    float mx = m_run;
#pragma unroll
    for (int e = 0; e < 16; ++e) {
      float v0 = S0[e], v1 = S1[e];
      if (masked) {
        const int kp = kpos + (e & 3) + 8 * (e >> 2) + 4 * hh;
        int d0 = qpos - kp; d0 = d0 < 0 ? -d0 : d0;
        int d1 = qpos - (kp + 32); d1 = d1 < 0 ? -d1 : d1;
        if (d0 > 128) v0 = -1e30f;
        if (d1 > 128) v1 = -1e30f;
      }
      S0[e] = v0; S1[e] = v1;
      mx = fmaxf(mx, fmaxf(v0, v1));
    }
    mx = fmaxf(mx, __shfl_xor(mx, 32));
    const float alpha = __builtin_amdgcn_exp2f(m_run - mx);
    m_run = mx;
    float rsum = 0.f;
#pragma unroll
    for (int e = 0; e < 16; ++e) {
      float p0 = __builtin_amdgcn_exp2f(S0[e] - mx), p1 = __builtin_amdgcn_exp2f(S1[e] - mx);
      S0[e] = p0; S1[e] = p1;
      rsum += p0 + p1;
    }
    rsum += __shfl_xor(rsum, 32);
    l_run = l_run * alpha + rsum;
#pragma unroll
    for (int e = 0; e < 16; ++e) { O0[e] *= alpha; O1[e] *= alpha; }
    const char* sv0 = sbase + 13312 + r32 * 136 + 8 * hh;
    const char* sv1 = sv0 + 32 * 136;
#define PV_STEP(pb, ka) { \
      { uint2 lo = *(const uint2*)(sv0 + (ka) * 2), hi = *(const uint2*)(sv0 + (ka) * 2 + 16); \
        bf16x8 va = __builtin_bit_cast(bf16x8, uint4{lo.x, lo.y, hi.x, hi.y}); O0 = __builtin_amdgcn_mfma_f32_32x32x16_bf16(va, pb, O0, 0, 0, 0); } \
      { uint2 lo = *(const uint2*)(sv1 + (ka) * 2), hi = *(const uint2*)(sv1 + (ka) * 2 + 16); \
        bf16x8 va = __builtin_bit_cast(bf16x8, uint4{lo.x, lo.y, hi.x, hi.y}); O1 = __builtin_amdgcn_mfma_f32_32x32x16_bf16(va, pb, O1, 0, 0, 0); } }
    SB();
    { bf16x8 pb = PACK8(S0, 0); PV_STEP(pb, 0) }
    { bf16x8 pb = PACK8(S0, 1); PV_STEP(pb, 16) }
    SB();
    { bf16x8 pb = PACK8(S1, 0); PV_STEP(pb, 32) }
    { bf16x8 pb = PACK8(S1, 1); PV_STEP(pb, 48) }
    SB();
    if (j + 1 < ntiles) {
      attn_sstore<NS>(smem + ((j + 1) & 1) * STG, rk0, rk1, rk2, rv0, rv1);
      if (j + 2 < ntiles) TILE_GLOAD(j + 2)
    }
    __syncthreads();
  }
#undef TILE_GLOAD
  const float inv = 1.f / l_run;
#pragma unroll
  for (int e4 = 0; e4 < 4; ++e4) {
    uint2 o;
    o.x = pack2(O0[4 * e4] * inv, O0[4 * e4 + 1] * inv); o.y = pack2(O0[4 * e4 + 2] * inv, O0[4 * e4 + 3] * inv);
    *(uint2*)(yrow + 8 * e4 + 4 * hh) = o;
    o.x = pack2(O1[4 * e4] * inv, O1[4 * e4 + 1] * inv); o.y = pack2(O1[4 * e4 + 2] * inv, O1[4 * e4 + 3] * inv);
    *(uint2*)(yrow + 32 + 8 * e4 + 4 * hh) = o;
  }
}

template <int MODE>
DI void scan_seg(const Params& p, int l, int seq, int blk, int d, int seg, char* smem) {
  const int t = tid(), lane = t & 63, w = t >> 6;
  const int c16 = lane & 15, g4 = lane >> 4;
  const bool is_ctx = seq < 16;
  const int b = is_ctx ? seq : seq - 16;
  const int L = is_ctx ? 256 : 4096;
  const int gbase = is_ctx ? b * 256 : T_CTX + b * 4096;
  const u16* XR = wsp<u16>(p, O_XR);
  u16* Y = wsp<u16>(p, O_YRNN);
  float* SUM = wsp<float>(p, O_SUM);
  char* sXc = smem;
  float* sA = (float*)(smem + 8704);
  float* sU = (float*)(smem + 8704 + 16384);
  const int cch = t & 127, th = t >> 7;
  const int chg = blk * 128 + cch;
  const float w0 = p.conv_w[(l * 4 + 0) * 1024 + chg], w1 = p.conv_w[(l * 4 + 1) * 1024 + chg];
  const float w2 = p.conv_w[(l * 4 + 2) * 1024 + chg], w3 = p.conv_w[(l * 4 + 3) * 1024 + chg];
  const float cb = p.conv_b[l * 1024 + chg];
  bf16x8 bw[4][4];
  {
    const u16* WL = wsw(p, l, O_WLRU) + (size_t)(d * 8 + blk) * 256 * 128 + (size_t)(32 * w + c16) * 128 + g4 * 8;
#pragma unroll
    for (int nf = 0; nf < 4; ++nf)
#pragma unroll
      for (int ks = 0; ks < 4; ++ks)
        bw[nf][ks] = *(const bf16x8*)(WL + (size_t)((nf & 1) * 16 + (nf >> 1) * 128) * 128 + ks * 32);
  }
  float ba[2], bi[2], cl[2];
#pragma unroll
  for (int jn = 0; jn < 2; ++jn) {
    const int ch = (l * 2 + d) * 1024 + blk * 128 + 32 * w + 16 * jn + c16;
    ba[jn] = p.lru_ba[ch]; bi[jn] = p.lru_bi[ch];
    cl[jn] = -8.f * log1pf(__expf(-p.lru_lam[ch]));
  }
  float h = 0.f, P = 1.f;
  if (MODE == 1 && !is_ctx && t < 128) {
    h = p.state[(((size_t)b * 4 + l) * 2 + d) * 1024 + blk * 128 + t];
    const float* sm = SUM + ((size_t)((b * 8 + blk) * 2 + d) * 16) * 256 + t;
    if (d == 0) { for (int s2 = 0; s2 < seg; ++s2) h = sm[s2 * 256] * h + sm[s2 * 256 + 128]; }
    else { for (int s2 = 15; s2 > seg; --s2) h = sm[s2 * 256] * h + sm[s2 * 256 + 128]; }
  }
#define X19(F) F(0) F(1) F(2) F(3) F(4) F(5) F(6) F(7) F(8) F(9) F(10) F(11) F(12) F(13) F(14) F(15) F(16) F(17) F(18)
#define XDECL(q) u16 xr##q = 0;
#define XLOAD(q) { const int pos = tcn + th * 16 - 1 + (q); xr##q = (pos >= 0 && pos < L) ? XR[(size_t)(gbase + pos) * 1024 + chg] : (u16)0; }
#define XCVT(q) xv[q] = bf2f(xr##q);
  X19(XDECL)
  { const int tcn = seg * 256 + (d == 0 ? 0 : 7) * 32; X19(XLOAD) }
  for (int ci = 0; ci < 8; ++ci) {
    const int tc0 = seg * 256 + (d == 0 ? ci : 7 - ci) * 32;
    {
      float xv[19];
      X19(XCVT)
#pragma unroll
      for (int q = 0; q < 16; ++q) {
        float xc = cb + w0 * xv[q] + w1 * xv[q + 1] + w2 * xv[q + 2] + w3 * xv[q + 3];
        *(u16*)(sXc + (th * 16 + q) * 272 + cch * 2) = f2bf(xc);
      }
    }
    unsigned yold0 = 0, yold1 = 0, yold2 = 0, yold3 = 0, yold4 = 0, yold5 = 0, yold6 = 0, yold7 = 0;
    {
      const int cn = ci < 7 ? ci + 1 : ci;
      const int tcn = seg * 256 + (d == 0 ? cn : 7 - cn) * 32;
      X19(XLOAD)
      if (MODE == 1 && d == 1) {
        const unsigned* yb = (const unsigned*)(Y + (size_t)(gbase + tc0 + (t >> 6)) * 1024 + blk * 128 + (t & 63) * 2);
        yold0 = yb[0]; yold1 = yb[4 * 512]; yold2 = yb[8 * 512]; yold3 = yb[12 * 512];
        yold4 = yb[16 * 512]; yold5 = yb[20 * 512]; yold6 = yb[24 * 512]; yold7 = yb[28 * 512];
      }
    }
    MB();
    __syncthreads();
    f32x4 aR[2][2], aI[2][2];
#pragma unroll
    for (int im = 0; im < 2; ++im)
#pragma unroll
      for (int jn = 0; jn < 2; ++jn) { aR[im][jn] = f32x4{0.f, 0.f, 0.f, 0.f}; aI[im][jn] = f32x4{0.f, 0.f, 0.f, 0.f}; }
#pragma unroll
    for (int ks = 0; ks < 4; ++ks)
#pragma unroll
      for (int im = 0; im < 2; ++im) {
        bf16x8 af = *(const bf16x8*)(sXc + (16 * im + c16) * 272 + (ks * 32 + g4 * 8) * 2);
#pragma unroll
        for (int jn = 0; jn < 2; ++jn) {
          aR[im][jn] = __builtin_amdgcn_mfma_f32_16x16x32_bf16(af, bw[jn][ks], aR[im][jn], 0, 0, 0);
          aI[im][jn] = __builtin_amdgcn_mfma_f32_16x16x32_bf16(af, bw[2 + jn][ks], aI[im][jn], 0, 0, 0);
        }
      }
#pragma unroll
    for (int im = 0; im < 2; ++im)
#pragma unroll
      for (int jn = 0; jn < 2; ++jn)
#pragma unroll
        for (int e = 0; e < 4; ++e) {
          const int tt = 16 * im + 4 * g4 + e, c = 32 * w + 16 * jn + c16;
          const float r = sigmoidf_(aR[im][jn][e] + ba[jn]);
          const float ig = sigmoidf_(aI[im][jn][e] + bi[jn]);
          const float a = __expf(cl[jn] * r);
          const float xc = bf2f(*(const u16*)(sXc + tt * 272 + c * 2));
          const float u = sqrtf(fmaxf(1.f - a * a, 0.f)) * ig * xc;
          sA[tt * 128 + c] = a; sU[tt * 128 + c] = u;
        }
    __syncthreads();
    if (t < 128) {
      if (d == 0) {
#pragma unroll 8
        for (int s = 0; s < 32; ++s) {
          const float a = sA[s * 128 + t];
          h = a * h + sU[s * 128 + t];
          if (MODE == 0) P *= a; else sU[s * 128 + t] = h;
        }
      } else {
#pragma unroll 8
        for (int s = 31; s >= 0; --s) {
          const float a = sA[s * 128 + t];
          h = a * h + sU[s * 128 + t];
          if (MODE == 0) P *= a; else sU[s * 128 + t] = h;
        }
      }
    }
    __syncthreads();
    if (MODE == 1) {
      const int c2 = (t & 63) * 2;
      unsigned* yb = (unsigned*)(Y + (size_t)(gbase + tc0 + (t >> 6)) * 1024 + blk * 128 + c2);
      const float* su = sU + (t >> 6) * 128 + c2;
#define YOUT(i, yo) { float h0 = su[(4 * (i)) * 128], h1 = su[(4 * (i)) * 128 + 1]; \
        if (d == 1) { h0 += __uint_as_float((yo) << 16); h1 += __uint_as_float((yo) & 0xffff0000u); } \
        yb[(size_t)(4 * (i)) * 512] = pack2(h0, h1); }
      YOUT(0, yold0) YOUT(1, yold1) YOUT(2, yold2) YOUT(3, yold3) YOUT(4, yold4) YOUT(5, yold5) YOUT(6, yold6) YOUT(7, yold7)
#undef YOUT
    }
  }
#undef X19
#undef XDECL
#undef XLOAD
#undef XCVT
  if (MODE == 0) {
    if (t < 128) {
      float* sm = SUM + ((size_t)(((b * 8 + blk) * 2 + d) * 16 + seg)) * 256 + t;
      sm[0] = P; sm[128] = h;
    }
  } else if (is_ctx && t < 128) {
    p.out[OUT_RG + (((size_t)b * 4 + l) * 2 + d) * 1024 + blk * 128 + t] = h;
  }
  __syncthreads();
}

DI void phase_mix(const Params& p, int l, char* smem) {
  constexpr float LOG2E = 1.4426950408889634f;
  constexpr int N0 = 1024, N1 = N0 + 2048, N2 = N1 + 2048, N3 = N2 + 128, N4 = N3 + 256, N5 = N4 + 256;
  for (int base = 0; base < N5; base += gridDim.x) {
    const int it = xcd_map(base);
    if (it >= N5) continue;
    const int t = tid(), lane = t & 63, w = t >> 6;
    const int r32 = lane & 31;
    if (it < N0 || (it >= N2 && it < N3)) {
      int seq, blk, seg;
      if (it < N0) { seg = it & 15; blk = (it >> 4) & 7; seq = 16 + (it >> 7); }
      else { const int i = it - N2; seg = 0; blk = i & 7; seq = i >> 3; }
      scan_seg<1>(p, l, seq, blk, 0, seg, smem);
      scan_seg<1>(p, l, seq, blk, 1, seg, smem);
#if PROBE == 4
      scan_seg<1>(p, l, seq, blk, 0, seg, smem);
      scan_seg<1>(p, l, seq, blk, 1, seg, smem);
#endif
    } else if (it < N1 || (it >= N3 && it < N4)) {
      const bool lat = it < N1;
      int b, h, qb;
      if (lat) { const int i = it - N0; qb = i & 31; h = (i >> 5) & 7; b = i >> 8; }
      else { const int i = it - N3; qb = i & 1; h = (i >> 1) & 7; b = i >> 4; }
      const int Lk = lat ? LK_LAT : 256;
      const int gq = (lat ? T_CTX + b * 4096 : b * 256) + qb * 128 + w * 32 + r32;
      const u16* Kn = (lat ? wsp<u16>(p, O_KNL) : wsp<u16>(p, O_KNC)) + ((size_t)b * 8 + h) * Lk * 64;
      const u16* Kr = (lat ? wsp<u16>(p, O_KRL) : wsp<u16>(p, O_KRC)) + (size_t)b * Lk * 32;
      const u16* Vt = (lat ? wsp<u16>(p, O_VTL) : wsp<u16>(p, O_VTC)) + ((size_t)b * 8 + h) * 64 * Lk;
      const u16* Q = wsp<u16>(p, O_Q) + (size_t)gq * 768;
      u16* yrow = wsp<u16>(p, O_CQ) + (size_t)gq * 512 + h * 64;
      attn_item<6>(Kn, 64, Kr, Vt, Lk, Lk >> 6, 0, 0, nullptr, 0, nullptr, 0, 0,
                   Q + h * 64, Q + 512 + h * 32, 0.10206207261596577f * LOG2E, -1e30f, 0.f, 0, yrow, smem);
#if PROBE == 5
      __syncthreads();
      attn_item<6>(Kn, 64, Kr, Vt, Lk, Lk >> 6, 0, 0, nullptr, 0, nullptr, 0, 0,
                   Q + h * 64, Q + 512 + h * 32, 0.10206207261596577f * LOG2E, -1e30f, 0.f, 0, yrow, smem);
#endif
    } else {
      const bool lat = it < N2;
      int b, h, qb;
      if (lat) { const int i = it - N1; qb = i & 31; h = (i >> 5) & 7; b = i >> 8; }
      else { const int i = it - N4; qb = i & 1; h = (i >> 1) & 7; b = i >> 4; }
      const int kvh = h >> 2;
      const int gseq = lat ? T_CTX + b * 4096 : b * 256;
      const int qpos = qb * 128 + w * 32 + r32;
      const int gq = gseq + qpos;
      u16* qrow = wsp<u16>(p, O_QS) + (size_t)gq * 512 + h * 64;
      const float sink2 = p.sink[l * 8 + h] * LOG2E;
      const int t0 = qb * 128;
      int jlo = 0, jhi = 6;
      if (t0 == 0) jlo = 2;
      if (t0 + 128 >= 4096) jhi = 4;
      const int ks0 = lat ? t0 - 128 + 64 * jlo : 0;
      const int nA = lat ? jhi - jlo : 4;
      const u16* KS = wsp<u16>(p, O_KS) + (size_t)(gseq + ks0) * 128 + kvh * 64;
      const u16* VT = lat ? wsp<u16>(p, O_VTSL) + ((size_t)b * 2 + kvh) * 64 * 4096 + ks0
                          : wsp<u16>(p, O_VTSC) + ((size_t)b * 2 + kvh) * 64 * 256;
      const u16* KC = wsp<u16>(p, O_KSC) + (size_t)b * 256 * 128 + kvh * 64;
      const u16* VC = wsp<u16>(p, O_VTSCC) + ((size_t)b * 2 + kvh) * 64 * 256;
      attn_item<4>(KS, 128, nullptr, VT, lat ? 4096 : 256, nA, ks0, lat ? 1 : 0, KC, 128, VC, 256, lat ? 4 : 0,
                   qrow, nullptr, 0.125f * LOG2E, sink2, 1.f, qpos, qrow, smem);
    }
    __syncthreads();
  }
}

DI void phase_gate(const Params& p, int l, char* smem) {
  const u16* H = wsp<u16>(p, O_H);
  const u16* W = wsw(p, l, O_WINB);
  for (int base = 0; base < 288 * 40; base += gridDim.x) {
    const int tile = xcd_map(base);
    if (tile >= 288 * 40) continue;
    const int sb = tile >> 6, jj = tile & 63;
    const int mt = (sb / 5) * 8 + (jj >> 3), nt = (sb % 5) * 8 + (jj & 7);
    const int g0 = mt * 128;
    f32x4 acc[4][4];
    zero_acc(acc);
    gemm_tile(H + (size_t)g0 * 1024, 1024, W + (size_t)nt * 128 * 1024, 1024, 1024, acc, smem);
    LANEVARS
    if (nt < 16) {
      u16* dst; int ld, cb;
      if (nt < 8) { dst = wsp<u16>(p, O_YRNN); ld = 1024; cb = nt * 128; }
      else if (nt < 12) { dst = wsp<u16>(p, O_CQ); ld = 512; cb = (nt - 8) * 128; }
      else { dst = wsp<u16>(p, O_QS); ld = 512; cb = (nt - 12) * 128; }
#pragma unroll
      for (int i = 0; i < 4; ++i)
#pragma unroll
        for (int j = 0; j < 4; ++j)
#pragma unroll
          for (int e = 0; e < 4; ++e) {
            const int g = g0 + wr * 64 + i * 16 + g4 * 4 + e;
            u16* d = dst + (size_t)g * ld + cb + wc * 64 + j * 16 + c16;
            const float gv = acc[i][j][e];
            *d = f2bf(bf2f(*d) * gv * sigmoidf_(gv));
            if (e == 3) SB();
          }
    } else {
      const int br = (nt - 16) >> 3, cb = ((nt - 16) & 7) * 128;
      u16* dst = br == 0 ? wsp<u16>(p, O_XR) : wsp<u16>(p, O_KS) + (size_t)(br - 1) * T_ALL * 1024;
#pragma unroll
      for (int i = 0; i < 4; ++i)
#pragma unroll
        for (int j = 0; j < 4; ++j)
#pragma unroll
          for (int e = 0; e < 4; ++e) {
            const int g = g0 + wr * 64 + i * 16 + g4 * 4 + e;
            dst[(size_t)g * 1024 + cb + wc * 64 + j * 16 + c16] = f2bf(sigmoidf_(acc[i][j][e]));
            if (e == 3) SB();
          }
    }
  }
}

DI void phase_merge(const Params& p, int l, char* smem) {
  u16* U = wsp<u16>(p, O_H);
  for (int base = 0; base < 288 * 8; base += gridDim.x) {
    const int tile = xcd_map(base);
    if (tile >= 288 * 8) continue;
    const int mt = tile >> 3, nt = tile & 7;
    const int g0 = mt * 128;
    f32x4 u[4][4];
    zero_acc(u);
    for (int br = 0; br < 3; ++br) {
      f32x4 acc[4][4];
      zero_acc(acc);
      const u16* Z; const u16* WT; int kz; const u16* M;
      if (br == 0) { Z = wsp<u16>(p, O_YRNN) + (size_t)g0 * 1024; WT = wsw(p, l, O_WBRR) + (size_t)nt * 128 * 1024; kz = 1024; M = wsp<u16>(p, O_XR); }
      else if (br == 1) { Z = wsp<u16>(p, O_CQ) + (size_t)g0 * 512; WT = wsw(p, l, O_WBRM) + (size_t)nt * 128 * 512; kz = 512; M = wsp<u16>(p, O_KS); }
      else { Z = wsp<u16>(p, O_QS) + (size_t)g0 * 512; WT = wsw(p, l, O_WBRS) + (size_t)nt * 128 * 512; kz = 512; M = wsp<u16>(p, O_KS) + (size_t)T_ALL * 1024; }
      gemm_tile(Z, kz, WT, kz, kz, acc, smem);
      LANEVARS
#pragma unroll
      for (int i = 0; i < 4; ++i)
#pragma unroll
        for (int j = 0; j < 4; ++j)
#pragma unroll
          for (int e = 0; e < 4; ++e) {
            const int g = g0 + wr * 64 + i * 16 + g4 * 4 + e;
            u[i][j][e] += bf2f(M[(size_t)g * 1024 + nt * 128 + wc * 64 + j * 16 + c16]) * acc[i][j][e];
            if (e == 3) SB();
          }
    }
    LANEVARS
#pragma unroll
    for (int i = 0; i < 4; ++i)
#pragma unroll
      for (int j = 0; j < 4; ++j)
#pragma unroll
        for (int e = 0; e < 4; ++e) {
          const int g = g0 + wr * 64 + i * 16 + g4 * 4 + e;
          U[(size_t)g * 1024 + nt * 128 + wc * 64 + j * 16 + c16] = f2bf(u[i][j][e]);
        }
  }
}

DI void phase_out(const Params& p, int l, char* smem) {
  const u16* U = wsp<u16>(p, O_H);
  const u16* W = wsw(p, l, O_WOUT);
  const float* MOD = wsp<float>(p, O_MOD) + (size_t)l * 9 * 3072;
  for (int base = 0; base < 288 * 8; base += gridDim.x) {
    const int tile = xcd_map(base);
    if (tile >= 288 * 8) continue;
    const int mt = tile >> 3, nt = tile & 7;
    const int g0 = mt * 128;
    const int ci = g0 < T_CTX ? 8 : ((g0 - T_CTX) >> 12);
    f32x4 acc[4][4];
    zero_acc(acc);
    gemm_tile(U + (size_t)g0 * 1024, 1024, W + (size_t)nt * 128 * 1024, 1024, 1024, acc, smem);
    LANEVARS
#pragma unroll
    for (int j = 0; j < 4; ++j) {
      const int col = nt * 128 + wc * 64 + j * 16 + c16;
      const float gt = MOD[ci * 3072 + 2048 + col];
#pragma unroll
      for (int i = 0; i < 4; ++i)
#pragma unroll
        for (int e = 0; e < 4; ++e) {
          const int g = g0 + wr * 64 + i * 16 + g4 * 4 + e;
          const float xo = xin_row(p, l, g)[col];
          p.out[(size_t)g * 1024 + col] = xo + gt * acc[i][j][e];
          if (e == 3) SB();
        }
    }
  }
}

DI void phase_final(const Params& p) {
  const int t = tid(), lane = t & 63, w = t >> 6;
  for (int row = blockIdx.x * 4 + w; row < T_ALL; row += gridDim.x * 4) {
    float* x = p.out + (size_t)row * 1024;
    float4 v[4];
    float ss = 0.f;
#pragma unroll
    for (int i = 0; i < 4; ++i) {
      v[i] = *(const float4*)(x + i * 256 + lane * 4);
      ss += v[i].x * v[i].x + v[i].y * v[i].y + v[i].z * v[i].z + v[i].w * v[i].w;
    }
    ss = wave_sum(ss);
    const float rs = rsqrtf(ss * (1.f / 1024.f) + EPS);
#pragma unroll
    for (int i = 0; i < 4; ++i) {
      const int c = i * 256 + lane * 4;
      const float4 g = *(const float4*)(p.final_norm + c);
      float4 o = {v[i].x * rs * g.x, v[i].y * rs * g.y, v[i].z * rs * g.z, v[i].w * rs * g.w};
      *(float4*)(x + c) = o;
    }
  }
}

constexpr int NPHASE_PER_LAYER = 7;
DI void run_phase(const Params& p, int ph, char* smem) {
  if (ph == 0) { phase_mod(p, smem); return; }
  if (ph == 1 + NLAYER * NPHASE_PER_LAYER) { phase_final(p); return; }
  const int l = (ph - 1) / NPHASE_PER_LAYER, s = (ph - 1) % NPHASE_PER_LAYER;
  switch (s) {
    case 0: phase_prep(p, l); break;
    case 1: phase_gemmA(p, l, smem); break;
    case 2: phase_qkv(p, l, smem); break;
    case 3: phase_mix(p, l, smem); break;
    case 4: phase_gate(p, l, smem); break;
    case 5: phase_merge(p, l, smem); break;
    default: phase_out(p, l, smem); break;
  }
}
constexpr int NPHASE = 2 + NLAYER * NPHASE_PER_LAYER;

#if MEGA
DI Params launder(const Params& p) {
  size_t z = 0;
  asm volatile("" : "+s"(z));
  Params q = p; q.ws = p.ws + z; q.out = p.out + z;
  return q;
}
struct XBar { unsigned* base; unsigned xcc; unsigned nloc; unsigned nx; };
#define XB_CENSUS(j) (64 * (j))
#define XB_XSUB(j) (1024 + 64 * (j))
#define XB_XGEN(j) (2048 + 64 * (j))
#define XB_TOP 3072
#define XB_TOPGEN 3136
DI unsigned xb_ld(unsigned* p) { return __hip_atomic_load(p, __ATOMIC_RELAXED, __HIP_MEMORY_SCOPE_AGENT); }
DI unsigned xb_add(unsigned* p, unsigned v) { return __hip_atomic_fetch_add(p, v, __ATOMIC_RELAXED, __HIP_MEMORY_SCOPE_AGENT); }
DI void xbar_post(XBar& xb, unsigned* base) {
  xb.base = base; xb.nloc = 0; xb.nx = 0;
  xb.xcc = (unsigned)__builtin_amdgcn_s_getreg((3 << 11) | 20) & 0xFu;
  if (threadIdx.x == 0) xb_add(&base[XB_CENSUS(xb.xcc)], 1u);
}
DI void xbar_census(XBar& xb) {
  unsigned nx = 0;
  for (int j = 0; j < 16; ++j) nx += xb_ld(&xb.base[XB_CENSUS(j)]) ? 1u : 0u;
  xb.nx = nx; xb.nloc = xb_ld(&xb.base[XB_CENSUS(xb.xcc)]);
}
DI void xbar_sync(const XBar& xb) {
  asm volatile("s_waitcnt vmcnt(0)" ::: "memory");
  __syncthreads();
  if (threadIdx.x == 0) {
    unsigned* bar = xb.base;
    const unsigned old = xb_add(&bar[XB_XSUB(xb.xcc)], 1u);
    const unsigned gen = old / xb.nloc;
    if (old + 1u == (gen + 1u) * xb.nloc) {
      __builtin_amdgcn_fence(__ATOMIC_RELEASE, "agent");
      asm volatile("s_waitcnt vmcnt(0)" ::: "memory");
      const unsigned og = xb_add(&bar[XB_TOP], 1u);
      const unsigned tg = og / xb.nx;
      if (og + 1u == (tg + 1u) * xb.nx) xb_add(&bar[XB_TOPGEN], 1u);
      else { unsigned sp = 0; while (xb_ld(&bar[XB_TOPGEN]) == tg) { __builtin_amdgcn_s_sleep(1); if (++sp > (1u << 22)) break; } }
      __builtin_amdgcn_fence(__ATOMIC_ACQUIRE, "agent");
      xb_add(&bar[XB_XGEN(xb.xcc)], 1u);
      asm volatile("s_waitcnt vmcnt(0)" ::: "memory");
    } else {
      unsigned sp = 0;
      while (xb_ld(&bar[XB_XGEN(xb.xcc)]) == gen) { __builtin_amdgcn_s_sleep(1); if (++sp > (1u << 22)) break; }
      __builtin_amdgcn_fence(__ATOMIC_ACQUIRE, "agent");
      asm volatile("s_waitcnt vmcnt(0)" ::: "memory");
    }
  }
  __syncthreads();
}
#define GSYNC() xbar_sync(xb)
__global__ void __launch_bounds__(256, 2) mega_kernel(Params p) {
  __shared__ __attribute__((aligned(16))) char smem[66048];
  cg::grid_group grid = cg::this_grid();
  XBar xb;
  xbar_post(xb, (unsigned*)(p.ws + O_BAR));
  phase_mod(launder(p), smem);
  convert_weights(launder(p), 0);
  grid.sync();
  xbar_census(xb);
  for (int l = 0; l < NLAYER; ++l) {
    phase_prep(launder(p), l);
    GSYNC();
#if PROBE == 1
    phase_prep(launder(p), l);
    GSYNC();
#endif
    phase_gemmA(launder(p), l, smem);
    GSYNC();
#if PROBE == 2
    phase_gemmA(launder(p), l, smem);
    GSYNC();
#endif
    phase_qkv(launder(p), l, smem);
    GSYNC();
    phase_mix(launder(p), l, smem);
    if (l + 1 < NLAYER) convert_weights(launder(p), l + 1);
    GSYNC();
    phase_gate(launder(p), l, smem);
    GSYNC();
    phase_merge(launder(p), l, smem);
    GSYNC();
#if PROBE == 3
    phase_merge(launder(p), l, smem);
    GSYNC();
#endif
    phase_out(launder(p), l, smem);
    GSYNC();
  }
  phase_final(launder(p));
}

#else
__global__ void __launch_bounds__(256, 2) phase_kernel(Params p, int ph) {
  __shared__ __attribute__((aligned(16))) char smem[66048];
  run_phase(p, ph, smem);
}

#endif
extern "C" void kernel_launch(void* const* d_in, const int* in_sizes, int n_in, void* d_out, int out_size, void* d_ws,
                              size_t ws_size, hipStream_t stream) {
  Params p{};
  const float** pp = (const float**)&p;
  for (int i = 0; i < 30; ++i) pp[i] = (const float*)d_in[i];
  p.out = (float*)d_out;
  p.ws = (char*)d_ws;
  if (ws_size < WS_NEED) fprintf(stderr, "workspace too small: %zu < %zu\n", ws_size, (size_t)WS_NEED);
#if MEGA
  static int grid_blocks = 0;
  if (!grid_blocks) {
    int dev = 0, cus = 0, per_cu = 0;
    hipGetDevice(&dev);
    hipDeviceGetAttribute(&cus, hipDeviceAttributeMultiprocessorCount, dev);
    hipOccupancyMaxActiveBlocksPerMultiprocessor(&per_cu, mega_kernel, 256, 0);
    if (per_cu > 2) per_cu = 2;
    grid_blocks = cus * per_cu;
  }
  (void)hipMemsetAsync((char*)d_ws + O_BAR, 0, BAR_BYTES, stream);
  void* args[] = {&p};
  hipError_t e = hipLaunchCooperativeKernel((void*)mega_kernel, dim3(grid_blocks), dim3(256), args, 0, stream);
  if (e != hipSuccess) fprintf(stderr, "cooperative launch failed: %s (grid %d)\n", hipGetErrorString(e), grid_blocks);
#else
  for (int ph = 0; ph < NPHASE; ++ph) phase_kernel<<<512, 256, 0, stream>>>(p, ph);
#endif
}
```

```cpp
#include <hip/hip_runtime.h>
#include <hip/hip_cooperative_groups.h>
#include <cstdio>
#include <cstdint>
namespace cg = cooperative_groups;

#ifndef PROBE
#define PROBE 0
#endif
#ifndef MEGA
#define MEGA 1
#endif

typedef unsigned short u16;
using bf16x8 = __attribute__((ext_vector_type(8))) short;
using f32x4 = __attribute__((ext_vector_type(4))) float;
using f32x16 = __attribute__((ext_vector_type(16))) float;
typedef __bf16 bf2_t __attribute__((ext_vector_type(2)));
typedef float f2_t __attribute__((ext_vector_type(2)));
#define DI __device__ __forceinline__

__device__ const float TAB_M[1024] = {
  1.00000000e+00f, 0.00000000e+00f, 1.00000000e+00f, 0.00000000e+00f, 1.00000000e+00f, 0.00000000e+00f, 1.00000000e+00f, 0.00000000e+00f,
  1.00000000e+00f, 0.00000000e+00f, 1.00000000e+00f, 0.00000000e+00f, 1.00000000e+00f, 0.00000000e+00f, 1.00000000e+00f, 0.00000000e+00f,
  5.40302277e-01f, 8.41470957e-01f, 9.50415254e-01f, 3.10983598e-01f, 9.95004177e-01f, 9.98334214e-02f, 9.99500036e-01f, 3.16175036e-02f,
  9.99949992e-01f, 9.99983307e-03f, 9.99994993e-01f, 3.16227227e-03f, 9.99999523e-01f, 9.99999931e-04f, 9.99999940e-01f, 3.16227757e-04f,
  -4.16146845e-01f, 9.09297407e-01f, 8.06578398e-01f, 5.91127098e-01f, 9.80066597e-01f, 1.98669329e-01f, 9.98000681e-01f, 6.32033944e-02f,
  9.99800026e-01f, 1.99986659e-02f, 9.99979973e-01f, 6.32451288e-03f, 9.99997973e-01f, 1.99999870e-03f, 9.99999821e-01f, 6.32455456e-04f,
  -9.89992499e-01f, 1.41120002e-01f, 5.82753658e-01f, 8.12648892e-01f, 9.55336511e-01f, 2.95520216e-01f, 9.95503366e-01f, 9.47260857e-02f,
  9.99550045e-01f, 2.99954992e-02f, 9.99954998e-01f, 9.48669016e-03f, 9.99995530e-01f, 2.99999560e-03f, 9.99999523e-01f, 9.48683126e-04f,
  -6.53643608e-01f, -7.56802499e-01f, 3.01137477e-01f, 9.53580737e-01f, 9.21060979e-01f, 3.89418334e-01f, 9.92010653e-01f, 1.26154065e-01f,
  9.99200106e-01f, 3.99893336e-02f, 9.99920011e-01f, 1.26487734e-02f, 9.99992013e-01f, 3.99998948e-03f, 9.99999225e-01f, 1.26491068e-03f,
  2.83662200e-01f, -9.58924294e-01f, -1.03423381e-02f, 9.99946535e-01f, 8.77582550e-01f, 4.79425550e-01f, 9.87526000e-01f, 1.57455876e-01f,
  9.98750269e-01f, 4.99791652e-02f, 9.99875009e-01f, 1.58107281e-02f, 9.99987483e-01f, 4.99997940e-03f, 9.99998748e-01f, 1.58113812e-03f,
  9.60170269e-01f, -2.79415488e-01f, -3.20796400e-01f, 9.47148204e-01f, 8.25335622e-01f, 5.64642489e-01f, 9.82053936e-01f, 1.88600272e-01f,
  9.98200536e-01f, 5.99640049e-02f, 9.99819994e-01f, 1.89725272e-02f, 9.99981999e-01f, 5.99996420e-03f, 9.99998212e-01f, 1.89736532e-03f,
  7.53902256e-01f, 6.56986594e-01f, -5.99437475e-01f, 8.00421596e-01f, 7.64842212e-01f, 6.44217670e-01f, 9.75599885e-01f, 2.19556093e-01f,
  9.97551024e-01f, 6.99428469e-02f, 9.99755025e-01f, 2.21341345e-02f, 9.99975502e-01f, 6.99994294e-03f, 9.99997556e-01f, 2.21359241e-03f,
  -1.45500034e-01f, 9.89358246e-01f, -8.18632424e-01f, 5.74317753e-01f, 6.96706712e-01f, 7.17356086e-01f, 9.68170285e-01f, 2.50292331e-01f,
  9.96801734e-01f, 7.99146891e-02f, 9.99680042e-01f, 2.52955221e-02f, 9.99967992e-01f, 7.99991470e-03f, 9.99996781e-01f, 2.52981926e-03f,
  -9.11130250e-01f, 4.12118495e-01f, -9.56644177e-01f, 2.91259229e-01f, 6.21609926e-01f, 7.83326924e-01f, 9.59772646e-01f, 2.80778319e-01f,
  9.95952725e-01f, 8.98785442e-02f, 9.99595046e-01f, 2.84566563e-02f, 9.99959528e-01f, 8.99987947e-03f, 9.99995947e-01f, 2.84604589e-03f,
  -8.39071512e-01f, -5.44021130e-01f, -9.99786079e-01f, -2.06835698e-02f, 5.40302277e-01f, 8.41470957e-01f, 9.50415313e-01f, 3.10983568e-01f,
  9.95004177e-01f, 9.98334140e-02f, 9.99500036e-01f, 3.16175036e-02f, 9.99949992e-01f, 9.99983400e-03f, 9.99994993e-01f, 3.16227227e-03f,
  4.42569796e-03f, -9.99990225e-01f, -9.43779767e-01f, -3.30574960e-01f, 4.53596085e-01f, 8.91207397e-01f, 9.40107584e-01f, 3.40877861e-01f,
  9.93956089e-01f, 1.09778300e-01f, 9.99395072e-01f, 3.47780399e-02f, 9.99939501e-01f, 1.09997792e-02f, 9.99993920e-01f, 3.47849843e-03f,
  8.43853951e-01f, -5.36572933e-01f, -7.94179380e-01f, -6.07683420e-01f, 3.62357706e-01f, 9.32039082e-01f, 9.28859890e-01f, 3.70431304e-01f,
  9.92808640e-01f, 1.19712204e-01f, 9.99280095e-01f, 3.79382223e-02f, 9.99927998e-01f, 1.19997123e-02f, 9.99992788e-01f, 3.79472389e-03f,
  9.07446802e-01f, 4.20167029e-01f, -5.65820515e-01f, -8.24528456e-01f, 2.67498761e-01f, 9.63558197e-01f, 9.16683376e-01f, 3.99614304e-01f,
  9.91561890e-01f, 1.29634142e-01f, 9.99155104e-01f, 4.10980321e-02f, 9.99915481e-01f, 1.29996343e-02f, 9.99991536e-01f, 4.11094911e-03f,
  1.36737213e-01f, 9.90607381e-01f, -2.81349480e-01f, -9.59605396e-01f, 1.69967160e-01f, 9.85449731e-01f, 9.03590262e-01f, 4.28397775e-01f,
  9.90216017e-01f, 1.39543116e-01f, 9.99020159e-01f, 4.42574248e-02f, 9.99902010e-01f, 1.39995432e-02f, 9.99990225e-01f, 4.42717411e-03f,
  -7.59687901e-01f, 6.50287867e-01f, 3.10223512e-02f, -9.99518692e-01f, 7.07371980e-02f, 9.97494996e-01f, 8.89593601e-01f, 4.56752867e-01f,
  9.88771081e-01f, 1.49438128e-01f, 9.98875201e-01f, 4.74163815e-02f, 9.99887526e-01f, 1.49994381e-02f, 9.99988735e-01f, 4.74339863e-03f,
  -9.57659483e-01f, -2.87903309e-01f, 3.40318173e-01f, -9.40310359e-01f, -2.91995462e-02f, 9.99573588e-01f, 8.74707460e-01f, 4.84651238e-01f,
  9.87227261e-01f, 1.59318209e-01f, 9.98720288e-01f, 5.05748577e-02f, 9.99872029e-01f, 1.59993190e-02f, 9.99987185e-01f, 5.05962269e-03f,
  -2.75163352e-01f, -9.61397469e-01f, 6.15864813e-01f, -7.87851870e-01f, -1.28844544e-01f, 9.91664827e-01f, 8.58946681e-01f, 5.12064993e-01f,
  9.85584795e-01f, 1.69182345e-01f, 9.98555362e-01f, 5.37328273e-02f, 9.99855518e-01f, 1.69991814e-02f, 9.99985576e-01f, 5.37584582e-03f,
  6.60316706e-01f, -7.50987232e-01f, 8.30336154e-01f, -5.57262897e-01f, -2.27202162e-01f, 9.73847628e-01f, 8.42327058e-01f, 5.38966715e-01f,
  9.83843684e-01f, 1.79029569e-01f, 9.98380423e-01f, 5.68902642e-02f, 9.99837995e-01f, 1.79990288e-02f, 9.99983788e-01f, 5.69206895e-03f,
  9.88704622e-01f, 1.49877205e-01f, 9.62463796e-01f, -2.71410108e-01f, -3.23289543e-01f, 9.46300089e-01f, 8.24865162e-01f, 5.65329552e-01f,
  9.82004225e-01f, 1.88858896e-01f, 9.98195529e-01f, 6.00471310e-02f, 9.99819517e-01f, 1.89988576e-02f, 9.99981940e-01f, 6.00829115e-03f,
  4.08082068e-01f, 9.12945271e-01f, 9.99144375e-01f, 4.13582884e-02f, -4.16146845e-01f, 9.09297407e-01f, 8.06578457e-01f, 5.91127038e-01f,
  9.80066597e-01f, 1.98669314e-01f, 9.98000681e-01f, 6.32033944e-02f, 9.99800026e-01f, 1.99986678e-02f, 9.99979973e-01f, 6.32451288e-03f,
  -5.47729254e-01f, 8.36655617e-01f, 9.36740458e-01f, 3.50024760e-01f, -5.04846215e-01f, 8.63209307e-01f, 7.87485182e-01f, 6.16333544e-01f,
  9.78030920e-01f, 2.08459899e-01f, 9.97795820e-01f, 6.63590282e-02f, 9.99779522e-01f, 2.09984574e-02f, 9.99977946e-01f, 6.64073415e-03f,
  -9.99960840e-01f, -8.85130931e-03f, 7.81440377e-01f, 6.23979926e-01f, -5.88501155e-01f, 8.08496356e-01f, 7.67604589e-01f, 6.40923738e-01f,
  9.75897431e-01f, 2.18229622e-01f, 9.97581005e-01f, 6.95140064e-02f, 9.99758005e-01f, 2.19982266e-02f, 9.99975801e-01f, 6.95695449e-03f,
  -5.32833040e-01f, -8.46220434e-01f, 5.48645258e-01f, 8.36055279e-01f, -6.66275978e-01f, 7.45705247e-01f, 7.46956408e-01f, 6.64873064e-01f,
  9.73666370e-01f, 2.27977514e-01f, 9.97356176e-01f, 7.26682767e-02f, 9.99735534e-01f, 2.29979735e-02f, 9.99973536e-01f, 7.27317436e-03f,
  4.24179018e-01f, -9.05578375e-01f, 2.61441678e-01f, 9.65219259e-01f, -7.37393796e-01f, 6.75463140e-01f, 7.25561321e-01f, 6.88157499e-01f,
  9.71337974e-01f, 2.37702623e-01f, 9.97121394e-01f, 7.58218244e-02f, 9.99711990e-01f, 2.39976961e-02f, 9.99971211e-01f, 7.58939330e-03f,
  9.91202831e-01f, -1.32351756e-01f, -5.16893305e-02f, 9.98663187e-01f, -8.01143587e-01f, 5.98472118e-01f, 7.03440726e-01f, 7.10753918e-01f,
  9.68912423e-01f, 2.47403964e-01f, 9.96876657e-01f, 7.89746121e-02f, 9.99687493e-01f, 2.49973964e-02f, 9.99968767e-01f, 7.90561177e-03f,
  6.46919310e-01f, 7.62558460e-01f, -3.59694332e-01f, 9.33070183e-01f, -8.56888831e-01f, 5.15501261e-01f, 6.80616796e-01f, 7.32639611e-01f,
  9.66389954e-01f, 2.57080555e-01f, 9.96621907e-01f, 8.21266174e-02f, 9.99662042e-01f, 2.59970706e-02f, 9.99966204e-01f, 8.22182931e-03f,
  -2.92138815e-01f, 9.56375957e-01f, -6.32028639e-01f, 7.74945021e-01f, -9.04072165e-01f, 4.27379847e-01f, 6.57112300e-01f, 7.53792703e-01f,
  9.63770926e-01f, 2.66731411e-01f, 9.96357203e-01f, 8.52777958e-02f, 9.99635518e-01f, 2.69967206e-02f, 9.99963522e-01f, 8.53804592e-03f,
  -9.62605894e-01f, 2.70905793e-01f, -8.41684937e-01f, 5.39968967e-01f, -9.42222297e-01f, 3.34988207e-01f, 6.32950664e-01f, 7.74192095e-01f,
  9.61055458e-01f, 2.76355654e-01f, 9.96082544e-01f, 8.84281173e-02f, 9.99608040e-01f, 2.79963426e-02f, 9.99960780e-01f, 8.85426160e-03f,
  -7.48057544e-01f, -6.63633883e-01f, -9.67871487e-01f, 2.51445323e-01f, -9.70958173e-01f, 2.39249229e-01f, 6.08156204e-01f, 7.93817401e-01f,
  9.58243906e-01f, 2.85952210e-01f, 9.95797932e-01f, 9.15775672e-02f, 9.99579549e-01f, 2.89959367e-02f, 9.99957979e-01f, 9.17047635e-03f,
  1.54251456e-01f, -9.88031626e-01f, -9.98075247e-01f, -6.20148405e-02f, -9.89992499e-01f, 1.41120002e-01f, 5.82753658e-01f, 8.12648892e-01f,
  9.55336511e-01f, 2.95520186e-01f, 9.95503366e-01f, 9.47260931e-02f, 9.99550045e-01f, 2.99955010e-02f, 9.99954998e-01f, 9.48669016e-03f,
  9.14742351e-01f, -4.04037654e-01f, -9.29300308e-01f, -3.69325012e-01f, -9.99135137e-01f, 4.15805206e-02f, 5.56768358e-01f, 8.30667794e-01f,
  9.52333570e-01f, 3.05058628e-01f, 9.95198846e-01f, 9.78736654e-02f, 9.99519527e-01f, 3.09950355e-02f, 9.99951959e-01f, 9.80290305e-03f,
  8.34223390e-01f, 5.51426709e-01f, -7.68367112e-01f, -6.40009403e-01f, -9.98294771e-01f, -5.83741926e-02f, 5.30226350e-01f, 8.47856104e-01f,
  9.49235439e-01f, 3.14566553e-01f, 9.94884372e-01f, 1.01020269e-01f, 9.99488056e-01f, 3.19945402e-02f, 9.99948800e-01f, 1.01191159e-02f,
  -1.32767474e-02f, 9.99911845e-01f, -5.31235278e-01f, -8.47224355e-01f, -9.87479806e-01f, -1.57745644e-01f, 5.03154159e-01f, 8.64196658e-01f,
  9.46042359e-01f, 3.24043006e-01f, 9.94559944e-01f, 1.04165860e-01f, 9.99455571e-01f, 3.29940096e-02f, 9.99945521e-01f, 1.04353270e-02f,
  -8.48570287e-01f, 5.29082716e-01f, -2.41421118e-01f, -9.70420420e-01f, -9.66798186e-01f, -2.55541205e-01f, 4.75578904e-01f, 8.79673064e-01f,
  9.42754686e-01f, 3.33487093e-01f, 9.94225562e-01f, 1.07310407e-01f, 9.99422073e-01f, 3.39934528e-02f, 9.99942183e-01f, 1.07515370e-02f,
  -9.03692186e-01f, -4.28182662e-01f, 7.23346695e-02f, -9.97380435e-01f, -9.36456680e-01f, -3.50783229e-01f, 4.47528064e-01f, 8.94269884e-01f,
  9.39372718e-01f, 3.42897803e-01f, 9.93881226e-01f, 1.10453881e-01f, 9.99387562e-01f, 3.49928550e-02f, 9.99938726e-01f, 1.10677453e-02f,
  -1.27963692e-01f, -9.91778851e-01f, 3.78916174e-01f, -9.25431013e-01f, -8.96758378e-01f, -4.42520559e-01f, 4.19029742e-01f, 9.07972515e-01f,
  9.35896814e-01f, 3.52274209e-01f, 9.93526995e-01f, 1.13596253e-01f, 9.99352098e-01f, 3.59922275e-02f, 9.99935210e-01f, 1.13839535e-02f,
  7.65414059e-01f, -6.43538117e-01f, 6.47921681e-01f, -7.61706948e-01f, -8.48100007e-01f, -5.29836178e-01f, 3.90112430e-01f, 9.20767248e-01f,
  9.32327330e-01f, 3.61615449e-01f, 9.93162811e-01f, 1.16737492e-01f, 9.99315560e-01f, 3.69915590e-02f, 9.99931574e-01f, 1.17001599e-02f,
  9.55073655e-01f, 2.96368569e-01f, 8.52673113e-01f, -5.22444785e-01f, -7.90967762e-01f, -6.11857831e-01f, 3.60805035e-01f, 9.32641268e-01f,
  9.28664625e-01f, 3.70920479e-01f, 9.92788672e-01f, 1.19877554e-01f, 9.99278069e-01f, 3.79908569e-02f, 9.99927819e-01f, 1.20163653e-02f,
  2.66642928e-01f, 9.63795364e-01f, 9.72865343e-01f, -2.31372014e-01f, -7.25932240e-01f, -6.87766254e-01f, 3.31136853e-01f, 9.43582714e-01f,
  9.24909055e-01f, 3.80188406e-01f, 9.92404640e-01f, 1.23016424e-01f, 9.99239624e-01f, 3.89901139e-02f, 9.99923944e-01f, 1.23325698e-02f,
  -6.66938066e-01f, 7.45113134e-01f, 9.96578991e-01f, 8.26458037e-02f, -6.53643608e-01f, -7.56802499e-01f, 3.01137596e-01f, 9.53580678e-01f,
  9.21060979e-01f, 3.89418334e-01f, 9.92010653e-01f, 1.26154065e-01f, 9.99200106e-01f, 3.99893373e-02f, 9.99920011e-01f, 1.26487734e-02f,
  -9.87339258e-01f, -1.58622667e-01f, 9.21462357e-01f, 3.88467699e-01f, -5.74824035e-01f, -8.18277061e-01f, 2.70837069e-01f, 9.62625206e-01f,
  9.17120814e-01f, 3.98609310e-01f, 9.91606772e-01f, 1.29290432e-01f, 9.99159634e-01f, 4.09885161e-02f, 9.99915957e-01f, 1.29649751e-02f,
  -3.99985313e-01f, -9.16521549e-01f, 7.54965365e-01f, 6.55764699e-01f, -4.90260571e-01f, -8.71575892e-01f, 2.40265876e-01f, 9.70707119e-01f,
  9.13088918e-01f, 4.07760441e-01f, 9.91192937e-01f, 1.32425532e-01f, 9.99118149e-01f, 4.19876575e-02f, 9.99911785e-01f, 1.32811759e-02f,
  5.55113316e-01f, -8.31774771e-01f, 5.13598442e-01f, 8.58030677e-01f, -4.00799006e-01f, -9.16166008e-01f, 2.09454417e-01f, 9.77818429e-01f,
  9.08965766e-01f, 4.16870773e-01f, 9.90769207e-01f, 1.35559291e-01f, 9.99075651e-01f, 4.29867506e-02f, 9.99907553e-01f, 1.35973748e-02f,
  9.99843299e-01f, 1.77019257e-02f, 2.21298173e-01f, 9.75206196e-01f, -3.07332784e-01f, -9.51602101e-01f, 1.78433523e-01f, 9.83951986e-01f,
  9.04751658e-01f, 4.25939471e-01f, 9.90335584e-01f, 1.38691694e-01f, 9.99032140e-01f, 4.39858064e-02f, 9.99903202e-01f, 1.39135728e-02f,
  5.25321960e-01f, 8.50903511e-01f, -9.29481089e-02f, 9.95670974e-01f, -2.10795805e-01f, -9.77530122e-01f, 1.47234216e-01f, 9.89101648e-01f,
  9.00447130e-01f, 4.34965521e-01f, 9.89892066e-01f, 1.41822711e-01f, 9.98987675e-01f, 4.49848175e-02f, 9.99898732e-01f, 1.42297689e-02f,
  -4.32177931e-01f, 9.01788354e-01f, -3.97976756e-01f, 9.17395473e-01f, -1.12152621e-01f, -9.93690968e-01f, 1.15887694e-01f, 9.93262351e-01f,
  8.96052480e-01f, 4.43948090e-01f, 9.89438653e-01f, 1.44952312e-01f, 9.98942196e-01f, 4.59837839e-02f, 9.99894202e-01f, 1.45459641e-02f,
  -9.92335498e-01f, 1.23573124e-01f, -6.63538277e-01f, 7.48142362e-01f, -1.23883775e-02f, -9.99923289e-01f, 8.44252855e-02f, 9.96429801e-01f,
  8.91568303e-01f, 4.52886283e-01f, 9.88975346e-01f, 1.48080453e-01f, 9.98895705e-01f, 4.69827019e-02f, 9.99889553e-01f, 1.48621574e-02f,
  -6.40144348e-01f, -7.68254638e-01f, -8.63296509e-01f, 5.04697084e-01f, 8.74991715e-02f, -9.96164620e-01f, 5.28784581e-02f, 9.98600960e-01f,
  8.86994898e-01f, 4.61779177e-01f, 9.88502085e-01f, 1.51207119e-01f, 9.98848200e-01f, 4.79815714e-02f, 9.99884784e-01f, 1.51783489e-02f,
  3.00592542e-01f, -9.53752637e-01f, -9.77442741e-01f, 2.11200655e-01f, 1.86512470e-01f, -9.82452571e-01f, 2.12787576e-02f, 9.99773562e-01f,
  8.82332861e-01f, 4.70625877e-01f, 9.88018990e-01f, 1.54332280e-01f, 9.98799741e-01f, 4.89803962e-02f, 9.99879956e-01f, 1.54945394e-02f,
  9.64965999e-01f, -2.62374848e-01f, -9.94656444e-01f, -1.03240460e-01f, 2.83662200e-01f, -9.58924294e-01f, -1.03422189e-02f, 9.99946535e-01f,
  8.77582550e-01f, 4.79425550e-01f, 9.87526000e-01f, 1.57455891e-01f, 9.98750269e-01f, 4.99791689e-02f, 9.99875009e-01f, 1.58107281e-02f,
  7.42154181e-01f, 6.70229197e-01f, -9.13230121e-01f, -4.07444149e-01f, 3.77977669e-01f, -9.25814748e-01f, -4.19528559e-02f, 9.99119580e-01f,
  8.72744501e-01f, 4.88177240e-01f, 9.87023175e-01f, 1.60577938e-01f, 9.98699784e-01f, 5.09778969e-02f, 9.99869943e-01f, 1.61269177e-02f,
  -1.62990779e-01f, 9.86627579e-01f, -7.41239965e-01f, -6.71240151e-01f, 4.68516916e-01f, -8.83454502e-01f, -7.35215396e-02f, 9.97293651e-01f,
  8.67819190e-01f, 4.96880114e-01f, 9.86510456e-01f, 1.63698375e-01f, 9.98648286e-01f, 5.19765690e-02f, 9.99864817e-01f, 1.64431017e-02f,
  -9.18282807e-01f, 3.95925164e-01f, -4.95741814e-01f, -8.68469954e-01f, 5.54374516e-01f, -8.32267344e-01f, -1.05016708e-01f, 9.94470477e-01f,
  8.62807095e-01f, 5.05533338e-01f, 9.85987842e-01f, 1.66817173e-01f, 9.98595834e-01f, 5.29751927e-02f, 9.99859571e-01f, 1.67592876e-02f,
  -8.29309821e-01f, -5.58789074e-01f, -2.01079622e-01f, -9.79574919e-01f, 6.34692967e-01f, -7.72764444e-01f, -1.36406869e-01f, 9.90652919e-01f,
  8.57708693e-01f, 5.14135957e-01f, 9.85455394e-01f, 1.69934288e-01f, 9.98542368e-01f, 5.39737605e-02f, 9.99854207e-01f, 1.70754679e-02f,
  2.21267566e-02f, -9.99755144e-01f, 1.13521777e-01f, -9.93535519e-01f, 7.08669782e-01f, -7.05540299e-01f, -1.67660639e-01f, 9.85844791e-01f,
  8.52524519e-01f, 5.22687256e-01f, 9.84913111e-01f, 1.73049718e-01f, 9.98487890e-01f, 5.49722798e-02f, 9.99848783e-01f, 1.73916500e-02f,
  8.53220105e-01f, -5.21551013e-01f, 4.16867077e-01f, -9.08967435e-01f, 7.75565803e-01f, -6.31266713e-01f, -1.98746875e-01f, 9.80050862e-01f,
  8.47255111e-01f, 5.31186223e-01f, 9.84360933e-01f, 1.76163420e-01f, 9.98432398e-01f, 5.59707358e-02f, 9.99843180e-01f, 1.77078284e-02f,
  8.99866819e-01f, 4.36164767e-01f, 6.78870201e-01f, -7.34258294e-01f, 8.34712923e-01f, -5.50685287e-01f, -2.29634270e-01f, 9.73276973e-01f,
  8.41901004e-01f, 5.39632022e-01f, 9.83798921e-01f, 1.79275364e-01f, 9.98375952e-01f, 5.69691435e-02f, 9.99837577e-01f, 1.80240069e-02f,
  1.19180135e-01f, 9.92872655e-01f, 8.73550534e-01f, -4.86733496e-01f, 8.85519624e-01f, -4.64602023e-01f, -2.60292053e-01f, 9.65529919e-01f,
  8.36462677e-01f, 5.48023939e-01f, 9.83227074e-01f, 1.82385504e-01f, 9.98318493e-01f, 5.79674877e-02f, 9.99831796e-01f, 1.83401816e-02f,
  -7.71080196e-01f, 6.36738002e-01f, 9.81602073e-01f, -1.90938011e-01f, 9.27478492e-01f, -3.73876572e-01f, -2.90689558e-01f, 9.56817448e-01f,
  8.30940723e-01f, 5.56361020e-01f, 9.82645452e-01f, 1.85493827e-01f, 9.98260021e-01f, 5.89657798e-02f, 9.99825954e-01f, 1.86563563e-02f,
  -9.52412963e-01f, -3.04810613e-01f, 9.92308319e-01f, 1.23790950e-01f, 9.60170269e-01f, -2.79415488e-01f, -3.20796400e-01f, 9.47148204e-01f,
  8.25335622e-01f, 5.64642429e-01f, 9.82053936e-01f, 1.88600287e-01f, 9.98200536e-01f, 5.99640086e-02f, 9.99819994e-01f, 1.89725272e-02f,
  -2.58101642e-01f, -9.66117799e-01f, 9.04607594e-01f, 4.26245421e-01f, 9.83268440e-01f, -1.82162598e-01f, -3.50582451e-01f, 9.36531842e-01f,
  8.19648027e-01f, 5.72867453e-01f, 9.81452644e-01f, 1.91704854e-01f, 9.98140097e-01f, 6.09621815e-02f, 9.99813974e-01f, 1.92886982e-02f,
  6.73507154e-01f, -7.39180684e-01f, 7.27198064e-01f, 6.86427653e-01f, 9.96542096e-01f, -8.30891207e-02f, -3.80017966e-01f, 9.24979091e-01f,
  8.13878477e-01f, 5.81035137e-01f, 9.80841517e-01f, 1.94807529e-01f, 9.98078644e-01f, 6.19602874e-02f, 9.99807835e-01f, 1.96048655e-02f,
  9.85896587e-01f, 1.67355701e-01f, 4.77671444e-01f, 8.78538549e-01f, 9.99858618e-01f, 1.68140903e-02f, -4.09073502e-01f, 9.12501454e-01f,
  8.08027506e-01f, 5.89144766e-01f, 9.80220556e-01f, 1.97908238e-01f, 9.98016179e-01f, 6.29583374e-02f, 9.99801576e-01f, 1.99210308e-02f,
};
__device__ const float TAB_S[2048] = {
  1.00000000e+00f, 0.00000000e+00f, 1.00000000e+00f, 0.00000000e+00f, 1.00000000e+00f, 0.00000000e+00f, 1.00000000e+00f, 0.00000000e+00f,
  1.00000000e+00f, 0.00000000e+00f, 1.00000000e+00f, 0.00000000e+00f, 1.00000000e+00f, 0.00000000e+00f, 1.00000000e+00f, 0.00000000e+00f,
  1.00000000e+00f, 0.00000000e+00f, 1.00000000e+00f, 0.00000000e+00f, 1.00000000e+00f, 0.00000000e+00f, 1.00000000e+00f, 0.00000000e+00f,
  1.00000000e+00f, 0.00000000e+00f, 1.00000000e+00f, 0.00000000e+00f, 1.00000000e+00f, 0.00000000e+00f, 1.00000000e+00f, 0.00000000e+00f,
  5.40302277e-01f, 8.41470957e-01f, 8.46009135e-01f, 5.33168435e-01f, 9.50415254e-01f, 3.10983598e-01f, 9.84230220e-01f, 1.76892191e-01f,
  9.95004177e-01f, 9.98334214e-02f, 9.98419285e-01f, 5.62044978e-02f, 9.99500036e-01f, 3.16175036e-02f, 9.99841869e-01f, 1.77818574e-02f,
  9.99949992e-01f, 9.99983307e-03f, 9.99984205e-01f, 5.62338345e-03f, 9.99994993e-01f, 3.16227227e-03f, 9.99998391e-01f, 1.77827850e-03f,
  9.99999523e-01f, 9.99999931e-04f, 9.99999821e-01f, 5.62341243e-04f, 9.99999940e-01f, 3.16227757e-04f, 1.00000000e+00f, 1.77827940e-04f,
  -4.16146845e-01f, 9.09297407e-01f, 4.31462824e-01f, 9.02130723e-01f, 8.06578398e-01f, 5.91127098e-01f, 9.37418282e-01f, 3.48205268e-01f,
  9.80066597e-01f, 1.98669329e-01f, 9.93682086e-01f, 1.12231314e-01f, 9.98000681e-01f, 6.32033944e-02f, 9.99367595e-01f, 3.55580896e-02f,
  9.99800026e-01f, 1.99986659e-02f, 9.99936759e-01f, 1.12465890e-02f, 9.99979973e-01f, 6.32451288e-03f, 9.99993682e-01f, 3.55655141e-03f,
  9.99997973e-01f, 1.99999870e-03f, 9.99999344e-01f, 1.12468237e-03f, 9.99999821e-01f, 6.32455456e-04f, 9.99999940e-01f, 3.55655880e-04f,
  -9.89992499e-01f, 1.41120002e-01f, -1.15966164e-01f, 9.93253171e-01f, 5.82753658e-01f, 8.12648892e-01f, 8.61040652e-01f, 5.08536100e-01f,
  9.55336511e-01f, 2.95520216e-01f, 9.85803485e-01f, 1.67903304e-01f, 9.95503366e-01f, 9.47260857e-02f, 9.98577297e-01f, 5.33230826e-02f,
  9.99550045e-01f, 2.99954992e-02f, 9.99857724e-01f, 1.68694388e-02f, 9.99954998e-01f, 9.48669016e-03f, 9.99985754e-01f, 5.33481315e-03f,
  9.99995530e-01f, 2.99999560e-03f, 9.99998569e-01f, 1.68702309e-03f, 9.99999523e-01f, 9.48683126e-04f, 9.99999881e-01f, 5.33483806e-04f,
  -6.53643608e-01f, -7.56802499e-01f, -6.27679706e-01f, 7.78471708e-01f, 3.01137477e-01f, 9.53580737e-01f, 7.57506192e-01f, 6.52827978e-01f,
  9.21060979e-01f, 3.89418334e-01f, 9.74808276e-01f, 2.23044485e-01f, 9.92010653e-01f, 1.26154065e-01f, 9.97471273e-01f, 7.10712075e-02f,
  9.99200106e-01f, 3.99893336e-02f, 9.99747038e-01f, 2.24917568e-02f, 9.99920011e-01f, 1.26487734e-02f, 9.99974728e-01f, 7.11305765e-03f,
  9.99992013e-01f, 3.99998948e-03f, 9.99997497e-01f, 2.24936334e-03f, 9.99999225e-01f, 1.26491068e-03f, 9.99999762e-01f, 7.11311703e-04f,
  2.83662200e-01f, -9.58924294e-01f, -9.46079254e-01f, 3.23935270e-01f, -1.03423381e-02f, 9.99946535e-01f, 6.30080283e-01f, 7.76529968e-01f,
  8.77582550e-01f, 4.79425550e-01f, 9.60731268e-01f, 2.77480543e-01f, 9.87526000e-01f, 1.57455876e-01f, 9.96049762e-01f, 8.87968615e-02f,
  9.98750269e-01f, 4.99791652e-02f, 9.99604762e-01f, 2.81133614e-02f, 9.99875009e-01f, 1.58107281e-02f, 9.99960482e-01f, 8.89127981e-03f,
  9.99987483e-01f, 4.99997940e-03f, 9.99996066e-01f, 2.81170290e-03f, 9.99998748e-01f, 1.58113812e-03f, 9.99999583e-01f, 8.89139599e-04f,
  9.60170269e-01f, -2.79415488e-01f, -9.73103702e-01f, -2.30367512e-01f, -3.20796400e-01f, 9.47148204e-01f, 4.82782036e-01f, 8.75740528e-01f,
  8.25335622e-01f, 5.64642489e-01f, 9.43616986e-01f, 3.31039310e-01f, 9.82053936e-01f, 1.88600272e-01f, 9.94313300e-01f, 1.06494442e-01f,
  9.98200536e-01f, 5.99640049e-02f, 9.99430835e-01f, 3.37340795e-02f, 9.99819994e-01f, 1.89725272e-02f, 9.99943078e-01f, 1.06694745e-02f,
  9.99981999e-01f, 5.99996420e-03f, 9.99994338e-01f, 3.37404152e-03f, 9.99998212e-01f, 1.89736532e-03f, 9.99999404e-01f, 1.06696738e-03f,
  7.53902256e-01f, 6.56986594e-01f, -7.00429797e-01f, -7.13721275e-01f, -5.99437475e-01f, 8.00421596e-01f, 3.20257008e-01f, 9.47330713e-01f,
  7.64842212e-01f, 6.44217670e-01f, 9.23519433e-01f, 3.83551568e-01f, 9.75599885e-01f, 2.19556093e-01f, 9.92262423e-01f, 1.24158338e-01f,
  9.97551024e-01f, 6.99428469e-02f, 9.99225318e-01f, 3.93537246e-02f, 9.99755025e-01f, 2.21341345e-02f, 9.99922514e-01f, 1.24476347e-02f,
  9.99975502e-01f, 6.99994294e-03f, 9.99992251e-01f, 3.93637875e-03f, 9.99997556e-01f, 2.21359241e-03f, 9.99999225e-01f, 1.24479528e-03f,
  -1.45500034e-01f, 9.89358246e-01f, -2.12036446e-01f, -9.77261782e-01f, -8.18632424e-01f, 5.74317753e-01f, 1.47631213e-01f, 9.89042461e-01f,
  6.96706712e-01f, 7.17356086e-01f, 9.00502324e-01f, 4.34851229e-01f, 9.68170285e-01f, 2.50292331e-01f, 9.89897788e-01f, 1.41782969e-01f,
  9.96801734e-01f, 7.99146891e-02f, 9.98988271e-01f, 4.49721329e-02f, 9.99680042e-01f, 2.52955221e-02f, 9.99898791e-01f, 1.42257558e-02f,
  9.99967992e-01f, 7.99991470e-03f, 9.99989867e-01f, 4.49871505e-03f, 9.99996781e-01f, 2.52981926e-03f, 9.99998987e-01f, 1.42262306e-03f,
  -9.11130250e-01f, 4.12118495e-01f, 3.41660261e-01f, -9.39823508e-01f, -9.56644177e-01f, 2.91259229e-01f, -2.96507962e-02f, 9.99560297e-01f,
  6.21609926e-01f, 7.83326924e-01f, 8.74638259e-01f, 4.84776139e-01f, 9.59772646e-01f, 2.80778319e-01f, 9.87220109e-01f, 1.59362778e-01f,
  9.95952725e-01f, 8.98785442e-02f, 9.98719573e-01f, 5.05891182e-02f, 9.99595046e-01f, 2.84566563e-02f, 9.99871910e-01f, 1.60038304e-02f,
  9.99959528e-01f, 8.99987947e-03f, 9.99987185e-01f, 5.06105041e-03f, 9.99995947e-01f, 2.84604589e-03f, 9.99998748e-01f, 1.60045072e-03f,
  -8.39071512e-01f, -5.44021130e-01f, 7.90131867e-01f, -6.12936914e-01f, -9.99786079e-01f, -2.06835698e-02f, -2.05997631e-01f, 9.78552461e-01f,
  5.40302277e-01f, 8.41470957e-01f, 8.46009135e-01f, 5.33168435e-01f, 9.50415313e-01f, 3.10983568e-01f, 9.84230220e-01f, 1.76892191e-01f,
  9.95004177e-01f, 9.98334140e-02f, 9.98419285e-01f, 5.62044978e-02f, 9.99500036e-01f, 3.16175036e-02f, 9.99841869e-01f, 1.77818574e-02f,
  9.99949992e-01f, 9.99983400e-03f, 9.99984205e-01f, 5.62338345e-03f, 9.99994993e-01f, 3.16227227e-03f, 9.99998391e-01f, 1.77827850e-03f,
  4.42569796e-03f, -9.99990225e-01f, 9.95257378e-01f, -9.72764567e-02f, -9.43779767e-01f, -3.30574960e-01f, -3.75847399e-01f, 9.26681578e-01f,
  4.53596085e-01f, 8.91207397e-01f, 8.14705312e-01f, 5.79875171e-01f, 9.40107584e-01f, 3.40877861e-01f, 9.80929136e-01f, 1.94365650e-01f,
  9.93956089e-01f, 1.09778300e-01f, 9.98087406e-01f, 6.18181042e-02f, 9.99395072e-01f, 3.47780399e-02f, 9.99808669e-01f, 1.95598267e-02f,
  9.99939501e-01f, 1.09997792e-02f, 9.99980867e-01f, 6.18571462e-03f, 9.99993920e-01f, 3.47849843e-03f, 9.99998093e-01f, 1.95610616e-03f,
  8.43853951e-01f, -5.36572933e-01f, 8.93861592e-01f, 4.48342979e-01f, -7.94179380e-01f, -6.07683420e-01f, -5.33843040e-01f, 8.45583618e-01f,
  3.62357706e-01f, 9.32039082e-01f, 7.80825913e-01f, 6.24748647e-01f, 9.28859890e-01f, 3.70431304e-01f, 9.77317870e-01f, 2.11777672e-01f,
  9.92808640e-01f, 1.19712204e-01f, 9.97723997e-01f, 6.74297586e-02f, 9.99280095e-01f, 3.79382223e-02f, 9.99772310e-01f, 2.13377345e-02f,
  9.99927998e-01f, 1.19997123e-02f, 9.99977231e-01f, 6.74804440e-03f, 9.99992788e-01f, 3.79472389e-03f, 9.99997735e-01f, 2.13393359e-03f,
  9.07446802e-01f, 4.20167029e-01f, 5.17172873e-01f, 8.55880976e-01f, -5.65820515e-01f, -8.24528456e-01f, -6.75001681e-01f, 7.37816215e-01f,
  2.67498761e-01f, 9.63558197e-01f, 7.44477987e-01f, 6.67647004e-01f, 9.16683376e-01f, 3.99614304e-01f, 9.73397553e-01f, 2.29122713e-01f,
  9.91561890e-01f, 1.29634142e-01f, 9.97329056e-01f, 7.30392784e-02f, 9.99155104e-01f, 4.10980321e-02f, 9.99732792e-01f, 2.31155735e-02f,
  9.99915481e-01f, 1.29996343e-02f, 9.99973297e-01f, 7.31037185e-03f, 9.99991536e-01f, 4.11094911e-03f, 9.99997318e-01f, 2.31176103e-03f,
  1.36737213e-01f, 9.90607381e-01f, -1.87961515e-02f, 9.99823332e-01f, -2.81349480e-01f, -9.59605396e-01f, -7.94870913e-01f, 6.06778562e-01f,
  1.69967160e-01f, 9.85449731e-01f, 7.05776393e-01f, 7.08434701e-01f, 9.03590262e-01f, 4.28397775e-01f, 9.69169438e-01f, 2.46395305e-01f,
  9.90216017e-01f, 1.39543116e-01f, 9.96902585e-01f, 7.86464810e-02f, 9.99020159e-01f, 4.42574248e-02f, 9.99690115e-01f, 2.48933397e-02f,
  9.99902010e-01f, 1.39995432e-02f, 9.99969006e-01f, 7.87269697e-03f, 9.99990225e-01f, 4.42717411e-03f, 9.99996901e-01f, 2.48958869e-03f,
  -7.59687901e-01f, 6.50287867e-01f, -5.48975468e-01f, 8.35838437e-01f, 3.10223512e-02f, -9.99518692e-01f, -8.89670432e-01f, 4.56603259e-01f,
  7.07371980e-02f, 9.97494996e-01f, 6.64843500e-01f, 7.46982634e-01f, 8.89593601e-01f, 4.56752867e-01f, 9.64634836e-01f, 2.63589978e-01f,
  9.88771081e-01f, 1.49438128e-01f, 9.96444523e-01f, 8.42512026e-02f, 9.98875201e-01f, 4.74163815e-02f, 9.99644279e-01f, 2.66710296e-02f,
  9.99887526e-01f, 1.49994381e-02f, 9.99964416e-01f, 8.43502022e-03f, 9.99988735e-01f, 4.74339863e-03f, 9.99996424e-01f, 2.66741589e-03f,
  -9.57659483e-01f, -2.87903309e-01f, -9.10081089e-01f, 4.14430231e-01f, 3.40318173e-01f, -9.40310359e-01f, -9.56410050e-01f, 2.92027086e-01f,
  -2.91995462e-02f, 9.99573588e-01f, 6.21808827e-01f, 7.83169091e-01f, 8.74707460e-01f, 4.84651238e-01f, 9.59795177e-01f, 2.80701309e-01f,
  9.87227261e-01f, 1.59318209e-01f, 9.95954990e-01f, 8.98532644e-02f, 9.98720288e-01f, 5.05748577e-02f, 9.99595284e-01f, 2.84486320e-02f,
  9.99872029e-01f, 1.59993190e-02f, 9.99959528e-01f, 8.99733976e-03f, 9.99987185e-01f, 5.05962269e-03f, 9.99995947e-01f, 2.84524332e-03f,
  -2.75163352e-01f, -9.61397469e-01f, -9.90897954e-01f, -1.34615138e-01f, 6.15864813e-01f, -7.87851870e-01f, -9.92985010e-01f, 1.18240520e-01f,
  -1.28844544e-01f, 9.91664827e-01f, 5.76808274e-01f, 8.16879570e-01f, 8.58946681e-01f, 5.12064993e-01f, 9.54652011e-01f, 2.97723860e-01f,
  9.85584795e-01f, 1.69182345e-01f, 9.95433986e-01f, 9.54524800e-02f, 9.98555362e-01f, 5.37328273e-02f, 9.99543071e-01f, 3.02261449e-02f,
  9.99855518e-01f, 1.69991814e-02f, 9.99954283e-01f, 9.55965649e-03f, 9.99985576e-01f, 5.37584582e-03f, 9.99995410e-01f, 3.02307028e-03f,
  6.60316706e-01f, -7.50987232e-01f, -7.66536534e-01f, -6.42200708e-01f, 8.30336154e-01f, -5.57262897e-01f, -9.98241663e-01f, -5.92755191e-02f,
  -2.27202162e-01f, 9.73847628e-01f, 5.29984176e-01f, 8.48007560e-01f, 8.42327058e-01f, 5.38966715e-01f, 9.49207008e-01f, 3.14652264e-01f,
  9.83843684e-01f, 1.79029569e-01f, 9.94881511e-01f, 1.01048686e-01f, 9.98380423e-01f, 5.68902642e-02f, 9.99487758e-01f, 3.20035629e-02f,
  9.99837995e-01f, 1.79990288e-02f, 9.99948800e-01f, 1.01219704e-02f, 9.99983788e-01f, 5.69206895e-03f, 9.99994874e-01f, 3.20089748e-03f,
  9.88704622e-01f, 1.49877205e-01f, -3.06095392e-01f, -9.52000856e-01f, 9.62463796e-01f, -2.71410108e-01f, -9.72014248e-01f, -2.34921798e-01f,
  -3.23289543e-01f, 9.46300089e-01f, 4.81484592e-01f, 8.76454532e-01f, 8.24865162e-01f, 5.65329552e-01f, 9.43461835e-01f, 3.31481189e-01f,
  9.82004225e-01f, 1.88858896e-01f, 9.94297504e-01f, 1.06641680e-01f, 9.98195529e-01f, 6.00471310e-02f, 9.99429286e-01f, 3.37808803e-02f,
  9.99819517e-01f, 1.89988576e-02f, 9.99942899e-01f, 1.06842816e-02f, 9.99981940e-01f, 6.00829115e-03f, 9.99994278e-01f, 3.37872445e-03f,
  4.08082068e-01f, 9.12945271e-01f, 2.48616725e-01f, -9.68601942e-01f, 9.99144375e-01f, 4.13582884e-02f, -9.15129960e-01f, -4.03158993e-01f,
  -4.16146845e-01f, 9.09297407e-01f, 4.31462824e-01f, 9.02130723e-01f, 8.06578457e-01f, 5.91127038e-01f, 9.37418282e-01f, 3.48205268e-01f,
  9.80066597e-01f, 1.98669314e-01f, 9.93682086e-01f, 1.12231314e-01f, 9.98000681e-01f, 6.32033944e-02f, 9.99367595e-01f, 3.55580896e-02f,
  9.99800026e-01f, 1.99986678e-02f, 9.99936759e-01f, 1.12465890e-02f, 9.99979973e-01f, 6.32451288e-03f, 9.99993682e-01f, 3.55655141e-03f,
  -5.47729254e-01f, 8.36655617e-01f, 7.26760268e-01f, -6.86891198e-01f, 9.36740458e-01f, 3.50024760e-01f, -8.29382956e-01f, -5.58680534e-01f,
  -5.04846215e-01f, 8.63209307e-01f, 3.80077004e-01f, 9.24954832e-01f, 7.87485182e-01f, 6.16333544e-01f, 9.31078374e-01f, 3.64819258e-01f,
  9.78030920e-01f, 2.08459899e-01f, 9.93035257e-01f, 1.17817394e-01f, 9.97795820e-01f, 6.63590282e-02f, 9.99302804e-01f, 3.73351872e-02f,
  9.99779522e-01f, 2.09984574e-02f, 9.99930263e-01f, 1.18088927e-02f, 9.99977946e-01f, 6.64073415e-03f, 9.99993026e-01f, 3.73437814e-03f,
  -9.99960840e-01f, -8.85130931e-03f, 9.81074572e-01f, -1.93630233e-01f, 7.81440377e-01f, 6.23979926e-01f, -7.17477441e-01f, -6.96581721e-01f,
  -5.88501155e-01f, 8.08496356e-01f, 3.27489585e-01f, 9.44854796e-01f, 7.67604589e-01f, 6.40923738e-01f, 9.24443960e-01f, 3.81317884e-01f,
  9.75897431e-01f, 2.18229622e-01f, 9.92357016e-01f, 1.23399742e-01f, 9.97581005e-01f, 6.95140064e-02f, 9.99234855e-01f, 3.91121693e-02f,
  9.99758005e-01f, 2.19982266e-02f, 9.99923468e-01f, 1.23711927e-02f, 9.99975801e-01f, 6.95695449e-03f, 9.99992371e-01f, 3.91220488e-03f,
  -5.32833040e-01f, -8.46220434e-01f, 9.33235765e-01f, 3.59264523e-01f, 5.48645258e-01f, 8.36055279e-01f, -5.82943261e-01f, -8.12512875e-01f,
  -6.66275978e-01f, 7.45705247e-01f, 2.73866832e-01f, 9.61767614e-01f, 7.46956408e-01f, 6.64873064e-01f, 9.17517304e-01f, 3.97695929e-01f,
  9.73666370e-01f, 2.27977514e-01f, 9.91647422e-01f, 1.28978193e-01f, 9.97356176e-01f, 7.26682767e-02f, 9.99163687e-01f, 4.08890247e-02f,
  9.99735534e-01f, 2.29979735e-02f, 9.99916375e-01f, 1.29334899e-02f, 9.99973536e-01f, 7.27317436e-03f, 9.99991655e-01f, 4.09003161e-03f,
  4.24179018e-01f, -9.05578375e-01f, 5.97977161e-01f, 8.01513135e-01f, 2.61441678e-01f, 9.65219259e-01f, -4.30023283e-01f, -9.02817786e-01f,
  -7.37393796e-01f, 6.75463140e-01f, 2.19378278e-01f, 9.75639880e-01f, 7.25561321e-01f, 6.88157499e-01f, 9.10300434e-01f, 4.13948208e-01f,
  9.71337974e-01f, 2.37702623e-01f, 9.90906477e-01f, 1.34552568e-01f, 9.97121394e-01f, 7.58218244e-02f, 9.99089420e-01f, 4.26657498e-02f,
  9.99711990e-01f, 2.39976961e-02f, 9.99908924e-01f, 1.34957815e-02f, 9.99971211e-01f, 7.58939330e-03f, 9.99990880e-01f, 4.26785741e-03f,
  9.91202831e-01f, -1.32351756e-01f, 7.85522610e-02f, 9.96909976e-01f, -5.16893305e-02f, 9.98663187e-01f, -2.63540596e-01f, -9.64648306e-01f,
  -8.01143587e-01f, 5.98472118e-01f, 1.64196163e-01f, 9.86427724e-01f, 7.03440726e-01f, 7.10753918e-01f, 9.02795732e-01f, 4.30069596e-01f,
  9.68912423e-01f, 2.47403964e-01f, 9.90134120e-01f, 1.40122697e-01f, 9.96876657e-01f, 7.89746121e-02f, 9.99011934e-01f, 4.44423407e-02f,
  9.99687493e-01f, 2.49973964e-02f, 9.99901175e-01f, 1.40580693e-02f, 9.99968767e-01f, 7.90561177e-03f, 9.99990106e-01f, 4.44568414e-03f,
  6.46919310e-01f, 7.62558460e-01f, -4.65064496e-01f, 8.85276794e-01f, -3.59694332e-01f, 9.33070183e-01f, -8.87455046e-02f, -9.96054351e-01f,
  -8.56888831e-01f, 5.15501261e-01f, 1.08494945e-01f, 9.94096994e-01f, 6.80616796e-01f, 7.32639611e-01f, 8.95005584e-01f, 4.46054995e-01f,
  9.66389954e-01f, 2.57080555e-01f, 9.89330530e-01f, 1.45688385e-01f, 9.96621907e-01f, 8.21266174e-02f, 9.98931348e-01f, 4.62187938e-02f,
  9.99662042e-01f, 2.59970706e-02f, 9.99893129e-01f, 1.46203535e-02f, 9.99966204e-01f, 8.22182931e-03f, 9.99989331e-01f, 4.62350994e-03f,
  -2.92138815e-01f, 9.56375957e-01f, -8.65450621e-01f, 5.00994205e-01f, -6.32028639e-01f, 7.74945021e-01f, 8.88481140e-02f, -9.96045172e-01f,
  -9.04072165e-01f, 4.27379847e-01f, 5.24506159e-02f, 9.98623490e-01f, 6.57112300e-01f, 7.53792703e-01f, 8.86932373e-01f, 4.61899310e-01f,
  9.63770926e-01f, 2.66731411e-01f, 9.88495648e-01f, 1.51249468e-01f, 9.96357203e-01f, 8.52777958e-02f, 9.98847544e-01f, 4.79951017e-02f,
  9.99635518e-01f, 2.69967206e-02f, 9.99884725e-01f, 1.51826320e-02f, 9.99963522e-01f, 8.53804592e-03f, 9.99988496e-01f, 4.80133574e-03f,
  -9.62605894e-01f, 2.70905793e-01f, -9.99293387e-01f, -3.75856608e-02f, -8.41684937e-01f, 5.39968967e-01f, 2.63639510e-01f, -9.64621305e-01f,
  -9.42222297e-01f, 3.34988207e-01f, -3.75941908e-03f, 9.99992907e-01f, 6.32950664e-01f, 7.74192095e-01f, 8.78578722e-01f, 4.77597594e-01f,
  9.61055458e-01f, 2.76355654e-01f, 9.87629473e-01f, 1.56805754e-01f, 9.96082544e-01f, 8.84281173e-02f, 9.98760641e-01f, 4.97712530e-02f,
  9.99608040e-01f, 2.79963426e-02f, 9.99876022e-01f, 1.57449059e-02f, 9.99960780e-01f, 8.85426160e-03f, 9.99987602e-01f, 4.97916201e-03f,
  -7.48057544e-01f, -6.63633883e-01f, -8.25371623e-01f, -5.64589798e-01f, -9.67871487e-01f, 2.51445323e-01f, 4.30115849e-01f, -9.02773678e-01f,
  -9.70958173e-01f, 2.39249229e-01f, -5.99575676e-02f, 9.98200953e-01f, 6.08156204e-01f, 7.93817401e-01f, 8.69947195e-01f, 4.93144840e-01f,
  9.58243906e-01f, 2.85952210e-01f, 9.86732066e-01f, 1.62357092e-01f, 9.95797932e-01f, 9.15775672e-02f, 9.98670578e-01f, 5.15472479e-02f,
  9.99579549e-01f, 2.89959367e-02f, 9.99867022e-01f, 1.63071752e-02f, 9.99957979e-01f, 9.17047635e-03f, 9.99986708e-01f, 5.15698735e-03f,
  1.54251456e-01f, -9.88031626e-01f, -3.97251874e-01f, -9.17709649e-01f, -9.98075247e-01f, -6.20148405e-02f, 5.83026946e-01f, -8.12452853e-01f,
  -9.89992499e-01f, 1.41120002e-01f, -1.15966164e-01f, 9.93253171e-01f, 5.82753658e-01f, 8.12648892e-01f, 8.61040652e-01f, 5.08536100e-01f,
  9.55336511e-01f, 2.95520186e-01f, 9.85803485e-01f, 1.67903304e-01f, 9.95503366e-01f, 9.47260931e-02f, 9.98577297e-01f, 5.33230826e-02f,
  9.99550045e-01f, 2.99955010e-02f, 9.99857724e-01f, 1.68694388e-02f, 9.99954998e-01f, 9.48669016e-03f, 9.99985754e-01f, 5.33481315e-03f,
  9.14742351e-01f, -4.04037654e-01f, 1.53215483e-01f, -9.88192797e-01f, -9.29300308e-01f, -3.69325012e-01f, 7.17549205e-01f, -6.96507812e-01f,
  -9.99135137e-01f, 4.15805206e-02f, -1.71608135e-01f, 9.85165298e-01f, 5.56768358e-01f, 8.30667794e-01f, 8.51861775e-01f, 5.23766637e-01f,
  9.52333570e-01f, 3.05058628e-01f, 9.84843671e-01f, 1.73444211e-01f, 9.95198846e-01f, 9.78736654e-02f, 9.98480916e-01f, 5.50987460e-02f,
  9.99519527e-01f, 3.09950355e-02f, 9.99848068e-01f, 1.74316969e-02f, 9.99951959e-01f, 9.80290305e-03f, 9.99984801e-01f, 5.51263802e-03f,
  8.34223390e-01f, 5.51426709e-01f, 6.56495154e-01f, -7.54330218e-01f, -7.68367112e-01f, -6.40009403e-01f, 8.29440355e-01f, -5.58595300e-01f,
  -9.98294771e-01f, -5.83741926e-02f, -2.26707578e-01f, 9.73962843e-01f, 5.30226350e-01f, 8.47856104e-01f, 8.42413545e-01f, 5.38831532e-01f,
  9.49235439e-01f, 3.14566553e-01f, 9.83852804e-01f, 1.78979620e-01f, 9.94884372e-01f, 1.01020269e-01f, 9.98381376e-01f, 5.68742342e-02f,
  9.99488056e-01f, 3.19945402e-02f, 9.99838114e-01f, 1.79939512e-02f, 9.99948800e-01f, 1.01191159e-02f, 9.99983788e-01f, 5.69046335e-03f,
  -1.32767474e-02f, 9.99911845e-01f, 9.57586050e-01f, -2.88147390e-01f, -5.31235278e-01f, -8.47224355e-01f, 9.15171385e-01f, -4.03064936e-01f,
  -9.87479806e-01f, -1.57745644e-01f, -2.81090319e-01f, 9.59681332e-01f, 5.03154159e-01f, 8.64196658e-01f, 8.32698941e-01f, 5.53726017e-01f,
  9.46042359e-01f, 3.24043006e-01f, 9.82830763e-01f, 1.84509367e-01f, 9.94559944e-01f, 1.04165860e-01f, 9.98278618e-01f, 5.86495437e-02f,
  9.99455571e-01f, 3.29940096e-02f, 9.99827802e-01f, 1.85561981e-02f, 9.99945521e-01f, 1.04353270e-02f, 9.99982774e-01f, 5.86828869e-03f,
  -8.48570287e-01f, 5.29082716e-01f, 9.63757515e-01f, 2.66779721e-01f, -2.41421118e-01f, -9.70420420e-01f, 9.72038329e-01f, -2.34822124e-01f,
  -9.66798186e-01f, -2.55541205e-01f, -3.34584385e-01f, 9.42365825e-01f, 4.75578904e-01f, 8.79673064e-01f, 8.22721004e-01f, 5.68445385e-01f,
  9.42754686e-01f, 3.33487093e-01f, 9.81777668e-01f, 1.90033287e-01f, 9.94225562e-01f, 1.07310407e-01f, 9.98172760e-01f, 6.04246669e-02f,
  9.99422073e-01f, 3.39934528e-02f, 9.99817252e-01f, 1.91184394e-02f, 9.99942183e-01f, 1.07515370e-02f, 9.99981701e-01f, 6.04611309e-03f,
  -9.03692186e-01f, -4.28182662e-01f, 6.73110247e-01f, 7.39542127e-01f, 7.23346695e-02f, -9.97380435e-01f, 9.98247743e-01f, -5.91726787e-02f,
  -9.36456680e-01f, -3.50783229e-01f, -3.87020677e-01f, 9.22071040e-01f, 4.47528064e-01f, 8.94269884e-01f, 8.12482953e-01f, 5.82984984e-01f,
  9.39372718e-01f, 3.42897803e-01f, 9.80693519e-01f, 1.95551202e-01f, 9.93881226e-01f, 1.10453881e-01f, 9.98063743e-01f, 6.21996038e-02f,
  9.99387562e-01f, 3.49928550e-02f, 9.99806345e-01f, 1.96806751e-02f, 9.99938726e-01f, 1.10677453e-02f, 9.99980628e-01f, 6.22393796e-03f,
  -1.27963692e-01f, -9.91778851e-01f, 1.75156534e-01f, 9.84540582e-01f, 3.78916174e-01f, -9.25431013e-01f, 9.92972851e-01f, 1.18342586e-01f,
  -8.96758378e-01f, -4.42520559e-01f, -4.38233554e-01f, 8.98861170e-01f, 4.19029742e-01f, 9.07972515e-01f, 8.01987886e-01f, 5.97340286e-01f,
  9.35896814e-01f, 3.52274209e-01f, 9.79578316e-01f, 2.01062918e-01f, 9.93526995e-01f, 1.13596253e-01f, 9.97951567e-01f, 6.39743358e-02f,
  9.99352098e-01f, 3.59922275e-02f, 9.99795079e-01f, 2.02429052e-02f, 9.99935210e-01f, 1.13839535e-02f, 9.99979496e-01f, 6.40176190e-03f,
  7.65414059e-01f, -6.43538117e-01f, -3.76742303e-01f, 9.26318109e-01f, 6.47921681e-01f, -7.61706948e-01f, 9.56380010e-01f, 2.92125374e-01f,
  -8.48100007e-01f, -5.29836178e-01f, -4.88060862e-01f, 8.72809589e-01f, 3.90112430e-01f, 9.20767248e-01f, 7.91239262e-01f, 6.11506701e-01f,
  9.32327330e-01f, 3.61615449e-01f, 9.78432178e-01f, 2.06568271e-01f, 9.93162811e-01f, 1.16737492e-01f, 9.97836173e-01f, 6.57488778e-02f,
  9.99315560e-01f, 3.69915590e-02f, 9.99783576e-01f, 2.08051261e-02f, 9.99931574e-01f, 1.17001599e-02f, 9.99978364e-01f, 6.57958630e-03f,
  9.55073655e-01f, 2.96368569e-01f, -8.12611222e-01f, 5.82806170e-01f, 8.52673113e-01f, -5.22444785e-01f, 8.89623463e-01f, 4.56694692e-01f,
  -7.90967762e-01f, -6.11857831e-01f, -5.36345184e-01f, 8.43998730e-01f, 3.60805035e-01f, 9.32641268e-01f, 7.80240417e-01f, 6.25479698e-01f,
  9.28664625e-01f, 3.70920479e-01f, 9.77255106e-01f, 2.12067112e-01f, 9.92788672e-01f, 1.19877554e-01f, 9.97717679e-01f, 6.75232038e-02f,
  9.99278069e-01f, 3.79908569e-02f, 9.99771714e-01f, 2.13673431e-02f, 9.99927819e-01f, 1.20163653e-02f, 9.99977171e-01f, 6.75741071e-03f,
  2.66642928e-01f, 9.63795364e-01f, -9.98210371e-01f, 5.98003156e-02f, 9.72865343e-01f, -2.31372014e-01f, 7.94808388e-01f, 6.06860459e-01f,
  -7.25932240e-01f, -6.87766254e-01f, -5.82933903e-01f, 8.12519610e-01f, 3.31136853e-01f, 9.43582714e-01f, 7.68994927e-01f, 6.39254928e-01f,
  9.24909055e-01f, 3.80188406e-01f, 9.76047099e-01f, 2.17559248e-01f, 9.92404640e-01f, 1.23016424e-01f, 9.97596025e-01f, 6.92973137e-02f,
  9.99239624e-01f, 3.89901139e-02f, 9.99759495e-01f, 2.19295528e-02f, 9.99923944e-01f, 1.23325698e-02f, 9.99975979e-01f, 6.93523418e-03f,
  -6.66938066e-01f, 7.45113134e-01f, -8.76379430e-01f, -4.81621295e-01f, 9.96578991e-01f, 8.26458037e-02f, 6.74925625e-01f, 7.37885714e-01f,
  -6.53643608e-01f, -7.56802499e-01f, -6.27679706e-01f, 7.78471708e-01f, 3.01137596e-01f, 9.53580678e-01f, 7.57506192e-01f, 6.52827978e-01f,
  9.21060979e-01f, 3.89418334e-01f, 9.74808276e-01f, 2.23044485e-01f, 9.92010653e-01f, 1.26154065e-01f, 9.97471273e-01f, 7.10712075e-02f,
  9.99200106e-01f, 3.99893373e-02f, 9.99747038e-01f, 2.24917568e-02f, 9.99920011e-01f, 1.26487734e-02f, 9.99974728e-01f, 7.11305765e-03f,
  -9.87339258e-01f, -1.58622667e-01f, -4.84639406e-01f, -8.74714017e-01f, 9.21462357e-01f, 3.88467699e-01f, 5.33756077e-01f, 8.45638454e-01f,
  -5.74824035e-01f, -8.18277061e-01f, -6.70441091e-01f, 7.41962790e-01f, 2.70837069e-01f, 9.62625206e-01f, 7.45777905e-01f, 6.66194677e-01f,
  9.17120814e-01f, 3.98609310e-01f, 9.73538578e-01f, 2.28522688e-01f, 9.91606772e-01f, 1.29290432e-01f, 9.97343302e-01f, 7.28448778e-02f,
  9.99159634e-01f, 4.09885161e-02f, 9.99734223e-01f, 2.30539497e-02f, 9.99915957e-01f, 1.29649751e-02f, 9.99973416e-01f, 7.29088066e-03f,
  -3.99985313e-01f, -9.16521549e-01f, 5.63609414e-02f, -9.98410463e-01f, 7.54965365e-01f, 6.55764699e-01f, 3.75752151e-01f, 9.26720202e-01f,
  -4.90260571e-01f, -8.71575892e-01f, -7.11082935e-01f, 7.03108132e-01f, 2.40265876e-01f, 9.70707119e-01f, 7.33813822e-01f, 6.79350674e-01f,
  9.13088918e-01f, 4.07760441e-01f, 9.72238123e-01f, 2.33993664e-01f, 9.91192937e-01f, 1.32425532e-01f, 9.97212172e-01f, 7.46183172e-02f,
  9.99118149e-01f, 4.19876575e-02f, 9.99721110e-01f, 2.36161388e-02f, 9.99911785e-01f, 1.32811759e-02f, 9.99972105e-01f, 7.46870413e-03f,
  5.55113316e-01f, -8.31774771e-01f, 5.80003142e-01f, -8.14614236e-01f, 5.13598442e-01f, 8.58030677e-01f, 2.05897167e-01f, 9.78573620e-01f,
  -4.00799006e-01f, -9.16166008e-01f, -7.49476731e-01f, 6.62030637e-01f, 2.09454417e-01f, 9.77818429e-01f, 7.21617639e-01f, 6.92291796e-01f,
  9.08965766e-01f, 4.16870773e-01f, 9.70906913e-01f, 2.39457220e-01f, 9.90769207e-01f, 1.35559291e-01f, 9.97077882e-01f, 7.63915181e-02f,
  9.99075651e-01f, 4.29867506e-02f, 9.99707639e-01f, 2.41783205e-02f, 9.99907553e-01f, 1.35973748e-02f, 9.99970794e-01f, 7.64652714e-03f,
  9.99843299e-01f, 1.77019257e-02f, 9.25014675e-01f, -3.79931390e-01f, 2.21298173e-01f, 9.75206196e-01f, 2.95478199e-02f, 9.99563396e-01f,
  -3.07332784e-01f, -9.51602101e-01f, -7.85501122e-01f, 6.18860185e-01f, 1.78433523e-01f, 9.83951986e-01f, 7.09193349e-01f, 7.05014050e-01f,
  9.04751658e-01f, 4.25939471e-01f, 9.69545007e-01f, 2.44913206e-01f, 9.90335584e-01f, 1.38691694e-01f, 9.96940494e-01f, 7.81644881e-02f,
  9.99032140e-01f, 4.39858064e-02f, 9.99693930e-01f, 2.47404929e-02f, 9.99903202e-01f, 1.39135728e-02f, 9.99969363e-01f, 7.82434922e-03f,
  5.25321960e-01f, 8.50903511e-01f, 9.85138178e-01f, 1.71763569e-01f, -9.29481089e-02f, 9.95670974e-01f, -1.47732988e-01f, 9.89027262e-01f,
  -2.10795805e-01f, -9.77530122e-01f, -8.19042206e-01f, 5.73733270e-01f, 1.47234216e-01f, 9.89101648e-01f, 6.96544766e-01f, 7.17513323e-01f,
  9.00447130e-01f, 4.34965521e-01f, 9.68152404e-01f, 2.50361472e-01f, 9.89892066e-01f, 1.41822711e-01f, 9.96799886e-01f, 7.99371973e-02f,
  9.98987675e-01f, 4.49848175e-02f, 9.99679863e-01f, 2.53026579e-02f, 9.99898732e-01f, 1.42297689e-02f, 9.99967992e-01f, 8.00217129e-03f,
  -4.32177931e-01f, 9.01788354e-01f, 7.41858006e-01f, 6.70557022e-01f, -3.97976756e-01f, 9.17395473e-01f, -3.20354372e-01f, 9.47297752e-01f,
  -1.12152621e-01f, -9.93690968e-01f, -8.49993885e-01f, 5.26792526e-01f, 1.15887694e-01f, 9.93262351e-01f, 6.83675885e-01f, 7.29785740e-01f,
  8.96052480e-01f, 4.43948090e-01f, 9.66729224e-01f, 2.55801797e-01f, 9.89438653e-01f, 1.44952312e-01f, 9.96656179e-01f, 8.17096606e-02f,
  9.98942196e-01f, 4.59837839e-02f, 9.99665439e-01f, 2.58648153e-02f, 9.99894202e-01f, 1.45459641e-02f, 9.99966562e-01f, 8.17999430e-03f,
  -9.92335498e-01f, 1.23573124e-01f, 2.70098448e-01f, 9.62832689e-01f, -6.63538277e-01f, 7.48142362e-01f, -4.82871950e-01f, 8.75690997e-01f,
  -1.23883775e-02f, -9.99923289e-01f, -8.78258407e-01f, 4.78186339e-01f, 8.44252855e-02f, 9.96429801e-01f, 6.70590878e-01f, 7.41827428e-01f,
  8.91568303e-01f, 4.52886283e-01f, 9.65275466e-01f, 2.61234075e-01f, 9.88975346e-01f, 1.48080453e-01f, 9.96509314e-01f, 8.34818557e-02f,
  9.98895705e-01f, 4.69827019e-02f, 9.99650776e-01f, 2.64269635e-02f, 9.99889553e-01f, 1.48621574e-02f, 9.99965072e-01f, 8.35781638e-03f,
  -6.40144348e-01f, -7.68254638e-01f, -2.84846604e-01f, 9.58573103e-01f, -8.63296509e-01f, 5.04697084e-01f, -6.30159974e-01f, 7.76465356e-01f,
  8.74991715e-02f, -9.96164620e-01f, -9.03746367e-01f, 4.28068399e-01f, 5.28784581e-02f, 9.98600960e-01f, 6.57293737e-01f, 7.53634512e-01f,
  8.86994898e-01f, 4.61779177e-01f, 9.63791192e-01f, 2.66658038e-01f, 9.88502085e-01f, 1.51207119e-01f, 9.96359289e-01f, 8.52537975e-02f,
  9.98848200e-01f, 4.79815714e-02f, 9.99635756e-01f, 2.69891042e-02f, 9.99884784e-01f, 1.51783489e-02f, 9.99963582e-01f, 8.53563752e-03f,
  3.00592542e-01f, -9.53752637e-01f, -7.52063990e-01f, 6.59090102e-01f, -9.77442741e-01f, 2.11200655e-01f, -7.57573068e-01f, 6.52750373e-01f,
  1.86512470e-01f, -9.82452571e-01f, -9.26377118e-01f, 3.76597136e-01f, 2.12787576e-02f, 9.99773562e-01f, 6.43788815e-01f, 7.65203178e-01f,
  8.82332861e-01f, 4.70625877e-01f, 9.62276459e-01f, 2.72073567e-01f, 9.88018990e-01f, 1.54332280e-01f, 9.96206105e-01f, 8.70254710e-02f,
  9.98799741e-01f, 4.89803962e-02f, 9.99620378e-01f, 2.75512375e-02f, 9.99879956e-01f, 1.54945394e-02f, 9.99962032e-01f, 8.71345960e-03f,
  9.64965999e-01f, -2.62374848e-01f, -9.87659097e-01f, 1.56619072e-01f, -9.94656444e-01f, -1.03240460e-01f, -8.61092687e-01f, 5.08447945e-01f,
  2.83662200e-01f, -9.58924294e-01f, -9.46079254e-01f, 3.23935270e-01f, -1.03422189e-02f, 9.99946535e-01f, 6.30080283e-01f, 7.76529968e-01f,
  8.77582550e-01f, 4.79425550e-01f, 9.60731268e-01f, 2.77480543e-01f, 9.87526000e-01f, 1.57455891e-01f, 9.96049762e-01f, 8.87968615e-02f,
  9.98750269e-01f, 4.99791689e-02f, 9.99604762e-01f, 2.81133596e-02f, 9.99875009e-01f, 1.58107281e-02f, 9.99960482e-01f, 8.89127981e-03f,
  7.42154181e-01f, 6.70229197e-01f, -9.19073522e-01f, -3.94086063e-01f, -9.13230121e-01f, -4.07444149e-01f, -9.37454224e-01f, 3.48108500e-01f,
  3.77977669e-01f, -9.25814748e-01f, -9.62790370e-01f, 2.70249337e-01f, -4.19528559e-02f, 9.99119580e-01f, 6.16172493e-01f, 7.87611187e-01f,
  8.72744501e-01f, 4.88177240e-01f, 9.59155679e-01f, 2.82878697e-01f, 9.87023175e-01f, 1.60577938e-01f, 9.95890260e-01f, 9.05679762e-02f,
  9.98699784e-01f, 5.09778969e-02f, 9.99588788e-01f, 2.86754742e-02f, 9.99869943e-01f, 1.61269177e-02f, 9.99958873e-01f, 9.06910095e-03f,
  -1.62990779e-01f, 9.86627579e-01f, -5.67430019e-01f, -8.23421597e-01f, -7.41239965e-01f, -6.71240151e-01f, -9.84248459e-01f, 1.76790684e-01f,
  4.68516916e-01f, -8.83454502e-01f, -9.76457715e-01f, 2.15709001e-01f, -7.35215396e-02f, 9.97293651e-01f, 6.02069914e-01f, 7.98443377e-01f,
  8.67819190e-01f, 4.96880114e-01f, 9.57549810e-01f, 2.88267940e-01f, 9.86510456e-01f, 1.63698375e-01f, 9.95727658e-01f, 9.23388004e-02f,
  9.98648286e-01f, 5.19765690e-02f, 9.99572515e-01f, 2.92375814e-02f, 9.99864817e-01f, 1.64431017e-02f, 9.99957263e-01f, 9.24692024e-03f,
  -9.18282807e-01f, 3.95925164e-01f, -4.10281904e-02f, -9.99157965e-01f, -4.95741814e-01f, -8.68469954e-01f, -1.00000000e+00f, -1.03020677e-04f,
  5.54374516e-01f, -8.32267344e-01f, -9.87038016e-01f, 1.60486728e-01f, -1.05016708e-01f, 9.94470477e-01f, 5.87776959e-01f, 8.09023023e-01f,
  8.62807095e-01f, 5.05533338e-01f, 9.55913603e-01f, 2.93648034e-01f, 9.85987842e-01f, 1.66817173e-01f, 9.95561838e-01f, 9.41093415e-02f,
  9.98595834e-01f, 5.29751927e-02f, 9.99555886e-01f, 2.97996756e-02f, 9.99859571e-01f, 1.67592876e-02f, 9.99955595e-01f, 9.42474138e-03f,
  -8.29309821e-01f, -5.58789074e-01f, 4.98009592e-01f, -8.67171526e-01f, -2.01079622e-01f, -9.79574919e-01f, -9.84212041e-01f, -1.76993474e-01f,
  6.34692967e-01f, -7.72764444e-01f, -9.94497895e-01f, 1.04756832e-01f, -1.36406869e-01f, 9.90652919e-01f, 5.73298037e-01f, 8.19346905e-01f,
  8.57708693e-01f, 5.14135957e-01f, 9.54247177e-01f, 2.99018890e-01f, 9.85455394e-01f, 1.69934288e-01f, 9.95392919e-01f, 9.58795771e-02f,
  9.98542368e-01f, 5.39737605e-02f, 9.99538958e-01f, 3.03617641e-02f, 9.99854207e-01f, 1.70754679e-02f, 9.99953866e-01f, 9.60256159e-03f,
  2.21267566e-02f, -9.99755144e-01f, 8.83669317e-01f, -4.68111664e-01f, 1.13521777e-01f, -9.93535519e-01f, -9.37382519e-01f, -3.48301649e-01f,
  7.08669782e-01f, -7.05540299e-01f, -9.98813629e-01f, 4.86960001e-02f, -1.67660639e-01f, 9.85844791e-01f, 5.58637917e-01f, 8.29411685e-01f,
  8.52524519e-01f, 5.22687256e-01f, 9.52550590e-01f, 3.04380238e-01f, 9.84913111e-01f, 1.73049718e-01f, 9.95220840e-01f, 9.76495072e-02f,
  9.98487890e-01f, 5.49722798e-02f, 9.99521732e-01f, 3.09238415e-02f, 9.99848783e-01f, 1.73916500e-02f, 9.99952197e-01f, 9.78038087e-03f,
  8.53220105e-01f, -5.21551013e-01f, 9.97174621e-01f, 7.51182064e-02f, 4.16867077e-01f, -9.08967435e-01f, -8.60988438e-01f, -5.08624554e-01f,
  7.75565803e-01f, -6.31266713e-01f, -9.99971747e-01f, -7.51878507e-03f, -1.98746875e-01f, 9.80050862e-01f, 5.43801069e-01f, 8.39214146e-01f,
  8.47255111e-01f, 5.31186223e-01f, 9.50823903e-01f, 3.09731960e-01f, 9.84360933e-01f, 1.76163420e-01f, 9.95045662e-01f, 9.94191393e-02f,
  9.98432398e-01f, 5.59707358e-02f, 9.99504209e-01f, 3.14859077e-02f, 9.99843180e-01f, 1.77078284e-02f, 9.99950409e-01f, 9.95820016e-03f,
  8.99866819e-01f, 4.36164767e-01f, 8.03569078e-01f, 5.95211506e-01f, 6.78870201e-01f, -7.34258294e-01f, -7.57439196e-01f, -6.52905703e-01f,
  8.34712923e-01f, -5.50685287e-01f, -9.97968495e-01f, -6.37097955e-02f, -2.29634270e-01f, 9.73276973e-01f, 5.28792322e-01f, 8.48751247e-01f,
  8.41901004e-01f, 5.39632022e-01f, 9.49067116e-01f, 3.15073937e-01f, 9.83798921e-01f, 1.79275364e-01f, 9.94867265e-01f, 1.01188451e-01f,
  9.98375952e-01f, 5.69691435e-02f, 9.99486327e-01f, 3.20479684e-02f, 9.99837577e-01f, 1.80240069e-02f, 9.99948621e-01f, 1.01360194e-02f,
  1.19180135e-01f, 9.92872655e-01f, 3.62476677e-01f, 9.31992829e-01f, 8.73550534e-01f, -4.86733496e-01f, -6.30000710e-01f, -7.76594579e-01f,
  8.85519624e-01f, -4.64602023e-01f, -9.92810190e-01f, -1.19699396e-01f, -2.60292053e-01f, 9.65529919e-01f, 5.13616323e-01f, 8.58020008e-01f,
  8.36462677e-01f, 5.48023939e-01f, 9.47280347e-01f, 3.20405900e-01f, 9.83227074e-01f, 1.82385504e-01f, 9.94685769e-01f, 1.02957435e-01f,
  9.98318493e-01f, 5.79674877e-02f, 9.99468148e-01f, 3.26100141e-02f, 9.99831796e-01f, 1.83401816e-02f, 9.99946833e-01f, 1.03138378e-02f,
  -7.71080196e-01f, 6.36738002e-01f, -1.90249100e-01f, 9.81735826e-01f, 9.81602073e-01f, -1.90938011e-01f, -4.82692331e-01f, -8.75790000e-01f,
  9.27478492e-01f, -3.73876572e-01f, -9.84513164e-01f, -1.75310582e-01f, -2.90689558e-01f, 9.56817448e-01f, 4.98277903e-01f, 8.67017388e-01f,
  8.30940723e-01f, 5.56361020e-01f, 9.45463598e-01f, 3.25727791e-01f, 9.82645452e-01f, 1.85493827e-01f, 9.94501114e-01f, 1.04726106e-01f,
  9.98260021e-01f, 5.89657798e-02f, 9.99449670e-01f, 3.31720486e-02f, 9.99825954e-01f, 1.86563563e-02f, 9.99944985e-01f, 1.04916561e-02f,
  -9.52412963e-01f, -3.04810613e-01f, -6.84381902e-01f, 7.29123712e-01f, 9.92308319e-01f, 1.23790950e-01f, -3.20159167e-01f, -9.47363734e-01f,
  9.60170269e-01f, -2.79415488e-01f, -9.73103702e-01f, -2.30367512e-01f, -3.20796400e-01f, 9.47148204e-01f, 4.82782036e-01f, 8.75740528e-01f,
  8.25335622e-01f, 5.64642429e-01f, 9.43616986e-01f, 3.31039310e-01f, 9.82053936e-01f, 1.88600287e-01f, 9.94313300e-01f, 1.06494442e-01f,
  9.98200536e-01f, 5.99640086e-02f, 9.99430835e-01f, 3.37340795e-02f, 9.99819994e-01f, 1.89725272e-02f, 9.99943078e-01f, 1.06694745e-02f,
  -2.58101642e-01f, -9.66117799e-01f, -9.67739642e-01f, 2.51952261e-01f, 9.04607594e-01f, 4.26245421e-01f, -1.47529200e-01f, -9.89057720e-01f,
  9.83268440e-01f, -1.82162598e-01f, -9.58617806e-01f, -2.84696162e-01f, -3.50582451e-01f, 9.36531842e-01f, 4.67133403e-01f, 8.84186864e-01f,
  8.19648027e-01f, 5.72867453e-01f, 9.41740453e-01f, 3.36340427e-01f, 9.81452644e-01f, 1.91704854e-01f, 9.94122326e-01f, 1.08262435e-01f,
  9.98140097e-01f, 6.09621815e-02f, 9.99411702e-01f, 3.42960916e-02f, 9.99813974e-01f, 1.92886982e-02f, 9.99941170e-01f, 1.08472919e-02f,
  6.73507154e-01f, -7.39180684e-01f, -9.53050017e-01f, -3.02812874e-01f, 7.27198064e-01f, 6.86427653e-01f, 2.97537707e-02f, -9.99557257e-01f,
  9.96542096e-01f, -8.30891207e-02f, -9.41101313e-01f, -3.38124752e-01f, -3.80017966e-01f, 9.24979091e-01f, 4.51337039e-01f, 8.92353535e-01f,
  8.13878477e-01f, 5.81035137e-01f, 9.39834237e-01f, 3.41630876e-01f, 9.80841517e-01f, 1.94807529e-01f, 9.93928254e-01f, 1.10030092e-01f,
  9.98078644e-01f, 6.19602874e-02f, 9.99392271e-01f, 3.48580964e-02f, 9.99807835e-01f, 1.96048655e-02f, 9.99939203e-01f, 1.10251084e-02f,
  9.85896587e-01f, 1.67355701e-01f, -6.44837022e-01f, -7.64320076e-01f, 4.77671444e-01f, 8.78538549e-01f, 2.06098333e-01f, -9.78531301e-01f,
  9.99858618e-01f, 1.68140903e-02f, -9.20609534e-01f, -3.90484393e-01f, -4.09073502e-01f, 9.12501454e-01f, 4.35397953e-01f, 9.00238097e-01f,
  8.08027506e-01f, 5.89144766e-01f, 9.37898219e-01f, 3.46910536e-01f, 9.80220556e-01f, 1.97908238e-01f, 9.93731022e-01f, 1.11797392e-01f,
  9.98016179e-01f, 6.29583374e-02f, 9.99372482e-01f, 3.54200937e-02f, 9.99801576e-01f, 1.99210308e-02f, 9.99937236e-01f, 1.12029258e-02f,
};

constexpr int T_ALL = 36864, T_CTX = 4096;
constexpr int NLAYER = 4;
constexpr float EPS = 1e-6f;
constexpr int LK_LAT = 4352;

struct Params {
  const float* x_prompt; const float* x_sample; const float* cache_ckv; const float* cache_krope;
  const float* cache_k; const float* cache_v; const float* state; const float* c; const float* c_ctx;
  const float* w_mod; const float* b_mod; const float* g_norm; const float* w_in; const float* conv_w; const float* conv_b;
  const float* lru_wa; const float* lru_ba; const float* lru_wi; const float* lru_bi; const float* lru_lam;
  const float* q_norm; const float* w_uq; const float* kv_norm; const float* w_ukv; const float* sink;
  const float* w_br_rnn; const float* w_br_mla; const float* w_br_swa; const float* w_out; const float* final_norm;
  float* out; char* ws;
};

constexpr size_t AL(size_t x) { return (x + 255) & ~(size_t)255; }
constexpr size_t O_WINA = 0;
constexpr size_t O_WINB = O_WINA + AL((size_t)2560 * 1024 * 2);
constexpr size_t O_WLRU = O_WINB + AL((size_t)5120 * 1024 * 2);
constexpr size_t O_WUQ = O_WLRU + AL((size_t)4096 * 128 * 2);
constexpr size_t O_WUKVG = O_WUQ + AL((size_t)768 * 384 * 2);
constexpr size_t O_WUKVR = O_WUKVG + AL((size_t)1024 * 256 * 2);
constexpr size_t O_WBRR = O_WUKVR + AL((size_t)1024 * 256 * 2);
constexpr size_t O_WBRM = O_WBRR + AL((size_t)1024 * 1024 * 2);
constexpr size_t O_WBRS = O_WBRM + AL((size_t)1024 * 512 * 2);
constexpr size_t O_WOUT = O_WBRS + AL((size_t)1024 * 512 * 2);
constexpr size_t O_MOD = O_WOUT + AL((size_t)1024 * 1024 * 2);
constexpr size_t O_H = O_MOD + AL((size_t)4 * 9 * 3072 * 4);
constexpr size_t O_XR = O_H + AL((size_t)T_ALL * 1024 * 2);
constexpr size_t O_CQ = O_XR + AL((size_t)T_ALL * 1024 * 2);
constexpr size_t O_CKV = O_CQ + AL((size_t)T_ALL * 384 * 2);
constexpr size_t O_CKVC = O_CKV + AL((size_t)T_ALL * 256 * 2);
constexpr size_t O_KRL = O_CKVC + AL((size_t)2048 * 256 * 2);
constexpr size_t O_KRC = O_KRL + AL((size_t)8 * LK_LAT * 32 * 2);
constexpr size_t O_QS = O_KRC + AL((size_t)16 * 256 * 32 * 2);
constexpr size_t O_KS = O_QS + AL((size_t)T_ALL * 512 * 2);
constexpr size_t O_KSC = O_KS + AL((size_t)T_ALL * 128 * 2);
constexpr size_t O_VTSL = O_KSC + AL((size_t)8 * 256 * 128 * 2);
constexpr size_t O_VTSC = O_VTSL + AL((size_t)8 * 2 * 64 * 4096 * 2);
constexpr size_t O_VTSCC = O_VTSC + AL((size_t)16 * 2 * 64 * 256 * 2);
constexpr size_t O_Q = O_VTSCC + AL((size_t)8 * 2 * 64 * 256 * 2);
constexpr size_t O_KNL = O_Q + AL((size_t)T_ALL * 768 * 2);
constexpr size_t O_KNC = O_KNL + AL((size_t)8 * 8 * LK_LAT * 64 * 2);
constexpr size_t O_VTL = O_KNC + AL((size_t)16 * 8 * 256 * 64 * 2);
constexpr size_t O_VTC = O_VTL + AL((size_t)8 * 8 * 64 * LK_LAT * 2);
constexpr size_t O_YRNN = O_VTC + AL((size_t)16 * 8 * 64 * 256 * 2);
static_assert(O_YRNN - O_KS >= (size_t)2 * T_ALL * 1024 * 2, "merge-gate buffers do not fit");
constexpr size_t O_SUM = O_YRNN + AL((size_t)T_ALL * 1024 * 2);
constexpr size_t O_BAR = O_SUM + AL((size_t)8 * 8 * 2 * 16 * 256 * 4);
constexpr size_t BAR_BYTES = 16384;
constexpr size_t O_W2 = O_BAR + BAR_BYTES;
constexpr size_t WS_NEED = O_W2 + O_MOD;

constexpr size_t OUT_CKV = (size_t)T_ALL * 1024;
constexpr size_t OUT_KROPE = OUT_CKV + (size_t)16 * 4 * 256 * 256;
constexpr size_t OUT_SK = OUT_KROPE + (size_t)16 * 4 * 256 * 32;
constexpr size_t OUT_SV = OUT_SK + (size_t)16 * 4 * 256 * 128;
constexpr size_t OUT_RG = OUT_SV + (size_t)16 * 4 * 256 * 128;

#define SB() __builtin_amdgcn_sched_barrier(0)
#define MB() asm volatile("" ::: "memory")
DI int tid() { int t = threadIdx.x; asm volatile("" : "+v"(t)); return t; }
DI int xcd_map(int base) {
  const int g = gridDim.x;
  if (g & 7) return base + blockIdx.x;
  return base + (blockIdx.x & 7) * (g >> 3) + (blockIdx.x >> 3);
}
#define LANEVARS const int t = tid(), lane = t & 63, w = t >> 6, wr = w >> 1, wc = w & 1; const int c16 = lane & 15, g4 = lane >> 4; (void)wr; (void)wc; (void)c16; (void)g4;
DI float bf2f(u16 v) { return __uint_as_float(((unsigned)v) << 16); }
DI unsigned pack2(float a, float b) {
  f2_t v = {a, b};
  bf2_t r = __builtin_convertvector(v, bf2_t);
  return __builtin_bit_cast(unsigned, r);
}
DI u16 f2bf(float a) { return (u16)(pack2(a, 0.f) & 0xffffu); }
DI float sigmoidf_(float x) { return __builtin_amdgcn_rcpf(1.f + __expf(-x)); }
DI float wave_sum(float v) {
#pragma unroll
  for (int o = 32; o > 0; o >>= 1) v += __shfl_xor(v, o);
  return v;
}
DI int perm32(int p) { return (p & 7) | ((p & 8) << 1) | ((p & 16) >> 1); }
DI const float* xin_row(const Params& p, int l, int row) {
  if (l == 0) return row < T_CTX ? p.x_prompt + (size_t)row * 1024 : p.x_sample + (size_t)(row - T_CTX) * 1024;
  return p.out + (size_t)row * 1024;
}
template <class T> DI T* wsp(const Params& p, size_t off) { return (T*)(p.ws + off); }
DI u16* wsw(const Params& p, int l, size_t off) { return (u16*)(p.ws + ((l & 1) ? O_W2 : 0) + off); }

template <int NJ>
DI void gemm_tile_t(const u16* A, int lda, const u16* B, int ldb, int K,
                    f32x4 (&acc)[4][NJ], char* smem) {
  const int t = tid(), lane = t & 63, w = t >> 6, wr = w >> 1, wc = w & 1;
  const int lr = t >> 3, slot = t & 7;
  const int c16 = lane & 15, g4 = lane >> 4;
  const int gch = slot ^ ((lr >> 1) & 7);
  const u16* ap = A + (size_t)lr * lda + gch * 8;
  const u16* bp = B + (size_t)lr * ldb + gch * 8;
  char* sdst = smem + t * 16;
#define DMA16(gp, lp) __builtin_amdgcn_global_load_lds((const unsigned*)(gp), (unsigned*)(lp), 16, 0, 0)
#define STAGE(base, ko) { DMA16(ap + (ko), (base)); DMA16(ap + (size_t)32 * lda + (ko), (base) + 4096); \
    DMA16(ap + (size_t)64 * lda + (ko), (base) + 8192); DMA16(ap + (size_t)96 * lda + (ko), (base) + 12288); \
    DMA16(bp + (ko), (base) + 16384); DMA16(bp + (size_t)32 * ldb + (ko), (base) + 16384 + 4096); \
    if (NJ > 2) { DMA16(bp + (size_t)64 * ldb + (ko), (base) + 16384 + 8192); DMA16(bp + (size_t)96 * ldb + (ko), (base) + 16384 + 12288); } }
  const int nk = K >> 6;
  const int arow = (wr * 64 + c16) * 128, brow = (wc * (16 * NJ) + c16) * 128;
  const int sw = (c16 >> 1) & 7;
  int kk = 0;
  STAGE(sdst, kk * 64)
  __syncthreads();
  for (int kt = 0; kt < nk; ++kt) {
    char* cur = smem + (kt & 1) * 32768;
    kk = (kk + 1 == nk) ? 0 : kk + 1;
    if (kt + 1 < nk) { char* nxt = sdst + ((kt + 1) & 1) * 32768; STAGE(nxt, kk * 64) }
#pragma unroll
    for (int ks = 0; ks < 2; ++ks) {
      bf16x8 af[4], bfr[NJ];
      const int ch = ((ks * 4 + g4) ^ sw) << 4;
#pragma unroll
      for (int i = 0; i < 4; ++i) af[i] = *(const bf16x8*)(cur + arow + i * 2048 + ch);
#pragma unroll
      for (int i = 0; i < NJ; ++i) bfr[i] = *(const bf16x8*)(cur + 16384 + brow + i * 2048 + ch);
#pragma unroll
      for (int i = 0; i < 4; ++i)
#pragma unroll
        for (int j = 0; j < NJ; ++j)
          acc[i][j] = __builtin_amdgcn_mfma_f32_16x16x32_bf16(af[i], bfr[j], acc[i][j], 0, 0, 0);
    }
    SB();
    __syncthreads();
  }
#undef STAGE
#undef DMA16
}
DI void gemm_tile(const u16* A, int lda, const u16* B, int ldb, int K,
                  f32x4 (&acc)[4][4], char* smem) {
  gemm_tile_t<4>(A, lda, B, ldb, K, acc, smem);
}
DI void zero_acc(f32x4 (&acc)[4][4]) {
#pragma unroll
  for (int i = 0; i < 4; ++i)
#pragma unroll
    for (int j = 0; j < 4; ++j) acc[i][j] = f32x4{0.f, 0.f, 0.f, 0.f};
}

struct TokTile { int g0; int is_ctx; int b; int p0; };
DI TokTile tok_tile(int mt) {
  TokTile r; r.g0 = mt * 128;
  if (r.g0 < T_CTX) { r.is_ctx = 1; r.b = r.g0 >> 8; r.p0 = r.g0 & 255; }
  else { r.is_ctx = 0; r.b = (r.g0 - T_CTX) >> 12; r.p0 = (r.g0 - T_CTX) & 4095; }
  return r;
}

DI void phase_mod(const Params& p, char* smem) {
  float* s_silu = (float*)smem;
  float* s_part = (float*)(smem + 36864);
  float* MOD = wsp<float>(p, O_MOD);
  const int t = tid();
  for (int i = t; i < 9 * 1024; i += 256) {
    float v = (i < 8192) ? p.c[i] : p.c_ctx[i - 8192];
    s_silu[i] = v * sigmoidf_(v);
  }
  __syncthreads();
  const int kg = t >> 6, cl = t & 63;
  for (int u = blockIdx.x; u < 4 * 48; u += gridDim.x) {
    const int l = u / 48, cb = u % 48;
    const int n = cb * 64 + cl;
    float acc[9];
#pragma unroll
    for (int ci = 0; ci < 9; ++ci) acc[ci] = 0.f;
    const float* wp = p.w_mod + ((size_t)l * 1024 + kg * 256) * 3072 + n;
    for (int k = 0; k < 256; ++k) {
      float wv = wp[(size_t)k * 3072];
#pragma unroll
      for (int ci = 0; ci < 9; ++ci) acc[ci] += s_silu[ci * 1024 + kg * 256 + k] * wv;
    }
#pragma unroll
    for (int ci = 0; ci < 9; ++ci) s_part[(kg * 9 + ci) * 64 + cl] = acc[ci];
    __syncthreads();
    for (int idx = t; idx < 9 * 64; idx += 256) {
      int ci = idx >> 6, c2 = idx & 63;
      float s = s_part[(0 * 9 + ci) * 64 + c2] + s_part[(1 * 9 + ci) * 64 + c2] + s_part[(2 * 9 + ci) * 64 + c2] +
                s_part[(3 * 9 + ci) * 64 + c2];
      MOD[((size_t)l * 9 + ci) * 3072 + cb * 64 + c2] = s + p.b_mod[l * 3072 + cb * 64 + c2];
    }
    __syncthreads();
  }
}

template <class F> DI void conv_job(u16* dst, int N, int K, F src) {
  const int total = N * (K >> 3);
  for (int idx = blockIdx.x * 256 + tid(); idx < total; idx += gridDim.x * 256) {
    const int n = idx % N, kb = idx / N;
    float v[8];
#pragma unroll
    for (int j = 0; j < 8; ++j) v[j] = src(kb * 8 + j, n);
    uint4 o;
    o.x = pack2(v[0], v[1]); o.y = pack2(v[2], v[3]); o.z = pack2(v[4], v[5]); o.w = pack2(v[6], v[7]);
    *(uint4*)(dst + (size_t)n * K + kb * 8) = o;
  }
}

DI void convert_weights(const Params& p, int l) {
  {
    const float* win = p.w_in + (size_t)l * 1024 * 7584;
    conv_job(wsw(p, l, O_WINA), 2560, 1024, [&](int k, int n) -> float {
      int col;
      if (n < 1024) col = n;
      else if (n < 1408) col = 2048 + (n - 1024);
      else if (n < 1664) col = 2432 + (n - 1408);
      else if (n < 1792) { int pp = n - 1664; col = pp < 32 ? 2688 + perm32(pp) : -1; }
      else if (n < 2304) col = 3232 + (n - 1792);
      else if (n < 2432) col = 3744 + (n - 2304);
      else col = 3872 + (n - 2432);
      return col < 0 ? 0.f : win[(size_t)k * 7584 + col];
    });
    conv_job(wsw(p, l, O_WINB), 5120, 1024, [&](int k, int n) -> float {
      int col;
      if (n < 1024) col = 1024 + n;
      else if (n < 1536) col = 2720 + (n - 1024);
      else if (n < 2048) col = 4000 + (n - 1536);
      else col = 4512 + (n - 2048);
      return win[(size_t)k * 7584 + col];
    });
    const float* wa = p.lru_wa + (size_t)l * 2 * 8 * 128 * 128;
    const float* wi = p.lru_wi + (size_t)l * 2 * 8 * 128 * 128;
    conv_job(wsw(p, l, O_WLRU), 4096, 128, [&](int k, int n) -> float {
      int db = n >> 8, nn = n & 255;
      return nn < 128 ? wa[((size_t)db * 128 + k) * 128 + nn] : wi[((size_t)db * 128 + k) * 128 + (nn - 128)];
    });
    const float* wuq = p.w_uq + (size_t)l * 384 * 768;
    const float* gq = p.q_norm + l * 384;
    conv_job(wsw(p, l, O_WUQ), 768, 384, [&](int k, int n) -> float {
      int col;
      if (n < 512) col = (n >> 6) * 96 + (n & 63);
      else { int hh = (n - 512) >> 5, pp = (n - 512) & 31; col = hh * 96 + 64 + perm32(pp); }
      return gq[k] * wuq[(size_t)k * 768 + col];
    });
    const float* wukv = p.w_ukv + (size_t)l * 256 * 1024;
    const float* gkv = p.kv_norm + l * 256;
    conv_job(wsw(p, l, O_WUKVG), 1024, 256, [&](int k, int n) -> float { return gkv[k] * wukv[(size_t)k * 1024 + n]; });
    conv_job(wsw(p, l, O_WUKVR), 1024, 256, [&](int k, int n) -> float { return wukv[(size_t)k * 1024 + n]; });
    const float* w1 = p.w_br_rnn + (size_t)l * 1024 * 1024;
    conv_job(wsw(p, l, O_WBRR), 1024, 1024, [&](int k, int n) -> float { return w1[(size_t)k * 1024 + n]; });
    const float* w2 = p.w_br_mla + (size_t)l * 512 * 1024;
    conv_job(wsw(p, l, O_WBRM), 1024, 512, [&](int k, int n) -> float { return w2[(size_t)k * 1024 + n]; });
    const float* w3 = p.w_br_swa + (size_t)l * 512 * 1024;
    conv_job(wsw(p, l, O_WBRS), 1024, 512, [&](int k, int n) -> float { return w3[(size_t)k * 1024 + n]; });
    const float* w4 = p.w_out + (size_t)l * 1024 * 1024;
    conv_job(wsw(p, l, O_WOUT), 1024, 1024, [&](int k, int n) -> float { return w4[(size_t)k * 1024 + n]; });
  }
}

DI void phase_prep(const Params& p, int l) {
  const int t = tid(), lane = t & 63, w = t >> 6;
  const float* MOD = wsp<float>(p, O_MOD) + (size_t)l * 9 * 3072;
  u16* H = wsp<u16>(p, O_H);
  for (int row = blockIdx.x * 4 + w; row < T_ALL; row += gridDim.x * 4) {
    const float* x = xin_row(p, l, row);
    const int ci = row < T_CTX ? 8 : ((row - T_CTX) >> 12);
    const float* md = MOD + ci * 3072;
    float4 v[4];
    float ss = 0.f;
#pragma unroll
    for (int i = 0; i < 4; ++i) {
      v[i] = *(const float4*)(x + i * 256 + lane * 4);
      ss += v[i].x * v[i].x + v[i].y * v[i].y + v[i].z * v[i].z + v[i].w * v[i].w;
    }
    ss = wave_sum(ss);
    const float rs = rsqrtf(ss * (1.f / 1024.f) + EPS);
#pragma unroll
    for (int i = 0; i < 4; ++i) {
      const int c = i * 256 + lane * 4;
      const float4 g = *(const float4*)(p.g_norm + l * 1024 + c);
      const float4 sh = *(const float4*)(md + c);
      const float4 sc = *(const float4*)(md + 1024 + c);
      float h0 = v[i].x * rs * g.x * (1.f + sc.x) + sh.x;
      float h1 = v[i].y * rs * g.y * (1.f + sc.y) + sh.y;
      float h2 = v[i].z * rs * g.z * (1.f + sc.z) + sh.z;
      float h3 = v[i].w * rs * g.w * (1.f + sc.w) + sh.w;
      uint2 o; o.x = pack2(h0, h1); o.y = pack2(h2, h3);
      *(uint2*)(H + (size_t)row * 1024 + c) = o;
    }
  }
  {
    const int gt = blockIdx.x * 256 + t, gs = gridDim.x * 256;
    u16* ckvc = wsp<u16>(p, O_CKVC);
    for (int i = gt; i < 2048 * 256; i += gs) {
      int r = i >> 8, k = i & 255, b = r >> 8, pos = r & 255;
      ckvc[i] = f2bf(p.cache_ckv[(((size_t)b * 4 + l) * 256 + pos) * 256 + k]);
    }
    u16* krl = wsp<u16>(p, O_KRL);
    for (int i = gt; i < 8 * 256 * 32; i += gs) {
      int pp = i & 31, pos = (i >> 5) & 255, b = i >> 13;
      krl[((size_t)b * LK_LAT + pos) * 32 + pp] = f2bf(p.cache_krope[(((size_t)b * 4 + l) * 256 + pos) * 32 + perm32(pp)]);
    }
    u16* ksc = wsp<u16>(p, O_KSC);
    for (int i = gt; i < 8 * 256 * 128; i += gs) {
      int c = i & 127, pos = (i >> 7) & 255, b = i >> 15;
      ksc[i] = f2bf(p.cache_k[(((size_t)b * 4 + l) * 256 + pos) * 128 + c]);
    }
    u16* vtc = wsp<u16>(p, O_VTSCC);
    for (int i = gt; i < 8 * 2 * 64 * 256; i += gs) {
      int pos = i & 255, dv = (i >> 8) & 63, kvh = (i >> 14) & 1, b = i >> 15;
      vtc[i] = f2bf(p.cache_v[(((size_t)b * 4 + l) * 256 + pos) * 128 + kvh * 64 + dv]);
    }
  }
}

DI void phase_gemmA(const Params& p, int l, char* smem) {
  const u16* H = wsp<u16>(p, O_H);
  const u16* W = wsw(p, l, O_WINA);
  for (int base = 0; base < 288 * 20; base += gridDim.x) {
    const int tile = xcd_map(base);
    if (tile >= 288 * 20) continue;
    const int sb = tile >> 5, jj = tile & 31;
    const int mt = (sb / 5) * 8 + (jj >> 2), nt = (sb % 5) * 4 + (jj & 3);
    const TokTile tt = tok_tile(mt);
    f32x4 acc[4][4];
    zero_acc(acc);
    gemm_tile(H + (size_t)tt.g0 * 1024, 1024, W + (size_t)nt * 128 * 1024, 1024, 1024, acc, smem);
    LANEVARS
    if (nt < 13) {
      u16* dst; int ld, cb;
      if (nt < 8) { dst = wsp<u16>(p, O_XR); ld = 1024; cb = nt * 128; }
      else if (nt < 11) { dst = wsp<u16>(p, O_CQ); ld = 384; cb = (nt - 8) * 128; }
      else { dst = wsp<u16>(p, O_CKV); ld = 256; cb = (nt - 11) * 128; }
#pragma unroll
      for (int i = 0; i < 4; ++i)
#pragma unroll
        for (int j = 0; j < 4; ++j)
#pragma unroll
          for (int e = 0; e < 4; ++e) {
            const int g = tt.g0 + wr * 64 + i * 16 + g4 * 4 + e;
            dst[(size_t)g * ld + cb + wc * 64 + j * 16 + c16] = f2bf(acc[i][j][e]);
            if (e == 3 && j == 3) SB();
          }
    } else if (nt == 13) {
      if (wc == 0) {
#pragma unroll
        for (int i = 0; i < 4; ++i)
#pragma unroll
          for (int e = 0; e < 4; ++e) {
            SB();
            const int r = wr * 64 + i * 16 + g4 * 4 + e;
            const int pos = tt.p0 + r;
            float x1 = acc[i][0][e], x2 = acc[i][1][e];
            if (tt.is_ctx) {
              u16* kr = wsp<u16>(p, O_KRC) + ((size_t)tt.b * 256 + pos) * 32;
              kr[c16] = f2bf(x1); kr[c16 + 16] = f2bf(x2);
              float* o = p.out + OUT_KROPE + (((size_t)tt.b * 4 + l) * 256 + pos) * 32;
              o[perm32(c16)] = x1; o[perm32(c16 + 16)] = x2;
            } else {
              const int pv = (c16 >= 8) ? (pos & 63) : (pos >> 6);
              const float cs = TAB_M[(pv * 8 + (c16 & 7)) * 2], sn = TAB_M[(pv * 8 + (c16 & 7)) * 2 + 1];
              u16* kr = wsp<u16>(p, O_KRL) + ((size_t)tt.b * LK_LAT + 256 + pos) * 32;
              kr[c16] = f2bf(x1 * cs - x2 * sn); kr[c16 + 16] = f2bf(x2 * cs + x1 * sn);
            }
          }
      }
    } else if (nt < 19) {
      const bool isk = (nt == 18);
      u16* dst = isk ? wsp<u16>(p, O_KS) : wsp<u16>(p, O_QS);
      const int ld = isk ? 128 : 512;
      const int cb = isk ? wc * 64 : ((nt - 14) * 2 + wc) * 64;
#pragma unroll
      for (int i = 0; i < 4; ++i)
#pragma unroll
        for (int e = 0; e < 4; ++e) {
          SB();
          const int r = wr * 64 + i * 16 + g4 * 4 + e;
          const int pos = tt.p0 + r, g = tt.g0 + r;
          float v0 = acc[i][0][e], v1 = acc[i][1][e], v2 = acc[i][2][e], v3 = acc[i][3][e];
          if (!tt.is_ctx) {
            const int pr = pos >> 6, pc = pos & 63;
            const float c0 = TAB_S[(pr * 16 + c16) * 2], s0 = TAB_S[(pr * 16 + c16) * 2 + 1];
            const float c1 = TAB_S[(pc * 16 + c16) * 2], s1 = TAB_S[(pc * 16 + c16) * 2 + 1];
            float a0 = v0 * c0 - v1 * s0, a1 = v1 * c0 + v0 * s0;
            float a2 = v2 * c1 - v3 * s1, a3 = v3 * c1 + v2 * s1;
            v0 = a0; v1 = a1; v2 = a2; v3 = a3;
          } else if (isk) {
            float* o = p.out + OUT_SK + (((size_t)tt.b * 4 + l) * 256 + pos) * 128 + cb + c16;
            o[0] = v0; o[16] = v1; o[32] = v2; o[48] = v3;
          }
          u16* d = dst + (size_t)g * ld + cb + c16;
          d[0] = f2bf(v0); d[16] = f2bf(v1); d[32] = f2bf(v2); d[48] = f2bf(v3);
        }
    } else {
      u16* vt = tt.is_ctx ? wsp<u16>(p, O_VTSC) : wsp<u16>(p, O_VTSL);
      const int L = tt.is_ctx ? 256 : 4096;
#pragma unroll
      for (int i = 0; i < 4; ++i)
#pragma unroll
        for (int j = 0; j < 4; ++j) {
          SB();
          const int r = wr * 64 + i * 16 + g4 * 4;
          const int pos = tt.p0 + r, dv = j * 16 + c16;
          uint2 o; o.x = pack2(acc[i][j][0], acc[i][j][1]); o.y = pack2(acc[i][j][2], acc[i][j][3]);
          *(uint2*)(vt + (((size_t)tt.b * 2 + wc) * 64 + dv) * L + pos) = o;
          if (tt.is_ctx) {
#pragma unroll
            for (int e = 0; e < 4; ++e)
              p.out[OUT_SV + (((size_t)tt.b * 4 + l) * 256 + pos + e) * 128 + wc * 64 + dv] = acc[i][j][e];
          }
        }
    }
  }
}

DI void row_scales(const u16* A, int K, float* s_rs) {
  const int t = tid(), row = t >> 1, half = t & 1;
  const u16* ap = A + (size_t)row * K + half * (K >> 1);
  float ss = 0.f;
  for (int c = 0; c < (K >> 4); ++c) {
    uint4 v = *(const uint4*)(ap + c * 8);
    unsigned wv[4] = {v.x, v.y, v.z, v.w};
#pragma unroll
    for (int q = 0; q < 4; ++q) {
      float a = __uint_as_float(wv[q] << 16), b = __uint_as_float(wv[q] & 0xffff0000u);
      ss += a * a + b * b;
    }
  }
  ss += __shfl_xor(ss, 1);
  if (half == 0) s_rs[row] = rsqrtf(ss / (float)K + EPS);
}

template <int MODE> DI void scan_seg(const Params& p, int l, int seq, int blk, int d, int seg, char* smem);
DI void phase_qkv(const Params& p, int l, char* smem) {
  float* s_rs = (float*)(smem + 65536);
  constexpr int NQ = 288 * 6, NKV = 304 * 8, NS1 = 2048;
  for (int base = 0; base < NS1 + NQ + NKV; base += gridDim.x) {
    const int tile0 = xcd_map(base);
    if (tile0 >= NS1 + NQ + NKV) continue;
    if (tile0 < NS1) {
      scan_seg<0>(p, l, 16 + (tile0 >> 8), (tile0 >> 5) & 7, (tile0 >> 4) & 1, tile0 & 15, smem);
#if PROBE == 4
      scan_seg<0>(p, l, 16 + (tile0 >> 8), (tile0 >> 5) & 7, (tile0 >> 4) & 1, tile0 & 15, smem);
#endif
      continue;
    }
    const int tile = tile0 - NS1;
    f32x4 acc[4][4];
    zero_acc(acc);
    if (tile < NQ) {
      const int mt = tile / 6, nt = tile % 6;
      const TokTile tt = tok_tile(mt);
      const u16* A = wsp<u16>(p, O_CQ) + (size_t)tt.g0 * 384;
      row_scales(A, 384, s_rs);
      gemm_tile(A, 384, wsw(p, l, O_WUQ) + (size_t)nt * 128 * 384, 384, 384, acc, smem);
      LANEVARS
      u16* Q = wsp<u16>(p, O_Q);
#pragma unroll
      for (int i = 0; i < 4; ++i)
#pragma unroll
        for (int e = 0; e < 4; ++e) {
          SB();
          const int r = wr * 64 + i * 16 + g4 * 4 + e;
          const int pos = tt.p0 + r, g = tt.g0 + r;
          const float rs = s_rs[r];
          float v0 = acc[i][0][e] * rs, v1 = acc[i][1][e] * rs, v2 = acc[i][2][e] * rs, v3 = acc[i][3][e] * rs;
          if (nt >= 4 && !tt.is_ctx) {
            const int pv = (c16 >= 8) ? (pos & 63) : (pos >> 6);
            const float cs = TAB_M[(pv * 8 + (c16 & 7)) * 2], sn = TAB_M[(pv * 8 + (c16 & 7)) * 2 + 1];
            float a0 = v0 * cs - v1 * sn, a1 = v1 * cs + v0 * sn;
            float a2 = v2 * cs - v3 * sn, a3 = v3 * cs + v2 * sn;
            v0 = a0; v1 = a1; v2 = a2; v3 = a3;
          }
          u16* d = Q + (size_t)g * 768 + nt * 128 + wc * 64 + c16;
          d[0] = f2bf(v0); d[16] = f2bf(v1); d[32] = f2bf(v2); d[48] = f2bf(v3);
        }
    } else {
      const int t2 = tile - NQ;
      const int mt = t2 >> 3, hd = t2 & 7;
      const u16* A; const u16* Wt; int is_ctx, seq, kp0;
      if (mt < 288) {
        const TokTile tt = tok_tile(mt);
        A = wsp<u16>(p, O_CKV) + (size_t)tt.g0 * 256;
        Wt = wsw(p, l, O_WUKVG);
        row_scales(A, 256, s_rs);
        is_ctx = tt.is_ctx; seq = tt.b; kp0 = tt.is_ctx ? tt.p0 : 256 + tt.p0;
        if (tt.is_ctx && hd == 0) {
          __syncthreads();
          const float* gkv = p.kv_norm + l * 256;
          for (int idx = tid(); idx < 128 * 256; idx += 256) {
            const int r = idx >> 8, k = idx & 255;
            p.out[OUT_CKV + (((size_t)tt.b * 4 + l) * 256 + tt.p0 + r) * 256 + k] = bf2f(A[(size_t)r * 256 + k]) * s_rs[r] * gkv[k];
          }
        }
      } else {
        const int row0 = (mt - 288) * 128;
        A = wsp<u16>(p, O_CKVC) + (size_t)row0 * 256;
        Wt = wsw(p, l, O_WUKVR);
        { const int t1 = tid(); if (t1 < 128) s_rs[t1] = 1.f; }
        is_ctx = 0; seq = row0 >> 8; kp0 = row0 & 255;
      }
      gemm_tile(A, 256, Wt + (size_t)hd * 128 * 256, 256, 256, acc, smem);
      LANEVARS
      const int Lk = is_ctx ? 256 : LK_LAT;
      if (wc == 0) {
        u16* Kn = (is_ctx ? wsp<u16>(p, O_KNC) : wsp<u16>(p, O_KNL)) + ((size_t)seq * 8 + hd) * Lk * 64;
#pragma unroll
        for (int i = 0; i < 4; ++i)
#pragma unroll
          for (int j = 0; j < 4; ++j)
#pragma unroll
            for (int e = 0; e < 4; ++e) {
              const int r = wr * 64 + i * 16 + g4 * 4 + e;
              Kn[(size_t)(kp0 + r) * 64 + j * 16 + c16] = f2bf(acc[i][j][e] * s_rs[r]);
              if (e == 3) SB();
            }
      } else {
        u16* Vt = (is_ctx ? wsp<u16>(p, O_VTC) : wsp<u16>(p, O_VTL)) + ((size_t)seq * 8 + hd) * 64 * Lk;
#pragma unroll
        for (int i = 0; i < 4; ++i)
#pragma unroll
          for (int j = 0; j < 4; ++j) {
            SB();
            const int r = wr * 64 + i * 16 + g4 * 4;
            uint2 o;
            o.x = pack2(acc[i][j][0] * s_rs[r], acc[i][j][1] * s_rs[r + 1]);
            o.y = pack2(acc[i][j][2] * s_rs[r + 2], acc[i][j][3] * s_rs[r + 3]);
            *(uint2*)(Vt + (size_t)(j * 16 + c16) * Lk + kp0 + r) = o;
          }
      }
    }
    __syncthreads();
  }
}

template <int NS> DI void attn_gload(const u16* k0, int k0s, const u16* k1, const u16* vt, int vts,
                                     uint4& rk0, uint4& rk1, uint4& rk2, uint4& rv0, uint4& rv1) {
  const int t = tid();
  if (NS == 6) {
    { const int c = t, key = c / 12, ch = c % 12;
      rk0 = (ch < 8) ? *(const uint4*)(k0 + (size_t)key * k0s + ch * 8) : *(const uint4*)(k1 + (size_t)key * 32 + (ch - 8) * 8); }
    { const int c = t + 256, key = c / 12, ch = c % 12;
      rk1 = (ch < 8) ? *(const uint4*)(k0 + (size_t)key * k0s + ch * 8) : *(const uint4*)(k1 + (size_t)key * 32 + (ch - 8) * 8); }
    { const int c = t + 512, key = c / 12, ch = c % 12;
      rk2 = (ch < 8) ? *(const uint4*)(k0 + (size_t)key * k0s + ch * 8) : *(const uint4*)(k1 + (size_t)key * 32 + (ch - 8) * 8); }
  } else {
    { const int c = t, key = c >> 3, ch = c & 7; rk0 = *(const uint4*)(k0 + (size_t)key * k0s + ch * 8); }
    { const int c = t + 256, key = c >> 3, ch = c & 7; rk1 = *(const uint4*)(k0 + (size_t)key * k0s + ch * 8); }
  }
  { const int c = t, dv = c >> 3, ch = c & 7; rv0 = *(const uint4*)(vt + (size_t)dv * vts + ch * 8); }
  { const int c = t + 256, dv = c >> 3, ch = c & 7; rv1 = *(const uint4*)(vt + (size_t)dv * vts + ch * 8); }
}
template <int NS> DI void attn_sstore(char* smem, const uint4& rk0, const uint4& rk1, const uint4& rk2, const uint4& rv0, const uint4& rv1) {
  constexpr int KSTR = (NS == 6) ? 208 : 144;
  const int t = tid();
  if (NS == 6) {
    { const int c = t, key = c / 12, ch = c % 12; *(uint4*)(smem + key * KSTR + ch * 16) = rk0; }
    { const int c = t + 256, key = c / 12, ch = c % 12; *(uint4*)(smem + key * KSTR + ch * 16) = rk1; }
    { const int c = t + 512, key = c / 12, ch = c % 12; *(uint4*)(smem + key * KSTR + ch * 16) = rk2; }
  } else {
    { const int c = t, key = c >> 3, ch = c & 7; *(uint4*)(smem + key * KSTR + ch * 16) = rk0; }
    { const int c = t + 256, key = c >> 3, ch = c & 7; *(uint4*)(smem + key * KSTR + ch * 16) = rk1; }
  }
  { const int c = t, dv = c >> 3, ch = c & 7; char* d = smem + 13312 + dv * 136 + ch * 16;
    *(uint2*)d = uint2{rv0.x, rv0.y}; *(uint2*)(d + 8) = uint2{rv0.z, rv0.w}; }
  { const int c = t + 256, dv = c >> 3, ch = c & 7; char* d = smem + 13312 + dv * 136 + ch * 16;
    *(uint2*)d = uint2{rv1.x, rv1.y}; *(uint2*)(d + 8) = uint2{rv1.z, rv1.w}; }
}

#define PACK8(S, s2) __builtin_bit_cast(bf16x8, uint4{pack2(S[8 * (s2)], S[8 * (s2) + 1]), pack2(S[8 * (s2) + 2], S[8 * (s2) + 3]), \
                                                        pack2(S[8 * (s2) + 4], S[8 * (s2) + 5]), pack2(S[8 * (s2) + 6], S[8 * (s2) + 7])})

template <int NS>
DI void attn_item(const u16* kA, int kAs, const u16* krA, const u16* vtA, int vtAs, int nA, int kposA, int maskA,
                  const u16* kB, int kBs, const u16* vtB, int vtBs, int nB,
                  const u16* qa, const u16* qb, float sc2, float m0, float l0, int qpos, u16* yrow, char* smem) {
  constexpr int KSTR = (NS == 6) ? 208 : 144;
  const int lane = tid() & 63;
  const int r32 = lane & 31, hh = lane >> 5;
  bf16x8 qf0, qf1, qf2, qf3, qf4, qf5;
  qf0 = *(const bf16x8*)(qa + 0 + 8 * hh); qf1 = *(const bf16x8*)(qa + 16 + 8 * hh);
  qf2 = *(const bf16x8*)(qa + 32 + 8 * hh); qf3 = *(const bf16x8*)(qa + 48 + 8 * hh);
  if (NS == 6) { qf4 = *(const bf16x8*)(qb + 0 + 8 * hh); qf5 = *(const bf16x8*)(qb + 16 + 8 * hh); }
  else { qf4 = qf0; qf5 = qf0; }
#define QSCALE(qf) { uint4 u_ = __builtin_bit_cast(uint4, qf); \
    u_.x = pack2(__uint_as_float(u_.x << 16) * sc2, __uint_as_float(u_.x & 0xffff0000u) * sc2); \
    u_.y = pack2(__uint_as_float(u_.y << 16) * sc2, __uint_as_float(u_.y & 0xffff0000u) * sc2); \
    u_.z = pack2(__uint_as_float(u_.z << 16) * sc2, __uint_as_float(u_.z & 0xffff0000u) * sc2); \
    u_.w = pack2(__uint_as_float(u_.w << 16) * sc2, __uint_as_float(u_.w & 0xffff0000u) * sc2); \
    qf = __builtin_bit_cast(bf16x8, u_); }
  QSCALE(qf0) QSCALE(qf1) QSCALE(qf2) QSCALE(qf3)
  if (NS == 6) { QSCALE(qf4) QSCALE(qf5) }
#undef QSCALE
  f32x16 O0, O1;
#pragma unroll
  for (int e = 0; e < 16; ++e) { O0[e] = 0.f; O1[e] = 0.f; }
  float m_run = m0, l_run = l0;
  uint4 rk0, rk1, rk2, rv0, rv1;
  rk2 = uint4{0, 0, 0, 0};
  const int ntiles = nA + nB;
#define TILE_GLOAD(jn) { if ((jn) < nA) attn_gload<NS>(kA + (size_t)(jn) * 64 * kAs, kAs, krA + (size_t)(jn) * 64 * 32, vtA + (jn) * 64, vtAs, rk0, rk1, rk2, rv0, rv1); \
    else { const int jb_ = (jn) - nA; attn_gload<NS>(kB + (size_t)jb_ * 64 * kBs, kBs, nullptr, vtB + jb_ * 64, vtBs, rk0, rk1, rk2, rv0, rv1); } }
  constexpr int STG = 22528;
  TILE_GLOAD(0)
  attn_sstore<NS>(smem, rk0, rk1, rk2, rv0, rv1);
  if (ntiles > 1) TILE_GLOAD(1)
  __syncthreads();
  for (int j = 0; j < ntiles; ++j) {
    char* sbase = smem + (j & 1) * STG;
    const int kpos = kposA + 64 * j;
    const bool masked = maskA && (j < nA);
    MB();
    f32x16 S0, S1;
#pragma unroll
    for (int e = 0; e < 16; ++e) { S0[e] = 0.f; S1[e] = 0.f; }
    const char* ka0 = sbase + r32 * KSTR + 16 * hh;
    const char* ka1 = sbase + (32 + r32) * KSTR + 16 * hh;
#define QK_STEP(s, qf) { bf16x8 a0 = *(const bf16x8*)(ka0 + 32 * (s)); bf16x8 a1 = *(const bf16x8*)(ka1 + 32 * (s)); \
      S0 = __builtin_amdgcn_mfma_f32_32x32x16_bf16(a0, qf, S0, 0, 0, 0); S1 = __builtin_amdgcn_mfma_f32_32x32x16_bf16(a1, qf, S1, 0, 0, 0); }
    QK_STEP(0, qf0) QK_STEP(1, qf1) QK_STEP(2, qf2) QK_STEP(3, qf3)
    if (NS == 6) { QK_STEP(4, qf4) QK_STEP(5, qf5) }
    SB();
    float mx = m_run;
#pragma unroll
    for (int e = 0; e < 16; ++e) {
      float v0 = S0[e], v1 = S1[e];
      if (masked) {
        const int kp = kpos + (e & 3) + 8 * (e >> 2) + 4 * hh;
        int d0 = qpos - kp; d0 = d0 < 0 ? -d0 : d0;
        int d1 = qpos - (kp + 32); d1 = d1 < 0 ? -d1 : d1;
        if (d0 > 128) v0 = -1e30f;
        if (d1 > 128) v1 = -1e30f;
      }
      S0[e] = v0; S1[e] = v1;
      mx = fmaxf(mx, fmaxf(v0, v1));
    }
    mx = fmaxf(mx, __shfl_xor(mx, 32));
    const float alpha = __builtin_amdgcn_exp2f(m_run - mx);
    m_run = mx;
    float rsum = 0.f;
#pragma unroll
    for (int e = 0; e < 16; ++e) {
      float p0 = __builtin_amdgcn_exp2f(S0[e] - mx), p1 = __builtin_amdgcn_exp2f(S1[e] - mx);
      S0[e] = p0; S1[e] = p1;
      rsum += p0 + p1;
    }
    rsum += __shfl_xor(rsum, 32);
    l_run = l_run * alpha + rsum;
#pragma unroll
    for (int e = 0; e < 16; ++e) { O0[e] *= alpha; O1[e] *= alpha; }
    const char* sv0 = sbase + 13312 + r32 * 136 + 8 * hh;
    const char* sv1 = sv0 + 32 * 136;
#define PV_STEP(pb, ka) { \
      { uint2 lo = *(const uint2*)(sv0 + (ka) * 2), hi = *(const uint2*)(sv0 + (ka) * 2 + 16); \
        bf16x8 va = __builtin_bit_cast(bf16x8, uint4{lo.x, lo.y, hi.x, hi.y}); O0 = __builtin_amdgcn_mfma_f32_32x32x16_bf16(va, pb, O0, 0, 0, 0); } \
      { uint2 lo = *(const uint2*)(sv1 + (ka) * 2), hi = *(const uint2*)(sv1 + (ka) * 2 + 16); \
        bf16x8 va = __builtin_bit_cast(bf16x8, uint4{lo.x, lo.y, hi.x, hi.y}); O1 = __builtin_amdgcn_mfma_f32_32x32x16_bf16(va, pb, O1, 0, 0, 0); } }
    SB();
    { bf16x8 pb = PACK8(S0, 0); PV_STEP(pb, 0) }
    { bf16x8 pb = PACK8(S0, 1); PV_STEP(pb, 16) }
    SB();
    { bf16x8 pb = PACK8(S1, 0); PV_STEP(pb, 32) }
    { bf16x8 pb = PACK8(S1, 1); PV_STEP(pb, 48) }
    SB();
    if (j + 1 < ntiles) {
      attn_sstore<NS>(smem + ((j + 1) & 1) * STG, rk0, rk1, rk2, rv0, rv1);
      if (j + 2 < ntiles) TILE_GLOAD(j + 2)
    }
    __syncthreads();
  }
#undef TILE_GLOAD
  const float inv = 1.f / l_run;
#pragma unroll
  for (int e4 = 0; e4 < 4; ++e4) {
    uint2 o;
    o.x = pack2(O0[4 * e4] * inv, O0[4 * e4 + 1] * inv); o.y = pack2(O0[4 * e4 + 2] * inv, O0[4 * e4 + 3] * inv);
    *(uint2*)(yrow + 8 * e4 + 4 * hh) = o;
    o.x = pack2(O1[4 * e4] * inv, O1[4 * e4 + 1] * inv); o.y = pack2(O1[4 * e4 + 2] * inv, O1[4 * e4 + 3] * inv);
    *(uint2*)(yrow + 32 + 8 * e4 + 4 * hh) = o;
  }
}

template <int MODE>
DI void scan_seg(const Params& p, int l, int seq, int blk, int d, int seg, char* smem) {
  const int t = tid(), lane = t & 63, w = t >> 6;
  const int c16 = lane & 15, g4 = lane >> 4;
  const bool is_ctx = seq < 16;
  const int b = is_ctx ? seq : seq - 16;
  const int L = is_ctx ? 256 : 4096;
  const int gbase = is_ctx ? b * 256 : T_CTX + b * 4096;
  const u16* XR = wsp<u16>(p, O_XR);
  u16* Y = wsp<u16>(p, O_YRNN);
  float* SUM = wsp<float>(p, O_SUM);
  char* sXc = smem;
  float* sA = (float*)(smem + 8704);
  float* sU = (float*)(smem + 8704 + 16384);
  const int cch = t & 127, th = t >> 7;
  const int chg = blk * 128 + cch;
  const float w0 = p.conv_w[(l * 4 + 0) * 1024 + chg], w1 = p.conv_w[(l * 4 + 1) * 1024 + chg];
  const float w2 = p.conv_w[(l * 4 + 2) * 1024 + chg], w3 = p.conv_w[(l * 4 + 3) * 1024 + chg];
  const float cb = p.conv_b[l * 1024 + chg];
  bf16x8 bw[4][4];
  {
    const u16* WL = wsw(p, l, O_WLRU) + (size_t)(d * 8 + blk) * 256 * 128 + (size_t)(32 * w + c16) * 128 + g4 * 8;
#pragma unroll
    for (int nf = 0; nf < 4; ++nf)
#pragma unroll
      for (int ks = 0; ks < 4; ++ks)
        bw[nf][ks] = *(const bf16x8*)(WL + (size_t)((nf & 1) * 16 + (nf >> 1) * 128) * 128 + ks * 32);
  }
  float ba[2], bi[2], cl[2];
#pragma unroll
  for (int jn = 0; jn < 2; ++jn) {
    const int ch = (l * 2 + d) * 1024 + blk * 128 + 32 * w + 16 * jn + c16;
    ba[jn] = p.lru_ba[ch]; bi[jn] = p.lru_bi[ch];
    cl[jn] = -8.f * log1pf(__expf(-p.lru_lam[ch]));
  }
  float h = 0.f, P = 1.f;
  if (MODE == 1 && !is_ctx && t < 128) {
    h = p.state[(((size_t)b * 4 + l) * 2 + d) * 1024 + blk * 128 + t];
    const float* sm = SUM + ((size_t)((b * 8 + blk) * 2 + d) * 16) * 256 + t;
    if (d == 0) { for (int s2 = 0; s2 < seg; ++s2) h = sm[s2 * 256] * h + sm[s2 * 256 + 128]; }
    else { for (int s2 = 15; s2 > seg; --s2) h = sm[s2 * 256] * h + sm[s2 * 256 + 128]; }
  }
#define X19(F) F(0) F(1) F(2) F(3) F(4) F(5) F(6) F(7) F(8) F(9) F(10) F(11) F(12) F(13) F(14) F(15) F(16) F(17) F(18)
#define XDECL(q) u16 xr##q = 0;
#define XLOAD(q) { const int pos = tcn + th * 16 - 1 + (q); xr##q = (pos >= 0 && pos < L) ? XR[(size_t)(gbase + pos) * 1024 + chg] : (u16)0; }
#define XCVT(q) xv[q] = bf2f(xr##q);
  X19(XDECL)
  { const int tcn = seg * 256 + (d == 0 ? 0 : 7) * 32; X19(XLOAD) }
  for (int ci = 0; ci < 8; ++ci) {
    const int tc0 = seg * 256 + (d == 0 ? ci : 7 - ci) * 32;
    {
      float xv[19];
      X19(XCVT)
#pragma unroll
      for (int q = 0; q < 16; ++q) {
        float xc = cb + w0 * xv[q] + w1 * xv[q + 1] + w2 * xv[q + 2] + w3 * xv[q + 3];
        *(u16*)(sXc + (th * 16 + q) * 272 + cch * 2) = f2bf(xc);
      }
    }
    unsigned yold0 = 0, yold1 = 0, yold2 = 0, yold3 = 0, yold4 = 0, yold5 = 0, yold6 = 0, yold7 = 0;
    {
      const int cn = ci < 7 ? ci + 1 : ci;
      const int tcn = seg * 256 + (d == 0 ? cn : 7 - cn) * 32;
      X19(XLOAD)
      if (MODE == 1 && d == 1) {
        const unsigned* yb = (const unsigned*)(Y + (size_t)(gbase + tc0 + (t >> 6)) * 1024 + blk * 128 + (t & 63) * 2);
        yold0 = yb[0]; yold1 = yb[4 * 512]; yold2 = yb[8 * 512]; yold3 = yb[12 * 512];
        yold4 = yb[16 * 512]; yold5 = yb[20 * 512]; yold6 = yb[24 * 512]; yold7 = yb[28 * 512];
      }
    }
    MB();
    __syncthreads();
    f32x4 aR[2][2], aI[2][2];
#pragma unroll
    for (int im = 0; im < 2; ++im)
#pragma unroll
      for (int jn = 0; jn < 2; ++jn) { aR[im][jn] = f32x4{0.f, 0.f, 0.f, 0.f}; aI[im][jn] = f32x4{0.f, 0.f, 0.f, 0.f}; }
#pragma unroll
    for (int ks = 0; ks < 4; ++ks)
#pragma unroll
      for (int im = 0; im < 2; ++im) {
        bf16x8 af = *(const bf16x8*)(sXc + (16 * im + c16) * 272 + (ks * 32 + g4 * 8) * 2);
#pragma unroll
        for (int jn = 0; jn < 2; ++jn) {
          aR[im][jn] = __builtin_amdgcn_mfma_f32_16x16x32_bf16(af, bw[jn][ks], aR[im][jn], 0, 0, 0);
          aI[im][jn] = __builtin_amdgcn_mfma_f32_16x16x32_bf16(af, bw[2 + jn][ks], aI[im][jn], 0, 0, 0);
        }
      }
#pragma unroll
    for (int im = 0; im < 2; ++im)
#pragma unroll
      for (int jn = 0; jn < 2; ++jn)
#pragma unroll
        for (int e = 0; e < 4; ++e) {
          const int tt = 16 * im + 4 * g4 + e, c = 32 * w + 16 * jn + c16;
          const float r = sigmoidf_(aR[im][jn][e] + ba[jn]);
          const float ig = sigmoidf_(aI[im][jn][e] + bi[jn]);
          const float a = __expf(cl[jn] * r);
          const float xc = bf2f(*(const u16*)(sXc + tt * 272 + c * 2));
          const float u = __builtin_amdgcn_sqrtf(fmaxf(1.f - a * a, 0.f)) * ig * xc;
          sA[tt * 128 + c] = a; sU[tt * 128 + c] = u;
        }
    __syncthreads();
    if (t < 128) {
      if (d == 0) {
#pragma unroll 8
        for (int s = 0; s < 32; ++s) {
          const float a = sA[s * 128 + t];
          h = a * h + sU[s * 128 + t];
          if (MODE == 0) P *= a; else sU[s * 128 + t] = h;
        }
      } else {
#pragma unroll 8
        for (int s = 31; s >= 0; --s) {
          const float a = sA[s * 128 + t];
          h = a * h + sU[s * 128 + t];
          if (MODE == 0) P *= a; else sU[s * 128 + t] = h;
        }
      }
    }
    __syncthreads();
    if (MODE == 1) {
      const int c2 = (t & 63) * 2;
      unsigned* yb = (unsigned*)(Y + (size_t)(gbase + tc0 + (t >> 6)) * 1024 + blk * 128 + c2);
      const float* su = sU + (t >> 6) * 128 + c2;
#define YOUT(i, yo) { float h0 = su[(4 * (i)) * 128], h1 = su[(4 * (i)) * 128 + 1]; \
        if (d == 1) { h0 += __uint_as_float((yo) << 16); h1 += __uint_as_float((yo) & 0xffff0000u); } \
        yb[(size_t)(4 * (i)) * 512] = pack2(h0, h1); }
      YOUT(0, yold0) YOUT(1, yold1) YOUT(2, yold2) YOUT(3, yold3) YOUT(4, yold4) YOUT(5, yold5) YOUT(6, yold6) YOUT(7, yold7)
#undef YOUT
    }
  }
#undef X19
#undef XDECL
#undef XLOAD
#undef XCVT
  if (MODE == 0) {
    if (t < 128) {
      float* sm = SUM + ((size_t)(((b * 8 + blk) * 2 + d) * 16 + seg)) * 256 + t;
      sm[0] = P; sm[128] = h;
    }
  } else if (is_ctx && t < 128) {
    p.out[OUT_RG + (((size_t)b * 4 + l) * 2 + d) * 1024 + blk * 128 + t] = h;
  }
  __syncthreads();
}

DI void phase_mix(const Params& p, int l, char* smem) {
  constexpr float LOG2E = 1.4426950408889634f;
  constexpr int N0 = 1024, N1 = N0 + 2048, N2 = N1 + 2048, N3 = N2 + 128, N4 = N3 + 256, N5 = N4 + 256;
  for (int base = 0; base < N5; base += gridDim.x) {
    const int vit = xcd_map(base);
    if (vit >= N5) continue;
    const int it = vit < N0 ? vit : (vit < N0 + 128 ? N2 + (vit - N0) : (vit < N3 ? vit - 128 : vit));
    const int t = tid(), lane = t & 63, w = t >> 6;
    const int r32 = lane & 31;
    if (it < N0 || (it >= N2 && it < N3)) {
      int seq, blk, seg;
      if (it < N0) { seg = it & 15; blk = (it >> 4) & 7; seq = 16 + (it >> 7); }
      else { const int i = it - N2; seg = 0; blk = i & 7; seq = i >> 3; }
      scan_seg<1>(p, l, seq, blk, 0, seg, smem);
      scan_seg<1>(p, l, seq, blk, 1, seg, smem);
#if PROBE == 4
      scan_seg<1>(p, l, seq, blk, 0, seg, smem);
      scan_seg<1>(p, l, seq, blk, 1, seg, smem);
#endif
    } else if (it < N1 || (it >= N3 && it < N4)) {
      const bool lat = it < N1;
      int b, h, qb;
      if (lat) { const int i = it - N0; qb = i & 31; h = (i >> 5) & 7; b = i >> 8; }
      else { const int i = it - N3; qb = i & 1; h = (i >> 1) & 7; b = i >> 4; }
      const int Lk = lat ? LK_LAT : 256;
      const int gq = (lat ? T_CTX + b * 4096 : b * 256) + qb * 128 + w * 32 + r32;
      const u16* Kn = (lat ? wsp<u16>(p, O_KNL) : wsp<u16>(p, O_KNC)) + ((size_t)b * 8 + h) * Lk * 64;
      const u16* Kr = (lat ? wsp<u16>(p, O_KRL) : wsp<u16>(p, O_KRC)) + (size_t)b * Lk * 32;
      const u16* Vt = (lat ? wsp<u16>(p, O_VTL) : wsp<u16>(p, O_VTC)) + ((size_t)b * 8 + h) * 64 * Lk;
      const u16* Q = wsp<u16>(p, O_Q) + (size_t)gq * 768;
      u16* yrow = wsp<u16>(p, O_CQ) + (size_t)gq * 512 + h * 64;
      attn_item<6>(Kn, 64, Kr, Vt, Lk, Lk >> 6, 0, 0, nullptr, 0, nullptr, 0, 0,
                   Q + h * 64, Q + 512 + h * 32, 0.10206207261596577f * LOG2E, -1e30f, 0.f, 0, yrow, smem);
#if PROBE == 5
      __syncthreads();
      attn_item<6>(Kn, 64, Kr, Vt, Lk, Lk >> 6, 0, 0, nullptr, 0, nullptr, 0, 0,
                   Q + h * 64, Q + 512 + h * 32, 0.10206207261596577f * LOG2E, -1e30f, 0.f, 0, yrow, smem);
#endif
    } else {
      const bool lat = it < N2;
      int b, h, qb;
      if (lat) { const int i = it - N1; qb = i & 31; h = (i >> 5) & 7; b = i >> 8; }
      else { const int i = it - N4; qb = i & 1; h = (i >> 1) & 7; b = i >> 4; }
      const int kvh = h >> 2;
      const int gseq = lat ? T_CTX + b * 4096 : b * 256;
      const int qpos = qb * 128 + w * 32 + r32;
      const int gq = gseq + qpos;
      u16* qrow = wsp<u16>(p, O_QS) + (size_t)gq * 512 + h * 64;
      const float sink2 = p.sink[l * 8 + h] * LOG2E;
      const int t0 = qb * 128;
      int jlo = 0, jhi = 6;
      if (t0 == 0) jlo = 2;
      if (t0 + 128 >= 4096) jhi = 4;
      const int ks0 = lat ? t0 - 128 + 64 * jlo : 0;
      const int nA = lat ? jhi - jlo : 4;
      const u16* KS = wsp<u16>(p, O_KS) + (size_t)(gseq + ks0) * 128 + kvh * 64;
      const u16* VT = lat ? wsp<u16>(p, O_VTSL) + ((size_t)b * 2 + kvh) * 64 * 4096 + ks0
                          : wsp<u16>(p, O_VTSC) + ((size_t)b * 2 + kvh) * 64 * 256;
      const u16* KC = wsp<u16>(p, O_KSC) + (size_t)b * 256 * 128 + kvh * 64;
      const u16* VC = wsp<u16>(p, O_VTSCC) + ((size_t)b * 2 + kvh) * 64 * 256;
      attn_item<4>(KS, 128, nullptr, VT, lat ? 4096 : 256, nA, ks0, lat ? 1 : 0, KC, 128, VC, 256, lat ? 4 : 0,
                   qrow, nullptr, 0.125f * LOG2E, sink2, 1.f, qpos, qrow, smem);
    }
    __syncthreads();
  }
}

DI void phase_gate(const Params& p, int l, char* smem) {
  const u16* H = wsp<u16>(p, O_H);
  const u16* W = wsw(p, l, O_WINB);
  for (int base = 0; base < 288 * 40; base += gridDim.x) {
    const int tile = xcd_map(base);
    if (tile >= 288 * 40) continue;
    const int sb = tile >> 6, jj = tile & 63;
    const int mt = (sb / 5) * 8 + (jj >> 3), nt = (sb % 5) * 8 + (jj & 7);
    const int g0 = mt * 128;
    f32x4 acc[4][4];
    zero_acc(acc);
    gemm_tile(H + (size_t)g0 * 1024, 1024, W + (size_t)nt * 128 * 1024, 1024, 1024, acc, smem);
    LANEVARS
    if (nt < 16) {
      u16* dst; int ld, cb;
      if (nt < 8) { dst = wsp<u16>(p, O_YRNN); ld = 1024; cb = nt * 128; }
      else if (nt < 12) { dst = wsp<u16>(p, O_CQ); ld = 512; cb = (nt - 8) * 128; }
      else { dst = wsp<u16>(p, O_QS); ld = 512; cb = (nt - 12) * 128; }
#pragma unroll
      for (int i = 0; i < 4; ++i)
#pragma unroll
        for (int j = 0; j < 4; ++j)
#pragma unroll
          for (int e = 0; e < 4; ++e) {
            const int g = g0 + wr * 64 + i * 16 + g4 * 4 + e;
            u16* d = dst + (size_t)g * ld + cb + wc * 64 + j * 16 + c16;
            const float gv = acc[i][j][e];
            *d = f2bf(bf2f(*d) * gv * sigmoidf_(gv));
            if (e == 3) SB();
          }
    } else {
      const int br = (nt - 16) >> 3, cb = ((nt - 16) & 7) * 128;
      u16* dst = br == 0 ? wsp<u16>(p, O_XR) : wsp<u16>(p, O_KS) + (size_t)(br - 1) * T_ALL * 1024;
#pragma unroll
      for (int i = 0; i < 4; ++i)
#pragma unroll
        for (int j = 0; j < 4; ++j)
#pragma unroll
          for (int e = 0; e < 4; ++e) {
            const int g = g0 + wr * 64 + i * 16 + g4 * 4 + e;
            dst[(size_t)g * 1024 + cb + wc * 64 + j * 16 + c16] = f2bf(sigmoidf_(acc[i][j][e]));
            if (e == 3) SB();
          }
    }
  }
}

DI void phase_merge(const Params& p, int l, char* smem) {
  u16* U = wsp<u16>(p, O_H);
  for (int base = 0; base < 288 * 8; base += gridDim.x) {
    const int tile = xcd_map(base);
    if (tile >= 288 * 8) continue;
    const int mt = tile >> 3, nt = tile & 7;
    const int g0 = mt * 128;
    f32x4 u[4][4];
    zero_acc(u);
    for (int br = 0; br < 3; ++br) {
      f32x4 acc[4][4];
      zero_acc(acc);
      const u16* Z; const u16* WT; int kz; const u16* M;
      if (br == 0) { Z = wsp<u16>(p, O_YRNN) + (size_t)g0 * 1024; WT = wsw(p, l, O_WBRR) + (size_t)nt * 128 * 1024; kz = 1024; M = wsp<u16>(p, O_XR); }
      else if (br == 1) { Z = wsp<u16>(p, O_CQ) + (size_t)g0 * 512; WT = wsw(p, l, O_WBRM) + (size_t)nt * 128 * 512; kz = 512; M = wsp<u16>(p, O_KS); }
      else { Z = wsp<u16>(p, O_QS) + (size_t)g0 * 512; WT = wsw(p, l, O_WBRS) + (size_t)nt * 128 * 512; kz = 512; M = wsp<u16>(p, O_KS) + (size_t)T_ALL * 1024; }
      gemm_tile(Z, kz, WT, kz, kz, acc, smem);
      LANEVARS
#pragma unroll
      for (int i = 0; i < 4; ++i)
#pragma unroll
        for (int j = 0; j < 4; ++j)
#pragma unroll
          for (int e = 0; e < 4; ++e) {
            const int g = g0 + wr * 64 + i * 16 + g4 * 4 + e;
            u[i][j][e] += bf2f(M[(size_t)g * 1024 + nt * 128 + wc * 64 + j * 16 + c16]) * acc[i][j][e];
            if (e == 3) SB();
          }
    }
    LANEVARS
#pragma unroll
    for (int i = 0; i < 4; ++i)
#pragma unroll
      for (int j = 0; j < 4; ++j)
#pragma unroll
        for (int e = 0; e < 4; ++e) {
          const int g = g0 + wr * 64 + i * 16 + g4 * 4 + e;
          U[(size_t)g * 1024 + nt * 128 + wc * 64 + j * 16 + c16] = f2bf(u[i][j][e]);
        }
  }
}

DI void phase_out(const Params& p, int l, char* smem) {
  const u16* U = wsp<u16>(p, O_H);
  const u16* W = wsw(p, l, O_WOUT);
  const float* MOD = wsp<float>(p, O_MOD) + (size_t)l * 9 * 3072;
  for (int base = 0; base < 288 * 8; base += gridDim.x) {
    const int tile = xcd_map(base);
    if (tile >= 288 * 8) continue;
    const int mt = tile >> 3, nt = tile & 7;
    const int g0 = mt * 128;
    const int ci = g0 < T_CTX ? 8 : ((g0 - T_CTX) >> 12);
    f32x4 acc[4][4];
    zero_acc(acc);
    gemm_tile(U + (size_t)g0 * 1024, 1024, W + (size_t)nt * 128 * 1024, 1024, 1024, acc, smem);
    LANEVARS
#pragma unroll
    for (int j = 0; j < 4; ++j) {
      const int col = nt * 128 + wc * 64 + j * 16 + c16;
      const float gt = MOD[ci * 3072 + 2048 + col];
#pragma unroll
      for (int i = 0; i < 4; ++i)
#pragma unroll
        for (int e = 0; e < 4; ++e) {
          const int g = g0 + wr * 64 + i * 16 + g4 * 4 + e;
          const float xo = xin_row(p, l, g)[col];
          p.out[(size_t)g * 1024 + col] = xo + gt * acc[i][j][e];
          if (e == 3) SB();
        }
    }
  }
}

DI void phase_final(const Params& p) {
  const int t = tid(), lane = t & 63, w = t >> 6;
  for (int row = blockIdx.x * 4 + w; row < T_ALL; row += gridDim.x * 4) {
    float* x = p.out + (size_t)row * 1024;
    float4 v[4];
    float ss = 0.f;
#pragma unroll
    for (int i = 0; i < 4; ++i) {
      v[i] = *(const float4*)(x + i * 256 + lane * 4);
      ss += v[i].x * v[i].x + v[i].y * v[i].y + v[i].z * v[i].z + v[i].w * v[i].w;
    }
    ss = wave_sum(ss);
    const float rs = rsqrtf(ss * (1.f / 1024.f) + EPS);
#pragma unroll
    for (int i = 0; i < 4; ++i) {
      const int c = i * 256 + lane * 4;
      const float4 g = *(const float4*)(p.final_norm + c);
      float4 o = {v[i].x * rs * g.x, v[i].y * rs * g.y, v[i].z * rs * g.z, v[i].w * rs * g.w};
      *(float4*)(x + c) = o;
    }
  }
}

constexpr int NPHASE_PER_LAYER = 7;
DI void run_phase(const Params& p, int ph, char* smem) {
  if (ph == 0) { phase_mod(p, smem); return; }
  if (ph == 1 + NLAYER * NPHASE_PER_LAYER) { phase_final(p); return; }
  const int l = (ph - 1) / NPHASE_PER_LAYER, s = (ph - 1) % NPHASE_PER_LAYER;
  switch (s) {
    case 0: phase_prep(p, l); break;
    case 1: phase_gemmA(p, l, smem); break;
    case 2: phase_qkv(p, l, smem); break;
    case 3: phase_mix(p, l, smem); break;
    case 4: phase_gate(p, l, smem); break;
    case 5: phase_merge(p, l, smem); break;
    default: phase_out(p, l, smem); break;
  }
}
constexpr int NPHASE = 2 + NLAYER * NPHASE_PER_LAYER;

#if MEGA
DI Params launder(const Params& p) {
  size_t z = 0;
  asm volatile("" : "+s"(z));
  Params q = p; q.ws = p.ws + z; q.out = p.out + z;
  return q;
}
struct XBar { unsigned* base; unsigned xcc; unsigned nloc; unsigned nx; };
#define XB_CENSUS(j) (64 * (j))
#define XB_XSUB(j) (1024 + 64 * (j))
#define XB_XGEN(j) (2048 + 64 * (j))
#define XB_TOP 3072
#define XB_TOPGEN 3136
DI unsigned xb_ld(unsigned* p) { return __hip_atomic_load(p, __ATOMIC_RELAXED, __HIP_MEMORY_SCOPE_AGENT); }
DI unsigned xb_add(unsigned* p, unsigned v) { return __hip_atomic_fetch_add(p, v, __ATOMIC_RELAXED, __HIP_MEMORY_SCOPE_AGENT); }
DI void xbar_post(XBar& xb, unsigned* base) {
  xb.base = base; xb.nloc = 0; xb.nx = 0;
  xb.xcc = (unsigned)__builtin_amdgcn_s_getreg((3 << 11) | 20) & 0xFu;
  if (threadIdx.x == 0) xb_add(&base[XB_CENSUS(xb.xcc)], 1u);
}
DI void xbar_census(XBar& xb) {
  unsigned nx = 0;
  for (int j = 0; j < 16; ++j) nx += xb_ld(&xb.base[XB_CENSUS(j)]) ? 1u : 0u;
  xb.nx = nx; xb.nloc = xb_ld(&xb.base[XB_CENSUS(xb.xcc)]);
}
DI void xbar_sync(const XBar& xb) {
  asm volatile("s_waitcnt vmcnt(0)" ::: "memory");
  __syncthreads();
  if (threadIdx.x == 0) {
    unsigned* bar = xb.base;
    const unsigned old = xb_add(&bar[XB_XSUB(xb.xcc)], 1u);
    const unsigned gen = old / xb.nloc;
    if (old + 1u == (gen + 1u) * xb.nloc) {
      __builtin_amdgcn_fence(__ATOMIC_RELEASE, "agent");
      asm volatile("s_waitcnt vmcnt(0)" ::: "memory");
      const unsigned og = xb_add(&bar[XB_TOP], 1u);
      const unsigned tg = og / xb.nx;
      if (og + 1u == (tg + 1u) * xb.nx) xb_add(&bar[XB_TOPGEN], 1u);
      else { unsigned sp = 0; while (xb_ld(&bar[XB_TOPGEN]) == tg) { __builtin_amdgcn_s_sleep(1); if (++sp > (1u << 22)) break; } }
      __builtin_amdgcn_fence(__ATOMIC_ACQUIRE, "agent");
      xb_add(&bar[XB_XGEN(xb.xcc)], 1u);
      asm volatile("s_waitcnt vmcnt(0)" ::: "memory");
    } else {
      unsigned sp = 0;
      while (xb_ld(&bar[XB_XGEN(xb.xcc)]) == gen) { __builtin_amdgcn_s_sleep(1); if (++sp > (1u << 22)) break; }
      __builtin_amdgcn_fence(__ATOMIC_ACQUIRE, "agent");
      asm volatile("s_waitcnt vmcnt(0)" ::: "memory");
    }
  }
  __syncthreads();
}
#define GSYNC() xbar_sync(xb)
__global__ void __launch_bounds__(256, 2) mega_kernel(Params p) {
  __shared__ __attribute__((aligned(16))) char smem[66048];
  cg::grid_group grid = cg::this_grid();
  XBar xb;
  xbar_post(xb, (unsigned*)(p.ws + O_BAR));
  phase_mod(launder(p), smem);
  convert_weights(launder(p), 0);
  grid.sync();
  xbar_census(xb);
  for (int l = 0; l < NLAYER; ++l) {
    phase_prep(launder(p), l);
    GSYNC();
#if PROBE == 1
    phase_prep(launder(p), l);
    GSYNC();
#endif
    phase_gemmA(launder(p), l, smem);
    GSYNC();
#if PROBE == 2
    phase_gemmA(launder(p), l, smem);
    GSYNC();
#endif
    phase_qkv(launder(p), l, smem);
    GSYNC();
    phase_mix(launder(p), l, smem);
    if (l + 1 < NLAYER) convert_weights(launder(p), l + 1);
    GSYNC();
    phase_gate(launder(p), l, smem);
    GSYNC();
    phase_merge(launder(p), l, smem);
    GSYNC();
#if PROBE == 3
    phase_merge(launder(p), l, smem);
    GSYNC();
#endif
    phase_out(launder(p), l, smem);
    GSYNC();
  }
  phase_final(launder(p));
}

#else
__global__ void __launch_bounds__(256, 2) phase_kernel(Params p, int ph) {
  __shared__ __attribute__((aligned(16))) char smem[66048];
  run_phase(p, ph, smem);
}

#endif
extern "C" void kernel_launch(void* const* d_in, const int* in_sizes, int n_in, void* d_out, int out_size, void* d_ws,
                              size_t ws_size, hipStream_t stream) {
  Params p{};
  const float** pp = (const float**)&p;
  for (int i = 0; i < 30; ++i) pp[i] = (const float*)d_in[i];
  p.out = (float*)d_out;
  p.ws = (char*)d_ws;
  if (ws_size < WS_NEED) fprintf(stderr, "workspace too small: %zu < %zu\n", ws_size, (size_t)WS_NEED);
#if MEGA
  static int grid_blocks = 0;
  if (!grid_blocks) {
    int dev = 0, cus = 0, per_cu = 0;
    hipGetDevice(&dev);
    hipDeviceGetAttribute(&cus, hipDeviceAttributeMultiprocessorCount, dev);
    hipOccupancyMaxActiveBlocksPerMultiprocessor(&per_cu, mega_kernel, 256, 0);
    if (per_cu > 2) per_cu = 2;
    grid_blocks = cus * per_cu;
  }
  (void)hipMemsetAsync((char*)d_ws + O_BAR, 0, BAR_BYTES, stream);
  void* args[] = {&p};
  hipError_t e = hipLaunchCooperativeKernel((void*)mega_kernel, dim3(grid_blocks), dim3(256), args, 0, stream);
  if (e != hipSuccess) fprintf(stderr, "cooperative launch failed: %s (grid %d)\n", hipGetErrorString(e), grid_blocks);
#else
  for (int ph = 0; ph < NPHASE; ++ph) phase_kernel<<<512, 256, 0, stream>>>(p, ph);
#endif
}
```

```cpp
#include <hip/hip_runtime.h>
#include <hip/hip_cooperative_groups.h>
#include <cstdio>
#include <cstdint>
namespace cg = cooperative_groups;

#ifndef PROBE
#define PROBE 0
#endif
#ifndef MEGA
#define MEGA 1
#endif

typedef unsigned short u16;
using bf16x8 = __attribute__((ext_vector_type(8))) short;
using f32x4 = __attribute__((ext_vector_type(4))) float;
using f32x16 = __attribute__((ext_vector_type(16))) float;
typedef __bf16 bf2_t __attribute__((ext_vector_type(2)));
typedef float f2_t __attribute__((ext_vector_type(2)));
#define DI __device__ __forceinline__

__device__ const float TAB_M[1024] = {
  1.00000000e+00f, 0.00000000e+00f, 1.00000000e+00f, 0.00000000e+00f, 1.00000000e+00f, 0.00000000e+00f, 1.00000000e+00f, 0.00000000e+00f,
  1.00000000e+00f, 0.00000000e+00f, 1.00000000e+00f, 0.00000000e+00f, 1.00000000e+00f, 0.00000000e+00f, 1.00000000e+00f, 0.00000000e+00f,
  5.40302277e-01f, 8.41470957e-01f, 9.50415254e-01f, 3.10983598e-01f, 9.95004177e-01f, 9.98334214e-02f, 9.99500036e-01f, 3.16175036e-02f,
  9.99949992e-01f, 9.99983307e-03f, 9.99994993e-01f, 3.16227227e-03f, 9.99999523e-01f, 9.99999931e-04f, 9.99999940e-01f, 3.16227757e-04f,
  -4.16146845e-01f, 9.09297407e-01f, 8.06578398e-01f, 5.91127098e-01f, 9.80066597e-01f, 1.98669329e-01f, 9.98000681e-01f, 6.32033944e-02f,
  9.99800026e-01f, 1.99986659e-02f, 9.99979973e-01f, 6.32451288e-03f, 9.99997973e-01f, 1.99999870e-03f, 9.99999821e-01f, 6.32455456e-04f,
  -9.89992499e-01f, 1.41120002e-01f, 5.82753658e-01f, 8.12648892e-01f, 9.55336511e-01f, 2.95520216e-01f, 9.95503366e-01f, 9.47260857e-02f,
  9.99550045e-01f, 2.99954992e-02f, 9.99954998e-01f, 9.48669016e-03f, 9.99995530e-01f, 2.99999560e-03f, 9.99999523e-01f, 9.48683126e-04f,
  -6.53643608e-01f, -7.56802499e-01f, 3.01137477e-01f, 9.53580737e-01f, 9.21060979e-01f, 3.89418334e-01f, 9.92010653e-01f, 1.26154065e-01f,
  9.99200106e-01f, 3.99893336e-02f, 9.99920011e-01f, 1.26487734e-02f, 9.99992013e-01f, 3.99998948e-03f, 9.99999225e-01f, 1.26491068e-03f,
  2.83662200e-01f, -9.58924294e-01f, -1.03423381e-02f, 9.99946535e-01f, 8.77582550e-01f, 4.79425550e-01f, 9.87526000e-01f, 1.57455876e-01f,
  9.98750269e-01f, 4.99791652e-02f, 9.99875009e-01f, 1.58107281e-02f, 9.99987483e-01f, 4.99997940e-03f, 9.99998748e-01f, 1.58113812e-03f,
  9.60170269e-01f, -2.79415488e-01f, -3.20796400e-01f, 9.47148204e-01f, 8.25335622e-01f, 5.64642489e-01f, 9.82053936e-01f, 1.88600272e-01f,
  9.98200536e-01f, 5.99640049e-02f, 9.99819994e-01f, 1.89725272e-02f, 9.99981999e-01f, 5.99996420e-03f, 9.99998212e-01f, 1.89736532e-03f,
  7.53902256e-01f, 6.56986594e-01f, -5.99437475e-01f, 8.00421596e-01f, 7.64842212e-01f, 6.44217670e-01f, 9.75599885e-01f, 2.19556093e-01f,
  9.97551024e-01f, 6.99428469e-02f, 9.99755025e-01f, 2.21341345e-02f, 9.99975502e-01f, 6.99994294e-03f, 9.99997556e-01f, 2.21359241e-03f,
  -1.45500034e-01f, 9.89358246e-01f, -8.18632424e-01f, 5.74317753e-01f, 6.96706712e-01f, 7.17356086e-01f, 9.68170285e-01f, 2.50292331e-01f,
  9.96801734e-01f, 7.99146891e-02f, 9.99680042e-01f, 2.52955221e-02f, 9.99967992e-01f, 7.99991470e-03f, 9.99996781e-01f, 2.52981926e-03f,
  -9.11130250e-01f, 4.12118495e-01f, -9.56644177e-01f, 2.91259229e-01f, 6.21609926e-01f, 7.83326924e-01f, 9.59772646e-01f, 2.80778319e-01f,
  9.95952725e-01f, 8.98785442e-02f, 9.99595046e-01f, 2.84566563e-02f, 9.99959528e-01f, 8.99987947e-03f, 9.99995947e-01f, 2.84604589e-03f,
  -8.39071512e-01f, -5.44021130e-01f, -9.99786079e-01f, -2.06835698e-02f, 5.40302277e-01f, 8.41470957e-01f, 9.50415313e-01f, 3.10983568e-01f,
  9.95004177e-01f, 9.98334140e-02f, 9.99500036e-01f, 3.16175036e-02f, 9.99949992e-01f, 9.99983400e-03f, 9.99994993e-01f, 3.16227227e-03f,
  4.42569796e-03f, -9.99990225e-01f, -9.43779767e-01f, -3.30574960e-01f, 4.53596085e-01f, 8.91207397e-01f, 9.40107584e-01f, 3.40877861e-01f,
  9.93956089e-01f, 1.09778300e-01f, 9.99395072e-01f, 3.47780399e-02f, 9.99939501e-01f, 1.09997792e-02f, 9.99993920e-01f, 3.47849843e-03f,
  8.43853951e-01f, -5.36572933e-01f, -7.94179380e-01f, -6.07683420e-01f, 3.62357706e-01f, 9.32039082e-01f, 9.28859890e-01f, 3.70431304e-01f,
  9.92808640e-01f, 1.19712204e-01f, 9.99280095e-01f, 3.79382223e-02f, 9.99927998e-01f, 1.19997123e-02f, 9.99992788e-01f, 3.79472389e-03f,
  9.07446802e-01f, 4.20167029e-01f, -5.65820515e-01f, -8.24528456e-01f, 2.67498761e-01f, 9.63558197e-01f, 9.16683376e-01f, 3.99614304e-01f,
  9.91561890e-01f, 1.29634142e-01f, 9.99155104e-01f, 4.10980321e-02f, 9.99915481e-01f, 1.29996343e-02f, 9.99991536e-01f, 4.11094911e-03f,
  1.36737213e-01f, 9.90607381e-01f, -2.81349480e-01f, -9.59605396e-01f, 1.69967160e-01f, 9.85449731e-01f, 9.03590262e-01f, 4.28397775e-01f,
  9.90216017e-01f, 1.39543116e-01f, 9.99020159e-01f, 4.42574248e-02f, 9.99902010e-01f, 1.39995432e-02f, 9.99990225e-01f, 4.42717411e-03f,
  -7.59687901e-01f, 6.50287867e-01f, 3.10223512e-02f, -9.99518692e-01f, 7.07371980e-02f, 9.97494996e-01f, 8.89593601e-01f, 4.56752867e-01f,
  9.88771081e-01f, 1.49438128e-01f, 9.98875201e-01f, 4.74163815e-02f, 9.99887526e-01f, 1.49994381e-02f, 9.99988735e-01f, 4.74339863e-03f,
  -9.57659483e-01f, -2.87903309e-01f, 3.40318173e-01f, -9.40310359e-01f, -2.91995462e-02f, 9.99573588e-01f, 8.74707460e-01f, 4.84651238e-01f,
  9.87227261e-01f, 1.59318209e-01f, 9.98720288e-01f, 5.05748577e-02f, 9.99872029e-01f, 1.59993190e-02f, 9.99987185e-01f, 5.05962269e-03f,
  -2.75163352e-01f, -9.61397469e-01f, 6.15864813e-01f, -7.87851870e-01f, -1.28844544e-01f, 9.91664827e-01f, 8.58946681e-01f, 5.12064993e-01f,
  9.85584795e-01f, 1.69182345e-01f, 9.98555362e-01f, 5.37328273e-02f, 9.99855518e-01f, 1.69991814e-02f, 9.99985576e-01f, 5.37584582e-03f,
  6.60316706e-01f, -7.50987232e-01f, 8.30336154e-01f, -5.57262897e-01f, -2.27202162e-01f, 9.73847628e-01f, 8.42327058e-01f, 5.38966715e-01f,
  9.83843684e-01f, 1.79029569e-01f, 9.98380423e-01f, 5.68902642e-02f, 9.99837995e-01f, 1.79990288e-02f, 9.99983788e-01f, 5.69206895e-03f,
  9.88704622e-01f, 1.49877205e-01f, 9.62463796e-01f, -2.71410108e-01f, -3.23289543e-01f, 9.46300089e-01f, 8.24865162e-01f, 5.65329552e-01f,
  9.82004225e-01f, 1.88858896e-01f, 9.98195529e-01f, 6.00471310e-02f, 9.99819517e-01f, 1.89988576e-02f, 9.99981940e-01f, 6.00829115e-03f,
  4.08082068e-01f, 9.12945271e-01f, 9.99144375e-01f, 4.13582884e-02f, -4.16146845e-01f, 9.09297407e-01f, 8.06578457e-01f, 5.91127038e-01f,
  9.80066597e-01f, 1.98669314e-01f, 9.98000681e-01f, 6.32033944e-02f, 9.99800026e-01f, 1.99986678e-02f, 9.99979973e-01f, 6.32451288e-03f,
  -5.47729254e-01f, 8.36655617e-01f, 9.36740458e-01f, 3.50024760e-01f, -5.04846215e-01f, 8.63209307e-01f, 7.87485182e-01f, 6.16333544e-01f,
  9.78030920e-01f, 2.08459899e-01f, 9.97795820e-01f, 6.63590282e-02f, 9.99779522e-01f, 2.09984574e-02f, 9.99977946e-01f, 6.64073415e-03f,
  -9.99960840e-01f, -8.85130931e-03f, 7.81440377e-01f, 6.23979926e-01f, -5.88501155e-01f, 8.08496356e-01f, 7.67604589e-01f, 6.40923738e-01f,
  9.75897431e-01f, 2.18229622e-01f, 9.97581005e-01f, 6.95140064e-02f, 9.99758005e-01f, 2.19982266e-02f, 9.99975801e-01f, 6.95695449e-03f,
  -5.32833040e-01f, -8.46220434e-01f, 5.48645258e-01f, 8.36055279e-01f, -6.66275978e-01f, 7.45705247e-01f, 7.46956408e-01f, 6.64873064e-01f,
  9.73666370e-01f, 2.27977514e-01f, 9.97356176e-01f, 7.26682767e-02f, 9.99735534e-01f, 2.29979735e-02f, 9.99973536e-01f, 7.27317436e-03f,
  4.24179018e-01f, -9.05578375e-01f, 2.61441678e-01f, 9.65219259e-01f, -7.37393796e-01f, 6.75463140e-01f, 7.25561321e-01f, 6.88157499e-01f,
  9.71337974e-01f, 2.37702623e-01f, 9.97121394e-01f, 7.58218244e-02f, 9.99711990e-01f, 2.39976961e-02f, 9.99971211e-01f, 7.58939330e-03f,
  9.91202831e-01f, -1.32351756e-01f, -5.16893305e-02f, 9.98663187e-01f, -8.01143587e-01f, 5.98472118e-01f, 7.03440726e-01f, 7.10753918e-01f,
  9.68912423e-01f, 2.47403964e-01f, 9.96876657e-01f, 7.89746121e-02f, 9.99687493e-01f, 2.49973964e-02f, 9.99968767e-01f, 7.90561177e-03f,
  6.46919310e-01f, 7.62558460e-01f, -3.59694332e-01f, 9.33070183e-01f, -8.56888831e-01f, 5.15501261e-01f, 6.80616796e-01f, 7.32639611e-01f,
  9.66389954e-01f, 2.57080555e-01f, 9.96621907e-01f, 8.21266174e-02f, 9.99662042e-01f, 2.59970706e-02f, 9.99966204e-01f, 8.22182931e-03f,
  -2.92138815e-01f, 9.56375957e-01f, -6.32028639e-01f, 7.74945021e-01f, -9.04072165e-01f, 4.27379847e-01f, 6.57112300e-01f, 7.53792703e-01f,
  9.63770926e-01f, 2.66731411e-01f, 9.96357203e-01f, 8.52777958e-02f, 9.99635518e-01f, 2.69967206e-02f, 9.99963522e-01f, 8.53804592e-03f,
  -9.62605894e-01f, 2.70905793e-01f, -8.41684937e-01f, 5.39968967e-01f, -9.42222297e-01f, 3.34988207e-01f, 6.32950664e-01f, 7.74192095e-01f,
  9.61055458e-01f, 2.76355654e-01f, 9.96082544e-01f, 8.84281173e-02f, 9.99608040e-01f, 2.79963426e-02f, 9.99960780e-01f, 8.85426160e-03f,
  -7.48057544e-01f, -6.63633883e-01f, -9.67871487e-01f, 2.51445323e-01f, -9.70958173e-01f, 2.39249229e-01f, 6.08156204e-01f, 7.93817401e-01f,
  9.58243906e-01f, 2.85952210e-01f, 9.95797932e-01f, 9.15775672e-02f, 9.99579549e-01f, 2.89959367e-02f, 9.99957979e-01f, 9.17047635e-03f,
  1.54251456e-01f, -9.88031626e-01f, -9.98075247e-01f, -6.20148405e-02f, -9.89992499e-01f, 1.41120002e-01f, 5.82753658e-01f, 8.12648892e-01f,
  9.55336511e-01f, 2.95520186e-01f, 9.95503366e-01f, 9.47260931e-02f, 9.99550045e-01f, 2.99955010e-02f, 9.99954998e-01f, 9.48669016e-03f,
  9.14742351e-01f, -4.04037654e-01f, -9.29300308e-01f, -3.69325012e-01f, -9.99135137e-01f, 4.15805206e-02f, 5.56768358e-01f, 8.30667794e-01f,
  9.52333570e-01f, 3.05058628e-01f, 9.95198846e-01f, 9.78736654e-02f, 9.99519527e-01f, 3.09950355e-02f, 9.99951959e-01f, 9.80290305e-03f,
  8.34223390e-01f, 5.51426709e-01f, -7.68367112e-01f, -6.40009403e-01f, -9.98294771e-01f, -5.83741926e-02f, 5.30226350e-01f, 8.47856104e-01f,
  9.49235439e-01f, 3.14566553e-01f, 9.94884372e-01f, 1.01020269e-01f, 9.99488056e-01f, 3.19945402e-02f, 9.99948800e-01f, 1.01191159e-02f,
  -1.32767474e-02f, 9.99911845e-01f, -5.31235278e-01f, -8.47224355e-01f, -9.87479806e-01f, -1.57745644e-01f, 5.03154159e-01f, 8.64196658e-01f,
  9.46042359e-01f, 3.24043006e-01f, 9.94559944e-01f, 1.04165860e-01f, 9.99455571e-01f, 3.29940096e-02f, 9.99945521e-01f, 1.04353270e-02f,
  -8.48570287e-01f, 5.29082716e-01f, -2.41421118e-01f, -9.70420420e-01f, -9.66798186e-01f, -2.55541205e-01f, 4.75578904e-01f, 8.79673064e-01f,
  9.42754686e-01f, 3.33487093e-01f, 9.94225562e-01f, 1.07310407e-01f, 9.99422073e-01f, 3.39934528e-02f, 9.99942183e-01f, 1.07515370e-02f,
  -9.03692186e-01f, -4.28182662e-01f, 7.23346695e-02f, -9.97380435e-01f, -9.36456680e-01f, -3.50783229e-01f, 4.47528064e-01f, 8.94269884e-01f,
  9.39372718e-01f, 3.42897803e-01f, 9.93881226e-01f, 1.10453881e-01f, 9.99387562e-01f, 3.49928550e-02f, 9.99938726e-01f, 1.10677453e-02f,
  -1.27963692e-01f, -9.91778851e-01f, 3.78916174e-01f, -9.25431013e-01f, -8.96758378e-01f, -4.42520559e-01f, 4.19029742e-01f, 9.07972515e-01f,
  9.35896814e-01f, 3.52274209e-01f, 9.93526995e-01f, 1.13596253e-01f, 9.99352098e-01f, 3.59922275e-02f, 9.99935210e-01f, 1.13839535e-02f,
  7.65414059e-01f, -6.43538117e-01f, 6.47921681e-01f, -7.61706948e-01f, -8.48100007e-01f, -5.29836178e-01f, 3.90112430e-01f, 9.20767248e-01f,
  9.32327330e-01f, 3.61615449e-01f, 9.93162811e-01f, 1.16737492e-01f, 9.99315560e-01f, 3.69915590e-02f, 9.99931574e-01f, 1.17001599e-02f,
  9.55073655e-01f, 2.96368569e-01f, 8.52673113e-01f, -5.22444785e-01f, -7.90967762e-01f, -6.11857831e-01f, 3.60805035e-01f, 9.32641268e-01f,
  9.28664625e-01f, 3.70920479e-01f, 9.92788672e-01f, 1.19877554e-01f, 9.99278069e-01f, 3.79908569e-02f, 9.99927819e-01f, 1.20163653e-02f,
  2.66642928e-01f, 9.63795364e-01f, 9.72865343e-01f, -2.31372014e-01f, -7.25932240e-01f, -6.87766254e-01f, 3.31136853e-01f, 9.43582714e-01f,
  9.24909055e-01f, 3.80188406e-01f, 9.92404640e-01f, 1.23016424e-01f, 9.99239624e-01f, 3.89901139e-02f, 9.99923944e-01f, 1.23325698e-02f,
  -6.66938066e-01f, 7.45113134e-01f, 9.96578991e-01f, 8.26458037e-02f, -6.53643608e-01f, -7.56802499e-01f, 3.01137596e-01f, 9.53580678e-01f,
  9.21060979e-01f, 3.89418334e-01f, 9.92010653e-01f, 1.26154065e-01f, 9.99200106e-01f, 3.99893373e-02f, 9.99920011e-01f, 1.26487734e-02f,
  -9.87339258e-01f, -1.58622667e-01f, 9.21462357e-01f, 3.88467699e-01f, -5.74824035e-01f, -8.18277061e-01f, 2.70837069e-01f, 9.62625206e-01f,
  9.17120814e-01f, 3.98609310e-01f, 9.91606772e-01f, 1.29290432e-01f, 9.99159634e-01f, 4.09885161e-02f, 9.99915957e-01f, 1.29649751e-02f,
  -3.99985313e-01f, -9.16521549e-01f, 7.54965365e-01f, 6.55764699e-01f, -4.90260571e-01f, -8.71575892e-01f, 2.40265876e-01f, 9.70707119e-01f,
  9.13088918e-01f, 4.07760441e-01f, 9.91192937e-01f, 1.32425532e-01f, 9.99118149e-01f, 4.19876575e-02f, 9.99911785e-01f, 1.32811759e-02f,
  5.55113316e-01f, -8.31774771e-01f, 5.13598442e-01f, 8.58030677e-01f, -4.00799006e-01f, -9.16166008e-01f, 2.09454417e-01f, 9.77818429e-01f,
  9.08965766e-01f, 4.16870773e-01f, 9.90769207e-01f, 1.35559291e-01f, 9.99075651e-01f, 4.29867506e-02f, 9.99907553e-01f, 1.35973748e-02f,
  9.99843299e-01f, 1.77019257e-02f, 2.21298173e-01f, 9.75206196e-01f, -3.07332784e-01f, -9.51602101e-01f, 1.78433523e-01f, 9.83951986e-01f,
  9.04751658e-01f, 4.25939471e-01f, 9.90335584e-01f, 1.38691694e-01f, 9.99032140e-01f, 4.39858064e-02f, 9.99903202e-01f, 1.39135728e-02f,
  5.25321960e-01f, 8.50903511e-01f, -9.29481089e-02f, 9.95670974e-01f, -2.10795805e-01f, -9.77530122e-01f, 1.47234216e-01f, 9.89101648e-01f,
  9.00447130e-01f, 4.34965521e-01f, 9.89892066e-01f, 1.41822711e-01f, 9.98987675e-01f, 4.49848175e-02f, 9.99898732e-01f, 1.42297689e-02f,
  -4.32177931e-01f, 9.01788354e-01f, -3.97976756e-01f, 9.17395473e-01f, -1.12152621e-01f, -9.93690968e-01f, 1.15887694e-01f, 9.93262351e-01f,
  8.96052480e-01f, 4.43948090e-01f, 9.89438653e-01f, 1.44952312e-01f, 9.98942196e-01f, 4.59837839e-02f, 9.99894202e-01f, 1.45459641e-02f,
  -9.92335498e-01f, 1.23573124e-01f, -6.63538277e-01f, 7.48142362e-01f, -1.23883775e-02f, -9.99923289e-01f, 8.44252855e-02f, 9.96429801e-01f,
  8.91568303e-01f, 4.52886283e-01f, 9.88975346e-01f, 1.48080453e-01f, 9.98895705e-01f, 4.69827019e-02f, 9.99889553e-01f, 1.48621574e-02f,
  -6.40144348e-01f, -7.68254638e-01f, -8.63296509e-01f, 5.04697084e-01f, 8.74991715e-02f, -9.96164620e-01f, 5.28784581e-02f, 9.98600960e-01f,
  8.86994898e-01f, 4.61779177e-01f, 9.88502085e-01f, 1.51207119e-01f, 9.98848200e-01f, 4.79815714e-02f, 9.99884784e-01f, 1.51783489e-02f,
  3.00592542e-01f, -9.53752637e-01f, -9.77442741e-01f, 2.11200655e-01f, 1.86512470e-01f, -9.82452571e-01f, 2.12787576e-02f, 9.99773562e-01f,
  8.82332861e-01f, 4.70625877e-01f, 9.88018990e-01f, 1.54332280e-01f, 9.98799741e-01f, 4.89803962e-02f, 9.99879956e-01f, 1.54945394e-02f,
  9.64965999e-01f, -2.62374848e-01f, -9.94656444e-01f, -1.03240460e-01f, 2.83662200e-01f, -9.58924294e-01f, -1.03422189e-02f, 9.99946535e-01f,
  8.77582550e-01f, 4.79425550e-01f, 9.87526000e-01f, 1.57455891e-01f, 9.98750269e-01f, 4.99791689e-02f, 9.99875009e-01f, 1.58107281e-02f,
  7.42154181e-01f, 6.70229197e-01f, -9.13230121e-01f, -4.07444149e-01f, 3.77977669e-01f, -9.25814748e-01f, -4.19528559e-02f, 9.99119580e-01f,
  8.72744501e-01f, 4.88177240e-01f, 9.87023175e-01f, 1.60577938e-01f, 9.98699784e-01f, 5.09778969e-02f, 9.99869943e-01f, 1.61269177e-02f,
  -1.62990779e-01f, 9.86627579e-01f, -7.41239965e-01f, -6.71240151e-01f, 4.68516916e-01f, -8.83454502e-01f, -7.35215396e-02f, 9.97293651e-01f,
  8.67819190e-01f, 4.96880114e-01f, 9.86510456e-01f, 1.63698375e-01f, 9.98648286e-01f, 5.19765690e-02f, 9.99864817e-01f, 1.64431017e-02f,
  -9.18282807e-01f, 3.95925164e-01f, -4.95741814e-01f, -8.68469954e-01f, 5.54374516e-01f, -8.32267344e-01f, -1.05016708e-01f, 9.94470477e-01f,
  8.62807095e-01f, 5.05533338e-01f, 9.85987842e-01f, 1.66817173e-01f, 9.98595834e-01f, 5.29751927e-02f, 9.99859571e-01f, 1.67592876e-02f,
  -8.29309821e-01f, -5.58789074e-01f, -2.01079622e-01f, -9.79574919e-01f, 6.34692967e-01f, -7.72764444e-01f, -1.36406869e-01f, 9.90652919e-01f,
  8.57708693e-01f, 5.14135957e-01f, 9.85455394e-01f, 1.69934288e-01f, 9.98542368e-01f, 5.39737605e-02f, 9.99854207e-01f, 1.70754679e-02f,
  2.21267566e-02f, -9.99755144e-01f, 1.13521777e-01f, -9.93535519e-01f, 7.08669782e-01f, -7.05540299e-01f, -1.67660639e-01f, 9.85844791e-01f,
  8.52524519e-01f, 5.22687256e-01f, 9.84913111e-01f, 1.73049718e-01f, 9.98487890e-01f, 5.49722798e-02f, 9.99848783e-01f, 1.73916500e-02f,
  8.53220105e-01f, -5.21551013e-01f, 4.16867077e-01f, -9.08967435e-01f, 7.75565803e-01f, -6.31266713e-01f, -1.98746875e-01f, 9.80050862e-01f,
  8.47255111e-01f, 5.31186223e-01f, 9.84360933e-01f, 1.76163420e-01f, 9.98432398e-01f, 5.59707358e-02f, 9.99843180e-01f, 1.77078284e-02f,
  8.99866819e-01f, 4.36164767e-01f, 6.78870201e-01f, -7.34258294e-01f, 8.34712923e-01f, -5.50685287e-01f, -2.29634270e-01f, 9.73276973e-01f,
  8.41901004e-01f, 5.39632022e-01f, 9.83798921e-01f, 1.79275364e-01f, 9.98375952e-01f, 5.69691435e-02f, 9.99837577e-01f, 1.80240069e-02f,
  1.19180135e-01f, 9.92872655e-01f, 8.73550534e-01f, -4.86733496e-01f, 8.85519624e-01f, -4.64602023e-01f, -2.60292053e-01f, 9.65529919e-01f,
  8.36462677e-01f, 5.48023939e-01f, 9.83227074e-01f, 1.82385504e-01f, 9.98318493e-01f, 5.79674877e-02f, 9.99831796e-01f, 1.83401816e-02f,
  -7.71080196e-01f, 6.36738002e-01f, 9.81602073e-01f, -1.90938011e-01f, 9.27478492e-01f, -3.73876572e-01f, -2.90689558e-01f, 9.56817448e-01f,
  8.30940723e-01f, 5.56361020e-01f, 9.82645452e-01f, 1.85493827e-01f, 9.98260021e-01f, 5.89657798e-02f, 9.99825954e-01f, 1.86563563e-02f,
  -9.52412963e-01f, -3.04810613e-01f, 9.92308319e-01f, 1.23790950e-01f, 9.60170269e-01f, -2.79415488e-01f, -3.20796400e-01f, 9.47148204e-01f,
  8.25335622e-01f, 5.64642429e-01f, 9.82053936e-01f, 1.88600287e-01f, 9.98200536e-01f, 5.99640086e-02f, 9.99819994e-01f, 1.89725272e-02f,
  -2.58101642e-01f, -9.66117799e-01f, 9.04607594e-01f, 4.26245421e-01f, 9.83268440e-01f, -1.82162598e-01f, -3.50582451e-01f, 9.36531842e-01f,
  8.19648027e-01f, 5.72867453e-01f, 9.81452644e-01f, 1.91704854e-01f, 9.98140097e-01f, 6.09621815e-02f, 9.99813974e-01f, 1.92886982e-02f,
  6.73507154e-01f, -7.39180684e-01f, 7.27198064e-01f, 6.86427653e-01f, 9.96542096e-01f, -8.30891207e-02f, -3.80017966e-01f, 9.24979091e-01f,
  8.13878477e-01f, 5.81035137e-01f, 9.80841517e-01f, 1.94807529e-01f, 9.98078644e-01f, 6.19602874e-02f, 9.99807835e-01f, 1.96048655e-02f,
  9.85896587e-01f, 1.67355701e-01f, 4.77671444e-01f, 8.78538549e-01f, 9.99858618e-01f, 1.68140903e-02f, -4.09073502e-01f, 9.12501454e-01f,
  8.08027506e-01f, 5.89144766e-01f, 9.80220556e-01f, 1.97908238e-01f, 9.98016179e-01f, 6.29583374e-02f, 9.99801576e-01f, 1.99210308e-02f,
};
__device__ const float TAB_S[2048] = {
  1.00000000e+00f, 0.00000000e+00f, 1.00000000e+00f, 0.00000000e+00f, 1.00000000e+00f, 0.00000000e+00f, 1.00000000e+00f, 0.00000000e+00f,
  1.00000000e+00f, 0.00000000e+00f, 1.00000000e+00f, 0.00000000e+00f, 1.00000000e+00f, 0.00000000e+00f, 1.00000000e+00f, 0.00000000e+00f,
  1.00000000e+00f, 0.00000000e+00f, 1.00000000e+00f, 0.00000000e+00f, 1.00000000e+00f, 0.00000000e+00f, 1.00000000e+00f, 0.00000000e+00f,
  1.00000000e+00f, 0.00000000e+00f, 1.00000000e+00f, 0.00000000e+00f, 1.00000000e+00f, 0.00000000e+00f, 1.00000000e+00f, 0.00000000e+00f,
  5.40302277e-01f, 8.41470957e-01f, 8.46009135e-01f, 5.33168435e-01f, 9.50415254e-01f, 3.10983598e-01f, 9.84230220e-01f, 1.76892191e-01f,
  9.95004177e-01f, 9.98334214e-02f, 9.98419285e-01f, 5.62044978e-02f, 9.99500036e-01f, 3.16175036e-02f, 9.99841869e-01f, 1.77818574e-02f,
  9.99949992e-01f, 9.99983307e-03f, 9.99984205e-01f, 5.62338345e-03f, 9.99994993e-01f, 3.16227227e-03f, 9.99998391e-01f, 1.77827850e-03f,
  9.99999523e-01f, 9.99999931e-04f, 9.99999821e-01f, 5.62341243e-04f, 9.99999940e-01f, 3.16227757e-04f, 1.00000000e+00f, 1.77827940e-04f,
  -4.16146845e-01f, 9.09297407e-01f, 4.31462824e-01f, 9.02130723e-01f, 8.06578398e-01f, 5.91127098e-01f, 9.37418282e-01f, 3.48205268e-01f,
  9.80066597e-01f, 1.98669329e-01f, 9.93682086e-01f, 1.12231314e-01f, 9.98000681e-01f, 6.32033944e-02f, 9.99367595e-01f, 3.55580896e-02f,
  9.99800026e-01f, 1.99986659e-02f, 9.99936759e-01f, 1.12465890e-02f, 9.99979973e-01f, 6.32451288e-03f, 9.99993682e-01f, 3.55655141e-03f,
  9.99997973e-01f, 1.99999870e-03f, 9.99999344e-01f, 1.12468237e-03f, 9.99999821e-01f, 6.32455456e-04f, 9.99999940e-01f, 3.55655880e-04f,
  -9.89992499e-01f, 1.41120002e-01f, -1.15966164e-01f, 9.93253171e-01f, 5.82753658e-01f, 8.12648892e-01f, 8.61040652e-01f, 5.08536100e-01f,
  9.55336511e-01f, 2.95520216e-01f, 9.85803485e-01f, 1.67903304e-01f, 9.95503366e-01f, 9.47260857e-02f, 9.98577297e-01f, 5.33230826e-02f,
  9.99550045e-01f, 2.99954992e-02f, 9.99857724e-01f, 1.68694388e-02f, 9.99954998e-01f, 9.48669016e-03f, 9.99985754e-01f, 5.33481315e-03f,
  9.99995530e-01f, 2.99999560e-03f, 9.99998569e-01f, 1.68702309e-03f, 9.99999523e-01f, 9.48683126e-04f, 9.99999881e-01f, 5.33483806e-04f,
  -6.53643608e-01f, -7.56802499e-01f, -6.27679706e-01f, 7.78471708e-01f, 3.01137477e-01f, 9.53580737e-01f, 7.57506192e-01f, 6.52827978e-01f,
  9.21060979e-01f, 3.89418334e-01f, 9.74808276e-01f, 2.23044485e-01f, 9.92010653e-01f, 1.26154065e-01f, 9.97471273e-01f, 7.10712075e-02f,
  9.99200106e-01f, 3.99893336e-02f, 9.99747038e-01f, 2.24917568e-02f, 9.99920011e-01f, 1.26487734e-02f, 9.99974728e-01f, 7.11305765e-03f,
  9.99992013e-01f, 3.99998948e-03f, 9.99997497e-01f, 2.24936334e-03f, 9.99999225e-01f, 1.26491068e-03f, 9.99999762e-01f, 7.11311703e-04f,
  2.83662200e-01f, -9.58924294e-01f, -9.46079254e-01f, 3.23935270e-01f, -1.03423381e-02f, 9.99946535e-01f, 6.30080283e-01f, 7.76529968e-01f,
  8.77582550e-01f, 4.79425550e-01f, 9.60731268e-01f, 2.77480543e-01f, 9.87526000e-01f, 1.57455876e-01f, 9.96049762e-01f, 8.87968615e-02f,
  9.98750269e-01f, 4.99791652e-02f, 9.99604762e-01f, 2.81133614e-02f, 9.99875009e-01f, 1.58107281e-02f, 9.99960482e-01f, 8.89127981e-03f,
  9.99987483e-01f, 4.99997940e-03f, 9.99996066e-01f, 2.81170290e-03f, 9.99998748e-01f, 1.58113812e-03f, 9.99999583e-01f, 8.89139599e-04f,
  9.60170269e-01f, -2.79415488e-01f, -9.73103702e-01f, -2.30367512e-01f, -3.20796400e-01f, 9.47148204e-01f, 4.82782036e-01f, 8.75740528e-01f,
  8.25335622e-01f, 5.64642489e-01f, 9.43616986e-01f, 3.31039310e-01f, 9.82053936e-01f, 1.88600272e-01f, 9.94313300e-01f, 1.06494442e-01f,
  9.98200536e-01f, 5.99640049e-02f, 9.99430835e-01f, 3.37340795e-02f, 9.99819994e-01f, 1.89725272e-02f, 9.99943078e-01f, 1.06694745e-02f,
  9.99981999e-01f, 5.99996420e-03f, 9.99994338e-01f, 3.37404152e-03f, 9.99998212e-01f, 1.89736532e-03f, 9.99999404e-01f, 1.06696738e-03f,
  7.53902256e-01f, 6.56986594e-01f, -7.00429797e-01f, -7.13721275e-01f, -5.99437475e-01f, 8.00421596e-01f, 3.20257008e-01f, 9.47330713e-01f,
  7.64842212e-01f, 6.44217670e-01f, 9.23519433e-01f, 3.83551568e-01f, 9.75599885e-01f, 2.19556093e-01f, 9.92262423e-01f, 1.24158338e-01f,
  9.97551024e-01f, 6.99428469e-02f, 9.99225318e-01f, 3.93537246e-02f, 9.99755025e-01f, 2.21341345e-02f, 9.99922514e-01f, 1.24476347e-02f,
  9.99975502e-01f, 6.99994294e-03f, 9.99992251e-01f, 3.93637875e-03f, 9.99997556e-01f, 2.21359241e-03f, 9.99999225e-01f, 1.24479528e-03f,
  -1.45500034e-01f, 9.89358246e-01f, -2.12036446e-01f, -9.77261782e-01f, -8.18632424e-01f, 5.74317753e-01f, 1.47631213e-01f, 9.89042461e-01f,
  6.96706712e-01f, 7.17356086e-01f, 9.00502324e-01f, 4.34851229e-01f, 9.68170285e-01f, 2.50292331e-01f, 9.89897788e-01f, 1.41782969e-01f,
  9.96801734e-01f, 7.99146891e-02f, 9.98988271e-01f, 4.49721329e-02f, 9.99680042e-01f, 2.52955221e-02f, 9.99898791e-01f, 1.42257558e-02f,
  9.99967992e-01f, 7.99991470e-03f, 9.99989867e-01f, 4.49871505e-03f, 9.99996781e-01f, 2.52981926e-03f, 9.99998987e-01f, 1.42262306e-03f,
  -9.11130250e-01f, 4.12118495e-01f, 3.41660261e-01f, -9.39823508e-01f, -9.56644177e-01f, 2.91259229e-01f, -2.96507962e-02f, 9.99560297e-01f,
  6.21609926e-01f, 7.83326924e-01f, 8.74638259e-01f, 4.84776139e-01f, 9.59772646e-01f, 2.80778319e-01f, 9.87220109e-01f, 1.59362778e-01f,
  9.95952725e-01f, 8.98785442e-02f, 9.98719573e-01f, 5.05891182e-02f, 9.99595046e-01f, 2.84566563e-02f, 9.99871910e-01f, 1.60038304e-02f,
  9.99959528e-01f, 8.99987947e-03f, 9.99987185e-01f, 5.06105041e-03f, 9.99995947e-01f, 2.84604589e-03f, 9.99998748e-01f, 1.60045072e-03f,
  -8.39071512e-01f, -5.44021130e-01f, 7.90131867e-01f, -6.12936914e-01f, -9.99786079e-01f, -2.06835698e-02f, -2.05997631e-01f, 9.78552461e-01f,
  5.40302277e-01f, 8.41470957e-01f, 8.46009135e-01f, 5.33168435e-01f, 9.50415313e-01f, 3.10983568e-01f, 9.84230220e-01f, 1.76892191e-01f,
  9.95004177e-01f, 9.98334140e-02f, 9.98419285e-01f, 5.62044978e-02f, 9.99500036e-01f, 3.16175036e-02f, 9.99841869e-01f, 1.77818574e-02f,
  9.99949992e-01f, 9.99983400e-03f, 9.99984205e-01f, 5.62338345e-03f, 9.99994993e-01f, 3.16227227e-03f, 9.99998391e-01f, 1.77827850e-03f,
  4.42569796e-03f, -9.99990225e-01f, 9.95257378e-01f, -9.72764567e-02f, -9.43779767e-01f, -3.30574960e-01f, -3.75847399e-01f, 9.26681578e-01f,
  4.53596085e-01f, 8.91207397e-01f, 8.14705312e-01f, 5.79875171e-01f, 9.40107584e-01f, 3.40877861e-01f, 9.80929136e-01f, 1.94365650e-01f,
  9.93956089e-01f, 1.09778300e-01f, 9.98087406e-01f, 6.18181042e-02f, 9.99395072e-01f, 3.47780399e-02f, 9.99808669e-01f, 1.95598267e-02f,
  9.99939501e-01f, 1.09997792e-02f, 9.99980867e-01f, 6.18571462e-03f, 9.99993920e-01f, 3.47849843e-03f, 9.99998093e-01f, 1.95610616e-03f,
  8.43853951e-01f, -5.36572933e-01f, 8.93861592e-01f, 4.48342979e-01f, -7.94179380e-01f, -6.07683420e-01f, -5.33843040e-01f, 8.45583618e-01f,
  3.62357706e-01f, 9.32039082e-01f, 7.80825913e-01f, 6.24748647e-01f, 9.28859890e-01f, 3.70431304e-01f, 9.77317870e-01f, 2.11777672e-01f,
  9.92808640e-01f, 1.19712204e-01f, 9.97723997e-01f, 6.74297586e-02f, 9.99280095e-01f, 3.79382223e-02f, 9.99772310e-01f, 2.13377345e-02f,
  9.99927998e-01f, 1.19997123e-02f, 9.99977231e-01f, 6.74804440e-03f, 9.99992788e-01f, 3.79472389e-03f, 9.99997735e-01f, 2.13393359e-03f,
  9.07446802e-01f, 4.20167029e-01f, 5.17172873e-01f, 8.55880976e-01f, -5.65820515e-01f, -8.24528456e-01f, -6.75001681e-01f, 7.37816215e-01f,
  2.67498761e-01f, 9.63558197e-01f, 7.44477987e-01f, 6.67647004e-01f, 9.16683376e-01f, 3.99614304e-01f, 9.73397553e-01f, 2.29122713e-01f,
  9.91561890e-01f, 1.29634142e-01f, 9.97329056e-01f, 7.30392784e-02f, 9.99155104e-01f, 4.10980321e-02f, 9.99732792e-01f, 2.31155735e-02f,
  9.99915481e-01f, 1.29996343e-02f, 9.99973297e-01f, 7.31037185e-03f, 9.99991536e-01f, 4.11094911e-03f, 9.99997318e-01f, 2.31176103e-03f,
  1.36737213e-01f, 9.90607381e-01f, -1.87961515e-02f, 9.99823332e-01f, -2.81349480e-01f, -9.59605396e-01f, -7.94870913e-01f, 6.06778562e-01f,
  1.69967160e-01f, 9.85449731e-01f, 7.05776393e-01f, 7.08434701e-01f, 9.03590262e-01f, 4.28397775e-01f, 9.69169438e-01f, 2.46395305e-01f,
  9.90216017e-01f, 1.39543116e-01f, 9.96902585e-01f, 7.86464810e-02f, 9.99020159e-01f, 4.42574248e-02f, 9.99690115e-01f, 2.48933397e-02f,
  9.99902010e-01f, 1.39995432e-02f, 9.99969006e-01f, 7.87269697e-03f, 9.99990225e-01f, 4.42717411e-03f, 9.99996901e-01f, 2.48958869e-03f,
  -7.59687901e-01f, 6.50287867e-01f, -5.48975468e-01f, 8.35838437e-01f, 3.10223512e-02f, -9.99518692e-01f, -8.89670432e-01f, 4.56603259e-01f,
  7.07371980e-02f, 9.97494996e-01f, 6.64843500e-01f, 7.46982634e-01f, 8.89593601e-01f, 4.56752867e-01f, 9.64634836e-01f, 2.63589978e-01f,
  9.88771081e-01f, 1.49438128e-01f, 9.96444523e-01f, 8.42512026e-02f, 9.98875201e-01f, 4.74163815e-02f, 9.99644279e-01f, 2.66710296e-02f,
  9.99887526e-01f, 1.49994381e-02f, 9.99964416e-01f, 8.43502022e-03f, 9.99988735e-01f, 4.74339863e-03f, 9.99996424e-01f, 2.66741589e-03f,
  -9.57659483e-01f, -2.87903309e-01f, -9.10081089e-01f, 4.14430231e-01f, 3.40318173e-01f, -9.40310359e-01f, -9.56410050e-01f, 2.92027086e-01f,
  -2.91995462e-02f, 9.99573588e-01f, 6.21808827e-01f, 7.83169091e-01f, 8.74707460e-01f, 4.84651238e-01f, 9.59795177e-01f, 2.80701309e-01f,
  9.87227261e-01f, 1.59318209e-01f, 9.95954990e-01f, 8.98532644e-02f, 9.98720288e-01f, 5.05748577e-02f, 9.99595284e-01f, 2.84486320e-02f,
  9.99872029e-01f, 1.59993190e-02f, 9.99959528e-01f, 8.99733976e-03f, 9.99987185e-01f, 5.05962269e-03f, 9.99995947e-01f, 2.84524332e-03f,
  -2.75163352e-01f, -9.61397469e-01f, -9.90897954e-01f, -1.34615138e-01f, 6.15864813e-01f, -7.87851870e-01f, -9.92985010e-01f, 1.18240520e-01f,
  -1.28844544e-01f, 9.91664827e-01f, 5.76808274e-01f, 8.16879570e-01f, 8.58946681e-01f, 5.12064993e-01f, 9.54652011e-01f, 2.97723860e-01f,
  9.85584795e-01f, 1.69182345e-01f, 9.95433986e-01f, 9.54524800e-02f, 9.98555362e-01f, 5.37328273e-02f, 9.99543071e-01f, 3.02261449e-02f,
  9.99855518e-01f, 1.69991814e-02f, 9.99954283e-01f, 9.55965649e-03f, 9.99985576e-01f, 5.37584582e-03f, 9.99995410e-01f, 3.02307028e-03f,
  6.60316706e-01f, -7.50987232e-01f, -7.66536534e-01f, -6.42200708e-01f, 8.30336154e-01f, -5.57262897e-01f, -9.98241663e-01f, -5.92755191e-02f,
  -2.27202162e-01f, 9.73847628e-01f, 5.29984176e-01f, 8.48007560e-01f, 8.42327058e-01f, 5.38966715e-01f, 9.49207008e-01f, 3.14652264e-01f,
  9.83843684e-01f, 1.79029569e-01f, 9.94881511e-01f, 1.01048686e-01f, 9.98380423e-01f, 5.68902642e-02f, 9.99487758e-01f, 3.20035629e-02f,
  9.99837995e-01f, 1.79990288e-02f, 9.99948800e-01f, 1.01219704e-02f, 9.99983788e-01f, 5.69206895e-03f, 9.99994874e-01f, 3.20089748e-03f,
  9.88704622e-01f, 1.49877205e-01f, -3.06095392e-01f, -9.52000856e-01f, 9.62463796e-01f, -2.71410108e-01f, -9.72014248e-01f, -2.34921798e-01f,
  -3.23289543e-01f, 9.46300089e-01f, 4.81484592e-01f, 8.76454532e-01f, 8.24865162e-01f, 5.65329552e-01f, 9.43461835e-01f, 3.31481189e-01f,
  9.82004225e-01f, 1.88858896e-01f, 9.94297504e-01f, 1.06641680e-01f, 9.98195529e-01f, 6.00471310e-02f, 9.99429286e-01f, 3.37808803e-02f,
  9.99819517e-01f, 1.89988576e-02f, 9.99942899e-01f, 1.06842816e-02f, 9.99981940e-01f, 6.00829115e-03f, 9.99994278e-01f, 3.37872445e-03f,
  4.08082068e-01f, 9.12945271e-01f, 2.48616725e-01f, -9.68601942e-01f, 9.99144375e-01f, 4.13582884e-02f, -9.15129960e-01f, -4.03158993e-01f,
  -4.16146845e-01f, 9.09297407e-01f, 4.31462824e-01f, 9.02130723e-01f, 8.06578457e-01f, 5.91127038e-01f, 9.37418282e-01f, 3.48205268e-01f,
  9.80066597e-01f, 1.98669314e-01f, 9.93682086e-01f, 1.12231314e-01f, 9.98000681e-01f, 6.32033944e-02f, 9.99367595e-01f, 3.55580896e-02f,
  9.99800026e-01f, 1.99986678e-02f, 9.99936759e-01f, 1.12465890e-02f, 9.99979973e-01f, 6.32451288e-03f, 9.99993682e-01f, 3.55655141e-03f,
  -5.47729254e-01f, 8.36655617e-01f, 7.26760268e-01f, -6.86891198e-01f, 9.36740458e-01f, 3.50024760e-01f, -8.29382956e-01f, -5.58680534e-01f,
  -5.04846215e-01f, 8.63209307e-01f, 3.80077004e-01f, 9.24954832e-01f, 7.87485182e-01f, 6.16333544e-01f, 9.31078374e-01f, 3.64819258e-01f,
  9.78030920e-01f, 2.08459899e-01f, 9.93035257e-01f, 1.17817394e-01f, 9.97795820e-01f, 6.63590282e-02f, 9.99302804e-01f, 3.73351872e-02f,
  9.99779522e-01f, 2.09984574e-02f, 9.99930263e-01f, 1.18088927e-02f, 9.99977946e-01f, 6.64073415e-03f, 9.99993026e-01f, 3.73437814e-03f,
  -9.99960840e-01f, -8.85130931e-03f, 9.81074572e-01f, -1.93630233e-01f, 7.81440377e-01f, 6.23979926e-01f, -7.17477441e-01f, -6.96581721e-01f,
  -5.88501155e-01f, 8.08496356e-01f, 3.27489585e-01f, 9.44854796e-01f, 7.67604589e-01f, 6.40923738e-01f, 9.24443960e-01f, 3.81317884e-01f,
  9.75897431e-01f, 2.18229622e-01f, 9.92357016e-01f, 1.23399742e-01f, 9.97581005e-01f, 6.95140064e-02f, 9.99234855e-01f, 3.91121693e-02f,
  9.99758005e-01f, 2.19982266e-02f, 9.99923468e-01f, 1.23711927e-02f, 9.99975801e-01f, 6.95695449e-03f, 9.99992371e-01f, 3.91220488e-03f,
  -5.32833040e-01f, -8.46220434e-01f, 9.33235765e-01f, 3.59264523e-01f, 5.48645258e-01f, 8.36055279e-01f, -5.82943261e-01f, -8.12512875e-01f,
  -6.66275978e-01f, 7.45705247e-01f, 2.73866832e-01f, 9.61767614e-01f, 7.46956408e-01f, 6.64873064e-01f, 9.17517304e-01f, 3.97695929e-01f,
  9.73666370e-01f, 2.27977514e-01f, 9.91647422e-01f, 1.28978193e-01f, 9.97356176e-01f, 7.26682767e-02f, 9.99163687e-01f, 4.08890247e-02f,
  9.99735534e-01f, 2.29979735e-02f, 9.99916375e-01f, 1.29334899e-02f, 9.99973536e-01f, 7.27317436e-03f, 9.99991655e-01f, 4.09003161e-03f,
  4.24179018e-01f, -9.05578375e-01f, 5.97977161e-01f, 8.01513135e-01f, 2.61441678e-01f, 9.65219259e-01f, -4.30023283e-01f, -9.02817786e-01f,
  -7.37393796e-01f, 6.75463140e-01f, 2.19378278e-01f, 9.75639880e-01f, 7.25561321e-01f, 6.88157499e-01f, 9.10300434e-01f, 4.13948208e-01f,
  9.71337974e-01f, 2.37702623e-01f, 9.90906477e-01f, 1.34552568e-01f, 9.97121394e-01f, 7.58218244e-02f, 9.99089420e-01f, 4.26657498e-02f,
  9.99711990e-01f, 2.39976961e-02f, 9.99908924e-01f, 1.34957815e-02f, 9.99971211e-01f, 7.58939330e-03f, 9.99990880e-01f, 4.26785741e-03f,
  9.91202831e-01f, -1.32351756e-01f, 7.85522610e-02f, 9.96909976e-01f, -5.16893305e-02f, 9.98663187e-01f, -2.63540596e-01f, -9.64648306e-01f,
  -8.01143587e-01f, 5.98472118e-01f, 1.64196163e-01f, 9.86427724e-01f, 7.03440726e-01f, 7.10753918e-01f, 9.02795732e-01f, 4.30069596e-01f,
  9.68912423e-01f, 2.47403964e-01f, 9.90134120e-01f, 1.40122697e-01f, 9.96876657e-01f, 7.89746121e-02f, 9.99011934e-01f, 4.44423407e-02f,
  9.99687493e-01f, 2.49973964e-02f, 9.99901175e-01f, 1.40580693e-02f, 9.99968767e-01f, 7.90561177e-03f, 9.99990106e-01f, 4.44568414e-03f,
  6.46919310e-01f, 7.62558460e-01f, -4.65064496e-01f, 8.85276794e-01f, -3.59694332e-01f, 9.33070183e-01f, -8.87455046e-02f, -9.96054351e-01f,
  -8.56888831e-01f, 5.15501261e-01f, 1.08494945e-01f, 9.94096994e-01f, 6.80616796e-01f, 7.32639611e-01f, 8.95005584e-01f, 4.46054995e-01f,
  9.66389954e-01f, 2.57080555e-01f, 9.89330530e-01f, 1.45688385e-01f, 9.96621907e-01f, 8.21266174e-02f, 9.98931348e-01f, 4.62187938e-02f,
  9.99662042e-01f, 2.59970706e-02f, 9.99893129e-01f, 1.46203535e-02f, 9.99966204e-01f, 8.22182931e-03f, 9.99989331e-01f, 4.62350994e-03f,
  -2.92138815e-01f, 9.56375957e-01f, -8.65450621e-01f, 5.00994205e-01f, -6.32028639e-01f, 7.74945021e-01f, 8.88481140e-02f, -9.96045172e-01f,
  -9.04072165e-01f, 4.27379847e-01f, 5.24506159e-02f, 9.98623490e-01f, 6.57112300e-01f, 7.53792703e-01f, 8.86932373e-01f, 4.61899310e-01f,
  9.63770926e-01f, 2.66731411e-01f, 9.88495648e-01f, 1.51249468e-01f, 9.96357203e-01f, 8.52777958e-02f, 9.98847544e-01f, 4.79951017e-02f,
  9.99635518e-01f, 2.69967206e-02f, 9.99884725e-01f, 1.51826320e-02f, 9.99963522e-01f, 8.53804592e-03f, 9.99988496e-01f, 4.80133574e-03f,
  -9.62605894e-01f, 2.70905793e-01f, -9.99293387e-01f, -3.75856608e-02f, -8.41684937e-01f, 5.39968967e-01f, 2.63639510e-01f, -9.64621305e-01f,
  -9.42222297e-01f, 3.34988207e-01f, -3.75941908e-03f, 9.99992907e-01f, 6.32950664e-01f, 7.74192095e-01f, 8.78578722e-01f, 4.77597594e-01f,
  9.61055458e-01f, 2.76355654e-01f, 9.87629473e-01f, 1.56805754e-01f, 9.96082544e-01f, 8.84281173e-02f, 9.98760641e-01f, 4.97712530e-02f,
  9.99608040e-01f, 2.79963426e-02f, 9.99876022e-01f, 1.57449059e-02f, 9.99960780e-01f, 8.85426160e-03f, 9.99987602e-01f, 4.97916201e-03f,
  -7.48057544e-01f, -6.63633883e-01f, -8.25371623e-01f, -5.64589798e-01f, -9.67871487e-01f, 2.51445323e-01f, 4.30115849e-01f, -9.02773678e-01f,
  -9.70958173e-01f, 2.39249229e-01f, -5.99575676e-02f, 9.98200953e-01f, 6.08156204e-01f, 7.93817401e-01f, 8.69947195e-01f, 4.93144840e-01f,
  9.58243906e-01f, 2.85952210e-01f, 9.86732066e-01f, 1.62357092e-01f, 9.95797932e-01f, 9.15775672e-02f, 9.98670578e-01f, 5.15472479e-02f,
  9.99579549e-01f, 2.89959367e-02f, 9.99867022e-01f, 1.63071752e-02f, 9.99957979e-01f, 9.17047635e-03f, 9.99986708e-01f, 5.15698735e-03f,
  1.54251456e-01f, -9.88031626e-01f, -3.97251874e-01f, -9.17709649e-01f, -9.98075247e-01f, -6.20148405e-02f, 5.83026946e-01f, -8.12452853e-01f,
  -9.89992499e-01f, 1.41120002e-01f, -1.15966164e-01f, 9.93253171e-01f, 5.82753658e-01f, 8.12648892e-01f, 8.61040652e-01f, 5.08536100e-01f,
  9.55336511e-01f, 2.95520186e-01f, 9.85803485e-01f, 1.67903304e-01f, 9.95503366e-01f, 9.47260931e-02f, 9.98577297e-01f, 5.33230826e-02f,
  9.99550045e-01f, 2.99955010e-02f, 9.99857724e-01f, 1.68694388e-02f, 9.99954998e-01f, 9.48669016e-03f, 9.99985754e-01f, 5.33481315e-03f,
  9.14742351e-01f, -4.04037654e-01f, 1.53215483e-01f, -9.88192797e-01f, -9.29300308e-01f, -3.69325012e-01f, 7.17549205e-01f, -6.96507812e-01f,
  -9.99135137e-01f, 4.15805206e-02f, -1.71608135e-01f, 9.85165298e-01f, 5.56768358e-01f, 8.30667794e-01f, 8.51861775e-01f, 5.23766637e-01f,
  9.52333570e-01f, 3.05058628e-01f, 9.84843671e-01f, 1.73444211e-01f, 9.95198846e-01f, 9.78736654e-02f, 9.98480916e-01f, 5.50987460e-02f,
  9.99519527e-01f, 3.09950355e-02f, 9.99848068e-01f, 1.74316969e-02f, 9.99951959e-01f, 9.80290305e-03f, 9.99984801e-01f, 5.51263802e-03f,
  8.34223390e-01f, 5.51426709e-01f, 6.56495154e-01f, -7.54330218e-01f, -7.68367112e-01f, -6.40009403e-01f, 8.29440355e-01f, -5.58595300e-01f,
  -9.98294771e-01f, -5.83741926e-02f, -2.26707578e-01f, 9.73962843e-01f, 5.30226350e-01f, 8.47856104e-01f, 8.42413545e-01f, 5.38831532e-01f,
  9.49235439e-01f, 3.14566553e-01f, 9.83852804e-01f, 1.78979620e-01f, 9.94884372e-01f, 1.01020269e-01f, 9.98381376e-01f, 5.68742342e-02f,
  9.99488056e-01f, 3.19945402e-02f, 9.99838114e-01f, 1.79939512e-02f, 9.99948800e-01f, 1.01191159e-02f, 9.99983788e-01f, 5.69046335e-03f,
  -1.32767474e-02f, 9.99911845e-01f, 9.57586050e-01f, -2.88147390e-01f, -5.31235278e-01f, -8.47224355e-01f, 9.15171385e-01f, -4.03064936e-01f,
  -9.87479806e-01f, -1.57745644e-01f, -2.81090319e-01f, 9.59681332e-01f, 5.03154159e-01f, 8.64196658e-01f, 8.32698941e-01f, 5.53726017e-01f,
  9.46042359e-01f, 3.24043006e-01f, 9.82830763e-01f, 1.84509367e-01f, 9.94559944e-01f, 1.04165860e-01f, 9.98278618e-01f, 5.86495437e-02f,
  9.99455571e-01f, 3.29940096e-02f, 9.99827802e-01f, 1.85561981e-02f, 9.99945521e-01f, 1.04353270e-02f, 9.99982774e-01f, 5.86828869e-03f,
  -8.48570287e-01f, 5.29082716e-01f, 9.63757515e-01f, 2.66779721e-01f, -2.41421118e-01f, -9.70420420e-01f, 9.72038329e-01f, -2.34822124e-01f,
  -9.66798186e-01f, -2.55541205e-01f, -3.34584385e-01f, 9.42365825e-01f, 4.75578904e-01f, 8.79673064e-01f, 8.22721004e-01f, 5.68445385e-01f,
  9.42754686e-01f, 3.33487093e-01f, 9.81777668e-01f, 1.90033287e-01f, 9.94225562e-01f, 1.07310407e-01f, 9.98172760e-01f, 6.04246669e-02f,
  9.99422073e-01f, 3.39934528e-02f, 9.99817252e-01f, 1.91184394e-02f, 9.99942183e-01f, 1.07515370e-02f, 9.99981701e-01f, 6.04611309e-03f,
  -9.03692186e-01f, -4.28182662e-01f, 6.73110247e-01f, 7.39542127e-01f, 7.23346695e-02f, -9.97380435e-01f, 9.98247743e-01f, -5.91726787e-02f,
  -9.36456680e-01f, -3.50783229e-01f, -3.87020677e-01f, 9.22071040e-01f, 4.47528064e-01f, 8.94269884e-01f, 8.12482953e-01f, 5.82984984e-01f,
  9.39372718e-01f, 3.42897803e-01f, 9.80693519e-01f, 1.95551202e-01f, 9.93881226e-01f, 1.10453881e-01f, 9.98063743e-01f, 6.21996038e-02f,
  9.99387562e-01f, 3.49928550e-02f, 9.99806345e-01f, 1.96806751e-02f, 9.99938726e-01f, 1.10677453e-02f, 9.99980628e-01f, 6.22393796e-03f,
  -1.27963692e-01f, -9.91778851e-01f, 1.75156534e-01f, 9.84540582e-01f, 3.78916174e-01f, -9.25431013e-01f, 9.92972851e-01f, 1.18342586e-01f,
  -8.96758378e-01f, -4.42520559e-01f, -4.38233554e-01f, 8.98861170e-01f, 4.19029742e-01f, 9.07972515e-01f, 8.01987886e-01f, 5.97340286e-01f,
  9.35896814e-01f, 3.52274209e-01f, 9.79578316e-01f, 2.01062918e-01f, 9.93526995e-01f, 1.13596253e-01f, 9.97951567e-01f, 6.39743358e-02f,
  9.99352098e-01f, 3.59922275e-02f, 9.99795079e-01f, 2.02429052e-02f, 9.99935210e-01f, 1.13839535e-02f, 9.99979496e-01f, 6.40176190e-03f,
  7.65414059e-01f, -6.43538117e-01f, -3.76742303e-01f, 9.26318109e-01f, 6.47921681e-01f, -7.61706948e-01f, 9.56380010e-01f, 2.92125374e-01f,
  -8.48100007e-01f, -5.29836178e-01f, -4.88060862e-01f, 8.72809589e-01f, 3.90112430e-01f, 9.20767248e-01f, 7.91239262e-01f, 6.11506701e-01f,
  9.32327330e-01f, 3.61615449e-01f, 9.78432178e-01f, 2.06568271e-01f, 9.93162811e-01f, 1.16737492e-01f, 9.97836173e-01f, 6.57488778e-02f,
  9.99315560e-01f, 3.69915590e-02f, 9.99783576e-01f, 2.08051261e-02f, 9.99931574e-01f, 1.17001599e-02f, 9.99978364e-01f, 6.57958630e-03f,
  9.55073655e-01f, 2.96368569e-01f, -8.12611222e-01f, 5.82806170e-01f, 8.52673113e-01f, -5.22444785e-01f, 8.89623463e-01f, 4.56694692e-01f,
  -7.90967762e-01f, -6.11857831e-01f, -5.36345184e-01f, 8.43998730e-01f, 3.60805035e-01f, 9.32641268e-01f, 7.80240417e-01f, 6.25479698e-01f,
  9.28664625e-01f, 3.70920479e-01f, 9.77255106e-01f, 2.12067112e-01f, 9.92788672e-01f, 1.19877554e-01f, 9.97717679e-01f, 6.75232038e-02f,
  9.99278069e-01f, 3.79908569e-02f, 9.99771714e-01f, 2.13673431e-02f, 9.99927819e-01f, 1.20163653e-02f, 9.99977171e-01f, 6.75741071e-03f,
  2.66642928e-01f, 9.63795364e-01f, -9.98210371e-01f, 5.98003156e-02f, 9.72865343e-01f, -2.31372014e-01f, 7.94808388e-01f, 6.06860459e-01f,
  -7.25932240e-01f, -6.87766254e-01f, -5.82933903e-01f, 8.12519610e-01f, 3.31136853e-01f, 9.43582714e-01f, 7.68994927e-01f, 6.39254928e-01f,
  9.24909055e-01f, 3.80188406e-01f, 9.76047099e-01f, 2.17559248e-01f, 9.92404640e-01f, 1.23016424e-01f, 9.97596025e-01f, 6.92973137e-02f,
  9.99239624e-01f, 3.89901139e-02f, 9.99759495e-01f, 2.19295528e-02f, 9.99923944e-01f, 1.23325698e-02f, 9.99975979e-01f, 6.93523418e-03f,
  -6.66938066e-01f, 7.45113134e-01f, -8.76379430e-01f, -4.81621295e-01f, 9.96578991e-01f, 8.26458037e-02f, 6.74925625e-01f, 7.37885714e-01f,
  -6.53643608e-01f, -7.56802499e-01f, -6.27679706e-01f, 7.78471708e-01f, 3.01137596e-01f, 9.53580678e-01f, 7.57506192e-01f, 6.52827978e-01f,
  9.21060979e-01f, 3.89418334e-01f, 9.74808276e-01f, 2.23044485e-01f, 9.92010653e-01f, 1.26154065e-01f, 9.97471273e-01f, 7.10712075e-02f,
  9.99200106e-01f, 3.99893373e-02f, 9.99747038e-01f, 2.24917568e-02f, 9.99920011e-01f, 1.26487734e-02f, 9.99974728e-01f, 7.11305765e-03f,
  -9.87339258e-01f, -1.58622667e-01f, -4.84639406e-01f, -8.74714017e-01f, 9.21462357e-01f, 3.88467699e-01f, 5.33756077e-01f, 8.45638454e-01f,
  -5.74824035e-01f, -8.18277061e-01f, -6.70441091e-01f, 7.41962790e-01f, 2.70837069e-01f, 9.62625206e-01f, 7.45777905e-01f, 6.66194677e-01f,
  9.17120814e-01f, 3.98609310e-01f, 9.73538578e-01f, 2.28522688e-01f, 9.91606772e-01f, 1.29290432e-01f, 9.97343302e-01f, 7.28448778e-02f,
  9.99159634e-01f, 4.09885161e-02f, 9.99734223e-01f, 2.30539497e-02f, 9.99915957e-01f, 1.29649751e-02f, 9.99973416e-01f, 7.29088066e-03f,
  -3.99985313e-01f, -9.16521549e-01f, 5.63609414e-02f, -9.98410463e-01f, 7.54965365e-01f, 6.55764699e-01f, 3.75752151e-01f, 9.26720202e-01f,
  -4.90260571e-01f, -8.71575892e-01f, -7.11082935e-01f, 7.03108132e-01f, 2.40265876e-01f, 9.70707119e-01f, 7.33813822e-01f, 6.79350674e-01f,
  9.13088918e-01f, 4.07760441e-01f, 9.72238123e-01f, 2.33993664e-01f, 9.91192937e-01f, 1.32425532e-01f, 9.97212172e-01f, 7.46183172e-02f,
  9.99118149e-01f, 4.19876575e-02f, 9.99721110e-01f, 2.36161388e-02f, 9.99911785e-01f, 1.32811759e-02f, 9.99972105e-01f, 7.46870413e-03f,
  5.55113316e-01f, -8.31774771e-01f, 5.80003142e-01f, -8.14614236e-01f, 5.13598442e-01f, 8.58030677e-01f, 2.05897167e-01f, 9.78573620e-01f,
  -4.00799006e-01f, -9.16166008e-01f, -7.49476731e-01f, 6.62030637e-01f, 2.09454417e-01f, 9.77818429e-01f, 7.21617639e-01f, 6.92291796e-01f,
  9.08965766e-01f, 4.16870773e-01f, 9.70906913e-01f, 2.39457220e-01f, 9.90769207e-01f, 1.35559291e-01f, 9.97077882e-01f, 7.63915181e-02f,
  9.99075651e-01f, 4.29867506e-02f, 9.99707639e-01f, 2.41783205e-02f, 9.99907553e-01f, 1.35973748e-02f, 9.99970794e-01f, 7.64652714e-03f,
  9.99843299e-01f, 1.77019257e-02f, 9.25014675e-01f, -3.79931390e-01f, 2.21298173e-01f, 9.75206196e-01f, 2.95478199e-02f, 9.99563396e-01f,
  -3.07332784e-01f, -9.51602101e-01f, -7.85501122e-01f, 6.18860185e-01f, 1.78433523e-01f, 9.83951986e-01f, 7.09193349e-01f, 7.05014050e-01f,
  9.04751658e-01f, 4.25939471e-01f, 9.69545007e-01f, 2.44913206e-01f, 9.90335584e-01f, 1.38691694e-01f, 9.96940494e-01f, 7.81644881e-02f,
  9.99032140e-01f, 4.39858064e-02f, 9.99693930e-01f, 2.47404929e-02f, 9.99903202e-01f, 1.39135728e-02f, 9.99969363e-01f, 7.82434922e-03f,
  5.25321960e-01f, 8.50903511e-01f, 9.85138178e-01f, 1.71763569e-01f, -9.29481089e-02f, 9.95670974e-01f, -1.47732988e-01f, 9.89027262e-01f,
  -2.10795805e-01f, -9.77530122e-01f, -8.19042206e-01f, 5.73733270e-01f, 1.47234216e-01f, 9.89101648e-01f, 6.96544766e-01f, 7.17513323e-01f,
  9.00447130e-01f, 4.34965521e-01f, 9.68152404e-01f, 2.50361472e-01f, 9.89892066e-01f, 1.41822711e-01f, 9.96799886e-01f, 7.99371973e-02f,
  9.98987675e-01f, 4.49848175e-02f, 9.99679863e-01f, 2.53026579e-02f, 9.99898732e-01f, 1.42297689e-02f, 9.99967992e-01f, 8.00217129e-03f,
  -4.32177931e-01f, 9.01788354e-01f, 7.41858006e-01f, 6.70557022e-01f, -3.97976756e-01f, 9.17395473e-01f, -3.20354372e-01f, 9.47297752e-01f,
  -1.12152621e-01f, -9.93690968e-01f, -8.49993885e-01f, 5.26792526e-01f, 1.15887694e-01f, 9.93262351e-01f, 6.83675885e-01f, 7.29785740e-01f,
  8.96052480e-01f, 4.43948090e-01f, 9.66729224e-01f, 2.55801797e-01f, 9.89438653e-01f, 1.44952312e-01f, 9.96656179e-01f, 8.17096606e-02f,
  9.98942196e-01f, 4.59837839e-02f, 9.99665439e-01f, 2.58648153e-02f, 9.99894202e-01f, 1.45459641e-02f, 9.99966562e-01f, 8.17999430e-03f,
  -9.92335498e-01f, 1.23573124e-01f, 2.70098448e-01f, 9.62832689e-01f, -6.63538277e-01f, 7.48142362e-01f, -4.82871950e-01f, 8.75690997e-01f,
  -1.23883775e-02f, -9.99923289e-01f, -8.78258407e-01f, 4.78186339e-01f, 8.44252855e-02f, 9.96429801e-01f, 6.70590878e-01f, 7.41827428e-01f,
  8.91568303e-01f, 4.52886283e-01f, 9.65275466e-01f, 2.61234075e-01f, 9.88975346e-01f, 1.48080453e-01f, 9.96509314e-01f, 8.34818557e-02f,
  9.98895705e-01f, 4.69827019e-02f, 9.99650776e-01f, 2.64269635e-02f, 9.99889553e-01f, 1.48621574e-02f, 9.99965072e-01f, 8.35781638e-03f,
  -6.40144348e-01f, -7.68254638e-01f, -2.84846604e-01f, 9.58573103e-01f, -8.63296509e-01f, 5.04697084e-01f, -6.30159974e-01f, 7.76465356e-01f,
  8.74991715e-02f, -9.96164620e-01f, -9.03746367e-01f, 4.28068399e-01f, 5.28784581e-02f, 9.98600960e-01f, 6.57293737e-01f, 7.53634512e-01f,
  8.86994898e-01f, 4.61779177e-01f, 9.63791192e-01f, 2.66658038e-01f, 9.88502085e-01f, 1.51207119e-01f, 9.96359289e-01f, 8.52537975e-02f,
  9.98848200e-01f, 4.79815714e-02f, 9.99635756e-01f, 2.69891042e-02f, 9.99884784e-01f, 1.51783489e-02f, 9.99963582e-01f, 8.53563752e-03f,
  3.00592542e-01f, -9.53752637e-01f, -7.52063990e-01f, 6.59090102e-01f, -9.77442741e-01f, 2.11200655e-01f, -7.57573068e-01f, 6.52750373e-01f,
  1.86512470e-01f, -9.82452571e-01f, -9.26377118e-01f, 3.76597136e-01f, 2.12787576e-02f, 9.99773562e-01f, 6.43788815e-01f, 7.65203178e-01f,
  8.82332861e-01f, 4.70625877e-01f, 9.62276459e-01f, 2.72073567e-01f, 9.88018990e-01f, 1.54332280e-01f, 9.96206105e-01f, 8.70254710e-02f,
  9.98799741e-01f, 4.89803962e-02f, 9.99620378e-01f, 2.75512375e-02f, 9.99879956e-01f, 1.54945394e-02f, 9.99962032e-01f, 8.71345960e-03f,
  9.64965999e-01f, -2.62374848e-01f, -9.87659097e-01f, 1.56619072e-01f, -9.94656444e-01f, -1.03240460e-01f, -8.61092687e-01f, 5.08447945e-01f,
  2.83662200e-01f, -9.58924294e-01f, -9.46079254e-01f, 3.23935270e-01f, -1.03422189e-02f, 9.99946535e-01f, 6.30080283e-01f, 7.76529968e-01f,
  8.77582550e-01f, 4.79425550e-01f, 9.60731268e-01f, 2.77480543e-01f, 9.87526000e-01f, 1.57455891e-01f, 9.96049762e-01f, 8.87968615e-02f,
  9.98750269e-01f, 4.99791689e-02f, 9.99604762e-01f, 2.81133596e-02f, 9.99875009e-01f, 1.58107281e-02f, 9.99960482e-01f, 8.89127981e-03f,
  7.42154181e-01f, 6.70229197e-01f, -9.19073522e-01f, -3.94086063e-01f, -9.13230121e-01f, -4.07444149e-01f, -9.37454224e-01f, 3.48108500e-01f,
  3.77977669e-01f, -9.25814748e-01f, -9.62790370e-01f, 2.70249337e-01f, -4.19528559e-02f, 9.99119580e-01f, 6.16172493e-01f, 7.87611187e-01f,
  8.72744501e-01f, 4.88177240e-01f, 9.59155679e-01f, 2.82878697e-01f, 9.87023175e-01f, 1.60577938e-01f, 9.95890260e-01f, 9.05679762e-02f,
  9.98699784e-01f, 5.09778969e-02f, 9.99588788e-01f, 2.86754742e-02f, 9.99869943e-01f, 1.61269177e-02f, 9.99958873e-01f, 9.06910095e-03f,
  -1.62990779e-01f, 9.86627579e-01f, -5.67430019e-01f, -8.23421597e-01f, -7.41239965e-01f, -6.71240151e-01f, -9.84248459e-01f, 1.76790684e-01f,
  4.68516916e-01f, -8.83454502e-01f, -9.76457715e-01f, 2.15709001e-01f, -7.35215396e-02f, 9.97293651e-01f, 6.02069914e-01f, 7.98443377e-01f,
  8.67819190e-01f, 4.96880114e-01f, 9.57549810e-01f, 2.88267940e-01f, 9.86510456e-01f, 1.63698375e-01f, 9.95727658e-01f, 9.23388004e-02f,
  9.98648286e-01f, 5.19765690e-02f, 9.99572515e-01f, 2.92375814e-02f, 9.99864817e-01f, 1.64431017e-02f, 9.99957263e-01f, 9.24692024e-03f,
  -9.18282807e-01f, 3.95925164e-01f, -4.10281904e-02f, -9.99157965e-01f, -4.95741814e-01f, -8.68469954e-01f, -1.00000000e+00f, -1.03020677e-04f,
  5.54374516e-01f, -8.32267344e-01f, -9.87038016e-01f, 1.60486728e-01f, -1.05016708e-01f, 9.94470477e-01f, 5.87776959e-01f, 8.09023023e-01f,
  8.62807095e-01f, 5.05533338e-01f, 9.55913603e-01f, 2.93648034e-01f, 9.85987842e-01f, 1.66817173e-01f, 9.95561838e-01f, 9.41093415e-02f,
  9.98595834e-01f, 5.29751927e-02f, 9.99555886e-01f, 2.97996756e-02f, 9.99859571e-01f, 1.67592876e-02f, 9.99955595e-01f, 9.42474138e-03f,
  -8.29309821e-01f, -5.58789074e-01f, 4.98009592e-01f, -8.67171526e-01f, -2.01079622e-01f, -9.79574919e-01f, -9.84212041e-01f, -1.76993474e-01f,
  6.34692967e-01f, -7.72764444e-01f, -9.94497895e-01f, 1.04756832e-01f, -1.36406869e-01f, 9.90652919e-01f, 5.73298037e-01f, 8.19346905e-01f,
  8.57708693e-01f, 5.14135957e-01f, 9.54247177e-01f, 2.99018890e-01f, 9.85455394e-01f, 1.69934288e-01f, 9.95392919e-01f, 9.58795771e-02f,
  9.98542368e-01f, 5.39737605e-02f, 9.99538958e-01f, 3.03617641e-02f, 9.99854207e-01f, 1.70754679e-02f, 9.99953866e-01f, 9.60256159e-03f,
  2.21267566e-02f, -9.99755144e-01f, 8.83669317e-01f, -4.68111664e-01f, 1.13521777e-01f, -9.93535519e-01f, -9.37382519e-01f, -3.48301649e-01f,
  7.08669782e-01f, -7.05540299e-01f, -9.98813629e-01f, 4.86960001e-02f, -1.67660639e-01f, 9.85844791e-01f, 5.58637917e-01f, 8.29411685e-01f,
  8.52524519e-01f, 5.22687256e-01f, 9.52550590e-01f, 3.04380238e-01f, 9.84913111e-01f, 1.73049718e-01f, 9.95220840e-01f, 9.76495072e-02f,
  9.98487890e-01f, 5.49722798e-02f, 9.99521732e-01f, 3.09238415e-02f, 9.99848783e-01f, 1.73916500e-02f, 9.99952197e-01f, 9.78038087e-03f,
  8.53220105e-01f, -5.21551013e-01f, 9.97174621e-01f, 7.51182064e-02f, 4.16867077e-01f, -9.08967435e-01f, -8.60988438e-01f, -5.08624554e-01f,
  7.75565803e-01f, -6.31266713e-01f, -9.99971747e-01f, -7.51878507e-03f, -1.98746875e-01f, 9.80050862e-01f, 5.43801069e-01f, 8.39214146e-01f,
  8.47255111e-01f, 5.31186223e-01f, 9.50823903e-01f, 3.09731960e-01f, 9.84360933e-01f, 1.76163420e-01f, 9.95045662e-01f, 9.94191393e-02f,
  9.98432398e-01f, 5.59707358e-02f, 9.99504209e-01f, 3.14859077e-02f, 9.99843180e-01f, 1.77078284e-02f, 9.99950409e-01f, 9.95820016e-03f,
  8.99866819e-01f, 4.36164767e-01f, 8.03569078e-01f, 5.95211506e-01f, 6.78870201e-01f, -7.34258294e-01f, -7.57439196e-01f, -6.52905703e-01f,
  8.34712923e-01f, -5.50685287e-01f, -9.97968495e-01f, -6.37097955e-02f, -2.29634270e-01f, 9.73276973e-01f, 5.28792322e-01f, 8.48751247e-01f,
  8.41901004e-01f, 5.39632022e-01f, 9.49067116e-01f, 3.15073937e-01f, 9.83798921e-01f, 1.79275364e-01f, 9.94867265e-01f, 1.01188451e-01f,
  9.98375952e-01f, 5.69691435e-02f, 9.99486327e-01f, 3.20479684e-02f, 9.99837577e-01f, 1.80240069e-02f, 9.99948621e-01f, 1.01360194e-02f,
  1.19180135e-01f, 9.92872655e-01f, 3.62476677e-01f, 9.31992829e-01f, 8.73550534e-01f, -4.86733496e-01f, -6.30000710e-01f, -7.76594579e-01f,
  8.85519624e-01f, -4.64602023e-01f, -9.92810190e-01f, -1.19699396e-01f, -2.60292053e-01f, 9.65529919e-01f, 5.13616323e-01f, 8.58020008e-01f,
  8.36462677e-01f, 5.48023939e-01f, 9.47280347e-01f, 3.20405900e-01f, 9.83227074e-01f, 1.82385504e-01f, 9.94685769e-01f, 1.02957435e-01f,
  9.98318493e-01f, 5.79674877e-02f, 9.99468148e-01f, 3.26100141e-02f, 9.99831796e-01f, 1.83401816e-02f, 9.99946833e-01f, 1.03138378e-02f,
  -7.71080196e-01f, 6.36738002e-01f, -1.90249100e-01f, 9.81735826e-01f, 9.81602073e-01f, -1.90938011e-01f, -4.82692331e-01f, -8.75790000e-01f,
  9.27478492e-01f, -3.73876572e-01f, -9.84513164e-01f, -1.75310582e-01f, -2.90689558e-01f, 9.56817448e-01f, 4.98277903e-01f, 8.67017388e-01f,
  8.30940723e-01f, 5.56361020e-01f, 9.45463598e-01f, 3.25727791e-01f, 9.82645452e-01f, 1.85493827e-01f, 9.94501114e-01f, 1.04726106e-01f,
  9.98260021e-01f, 5.89657798e-02f, 9.99449670e-01f, 3.31720486e-02f, 9.99825954e-01f, 1.86563563e-02f, 9.99944985e-01f, 1.04916561e-02f,
  -9.52412963e-01f, -3.04810613e-01f, -6.84381902e-01f, 7.29123712e-01f, 9.92308319e-01f, 1.23790950e-01f, -3.20159167e-01f, -9.47363734e-01f,
  9.60170269e-01f, -2.79415488e-01f, -9.73103702e-01f, -2.30367512e-01f, -3.20796400e-01f, 9.47148204e-01f, 4.82782036e-01f, 8.75740528e-01f,
  8.25335622e-01f, 5.64642429e-01f, 9.43616986e-01f, 3.31039310e-01f, 9.82053936e-01f, 1.88600287e-01f, 9.94313300e-01f, 1.06494442e-01f,
  9.98200536e-01f, 5.99640086e-02f, 9.99430835e-01f, 3.37340795e-02f, 9.99819994e-01f, 1.89725272e-02f, 9.99943078e-01f, 1.06694745e-02f,
  -2.58101642e-01f, -9.66117799e-01f, -9.67739642e-01f, 2.51952261e-01f, 9.04607594e-01f, 4.26245421e-01f, -1.47529200e-01f, -9.89057720e-01f,
  9.83268440e-01f, -1.82162598e-01f, -9.58617806e-01f, -2.84696162e-01f, -3.50582451e-01f, 9.36531842e-01f, 4.67133403e-01f, 8.84186864e-01f,
  8.19648027e-01f, 5.72867453e-01f, 9.41740453e-01f, 3.36340427e-01f, 9.81452644e-01f, 1.91704854e-01f, 9.94122326e-01f, 1.08262435e-01f,
  9.98140097e-01f, 6.09621815e-02f, 9.99411702e-01f, 3.42960916e-02f, 9.99813974e-01f, 1.92886982e-02f, 9.99941170e-01f, 1.08472919e-02f,
  6.73507154e-01f, -7.39180684e-01f, -9.53050017e-01f, -3.02812874e-01f, 7.27198064e-01f, 6.86427653e-01f, 2.97537707e-02f, -9.99557257e-01f,
  9.96542096e-01f, -8.30891207e-02f, -9.41101313e-01f, -3.38124752e-01f, -3.80017966e-01f, 9.24979091e-01f, 4.51337039e-01f, 8.92353535e-01f,
  8.13878477e-01f, 5.81035137e-01f, 9.39834237e-01f, 3.41630876e-01f, 9.80841517e-01f, 1.94807529e-01f, 9.93928254e-01f, 1.10030092e-01f,
  9.98078644e-01f, 6.19602874e-02f, 9.99392271e-01f, 3.48580964e-02f, 9.99807835e-01f, 1.96048655e-02f, 9.99939203e-01f, 1.10251084e-02f,
  9.85896587e-01f, 1.67355701e-01f, -6.44837022e-01f, -7.64320076e-01f, 4.77671444e-01f, 8.78538549e-01f, 2.06098333e-01f, -9.78531301e-01f,
  9.99858618e-01f, 1.68140903e-02f, -9.20609534e-01f, -3.90484393e-01f, -4.09073502e-01f, 9.12501454e-01f, 4.35397953e-01f, 9.00238097e-01f,
  8.08027506e-01f, 5.89144766e-01f, 9.37898219e-01f, 3.46910536e-01f, 9.80220556e-01f, 1.97908238e-01f, 9.93731022e-01f, 1.11797392e-01f,
  9.98016179e-01f, 6.29583374e-02f, 9.99372482e-01f, 3.54200937e-02f, 9.99801576e-01f, 1.99210308e-02f, 9.99937236e-01f, 1.12029258e-02f,
};

constexpr int T_ALL = 36864, T_CTX = 4096;
constexpr int NLAYER = 4;
constexpr float EPS = 1e-6f;
constexpr int LK_LAT = 4352;

struct Params {
  const float* x_prompt; const float* x_sample; const float* cache_ckv; const float* cache_krope;
  const float* cache_k; const float* cache_v; const float* state; const float* c; const float* c_ctx;
  const float* w_mod; const float* b_mod; const float* g_norm; const float* w_in; const float* conv_w; const float* conv_b;
  const float* lru_wa; const float* lru_ba; const float* lru_wi; const float* lru_bi; const float* lru_lam;
  const float* q_norm; const float* w_uq; const float* kv_norm; const float* w_ukv; const float* sink;
  const float* w_br_rnn; const float* w_br_mla; const float* w_br_swa; const float* w_out; const float* final_norm;
  float* out; char* ws;
};

constexpr size_t AL(size_t x) { return (x + 255) & ~(size_t)255; }
constexpr size_t O_WINA = 0;
constexpr size_t O_WINB = O_WINA + AL((size_t)2560 * 1024 * 2);
constexpr size_t O_WLRU = O_WINB + AL((size_t)5120 * 1024 * 2);
constexpr size_t O_WUQ = O_WLRU + AL((size_t)4096 * 128 * 2);
constexpr size_t O_WUKVG = O_WUQ + AL((size_t)768 * 384 * 2);
constexpr size_t O_WUKVR = O_WUKVG + AL((size_t)1024 * 256 * 2);
constexpr size_t O_WBRR = O_WUKVR + AL((size_t)1024 * 256 * 2);
constexpr size_t O_WBRM = O_WBRR + AL((size_t)1024 * 1024 * 2);
constexpr size_t O_WBRS = O_WBRM + AL((size_t)1024 * 512 * 2);
constexpr size_t O_WOUT = O_WBRS + AL((size_t)1024 * 512 * 2);
constexpr size_t O_MOD = O_WOUT + AL((size_t)1024 * 1024 * 2);
constexpr size_t O_H = O_MOD + AL((size_t)4 * 9 * 3072 * 4);
constexpr size_t O_XR = O_H + AL((size_t)T_ALL * 1024 * 2);
constexpr size_t O_CQ = O_XR + AL((size_t)T_ALL * 1024 * 2);
constexpr size_t O_CKV = O_CQ + AL((size_t)T_ALL * 384 * 2);
constexpr size_t O_CKVC = O_CKV + AL((size_t)T_ALL * 256 * 2);
constexpr size_t O_KRL = O_CKVC + AL((size_t)2048 * 256 * 2);
constexpr size_t O_KRC = O_KRL + AL((size_t)8 * LK_LAT * 32 * 2);
constexpr size_t O_QS = O_KRC + AL((size_t)16 * 256 * 32 * 2);
constexpr size_t O_KS = O_QS + AL((size_t)T_ALL * 512 * 2);
constexpr size_t O_KSC = O_KS + AL((size_t)T_ALL * 128 * 2);
constexpr size_t O_VTSL = O_KSC + AL((size_t)8 * 256 * 128 * 2);
constexpr size_t O_VTSC = O_VTSL + AL((size_t)8 * 2 * 64 * 4096 * 2);
constexpr size_t O_VTSCC = O_VTSC + AL((size_t)16 * 2 * 64 * 256 * 2);
constexpr size_t O_Q = O_VTSCC + AL((size_t)8 * 2 * 64 * 256 * 2);
constexpr size_t O_KNL = O_Q + AL((size_t)T_ALL * 768 * 2);
constexpr size_t O_KNC = O_KNL + AL((size_t)8 * 8 * LK_LAT * 64 * 2);
constexpr size_t O_VTL = O_KNC + AL((size_t)16 * 8 * 256 * 64 * 2);
constexpr size_t O_VTC = O_VTL + AL((size_t)8 * 8 * 64 * LK_LAT * 2);
constexpr size_t O_YRNN = O_VTC + AL((size_t)16 * 8 * 64 * 256 * 2);
static_assert(O_YRNN - O_KS >= (size_t)2 * T_ALL * 1024 * 2, "merge-gate buffers do not fit");
constexpr size_t O_SUM = O_YRNN + AL((size_t)T_ALL * 1024 * 2);
constexpr size_t O_BAR = O_SUM + AL((size_t)8 * 8 * 2 * 16 * 256 * 4);
constexpr size_t BAR_BYTES = 16384;
constexpr size_t O_W2 = O_BAR + BAR_BYTES;
constexpr size_t WS_NEED = O_W2 + O_MOD;

constexpr size_t OUT_CKV = (size_t)T_ALL * 1024;
constexpr size_t OUT_KROPE = OUT_CKV + (size_t)16 * 4 * 256 * 256;
constexpr size_t OUT_SK = OUT_KROPE + (size_t)16 * 4 * 256 * 32;
constexpr size_t OUT_SV = OUT_SK + (size_t)16 * 4 * 256 * 128;
constexpr size_t OUT_RG = OUT_SV + (size_t)16 * 4 * 256 * 128;

#define SB() __builtin_amdgcn_sched_barrier(0)
#define MB() asm volatile("" ::: "memory")
DI int tid() { int t = threadIdx.x; asm volatile("" : "+v"(t)); return t; }
DI int xcd_map(int base) {
  const int g = gridDim.x;
  if (g & 7) return base + blockIdx.x;
  return base + (blockIdx.x & 7) * (g >> 3) + (blockIdx.x >> 3);
}
#define LANEVARS const int t = tid(), lane = t & 63, w = t >> 6, wr = w >> 1, wc = w & 1; const int c16 = lane & 15, g4 = lane >> 4; (void)wr; (void)wc; (void)c16; (void)g4;
DI float bf2f(u16 v) { return __uint_as_float(((unsigned)v) << 16); }
DI unsigned pack2(float a, float b) {
  f2_t v = {a, b};
  bf2_t r = __builtin_convertvector(v, bf2_t);
  return __builtin_bit_cast(unsigned, r);
}
DI u16 f2bf(float a) { return (u16)(pack2(a, 0.f) & 0xffffu); }
DI float sigmoidf_(float x) { return __builtin_amdgcn_rcpf(1.f + __expf(-x)); }
DI float wave_sum(float v) {
#pragma unroll
  for (int o = 32; o > 0; o >>= 1) v += __shfl_xor(v, o);
  return v;
}
DI int perm32(int p) { return (p & 7) | ((p & 8) << 1) | ((p & 16) >> 1); }
DI const float* xin_row(const Params& p, int l, int row) {
  if (l == 0) return row < T_CTX ? p.x_prompt + (size_t)row * 1024 : p.x_sample + (size_t)(row - T_CTX) * 1024;
  return p.out + (size_t)row * 1024;
}
template <class T> DI T* wsp(const Params& p, size_t off) { return (T*)(p.ws + off); }
DI u16* wsw(const Params& p, int l, size_t off) { return (u16*)(p.ws + ((l & 1) ? O_W2 : 0) + off); }

template <int NJ>
DI void gemm_tile_t(const u16* A, int lda, const u16* B, int ldb, int K,
                    f32x4 (&acc)[4][NJ], char* smem) {
  const int t = tid(), lane = t & 63, w = t >> 6, wr = w >> 1, wc = w & 1;
  const int lr = t >> 3, slot = t & 7;
  const int c16 = lane & 15, g4 = lane >> 4;
  const int gch = slot ^ ((lr >> 1) & 7);
  const u16* ap = A + (size_t)lr * lda + gch * 8;
  const u16* bp = B + (size_t)lr * ldb + gch * 8;
  char* sdst = smem + t * 16;
#define DMA16(gp, lp) __builtin_amdgcn_global_load_lds((const unsigned*)(gp), (unsigned*)(lp), 16, 0, 0)
#define STAGE(base, ko) { DMA16(ap + (ko), (base)); DMA16(ap + (size_t)32 * lda + (ko), (base) + 4096); \
    DMA16(ap + (size_t)64 * lda + (ko), (base) + 8192); DMA16(ap + (size_t)96 * lda + (ko), (base) + 12288); \
    DMA16(bp + (ko), (base) + 16384); DMA16(bp + (size_t)32 * ldb + (ko), (base) + 16384 + 4096); \
    if (NJ > 2) { DMA16(bp + (size_t)64 * ldb + (ko), (base) + 16384 + 8192); DMA16(bp + (size_t)96 * ldb + (ko), (base) + 16384 + 12288); } }
  const int nk = K >> 6;
  const int arow = (wr * 64 + c16) * 128, brow = (wc * (16 * NJ) + c16) * 128;
  const int sw = (c16 >> 1) & 7;
  int kk = 0;
  STAGE(sdst, kk * 64)
  __syncthreads();
  for (int kt = 0; kt < nk; ++kt) {
    char* cur = smem + (kt & 1) * 32768;
    kk = (kk + 1 == nk) ? 0 : kk + 1;
    if (kt + 1 < nk) { char* nxt = sdst + ((kt + 1) & 1) * 32768; STAGE(nxt, kk * 64) }
#pragma unroll
    for (int ks = 0; ks < 2; ++ks) {
      bf16x8 af[4], bfr[NJ];
      const int ch = ((ks * 4 + g4) ^ sw) << 4;
#pragma unroll
      for (int i = 0; i < 4; ++i) af[i] = *(const bf16x8*)(cur + arow + i * 2048 + ch);
#pragma unroll
      for (int i = 0; i < NJ; ++i) bfr[i] = *(const bf16x8*)(cur + 16384 + brow + i * 2048 + ch);
#pragma unroll
      for (int i = 0; i < 4; ++i)
#pragma unroll
        for (int j = 0; j < NJ; ++j)
          acc[i][j] = __builtin_amdgcn_mfma_f32_16x16x32_bf16(af[i], bfr[j], acc[i][j], 0, 0, 0);
    }
    SB();
    __syncthreads();
  }
#undef STAGE
#undef DMA16
}
DI void gemm_tile(const u16* A, int lda, const u16* B, int ldb, int K,
                  f32x4 (&acc)[4][4], char* smem) {
  gemm_tile_t<4>(A, lda, B, ldb, K, acc, smem);
}
DI void zero_acc(f32x4 (&acc)[4][4]) {
#pragma unroll
  for (int i = 0; i < 4; ++i)
#pragma unroll
    for (int j = 0; j < 4; ++j) acc[i][j] = f32x4{0.f, 0.f, 0.f, 0.f};
}

struct TokTile { int g0; int is_ctx; int b; int p0; };
DI TokTile tok_tile(int mt) {
  TokTile r; r.g0 = mt * 128;
  if (r.g0 < T_CTX) { r.is_ctx = 1; r.b = r.g0 >> 8; r.p0 = r.g0 & 255; }
  else { r.is_ctx = 0; r.b = (r.g0 - T_CTX) >> 12; r.p0 = (r.g0 - T_CTX) & 4095; }
  return r;
}

DI void phase_mod(const Params& p, char* smem) {
  float* s_silu = (float*)smem;
  float* s_part = (float*)(smem + 36864);
  float* MOD = wsp<float>(p, O_MOD);
  const int t = tid();
  for (int i = t; i < 9 * 1024; i += 256) {
    float v = (i < 8192) ? p.c[i] : p.c_ctx[i - 8192];
    s_silu[i] = v * sigmoidf_(v);
  }
  __syncthreads();
  const int kg = t >> 6, cl = t & 63;
  for (int u = blockIdx.x; u < 4 * 48; u += gridDim.x) {
    const int l = u / 48, cb = u % 48;
    const int n = cb * 64 + cl;
    float acc[9];
#pragma unroll
    for (int ci = 0; ci < 9; ++ci) acc[ci] = 0.f;
    const float* wp = p.w_mod + ((size_t)l * 1024 + kg * 256) * 3072 + n;
    for (int k = 0; k < 256; ++k) {
      float wv = wp[(size_t)k * 3072];
#pragma unroll
      for (int ci = 0; ci < 9; ++ci) acc[ci] += s_silu[ci * 1024 + kg * 256 + k] * wv;
    }
#pragma unroll
    for (int ci = 0; ci < 9; ++ci) s_part[(kg * 9 + ci) * 64 + cl] = acc[ci];
    __syncthreads();
    for (int idx = t; idx < 9 * 64; idx += 256) {
      int ci = idx >> 6, c2 = idx & 63;
      float s = s_part[(0 * 9 + ci) * 64 + c2] + s_part[(1 * 9 + ci) * 64 + c2] + s_part[(2 * 9 + ci) * 64 + c2] +
                s_part[(3 * 9 + ci) * 64 + c2];
      MOD[((size_t)l * 9 + ci) * 3072 + cb * 64 + c2] = s + p.b_mod[l * 3072 + cb * 64 + c2];
    }
    __syncthreads();
  }
}

template <class F> DI void conv_job(u16* dst, int N, int K, F src) {
  const int total = N * (K >> 3);
  for (int idx = blockIdx.x * 256 + tid(); idx < total; idx += gridDim.x * 256) {
    const int n = idx % N, kb = idx / N;
    float v[8];
#pragma unroll
    for (int j = 0; j < 8; ++j) v[j] = src(kb * 8 + j, n);
    uint4 o;
    o.x = pack2(v[0], v[1]); o.y = pack2(v[2], v[3]); o.z = pack2(v[4], v[5]); o.w = pack2(v[6], v[7]);
    *(uint4*)(dst + (size_t)n * K + kb * 8) = o;
  }
}

DI void convert_weights(const Params& p, int l) {
  {
    const float* win = p.w_in + (size_t)l * 1024 * 7584;
    conv_job(wsw(p, l, O_WINA), 2560, 1024, [&](int k, int n) -> float {
      int col;
      if (n < 1024) col = n;
      else if (n < 1408) col = 2048 + (n - 1024);
      else if (n < 1664) col = 2432 + (n - 1408);
      else if (n < 1792) { int pp = n - 1664; col = pp < 32 ? 2688 + perm32(pp) : -1; }
      else if (n < 2304) col = 3232 + (n - 1792);
      else if (n < 2432) col = 3744 + (n - 2304);
      else col = 3872 + (n - 2432);
      return col < 0 ? 0.f : win[(size_t)k * 7584 + col];
    });
    conv_job(wsw(p, l, O_WINB), 5120, 1024, [&](int k, int n) -> float {
      int col;
      if (n < 1024) col = 1024 + n;
      else if (n < 1536) col = 2720 + (n - 1024);
      else if (n < 2048) col = 4000 + (n - 1536);
      else col = 4512 + (n - 2048);
      return win[(size_t)k * 7584 + col];
    });
    const float* wa = p.lru_wa + (size_t)l * 2 * 8 * 128 * 128;
    const float* wi = p.lru_wi + (size_t)l * 2 * 8 * 128 * 128;
    conv_job(wsw(p, l, O_WLRU), 4096, 128, [&](int k, int n) -> float {
      int db = n >> 8, nn = n & 255;
      return nn < 128 ? wa[((size_t)db * 128 + k) * 128 + nn] : wi[((size_t)db * 128 + k) * 128 + (nn - 128)];
    });
    const float* wuq = p.w_uq + (size_t)l * 384 * 768;
    const float* gq = p.q_norm + l * 384;
    conv_job(wsw(p, l, O_WUQ), 768, 384, [&](int k, int n) -> float {
      int col;
      if (n < 512) col = (n >> 6) * 96 + (n & 63);
      else { int hh = (n - 512) >> 5, pp = (n - 512) & 31; col = hh * 96 + 64 + perm32(pp); }
      return gq[k] * wuq[(size_t)k * 768 + col];
    });
    const float* wukv = p.w_ukv + (size_t)l * 256 * 1024;
    const float* gkv = p.kv_norm + l * 256;
    conv_job(wsw(p, l, O_WUKVG), 1024, 256, [&](int k, int n) -> float { return gkv[k] * wukv[(size_t)k * 1024 + n]; });
    conv_job(wsw(p, l, O_WUKVR), 1024, 256, [&](int k, int n) -> float { return wukv[(size_t)k * 1024 + n]; });
    const float* w1 = p.w_br_rnn + (size_t)l * 1024 * 1024;
    conv_job(wsw(p, l, O_WBRR), 1024, 1024, [&](int k, int n) -> float { return w1[(size_t)k * 1024 + n]; });
    const float* w2 = p.w_br_mla + (size_t)l * 512 * 1024;
    conv_job(wsw(p, l, O_WBRM), 1024, 512, [&](int k, int n) -> float { return w2[(size_t)k * 1024 + n]; });
    const float* w3 = p.w_br_swa + (size_t)l * 512 * 1024;
    conv_job(wsw(p, l, O_WBRS), 1024, 512, [&](int k, int n) -> float { return w3[(size_t)k * 1024 + n]; });
    const float* w4 = p.w_out + (size_t)l * 1024 * 1024;
    conv_job(wsw(p, l, O_WOUT), 1024, 1024, [&](int k, int n) -> float { return w4[(size_t)k * 1024 + n]; });
  }
}

DI void phase_prep(const Params& p, int l) {
  const int t = tid(), lane = t & 63, w = t >> 6;
  const float* MOD = wsp<float>(p, O_MOD) + (size_t)l * 9 * 3072;
  u16* H = wsp<u16>(p, O_H);
  for (int row = blockIdx.x * 4 + w; row < T_ALL; row += gridDim.x * 4) {
    const float* x = xin_row(p, l, row);
    const int ci = row < T_CTX ? 8 : ((row - T_CTX) >> 12);
    const float* md = MOD + ci * 3072;
    float4 v[4];
    float ss = 0.f;
#pragma unroll
    for (int i = 0; i < 4; ++i) {
      v[i] = *(const float4*)(x + i * 256 + lane * 4);
      ss += v[i].x * v[i].x + v[i].y * v[i].y + v[i].z * v[i].z + v[i].w * v[i].w;
    }
    ss = wave_sum(ss);
    const float rs = rsqrtf(ss * (1.f / 1024.f) + EPS);
#pragma unroll
    for (int i = 0; i < 4; ++i) {
      const int c = i * 256 + lane * 4;
      const float4 g = *(const float4*)(p.g_norm + l * 1024 + c);
      const float4 sh = *(const float4*)(md + c);
      const float4 sc = *(const float4*)(md + 1024 + c);
      float h0 = v[i].x * rs * g.x * (1.f + sc.x) + sh.x;
      float h1 = v[i].y * rs * g.y * (1.f + sc.y) + sh.y;
      float h2 = v[i].z * rs * g.z * (1.f + sc.z) + sh.z;
      float h3 = v[i].w * rs * g.w * (1.f + sc.w) + sh.w;
      uint2 o; o.x = pack2(h0, h1); o.y = pack2(h2, h3);
      *(uint2*)(H + (size_t)row * 1024 + c) = o;
    }
  }
  {
    const int gt = blockIdx.x * 256 + t, gs = gridDim.x * 256;
    u16* ckvc = wsp<u16>(p, O_CKVC);
    for (int i = gt; i < 2048 * 256; i += gs) {
      int r = i >> 8, k = i & 255, b = r >> 8, pos = r & 255;
      ckvc[i] = f2bf(p.cache_ckv[(((size_t)b * 4 + l) * 256 + pos) * 256 + k]);
    }
    u16* krl = wsp<u16>(p, O_KRL);
    for (int i = gt; i < 8 * 256 * 32; i += gs) {
      int pp = i & 31, pos = (i >> 5) & 255, b = i >> 13;
      krl[((size_t)b * LK_LAT + pos) * 32 + pp] = f2bf(p.cache_krope[(((size_t)b * 4 + l) * 256 + pos) * 32 + perm32(pp)]);
    }
    u16* ksc = wsp<u16>(p, O_KSC);
    for (int i = gt; i < 8 * 256 * 128; i += gs) {
      int c = i & 127, pos = (i >> 7) & 255, b = i >> 15;
      ksc[i] = f2bf(p.cache_k[(((size_t)b * 4 + l) * 256 + pos) * 128 + c]);
    }
    u16* vtc = wsp<u16>(p, O_VTSCC);
    for (int i = gt; i < 8 * 2 * 64 * 256; i += gs) {
      int pos = i & 255, dv = (i >> 8) & 63, kvh = (i >> 14) & 1, b = i >> 15;
      vtc[i] = f2bf(p.cache_v[(((size_t)b * 4 + l) * 256 + pos) * 128 + kvh * 64 + dv]);
    }
  }
}

DI void phase_gemmA(const Params& p, int l, char* smem) {
  const u16* H = wsp<u16>(p, O_H);
  const u16* W = wsw(p, l, O_WINA);
  for (int base = 0; base < 288 * 20; base += gridDim.x) {
    const int tile = xcd_map(base);
    if (tile >= 288 * 20) continue;
    const int sb = tile >> 5, jj = tile & 31;
    const int mt = (sb / 5) * 8 + (jj >> 2), nt = (sb % 5) * 4 + (jj & 3);
    const TokTile tt = tok_tile(mt);
    f32x4 acc[4][4];
    zero_acc(acc);
    gemm_tile(H + (size_t)tt.g0 * 1024, 1024, W + (size_t)nt * 128 * 1024, 1024, 1024, acc, smem);
    LANEVARS
    if (nt < 13) {
      u16* dst; int ld, cb;
      if (nt < 8) { dst = wsp<u16>(p, O_XR); ld = 1024; cb = nt * 128; }
      else if (nt < 11) { dst = wsp<u16>(p, O_CQ); ld = 384; cb = (nt - 8) * 128; }
      else { dst = wsp<u16>(p, O_CKV); ld = 256; cb = (nt - 11) * 128; }
#pragma unroll
      for (int i = 0; i < 4; ++i)
#pragma unroll
        for (int j = 0; j < 4; ++j)
#pragma unroll
          for (int e = 0; e < 4; ++e) {
            const int g = tt.g0 + wr * 64 + i * 16 + g4 * 4 + e;
            dst[(size_t)g * ld + cb + wc * 64 + j * 16 + c16] = f2bf(acc[i][j][e]);
            if (e == 3 && j == 3) SB();
          }
    } else if (nt == 13) {
      if (wc == 0) {
#pragma unroll
        for (int i = 0; i < 4; ++i)
#pragma unroll
          for (int e = 0; e < 4; ++e) {
            SB();
            const int r = wr * 64 + i * 16 + g4 * 4 + e;
            const int pos = tt.p0 + r;
            float x1 = acc[i][0][e], x2 = acc[i][1][e];
            if (tt.is_ctx) {
              u16* kr = wsp<u16>(p, O_KRC) + ((size_t)tt.b * 256 + pos) * 32;
              kr[c16] = f2bf(x1); kr[c16 + 16] = f2bf(x2);
              float* o = p.out + OUT_KROPE + (((size_t)tt.b * 4 + l) * 256 + pos) * 32;
              o[perm32(c16)] = x1; o[perm32(c16 + 16)] = x2;
            } else {
              const int pv = (c16 >= 8) ? (pos & 63) : (pos >> 6);
              const float cs = TAB_M[(pv * 8 + (c16 & 7)) * 2], sn = TAB_M[(pv * 8 + (c16 & 7)) * 2 + 1];
              u16* kr = wsp<u16>(p, O_KRL) + ((size_t)tt.b * LK_LAT + 256 + pos) * 32;
              kr[c16] = f2bf(x1 * cs - x2 * sn); kr[c16 + 16] = f2bf(x2 * cs + x1 * sn);
            }
          }
      }
    } else if (nt < 19) {
      const bool isk = (nt == 18);
      u16* dst = isk ? wsp<u16>(p, O_KS) : wsp<u16>(p, O_QS);
      const int ld = isk ? 128 : 512;
      const int cb = isk ? wc * 64 : ((nt - 14) * 2 + wc) * 64;
#pragma unroll
      for (int i = 0; i < 4; ++i)
#pragma unroll
        for (int e = 0; e < 4; ++e) {
          SB();
          const int r = wr * 64 + i * 16 + g4 * 4 + e;
          const int pos = tt.p0 + r, g = tt.g0 + r;
          float v0 = acc[i][0][e], v1 = acc[i][1][e], v2 = acc[i][2][e], v3 = acc[i][3][e];
          if (!tt.is_ctx) {
            const int pr = pos >> 6, pc = pos & 63;
            const float c0 = TAB_S[(pr * 16 + c16) * 2], s0 = TAB_S[(pr * 16 + c16) * 2 + 1];
            const float c1 = TAB_S[(pc * 16 + c16) * 2], s1 = TAB_S[(pc * 16 + c16) * 2 + 1];
            float a0 = v0 * c0 - v1 * s0, a1 = v1 * c0 + v0 * s0;
            float a2 = v2 * c1 - v3 * s1, a3 = v3 * c1 + v2 * s1;
            v0 = a0; v1 = a1; v2 = a2; v3 = a3;
          } else if (isk) {
            float* o = p.out + OUT_SK + (((size_t)tt.b * 4 + l) * 256 + pos) * 128 + cb + c16;
            o[0] = v0; o[16] = v1; o[32] = v2; o[48] = v3;
          }
          u16* d = dst + (size_t)g * ld + cb + c16;
          d[0] = f2bf(v0); d[16] = f2bf(v1); d[32] = f2bf(v2); d[48] = f2bf(v3);
        }
    } else {
      u16* vt = tt.is_ctx ? wsp<u16>(p, O_VTSC) : wsp<u16>(p, O_VTSL);
      const int L = tt.is_ctx ? 256 : 4096;
#pragma unroll
      for (int i = 0; i < 4; ++i)
#pragma unroll
        for (int j = 0; j < 4; ++j) {
          SB();
          const int r = wr * 64 + i * 16 + g4 * 4;
          const int pos = tt.p0 + r, dv = j * 16 + c16;
          uint2 o; o.x = pack2(acc[i][j][0], acc[i][j][1]); o.y = pack2(acc[i][j][2], acc[i][j][3]);
          *(uint2*)(vt + (((size_t)tt.b * 2 + wc) * 64 + dv) * L + pos) = o;
          if (tt.is_ctx) {
#pragma unroll
            for (int e = 0; e < 4; ++e)
              p.out[OUT_SV + (((size_t)tt.b * 4 + l) * 256 + pos + e) * 128 + wc * 64 + dv] = acc[i][j][e];
          }
        }
    }
  }
}

DI void row_scales(const u16* A, int K, float* s_rs) {
  const int t = tid(), row = t >> 1, half = t & 1;
  const u16* ap = A + (size_t)row * K + half * (K >> 1);
  float ss = 0.f;
  for (int c = 0; c < (K >> 4); ++c) {
    uint4 v = *(const uint4*)(ap + c * 8);
    unsigned wv[4] = {v.x, v.y, v.z, v.w};
#pragma unroll
    for (int q = 0; q < 4; ++q) {
      float a = __uint_as_float(wv[q] << 16), b = __uint_as_float(wv[q] & 0xffff0000u);
      ss += a * a + b * b;
    }
  }
  ss += __shfl_xor(ss, 1);
  if (half == 0) s_rs[row] = rsqrtf(ss / (float)K + EPS);
}

template <int MODE> DI void scan_seg(const Params& p, int l, int seq, int blk, int d, int seg, char* smem);
DI void phase_qkv(const Params& p, int l, char* smem) {
  float* s_rs = (float*)(smem + 65536);
  constexpr int NQ = 288 * 6, NKV = 304 * 8, NS1 = 2048;
  for (int base = 0; base < NS1 + NQ + NKV; base += gridDim.x) {
    const int tile0 = xcd_map(base);
    if (tile0 >= NS1 + NQ + NKV) continue;
    if (tile0 < NS1) {
      scan_seg<0>(p, l, 16 + (tile0 >> 8), (tile0 >> 5) & 7, (tile0 >> 4) & 1, tile0 & 15, smem);
#if PROBE == 4
      scan_seg<0>(p, l, 16 + (tile0 >> 8), (tile0 >> 5) & 7, (tile0 >> 4) & 1, tile0 & 15, smem);
#endif
      continue;
    }
    const int tile = tile0 - NS1;
    f32x4 acc[4][4];
    zero_acc(acc);
    if (tile < NQ) {
      const int mt = tile / 6, nt = tile % 6;
      const TokTile tt = tok_tile(mt);
      const u16* A = wsp<u16>(p, O_CQ) + (size_t)tt.g0 * 384;
      row_scales(A, 384, s_rs);
      gemm_tile(A, 384, wsw(p, l, O_WUQ) + (size_t)nt * 128 * 384, 384, 384, acc, smem);
      LANEVARS
      u16* Q = wsp<u16>(p, O_Q);
#pragma unroll
      for (int i = 0; i < 4; ++i)
#pragma unroll
        for (int e = 0; e < 4; ++e) {
          SB();
          const int r = wr * 64 + i * 16 + g4 * 4 + e;
          const int pos = tt.p0 + r, g = tt.g0 + r;
          const float rs = s_rs[r];
          float v0 = acc[i][0][e] * rs, v1 = acc[i][1][e] * rs, v2 = acc[i][2][e] * rs, v3 = acc[i][3][e] * rs;
          if (nt >= 4 && !tt.is_ctx) {
            const int pv = (c16 >= 8) ? (pos & 63) : (pos >> 6);
            const float cs = TAB_M[(pv * 8 + (c16 & 7)) * 2], sn = TAB_M[(pv * 8 + (c16 & 7)) * 2 + 1];
            float a0 = v0 * cs - v1 * sn, a1 = v1 * cs + v0 * sn;
            float a2 = v2 * cs - v3 * sn, a3 = v3 * cs + v2 * sn;
            v0 = a0; v1 = a1; v2 = a2; v3 = a3;
          }
          u16* d = Q + (size_t)g * 768 + nt * 128 + wc * 64 + c16;
          d[0] = f2bf(v0); d[16] = f2bf(v1); d[32] = f2bf(v2); d[48] = f2bf(v3);
        }
    } else {
      const int t2 = tile - NQ;
      const int mt = t2 >> 3, hd = t2 & 7;
      const u16* A; const u16* Wt; int is_ctx, seq, kp0;
      if (mt < 288) {
        const TokTile tt = tok_tile(mt);
        A = wsp<u16>(p, O_CKV) + (size_t)tt.g0 * 256;
        Wt = wsw(p, l, O_WUKVG);
        row_scales(A, 256, s_rs);
        is_ctx = tt.is_ctx; seq = tt.b; kp0 = tt.is_ctx ? tt.p0 : 256 + tt.p0;
        if (tt.is_ctx && hd == 0) {
          __syncthreads();
          const float* gkv = p.kv_norm + l * 256;
          for (int idx = tid(); idx < 128 * 256; idx += 256) {
            const int r = idx >> 8, k = idx & 255;
            p.out[OUT_CKV + (((size_t)tt.b * 4 + l) * 256 + tt.p0 + r) * 256 + k] = bf2f(A[(size_t)r * 256 + k]) * s_rs[r] * gkv[k];
          }
        }
      } else {
        const int row0 = (mt - 288) * 128;
        A = wsp<u16>(p, O_CKVC) + (size_t)row0 * 256;
        Wt = wsw(p, l, O_WUKVR);
        { const int t1 = tid(); if (t1 < 128) s_rs[t1] = 1.f; }
        is_ctx = 0; seq = row0 >> 8; kp0 = row0 & 255;
      }
      gemm_tile(A, 256, Wt + (size_t)hd * 128 * 256, 256, 256, acc, smem);
      LANEVARS
      const int Lk = is_ctx ? 256 : LK_LAT;
      if (wc == 0) {
        u16* Kn = (is_ctx ? wsp<u16>(p, O_KNC) : wsp<u16>(p, O_KNL)) + ((size_t)seq * 8 + hd) * Lk * 64;
#pragma unroll
        for (int i = 0; i < 4; ++i)
#pragma unroll
          for (int j = 0; j < 4; ++j)
#pragma unroll
            for (int e = 0; e < 4; ++e) {
              const int r = wr * 64 + i * 16 + g4 * 4 + e;
              Kn[(size_t)(kp0 + r) * 64 + j * 16 + c16] = f2bf(acc[i][j][e] * s_rs[r]);
              if (e == 3) SB();
            }
      } else {
        u16* Vt = (is_ctx ? wsp<u16>(p, O_VTC) : wsp<u16>(p, O_VTL)) + ((size_t)seq * 8 + hd) * 64 * Lk;
#pragma unroll
        for (int i = 0; i < 4; ++i)
#pragma unroll
          for (int j = 0; j < 4; ++j) {
            SB();
            const int r = wr * 64 + i * 16 + g4 * 4;
            uint2 o;
            o.x = pack2(acc[i][j][0] * s_rs[r], acc[i][j][1] * s_rs[r + 1]);
            o.y = pack2(acc[i][j][2] * s_rs[r + 2], acc[i][j][3] * s_rs[r + 3]);
            *(uint2*)(Vt + (size_t)(j * 16 + c16) * Lk + kp0 + r) = o;
          }
      }
    }
    __syncthreads();
  }
}

template <int NS> DI void attn_gload(const int t, const u16* k0, int k0s, const u16* k1, const u16* vt, int vts,
                                     uint4& rk0, uint4& rk1, uint4& rk2, uint4& rv0, uint4& rv1) {
  if (NS == 6) {
    { const int c = t, key = c / 12, ch = c % 12;
      rk0 = (ch < 8) ? *(const uint4*)(k0 + (size_t)key * k0s + ch * 8) : *(const uint4*)(k1 + (size_t)key * 32 + (ch - 8) * 8); }
    { const int c = t + 256, key = c / 12, ch = c % 12;
      rk1 = (ch < 8) ? *(const uint4*)(k0 + (size_t)key * k0s + ch * 8) : *(const uint4*)(k1 + (size_t)key * 32 + (ch - 8) * 8); }
    { const int c = t + 512, key = c / 12, ch = c % 12;
      rk2 = (ch < 8) ? *(const uint4*)(k0 + (size_t)key * k0s + ch * 8) : *(const uint4*)(k1 + (size_t)key * 32 + (ch - 8) * 8); }
  } else {
    { const int c = t, key = c >> 3, ch = c & 7; rk0 = *(const uint4*)(k0 + (size_t)key * k0s + ch * 8); }
    { const int c = t + 256, key = c >> 3, ch = c & 7; rk1 = *(const uint4*)(k0 + (size_t)key * k0s + ch * 8); }
  }
  { const int c = t, dv = c >> 3, ch = c & 7; rv0 = *(const uint4*)(vt + (size_t)dv * vts + ch * 8); }
  { const int c = t + 256, dv = c >> 3, ch = c & 7; rv1 = *(const uint4*)(vt + (size_t)dv * vts + ch * 8); }
}
template <int NS> DI void attn_sstore(const int t, char* smem, const uint4& rk0, const uint4& rk1, const uint4& rk2, const uint4& rv0, const uint4& rv1) {
  constexpr int KSTR = (NS == 6) ? 208 : 144;
  if (NS == 6) {
    { const int c = t, key = c / 12, ch = c % 12; *(uint4*)(smem + key * KSTR + ch * 16) = rk0; }
    { const int c = t + 256, key = c / 12, ch = c % 12; *(uint4*)(smem + key * KSTR + ch * 16) = rk1; }
    { const int c = t + 512, key = c / 12, ch = c % 12; *(uint4*)(smem + key * KSTR + ch * 16) = rk2; }
  } else {
    { const int c = t, key = c >> 3, ch = c & 7; *(uint4*)(smem + key * KSTR + ch * 16) = rk0; }
    { const int c = t + 256, key = c >> 3, ch = c & 7; *(uint4*)(smem + key * KSTR + ch * 16) = rk1; }
  }
  { const int c = t, dv = c >> 3, ch = c & 7; char* d = smem + 13312 + dv * 136 + ch * 16;
    *(uint2*)d = uint2{rv0.x, rv0.y}; *(uint2*)(d + 8) = uint2{rv0.z, rv0.w}; }
  { const int c = t + 256, dv = c >> 3, ch = c & 7; char* d = smem + 13312 + dv * 136 + ch * 16;
    *(uint2*)d = uint2{rv1.x, rv1.y}; *(uint2*)(d + 8) = uint2{rv1.z, rv1.w}; }
}

#define PACK8(S, s2) __builtin_bit_cast(bf16x8, uint4{pack2(S[8 * (s2)], S[8 * (s2) + 1]), pack2(S[8 * (s2) + 2], S[8 * (s2) + 3]), \
                                                        pack2(S[8 * (s2) + 4], S[8 * (s2) + 5]), pack2(S[8 * (s2) + 6], S[8 * (s2) + 7])})

template <int NS>
DI void attn_item(const u16* kA, int kAs, const u16* krA, const u16* vtA, int vtAs, int nA, int kposA, int maskA,
                  const u16* kB, int kBs, const u16* vtB, int vtBs, int nB,
                  const u16* qa, const u16* qb, float sc2, float m0, float l0, int qpos, u16* yrow, char* smem) {
  constexpr int KSTR = (NS == 6) ? 208 : 144;
  const int tt_ = tid();
  const int lane = tt_ & 63;
  const int r32 = lane & 31, hh = lane >> 5;
  bf16x8 qf0, qf1, qf2, qf3, qf4, qf5;
  qf0 = *(const bf16x8*)(qa + 0 + 8 * hh); qf1 = *(const bf16x8*)(qa + 16 + 8 * hh);
  qf2 = *(const bf16x8*)(qa + 32 + 8 * hh); qf3 = *(const bf16x8*)(qa + 48 + 8 * hh);
  if (NS == 6) { qf4 = *(const bf16x8*)(qb + 0 + 8 * hh); qf5 = *(const bf16x8*)(qb + 16 + 8 * hh); }
  else { qf4 = qf0; qf5 = qf0; }
#define QSCALE(qf) { uint4 u_ = __builtin_bit_cast(uint4, qf); \
    u_.x = pack2(__uint_as_float(u_.x << 16) * sc2, __uint_as_float(u_.x & 0xffff0000u) * sc2); \
    u_.y = pack2(__uint_as_float(u_.y << 16) * sc2, __uint_as_float(u_.y & 0xffff0000u) * sc2); \
    u_.z = pack2(__uint_as_float(u_.z << 16) * sc2, __uint_as_float(u_.z & 0xffff0000u) * sc2); \
    u_.w = pack2(__uint_as_float(u_.w << 16) * sc2, __uint_as_float(u_.w & 0xffff0000u) * sc2); \
    qf = __builtin_bit_cast(bf16x8, u_); }
  QSCALE(qf0) QSCALE(qf1) QSCALE(qf2) QSCALE(qf3)
  if (NS == 6) { QSCALE(qf4) QSCALE(qf5) }
#undef QSCALE
  f32x16 O0, O1;
#pragma unroll
  for (int e = 0; e < 16; ++e) { O0[e] = 0.f; O1[e] = 0.f; }
  float m_run = m0, l_run = l0;
  uint4 rk0, rk1, rk2, rv0, rv1;
  rk2 = uint4{0, 0, 0, 0};
  const int ntiles = nA + nB;
#define TILE_GLOAD(jn) { if ((jn) < nA) attn_gload<NS>(tt_, kA + (size_t)(jn) * 64 * kAs, kAs, krA + (size_t)(jn) * 64 * 32, vtA + (jn) * 64, vtAs, rk0, rk1, rk2, rv0, rv1); \
    else { const int jb_ = (jn) - nA; attn_gload<NS>(tt_, kB + (size_t)jb_ * 64 * kBs, kBs, nullptr, vtB + jb_ * 64, vtBs, rk0, rk1, rk2, rv0, rv1); } }
  constexpr int STG = 22528;
  TILE_GLOAD(0)
  attn_sstore<NS>(tt_, smem, rk0, rk1, rk2, rv0, rv1);
  if (ntiles > 1) TILE_GLOAD(1)
  __syncthreads();
  for (int j = 0; j < ntiles; ++j) {
    char* sbase = smem + (j & 1) * STG;
    const int kpos = kposA + 64 * j;
    const bool masked = maskA && (j < nA);
    MB();
    f32x16 S0, S1;
#pragma unroll
    for (int e = 0; e < 16; ++e) { S0[e] = 0.f; S1[e] = 0.f; }
    const char* ka0 = sbase + r32 * KSTR + 16 * hh;
    const char* ka1 = sbase + (32 + r32) * KSTR + 16 * hh;
#define QK_STEP(s, qf) { bf16x8 a0 = *(const bf16x8*)(ka0 + 32 * (s)); bf16x8 a1 = *(const bf16x8*)(ka1 + 32 * (s)); \
      S0 = __builtin_amdgcn_mfma_f32_32x32x16_bf16(a0, qf, S0, 0, 0, 0); S1 = __builtin_amdgcn_mfma_f32_32x32x16_bf16(a1, qf, S1, 0, 0, 0); }
    QK_STEP(0, qf0) QK_STEP(1, qf1) QK_STEP(2, qf2) QK_STEP(3, qf3)
    if (NS == 6) { QK_STEP(4, qf4) QK_STEP(5, qf5) }
    SB();
    float mx = m_run;
#pragma unroll
    for (int e = 0; e < 16; ++e) {
      float v0 = S0[e], v1 = S1[e];
      if (masked) {
        const int kp = kpos + (e & 3) + 8 * (e >> 2) + 4 * hh;
        int d0 = qpos - kp; d0 = d0 < 0 ? -d0 : d0;
        int d1 = qpos - (kp + 32); d1 = d1 < 0 ? -d1 : d1;
        if (d0 > 128) v0 = -1e30f;
        if (d1 > 128) v1 = -1e30f;
      }
      S0[e] = v0; S1[e] = v1;
      mx = fmaxf(mx, fmaxf(v0, v1));
    }
    mx = fmaxf(mx, __shfl_xor(mx, 32));
    const float alpha = __builtin_amdgcn_exp2f(m_run - mx);
    m_run = mx;
    float rsum = 0.f;
#pragma unroll
    for (int e = 0; e < 16; ++e) {
      float p0 = __builtin_amdgcn_exp2f(S0[e] - mx), p1 = __builtin_amdgcn_exp2f(S1[e] - mx);
      S0[e] = p0; S1[e] = p1;
      rsum += p0 + p1;
    }
    rsum += __shfl_xor(rsum, 32);
    l_run = l_run * alpha + rsum;
#pragma unroll
    for (int e = 0; e < 16; ++e) { O0[e] *= alpha; O1[e] *= alpha; }
    const char* sv0 = sbase + 13312 + r32 * 136 + 8 * hh;
    const char* sv1 = sv0 + 32 * 136;
#define PV_STEP(pb, ka) { \
      { uint2 lo = *(const uint2*)(sv0 + (ka) * 2), hi = *(const uint2*)(sv0 + (ka) * 2 + 16); \
        bf16x8 va = __builtin_bit_cast(bf16x8, uint4{lo.x, lo.y, hi.x, hi.y}); O0 = __builtin_amdgcn_mfma_f32_32x32x16_bf16(va, pb, O0, 0, 0, 0); } \
      { uint2 lo = *(const uint2*)(sv1 + (ka) * 2), hi = *(const uint2*)(sv1 + (ka) * 2 + 16); \
        bf16x8 va = __builtin_bit_cast(bf16x8, uint4{lo.x, lo.y, hi.x, hi.y}); O1 = __builtin_amdgcn_mfma_f32_32x32x16_bf16(va, pb, O1, 0, 0, 0); } }
    SB();
    { bf16x8 pb = PACK8(S0, 0); PV_STEP(pb, 0) }
    { bf16x8 pb = PACK8(S0, 1); PV_STEP(pb, 16) }
    SB();
    { bf16x8 pb = PACK8(S1, 0); PV_STEP(pb, 32) }
    { bf16x8 pb = PACK8(S1, 1); PV_STEP(pb, 48) }
    SB();
    if (j + 1 < ntiles) {
      attn_sstore<NS>(tt_, smem + ((j + 1) & 1) * STG, rk0, rk1, rk2, rv0, rv1);
      if (j + 2 < ntiles) TILE_GLOAD(j + 2)
    }
    __syncthreads();
  }
#undef TILE_GLOAD
  const float inv = 1.f / l_run;
#pragma unroll
  for (int e4 = 0; e4 < 4; ++e4) {
    uint2 o;
    o.x = pack2(O0[4 * e4] * inv, O0[4 * e4 + 1] * inv); o.y = pack2(O0[4 * e4 + 2] * inv, O0[4 * e4 + 3] * inv);
    *(uint2*)(yrow + 8 * e4 + 4 * hh) = o;
    o.x = pack2(O1[4 * e4] * inv, O1[4 * e4 + 1] * inv); o.y = pack2(O1[4 * e4 + 2] * inv, O1[4 * e4 + 3] * inv);
    *(uint2*)(yrow + 32 + 8 * e4 + 4 * hh) = o;
  }
}

template <int MODE>
DI void scan_seg(const Params& p, int l, int seq, int blk, int d, int seg, char* smem) {
  const int t = tid(), lane = t & 63, w = t >> 6;
  const int c16 = lane & 15, g4 = lane >> 4;
  const bool is_ctx = seq < 16;
  const int b = is_ctx ? seq : seq - 16;
  const int L = is_ctx ? 256 : 4096;
  const int gbase = is_ctx ? b * 256 : T_CTX + b * 4096;
  const u16* XR = wsp<u16>(p, O_XR);
  u16* Y = wsp<u16>(p, O_YRNN);
  float* SUM = wsp<float>(p, O_SUM);
  char* sXc = smem;
  float* sA = (float*)(smem + 8704);
  float* sU = (float*)(smem + 8704 + 16384);
  const int cch = t & 127, th = t >> 7;
  const int chg = blk * 128 + cch;
  const float w0 = p.conv_w[(l * 4 + 0) * 1024 + chg], w1 = p.conv_w[(l * 4 + 1) * 1024 + chg];
  const float w2 = p.conv_w[(l * 4 + 2) * 1024 + chg], w3 = p.conv_w[(l * 4 + 3) * 1024 + chg];
  const float cb = p.conv_b[l * 1024 + chg];
  bf16x8 bw[4][4];
  {
    const u16* WL = wsw(p, l, O_WLRU) + (size_t)(d * 8 + blk) * 256 * 128 + (size_t)(32 * w + c16) * 128 + g4 * 8;
#pragma unroll
    for (int nf = 0; nf < 4; ++nf)
#pragma unroll
      for (int ks = 0; ks < 4; ++ks)
        bw[nf][ks] = *(const bf16x8*)(WL + (size_t)((nf & 1) * 16 + (nf >> 1) * 128) * 128 + ks * 32);
  }
  float ba[2], bi[2], cl[2];
#pragma unroll
  for (int jn = 0; jn < 2; ++jn) {
    const int ch = (l * 2 + d) * 1024 + blk * 128 + 32 * w + 16 * jn + c16;
    ba[jn] = p.lru_ba[ch]; bi[jn] = p.lru_bi[ch];
    cl[jn] = -8.f * log1pf(__expf(-p.lru_lam[ch]));
  }
  float h = 0.f, P = 1.f;
  if (MODE == 1 && !is_ctx && t < 128) {
    h = p.state[(((size_t)b * 4 + l) * 2 + d) * 1024 + blk * 128 + t];
    const float* sm = SUM + ((size_t)((b * 8 + blk) * 2 + d) * 16) * 256 + t;
    if (d == 0) { for (int s2 = 0; s2 < seg; ++s2) h = sm[s2 * 256] * h + sm[s2 * 256 + 128]; }
    else { for (int s2 = 15; s2 > seg; --s2) h = sm[s2 * 256] * h + sm[s2 * 256 + 128]; }
  }
#define X19(F) F(0) F(1) F(2) F(3) F(4) F(5) F(6) F(7) F(8) F(9) F(10) F(11) F(12) F(13) F(14) F(15) F(16) F(17) F(18)
#define XDECL(q) u16 xr##q = 0;
#define XLOAD(q) { const int pos = tcn + th * 16 - 1 + (q); xr##q = (pos >= 0 && pos < L) ? XR[(size_t)(gbase + pos) * 1024 + chg] : (u16)0; }
#define XCVT(q) xv[q] = bf2f(xr##q);
  X19(XDECL)
  { const int tcn = seg * 256 + (d == 0 ? 0 : 7) * 32; X19(XLOAD) }
  for (int ci = 0; ci < 8; ++ci) {
    const int tc0 = seg * 256 + (d == 0 ? ci : 7 - ci) * 32;
    {
      float xv[19];
      X19(XCVT)
#pragma unroll
      for (int q = 0; q < 16; ++q) {
        float xc = cb + w0 * xv[q] + w1 * xv[q + 1] + w2 * xv[q + 2] + w3 * xv[q + 3];
        *(u16*)(sXc + (th * 16 + q) * 272 + cch * 2) = f2bf(xc);
      }
    }
    unsigned yold0 = 0, yold1 = 0, yold2 = 0, yold3 = 0, yold4 = 0, yold5 = 0, yold6 = 0, yold7 = 0;
    {
      const int cn = ci < 7 ? ci + 1 : ci;
      const int tcn = seg * 256 + (d == 0 ? cn : 7 - cn) * 32;
      X19(XLOAD)
      if (MODE == 1 && d == 1) {
        const unsigned* yb = (const unsigned*)(Y + (size_t)(gbase + tc0 + (t >> 6)) * 1024 + blk * 128 + (t & 63) * 2);
        yold0 = yb[0]; yold1 = yb[4 * 512]; yold2 = yb[8 * 512]; yold3 = yb[12 * 512];
        yold4 = yb[16 * 512]; yold5 = yb[20 * 512]; yold6 = yb[24 * 512]; yold7 = yb[28 * 512];
      }
    }
    MB();
    __syncthreads();
    f32x4 aR[2][2], aI[2][2];
#pragma unroll
    for (int im = 0; im < 2; ++im)
#pragma unroll
      for (int jn = 0; jn < 2; ++jn) { aR[im][jn] = f32x4{0.f, 0.f, 0.f, 0.f}; aI[im][jn] = f32x4{0.f, 0.f, 0.f, 0.f}; }
#pragma unroll
    for (int ks = 0; ks < 4; ++ks)
#pragma unroll
      for (int im = 0; im < 2; ++im) {
        bf16x8 af = *(const bf16x8*)(sXc + (16 * im + c16) * 272 + (ks * 32 + g4 * 8) * 2);
#pragma unroll
        for (int jn = 0; jn < 2; ++jn) {
          aR[im][jn] = __builtin_amdgcn_mfma_f32_16x16x32_bf16(af, bw[jn][ks], aR[im][jn], 0, 0, 0);
          aI[im][jn] = __builtin_amdgcn_mfma_f32_16x16x32_bf16(af, bw[2 + jn][ks], aI[im][jn], 0, 0, 0);
        }
      }
#pragma unroll
    for (int im = 0; im < 2; ++im)
#pragma unroll
      for (int jn = 0; jn < 2; ++jn)
#pragma unroll
        for (int e = 0; e < 4; ++e) {
          const int tt = 16 * im + 4 * g4 + e, c = 32 * w + 16 * jn + c16;
          const float r = sigmoidf_(aR[im][jn][e] + ba[jn]);
          const float ig = sigmoidf_(aI[im][jn][e] + bi[jn]);
          const float a = __expf(cl[jn] * r);
          const float xc = bf2f(*(const u16*)(sXc + tt * 272 + c * 2));
          const float u = __builtin_amdgcn_sqrtf(fmaxf(1.f - a * a, 0.f)) * ig * xc;
          sA[tt * 128 + c] = a; sU[tt * 128 + c] = u;
        }
    __syncthreads();
    if (t < 128) {
      if (d == 0) {
#pragma unroll 8
        for (int s = 0; s < 32; ++s) {
          const float a = sA[s * 128 + t];
          h = a * h + sU[s * 128 + t];
          if (MODE == 0) P *= a; else sU[s * 128 + t] = h;
        }
      } else {
#pragma unroll 8
        for (int s = 31; s >= 0; --s) {
          const float a = sA[s * 128 + t];
          h = a * h + sU[s * 128 + t];
          if (MODE == 0) P *= a; else sU[s * 128 + t] = h;
        }
      }
    }
    __syncthreads();
    if (MODE == 1) {
      const int c2 = (t & 63) * 2;
      unsigned* yb = (unsigned*)(Y + (size_t)(gbase + tc0 + (t >> 6)) * 1024 + blk * 128 + c2);
      const float* su = sU + (t >> 6) * 128 + c2;
#define YOUT(i, yo) { float h0 = su[(4 * (i)) * 128], h1 = su[(4 * (i)) * 128 + 1]; \
        if (d == 1) { h0 += __uint_as_float((yo) << 16); h1 += __uint_as_float((yo) & 0xffff0000u); } \
        yb[(size_t)(4 * (i)) * 512] = pack2(h0, h1); }
      YOUT(0, yold0) YOUT(1, yold1) YOUT(2, yold2) YOUT(3, yold3) YOUT(4, yold4) YOUT(5, yold5) YOUT(6, yold6) YOUT(7, yold7)
#undef YOUT
    }
  }
#undef X19
#undef XDECL
#undef XLOAD
#undef XCVT
  if (MODE == 0) {
    if (t < 128) {
      float* sm = SUM + ((size_t)(((b * 8 + blk) * 2 + d) * 16 + seg)) * 256 + t;
      sm[0] = P; sm[128] = h;
    }
  } else if (is_ctx && t < 128) {
    p.out[OUT_RG + (((size_t)b * 4 + l) * 2 + d) * 1024 + blk * 128 + t] = h;
  }
  __syncthreads();
}

DI void phase_mix(const Params& p, int l, char* smem) {
  constexpr float LOG2E = 1.4426950408889634f;
  constexpr int N0 = 1024, N1 = N0 + 2048, N2 = N1 + 2048, N3 = N2 + 128, N4 = N3 + 256, N5 = N4 + 256;
  for (int base = 0; base < N5; base += gridDim.x) {
    const int vit = xcd_map(base);
    if (vit >= N5) continue;
    const int it = vit < N0 ? vit : (vit < N0 + 128 ? N2 + (vit - N0) : (vit < N3 ? vit - 128 : vit));
    const int t = tid(), lane = t & 63, w = t >> 6;
    const int r32 = lane & 31;
    if (it < N0 || (it >= N2 && it < N3)) {
      int seq, blk, seg;
      if (it < N0) { seg = it & 15; blk = (it >> 4) & 7; seq = 16 + (it >> 7); }
      else { const int i = it - N2; seg = 0; blk = i & 7; seq = i >> 3; }
      scan_seg<1>(p, l, seq, blk, 0, seg, smem);
      scan_seg<1>(p, l, seq, blk, 1, seg, smem);
#if PROBE == 4
      scan_seg<1>(p, l, seq, blk, 0, seg, smem);
      scan_seg<1>(p, l, seq, blk, 1, seg, smem);
#endif
    } else if (it < N1 || (it >= N3 && it < N4)) {
      const bool lat = it < N1;
      int b, h, qb;
      if (lat) { const int i = it - N0; qb = i & 31; h = (i >> 5) & 7; b = i >> 8; }
      else { const int i = it - N3; qb = i & 1; h = (i >> 1) & 7; b = i >> 4; }
      const int Lk = lat ? LK_LAT : 256;
      const int gq = (lat ? T_CTX + b * 4096 : b * 256) + qb * 128 + w * 32 + r32;
      const u16* Kn = (lat ? wsp<u16>(p, O_KNL) : wsp<u16>(p, O_KNC)) + ((size_t)b * 8 + h) * Lk * 64;
      const u16* Kr = (lat ? wsp<u16>(p, O_KRL) : wsp<u16>(p, O_KRC)) + (size_t)b * Lk * 32;
      const u16* Vt = (lat ? wsp<u16>(p, O_VTL) : wsp<u16>(p, O_VTC)) + ((size_t)b * 8 + h) * 64 * Lk;
      const u16* Q = wsp<u16>(p, O_Q) + (size_t)gq * 768;
      u16* yrow = wsp<u16>(p, O_CQ) + (size_t)gq * 512 + h * 64;
      attn_item<6>(Kn, 64, Kr, Vt, Lk, Lk >> 6, 0, 0, nullptr, 0, nullptr, 0, 0,
                   Q + h * 64, Q + 512 + h * 32, 0.10206207261596577f * LOG2E, -1e30f, 0.f, 0, yrow, smem);
#if PROBE == 5
      __syncthreads();
      attn_item<6>(Kn, 64, Kr, Vt, Lk, Lk >> 6, 0, 0, nullptr, 0, nullptr, 0, 0,
                   Q + h * 64, Q + 512 + h * 32, 0.10206207261596577f * LOG2E, -1e30f, 0.f, 0, yrow, smem);
#endif
    } else {
      const bool lat = it < N2;
      int b, h, qb;
      if (lat) { const int i = it - N1; qb = i & 31; h = (i >> 5) & 7; b = i >> 8; }
      else { const int i = it - N4; qb = i & 1; h = (i >> 1) & 7; b = i >> 4; }
      const int kvh = h >> 2;
      const int gseq = lat ? T_CTX + b * 4096 : b * 256;
      const int qpos = qb * 128 + w * 32 + r32;
      const int gq = gseq + qpos;
      u16* qrow = wsp<u16>(p, O_QS) + (size_t)gq * 512 + h * 64;
      const float sink2 = p.sink[l * 8 + h] * LOG2E;
      const int t0 = qb * 128;
      int jlo = 0, jhi = 6;
      if (t0 == 0) jlo = 2;
      if (t0 + 128 >= 4096) jhi = 4;
      const int ks0 = lat ? t0 - 128 + 64 * jlo : 0;
      const int nA = lat ? jhi - jlo : 4;
      const u16* KS = wsp<u16>(p, O_KS) + (size_t)(gseq + ks0) * 128 + kvh * 64;
      const u16* VT = lat ? wsp<u16>(p, O_VTSL) + ((size_t)b * 2 + kvh) * 64 * 4096 + ks0
                          : wsp<u16>(p, O_VTSC) + ((size_t)b * 2 + kvh) * 64 * 256;
      const u16* KC = wsp<u16>(p, O_KSC) + (size_t)b * 256 * 128 + kvh * 64;
      const u16* VC = wsp<u16>(p, O_VTSCC) + ((size_t)b * 2 + kvh) * 64 * 256;
      attn_item<4>(KS, 128, nullptr, VT, lat ? 4096 : 256, nA, ks0, lat ? 1 : 0, KC, 128, VC, 256, lat ? 4 : 0,
                   qrow, nullptr, 0.125f * LOG2E, sink2, 1.f, qpos, qrow, smem);
    }
    __syncthreads();
  }
}

DI void phase_gate(const Params& p, int l, char* smem) {
  const u16* H = wsp<u16>(p, O_H);
  const u16* W = wsw(p, l, O_WINB);
  for (int base = 0; base < 288 * 40; base += gridDim.x) {
    const int tile = xcd_map(base);
    if (tile >= 288 * 40) continue;
    const int sb = tile >> 6, jj = tile & 63;
    const int mt = (sb / 5) * 8 + (jj >> 3), nt = (sb % 5) * 8 + (jj & 7);
    const int g0 = mt * 128;
    f32x4 acc[4][4];
    zero_acc(acc);
    gemm_tile(H + (size_t)g0 * 1024, 1024, W + (size_t)nt * 128 * 1024, 1024, 1024, acc, smem);
    LANEVARS
    if (nt < 16) {
      u16* dst; int ld, cb;
      if (nt < 8) { dst = wsp<u16>(p, O_YRNN); ld = 1024; cb = nt * 128; }
      else if (nt < 12) { dst = wsp<u16>(p, O_CQ); ld = 512; cb = (nt - 8) * 128; }
      else { dst = wsp<u16>(p, O_QS); ld = 512; cb = (nt - 12) * 128; }
#pragma unroll
      for (int i = 0; i < 4; ++i)
#pragma unroll
        for (int j = 0; j < 4; ++j)
#pragma unroll
          for (int e = 0; e < 4; ++e) {
            const int g = g0 + wr * 64 + i * 16 + g4 * 4 + e;
            u16* d = dst + (size_t)g * ld + cb + wc * 64 + j * 16 + c16;
            const float gv = acc[i][j][e];
            *d = f2bf(bf2f(*d) * gv * sigmoidf_(gv));
            if (e == 3) SB();
          }
    } else {
      const int br = (nt - 16) >> 3, cb = ((nt - 16) & 7) * 128;
      u16* dst = br == 0 ? wsp<u16>(p, O_XR) : wsp<u16>(p, O_KS) + (size_t)(br - 1) * T_ALL * 1024;
#pragma unroll
      for (int i = 0; i < 4; ++i)
#pragma unroll
        for (int j = 0; j < 4; ++j)
#pragma unroll
          for (int e = 0; e < 4; ++e) {
            const int g = g0 + wr * 64 + i * 16 + g4 * 4 + e;
            dst[(size_t)g * 1024 + cb + wc * 64 + j * 16 + c16] = f2bf(sigmoidf_(acc[i][j][e]));
            if (e == 3) SB();
          }
    }
  }
}

DI void phase_merge(const Params& p, int l, char* smem) {
  u16* U = wsp<u16>(p, O_H);
  for (int base = 0; base < 288 * 8; base += gridDim.x) {
    const int tile = xcd_map(base);
    if (tile >= 288 * 8) continue;
    const int mt = tile >> 3, nt = tile & 7;
    const int g0 = mt * 128;
    f32x4 u[4][4];
    zero_acc(u);
    for (int br = 0; br < 3; ++br) {
      f32x4 acc[4][4];
      zero_acc(acc);
      const u16* Z; const u16* WT; int kz; const u16* M;
      if (br == 0) { Z = wsp<u16>(p, O_YRNN) + (size_t)g0 * 1024; WT = wsw(p, l, O_WBRR) + (size_t)nt * 128 * 1024; kz = 1024; M = wsp<u16>(p, O_XR); }
      else if (br == 1) { Z = wsp<u16>(p, O_CQ) + (size_t)g0 * 512; WT = wsw(p, l, O_WBRM) + (size_t)nt * 128 * 512; kz = 512; M = wsp<u16>(p, O_KS); }
      else { Z = wsp<u16>(p, O_QS) + (size_t)g0 * 512; WT = wsw(p, l, O_WBRS) + (size_t)nt * 128 * 512; kz = 512; M = wsp<u16>(p, O_KS) + (size_t)T_ALL * 1024; }
      gemm_tile(Z, kz, WT, kz, kz, acc, smem);
      LANEVARS
#pragma unroll
      for (int i = 0; i < 4; ++i)
#pragma unroll
        for (int j = 0; j < 4; ++j)
#pragma unroll
          for (int e = 0; e < 4; ++e) {
            const int g = g0 + wr * 64 + i * 16 + g4 * 4 + e;
            u[i][j][e] += bf2f(M[(size_t)g * 1024 + nt * 128 + wc * 64 + j * 16 + c16]) * acc[i][j][e];
            if (e == 3) SB();
          }
    }
    LANEVARS
#pragma unroll
    for (int i = 0; i < 4; ++i)
#pragma unroll
      for (int j = 0; j < 4; ++j)
#pragma unroll
        for (int e = 0; e < 4; ++e) {
          const int g = g0 + wr * 64 + i * 16 + g4 * 4 + e;
          U[(size_t)g * 1024 + nt * 128 + wc * 64 + j * 16 + c16] = f2bf(u[i][j][e]);
        }
  }
}

DI void phase_out(const Params& p, int l, char* smem) {
  const u16* U = wsp<u16>(p, O_H);
  const u16* W = wsw(p, l, O_WOUT);
  const float* MOD = wsp<float>(p, O_MOD) + (size_t)l * 9 * 3072;
  for (int base = 0; base < 288 * 8; base += gridDim.x) {
    const int tile = xcd_map(base);
    if (tile >= 288 * 8) continue;
    const int mt = tile >> 3, nt = tile & 7;
    const int g0 = mt * 128;
    const int ci = g0 < T_CTX ? 8 : ((g0 - T_CTX) >> 12);
    f32x4 acc[4][4];
    zero_acc(acc);
    gemm_tile(U + (size_t)g0 * 1024, 1024, W + (size_t)nt * 128 * 1024, 1024, 1024, acc, smem);
    LANEVARS
#pragma unroll
    for (int j = 0; j < 4; ++j) {
      const int col = nt * 128 + wc * 64 + j * 16 + c16;
      const float gt = MOD[ci * 3072 + 2048 + col];
#pragma unroll
      for (int i = 0; i < 4; ++i)
#pragma unroll
        for (int e = 0; e < 4; ++e) {
          const int g = g0 + wr * 64 + i * 16 + g4 * 4 + e;
          const float xo = xin_row(p, l, g)[col];
          p.out[(size_t)g * 1024 + col] = xo + gt * acc[i][j][e];
          if (e == 3) SB();
        }
    }
  }
}

DI void phase_final(const Params& p) {
  const int t = tid(), lane = t & 63, w = t >> 6;
  for (int row = blockIdx.x * 4 + w; row < T_ALL; row += gridDim.x * 4) {
    float* x = p.out + (size_t)row * 1024;
    float4 v[4];
    float ss = 0.f;
#pragma unroll
    for (int i = 0; i < 4; ++i) {
      v[i] = *(const float4*)(x + i * 256 + lane * 4);
      ss += v[i].x * v[i].x + v[i].y * v[i].y + v[i].z * v[i].z + v[i].w * v[i].w;
    }
    ss = wave_sum(ss);
    const float rs = rsqrtf(ss * (1.f / 1024.f) + EPS);
#pragma unroll
    for (int i = 0; i < 4; ++i) {
      const int c = i * 256 + lane * 4;
      const float4 g = *(const float4*)(p.final_norm + c);
      float4 o = {v[i].x * rs * g.x, v[i].y * rs * g.y, v[i].z * rs * g.z, v[i].w * rs * g.w};
      *(float4*)(x + c) = o;
    }
  }
}

constexpr int NPHASE_PER_LAYER = 7;
DI void run_phase(const Params& p, int ph, char* smem) {
  if (ph == 0) { phase_mod(p, smem); return; }
  if (ph == 1 + NLAYER * NPHASE_PER_LAYER) { phase_final(p); return; }
  const int l = (ph - 1) / NPHASE_PER_LAYER, s = (ph - 1) % NPHASE_PER_LAYER;
  switch (s) {
    case 0: phase_prep(p, l); break;
    case 1: phase_gemmA(p, l, smem); break;
    case 2: phase_qkv(p, l, smem); break;
    case 3: phase_mix(p, l, smem); break;
    case 4: phase_gate(p, l, smem); break;
    case 5: phase_merge(p, l, smem); break;
    default: phase_out(p, l, smem); break;
  }
}
constexpr int NPHASE = 2 + NLAYER * NPHASE_PER_LAYER;

#if MEGA
DI Params launder(const Params& p) {
  size_t z = 0;
  asm volatile("" : "+s"(z));
  Params q = p; q.ws = p.ws + z; q.out = p.out + z;
  return q;
}
struct XBar { unsigned* base; unsigned xcc; unsigned nloc; unsigned nx; };
#define XB_CENSUS(j) (64 * (j))
#define XB_XSUB(j) (1024 + 64 * (j))
#define XB_XGEN(j) (2048 + 64 * (j))
#define XB_TOP 3072
#define XB_TOPGEN 3136
DI unsigned xb_ld(unsigned* p) { return __hip_atomic_load(p, __ATOMIC_RELAXED, __HIP_MEMORY_SCOPE_AGENT); }
DI unsigned xb_add(unsigned* p, unsigned v) { return __hip_atomic_fetch_add(p, v, __ATOMIC_RELAXED, __HIP_MEMORY_SCOPE_AGENT); }
DI void xbar_post(XBar& xb, unsigned* base) {
  xb.base = base; xb.nloc = 0; xb.nx = 0;
  xb.xcc = (unsigned)__builtin_amdgcn_s_getreg((3 << 11) | 20) & 0xFu;
  if (threadIdx.x == 0) xb_add(&base[XB_CENSUS(xb.xcc)], 1u);
}
DI void xbar_census(XBar& xb) {
  unsigned nx = 0;
  for (int j = 0; j < 16; ++j) nx += xb_ld(&xb.base[XB_CENSUS(j)]) ? 1u : 0u;
  xb.nx = nx; xb.nloc = xb_ld(&xb.base[XB_CENSUS(xb.xcc)]);
}
DI void xbar_sync(const XBar& xb) {
  asm volatile("s_waitcnt vmcnt(0)" ::: "memory");
  __syncthreads();
  if (threadIdx.x == 0) {
    unsigned* bar = xb.base;
    const unsigned old = xb_add(&bar[XB_XSUB(xb.xcc)], 1u);
    const unsigned gen = old / xb.nloc;
    if (old + 1u == (gen + 1u) * xb.nloc) {
      __builtin_amdgcn_fence(__ATOMIC_RELEASE, "agent");
      asm volatile("s_waitcnt vmcnt(0)" ::: "memory");
      const unsigned og = xb_add(&bar[XB_TOP], 1u);
      const unsigned tg = og / xb.nx;
      if (og + 1u == (tg + 1u) * xb.nx) xb_add(&bar[XB_TOPGEN], 1u);
      else { unsigned sp = 0; while (xb_ld(&bar[XB_TOPGEN]) == tg) { __builtin_amdgcn_s_sleep(1); if (++sp > (1u << 22)) break; } }
      __builtin_amdgcn_fence(__ATOMIC_ACQUIRE, "agent");
      xb_add(&bar[XB_XGEN(xb.xcc)], 1u);
      asm volatile("s_waitcnt vmcnt(0)" ::: "memory");
    } else {
      unsigned sp = 0;
      while (xb_ld(&bar[XB_XGEN(xb.xcc)]) == gen) { __builtin_amdgcn_s_sleep(1); if (++sp > (1u << 22)) break; }
      __builtin_amdgcn_fence(__ATOMIC_ACQUIRE, "agent");
      asm volatile("s_waitcnt vmcnt(0)" ::: "memory");
    }
  }
  __syncthreads();
}
#define GSYNC() xbar_sync(xb)
__global__ void __launch_bounds__(256, 2) mega_kernel(Params p) {
  __shared__ __attribute__((aligned(16))) char smem[66048];
  cg::grid_group grid = cg::this_grid();
  XBar xb;
  xbar_post(xb, (unsigned*)(p.ws + O_BAR));
  phase_mod(launder(p), smem);
  convert_weights(launder(p), 0);
  grid.sync();
  xbar_census(xb);
  for (int l = 0; l < NLAYER; ++l) {
    phase_prep(launder(p), l);
    GSYNC();
#if PROBE == 1
    phase_prep(launder(p), l);
    GSYNC();
#endif
    phase_gemmA(launder(p), l, smem);
    GSYNC();
#if PROBE == 2
    phase_gemmA(launder(p), l, smem);
    GSYNC();
#endif
    phase_qkv(launder(p), l, smem);
    GSYNC();
    phase_mix(launder(p), l, smem);
    if (l + 1 < NLAYER) convert_weights(launder(p), l + 1);
    GSYNC();
    phase_gate(launder(p), l, smem);
    GSYNC();
    phase_merge(launder(p), l, smem);
    GSYNC();
#if PROBE == 3
    phase_merge(launder(p), l, smem);
    GSYNC();
#endif
    phase_out(launder(p), l, smem);
    GSYNC();
  }
  phase_final(launder(p));
}

#else
__global__ void __launch_bounds__(256, 2) phase_kernel(Params p, int ph) {
  __shared__ __attribute__((aligned(16))) char smem[66048];
  run_phase(p, ph, smem);
}

#endif
extern "C" void kernel_launch(void* const* d_in, const int* in_sizes, int n_in, void* d_out, int out_size, void* d_ws,
                              size_t ws_size, hipStream_t stream) {
  Params p{};
  const float** pp = (const float**)&p;
  for (int i = 0; i < 30; ++i) pp[i] = (const float*)d_in[i];
  p.out = (float*)d_out;
  p.ws = (char*)d_ws;
  if (ws_size < WS_NEED) fprintf(stderr, "workspace too small: %zu < %zu\n", ws_size, (size_t)WS_NEED);
#if MEGA
  static int grid_blocks = 0;
  if (!grid_blocks) {
    int dev = 0, cus = 0, per_cu = 0;
    hipGetDevice(&dev);
    hipDeviceGetAttribute(&cus, hipDeviceAttributeMultiprocessorCount, dev);
    hipOccupancyMaxActiveBlocksPerMultiprocessor(&per_cu, mega_kernel, 256, 0);
    if (per_cu > 2) per_cu = 2;
    grid_blocks = cus * per_cu;
  }
  (void)hipMemsetAsync((char*)d_ws + O_BAR, 0, BAR_BYTES, stream);
  void* args[] = {&p};
  hipError_t e = hipLaunchCooperativeKernel((void*)mega_kernel, dim3(grid_blocks), dim3(256), args, 0, stream);
  if (e != hipSuccess) fprintf(stderr, "cooperative launch failed: %s (grid %d)\n", hipGetErrorString(e), grid_blocks);
#else
  for (int ph = 0; ph < NPHASE; ++ph) phase_kernel<<<512, 256, 0, stream>>>(p, ph);
#endif
}
```

```cpp
#include <hip/hip_runtime.h>
#include <hip/hip_cooperative_groups.h>
#include <cstdio>
#include <cstdint>
namespace cg = cooperative_groups;

#ifndef PROBE
#define PROBE 0
#endif
#ifndef MEGA
#define MEGA 1
#endif

typedef unsigned short u16;
using bf16x8 = __attribute__((ext_vector_type(8))) short;
using f32x4 = __attribute__((ext_vector_type(4))) float;
using f32x16 = __attribute__((ext_vector_type(16))) float;
typedef __bf16 bf2_t __attribute__((ext_vector_type(2)));
typedef float f2_t __attribute__((ext_vector_type(2)));
#define DI __device__ __forceinline__

__device__ const float TAB_M[1024] = {
  1.00000000e+00f, 0.00000000e+00f, 1.00000000e+00f, 0.00000000e+00f, 1.00000000e+00f, 0.00000000e+00f, 1.00000000e+00f, 0.00000000e+00f,
  1.00000000e+00f, 0.00000000e+00f, 1.00000000e+00f, 0.00000000e+00f, 1.00000000e+00f, 0.00000000e+00f, 1.00000000e+00f, 0.00000000e+00f,
  5.40302277e-01f, 8.41470957e-01f, 9.50415254e-01f, 3.10983598e-01f, 9.95004177e-01f, 9.98334214e-02f, 9.99500036e-01f, 3.16175036e-02f,
  9.99949992e-01f, 9.99983307e-03f, 9.99994993e-01f, 3.16227227e-03f, 9.99999523e-01f, 9.99999931e-04f, 9.99999940e-01f, 3.16227757e-04f,
  -4.16146845e-01f, 9.09297407e-01f, 8.06578398e-01f, 5.91127098e-01f, 9.80066597e-01f, 1.98669329e-01f, 9.98000681e-01f, 6.32033944e-02f,
  9.99800026e-01f, 1.99986659e-02f, 9.99979973e-01f, 6.32451288e-03f, 9.99997973e-01f, 1.99999870e-03f, 9.99999821e-01f, 6.32455456e-04f,
  -9.89992499e-01f, 1.41120002e-01f, 5.82753658e-01f, 8.12648892e-01f, 9.55336511e-01f, 2.95520216e-01f, 9.95503366e-01f, 9.47260857e-02f,
  9.99550045e-01f, 2.99954992e-02f, 9.99954998e-01f, 9.48669016e-03f, 9.99995530e-01f, 2.99999560e-03f, 9.99999523e-01f, 9.48683126e-04f,
  -6.53643608e-01f, -7.56802499e-01f, 3.01137477e-01f, 9.53580737e-01f, 9.21060979e-01f, 3.89418334e-01f, 9.92010653e-01f, 1.26154065e-01f,
  9.99200106e-01f, 3.99893336e-02f, 9.99920011e-01f, 1.26487734e-02f, 9.99992013e-01f, 3.99998948e-03f, 9.99999225e-01f, 1.26491068e-03f,
  2.83662200e-01f, -9.58924294e-01f, -1.03423381e-02f, 9.99946535e-01f, 8.77582550e-01f, 4.79425550e-01f, 9.87526000e-01f, 1.57455876e-01f,
  9.98750269e-01f, 4.99791652e-02f, 9.99875009e-01f, 1.58107281e-02f, 9.99987483e-01f, 4.99997940e-03f, 9.99998748e-01f, 1.58113812e-03f,
  9.60170269e-01f, -2.79415488e-01f, -3.20796400e-01f, 9.47148204e-01f, 8.25335622e-01f, 5.64642489e-01f, 9.82053936e-01f, 1.88600272e-01f,
  9.98200536e-01f, 5.99640049e-02f, 9.99819994e-01f, 1.89725272e-02f, 9.99981999e-01f, 5.99996420e-03f, 9.99998212e-01f, 1.89736532e-03f,
  7.53902256e-01f, 6.56986594e-01f, -5.99437475e-01f, 8.00421596e-01f, 7.64842212e-01f, 6.44217670e-01f, 9.75599885e-01f, 2.19556093e-01f,
  9.97551024e-01f, 6.99428469e-02f, 9.99755025e-01f, 2.21341345e-02f, 9.99975502e-01f, 6.99994294e-03f, 9.99997556e-01f, 2.21359241e-03f,
  -1.45500034e-01f, 9.89358246e-01f, -8.18632424e-01f, 5.74317753e-01f, 6.96706712e-01f, 7.17356086e-01f, 9.68170285e-01f, 2.50292331e-01f,
  9.96801734e-01f, 7.99146891e-02f, 9.99680042e-01f, 2.52955221e-02f, 9.99967992e-01f, 7.99991470e-03f, 9.99996781e-01f, 2.52981926e-03f,
  -9.11130250e-01f, 4.12118495e-01f, -9.56644177e-01f, 2.91259229e-01f, 6.21609926e-01f, 7.83326924e-01f, 9.59772646e-01f, 2.80778319e-01f,
  9.95952725e-01f, 8.98785442e-02f, 9.99595046e-01f, 2.84566563e-02f, 9.99959528e-01f, 8.99987947e-03f, 9.99995947e-01f, 2.84604589e-03f,
  -8.39071512e-01f, -5.44021130e-01f, -9.99786079e-01f, -2.06835698e-02f, 5.40302277e-01f, 8.41470957e-01f, 9.50415313e-01f, 3.10983568e-01f,
  9.95004177e-01f, 9.98334140e-02f, 9.99500036e-01f, 3.16175036e-02f, 9.99949992e-01f, 9.99983400e-03f, 9.99994993e-01f, 3.16227227e-03f,
  4.42569796e-03f, -9.99990225e-01f, -9.43779767e-01f, -3.30574960e-01f, 4.53596085e-01f, 8.91207397e-01f, 9.40107584e-01f, 3.40877861e-01f,
  9.93956089e-01f, 1.09778300e-01f, 9.99395072e-01f, 3.47780399e-02f, 9.99939501e-01f, 1.09997792e-02f, 9.99993920e-01f, 3.47849843e-03f,
  8.43853951e-01f, -5.36572933e-01f, -7.94179380e-01f, -6.07683420e-01f, 3.62357706e-01f, 9.32039082e-01f, 9.28859890e-01f, 3.70431304e-01f,
  9.92808640e-01f, 1.19712204e-01f, 9.99280095e-01f, 3.79382223e-02f, 9.99927998e-01f, 1.19997123e-02f, 9.99992788e-01f, 3.79472389e-03f,
  9.07446802e-01f, 4.20167029e-01f, -5.65820515e-01f, -8.24528456e-01f, 2.67498761e-01f, 9.63558197e-01f, 9.16683376e-01f, 3.99614304e-01f,
  9.91561890e-01f, 1.29634142e-01f, 9.99155104e-01f, 4.10980321e-02f, 9.99915481e-01f, 1.29996343e-02f, 9.99991536e-01f, 4.11094911e-03f,
  1.36737213e-01f, 9.90607381e-01f, -2.81349480e-01f, -9.59605396e-01f, 1.69967160e-01f, 9.85449731e-01f, 9.03590262e-01f, 4.28397775e-01f,
  9.90216017e-01f, 1.39543116e-01f, 9.99020159e-01f, 4.42574248e-02f, 9.99902010e-01f, 1.39995432e-02f, 9.99990225e-01f, 4.42717411e-03f,
  -7.59687901e-01f, 6.50287867e-01f, 3.10223512e-02f, -9.99518692e-01f, 7.07371980e-02f, 9.97494996e-01f, 8.89593601e-01f, 4.56752867e-01f,
  9.88771081e-01f, 1.49438128e-01f, 9.98875201e-01f, 4.74163815e-02f, 9.99887526e-01f, 1.49994381e-02f, 9.99988735e-01f, 4.74339863e-03f,
  -9.57659483e-01f, -2.87903309e-01f, 3.40318173e-01f, -9.40310359e-01f, -2.91995462e-02f, 9.99573588e-01f, 8.74707460e-01f, 4.84651238e-01f,
  9.87227261e-01f, 1.59318209e-01f, 9.98720288e-01f, 5.05748577e-02f, 9.99872029e-01f, 1.59993190e-02f, 9.99987185e-01f, 5.05962269e-03f,
  -2.75163352e-01f, -9.61397469e-01f, 6.15864813e-01f, -7.87851870e-01f, -1.28844544e-01f, 9.91664827e-01f, 8.58946681e-01f, 5.12064993e-01f,
  9.85584795e-01f, 1.69182345e-01f, 9.98555362e-01f, 5.37328273e-02f, 9.99855518e-01f, 1.69991814e-02f, 9.99985576e-01f, 5.37584582e-03f,
  6.60316706e-01f, -7.50987232e-01f, 8.30336154e-01f, -5.57262897e-01f, -2.27202162e-01f, 9.73847628e-01f, 8.42327058e-01f, 5.38966715e-01f,
  9.83843684e-01f, 1.79029569e-01f, 9.98380423e-01f, 5.68902642e-02f, 9.99837995e-01f, 1.79990288e-02f, 9.99983788e-01f, 5.69206895e-03f,
  9.88704622e-01f, 1.49877205e-01f, 9.62463796e-01f, -2.71410108e-01f, -3.23289543e-01f, 9.46300089e-01f, 8.24865162e-01f, 5.65329552e-01f,
  9.82004225e-01f, 1.88858896e-01f, 9.98195529e-01f, 6.00471310e-02f, 9.99819517e-01f, 1.89988576e-02f, 9.99981940e-01f, 6.00829115e-03f,
  4.08082068e-01f, 9.12945271e-01f, 9.99144375e-01f, 4.13582884e-02f, -4.16146845e-01f, 9.09297407e-01f, 8.06578457e-01f, 5.91127038e-01f,
  9.80066597e-01f, 1.98669314e-01f, 9.98000681e-01f, 6.32033944e-02f, 9.99800026e-01f, 1.99986678e-02f, 9.99979973e-01f, 6.32451288e-03f,
  -5.47729254e-01f, 8.36655617e-01f, 9.36740458e-01f, 3.50024760e-01f, -5.04846215e-01f, 8.63209307e-01f, 7.87485182e-01f, 6.16333544e-01f,
  9.78030920e-01f, 2.08459899e-01f, 9.97795820e-01f, 6.63590282e-02f, 9.99779522e-01f, 2.09984574e-02f, 9.99977946e-01f, 6.64073415e-03f,
  -9.99960840e-01f, -8.85130931e-03f, 7.81440377e-01f, 6.23979926e-01f, -5.88501155e-01f, 8.08496356e-01f, 7.67604589e-01f, 6.40923738e-01f,
  9.75897431e-01f, 2.18229622e-01f, 9.97581005e-01f, 6.95140064e-02f, 9.99758005e-01f, 2.19982266e-02f, 9.99975801e-01f, 6.95695449e-03f,
  -5.32833040e-01f, -8.46220434e-01f, 5.48645258e-01f, 8.36055279e-01f, -6.66275978e-01f, 7.45705247e-01f, 7.46956408e-01f, 6.64873064e-01f,
  9.73666370e-01f, 2.27977514e-01f, 9.97356176e-01f, 7.26682767e-02f, 9.99735534e-01f, 2.29979735e-02f, 9.99973536e-01f, 7.27317436e-03f,
  4.24179018e-01f, -9.05578375e-01f, 2.61441678e-01f, 9.65219259e-01f, -7.37393796e-01f, 6.75463140e-01f, 7.25561321e-01f, 6.88157499e-01f,
  9.71337974e-01f, 2.37702623e-01f, 9.97121394e-01f, 7.58218244e-02f, 9.99711990e-01f, 2.39976961e-02f, 9.99971211e-01f, 7.58939330e-03f,
  9.91202831e-01f, -1.32351756e-01f, -5.16893305e-02f, 9.98663187e-01f, -8.01143587e-01f, 5.98472118e-01f, 7.03440726e-01f, 7.10753918e-01f,
  9.68912423e-01f, 2.47403964e-01f, 9.96876657e-01f, 7.89746121e-02f, 9.99687493e-01f, 2.49973964e-02f, 9.99968767e-01f, 7.90561177e-03f,
  6.46919310e-01f, 7.62558460e-01f, -3.59694332e-01f, 9.33070183e-01f, -8.56888831e-01f, 5.15501261e-01f, 6.80616796e-01f, 7.32639611e-01f,
  9.66389954e-01f, 2.57080555e-01f, 9.96621907e-01f, 8.21266174e-02f, 9.99662042e-01f, 2.59970706e-02f, 9.99966204e-01f, 8.22182931e-03f,
  -2.92138815e-01f, 9.56375957e-01f, -6.32028639e-01f, 7.74945021e-01f, -9.04072165e-01f, 4.27379847e-01f, 6.57112300e-01f, 7.53792703e-01f,
  9.63770926e-01f, 2.66731411e-01f, 9.96357203e-01f, 8.52777958e-02f, 9.99635518e-01f, 2.69967206e-02f, 9.99963522e-01f, 8.53804592e-03f,
  -9.62605894e-01f, 2.70905793e-01f, -8.41684937e-01f, 5.39968967e-01f, -9.42222297e-01f, 3.34988207e-01f, 6.32950664e-01f, 7.74192095e-01f,
  9.61055458e-01f, 2.76355654e-01f, 9.96082544e-01f, 8.84281173e-02f, 9.99608040e-01f, 2.79963426e-02f, 9.99960780e-01f, 8.85426160e-03f,
  -7.48057544e-01f, -6.63633883e-01f, -9.67871487e-01f, 2.51445323e-01f, -9.70958173e-01f, 2.39249229e-01f, 6.08156204e-01f, 7.93817401e-01f,
  9.58243906e-01f, 2.85952210e-01f, 9.95797932e-01f, 9.15775672e-02f, 9.99579549e-01f, 2.89959367e-02f, 9.99957979e-01f, 9.17047635e-03f,
  1.54251456e-01f, -9.88031626e-01f, -9.98075247e-01f, -6.20148405e-02f, -9.89992499e-01f, 1.41120002e-01f, 5.82753658e-01f, 8.12648892e-01f,
  9.55336511e-01f, 2.95520186e-01f, 9.95503366e-01f, 9.47260931e-02f, 9.99550045e-01f, 2.99955010e-02f, 9.99954998e-01f, 9.48669016e-03f,
  9.14742351e-01f, -4.04037654e-01f, -9.29300308e-01f, -3.69325012e-01f, -9.99135137e-01f, 4.15805206e-02f, 5.56768358e-01f, 8.30667794e-01f,
  9.52333570e-01f, 3.05058628e-01f, 9.95198846e-01f, 9.78736654e-02f, 9.99519527e-01f, 3.09950355e-02f, 9.99951959e-01f, 9.80290305e-03f,
  8.34223390e-01f, 5.51426709e-01f, -7.68367112e-01f, -6.40009403e-01f, -9.98294771e-01f, -5.83741926e-02f, 5.30226350e-01f, 8.47856104e-01f,
  9.49235439e-01f, 3.14566553e-01f, 9.94884372e-01f, 1.01020269e-01f, 9.99488056e-01f, 3.19945402e-02f, 9.99948800e-01f, 1.01191159e-02f,
  -1.32767474e-02f, 9.99911845e-01f, -5.31235278e-01f, -8.47224355e-01f, -9.87479806e-01f, -1.57745644e-01f, 5.03154159e-01f, 8.64196658e-01f,
  9.46042359e-01f, 3.24043006e-01f, 9.94559944e-01f, 1.04165860e-01f, 9.99455571e-01f, 3.29940096e-02f, 9.99945521e-01f, 1.04353270e-02f,
  -8.48570287e-01f, 5.29082716e-01f, -2.41421118e-01f, -9.70420420e-01f, -9.66798186e-01f, -2.55541205e-01f, 4.75578904e-01f, 8.79673064e-01f,
  9.42754686e-01f, 3.33487093e-01f, 9.94225562e-01f, 1.07310407e-01f, 9.99422073e-01f, 3.39934528e-02f, 9.99942183e-01f, 1.07515370e-02f,
  -9.03692186e-01f, -4.28182662e-01f, 7.23346695e-02f, -9.97380435e-01f, -9.36456680e-01f, -3.50783229e-01f, 4.47528064e-01f, 8.94269884e-01f,
  9.39372718e-01f, 3.42897803e-01f, 9.93881226e-01f, 1.10453881e-01f, 9.99387562e-01f, 3.49928550e-02f, 9.99938726e-01f, 1.10677453e-02f,
  -1.27963692e-01f, -9.91778851e-01f, 3.78916174e-01f, -9.25431013e-01f, -8.96758378e-01f, -4.42520559e-01f, 4.19029742e-01f, 9.07972515e-01f,
  9.35896814e-01f, 3.52274209e-01f, 9.93526995e-01f, 1.13596253e-01f, 9.99352098e-01f, 3.59922275e-02f, 9.99935210e-01f, 1.13839535e-02f,
  7.65414059e-01f, -6.43538117e-01f, 6.47921681e-01f, -7.61706948e-01f, -8.48100007e-01f, -5.29836178e-01f, 3.90112430e-01f, 9.20767248e-01f,
  9.32327330e-01f, 3.61615449e-01f, 9.93162811e-01f, 1.16737492e-01f, 9.99315560e-01f, 3.69915590e-02f, 9.99931574e-01f, 1.17001599e-02f,
  9.55073655e-01f, 2.96368569e-01f, 8.52673113e-01f, -5.22444785e-01f, -7.90967762e-01f, -6.11857831e-01f, 3.60805035e-01f, 9.32641268e-01f,
  9.28664625e-01f, 3.70920479e-01f, 9.92788672e-01f, 1.19877554e-01f, 9.99278069e-01f, 3.79908569e-02f, 9.99927819e-01f, 1.20163653e-02f,
  2.66642928e-01f, 9.63795364e-01f, 9.72865343e-01f, -2.31372014e-01f, -7.25932240e-01f, -6.87766254e-01f, 3.31136853e-01f, 9.43582714e-01f,
  9.24909055e-01f, 3.80188406e-01f, 9.92404640e-01f, 1.23016424e-01f, 9.99239624e-01f, 3.89901139e-02f, 9.99923944e-01f, 1.23325698e-02f,
  -6.66938066e-01f, 7.45113134e-01f, 9.96578991e-01f, 8.26458037e-02f, -6.53643608e-01f, -7.56802499e-01f, 3.01137596e-01f, 9.53580678e-01f,
  9.21060979e-01f, 3.89418334e-01f, 9.92010653e-01f, 1.26154065e-01f, 9.99200106e-01f, 3.99893373e-02f, 9.99920011e-01f, 1.26487734e-02f,
  -9.87339258e-01f, -1.58622667e-01f, 9.21462357e-01f, 3.88467699e-01f, -5.74824035e-01f, -8.18277061e-01f, 2.70837069e-01f, 9.62625206e-01f,
  9.17120814e-01f, 3.98609310e-01f, 9.91606772e-01f, 1.29290432e-01f, 9.99159634e-01f, 4.09885161e-02f, 9.99915957e-01f, 1.29649751e-02f,
  -3.99985313e-01f, -9.16521549e-01f, 7.54965365e-01f, 6.55764699e-01f, -4.90260571e-01f, -8.71575892e-01f, 2.40265876e-01f, 9.70707119e-01f,
  9.13088918e-01f, 4.07760441e-01f, 9.91192937e-01f, 1.32425532e-01f, 9.99118149e-01f, 4.19876575e-02f, 9.99911785e-01f, 1.32811759e-02f,
  5.55113316e-01f, -8.31774771e-01f, 5.13598442e-01f, 8.58030677e-01f, -4.00799006e-01f, -9.16166008e-01f, 2.09454417e-01f, 9.77818429e-01f,
  9.08965766e-01f, 4.16870773e-01f, 9.90769207e-01f, 1.35559291e-01f, 9.99075651e-01f, 4.29867506e-02f, 9.99907553e-01f, 1.35973748e-02f,
  9.99843299e-01f, 1.77019257e-02f, 2.21298173e-01f, 9.75206196e-01f, -3.07332784e-01f, -9.51602101e-01f, 1.78433523e-01f, 9.83951986e-01f,
  9.04751658e-01f, 4.25939471e-01f, 9.90335584e-01f, 1.38691694e-01f, 9.99032140e-01f, 4.39858064e-02f, 9.99903202e-01f, 1.39135728e-02f,
  5.25321960e-01f, 8.50903511e-01f, -9.29481089e-02f, 9.95670974e-01f, -2.10795805e-01f, -9.77530122e-01f, 1.47234216e-01f, 9.89101648e-01f,
  9.00447130e-01f, 4.34965521e-01f, 9.89892066e-01f, 1.41822711e-01f, 9.98987675e-01f, 4.49848175e-02f, 9.99898732e-01f, 1.42297689e-02f,
  -4.32177931e-01f, 9.01788354e-01f, -3.97976756e-01f, 9.17395473e-01f, -1.12152621e-01f, -9.93690968e-01f, 1.15887694e-01f, 9.93262351e-01f,
  8.96052480e-01f, 4.43948090e-01f, 9.89438653e-01f, 1.44952312e-01f, 9.98942196e-01f, 4.59837839e-02f, 9.99894202e-01f, 1.45459641e-02f,
  -9.92335498e-01f, 1.23573124e-01f, -6.63538277e-01f, 7.48142362e-01f, -1.23883775e-02f, -9.99923289e-01f, 8.44252855e-02f, 9.96429801e-01f,
  8.91568303e-01f, 4.52886283e-01f, 9.88975346e-01f, 1.48080453e-01f, 9.98895705e-01f, 4.69827019e-02f, 9.99889553e-01f, 1.48621574e-02f,
  -6.40144348e-01f, -7.68254638e-01f, -8.63296509e-01f, 5.04697084e-01f, 8.74991715e-02f, -9.96164620e-01f, 5.28784581e-02f, 9.98600960e-01f,
  8.86994898e-01f, 4.61779177e-01f, 9.88502085e-01f, 1.51207119e-01f, 9.98848200e-01f, 4.79815714e-02f, 9.99884784e-01f, 1.51783489e-02f,
  3.00592542e-01f, -9.53752637e-01f, -9.77442741e-01f, 2.11200655e-01f, 1.86512470e-01f, -9.82452571e-01f, 2.12787576e-02f, 9.99773562e-01f,
  8.82332861e-01f, 4.70625877e-01f, 9.88018990e-01f, 1.54332280e-01f, 9.98799741e-01f, 4.89803962e-02f, 9.99879956e-01f, 1.54945394e-02f,
  9.64965999e-01f, -2.62374848e-01f, -9.94656444e-01f, -1.03240460e-01f, 2.83662200e-01f, -9.58924294e-01f, -1.03422189e-02f, 9.99946535e-01f,
  8.77582550e-01f, 4.79425550e-01f, 9.87526000e-01f, 1.57455891e-01f, 9.98750269e-01f, 4.99791689e-02f, 9.99875009e-01f, 1.58107281e-02f,
  7.42154181e-01f, 6.70229197e-01f, -9.13230121e-01f, -4.07444149e-01f, 3.77977669e-01f, -9.25814748e-01f, -4.19528559e-02f, 9.99119580e-01f,
  8.72744501e-01f, 4.88177240e-01f, 9.87023175e-01f, 1.60577938e-01f, 9.98699784e-01f, 5.09778969e-02f, 9.99869943e-01f, 1.61269177e-02f,
  -1.62990779e-01f, 9.86627579e-01f, -7.41239965e-01f, -6.71240151e-01f, 4.68516916e-01f, -8.83454502e-01f, -7.35215396e-02f, 9.97293651e-01f,
  8.67819190e-01f, 4.96880114e-01f, 9.86510456e-01f, 1.63698375e-01f, 9.98648286e-01f, 5.19765690e-02f, 9.99864817e-01f, 1.64431017e-02f,
  -9.18282807e-01f, 3.95925164e-01f, -4.95741814e-01f, -8.68469954e-01f, 5.54374516e-01f, -8.32267344e-01f, -1.05016708e-01f, 9.94470477e-01f,
  8.62807095e-01f, 5.05533338e-01f, 9.85987842e-01f, 1.66817173e-01f, 9.98595834e-01f, 5.29751927e-02f, 9.99859571e-01f, 1.67592876e-02f,
  -8.29309821e-01f, -5.58789074e-01f, -2.01079622e-01f, -9.79574919e-01f, 6.34692967e-01f, -7.72764444e-01f, -1.36406869e-01f, 9.90652919e-01f,
  8.57708693e-01f, 5.14135957e-01f, 9.85455394e-01f, 1.69934288e-01f, 9.98542368e-01f, 5.39737605e-02f, 9.99854207e-01f, 1.70754679e-02f,
  2.21267566e-02f, -9.99755144e-01f, 1.13521777e-01f, -9.93535519e-01f, 7.08669782e-01f, -7.05540299e-01f, -1.67660639e-01f, 9.85844791e-01f,
  8.52524519e-01f, 5.22687256e-01f, 9.84913111e-01f, 1.73049718e-01f, 9.98487890e-01f, 5.49722798e-02f, 9.99848783e-01f, 1.73916500e-02f,
  8.53220105e-01f, -5.21551013e-01f, 4.16867077e-01f, -9.08967435e-01f, 7.75565803e-01f, -6.31266713e-01f, -1.98746875e-01f, 9.80050862e-01f,
  8.47255111e-01f, 5.31186223e-01f, 9.84360933e-01f, 1.76163420e-01f, 9.98432398e-01f, 5.59707358e-02f, 9.99843180e-01f, 1.77078284e-02f,
  8.99866819e-01f, 4.36164767e-01f, 6.78870201e-01f, -7.34258294e-01f, 8.34712923e-01f, -5.50685287e-01f, -2.29634270e-01f, 9.73276973e-01f,
  8.41901004e-01f, 5.39632022e-01f, 9.83798921e-01f, 1.79275364e-01f, 9.98375952e-01f, 5.69691435e-02f, 9.99837577e-01f, 1.80240069e-02f,
  1.19180135e-01f, 9.92872655e-01f, 8.73550534e-01f, -4.86733496e-01f, 8.85519624e-01f, -4.64602023e-01f, -2.60292053e-01f, 9.65529919e-01f,
  8.36462677e-01f, 5.48023939e-01f, 9.83227074e-01f, 1.82385504e-01f, 9.98318493e-01f, 5.79674877e-02f, 9.99831796e-01f, 1.83401816e-02f,
  -7.71080196e-01f, 6.36738002e-01f, 9.81602073e-01f, -1.90938011e-01f, 9.27478492e-01f, -3.73876572e-01f, -2.90689558e-01f, 9.56817448e-01f,
  8.30940723e-01f, 5.56361020e-01f, 9.82645452e-01f, 1.85493827e-01f, 9.98260021e-01f, 5.89657798e-02f, 9.99825954e-01f, 1.86563563e-02f,
  -9.52412963e-01f, -3.04810613e-01f, 9.92308319e-01f, 1.23790950e-01f, 9.60170269e-01f, -2.79415488e-01f, -3.20796400e-01f, 9.47148204e-01f,
  8.25335622e-01f, 5.64642429e-01f, 9.82053936e-01f, 1.88600287e-01f, 9.98200536e-01f, 5.99640086e-02f, 9.99819994e-01f, 1.89725272e-02f,
  -2.58101642e-01f, -9.66117799e-01f, 9.04607594e-01f, 4.26245421e-01f, 9.83268440e-01f, -1.82162598e-01f, -3.50582451e-01f, 9.36531842e-01f,
  8.19648027e-01f, 5.72867453e-01f, 9.81452644e-01f, 1.91704854e-01f, 9.98140097e-01f, 6.09621815e-02f, 9.99813974e-01f, 1.92886982e-02f,
  6.73507154e-01f, -7.39180684e-01f, 7.27198064e-01f, 6.86427653e-01f, 9.96542096e-01f, -8.30891207e-02f, -3.80017966e-01f, 9.24979091e-01f,
  8.13878477e-01f, 5.81035137e-01f, 9.80841517e-01f, 1.94807529e-01f, 9.98078644e-01f, 6.19602874e-02f, 9.99807835e-01f, 1.96048655e-02f,
  9.85896587e-01f, 1.67355701e-01f, 4.77671444e-01f, 8.78538549e-01f, 9.99858618e-01f, 1.68140903e-02f, -4.09073502e-01f, 9.12501454e-01f,
  8.08027506e-01f, 5.89144766e-01f, 9.80220556e-01f, 1.97908238e-01f, 9.98016179e-01f, 6.29583374e-02f, 9.99801576e-01f, 1.99210308e-02f,
};
__device__ const float TAB_S[2048] = {
  1.00000000e+00f, 0.00000000e+00f, 1.00000000e+00f, 0.00000000e+00f, 1.00000000e+00f, 0.00000000e+00f, 1.00000000e+00f, 0.00000000e+00f,
  1.00000000e+00f, 0.00000000e+00f, 1.00000000e+00f, 0.00000000e+00f, 1.00000000e+00f, 0.00000000e+00f, 1.00000000e+00f, 0.00000000e+00f,
  1.00000000e+00f, 0.00000000e+00f, 1.00000000e+00f, 0.00000000e+00f, 1.00000000e+00f, 0.00000000e+00f, 1.00000000e+00f, 0.00000000e+00f,
  1.00000000e+00f, 0.00000000e+00f, 1.00000000e+00f, 0.00000000e+00f, 1.00000000e+00f, 0.00000000e+00f, 1.00000000e+00f, 0.00000000e+00f,
  5.40302277e-01f, 8.41470957e-01f, 8.46009135e-01f, 5.33168435e-01f, 9.50415254e-01f, 3.10983598e-01f, 9.84230220e-01f, 1.76892191e-01f,
  9.95004177e-01f, 9.98334214e-02f, 9.98419285e-01f, 5.62044978e-02f, 9.99500036e-01f, 3.16175036e-02f, 9.99841869e-01f, 1.77818574e-02f,
  9.99949992e-01f, 9.99983307e-03f, 9.99984205e-01f, 5.62338345e-03f, 9.99994993e-01f, 3.16227227e-03f, 9.99998391e-01f, 1.77827850e-03f,
  9.99999523e-01f, 9.99999931e-04f, 9.99999821e-01f, 5.62341243e-04f, 9.99999940e-01f, 3.16227757e-04f, 1.00000000e+00f, 1.77827940e-04f,
  -4.16146845e-01f, 9.09297407e-01f, 4.31462824e-01f, 9.02130723e-01f, 8.06578398e-01f, 5.91127098e-01f, 9.37418282e-01f, 3.48205268e-01f,
  9.80066597e-01f, 1.98669329e-01f, 9.93682086e-01f, 1.12231314e-01f, 9.98000681e-01f, 6.32033944e-02f, 9.99367595e-01f, 3.55580896e-02f,
  9.99800026e-01f, 1.99986659e-02f, 9.99936759e-01f, 1.12465890e-02f, 9.99979973e-01f, 6.32451288e-03f, 9.99993682e-01f, 3.55655141e-03f,
  9.99997973e-01f, 1.99999870e-03f, 9.99999344e-01f, 1.12468237e-03f, 9.99999821e-01f, 6.32455456e-04f, 9.99999940e-01f, 3.55655880e-04f,
  -9.89992499e-01f, 1.41120002e-01f, -1.15966164e-01f, 9.93253171e-01f, 5.82753658e-01f, 8.12648892e-01f, 8.61040652e-01f, 5.08536100e-01f,
  9.55336511e-01f, 2.95520216e-01f, 9.85803485e-01f, 1.67903304e-01f, 9.95503366e-01f, 9.47260857e-02f, 9.98577297e-01f, 5.33230826e-02f,
  9.99550045e-01f, 2.99954992e-02f, 9.99857724e-01f, 1.68694388e-02f, 9.99954998e-01f, 9.48669016e-03f, 9.99985754e-01f, 5.33481315e-03f,
  9.99995530e-01f, 2.99999560e-03f, 9.99998569e-01f, 1.68702309e-03f, 9.99999523e-01f, 9.48683126e-04f, 9.99999881e-01f, 5.33483806e-04f,
  -6.53643608e-01f, -7.56802499e-01f, -6.27679706e-01f, 7.78471708e-01f, 3.01137477e-01f, 9.53580737e-01f, 7.57506192e-01f, 6.52827978e-01f,
  9.21060979e-01f, 3.89418334e-01f, 9.74808276e-01f, 2.23044485e-01f, 9.92010653e-01f, 1.26154065e-01f, 9.97471273e-01f, 7.10712075e-02f,
  9.99200106e-01f, 3.99893336e-02f, 9.99747038e-01f, 2.24917568e-02f, 9.99920011e-01f, 1.26487734e-02f, 9.99974728e-01f, 7.11305765e-03f,
  9.99992013e-01f, 3.99998948e-03f, 9.99997497e-01f, 2.24936334e-03f, 9.99999225e-01f, 1.26491068e-03f, 9.99999762e-01f, 7.11311703e-04f,
  2.83662200e-01f, -9.58924294e-01f, -9.46079254e-01f, 3.23935270e-01f, -1.03423381e-02f, 9.99946535e-01f, 6.30080283e-01f, 7.76529968e-01f,
  8.77582550e-01f, 4.79425550e-01f, 9.60731268e-01f, 2.77480543e-01f, 9.87526000e-01f, 1.57455876e-01f, 9.96049762e-01f, 8.87968615e-02f,
  9.98750269e-01f, 4.99791652e-02f, 9.99604762e-01f, 2.81133614e-02f, 9.99875009e-01f, 1.58107281e-02f, 9.99960482e-01f, 8.89127981e-03f,
  9.99987483e-01f, 4.99997940e-03f, 9.99996066e-01f, 2.81170290e-03f, 9.99998748e-01f, 1.58113812e-03f, 9.99999583e-01f, 8.89139599e-04f,
  9.60170269e-01f, -2.79415488e-01f, -9.73103702e-01f, -2.30367512e-01f, -3.20796400e-01f, 9.47148204e-01f, 4.82782036e-01f, 8.75740528e-01f,
  8.25335622e-01f, 5.64642489e-01f, 9.43616986e-01f, 3.31039310e-01f, 9.82053936e-01f, 1.88600272e-01f, 9.94313300e-01f, 1.06494442e-01f,
  9.98200536e-01f, 5.99640049e-02f, 9.99430835e-01f, 3.37340795e-02f, 9.99819994e-01f, 1.89725272e-02f, 9.99943078e-01f, 1.06694745e-02f,
  9.99981999e-01f, 5.99996420e-03f, 9.99994338e-01f, 3.37404152e-03f, 9.99998212e-01f, 1.89736532e-03f, 9.99999404e-01f, 1.06696738e-03f,
  7.53902256e-01f, 6.56986594e-01f, -7.00429797e-01f, -7.13721275e-01f, -5.99437475e-01f, 8.00421596e-01f, 3.20257008e-01f, 9.47330713e-01f,
  7.64842212e-01f, 6.44217670e-01f, 9.23519433e-01f, 3.83551568e-01f, 9.75599885e-01f, 2.19556093e-01f, 9.92262423e-01f, 1.24158338e-01f,
  9.97551024e-01f, 6.99428469e-02f, 9.99225318e-01f, 3.93537246e-02f, 9.99755025e-01f, 2.21341345e-02f, 9.99922514e-01f, 1.24476347e-02f,
  9.99975502e-01f, 6.99994294e-03f, 9.99992251e-01f, 3.93637875e-03f, 9.99997556e-01f, 2.21359241e-03f, 9.99999225e-01f, 1.24479528e-03f,
  -1.45500034e-01f, 9.89358246e-01f, -2.12036446e-01f, -9.77261782e-01f, -8.18632424e-01f, 5.74317753e-01f, 1.47631213e-01f, 9.89042461e-01f,
  6.96706712e-01f, 7.17356086e-01f, 9.00502324e-01f, 4.34851229e-01f, 9.68170285e-01f, 2.50292331e-01f, 9.89897788e-01f, 1.41782969e-01f,
  9.96801734e-01f, 7.99146891e-02f, 9.98988271e-01f, 4.49721329e-02f, 9.99680042e-01f, 2.52955221e-02f, 9.99898791e-01f, 1.42257558e-02f,
  9.99967992e-01f, 7.99991470e-03f, 9.99989867e-01f, 4.49871505e-03f, 9.99996781e-01f, 2.52981926e-03f, 9.99998987e-01f, 1.42262306e-03f,
  -9.11130250e-01f, 4.12118495e-01f, 3.41660261e-01f, -9.39823508e-01f, -9.56644177e-01f, 2.91259229e-01f, -2.96507962e-02f, 9.99560297e-01f,
  6.21609926e-01f, 7.83326924e-01f, 8.74638259e-01f, 4.84776139e-01f, 9.59772646e-01f, 2.80778319e-01f, 9.87220109e-01f, 1.59362778e-01f,
  9.95952725e-01f, 8.98785442e-02f, 9.98719573e-01f, 5.05891182e-02f, 9.99595046e-01f, 2.84566563e-02f, 9.99871910e-01f, 1.60038304e-02f,
  9.99959528e-01f, 8.99987947e-03f, 9.99987185e-01f, 5.06105041e-03f, 9.99995947e-01f, 2.84604589e-03f, 9.99998748e-01f, 1.60045072e-03f,
  -8.39071512e-01f, -5.44021130e-01f, 7.90131867e-01f, -6.12936914e-01f, -9.99786079e-01f, -2.06835698e-02f, -2.05997631e-01f, 9.78552461e-01f,
  5.40302277e-01f, 8.41470957e-01f, 8.46009135e-01f, 5.33168435e-01f, 9.50415313e-01f, 3.10983568e-01f, 9.84230220e-01f, 1.76892191e-01f,
  9.95004177e-01f, 9.98334140e-02f, 9.98419285e-01f, 5.62044978e-02f, 9.99500036e-01f, 3.16175036e-02f, 9.99841869e-01f, 1.77818574e-02f,
  9.99949992e-01f, 9.99983400e-03f, 9.99984205e-01f, 5.62338345e-03f, 9.99994993e-01f, 3.16227227e-03f, 9.99998391e-01f, 1.77827850e-03f,
  4.42569796e-03f, -9.99990225e-01f, 9.95257378e-01f, -9.72764567e-02f, -9.43779767e-01f, -3.30574960e-01f, -3.75847399e-01f, 9.26681578e-01f,
  4.53596085e-01f, 8.91207397e-01f, 8.14705312e-01f, 5.79875171e-01f, 9.40107584e-01f, 3.40877861e-01f, 9.80929136e-01f, 1.94365650e-01f,
  9.93956089e-01f, 1.09778300e-01f, 9.98087406e-01f, 6.18181042e-02f, 9.99395072e-01f, 3.47780399e-02f, 9.99808669e-01f, 1.95598267e-02f,
  9.99939501e-01f, 1.09997792e-02f, 9.99980867e-01f, 6.18571462e-03f, 9.99993920e-01f, 3.47849843e-03f, 9.99998093e-01f, 1.95610616e-03f,
  8.43853951e-01f, -5.36572933e-01f, 8.93861592e-01f, 4.48342979e-01f, -7.94179380e-01f, -6.07683420e-01f, -5.33843040e-01f, 8.45583618e-01f,
  3.62357706e-01f, 9.32039082e-01f, 7.80825913e-01f, 6.24748647e-01f, 9.28859890e-01f, 3.70431304e-01f, 9.77317870e-01f, 2.11777672e-01f,
  9.92808640e-01f, 1.19712204e-01f, 9.97723997e-01f, 6.74297586e-02f, 9.99280095e-01f, 3.79382223e-02f, 9.99772310e-01f, 2.13377345e-02f,
  9.99927998e-01f, 1.19997123e-02f, 9.99977231e-01f, 6.74804440e-03f, 9.99992788e-01f, 3.79472389e-03f, 9.99997735e-01f, 2.13393359e-03f,
  9.07446802e-01f, 4.20167029e-01f, 5.17172873e-01f, 8.55880976e-01f, -5.65820515e-01f, -8.24528456e-01f, -6.75001681e-01f, 7.37816215e-01f,
  2.67498761e-01f, 9.63558197e-01f, 7.44477987e-01f, 6.67647004e-01f, 9.16683376e-01f, 3.99614304e-01f, 9.73397553e-01f, 2.29122713e-01f,
  9.91561890e-01f, 1.29634142e-01f, 9.97329056e-01f, 7.30392784e-02f, 9.99155104e-01f, 4.10980321e-02f, 9.99732792e-01f, 2.31155735e-02f,
  9.99915481e-01f, 1.29996343e-02f, 9.99973297e-01f, 7.31037185e-03f, 9.99991536e-01f, 4.11094911e-03f, 9.99997318e-01f, 2.31176103e-03f,
  1.36737213e-01f, 9.90607381e-01f, -1.87961515e-02f, 9.99823332e-01f, -2.81349480e-01f, -9.59605396e-01f, -7.94870913e-01f, 6.06778562e-01f,
  1.69967160e-01f, 9.85449731e-01f, 7.05776393e-01f, 7.08434701e-01f, 9.03590262e-01f, 4.28397775e-01f, 9.69169438e-01f, 2.46395305e-01f,
  9.90216017e-01f, 1.39543116e-01f, 9.96902585e-01f, 7.86464810e-02f, 9.99020159e-01f, 4.42574248e-02f, 9.99690115e-01f, 2.48933397e-02f,
  9.99902010e-01f, 1.39995432e-02f, 9.99969006e-01f, 7.87269697e-03f, 9.99990225e-01f, 4.42717411e-03f, 9.99996901e-01f, 2.48958869e-03f,
  -7.59687901e-01f, 6.50287867e-01f, -5.48975468e-01f, 8.35838437e-01f, 3.10223512e-02f, -9.99518692e-01f, -8.89670432e-01f, 4.56603259e-01f,
  7.07371980e-02f, 9.97494996e-01f, 6.64843500e-01f, 7.46982634e-01f, 8.89593601e-01f, 4.56752867e-01f, 9.64634836e-01f, 2.63589978e-01f,
  9.88771081e-01f, 1.49438128e-01f, 9.96444523e-01f, 8.42512026e-02f, 9.98875201e-01f, 4.74163815e-02f, 9.99644279e-01f, 2.66710296e-02f,
  9.99887526e-01f, 1.49994381e-02f, 9.99964416e-01f, 8.43502022e-03f, 9.99988735e-01f, 4.74339863e-03f, 9.99996424e-01f, 2.66741589e-03f,
  -9.57659483e-01f, -2.87903309e-01f, -9.10081089e-01f, 4.14430231e-01f, 3.40318173e-01f, -9.40310359e-01f, -9.56410050e-01f, 2.92027086e-01f,
  -2.91995462e-02f, 9.99573588e-01f, 6.21808827e-01f, 7.83169091e-01f, 8.74707460e-01f, 4.84651238e-01f, 9.59795177e-01f, 2.80701309e-01f,
  9.87227261e-01f, 1.59318209e-01f, 9.95954990e-01f, 8.98532644e-02f, 9.98720288e-01f, 5.05748577e-02f, 9.99595284e-01f, 2.84486320e-02f,
  9.99872029e-01f, 1.59993190e-02f, 9.99959528e-01f, 8.99733976e-03f, 9.99987185e-01f, 5.05962269e-03f, 9.99995947e-01f, 2.84524332e-03f,
  -2.75163352e-01f, -9.61397469e-01f, -9.90897954e-01f, -1.34615138e-01f, 6.15864813e-01f, -7.87851870e-01f, -9.92985010e-01f, 1.18240520e-01f,
  -1.28844544e-01f, 9.91664827e-01f, 5.76808274e-01f, 8.16879570e-01f, 8.58946681e-01f, 5.12064993e-01f, 9.54652011e-01f, 2.97723860e-01f,
  9.85584795e-01f, 1.69182345e-01f, 9.95433986e-01f, 9.54524800e-02f, 9.98555362e-01f, 5.37328273e-02f, 9.99543071e-01f, 3.02261449e-02f,
  9.99855518e-01f, 1.69991814e-02f, 9.99954283e-01f, 9.55965649e-03f, 9.99985576e-01f, 5.37584582e-03f, 9.99995410e-01f, 3.02307028e-03f,
  6.60316706e-01f, -7.50987232e-01f, -7.66536534e-01f, -6.42200708e-01f, 8.30336154e-01f, -5.57262897e-01f, -9.98241663e-01f, -5.92755191e-02f,
  -2.27202162e-01f, 9.73847628e-01f, 5.29984176e-01f, 8.48007560e-01f, 8.42327058e-01f, 5.38966715e-01f, 9.49207008e-01f, 3.14652264e-01f,
  9.83843684e-01f, 1.79029569e-01f, 9.94881511e-01f, 1.01048686e-01f, 9.98380423e-01f, 5.68902642e-02f, 9.99487758e-01f, 3.20035629e-02f,
  9.99837995e-01f, 1.79990288e-02f, 9.99948800e-01f, 1.01219704e-02f, 9.99983788e-01f, 5.69206895e-03f, 9.99994874e-01f, 3.20089748e-03f,
  9.88704622e-01f, 1.49877205e-01f, -3.06095392e-01f, -9.52000856e-01f, 9.62463796e-01f, -2.71410108e-01f, -9.72014248e-01f, -2.34921798e-01f,
  -3.23289543e-01f, 9.46300089e-01f, 4.81484592e-01f, 8.76454532e-01f, 8.24865162e-01f, 5.65329552e-01f, 9.43461835e-01f, 3.31481189e-01f,
  9.82004225e-01f, 1.88858896e-01f, 9.94297504e-01f, 1.06641680e-01f, 9.98195529e-01f, 6.00471310e-02f, 9.99429286e-01f, 3.37808803e-02f,
  9.99819517e-01f, 1.89988576e-02f, 9.99942899e-01f, 1.06842816e-02f, 9.99981940e-01f, 6.00829115e-03f, 9.99994278e-01f, 3.37872445e-03f,
  4.08082068e-01f, 9.12945271e-01f, 2.48616725e-01f, -9.68601942e-01f, 9.99144375e-01f, 4.13582884e-02f, -9.15129960e-01f, -4.03158993e-01f,
  -4.16146845e-01f, 9.09297407e-01f, 4.31462824e-01f, 9.02130723e-01f, 8.06578457e-01f, 5.91127038e-01f, 9.37418282e-01f, 3.48205268e-01f,
  9.80066597e-01f, 1.98669314e-01f, 9.93682086e-01f, 1.12231314e-01f, 9.98000681e-01f, 6.32033944e-02f, 9.99367595e-01f, 3.55580896e-02f,
  9.99800026e-01f, 1.99986678e-02f, 9.99936759e-01f, 1.12465890e-02f, 9.99979973e-01f, 6.32451288e-03f, 9.99993682e-01f, 3.55655141e-03f,
  -5.47729254e-01f, 8.36655617e-01f, 7.26760268e-01f, -6.86891198e-01f, 9.36740458e-01f, 3.50024760e-01f, -8.29382956e-01f, -5.58680534e-01f,
  -5.04846215e-01f, 8.63209307e-01f, 3.80077004e-01f, 9.24954832e-01f, 7.87485182e-01f, 6.16333544e-01f, 9.31078374e-01f, 3.64819258e-01f,
  9.78030920e-01f, 2.08459899e-01f, 9.93035257e-01f, 1.17817394e-01f, 9.97795820e-01f, 6.63590282e-02f, 9.99302804e-01f, 3.73351872e-02f,
  9.99779522e-01f, 2.09984574e-02f, 9.99930263e-01f, 1.18088927e-02f, 9.99977946e-01f, 6.64073415e-03f, 9.99993026e-01f, 3.73437814e-03f,
  -9.99960840e-01f, -8.85130931e-03f, 9.81074572e-01f, -1.93630233e-01f, 7.81440377e-01f, 6.23979926e-01f, -7.17477441e-01f, -6.96581721e-01f,
  -5.88501155e-01f, 8.08496356e-01f, 3.27489585e-01f, 9.44854796e-01f, 7.67604589e-01f, 6.40923738e-01f, 9.24443960e-01f, 3.81317884e-01f,
  9.75897431e-01f, 2.18229622e-01f, 9.92357016e-01f, 1.23399742e-01f, 9.97581005e-01f, 6.95140064e-02f, 9.99234855e-01f, 3.91121693e-02f,
  9.99758005e-01f, 2.19982266e-02f, 9.99923468e-01f, 1.23711927e-02f, 9.99975801e-01f, 6.95695449e-03f, 9.99992371e-01f, 3.91220488e-03f,
  -5.32833040e-01f, -8.46220434e-01f, 9.33235765e-01f, 3.59264523e-01f, 5.48645258e-01f, 8.36055279e-01f, -5.82943261e-01f, -8.12512875e-01f,
  -6.66275978e-01f, 7.45705247e-01f, 2.73866832e-01f, 9.61767614e-01f, 7.46956408e-01f, 6.64873064e-01f, 9.17517304e-01f, 3.97695929e-01f,
  9.73666370e-01f, 2.27977514e-01f, 9.91647422e-01f, 1.28978193e-01f, 9.97356176e-01f, 7.26682767e-02f, 9.99163687e-01f, 4.08890247e-02f,
  9.99735534e-01f, 2.29979735e-02f, 9.99916375e-01f, 1.29334899e-02f, 9.99973536e-01f, 7.27317436e-03f, 9.99991655e-01f, 4.09003161e-03f,
  4.24179018e-01f, -9.05578375e-01f, 5.97977161e-01f, 8.01513135e-01f, 2.61441678e-01f, 9.65219259e-01f, -4.30023283e-01f, -9.02817786e-01f,
  -7.37393796e-01f, 6.75463140e-01f, 2.19378278e-01f, 9.75639880e-01f, 7.25561321e-01f, 6.88157499e-01f, 9.10300434e-01f, 4.13948208e-01f,
  9.71337974e-01f, 2.37702623e-01f, 9.90906477e-01f, 1.34552568e-01f, 9.97121394e-01f, 7.58218244e-02f, 9.99089420e-01f, 4.26657498e-02f,
  9.99711990e-01f, 2.39976961e-02f, 9.99908924e-01f, 1.34957815e-02f, 9.99971211e-01f, 7.58939330e-03f, 9.99990880e-01f, 4.26785741e-03f,
  9.91202831e-01f, -1.32351756e-01f, 7.85522610e-02f, 9.96909976e-01f, -5.16893305e-02f, 9.98663187e-01f, -2.63540596e-01f, -9.64648306e-01f,
  -8.01143587e-01f, 5.98472118e-01f, 1.64196163e-01f, 9.86427724e-01f, 7.03440726e-01f, 7.10753918e-01f, 9.02795732e-01f, 4.30069596e-01f,
  9.68912423e-01f, 2.47403964e-01f, 9.90134120e-01f, 1.40122697e-01f, 9.96876657e-01f, 7.89746121e-02f, 9.99011934e-01f, 4.44423407e-02f,
  9.99687493e-01f, 2.49973964e-02f, 9.99901175e-01f, 1.40580693e-02f, 9.99968767e-01f, 7.90561177e-03f, 9.99990106e-01f, 4.44568414e-03f,
  6.46919310e-01f, 7.62558460e-01f, -4.65064496e-01f, 8.85276794e-01f, -3.59694332e-01f, 9.33070183e-01f, -8.87455046e-02f, -9.96054351e-01f,
  -8.56888831e-01f, 5.15501261e-01f, 1.08494945e-01f, 9.94096994e-01f, 6.80616796e-01f, 7.32639611e-01f, 8.95005584e-01f, 4.46054995e-01f,
  9.66389954e-01f, 2.57080555e-01f, 9.89330530e-01f, 1.45688385e-01f, 9.96621907e-01f, 8.21266174e-02f, 9.98931348e-01f, 4.62187938e-02f,
  9.99662042e-01f, 2.59970706e-02f, 9.99893129e-01f, 1.46203535e-02f, 9.99966204e-01f, 8.22182931e-03f, 9.99989331e-01f, 4.62350994e-03f,
  -2.92138815e-01f, 9.56375957e-01f, -8.65450621e-01f, 5.00994205e-01f, -6.32028639e-01f, 7.74945021e-01f, 8.88481140e-02f, -9.96045172e-01f,
  -9.04072165e-01f, 4.27379847e-01f, 5.24506159e-02f, 9.98623490e-01f, 6.57112300e-01f, 7.53792703e-01f, 8.86932373e-01f, 4.61899310e-01f,
  9.63770926e-01f, 2.66731411e-01f, 9.88495648e-01f, 1.51249468e-01f, 9.96357203e-01f, 8.52777958e-02f, 9.98847544e-01f, 4.79951017e-02f,
  9.99635518e-01f, 2.69967206e-02f, 9.99884725e-01f, 1.51826320e-02f, 9.99963522e-01f, 8.53804592e-03f, 9.99988496e-01f, 4.80133574e-03f,
  -9.62605894e-01f, 2.70905793e-01f, -9.99293387e-01f, -3.75856608e-02f, -8.41684937e-01f, 5.39968967e-01f, 2.63639510e-01f, -9.64621305e-01f,
  -9.42222297e-01f, 3.34988207e-01f, -3.75941908e-03f, 9.99992907e-01f, 6.32950664e-01f, 7.74192095e-01f, 8.78578722e-01f, 4.77597594e-01f,
  9.61055458e-01f, 2.76355654e-01f, 9.87629473e-01f, 1.56805754e-01f, 9.96082544e-01f, 8.84281173e-02f, 9.98760641e-01f, 4.97712530e-02f,
  9.99608040e-01f, 2.79963426e-02f, 9.99876022e-01f, 1.57449059e-02f, 9.99960780e-01f, 8.85426160e-03f, 9.99987602e-01f, 4.97916201e-03f,
  -7.48057544e-01f, -6.63633883e-01f, -8.25371623e-01f, -5.64589798e-01f, -9.67871487e-01f, 2.51445323e-01f, 4.30115849e-01f, -9.02773678e-01f,
  -9.70958173e-01f, 2.39249229e-01f, -5.99575676e-02f, 9.98200953e-01f, 6.08156204e-01f, 7.93817401e-01f, 8.69947195e-01f, 4.93144840e-01f,
  9.58243906e-01f, 2.85952210e-01f, 9.86732066e-01f, 1.62357092e-01f, 9.95797932e-01f, 9.15775672e-02f, 9.98670578e-01f, 5.15472479e-02f,
  9.99579549e-01f, 2.89959367e-02f, 9.99867022e-01f, 1.63071752e-02f, 9.99957979e-01f, 9.17047635e-03f, 9.99986708e-01f, 5.15698735e-03f,
  1.54251456e-01f, -9.88031626e-01f, -3.97251874e-01f, -9.17709649e-01f, -9.98075247e-01f, -6.20148405e-02f, 5.83026946e-01f, -8.12452853e-01f,
  -9.89992499e-01f, 1.41120002e-01f, -1.15966164e-01f, 9.93253171e-01f, 5.82753658e-01f, 8.12648892e-01f, 8.61040652e-01f, 5.08536100e-01f,
  9.55336511e-01f, 2.95520186e-01f, 9.85803485e-01f, 1.67903304e-01f, 9.95503366e-01f, 9.47260931e-02f, 9.98577297e-01f, 5.33230826e-02f,
  9.99550045e-01f, 2.99955010e-02f, 9.99857724e-01f, 1.68694388e-02f, 9.99954998e-01f, 9.48669016e-03f, 9.99985754e-01f, 5.33481315e-03f,
  9.14742351e-01f, -4.04037654e-01f, 1.53215483e-01f, -9.88192797e-01f, -9.29300308e-01f, -3.69325012e-01f, 7.17549205e-01f, -6.96507812e-01f,
  -9.99135137e-01f, 4.15805206e-02f, -1.71608135e-01f, 9.85165298e-01f, 5.56768358e-01f, 8.30667794e-01f, 8.51861775e-01f, 5.23766637e-01f,
  9.52333570e-01f, 3.05058628e-01f, 9.84843671e-01f, 1.73444211e-01f, 9.95198846e-01f, 9.78736654e-02f, 9.98480916e-01f, 5.50987460e-02f,
  9.99519527e-01f, 3.09950355e-02f, 9.99848068e-01f, 1.74316969e-02f, 9.99951959e-01f, 9.80290305e-03f, 9.99984801e-01f, 5.51263802e-03f,
  8.34223390e-01f, 5.51426709e-01f, 6.56495154e-01f, -7.54330218e-01f, -7.68367112e-01f, -6.40009403e-01f, 8.29440355e-01f, -5.58595300e-01f,
  -9.98294771e-01f, -5.83741926e-02f, -2.26707578e-01f, 9.73962843e-01f, 5.30226350e-01f, 8.47856104e-01f, 8.42413545e-01f, 5.38831532e-01f,
  9.49235439e-01f, 3.14566553e-01f, 9.83852804e-01f, 1.78979620e-01f, 9.94884372e-01f, 1.01020269e-01f, 9.98381376e-01f, 5.68742342e-02f,
  9.99488056e-01f, 3.19945402e-02f, 9.99838114e-01f, 1.79939512e-02f, 9.99948800e-01f, 1.01191159e-02f, 9.99983788e-01f, 5.69046335e-03f,
  -1.32767474e-02f, 9.99911845e-01f, 9.57586050e-01f, -2.88147390e-01f, -5.31235278e-01f, -8.47224355e-01f, 9.15171385e-01f, -4.03064936e-01f,
  -9.87479806e-01f, -1.57745644e-01f, -2.81090319e-01f, 9.59681332e-01f, 5.03154159e-01f, 8.64196658e-01f, 8.32698941e-01f, 5.53726017e-01f,
  9.46042359e-01f, 3.24043006e-01f, 9.82830763e-01f, 1.84509367e-01f, 9.94559944e-01f, 1.04165860e-01f, 9.98278618e-01f, 5.86495437e-02f,
  9.99455571e-01f, 3.29940096e-02f, 9.99827802e-01f, 1.85561981e-02f, 9.99945521e-01f, 1.04353270e-02f, 9.99982774e-01f, 5.86828869e-03f,
  -8.48570287e-01f, 5.29082716e-01f, 9.63757515e-01f, 2.66779721e-01f, -2.41421118e-01f, -9.70420420e-01f, 9.72038329e-01f, -2.34822124e-01f,
  -9.66798186e-01f, -2.55541205e-01f, -3.34584385e-01f, 9.42365825e-01f, 4.75578904e-01f, 8.79673064e-01f, 8.22721004e-01f, 5.68445385e-01f,
  9.42754686e-01f, 3.33487093e-01f, 9.81777668e-01f, 1.90033287e-01f, 9.94225562e-01f, 1.07310407e-01f, 9.98172760e-01f, 6.04246669e-02f,
  9.99422073e-01f, 3.39934528e-02f, 9.99817252e-01f, 1.91184394e-02f, 9.99942183e-01f, 1.07515370e-02f, 9.99981701e-01f, 6.04611309e-03f,
  -9.03692186e-01f, -4.28182662e-01f, 6.73110247e-01f, 7.39542127e-01f, 7.23346695e-02f, -9.97380435e-01f, 9.98247743e-01f, -5.91726787e-02f,
  -9.36456680e-01f, -3.50783229e-01f, -3.87020677e-01f, 9.22071040e-01f, 4.47528064e-01f, 8.94269884e-01f, 8.12482953e-01f, 5.82984984e-01f,
  9.39372718e-01f, 3.42897803e-01f, 9.80693519e-01f, 1.95551202e-01f, 9.93881226e-01f, 1.10453881e-01f, 9.98063743e-01f, 6.21996038e-02f,
  9.99387562e-01f, 3.49928550e-02f, 9.99806345e-01f, 1.96806751e-02f, 9.99938726e-01f, 1.10677453e-02f, 9.99980628e-01f, 6.22393796e-03f,
  -1.27963692e-01f, -9.91778851e-01f, 1.75156534e-01f, 9.84540582e-01f, 3.78916174e-01f, -9.25431013e-01f, 9.92972851e-01f, 1.18342586e-01f,
  -8.96758378e-01f, -4.42520559e-01f, -4.38233554e-01f, 8.98861170e-01f, 4.19029742e-01f, 9.07972515e-01f, 8.01987886e-01f, 5.97340286e-01f,
  9.35896814e-01f, 3.52274209e-01f, 9.79578316e-01f, 2.01062918e-01f, 9.93526995e-01f, 1.13596253e-01f, 9.97951567e-01f, 6.39743358e-02f,
  9.99352098e-01f, 3.59922275e-02f, 9.99795079e-01f, 2.02429052e-02f, 9.99935210e-01f, 1.13839535e-02f, 9.99979496e-01f, 6.40176190e-03f,
  7.65414059e-01f, -6.43538117e-01f, -3.76742303e-01f, 9.26318109e-01f, 6.47921681e-01f, -7.61706948e-01f, 9.56380010e-01f, 2.92125374e-01f,
  -8.48100007e-01f, -5.29836178e-01f, -4.88060862e-01f, 8.72809589e-01f, 3.90112430e-01f, 9.20767248e-01f, 7.91239262e-01f, 6.11506701e-01f,
  9.32327330e-01f, 3.61615449e-01f, 9.78432178e-01f, 2.06568271e-01f, 9.93162811e-01f, 1.16737492e-01f, 9.97836173e-01f, 6.57488778e-02f,
  9.99315560e-01f, 3.69915590e-02f, 9.99783576e-01f, 2.08051261e-02f, 9.99931574e-01f, 1.17001599e-02f, 9.99978364e-01f, 6.57958630e-03f,
  9.55073655e-01f, 2.96368569e-01f, -8.12611222e-01f, 5.82806170e-01f, 8.52673113e-01f, -5.22444785e-01f, 8.89623463e-01f, 4.56694692e-01f,
  -7.90967762e-01f, -6.11857831e-01f, -5.36345184e-01f, 8.43998730e-01f, 3.60805035e-01f, 9.32641268e-01f, 7.80240417e-01f, 6.25479698e-01f,
  9.28664625e-01f, 3.70920479e-01f, 9.77255106e-01f, 2.12067112e-01f, 9.92788672e-01f, 1.19877554e-01f, 9.97717679e-01f, 6.75232038e-02f,
  9.99278069e-01f, 3.79908569e-02f, 9.99771714e-01f, 2.13673431e-02f, 9.99927819e-01f, 1.20163653e-02f, 9.99977171e-01f, 6.75741071e-03f,
  2.66642928e-01f, 9.63795364e-01f, -9.98210371e-01f, 5.98003156e-02f, 9.72865343e-01f, -2.31372014e-01f, 7.94808388e-01f, 6.06860459e-01f,
  -7.25932240e-01f, -6.87766254e-01f, -5.82933903e-01f, 8.12519610e-01f, 3.31136853e-01f, 9.43582714e-01f, 7.68994927e-01f, 6.39254928e-01f,
  9.24909055e-01f, 3.80188406e-01f, 9.76047099e-01f, 2.17559248e-01f, 9.92404640e-01f, 1.23016424e-01f, 9.97596025e-01f, 6.92973137e-02f,
  9.99239624e-01f, 3.89901139e-02f, 9.99759495e-01f, 2.19295528e-02f, 9.99923944e-01f, 1.23325698e-02f, 9.99975979e-01f, 6.93523418e-03f,
  -6.66938066e-01f, 7.45113134e-01f, -8.76379430e-01f, -4.81621295e-01f, 9.96578991e-01f, 8.26458037e-02f, 6.74925625e-01f, 7.37885714e-01f,
  -6.53643608e-01f, -7.56802499e-01f, -6.27679706e-01f, 7.78471708e-01f, 3.01137596e-01f, 9.53580678e-01f, 7.57506192e-01f, 6.52827978e-01f,
  9.21060979e-01f, 3.89418334e-01f, 9.74808276e-01f, 2.23044485e-01f, 9.92010653e-01f, 1.26154065e-01f, 9.97471273e-01f, 7.10712075e-02f,
  9.99200106e-01f, 3.99893373e-02f, 9.99747038e-01f, 2.24917568e-02f, 9.99920011e-01f, 1.26487734e-02f, 9.99974728e-01f, 7.11305765e-03f,
  -9.87339258e-01f, -1.58622667e-01f, -4.84639406e-01f, -8.74714017e-01f, 9.21462357e-01f, 3.88467699e-01f, 5.33756077e-01f, 8.45638454e-01f,
  -5.74824035e-01f, -8.18277061e-01f, -6.70441091e-01f, 7.41962790e-01f, 2.70837069e-01f, 9.62625206e-01f, 7.45777905e-01f, 6.66194677e-01f,
  9.17120814e-01f, 3.98609310e-01f, 9.73538578e-01f, 2.28522688e-01f, 9.91606772e-01f, 1.29290432e-01f, 9.97343302e-01f, 7.28448778e-02f,
  9.99159634e-01f, 4.09885161e-02f, 9.99734223e-01f, 2.30539497e-02f, 9.99915957e-01f, 1.29649751e-02f, 9.99973416e-01f, 7.29088066e-03f,
  -3.99985313e-01f, -9.16521549e-01f, 5.63609414e-02f, -9.98410463e-01f, 7.54965365e-01f, 6.55764699e-01f, 3.75752151e-01f, 9.26720202e-01f,
  -4.90260571e-01f, -8.71575892e-01f, -7.11082935e-01f, 7.03108132e-01f, 2.40265876e-01f, 9.70707119e-01f, 7.33813822e-01f, 6.79350674e-01f,
  9.13088918e-01f, 4.07760441e-01f, 9.72238123e-01f, 2.33993664e-01f, 9.91192937e-01f, 1.32425532e-01f, 9.97212172e-01f, 7.46183172e-02f,
  9.99118149e-01f, 4.19876575e-02f, 9.99721110e-01f, 2.36161388e-02f, 9.99911785e-01f, 1.32811759e-02f, 9.99972105e-01f, 7.46870413e-03f,
  5.55113316e-01f, -8.31774771e-01f, 5.80003142e-01f, -8.14614236e-01f, 5.13598442e-01f, 8.58030677e-01f, 2.05897167e-01f, 9.78573620e-01f,
  -4.00799006e-01f, -9.16166008e-01f, -7.49476731e-01f, 6.62030637e-01f, 2.09454417e-01f, 9.77818429e-01f, 7.21617639e-01f, 6.92291796e-01f,
  9.08965766e-01f, 4.16870773e-01f, 9.70906913e-01f, 2.39457220e-01f, 9.90769207e-01f, 1.35559291e-01f, 9.97077882e-01f, 7.63915181e-02f,
  9.99075651e-01f, 4.29867506e-02f, 9.99707639e-01f, 2.41783205e-02f, 9.99907553e-01f, 1.35973748e-02f, 9.99970794e-01f, 7.64652714e-03f,
  9.99843299e-01f, 1.77019257e-02f, 9.25014675e-01f, -3.79931390e-01f, 2.21298173e-01f, 9.75206196e-01f, 2.95478199e-02f, 9.99563396e-01f,
  -3.07332784e-01f, -9.51602101e-01f, -7.85501122e-01f, 6.18860185e-01f, 1.78433523e-01f, 9.83951986e-01f, 7.09193349e-01f, 7.05014050e-01f,
  9.04751658e-01f, 4.25939471e-01f, 9.69545007e-01f, 2.44913206e-01f, 9.90335584e-01f, 1.38691694e-01f, 9.96940494e-01f, 7.81644881e-02f,
  9.99032140e-01f, 4.39858064e-02f, 9.99693930e-01f, 2.47404929e-02f, 9.99903202e-01f, 1.39135728e-02f, 9.99969363e-01f, 7.82434922e-03f,
  5.25321960e-01f, 8.50903511e-01f, 9.85138178e-01f, 1.71763569e-01f, -9.29481089e-02f, 9.95670974e-01f, -1.47732988e-01f, 9.89027262e-01f,
  -2.10795805e-01f, -9.77530122e-01f, -8.19042206e-01f, 5.73733270e-01f, 1.47234216e-01f, 9.89101648e-01f, 6.96544766e-01f, 7.17513323e-01f,
  9.00447130e-01f, 4.34965521e-01f, 9.68152404e-01f, 2.50361472e-01f, 9.89892066e-01f, 1.41822711e-01f, 9.96799886e-01f, 7.99371973e-02f,
  9.98987675e-01f, 4.49848175e-02f, 9.99679863e-01f, 2.53026579e-02f, 9.99898732e-01f, 1.42297689e-02f, 9.99967992e-01f, 8.00217129e-03f,
  -4.32177931e-01f, 9.01788354e-01f, 7.41858006e-01f, 6.70557022e-01f, -3.97976756e-01f, 9.17395473e-01f, -3.20354372e-01f, 9.47297752e-01f,
  -1.12152621e-01f, -9.93690968e-01f, -8.49993885e-01f, 5.26792526e-01f, 1.15887694e-01f, 9.93262351e-01f, 6.83675885e-01f, 7.29785740e-01f,
  8.96052480e-01f, 4.43948090e-01f, 9.66729224e-01f, 2.55801797e-01f, 9.89438653e-01f, 1.44952312e-01f, 9.96656179e-01f, 8.17096606e-02f,
  9.98942196e-01f, 4.59837839e-02f, 9.99665439e-01f, 2.58648153e-02f, 9.99894202e-01f, 1.45459641e-02f, 9.99966562e-01f, 8.17999430e-03f,
  -9.92335498e-01f, 1.23573124e-01f, 2.70098448e-01f, 9.62832689e-01f, -6.63538277e-01f, 7.48142362e-01f, -4.82871950e-01f, 8.75690997e-01f,
  -1.23883775e-02f, -9.99923289e-01f, -8.78258407e-01f, 4.78186339e-01f, 8.44252855e-02f, 9.96429801e-01f, 6.70590878e-01f, 7.41827428e-01f,
  8.91568303e-01f, 4.52886283e-01f, 9.65275466e-01f, 2.61234075e-01f, 9.88975346e-01f, 1.48080453e-01f, 9.96509314e-01f, 8.34818557e-02f,
  9.98895705e-01f, 4.69827019e-02f, 9.99650776e-01f, 2.64269635e-02f, 9.99889553e-01f, 1.48621574e-02f, 9.99965072e-01f, 8.35781638e-03f,
  -6.40144348e-01f, -7.68254638e-01f, -2.84846604e-01f, 9.58573103e-01f, -8.63296509e-01f, 5.04697084e-01f, -6.30159974e-01f, 7.76465356e-01f,
  8.74991715e-02f, -9.96164620e-01f, -9.03746367e-01f, 4.28068399e-01f, 5.28784581e-02f, 9.98600960e-01f, 6.57293737e-01f, 7.53634512e-01f,
  8.86994898e-01f, 4.61779177e-01f, 9.63791192e-01f, 2.66658038e-01f, 9.88502085e-01f, 1.51207119e-01f, 9.96359289e-01f, 8.52537975e-02f,
  9.98848200e-01f, 4.79815714e-02f, 9.99635756e-01f, 2.69891042e-02f, 9.99884784e-01f, 1.51783489e-02f, 9.99963582e-01f, 8.53563752e-03f,
  3.00592542e-01f, -9.53752637e-01f, -7.52063990e-01f, 6.59090102e-01f, -9.77442741e-01f, 2.11200655e-01f, -7.57573068e-01f, 6.52750373e-01f,
  1.86512470e-01f, -9.82452571e-01f, -9.26377118e-01f, 3.76597136e-01f, 2.12787576e-02f, 9.99773562e-01f, 6.43788815e-01f, 7.65203178e-01f,
  8.82332861e-01f, 4.70625877e-01f, 9.62276459e-01f, 2.72073567e-01f, 9.88018990e-01f, 1.54332280e-01f, 9.96206105e-01f, 8.70254710e-02f,
  9.98799741e-01f, 4.89803962e-02f, 9.99620378e-01f, 2.75512375e-02f, 9.99879956e-01f, 1.54945394e-02f, 9.99962032e-01f, 8.71345960e-03f,
  9.64965999e-01f, -2.62374848e-01f, -9.87659097e-01f, 1.56619072e-01f, -9.94656444e-01f, -1.03240460e-01f, -8.61092687e-01f, 5.08447945e-01f,
  2.83662200e-01f, -9.58924294e-01f, -9.46079254e-01f, 3.23935270e-01f, -1.03422189e-02f, 9.99946535e-01f, 6.30080283e-01f, 7.76529968e-01f,
  8.77582550e-01f, 4.79425550e-01f, 9.60731268e-01f, 2.77480543e-01f, 9.87526000e-01f, 1.57455891e-01f, 9.96049762e-01f, 8.87968615e-02f,
  9.98750269e-01f, 4.99791689e-02f, 9.99604762e-01f, 2.81133596e-02f, 9.99875009e-01f, 1.58107281e-02f, 9.99960482e-01f, 8.89127981e-03f,
  7.42154181e-01f, 6.70229197e-01f, -9.19073522e-01f, -3.94086063e-01f, -9.13230121e-01f, -4.07444149e-01f, -9.37454224e-01f, 3.48108500e-01f,
  3.77977669e-01f, -9.25814748e-01f, -9.62790370e-01f, 2.70249337e-01f, -4.19528559e-02f, 9.99119580e-01f, 6.16172493e-01f, 7.87611187e-01f,
  8.72744501e-01f, 4.88177240e-01f, 9.59155679e-01f, 2.82878697e-01f, 9.87023175e-01f, 1.60577938e-01f, 9.95890260e-01f, 9.05679762e-02f,
  9.98699784e-01f, 5.09778969e-02f, 9.99588788e-01f, 2.86754742e-02f, 9.99869943e-01f, 1.61269177e-02f, 9.99958873e-01f, 9.06910095e-03f,
  -1.62990779e-01f, 9.86627579e-01f, -5.67430019e-01f, -8.23421597e-01f, -7.41239965e-01f, -6.71240151e-01f, -9.84248459e-01f, 1.76790684e-01f,
  4.68516916e-01f, -8.83454502e-01f, -9.76457715e-01f, 2.15709001e-01f, -7.35215396e-02f, 9.97293651e-01f, 6.02069914e-01f, 7.98443377e-01f,
  8.67819190e-01f, 4.96880114e-01f, 9.57549810e-01f, 2.88267940e-01f, 9.86510456e-01f, 1.63698375e-01f, 9.95727658e-01f, 9.23388004e-02f,
  9.98648286e-01f, 5.19765690e-02f, 9.99572515e-01f, 2.92375814e-02f, 9.99864817e-01f, 1.64431017e-02f, 9.99957263e-01f, 9.24692024e-03f,
  -9.18282807e-01f, 3.95925164e-01f, -4.10281904e-02f, -9.99157965e-01f, -4.95741814e-01f, -8.68469954e-01f, -1.00000000e+00f, -1.03020677e-04f,
  5.54374516e-01f, -8.32267344e-01f, -9.87038016e-01f, 1.60486728e-01f, -1.05016708e-01f, 9.94470477e-01f, 5.87776959e-01f, 8.09023023e-01f,
  8.62807095e-01f, 5.05533338e-01f, 9.55913603e-01f, 2.93648034e-01f, 9.85987842e-01f, 1.66817173e-01f, 9.95561838e-01f, 9.41093415e-02f,
  9.98595834e-01f, 5.29751927e-02f, 9.99555886e-01f, 2.97996756e-02f, 9.99859571e-01f, 1.67592876e-02f, 9.99955595e-01f, 9.42474138e-03f,
  -8.29309821e-01f, -5.58789074e-01f, 4.98009592e-01f, -8.67171526e-01f, -2.01079622e-01f, -9.79574919e-01f, -9.84212041e-01f, -1.76993474e-01f,
  6.34692967e-01f, -7.72764444e-01f, -9.94497895e-01f, 1.04756832e-01f, -1.36406869e-01f, 9.90652919e-01f, 5.73298037e-01f, 8.19346905e-01f,
  8.57708693e-01f, 5.14135957e-01f, 9.54247177e-01f, 2.99018890e-01f, 9.85455394e-01f, 1.69934288e-01f, 9.95392919e-01f, 9.58795771e-02f,
  9.98542368e-01f, 5.39737605e-02f, 9.99538958e-01f, 3.03617641e-02f, 9.99854207e-01f, 1.70754679e-02f, 9.99953866e-01f, 9.60256159e-03f,
  2.21267566e-02f, -9.99755144e-01f, 8.83669317e-01f, -4.68111664e-01f, 1.13521777e-01f, -9.93535519e-01f, -9.37382519e-01f, -3.48301649e-01f,
  7.08669782e-01f, -7.05540299e-01f, -9.98813629e-01f, 4.86960001e-02f, -1.67660639e-01f, 9.85844791e-01f, 5.58637917e-01f, 8.29411685e-01f,
  8.52524519e-01f, 5.22687256e-01f, 9.52550590e-01f, 3.04380238e-01f, 9.84913111e-01f, 1.73049718e-01f, 9.95220840e-01f, 9.76495072e-02f,
  9.98487890e-01f, 5.49722798e-02f, 9.99521732e-01f, 3.09238415e-02f, 9.99848783e-01f, 1.73916500e-02f, 9.99952197e-01f, 9.78038087e-03f,
  8.53220105e-01f, -5.21551013e-01f, 9.97174621e-01f, 7.51182064e-02f, 4.16867077e-01f, -9.08967435e-01f, -8.60988438e-01f, -5.08624554e-01f,
  7.75565803e-01f, -6.31266713e-01f, -9.99971747e-01f, -7.51878507e-03f, -1.98746875e-01f, 9.80050862e-01f, 5.43801069e-01f, 8.39214146e-01f,
  8.47255111e-01f, 5.31186223e-01f, 9.50823903e-01f, 3.09731960e-01f, 9.84360933e-01f, 1.76163420e-01f, 9.95045662e-01f, 9.94191393e-02f,
  9.98432398e-01f, 5.59707358e-02f, 9.99504209e-01f, 3.14859077e-02f, 9.99843180e-01f, 1.77078284e-02f, 9.99950409e-01f, 9.95820016e-03f,
  8.99866819e-01f, 4.36164767e-01f, 8.03569078e-01f, 5.95211506e-01f, 6.78870201e-01f, -7.34258294e-01f, -7.57439196e-01f, -6.52905703e-01f,
  8.34712923e-01f, -5.50685287e-01f, -9.97968495e-01f, -6.37097955e-02f, -2.29634270e-01f, 9.73276973e-01f, 5.28792322e-01f, 8.48751247e-01f,
  8.41901004e-01f, 5.39632022e-01f, 9.49067116e-01f, 3.15073937e-01f, 9.83798921e-01f, 1.79275364e-01f, 9.94867265e-01f, 1.01188451e-01f,
  9.98375952e-01f, 5.69691435e-02f, 9.99486327e-01f, 3.20479684e-02f, 9.99837577e-01f, 1.80240069e-02f, 9.99948621e-01f, 1.01360194e-02f,
  1.19180135e-01f, 9.92872655e-01f, 3.62476677e-01f, 9.31992829e-01f, 8.73550534e-01f, -4.86733496e-01f, -6.30000710e-01f, -7.76594579e-01f,
  8.85519624e-01f, -4.64602023e-01f, -9.92810190e-01f, -1.19699396e-01f, -2.60292053e-01f, 9.65529919e-01f, 5.13616323e-01f, 8.58020008e-01f,
  8.36462677e-01f, 5.48023939e-01f, 9.47280347e-01f, 3.20405900e-01f, 9.83227074e-01f, 1.82385504e-01f, 9.94685769e-01f, 1.02957435e-01f,
  9.98318493e-01f, 5.79674877e-02f, 9.99468148e-01f, 3.26100141e-02f, 9.99831796e-01f, 1.83401816e-02f, 9.99946833e-01f, 1.03138378e-02f,
  -7.71080196e-01f, 6.36738002e-01f, -1.90249100e-01f, 9.81735826e-01f, 9.81602073e-01f, -1.90938011e-01f, -4.82692331e-01f, -8.75790000e-01f,
  9.27478492e-01f, -3.73876572e-01f, -9.84513164e-01f, -1.75310582e-01f, -2.90689558e-01f, 9.56817448e-01f, 4.98277903e-01f, 8.67017388e-01f,
  8.30940723e-01f, 5.56361020e-01f, 9.45463598e-01f, 3.25727791e-01f, 9.82645452e-01f, 1.85493827e-01f, 9.94501114e-01f, 1.04726106e-01f,
  9.98260021e-01f, 5.89657798e-02f, 9.99449670e-01f, 3.31720486e-02f, 9.99825954e-01f, 1.86563563e-02f, 9.99944985e-01f, 1.04916561e-02f,
  -9.52412963e-01f, -3.04810613e-01f, -6.84381902e-01f, 7.29123712e-01f, 9.92308319e-01f, 1.23790950e-01f, -3.20159167e-01f, -9.47363734e-01f,
  9.60170269e-01f, -2.79415488e-01f, -9.73103702e-01f, -2.30367512e-01f, -3.20796400e-01f, 9.47148204e-01f, 4.82782036e-01f, 8.75740528e-01f,
  8.25335622e-01f, 5.64642429e-01f, 9.43616986e-01f, 3.31039310e-01f, 9.82053936e-01f, 1.88600287e-01f, 9.94313300e-01f, 1.06494442e-01f,
  9.98200536e-01f, 5.99640086e-02f, 9.99430835e-01f, 3.37340795e-02f, 9.99819994e-01f, 1.89725272e-02f, 9.99943078e-01f, 1.06694745e-02f,
  -2.58101642e-01f, -9.66117799e-01f, -9.67739642e-01f, 2.51952261e-01f, 9.04607594e-01f, 4.26245421e-01f, -1.47529200e-01f, -9.89057720e-01f,
  9.83268440e-01f, -1.82162598e-01f, -9.58617806e-01f, -2.84696162e-01f, -3.50582451e-01f, 9.36531842e-01f, 4.67133403e-01f, 8.84186864e-01f,
  8.19648027e-01f, 5.72867453e-01f, 9.41740453e-01f, 3.36340427e-01f, 9.81452644e-01f, 1.91704854e-01f, 9.94122326e-01f, 1.08262435e-01f,
  9.98140097e-01f, 6.09621815e-02f, 9.99411702e-01f, 3.42960916e-02f, 9.99813974e-01f, 1.92886982e-02f, 9.99941170e-01f, 1.08472919e-02f,
  6.73507154e-01f, -7.39180684e-01f, -9.53050017e-01f, -3.02812874e-01f, 7.27198064e-01f, 6.86427653e-01f, 2.97537707e-02f, -9.99557257e-01f,
  9.96542096e-01f, -8.30891207e-02f, -9.41101313e-01f, -3.38124752e-01f, -3.80017966e-01f, 9.24979091e-01f, 4.51337039e-01f, 8.92353535e-01f,
  8.13878477e-01f, 5.81035137e-01f, 9.39834237e-01f, 3.41630876e-01f, 9.80841517e-01f, 1.94807529e-01f, 9.93928254e-01f, 1.10030092e-01f,
  9.98078644e-01f, 6.19602874e-02f, 9.99392271e-01f, 3.48580964e-02f, 9.99807835e-01f, 1.96048655e-02f, 9.99939203e-01f, 1.10251084e-02f,
  9.85896587e-01f, 1.67355701e-01f, -6.44837022e-01f, -7.64320076e-01f, 4.77671444e-01f, 8.78538549e-01f, 2.06098333e-01f, -9.78531301e-01f,
  9.99858618e-01f, 1.68140903e-02f, -9.20609534e-01f, -3.90484393e-01f, -4.09073502e-01f, 9.12501454e-01f, 4.35397953e-01f, 9.00238097e-01f,
  8.08027506e-01f, 5.89144766e-01f, 9.37898219e-01f, 3.46910536e-01f, 9.80220556e-01f, 1.97908238e-01f, 9.93731022e-01f, 1.11797392e-01f,
  9.98016179e-01f, 6.29583374e-02f, 9.99372482e-01f, 3.54200937e-02f, 9.99801576e-01f, 1.99210308e-02f, 9.99937236e-01f, 1.12029258e-02f,
};

constexpr int T_ALL = 36864, T_CTX = 4096;
constexpr int NLAYER = 4;
constexpr float EPS = 1e-6f;
constexpr int LK_LAT = 4352;

struct Params {
  const float* x_prompt; const float* x_sample; const float* cache_ckv; const float* cache_krope;
  const float* cache_k; const float* cache_v; const float* state; const float* c; const float* c_ctx;
  const float* w_mod; const float* b_mod; const float* g_norm; const float* w_in; const float* conv_w; const float* conv_b;
  const float* lru_wa; const float* lru_ba; const float* lru_wi; const float* lru_bi; const float* lru_lam;
  const float* q_norm; const float* w_uq; const float* kv_norm; const float* w_ukv; const float* sink;
  const float* w_br_rnn; const float* w_br_mla; const float* w_br_swa; const float* w_out; const float* final_norm;
  float* out; char* ws;
};

constexpr size_t AL(size_t x) { return (x + 255) & ~(size_t)255; }
constexpr size_t O_WINA = 0;
constexpr size_t O_WINB = O_WINA + AL((size_t)2560 * 1024 * 2);
constexpr size_t O_WLRU = O_WINB + AL((size_t)5120 * 1024 * 2);
constexpr size_t O_WUQ = O_WLRU + AL((size_t)4096 * 128 * 2);
constexpr size_t O_WUKVG = O_WUQ + AL((size_t)768 * 384 * 2);
constexpr size_t O_WUKVR = O_WUKVG + AL((size_t)1024 * 256 * 2);
constexpr size_t O_WBRR = O_WUKVR + AL((size_t)1024 * 256 * 2);
constexpr size_t O_WBRM = O_WBRR + AL((size_t)1024 * 1024 * 2);
constexpr size_t O_WBRS = O_WBRM + AL((size_t)1024 * 512 * 2);
constexpr size_t O_WOUT = O_WBRS + AL((size_t)1024 * 512 * 2);
constexpr size_t O_MOD = O_WOUT + AL((size_t)1024 * 1024 * 2);
constexpr size_t O_H = O_MOD + AL((size_t)4 * 9 * 3072 * 4);
constexpr size_t O_XR = O_H + AL((size_t)T_ALL * 1024 * 2);
constexpr size_t O_CQ = O_XR + AL((size_t)T_ALL * 1024 * 2);
constexpr size_t O_CKV = O_CQ + AL((size_t)T_ALL * 384 * 2);
constexpr size_t O_CKVC = O_CKV + AL((size_t)T_ALL * 256 * 2);
constexpr size_t O_KRL = O_CKVC + AL((size_t)2048 * 256 * 2);
constexpr size_t O_KRC = O_KRL + AL((size_t)8 * LK_LAT * 32 * 2);
constexpr size_t O_QS = O_KRC + AL((size_t)16 * 256 * 32 * 2);
constexpr size_t O_KS = O_QS + AL((size_t)T_ALL * 512 * 2);
constexpr size_t O_KSC = O_KS + AL((size_t)T_ALL * 128 * 2);
constexpr size_t O_VTSL = O_KSC + AL((size_t)8 * 256 * 128 * 2);
constexpr size_t O_VTSC = O_VTSL + AL((size_t)8 * 2 * 64 * 4096 * 2);
constexpr size_t O_VTSCC = O_VTSC + AL((size_t)16 * 2 * 64 * 256 * 2);
constexpr size_t O_Q = O_VTSCC + AL((size_t)8 * 2 * 64 * 256 * 2);
constexpr size_t O_KNL = O_Q + AL((size_t)T_ALL * 768 * 2);
constexpr size_t O_KNC = O_KNL + AL((size_t)8 * 8 * LK_LAT * 64 * 2);
constexpr size_t O_VTL = O_KNC + AL((size_t)16 * 8 * 256 * 64 * 2);
constexpr size_t O_VTC = O_VTL + AL((size_t)8 * 8 * 64 * LK_LAT * 2);
constexpr size_t O_YRNN = O_VTC + AL((size_t)16 * 8 * 64 * 256 * 2);
static_assert(O_YRNN - O_KS >= (size_t)2 * T_ALL * 1024 * 2, "merge-gate buffers do not fit");
constexpr size_t O_SUM = O_YRNN + AL((size_t)T_ALL * 1024 * 2);
constexpr size_t O_BAR = O_SUM + AL((size_t)8 * 8 * 2 * 16 * 256 * 4);
constexpr size_t BAR_BYTES = 16384;
constexpr size_t O_W2 = O_BAR + BAR_BYTES;
constexpr size_t WS_NEED = O_W2 + O_MOD;

constexpr size_t OUT_CKV = (size_t)T_ALL * 1024;
constexpr size_t OUT_KROPE = OUT_CKV + (size_t)16 * 4 * 256 * 256;
constexpr size_t OUT_SK = OUT_KROPE + (size_t)16 * 4 * 256 * 32;
constexpr size_t OUT_SV = OUT_SK + (size_t)16 * 4 * 256 * 128;
constexpr size_t OUT_RG = OUT_SV + (size_t)16 * 4 * 256 * 128;

#define SB() __builtin_amdgcn_sched_barrier(0)
#define MB() asm volatile("" ::: "memory")
DI int tid() { int t = threadIdx.x; asm volatile("" : "+v"(t)); return t; }
DI int xcd_map(int base) {
  const int g = gridDim.x;
  if (g & 7) return base + blockIdx.x;
  return base + (blockIdx.x & 7) * (g >> 3) + (blockIdx.x >> 3);
}
#define LANEVARS const int t = tid(), lane = t & 63, w = t >> 6, wr = w >> 1, wc = w & 1; const int c16 = lane & 15, g4 = lane >> 4; (void)wr; (void)wc; (void)c16; (void)g4;
DI float bf2f(u16 v) { return __uint_as_float(((unsigned)v) << 16); }
DI unsigned pack2(float a, float b) {
  f2_t v = {a, b};
  bf2_t r = __builtin_convertvector(v, bf2_t);
  return __builtin_bit_cast(unsigned, r);
}
DI u16 f2bf(float a) { return (u16)(pack2(a, 0.f) & 0xffffu); }
DI float sigmoidf_(float x) { return __builtin_amdgcn_rcpf(1.f + __expf(-x)); }
DI float wave_sum(float v) {
#pragma unroll
  for (int o = 32; o > 0; o >>= 1) v += __shfl_xor(v, o);
  return v;
}
DI int perm32(int p) { return (p & 7) | ((p & 8) << 1) | ((p & 16) >> 1); }
DI const float* xin_row(const Params& p, int l, int row) {
  if (l == 0) return row < T_CTX ? p.x_prompt + (size_t)row * 1024 : p.x_sample + (size_t)(row - T_CTX) * 1024;
  return p.out + (size_t)row * 1024;
}
template <class T> DI T* wsp(const Params& p, size_t off) { return (T*)(p.ws + off); }
DI u16* wsw(const Params& p, int l, size_t off) { return (u16*)(p.ws + ((l & 1) ? O_W2 : 0) + off); }

template <int NJ>
DI void gemm_tile_t(const u16* A, int lda, const u16* B, int ldb, int K,
                    f32x4 (&acc)[4][NJ], char* smem) {
  const int t = tid(), lane = t & 63, w = t >> 6, wr = w >> 1, wc = w & 1;
  const int lr = t >> 3, slot = t & 7;
  const int c16 = lane & 15, g4 = lane >> 4;
  const int gch = slot ^ ((lr >> 1) & 7);
  const u16* ap = A + (size_t)lr * lda + gch * 8;
  const u16* bp = B + (size_t)lr * ldb + gch * 8;
  char* sdst = smem + t * 16;
#define DMA16(gp, lp) __builtin_amdgcn_global_load_lds((const unsigned*)(gp), (unsigned*)(lp), 16, 0, 0)
#define STAGE(base, ko) { DMA16(ap + (ko), (base)); DMA16(ap + (size_t)32 * lda + (ko), (base) + 4096); \
    DMA16(ap + (size_t)64 * lda + (ko), (base) + 8192); DMA16(ap + (size_t)96 * lda + (ko), (base) + 12288); \
    DMA16(bp + (ko), (base) + 16384); DMA16(bp + (size_t)32 * ldb + (ko), (base) + 16384 + 4096); \
    if (NJ > 2) { DMA16(bp + (size_t)64 * ldb + (ko), (base) + 16384 + 8192); DMA16(bp + (size_t)96 * ldb + (ko), (base) + 16384 + 12288); } }
  const int nk = K >> 6;
  const int arow = (wr * 64 + c16) * 128, brow = (wc * (16 * NJ) + c16) * 128;
  const int sw = (c16 >> 1) & 7;
  int kk = 0;
  STAGE(sdst, kk * 64)
  __syncthreads();
  for (int kt = 0; kt < nk; ++kt) {
    char* cur = smem + (kt & 1) * 32768;
    kk = (kk + 1 == nk) ? 0 : kk + 1;
    if (kt + 1 < nk) { char* nxt = sdst + ((kt + 1) & 1) * 32768; STAGE(nxt, kk * 64) }
#pragma unroll
    for (int ks = 0; ks < 2; ++ks) {
      bf16x8 af[4], bfr[NJ];
      const int ch = ((ks * 4 + g4) ^ sw) << 4;
#pragma unroll
      for (int i = 0; i < 4; ++i) af[i] = *(const bf16x8*)(cur + arow + i * 2048 + ch);
#pragma unroll
      for (int i = 0; i < NJ; ++i) bfr[i] = *(const bf16x8*)(cur + 16384 + brow + i * 2048 + ch);
#pragma unroll
      for (int i = 0; i < 4; ++i)
#pragma unroll
        for (int j = 0; j < NJ; ++j)
          acc[i][j] = __builtin_amdgcn_mfma_f32_16x16x32_bf16(af[i], bfr[j], acc[i][j], 0, 0, 0);
    }
    SB();
    __syncthreads();
  }
#undef STAGE
#undef DMA16
}
DI void gemm_tile(const u16* A, int lda, const u16* B, int ldb, int K,
                  f32x4 (&acc)[4][4], char* smem) {
  gemm_tile_t<4>(A, lda, B, ldb, K, acc, smem);
}
DI void zero_acc(f32x4 (&acc)[4][4]) {
#pragma unroll
  for (int i = 0; i < 4; ++i)
#pragma unroll
    for (int j = 0; j < 4; ++j) acc[i][j] = f32x4{0.f, 0.f, 0.f, 0.f};
}

struct TokTile { int g0; int is_ctx; int b; int p0; };
DI TokTile tok_tile(int mt) {
  TokTile r; r.g0 = mt * 128;
  if (r.g0 < T_CTX) { r.is_ctx = 1; r.b = r.g0 >> 8; r.p0 = r.g0 & 255; }
  else { r.is_ctx = 0; r.b = (r.g0 - T_CTX) >> 12; r.p0 = (r.g0 - T_CTX) & 4095; }
  return r;
}

DI void phase_mod(const Params& p, char* smem) {
  float* s_silu = (float*)smem;
  float* s_part = (float*)(smem + 36864);
  float* MOD = wsp<float>(p, O_MOD);
  const int t = tid();
  for (int i = t; i < 9 * 1024; i += 256) {
    float v = (i < 8192) ? p.c[i] : p.c_ctx[i - 8192];
    s_silu[i] = v * sigmoidf_(v);
  }
  __syncthreads();
  const int kg = t >> 6, cl = t & 63;
  for (int u = blockIdx.x; u < 4 * 48; u += gridDim.x) {
    const int l = u / 48, cb = u % 48;
    const int n = cb * 64 + cl;
    float acc[9];
#pragma unroll
    for (int ci = 0; ci < 9; ++ci) acc[ci] = 0.f;
    const float* wp = p.w_mod + ((size_t)l * 1024 + kg * 256) * 3072 + n;
    for (int k = 0; k < 256; ++k) {
      float wv = wp[(size_t)k * 3072];
#pragma unroll
      for (int ci = 0; ci < 9; ++ci) acc[ci] += s_silu[ci * 1024 + kg * 256 + k] * wv;
    }
#pragma unroll
    for (int ci = 0; ci < 9; ++ci) s_part[(kg * 9 + ci) * 64 + cl] = acc[ci];
    __syncthreads();
    for (int idx = t; idx < 9 * 64; idx += 256) {
      int ci = idx >> 6, c2 = idx & 63;
      float s = s_part[(0 * 9 + ci) * 64 + c2] + s_part[(1 * 9 + ci) * 64 + c2] + s_part[(2 * 9 + ci) * 64 + c2] +
                s_part[(3 * 9 + ci) * 64 + c2];
      MOD[((size_t)l * 9 + ci) * 3072 + cb * 64 + c2] = s + p.b_mod[l * 3072 + cb * 64 + c2];
    }
    __syncthreads();
  }
}

template <class F> DI void conv_job(u16* dst, int N, int K, F src) {
  const int total = N * (K >> 3);
  for (int idx = blockIdx.x * 256 + tid(); idx < total; idx += gridDim.x * 256) {
    const int n = idx % N, kb = idx / N;
    float v[8];
#pragma unroll
    for (int j = 0; j < 8; ++j) v[j] = src(kb * 8 + j, n);
    uint4 o;
    o.x = pack2(v[0], v[1]); o.y = pack2(v[2], v[3]); o.z = pack2(v[4], v[5]); o.w = pack2(v[6], v[7]);
    *(uint4*)(dst + (size_t)n * K + kb * 8) = o;
  }
}

DI void convert_weights(const Params& p, int l) {
  {
    const float* win = p.w_in + (size_t)l * 1024 * 7584;
    conv_job(wsw(p, l, O_WINA), 2560, 1024, [&](int k, int n) -> float {
      int col;
      if (n < 1024) col = n;
      else if (n < 1408) col = 2048 + (n - 1024);
      else if (n < 1664) col = 2432 + (n - 1408);
      else if (n < 1792) { int pp = n - 1664; col = pp < 32 ? 2688 + perm32(pp) : -1; }
      else if (n < 2304) col = 3232 + (n - 1792);
      else if (n < 2432) col = 3744 + (n - 2304);
      else col = 3872 + (n - 2432);
      return col < 0 ? 0.f : win[(size_t)k * 7584 + col];
    });
    conv_job(wsw(p, l, O_WINB), 5120, 1024, [&](int k, int n) -> float {
      int col;
      if (n < 1024) col = 1024 + n;
      else if (n < 1536) col = 2720 + (n - 1024);
      else if (n < 2048) col = 4000 + (n - 1536);
      else col = 4512 + (n - 2048);
      return win[(size_t)k * 7584 + col];
    });
    const float* wa = p.lru_wa + (size_t)l * 2 * 8 * 128 * 128;
    const float* wi = p.lru_wi + (size_t)l * 2 * 8 * 128 * 128;
    conv_job(wsw(p, l, O_WLRU), 4096, 128, [&](int k, int n) -> float {
      int db = n >> 8, nn = n & 255;
      return nn < 128 ? wa[((size_t)db * 128 + k) * 128 + nn] : wi[((size_t)db * 128 + k) * 128 + (nn - 128)];
    });
    const float* wuq = p.w_uq + (size_t)l * 384 * 768;
    const float* gq = p.q_norm + l * 384;
    conv_job(wsw(p, l, O_WUQ), 768, 384, [&](int k, int n) -> float {
      int col;
      if (n < 512) col = (n >> 6) * 96 + (n & 63);
      else { int hh = (n - 512) >> 5, pp = (n - 512) & 31; col = hh * 96 + 64 + perm32(pp); }
      return gq[k] * wuq[(size_t)k * 768 + col];
    });
    const float* wukv = p.w_ukv + (size_t)l * 256 * 1024;
    const float* gkv = p.kv_norm + l * 256;
    conv_job(wsw(p, l, O_WUKVG), 1024, 256, [&](int k, int n) -> float { return gkv[k] * wukv[(size_t)k * 1024 + n]; });
    conv_job(wsw(p, l, O_WUKVR), 1024, 256, [&](int k, int n) -> float { return wukv[(size_t)k * 1024 + n]; });
    const float* w1 = p.w_br_rnn + (size_t)l * 1024 * 1024;
    conv_job(wsw(p, l, O_WBRR), 1024, 1024, [&](int k, int n) -> float { return w1[(size_t)k * 1024 + n]; });
    const float* w2 = p.w_br_mla + (size_t)l * 512 * 1024;
    conv_job(wsw(p, l, O_WBRM), 1024, 512, [&](int k, int n) -> float { return w2[(size_t)k * 1024 + n]; });
    const float* w3 = p.w_br_swa + (size_t)l * 512 * 1024;
    conv_job(wsw(p, l, O_WBRS), 1024, 512, [&](int k, int n) -> float { return w3[(size_t)k * 1024 + n]; });
    const float* w4 = p.w_out + (size_t)l * 1024 * 1024;
    conv_job(wsw(p, l, O_WOUT), 1024, 1024, [&](int k, int n) -> float { return w4[(size_t)k * 1024 + n]; });
  }
}

DI void phase_prep(const Params& p, int l) {
  const int t = tid(), lane = t & 63, w = t >> 6;
  const float* MOD = wsp<float>(p, O_MOD) + (size_t)l * 9 * 3072;
  u16* H = wsp<u16>(p, O_H);
  for (int row = blockIdx.x * 4 + w; row < T_ALL; row += gridDim.x * 4) {
    const float* x = xin_row(p, l, row);
    const int ci = row < T_CTX ? 8 : ((row - T_CTX) >> 12);
    const float* md = MOD + ci * 3072;
    float4 v[4];
    float ss = 0.f;
#pragma unroll
    for (int i = 0; i < 4; ++i) {
      v[i] = *(const float4*)(x + i * 256 + lane * 4);
      ss += v[i].x * v[i].x + v[i].y * v[i].y + v[i].z * v[i].z + v[i].w * v[i].w;
    }
    ss = wave_sum(ss);
    const float rs = rsqrtf(ss * (1.f / 1024.f) + EPS);
#pragma unroll
    for (int i = 0; i < 4; ++i) {
      const int c = i * 256 + lane * 4;
      const float4 g = *(const float4*)(p.g_norm + l * 1024 + c);
      const float4 sh = *(const float4*)(md + c);
      const float4 sc = *(const float4*)(md + 1024 + c);
      float h0 = v[i].x * rs * g.x * (1.f + sc.x) + sh.x;
      float h1 = v[i].y * rs * g.y * (1.f + sc.y) + sh.y;
      float h2 = v[i].z * rs * g.z * (1.f + sc.z) + sh.z;
      float h3 = v[i].w * rs * g.w * (1.f + sc.w) + sh.w;
      uint2 o; o.x = pack2(h0, h1); o.y = pack2(h2, h3);
      *(uint2*)(H + (size_t)row * 1024 + c) = o;
    }
  }
  {
    const int gt = blockIdx.x * 256 + t, gs = gridDim.x * 256;
    u16* ckvc = wsp<u16>(p, O_CKVC);
    for (int i = gt; i < 2048 * 256; i += gs) {
      int r = i >> 8, k = i & 255, b = r >> 8, pos = r & 255;
      ckvc[i] = f2bf(p.cache_ckv[(((size_t)b * 4 + l) * 256 + pos) * 256 + k]);
    }
    u16* krl = wsp<u16>(p, O_KRL);
    for (int i = gt; i < 8 * 256 * 32; i += gs) {
      int pp = i & 31, pos = (i >> 5) & 255, b = i >> 13;
      krl[((size_t)b * LK_LAT + pos) * 32 + pp] = f2bf(p.cache_krope[(((size_t)b * 4 + l) * 256 + pos) * 32 + perm32(pp)]);
    }
    u16* ksc = wsp<u16>(p, O_KSC);
    for (int i = gt; i < 8 * 256 * 128; i += gs) {
      int c = i & 127, pos = (i >> 7) & 255, b = i >> 15;
      ksc[i] = f2bf(p.cache_k[(((size_t)b * 4 + l) * 256 + pos) * 128 + c]);
    }
    u16* vtc = wsp<u16>(p, O_VTSCC);
    for (int i = gt; i < 8 * 2 * 64 * 256; i += gs) {
      int pos = i & 255, dv = (i >> 8) & 63, kvh = (i >> 14) & 1, b = i >> 15;
      vtc[i] = f2bf(p.cache_v[(((size_t)b * 4 + l) * 256 + pos) * 128 + kvh * 64 + dv]);
    }
  }
}

DI void phase_gemmA(const Params& p, int l, char* smem) {
  const u16* H = wsp<u16>(p, O_H);
  const u16* W = wsw(p, l, O_WINA);
  for (int base = 0; base < 288 * 20; base += gridDim.x) {
    const int tile = xcd_map(base);
    if (tile >= 288 * 20) continue;
    const int sb = tile >> 5, jj = tile & 31;
    const int mt = (sb / 5) * 8 + (jj >> 2), nt = (sb % 5) * 4 + (jj & 3);
    const TokTile tt = tok_tile(mt);
    f32x4 acc[4][4];
    zero_acc(acc);
    gemm_tile(H + (size_t)tt.g0 * 1024, 1024, W + (size_t)nt * 128 * 1024, 1024, 1024, acc, smem);
    LANEVARS
    if (nt < 13) {
      u16* dst; int ld, cb;
      if (nt < 8) { dst = wsp<u16>(p, O_XR); ld = 1024; cb = nt * 128; }
      else if (nt < 11) { dst = wsp<u16>(p, O_CQ); ld = 384; cb = (nt - 8) * 128; }
      else { dst = wsp<u16>(p, O_CKV); ld = 256; cb = (nt - 11) * 128; }
#pragma unroll
      for (int i = 0; i < 4; ++i)
#pragma unroll
        for (int j = 0; j < 4; ++j)
#pragma unroll
          for (int e = 0; e < 4; ++e) {
            const int g = tt.g0 + wr * 64 + i * 16 + g4 * 4 + e;
            dst[(size_t)g * ld + cb + wc * 64 + j * 16 + c16] = f2bf(acc[i][j][e]);
            if (e == 3 && j == 3) SB();
          }
    } else if (nt == 13) {
      if (wc == 0) {
#pragma unroll
        for (int i = 0; i < 4; ++i)
#pragma unroll
          for (int e = 0; e < 4; ++e) {
            SB();
            const int r = wr * 64 + i * 16 + g4 * 4 + e;
            const int pos = tt.p0 + r;
            float x1 = acc[i][0][e], x2 = acc[i][1][e];
            if (tt.is_ctx) {
              u16* kr = wsp<u16>(p, O_KRC) + ((size_t)tt.b * 256 + pos) * 32;
              kr[c16] = f2bf(x1); kr[c16 + 16] = f2bf(x2);
              float* o = p.out + OUT_KROPE + (((size_t)tt.b * 4 + l) * 256 + pos) * 32;
              o[perm32(c16)] = x1; o[perm32(c16 + 16)] = x2;
            } else {
              const int pv = (c16 >= 8) ? (pos & 63) : (pos >> 6);
              const float cs = TAB_M[(pv * 8 + (c16 & 7)) * 2], sn = TAB_M[(pv * 8 + (c16 & 7)) * 2 + 1];
              u16* kr = wsp<u16>(p, O_KRL) + ((size_t)tt.b * LK_LAT + 256 + pos) * 32;
              kr[c16] = f2bf(x1 * cs - x2 * sn); kr[c16 + 16] = f2bf(x2 * cs + x1 * sn);
            }
          }
      }
    } else if (nt < 19) {
      const bool isk = (nt == 18);
      u16* dst = isk ? wsp<u16>(p, O_KS) : wsp<u16>(p, O_QS);
      const int ld = isk ? 128 : 512;
      const int cb = isk ? wc * 64 : ((nt - 14) * 2 + wc) * 64;
#pragma unroll
      for (int i = 0; i < 4; ++i)
#pragma unroll
        for (int e = 0; e < 4; ++e) {
          SB();
          const int r = wr * 64 + i * 16 + g4 * 4 + e;
          const int pos = tt.p0 + r, g = tt.g0 + r;
          float v0 = acc[i][0][e], v1 = acc[i][1][e], v2 = acc[i][2][e], v3 = acc[i][3][e];
          if (!tt.is_ctx) {
            const int pr = pos >> 6, pc = pos & 63;
            const float c0 = TAB_S[(pr * 16 + c16) * 2], s0 = TAB_S[(pr * 16 + c16) * 2 + 1];
            const float c1 = TAB_S[(pc * 16 + c16) * 2], s1 = TAB_S[(pc * 16 + c16) * 2 + 1];
            float a0 = v0 * c0 - v1 * s0, a1 = v1 * c0 + v0 * s0;
            float a2 = v2 * c1 - v3 * s1, a3 = v3 * c1 + v2 * s1;
            v0 = a0; v1 = a1; v2 = a2; v3 = a3;
          } else if (isk) {
            float* o = p.out + OUT_SK + (((size_t)tt.b * 4 + l) * 256 + pos) * 128 + cb + c16;
            o[0] = v0; o[16] = v1; o[32] = v2; o[48] = v3;
          }
          u16* d = dst + (size_t)g * ld + cb + c16;
          d[0] = f2bf(v0); d[16] = f2bf(v1); d[32] = f2bf(v2); d[48] = f2bf(v3);
        }
    } else {
      u16* vt = tt.is_ctx ? wsp<u16>(p, O_VTSC) : wsp<u16>(p, O_VTSL);
      const int L = tt.is_ctx ? 256 : 4096;
#pragma unroll
      for (int i = 0; i < 4; ++i)
#pragma unroll
        for (int j = 0; j < 4; ++j) {
          SB();
          const int r = wr * 64 + i * 16 + g4 * 4;
          const int pos = tt.p0 + r, dv = j * 16 + c16;
          uint2 o; o.x = pack2(acc[i][j][0], acc[i][j][1]); o.y = pack2(acc[i][j][2], acc[i][j][3]);
          *(uint2*)(vt + (((size_t)tt.b * 2 + wc) * 64 + dv) * L + pos) = o;
          if (tt.is_ctx) {
#pragma unroll
            for (int e = 0; e < 4; ++e)
              p.out[OUT_SV + (((size_t)tt.b * 4 + l) * 256 + pos + e) * 128 + wc * 64 + dv] = acc[i][j][e];
          }
        }
    }
  }
}

DI void row_scales(const u16* A, int K, float* s_rs) {
  const int t = tid(), row = t >> 1, half = t & 1;
  const u16* ap = A + (size_t)row * K + half * (K >> 1);
  float ss = 0.f;
  for (int c = 0; c < (K >> 4); ++c) {
    uint4 v = *(const uint4*)(ap + c * 8);
    unsigned wv[4] = {v.x, v.y, v.z, v.w};
#pragma unroll
    for (int q = 0; q < 4; ++q) {
      float a = __uint_as_float(wv[q] << 16), b = __uint_as_float(wv[q] & 0xffff0000u);
      ss += a * a + b * b;
    }
  }
  ss += __shfl_xor(ss, 1);
  if (half == 0) s_rs[row] = rsqrtf(ss / (float)K + EPS);
}

template <int MODE> DI void scan_seg(const Params& p, int l, int seq, int blk, int d, int seg, char* smem);
DI void phase_qkv(const Params& p, int l, char* smem) {
  float* s_rs = (float*)(smem + 65536);
  constexpr int NQ = 288 * 6, NKV = 304 * 8, NS1 = 2048;
  for (int base = 0; base < NS1 + NQ + NKV; base += gridDim.x) {
    const int tile0 = xcd_map(base);
    if (tile0 >= NS1 + NQ + NKV) continue;
    if (tile0 < NS1) {
      scan_seg<0>(p, l, 16 + (tile0 >> 8), (tile0 >> 5) & 7, (tile0 >> 4) & 1, tile0 & 15, smem);
#if PROBE == 4
      scan_seg<0>(p, l, 16 + (tile0 >> 8), (tile0 >> 5) & 7, (tile0 >> 4) & 1, tile0 & 15, smem);
#endif
      continue;
    }
    const int tile = tile0 - NS1;
    f32x4 acc[4][4];
    zero_acc(acc);
    if (tile < NQ) {
      const int mt = tile / 6, nt = tile % 6;
      const TokTile tt = tok_tile(mt);
      const u16* A = wsp<u16>(p, O_CQ) + (size_t)tt.g0 * 384;
      row_scales(A, 384, s_rs);
      gemm_tile(A, 384, wsw(p, l, O_WUQ) + (size_t)nt * 128 * 384, 384, 384, acc, smem);
      LANEVARS
      u16* Q = wsp<u16>(p, O_Q);
#pragma unroll
      for (int i = 0; i < 4; ++i)
#pragma unroll
        for (int e = 0; e < 4; ++e) {
          SB();
          const int r = wr * 64 + i * 16 + g4 * 4 + e;
          const int pos = tt.p0 + r, g = tt.g0 + r;
          const float rs = s_rs[r];
          float v0 = acc[i][0][e] * rs, v1 = acc[i][1][e] * rs, v2 = acc[i][2][e] * rs, v3 = acc[i][3][e] * rs;
          if (nt >= 4 && !tt.is_ctx) {
            const int pv = (c16 >= 8) ? (pos & 63) : (pos >> 6);
            const float cs = TAB_M[(pv * 8 + (c16 & 7)) * 2], sn = TAB_M[(pv * 8 + (c16 & 7)) * 2 + 1];
            float a0 = v0 * cs - v1 * sn, a1 = v1 * cs + v0 * sn;
            float a2 = v2 * cs - v3 * sn, a3 = v3 * cs + v2 * sn;
            v0 = a0; v1 = a1; v2 = a2; v3 = a3;
          }
          u16* d = Q + (size_t)g * 768 + nt * 128 + wc * 64 + c16;
          d[0] = f2bf(v0); d[16] = f2bf(v1); d[32] = f2bf(v2); d[48] = f2bf(v3);
        }
    } else {
      const int t2 = tile - NQ;
      const int mt = t2 >> 3, hd = t2 & 7;
      const u16* A; const u16* Wt; int is_ctx, seq, kp0;
      if (mt < 288) {
        const TokTile tt = tok_tile(mt);
        A = wsp<u16>(p, O_CKV) + (size_t)tt.g0 * 256;
        Wt = wsw(p, l, O_WUKVG);
        row_scales(A, 256, s_rs);
        is_ctx = tt.is_ctx; seq = tt.b; kp0 = tt.is_ctx ? tt.p0 : 256 + tt.p0;
        if (tt.is_ctx && hd == 0) {
          __syncthreads();
          const float* gkv = p.kv_norm + l * 256;
          for (int idx = tid(); idx < 128 * 256; idx += 256) {
            const int r = idx >> 8, k = idx & 255;
            p.out[OUT_CKV + (((size_t)tt.b * 4 + l) * 256 + tt.p0 + r) * 256 + k] = bf2f(A[(size_t)r * 256 + k]) * s_rs[r] * gkv[k];
          }
        }
      } else {
        const int row0 = (mt - 288) * 128;
        A = wsp<u16>(p, O_CKVC) + (size_t)row0 * 256;
        Wt = wsw(p, l, O_WUKVR);
        { const int t1 = tid(); if (t1 < 128) s_rs[t1] = 1.f; }
        is_ctx = 0; seq = row0 >> 8; kp0 = row0 & 255;
      }
      gemm_tile(A, 256, Wt + (size_t)hd * 128 * 256, 256, 256, acc, smem);
      LANEVARS
      const int Lk = is_ctx ? 256 : LK_LAT;
      if (wc == 0) {
        u16* Kn = (is_ctx ? wsp<u16>(p, O_KNC) : wsp<u16>(p, O_KNL)) + ((size_t)seq * 8 + hd) * Lk * 64;
#pragma unroll
        for (int i = 0; i < 4; ++i)
#pragma unroll
          for (int j = 0; j < 4; ++j)
#pragma unroll
            for (int e = 0; e < 4; ++e) {
              const int r = wr * 64 + i * 16 + g4 * 4 + e;
              Kn[(size_t)(kp0 + r) * 64 + j * 16 + c16] = f2bf(acc[i][j][e] * s_rs[r]);
              if (e == 3) SB();
            }
      } else {
        u16* Vt = (is_ctx ? wsp<u16>(p, O_VTC) : wsp<u16>(p, O_VTL)) + ((size_t)seq * 8 + hd) * 64 * Lk;
#pragma unroll
        for (int i = 0; i < 4; ++i)
#pragma unroll
          for (int j = 0; j < 4; ++j) {
            SB();
            const int r = wr * 64 + i * 16 + g4 * 4;
            uint2 o;
            o.x = pack2(acc[i][j][0] * s_rs[r], acc[i][j][1] * s_rs[r + 1]);
            o.y = pack2(acc[i][j][2] * s_rs[r + 2], acc[i][j][3] * s_rs[r + 3]);
            *(uint2*)(Vt + (size_t)(j * 16 + c16) * Lk + kp0 + r) = o;
          }
      }
    }
    __syncthreads();
  }
}

template <int NS> DI void attn_gload(const int t, const u16* k0, int k0s, const u16* k1, const u16* vt, int vts,
                                     uint4& rk0, uint4& rk1, uint4& rk2, uint4& rv0, uint4& rv1) {
  if (NS == 6) {
    { const int c = t, key = c / 12, ch = c % 12;
      rk0 = (ch < 8) ? *(const uint4*)(k0 + (size_t)key * k0s + ch * 8) : *(const uint4*)(k1 + (size_t)key * 32 + (ch - 8) * 8); }
    { const int c = t + 256, key = c / 12, ch = c % 12;
      rk1 = (ch < 8) ? *(const uint4*)(k0 + (size_t)key * k0s + ch * 8) : *(const uint4*)(k1 + (size_t)key * 32 + (ch - 8) * 8); }
    { const int c = t + 512, key = c / 12, ch = c % 12;
      rk2 = (ch < 8) ? *(const uint4*)(k0 + (size_t)key * k0s + ch * 8) : *(const uint4*)(k1 + (size_t)key * 32 + (ch - 8) * 8); }
  } else {
    { const int c = t, key = c >> 3, ch = c & 7; rk0 = *(const uint4*)(k0 + (size_t)key * k0s + ch * 8); }
    { const int c = t + 256, key = c >> 3, ch = c & 7; rk1 = *(const uint4*)(k0 + (size_t)key * k0s + ch * 8); }
  }
  { const int c = t, dv = c >> 3, ch = c & 7; rv0 = *(const uint4*)(vt + (size_t)dv * vts + ch * 8); }
  { const int c = t + 256, dv = c >> 3, ch = c & 7; rv1 = *(const uint4*)(vt + (size_t)dv * vts + ch * 8); }
}
template <int NS> DI void attn_sstore(const int t, char* smem, const uint4& rk0, const uint4& rk1, const uint4& rk2, const uint4& rv0, const uint4& rv1) {
  constexpr int KSTR = (NS == 6) ? 208 : 144;
  if (NS == 6) {
    { const int c = t, key = c / 12, ch = c % 12; *(uint4*)(smem + key * KSTR + ch * 16) = rk0; }
    { const int c = t + 256, key = c / 12, ch = c % 12; *(uint4*)(smem + key * KSTR + ch * 16) = rk1; }
    { const int c = t + 512, key = c / 12, ch = c % 12; *(uint4*)(smem + key * KSTR + ch * 16) = rk2; }
  } else {
    { const int c = t, key = c >> 3, ch = c & 7; *(uint4*)(smem + key * KSTR + ch * 16) = rk0; }
    { const int c = t + 256, key = c >> 3, ch = c & 7; *(uint4*)(smem + key * KSTR + ch * 16) = rk1; }
  }
  { const int c = t, dv = c >> 3, ch = c & 7; char* d = smem + 13312 + dv * 136 + ch * 16;
    *(uint2*)d = uint2{rv0.x, rv0.y}; *(uint2*)(d + 8) = uint2{rv0.z, rv0.w}; }
  { const int c = t + 256, dv = c >> 3, ch = c & 7; char* d = smem + 13312 + dv * 136 + ch * 16;
    *(uint2*)d = uint2{rv1.x, rv1.y}; *(uint2*)(d + 8) = uint2{rv1.z, rv1.w}; }
}

#define PACK8(S, s2) __builtin_bit_cast(bf16x8, uint4{pack2(S[8 * (s2)], S[8 * (s2) + 1]), pack2(S[8 * (s2) + 2], S[8 * (s2) + 3]), \
                                                        pack2(S[8 * (s2) + 4], S[8 * (s2) + 5]), pack2(S[8 * (s2) + 6], S[8 * (s2) + 7])})

template <int NS>
DI void attn_item(const u16* kA, int kAs, const u16* krA, const u16* vtA, int vtAs, int nA, int kposA, int maskA,
                  const u16* kB, int kBs, const u16* vtB, int vtBs, int nB,
                  const u16* qa, const u16* qb, float sc2, float m0, float l0, int qpos, u16* yrow, char* smem) {
  constexpr int KSTR = (NS == 6) ? 208 : 144;
  const int tt_ = tid();
  const int lane = tt_ & 63;
  const int r32 = lane & 31, hh = lane >> 5;
  bf16x8 qf0, qf1, qf2, qf3, qf4, qf5;
  qf0 = *(const bf16x8*)(qa + 0 + 8 * hh); qf1 = *(const bf16x8*)(qa + 16 + 8 * hh);
  qf2 = *(const bf16x8*)(qa + 32 + 8 * hh); qf3 = *(const bf16x8*)(qa + 48 + 8 * hh);
  if (NS == 6) { qf4 = *(const bf16x8*)(qb + 0 + 8 * hh); qf5 = *(const bf16x8*)(qb + 16 + 8 * hh); }
  else { qf4 = qf0; qf5 = qf0; }
#define QSCALE(qf) { uint4 u_ = __builtin_bit_cast(uint4, qf); \
    u_.x = pack2(__uint_as_float(u_.x << 16) * sc2, __uint_as_float(u_.x & 0xffff0000u) * sc2); \
    u_.y = pack2(__uint_as_float(u_.y << 16) * sc2, __uint_as_float(u_.y & 0xffff0000u) * sc2); \
    u_.z = pack2(__uint_as_float(u_.z << 16) * sc2, __uint_as_float(u_.z & 0xffff0000u) * sc2); \
    u_.w = pack2(__uint_as_float(u_.w << 16) * sc2, __uint_as_float(u_.w & 0xffff0000u) * sc2); \
    qf = __builtin_bit_cast(bf16x8, u_); }
  QSCALE(qf0) QSCALE(qf1) QSCALE(qf2) QSCALE(qf3)
  if (NS == 6) { QSCALE(qf4) QSCALE(qf5) }
#undef QSCALE
  f32x16 O0, O1;
#pragma unroll
  for (int e = 0; e < 16; ++e) { O0[e] = 0.f; O1[e] = 0.f; }
  float m_run = m0, l_run = l0;
  uint4 rk0, rk1, rk2, rv0, rv1;
  rk2 = uint4{0, 0, 0, 0};
  const int ntiles = nA + nB;
#define TILE_GLOAD(jn) { if ((jn) < nA) attn_gload<NS>(tt_, kA + (size_t)(jn) * 64 * kAs, kAs, krA + (size_t)(jn) * 64 * 32, vtA + (jn) * 64, vtAs, rk0, rk1, rk2, rv0, rv1); \
    else { const int jb_ = (jn) - nA; attn_gload<NS>(tt_, kB + (size_t)jb_ * 64 * kBs, kBs, nullptr, vtB + jb_ * 64, vtBs, rk0, rk1, rk2, rv0, rv1); } }
  constexpr int STG = 22528;
  TILE_GLOAD(0)
  attn_sstore<NS>(tt_, smem, rk0, rk1, rk2, rv0, rv1);
  if (ntiles > 1) TILE_GLOAD(1)
  __syncthreads();
  for (int j = 0; j < ntiles; ++j) {
    char* sbase = smem + (j & 1) * STG;
    const int kpos = kposA + 64 * j;
    const bool masked = maskA && (j < nA);
    MB();
    f32x16 S0, S1;
#pragma unroll
    for (int e = 0; e < 16; ++e) { S0[e] = 0.f; S1[e] = 0.f; }
    const char* ka0 = sbase + r32 * KSTR + 16 * hh;
    const char* ka1 = sbase + (32 + r32) * KSTR + 16 * hh;
#define QK_STEP(s, qf) { bf16x8 a0 = *(const bf16x8*)(ka0 + 32 * (s)); bf16x8 a1 = *(const bf16x8*)(ka1 + 32 * (s)); \
      S0 = __builtin_amdgcn_mfma_f32_32x32x16_bf16(a0, qf, S0, 0, 0, 0); S1 = __builtin_amdgcn_mfma_f32_32x32x16_bf16(a1, qf, S1, 0, 0, 0); }
    QK_STEP(0, qf0) QK_STEP(1, qf1) QK_STEP(2, qf2) QK_STEP(3, qf3)
    if (NS == 6) { QK_STEP(4, qf4) QK_STEP(5, qf5) }
    SB();
    float mx = m_run;
#pragma unroll
    for (int e = 0; e < 16; ++e) {
      float v0 = S0[e], v1 = S1[e];
      if (masked) {
        const int kp = kpos + (e & 3) + 8 * (e >> 2) + 4 * hh;
        int d0 = qpos - kp; d0 = d0 < 0 ? -d0 : d0;
        int d1 = qpos - (kp + 32); d1 = d1 < 0 ? -d1 : d1;
        if (d0 > 128) v0 = -1e30f;
        if (d1 > 128) v1 = -1e30f;
      }
      S0[e] = v0; S1[e] = v1;
      mx = fmaxf(mx, fmaxf(v0, v1));
    }
    mx = fmaxf(mx, __shfl_xor(mx, 32));
    const float alpha = __builtin_amdgcn_exp2f(m_run - mx);
    m_run = mx;
    float rsum = 0.f;
#pragma unroll
    for (int e = 0; e < 16; ++e) {
      float p0 = __builtin_amdgcn_exp2f(S0[e] - mx), p1 = __builtin_amdgcn_exp2f(S1[e] - mx);
      S0[e] = p0; S1[e] = p1;
      rsum += p0 + p1;
    }
    rsum += __shfl_xor(rsum, 32);
    l_run = l_run * alpha + rsum;
#pragma unroll
    for (int e = 0; e < 16; ++e) { O0[e] *= alpha; O1[e] *= alpha; }
    const char* sv0 = sbase + 13312 + r32 * 136 + 8 * hh;
    const char* sv1 = sv0 + 32 * 136;
#define PV_STEP(pb, ka) { \
      { uint2 lo = *(const uint2*)(sv0 + (ka) * 2), hi = *(const uint2*)(sv0 + (ka) * 2 + 16); \
        bf16x8 va = __builtin_bit_cast(bf16x8, uint4{lo.x, lo.y, hi.x, hi.y}); O0 = __builtin_amdgcn_mfma_f32_32x32x16_bf16(va, pb, O0, 0, 0, 0); } \
      { uint2 lo = *(const uint2*)(sv1 + (ka) * 2), hi = *(const uint2*)(sv1 + (ka) * 2 + 16); \
        bf16x8 va = __builtin_bit_cast(bf16x8, uint4{lo.x, lo.y, hi.x, hi.y}); O1 = __builtin_amdgcn_mfma_f32_32x32x16_bf16(va, pb, O1, 0, 0, 0); } }
    SB();
    { bf16x8 pb = PACK8(S0, 0); PV_STEP(pb, 0) }
    { bf16x8 pb = PACK8(S0, 1); PV_STEP(pb, 16) }
    SB();
    { bf16x8 pb = PACK8(S1, 0); PV_STEP(pb, 32) }
    { bf16x8 pb = PACK8(S1, 1); PV_STEP(pb, 48) }
    SB();
    if (j + 1 < ntiles) {
      attn_sstore<NS>(tt_, smem + ((j + 1) & 1) * STG, rk0, rk1, rk2, rv0, rv1);
      if (j + 2 < ntiles) TILE_GLOAD(j + 2)
    }
    __syncthreads();
  }
#undef TILE_GLOAD
  const float inv = 1.f / l_run;
#pragma unroll
  for (int e4 = 0; e4 < 4; ++e4) {
    uint2 o;
    o.x = pack2(O0[4 * e4] * inv, O0[4 * e4 + 1] * inv); o.y = pack2(O0[4 * e4 + 2] * inv, O0[4 * e4 + 3] * inv);
    *(uint2*)(yrow + 8 * e4 + 4 * hh) = o;
    o.x = pack2(O1[4 * e4] * inv, O1[4 * e4 + 1] * inv); o.y = pack2(O1[4 * e4 + 2] * inv, O1[4 * e4 + 3] * inv);
    *(uint2*)(yrow + 32 + 8 * e4 + 4 * hh) = o;
  }
}

template <int MODE>
DI void scan_seg(const Params& p, int l, int seq, int blk, int d, int seg, char* smem) {
  const int t = tid(), lane = t & 63, w = t >> 6;
  const int c16 = lane & 15, g4 = lane >> 4;
  const bool is_ctx = seq < 16;
  const int b = is_ctx ? seq : seq - 16;
  const int L = is_ctx ? 256 : 4096;
  const int gbase = is_ctx ? b * 256 : T_CTX + b * 4096;
  const u16* XR = wsp<u16>(p, O_XR);
  u16* Y = wsp<u16>(p, O_YRNN);
  float* SUM = wsp<float>(p, O_SUM);
  char* sXc = smem;
  float* sA = (float*)(smem + 8704);
  float* sU = (float*)(smem + 8704 + 16384);
  const int cch = t & 127, th = t >> 7;
  const int chg = blk * 128 + cch;
  const float w0 = p.conv_w[(l * 4 + 0) * 1024 + chg], w1 = p.conv_w[(l * 4 + 1) * 1024 + chg];
  const float w2 = p.conv_w[(l * 4 + 2) * 1024 + chg], w3 = p.conv_w[(l * 4 + 3) * 1024 + chg];
  const float cb = p.conv_b[l * 1024 + chg];
  bf16x8 bw[4][4];
  {
    const u16* WL = wsw(p, l, O_WLRU) + (size_t)(d * 8 + blk) * 256 * 128 + (size_t)(32 * w + c16) * 128 + g4 * 8;
#pragma unroll
    for (int nf = 0; nf < 4; ++nf)
#pragma unroll
      for (int ks = 0; ks < 4; ++ks)
        bw[nf][ks] = *(const bf16x8*)(WL + (size_t)((nf & 1) * 16 + (nf >> 1) * 128) * 128 + ks * 32);
  }
  float ba[2], bi[2], cl[2];
#pragma unroll
  for (int jn = 0; jn < 2; ++jn) {
    const int ch = (l * 2 + d) * 1024 + blk * 128 + 32 * w + 16 * jn + c16;
    ba[jn] = p.lru_ba[ch]; bi[jn] = p.lru_bi[ch];
    cl[jn] = -8.f * log1pf(__expf(-p.lru_lam[ch]));
  }
  float h = 0.f, P = 1.f;
  if (MODE == 1 && !is_ctx && t < 128) {
    h = p.state[(((size_t)b * 4 + l) * 2 + d) * 1024 + blk * 128 + t];
    const float* sm = SUM + ((size_t)((b * 8 + blk) * 2 + d) * 16) * 256 + t;
    float Pv[16], Hv[16];
#pragma unroll
    for (int s2 = 0; s2 < 16; ++s2) { Pv[s2] = sm[s2 * 256]; Hv[s2] = sm[s2 * 256 + 128]; }
    if (d == 0) {
#pragma unroll
      for (int s2 = 0; s2 < 16; ++s2) if (s2 < seg) h = Pv[s2] * h + Hv[s2];
    } else {
#pragma unroll
      for (int s2 = 15; s2 >= 0; --s2) if (s2 > seg) h = Pv[s2] * h + Hv[s2];
    }
  }
#define X19(F) F(0) F(1) F(2) F(3) F(4) F(5) F(6) F(7) F(8) F(9) F(10) F(11) F(12) F(13) F(14) F(15) F(16) F(17) F(18)
#define XDECL(q) u16 xr##q = 0;
#define XLOAD(q) { const int pos = tcn + th * 16 - 1 + (q); xr##q = (pos >= 0 && pos < L) ? XR[(size_t)(gbase + pos) * 1024 + chg] : (u16)0; }
#define XCVT(q) xv[q] = bf2f(xr##q);
  X19(XDECL)
  { const int tcn = seg * 256 + (d == 0 ? 0 : 7) * 32; X19(XLOAD) }
  for (int ci = 0; ci < 8; ++ci) {
    const int tc0 = seg * 256 + (d == 0 ? ci : 7 - ci) * 32;
    {
      float xv[19];
      X19(XCVT)
#pragma unroll
      for (int q = 0; q < 16; ++q) {
        float xc = cb + w0 * xv[q] + w1 * xv[q + 1] + w2 * xv[q + 2] + w3 * xv[q + 3];
        *(u16*)(sXc + (th * 16 + q) * 272 + cch * 2) = f2bf(xc);
      }
    }
    unsigned yold0 = 0, yold1 = 0, yold2 = 0, yold3 = 0, yold4 = 0, yold5 = 0, yold6 = 0, yold7 = 0;
    {
      const int cn = ci < 7 ? ci + 1 : ci;
      const int tcn = seg * 256 + (d == 0 ? cn : 7 - cn) * 32;
      X19(XLOAD)
      if (MODE == 1 && d == 1) {
        const unsigned* yb = (const unsigned*)(Y + (size_t)(gbase + tc0 + (t >> 6)) * 1024 + blk * 128 + (t & 63) * 2);
        yold0 = yb[0]; yold1 = yb[4 * 512]; yold2 = yb[8 * 512]; yold3 = yb[12 * 512];
        yold4 = yb[16 * 512]; yold5 = yb[20 * 512]; yold6 = yb[24 * 512]; yold7 = yb[28 * 512];
      }
    }
    MB();
    __syncthreads();
    f32x4 aR[2][2], aI[2][2];
#pragma unroll
    for (int im = 0; im < 2; ++im)
#pragma unroll
      for (int jn = 0; jn < 2; ++jn) { aR[im][jn] = f32x4{0.f, 0.f, 0.f, 0.f}; aI[im][jn] = f32x4{0.f, 0.f, 0.f, 0.f}; }
#pragma unroll
    for (int ks = 0; ks < 4; ++ks)
#pragma unroll
      for (int im = 0; im < 2; ++im) {
        bf16x8 af = *(const bf16x8*)(sXc + (16 * im + c16) * 272 + (ks * 32 + g4 * 8) * 2);
#pragma unroll
        for (int jn = 0; jn < 2; ++jn) {
          aR[im][jn] = __builtin_amdgcn_mfma_f32_16x16x32_bf16(af, bw[jn][ks], aR[im][jn], 0, 0, 0);
          aI[im][jn] = __builtin_amdgcn_mfma_f32_16x16x32_bf16(af, bw[2 + jn][ks], aI[im][jn], 0, 0, 0);
        }
      }
#pragma unroll
    for (int im = 0; im < 2; ++im)
#pragma unroll
      for (int jn = 0; jn < 2; ++jn)
#pragma unroll
        for (int e = 0; e < 4; ++e) {
          const int tt = 16 * im + 4 * g4 + e, c = 32 * w + 16 * jn + c16;
          const float r = sigmoidf_(aR[im][jn][e] + ba[jn]);
          const float ig = sigmoidf_(aI[im][jn][e] + bi[jn]);
          const float a = __expf(cl[jn] * r);
          const float xc = bf2f(*(const u16*)(sXc + tt * 272 + c * 2));
          const float u = __builtin_amdgcn_sqrtf(fmaxf(1.f - a * a, 0.f)) * ig * xc;
          sA[tt * 128 + c] = a; sU[tt * 128 + c] = u;
        }
    __syncthreads();
    if (t < 128) {
      if (d == 0) {
#pragma unroll 8
        for (int s = 0; s < 32; ++s) {
          const float a = sA[s * 128 + t];
          h = a * h + sU[s * 128 + t];
          if (MODE == 0) P *= a; else sU[s * 128 + t] = h;
        }
      } else {
#pragma unroll 8
        for (int s = 31; s >= 0; --s) {
          const float a = sA[s * 128 + t];
          h = a * h + sU[s * 128 + t];
          if (MODE == 0) P *= a; else sU[s * 128 + t] = h;
        }
      }
    }
    __syncthreads();
    if (MODE == 1) {
      const int c2 = (t & 63) * 2;
      unsigned* yb = (unsigned*)(Y + (size_t)(gbase + tc0 + (t >> 6)) * 1024 + blk * 128 + c2);
      const float* su = sU + (t >> 6) * 128 + c2;
#define YOUT(i, yo) { float h0 = su[(4 * (i)) * 128], h1 = su[(4 * (i)) * 128 + 1]; \
        if (d == 1) { h0 += __uint_as_float((yo) << 16); h1 += __uint_as_float((yo) & 0xffff0000u); } \
        yb[(size_t)(4 * (i)) * 512] = pack2(h0, h1); }
      YOUT(0, yold0) YOUT(1, yold1) YOUT(2, yold2) YOUT(3, yold3) YOUT(4, yold4) YOUT(5, yold5) YOUT(6, yold6) YOUT(7, yold7)
#undef YOUT
    }
  }
#undef X19
#undef XDECL
#undef XLOAD
#undef XCVT
  if (MODE == 0) {
    if (t < 128) {
      float* sm = SUM + ((size_t)(((b * 8 + blk) * 2 + d) * 16 + seg)) * 256 + t;
      sm[0] = P; sm[128] = h;
    }
  } else if (is_ctx && t < 128) {
    p.out[OUT_RG + (((size_t)b * 4 + l) * 2 + d) * 1024 + blk * 128 + t] = h;
  }
  __syncthreads();
}

DI void phase_mix(const Params& p, int l, char* smem) {
  constexpr float LOG2E = 1.4426950408889634f;
  constexpr int N0 = 1024, N1 = N0 + 2048, N2 = N1 + 2048, N3 = N2 + 128, N4 = N3 + 256, N5 = N4 + 256;
  for (int base = 0; base < N5; base += gridDim.x) {
    const int vit = xcd_map(base);
    if (vit >= N5) continue;
    const int it = vit < N0 ? vit : (vit < N0 + 128 ? N2 + (vit - N0) : (vit < N3 ? vit - 128 : vit));
    const int t = tid(), lane = t & 63, w = t >> 6;
    const int r32 = lane & 31;
    if (it < N0 || (it >= N2 && it < N3)) {
      int seq, blk, seg;
      if (it < N0) { seg = it & 15; blk = (it >> 4) & 7; seq = 16 + (it >> 7); }
      else { const int i = it - N2; seg = 0; blk = i & 7; seq = i >> 3; }
      scan_seg<1>(p, l, seq, blk, 0, seg, smem);
      scan_seg<1>(p, l, seq, blk, 1, seg, smem);
#if PROBE == 4
      scan_seg<1>(p, l, seq, blk, 0, seg, smem);
      scan_seg<1>(p, l, seq, blk, 1, seg, smem);
#endif
    } else if (it < N1 || (it >= N3 && it < N4)) {
      const bool lat = it < N1;
      int b, h, qb;
      if (lat) { const int i = it - N0; qb = i & 31; h = (i >> 5) & 7; b = i >> 8; }
      else { const int i = it - N3; qb = i & 1; h = (i >> 1) & 7; b = i >> 4; }
      const int Lk = lat ? LK_LAT : 256;
      const int gq = (lat ? T_CTX + b * 4096 : b * 256) + qb * 128 + w * 32 + r32;
      const u16* Kn = (lat ? wsp<u16>(p, O_KNL) : wsp<u16>(p, O_KNC)) + ((size_t)b * 8 + h) * Lk * 64;
      const u16* Kr = (lat ? wsp<u16>(p, O_KRL) : wsp<u16>(p, O_KRC)) + (size_t)b * Lk * 32;
      const u16* Vt = (lat ? wsp<u16>(p, O_VTL) : wsp<u16>(p, O_VTC)) + ((size_t)b * 8 + h) * 64 * Lk;
      const u16* Q = wsp<u16>(p, O_Q) + (size_t)gq * 768;
      u16* yrow = wsp<u16>(p, O_CQ) + (size_t)gq * 512 + h * 64;
      attn_item<6>(Kn, 64, Kr, Vt, Lk, Lk >> 6, 0, 0, nullptr, 0, nullptr, 0, 0,
                   Q + h * 64, Q + 512 + h * 32, 0.10206207261596577f * LOG2E, -1e30f, 0.f, 0, yrow, smem);
#if PROBE == 5
      __syncthreads();
      attn_item<6>(Kn, 64, Kr, Vt, Lk, Lk >> 6, 0, 0, nullptr, 0, nullptr, 0, 0,
                   Q + h * 64, Q + 512 + h * 32, 0.10206207261596577f * LOG2E, -1e30f, 0.f, 0, yrow, smem);
#endif
    } else {
      const bool lat = it < N2;
      int b, h, qb;
      if (lat) { const int i = it - N1; qb = i & 31; h = (i >> 5) & 7; b = i >> 8; }
      else { const int i = it - N4; qb = i & 1; h = (i >> 1) & 7; b = i >> 4; }
      const int kvh = h >> 2;
      const int gseq = lat ? T_CTX + b * 4096 : b * 256;
      const int qpos = qb * 128 + w * 32 + r32;
      const int gq = gseq + qpos;
      u16* qrow = wsp<u16>(p, O_QS) + (size_t)gq * 512 + h * 64;
      const float sink2 = p.sink[l * 8 + h] * LOG2E;
      const int t0 = qb * 128;
      int jlo = 0, jhi = 6;
      if (t0 == 0) jlo = 2;
      if (t0 + 128 >= 4096) jhi = 4;
      const int ks0 = lat ? t0 - 128 + 64 * jlo : 0;
      const int nA = lat ? jhi - jlo : 4;
      const u16* KS = wsp<u16>(p, O_KS) + (size_t)(gseq + ks0) * 128 + kvh * 64;
      const u16* VT = lat ? wsp<u16>(p, O_VTSL) + ((size_t)b * 2 + kvh) * 64 * 4096 + ks0
                          : wsp<u16>(p, O_VTSC) + ((size_t)b * 2 + kvh) * 64 * 256;
      const u16* KC = wsp<u16>(p, O_KSC) + (size_t)b * 256 * 128 + kvh * 64;
      const u16* VC = wsp<u16>(p, O_VTSCC) + ((size_t)b * 2 + kvh) * 64 * 256;
      attn_item<4>(KS, 128, nullptr, VT, lat ? 4096 : 256, nA, ks0, lat ? 1 : 0, KC, 128, VC, 256, lat ? 4 : 0,
                   qrow, nullptr, 0.125f * LOG2E, sink2, 1.f, qpos, qrow, smem);
    }
    __syncthreads();
  }
}

DI void phase_gate(const Params& p, int l, char* smem) {
  const u16* H = wsp<u16>(p, O_H);
  const u16* W = wsw(p, l, O_WINB);
  for (int base = 0; base < 288 * 40; base += gridDim.x) {
    const int tile = xcd_map(base);
    if (tile >= 288 * 40) continue;
    const int sb = tile >> 6, jj = tile & 63;
    const int mt = (sb / 5) * 8 + (jj >> 3), nt = (sb % 5) * 8 + (jj & 7);
    const int g0 = mt * 128;
    f32x4 acc[4][4];
    zero_acc(acc);
    gemm_tile(H + (size_t)g0 * 1024, 1024, W + (size_t)nt * 128 * 1024, 1024, 1024, acc, smem);
    LANEVARS
    if (nt < 16) {
      u16* dst; int ld, cb;
      if (nt < 8) { dst = wsp<u16>(p, O_YRNN); ld = 1024; cb = nt * 128; }
      else if (nt < 12) { dst = wsp<u16>(p, O_CQ); ld = 512; cb = (nt - 8) * 128; }
      else { dst = wsp<u16>(p, O_QS); ld = 512; cb = (nt - 12) * 128; }
#pragma unroll
      for (int i = 0; i < 4; ++i)
#pragma unroll
        for (int j = 0; j < 4; ++j)
#pragma unroll
          for (int e = 0; e < 4; ++e) {
            const int g = g0 + wr * 64 + i * 16 + g4 * 4 + e;
            u16* d = dst + (size_t)g * ld + cb + wc * 64 + j * 16 + c16;
            const float gv = acc[i][j][e];
            *d = f2bf(bf2f(*d) * gv * sigmoidf_(gv));
            if (e == 3) SB();
          }
    } else {
      const int br = (nt - 16) >> 3, cb = ((nt - 16) & 7) * 128;
      u16* dst = br == 0 ? wsp<u16>(p, O_XR) : wsp<u16>(p, O_KS) + (size_t)(br - 1) * T_ALL * 1024;
#pragma unroll
      for (int i = 0; i < 4; ++i)
#pragma unroll
        for (int j = 0; j < 4; ++j)
#pragma unroll
          for (int e = 0; e < 4; ++e) {
            const int g = g0 + wr * 64 + i * 16 + g4 * 4 + e;
            dst[(size_t)g * 1024 + cb + wc * 64 + j * 16 + c16] = f2bf(sigmoidf_(acc[i][j][e]));
            if (e == 3) SB();
          }
    }
  }
}

DI void phase_merge(const Params& p, int l, char* smem) {
  u16* U = wsp<u16>(p, O_H);
  for (int base = 0; base < 288 * 8; base += gridDim.x) {
    const int tile = xcd_map(base);
    if (tile >= 288 * 8) continue;
    const int mt = tile >> 3, nt = tile & 7;
    const int g0 = mt * 128;
    f32x4 u[4][4];
    zero_acc(u);
    for (int br = 0; br < 3; ++br) {
      f32x4 acc[4][4];
      zero_acc(acc);
      const u16* Z; const u16* WT; int kz; const u16* M;
      if (br == 0) { Z = wsp<u16>(p, O_YRNN) + (size_t)g0 * 1024; WT = wsw(p, l, O_WBRR) + (size_t)nt * 128 * 1024; kz = 1024; M = wsp<u16>(p, O_XR); }
      else if (br == 1) { Z = wsp<u16>(p, O_CQ) + (size_t)g0 * 512; WT = wsw(p, l, O_WBRM) + (size_t)nt * 128 * 512; kz = 512; M = wsp<u16>(p, O_KS); }
      else { Z = wsp<u16>(p, O_QS) + (size_t)g0 * 512; WT = wsw(p, l, O_WBRS) + (size_t)nt * 128 * 512; kz = 512; M = wsp<u16>(p, O_KS) + (size_t)T_ALL * 1024; }
      gemm_tile(Z, kz, WT, kz, kz, acc, smem);
      LANEVARS
#pragma unroll
      for (int i = 0; i < 4; ++i)
#pragma unroll
        for (int j = 0; j < 4; ++j)
#pragma unroll
          for (int e = 0; e < 4; ++e) {
            const int g = g0 + wr * 64 + i * 16 + g4 * 4 + e;
            u[i][j][e] += bf2f(M[(size_t)g * 1024 + nt * 128 + wc * 64 + j * 16 + c16]) * acc[i][j][e];
            if (e == 3) SB();
          }
    }
    LANEVARS
#pragma unroll
    for (int i = 0; i < 4; ++i)
#pragma unroll
      for (int j = 0; j < 4; ++j)
#pragma unroll
        for (int e = 0; e < 4; ++e) {
          const int g = g0 + wr * 64 + i * 16 + g4 * 4 + e;
          U[(size_t)g * 1024 + nt * 128 + wc * 64 + j * 16 + c16] = f2bf(u[i][j][e]);
        }
  }
}

DI void phase_out(const Params& p, int l, char* smem) {
  const u16* U = wsp<u16>(p, O_H);
  const u16* W = wsw(p, l, O_WOUT);
  const float* MOD = wsp<float>(p, O_MOD) + (size_t)l * 9 * 3072;
  for (int base = 0; base < 288 * 8; base += gridDim.x) {
    const int tile = xcd_map(base);
    if (tile >= 288 * 8) continue;
    const int mt = tile >> 3, nt = tile & 7;
    const int g0 = mt * 128;
    const int ci = g0 < T_CTX ? 8 : ((g0 - T_CTX) >> 12);
    f32x4 acc[4][4];
    zero_acc(acc);
    gemm_tile(U + (size_t)g0 * 1024, 1024, W + (size_t)nt * 128 * 1024, 1024, 1024, acc, smem);
    LANEVARS
#pragma unroll
    for (int j = 0; j < 4; ++j) {
      const int col = nt * 128 + wc * 64 + j * 16 + c16;
      const float gt = MOD[ci * 3072 + 2048 + col];
#pragma unroll
      for (int i = 0; i < 4; ++i)
#pragma unroll
        for (int e = 0; e < 4; ++e) {
          const int g = g0 + wr * 64 + i * 16 + g4 * 4 + e;
          const float xo = xin_row(p, l, g)[col];
          p.out[(size_t)g * 1024 + col] = xo + gt * acc[i][j][e];
          if (e == 3) SB();
        }
    }
  }
}

DI void phase_final(const Params& p) {
  const int t = tid(), lane = t & 63, w = t >> 6;
  for (int row = blockIdx.x * 4 + w; row < T_ALL; row += gridDim.x * 4) {
    float* x = p.out + (size_t)row * 1024;
    float4 v[4];
    float ss = 0.f;
#pragma unroll
    for (int i = 0; i < 4; ++i) {
      v[i] = *(const float4*)(x + i * 256 + lane * 4);
      ss += v[i].x * v[i].x + v[i].y * v[i].y + v[i].z * v[i].z + v[i].w * v[i].w;
    }
    ss = wave_sum(ss);
    const float rs = rsqrtf(ss * (1.f / 1024.f) + EPS);
#pragma unroll
    for (int i = 0; i < 4; ++i) {
      const int c = i * 256 + lane * 4;
      const float4 g = *(const float4*)(p.final_norm + c);
      float4 o = {v[i].x * rs * g.x, v[i].y * rs * g.y, v[i].z * rs * g.z, v[i].w * rs * g.w};
      *(float4*)(x + c) = o;
    }
  }
}

constexpr int NPHASE_PER_LAYER = 7;
DI void run_phase(const Params& p, int ph, char* smem) {
  if (ph == 0) { phase_mod(p, smem); return; }
  if (ph == 1 + NLAYER * NPHASE_PER_LAYER) { phase_final(p); return; }
  const int l = (ph - 1) / NPHASE_PER_LAYER, s = (ph - 1) % NPHASE_PER_LAYER;
  switch (s) {
    case 0: phase_prep(p, l); break;
    case 1: phase_gemmA(p, l, smem); break;
    case 2: phase_qkv(p, l, smem); break;
    case 3: phase_mix(p, l, smem); break;
    case 4: phase_gate(p, l, smem); break;
    case 5: phase_merge(p, l, smem); break;
    default: phase_out(p, l, smem); break;
  }
}
constexpr int NPHASE = 2 + NLAYER * NPHASE_PER_LAYER;

#if MEGA
DI Params launder(const Params& p) {
  size_t z = 0;
  asm volatile("" : "+s"(z));
  Params q = p; q.ws = p.ws + z; q.out = p.out + z;
  return q;
}
struct XBar { unsigned* base; unsigned xcc; unsigned nloc; unsigned nx; };
#define XB_CENSUS(j) (64 * (j))
#define XB_XSUB(j) (1024 + 64 * (j))
#define XB_XGEN(j) (2048 + 64 * (j))
#define XB_TOP 3072
#define XB_TOPGEN 3136
DI unsigned xb_ld(unsigned* p) { return __hip_atomic_load(p, __ATOMIC_RELAXED, __HIP_MEMORY_SCOPE_AGENT); }
DI unsigned xb_add(unsigned* p, unsigned v) { return __hip_atomic_fetch_add(p, v, __ATOMIC_RELAXED, __HIP_MEMORY_SCOPE_AGENT); }
DI void xbar_post(XBar& xb, unsigned* base) {
  xb.base = base; xb.nloc = 0; xb.nx = 0;
  xb.xcc = (unsigned)__builtin_amdgcn_s_getreg((3 << 11) | 20) & 0xFu;
  if (threadIdx.x == 0) xb_add(&base[XB_CENSUS(xb.xcc)], 1u);
}
DI void xbar_census(XBar& xb) {
  if (threadIdx.x == 0) {
    unsigned nx = 0;
    for (int j = 0; j < 16; ++j) nx += xb_ld(&xb.base[XB_CENSUS(j)]) ? 1u : 0u;
    xb.nx = nx; xb.nloc = xb_ld(&xb.base[XB_CENSUS(xb.xcc)]);
  }
}
DI void xbar_sync(const XBar& xb) {
  asm volatile("s_waitcnt vmcnt(0)" ::: "memory");
  __syncthreads();
  if (threadIdx.x == 0) {
    unsigned* bar = xb.base;
    const unsigned old = xb_add(&bar[XB_XSUB(xb.xcc)], 1u);
    const unsigned gen = old / xb.nloc;
    if (old + 1u == (gen + 1u) * xb.nloc) {
      __builtin_amdgcn_fence(__ATOMIC_RELEASE, "agent");
      asm volatile("s_waitcnt vmcnt(0)" ::: "memory");
      const unsigned og = xb_add(&bar[XB_TOP], 1u);
      const unsigned tg = og / xb.nx;
      if (og + 1u == (tg + 1u) * xb.nx) xb_add(&bar[XB_TOPGEN], 1u);
      else { unsigned sp = 0; while (xb_ld(&bar[XB_TOPGEN]) == tg) { __builtin_amdgcn_s_sleep(1); if (++sp > (1u << 22)) break; } }
      __builtin_amdgcn_fence(__ATOMIC_ACQUIRE, "agent");
      xb_add(&bar[XB_XGEN(xb.xcc)], 1u);
      asm volatile("s_waitcnt vmcnt(0)" ::: "memory");
    } else {
      unsigned sp = 0;
      while (xb_ld(&bar[XB_XGEN(xb.xcc)]) == gen) { __builtin_amdgcn_s_sleep(1); if (++sp > (1u << 22)) break; }
      __builtin_amdgcn_fence(__ATOMIC_ACQUIRE, "agent");
      asm volatile("s_waitcnt vmcnt(0)" ::: "memory");
    }
  }
  __syncthreads();
}
#define GSYNC() xbar_sync(xb)
__global__ void __launch_bounds__(256, 2) mega_kernel(Params p) {
  __shared__ __attribute__((aligned(16))) char smem[66048];
  cg::grid_group grid = cg::this_grid();
  XBar xb;
  xbar_post(xb, (unsigned*)(p.ws + O_BAR));
  phase_mod(launder(p), smem);
  convert_weights(launder(p), 0);
  grid.sync();
  xbar_census(xb);
  for (int l = 0; l < NLAYER; ++l) {
    phase_prep(launder(p), l);
    GSYNC();
#if PROBE == 1
    phase_prep(launder(p), l);
    GSYNC();
#endif
    phase_gemmA(launder(p), l, smem);
    GSYNC();
#if PROBE == 2
    phase_gemmA(launder(p), l, smem);
    GSYNC();
#endif
    phase_qkv(launder(p), l, smem);
    GSYNC();
    phase_mix(launder(p), l, smem);
    if (l + 1 < NLAYER) convert_weights(launder(p), l + 1);
    GSYNC();
    phase_gate(launder(p), l, smem);
    GSYNC();
    phase_merge(launder(p), l, smem);
    GSYNC();
#if PROBE == 3
    phase_merge(launder(p), l, smem);
    GSYNC();
#endif
    phase_out(launder(p), l, smem);
    GSYNC();
  }
  phase_final(launder(p));
}

#else
__global__ void __launch_bounds__(256, 2) phase_kernel(Params p, int ph) {
  __shared__ __attribute__((aligned(16))) char smem[66048];
  run_phase(p, ph, smem);
}

#endif
extern "C" void kernel_launch(void* const* d_in, const int* in_sizes, int n_in, void* d_out, int out_size, void* d_ws,
                              size_t ws_size, hipStream_t stream) {
  Params p{};
  const float** pp = (const float**)&p;
  for (int i = 0; i < 30; ++i) pp[i] = (const float*)d_in[i];
  p.out = (float*)d_out;
  p.ws = (char*)d_ws;
  if (ws_size < WS_NEED) fprintf(stderr, "workspace too small: %zu < %zu\n", ws_size, (size_t)WS_NEED);
#if MEGA
  static int grid_blocks = 0;
  if (!grid_blocks) {
    int dev = 0, cus = 0, per_cu = 0;
    hipGetDevice(&dev);
    hipDeviceGetAttribute(&cus, hipDeviceAttributeMultiprocessorCount, dev);
    hipOccupancyMaxActiveBlocksPerMultiprocessor(&per_cu, mega_kernel, 256, 0);
    if (per_cu > 2) per_cu = 2;
    grid_blocks = cus * per_cu;
  }
  (void)hipMemsetAsync((char*)d_ws + O_BAR, 0, BAR_BYTES, stream);
  void* args[] = {&p};
  hipError_t e = hipLaunchCooperativeKernel((void*)mega_kernel, dim3(grid_blocks), dim3(256), args, 0, stream);
  if (e != hipSuccess) fprintf(stderr, "cooperative launch failed: %s (grid %d)\n", hipGetErrorString(e), grid_blocks);
#else
  for (int ph = 0; ph < NPHASE; ++ph) phase_kernel<<<512, 256, 0, stream>>>(p, ph);
#endif
}
```

```cpp
#include <hip/hip_runtime.h>
#include <hip/hip_cooperative_groups.h>
#include <cstdio>
#include <cstdint>
namespace cg = cooperative_groups;

#ifndef PROBE
#define PROBE 0
#endif
#ifndef MEGA
#define MEGA 1
#endif

typedef unsigned short u16;
using bf16x8 = __attribute__((ext_vector_type(8))) short;
using f32x4 = __attribute__((ext_vector_type(4))) float;
using f32x16 = __attribute__((ext_vector_type(16))) float;
typedef __bf16 bf2_t __attribute__((ext_vector_type(2)));
typedef float f2_t __attribute__((ext_vector_type(2)));
#define DI __device__ __forceinline__

__device__ const float TAB_M[1024] = {
  1.00000000e+00f, 0.00000000e+00f, 1.00000000e+00f, 0.00000000e+00f, 1.00000000e+00f, 0.00000000e+00f, 1.00000000e+00f, 0.00000000e+00f,
  1.00000000e+00f, 0.00000000e+00f, 1.00000000e+00f, 0.00000000e+00f, 1.00000000e+00f, 0.00000000e+00f, 1.00000000e+00f, 0.00000000e+00f,
  5.40302277e-01f, 8.41470957e-01f, 9.50415254e-01f, 3.10983598e-01f, 9.95004177e-01f, 9.98334214e-02f, 9.99500036e-01f, 3.16175036e-02f,
  9.99949992e-01f, 9.99983307e-03f, 9.99994993e-01f, 3.16227227e-03f, 9.99999523e-01f, 9.99999931e-04f, 9.99999940e-01f, 3.16227757e-04f,
  -4.16146845e-01f, 9.09297407e-01f, 8.06578398e-01f, 5.91127098e-01f, 9.80066597e-01f, 1.98669329e-01f, 9.98000681e-01f, 6.32033944e-02f,
  9.99800026e-01f, 1.99986659e-02f, 9.99979973e-01f, 6.32451288e-03f, 9.99997973e-01f, 1.99999870e-03f, 9.99999821e-01f, 6.32455456e-04f,
  -9.89992499e-01f, 1.41120002e-01f, 5.82753658e-01f, 8.12648892e-01f, 9.55336511e-01f, 2.95520216e-01f, 9.95503366e-01f, 9.47260857e-02f,
  9.99550045e-01f, 2.99954992e-02f, 9.99954998e-01f, 9.48669016e-03f, 9.99995530e-01f, 2.99999560e-03f, 9.99999523e-01f, 9.48683126e-04f,
  -6.53643608e-01f, -7.56802499e-01f, 3.01137477e-01f, 9.53580737e-01f, 9.21060979e-01f, 3.89418334e-01f, 9.92010653e-01f, 1.26154065e-01f,
  9.99200106e-01f, 3.99893336e-02f, 9.99920011e-01f, 1.26487734e-02f, 9.99992013e-01f, 3.99998948e-03f, 9.99999225e-01f, 1.26491068e-03f,
  2.83662200e-01f, -9.58924294e-01f, -1.03423381e-02f, 9.99946535e-01f, 8.77582550e-01f, 4.79425550e-01f, 9.87526000e-01f, 1.57455876e-01f,
  9.98750269e-01f, 4.99791652e-02f, 9.99875009e-01f, 1.58107281e-02f, 9.99987483e-01f, 4.99997940e-03f, 9.99998748e-01f, 1.58113812e-03f,
  9.60170269e-01f, -2.79415488e-01f, -3.20796400e-01f, 9.47148204e-01f, 8.25335622e-01f, 5.64642489e-01f, 9.82053936e-01f, 1.88600272e-01f,
  9.98200536e-01f, 5.99640049e-02f, 9.99819994e-01f, 1.89725272e-02f, 9.99981999e-01f, 5.99996420e-03f, 9.99998212e-01f, 1.89736532e-03f,
  7.53902256e-01f, 6.56986594e-01f, -5.99437475e-01f, 8.00421596e-01f, 7.64842212e-01f, 6.44217670e-01f, 9.75599885e-01f, 2.19556093e-01f,
  9.97551024e-01f, 6.99428469e-02f, 9.99755025e-01f, 2.21341345e-02f, 9.99975502e-01f, 6.99994294e-03f, 9.99997556e-01f, 2.21359241e-03f,
  -1.45500034e-01f, 9.89358246e-01f, -8.18632424e-01f, 5.74317753e-01f, 6.96706712e-01f, 7.17356086e-01f, 9.68170285e-01f, 2.50292331e-01f,
  9.96801734e-01f, 7.99146891e-02f, 9.99680042e-01f, 2.52955221e-02f, 9.99967992e-01f, 7.99991470e-03f, 9.99996781e-01f, 2.52981926e-03f,
  -9.11130250e-01f, 4.12118495e-01f, -9.56644177e-01f, 2.91259229e-01f, 6.21609926e-01f, 7.83326924e-01f, 9.59772646e-01f, 2.80778319e-01f,
  9.95952725e-01f, 8.98785442e-02f, 9.99595046e-01f, 2.84566563e-02f, 9.99959528e-01f, 8.99987947e-03f, 9.99995947e-01f, 2.84604589e-03f,
  -8.39071512e-01f, -5.44021130e-01f, -9.99786079e-01f, -2.06835698e-02f, 5.40302277e-01f, 8.41470957e-01f, 9.50415313e-01f, 3.10983568e-01f,
  9.95004177e-01f, 9.98334140e-02f, 9.99500036e-01f, 3.16175036e-02f, 9.99949992e-01f, 9.99983400e-03f, 9.99994993e-01f, 3.16227227e-03f,
  4.42569796e-03f, -9.99990225e-01f, -9.43779767e-01f, -3.30574960e-01f, 4.53596085e-01f, 8.91207397e-01f, 9.40107584e-01f, 3.40877861e-01f,
  9.93956089e-01f, 1.09778300e-01f, 9.99395072e-01f, 3.47780399e-02f, 9.99939501e-01f, 1.09997792e-02f, 9.99993920e-01f, 3.47849843e-03f,
  8.43853951e-01f, -5.36572933e-01f, -7.94179380e-01f, -6.07683420e-01f, 3.62357706e-01f, 9.32039082e-01f, 9.28859890e-01f, 3.70431304e-01f,
  9.92808640e-01f, 1.19712204e-01f, 9.99280095e-01f, 3.79382223e-02f, 9.99927998e-01f, 1.19997123e-02f, 9.99992788e-01f, 3.79472389e-03f,
  9.07446802e-01f, 4.20167029e-01f, -5.65820515e-01f, -8.24528456e-01f, 2.67498761e-01f, 9.63558197e-01f, 9.16683376e-01f, 3.99614304e-01f,
  9.91561890e-01f, 1.29634142e-01f, 9.99155104e-01f, 4.10980321e-02f, 9.99915481e-01f, 1.29996343e-02f, 9.99991536e-01f, 4.11094911e-03f,
  1.36737213e-01f, 9.90607381e-01f, -2.81349480e-01f, -9.59605396e-01f, 1.69967160e-01f, 9.85449731e-01f, 9.03590262e-01f, 4.28397775e-01f,
  9.90216017e-01f, 1.39543116e-01f, 9.99020159e-01f, 4.42574248e-02f, 9.99902010e-01f, 1.39995432e-02f, 9.99990225e-01f, 4.42717411e-03f,
  -7.59687901e-01f, 6.50287867e-01f, 3.10223512e-02f, -9.99518692e-01f, 7.07371980e-02f, 9.97494996e-01f, 8.89593601e-01f, 4.56752867e-01f,
  9.88771081e-01f, 1.49438128e-01f, 9.98875201e-01f, 4.74163815e-02f, 9.99887526e-01f, 1.49994381e-02f, 9.99988735e-01f, 4.74339863e-03f,
  -9.57659483e-01f, -2.87903309e-01f, 3.40318173e-01f, -9.40310359e-01f, -2.91995462e-02f, 9.99573588e-01f, 8.74707460e-01f, 4.84651238e-01f,
  9.87227261e-01f, 1.59318209e-01f, 9.98720288e-01f, 5.05748577e-02f, 9.99872029e-01f, 1.59993190e-02f, 9.99987185e-01f, 5.05962269e-03f,
  -2.75163352e-01f, -9.61397469e-01f, 6.15864813e-01f, -7.87851870e-01f, -1.28844544e-01f, 9.91664827e-01f, 8.58946681e-01f, 5.12064993e-01f,
  9.85584795e-01f, 1.69182345e-01f, 9.98555362e-01f, 5.37328273e-02f, 9.99855518e-01f, 1.69991814e-02f, 9.99985576e-01f, 5.37584582e-03f,
  6.60316706e-01f, -7.50987232e-01f, 8.30336154e-01f, -5.57262897e-01f, -2.27202162e-01f, 9.73847628e-01f, 8.42327058e-01f, 5.38966715e-01f,
  9.83843684e-01f, 1.79029569e-01f, 9.98380423e-01f, 5.68902642e-02f, 9.99837995e-01f, 1.79990288e-02f, 9.99983788e-01f, 5.69206895e-03f,
  9.88704622e-01f, 1.49877205e-01f, 9.62463796e-01f, -2.71410108e-01f, -3.23289543e-01f, 9.46300089e-01f, 8.24865162e-01f, 5.65329552e-01f,
  9.82004225e-01f, 1.88858896e-01f, 9.98195529e-01f, 6.00471310e-02f, 9.99819517e-01f, 1.89988576e-02f, 9.99981940e-01f, 6.00829115e-03f,
  4.08082068e-01f, 9.12945271e-01f, 9.99144375e-01f, 4.13582884e-02f, -4.16146845e-01f, 9.09297407e-01f, 8.06578457e-01f, 5.91127038e-01f,
  9.80066597e-01f, 1.98669314e-01f, 9.98000681e-01f, 6.32033944e-02f, 9.99800026e-01f, 1.99986678e-02f, 9.99979973e-01f, 6.32451288e-03f,
  -5.47729254e-01f, 8.36655617e-01f, 9.36740458e-01f, 3.50024760e-01f, -5.04846215e-01f, 8.63209307e-01f, 7.87485182e-01f, 6.16333544e-01f,
  9.78030920e-01f, 2.08459899e-01f, 9.97795820e-01f, 6.63590282e-02f, 9.99779522e-01f, 2.09984574e-02f, 9.99977946e-01f, 6.64073415e-03f,
  -9.99960840e-01f, -8.85130931e-03f, 7.81440377e-01f, 6.23979926e-01f, -5.88501155e-01f, 8.08496356e-01f, 7.67604589e-01f, 6.40923738e-01f,
  9.75897431e-01f, 2.18229622e-01f, 9.97581005e-01f, 6.95140064e-02f, 9.99758005e-01f, 2.19982266e-02f, 9.99975801e-01f, 6.95695449e-03f,
  -5.32833040e-01f, -8.46220434e-01f, 5.48645258e-01f, 8.36055279e-01f, -6.66275978e-01f, 7.45705247e-01f, 7.46956408e-01f, 6.64873064e-01f,
  9.73666370e-01f, 2.27977514e-01f, 9.97356176e-01f, 7.26682767e-02f, 9.99735534e-01f, 2.29979735e-02f, 9.99973536e-01f, 7.27317436e-03f,
  4.24179018e-01f, -9.05578375e-01f, 2.61441678e-01f, 9.65219259e-01f, -7.37393796e-01f, 6.75463140e-01f, 7.25561321e-01f, 6.88157499e-01f,
  9.71337974e-01f, 2.37702623e-01f, 9.97121394e-01f, 7.58218244e-02f, 9.99711990e-01f, 2.39976961e-02f, 9.99971211e-01f, 7.58939330e-03f,
  9.91202831e-01f, -1.32351756e-01f, -5.16893305e-02f, 9.98663187e-01f, -8.01143587e-01f, 5.98472118e-01f, 7.03440726e-01f, 7.10753918e-01f,
  9.68912423e-01f, 2.47403964e-01f, 9.96876657e-01f, 7.89746121e-02f, 9.99687493e-01f, 2.49973964e-02f, 9.99968767e-01f, 7.90561177e-03f,
  6.46919310e-01f, 7.62558460e-01f, -3.59694332e-01f, 9.33070183e-01f, -8.56888831e-01f, 5.15501261e-01f, 6.80616796e-01f, 7.32639611e-01f,
  9.66389954e-01f, 2.57080555e-01f, 9.96621907e-01f, 8.21266174e-02f, 9.99662042e-01f, 2.59970706e-02f, 9.99966204e-01f, 8.22182931e-03f,
  -2.92138815e-01f, 9.56375957e-01f, -6.32028639e-01f, 7.74945021e-01f, -9.04072165e-01f, 4.27379847e-01f, 6.57112300e-01f, 7.53792703e-01f,
  9.63770926e-01f, 2.66731411e-01f, 9.96357203e-01f, 8.52777958e-02f, 9.99635518e-01f, 2.69967206e-02f, 9.99963522e-01f, 8.53804592e-03f,
  -9.62605894e-01f, 2.70905793e-01f, -8.41684937e-01f, 5.39968967e-01f, -9.42222297e-01f, 3.34988207e-01f, 6.32950664e-01f, 7.74192095e-01f,
  9.61055458e-01f, 2.76355654e-01f, 9.96082544e-01f, 8.84281173e-02f, 9.99608040e-01f, 2.79963426e-02f, 9.99960780e-01f, 8.85426160e-03f,
  -7.48057544e-01f, -6.63633883e-01f, -9.67871487e-01f, 2.51445323e-01f, -9.70958173e-01f, 2.39249229e-01f, 6.08156204e-01f, 7.93817401e-01f,
  9.58243906e-01f, 2.85952210e-01f, 9.95797932e-01f, 9.15775672e-02f, 9.99579549e-01f, 2.89959367e-02f, 9.99957979e-01f, 9.17047635e-03f,
  1.54251456e-01f, -9.88031626e-01f, -9.98075247e-01f, -6.20148405e-02f, -9.89992499e-01f, 1.41120002e-01f, 5.82753658e-01f, 8.12648892e-01f,
  9.55336511e-01f, 2.95520186e-01f, 9.95503366e-01f, 9.47260931e-02f, 9.99550045e-01f, 2.99955010e-02f, 9.99954998e-01f, 9.48669016e-03f,
  9.14742351e-01f, -4.04037654e-01f, -9.29300308e-01f, -3.69325012e-01f, -9.99135137e-01f, 4.15805206e-02f, 5.56768358e-01f, 8.30667794e-01f,
  9.52333570e-01f, 3.05058628e-01f, 9.95198846e-01f, 9.78736654e-02f, 9.99519527e-01f, 3.09950355e-02f, 9.99951959e-01f, 9.80290305e-03f,
  8.34223390e-01f, 5.51426709e-01f, -7.68367112e-01f, -6.40009403e-01f, -9.98294771e-01f, -5.83741926e-02f, 5.30226350e-01f, 8.47856104e-01f,
  9.49235439e-01f, 3.14566553e-01f, 9.94884372e-01f, 1.01020269e-01f, 9.99488056e-01f, 3.19945402e-02f, 9.99948800e-01f, 1.01191159e-02f,
  -1.32767474e-02f, 9.99911845e-01f, -5.31235278e-01f, -8.47224355e-01f, -9.87479806e-01f, -1.57745644e-01f, 5.03154159e-01f, 8.64196658e-01f,
  9.46042359e-01f, 3.24043006e-01f, 9.94559944e-01f, 1.04165860e-01f, 9.99455571e-01f, 3.29940096e-02f, 9.99945521e-01f, 1.04353270e-02f,
  -8.48570287e-01f, 5.29082716e-01f, -2.41421118e-01f, -9.70420420e-01f, -9.66798186e-01f, -2.55541205e-01f, 4.75578904e-01f, 8.79673064e-01f,
  9.42754686e-01f, 3.33487093e-01f, 9.94225562e-01f, 1.07310407e-01f, 9.99422073e-01f, 3.39934528e-02f, 9.99942183e-01f, 1.07515370e-02f,
  -9.03692186e-01f, -4.28182662e-01f, 7.23346695e-02f, -9.97380435e-01f, -9.36456680e-01f, -3.50783229e-01f, 4.47528064e-01f, 8.94269884e-01f,
  9.39372718e-01f, 3.42897803e-01f, 9.93881226e-01f, 1.10453881e-01f, 9.99387562e-01f, 3.49928550e-02f, 9.99938726e-01f, 1.10677453e-02f,
  -1.27963692e-01f, -9.91778851e-01f, 3.78916174e-01f, -9.25431013e-01f, -8.96758378e-01f, -4.42520559e-01f, 4.19029742e-01f, 9.07972515e-01f,
  9.35896814e-01f, 3.52274209e-01f, 9.93526995e-01f, 1.13596253e-01f, 9.99352098e-01f, 3.59922275e-02f, 9.99935210e-01f, 1.13839535e-02f,
  7.65414059e-01f, -6.43538117e-01f, 6.47921681e-01f, -7.61706948e-01f, -8.48100007e-01f, -5.29836178e-01f, 3.90112430e-01f, 9.20767248e-01f,
  9.32327330e-01f, 3.61615449e-01f, 9.93162811e-01f, 1.16737492e-01f, 9.99315560e-01f, 3.69915590e-02f, 9.99931574e-01f, 1.17001599e-02f,
  9.55073655e-01f, 2.96368569e-01f, 8.52673113e-01f, -5.22444785e-01f, -7.90967762e-01f, -6.11857831e-01f, 3.60805035e-01f, 9.32641268e-01f,
  9.28664625e-01f, 3.70920479e-01f, 9.92788672e-01f, 1.19877554e-01f, 9.99278069e-01f, 3.79908569e-02f, 9.99927819e-01f, 1.20163653e-02f,
  2.66642928e-01f, 9.63795364e-01f, 9.72865343e-01f, -2.31372014e-01f, -7.25932240e-01f, -6.87766254e-01f, 3.31136853e-01f, 9.43582714e-01f,
  9.24909055e-01f, 3.80188406e-01f, 9.92404640e-01f, 1.23016424e-01f, 9.99239624e-01f, 3.89901139e-02f, 9.99923944e-01f, 1.23325698e-02f,
  -6.66938066e-01f, 7.45113134e-01f, 9.96578991e-01f, 8.26458037e-02f, -6.53643608e-01f, -7.56802499e-01f, 3.01137596e-01f, 9.53580678e-01f,
  9.21060979e-01f, 3.89418334e-01f, 9.92010653e-01f, 1.26154065e-01f, 9.99200106e-01f, 3.99893373e-02f, 9.99920011e-01f, 1.26487734e-02f,
  -9.87339258e-01f, -1.58622667e-01f, 9.21462357e-01f, 3.88467699e-01f, -5.74824035e-01f, -8.18277061e-01f, 2.70837069e-01f, 9.62625206e-01f,
  9.17120814e-01f, 3.98609310e-01f, 9.91606772e-01f, 1.29290432e-01f, 9.99159634e-01f, 4.09885161e-02f, 9.99915957e-01f, 1.29649751e-02f,
  -3.99985313e-01f, -9.16521549e-01f, 7.54965365e-01f, 6.55764699e-01f, -4.90260571e-01f, -8.71575892e-01f, 2.40265876e-01f, 9.70707119e-01f,
  9.13088918e-01f, 4.07760441e-01f, 9.91192937e-01f, 1.32425532e-01f, 9.99118149e-01f, 4.19876575e-02f, 9.99911785e-01f, 1.32811759e-02f,
  5.55113316e-01f, -8.31774771e-01f, 5.13598442e-01f, 8.58030677e-01f, -4.00799006e-01f, -9.16166008e-01f, 2.09454417e-01f, 9.77818429e-01f,
  9.08965766e-01f, 4.16870773e-01f, 9.90769207e-01f, 1.35559291e-01f, 9.99075651e-01f, 4.29867506e-02f, 9.99907553e-01f, 1.35973748e-02f,
  9.99843299e-01f, 1.77019257e-02f, 2.21298173e-01f, 9.75206196e-01f, -3.07332784e-01f, -9.51602101e-01f, 1.78433523e-01f, 9.83951986e-01f,
  9.04751658e-01f, 4.25939471e-01f, 9.90335584e-01f, 1.38691694e-01f, 9.99032140e-01f, 4.39858064e-02f, 9.99903202e-01f, 1.39135728e-02f,
  5.25321960e-01f, 8.50903511e-01f, -9.29481089e-02f, 9.95670974e-01f, -2.10795805e-01f, -9.77530122e-01f, 1.47234216e-01f, 9.89101648e-01f,
  9.00447130e-01f, 4.34965521e-01f, 9.89892066e-01f, 1.41822711e-01f, 9.98987675e-01f, 4.49848175e-02f, 9.99898732e-01f, 1.42297689e-02f,
  -4.32177931e-01f, 9.01788354e-01f, -3.97976756e-01f, 9.17395473e-01f, -1.12152621e-01f, -9.93690968e-01f, 1.15887694e-01f, 9.93262351e-01f,
  8.96052480e-01f, 4.43948090e-01f, 9.89438653e-01f, 1.44952312e-01f, 9.98942196e-01f, 4.59837839e-02f, 9.99894202e-01f, 1.45459641e-02f,
  -9.92335498e-01f, 1.23573124e-01f, -6.63538277e-01f, 7.48142362e-01f, -1.23883775e-02f, -9.99923289e-01f, 8.44252855e-02f, 9.96429801e-01f,
  8.91568303e-01f, 4.52886283e-01f, 9.88975346e-01f, 1.48080453e-01f, 9.98895705e-01f, 4.69827019e-02f, 9.99889553e-01f, 1.48621574e-02f,
  -6.40144348e-01f, -7.68254638e-01f, -8.63296509e-01f, 5.04697084e-01f, 8.74991715e-02f, -9.96164620e-01f, 5.28784581e-02f, 9.98600960e-01f,
  8.86994898e-01f, 4.61779177e-01f, 9.88502085e-01f, 1.51207119e-01f, 9.98848200e-01f, 4.79815714e-02f, 9.99884784e-01f, 1.51783489e-02f,
  3.00592542e-01f, -9.53752637e-01f, -9.77442741e-01f, 2.11200655e-01f, 1.86512470e-01f, -9.82452571e-01f, 2.12787576e-02f, 9.99773562e-01f,
  8.82332861e-01f, 4.70625877e-01f, 9.88018990e-01f, 1.54332280e-01f, 9.98799741e-01f, 4.89803962e-02f, 9.99879956e-01f, 1.54945394e-02f,
  9.64965999e-01f, -2.62374848e-01f, -9.94656444e-01f, -1.03240460e-01f, 2.83662200e-01f, -9.58924294e-01f, -1.03422189e-02f, 9.99946535e-01f,
  8.77582550e-01f, 4.79425550e-01f, 9.87526000e-01f, 1.57455891e-01f, 9.98750269e-01f, 4.99791689e-02f, 9.99875009e-01f, 1.58107281e-02f,
  7.42154181e-01f, 6.70229197e-01f, -9.13230121e-01f, -4.07444149e-01f, 3.77977669e-01f, -9.25814748e-01f, -4.19528559e-02f, 9.99119580e-01f,
  8.72744501e-01f, 4.88177240e-01f, 9.87023175e-01f, 1.60577938e-01f, 9.98699784e-01f, 5.09778969e-02f, 9.99869943e-01f, 1.61269177e-02f,
  -1.62990779e-01f, 9.86627579e-01f, -7.41239965e-01f, -6.71240151e-01f, 4.68516916e-01f, -8.83454502e-01f, -7.35215396e-02f, 9.97293651e-01f,
  8.67819190e-01f, 4.96880114e-01f, 9.86510456e-01f, 1.63698375e-01f, 9.98648286e-01f, 5.19765690e-02f, 9.99864817e-01f, 1.64431017e-02f,
  -9.18282807e-01f, 3.95925164e-01f, -4.95741814e-01f, -8.68469954e-01f, 5.54374516e-01f, -8.32267344e-01f, -1.05016708e-01f, 9.94470477e-01f,
  8.62807095e-01f, 5.05533338e-01f, 9.85987842e-01f, 1.66817173e-01f, 9.98595834e-01f, 5.29751927e-02f, 9.99859571e-01f, 1.67592876e-02f,
  -8.29309821e-01f, -5.58789074e-01f, -2.01079622e-01f, -9.79574919e-01f, 6.34692967e-01f, -7.72764444e-01f, -1.36406869e-01f, 9.90652919e-01f,
  8.57708693e-01f, 5.14135957e-01f, 9.85455394e-01f, 1.69934288e-01f, 9.98542368e-01f, 5.39737605e-02f, 9.99854207e-01f, 1.70754679e-02f,
  2.21267566e-02f, -9.99755144e-01f, 1.13521777e-01f, -9.93535519e-01f, 7.08669782e-01f, -7.05540299e-01f, -1.67660639e-01f, 9.85844791e-01f,
  8.52524519e-01f, 5.22687256e-01f, 9.84913111e-01f, 1.73049718e-01f, 9.98487890e-01f, 5.49722798e-02f, 9.99848783e-01f, 1.73916500e-02f,
  8.53220105e-01f, -5.21551013e-01f, 4.16867077e-01f, -9.08967435e-01f, 7.75565803e-01f, -6.31266713e-01f, -1.98746875e-01f, 9.80050862e-01f,
  8.47255111e-01f, 5.31186223e-01f, 9.84360933e-01f, 1.76163420e-01f, 9.98432398e-01f, 5.59707358e-02f, 9.99843180e-01f, 1.77078284e-02f,
  8.99866819e-01f, 4.36164767e-01f, 6.78870201e-01f, -7.34258294e-01f, 8.34712923e-01f, -5.50685287e-01f, -2.29634270e-01f, 9.73276973e-01f,
  8.41901004e-01f, 5.39632022e-01f, 9.83798921e-01f, 1.79275364e-01f, 9.98375952e-01f, 5.69691435e-02f, 9.99837577e-01f, 1.80240069e-02f,
  1.19180135e-01f, 9.92872655e-01f, 8.73550534e-01f, -4.86733496e-01f, 8.85519624e-01f, -4.64602023e-01f, -2.60292053e-01f, 9.65529919e-01f,
  8.36462677e-01f, 5.48023939e-01f, 9.83227074e-01f, 1.82385504e-01f, 9.98318493e-01f, 5.79674877e-02f, 9.99831796e-01f, 1.83401816e-02f,
  -7.71080196e-01f, 6.36738002e-01f, 9.81602073e-01f, -1.90938011e-01f, 9.27478492e-01f, -3.73876572e-01f, -2.90689558e-01f, 9.56817448e-01f,
  8.30940723e-01f, 5.56361020e-01f, 9.82645452e-01f, 1.85493827e-01f, 9.98260021e-01f, 5.89657798e-02f, 9.99825954e-01f, 1.86563563e-02f,
  -9.52412963e-01f, -3.04810613e-01f, 9.92308319e-01f, 1.23790950e-01f, 9.60170269e-01f, -2.79415488e-01f, -3.20796400e-01f, 9.47148204e-01f,
  8.25335622e-01f, 5.64642429e-01f, 9.82053936e-01f, 1.88600287e-01f, 9.98200536e-01f, 5.99640086e-02f, 9.99819994e-01f, 1.89725272e-02f,
  -2.58101642e-01f, -9.66117799e-01f, 9.04607594e-01f, 4.26245421e-01f, 9.83268440e-01f, -1.82162598e-01f, -3.50582451e-01f, 9.36531842e-01f,
  8.19648027e-01f, 5.72867453e-01f, 9.81452644e-01f, 1.91704854e-01f, 9.98140097e-01f, 6.09621815e-02f, 9.99813974e-01f, 1.92886982e-02f,
  6.73507154e-01f, -7.39180684e-01f, 7.27198064e-01f, 6.86427653e-01f, 9.96542096e-01f, -8.30891207e-02f, -3.80017966e-01f, 9.24979091e-01f,
  8.13878477e-01f, 5.81035137e-01f, 9.80841517e-01f, 1.94807529e-01f, 9.98078644e-01f, 6.19602874e-02f, 9.99807835e-01f, 1.96048655e-02f,
  9.85896587e-01f, 1.67355701e-01f, 4.77671444e-01f, 8.78538549e-01f, 9.99858618e-01f, 1.68140903e-02f, -4.09073502e-01f, 9.12501454e-01f,
  8.08027506e-01f, 5.89144766e-01f, 9.80220556e-01f, 1.97908238e-01f, 9.98016179e-01f, 6.29583374e-02f, 9.99801576e-01f, 1.99210308e-02f,
};
__device__ const float TAB_S[2048] = {
  1.00000000e+00f, 0.00000000e+00f, 1.00000000e+00f, 0.00000000e+00f, 1.00000000e+00f, 0.00000000e+00f, 1.00000000e+00f, 0.00000000e+00f,
  1.00000000e+00f, 0.00000000e+00f, 1.00000000e+00f, 0.00000000e+00f, 1.00000000e+00f, 0.00000000e+00f, 1.00000000e+00f, 0.00000000e+00f,
  1.00000000e+00f, 0.00000000e+00f, 1.00000000e+00f, 0.00000000e+00f, 1.00000000e+00f, 0.00000000e+00f, 1.00000000e+00f, 0.00000000e+00f,
  1.00000000e+00f, 0.00000000e+00f, 1.00000000e+00f, 0.00000000e+00f, 1.00000000e+00f, 0.00000000e+00f, 1.00000000e+00f, 0.00000000e+00f,
  5.40302277e-01f, 8.41470957e-01f, 8.46009135e-01f, 5.33168435e-01f, 9.50415254e-01f, 3.10983598e-01f, 9.84230220e-01f, 1.76892191e-01f,
  9.95004177e-01f, 9.98334214e-02f, 9.98419285e-01f, 5.62044978e-02f, 9.99500036e-01f, 3.16175036e-02f, 9.99841869e-01f, 1.77818574e-02f,
  9.99949992e-01f, 9.99983307e-03f, 9.99984205e-01f, 5.62338345e-03f, 9.99994993e-01f, 3.16227227e-03f, 9.99998391e-01f, 1.77827850e-03f,
  9.99999523e-01f, 9.99999931e-04f, 9.99999821e-01f, 5.62341243e-04f, 9.99999940e-01f, 3.16227757e-04f, 1.00000000e+00f, 1.77827940e-04f,
  -4.16146845e-01f, 9.09297407e-01f, 4.31462824e-01f, 9.02130723e-01f, 8.06578398e-01f, 5.91127098e-01f, 9.37418282e-01f, 3.48205268e-01f,
  9.80066597e-01f, 1.98669329e-01f, 9.93682086e-01f, 1.12231314e-01f, 9.98000681e-01f, 6.32033944e-02f, 9.99367595e-01f, 3.55580896e-02f,
  9.99800026e-01f, 1.99986659e-02f, 9.99936759e-01f, 1.12465890e-02f, 9.99979973e-01f, 6.32451288e-03f, 9.99993682e-01f, 3.55655141e-03f,
  9.99997973e-01f, 1.99999870e-03f, 9.99999344e-01f, 1.12468237e-03f, 9.99999821e-01f, 6.32455456e-04f, 9.99999940e-01f, 3.55655880e-04f,
  -9.89992499e-01f, 1.41120002e-01f, -1.15966164e-01f, 9.93253171e-01f, 5.82753658e-01f, 8.12648892e-01f, 8.61040652e-01f, 5.08536100e-01f,
  9.55336511e-01f, 2.95520216e-01f, 9.85803485e-01f, 1.67903304e-01f, 9.95503366e-01f, 9.47260857e-02f, 9.98577297e-01f, 5.33230826e-02f,
  9.99550045e-01f, 2.99954992e-02f, 9.99857724e-01f, 1.68694388e-02f, 9.99954998e-01f, 9.48669016e-03f, 9.99985754e-01f, 5.33481315e-03f,
  9.99995530e-01f, 2.99999560e-03f, 9.99998569e-01f, 1.68702309e-03f, 9.99999523e-01f, 9.48683126e-04f, 9.99999881e-01f, 5.33483806e-04f,
  -6.53643608e-01f, -7.56802499e-01f, -6.27679706e-01f, 7.78471708e-01f, 3.01137477e-01f, 9.53580737e-01f, 7.57506192e-01f, 6.52827978e-01f,
  9.21060979e-01f, 3.89418334e-01f, 9.74808276e-01f, 2.23044485e-01f, 9.92010653e-01f, 1.26154065e-01f, 9.97471273e-01f, 7.10712075e-02f,
  9.99200106e-01f, 3.99893336e-02f, 9.99747038e-01f, 2.24917568e-02f, 9.99920011e-01f, 1.26487734e-02f, 9.99974728e-01f, 7.11305765e-03f,
  9.99992013e-01f, 3.99998948e-03f, 9.99997497e-01f, 2.24936334e-03f, 9.99999225e-01f, 1.26491068e-03f, 9.99999762e-01f, 7.11311703e-04f,
  2.83662200e-01f, -9.58924294e-01f, -9.46079254e-01f, 3.23935270e-01f, -1.03423381e-02f, 9.99946535e-01f, 6.30080283e-01f, 7.76529968e-01f,
  8.77582550e-01f, 4.79425550e-01f, 9.60731268e-01f, 2.77480543e-01f, 9.87526000e-01f, 1.57455876e-01f, 9.96049762e-01f, 8.87968615e-02f,
  9.98750269e-01f, 4.99791652e-02f, 9.99604762e-01f, 2.81133614e-02f, 9.99875009e-01f, 1.58107281e-02f, 9.99960482e-01f, 8.89127981e-03f,
  9.99987483e-01f, 4.99997940e-03f, 9.99996066e-01f, 2.81170290e-03f, 9.99998748e-01f, 1.58113812e-03f, 9.99999583e-01f, 8.89139599e-04f,
  9.60170269e-01f, -2.79415488e-01f, -9.73103702e-01f, -2.30367512e-01f, -3.20796400e-01f, 9.47148204e-01f, 4.82782036e-01f, 8.75740528e-01f,
  8.25335622e-01f, 5.64642489e-01f, 9.43616986e-01f, 3.31039310e-01f, 9.82053936e-01f, 1.88600272e-01f, 9.94313300e-01f, 1.06494442e-01f,
  9.98200536e-01f, 5.99640049e-02f, 9.99430835e-01f, 3.37340795e-02f, 9.99819994e-01f, 1.89725272e-02f, 9.99943078e-01f, 1.06694745e-02f,
  9.99981999e-01f, 5.99996420e-03f, 9.99994338e-01f, 3.37404152e-03f, 9.99998212e-01f, 1.89736532e-03f, 9.99999404e-01f, 1.06696738e-03f,
  7.53902256e-01f, 6.56986594e-01f, -7.00429797e-01f, -7.13721275e-01f, -5.99437475e-01f, 8.00421596e-01f, 3.20257008e-01f, 9.47330713e-01f,
  7.64842212e-01f, 6.44217670e-01f, 9.23519433e-01f, 3.83551568e-01f, 9.75599885e-01f, 2.19556093e-01f, 9.92262423e-01f, 1.24158338e-01f,
  9.97551024e-01f, 6.99428469e-02f, 9.99225318e-01f, 3.93537246e-02f, 9.99755025e-01f, 2.21341345e-02f, 9.99922514e-01f, 1.24476347e-02f,
  9.99975502e-01f, 6.99994294e-03f, 9.99992251e-01f, 3.93637875e-03f, 9.99997556e-01f, 2.21359241e-03f, 9.99999225e-01f, 1.24479528e-03f,
  -1.45500034e-01f, 9.89358246e-01f, -2.12036446e-01f, -9.77261782e-01f, -8.18632424e-01f, 5.74317753e-01f, 1.47631213e-01f, 9.89042461e-01f,
  6.96706712e-01f, 7.17356086e-01f, 9.00502324e-01f, 4.34851229e-01f, 9.68170285e-01f, 2.50292331e-01f, 9.89897788e-01f, 1.41782969e-01f,
  9.96801734e-01f, 7.99146891e-02f, 9.98988271e-01f, 4.49721329e-02f, 9.99680042e-01f, 2.52955221e-02f, 9.99898791e-01f, 1.42257558e-02f,
  9.99967992e-01f, 7.99991470e-03f, 9.99989867e-01f, 4.49871505e-03f, 9.99996781e-01f, 2.52981926e-03f, 9.99998987e-01f, 1.42262306e-03f,
  -9.11130250e-01f, 4.12118495e-01f, 3.41660261e-01f, -9.39823508e-01f, -9.56644177e-01f, 2.91259229e-01f, -2.96507962e-02f, 9.99560297e-01f,
  6.21609926e-01f, 7.83326924e-01f, 8.74638259e-01f, 4.84776139e-01f, 9.59772646e-01f, 2.80778319e-01f, 9.87220109e-01f, 1.59362778e-01f,
  9.95952725e-01f, 8.98785442e-02f, 9.98719573e-01f, 5.05891182e-02f, 9.99595046e-01f, 2.84566563e-02f, 9.99871910e-01f, 1.60038304e-02f,
  9.99959528e-01f, 8.99987947e-03f, 9.99987185e-01f, 5.06105041e-03f, 9.99995947e-01f, 2.84604589e-03f, 9.99998748e-01f, 1.60045072e-03f,
  -8.39071512e-01f, -5.44021130e-01f, 7.90131867e-01f, -6.12936914e-01f, -9.99786079e-01f, -2.06835698e-02f, -2.05997631e-01f, 9.78552461e-01f,
  5.40302277e-01f, 8.41470957e-01f, 8.46009135e-01f, 5.33168435e-01f, 9.50415313e-01f, 3.10983568e-01f, 9.84230220e-01f, 1.76892191e-01f,
  9.95004177e-01f, 9.98334140e-02f, 9.98419285e-01f, 5.62044978e-02f, 9.99500036e-01f, 3.16175036e-02f, 9.99841869e-01f, 1.77818574e-02f,
  9.99949992e-01f, 9.99983400e-03f, 9.99984205e-01f, 5.62338345e-03f, 9.99994993e-01f, 3.16227227e-03f, 9.99998391e-01f, 1.77827850e-03f,
  4.42569796e-03f, -9.99990225e-01f, 9.95257378e-01f, -9.72764567e-02f, -9.43779767e-01f, -3.30574960e-01f, -3.75847399e-01f, 9.26681578e-01f,
  4.53596085e-01f, 8.91207397e-01f, 8.14705312e-01f, 5.79875171e-01f, 9.40107584e-01f, 3.40877861e-01f, 9.80929136e-01f, 1.94365650e-01f,
  9.93956089e-01f, 1.09778300e-01f, 9.98087406e-01f, 6.18181042e-02f, 9.99395072e-01f, 3.47780399e-02f, 9.99808669e-01f, 1.95598267e-02f,
  9.99939501e-01f, 1.09997792e-02f, 9.99980867e-01f, 6.18571462e-03f, 9.99993920e-01f, 3.47849843e-03f, 9.99998093e-01f, 1.95610616e-03f,
  8.43853951e-01f, -5.36572933e-01f, 8.93861592e-01f, 4.48342979e-01f, -7.94179380e-01f, -6.07683420e-01f, -5.33843040e-01f, 8.45583618e-01f,
  3.62357706e-01f, 9.32039082e-01f, 7.80825913e-01f, 6.24748647e-01f, 9.28859890e-01f, 3.70431304e-01f, 9.77317870e-01f, 2.11777672e-01f,
  9.92808640e-01f, 1.19712204e-01f, 9.97723997e-01f, 6.74297586e-02f, 9.99280095e-01f, 3.79382223e-02f, 9.99772310e-01f, 2.13377345e-02f,
  9.99927998e-01f, 1.19997123e-02f, 9.99977231e-01f, 6.74804440e-03f, 9.99992788e-01f, 3.79472389e-03f, 9.99997735e-01f, 2.13393359e-03f,
  9.07446802e-01f, 4.20167029e-01f, 5.17172873e-01f, 8.55880976e-01f, -5.65820515e-01f, -8.24528456e-01f, -6.75001681e-01f, 7.37816215e-01f,
  2.67498761e-01f, 9.63558197e-01f, 7.44477987e-01f, 6.67647004e-01f, 9.16683376e-01f, 3.99614304e-01f, 9.73397553e-01f, 2.29122713e-01f,
  9.91561890e-01f, 1.29634142e-01f, 9.97329056e-01f, 7.30392784e-02f, 9.99155104e-01f, 4.10980321e-02f, 9.99732792e-01f, 2.31155735e-02f,
  9.99915481e-01f, 1.29996343e-02f, 9.99973297e-01f, 7.31037185e-03f, 9.99991536e-01f, 4.11094911e-03f, 9.99997318e-01f, 2.31176103e-03f,
  1.36737213e-01f, 9.90607381e-01f, -1.87961515e-02f, 9.99823332e-01f, -2.81349480e-01f, -9.59605396e-01f, -7.94870913e-01f, 6.06778562e-01f,
  1.69967160e-01f, 9.85449731e-01f, 7.05776393e-01f, 7.08434701e-01f, 9.03590262e-01f, 4.28397775e-01f, 9.69169438e-01f, 2.46395305e-01f,
  9.90216017e-01f, 1.39543116e-01f, 9.96902585e-01f, 7.86464810e-02f, 9.99020159e-01f, 4.42574248e-02f, 9.99690115e-01f, 2.48933397e-02f,
  9.99902010e-01f, 1.39995432e-02f, 9.99969006e-01f, 7.87269697e-03f, 9.99990225e-01f, 4.42717411e-03f, 9.99996901e-01f, 2.48958869e-03f,
  -7.59687901e-01f, 6.50287867e-01f, -5.48975468e-01f, 8.35838437e-01f, 3.10223512e-02f, -9.99518692e-01f, -8.89670432e-01f, 4.56603259e-01f,
  7.07371980e-02f, 9.97494996e-01f, 6.64843500e-01f, 7.46982634e-01f, 8.89593601e-01f, 4.56752867e-01f, 9.64634836e-01f, 2.63589978e-01f,
  9.88771081e-01f, 1.49438128e-01f, 9.96444523e-01f, 8.42512026e-02f, 9.98875201e-01f, 4.74163815e-02f, 9.99644279e-01f, 2.66710296e-02f,
  9.99887526e-01f, 1.49994381e-02f, 9.99964416e-01f, 8.43502022e-03f, 9.99988735e-01f, 4.74339863e-03f, 9.99996424e-01f, 2.66741589e-03f,
  -9.57659483e-01f, -2.87903309e-01f, -9.10081089e-01f, 4.14430231e-01f, 3.40318173e-01f, -9.40310359e-01f, -9.56410050e-01f, 2.92027086e-01f,
  -2.91995462e-02f, 9.99573588e-01f, 6.21808827e-01f, 7.83169091e-01f, 8.74707460e-01f, 4.84651238e-01f, 9.59795177e-01f, 2.80701309e-01f,
  9.87227261e-01f, 1.59318209e-01f, 9.95954990e-01f, 8.98532644e-02f, 9.98720288e-01f, 5.05748577e-02f, 9.99595284e-01f, 2.84486320e-02f,
  9.99872029e-01f, 1.59993190e-02f, 9.99959528e-01f, 8.99733976e-03f, 9.99987185e-01f, 5.05962269e-03f, 9.99995947e-01f, 2.84524332e-03f,
  -2.75163352e-01f, -9.61397469e-01f, -9.90897954e-01f, -1.34615138e-01f, 6.15864813e-01f, -7.87851870e-01f, -9.92985010e-01f, 1.18240520e-01f,
  -1.28844544e-01f, 9.91664827e-01f, 5.76808274e-01f, 8.16879570e-01f, 8.58946681e-01f, 5.12064993e-01f, 9.54652011e-01f, 2.97723860e-01f,
  9.85584795e-01f, 1.69182345e-01f, 9.95433986e-01f, 9.54524800e-02f, 9.98555362e-01f, 5.37328273e-02f, 9.99543071e-01f, 3.02261449e-02f,
  9.99855518e-01f, 1.69991814e-02f, 9.99954283e-01f, 9.55965649e-03f, 9.99985576e-01f, 5.37584582e-03f, 9.99995410e-01f, 3.02307028e-03f,
  6.60316706e-01f, -7.50987232e-01f, -7.66536534e-01f, -6.42200708e-01f, 8.30336154e-01f, -5.57262897e-01f, -9.98241663e-01f, -5.92755191e-02f,
  -2.27202162e-01f, 9.73847628e-01f, 5.29984176e-01f, 8.48007560e-01f, 8.42327058e-01f, 5.38966715e-01f, 9.49207008e-01f, 3.14652264e-01f,
  9.83843684e-01f, 1.79029569e-01f, 9.94881511e-01f, 1.01048686e-01f, 9.98380423e-01f, 5.68902642e-02f, 9.99487758e-01f, 3.20035629e-02f,
  9.99837995e-01f, 1.79990288e-02f, 9.99948800e-01f, 1.01219704e-02f, 9.99983788e-01f, 5.69206895e-03f, 9.99994874e-01f, 3.20089748e-03f,
  9.88704622e-01f, 1.49877205e-01f, -3.06095392e-01f, -9.52000856e-01f, 9.62463796e-01f, -2.71410108e-01f, -9.72014248e-01f, -2.34921798e-01f,
  -3.23289543e-01f, 9.46300089e-01f, 4.81484592e-01f, 8.76454532e-01f, 8.24865162e-01f, 5.65329552e-01f, 9.43461835e-01f, 3.31481189e-01f,
  9.82004225e-01f, 1.88858896e-01f, 9.94297504e-01f, 1.06641680e-01f, 9.98195529e-01f, 6.00471310e-02f, 9.99429286e-01f, 3.37808803e-02f,
  9.99819517e-01f, 1.89988576e-02f, 9.99942899e-01f, 1.06842816e-02f, 9.99981940e-01f, 6.00829115e-03f, 9.99994278e-01f, 3.37872445e-03f,
  4.08082068e-01f, 9.12945271e-01f, 2.48616725e-01f, -9.68601942e-01f, 9.99144375e-01f, 4.13582884e-02f, -9.15129960e-01f, -4.03158993e-01f,
  -4.16146845e-01f, 9.09297407e-01f, 4.31462824e-01f, 9.02130723e-01f, 8.06578457e-01f, 5.91127038e-01f, 9.37418282e-01f, 3.48205268e-01f,
  9.80066597e-01f, 1.98669314e-01f, 9.93682086e-01f, 1.12231314e-01f, 9.98000681e-01f, 6.32033944e-02f, 9.99367595e-01f, 3.55580896e-02f,
  9.99800026e-01f, 1.99986678e-02f, 9.99936759e-01f, 1.12465890e-02f, 9.99979973e-01f, 6.32451288e-03f, 9.99993682e-01f, 3.55655141e-03f,
  -5.47729254e-01f, 8.36655617e-01f, 7.26760268e-01f, -6.86891198e-01f, 9.36740458e-01f, 3.50024760e-01f, -8.29382956e-01f, -5.58680534e-01f,
  -5.04846215e-01f, 8.63209307e-01f, 3.80077004e-01f, 9.24954832e-01f, 7.87485182e-01f, 6.16333544e-01f, 9.31078374e-01f, 3.64819258e-01f,
  9.78030920e-01f, 2.08459899e-01f, 9.93035257e-01f, 1.17817394e-01f, 9.97795820e-01f, 6.63590282e-02f, 9.99302804e-01f, 3.73351872e-02f,
  9.99779522e-01f, 2.09984574e-02f, 9.99930263e-01f, 1.18088927e-02f, 9.99977946e-01f, 6.64073415e-03f, 9.99993026e-01f, 3.73437814e-03f,
  -9.99960840e-01f, -8.85130931e-03f, 9.81074572e-01f, -1.93630233e-01f, 7.81440377e-01f, 6.23979926e-01f, -7.17477441e-01f, -6.96581721e-01f,
  -5.88501155e-01f, 8.08496356e-01f, 3.27489585e-01f, 9.44854796e-01f, 7.67604589e-01f, 6.40923738e-01f, 9.24443960e-01f, 3.81317884e-01f,
  9.75897431e-01f, 2.18229622e-01f, 9.92357016e-01f, 1.23399742e-01f, 9.97581005e-01f, 6.95140064e-02f, 9.99234855e-01f, 3.91121693e-02f,
  9.99758005e-01f, 2.19982266e-02f, 9.99923468e-01f, 1.23711927e-02f, 9.99975801e-01f, 6.95695449e-03f, 9.99992371e-01f, 3.91220488e-03f,
  -5.32833040e-01f, -8.46220434e-01f, 9.33235765e-01f, 3.59264523e-01f, 5.48645258e-01f, 8.36055279e-01f, -5.82943261e-01f, -8.12512875e-01f,
  -6.66275978e-01f, 7.45705247e-01f, 2.73866832e-01f, 9.61767614e-01f, 7.46956408e-01f, 6.64873064e-01f, 9.17517304e-01f, 3.97695929e-01f,
  9.73666370e-01f, 2.27977514e-01f, 9.91647422e-01f, 1.28978193e-01f, 9.97356176e-01f, 7.26682767e-02f, 9.99163687e-01f, 4.08890247e-02f,
  9.99735534e-01f, 2.29979735e-02f, 9.99916375e-01f, 1.29334899e-02f, 9.99973536e-01f, 7.27317436e-03f, 9.99991655e-01f, 4.09003161e-03f,
  4.24179018e-01f, -9.05578375e-01f, 5.97977161e-01f, 8.01513135e-01f, 2.61441678e-01f, 9.65219259e-01f, -4.30023283e-01f, -9.02817786e-01f,
  -7.37393796e-01f, 6.75463140e-01f, 2.19378278e-01f, 9.75639880e-01f, 7.25561321e-01f, 6.88157499e-01f, 9.10300434e-01f, 4.13948208e-01f,
  9.71337974e-01f, 2.37702623e-01f, 9.90906477e-01f, 1.34552568e-01f, 9.97121394e-01f, 7.58218244e-02f, 9.99089420e-01f, 4.26657498e-02f,
  9.99711990e-01f, 2.39976961e-02f, 9.99908924e-01f, 1.34957815e-02f, 9.99971211e-01f, 7.58939330e-03f, 9.99990880e-01f, 4.26785741e-03f,
  9.91202831e-01f, -1.32351756e-01f, 7.85522610e-02f, 9.96909976e-01f, -5.16893305e-02f, 9.98663187e-01f, -2.63540596e-01f, -9.64648306e-01f,
  -8.01143587e-01f, 5.98472118e-01f, 1.64196163e-01f, 9.86427724e-01f, 7.03440726e-01f, 7.10753918e-01f, 9.02795732e-01f, 4.30069596e-01f,
  9.68912423e-01f, 2.47403964e-01f, 9.90134120e-01f, 1.40122697e-01f, 9.96876657e-01f, 7.89746121e-02f, 9.99011934e-01f, 4.44423407e-02f,
  9.99687493e-01f, 2.49973964e-02f, 9.99901175e-01f, 1.40580693e-02f, 9.99968767e-01f, 7.90561177e-03f, 9.99990106e-01f, 4.44568414e-03f,
  6.46919310e-01f, 7.62558460e-01f, -4.65064496e-01f, 8.85276794e-01f, -3.59694332e-01f, 9.33070183e-01f, -8.87455046e-02f, -9.96054351e-01f,
  -8.56888831e-01f, 5.15501261e-01f, 1.08494945e-01f, 9.94096994e-01f, 6.80616796e-01f, 7.32639611e-01f, 8.95005584e-01f, 4.46054995e-01f,
  9.66389954e-01f, 2.57080555e-01f, 9.89330530e-01f, 1.45688385e-01f, 9.96621907e-01f, 8.21266174e-02f, 9.98931348e-01f, 4.62187938e-02f,
  9.99662042e-01f, 2.59970706e-02f, 9.99893129e-01f, 1.46203535e-02f, 9.99966204e-01f, 8.22182931e-03f, 9.99989331e-01f, 4.62350994e-03f,
  -2.92138815e-01f, 9.56375957e-01f, -8.65450621e-01f, 5.00994205e-01f, -6.32028639e-01f, 7.74945021e-01f, 8.88481140e-02f, -9.96045172e-01f,
  -9.04072165e-01f, 4.27379847e-01f, 5.24506159e-02f, 9.98623490e-01f, 6.57112300e-01f, 7.53792703e-01f, 8.86932373e-01f, 4.61899310e-01f,
  9.63770926e-01f, 2.66731411e-01f, 9.88495648e-01f, 1.51249468e-01f, 9.96357203e-01f, 8.52777958e-02f, 9.98847544e-01f, 4.79951017e-02f,
  9.99635518e-01f, 2.69967206e-02f, 9.99884725e-01f, 1.51826320e-02f, 9.99963522e-01f, 8.53804592e-03f, 9.99988496e-01f, 4.80133574e-03f,
  -9.62605894e-01f, 2.70905793e-01f, -9.99293387e-01f, -3.75856608e-02f, -8.41684937e-01f, 5.39968967e-01f, 2.63639510e-01f, -9.64621305e-01f,
  -9.42222297e-01f, 3.34988207e-01f, -3.75941908e-03f, 9.99992907e-01f, 6.32950664e-01f, 7.74192095e-01f, 8.78578722e-01f, 4.77597594e-01f,
  9.61055458e-01f, 2.76355654e-01f, 9.87629473e-01f, 1.56805754e-01f, 9.96082544e-01f, 8.84281173e-02f, 9.98760641e-01f, 4.97712530e-02f,
  9.99608040e-01f, 2.79963426e-02f, 9.99876022e-01f, 1.57449059e-02f, 9.99960780e-01f, 8.85426160e-03f, 9.99987602e-01f, 4.97916201e-03f,
  -7.48057544e-01f, -6.63633883e-01f, -8.25371623e-01f, -5.64589798e-01f, -9.67871487e-01f, 2.51445323e-01f, 4.30115849e-01f, -9.02773678e-01f,
  -9.70958173e-01f, 2.39249229e-01f, -5.99575676e-02f, 9.98200953e-01f, 6.08156204e-01f, 7.93817401e-01f, 8.69947195e-01f, 4.93144840e-01f,
  9.58243906e-01f, 2.85952210e-01f, 9.86732066e-01f, 1.62357092e-01f, 9.95797932e-01f, 9.15775672e-02f, 9.98670578e-01f, 5.15472479e-02f,
  9.99579549e-01f, 2.89959367e-02f, 9.99867022e-01f, 1.63071752e-02f, 9.99957979e-01f, 9.17047635e-03f, 9.99986708e-01f, 5.15698735e-03f,
  1.54251456e-01f, -9.88031626e-01f, -3.97251874e-01f, -9.17709649e-01f, -9.98075247e-01f, -6.20148405e-02f, 5.83026946e-01f, -8.12452853e-01f,
  -9.89992499e-01f, 1.41120002e-01f, -1.15966164e-01f, 9.93253171e-01f, 5.82753658e-01f, 8.12648892e-01f, 8.61040652e-01f, 5.08536100e-01f,
  9.55336511e-01f, 2.95520186e-01f, 9.85803485e-01f, 1.67903304e-01f, 9.95503366e-01f, 9.47260931e-02f, 9.98577297e-01f, 5.33230826e-02f,
  9.99550045e-01f, 2.99955010e-02f, 9.99857724e-01f, 1.68694388e-02f, 9.99954998e-01f, 9.48669016e-03f, 9.99985754e-01f, 5.33481315e-03f,
  9.14742351e-01f, -4.04037654e-01f, 1.53215483e-01f, -9.88192797e-01f, -9.29300308e-01f, -3.69325012e-01f, 7.17549205e-01f, -6.96507812e-01f,
  -9.99135137e-01f, 4.15805206e-02f, -1.71608135e-01f, 9.85165298e-01f, 5.56768358e-01f, 8.30667794e-01f, 8.51861775e-01f, 5.23766637e-01f,
  9.52333570e-01f, 3.05058628e-01f, 9.84843671e-01f, 1.73444211e-01f, 9.95198846e-01f, 9.78736654e-02f, 9.98480916e-01f, 5.50987460e-02f,
  9.99519527e-01f, 3.09950355e-02f, 9.99848068e-01f, 1.74316969e-02f, 9.99951959e-01f, 9.80290305e-03f, 9.99984801e-01f, 5.51263802e-03f,
  8.34223390e-01f, 5.51426709e-01f, 6.56495154e-01f, -7.54330218e-01f, -7.68367112e-01f, -6.40009403e-01f, 8.29440355e-01f, -5.58595300e-01f,
  -9.98294771e-01f, -5.83741926e-02f, -2.26707578e-01f, 9.73962843e-01f, 5.30226350e-01f, 8.47856104e-01f, 8.42413545e-01f, 5.38831532e-01f,
  9.49235439e-01f, 3.14566553e-01f, 9.83852804e-01f, 1.78979620e-01f, 9.94884372e-01f, 1.01020269e-01f, 9.98381376e-01f, 5.68742342e-02f,
  9.99488056e-01f, 3.19945402e-02f, 9.99838114e-01f, 1.79939512e-02f, 9.99948800e-01f, 1.01191159e-02f, 9.99983788e-01f, 5.69046335e-03f,
  -1.32767474e-02f, 9.99911845e-01f, 9.57586050e-01f, -2.88147390e-01f, -5.31235278e-01f, -8.47224355e-01f, 9.15171385e-01f, -4.03064936e-01f,
  -9.87479806e-01f, -1.57745644e-01f, -2.81090319e-01f, 9.59681332e-01f, 5.03154159e-01f, 8.64196658e-01f, 8.32698941e-01f, 5.53726017e-01f,
  9.46042359e-01f, 3.24043006e-01f, 9.82830763e-01f, 1.84509367e-01f, 9.94559944e-01f, 1.04165860e-01f, 9.98278618e-01f, 5.86495437e-02f,
  9.99455571e-01f, 3.29940096e-02f, 9.99827802e-01f, 1.85561981e-02f, 9.99945521e-01f, 1.04353270e-02f, 9.99982774e-01f, 5.86828869e-03f,
  -8.48570287e-01f, 5.29082716e-01f, 9.63757515e-01f, 2.66779721e-01f, -2.41421118e-01f, -9.70420420e-01f, 9.72038329e-01f, -2.34822124e-01f,
  -9.66798186e-01f, -2.55541205e-01f, -3.34584385e-01f, 9.42365825e-01f, 4.75578904e-01f, 8.79673064e-01f, 8.22721004e-01f, 5.68445385e-01f,
  9.42754686e-01f, 3.33487093e-01f, 9.81777668e-01f, 1.90033287e-01f, 9.94225562e-01f, 1.07310407e-01f, 9.98172760e-01f, 6.04246669e-02f,
  9.99422073e-01f, 3.39934528e-02f, 9.99817252e-01f, 1.91184394e-02f, 9.99942183e-01f, 1.07515370e-02f, 9.99981701e-01f, 6.04611309e-03f,
  -9.03692186e-01f, -4.28182662e-01f, 6.73110247e-01f, 7.39542127e-01f, 7.23346695e-02f, -9.97380435e-01f, 9.98247743e-01f, -5.91726787e-02f,
  -9.36456680e-01f, -3.50783229e-01f, -3.87020677e-01f, 9.22071040e-01f, 4.47528064e-01f, 8.94269884e-01f, 8.12482953e-01f, 5.82984984e-01f,
  9.39372718e-01f, 3.42897803e-01f, 9.80693519e-01f, 1.95551202e-01f, 9.93881226e-01f, 1.10453881e-01f, 9.98063743e-01f, 6.21996038e-02f,
  9.99387562e-01f, 3.49928550e-02f, 9.99806345e-01f, 1.96806751e-02f, 9.99938726e-01f, 1.10677453e-02f, 9.99980628e-01f, 6.22393796e-03f,
  -1.27963692e-01f, -9.91778851e-01f, 1.75156534e-01f, 9.84540582e-01f, 3.78916174e-01f, -9.25431013e-01f, 9.92972851e-01f, 1.18342586e-01f,
  -8.96758378e-01f, -4.42520559e-01f, -4.38233554e-01f, 8.98861170e-01f, 4.19029742e-01f, 9.07972515e-01f, 8.01987886e-01f, 5.97340286e-01f,
  9.35896814e-01f, 3.52274209e-01f, 9.79578316e-01f, 2.01062918e-01f, 9.93526995e-01f, 1.13596253e-01f, 9.97951567e-01f, 6.39743358e-02f,
  9.99352098e-01f, 3.59922275e-02f, 9.99795079e-01f, 2.02429052e-02f, 9.99935210e-01f, 1.13839535e-02f, 9.99979496e-01f, 6.40176190e-03f,
  7.65414059e-01f, -6.43538117e-01f, -3.76742303e-01f, 9.26318109e-01f, 6.47921681e-01f, -7.61706948e-01f, 9.56380010e-01f, 2.92125374e-01f,
  -8.48100007e-01f, -5.29836178e-01f, -4.88060862e-01f, 8.72809589e-01f, 3.90112430e-01f, 9.20767248e-01f, 7.91239262e-01f, 6.11506701e-01f,
  9.32327330e-01f, 3.61615449e-01f, 9.78432178e-01f, 2.06568271e-01f, 9.93162811e-01f, 1.16737492e-01f, 9.97836173e-01f, 6.57488778e-02f,
  9.99315560e-01f, 3.69915590e-02f, 9.99783576e-01f, 2.08051261e-02f, 9.99931574e-01f, 1.17001599e-02f, 9.99978364e-01f, 6.57958630e-03f,
  9.55073655e-01f, 2.96368569e-01f, -8.12611222e-01f, 5.82806170e-01f, 8.52673113e-01f, -5.22444785e-01f, 8.89623463e-01f, 4.56694692e-01f,
  -7.90967762e-01f, -6.11857831e-01f, -5.36345184e-01f, 8.43998730e-01f, 3.60805035e-01f, 9.32641268e-01f, 7.80240417e-01f, 6.25479698e-01f,
  9.28664625e-01f, 3.70920479e-01f, 9.77255106e-01f, 2.12067112e-01f, 9.92788672e-01f, 1.19877554e-01f, 9.97717679e-01f, 6.75232038e-02f,
  9.99278069e-01f, 3.79908569e-02f, 9.99771714e-01f, 2.13673431e-02f, 9.99927819e-01f, 1.20163653e-02f, 9.99977171e-01f, 6.75741071e-03f,
  2.66642928e-01f, 9.63795364e-01f, -9.98210371e-01f, 5.98003156e-02f, 9.72865343e-01f, -2.31372014e-01f, 7.94808388e-01f, 6.06860459e-01f,
  -7.25932240e-01f, -6.87766254e-01f, -5.82933903e-01f, 8.12519610e-01f, 3.31136853e-01f, 9.43582714e-01f, 7.68994927e-01f, 6.39254928e-01f,
  9.24909055e-01f, 3.80188406e-01f, 9.76047099e-01f, 2.17559248e-01f, 9.92404640e-01f, 1.23016424e-01f, 9.97596025e-01f, 6.92973137e-02f,
  9.99239624e-01f, 3.89901139e-02f, 9.99759495e-01f, 2.19295528e-02f, 9.99923944e-01f, 1.23325698e-02f, 9.99975979e-01f, 6.93523418e-03f,
  -6.66938066e-01f, 7.45113134e-01f, -8.76379430e-01f, -4.81621295e-01f, 9.96578991e-01f, 8.26458037e-02f, 6.74925625e-01f, 7.37885714e-01f,
  -6.53643608e-01f, -7.56802499e-01f, -6.27679706e-01f, 7.78471708e-01f, 3.01137596e-01f, 9.53580678e-01f, 7.57506192e-01f, 6.52827978e-01f,
  9.21060979e-01f, 3.89418334e-01f, 9.74808276e-01f, 2.23044485e-01f, 9.92010653e-01f, 1.26154065e-01f, 9.97471273e-01f, 7.10712075e-02f,
  9.99200106e-01f, 3.99893373e-02f, 9.99747038e-01f, 2.24917568e-02f, 9.99920011e-01f, 1.26487734e-02f, 9.99974728e-01f, 7.11305765e-03f,
  -9.87339258e-01f, -1.58622667e-01f, -4.84639406e-01f, -8.74714017e-01f, 9.21462357e-01f, 3.88467699e-01f, 5.33756077e-01f, 8.45638454e-01f,
  -5.74824035e-01f, -8.18277061e-01f, -6.70441091e-01f, 7.41962790e-01f, 2.70837069e-01f, 9.62625206e-01f, 7.45777905e-01f, 6.66194677e-01f,
  9.17120814e-01f, 3.98609310e-01f, 9.73538578e-01f, 2.28522688e-01f, 9.91606772e-01f, 1.29290432e-01f, 9.97343302e-01f, 7.28448778e-02f,
  9.99159634e-01f, 4.09885161e-02f, 9.99734223e-01f, 2.30539497e-02f, 9.99915957e-01f, 1.29649751e-02f, 9.99973416e-01f, 7.29088066e-03f,
  -3.99985313e-01f, -9.16521549e-01f, 5.63609414e-02f, -9.98410463e-01f, 7.54965365e-01f, 6.55764699e-01f, 3.75752151e-01f, 9.26720202e-01f,
  -4.90260571e-01f, -8.71575892e-01f, -7.11082935e-01f, 7.03108132e-01f, 2.40265876e-01f, 9.70707119e-01f, 7.33813822e-01f, 6.79350674e-01f,
  9.13088918e-01f, 4.07760441e-01f, 9.72238123e-01f, 2.33993664e-01f, 9.91192937e-01f, 1.32425532e-01f, 9.97212172e-01f, 7.46183172e-02f,
  9.99118149e-01f, 4.19876575e-02f, 9.99721110e-01f, 2.36161388e-02f, 9.99911785e-01f, 1.32811759e-02f, 9.99972105e-01f, 7.46870413e-03f,
  5.55113316e-01f, -8.31774771e-01f, 5.80003142e-01f, -8.14614236e-01f, 5.13598442e-01f, 8.58030677e-01f, 2.05897167e-01f, 9.78573620e-01f,
  -4.00799006e-01f, -9.16166008e-01f, -7.49476731e-01f, 6.62030637e-01f, 2.09454417e-01f, 9.77818429e-01f, 7.21617639e-01f, 6.92291796e-01f,
  9.08965766e-01f, 4.16870773e-01f, 9.70906913e-01f, 2.39457220e-01f, 9.90769207e-01f, 1.35559291e-01f, 9.97077882e-01f, 7.63915181e-02f,
  9.99075651e-01f, 4.29867506e-02f, 9.99707639e-01f, 2.41783205e-02f, 9.99907553e-01f, 1.35973748e-02f, 9.99970794e-01f, 7.64652714e-03f,
  9.99843299e-01f, 1.77019257e-02f, 9.25014675e-01f, -3.79931390e-01f, 2.21298173e-01f, 9.75206196e-01f, 2.95478199e-02f, 9.99563396e-01f,
  -3.07332784e-01f, -9.51602101e-01f, -7.85501122e-01f, 6.18860185e-01f, 1.78433523e-01f, 9.83951986e-01f, 7.09193349e-01f, 7.05014050e-01f,
  9.04751658e-01f, 4.25939471e-01f, 9.69545007e-01f, 2.44913206e-01f, 9.90335584e-01f, 1.38691694e-01f, 9.96940494e-01f, 7.81644881e-02f,
  9.99032140e-01f, 4.39858064e-02f, 9.99693930e-01f, 2.47404929e-02f, 9.99903202e-01f, 1.39135728e-02f, 9.99969363e-01f, 7.82434922e-03f,
  5.25321960e-01f, 8.50903511e-01f, 9.85138178e-01f, 1.71763569e-01f, -9.29481089e-02f, 9.95670974e-01f, -1.47732988e-01f, 9.89027262e-01f,
  -2.10795805e-01f, -9.77530122e-01f, -8.19042206e-01f, 5.73733270e-01f, 1.47234216e-01f, 9.89101648e-01f, 6.96544766e-01f, 7.17513323e-01f,
  9.00447130e-01f, 4.34965521e-01f, 9.68152404e-01f, 2.50361472e-01f, 9.89892066e-01f, 1.41822711e-01f, 9.96799886e-01f, 7.99371973e-02f,
  9.98987675e-01f, 4.49848175e-02f, 9.99679863e-01f, 2.53026579e-02f, 9.99898732e-01f, 1.42297689e-02f, 9.99967992e-01f, 8.00217129e-03f,
  -4.32177931e-01f, 9.01788354e-01f, 7.41858006e-01f, 6.70557022e-01f, -3.97976756e-01f, 9.17395473e-01f, -3.20354372e-01f, 9.47297752e-01f,
  -1.12152621e-01f, -9.93690968e-01f, -8.49993885e-01f, 5.26792526e-01f, 1.15887694e-01f, 9.93262351e-01f, 6.83675885e-01f, 7.29785740e-01f,
  8.96052480e-01f, 4.43948090e-01f, 9.66729224e-01f, 2.55801797e-01f, 9.89438653e-01f, 1.44952312e-01f, 9.96656179e-01f, 8.17096606e-02f,
  9.98942196e-01f, 4.59837839e-02f, 9.99665439e-01f, 2.58648153e-02f, 9.99894202e-01f, 1.45459641e-02f, 9.99966562e-01f, 8.17999430e-03f,
  -9.92335498e-01f, 1.23573124e-01f, 2.70098448e-01f, 9.62832689e-01f, -6.63538277e-01f, 7.48142362e-01f, -4.82871950e-01f, 8.75690997e-01f,
  -1.23883775e-02f, -9.99923289e-01f, -8.78258407e-01f, 4.78186339e-01f, 8.44252855e-02f, 9.96429801e-01f, 6.70590878e-01f, 7.41827428e-01f,
  8.91568303e-01f, 4.52886283e-01f, 9.65275466e-01f, 2.61234075e-01f, 9.88975346e-01f, 1.48080453e-01f, 9.96509314e-01f, 8.34818557e-02f,
  9.98895705e-01f, 4.69827019e-02f, 9.99650776e-01f, 2.64269635e-02f, 9.99889553e-01f, 1.48621574e-02f, 9.99965072e-01f, 8.35781638e-03f,
  -6.40144348e-01f, -7.68254638e-01f, -2.84846604e-01f, 9.58573103e-01f, -8.63296509e-01f, 5.04697084e-01f, -6.30159974e-01f, 7.76465356e-01f,
  8.74991715e-02f, -9.96164620e-01f, -9.03746367e-01f, 4.28068399e-01f, 5.28784581e-02f, 9.98600960e-01f, 6.57293737e-01f, 7.53634512e-01f,
  8.86994898e-01f, 4.61779177e-01f, 9.63791192e-01f, 2.66658038e-01f, 9.88502085e-01f, 1.51207119e-01f, 9.96359289e-01f, 8.52537975e-02f,
  9.98848200e-01f, 4.79815714e-02f, 9.99635756e-01f, 2.69891042e-02f, 9.99884784e-01f, 1.51783489e-02f, 9.99963582e-01f, 8.53563752e-03f,
  3.00592542e-01f, -9.53752637e-01f, -7.52063990e-01f, 6.59090102e-01f, -9.77442741e-01f, 2.11200655e-01f, -7.57573068e-01f, 6.52750373e-01f,
  1.86512470e-01f, -9.82452571e-01f, -9.26377118e-01f, 3.76597136e-01f, 2.12787576e-02f, 9.99773562e-01f, 6.43788815e-01f, 7.65203178e-01f,
  8.82332861e-01f, 4.70625877e-01f, 9.62276459e-01f, 2.72073567e-01f, 9.88018990e-01f, 1.54332280e-01f, 9.96206105e-01f, 8.70254710e-02f,
  9.98799741e-01f, 4.89803962e-02f, 9.99620378e-01f, 2.75512375e-02f, 9.99879956e-01f, 1.54945394e-02f, 9.99962032e-01f, 8.71345960e-03f,
  9.64965999e-01f, -2.62374848e-01f, -9.87659097e-01f, 1.56619072e-01f, -9.94656444e-01f, -1.03240460e-01f, -8.61092687e-01f, 5.08447945e-01f,
  2.83662200e-01f, -9.58924294e-01f, -9.46079254e-01f, 3.23935270e-01f, -1.03422189e-02f, 9.99946535e-01f, 6.30080283e-01f, 7.76529968e-01f,
  8.77582550e-01f, 4.79425550e-01f, 9.60731268e-01f, 2.77480543e-01f, 9.87526000e-01f, 1.57455891e-01f, 9.96049762e-01f, 8.87968615e-02f,
  9.98750269e-01f, 4.99791689e-02f, 9.99604762e-01f, 2.81133596e-02f, 9.99875009e-01f, 1.58107281e-02f, 9.99960482e-01f, 8.89127981e-03f,
  7.42154181e-01f, 6.70229197e-01f, -9.19073522e-01f, -3.94086063e-01f, -9.13230121e-01f, -4.07444149e-01f, -9.37454224e-01f, 3.48108500e-01f,
  3.77977669e-01f, -9.25814748e-01f, -9.62790370e-01f, 2.70249337e-01f, -4.19528559e-02f, 9.99119580e-01f, 6.16172493e-01f, 7.87611187e-01f,
  8.72744501e-01f, 4.88177240e-01f, 9.59155679e-01f, 2.82878697e-01f, 9.87023175e-01f, 1.60577938e-01f, 9.95890260e-01f, 9.05679762e-02f,
  9.98699784e-01f, 5.09778969e-02f, 9.99588788e-01f, 2.86754742e-02f, 9.99869943e-01f, 1.61269177e-02f, 9.99958873e-01f, 9.06910095e-03f,
  -1.62990779e-01f, 9.86627579e-01f, -5.67430019e-01f, -8.23421597e-01f, -7.41239965e-01f, -6.71240151e-01f, -9.84248459e-01f, 1.76790684e-01f,
  4.68516916e-01f, -8.83454502e-01f, -9.76457715e-01f, 2.15709001e-01f, -7.35215396e-02f, 9.97293651e-01f, 6.02069914e-01f, 7.98443377e-01f,
  8.67819190e-01f, 4.96880114e-01f, 9.57549810e-01f, 2.88267940e-01f, 9.86510456e-01f, 1.63698375e-01f, 9.95727658e-01f, 9.23388004e-02f,
  9.98648286e-01f, 5.19765690e-02f, 9.99572515e-01f, 2.92375814e-02f, 9.99864817e-01f, 1.64431017e-02f, 9.99957263e-01f, 9.24692024e-03f,
  -9.18282807e-01f, 3.95925164e-01f, -4.10281904e-02f, -9.99157965e-01f, -4.95741814e-01f, -8.68469954e-01f, -1.00000000e+00f, -1.03020677e-04f,
  5.54374516e-01f, -8.32267344e-01f, -9.87038016e-01f, 1.60486728e-01f, -1.05016708e-01f, 9.94470477e-01f, 5.87776959e-01f, 8.09023023e-01f,
  8.62807095e-01f, 5.05533338e-01f, 9.55913603e-01f, 2.93648034e-01f, 9.85987842e-01f, 1.66817173e-01f, 9.95561838e-01f, 9.41093415e-02f,
  9.98595834e-01f, 5.29751927e-02f, 9.99555886e-01f, 2.97996756e-02f, 9.99859571e-01f, 1.67592876e-02f, 9.99955595e-01f, 9.42474138e-03f,
  -8.29309821e-01f, -5.58789074e-01f, 4.98009592e-01f, -8.67171526e-01f, -2.01079622e-01f, -9.79574919e-01f, -9.84212041e-01f, -1.76993474e-01f,
  6.34692967e-01f, -7.72764444e-01f, -9.94497895e-01f, 1.04756832e-01f, -1.36406869e-01f, 9.90652919e-01f, 5.73298037e-01f, 8.19346905e-01f,
  8.57708693e-01f, 5.14135957e-01f, 9.54247177e-01f, 2.99018890e-01f, 9.85455394e-01f, 1.69934288e-01f, 9.95392919e-01f, 9.58795771e-02f,
  9.98542368e-01f, 5.39737605e-02f, 9.99538958e-01f, 3.03617641e-02f, 9.99854207e-01f, 1.70754679e-02f, 9.99953866e-01f, 9.60256159e-03f,
  2.21267566e-02f, -9.99755144e-01f, 8.83669317e-01f, -4.68111664e-01f, 1.13521777e-01f, -9.93535519e-01f, -9.37382519e-01f, -3.48301649e-01f,
  7.08669782e-01f, -7.05540299e-01f, -9.98813629e-01f, 4.86960001e-02f, -1.67660639e-01f, 9.85844791e-01f, 5.58637917e-01f, 8.29411685e-01f,
  8.52524519e-01f, 5.22687256e-01f, 9.52550590e-01f, 3.04380238e-01f, 9.84913111e-01f, 1.73049718e-01f, 9.95220840e-01f, 9.76495072e-02f,
  9.98487890e-01f, 5.49722798e-02f, 9.99521732e-01f, 3.09238415e-02f, 9.99848783e-01f, 1.73916500e-02f, 9.99952197e-01f, 9.78038087e-03f,
  8.53220105e-01f, -5.21551013e-01f, 9.97174621e-01f, 7.51182064e-02f, 4.16867077e-01f, -9.08967435e-01f, -8.60988438e-01f, -5.08624554e-01f,
  7.75565803e-01f, -6.31266713e-01f, -9.99971747e-01f, -7.51878507e-03f, -1.98746875e-01f, 9.80050862e-01f, 5.43801069e-01f, 8.39214146e-01f,
  8.47255111e-01f, 5.31186223e-01f, 9.50823903e-01f, 3.09731960e-01f, 9.84360933e-01f, 1.76163420e-01f, 9.95045662e-01f, 9.94191393e-02f,
  9.98432398e-01f, 5.59707358e-02f, 9.99504209e-01f, 3.14859077e-02f, 9.99843180e-01f, 1.77078284e-02f, 9.99950409e-01f, 9.95820016e-03f,
  8.99866819e-01f, 4.36164767e-01f, 8.03569078e-01f, 5.95211506e-01f, 6.78870201e-01f, -7.34258294e-01f, -7.57439196e-01f, -6.52905703e-01f,
  8.34712923e-01f, -5.50685287e-01f, -9.97968495e-01f, -6.37097955e-02f, -2.29634270e-01f, 9.73276973e-01f, 5.28792322e-01f, 8.48751247e-01f,
  8.41901004e-01f, 5.39632022e-01f, 9.49067116e-01f, 3.15073937e-01f, 9.83798921e-01f, 1.79275364e-01f, 9.94867265e-01f, 1.01188451e-01f,
  9.98375952e-01f, 5.69691435e-02f, 9.99486327e-01f, 3.20479684e-02f, 9.99837577e-01f, 1.80240069e-02f, 9.99948621e-01f, 1.01360194e-02f,
  1.19180135e-01f, 9.92872655e-01f, 3.62476677e-01f, 9.31992829e-01f, 8.73550534e-01f, -4.86733496e-01f, -6.30000710e-01f, -7.76594579e-01f,
  8.85519624e-01f, -4.64602023e-01f, -9.92810190e-01f, -1.19699396e-01f, -2.60292053e-01f, 9.65529919e-01f, 5.13616323e-01f, 8.58020008e-01f,
  8.36462677e-01f, 5.48023939e-01f, 9.47280347e-01f, 3.20405900e-01f, 9.83227074e-01f, 1.82385504e-01f, 9.94685769e-01f, 1.02957435e-01f,
  9.98318493e-01f, 5.79674877e-02f, 9.99468148e-01f, 3.26100141e-02f, 9.99831796e-01f, 1.83401816e-02f, 9.99946833e-01f, 1.03138378e-02f,
  -7.71080196e-01f, 6.36738002e-01f, -1.90249100e-01f, 9.81735826e-01f, 9.81602073e-01f, -1.90938011e-01f, -4.82692331e-01f, -8.75790000e-01f,
  9.27478492e-01f, -3.73876572e-01f, -9.84513164e-01f, -1.75310582e-01f, -2.90689558e-01f, 9.56817448e-01f, 4.98277903e-01f, 8.67017388e-01f,
  8.30940723e-01f, 5.56361020e-01f, 9.45463598e-01f, 3.25727791e-01f, 9.82645452e-01f, 1.85493827e-01f, 9.94501114e-01f, 1.04726106e-01f,
  9.98260021e-01f, 5.89657798e-02f, 9.99449670e-01f, 3.31720486e-02f, 9.99825954e-01f, 1.86563563e-02f, 9.99944985e-01f, 1.04916561e-02f,
  -9.52412963e-01f, -3.04810613e-01f, -6.84381902e-01f, 7.29123712e-01f, 9.92308319e-01f, 1.23790950e-01f, -3.20159167e-01f, -9.47363734e-01f,
  9.60170269e-01f, -2.79415488e-01f, -9.73103702e-01f, -2.30367512e-01f, -3.20796400e-01f, 9.47148204e-01f, 4.82782036e-01f, 8.75740528e-01f,
  8.25335622e-01f, 5.64642429e-01f, 9.43616986e-01f, 3.31039310e-01f, 9.82053936e-01f, 1.88600287e-01f, 9.94313300e-01f, 1.06494442e-01f,
  9.98200536e-01f, 5.99640086e-02f, 9.99430835e-01f, 3.37340795e-02f, 9.99819994e-01f, 1.89725272e-02f, 9.99943078e-01f, 1.06694745e-02f,
  -2.58101642e-01f, -9.66117799e-01f, -9.67739642e-01f, 2.51952261e-01f, 9.04607594e-01f, 4.26245421e-01f, -1.47529200e-01f, -9.89057720e-01f,
  9.83268440e-01f, -1.82162598e-01f, -9.58617806e-01f, -2.84696162e-01f, -3.50582451e-01f, 9.36531842e-01f, 4.67133403e-01f, 8.84186864e-01f,
  8.19648027e-01f, 5.72867453e-01f, 9.41740453e-01f, 3.36340427e-01f, 9.81452644e-01f, 1.91704854e-01f, 9.94122326e-01f, 1.08262435e-01f,
  9.98140097e-01f, 6.09621815e-02f, 9.99411702e-01f, 3.42960916e-02f, 9.99813974e-01f, 1.92886982e-02f, 9.99941170e-01f, 1.08472919e-02f,
  6.73507154e-01f, -7.39180684e-01f, -9.53050017e-01f, -3.02812874e-01f, 7.27198064e-01f, 6.86427653e-01f, 2.97537707e-02f, -9.99557257e-01f,
  9.96542096e-01f, -8.30891207e-02f, -9.41101313e-01f, -3.38124752e-01f, -3.80017966e-01f, 9.24979091e-01f, 4.51337039e-01f, 8.92353535e-01f,
  8.13878477e-01f, 5.81035137e-01f, 9.39834237e-01f, 3.41630876e-01f, 9.80841517e-01f, 1.94807529e-01f, 9.93928254e-01f, 1.10030092e-01f,
  9.98078644e-01f, 6.19602874e-02f, 9.99392271e-01f, 3.48580964e-02f, 9.99807835e-01f, 1.96048655e-02f, 9.99939203e-01f, 1.10251084e-02f,
  9.85896587e-01f, 1.67355701e-01f, -6.44837022e-01f, -7.64320076e-01f, 4.77671444e-01f, 8.78538549e-01f, 2.06098333e-01f, -9.78531301e-01f,
  9.99858618e-01f, 1.68140903e-02f, -9.20609534e-01f, -3.90484393e-01f, -4.09073502e-01f, 9.12501454e-01f, 4.35397953e-01f, 9.00238097e-01f,
  8.08027506e-01f, 5.89144766e-01f, 9.37898219e-01f, 3.46910536e-01f, 9.80220556e-01f, 1.97908238e-01f, 9.93731022e-01f, 1.11797392e-01f,
  9.98016179e-01f, 6.29583374e-02f, 9.99372482e-01f, 3.54200937e-02f, 9.99801576e-01f, 1.99210308e-02f, 9.99937236e-01f, 1.12029258e-02f,
};

constexpr int T_ALL = 36864, T_CTX = 4096;
constexpr int NLAYER = 4;
constexpr float EPS = 1e-6f;
constexpr int LK_LAT = 4352;

struct Params {
  const float* x_prompt; const float* x_sample; const float* cache_ckv; const float* cache_krope;
  const float* cache_k; const float* cache_v; const float* state; const float* c; const float* c_ctx;
  const float* w_mod; const float* b_mod; const float* g_norm; const float* w_in; const float* conv_w; const float* conv_b;
  const float* lru_wa; const float* lru_ba; const float* lru_wi; const float* lru_bi; const float* lru_lam;
  const float* q_norm; const float* w_uq; const float* kv_norm; const float* w_ukv; const float* sink;
  const float* w_br_rnn; const float* w_br_mla; const float* w_br_swa; const float* w_out; const float* final_norm;
  float* out; char* ws;
};

constexpr size_t AL(size_t x) { return (x + 255) & ~(size_t)255; }
constexpr size_t O_WINA = 0;
constexpr size_t O_WINB = O_WINA + AL((size_t)2560 * 1024 * 2);
constexpr size_t O_WLRU = O_WINB + AL((size_t)5120 * 1024 * 2);
constexpr size_t O_WUQ = O_WLRU + AL((size_t)4096 * 128 * 2);
constexpr size_t O_WUKVG = O_WUQ + AL((size_t)768 * 384 * 2);
constexpr size_t O_WUKVR = O_WUKVG + AL((size_t)1024 * 256 * 2);
constexpr size_t O_WBRR = O_WUKVR + AL((size_t)1024 * 256 * 2);
constexpr size_t O_WBRM = O_WBRR + AL((size_t)1024 * 1024 * 2);
constexpr size_t O_WBRS = O_WBRM + AL((size_t)1024 * 512 * 2);
constexpr size_t O_WOUT = O_WBRS + AL((size_t)1024 * 512 * 2);
constexpr size_t O_MOD = O_WOUT + AL((size_t)1024 * 1024 * 2);
constexpr size_t O_H = O_MOD + AL((size_t)4 * 9 * 3072 * 4);
constexpr size_t O_XR = O_H + AL((size_t)T_ALL * 1024 * 2);
constexpr size_t O_CQ = O_XR + AL((size_t)T_ALL * 1024 * 2);
constexpr size_t O_CKV = O_CQ + AL((size_t)T_ALL * 384 * 2);
constexpr size_t O_CKVC = O_CKV + AL((size_t)T_ALL * 256 * 2);
constexpr size_t O_KRL = O_CKVC + AL((size_t)2048 * 256 * 2);
constexpr size_t O_KRC = O_KRL + AL((size_t)8 * LK_LAT * 32 * 2);
constexpr size_t O_QS = O_KRC + AL((size_t)16 * 256 * 32 * 2);
constexpr size_t O_KS = O_QS + AL((size_t)T_ALL * 512 * 2);
constexpr size_t O_KSC = O_KS + AL((size_t)T_ALL * 128 * 2);
constexpr size_t O_VTSL = O_KSC + AL((size_t)8 * 256 * 128 * 2);
constexpr size_t O_VTSC = O_VTSL + AL((size_t)8 * 2 * 64 * 4096 * 2);
constexpr size_t O_VTSCC = O_VTSC + AL((size_t)16 * 2 * 64 * 256 * 2);
constexpr size_t O_Q = O_VTSCC + AL((size_t)8 * 2 * 64 * 256 * 2);
constexpr size_t O_KNL = O_Q + AL((size_t)T_ALL * 768 * 2);
constexpr size_t O_KNC = O_KNL + AL((size_t)8 * 8 * LK_LAT * 64 * 2);
constexpr size_t O_VTL = O_KNC + AL((size_t)16 * 8 * 256 * 64 * 2);
constexpr size_t O_VTC = O_VTL + AL((size_t)8 * 8 * 64 * LK_LAT * 2);
constexpr size_t O_YRNN = O_VTC + AL((size_t)16 * 8 * 64 * 256 * 2);
static_assert(O_YRNN - O_KS >= (size_t)2 * T_ALL * 1024 * 2, "merge-gate buffers do not fit");
constexpr size_t O_SUM = O_YRNN + AL((size_t)T_ALL * 1024 * 2);
constexpr size_t O_BAR = O_SUM + AL((size_t)8 * 8 * 2 * 16 * 256 * 4);
constexpr size_t BAR_BYTES = 16384;
constexpr size_t O_W2 = O_BAR + BAR_BYTES;
constexpr size_t WS_NEED = O_W2 + O_MOD;

constexpr size_t OUT_CKV = (size_t)T_ALL * 1024;
constexpr size_t OUT_KROPE = OUT_CKV + (size_t)16 * 4 * 256 * 256;
constexpr size_t OUT_SK = OUT_KROPE + (size_t)16 * 4 * 256 * 32;
constexpr size_t OUT_SV = OUT_SK + (size_t)16 * 4 * 256 * 128;
constexpr size_t OUT_RG = OUT_SV + (size_t)16 * 4 * 256 * 128;

#define SB() __builtin_amdgcn_sched_barrier(0)
#define MB() asm volatile("" ::: "memory")
DI int tid() { int t = threadIdx.x; asm volatile("" : "+v"(t)); return t; }
DI int xcd_map(int base) {
  const int g = gridDim.x;
  if (g & 7) return base + blockIdx.x;
  return base + (blockIdx.x & 7) * (g >> 3) + (blockIdx.x >> 3);
}
#define LANEVARS const int t = tid(), lane = t & 63, w = t >> 6, wr = w >> 1, wc = w & 1; const int c16 = lane & 15, g4 = lane >> 4; (void)wr; (void)wc; (void)c16; (void)g4;
DI float bf2f(u16 v) { return __uint_as_float(((unsigned)v) << 16); }
DI unsigned pack2(float a, float b) {
  f2_t v = {a, b};
  bf2_t r = __builtin_convertvector(v, bf2_t);
  return __builtin_bit_cast(unsigned, r);
}
DI u16 f2bf(float a) { return (u16)(pack2(a, 0.f) & 0xffffu); }
DI float sigmoidf_(float x) { return __builtin_amdgcn_rcpf(1.f + __expf(-x)); }
DI float wave_sum(float v) {
#pragma unroll
  for (int o = 32; o > 0; o >>= 1) v += __shfl_xor(v, o);
  return v;
}
DI int perm32(int p) { return (p & 7) | ((p & 8) << 1) | ((p & 16) >> 1); }
DI const float* xin_row(const Params& p, int l, int row) {
  if (l == 0) return row < T_CTX ? p.x_prompt + (size_t)row * 1024 : p.x_sample + (size_t)(row - T_CTX) * 1024;
  return p.out + (size_t)row * 1024;
}
template <class T> DI T* wsp(const Params& p, size_t off) { return (T*)(p.ws + off); }
DI u16* wsw(const Params& p, int l, size_t off) { return (u16*)(p.ws + ((l & 1) ? O_W2 : 0) + off); }

template <int NJ>
DI void gemm_tile_t(const u16* A, int lda, const u16* B, int ldb, int K,
                    f32x4 (&acc)[4][NJ], char* smem) {
  const int t = tid(), lane = t & 63, w = t >> 6, wr = w >> 1, wc = w & 1;
  const int lr = t >> 3, slot = t & 7;
  const int c16 = lane & 15, g4 = lane >> 4;
  const int gch = slot ^ ((lr >> 1) & 7);
  const u16* ap = A + (size_t)lr * lda + gch * 8;
  const u16* bp = B + (size_t)lr * ldb + gch * 8;
  char* sdst = smem + t * 16;
#define DMA16(gp, lp) __builtin_amdgcn_global_load_lds((const unsigned*)(gp), (unsigned*)(lp), 16, 0, 0)
#define STAGE(base, ko) { DMA16(ap + (ko), (base)); DMA16(ap + (size_t)32 * lda + (ko), (base) + 4096); \
    DMA16(ap + (size_t)64 * lda + (ko), (base) + 8192); DMA16(ap + (size_t)96 * lda + (ko), (base) + 12288); \
    DMA16(bp + (ko), (base) + 16384); DMA16(bp + (size_t)32 * ldb + (ko), (base) + 16384 + 4096); \
    if (NJ > 2) { DMA16(bp + (size_t)64 * ldb + (ko), (base) + 16384 + 8192); DMA16(bp + (size_t)96 * ldb + (ko), (base) + 16384 + 12288); } }
  const int nk = K >> 6;
  const int arow = (wr * 64 + c16) * 128, brow = (wc * (16 * NJ) + c16) * 128;
  const int sw = (c16 >> 1) & 7;
  int kk = 0;
  STAGE(sdst, kk * 64)
  __syncthreads();
  for (int kt = 0; kt < nk; ++kt) {
    char* cur = smem + (kt & 1) * 32768;
    kk = (kk + 1 == nk) ? 0 : kk + 1;
    if (kt + 1 < nk) { char* nxt = sdst + ((kt + 1) & 1) * 32768; STAGE(nxt, kk * 64) }
#pragma unroll
    for (int ks = 0; ks < 2; ++ks) {
      bf16x8 af[4], bfr[NJ];
      const int ch = ((ks * 4 + g4) ^ sw) << 4;
#pragma unroll
      for (int i = 0; i < 4; ++i) af[i] = *(const bf16x8*)(cur + arow + i * 2048 + ch);
#pragma unroll
      for (int i = 0; i < NJ; ++i) bfr[i] = *(const bf16x8*)(cur + 16384 + brow + i * 2048 + ch);
#pragma unroll
      for (int i = 0; i < 4; ++i)
#pragma unroll
        for (int j = 0; j < NJ; ++j)
          acc[i][j] = __builtin_amdgcn_mfma_f32_16x16x32_bf16(af[i], bfr[j], acc[i][j], 0, 0, 0);
    }
    SB();
    __syncthreads();
  }
#undef STAGE
#undef DMA16
}
DI void gemm_tile(const u16* A, int lda, const u16* B, int ldb, int K,
                  f32x4 (&acc)[4][4], char* smem) {
  gemm_tile_t<4>(A, lda, B, ldb, K, acc, smem);
}
DI void zero_acc(f32x4 (&acc)[4][4]) {
#pragma unroll
  for (int i = 0; i < 4; ++i)
#pragma unroll
    for (int j = 0; j < 4; ++j) acc[i][j] = f32x4{0.f, 0.f, 0.f, 0.f};
}

struct TokTile { int g0; int is_ctx; int b; int p0; };
DI TokTile tok_tile(int mt) {
  TokTile r; r.g0 = mt * 128;
  if (r.g0 < T_CTX) { r.is_ctx = 1; r.b = r.g0 >> 8; r.p0 = r.g0 & 255; }
  else { r.is_ctx = 0; r.b = (r.g0 - T_CTX) >> 12; r.p0 = (r.g0 - T_CTX) & 4095; }
  return r;
}

DI void phase_mod(const Params& p, char* smem) {
  float* s_silu = (float*)smem;
  float* s_part = (float*)(smem + 36864);
  float* MOD = wsp<float>(p, O_MOD);
  const int t = tid();
  for (int i = t; i < 9 * 1024; i += 256) {
    float v = (i < 8192) ? p.c[i] : p.c_ctx[i - 8192];
    s_silu[i] = v * sigmoidf_(v);
  }
  __syncthreads();
  const int kg = t >> 6, cl = t & 63;
  for (int u = blockIdx.x; u < 4 * 48; u += gridDim.x) {
    const int l = u / 48, cb = u % 48;
    const int n = cb * 64 + cl;
    float acc[9];
#pragma unroll
    for (int ci = 0; ci < 9; ++ci) acc[ci] = 0.f;
    const float* wp = p.w_mod + ((size_t)l * 1024 + kg * 256) * 3072 + n;
    for (int k = 0; k < 256; ++k) {
      float wv = wp[(size_t)k * 3072];
#pragma unroll
      for (int ci = 0; ci < 9; ++ci) acc[ci] += s_silu[ci * 1024 + kg * 256 + k] * wv;
    }
#pragma unroll
    for (int ci = 0; ci < 9; ++ci) s_part[(kg * 9 + ci) * 64 + cl] = acc[ci];
    __syncthreads();
    for (int idx = t; idx < 9 * 64; idx += 256) {
      int ci = idx >> 6, c2 = idx & 63;
      float s = s_part[(0 * 9 + ci) * 64 + c2] + s_part[(1 * 9 + ci) * 64 + c2] + s_part[(2 * 9 + ci) * 64 + c2] +
                s_part[(3 * 9 + ci) * 64 + c2];
      MOD[((size_t)l * 9 + ci) * 3072 + cb * 64 + c2] = s + p.b_mod[l * 3072 + cb * 64 + c2];
    }
    __syncthreads();
  }
}

template <class F> DI void conv_job(u16* dst, int N, int K, F src) {
  const int total = N * (K >> 3);
  for (int idx = blockIdx.x * 256 + tid(); idx < total; idx += gridDim.x * 256) {
    const int n = idx % N, kb = idx / N;
    float v[8];
#pragma unroll
    for (int j = 0; j < 8; ++j) v[j] = src(kb * 8 + j, n);
    uint4 o;
    o.x = pack2(v[0], v[1]); o.y = pack2(v[2], v[3]); o.z = pack2(v[4], v[5]); o.w = pack2(v[6], v[7]);
    *(uint4*)(dst + (size_t)n * K + kb * 8) = o;
  }
}

DI void convert_weights(const Params& p, int l) {
  {
    const float* win = p.w_in + (size_t)l * 1024 * 7584;
    conv_job(wsw(p, l, O_WINA), 2560, 1024, [&](int k, int n) -> float {
      int col;
      if (n < 1024) col = n;
      else if (n < 1408) col = 2048 + (n - 1024);
      else if (n < 1664) col = 2432 + (n - 1408);
      else if (n < 1792) { int pp = n - 1664; col = pp < 32 ? 2688 + perm32(pp) : -1; }
      else if (n < 2304) col = 3232 + (n - 1792);
      else if (n < 2432) col = 3744 + (n - 2304);
      else col = 3872 + (n - 2432);
      return col < 0 ? 0.f : win[(size_t)k * 7584 + col];
    });
    conv_job(wsw(p, l, O_WINB), 5120, 1024, [&](int k, int n) -> float {
      int col;
      if (n < 1024) col = 1024 + n;
      else if (n < 1536) col = 2720 + (n - 1024);
      else if (n < 2048) col = 4000 + (n - 1536);
      else col = 4512 + (n - 2048);
      return win[(size_t)k * 7584 + col];
    });
    const float* wa = p.lru_wa + (size_t)l * 2 * 8 * 128 * 128;
    const float* wi = p.lru_wi + (size_t)l * 2 * 8 * 128 * 128;
    conv_job(wsw(p, l, O_WLRU), 4096, 128, [&](int k, int n) -> float {
      int db = n >> 8, nn = n & 255;
      return nn < 128 ? wa[((size_t)db * 128 + k) * 128 + nn] : wi[((size_t)db * 128 + k) * 128 + (nn - 128)];
    });
    const float* wuq = p.w_uq + (size_t)l * 384 * 768;
    const float* gq = p.q_norm + l * 384;
    conv_job(wsw(p, l, O_WUQ), 768, 384, [&](int k, int n) -> float {
      int col;
      if (n < 512) col = (n >> 6) * 96 + (n & 63);
      else { int hh = (n - 512) >> 5, pp = (n - 512) & 31; col = hh * 96 + 64 + perm32(pp); }
      return gq[k] * wuq[(size_t)k * 768 + col];
    });
    const float* wukv = p.w_ukv + (size_t)l * 256 * 1024;
    const float* gkv = p.kv_norm + l * 256;
    conv_job(wsw(p, l, O_WUKVG), 1024, 256, [&](int k, int n) -> float { return gkv[k] * wukv[(size_t)k * 1024 + n]; });
    conv_job(wsw(p, l, O_WUKVR), 1024, 256, [&](int k, int n) -> float { return wukv[(size_t)k * 1024 + n]; });
    const float* w1 = p.w_br_rnn + (size_t)l * 1024 * 1024;
    conv_job(wsw(p, l, O_WBRR), 1024, 1024, [&](int k, int n) -> float { return w1[(size_t)k * 1024 + n]; });
    const float* w2 = p.w_br_mla + (size_t)l * 512 * 1024;
    conv_job(wsw(p, l, O_WBRM), 1024, 512, [&](int k, int n) -> float { return w2[(size_t)k * 1024 + n]; });
    const float* w3 = p.w_br_swa + (size_t)l * 512 * 1024;
    conv_job(wsw(p, l, O_WBRS), 1024, 512, [&](int k, int n) -> float { return w3[(size_t)k * 1024 + n]; });
    const float* w4 = p.w_out + (size_t)l * 1024 * 1024;
    conv_job(wsw(p, l, O_WOUT), 1024, 1024, [&](int k, int n) -> float { return w4[(size_t)k * 1024 + n]; });
  }
}

DI void phase_prep(const Params& p, int l) {
  const int t = tid(), lane = t & 63, w = t >> 6;
  const float* MOD = wsp<float>(p, O_MOD) + (size_t)l * 9 * 3072;
  u16* H = wsp<u16>(p, O_H);
  for (int row = blockIdx.x * 4 + w; row < T_ALL; row += gridDim.x * 4) {
    const float* x = xin_row(p, l, row);
    const int ci = row < T_CTX ? 8 : ((row - T_CTX) >> 12);
    const float* md = MOD + ci * 3072;
    float4 v[4];
    float ss = 0.f;
#pragma unroll
    for (int i = 0; i < 4; ++i) {
      v[i] = *(const float4*)(x + i * 256 + lane * 4);
      ss += v[i].x * v[i].x + v[i].y * v[i].y + v[i].z * v[i].z + v[i].w * v[i].w;
    }
    ss = wave_sum(ss);
    const float rs = rsqrtf(ss * (1.f / 1024.f) + EPS);
#pragma unroll
    for (int i = 0; i < 4; ++i) {
      const int c = i * 256 + lane * 4;
      const float4 g = *(const float4*)(p.g_norm + l * 1024 + c);
      const float4 sh = *(const float4*)(md + c);
      const float4 sc = *(const float4*)(md + 1024 + c);
      float h0 = v[i].x * rs * g.x * (1.f + sc.x) + sh.x;
      float h1 = v[i].y * rs * g.y * (1.f + sc.y) + sh.y;
      float h2 = v[i].z * rs * g.z * (1.f + sc.z) + sh.z;
      float h3 = v[i].w * rs * g.w * (1.f + sc.w) + sh.w;
      uint2 o; o.x = pack2(h0, h1); o.y = pack2(h2, h3);
      *(uint2*)(H + (size_t)row * 1024 + c) = o;
    }
  }
  {
    const int gt = blockIdx.x * 256 + t, gs = gridDim.x * 256;
    u16* ckvc = wsp<u16>(p, O_CKVC);
    for (int i = gt; i < 2048 * 256; i += gs) {
      int r = i >> 8, k = i & 255, b = r >> 8, pos = r & 255;
      ckvc[i] = f2bf(p.cache_ckv[(((size_t)b * 4 + l) * 256 + pos) * 256 + k]);
    }
    u16* krl = wsp<u16>(p, O_KRL);
    for (int i = gt; i < 8 * 256 * 32; i += gs) {
      int pp = i & 31, pos = (i >> 5) & 255, b = i >> 13;
      krl[((size_t)b * LK_LAT + pos) * 32 + pp] = f2bf(p.cache_krope[(((size_t)b * 4 + l) * 256 + pos) * 32 + perm32(pp)]);
    }
    u16* ksc = wsp<u16>(p, O_KSC);
    for (int i = gt; i < 8 * 256 * 128; i += gs) {
      int c = i & 127, pos = (i >> 7) & 255, b = i >> 15;
      ksc[i] = f2bf(p.cache_k[(((size_t)b * 4 + l) * 256 + pos) * 128 + c]);
    }
    u16* vtc = wsp<u16>(p, O_VTSCC);
    for (int i = gt; i < 8 * 2 * 64 * 256; i += gs) {
      int pos = i & 255, dv = (i >> 8) & 63, kvh = (i >> 14) & 1, b = i >> 15;
      vtc[i] = f2bf(p.cache_v[(((size_t)b * 4 + l) * 256 + pos) * 128 + kvh * 64 + dv]);
    }
  }
}

DI void phase_gemmA(const Params& p, int l, char* smem) {
  const u16* H = wsp<u16>(p, O_H);
  const u16* W = wsw(p, l, O_WINA);
  for (int base = 0; base < 288 * 20; base += gridDim.x) {
    const int tile = xcd_map(base);
    if (tile >= 288 * 20) continue;
    const int sb = tile >> 5, jj = tile & 31;
    const int mt = (sb / 5) * 8 + (jj >> 2), nt = (sb % 5) * 4 + (jj & 3);
    const TokTile tt = tok_tile(mt);
    f32x4 acc[4][4];
    zero_acc(acc);
    gemm_tile(H + (size_t)tt.g0 * 1024, 1024, W + (size_t)nt * 128 * 1024, 1024, 1024, acc, smem);
    LANEVARS
    if (nt < 13) {
      u16* dst; int ld, cb;
      if (nt < 8) { dst = wsp<u16>(p, O_XR); ld = 1024; cb = nt * 128; }
      else if (nt < 11) { dst = wsp<u16>(p, O_CQ); ld = 384; cb = (nt - 8) * 128; }
      else { dst = wsp<u16>(p, O_CKV); ld = 256; cb = (nt - 11) * 128; }
#pragma unroll
      for (int i = 0; i < 4; ++i)
#pragma unroll
        for (int j = 0; j < 4; ++j)
#pragma unroll
          for (int e = 0; e < 4; ++e) {
            const int g = tt.g0 + wr * 64 + i * 16 + g4 * 4 + e;
            dst[(size_t)g * ld + cb + wc * 64 + j * 16 + c16] = f2bf(acc[i][j][e]);
            if (e == 3 && j == 3) SB();
          }
    } else if (nt == 13) {
      if (wc == 0) {
#pragma unroll
        for (int i = 0; i < 4; ++i)
#pragma unroll
          for (int e = 0; e < 4; ++e) {
            SB();
            const int r = wr * 64 + i * 16 + g4 * 4 + e;
            const int pos = tt.p0 + r;
            float x1 = acc[i][0][e], x2 = acc[i][1][e];
            if (tt.is_ctx) {
              u16* kr = wsp<u16>(p, O_KRC) + ((size_t)tt.b * 256 + pos) * 32;
              kr[c16] = f2bf(x1); kr[c16 + 16] = f2bf(x2);
              float* o = p.out + OUT_KROPE + (((size_t)tt.b * 4 + l) * 256 + pos) * 32;
              o[perm32(c16)] = x1; o[perm32(c16 + 16)] = x2;
            } else {
              const int pv = (c16 >= 8) ? (pos & 63) : (pos >> 6);
              const float cs = TAB_M[(pv * 8 + (c16 & 7)) * 2], sn = TAB_M[(pv * 8 + (c16 & 7)) * 2 + 1];
              u16* kr = wsp<u16>(p, O_KRL) + ((size_t)tt.b * LK_LAT + 256 + pos) * 32;
              kr[c16] = f2bf(x1 * cs - x2 * sn); kr[c16 + 16] = f2bf(x2 * cs + x1 * sn);
            }
          }
      }
    } else if (nt < 19) {
      const bool isk = (nt == 18);
      u16* dst = isk ? wsp<u16>(p, O_KS) : wsp<u16>(p, O_QS);
      const int ld = isk ? 128 : 512;
      const int cb = isk ? wc * 64 : ((nt - 14) * 2 + wc) * 64;
#pragma unroll
      for (int i = 0; i < 4; ++i)
#pragma unroll
        for (int e = 0; e < 4; ++e) {
          SB();
          const int r = wr * 64 + i * 16 + g4 * 4 + e;
          const int pos = tt.p0 + r, g = tt.g0 + r;
          float v0 = acc[i][0][e], v1 = acc[i][1][e], v2 = acc[i][2][e], v3 = acc[i][3][e];
          if (!tt.is_ctx) {
            const int pr = pos >> 6, pc = pos & 63;
            const float c0 = TAB_S[(pr * 16 + c16) * 2], s0 = TAB_S[(pr * 16 + c16) * 2 + 1];
            const float c1 = TAB_S[(pc * 16 + c16) * 2], s1 = TAB_S[(pc * 16 + c16) * 2 + 1];
            float a0 = v0 * c0 - v1 * s0, a1 = v1 * c0 + v0 * s0;
            float a2 = v2 * c1 - v3 * s1, a3 = v3 * c1 + v2 * s1;
            v0 = a0; v1 = a1; v2 = a2; v3 = a3;
          } else if (isk) {
            float* o = p.out + OUT_SK + (((size_t)tt.b * 4 + l) * 256 + pos) * 128 + cb + c16;
            o[0] = v0; o[16] = v1; o[32] = v2; o[48] = v3;
          }
          u16* d = dst + (size_t)g * ld + cb + c16;
          d[0] = f2bf(v0); d[16] = f2bf(v1); d[32] = f2bf(v2); d[48] = f2bf(v3);
        }
    } else {
      u16* vt = tt.is_ctx ? wsp<u16>(p, O_VTSC) : wsp<u16>(p, O_VTSL);
      const int L = tt.is_ctx ? 256 : 4096;
#pragma unroll
      for (int i = 0; i < 4; ++i)
#pragma unroll
        for (int j = 0; j < 4; ++j) {
          SB();
          const int r = wr * 64 + i * 16 + g4 * 4;
          const int pos = tt.p0 + r, dv = j * 16 + c16;
          uint2 o; o.x = pack2(acc[i][j][0], acc[i][j][1]); o.y = pack2(acc[i][j][2], acc[i][j][3]);
          *(uint2*)(vt + (((size_t)tt.b * 2 + wc) * 64 + dv) * L + pos) = o;
          if (tt.is_ctx) {
#pragma unroll
            for (int e = 0; e < 4; ++e)
              p.out[OUT_SV + (((size_t)tt.b * 4 + l) * 256 + pos + e) * 128 + wc * 64 + dv] = acc[i][j][e];
          }
        }
    }
  }
}

DI void row_scales(const u16* A, int K, float* s_rs) {
  const int t = tid(), row = t >> 1, half = t & 1;
  const u16* ap = A + (size_t)row * K + half * (K >> 1);
  float ss = 0.f;
  for (int c = 0; c < (K >> 4); ++c) {
    uint4 v = *(const uint4*)(ap + c * 8);
    unsigned wv[4] = {v.x, v.y, v.z, v.w};
#pragma unroll
    for (int q = 0; q < 4; ++q) {
      float a = __uint_as_float(wv[q] << 16), b = __uint_as_float(wv[q] & 0xffff0000u);
      ss += a * a + b * b;
    }
  }
  ss += __shfl_xor(ss, 1);
  if (half == 0) s_rs[row] = rsqrtf(ss / (float)K + EPS);
}

template <int MODE> DI void scan_seg(const Params& p, int l, int seq, int blk, int d, int seg, char* smem);
DI void phase_qkv(const Params& p, int l, char* smem) {
  float* s_rs = (float*)(smem + 65536);
  constexpr int NQ = 288 * 6, NKV = 304 * 8, NS1 = 2048;
  for (int base = 0; base < NS1 + NQ + NKV; base += gridDim.x) {
    const int tile0 = xcd_map(base);
    if (tile0 >= NS1 + NQ + NKV) continue;
    if (tile0 < NS1) {
      scan_seg<0>(p, l, 16 + (tile0 >> 8), (tile0 >> 5) & 7, (tile0 >> 4) & 1, tile0 & 15, smem);
#if PROBE == 4
      scan_seg<0>(p, l, 16 + (tile0 >> 8), (tile0 >> 5) & 7, (tile0 >> 4) & 1, tile0 & 15, smem);
#endif
      continue;
    }
    const int tile = tile0 - NS1;
    f32x4 acc[4][4];
    zero_acc(acc);
    if (tile < NQ) {
      const int mt = tile / 6, nt = tile % 6;
      const TokTile tt = tok_tile(mt);
      const u16* A = wsp<u16>(p, O_CQ) + (size_t)tt.g0 * 384;
      row_scales(A, 384, s_rs);
      gemm_tile(A, 384, wsw(p, l, O_WUQ) + (size_t)nt * 128 * 384, 384, 384, acc, smem);
      LANEVARS
      u16* Q = wsp<u16>(p, O_Q);
#pragma unroll
      for (int i = 0; i < 4; ++i)
#pragma unroll
        for (int e = 0; e < 4; ++e) {
          SB();
          const int r = wr * 64 + i * 16 + g4 * 4 + e;
          const int pos = tt.p0 + r, g = tt.g0 + r;
          const float rs = s_rs[r];
          float v0 = acc[i][0][e] * rs, v1 = acc[i][1][e] * rs, v2 = acc[i][2][e] * rs, v3 = acc[i][3][e] * rs;
          if (nt >= 4 && !tt.is_ctx) {
            const int pv = (c16 >= 8) ? (pos & 63) : (pos >> 6);
            const float cs = TAB_M[(pv * 8 + (c16 & 7)) * 2], sn = TAB_M[(pv * 8 + (c16 & 7)) * 2 + 1];
            float a0 = v0 * cs - v1 * sn, a1 = v1 * cs + v0 * sn;
            float a2 = v2 * cs - v3 * sn, a3 = v3 * cs + v2 * sn;
            v0 = a0; v1 = a1; v2 = a2; v3 = a3;
          }
          u16* d = Q + (size_t)g * 768 + nt * 128 + wc * 64 + c16;
          d[0] = f2bf(v0); d[16] = f2bf(v1); d[32] = f2bf(v2); d[48] = f2bf(v3);
        }
    } else {
      const int t2 = tile - NQ;
      const int mt = t2 >> 3, hd = t2 & 7;
      const u16* A; const u16* Wt; int is_ctx, seq, kp0;
      if (mt < 288) {
        const TokTile tt = tok_tile(mt);
        A = wsp<u16>(p, O_CKV) + (size_t)tt.g0 * 256;
        Wt = wsw(p, l, O_WUKVG);
        row_scales(A, 256, s_rs);
        is_ctx = tt.is_ctx; seq = tt.b; kp0 = tt.is_ctx ? tt.p0 : 256 + tt.p0;
        if (tt.is_ctx && hd == 0) {
          __syncthreads();
          const float* gkv = p.kv_norm + l * 256;
          for (int idx = tid(); idx < 128 * 256; idx += 256) {
            const int r = idx >> 8, k = idx & 255;
            p.out[OUT_CKV + (((size_t)tt.b * 4 + l) * 256 + tt.p0 + r) * 256 + k] = bf2f(A[(size_t)r * 256 + k]) * s_rs[r] * gkv[k];
          }
        }
      } else {
        const int row0 = (mt - 288) * 128;
        A = wsp<u16>(p, O_CKVC) + (size_t)row0 * 256;
        Wt = wsw(p, l, O_WUKVR);
        { const int t1 = tid(); if (t1 < 128) s_rs[t1] = 1.f; }
        is_ctx = 0; seq = row0 >> 8; kp0 = row0 & 255;
      }
      gemm_tile(A, 256, Wt + (size_t)hd * 128 * 256, 256, 256, acc, smem);
      LANEVARS
      const int Lk = is_ctx ? 256 : LK_LAT;
      if (wc == 0) {
        u16* Kn = (is_ctx ? wsp<u16>(p, O_KNC) : wsp<u16>(p, O_KNL)) + ((size_t)seq * 8 + hd) * Lk * 64;
#pragma unroll
        for (int i = 0; i < 4; ++i)
#pragma unroll
          for (int j = 0; j < 4; ++j)
#pragma unroll
            for (int e = 0; e < 4; ++e) {
              const int r = wr * 64 + i * 16 + g4 * 4 + e;
              Kn[(size_t)(kp0 + r) * 64 + j * 16 + c16] = f2bf(acc[i][j][e] * s_rs[r]);
              if (e == 3) SB();
            }
      } else {
        u16* Vt = (is_ctx ? wsp<u16>(p, O_VTC) : wsp<u16>(p, O_VTL)) + ((size_t)seq * 8 + hd) * 64 * Lk;
#pragma unroll
        for (int i = 0; i < 4; ++i)
#pragma unroll
          for (int j = 0; j < 4; ++j) {
            SB();
            const int r = wr * 64 + i * 16 + g4 * 4;
            uint2 o;
            o.x = pack2(acc[i][j][0] * s_rs[r], acc[i][j][1] * s_rs[r + 1]);
            o.y = pack2(acc[i][j][2] * s_rs[r + 2], acc[i][j][3] * s_rs[r + 3]);
            *(uint2*)(Vt + (size_t)(j * 16 + c16) * Lk + kp0 + r) = o;
          }
      }
    }
    __syncthreads();
  }
}

template <int NS> DI void attn_gload(const int t, const u16* k0, int k0s, const u16* k1, const u16* vt, int vts,
                                     uint4& rk0, uint4& rk1, uint4& rk2, uint4& rv0, uint4& rv1) {
  if (NS == 6) {
    { const int c = t, key = c / 12, ch = c % 12;
      rk0 = (ch < 8) ? *(const uint4*)(k0 + (size_t)key * k0s + ch * 8) : *(const uint4*)(k1 + (size_t)key * 32 + (ch - 8) * 8); }
    { const int c = t + 256, key = c / 12, ch = c % 12;
      rk1 = (ch < 8) ? *(const uint4*)(k0 + (size_t)key * k0s + ch * 8) : *(const uint4*)(k1 + (size_t)key * 32 + (ch - 8) * 8); }
    { const int c = t + 512, key = c / 12, ch = c % 12;
      rk2 = (ch < 8) ? *(const uint4*)(k0 + (size_t)key * k0s + ch * 8) : *(const uint4*)(k1 + (size_t)key * 32 + (ch - 8) * 8); }
  } else {
    { const int c = t, key = c >> 3, ch = c & 7; rk0 = *(const uint4*)(k0 + (size_t)key * k0s + ch * 8); }
    { const int c = t + 256, key = c >> 3, ch = c & 7; rk1 = *(const uint4*)(k0 + (size_t)key * k0s + ch * 8); }
  }
  { const int c = t, dv = c >> 3, ch = c & 7; rv0 = *(const uint4*)(vt + (size_t)dv * vts + ch * 8); }
  { const int c = t + 256, dv = c >> 3, ch = c & 7; rv1 = *(const uint4*)(vt + (size_t)dv * vts + ch * 8); }
}
template <int NS> DI void attn_sstore(const int t, char* smem, const uint4& rk0, const uint4& rk1, const uint4& rk2, const uint4& rv0, const uint4& rv1) {
  constexpr int KSTR = (NS == 6) ? 208 : 144;
  if (NS == 6) {
    { const int c = t, key = c / 12, ch = c % 12; *(uint4*)(smem + key * KSTR + ch * 16) = rk0; }
    { const int c = t + 256, key = c / 12, ch = c % 12; *(uint4*)(smem + key * KSTR + ch * 16) = rk1; }
    { const int c = t + 512, key = c / 12, ch = c % 12; *(uint4*)(smem + key * KSTR + ch * 16) = rk2; }
  } else {
    { const int c = t, key = c >> 3, ch = c & 7; *(uint4*)(smem + key * KSTR + ch * 16) = rk0; }
    { const int c = t + 256, key = c >> 3, ch = c & 7; *(uint4*)(smem + key * KSTR + ch * 16) = rk1; }
  }
  { const int c = t, dv = c >> 3, ch = c & 7; char* d = smem + 13312 + dv * 136 + ch * 16;
    *(uint2*)d = uint2{rv0.x, rv0.y}; *(uint2*)(d + 8) = uint2{rv0.z, rv0.w}; }
  { const int c = t + 256, dv = c >> 3, ch = c & 7; char* d = smem + 13312 + dv * 136 + ch * 16;
    *(uint2*)d = uint2{rv1.x, rv1.y}; *(uint2*)(d + 8) = uint2{rv1.z, rv1.w}; }
}

#define PACK8(S, s2) __builtin_bit_cast(bf16x8, uint4{pack2(S[8 * (s2)], S[8 * (s2) + 1]), pack2(S[8 * (s2) + 2], S[8 * (s2) + 3]), \
                                                        pack2(S[8 * (s2) + 4], S[8 * (s2) + 5]), pack2(S[8 * (s2) + 6], S[8 * (s2) + 7])})

template <int NS>
DI void attn_item(const u16* kA, int kAs, const u16* krA, const u16* vtA, int vtAs, int nA, int kposA, int maskA,
                  const u16* kB, int kBs, const u16* vtB, int vtBs, int nB,
                  const u16* qa, const u16* qb, float sc2, float m0, float l0, int qpos, u16* yrow, char* smem) {
  constexpr int KSTR = (NS == 6) ? 208 : 144;
  const int tt_ = tid();
  const int lane = tt_ & 63;
  const int r32 = lane & 31, hh = lane >> 5;
  bf16x8 qf0, qf1, qf2, qf3, qf4, qf5;
  qf0 = *(const bf16x8*)(qa + 0 + 8 * hh); qf1 = *(const bf16x8*)(qa + 16 + 8 * hh);
  qf2 = *(const bf16x8*)(qa + 32 + 8 * hh); qf3 = *(const bf16x8*)(qa + 48 + 8 * hh);
  if (NS == 6) { qf4 = *(const bf16x8*)(qb + 0 + 8 * hh); qf5 = *(const bf16x8*)(qb + 16 + 8 * hh); }
  else { qf4 = qf0; qf5 = qf0; }
#define QSCALE(qf) { uint4 u_ = __builtin_bit_cast(uint4, qf); \
    u_.x = pack2(__uint_as_float(u_.x << 16) * sc2, __uint_as_float(u_.x & 0xffff0000u) * sc2); \
    u_.y = pack2(__uint_as_float(u_.y << 16) * sc2, __uint_as_float(u_.y & 0xffff0000u) * sc2); \
    u_.z = pack2(__uint_as_float(u_.z << 16) * sc2, __uint_as_float(u_.z & 0xffff0000u) * sc2); \
    u_.w = pack2(__uint_as_float(u_.w << 16) * sc2, __uint_as_float(u_.w & 0xffff0000u) * sc2); \
    qf = __builtin_bit_cast(bf16x8, u_); }
  QSCALE(qf0) QSCALE(qf1) QSCALE(qf2) QSCALE(qf3)
  if (NS == 6) { QSCALE(qf4) QSCALE(qf5) }
#undef QSCALE
  f32x16 O0, O1;
#pragma unroll
  for (int e = 0; e < 16; ++e) { O0[e] = 0.f; O1[e] = 0.f; }
  float m_run = m0, l_run = l0;
  uint4 rk0, rk1, rk2, rv0, rv1;
  rk2 = uint4{0, 0, 0, 0};
  const int ntiles = nA + nB;
#define TILE_GLOAD(jn) { if ((jn) < nA) attn_gload<NS>(tt_, kA + (size_t)(jn) * 64 * kAs, kAs, krA + (size_t)(jn) * 64 * 32, vtA + (jn) * 64, vtAs, rk0, rk1, rk2, rv0, rv1); \
    else { const int jb_ = (jn) - nA; attn_gload<NS>(tt_, kB + (size_t)jb_ * 64 * kBs, kBs, nullptr, vtB + jb_ * 64, vtBs, rk0, rk1, rk2, rv0, rv1); } }
  constexpr int STG = 22528;
  TILE_GLOAD(0)
  attn_sstore<NS>(tt_, smem, rk0, rk1, rk2, rv0, rv1);
  if (ntiles > 1) TILE_GLOAD(1)
  __syncthreads();
  for (int j = 0; j < ntiles; ++j) {
    char* sbase = smem + (j & 1) * STG;
    const int kpos = kposA + 64 * j;
    const bool masked = maskA && (j < nA);
    MB();
    f32x16 S0, S1;
#pragma unroll
    for (int e = 0; e < 16; ++e) { S0[e] = 0.f; S1[e] = 0.f; }
    const char* ka0 = sbase + r32 * KSTR + 16 * hh;
    const char* ka1 = sbase + (32 + r32) * KSTR + 16 * hh;
#define QK_STEP(s, qf) { bf16x8 a0 = *(const bf16x8*)(ka0 + 32 * (s)); bf16x8 a1 = *(const bf16x8*)(ka1 + 32 * (s)); \
      S0 = __builtin_amdgcn_mfma_f32_32x32x16_bf16(a0, qf, S0, 0, 0, 0); S1 = __builtin_amdgcn_mfma_f32_32x32x16_bf16(a1, qf, S1, 0, 0, 0); }
    QK_STEP(0, qf0) QK_STEP(1, qf1) QK_STEP(2, qf2) QK_STEP(3, qf3)
    if (NS == 6) { QK_STEP(4, qf4) QK_STEP(5, qf5) }
    SB();
    float mx = m_run;
#pragma unroll
    for (int e = 0; e < 16; ++e) {
      float v0 = S0[e], v1 = S1[e];
      if (masked) {
        const int kp = kpos + (e & 3) + 8 * (e >> 2) + 4 * hh;
        int d0 = qpos - kp; d0 = d0 < 0 ? -d0 : d0;
        int d1 = qpos - (kp + 32); d1 = d1 < 0 ? -d1 : d1;
        if (d0 > 128) v0 = -1e30f;
        if (d1 > 128) v1 = -1e30f;
      }
      S0[e] = v0; S1[e] = v1;
      mx = fmaxf(mx, fmaxf(v0, v1));
    }
    mx = fmaxf(mx, __shfl_xor(mx, 32));
    const float alpha = __builtin_amdgcn_exp2f(m_run - mx);
    m_run = mx;
    const f2_t m2 = {mx, mx};
    f2_t rs2 = {0.f, 0.f};
#pragma unroll
    for (int e = 0; e < 16; e += 2) {
      const f2_t d0 = f2_t{S0[e], S0[e + 1]} - m2, d1 = f2_t{S1[e], S1[e + 1]} - m2;
      const f2_t p0 = {__builtin_amdgcn_exp2f(d0.x), __builtin_amdgcn_exp2f(d0.y)};
      const f2_t p1 = {__builtin_amdgcn_exp2f(d1.x), __builtin_amdgcn_exp2f(d1.y)};
      S0[e] = p0.x; S0[e + 1] = p0.y; S1[e] = p1.x; S1[e + 1] = p1.y;
      rs2 += p0 + p1;
    }
    float rsum = rs2.x + rs2.y;
    rsum += __shfl_xor(rsum, 32);
    l_run = l_run * alpha + rsum;
#pragma unroll
    for (int e = 0; e < 16; ++e) { O0[e] *= alpha; O1[e] *= alpha; }
    const char* sv0 = sbase + 13312 + r32 * 136 + 8 * hh;
    const char* sv1 = sv0 + 32 * 136;
#define PV_STEP(pb, ka) { \
      { uint2 lo = *(const uint2*)(sv0 + (ka) * 2), hi = *(const uint2*)(sv0 + (ka) * 2 + 16); \
        bf16x8 va = __builtin_bit_cast(bf16x8, uint4{lo.x, lo.y, hi.x, hi.y}); O0 = __builtin_amdgcn_mfma_f32_32x32x16_bf16(va, pb, O0, 0, 0, 0); } \
      { uint2 lo = *(const uint2*)(sv1 + (ka) * 2), hi = *(const uint2*)(sv1 + (ka) * 2 + 16); \
        bf16x8 va = __builtin_bit_cast(bf16x8, uint4{lo.x, lo.y, hi.x, hi.y}); O1 = __builtin_amdgcn_mfma_f32_32x32x16_bf16(va, pb, O1, 0, 0, 0); } }
    SB();
    { bf16x8 pb = PACK8(S0, 0); PV_STEP(pb, 0) }
    { bf16x8 pb = PACK8(S0, 1); PV_STEP(pb, 16) }
    SB();
    { bf16x8 pb = PACK8(S1, 0); PV_STEP(pb, 32) }
    { bf16x8 pb = PACK8(S1, 1); PV_STEP(pb, 48) }
    SB();
    if (j + 1 < ntiles) {
      attn_sstore<NS>(tt_, smem + ((j + 1) & 1) * STG, rk0, rk1, rk2, rv0, rv1);
      if (j + 2 < ntiles) TILE_GLOAD(j + 2)
    }
    __syncthreads();
  }
#undef TILE_GLOAD
  const float inv = 1.f / l_run;
#pragma unroll
  for (int e4 = 0; e4 < 4; ++e4) {
    uint2 o;
    o.x = pack2(O0[4 * e4] * inv, O0[4 * e4 + 1] * inv); o.y = pack2(O0[4 * e4 + 2] * inv, O0[4 * e4 + 3] * inv);
    *(uint2*)(yrow + 8 * e4 + 4 * hh) = o;
    o.x = pack2(O1[4 * e4] * inv, O1[4 * e4 + 1] * inv); o.y = pack2(O1[4 * e4 + 2] * inv, O1[4 * e4 + 3] * inv);
    *(uint2*)(yrow + 32 + 8 * e4 + 4 * hh) = o;
  }
}

template <int MODE>
DI void scan_seg(const Params& p, int l, int seq, int blk, int d, int seg, char* smem) {
  const int t = tid(), lane = t & 63, w = t >> 6;
  const int c16 = lane & 15, g4 = lane >> 4;
  const bool is_ctx = seq < 16;
  const int b = is_ctx ? seq : seq - 16;
  const int L = is_ctx ? 256 : 4096;
  const int gbase = is_ctx ? b * 256 : T_CTX + b * 4096;
  const u16* XR = wsp<u16>(p, O_XR);
  u16* Y = wsp<u16>(p, O_YRNN);
  float* SUM = wsp<float>(p, O_SUM);
  char* sXc = smem;
  float* sA = (float*)(smem + 8704);
  float* sU = (float*)(smem + 8704 + 16384);
  const int cch = t & 127, th = t >> 7;
  const int chg = blk * 128 + cch;
  const float w0 = p.conv_w[(l * 4 + 0) * 1024 + chg], w1 = p.conv_w[(l * 4 + 1) * 1024 + chg];
  const float w2 = p.conv_w[(l * 4 + 2) * 1024 + chg], w3 = p.conv_w[(l * 4 + 3) * 1024 + chg];
  const float cb = p.conv_b[l * 1024 + chg];
  bf16x8 bw[4][4];
  {
    const u16* WL = wsw(p, l, O_WLRU) + (size_t)(d * 8 + blk) * 256 * 128 + (size_t)(32 * w + c16) * 128 + g4 * 8;
#pragma unroll
    for (int nf = 0; nf < 4; ++nf)
#pragma unroll
      for (int ks = 0; ks < 4; ++ks)
        bw[nf][ks] = *(const bf16x8*)(WL + (size_t)((nf & 1) * 16 + (nf >> 1) * 128) * 128 + ks * 32);
  }
  float ba[2], bi[2], cl[2];
#pragma unroll
  for (int jn = 0; jn < 2; ++jn) {
    const int ch = (l * 2 + d) * 1024 + blk * 128 + 32 * w + 16 * jn + c16;
    ba[jn] = p.lru_ba[ch]; bi[jn] = p.lru_bi[ch];
    cl[jn] = -8.f * log1pf(__expf(-p.lru_lam[ch]));
  }
  float h = 0.f, P = 1.f;
  if (MODE == 1 && !is_ctx && t < 128) {
    h = p.state[(((size_t)b * 4 + l) * 2 + d) * 1024 + blk * 128 + t];
    const float* sm = SUM + ((size_t)((b * 8 + blk) * 2 + d) * 16) * 256 + t;
    float Pv[16], Hv[16];
#pragma unroll
    for (int s2 = 0; s2 < 16; ++s2) { Pv[s2] = sm[s2 * 256]; Hv[s2] = sm[s2 * 256 + 128]; }
    if (d == 0) {
#pragma unroll
      for (int s2 = 0; s2 < 16; ++s2) if (s2 < seg) h = Pv[s2] * h + Hv[s2];
    } else {
#pragma unroll
      for (int s2 = 15; s2 >= 0; --s2) if (s2 > seg) h = Pv[s2] * h + Hv[s2];
    }
  }
#define X19(F) F(0) F(1) F(2) F(3) F(4) F(5) F(6) F(7) F(8) F(9) F(10) F(11) F(12) F(13) F(14) F(15) F(16) F(17) F(18)
#define XDECL(q) u16 xr##q = 0;
#define XLOAD(q) { const int pos = tcn + th * 16 - 1 + (q); xr##q = (pos >= 0 && pos < L) ? XR[(size_t)(gbase + pos) * 1024 + chg] : (u16)0; }
#define XCVT(q) xv[q] = bf2f(xr##q);
  X19(XDECL)
  { const int tcn = seg * 256 + (d == 0 ? 0 : 7) * 32; X19(XLOAD) }
  for (int ci = 0; ci < 8; ++ci) {
    const int tc0 = seg * 256 + (d == 0 ? ci : 7 - ci) * 32;
    {
      float xv[19];
      X19(XCVT)
#pragma unroll
      for (int q = 0; q < 16; ++q) {
        float xc = cb + w0 * xv[q] + w1 * xv[q + 1] + w2 * xv[q + 2] + w3 * xv[q + 3];
        *(u16*)(sXc + (th * 16 + q) * 272 + cch * 2) = f2bf(xc);
      }
    }
    unsigned yold0 = 0, yold1 = 0, yold2 = 0, yold3 = 0, yold4 = 0, yold5 = 0, yold6 = 0, yold7 = 0;
    {
      const int cn = ci < 7 ? ci + 1 : ci;
      const int tcn = seg * 256 + (d == 0 ? cn : 7 - cn) * 32;
      X19(XLOAD)
      if (MODE == 1 && d == 1) {
        const unsigned* yb = (const unsigned*)(Y + (size_t)(gbase + tc0 + (t >> 6)) * 1024 + blk * 128 + (t & 63) * 2);
        yold0 = yb[0]; yold1 = yb[4 * 512]; yold2 = yb[8 * 512]; yold3 = yb[12 * 512];
        yold4 = yb[16 * 512]; yold5 = yb[20 * 512]; yold6 = yb[24 * 512]; yold7 = yb[28 * 512];
      }
    }
    MB();
    __syncthreads();
    f32x4 aR[2][2], aI[2][2];
#pragma unroll
    for (int im = 0; im < 2; ++im)
#pragma unroll
      for (int jn = 0; jn < 2; ++jn) { aR[im][jn] = f32x4{0.f, 0.f, 0.f, 0.f}; aI[im][jn] = f32x4{0.f, 0.f, 0.f, 0.f}; }
#pragma unroll
    for (int ks = 0; ks < 4; ++ks)
#pragma unroll
      for (int im = 0; im < 2; ++im) {
        bf16x8 af = *(const bf16x8*)(sXc + (16 * im + c16) * 272 + (ks * 32 + g4 * 8) * 2);
#pragma unroll
        for (int jn = 0; jn < 2; ++jn) {
          aR[im][jn] = __builtin_amdgcn_mfma_f32_16x16x32_bf16(af, bw[jn][ks], aR[im][jn], 0, 0, 0);
          aI[im][jn] = __builtin_amdgcn_mfma_f32_16x16x32_bf16(af, bw[2 + jn][ks], aI[im][jn], 0, 0, 0);
        }
      }
#pragma unroll
    for (int im = 0; im < 2; ++im)
#pragma unroll
      for (int jn = 0; jn < 2; ++jn)
#pragma unroll
        for (int e = 0; e < 4; ++e) {
          const int tt = 16 * im + 4 * g4 + e, c = 32 * w + 16 * jn + c16;
          const float r = sigmoidf_(aR[im][jn][e] + ba[jn]);
          const float ig = sigmoidf_(aI[im][jn][e] + bi[jn]);
          const float a = __expf(cl[jn] * r);
          const float xc = bf2f(*(const u16*)(sXc + tt * 272 + c * 2));
          const float u = __builtin_amdgcn_sqrtf(fmaxf(1.f - a * a, 0.f)) * ig * xc;
          sA[tt * 128 + c] = a; sU[tt * 128 + c] = u;
        }
    __syncthreads();
    if (t < 128) {
      if (d == 0) {
#pragma unroll 8
        for (int s = 0; s < 32; ++s) {
          const float a = sA[s * 128 + t];
          h = a * h + sU[s * 128 + t];
          if (MODE == 0) P *= a; else sU[s * 128 + t] = h;
        }
      } else {
#pragma unroll 8
        for (int s = 31; s >= 0; --s) {
          const float a = sA[s * 128 + t];
          h = a * h + sU[s * 128 + t];
          if (MODE == 0) P *= a; else sU[s * 128 + t] = h;
        }
      }
    }
    __syncthreads();
    if (MODE == 1) {
      const int c2 = (t & 63) * 2;
      unsigned* yb = (unsigned*)(Y + (size_t)(gbase + tc0 + (t >> 6)) * 1024 + blk * 128 + c2);
      const float* su = sU + (t >> 6) * 128 + c2;
#define YOUT(i, yo) { float h0 = su[(4 * (i)) * 128], h1 = su[(4 * (i)) * 128 + 1]; \
        if (d == 1) { h0 += __uint_as_float((yo) << 16); h1 += __uint_as_float((yo) & 0xffff0000u); } \
        yb[(size_t)(4 * (i)) * 512] = pack2(h0, h1); }
      YOUT(0, yold0) YOUT(1, yold1) YOUT(2, yold2) YOUT(3, yold3) YOUT(4, yold4) YOUT(5, yold5) YOUT(6, yold6) YOUT(7, yold7)
#undef YOUT
    }
  }
#undef X19
#undef XDECL
#undef XLOAD
#undef XCVT
  if (MODE == 0) {
    if (t < 128) {
      float* sm = SUM + ((size_t)(((b * 8 + blk) * 2 + d) * 16 + seg)) * 256 + t;
      sm[0] = P; sm[128] = h;
    }
  } else if (is_ctx && t < 128) {
    p.out[OUT_RG + (((size_t)b * 4 + l) * 2 + d) * 1024 + blk * 128 + t] = h;
  }
  __syncthreads();
}

DI void phase_mix(const Params& p, int l, char* smem) {
  constexpr float LOG2E = 1.4426950408889634f;
  constexpr int N0 = 1024, N1 = N0 + 2048, N2 = N1 + 2048, N3 = N2 + 128, N4 = N3 + 256, N5 = N4 + 256;
  for (int base = 0; base < N5; base += gridDim.x) {
    const int vit = xcd_map(base);
    if (vit >= N5) continue;
    const int it = vit < N0 ? vit : (vit < N0 + 128 ? N2 + (vit - N0) : (vit < N3 ? vit - 128 : vit));
    const int t = tid(), lane = t & 63, w = t >> 6;
    const int r32 = lane & 31;
    if (it < N0 || (it >= N2 && it < N3)) {
      int seq, blk, seg;
      if (it < N0) { seg = it & 15; blk = (it >> 4) & 7; seq = 16 + (it >> 7); }
      else { const int i = it - N2; seg = 0; blk = i & 7; seq = i >> 3; }
      scan_seg<1>(p, l, seq, blk, 0, seg, smem);
      scan_seg<1>(p, l, seq, blk, 1, seg, smem);
#if PROBE == 4
      scan_seg<1>(p, l, seq, blk, 0, seg, smem);
      scan_seg<1>(p, l, seq, blk, 1, seg, smem);
#endif
    } else if (it < N1 || (it >= N3 && it < N4)) {
      const bool lat = it < N1;
      int b, h, qb;
      if (lat) { const int i = it - N0; qb = i & 31; h = (i >> 5) & 7; b = i >> 8; }
      else { const int i = it - N3; qb = i & 1; h = (i >> 1) & 7; b = i >> 4; }
      const int Lk = lat ? LK_LAT : 256;
      const int gq = (lat ? T_CTX + b * 4096 : b * 256) + qb * 128 + w * 32 + r32;
      const u16* Kn = (lat ? wsp<u16>(p, O_KNL) : wsp<u16>(p, O_KNC)) + ((size_t)b * 8 + h) * Lk * 64;
      const u16* Kr = (lat ? wsp<u16>(p, O_KRL) : wsp<u16>(p, O_KRC)) + (size_t)b * Lk * 32;
      const u16* Vt = (lat ? wsp<u16>(p, O_VTL) : wsp<u16>(p, O_VTC)) + ((size_t)b * 8 + h) * 64 * Lk;
      const u16* Q = wsp<u16>(p, O_Q) + (size_t)gq * 768;
      u16* yrow = wsp<u16>(p, O_CQ) + (size_t)gq * 512 + h * 64;
      attn_item<6>(Kn, 64, Kr, Vt, Lk, Lk >> 6, 0, 0, nullptr, 0, nullptr, 0, 0,
                   Q + h * 64, Q + 512 + h * 32, 0.10206207261596577f * LOG2E, -1e30f, 0.f, 0, yrow, smem);
#if PROBE == 5
      __syncthreads();
      attn_item<6>(Kn, 64, Kr, Vt, Lk, Lk >> 6, 0, 0, nullptr, 0, nullptr, 0, 0,
                   Q + h * 64, Q + 512 + h * 32, 0.10206207261596577f * LOG2E, -1e30f, 0.f, 0, yrow, smem);
#endif
    } else {
      const bool lat = it < N2;
      int b, h, qb;
      if (lat) { const int i = it - N1; qb = i & 31; h = (i >> 5) & 7; b = i >> 8; }
      else { const int i = it - N4; qb = i & 1; h = (i >> 1) & 7; b = i >> 4; }
      const int kvh = h >> 2;
      const int gseq = lat ? T_CTX + b * 4096 : b * 256;
      const int qpos = qb * 128 + w * 32 + r32;
      const int gq = gseq + qpos;
      u16* qrow = wsp<u16>(p, O_QS) + (size_t)gq * 512 + h * 64;
      const float sink2 = p.sink[l * 8 + h] * LOG2E;
      const int t0 = qb * 128;
      int jlo = 0, jhi = 6;
      if (t0 == 0) jlo = 2;
      if (t0 + 128 >= 4096) jhi = 4;
      const int ks0 = lat ? t0 - 128 + 64 * jlo : 0;
      const int nA = lat ? jhi - jlo : 4;
      const u16* KS = wsp<u16>(p, O_KS) + (size_t)(gseq + ks0) * 128 + kvh * 64;
      const u16* VT = lat ? wsp<u16>(p, O_VTSL) + ((size_t)b * 2 + kvh) * 64 * 4096 + ks0
                          : wsp<u16>(p, O_VTSC) + ((size_t)b * 2 + kvh) * 64 * 256;
      const u16* KC = wsp<u16>(p, O_KSC) + (size_t)b * 256 * 128 + kvh * 64;
      const u16* VC = wsp<u16>(p, O_VTSCC) + ((size_t)b * 2 + kvh) * 64 * 256;
      attn_item<4>(KS, 128, nullptr, VT, lat ? 4096 : 256, nA, ks0, lat ? 1 : 0, KC, 128, VC, 256, lat ? 4 : 0,
                   qrow, nullptr, 0.125f * LOG2E, sink2, 1.f, qpos, qrow, smem);
    }
    __syncthreads();
  }
}

DI void phase_gate(const Params& p, int l, char* smem) {
  const u16* H = wsp<u16>(p, O_H);
  const u16* W = wsw(p, l, O_WINB);
  for (int base = 0; base < 288 * 40; base += gridDim.x) {
    const int tile = xcd_map(base);
    if (tile >= 288 * 40) continue;
    const int sb = tile >> 6, jj = tile & 63;
    const int mt = (sb / 5) * 8 + (jj >> 3), nt = (sb % 5) * 8 + (jj & 7);
    const int g0 = mt * 128;
    f32x4 acc[4][4];
    zero_acc(acc);
    gemm_tile(H + (size_t)g0 * 1024, 1024, W + (size_t)nt * 128 * 1024, 1024, 1024, acc, smem);
    LANEVARS
    if (nt < 16) {
      u16* dst; int ld, cb;
      if (nt < 8) { dst = wsp<u16>(p, O_YRNN); ld = 1024; cb = nt * 128; }
      else if (nt < 12) { dst = wsp<u16>(p, O_CQ); ld = 512; cb = (nt - 8) * 128; }
      else { dst = wsp<u16>(p, O_QS); ld = 512; cb = (nt - 12) * 128; }
#pragma unroll
      for (int i = 0; i < 4; ++i)
#pragma unroll
        for (int j = 0; j < 4; ++j)
#pragma unroll
          for (int e = 0; e < 4; ++e) {
            const int g = g0 + wr * 64 + i * 16 + g4 * 4 + e;
            u16* d = dst + (size_t)g * ld + cb + wc * 64 + j * 16 + c16;
            const float gv = acc[i][j][e];
            *d = f2bf(bf2f(*d) * gv * sigmoidf_(gv));
            if (e == 3) SB();
          }
    } else {
      const int br = (nt - 16) >> 3, cb = ((nt - 16) & 7) * 128;
      u16* dst = br == 0 ? wsp<u16>(p, O_XR) : wsp<u16>(p, O_KS) + (size_t)(br - 1) * T_ALL * 1024;
#pragma unroll
      for (int i = 0; i < 4; ++i)
#pragma unroll
        for (int j = 0; j < 4; ++j)
#pragma unroll
          for (int e = 0; e < 4; ++e) {
            const int g = g0 + wr * 64 + i * 16 + g4 * 4 + e;
            dst[(size_t)g * 1024 + cb + wc * 64 + j * 16 + c16] = f2bf(sigmoidf_(acc[i][j][e]));
            if (e == 3) SB();
          }
    }
  }
}

DI void phase_merge(const Params& p, int l, char* smem) {
  u16* U = wsp<u16>(p, O_H);
  for (int base = 0; base < 288 * 8; base += gridDim.x) {
    const int tile = xcd_map(base);
    if (tile >= 288 * 8) continue;
    const int mt = tile >> 3, nt = tile & 7;
    const int g0 = mt * 128;
    f32x4 u[4][4];
    zero_acc(u);
    for (int br = 0; br < 3; ++br) {
      f32x4 acc[4][4];
      zero_acc(acc);
      const u16* Z; const u16* WT; int kz; const u16* M;
      if (br == 0) { Z = wsp<u16>(p, O_YRNN) + (size_t)g0 * 1024; WT = wsw(p, l, O_WBRR) + (size_t)nt * 128 * 1024; kz = 1024; M = wsp<u16>(p, O_XR); }
      else if (br == 1) { Z = wsp<u16>(p, O_CQ) + (size_t)g0 * 512; WT = wsw(p, l, O_WBRM) + (size_t)nt * 128 * 512; kz = 512; M = wsp<u16>(p, O_KS); }
      else { Z = wsp<u16>(p, O_QS) + (size_t)g0 * 512; WT = wsw(p, l, O_WBRS) + (size_t)nt * 128 * 512; kz = 512; M = wsp<u16>(p, O_KS) + (size_t)T_ALL * 1024; }
      gemm_tile(Z, kz, WT, kz, kz, acc, smem);
      LANEVARS
#pragma unroll
      for (int i = 0; i < 4; ++i)
#pragma unroll
        for (int j = 0; j < 4; ++j)
#pragma unroll
          for (int e = 0; e < 4; ++e) {
            const int g = g0 + wr * 64 + i * 16 + g4 * 4 + e;
            u[i][j][e] += bf2f(M[(size_t)g * 1024 + nt * 128 + wc * 64 + j * 16 + c16]) * acc[i][j][e];
            if (e == 3) SB();
          }
    }
    LANEVARS
#pragma unroll
    for (int i = 0; i < 4; ++i)
#pragma unroll
      for (int j = 0; j < 4; ++j)
#pragma unroll
        for (int e = 0; e < 4; ++e) {
          const int g = g0 + wr * 64 + i * 16 + g4 * 4 + e;
          U[(size_t)g * 1024 + nt * 128 + wc * 64 + j * 16 + c16] = f2bf(u[i][j][e]);
        }
  }
}

DI void phase_out(const Params& p, int l, char* smem) {
  const u16* U = wsp<u16>(p, O_H);
  const u16* W = wsw(p, l, O_WOUT);
  const float* MOD = wsp<float>(p, O_MOD) + (size_t)l * 9 * 3072;
  for (int base = 0; base < 288 * 8; base += gridDim.x) {
    const int tile = xcd_map(base);
    if (tile >= 288 * 8) continue;
    const int mt = tile >> 3, nt = tile & 7;
    const int g0 = mt * 128;
    const int ci = g0 < T_CTX ? 8 : ((g0 - T_CTX) >> 12);
    f32x4 acc[4][4];
    zero_acc(acc);
    gemm_tile(U + (size_t)g0 * 1024, 1024, W + (size_t)nt * 128 * 1024, 1024, 1024, acc, smem);
    LANEVARS
#pragma unroll
    for (int j = 0; j < 4; ++j) {
      const int col = nt * 128 + wc * 64 + j * 16 + c16;
      const float gt = MOD[ci * 3072 + 2048 + col];
#pragma unroll
      for (int i = 0; i < 4; ++i)
#pragma unroll
        for (int e = 0; e < 4; ++e) {
          const int g = g0 + wr * 64 + i * 16 + g4 * 4 + e;
          const float xo = xin_row(p, l, g)[col];
          p.out[(size_t)g * 1024 + col] = xo + gt * acc[i][j][e];
          if (e == 3) SB();
        }
    }
  }
}

DI void phase_final(const Params& p) {
  const int t = tid(), lane = t & 63, w = t >> 6;
  for (int row = blockIdx.x * 4 + w; row < T_ALL; row += gridDim.x * 4) {
    float* x = p.out + (size_t)row * 1024;
    float4 v[4];
    float ss = 0.f;
#pragma unroll
    for (int i = 0; i < 4; ++i) {
      v[i] = *(const float4*)(x + i * 256 + lane * 4);
      ss += v[i].x * v[i].x + v[i].y * v[i].y + v[i].z * v[i].z + v[i].w * v[i].w;
    }
    ss = wave_sum(ss);
    const float rs = rsqrtf(ss * (1.f / 1024.f) + EPS);
#pragma unroll
    for (int i = 0; i < 4; ++i) {
      const int c = i * 256 + lane * 4;
      const float4 g = *(const float4*)(p.final_norm + c);
      float4 o = {v[i].x * rs * g.x, v[i].y * rs * g.y, v[i].z * rs * g.z, v[i].w * rs * g.w};
      *(float4*)(x + c) = o;
    }
  }
}

constexpr int NPHASE_PER_LAYER = 7;
DI void run_phase(const Params& p, int ph, char* smem) {
  if (ph == 0) { phase_mod(p, smem); return; }
  if (ph == 1 + NLAYER * NPHASE_PER_LAYER) { phase_final(p); return; }
  const int l = (ph - 1) / NPHASE_PER_LAYER, s = (ph - 1) % NPHASE_PER_LAYER;
  switch (s) {
    case 0: phase_prep(p, l); break;
    case 1: phase_gemmA(p, l, smem); break;
    case 2: phase_qkv(p, l, smem); break;
    case 3: phase_mix(p, l, smem); break;
    case 4: phase_gate(p, l, smem); break;
    case 5: phase_merge(p, l, smem); break;
    default: phase_out(p, l, smem); break;
  }
}
constexpr int NPHASE = 2 + NLAYER * NPHASE_PER_LAYER;

#if MEGA
DI Params launder(const Params& p) {
  size_t z = 0;
  asm volatile("" : "+s"(z));
  Params q = p; q.ws = p.ws + z; q.out = p.out + z;
  return q;
}
struct XBar { unsigned* base; unsigned xcc; unsigned nloc; unsigned nx; };
#define XB_CENSUS(j) (64 * (j))
#define XB_XSUB(j) (1024 + 64 * (j))
#define XB_XGEN(j) (2048 + 64 * (j))
#define XB_TOP 3072
#define XB_TOPGEN 3136
DI unsigned xb_ld(unsigned* p) { return __hip_atomic_load(p, __ATOMIC_RELAXED, __HIP_MEMORY_SCOPE_AGENT); }
DI unsigned xb_add(unsigned* p, unsigned v) { return __hip_atomic_fetch_add(p, v, __ATOMIC_RELAXED, __HIP_MEMORY_SCOPE_AGENT); }
DI void xbar_post(XBar& xb, unsigned* base) {
  xb.base = base; xb.nloc = 0; xb.nx = 0;
  xb.xcc = (unsigned)__builtin_amdgcn_s_getreg((3 << 11) | 20) & 0xFu;
  if (threadIdx.x == 0) xb_add(&base[XB_CENSUS(xb.xcc)], 1u);
}
DI void xbar_census(XBar& xb) {
  if (threadIdx.x == 0) {
    unsigned nx = 0;
    for (int j = 0; j < 16; ++j) nx += xb_ld(&xb.base[XB_CENSUS(j)]) ? 1u : 0u;
    xb.nx = nx; xb.nloc = xb_ld(&xb.base[XB_CENSUS(xb.xcc)]);
  }
}
DI void xbar_sync(const XBar& xb) {
  asm volatile("s_waitcnt vmcnt(0)" ::: "memory");
  __syncthreads();
  if (threadIdx.x == 0) {
    unsigned* bar = xb.base;
    const unsigned old = xb_add(&bar[XB_XSUB(xb.xcc)], 1u);
    const unsigned gen = old / xb.nloc;
    if (old + 1u == (gen + 1u) * xb.nloc) {
      __builtin_amdgcn_fence(__ATOMIC_RELEASE, "agent");
      asm volatile("s_waitcnt vmcnt(0)" ::: "memory");
      const unsigned og = xb_add(&bar[XB_TOP], 1u);
      const unsigned tg = og / xb.nx;
      if (og + 1u == (tg + 1u) * xb.nx) xb_add(&bar[XB_TOPGEN], 1u);
      else { unsigned sp = 0; while (xb_ld(&bar[XB_TOPGEN]) == tg) { __builtin_amdgcn_s_sleep(1); if (++sp > (1u << 22)) break; } }
      __builtin_amdgcn_fence(__ATOMIC_ACQUIRE, "agent");
      xb_add(&bar[XB_XGEN(xb.xcc)], 1u);
      asm volatile("s_waitcnt vmcnt(0)" ::: "memory");
    } else {
      unsigned sp = 0;
      while (xb_ld(&bar[XB_XGEN(xb.xcc)]) == gen) { __builtin_amdgcn_s_sleep(1); if (++sp > (1u << 22)) break; }
      __builtin_amdgcn_fence(__ATOMIC_ACQUIRE, "agent");
      asm volatile("s_waitcnt vmcnt(0)" ::: "memory");
    }
  }
  __syncthreads();
}
#define GSYNC() xbar_sync(xb)
__global__ void __launch_bounds__(256, 2) mega_kernel(Params p) {
  __shared__ __attribute__((aligned(16))) char smem[66048];
  cg::grid_group grid = cg::this_grid();
  XBar xb;
  xbar_post(xb, (unsigned*)(p.ws + O_BAR));
  phase_mod(launder(p), smem);
  convert_weights(launder(p), 0);
  grid.sync();
  xbar_census(xb);
  for (int l = 0; l < NLAYER; ++l) {
    phase_prep(launder(p), l);
    GSYNC();
#if PROBE == 1
    phase_prep(launder(p), l);
    GSYNC();
#endif
    phase_gemmA(launder(p), l, smem);
    GSYNC();
#if PROBE == 2
    phase_gemmA(launder(p), l, smem);
    GSYNC();
#endif
    phase_qkv(launder(p), l, smem);
    GSYNC();
    phase_mix(launder(p), l, smem);
    if (l + 1 < NLAYER) convert_weights(launder(p), l + 1);
    GSYNC();
    phase_gate(launder(p), l, smem);
    GSYNC();
    phase_merge(launder(p), l, smem);
    GSYNC();
#if PROBE == 3
    phase_merge(launder(p), l, smem);
    GSYNC();
#endif
    phase_out(launder(p), l, smem);
    GSYNC();
  }
  phase_final(launder(p));
}

#else
__global__ void __launch_bounds__(256, 2) phase_kernel(Params p, int ph) {
  __shared__ __attribute__((aligned(16))) char smem[66048];
  run_phase(p, ph, smem);
}

#endif
extern "C" void kernel_launch(void* const* d_in, const int* in_sizes, int n_in, void* d_out, int out_size, void* d_ws,
                              size_t ws_size, hipStream_t stream) {
  Params p{};
  const float** pp = (const float**)&p;
  for (int i = 0; i < 30; ++i) pp[i] = (const float*)d_in[i];
  p.out = (float*)d_out;
  p.ws = (char*)d_ws;
  if (ws_size < WS_NEED) fprintf(stderr, "workspace too small: %zu < %zu\n", ws_size, (size_t)WS_NEED);
#if MEGA
  static int grid_blocks = 0;
  if (!grid_blocks) {
    int dev = 0, cus = 0, per_cu = 0;
    hipGetDevice(&dev);
    hipDeviceGetAttribute(&cus, hipDeviceAttributeMultiprocessorCount, dev);
    hipOccupancyMaxActiveBlocksPerMultiprocessor(&per_cu, mega_kernel, 256, 0);
    if (per_cu > 2) per_cu = 2;
    grid_blocks = cus * per_cu;
  }
  (void)hipMemsetAsync((char*)d_ws + O_BAR, 0, BAR_BYTES, stream);
  void* args[] = {&p};
  hipError_t e = hipLaunchCooperativeKernel((void*)mega_kernel, dim3(grid_blocks), dim3(256), args, 0, stream);
  if (e != hipSuccess) fprintf(stderr, "cooperative launch failed: %s (grid %d)\n", hipGetErrorString(e), grid_blocks);
#else
  for (int ph = 0; ph < NPHASE; ++ph) phase_kernel<<<512, 256, 0, stream>>>(p, ph);
#endif
}
```

```cpp
#include <hip/hip_runtime.h>
#include <hip/hip_cooperative_groups.h>
#include <cstdio>
#include <cstdint>
namespace cg = cooperative_groups;

#ifndef PROBE
#define PROBE 0
#endif
#ifndef MEGA
#define MEGA 1
#endif

typedef unsigned short u16;
using bf16x8 = __attribute__((ext_vector_type(8))) short;
using f32x4 = __attribute__((ext_vector_type(4))) float;
using f32x16 = __attribute__((ext_vector_type(16))) float;
typedef __bf16 bf2_t __attribute__((ext_vector_type(2)));
typedef float f2_t __attribute__((ext_vector_type(2)));
#define DI __device__ __forceinline__

__device__ const float TAB_M[1024] = {
  1.00000000e+00f, 0.00000000e+00f, 1.00000000e+00f, 0.00000000e+00f, 1.00000000e+00f, 0.00000000e+00f, 1.00000000e+00f, 0.00000000e+00f,
  1.00000000e+00f, 0.00000000e+00f, 1.00000000e+00f, 0.00000000e+00f, 1.00000000e+00f, 0.00000000e+00f, 1.00000000e+00f, 0.00000000e+00f,
  5.40302277e-01f, 8.41470957e-01f, 9.50415254e-01f, 3.10983598e-01f, 9.95004177e-01f, 9.98334214e-02f, 9.99500036e-01f, 3.16175036e-02f,
  9.99949992e-01f, 9.99983307e-03f, 9.99994993e-01f, 3.16227227e-03f, 9.99999523e-01f, 9.99999931e-04f, 9.99999940e-01f, 3.16227757e-04f,
  -4.16146845e-01f, 9.09297407e-01f, 8.06578398e-01f, 5.91127098e-01f, 9.80066597e-01f, 1.98669329e-01f, 9.98000681e-01f, 6.32033944e-02f,
  9.99800026e-01f, 1.99986659e-02f, 9.99979973e-01f, 6.32451288e-03f, 9.99997973e-01f, 1.99999870e-03f, 9.99999821e-01f, 6.32455456e-04f,
  -9.89992499e-01f, 1.41120002e-01f, 5.82753658e-01f, 8.12648892e-01f, 9.55336511e-01f, 2.95520216e-01f, 9.95503366e-01f, 9.47260857e-02f,
  9.99550045e-01f, 2.99954992e-02f, 9.99954998e-01f, 9.48669016e-03f, 9.99995530e-01f, 2.99999560e-03f, 9.99999523e-01f, 9.48683126e-04f,
  -6.53643608e-01f, -7.56802499e-01f, 3.01137477e-01f, 9.53580737e-01f, 9.21060979e-01f, 3.89418334e-01f, 9.92010653e-01f, 1.26154065e-01f,
  9.99200106e-01f, 3.99893336e-02f, 9.99920011e-01f, 1.26487734e-02f, 9.99992013e-01f, 3.99998948e-03f, 9.99999225e-01f, 1.26491068e-03f,
  2.83662200e-01f, -9.58924294e-01f, -1.03423381e-02f, 9.99946535e-01f, 8.77582550e-01f, 4.79425550e-01f, 9.87526000e-01f, 1.57455876e-01f,
  9.98750269e-01f, 4.99791652e-02f, 9.99875009e-01f, 1.58107281e-02f, 9.99987483e-01f, 4.99997940e-03f, 9.99998748e-01f, 1.58113812e-03f,
  9.60170269e-01f, -2.79415488e-01f, -3.20796400e-01f, 9.47148204e-01f, 8.25335622e-01f, 5.64642489e-01f, 9.82053936e-01f, 1.88600272e-01f,
  9.98200536e-01f, 5.99640049e-02f, 9.99819994e-01f, 1.89725272e-02f, 9.99981999e-01f, 5.99996420e-03f, 9.99998212e-01f, 1.89736532e-03f,
  7.53902256e-01f, 6.56986594e-01f, -5.99437475e-01f, 8.00421596e-01f, 7.64842212e-01f, 6.44217670e-01f, 9.75599885e-01f, 2.19556093e-01f,
  9.97551024e-01f, 6.99428469e-02f, 9.99755025e-01f, 2.21341345e-02f, 9.99975502e-01f, 6.99994294e-03f, 9.99997556e-01f, 2.21359241e-03f,
  -1.45500034e-01f, 9.89358246e-01f, -8.18632424e-01f, 5.74317753e-01f, 6.96706712e-01f, 7.17356086e-01f, 9.68170285e-01f, 2.50292331e-01f,
  9.96801734e-01f, 7.99146891e-02f, 9.99680042e-01f, 2.52955221e-02f, 9.99967992e-01f, 7.99991470e-03f, 9.99996781e-01f, 2.52981926e-03f,
  -9.11130250e-01f, 4.12118495e-01f, -9.56644177e-01f, 2.91259229e-01f, 6.21609926e-01f, 7.83326924e-01f, 9.59772646e-01f, 2.80778319e-01f,
  9.95952725e-01f, 8.98785442e-02f, 9.99595046e-01f, 2.84566563e-02f, 9.99959528e-01f, 8.99987947e-03f, 9.99995947e-01f, 2.84604589e-03f,
  -8.39071512e-01f, -5.44021130e-01f, -9.99786079e-01f, -2.06835698e-02f, 5.40302277e-01f, 8.41470957e-01f, 9.50415313e-01f, 3.10983568e-01f,
  9.95004177e-01f, 9.98334140e-02f, 9.99500036e-01f, 3.16175036e-02f, 9.99949992e-01f, 9.99983400e-03f, 9.99994993e-01f, 3.16227227e-03f,
  4.42569796e-03f, -9.99990225e-01f, -9.43779767e-01f, -3.30574960e-01f, 4.53596085e-01f, 8.91207397e-01f, 9.40107584e-01f, 3.40877861e-01f,
  9.93956089e-01f, 1.09778300e-01f, 9.99395072e-01f, 3.47780399e-02f, 9.99939501e-01f, 1.09997792e-02f, 9.99993920e-01f, 3.47849843e-03f,
  8.43853951e-01f, -5.36572933e-01f, -7.94179380e-01f, -6.07683420e-01f, 3.62357706e-01f, 9.32039082e-01f, 9.28859890e-01f, 3.70431304e-01f,
  9.92808640e-01f, 1.19712204e-01f, 9.99280095e-01f, 3.79382223e-02f, 9.99927998e-01f, 1.19997123e-02f, 9.99992788e-01f, 3.79472389e-03f,
  9.07446802e-01f, 4.20167029e-01f, -5.65820515e-01f, -8.24528456e-01f, 2.67498761e-01f, 9.63558197e-01f, 9.16683376e-01f, 3.99614304e-01f,
  9.91561890e-01f, 1.29634142e-01f, 9.99155104e-01f, 4.10980321e-02f, 9.99915481e-01f, 1.29996343e-02f, 9.99991536e-01f, 4.11094911e-03f,
  1.36737213e-01f, 9.90607381e-01f, -2.81349480e-01f, -9.59605396e-01f, 1.69967160e-01f, 9.85449731e-01f, 9.03590262e-01f, 4.28397775e-01f,
  9.90216017e-01f, 1.39543116e-01f, 9.99020159e-01f, 4.42574248e-02f, 9.99902010e-01f, 1.39995432e-02f, 9.99990225e-01f, 4.42717411e-03f,
  -7.59687901e-01f, 6.50287867e-01f, 3.10223512e-02f, -9.99518692e-01f, 7.07371980e-02f, 9.97494996e-01f, 8.89593601e-01f, 4.56752867e-01f,
  9.88771081e-01f, 1.49438128e-01f, 9.98875201e-01f, 4.74163815e-02f, 9.99887526e-01f, 1.49994381e-02f, 9.99988735e-01f, 4.74339863e-03f,
  -9.57659483e-01f, -2.87903309e-01f, 3.40318173e-01f, -9.40310359e-01f, -2.91995462e-02f, 9.99573588e-01f, 8.74707460e-01f, 4.84651238e-01f,
  9.87227261e-01f, 1.59318209e-01f, 9.98720288e-01f, 5.05748577e-02f, 9.99872029e-01f, 1.59993190e-02f, 9.99987185e-01f, 5.05962269e-03f,
  -2.75163352e-01f, -9.61397469e-01f, 6.15864813e-01f, -7.87851870e-01f, -1.28844544e-01f, 9.91664827e-01f, 8.58946681e-01f, 5.12064993e-01f,
  9.85584795e-01f, 1.69182345e-01f, 9.98555362e-01f, 5.37328273e-02f, 9.99855518e-01f, 1.69991814e-02f, 9.99985576e-01f, 5.37584582e-03f,
  6.60316706e-01f, -7.50987232e-01f, 8.30336154e-01f, -5.57262897e-01f, -2.27202162e-01f, 9.73847628e-01f, 8.42327058e-01f, 5.38966715e-01f,
  9.83843684e-01f, 1.79029569e-01f, 9.98380423e-01f, 5.68902642e-02f, 9.99837995e-01f, 1.79990288e-02f, 9.99983788e-01f, 5.69206895e-03f,
  9.88704622e-01f, 1.49877205e-01f, 9.62463796e-01f, -2.71410108e-01f, -3.23289543e-01f, 9.46300089e-01f, 8.24865162e-01f, 5.65329552e-01f,
  9.82004225e-01f, 1.88858896e-01f, 9.98195529e-01f, 6.00471310e-02f, 9.99819517e-01f, 1.89988576e-02f, 9.99981940e-01f, 6.00829115e-03f,
  4.08082068e-01f, 9.12945271e-01f, 9.99144375e-01f, 4.13582884e-02f, -4.16146845e-01f, 9.09297407e-01f, 8.06578457e-01f, 5.91127038e-01f,
  9.80066597e-01f, 1.98669314e-01f, 9.98000681e-01f, 6.32033944e-02f, 9.99800026e-01f, 1.99986678e-02f, 9.99979973e-01f, 6.32451288e-03f,
  -5.47729254e-01f, 8.36655617e-01f, 9.36740458e-01f, 3.50024760e-01f, -5.04846215e-01f, 8.63209307e-01f, 7.87485182e-01f, 6.16333544e-01f,
  9.78030920e-01f, 2.08459899e-01f, 9.97795820e-01f, 6.63590282e-02f, 9.99779522e-01f, 2.09984574e-02f, 9.99977946e-01f, 6.64073415e-03f,
  -9.99960840e-01f, -8.85130931e-03f, 7.81440377e-01f, 6.23979926e-01f, -5.88501155e-01f, 8.08496356e-01f, 7.67604589e-01f, 6.40923738e-01f,
  9.75897431e-01f, 2.18229622e-01f, 9.97581005e-01f, 6.95140064e-02f, 9.99758005e-01f, 2.19982266e-02f, 9.99975801e-01f, 6.95695449e-03f,
  -5.32833040e-01f, -8.46220434e-01f, 5.48645258e-01f, 8.36055279e-01f, -6.66275978e-01f, 7.45705247e-01f, 7.46956408e-01f, 6.64873064e-01f,
  9.73666370e-01f, 2.27977514e-01f, 9.97356176e-01f, 7.26682767e-02f, 9.99735534e-01f, 2.29979735e-02f, 9.99973536e-01f, 7.27317436e-03f,
  4.24179018e-01f, -9.05578375e-01f, 2.61441678e-01f, 9.65219259e-01f, -7.37393796e-01f, 6.75463140e-01f, 7.25561321e-01f, 6.88157499e-01f,
  9.71337974e-01f, 2.37702623e-01f, 9.97121394e-01f, 7.58218244e-02f, 9.99711990e-01f, 2.39976961e-02f, 9.99971211e-01f, 7.58939330e-03f,
  9.91202831e-01f, -1.32351756e-01f, -5.16893305e-02f, 9.98663187e-01f, -8.01143587e-01f, 5.98472118e-01f, 7.03440726e-01f, 7.10753918e-01f,
  9.68912423e-01f, 2.47403964e-01f, 9.96876657e-01f, 7.89746121e-02f, 9.99687493e-01f, 2.49973964e-02f, 9.99968767e-01f, 7.90561177e-03f,
  6.46919310e-01f, 7.62558460e-01f, -3.59694332e-01f, 9.33070183e-01f, -8.56888831e-01f, 5.15501261e-01f, 6.80616796e-01f, 7.32639611e-01f,
  9.66389954e-01f, 2.57080555e-01f, 9.96621907e-01f, 8.21266174e-02f, 9.99662042e-01f, 2.59970706e-02f, 9.99966204e-01f, 8.22182931e-03f,
  -2.92138815e-01f, 9.56375957e-01f, -6.32028639e-01f, 7.74945021e-01f, -9.04072165e-01f, 4.27379847e-01f, 6.57112300e-01f, 7.53792703e-01f,
  9.63770926e-01f, 2.66731411e-01f, 9.96357203e-01f, 8.52777958e-02f, 9.99635518e-01f, 2.69967206e-02f, 9.99963522e-01f, 8.53804592e-03f,
  -9.62605894e-01f, 2.70905793e-01f, -8.41684937e-01f, 5.39968967e-01f, -9.42222297e-01f, 3.34988207e-01f, 6.32950664e-01f, 7.74192095e-01f,
  9.61055458e-01f, 2.76355654e-01f, 9.96082544e-01f, 8.84281173e-02f, 9.99608040e-01f, 2.79963426e-02f, 9.99960780e-01f, 8.85426160e-03f,
  -7.48057544e-01f, -6.63633883e-01f, -9.67871487e-01f, 2.51445323e-01f, -9.70958173e-01f, 2.39249229e-01f, 6.08156204e-01f, 7.93817401e-01f,
  9.58243906e-01f, 2.85952210e-01f, 9.95797932e-01f, 9.15775672e-02f, 9.99579549e-01f, 2.89959367e-02f, 9.99957979e-01f, 9.17047635e-03f,
  1.54251456e-01f, -9.88031626e-01f, -9.98075247e-01f, -6.20148405e-02f, -9.89992499e-01f, 1.41120002e-01f, 5.82753658e-01f, 8.12648892e-01f,
  9.55336511e-01f, 2.95520186e-01f, 9.95503366e-01f, 9.47260931e-02f, 9.99550045e-01f, 2.99955010e-02f, 9.99954998e-01f, 9.48669016e-03f,
  9.14742351e-01f, -4.04037654e-01f, -9.29300308e-01f, -3.69325012e-01f, -9.99135137e-01f, 4.15805206e-02f, 5.56768358e-01f, 8.30667794e-01f,
  9.52333570e-01f, 3.05058628e-01f, 9.95198846e-01f, 9.78736654e-02f, 9.99519527e-01f, 3.09950355e-02f, 9.99951959e-01f, 9.80290305e-03f,
  8.34223390e-01f, 5.51426709e-01f, -7.68367112e-01f, -6.40009403e-01f, -9.98294771e-01f, -5.83741926e-02f, 5.30226350e-01f, 8.47856104e-01f,
  9.49235439e-01f, 3.14566553e-01f, 9.94884372e-01f, 1.01020269e-01f, 9.99488056e-01f, 3.19945402e-02f, 9.99948800e-01f, 1.01191159e-02f,
  -1.32767474e-02f, 9.99911845e-01f, -5.31235278e-01f, -8.47224355e-01f, -9.87479806e-01f, -1.57745644e-01f, 5.03154159e-01f, 8.64196658e-01f,
  9.46042359e-01f, 3.24043006e-01f, 9.94559944e-01f, 1.04165860e-01f, 9.99455571e-01f, 3.29940096e-02f, 9.99945521e-01f, 1.04353270e-02f,
  -8.48570287e-01f, 5.29082716e-01f, -2.41421118e-01f, -9.70420420e-01f, -9.66798186e-01f, -2.55541205e-01f, 4.75578904e-01f, 8.79673064e-01f,
  9.42754686e-01f, 3.33487093e-01f, 9.94225562e-01f, 1.07310407e-01f, 9.99422073e-01f, 3.39934528e-02f, 9.99942183e-01f, 1.07515370e-02f,
  -9.03692186e-01f, -4.28182662e-01f, 7.23346695e-02f, -9.97380435e-01f, -9.36456680e-01f, -3.50783229e-01f, 4.47528064e-01f, 8.94269884e-01f,
  9.39372718e-01f, 3.42897803e-01f, 9.93881226e-01f, 1.10453881e-01f, 9.99387562e-01f, 3.49928550e-02f, 9.99938726e-01f, 1.10677453e-02f,
  -1.27963692e-01f, -9.91778851e-01f, 3.78916174e-01f, -9.25431013e-01f, -8.96758378e-01f, -4.42520559e-01f, 4.19029742e-01f, 9.07972515e-01f,
  9.35896814e-01f, 3.52274209e-01f, 9.93526995e-01f, 1.13596253e-01f, 9.99352098e-01f, 3.59922275e-02f, 9.99935210e-01f, 1.13839535e-02f,
  7.65414059e-01f, -6.43538117e-01f, 6.47921681e-01f, -7.61706948e-01f, -8.48100007e-01f, -5.29836178e-01f, 3.90112430e-01f, 9.20767248e-01f,
  9.32327330e-01f, 3.61615449e-01f, 9.93162811e-01f, 1.16737492e-01f, 9.99315560e-01f, 3.69915590e-02f, 9.99931574e-01f, 1.17001599e-02f,
  9.55073655e-01f, 2.96368569e-01f, 8.52673113e-01f, -5.22444785e-01f, -7.90967762e-01f, -6.11857831e-01f, 3.60805035e-01f, 9.32641268e-01f,
  9.28664625e-01f, 3.70920479e-01f, 9.92788672e-01f, 1.19877554e-01f, 9.99278069e-01f, 3.79908569e-02f, 9.99927819e-01f, 1.20163653e-02f,
  2.66642928e-01f, 9.63795364e-01f, 9.72865343e-01f, -2.31372014e-01f, -7.25932240e-01f, -6.87766254e-01f, 3.31136853e-01f, 9.43582714e-01f,
  9.24909055e-01f, 3.80188406e-01f, 9.92404640e-01f, 1.23016424e-01f, 9.99239624e-01f, 3.89901139e-02f, 9.99923944e-01f, 1.23325698e-02f,
  -6.66938066e-01f, 7.45113134e-01f, 9.96578991e-01f, 8.26458037e-02f, -6.53643608e-01f, -7.56802499e-01f, 3.01137596e-01f, 9.53580678e-01f,
  9.21060979e-01f, 3.89418334e-01f, 9.92010653e-01f, 1.26154065e-01f, 9.99200106e-01f, 3.99893373e-02f, 9.99920011e-01f, 1.26487734e-02f,
  -9.87339258e-01f, -1.58622667e-01f, 9.21462357e-01f, 3.88467699e-01f, -5.74824035e-01f, -8.18277061e-01f, 2.70837069e-01f, 9.62625206e-01f,
  9.17120814e-01f, 3.98609310e-01f, 9.91606772e-01f, 1.29290432e-01f, 9.99159634e-01f, 4.09885161e-02f, 9.99915957e-01f, 1.29649751e-02f,
  -3.99985313e-01f, -9.16521549e-01f, 7.54965365e-01f, 6.55764699e-01f, -4.90260571e-01f, -8.71575892e-01f, 2.40265876e-01f, 9.70707119e-01f,
  9.13088918e-01f, 4.07760441e-01f, 9.91192937e-01f, 1.32425532e-01f, 9.99118149e-01f, 4.19876575e-02f, 9.99911785e-01f, 1.32811759e-02f,
  5.55113316e-01f, -8.31774771e-01f, 5.13598442e-01f, 8.58030677e-01f, -4.00799006e-01f, -9.16166008e-01f, 2.09454417e-01f, 9.77818429e-01f,
  9.08965766e-01f, 4.16870773e-01f, 9.90769207e-01f, 1.35559291e-01f, 9.99075651e-01f, 4.29867506e-02f, 9.99907553e-01f, 1.35973748e-02f,
  9.99843299e-01f, 1.77019257e-02f, 2.21298173e-01f, 9.75206196e-01f, -3.07332784e-01f, -9.51602101e-01f, 1.78433523e-01f, 9.83951986e-01f,
  9.04751658e-01f, 4.25939471e-01f, 9.90335584e-01f, 1.38691694e-01f, 9.99032140e-01f, 4.39858064e-02f, 9.99903202e-01f, 1.39135728e-02f,
  5.25321960e-01f, 8.50903511e-01f, -9.29481089e-02f, 9.95670974e-01f, -2.10795805e-01f, -9.77530122e-01f, 1.47234216e-01f, 9.89101648e-01f,
  9.00447130e-01f, 4.34965521e-01f, 9.89892066e-01f, 1.41822711e-01f, 9.98987675e-01f, 4.49848175e-02f, 9.99898732e-01f, 1.42297689e-02f,
  -4.32177931e-01f, 9.01788354e-01f, -3.97976756e-01f, 9.17395473e-01f, -1.12152621e-01f, -9.93690968e-01f, 1.15887694e-01f, 9.93262351e-01f,
  8.96052480e-01f, 4.43948090e-01f, 9.89438653e-01f, 1.44952312e-01f, 9.98942196e-01f, 4.59837839e-02f, 9.99894202e-01f, 1.45459641e-02f,
  -9.92335498e-01f, 1.23573124e-01f, -6.63538277e-01f, 7.48142362e-01f, -1.23883775e-02f, -9.99923289e-01f, 8.44252855e-02f, 9.96429801e-01f,
  8.91568303e-01f, 4.52886283e-01f, 9.88975346e-01f, 1.48080453e-01f, 9.98895705e-01f, 4.69827019e-02f, 9.99889553e-01f, 1.48621574e-02f,
  -6.40144348e-01f, -7.68254638e-01f, -8.63296509e-01f, 5.04697084e-01f, 8.74991715e-02f, -9.96164620e-01f, 5.28784581e-02f, 9.98600960e-01f,
  8.86994898e-01f, 4.61779177e-01f, 9.88502085e-01f, 1.51207119e-01f, 9.98848200e-01f, 4.79815714e-02f, 9.99884784e-01f, 1.51783489e-02f,
  3.00592542e-01f, -9.53752637e-01f, -9.77442741e-01f, 2.11200655e-01f, 1.86512470e-01f, -9.82452571e-01f, 2.12787576e-02f, 9.99773562e-01f,
  8.82332861e-01f, 4.70625877e-01f, 9.88018990e-01f, 1.54332280e-01f, 9.98799741e-01f, 4.89803962e-02f, 9.99879956e-01f, 1.54945394e-02f,
  9.64965999e-01f, -2.62374848e-01f, -9.94656444e-01f, -1.03240460e-01f, 2.83662200e-01f, -9.58924294e-01f, -1.03422189e-02f, 9.99946535e-01f,
  8.77582550e-01f, 4.79425550e-01f, 9.87526000e-01f, 1.57455891e-01f, 9.98750269e-01f, 4.99791689e-02f, 9.99875009e-01f, 1.58107281e-02f,
  7.42154181e-01f, 6.70229197e-01f, -9.13230121e-01f, -4.07444149e-01f, 3.77977669e-01f, -9.25814748e-01f, -4.19528559e-02f, 9.99119580e-01f,
  8.72744501e-01f, 4.88177240e-01f, 9.87023175e-01f, 1.60577938e-01f, 9.98699784e-01f, 5.09778969e-02f, 9.99869943e-01f, 1.61269177e-02f,
  -1.62990779e-01f, 9.86627579e-01f, -7.41239965e-01f, -6.71240151e-01f, 4.68516916e-01f, -8.83454502e-01f, -7.35215396e-02f, 9.97293651e-01f,
  8.67819190e-01f, 4.96880114e-01f, 9.86510456e-01f, 1.63698375e-01f, 9.98648286e-01f, 5.19765690e-02f, 9.99864817e-01f, 1.64431017e-02f,
  -9.18282807e-01f, 3.95925164e-01f, -4.95741814e-01f, -8.68469954e-01f, 5.54374516e-01f, -8.32267344e-01f, -1.05016708e-01f, 9.94470477e-01f,
  8.62807095e-01f, 5.05533338e-01f, 9.85987842e-01f, 1.66817173e-01f, 9.98595834e-01f, 5.29751927e-02f, 9.99859571e-01f, 1.67592876e-02f,
  -8.29309821e-01f, -5.58789074e-01f, -2.01079622e-01f, -9.79574919e-01f, 6.34692967e-01f, -7.72764444e-01f, -1.36406869e-01f, 9.90652919e-01f,
  8.57708693e-01f, 5.14135957e-01f, 9.85455394e-01f, 1.69934288e-01f, 9.98542368e-01f, 5.39737605e-02f, 9.99854207e-01f, 1.70754679e-02f,
  2.21267566e-02f, -9.99755144e-01f, 1.13521777e-01f, -9.93535519e-01f, 7.08669782e-01f, -7.05540299e-01f, -1.67660639e-01f, 9.85844791e-01f,
  8.52524519e-01f, 5.22687256e-01f, 9.84913111e-01f, 1.73049718e-01f, 9.98487890e-01f, 5.49722798e-02f, 9.99848783e-01f, 1.73916500e-02f,
  8.53220105e-01f, -5.21551013e-01f, 4.16867077e-01f, -9.08967435e-01f, 7.75565803e-01f, -6.31266713e-01f, -1.98746875e-01f, 9.80050862e-01f,
  8.47255111e-01f, 5.31186223e-01f, 9.84360933e-01f, 1.76163420e-01f, 9.98432398e-01f, 5.59707358e-02f, 9.99843180e-01f, 1.77078284e-02f,
  8.99866819e-01f, 4.36164767e-01f, 6.78870201e-01f, -7.34258294e-01f, 8.34712923e-01f, -5.50685287e-01f, -2.29634270e-01f, 9.73276973e-01f,
  8.41901004e-01f, 5.39632022e-01f, 9.83798921e-01f, 1.79275364e-01f, 9.98375952e-01f, 5.69691435e-02f, 9.99837577e-01f, 1.80240069e-02f,
  1.19180135e-01f, 9.92872655e-01f, 8.73550534e-01f, -4.86733496e-01f, 8.85519624e-01f, -4.64602023e-01f, -2.60292053e-01f, 9.65529919e-01f,
  8.36462677e-01f, 5.48023939e-01f, 9.83227074e-01f, 1.82385504e-01f, 9.98318493e-01f, 5.79674877e-02f, 9.99831796e-01f, 1.83401816e-02f,
  -7.71080196e-01f, 6.36738002e-01f, 9.81602073e-01f, -1.90938011e-01f, 9.27478492e-01f, -3.73876572e-01f, -2.90689558e-01f, 9.56817448e-01f,
  8.30940723e-01f, 5.56361020e-01f, 9.82645452e-01f, 1.85493827e-01f, 9.98260021e-01f, 5.89657798e-02f, 9.99825954e-01f, 1.86563563e-02f,
  -9.52412963e-01f, -3.04810613e-01f, 9.92308319e-01f, 1.23790950e-01f, 9.60170269e-01f, -2.79415488e-01f, -3.20796400e-01f, 9.47148204e-01f,
  8.25335622e-01f, 5.64642429e-01f, 9.82053936e-01f, 1.88600287e-01f, 9.98200536e-01f, 5.99640086e-02f, 9.99819994e-01f, 1.89725272e-02f,
  -2.58101642e-01f, -9.66117799e-01f, 9.04607594e-01f, 4.26245421e-01f, 9.83268440e-01f, -1.82162598e-01f, -3.50582451e-01f, 9.36531842e-01f,
  8.19648027e-01f, 5.72867453e-01f, 9.81452644e-01f, 1.91704854e-01f, 9.98140097e-01f, 6.09621815e-02f, 9.99813974e-01f, 1.92886982e-02f,
  6.73507154e-01f, -7.39180684e-01f, 7.27198064e-01f, 6.86427653e-01f, 9.96542096e-01f, -8.30891207e-02f, -3.80017966e-01f, 9.24979091e-01f,
  8.13878477e-01f, 5.81035137e-01f, 9.80841517e-01f, 1.94807529e-01f, 9.98078644e-01f, 6.19602874e-02f, 9.99807835e-01f, 1.96048655e-02f,
  9.85896587e-01f, 1.67355701e-01f, 4.77671444e-01f, 8.78538549e-01f, 9.99858618e-01f, 1.68140903e-02f, -4.09073502e-01f, 9.12501454e-01f,
  8.08027506e-01f, 5.89144766e-01f, 9.80220556e-01f, 1.97908238e-01f, 9.98016179e-01f, 6.29583374e-02f, 9.99801576e-01f, 1.99210308e-02f,
};
__device__ const float TAB_S[2048] = {
  1.00000000e+00f, 0.00000000e+00f, 1.00000000e+00f, 0.00000000e+00f, 1.00000000e+00f, 0.00000000e+00f, 1.00000000e+00f, 0.00000000e+00f,
  1.00000000e+00f, 0.00000000e+00f, 1.00000000e+00f, 0.00000000e+00f, 1.00000000e+00f, 0.00000000e+00f, 1.00000000e+00f, 0.00000000e+00f,
  1.00000000e+00f, 0.00000000e+00f, 1.00000000e+00f, 0.00000000e+00f, 1.00000000e+00f, 0.00000000e+00f, 1.00000000e+00f, 0.00000000e+00f,
  1.00000000e+00f, 0.00000000e+00f, 1.00000000e+00f, 0.00000000e+00f, 1.00000000e+00f, 0.00000000e+00f, 1.00000000e+00f, 0.00000000e+00f,
  5.40302277e-01f, 8.41470957e-01f, 8.46009135e-01f, 5.33168435e-01f, 9.50415254e-01f, 3.10983598e-01f, 9.84230220e-01f, 1.76892191e-01f,
  9.95004177e-01f, 9.98334214e-02f, 9.98419285e-01f, 5.62044978e-02f, 9.99500036e-01f, 3.16175036e-02f, 9.99841869e-01f, 1.77818574e-02f,
  9.99949992e-01f, 9.99983307e-03f, 9.99984205e-01f, 5.62338345e-03f, 9.99994993e-01f, 3.16227227e-03f, 9.99998391e-01f, 1.77827850e-03f,
  9.99999523e-01f, 9.99999931e-04f, 9.99999821e-01f, 5.62341243e-04f, 9.99999940e-01f, 3.16227757e-04f, 1.00000000e+00f, 1.77827940e-04f,
  -4.16146845e-01f, 9.09297407e-01f, 4.31462824e-01f, 9.02130723e-01f, 8.06578398e-01f, 5.91127098e-01f, 9.37418282e-01f, 3.48205268e-01f,
  9.80066597e-01f, 1.98669329e-01f, 9.93682086e-01f, 1.12231314e-01f, 9.98000681e-01f, 6.32033944e-02f, 9.99367595e-01f, 3.55580896e-02f,
  9.99800026e-01f, 1.99986659e-02f, 9.99936759e-01f, 1.12465890e-02f, 9.99979973e-01f, 6.32451288e-03f, 9.99993682e-01f, 3.55655141e-03f,
  9.99997973e-01f, 1.99999870e-03f, 9.99999344e-01f, 1.12468237e-03f, 9.99999821e-01f, 6.32455456e-04f, 9.99999940e-01f, 3.55655880e-04f,
  -9.89992499e-01f, 1.41120002e-01f, -1.15966164e-01f, 9.93253171e-01f, 5.82753658e-01f, 8.12648892e-01f, 8.61040652e-01f, 5.08536100e-01f,
  9.55336511e-01f, 2.95520216e-01f, 9.85803485e-01f, 1.67903304e-01f, 9.95503366e-01f, 9.47260857e-02f, 9.98577297e-01f, 5.33230826e-02f,
  9.99550045e-01f, 2.99954992e-02f, 9.99857724e-01f, 1.68694388e-02f, 9.99954998e-01f, 9.48669016e-03f, 9.99985754e-01f, 5.33481315e-03f,
  9.99995530e-01f, 2.99999560e-03f, 9.99998569e-01f, 1.68702309e-03f, 9.99999523e-01f, 9.48683126e-04f, 9.99999881e-01f, 5.33483806e-04f,
  -6.53643608e-01f, -7.56802499e-01f, -6.27679706e-01f, 7.78471708e-01f, 3.01137477e-01f, 9.53580737e-01f, 7.57506192e-01f, 6.52827978e-01f,
  9.21060979e-01f, 3.89418334e-01f, 9.74808276e-01f, 2.23044485e-01f, 9.92010653e-01f, 1.26154065e-01f, 9.97471273e-01f, 7.10712075e-02f,
  9.99200106e-01f, 3.99893336e-02f, 9.99747038e-01f, 2.24917568e-02f, 9.99920011e-01f, 1.26487734e-02f, 9.99974728e-01f, 7.11305765e-03f,
  9.99992013e-01f, 3.99998948e-03f, 9.99997497e-01f, 2.24936334e-03f, 9.99999225e-01f, 1.26491068e-03f, 9.99999762e-01f, 7.11311703e-04f,
  2.83662200e-01f, -9.58924294e-01f, -9.46079254e-01f, 3.23935270e-01f, -1.03423381e-02f, 9.99946535e-01f, 6.30080283e-01f, 7.76529968e-01f,
  8.77582550e-01f, 4.79425550e-01f, 9.60731268e-01f, 2.77480543e-01f, 9.87526000e-01f, 1.57455876e-01f, 9.96049762e-01f, 8.87968615e-02f,
  9.98750269e-01f, 4.99791652e-02f, 9.99604762e-01f, 2.81133614e-02f, 9.99875009e-01f, 1.58107281e-02f, 9.99960482e-01f, 8.89127981e-03f,
  9.99987483e-01f, 4.99997940e-03f, 9.99996066e-01f, 2.81170290e-03f, 9.99998748e-01f, 1.58113812e-03f, 9.99999583e-01f, 8.89139599e-04f,
  9.60170269e-01f, -2.79415488e-01f, -9.73103702e-01f, -2.30367512e-01f, -3.20796400e-01f, 9.47148204e-01f, 4.82782036e-01f, 8.75740528e-01f,
  8.25335622e-01f, 5.64642489e-01f, 9.43616986e-01f, 3.31039310e-01f, 9.82053936e-01f, 1.88600272e-01f, 9.94313300e-01f, 1.06494442e-01f,
  9.98200536e-01f, 5.99640049e-02f, 9.99430835e-01f, 3.37340795e-02f, 9.99819994e-01f, 1.89725272e-02f, 9.99943078e-01f, 1.06694745e-02f,
  9.99981999e-01f, 5.99996420e-03f, 9.99994338e-01f, 3.37404152e-03f, 9.99998212e-01f, 1.89736532e-03f, 9.99999404e-01f, 1.06696738e-03f,
  7.53902256e-01f, 6.56986594e-01f, -7.00429797e-01f, -7.13721275e-01f, -5.99437475e-01f, 8.00421596e-01f, 3.20257008e-01f, 9.47330713e-01f,
  7.64842212e-01f, 6.44217670e-01f, 9.23519433e-01f, 3.83551568e-01f, 9.75599885e-01f, 2.19556093e-01f, 9.92262423e-01f, 1.24158338e-01f,
  9.97551024e-01f, 6.99428469e-02f, 9.99225318e-01f, 3.93537246e-02f, 9.99755025e-01f, 2.21341345e-02f, 9.99922514e-01f, 1.24476347e-02f,
  9.99975502e-01f, 6.99994294e-03f, 9.99992251e-01f, 3.93637875e-03f, 9.99997556e-01f, 2.21359241e-03f, 9.99999225e-01f, 1.24479528e-03f,
  -1.45500034e-01f, 9.89358246e-01f, -2.12036446e-01f, -9.77261782e-01f, -8.18632424e-01f, 5.74317753e-01f, 1.47631213e-01f, 9.89042461e-01f,
  6.96706712e-01f, 7.17356086e-01f, 9.00502324e-01f, 4.34851229e-01f, 9.68170285e-01f, 2.50292331e-01f, 9.89897788e-01f, 1.41782969e-01f,
  9.96801734e-01f, 7.99146891e-02f, 9.98988271e-01f, 4.49721329e-02f, 9.99680042e-01f, 2.52955221e-02f, 9.99898791e-01f, 1.42257558e-02f,
  9.99967992e-01f, 7.99991470e-03f, 9.99989867e-01f, 4.49871505e-03f, 9.99996781e-01f, 2.52981926e-03f, 9.99998987e-01f, 1.42262306e-03f,
  -9.11130250e-01f, 4.12118495e-01f, 3.41660261e-01f, -9.39823508e-01f, -9.56644177e-01f, 2.91259229e-01f, -2.96507962e-02f, 9.99560297e-01f,
  6.21609926e-01f, 7.83326924e-01f, 8.74638259e-01f, 4.84776139e-01f, 9.59772646e-01f, 2.80778319e-01f, 9.87220109e-01f, 1.59362778e-01f,
  9.95952725e-01f, 8.98785442e-02f, 9.98719573e-01f, 5.05891182e-02f, 9.99595046e-01f, 2.84566563e-02f, 9.99871910e-01f, 1.60038304e-02f,
  9.99959528e-01f, 8.99987947e-03f, 9.99987185e-01f, 5.06105041e-03f, 9.99995947e-01f, 2.84604589e-03f, 9.99998748e-01f, 1.60045072e-03f,
  -8.39071512e-01f, -5.44021130e-01f, 7.90131867e-01f, -6.12936914e-01f, -9.99786079e-01f, -2.06835698e-02f, -2.05997631e-01f, 9.78552461e-01f,
  5.40302277e-01f, 8.41470957e-01f, 8.46009135e-01f, 5.33168435e-01f, 9.50415313e-01f, 3.10983568e-01f, 9.84230220e-01f, 1.76892191e-01f,
  9.95004177e-01f, 9.98334140e-02f, 9.98419285e-01f, 5.62044978e-02f, 9.99500036e-01f, 3.16175036e-02f, 9.99841869e-01f, 1.77818574e-02f,
  9.99949992e-01f, 9.99983400e-03f, 9.99984205e-01f, 5.62338345e-03f, 9.99994993e-01f, 3.16227227e-03f, 9.99998391e-01f, 1.77827850e-03f,
  4.42569796e-03f, -9.99990225e-01f, 9.95257378e-01f, -9.72764567e-02f, -9.43779767e-01f, -3.30574960e-01f, -3.75847399e-01f, 9.26681578e-01f,
  4.53596085e-01f, 8.91207397e-01f, 8.14705312e-01f, 5.79875171e-01f, 9.40107584e-01f, 3.40877861e-01f, 9.80929136e-01f, 1.94365650e-01f,
  9.93956089e-01f, 1.09778300e-01f, 9.98087406e-01f, 6.18181042e-02f, 9.99395072e-01f, 3.47780399e-02f, 9.99808669e-01f, 1.95598267e-02f,
  9.99939501e-01f, 1.09997792e-02f, 9.99980867e-01f, 6.18571462e-03f, 9.99993920e-01f, 3.47849843e-03f, 9.99998093e-01f, 1.95610616e-03f,
  8.43853951e-01f, -5.36572933e-01f, 8.93861592e-01f, 4.48342979e-01f, -7.94179380e-01f, -6.07683420e-01f, -5.33843040e-01f, 8.45583618e-01f,
  3.62357706e-01f, 9.32039082e-01f, 7.80825913e-01f, 6.24748647e-01f, 9.28859890e-01f, 3.70431304e-01f, 9.77317870e-01f, 2.11777672e-01f,
  9.92808640e-01f, 1.19712204e-01f, 9.97723997e-01f, 6.74297586e-02f, 9.99280095e-01f, 3.79382223e-02f, 9.99772310e-01f, 2.13377345e-02f,
  9.99927998e-01f, 1.19997123e-02f, 9.99977231e-01f, 6.74804440e-03f, 9.99992788e-01f, 3.79472389e-03f, 9.99997735e-01f, 2.13393359e-03f,
  9.07446802e-01f, 4.20167029e-01f, 5.17172873e-01f, 8.55880976e-01f, -5.65820515e-01f, -8.24528456e-01f, -6.75001681e-01f, 7.37816215e-01f,
  2.67498761e-01f, 9.63558197e-01f, 7.44477987e-01f, 6.67647004e-01f, 9.16683376e-01f, 3.99614304e-01f, 9.73397553e-01f, 2.29122713e-01f,
  9.91561890e-01f, 1.29634142e-01f, 9.97329056e-01f, 7.30392784e-02f, 9.99155104e-01f, 4.10980321e-02f, 9.99732792e-01f, 2.31155735e-02f,
  9.99915481e-01f, 1.29996343e-02f, 9.99973297e-01f, 7.31037185e-03f, 9.99991536e-01f, 4.11094911e-03f, 9.99997318e-01f, 2.31176103e-03f,
  1.36737213e-01f, 9.90607381e-01f, -1.87961515e-02f, 9.99823332e-01f, -2.81349480e-01f, -9.59605396e-01f, -7.94870913e-01f, 6.06778562e-01f,
  1.69967160e-01f, 9.85449731e-01f, 7.05776393e-01f, 7.08434701e-01f, 9.03590262e-01f, 4.28397775e-01f, 9.69169438e-01f, 2.46395305e-01f,
  9.90216017e-01f, 1.39543116e-01f, 9.96902585e-01f, 7.86464810e-02f, 9.99020159e-01f, 4.42574248e-02f, 9.99690115e-01f, 2.48933397e-02f,
  9.99902010e-01f, 1.39995432e-02f, 9.99969006e-01f, 7.87269697e-03f, 9.99990225e-01f, 4.42717411e-03f, 9.99996901e-01f, 2.48958869e-03f,
  -7.59687901e-01f, 6.50287867e-01f, -5.48975468e-01f, 8.35838437e-01f, 3.10223512e-02f, -9.99518692e-01f, -8.89670432e-01f, 4.56603259e-01f,
  7.07371980e-02f, 9.97494996e-01f, 6.64843500e-01f, 7.46982634e-01f, 8.89593601e-01f, 4.56752867e-01f, 9.64634836e-01f, 2.63589978e-01f,
  9.88771081e-01f, 1.49438128e-01f, 9.96444523e-01f, 8.42512026e-02f, 9.98875201e-01f, 4.74163815e-02f, 9.99644279e-01f, 2.66710296e-02f,
  9.99887526e-01f, 1.49994381e-02f, 9.99964416e-01f, 8.43502022e-03f, 9.99988735e-01f, 4.74339863e-03f, 9.99996424e-01f, 2.66741589e-03f,
  -9.57659483e-01f, -2.87903309e-01f, -9.10081089e-01f, 4.14430231e-01f, 3.40318173e-01f, -9.40310359e-01f, -9.56410050e-01f, 2.92027086e-01f,
  -2.91995462e-02f, 9.99573588e-01f, 6.21808827e-01f, 7.83169091e-01f, 8.74707460e-01f, 4.84651238e-01f, 9.59795177e-01f, 2.80701309e-01f,
  9.87227261e-01f, 1.59318209e-01f, 9.95954990e-01f, 8.98532644e-02f, 9.98720288e-01f, 5.05748577e-02f, 9.99595284e-01f, 2.84486320e-02f,
  9.99872029e-01f, 1.59993190e-02f, 9.99959528e-01f, 8.99733976e-03f, 9.99987185e-01f, 5.05962269e-03f, 9.99995947e-01f, 2.84524332e-03f,
  -2.75163352e-01f, -9.61397469e-01f, -9.90897954e-01f, -1.34615138e-01f, 6.15864813e-01f, -7.87851870e-01f, -9.92985010e-01f, 1.18240520e-01f,
  -1.28844544e-01f, 9.91664827e-01f, 5.76808274e-01f, 8.16879570e-01f, 8.58946681e-01f, 5.12064993e-01f, 9.54652011e-01f, 2.97723860e-01f,
  9.85584795e-01f, 1.69182345e-01f, 9.95433986e-01f, 9.54524800e-02f, 9.98555362e-01f, 5.37328273e-02f, 9.99543071e-01f, 3.02261449e-02f,
  9.99855518e-01f, 1.69991814e-02f, 9.99954283e-01f, 9.55965649e-03f, 9.99985576e-01f, 5.37584582e-03f, 9.99995410e-01f, 3.02307028e-03f,
  6.60316706e-01f, -7.50987232e-01f, -7.66536534e-01f, -6.42200708e-01f, 8.30336154e-01f, -5.57262897e-01f, -9.98241663e-01f, -5.92755191e-02f,
  -2.27202162e-01f, 9.73847628e-01f, 5.29984176e-01f, 8.48007560e-01f, 8.42327058e-01f, 5.38966715e-01f, 9.49207008e-01f, 3.14652264e-01f,
  9.83843684e-01f, 1.79029569e-01f, 9.94881511e-01f, 1.01048686e-01f, 9.98380423e-01f, 5.68902642e-02f, 9.99487758e-01f, 3.20035629e-02f,
  9.99837995e-01f, 1.79990288e-02f, 9.99948800e-01f, 1.01219704e-02f, 9.99983788e-01f, 5.69206895e-03f, 9.99994874e-01f, 3.20089748e-03f,
  9.88704622e-01f, 1.49877205e-01f, -3.06095392e-01f, -9.52000856e-01f, 9.62463796e-01f, -2.71410108e-01f, -9.72014248e-01f, -2.34921798e-01f,
  -3.23289543e-01f, 9.46300089e-01f, 4.81484592e-01f, 8.76454532e-01f, 8.24865162e-01f, 5.65329552e-01f, 9.43461835e-01f, 3.31481189e-01f,
  9.82004225e-01f, 1.88858896e-01f, 9.94297504e-01f, 1.06641680e-01f, 9.98195529e-01f, 6.00471310e-02f, 9.99429286e-01f, 3.37808803e-02f,
  9.99819517e-01f, 1.89988576e-02f, 9.99942899e-01f, 1.06842816e-02f, 9.99981940e-01f, 6.00829115e-03f, 9.99994278e-01f, 3.37872445e-03f,
  4.08082068e-01f, 9.12945271e-01f, 2.48616725e-01f, -9.68601942e-01f, 9.99144375e-01f, 4.13582884e-02f, -9.15129960e-01f, -4.03158993e-01f,
  -4.16146845e-01f, 9.09297407e-01f, 4.31462824e-01f, 9.02130723e-01f, 8.06578457e-01f, 5.91127038e-01f, 9.37418282e-01f, 3.48205268e-01f,
  9.80066597e-01f, 1.98669314e-01f, 9.93682086e-01f, 1.12231314e-01f, 9.98000681e-01f, 6.32033944e-02f, 9.99367595e-01f, 3.55580896e-02f,
  9.99800026e-01f, 1.99986678e-02f, 9.99936759e-01f, 1.12465890e-02f, 9.99979973e-01f, 6.32451288e-03f, 9.99993682e-01f, 3.55655141e-03f,
  -5.47729254e-01f, 8.36655617e-01f, 7.26760268e-01f, -6.86891198e-01f, 9.36740458e-01f, 3.50024760e-01f, -8.29382956e-01f, -5.58680534e-01f,
  -5.04846215e-01f, 8.63209307e-01f, 3.80077004e-01f, 9.24954832e-01f, 7.87485182e-01f, 6.16333544e-01f, 9.31078374e-01f, 3.64819258e-01f,
  9.78030920e-01f, 2.08459899e-01f, 9.93035257e-01f, 1.17817394e-01f, 9.97795820e-01f, 6.63590282e-02f, 9.99302804e-01f, 3.73351872e-02f,
  9.99779522e-01f, 2.09984574e-02f, 9.99930263e-01f, 1.18088927e-02f, 9.99977946e-01f, 6.64073415e-03f, 9.99993026e-01f, 3.73437814e-03f,
  -9.99960840e-01f, -8.85130931e-03f, 9.81074572e-01f, -1.93630233e-01f, 7.81440377e-01f, 6.23979926e-01f, -7.17477441e-01f, -6.96581721e-01f,
  -5.88501155e-01f, 8.08496356e-01f, 3.27489585e-01f, 9.44854796e-01f, 7.67604589e-01f, 6.40923738e-01f, 9.24443960e-01f, 3.81317884e-01f,
  9.75897431e-01f, 2.18229622e-01f, 9.92357016e-01f, 1.23399742e-01f, 9.97581005e-01f, 6.95140064e-02f, 9.99234855e-01f, 3.91121693e-02f,
  9.99758005e-01f, 2.19982266e-02f, 9.99923468e-01f, 1.23711927e-02f, 9.99975801e-01f, 6.95695449e-03f, 9.99992371e-01f, 3.91220488e-03f,
  -5.32833040e-01f, -8.46220434e-01f, 9.33235765e-01f, 3.59264523e-01f, 5.48645258e-01f, 8.36055279e-01f, -5.82943261e-01f, -8.12512875e-01f,
  -6.66275978e-01f, 7.45705247e-01f, 2.73866832e-01f, 9.61767614e-01f, 7.46956408e-01f, 6.64873064e-01f, 9.17517304e-01f, 3.97695929e-01f,
  9.73666370e-01f, 2.27977514e-01f, 9.91647422e-01f, 1.28978193e-01f, 9.97356176e-01f, 7.26682767e-02f, 9.99163687e-01f, 4.08890247e-02f,
  9.99735534e-01f, 2.29979735e-02f, 9.99916375e-01f, 1.29334899e-02f, 9.99973536e-01f, 7.27317436e-03f, 9.99991655e-01f, 4.09003161e-03f,
  4.24179018e-01f, -9.05578375e-01f, 5.97977161e-01f, 8.01513135e-01f, 2.61441678e-01f, 9.65219259e-01f, -4.30023283e-01f, -9.02817786e-01f,
  -7.37393796e-01f, 6.75463140e-01f, 2.19378278e-01f, 9.75639880e-01f, 7.25561321e-01f, 6.88157499e-01f, 9.10300434e-01f, 4.13948208e-01f,
  9.71337974e-01f, 2.37702623e-01f, 9.90906477e-01f, 1.34552568e-01f, 9.97121394e-01f, 7.58218244e-02f, 9.99089420e-01f, 4.26657498e-02f,
  9.99711990e-01f, 2.39976961e-02f, 9.99908924e-01f, 1.34957815e-02f, 9.99971211e-01f, 7.58939330e-03f, 9.99990880e-01f, 4.26785741e-03f,
  9.91202831e-01f, -1.32351756e-01f, 7.85522610e-02f, 9.96909976e-01f, -5.16893305e-02f, 9.98663187e-01f, -2.63540596e-01f, -9.64648306e-01f,
  -8.01143587e-01f, 5.98472118e-01f, 1.64196163e-01f, 9.86427724e-01f, 7.03440726e-01f, 7.10753918e-01f, 9.02795732e-01f, 4.30069596e-01f,
  9.68912423e-01f, 2.47403964e-01f, 9.90134120e-01f, 1.40122697e-01f, 9.96876657e-01f, 7.89746121e-02f, 9.99011934e-01f, 4.44423407e-02f,
  9.99687493e-01f, 2.49973964e-02f, 9.99901175e-01f, 1.40580693e-02f, 9.99968767e-01f, 7.90561177e-03f, 9.99990106e-01f, 4.44568414e-03f,
  6.46919310e-01f, 7.62558460e-01f, -4.65064496e-01f, 8.85276794e-01f, -3.59694332e-01f, 9.33070183e-01f, -8.87455046e-02f, -9.96054351e-01f,
  -8.56888831e-01f, 5.15501261e-01f, 1.08494945e-01f, 9.94096994e-01f, 6.80616796e-01f, 7.32639611e-01f, 8.95005584e-01f, 4.46054995e-01f,
  9.66389954e-01f, 2.57080555e-01f, 9.89330530e-01f, 1.45688385e-01f, 9.96621907e-01f, 8.21266174e-02f, 9.98931348e-01f, 4.62187938e-02f,
  9.99662042e-01f, 2.59970706e-02f, 9.99893129e-01f, 1.46203535e-02f, 9.99966204e-01f, 8.22182931e-03f, 9.99989331e-01f, 4.62350994e-03f,
  -2.92138815e-01f, 9.56375957e-01f, -8.65450621e-01f, 5.00994205e-01f, -6.32028639e-01f, 7.74945021e-01f, 8.88481140e-02f, -9.96045172e-01f,
  -9.04072165e-01f, 4.27379847e-01f, 5.24506159e-02f, 9.98623490e-01f, 6.57112300e-01f, 7.53792703e-01f, 8.86932373e-01f, 4.61899310e-01f,
  9.63770926e-01f, 2.66731411e-01f, 9.88495648e-01f, 1.51249468e-01f, 9.96357203e-01f, 8.52777958e-02f, 9.98847544e-01f, 4.79951017e-02f,
  9.99635518e-01f, 2.69967206e-02f, 9.99884725e-01f, 1.51826320e-02f, 9.99963522e-01f, 8.53804592e-03f, 9.99988496e-01f, 4.80133574e-03f,
  -9.62605894e-01f, 2.70905793e-01f, -9.99293387e-01f, -3.75856608e-02f, -8.41684937e-01f, 5.39968967e-01f, 2.63639510e-01f, -9.64621305e-01f,
  -9.42222297e-01f, 3.34988207e-01f, -3.75941908e-03f, 9.99992907e-01f, 6.32950664e-01f, 7.74192095e-01f, 8.78578722e-01f, 4.77597594e-01f,
  9.61055458e-01f, 2.76355654e-01f, 9.87629473e-01f, 1.56805754e-01f, 9.96082544e-01f, 8.84281173e-02f, 9.98760641e-01f, 4.97712530e-02f,
  9.99608040e-01f, 2.79963426e-02f, 9.99876022e-01f, 1.57449059e-02f, 9.99960780e-01f, 8.85426160e-03f, 9.99987602e-01f, 4.97916201e-03f,
  -7.48057544e-01f, -6.63633883e-01f, -8.25371623e-01f, -5.64589798e-01f, -9.67871487e-01f, 2.51445323e-01f, 4.30115849e-01f, -9.02773678e-01f,
  -9.70958173e-01f, 2.39249229e-01f, -5.99575676e-02f, 9.98200953e-01f, 6.08156204e-01f, 7.93817401e-01f, 8.69947195e-01f, 4.93144840e-01f,
  9.58243906e-01f, 2.85952210e-01f, 9.86732066e-01f, 1.62357092e-01f, 9.95797932e-01f, 9.15775672e-02f, 9.98670578e-01f, 5.15472479e-02f,
  9.99579549e-01f, 2.89959367e-02f, 9.99867022e-01f, 1.63071752e-02f, 9.99957979e-01f, 9.17047635e-03f, 9.99986708e-01f, 5.15698735e-03f,
  1.54251456e-01f, -9.88031626e-01f, -3.97251874e-01f, -9.17709649e-01f, -9.98075247e-01f, -6.20148405e-02f, 5.83026946e-01f, -8.12452853e-01f,
  -9.89992499e-01f, 1.41120002e-01f, -1.15966164e-01f, 9.93253171e-01f, 5.82753658e-01f, 8.12648892e-01f, 8.61040652e-01f, 5.08536100e-01f,
  9.55336511e-01f, 2.95520186e-01f, 9.85803485e-01f, 1.67903304e-01f, 9.95503366e-01f, 9.47260931e-02f, 9.98577297e-01f, 5.33230826e-02f,
  9.99550045e-01f, 2.99955010e-02f, 9.99857724e-01f, 1.68694388e-02f, 9.99954998e-01f, 9.48669016e-03f, 9.99985754e-01f, 5.33481315e-03f,
  9.14742351e-01f, -4.04037654e-01f, 1.53215483e-01f, -9.88192797e-01f, -9.29300308e-01f, -3.69325012e-01f, 7.17549205e-01f, -6.96507812e-01f,
  -9.99135137e-01f, 4.15805206e-02f, -1.71608135e-01f, 9.85165298e-01f, 5.56768358e-01f, 8.30667794e-01f, 8.51861775e-01f, 5.23766637e-01f,
  9.52333570e-01f, 3.05058628e-01f, 9.84843671e-01f, 1.73444211e-01f, 9.95198846e-01f, 9.78736654e-02f, 9.98480916e-01f, 5.50987460e-02f,
  9.99519527e-01f, 3.09950355e-02f, 9.99848068e-01f, 1.74316969e-02f, 9.99951959e-01f, 9.80290305e-03f, 9.99984801e-01f, 5.51263802e-03f,
  8.34223390e-01f, 5.51426709e-01f, 6.56495154e-01f, -7.54330218e-01f, -7.68367112e-01f, -6.40009403e-01f, 8.29440355e-01f, -5.58595300e-01f,
  -9.98294771e-01f, -5.83741926e-02f, -2.26707578e-01f, 9.73962843e-01f, 5.30226350e-01f, 8.47856104e-01f, 8.42413545e-01f, 5.38831532e-01f,
  9.49235439e-01f, 3.14566553e-01f, 9.83852804e-01f, 1.78979620e-01f, 9.94884372e-01f, 1.01020269e-01f, 9.98381376e-01f, 5.68742342e-02f,
  9.99488056e-01f, 3.19945402e-02f, 9.99838114e-01f, 1.79939512e-02f, 9.99948800e-01f, 1.01191159e-02f, 9.99983788e-01f, 5.69046335e-03f,
  -1.32767474e-02f, 9.99911845e-01f, 9.57586050e-01f, -2.88147390e-01f, -5.31235278e-01f, -8.47224355e-01f, 9.15171385e-01f, -4.03064936e-01f,
  -9.87479806e-01f, -1.57745644e-01f, -2.81090319e-01f, 9.59681332e-01f, 5.03154159e-01f, 8.64196658e-01f, 8.32698941e-01f, 5.53726017e-01f,
  9.46042359e-01f, 3.24043006e-01f, 9.82830763e-01f, 1.84509367e-01f, 9.94559944e-01f, 1.04165860e-01f, 9.98278618e-01f, 5.86495437e-02f,
  9.99455571e-01f, 3.29940096e-02f, 9.99827802e-01f, 1.85561981e-02f, 9.99945521e-01f, 1.04353270e-02f, 9.99982774e-01f, 5.86828869e-03f,
  -8.48570287e-01f, 5.29082716e-01f, 9.63757515e-01f, 2.66779721e-01f, -2.41421118e-01f, -9.70420420e-01f, 9.72038329e-01f, -2.34822124e-01f,
  -9.66798186e-01f, -2.55541205e-01f, -3.34584385e-01f, 9.42365825e-01f, 4.75578904e-01f, 8.79673064e-01f, 8.22721004e-01f, 5.68445385e-01f,
  9.42754686e-01f, 3.33487093e-01f, 9.81777668e-01f, 1.90033287e-01f, 9.94225562e-01f, 1.07310407e-01f, 9.98172760e-01f, 6.04246669e-02f,
  9.99422073e-01f, 3.39934528e-02f, 9.99817252e-01f, 1.91184394e-02f, 9.99942183e-01f, 1.07515370e-02f, 9.99981701e-01f, 6.04611309e-03f,
  -9.03692186e-01f, -4.28182662e-01f, 6.73110247e-01f, 7.39542127e-01f, 7.23346695e-02f, -9.97380435e-01f, 9.98247743e-01f, -5.91726787e-02f,
  -9.36456680e-01f, -3.50783229e-01f, -3.87020677e-01f, 9.22071040e-01f, 4.47528064e-01f, 8.94269884e-01f, 8.12482953e-01f, 5.82984984e-01f,
  9.39372718e-01f, 3.42897803e-01f, 9.80693519e-01f, 1.95551202e-01f, 9.93881226e-01f, 1.10453881e-01f, 9.98063743e-01f, 6.21996038e-02f,
  9.99387562e-01f, 3.49928550e-02f, 9.99806345e-01f, 1.96806751e-02f, 9.99938726e-01f, 1.10677453e-02f, 9.99980628e-01f, 6.22393796e-03f,
  -1.27963692e-01f, -9.91778851e-01f, 1.75156534e-01f, 9.84540582e-01f, 3.78916174e-01f, -9.25431013e-01f, 9.92972851e-01f, 1.18342586e-01f,
  -8.96758378e-01f, -4.42520559e-01f, -4.38233554e-01f, 8.98861170e-01f, 4.19029742e-01f, 9.07972515e-01f, 8.01987886e-01f, 5.97340286e-01f,
  9.35896814e-01f, 3.52274209e-01f, 9.79578316e-01f, 2.01062918e-01f, 9.93526995e-01f, 1.13596253e-01f, 9.97951567e-01f, 6.39743358e-02f,
  9.99352098e-01f, 3.59922275e-02f, 9.99795079e-01f, 2.02429052e-02f, 9.99935210e-01f, 1.13839535e-02f, 9.99979496e-01f, 6.40176190e-03f,
  7.65414059e-01f, -6.43538117e-01f, -3.76742303e-01f, 9.26318109e-01f, 6.47921681e-01f, -7.61706948e-01f, 9.56380010e-01f, 2.92125374e-01f,
  -8.48100007e-01f, -5.29836178e-01f, -4.88060862e-01f, 8.72809589e-01f, 3.90112430e-01f, 9.20767248e-01f, 7.91239262e-01f, 6.11506701e-01f,
  9.32327330e-01f, 3.61615449e-01f, 9.78432178e-01f, 2.06568271e-01f, 9.93162811e-01f, 1.16737492e-01f, 9.97836173e-01f, 6.57488778e-02f,
  9.99315560e-01f, 3.69915590e-02f, 9.99783576e-01f, 2.08051261e-02f, 9.99931574e-01f, 1.17001599e-02f, 9.99978364e-01f, 6.57958630e-03f,
  9.55073655e-01f, 2.96368569e-01f, -8.12611222e-01f, 5.82806170e-01f, 8.52673113e-01f, -5.22444785e-01f, 8.89623463e-01f, 4.56694692e-01f,
  -7.90967762e-01f, -6.11857831e-01f, -5.36345184e-01f, 8.43998730e-01f, 3.60805035e-01f, 9.32641268e-01f, 7.80240417e-01f, 6.25479698e-01f,
  9.28664625e-01f, 3.70920479e-01f, 9.77255106e-01f, 2.12067112e-01f, 9.92788672e-01f, 1.19877554e-01f, 9.97717679e-01f, 6.75232038e-02f,
  9.99278069e-01f, 3.79908569e-02f, 9.99771714e-01f, 2.13673431e-02f, 9.99927819e-01f, 1.20163653e-02f, 9.99977171e-01f, 6.75741071e-03f,
  2.66642928e-01f, 9.63795364e-01f, -9.98210371e-01f, 5.98003156e-02f, 9.72865343e-01f, -2.31372014e-01f, 7.94808388e-01f, 6.06860459e-01f,
  -7.25932240e-01f, -6.87766254e-01f, -5.82933903e-01f, 8.12519610e-01f, 3.31136853e-01f, 9.43582714e-01f, 7.68994927e-01f, 6.39254928e-01f,
  9.24909055e-01f, 3.80188406e-01f, 9.76047099e-01f, 2.17559248e-01f, 9.92404640e-01f, 1.23016424e-01f, 9.97596025e-01f, 6.92973137e-02f,
  9.99239624e-01f, 3.89901139e-02f, 9.99759495e-01f, 2.19295528e-02f, 9.99923944e-01f, 1.23325698e-02f, 9.99975979e-01f, 6.93523418e-03f,
  -6.66938066e-01f, 7.45113134e-01f, -8.76379430e-01f, -4.81621295e-01f, 9.96578991e-01f, 8.26458037e-02f, 6.74925625e-01f, 7.37885714e-01f,
  -6.53643608e-01f, -7.56802499e-01f, -6.27679706e-01f, 7.78471708e-01f, 3.01137596e-01f, 9.53580678e-01f, 7.57506192e-01f, 6.52827978e-01f,
  9.21060979e-01f, 3.89418334e-01f, 9.74808276e-01f, 2.23044485e-01f, 9.92010653e-01f, 1.26154065e-01f, 9.97471273e-01f, 7.10712075e-02f,
  9.99200106e-01f, 3.99893373e-02f, 9.99747038e-01f, 2.24917568e-02f, 9.99920011e-01f, 1.26487734e-02f, 9.99974728e-01f, 7.11305765e-03f,
  -9.87339258e-01f, -1.58622667e-01f, -4.84639406e-01f, -8.74714017e-01f, 9.21462357e-01f, 3.88467699e-01f, 5.33756077e-01f, 8.45638454e-01f,
  -5.74824035e-01f, -8.18277061e-01f, -6.70441091e-01f, 7.41962790e-01f, 2.70837069e-01f, 9.62625206e-01f, 7.45777905e-01f, 6.66194677e-01f,
  9.17120814e-01f, 3.98609310e-01f, 9.73538578e-01f, 2.28522688e-01f, 9.91606772e-01f, 1.29290432e-01f, 9.97343302e-01f, 7.28448778e-02f,
  9.99159634e-01f, 4.09885161e-02f, 9.99734223e-01f, 2.30539497e-02f, 9.99915957e-01f, 1.29649751e-02f, 9.99973416e-01f, 7.29088066e-03f,
  -3.99985313e-01f, -9.16521549e-01f, 5.63609414e-02f, -9.98410463e-01f, 7.54965365e-01f, 6.55764699e-01f, 3.75752151e-01f, 9.26720202e-01f,
  -4.90260571e-01f, -8.71575892e-01f, -7.11082935e-01f, 7.03108132e-01f, 2.40265876e-01f, 9.70707119e-01f, 7.33813822e-01f, 6.79350674e-01f,
  9.13088918e-01f, 4.07760441e-01f, 9.72238123e-01f, 2.33993664e-01f, 9.91192937e-01f, 1.32425532e-01f, 9.97212172e-01f, 7.46183172e-02f,
  9.99118149e-01f, 4.19876575e-02f, 9.99721110e-01f, 2.36161388e-02f, 9.99911785e-01f, 1.32811759e-02f, 9.99972105e-01f, 7.46870413e-03f,
  5.55113316e-01f, -8.31774771e-01f, 5.80003142e-01f, -8.14614236e-01f, 5.13598442e-01f, 8.58030677e-01f, 2.05897167e-01f, 9.78573620e-01f,
  -4.00799006e-01f, -9.16166008e-01f, -7.49476731e-01f, 6.62030637e-01f, 2.09454417e-01f, 9.77818429e-01f, 7.21617639e-01f, 6.92291796e-01f,
  9.08965766e-01f, 4.16870773e-01f, 9.70906913e-01f, 2.39457220e-01f, 9.90769207e-01f, 1.35559291e-01f, 9.97077882e-01f, 7.63915181e-02f,
  9.99075651e-01f, 4.29867506e-02f, 9.99707639e-01f, 2.41783205e-02f, 9.99907553e-01f, 1.35973748e-02f, 9.99970794e-01f, 7.64652714e-03f,
  9.99843299e-01f, 1.77019257e-02f, 9.25014675e-01f, -3.79931390e-01f, 2.21298173e-01f, 9.75206196e-01f, 2.95478199e-02f, 9.99563396e-01f,
  -3.07332784e-01f, -9.51602101e-01f, -7.85501122e-01f, 6.18860185e-01f, 1.78433523e-01f, 9.83951986e-01f, 7.09193349e-01f, 7.05014050e-01f,
  9.04751658e-01f, 4.25939471e-01f, 9.69545007e-01f, 2.44913206e-01f, 9.90335584e-01f, 1.38691694e-01f, 9.96940494e-01f, 7.81644881e-02f,
  9.99032140e-01f, 4.39858064e-02f, 9.99693930e-01f, 2.47404929e-02f, 9.99903202e-01f, 1.39135728e-02f, 9.99969363e-01f, 7.82434922e-03f,
  5.25321960e-01f, 8.50903511e-01f, 9.85138178e-01f, 1.71763569e-01f, -9.29481089e-02f, 9.95670974e-01f, -1.47732988e-01f, 9.89027262e-01f,
  -2.10795805e-01f, -9.77530122e-01f, -8.19042206e-01f, 5.73733270e-01f, 1.47234216e-01f, 9.89101648e-01f, 6.96544766e-01f, 7.17513323e-01f,
  9.00447130e-01f, 4.34965521e-01f, 9.68152404e-01f, 2.50361472e-01f, 9.89892066e-01f, 1.41822711e-01f, 9.96799886e-01f, 7.99371973e-02f,
  9.98987675e-01f, 4.49848175e-02f, 9.99679863e-01f, 2.53026579e-02f, 9.99898732e-01f, 1.42297689e-02f, 9.99967992e-01f, 8.00217129e-03f,
  -4.32177931e-01f, 9.01788354e-01f, 7.41858006e-01f, 6.70557022e-01f, -3.97976756e-01f, 9.17395473e-01f, -3.20354372e-01f, 9.47297752e-01f,
  -1.12152621e-01f, -9.93690968e-01f, -8.49993885e-01f, 5.26792526e-01f, 1.15887694e-01f, 9.93262351e-01f, 6.83675885e-01f, 7.29785740e-01f,
  8.96052480e-01f, 4.43948090e-01f, 9.66729224e-01f, 2.55801797e-01f, 9.89438653e-01f, 1.44952312e-01f, 9.96656179e-01f, 8.17096606e-02f,
  9.98942196e-01f, 4.59837839e-02f, 9.99665439e-01f, 2.58648153e-02f, 9.99894202e-01f, 1.45459641e-02f, 9.99966562e-01f, 8.17999430e-03f,
  -9.92335498e-01f, 1.23573124e-01f, 2.70098448e-01f, 9.62832689e-01f, -6.63538277e-01f, 7.48142362e-01f, -4.82871950e-01f, 8.75690997e-01f,
  -1.23883775e-02f, -9.99923289e-01f, -8.78258407e-01f, 4.78186339e-01f, 8.44252855e-02f, 9.96429801e-01f, 6.70590878e-01f, 7.41827428e-01f,
  8.91568303e-01f, 4.52886283e-01f, 9.65275466e-01f, 2.61234075e-01f, 9.88975346e-01f, 1.48080453e-01f, 9.96509314e-01f, 8.34818557e-02f,
  9.98895705e-01f, 4.69827019e-02f, 9.99650776e-01f, 2.64269635e-02f, 9.99889553e-01f, 1.48621574e-02f, 9.99965072e-01f, 8.35781638e-03f,
  -6.40144348e-01f, -7.68254638e-01f, -2.84846604e-01f, 9.58573103e-01f, -8.63296509e-01f, 5.04697084e-01f, -6.30159974e-01f, 7.76465356e-01f,
  8.74991715e-02f, -9.96164620e-01f, -9.03746367e-01f, 4.28068399e-01f, 5.28784581e-02f, 9.98600960e-01f, 6.57293737e-01f, 7.53634512e-01f,
  8.86994898e-01f, 4.61779177e-01f, 9.63791192e-01f, 2.66658038e-01f, 9.88502085e-01f, 1.51207119e-01f, 9.96359289e-01f, 8.52537975e-02f,
  9.98848200e-01f, 4.79815714e-02f, 9.99635756e-01f, 2.69891042e-02f, 9.99884784e-01f, 1.51783489e-02f, 9.99963582e-01f, 8.53563752e-03f,
  3.00592542e-01f, -9.53752637e-01f, -7.52063990e-01f, 6.59090102e-01f, -9.77442741e-01f, 2.11200655e-01f, -7.57573068e-01f, 6.52750373e-01f,
  1.86512470e-01f, -9.82452571e-01f, -9.26377118e-01f, 3.76597136e-01f, 2.12787576e-02f, 9.99773562e-01f, 6.43788815e-01f, 7.65203178e-01f,
  8.82332861e-01f, 4.70625877e-01f, 9.62276459e-01f, 2.72073567e-01f, 9.88018990e-01f, 1.54332280e-01f, 9.96206105e-01f, 8.70254710e-02f,
  9.98799741e-01f, 4.89803962e-02f, 9.99620378e-01f, 2.75512375e-02f, 9.99879956e-01f, 1.54945394e-02f, 9.99962032e-01f, 8.71345960e-03f,
  9.64965999e-01f, -2.62374848e-01f, -9.87659097e-01f, 1.56619072e-01f, -9.94656444e-01f, -1.03240460e-01f, -8.61092687e-01f, 5.08447945e-01f,
  2.83662200e-01f, -9.58924294e-01f, -9.46079254e-01f, 3.23935270e-01f, -1.03422189e-02f, 9.99946535e-01f, 6.30080283e-01f, 7.76529968e-01f,
  8.77582550e-01f, 4.79425550e-01f, 9.60731268e-01f, 2.77480543e-01f, 9.87526000e-01f, 1.57455891e-01f, 9.96049762e-01f, 8.87968615e-02f,
  9.98750269e-01f, 4.99791689e-02f, 9.99604762e-01f, 2.81133596e-02f, 9.99875009e-01f, 1.58107281e-02f, 9.99960482e-01f, 8.89127981e-03f,
  7.42154181e-01f, 6.70229197e-01f, -9.19073522e-01f, -3.94086063e-01f, -9.13230121e-01f, -4.07444149e-01f, -9.37454224e-01f, 3.48108500e-01f,
  3.77977669e-01f, -9.25814748e-01f, -9.62790370e-01f, 2.70249337e-01f, -4.19528559e-02f, 9.99119580e-01f, 6.16172493e-01f, 7.87611187e-01f,
  8.72744501e-01f, 4.88177240e-01f, 9.59155679e-01f, 2.82878697e-01f, 9.87023175e-01f, 1.60577938e-01f, 9.95890260e-01f, 9.05679762e-02f,
  9.98699784e-01f, 5.09778969e-02f, 9.99588788e-01f, 2.86754742e-02f, 9.99869943e-01f, 1.61269177e-02f, 9.99958873e-01f, 9.06910095e-03f,
  -1.62990779e-01f, 9.86627579e-01f, -5.67430019e-01f, -8.23421597e-01f, -7.41239965e-01f, -6.71240151e-01f, -9.84248459e-01f, 1.76790684e-01f,
  4.68516916e-01f, -8.83454502e-01f, -9.76457715e-01f, 2.15709001e-01f, -7.35215396e-02f, 9.97293651e-01f, 6.02069914e-01f, 7.98443377e-01f,
  8.67819190e-01f, 4.96880114e-01f, 9.57549810e-01f, 2.88267940e-01f, 9.86510456e-01f, 1.63698375e-01f, 9.95727658e-01f, 9.23388004e-02f,
  9.98648286e-01f, 5.19765690e-02f, 9.99572515e-01f, 2.92375814e-02f, 9.99864817e-01f, 1.64431017e-02f, 9.99957263e-01f, 9.24692024e-03f,
  -9.18282807e-01f, 3.95925164e-01f, -4.10281904e-02f, -9.99157965e-01f, -4.95741814e-01f, -8.68469954e-01f, -1.00000000e+00f, -1.03020677e-04f,
  5.54374516e-01f, -8.32267344e-01f, -9.87038016e-01f, 1.60486728e-01f, -1.05016708e-01f, 9.94470477e-01f, 5.87776959e-01f, 8.09023023e-01f,
  8.62807095e-01f, 5.05533338e-01f, 9.55913603e-01f, 2.93648034e-01f, 9.85987842e-01f, 1.66817173e-01f, 9.95561838e-01f, 9.41093415e-02f,
  9.98595834e-01f, 5.29751927e-02f, 9.99555886e-01f, 2.97996756e-02f, 9.99859571e-01f, 1.67592876e-02f, 9.99955595e-01f, 9.42474138e-03f,
  -8.29309821e-01f, -5.58789074e-01f, 4.98009592e-01f, -8.67171526e-01f, -2.01079622e-01f, -9.79574919e-01f, -9.84212041e-01f, -1.76993474e-01f,
  6.34692967e-01f, -7.72764444e-01f, -9.94497895e-01f, 1.04756832e-01f, -1.36406869e-01f, 9.90652919e-01f, 5.73298037e-01f, 8.19346905e-01f,
  8.57708693e-01f, 5.14135957e-01f, 9.54247177e-01f, 2.99018890e-01f, 9.85455394e-01f, 1.69934288e-01f, 9.95392919e-01f, 9.58795771e-02f,
  9.98542368e-01f, 5.39737605e-02f, 9.99538958e-01f, 3.03617641e-02f, 9.99854207e-01f, 1.70754679e-02f, 9.99953866e-01f, 9.60256159e-03f,
  2.21267566e-02f, -9.99755144e-01f, 8.83669317e-01f, -4.68111664e-01f, 1.13521777e-01f, -9.93535519e-01f, -9.37382519e-01f, -3.48301649e-01f,
  7.08669782e-01f, -7.05540299e-01f, -9.98813629e-01f, 4.86960001e-02f, -1.67660639e-01f, 9.85844791e-01f, 5.58637917e-01f, 8.29411685e-01f,
  8.52524519e-01f, 5.22687256e-01f, 9.52550590e-01f, 3.04380238e-01f, 9.84913111e-01f, 1.73049718e-01f, 9.95220840e-01f, 9.76495072e-02f,
  9.98487890e-01f, 5.49722798e-02f, 9.99521732e-01f, 3.09238415e-02f, 9.99848783e-01f, 1.73916500e-02f, 9.99952197e-01f, 9.78038087e-03f,
  8.53220105e-01f, -5.21551013e-01f, 9.97174621e-01f, 7.51182064e-02f, 4.16867077e-01f, -9.08967435e-01f, -8.60988438e-01f, -5.08624554e-01f,
  7.75565803e-01f, -6.31266713e-01f, -9.99971747e-01f, -7.51878507e-03f, -1.98746875e-01f, 9.80050862e-01f, 5.43801069e-01f, 8.39214146e-01f,
  8.47255111e-01f, 5.31186223e-01f, 9.50823903e-01f, 3.09731960e-01f, 9.84360933e-01f, 1.76163420e-01f, 9.95045662e-01f, 9.94191393e-02f,
  9.98432398e-01f, 5.59707358e-02f, 9.99504209e-01f, 3.14859077e-02f, 9.99843180e-01f, 1.77078284e-02f, 9.99950409e-01f, 9.95820016e-03f,
  8.99866819e-01f, 4.36164767e-01f, 8.03569078e-01f, 5.95211506e-01f, 6.78870201e-01f, -7.34258294e-01f, -7.57439196e-01f, -6.52905703e-01f,
  8.34712923e-01f, -5.50685287e-01f, -9.97968495e-01f, -6.37097955e-02f, -2.29634270e-01f, 9.73276973e-01f, 5.28792322e-01f, 8.48751247e-01f,
  8.41901004e-01f, 5.39632022e-01f, 9.49067116e-01f, 3.15073937e-01f, 9.83798921e-01f, 1.79275364e-01f, 9.94867265e-01f, 1.01188451e-01f,
  9.98375952e-01f, 5.69691435e-02f, 9.99486327e-01f, 3.20479684e-02f, 9.99837577e-01f, 1.80240069e-02f, 9.99948621e-01f, 1.01360194e-02f,
  1.19180135e-01f, 9.92872655e-01f, 3.62476677e-01f, 9.31992829e-01f, 8.73550534e-01f, -4.86733496e-01f, -6.30000710e-01f, -7.76594579e-01f,
  8.85519624e-01f, -4.64602023e-01f, -9.92810190e-01f, -1.19699396e-01f, -2.60292053e-01f, 9.65529919e-01f, 5.13616323e-01f, 8.58020008e-01f,
  8.36462677e-01f, 5.48023939e-01f, 9.47280347e-01f, 3.20405900e-01f, 9.83227074e-01f, 1.82385504e-01f, 9.94685769e-01f, 1.02957435e-01f,
  9.98318493e-01f, 5.79674877e-02f, 9.99468148e-01f, 3.26100141e-02f, 9.99831796e-01f, 1.83401816e-02f, 9.99946833e-01f, 1.03138378e-02f,
  -7.71080196e-01f, 6.36738002e-01f, -1.90249100e-01f, 9.81735826e-01f, 9.81602073e-01f, -1.90938011e-01f, -4.82692331e-01f, -8.75790000e-01f,
  9.27478492e-01f, -3.73876572e-01f, -9.84513164e-01f, -1.75310582e-01f, -2.90689558e-01f, 9.56817448e-01f, 4.98277903e-01f, 8.67017388e-01f,
  8.30940723e-01f, 5.56361020e-01f, 9.45463598e-01f, 3.25727791e-01f, 9.82645452e-01f, 1.85493827e-01f, 9.94501114e-01f, 1.04726106e-01f,
  9.98260021e-01f, 5.89657798e-02f, 9.99449670e-01f, 3.31720486e-02f, 9.99825954e-01f, 1.86563563e-02f, 9.99944985e-01f, 1.04916561e-02f,
  -9.52412963e-01f, -3.04810613e-01f, -6.84381902e-01f, 7.29123712e-01f, 9.92308319e-01f, 1.23790950e-01f, -3.20159167e-01f, -9.47363734e-01f,
  9.60170269e-01f, -2.79415488e-01f, -9.73103702e-01f, -2.30367512e-01f, -3.20796400e-01f, 9.47148204e-01f, 4.82782036e-01f, 8.75740528e-01f,
  8.25335622e-01f, 5.64642429e-01f, 9.43616986e-01f, 3.31039310e-01f, 9.82053936e-01f, 1.88600287e-01f, 9.94313300e-01f, 1.06494442e-01f,
  9.98200536e-01f, 5.99640086e-02f, 9.99430835e-01f, 3.37340795e-02f, 9.99819994e-01f, 1.89725272e-02f, 9.99943078e-01f, 1.06694745e-02f,
  -2.58101642e-01f, -9.66117799e-01f, -9.67739642e-01f, 2.51952261e-01f, 9.04607594e-01f, 4.26245421e-01f, -1.47529200e-01f, -9.89057720e-01f,
  9.83268440e-01f, -1.82162598e-01f, -9.58617806e-01f, -2.84696162e-01f, -3.50582451e-01f, 9.36531842e-01f, 4.67133403e-01f, 8.84186864e-01f,
  8.19648027e-01f, 5.72867453e-01f, 9.41740453e-01f, 3.36340427e-01f, 9.81452644e-01f, 1.91704854e-01f, 9.94122326e-01f, 1.08262435e-01f,
  9.98140097e-01f, 6.09621815e-02f, 9.99411702e-01f, 3.42960916e-02f, 9.99813974e-01f, 1.92886982e-02f, 9.99941170e-01f, 1.08472919e-02f,
  6.73507154e-01f, -7.39180684e-01f, -9.53050017e-01f, -3.02812874e-01f, 7.27198064e-01f, 6.86427653e-01f, 2.97537707e-02f, -9.99557257e-01f,
  9.96542096e-01f, -8.30891207e-02f, -9.41101313e-01f, -3.38124752e-01f, -3.80017966e-01f, 9.24979091e-01f, 4.51337039e-01f, 8.92353535e-01f,
  8.13878477e-01f, 5.81035137e-01f, 9.39834237e-01f, 3.41630876e-01f, 9.80841517e-01f, 1.94807529e-01f, 9.93928254e-01f, 1.10030092e-01f,
  9.98078644e-01f, 6.19602874e-02f, 9.99392271e-01f, 3.48580964e-02f, 9.99807835e-01f, 1.96048655e-02f, 9.99939203e-01f, 1.10251084e-02f,
  9.85896587e-01f, 1.67355701e-01f, -6.44837022e-01f, -7.64320076e-01f, 4.77671444e-01f, 8.78538549e-01f, 2.06098333e-01f, -9.78531301e-01f,
  9.99858618e-01f, 1.68140903e-02f, -9.20609534e-01f, -3.90484393e-01f, -4.09073502e-01f, 9.12501454e-01f, 4.35397953e-01f, 9.00238097e-01f,
  8.08027506e-01f, 5.89144766e-01f, 9.37898219e-01f, 3.46910536e-01f, 9.80220556e-01f, 1.97908238e-01f, 9.93731022e-01f, 1.11797392e-01f,
  9.98016179e-01f, 6.29583374e-02f, 9.99372482e-01f, 3.54200937e-02f, 9.99801576e-01f, 1.99210308e-02f, 9.99937236e-01f, 1.12029258e-02f,
};

constexpr int T_ALL = 36864, T_CTX = 4096;
constexpr int NLAYER = 4;
constexpr float EPS = 1e-6f;
constexpr int LK_LAT = 4352;

struct Params {
  const float* x_prompt; const float* x_sample; const float* cache_ckv; const float* cache_krope;
  const float* cache_k; const float* cache_v; const float* state; const float* c; const float* c_ctx;
  const float* w_mod; const float* b_mod; const float* g_norm; const float* w_in; const float* conv_w; const float* conv_b;
  const float* lru_wa; const float* lru_ba; const float* lru_wi; const float* lru_bi; const float* lru_lam;
  const float* q_norm; const float* w_uq; const float* kv_norm; const float* w_ukv; const float* sink;
  const float* w_br_rnn; const float* w_br_mla; const float* w_br_swa; const float* w_out; const float* final_norm;
  float* out; char* ws;
};

constexpr size_t AL(size_t x) { return (x + 255) & ~(size_t)255; }
constexpr size_t O_WINA = 0;
constexpr size_t O_WINB = O_WINA + AL((size_t)2560 * 1024 * 2);
constexpr size_t O_WLRU = O_WINB + AL((size_t)5120 * 1024 * 2);
constexpr size_t O_WUQ = O_WLRU + AL((size_t)4096 * 128 * 2);
constexpr size_t O_WUKVG = O_WUQ + AL((size_t)768 * 384 * 2);
constexpr size_t O_WUKVR = O_WUKVG + AL((size_t)1024 * 256 * 2);
constexpr size_t O_WBRR = O_WUKVR + AL((size_t)1024 * 256 * 2);
constexpr size_t O_WBRM = O_WBRR + AL((size_t)1024 * 1024 * 2);
constexpr size_t O_WBRS = O_WBRM + AL((size_t)1024 * 512 * 2);
constexpr size_t O_WOUT = O_WBRS + AL((size_t)1024 * 512 * 2);
constexpr size_t O_MOD = O_WOUT + AL((size_t)1024 * 1024 * 2);
constexpr size_t O_H = O_MOD + AL((size_t)4 * 9 * 3072 * 4);
constexpr size_t O_XR = O_H + AL((size_t)T_ALL * 1024 * 2);
constexpr size_t O_CQ = O_XR + AL((size_t)T_ALL * 1024 * 2);
constexpr size_t O_CKV = O_CQ + AL((size_t)T_ALL * 384 * 2);
constexpr size_t O_CKVC = O_CKV + AL((size_t)T_ALL * 256 * 2);
constexpr size_t O_KRL = O_CKVC + AL((size_t)2048 * 256 * 2);
constexpr size_t O_KRC = O_KRL + AL((size_t)8 * LK_LAT * 32 * 2);
constexpr size_t O_QS = O_KRC + AL((size_t)16 * 256 * 32 * 2);
constexpr size_t O_KS = O_QS + AL((size_t)T_ALL * 512 * 2);
constexpr size_t O_KSC = O_KS + AL((size_t)T_ALL * 128 * 2);
constexpr size_t O_VTSL = O_KSC + AL((size_t)8 * 256 * 128 * 2);
constexpr size_t O_VTSC = O_VTSL + AL((size_t)8 * 2 * 64 * 4096 * 2);
constexpr size_t O_VTSCC = O_VTSC + AL((size_t)16 * 2 * 64 * 256 * 2);
constexpr size_t O_Q = O_VTSCC + AL((size_t)8 * 2 * 64 * 256 * 2);
constexpr size_t O_KNL = O_Q + AL((size_t)T_ALL * 768 * 2);
constexpr size_t O_KNC = O_KNL + AL((size_t)8 * 8 * LK_LAT * 64 * 2);
constexpr size_t O_VTL = O_KNC + AL((size_t)16 * 8 * 256 * 64 * 2);
constexpr size_t O_VTC = O_VTL + AL((size_t)8 * 8 * 64 * LK_LAT * 2);
constexpr size_t O_YRNN = O_VTC + AL((size_t)16 * 8 * 64 * 256 * 2);
static_assert(O_YRNN - O_KS >= (size_t)2 * T_ALL * 1024 * 2, "merge-gate buffers do not fit");
constexpr size_t O_SUM = O_YRNN + AL((size_t)T_ALL * 1024 * 2);
constexpr size_t O_BAR = O_SUM + AL((size_t)8 * 8 * 2 * 16 * 256 * 4);
constexpr size_t BAR_BYTES = 16384;
constexpr size_t O_W2 = O_BAR + BAR_BYTES;
constexpr size_t WS_NEED = O_W2 + O_MOD;

constexpr size_t OUT_CKV = (size_t)T_ALL * 1024;
constexpr size_t OUT_KROPE = OUT_CKV + (size_t)16 * 4 * 256 * 256;
constexpr size_t OUT_SK = OUT_KROPE + (size_t)16 * 4 * 256 * 32;
constexpr size_t OUT_SV = OUT_SK + (size_t)16 * 4 * 256 * 128;
constexpr size_t OUT_RG = OUT_SV + (size_t)16 * 4 * 256 * 128;

#define SB() __builtin_amdgcn_sched_barrier(0)
#define MB() asm volatile("" ::: "memory")
DI int tid() { int t = threadIdx.x; asm volatile("" : "+v"(t)); return t; }
DI int xcd_map(int base) {
  const int g = gridDim.x;
  if (g & 7) return base + blockIdx.x;
  return base + (blockIdx.x & 7) * (g >> 3) + (blockIdx.x >> 3);
}
#define LANEVARS const int t = tid(), lane = t & 63, w = t >> 6, wr = w >> 1, wc = w & 1; const int c16 = lane & 15, g4 = lane >> 4; (void)wr; (void)wc; (void)c16; (void)g4;
DI float bf2f(u16 v) { return __uint_as_float(((unsigned)v) << 16); }
DI unsigned pack2(float a, float b) {
  f2_t v = {a, b};
  bf2_t r = __builtin_convertvector(v, bf2_t);
  return __builtin_bit_cast(unsigned, r);
}
DI u16 f2bf(float a) { return (u16)(pack2(a, 0.f) & 0xffffu); }
DI float sigmoidf_(float x) { return __builtin_amdgcn_rcpf(1.f + __expf(-x)); }
DI float wave_sum(float v) {
#pragma unroll
  for (int o = 32; o > 0; o >>= 1) v += __shfl_xor(v, o);
  return v;
}
DI int perm32(int p) { return (p & 7) | ((p & 8) << 1) | ((p & 16) >> 1); }
DI const float* xin_row(const Params& p, int l, int row) {
  if (l == 0) return row < T_CTX ? p.x_prompt + (size_t)row * 1024 : p.x_sample + (size_t)(row - T_CTX) * 1024;
  return p.out + (size_t)row * 1024;
}
template <class T> DI T* wsp(const Params& p, size_t off) { return (T*)(p.ws + off); }
DI u16* wsw(const Params& p, int l, size_t off) { return (u16*)(p.ws + ((l & 1) ? O_W2 : 0) + off); }

template <int NJ, bool SWAP = false>
DI void gemm_tile_t(const u16* A, int lda, const u16* B, int ldb, int K,
                    f32x4 (&acc)[4][NJ], char* smem) {
  const int t = tid(), lane = t & 63, w = t >> 6, wr = w >> 1, wc = w & 1;
  const int lr = t >> 3, slot = t & 7;
  const int c16 = lane & 15, g4 = lane >> 4;
  const int gch = slot ^ ((lr >> 1) & 7);
  const u16* ap = A + (size_t)lr * lda + gch * 8;
  const u16* bp = B + (size_t)lr * ldb + gch * 8;
  char* sdst = smem + t * 16;
#define DMA16(gp, lp) __builtin_amdgcn_global_load_lds((const unsigned*)(gp), (unsigned*)(lp), 16, 0, 0)
#define STAGE(base, ko) { DMA16(ap + (ko), (base)); DMA16(ap + (size_t)32 * lda + (ko), (base) + 4096); \
    DMA16(ap + (size_t)64 * lda + (ko), (base) + 8192); DMA16(ap + (size_t)96 * lda + (ko), (base) + 12288); \
    DMA16(bp + (ko), (base) + 16384); DMA16(bp + (size_t)32 * ldb + (ko), (base) + 16384 + 4096); \
    if (NJ > 2) { DMA16(bp + (size_t)64 * ldb + (ko), (base) + 16384 + 8192); DMA16(bp + (size_t)96 * ldb + (ko), (base) + 16384 + 12288); } }
  const int nk = K >> 6;
  const int arow = (wr * 64 + c16) * 128, brow = (wc * (16 * NJ) + c16) * 128;
  const int sw = (c16 >> 1) & 7;
  int kk = 0;
  STAGE(sdst, kk * 64)
  __syncthreads();
  for (int kt = 0; kt < nk; ++kt) {
    char* cur = smem + (kt & 1) * 32768;
    kk = (kk + 1 == nk) ? 0 : kk + 1;
    if (kt + 1 < nk) { char* nxt = sdst + ((kt + 1) & 1) * 32768; STAGE(nxt, kk * 64) }
#pragma unroll
    for (int ks = 0; ks < 2; ++ks) {
      bf16x8 af[4], bfr[NJ];
      const int ch = ((ks * 4 + g4) ^ sw) << 4;
#pragma unroll
      for (int i = 0; i < 4; ++i) af[i] = *(const bf16x8*)(cur + arow + i * 2048 + ch);
#pragma unroll
      for (int i = 0; i < NJ; ++i) bfr[i] = *(const bf16x8*)(cur + 16384 + brow + i * 2048 + ch);
#pragma unroll
      for (int i = 0; i < 4; ++i)
#pragma unroll
        for (int j = 0; j < NJ; ++j)
          acc[i][j] = SWAP ? __builtin_amdgcn_mfma_f32_16x16x32_bf16(bfr[j], af[i], acc[i][j], 0, 0, 0)
                           : __builtin_amdgcn_mfma_f32_16x16x32_bf16(af[i], bfr[j], acc[i][j], 0, 0, 0);
    }
    SB();
    __syncthreads();
  }
#undef STAGE
#undef DMA16
}
DI void gemm_tile(const u16* A, int lda, const u16* B, int ldb, int K,
                  f32x4 (&acc)[4][4], char* smem) {
  gemm_tile_t<4>(A, lda, B, ldb, K, acc, smem);
}
DI void gemm_tile_T(const u16* A, int lda, const u16* B, int ldb, int K,
                    f32x4 (&acc)[4][4], char* smem) {
  gemm_tile_t<4, true>(A, lda, B, ldb, K, acc, smem);
}
DI void zero_acc(f32x4 (&acc)[4][4]) {
#pragma unroll
  for (int i = 0; i < 4; ++i)
#pragma unroll
    for (int j = 0; j < 4; ++j) acc[i][j] = f32x4{0.f, 0.f, 0.f, 0.f};
}

struct TokTile { int g0; int is_ctx; int b; int p0; };
DI TokTile tok_tile(int mt) {
  TokTile r; r.g0 = mt * 128;
  if (r.g0 < T_CTX) { r.is_ctx = 1; r.b = r.g0 >> 8; r.p0 = r.g0 & 255; }
  else { r.is_ctx = 0; r.b = (r.g0 - T_CTX) >> 12; r.p0 = (r.g0 - T_CTX) & 4095; }
  return r;
}

DI void phase_mod(const Params& p, char* smem) {
  float* s_silu = (float*)smem;
  float* s_part = (float*)(smem + 36864);
  float* MOD = wsp<float>(p, O_MOD);
  const int t = tid();
  for (int i = t; i < 9 * 1024; i += 256) {
    float v = (i < 8192) ? p.c[i] : p.c_ctx[i - 8192];
    s_silu[i] = v * sigmoidf_(v);
  }
  __syncthreads();
  const int kg = t >> 6, cl = t & 63;
  for (int u = blockIdx.x; u < 4 * 48; u += gridDim.x) {
    const int l = u / 48, cb = u % 48;
    const int n = cb * 64 + cl;
    float acc[9];
#pragma unroll
    for (int ci = 0; ci < 9; ++ci) acc[ci] = 0.f;
    const float* wp = p.w_mod + ((size_t)l * 1024 + kg * 256) * 3072 + n;
    for (int k = 0; k < 256; ++k) {
      float wv = wp[(size_t)k * 3072];
#pragma unroll
      for (int ci = 0; ci < 9; ++ci) acc[ci] += s_silu[ci * 1024 + kg * 256 + k] * wv;
    }
#pragma unroll
    for (int ci = 0; ci < 9; ++ci) s_part[(kg * 9 + ci) * 64 + cl] = acc[ci];
    __syncthreads();
    for (int idx = t; idx < 9 * 64; idx += 256) {
      int ci = idx >> 6, c2 = idx & 63;
      float s = s_part[(0 * 9 + ci) * 64 + c2] + s_part[(1 * 9 + ci) * 64 + c2] + s_part[(2 * 9 + ci) * 64 + c2] +
                s_part[(3 * 9 + ci) * 64 + c2];
      MOD[((size_t)l * 9 + ci) * 3072 + cb * 64 + c2] = s + p.b_mod[l * 3072 + cb * 64 + c2];
    }
    __syncthreads();
  }
}

template <class F> DI void conv_job(u16* dst, int N, int K, F src) {
  const int total = N * (K >> 3);
  for (int idx = blockIdx.x * 256 + tid(); idx < total; idx += gridDim.x * 256) {
    const int n = idx % N, kb = idx / N;
    float v[8];
#pragma unroll
    for (int j = 0; j < 8; ++j) v[j] = src(kb * 8 + j, n);
    uint4 o;
    o.x = pack2(v[0], v[1]); o.y = pack2(v[2], v[3]); o.z = pack2(v[4], v[5]); o.w = pack2(v[6], v[7]);
    *(uint4*)(dst + (size_t)n * K + kb * 8) = o;
  }
}

DI void convert_weights(const Params& p, int l) {
  {
    const float* win = p.w_in + (size_t)l * 1024 * 7584;
    conv_job(wsw(p, l, O_WINA), 2560, 1024, [&](int k, int n) -> float {
      int col;
      if (n < 1024) col = n;
      else if (n < 1408) col = 2048 + (n - 1024);
      else if (n < 1664) col = 2432 + (n - 1408);
      else if (n < 1792) { int pp = n - 1664; col = pp < 32 ? 2688 + perm32(pp) : -1; }
      else if (n < 2304) col = 3232 + (n - 1792);
      else if (n < 2432) col = 3744 + (n - 2304);
      else col = 3872 + (n - 2432);
      return col < 0 ? 0.f : win[(size_t)k * 7584 + col];
    });
    conv_job(wsw(p, l, O_WINB), 5120, 1024, [&](int k, int n) -> float {
      int col;
      if (n < 1024) col = 1024 + n;
      else if (n < 1536) col = 2720 + (n - 1024);
      else if (n < 2048) col = 4000 + (n - 1536);
      else col = 4512 + (n - 2048);
      return win[(size_t)k * 7584 + col];
    });
    const float* wa = p.lru_wa + (size_t)l * 2 * 8 * 128 * 128;
    const float* wi = p.lru_wi + (size_t)l * 2 * 8 * 128 * 128;
    conv_job(wsw(p, l, O_WLRU), 4096, 128, [&](int k, int n) -> float {
      int db = n >> 8, nn = n & 255;
      return nn < 128 ? wa[((size_t)db * 128 + k) * 128 + nn] : wi[((size_t)db * 128 + k) * 128 + (nn - 128)];
    });
    const float* wuq = p.w_uq + (size_t)l * 384 * 768;
    const float* gq = p.q_norm + l * 384;
    conv_job(wsw(p, l, O_WUQ), 768, 384, [&](int k, int n) -> float {
      int col;
      if (n < 512) col = (n >> 6) * 96 + (n & 63);
      else { int hh = (n - 512) >> 5, pp = (n - 512) & 31; col = hh * 96 + 64 + perm32(pp); }
      return gq[k] * wuq[(size_t)k * 768 + col];
    });
    const float* wukv = p.w_ukv + (size_t)l * 256 * 1024;
    const float* gkv = p.kv_norm + l * 256;
    conv_job(wsw(p, l, O_WUKVG), 1024, 256, [&](int k, int n) -> float { return gkv[k] * wukv[(size_t)k * 1024 + n]; });
    conv_job(wsw(p, l, O_WUKVR), 1024, 256, [&](int k, int n) -> float { return wukv[(size_t)k * 1024 + n]; });
    const float* w1 = p.w_br_rnn + (size_t)l * 1024 * 1024;
    conv_job(wsw(p, l, O_WBRR), 1024, 1024, [&](int k, int n) -> float { return w1[(size_t)k * 1024 + n]; });
    const float* w2 = p.w_br_mla + (size_t)l * 512 * 1024;
    conv_job(wsw(p, l, O_WBRM), 1024, 512, [&](int k, int n) -> float { return w2[(size_t)k * 1024 + n]; });
    const float* w3 = p.w_br_swa + (size_t)l * 512 * 1024;
    conv_job(wsw(p, l, O_WBRS), 1024, 512, [&](int k, int n) -> float { return w3[(size_t)k * 1024 + n]; });
    const float* w4 = p.w_out + (size_t)l * 1024 * 1024;
    conv_job(wsw(p, l, O_WOUT), 1024, 1024, [&](int k, int n) -> float { return w4[(size_t)k * 1024 + n]; });
  }
}

DI void phase_prep(const Params& p, int l) {
  const int t = tid(), lane = t & 63, w = t >> 6;
  const float* MOD = wsp<float>(p, O_MOD) + (size_t)l * 9 * 3072;
  u16* H = wsp<u16>(p, O_H);
  for (int row = blockIdx.x * 4 + w; row < T_ALL; row += gridDim.x * 4) {
    const float* x = xin_row(p, l, row);
    const int ci = row < T_CTX ? 8 : ((row - T_CTX) >> 12);
    const float* md = MOD + ci * 3072;
    float4 v[4];
    float ss = 0.f;
#pragma unroll
    for (int i = 0; i < 4; ++i) {
      v[i] = *(const float4*)(x + i * 256 + lane * 4);
      ss += v[i].x * v[i].x + v[i].y * v[i].y + v[i].z * v[i].z + v[i].w * v[i].w;
    }
    ss = wave_sum(ss);
    const float rs = rsqrtf(ss * (1.f / 1024.f) + EPS);
#pragma unroll
    for (int i = 0; i < 4; ++i) {
      const int c = i * 256 + lane * 4;
      const float4 g = *(const float4*)(p.g_norm + l * 1024 + c);
      const float4 sh = *(const float4*)(md + c);
      const float4 sc = *(const float4*)(md + 1024 + c);
      float h0 = v[i].x * rs * g.x * (1.f + sc.x) + sh.x;
      float h1 = v[i].y * rs * g.y * (1.f + sc.y) + sh.y;
      float h2 = v[i].z * rs * g.z * (1.f + sc.z) + sh.z;
      float h3 = v[i].w * rs * g.w * (1.f + sc.w) + sh.w;
      uint2 o; o.x = pack2(h0, h1); o.y = pack2(h2, h3);
      *(uint2*)(H + (size_t)row * 1024 + c) = o;
    }
  }
  {
    const int gt = blockIdx.x * 256 + t, gs = gridDim.x * 256;
    u16* ckvc = wsp<u16>(p, O_CKVC);
    for (int i = gt; i < 2048 * 256; i += gs) {
      int r = i >> 8, k = i & 255, b = r >> 8, pos = r & 255;
      ckvc[i] = f2bf(p.cache_ckv[(((size_t)b * 4 + l) * 256 + pos) * 256 + k]);
    }
    u16* krl = wsp<u16>(p, O_KRL);
    for (int i = gt; i < 8 * 256 * 32; i += gs) {
      int pp = i & 31, pos = (i >> 5) & 255, b = i >> 13;
      krl[((size_t)b * LK_LAT + pos) * 32 + pp] = f2bf(p.cache_krope[(((size_t)b * 4 + l) * 256 + pos) * 32 + perm32(pp)]);
    }
    u16* ksc = wsp<u16>(p, O_KSC);
    for (int i = gt; i < 8 * 256 * 128; i += gs) {
      int c = i & 127, pos = (i >> 7) & 255, b = i >> 15;
      ksc[i] = f2bf(p.cache_k[(((size_t)b * 4 + l) * 256 + pos) * 128 + c]);
    }
    u16* vtc = wsp<u16>(p, O_VTSCC);
    for (int i = gt; i < 8 * 2 * 64 * 256; i += gs) {
      int pos = i & 255, dv = (i >> 8) & 63, kvh = (i >> 14) & 1, b = i >> 15;
      vtc[i] = f2bf(p.cache_v[(((size_t)b * 4 + l) * 256 + pos) * 128 + kvh * 64 + dv]);
    }
  }
}

DI void phase_gemmA(const Params& p, int l, char* smem) {
  const u16* H = wsp<u16>(p, O_H);
  const u16* W = wsw(p, l, O_WINA);
  for (int base = 0; base < 288 * 20; base += gridDim.x) {
    const int tile = xcd_map(base);
    if (tile >= 288 * 20) continue;
    const int sb = tile >> 5, jj = tile & 31;
    const int mt = (sb / 5) * 8 + (jj >> 2), nt = (sb % 5) * 4 + (jj & 3);
    const TokTile tt = tok_tile(mt);
    f32x4 acc[4][4];
    zero_acc(acc);
    gemm_tile(H + (size_t)tt.g0 * 1024, 1024, W + (size_t)nt * 128 * 1024, 1024, 1024, acc, smem);
    LANEVARS
    if (nt < 13) {
      u16* dst; int ld, cb;
      if (nt < 8) { dst = wsp<u16>(p, O_XR); ld = 1024; cb = nt * 128; }
      else if (nt < 11) { dst = wsp<u16>(p, O_CQ); ld = 384; cb = (nt - 8) * 128; }
      else { dst = wsp<u16>(p, O_CKV); ld = 256; cb = (nt - 11) * 128; }
#pragma unroll
      for (int i = 0; i < 4; ++i)
#pragma unroll
        for (int j = 0; j < 4; ++j)
#pragma unroll
          for (int e = 0; e < 4; ++e) {
            const int g = tt.g0 + wr * 64 + i * 16 + g4 * 4 + e;
            dst[(size_t)g * ld + cb + wc * 64 + j * 16 + c16] = f2bf(acc[i][j][e]);
            if (e == 3 && j == 3) SB();
          }
    } else if (nt == 13) {
      if (wc == 0) {
#pragma unroll
        for (int i = 0; i < 4; ++i)
#pragma unroll
          for (int e = 0; e < 4; ++e) {
            SB();
            const int r = wr * 64 + i * 16 + g4 * 4 + e;
            const int pos = tt.p0 + r;
            float x1 = acc[i][0][e], x2 = acc[i][1][e];
            if (tt.is_ctx) {
              u16* kr = wsp<u16>(p, O_KRC) + ((size_t)tt.b * 256 + pos) * 32;
              kr[c16] = f2bf(x1); kr[c16 + 16] = f2bf(x2);
              float* o = p.out + OUT_KROPE + (((size_t)tt.b * 4 + l) * 256 + pos) * 32;
              o[perm32(c16)] = x1; o[perm32(c16 + 16)] = x2;
            } else {
              const int pv = (c16 >= 8) ? (pos & 63) : (pos >> 6);
              const float cs = TAB_M[(pv * 8 + (c16 & 7)) * 2], sn = TAB_M[(pv * 8 + (c16 & 7)) * 2 + 1];
              u16* kr = wsp<u16>(p, O_KRL) + ((size_t)tt.b * LK_LAT + 256 + pos) * 32;
              kr[c16] = f2bf(x1 * cs - x2 * sn); kr[c16 + 16] = f2bf(x2 * cs + x1 * sn);
            }
          }
      }
    } else if (nt < 19) {
      const bool isk = (nt == 18);
      u16* dst = isk ? wsp<u16>(p, O_KS) : wsp<u16>(p, O_QS);
      const int ld = isk ? 128 : 512;
      const int cb = isk ? wc * 64 : ((nt - 14) * 2 + wc) * 64;
#pragma unroll
      for (int i = 0; i < 4; ++i)
#pragma unroll
        for (int e = 0; e < 4; ++e) {
          SB();
          const int r = wr * 64 + i * 16 + g4 * 4 + e;
          const int pos = tt.p0 + r, g = tt.g0 + r;
          float v0 = acc[i][0][e], v1 = acc[i][1][e], v2 = acc[i][2][e], v3 = acc[i][3][e];
          if (!tt.is_ctx) {
            const int pr = pos >> 6, pc = pos & 63;
            const float c0 = TAB_S[(pr * 16 + c16) * 2], s0 = TAB_S[(pr * 16 + c16) * 2 + 1];
            const float c1 = TAB_S[(pc * 16 + c16) * 2], s1 = TAB_S[(pc * 16 + c16) * 2 + 1];
            float a0 = v0 * c0 - v1 * s0, a1 = v1 * c0 + v0 * s0;
            float a2 = v2 * c1 - v3 * s1, a3 = v3 * c1 + v2 * s1;
            v0 = a0; v1 = a1; v2 = a2; v3 = a3;
          } else if (isk) {
            float* o = p.out + OUT_SK + (((size_t)tt.b * 4 + l) * 256 + pos) * 128 + cb + c16;
            o[0] = v0; o[16] = v1; o[32] = v2; o[48] = v3;
          }
          u16* d = dst + (size_t)g * ld + cb + c16;
          d[0] = f2bf(v0); d[16] = f2bf(v1); d[32] = f2bf(v2); d[48] = f2bf(v3);
        }
    } else {
      u16* vt = tt.is_ctx ? wsp<u16>(p, O_VTSC) : wsp<u16>(p, O_VTSL);
      const int L = tt.is_ctx ? 256 : 4096;
#pragma unroll
      for (int i = 0; i < 4; ++i)
#pragma unroll
        for (int j = 0; j < 4; ++j) {
          SB();
          const int r = wr * 64 + i * 16 + g4 * 4;
          const int pos = tt.p0 + r, dv = j * 16 + c16;
          uint2 o; o.x = pack2(acc[i][j][0], acc[i][j][1]); o.y = pack2(acc[i][j][2], acc[i][j][3]);
          *(uint2*)(vt + (((size_t)tt.b * 2 + wc) * 64 + dv) * L + pos) = o;
          if (tt.is_ctx) {
#pragma unroll
            for (int e = 0; e < 4; ++e)
              p.out[OUT_SV + (((size_t)tt.b * 4 + l) * 256 + pos + e) * 128 + wc * 64 + dv] = acc[i][j][e];
          }
        }
    }
  }
}

DI void row_scales(const u16* A, int K, float* s_rs) {
  const int t = tid(), row = t >> 1, half = t & 1;
  const u16* ap = A + (size_t)row * K + half * (K >> 1);
  float ss = 0.f;
  for (int c = 0; c < (K >> 4); ++c) {
    uint4 v = *(const uint4*)(ap + c * 8);
    unsigned wv[4] = {v.x, v.y, v.z, v.w};
#pragma unroll
    for (int q = 0; q < 4; ++q) {
      float a = __uint_as_float(wv[q] << 16), b = __uint_as_float(wv[q] & 0xffff0000u);
      ss += a * a + b * b;
    }
  }
  ss += __shfl_xor(ss, 1);
  if (half == 0) s_rs[row] = rsqrtf(ss / (float)K + EPS);
}

template <int MODE> DI void scan_seg(const Params& p, int l, int seq, int blk, int d, int seg, char* smem);
DI void phase_qkv(const Params& p, int l, char* smem) {
  float* s_rs = (float*)(smem + 65536);
  constexpr int NQ = 288 * 6, NKV = 304 * 8, NS1 = 2048;
  for (int base = 0; base < NS1 + NQ + NKV; base += gridDim.x) {
    const int tile0 = xcd_map(base);
    if (tile0 >= NS1 + NQ + NKV) continue;
    if (tile0 < NS1) {
      scan_seg<0>(p, l, 16 + (tile0 >> 8), (tile0 >> 5) & 7, (tile0 >> 4) & 1, tile0 & 15, smem);
#if PROBE == 4
      scan_seg<0>(p, l, 16 + (tile0 >> 8), (tile0 >> 5) & 7, (tile0 >> 4) & 1, tile0 & 15, smem);
#endif
      continue;
    }
    const int tile = tile0 - NS1;
    f32x4 acc[4][4];
    zero_acc(acc);
    if (tile < NQ) {
      const int mt = tile / 6, nt = tile % 6;
      const TokTile tt = tok_tile(mt);
      const u16* A = wsp<u16>(p, O_CQ) + (size_t)tt.g0 * 384;
      row_scales(A, 384, s_rs);
      gemm_tile(A, 384, wsw(p, l, O_WUQ) + (size_t)nt * 128 * 384, 384, 384, acc, smem);
      LANEVARS
      u16* Q = wsp<u16>(p, O_Q);
#pragma unroll
      for (int i = 0; i < 4; ++i)
#pragma unroll
        for (int e = 0; e < 4; ++e) {
          SB();
          const int r = wr * 64 + i * 16 + g4 * 4 + e;
          const int pos = tt.p0 + r, g = tt.g0 + r;
          const float rs = s_rs[r];
          float v0 = acc[i][0][e] * rs, v1 = acc[i][1][e] * rs, v2 = acc[i][2][e] * rs, v3 = acc[i][3][e] * rs;
          if (nt >= 4 && !tt.is_ctx) {
            const int pv = (c16 >= 8) ? (pos & 63) : (pos >> 6);
            const float cs = TAB_M[(pv * 8 + (c16 & 7)) * 2], sn = TAB_M[(pv * 8 + (c16 & 7)) * 2 + 1];
            float a0 = v0 * cs - v1 * sn, a1 = v1 * cs + v0 * sn;
            float a2 = v2 * cs - v3 * sn, a3 = v3 * cs + v2 * sn;
            v0 = a0; v1 = a1; v2 = a2; v3 = a3;
          }
          u16* d = Q + (size_t)g * 768 + nt * 128 + wc * 64 + c16;
          d[0] = f2bf(v0); d[16] = f2bf(v1); d[32] = f2bf(v2); d[48] = f2bf(v3);
        }
    } else {
      const int t2 = tile - NQ;
      const int mt = t2 >> 3, hd = t2 & 7;
      const u16* A; const u16* Wt; int is_ctx, seq, kp0;
      if (mt < 288) {
        const TokTile tt = tok_tile(mt);
        A = wsp<u16>(p, O_CKV) + (size_t)tt.g0 * 256;
        Wt = wsw(p, l, O_WUKVG);
        row_scales(A, 256, s_rs);
        is_ctx = tt.is_ctx; seq = tt.b; kp0 = tt.is_ctx ? tt.p0 : 256 + tt.p0;
        if (tt.is_ctx && hd == 0) {
          __syncthreads();
          const float* gkv = p.kv_norm + l * 256;
          for (int idx = tid(); idx < 128 * 256; idx += 256) {
            const int r = idx >> 8, k = idx & 255;
            p.out[OUT_CKV + (((size_t)tt.b * 4 + l) * 256 + tt.p0 + r) * 256 + k] = bf2f(A[(size_t)r * 256 + k]) * s_rs[r] * gkv[k];
          }
        }
      } else {
        const int row0 = (mt - 288) * 128;
        A = wsp<u16>(p, O_CKVC) + (size_t)row0 * 256;
        Wt = wsw(p, l, O_WUKVR);
        { const int t1 = tid(); if (t1 < 128) s_rs[t1] = 1.f; }
        is_ctx = 0; seq = row0 >> 8; kp0 = row0 & 255;
      }
      gemm_tile(A, 256, Wt + (size_t)hd * 128 * 256, 256, 256, acc, smem);
      LANEVARS
      const int Lk = is_ctx ? 256 : LK_LAT;
      if (wc == 0) {
        u16* Kn = (is_ctx ? wsp<u16>(p, O_KNC) : wsp<u16>(p, O_KNL)) + ((size_t)seq * 8 + hd) * Lk * 64;
#pragma unroll
        for (int i = 0; i < 4; ++i)
#pragma unroll
          for (int j = 0; j < 4; ++j)
#pragma unroll
            for (int e = 0; e < 4; ++e) {
              const int r = wr * 64 + i * 16 + g4 * 4 + e;
              Kn[(size_t)(kp0 + r) * 64 + j * 16 + c16] = f2bf(acc[i][j][e] * s_rs[r]);
              if (e == 3) SB();
            }
      } else {
        u16* Vt = (is_ctx ? wsp<u16>(p, O_VTC) : wsp<u16>(p, O_VTL)) + ((size_t)seq * 8 + hd) * 64 * Lk;
#pragma unroll
        for (int i = 0; i < 4; ++i)
#pragma unroll
          for (int j = 0; j < 4; ++j) {
            SB();
            const int r = wr * 64 + i * 16 + g4 * 4;
            uint2 o;
            o.x = pack2(acc[i][j][0] * s_rs[r], acc[i][j][1] * s_rs[r + 1]);
            o.y = pack2(acc[i][j][2] * s_rs[r + 2], acc[i][j][3] * s_rs[r + 3]);
            *(uint2*)(Vt + (size_t)(j * 16 + c16) * Lk + kp0 + r) = o;
          }
      }
    }
    __syncthreads();
  }
}

template <int NS> DI void attn_gload(const int t, const u16* k0, int k0s, const u16* k1, const u16* vt, int vts,
                                     uint4& rk0, uint4& rk1, uint4& rk2, uint4& rv0, uint4& rv1) {
  if (NS == 6) {
    { const int c = t, key = c / 12, ch = c % 12;
      rk0 = (ch < 8) ? *(const uint4*)(k0 + (size_t)key * k0s + ch * 8) : *(const uint4*)(k1 + (size_t)key * 32 + (ch - 8) * 8); }
    { const int c = t + 256, key = c / 12, ch = c % 12;
      rk1 = (ch < 8) ? *(const uint4*)(k0 + (size_t)key * k0s + ch * 8) : *(const uint4*)(k1 + (size_t)key * 32 + (ch - 8) * 8); }
    { const int c = t + 512, key = c / 12, ch = c % 12;
      rk2 = (ch < 8) ? *(const uint4*)(k0 + (size_t)key * k0s + ch * 8) : *(const uint4*)(k1 + (size_t)key * 32 + (ch - 8) * 8); }
  } else {
    { const int c = t, key = c >> 3, ch = c & 7; rk0 = *(const uint4*)(k0 + (size_t)key * k0s + ch * 8); }
    { const int c = t + 256, key = c >> 3, ch = c & 7; rk1 = *(const uint4*)(k0 + (size_t)key * k0s + ch * 8); }
  }
  { const int c = t, dv = c >> 3, ch = c & 7; rv0 = *(const uint4*)(vt + (size_t)dv * vts + ch * 8); }
  { const int c = t + 256, dv = c >> 3, ch = c & 7; rv1 = *(const uint4*)(vt + (size_t)dv * vts + ch * 8); }
}
template <int NS> DI void attn_sstore(const int t, char* smem, const uint4& rk0, const uint4& rk1, const uint4& rk2, const uint4& rv0, const uint4& rv1) {
  constexpr int KSTR = (NS == 6) ? 208 : 144;
  if (NS == 6) {
    { const int c = t, key = c / 12, ch = c % 12; *(uint4*)(smem + key * KSTR + ch * 16) = rk0; }
    { const int c = t + 256, key = c / 12, ch = c % 12; *(uint4*)(smem + key * KSTR + ch * 16) = rk1; }
    { const int c = t + 512, key = c / 12, ch = c % 12; *(uint4*)(smem + key * KSTR + ch * 16) = rk2; }
  } else {
    { const int c = t, key = c >> 3, ch = c & 7; *(uint4*)(smem + key * KSTR + ch * 16) = rk0; }
    { const int c = t + 256, key = c >> 3, ch = c & 7; *(uint4*)(smem + key * KSTR + ch * 16) = rk1; }
  }
  { const int c = t, dv = c >> 3, ch = c & 7; char* d = smem + 13312 + dv * 136 + ch * 16;
    *(uint2*)d = uint2{rv0.x, rv0.y}; *(uint2*)(d + 8) = uint2{rv0.z, rv0.w}; }
  { const int c = t + 256, dv = c >> 3, ch = c & 7; char* d = smem + 13312 + dv * 136 + ch * 16;
    *(uint2*)d = uint2{rv1.x, rv1.y}; *(uint2*)(d + 8) = uint2{rv1.z, rv1.w}; }
}

#define PACK8(S, s2) __builtin_bit_cast(bf16x8, uint4{pack2(S[8 * (s2)], S[8 * (s2) + 1]), pack2(S[8 * (s2) + 2], S[8 * (s2) + 3]), \
                                                        pack2(S[8 * (s2) + 4], S[8 * (s2) + 5]), pack2(S[8 * (s2) + 6], S[8 * (s2) + 7])})

template <int NS>
DI void attn_item(const u16* kA, int kAs, const u16* krA, const u16* vtA, int vtAs, int nA, int kposA, int maskA,
                  const u16* kB, int kBs, const u16* vtB, int vtBs, int nB,
                  const u16* qa, const u16* qb, float sc2, float m0, float l0, int qpos, u16* yrow, char* smem) {
  constexpr int KSTR = (NS == 6) ? 208 : 144;
  const int tt_ = tid();
  const int lane = tt_ & 63;
  const int r32 = lane & 31, hh = lane >> 5;
  bf16x8 qf0, qf1, qf2, qf3, qf4, qf5;
  qf0 = *(const bf16x8*)(qa + 0 + 8 * hh); qf1 = *(const bf16x8*)(qa + 16 + 8 * hh);
  qf2 = *(const bf16x8*)(qa + 32 + 8 * hh); qf3 = *(const bf16x8*)(qa + 48 + 8 * hh);
  if (NS == 6) { qf4 = *(const bf16x8*)(qb + 0 + 8 * hh); qf5 = *(const bf16x8*)(qb + 16 + 8 * hh); }
  else { qf4 = qf0; qf5 = qf0; }
#define QSCALE(qf) { uint4 u_ = __builtin_bit_cast(uint4, qf); \
    u_.x = pack2(__uint_as_float(u_.x << 16) * sc2, __uint_as_float(u_.x & 0xffff0000u) * sc2); \
    u_.y = pack2(__uint_as_float(u_.y << 16) * sc2, __uint_as_float(u_.y & 0xffff0000u) * sc2); \
    u_.z = pack2(__uint_as_float(u_.z << 16) * sc2, __uint_as_float(u_.z & 0xffff0000u) * sc2); \
    u_.w = pack2(__uint_as_float(u_.w << 16) * sc2, __uint_as_float(u_.w & 0xffff0000u) * sc2); \
    qf = __builtin_bit_cast(bf16x8, u_); }
  QSCALE(qf0) QSCALE(qf1) QSCALE(qf2) QSCALE(qf3)
  if (NS == 6) { QSCALE(qf4) QSCALE(qf5) }
#undef QSCALE
  f32x16 O0, O1;
#pragma unroll
  for (int e = 0; e < 16; ++e) { O0[e] = 0.f; O1[e] = 0.f; }
  float m_run = m0, l_run = l0;
  uint4 rk0, rk1, rk2, rv0, rv1;
  rk2 = uint4{0, 0, 0, 0};
  const int ntiles = nA + nB;
#define TILE_GLOAD(jn) { if ((jn) < nA) attn_gload<NS>(tt_, kA + (size_t)(jn) * 64 * kAs, kAs, krA + (size_t)(jn) * 64 * 32, vtA + (jn) * 64, vtAs, rk0, rk1, rk2, rv0, rv1); \
    else { const int jb_ = (jn) - nA; attn_gload<NS>(tt_, kB + (size_t)jb_ * 64 * kBs, kBs, nullptr, vtB + jb_ * 64, vtBs, rk0, rk1, rk2, rv0, rv1); } }
  constexpr int STG = 22528;
  TILE_GLOAD(0)
  attn_sstore<NS>(tt_, smem, rk0, rk1, rk2, rv0, rv1);
  if (ntiles > 1) TILE_GLOAD(1)
  __syncthreads();
  for (int j = 0; j < ntiles; ++j) {
    char* sbase = smem + (j & 1) * STG;
    const int kpos = kposA + 64 * j;
    const bool masked = maskA && (j < nA);
    MB();
    f32x16 S0, S1;
#pragma unroll
    for (int e = 0; e < 16; ++e) { S0[e] = 0.f; S1[e] = 0.f; }
    const char* ka0 = sbase + r32 * KSTR + 16 * hh;
    const char* ka1 = sbase + (32 + r32) * KSTR + 16 * hh;
#define QK_STEP(s, qf) { bf16x8 a0 = *(const bf16x8*)(ka0 + 32 * (s)); bf16x8 a1 = *(const bf16x8*)(ka1 + 32 * (s)); \
      S0 = __builtin_amdgcn_mfma_f32_32x32x16_bf16(a0, qf, S0, 0, 0, 0); S1 = __builtin_amdgcn_mfma_f32_32x32x16_bf16(a1, qf, S1, 0, 0, 0); }
    QK_STEP(0, qf0) QK_STEP(1, qf1) QK_STEP(2, qf2) QK_STEP(3, qf3)
    if (NS == 6) { QK_STEP(4, qf4) QK_STEP(5, qf5) }
    SB();
    float mx = m_run;
#pragma unroll
    for (int e = 0; e < 16; ++e) {
      float v0 = S0[e], v1 = S1[e];
      if (masked) {
        const int kp = kpos + (e & 3) + 8 * (e >> 2) + 4 * hh;
        int d0 = qpos - kp; d0 = d0 < 0 ? -d0 : d0;
        int d1 = qpos - (kp + 32); d1 = d1 < 0 ? -d1 : d1;
        if (d0 > 128) v0 = -1e30f;
        if (d1 > 128) v1 = -1e30f;
      }
      S0[e] = v0; S1[e] = v1;
      mx = fmaxf(mx, fmaxf(v0, v1));
    }
    mx = fmaxf(mx, __shfl_xor(mx, 32));
    const float alpha = __builtin_amdgcn_exp2f(m_run - mx);
    m_run = mx;
    const f2_t m2 = {mx, mx};
    f2_t rs2 = {0.f, 0.f};
#pragma unroll
    for (int e = 0; e < 16; e += 2) {
      const f2_t d0 = f2_t{S0[e], S0[e + 1]} - m2, d1 = f2_t{S1[e], S1[e + 1]} - m2;
      const f2_t p0 = {__builtin_amdgcn_exp2f(d0.x), __builtin_amdgcn_exp2f(d0.y)};
      const f2_t p1 = {__builtin_amdgcn_exp2f(d1.x), __builtin_amdgcn_exp2f(d1.y)};
      S0[e] = p0.x; S0[e + 1] = p0.y; S1[e] = p1.x; S1[e + 1] = p1.y;
      rs2 += p0 + p1;
    }
    float rsum = rs2.x + rs2.y;
    rsum += __shfl_xor(rsum, 32);
    l_run = l_run * alpha + rsum;
#pragma unroll
    for (int e = 0; e < 16; ++e) { O0[e] *= alpha; O1[e] *= alpha; }
    const char* sv0 = sbase + 13312 + r32 * 136 + 8 * hh;
    const char* sv1 = sv0 + 32 * 136;
#define PV_STEP(pb, ka) { \
      { uint2 lo = *(const uint2*)(sv0 + (ka) * 2), hi = *(const uint2*)(sv0 + (ka) * 2 + 16); \
        bf16x8 va = __builtin_bit_cast(bf16x8, uint4{lo.x, lo.y, hi.x, hi.y}); O0 = __builtin_amdgcn_mfma_f32_32x32x16_bf16(va, pb, O0, 0, 0, 0); } \
      { uint2 lo = *(const uint2*)(sv1 + (ka) * 2), hi = *(const uint2*)(sv1 + (ka) * 2 + 16); \
        bf16x8 va = __builtin_bit_cast(bf16x8, uint4{lo.x, lo.y, hi.x, hi.y}); O1 = __builtin_amdgcn_mfma_f32_32x32x16_bf16(va, pb, O1, 0, 0, 0); } }
    SB();
    { bf16x8 pb = PACK8(S0, 0); PV_STEP(pb, 0) }
    { bf16x8 pb = PACK8(S0, 1); PV_STEP(pb, 16) }
    SB();
    { bf16x8 pb = PACK8(S1, 0); PV_STEP(pb, 32) }
    { bf16x8 pb = PACK8(S1, 1); PV_STEP(pb, 48) }
    SB();
    if (j + 1 < ntiles) {
      attn_sstore<NS>(tt_, smem + ((j + 1) & 1) * STG, rk0, rk1, rk2, rv0, rv1);
      if (j + 2 < ntiles) TILE_GLOAD(j + 2)
    }
    __syncthreads();
  }
#undef TILE_GLOAD
  const float inv = 1.f / l_run;
#pragma unroll
  for (int e4 = 0; e4 < 4; ++e4) {
    uint2 o;
    o.x = pack2(O0[4 * e4] * inv, O0[4 * e4 + 1] * inv); o.y = pack2(O0[4 * e4 + 2] * inv, O0[4 * e4 + 3] * inv);
    *(uint2*)(yrow + 8 * e4 + 4 * hh) = o;
    o.x = pack2(O1[4 * e4] * inv, O1[4 * e4 + 1] * inv); o.y = pack2(O1[4 * e4 + 2] * inv, O1[4 * e4 + 3] * inv);
    *(uint2*)(yrow + 32 + 8 * e4 + 4 * hh) = o;
  }
}

template <int MODE>
DI void scan_seg(const Params& p, int l, int seq, int blk, int d, int seg, char* smem) {
  const int t = tid(), lane = t & 63, w = t >> 6;
  const int c16 = lane & 15, g4 = lane >> 4;
  const bool is_ctx = seq < 16;
  const int b = is_ctx ? seq : seq - 16;
  const int L = is_ctx ? 256 : 4096;
  const int gbase = is_ctx ? b * 256 : T_CTX + b * 4096;
  const u16* XR = wsp<u16>(p, O_XR);
  u16* Y = wsp<u16>(p, O_YRNN);
  float* SUM = wsp<float>(p, O_SUM);
  char* sXc = smem;
  float* sA = (float*)(smem + 8704);
  float* sU = (float*)(smem + 8704 + 16384);
  const int cch = t & 127, th = t >> 7;
  const int chg = blk * 128 + cch;
  const float w0 = p.conv_w[(l * 4 + 0) * 1024 + chg], w1 = p.conv_w[(l * 4 + 1) * 1024 + chg];
  const float w2 = p.conv_w[(l * 4 + 2) * 1024 + chg], w3 = p.conv_w[(l * 4 + 3) * 1024 + chg];
  const float cb = p.conv_b[l * 1024 + chg];
  bf16x8 bw[4][4];
  {
    const u16* WL = wsw(p, l, O_WLRU) + (size_t)(d * 8 + blk) * 256 * 128 + (size_t)(32 * w + c16) * 128 + g4 * 8;
#pragma unroll
    for (int nf = 0; nf < 4; ++nf)
#pragma unroll
      for (int ks = 0; ks < 4; ++ks)
        bw[nf][ks] = *(const bf16x8*)(WL + (size_t)((nf & 1) * 16 + (nf >> 1) * 128) * 128 + ks * 32);
  }
  float ba[2], bi[2], cl[2];
#pragma unroll
  for (int jn = 0; jn < 2; ++jn) {
    const int ch = (l * 2 + d) * 1024 + blk * 128 + 32 * w + 16 * jn + c16;
    ba[jn] = p.lru_ba[ch]; bi[jn] = p.lru_bi[ch];
    cl[jn] = -8.f * log1pf(__expf(-p.lru_lam[ch]));
  }
  float h = 0.f, P = 1.f;
  if (MODE == 1 && !is_ctx && t < 128) {
    h = p.state[(((size_t)b * 4 + l) * 2 + d) * 1024 + blk * 128 + t];
    const float* sm = SUM + ((size_t)((b * 8 + blk) * 2 + d) * 16) * 256 + t;
    float Pv[16], Hv[16];
#pragma unroll
    for (int s2 = 0; s2 < 16; ++s2) { Pv[s2] = sm[s2 * 256]; Hv[s2] = sm[s2 * 256 + 128]; }
    if (d == 0) {
#pragma unroll
      for (int s2 = 0; s2 < 16; ++s2) if (s2 < seg) h = Pv[s2] * h + Hv[s2];
    } else {
#pragma unroll
      for (int s2 = 15; s2 >= 0; --s2) if (s2 > seg) h = Pv[s2] * h + Hv[s2];
    }
  }
#define X19(F) F(0) F(1) F(2) F(3) F(4) F(5) F(6) F(7) F(8) F(9) F(10) F(11) F(12) F(13) F(14) F(15) F(16) F(17) F(18)
#define XDECL(q) u16 xr##q = 0;
#define XLOAD(q) { const int pos = tcn + th * 16 - 1 + (q); xr##q = (pos >= 0 && pos < L) ? XR[(size_t)(gbase + pos) * 1024 + chg] : (u16)0; }
#define XCVT(q) xv[q] = bf2f(xr##q);
  X19(XDECL)
  { const int tcn = seg * 256 + (d == 0 ? 0 : 7) * 32; X19(XLOAD) }
  for (int ci = 0; ci < 8; ++ci) {
    const int tc0 = seg * 256 + (d == 0 ? ci : 7 - ci) * 32;
    {
      float xv[19];
      X19(XCVT)
#pragma unroll
      for (int q = 0; q < 16; ++q) {
        float xc = cb + w0 * xv[q] + w1 * xv[q + 1] + w2 * xv[q + 2] + w3 * xv[q + 3];
        *(u16*)(sXc + (th * 16 + q) * 272 + cch * 2) = f2bf(xc);
      }
    }
    unsigned yold0 = 0, yold1 = 0, yold2 = 0, yold3 = 0, yold4 = 0, yold5 = 0, yold6 = 0, yold7 = 0;
    {
      const int cn = ci < 7 ? ci + 1 : ci;
      const int tcn = seg * 256 + (d == 0 ? cn : 7 - cn) * 32;
      X19(XLOAD)
      if (MODE == 1 && d == 1) {
        const unsigned* yb = (const unsigned*)(Y + (size_t)(gbase + tc0 + (t >> 6)) * 1024 + blk * 128 + (t & 63) * 2);
        yold0 = yb[0]; yold1 = yb[4 * 512]; yold2 = yb[8 * 512]; yold3 = yb[12 * 512];
        yold4 = yb[16 * 512]; yold5 = yb[20 * 512]; yold6 = yb[24 * 512]; yold7 = yb[28 * 512];
      }
    }
    MB();
    __syncthreads();
    f32x4 aR[2][2], aI[2][2];
#pragma unroll
    for (int im = 0; im < 2; ++im)
#pragma unroll
      for (int jn = 0; jn < 2; ++jn) { aR[im][jn] = f32x4{0.f, 0.f, 0.f, 0.f}; aI[im][jn] = f32x4{0.f, 0.f, 0.f, 0.f}; }
#pragma unroll
    for (int ks = 0; ks < 4; ++ks)
#pragma unroll
      for (int im = 0; im < 2; ++im) {
        bf16x8 af = *(const bf16x8*)(sXc + (16 * im + c16) * 272 + (ks * 32 + g4 * 8) * 2);
#pragma unroll
        for (int jn = 0; jn < 2; ++jn) {
          aR[im][jn] = __builtin_amdgcn_mfma_f32_16x16x32_bf16(af, bw[jn][ks], aR[im][jn], 0, 0, 0);
          aI[im][jn] = __builtin_amdgcn_mfma_f32_16x16x32_bf16(af, bw[2 + jn][ks], aI[im][jn], 0, 0, 0);
        }
      }
#pragma unroll
    for (int im = 0; im < 2; ++im)
#pragma unroll
      for (int jn = 0; jn < 2; ++jn)
#pragma unroll
        for (int e = 0; e < 4; ++e) {
          const int tt = 16 * im + 4 * g4 + e, c = 32 * w + 16 * jn + c16;
          const float r = sigmoidf_(aR[im][jn][e] + ba[jn]);
          const float ig = sigmoidf_(aI[im][jn][e] + bi[jn]);
          const float a = __expf(cl[jn] * r);
          const float xc = bf2f(*(const u16*)(sXc + tt * 272 + c * 2));
          const float u = __builtin_amdgcn_sqrtf(fmaxf(1.f - a * a, 0.f)) * ig * xc;
          sA[tt * 128 + c] = a; sU[tt * 128 + c] = u;
        }
    __syncthreads();
    if (t < 128) {
      if (d == 0) {
#pragma unroll 8
        for (int s = 0; s < 32; ++s) {
          const float a = sA[s * 128 + t];
          h = a * h + sU[s * 128 + t];
          if (MODE == 0) P *= a; else sU[s * 128 + t] = h;
        }
      } else {
#pragma unroll 8
        for (int s = 31; s >= 0; --s) {
          const float a = sA[s * 128 + t];
          h = a * h + sU[s * 128 + t];
          if (MODE == 0) P *= a; else sU[s * 128 + t] = h;
        }
      }
    }
    __syncthreads();
    if (MODE == 1) {
      const int c2 = (t & 63) * 2;
      unsigned* yb = (unsigned*)(Y + (size_t)(gbase + tc0 + (t >> 6)) * 1024 + blk * 128 + c2);
      const float* su = sU + (t >> 6) * 128 + c2;
#define YOUT(i, yo) { float h0 = su[(4 * (i)) * 128], h1 = su[(4 * (i)) * 128 + 1]; \
        if (d == 1) { h0 += __uint_as_float((yo) << 16); h1 += __uint_as_float((yo) & 0xffff0000u); } \
        yb[(size_t)(4 * (i)) * 512] = pack2(h0, h1); }
      YOUT(0, yold0) YOUT(1, yold1) YOUT(2, yold2) YOUT(3, yold3) YOUT(4, yold4) YOUT(5, yold5) YOUT(6, yold6) YOUT(7, yold7)
#undef YOUT
    }
  }
#undef X19
#undef XDECL
#undef XLOAD
#undef XCVT
  if (MODE == 0) {
    if (t < 128) {
      float* sm = SUM + ((size_t)(((b * 8 + blk) * 2 + d) * 16 + seg)) * 256 + t;
      sm[0] = P; sm[128] = h;
    }
  } else if (is_ctx && t < 128) {
    p.out[OUT_RG + (((size_t)b * 4 + l) * 2 + d) * 1024 + blk * 128 + t] = h;
  }
  __syncthreads();
}

DI void phase_mix(const Params& p, int l, char* smem) {
  constexpr float LOG2E = 1.4426950408889634f;
  constexpr int N0 = 1024, N1 = N0 + 2048, N2 = N1 + 2048, N3 = N2 + 128, N4 = N3 + 256, N5 = N4 + 256;
  for (int base = 0; base < N5; base += gridDim.x) {
    const int vit = xcd_map(base);
    if (vit >= N5) continue;
    const int it = vit < N0 ? vit : (vit < N0 + 128 ? N2 + (vit - N0) : (vit < N3 ? vit - 128 : vit));
    const int t = tid(), lane = t & 63, w = t >> 6;
    const int r32 = lane & 31;
    if (it < N0 || (it >= N2 && it < N3)) {
      int seq, blk, seg;
      if (it < N0) { seg = it & 15; blk = (it >> 4) & 7; seq = 16 + (it >> 7); }
      else { const int i = it - N2; seg = 0; blk = i & 7; seq = i >> 3; }
      scan_seg<1>(p, l, seq, blk, 0, seg, smem);
      scan_seg<1>(p, l, seq, blk, 1, seg, smem);
#if PROBE == 4
      scan_seg<1>(p, l, seq, blk, 0, seg, smem);
      scan_seg<1>(p, l, seq, blk, 1, seg, smem);
#endif
    } else if (it < N1 || (it >= N3 && it < N4)) {
      const bool lat = it < N1;
      int b, h, qb;
      if (lat) { const int i = it - N0; qb = i & 31; h = (i >> 5) & 7; b = i >> 8; }
      else { const int i = it - N3; qb = i & 1; h = (i >> 1) & 7; b = i >> 4; }
      const int Lk = lat ? LK_LAT : 256;
      const int gq = (lat ? T_CTX + b * 4096 : b * 256) + qb * 128 + w * 32 + r32;
      const u16* Kn = (lat ? wsp<u16>(p, O_KNL) : wsp<u16>(p, O_KNC)) + ((size_t)b * 8 + h) * Lk * 64;
      const u16* Kr = (lat ? wsp<u16>(p, O_KRL) : wsp<u16>(p, O_KRC)) + (size_t)b * Lk * 32;
      const u16* Vt = (lat ? wsp<u16>(p, O_VTL) : wsp<u16>(p, O_VTC)) + ((size_t)b * 8 + h) * 64 * Lk;
      const u16* Q = wsp<u16>(p, O_Q) + (size_t)gq * 768;
      u16* yrow = wsp<u16>(p, O_CQ) + (size_t)gq * 512 + h * 64;
      attn_item<6>(Kn, 64, Kr, Vt, Lk, Lk >> 6, 0, 0, nullptr, 0, nullptr, 0, 0,
                   Q + h * 64, Q + 512 + h * 32, 0.10206207261596577f * LOG2E, -1e30f, 0.f, 0, yrow, smem);
#if PROBE == 5
      __syncthreads();
      attn_item<6>(Kn, 64, Kr, Vt, Lk, Lk >> 6, 0, 0, nullptr, 0, nullptr, 0, 0,
                   Q + h * 64, Q + 512 + h * 32, 0.10206207261596577f * LOG2E, -1e30f, 0.f, 0, yrow, smem);
#endif
    } else {
      const bool lat = it < N2;
      int b, h, qb;
      if (lat) { const int i = it - N1; qb = i & 31; h = (i >> 5) & 7; b = i >> 8; }
      else { const int i = it - N4; qb = i & 1; h = (i >> 1) & 7; b = i >> 4; }
      const int kvh = h >> 2;
      const int gseq = lat ? T_CTX + b * 4096 : b * 256;
      const int qpos = qb * 128 + w * 32 + r32;
      const int gq = gseq + qpos;
      u16* qrow = wsp<u16>(p, O_QS) + (size_t)gq * 512 + h * 64;
      const float sink2 = p.sink[l * 8 + h] * LOG2E;
      const int t0 = qb * 128;
      int jlo = 0, jhi = 6;
      if (t0 == 0) jlo = 2;
      if (t0 + 128 >= 4096) jhi = 4;
      const int ks0 = lat ? t0 - 128 + 64 * jlo : 0;
      const int nA = lat ? jhi - jlo : 4;
      const u16* KS = wsp<u16>(p, O_KS) + (size_t)(gseq + ks0) * 128 + kvh * 64;
      const u16* VT = lat ? wsp<u16>(p, O_VTSL) + ((size_t)b * 2 + kvh) * 64 * 4096 + ks0
                          : wsp<u16>(p, O_VTSC) + ((size_t)b * 2 + kvh) * 64 * 256;
      const u16* KC = wsp<u16>(p, O_KSC) + (size_t)b * 256 * 128 + kvh * 64;
      const u16* VC = wsp<u16>(p, O_VTSCC) + ((size_t)b * 2 + kvh) * 64 * 256;
      attn_item<4>(KS, 128, nullptr, VT, lat ? 4096 : 256, nA, ks0, lat ? 1 : 0, KC, 128, VC, 256, lat ? 4 : 0,
                   qrow, nullptr, 0.125f * LOG2E, sink2, 1.f, qpos, qrow, smem);
    }
    __syncthreads();
  }
}

DI void phase_gate(const Params& p, int l, char* smem) {
  const u16* H = wsp<u16>(p, O_H);
  const u16* W = wsw(p, l, O_WINB);
  for (int base = 0; base < 288 * 40; base += gridDim.x) {
    const int tile = xcd_map(base);
    if (tile >= 288 * 40) continue;
    const int sb = tile >> 6, jj = tile & 63;
    const int mt = (sb / 5) * 8 + (jj >> 3), nt = (sb % 5) * 8 + (jj & 7);
    const int g0 = mt * 128;
    f32x4 acc[4][4];
    zero_acc(acc);
    gemm_tile_T(H + (size_t)g0 * 1024, 1024, W + (size_t)nt * 128 * 1024, 1024, 1024, acc, smem);
    LANEVARS
    if (nt < 16) {
      u16* dst; int ld, cb;
      if (nt < 8) { dst = wsp<u16>(p, O_YRNN); ld = 1024; cb = nt * 128; }
      else if (nt < 12) { dst = wsp<u16>(p, O_CQ); ld = 512; cb = (nt - 8) * 128; }
      else { dst = wsp<u16>(p, O_QS); ld = 512; cb = (nt - 12) * 128; }
#pragma unroll
      for (int i = 0; i < 4; ++i)
#pragma unroll
        for (int j = 0; j < 4; ++j) {
          const int g = g0 + wr * 64 + i * 16 + c16;
          uint2* d = (uint2*)(dst + (size_t)g * ld + cb + wc * 64 + j * 16 + g4 * 4);
          const uint2 y = *d;
          const float g0v = acc[i][j][0], g1v = acc[i][j][1], g2v = acc[i][j][2], g3v = acc[i][j][3];
          uint2 o;
          o.x = pack2(__uint_as_float(y.x << 16) * g0v * sigmoidf_(g0v), __uint_as_float(y.x & 0xffff0000u) * g1v * sigmoidf_(g1v));
          o.y = pack2(__uint_as_float(y.y << 16) * g2v * sigmoidf_(g2v), __uint_as_float(y.y & 0xffff0000u) * g3v * sigmoidf_(g3v));
          *d = o;
          SB();
        }
    } else {
      const int br = (nt - 16) >> 3, cb = ((nt - 16) & 7) * 128;
      u16* dst = br == 0 ? wsp<u16>(p, O_XR) : wsp<u16>(p, O_KS) + (size_t)(br - 1) * T_ALL * 1024;
#pragma unroll
      for (int i = 0; i < 4; ++i)
#pragma unroll
        for (int j = 0; j < 4; ++j) {
          const int g = g0 + wr * 64 + i * 16 + c16;
          uint2 o;
          o.x = pack2(sigmoidf_(acc[i][j][0]), sigmoidf_(acc[i][j][1]));
          o.y = pack2(sigmoidf_(acc[i][j][2]), sigmoidf_(acc[i][j][3]));
          *(uint2*)(dst + (size_t)g * 1024 + cb + wc * 64 + j * 16 + g4 * 4) = o;
          SB();
        }
    }
  }
}

DI void phase_merge(const Params& p, int l, char* smem) {
  u16* U = wsp<u16>(p, O_H);
  for (int base = 0; base < 288 * 8; base += gridDim.x) {
    const int tile = xcd_map(base);
    if (tile >= 288 * 8) continue;
    const int mt = tile >> 3, nt = tile & 7;
    const int g0 = mt * 128;
    f32x4 u[4][4];
    zero_acc(u);
    for (int br = 0; br < 3; ++br) {
      f32x4 acc[4][4];
      zero_acc(acc);
      const u16* Z; const u16* WT; int kz; const u16* M;
      if (br == 0) { Z = wsp<u16>(p, O_YRNN) + (size_t)g0 * 1024; WT = wsw(p, l, O_WBRR) + (size_t)nt * 128 * 1024; kz = 1024; M = wsp<u16>(p, O_XR); }
      else if (br == 1) { Z = wsp<u16>(p, O_CQ) + (size_t)g0 * 512; WT = wsw(p, l, O_WBRM) + (size_t)nt * 128 * 512; kz = 512; M = wsp<u16>(p, O_KS); }
      else { Z = wsp<u16>(p, O_QS) + (size_t)g0 * 512; WT = wsw(p, l, O_WBRS) + (size_t)nt * 128 * 512; kz = 512; M = wsp<u16>(p, O_KS) + (size_t)T_ALL * 1024; }
      gemm_tile(Z, kz, WT, kz, kz, acc, smem);
      LANEVARS
#pragma unroll
      for (int i = 0; i < 4; ++i)
#pragma unroll
        for (int j = 0; j < 4; ++j)
#pragma unroll
          for (int e = 0; e < 4; ++e) {
            const int g = g0 + wr * 64 + i * 16 + g4 * 4 + e;
            u[i][j][e] += bf2f(M[(size_t)g * 1024 + nt * 128 + wc * 64 + j * 16 + c16]) * acc[i][j][e];
            if (e == 3) SB();
          }
    }
    LANEVARS
#pragma unroll
    for (int i = 0; i < 4; ++i)
#pragma unroll
      for (int j = 0; j < 4; ++j)
#pragma unroll
        for (int e = 0; e < 4; ++e) {
          const int g = g0 + wr * 64 + i * 16 + g4 * 4 + e;
          U[(size_t)g * 1024 + nt * 128 + wc * 64 + j * 16 + c16] = f2bf(u[i][j][e]);
        }
  }
}

DI void phase_out(const Params& p, int l, char* smem) {
  const u16* U = wsp<u16>(p, O_H);
  const u16* W = wsw(p, l, O_WOUT);
  const float* MOD = wsp<float>(p, O_MOD) + (size_t)l * 9 * 3072;
  for (int base = 0; base < 288 * 8; base += gridDim.x) {
    const int tile = xcd_map(base);
    if (tile >= 288 * 8) continue;
    const int mt = tile >> 3, nt = tile & 7;
    const int g0 = mt * 128;
    const int ci = g0 < T_CTX ? 8 : ((g0 - T_CTX) >> 12);
    f32x4 acc[4][4];
    zero_acc(acc);
    gemm_tile_T(U + (size_t)g0 * 1024, 1024, W + (size_t)nt * 128 * 1024, 1024, 1024, acc, smem);
    LANEVARS
#pragma unroll
    for (int j = 0; j < 4; ++j) {
      const int col = nt * 128 + wc * 64 + j * 16 + g4 * 4;
      const float4 gt = *(const float4*)(MOD + ci * 3072 + 2048 + col);
#pragma unroll
      for (int i = 0; i < 4; ++i) {
        const int g = g0 + wr * 64 + i * 16 + c16;
        const float4 xo = *(const float4*)(xin_row(p, l, g) + col);
        float4 r;
        r.x = xo.x + gt.x * acc[i][j][0]; r.y = xo.y + gt.y * acc[i][j][1];
        r.z = xo.z + gt.z * acc[i][j][2]; r.w = xo.w + gt.w * acc[i][j][3];
        *(float4*)(p.out + (size_t)g * 1024 + col) = r;
        SB();
      }
    }
  }
}

DI void phase_final(const Params& p) {
  const int t = tid(), lane = t & 63, w = t >> 6;
  for (int row = blockIdx.x * 4 + w; row < T_ALL; row += gridDim.x * 4) {
    float* x = p.out + (size_t)row * 1024;
    float4 v[4];
    float ss = 0.f;
#pragma unroll
    for (int i = 0; i < 4; ++i) {
      v[i] = *(const float4*)(x + i * 256 + lane * 4);
      ss += v[i].x * v[i].x + v[i].y * v[i].y + v[i].z * v[i].z + v[i].w * v[i].w;
    }
    ss = wave_sum(ss);
    const float rs = rsqrtf(ss * (1.f / 1024.f) + EPS);
#pragma unroll
    for (int i = 0; i < 4; ++i) {
      const int c = i * 256 + lane * 4;
      const float4 g = *(const float4*)(p.final_norm + c);
      float4 o = {v[i].x * rs * g.x, v[i].y * rs * g.y, v[i].z * rs * g.z, v[i].w * rs * g.w};
      *(float4*)(x + c) = o;
    }
  }
}

constexpr int NPHASE_PER_LAYER = 7;
DI void run_phase(const Params& p, int ph, char* smem) {
  if (ph == 0) { phase_mod(p, smem); return; }
  if (ph == 1 + NLAYER * NPHASE_PER_LAYER) { phase_final(p); return; }
  const int l = (ph - 1) / NPHASE_PER_LAYER, s = (ph - 1) % NPHASE_PER_LAYER;
  switch (s) {
    case 0: phase_prep(p, l); break;
    case 1: phase_gemmA(p, l, smem); break;
    case 2: phase_qkv(p, l, smem); break;
    case 3: phase_mix(p, l, smem); break;
    case 4: phase_gate(p, l, smem); break;
    case 5: phase_merge(p, l, smem); break;
    default: phase_out(p, l, smem); break;
  }
}
constexpr int NPHASE = 2 + NLAYER * NPHASE_PER_LAYER;

#if MEGA
DI Params launder(const Params& p) {
  size_t z = 0;
  asm volatile("" : "+s"(z));
  Params q = p; q.ws = p.ws + z; q.out = p.out + z;
  return q;
}
struct XBar { unsigned* base; unsigned xcc; unsigned nloc; unsigned nx; };
#define XB_CENSUS(j) (64 * (j))
#define XB_XSUB(j) (1024 + 64 * (j))
#define XB_XGEN(j) (2048 + 64 * (j))
#define XB_TOP 3072
#define XB_TOPGEN 3136
DI unsigned xb_ld(unsigned* p) { return __hip_atomic_load(p, __ATOMIC_RELAXED, __HIP_MEMORY_SCOPE_AGENT); }
DI unsigned xb_add(unsigned* p, unsigned v) { return __hip_atomic_fetch_add(p, v, __ATOMIC_RELAXED, __HIP_MEMORY_SCOPE_AGENT); }
DI void xbar_post(XBar& xb, unsigned* base) {
  xb.base = base; xb.nloc = 0; xb.nx = 0;
  xb.xcc = (unsigned)__builtin_amdgcn_s_getreg((3 << 11) | 20) & 0xFu;
  if (threadIdx.x == 0) xb_add(&base[XB_CENSUS(xb.xcc)], 1u);
}
DI void xbar_census(XBar& xb) {
  if (threadIdx.x == 0) {
    unsigned nx = 0;
    for (int j = 0; j < 16; ++j) nx += xb_ld(&xb.base[XB_CENSUS(j)]) ? 1u : 0u;
    xb.nx = nx; xb.nloc = xb_ld(&xb.base[XB_CENSUS(xb.xcc)]);
  }
}
DI void xbar_sync(const XBar& xb) {
  asm volatile("s_waitcnt vmcnt(0)" ::: "memory");
  __syncthreads();
  if (threadIdx.x == 0) {
    unsigned* bar = xb.base;
    const unsigned old = xb_add(&bar[XB_XSUB(xb.xcc)], 1u);
    const unsigned gen = old / xb.nloc;
    if (old + 1u == (gen + 1u) * xb.nloc) {
      __builtin_amdgcn_fence(__ATOMIC_RELEASE, "agent");
      asm volatile("s_waitcnt vmcnt(0)" ::: "memory");
      const unsigned og = xb_add(&bar[XB_TOP], 1u);
      const unsigned tg = og / xb.nx;
      if (og + 1u == (tg + 1u) * xb.nx) xb_add(&bar[XB_TOPGEN], 1u);
      else { unsigned sp = 0; while (xb_ld(&bar[XB_TOPGEN]) == tg) { __builtin_amdgcn_s_sleep(1); if (++sp > (1u << 22)) break; } }
      __builtin_amdgcn_fence(__ATOMIC_ACQUIRE, "agent");
      xb_add(&bar[XB_XGEN(xb.xcc)], 1u);
      asm volatile("s_waitcnt vmcnt(0)" ::: "memory");
    } else {
      unsigned sp = 0;
      while (xb_ld(&bar[XB_XGEN(xb.xcc)]) == gen) { __builtin_amdgcn_s_sleep(1); if (++sp > (1u << 22)) break; }
      __builtin_amdgcn_fence(__ATOMIC_ACQUIRE, "agent");
      asm volatile("s_waitcnt vmcnt(0)" ::: "memory");
    }
  }
  __syncthreads();
}
#define GSYNC() xbar_sync(xb)
__global__ void __launch_bounds__(256, 2) mega_kernel(Params p) {
  __shared__ __attribute__((aligned(16))) char smem[66048];
  cg::grid_group grid = cg::this_grid();
  XBar xb;
  xbar_post(xb, (unsigned*)(p.ws + O_BAR));
  phase_mod(launder(p), smem);
  convert_weights(launder(p), 0);
  grid.sync();
  xbar_census(xb);
  for (int l = 0; l < NLAYER; ++l) {
    phase_prep(launder(p), l);
    GSYNC();
#if PROBE == 1
    phase_prep(launder(p), l);
    GSYNC();
#endif
    phase_gemmA(launder(p), l, smem);
    GSYNC();
#if PROBE == 2
    phase_gemmA(launder(p), l, smem);
    GSYNC();
#endif
    phase_qkv(launder(p), l, smem);
    GSYNC();
    phase_mix(launder(p), l, smem);
    if (l + 1 < NLAYER) convert_weights(launder(p), l + 1);
    GSYNC();
    phase_gate(launder(p), l, smem);
    GSYNC();
    phase_merge(launder(p), l, smem);
    GSYNC();
#if PROBE == 3
    phase_merge(launder(p), l, smem);
    GSYNC();
#endif
    phase_out(launder(p), l, smem);
    GSYNC();
  }
  phase_final(launder(p));
}

#else
__global__ void __launch_bounds__(256, 2) phase_kernel(Params p, int ph) {
  __shared__ __attribute__((aligned(16))) char smem[66048];
  run_phase(p, ph, smem);
}

#endif
extern "C" void kernel_launch(void* const* d_in, const int* in_sizes, int n_in, void* d_out, int out_size, void* d_ws,
                              size_t ws_size, hipStream_t stream) {
  Params p{};
  const float** pp = (const float**)&p;
  for (int i = 0; i < 30; ++i) pp[i] = (const float*)d_in[i];
  p.out = (float*)d_out;
  p.ws = (char*)d_ws;
  if (ws_size < WS_NEED) fprintf(stderr, "workspace too small: %zu < %zu\n", ws_size, (size_t)WS_NEED);
#if MEGA
  static int grid_blocks = 0;
  if (!grid_blocks) {
    int dev = 0, cus = 0, per_cu = 0;
    hipGetDevice(&dev);
    hipDeviceGetAttribute(&cus, hipDeviceAttributeMultiprocessorCount, dev);
    hipOccupancyMaxActiveBlocksPerMultiprocessor(&per_cu, mega_kernel, 256, 0);
    if (per_cu > 2) per_cu = 2;
    grid_blocks = cus * per_cu;
  }
  (void)hipMemsetAsync((char*)d_ws + O_BAR, 0, BAR_BYTES, stream);
  void* args[] = {&p};
  hipError_t e = hipLaunchCooperativeKernel((void*)mega_kernel, dim3(grid_blocks), dim3(256), args, 0, stream);
  if (e != hipSuccess) fprintf(stderr, "cooperative launch failed: %s (grid %d)\n", hipGetErrorString(e), grid_blocks);
#else
  for (int ph = 0; ph < NPHASE; ++ph) phase_kernel<<<512, 256, 0, stream>>>(p, ph);
#endif
}
```

```cpp
#include <hip/hip_runtime.h>
#include <hip/hip_cooperative_groups.h>
#include <cstdio>
#include <cstdint>
namespace cg = cooperative_groups;

#ifndef PROBE
#define PROBE 0
#endif
#ifndef MEGA
#define MEGA 1
#endif

typedef unsigned short u16;
using bf16x8 = __attribute__((ext_vector_type(8))) short;
using f32x4 = __attribute__((ext_vector_type(4))) float;
using f32x16 = __attribute__((ext_vector_type(16))) float;
typedef __bf16 bf2_t __attribute__((ext_vector_type(2)));
typedef float f2_t __attribute__((ext_vector_type(2)));
#define DI __device__ __forceinline__

__device__ const float TAB_M[1024] = {
  1.00000000e+00f, 0.00000000e+00f, 1.00000000e+00f, 0.00000000e+00f, 1.00000000e+00f, 0.00000000e+00f, 1.00000000e+00f, 0.00000000e+00f,
  1.00000000e+00f, 0.00000000e+00f, 1.00000000e+00f, 0.00000000e+00f, 1.00000000e+00f, 0.00000000e+00f, 1.00000000e+00f, 0.00000000e+00f,
  5.40302277e-01f, 8.41470957e-01f, 9.50415254e-01f, 3.10983598e-01f, 9.95004177e-01f, 9.98334214e-02f, 9.99500036e-01f, 3.16175036e-02f,
  9.99949992e-01f, 9.99983307e-03f, 9.99994993e-01f, 3.16227227e-03f, 9.99999523e-01f, 9.99999931e-04f, 9.99999940e-01f, 3.16227757e-04f,
  -4.16146845e-01f, 9.09297407e-01f, 8.06578398e-01f, 5.91127098e-01f, 9.80066597e-01f, 1.98669329e-01f, 9.98000681e-01f, 6.32033944e-02f,
  9.99800026e-01f, 1.99986659e-02f, 9.99979973e-01f, 6.32451288e-03f, 9.99997973e-01f, 1.99999870e-03f, 9.99999821e-01f, 6.32455456e-04f,
  -9.89992499e-01f, 1.41120002e-01f, 5.82753658e-01f, 8.12648892e-01f, 9.55336511e-01f, 2.95520216e-01f, 9.95503366e-01f, 9.47260857e-02f,
  9.99550045e-01f, 2.99954992e-02f, 9.99954998e-01f, 9.48669016e-03f, 9.99995530e-01f, 2.99999560e-03f, 9.99999523e-01f, 9.48683126e-04f,
  -6.53643608e-01f, -7.56802499e-01f, 3.01137477e-01f, 9.53580737e-01f, 9.21060979e-01f, 3.89418334e-01f, 9.92010653e-01f, 1.26154065e-01f,
  9.99200106e-01f, 3.99893336e-02f, 9.99920011e-01f, 1.26487734e-02f, 9.99992013e-01f, 3.99998948e-03f, 9.99999225e-01f, 1.26491068e-03f,
  2.83662200e-01f, -9.58924294e-01f, -1.03423381e-02f, 9.99946535e-01f, 8.77582550e-01f, 4.79425550e-01f, 9.87526000e-01f, 1.57455876e-01f,
  9.98750269e-01f, 4.99791652e-02f, 9.99875009e-01f, 1.58107281e-02f, 9.99987483e-01f, 4.99997940e-03f, 9.99998748e-01f, 1.58113812e-03f,
  9.60170269e-01f, -2.79415488e-01f, -3.20796400e-01f, 9.47148204e-01f, 8.25335622e-01f, 5.64642489e-01f, 9.82053936e-01f, 1.88600272e-01f,
  9.98200536e-01f, 5.99640049e-02f, 9.99819994e-01f, 1.89725272e-02f, 9.99981999e-01f, 5.99996420e-03f, 9.99998212e-01f, 1.89736532e-03f,
  7.53902256e-01f, 6.56986594e-01f, -5.99437475e-01f, 8.00421596e-01f, 7.64842212e-01f, 6.44217670e-01f, 9.75599885e-01f, 2.19556093e-01f,
  9.97551024e-01f, 6.99428469e-02f, 9.99755025e-01f, 2.21341345e-02f, 9.99975502e-01f, 6.99994294e-03f, 9.99997556e-01f, 2.21359241e-03f,
  -1.45500034e-01f, 9.89358246e-01f, -8.18632424e-01f, 5.74317753e-01f, 6.96706712e-01f, 7.17356086e-01f, 9.68170285e-01f, 2.50292331e-01f,
  9.96801734e-01f, 7.99146891e-02f, 9.99680042e-01f, 2.52955221e-02f, 9.99967992e-01f, 7.99991470e-03f, 9.99996781e-01f, 2.52981926e-03f,
  -9.11130250e-01f, 4.12118495e-01f, -9.56644177e-01f, 2.91259229e-01f, 6.21609926e-01f, 7.83326924e-01f, 9.59772646e-01f, 2.80778319e-01f,
  9.95952725e-01f, 8.98785442e-02f, 9.99595046e-01f, 2.84566563e-02f, 9.99959528e-01f, 8.99987947e-03f, 9.99995947e-01f, 2.84604589e-03f,
  -8.39071512e-01f, -5.44021130e-01f, -9.99786079e-01f, -2.06835698e-02f, 5.40302277e-01f, 8.41470957e-01f, 9.50415313e-01f, 3.10983568e-01f,
  9.95004177e-01f, 9.98334140e-02f, 9.99500036e-01f, 3.16175036e-02f, 9.99949992e-01f, 9.99983400e-03f, 9.99994993e-01f, 3.16227227e-03f,
  4.42569796e-03f, -9.99990225e-01f, -9.43779767e-01f, -3.30574960e-01f, 4.53596085e-01f, 8.91207397e-01f, 9.40107584e-01f, 3.40877861e-01f,
  9.93956089e-01f, 1.09778300e-01f, 9.99395072e-01f, 3.47780399e-02f, 9.99939501e-01f, 1.09997792e-02f, 9.99993920e-01f, 3.47849843e-03f,
  8.43853951e-01f, -5.36572933e-01f, -7.94179380e-01f, -6.07683420e-01f, 3.62357706e-01f, 9.32039082e-01f, 9.28859890e-01f, 3.70431304e-01f,
  9.92808640e-01f, 1.19712204e-01f, 9.99280095e-01f, 3.79382223e-02f, 9.99927998e-01f, 1.19997123e-02f, 9.99992788e-01f, 3.79472389e-03f,
  9.07446802e-01f, 4.20167029e-01f, -5.65820515e-01f, -8.24528456e-01f, 2.67498761e-01f, 9.63558197e-01f, 9.16683376e-01f, 3.99614304e-01f,
  9.91561890e-01f, 1.29634142e-01f, 9.99155104e-01f, 4.10980321e-02f, 9.99915481e-01f, 1.29996343e-02f, 9.99991536e-01f, 4.11094911e-03f,
  1.36737213e-01f, 9.90607381e-01f, -2.81349480e-01f, -9.59605396e-01f, 1.69967160e-01f, 9.85449731e-01f, 9.03590262e-01f, 4.28397775e-01f,
  9.90216017e-01f, 1.39543116e-01f, 9.99020159e-01f, 4.42574248e-02f, 9.99902010e-01f, 1.39995432e-02f, 9.99990225e-01f, 4.42717411e-03f,
  -7.59687901e-01f, 6.50287867e-01f, 3.10223512e-02f, -9.99518692e-01f, 7.07371980e-02f, 9.97494996e-01f, 8.89593601e-01f, 4.56752867e-01f,
  9.88771081e-01f, 1.49438128e-01f, 9.98875201e-01f, 4.74163815e-02f, 9.99887526e-01f, 1.49994381e-02f, 9.99988735e-01f, 4.74339863e-03f,
  -9.57659483e-01f, -2.87903309e-01f, 3.40318173e-01f, -9.40310359e-01f, -2.91995462e-02f, 9.99573588e-01f, 8.74707460e-01f, 4.84651238e-01f,
  9.87227261e-01f, 1.59318209e-01f, 9.98720288e-01f, 5.05748577e-02f, 9.99872029e-01f, 1.59993190e-02f, 9.99987185e-01f, 5.05962269e-03f,
  -2.75163352e-01f, -9.61397469e-01f, 6.15864813e-01f, -7.87851870e-01f, -1.28844544e-01f, 9.91664827e-01f, 8.58946681e-01f, 5.12064993e-01f,
  9.85584795e-01f, 1.69182345e-01f, 9.98555362e-01f, 5.37328273e-02f, 9.99855518e-01f, 1.69991814e-02f, 9.99985576e-01f, 5.37584582e-03f,
  6.60316706e-01f, -7.50987232e-01f, 8.30336154e-01f, -5.57262897e-01f, -2.27202162e-01f, 9.73847628e-01f, 8.42327058e-01f, 5.38966715e-01f,
  9.83843684e-01f, 1.79029569e-01f, 9.98380423e-01f, 5.68902642e-02f, 9.99837995e-01f, 1.79990288e-02f, 9.99983788e-01f, 5.69206895e-03f,
  9.88704622e-01f, 1.49877205e-01f, 9.62463796e-01f, -2.71410108e-01f, -3.23289543e-01f, 9.46300089e-01f, 8.24865162e-01f, 5.65329552e-01f,
  9.82004225e-01f, 1.88858896e-01f, 9.98195529e-01f, 6.00471310e-02f, 9.99819517e-01f, 1.89988576e-02f, 9.99981940e-01f, 6.00829115e-03f,
  4.08082068e-01f, 9.12945271e-01f, 9.99144375e-01f, 4.13582884e-02f, -4.16146845e-01f, 9.09297407e-01f, 8.06578457e-01f, 5.91127038e-01f,
  9.80066597e-01f, 1.98669314e-01f, 9.98000681e-01f, 6.32033944e-02f, 9.99800026e-01f, 1.99986678e-02f, 9.99979973e-01f, 6.32451288e-03f,
  -5.47729254e-01f, 8.36655617e-01f, 9.36740458e-01f, 3.50024760e-01f, -5.04846215e-01f, 8.63209307e-01f, 7.87485182e-01f, 6.16333544e-01f,
  9.78030920e-01f, 2.08459899e-01f, 9.97795820e-01f, 6.63590282e-02f, 9.99779522e-01f, 2.09984574e-02f, 9.99977946e-01f, 6.64073415e-03f,
  -9.99960840e-01f, -8.85130931e-03f, 7.81440377e-01f, 6.23979926e-01f, -5.88501155e-01f, 8.08496356e-01f, 7.67604589e-01f, 6.40923738e-01f,
  9.75897431e-01f, 2.18229622e-01f, 9.97581005e-01f, 6.95140064e-02f, 9.99758005e-01f, 2.19982266e-02f, 9.99975801e-01f, 6.95695449e-03f,
  -5.32833040e-01f, -8.46220434e-01f, 5.48645258e-01f, 8.36055279e-01f, -6.66275978e-01f, 7.45705247e-01f, 7.46956408e-01f, 6.64873064e-01f,
  9.73666370e-01f, 2.27977514e-01f, 9.97356176e-01f, 7.26682767e-02f, 9.99735534e-01f, 2.29979735e-02f, 9.99973536e-01f, 7.27317436e-03f,
  4.24179018e-01f, -9.05578375e-01f, 2.61441678e-01f, 9.65219259e-01f, -7.37393796e-01f, 6.75463140e-01f, 7.25561321e-01f, 6.88157499e-01f,
  9.71337974e-01f, 2.37702623e-01f, 9.97121394e-01f, 7.58218244e-02f, 9.99711990e-01f, 2.39976961e-02f, 9.99971211e-01f, 7.58939330e-03f,
  9.91202831e-01f, -1.32351756e-01f, -5.16893305e-02f, 9.98663187e-01f, -8.01143587e-01f, 5.98472118e-01f, 7.03440726e-01f, 7.10753918e-01f,
  9.68912423e-01f, 2.47403964e-01f, 9.96876657e-01f, 7.89746121e-02f, 9.99687493e-01f, 2.49973964e-02f, 9.99968767e-01f, 7.90561177e-03f,
  6.46919310e-01f, 7.62558460e-01f, -3.59694332e-01f, 9.33070183e-01f, -8.56888831e-01f, 5.15501261e-01f, 6.80616796e-01f, 7.32639611e-01f,
  9.66389954e-01f, 2.57080555e-01f, 9.96621907e-01f, 8.21266174e-02f, 9.99662042e-01f, 2.59970706e-02f, 9.99966204e-01f, 8.22182931e-03f,
  -2.92138815e-01f, 9.56375957e-01f, -6.32028639e-01f, 7.74945021e-01f, -9.04072165e-01f, 4.27379847e-01f, 6.57112300e-01f, 7.53792703e-01f,
  9.63770926e-01f, 2.66731411e-01f, 9.96357203e-01f, 8.52777958e-02f, 9.99635518e-01f, 2.69967206e-02f, 9.99963522e-01f, 8.53804592e-03f,
  -9.62605894e-01f, 2.70905793e-01f, -8.41684937e-01f, 5.39968967e-01f, -9.42222297e-01f, 3.34988207e-01f, 6.32950664e-01f, 7.74192095e-01f,
  9.61055458e-01f, 2.76355654e-01f, 9.96082544e-01f, 8.84281173e-02f, 9.99608040e-01f, 2.79963426e-02f, 9.99960780e-01f, 8.85426160e-03f,
  -7.48057544e-01f, -6.63633883e-01f, -9.67871487e-01f, 2.51445323e-01f, -9.70958173e-01f, 2.39249229e-01f, 6.08156204e-01f, 7.93817401e-01f,
  9.58243906e-01f, 2.85952210e-01f, 9.95797932e-01f, 9.15775672e-02f, 9.99579549e-01f, 2.89959367e-02f, 9.99957979e-01f, 9.17047635e-03f,
  1.54251456e-01f, -9.88031626e-01f, -9.98075247e-01f, -6.20148405e-02f, -9.89992499e-01f, 1.41120002e-01f, 5.82753658e-01f, 8.12648892e-01f,
  9.55336511e-01f, 2.95520186e-01f, 9.95503366e-01f, 9.47260931e-02f, 9.99550045e-01f, 2.99955010e-02f, 9.99954998e-01f, 9.48669016e-03f,
  9.14742351e-01f, -4.04037654e-01f, -9.29300308e-01f, -3.69325012e-01f, -9.99135137e-01f, 4.15805206e-02f, 5.56768358e-01f, 8.30667794e-01f,
  9.52333570e-01f, 3.05058628e-01f, 9.95198846e-01f, 9.78736654e-02f, 9.99519527e-01f, 3.09950355e-02f, 9.99951959e-01f, 9.80290305e-03f,
  8.34223390e-01f, 5.51426709e-01f, -7.68367112e-01f, -6.40009403e-01f, -9.98294771e-01f, -5.83741926e-02f, 5.30226350e-01f, 8.47856104e-01f,
  9.49235439e-01f, 3.14566553e-01f, 9.94884372e-01f, 1.01020269e-01f, 9.99488056e-01f, 3.19945402e-02f, 9.99948800e-01f, 1.01191159e-02f,
  -1.32767474e-02f, 9.99911845e-01f, -5.31235278e-01f, -8.47224355e-01f, -9.87479806e-01f, -1.57745644e-01f, 5.03154159e-01f, 8.64196658e-01f,
  9.46042359e-01f, 3.24043006e-01f, 9.94559944e-01f, 1.04165860e-01f, 9.99455571e-01f, 3.29940096e-02f, 9.99945521e-01f, 1.04353270e-02f,
  -8.48570287e-01f, 5.29082716e-01f, -2.41421118e-01f, -9.70420420e-01f, -9.66798186e-01f, -2.55541205e-01f, 4.75578904e-01f, 8.79673064e-01f,
  9.42754686e-01f, 3.33487093e-01f, 9.94225562e-01f, 1.07310407e-01f, 9.99422073e-01f, 3.39934528e-02f, 9.99942183e-01f, 1.07515370e-02f,
  -9.03692186e-01f, -4.28182662e-01f, 7.23346695e-02f, -9.97380435e-01f, -9.36456680e-01f, -3.50783229e-01f, 4.47528064e-01f, 8.94269884e-01f,
  9.39372718e-01f, 3.42897803e-01f, 9.93881226e-01f, 1.10453881e-01f, 9.99387562e-01f, 3.49928550e-02f, 9.99938726e-01f, 1.10677453e-02f,
  -1.27963692e-01f, -9.91778851e-01f, 3.78916174e-01f, -9.25431013e-01f, -8.96758378e-01f, -4.42520559e-01f, 4.19029742e-01f, 9.07972515e-01f,
  9.35896814e-01f, 3.52274209e-01f, 9.93526995e-01f, 1.13596253e-01f, 9.99352098e-01f, 3.59922275e-02f, 9.99935210e-01f, 1.13839535e-02f,
  7.65414059e-01f, -6.43538117e-01f, 6.47921681e-01f, -7.61706948e-01f, -8.48100007e-01f, -5.29836178e-01f, 3.90112430e-01f, 9.20767248e-01f,
  9.32327330e-01f, 3.61615449e-01f, 9.93162811e-01f, 1.16737492e-01f, 9.99315560e-01f, 3.69915590e-02f, 9.99931574e-01f, 1.17001599e-02f,
  9.55073655e-01f, 2.96368569e-01f, 8.52673113e-01f, -5.22444785e-01f, -7.90967762e-01f, -6.11857831e-01f, 3.60805035e-01f, 9.32641268e-01f,
  9.28664625e-01f, 3.70920479e-01f, 9.92788672e-01f, 1.19877554e-01f, 9.99278069e-01f, 3.79908569e-02f, 9.99927819e-01f, 1.20163653e-02f,
  2.66642928e-01f, 9.63795364e-01f, 9.72865343e-01f, -2.31372014e-01f, -7.25932240e-01f, -6.87766254e-01f, 3.31136853e-01f, 9.43582714e-01f,
  9.24909055e-01f, 3.80188406e-01f, 9.92404640e-01f, 1.23016424e-01f, 9.99239624e-01f, 3.89901139e-02f, 9.99923944e-01f, 1.23325698e-02f,
  -6.66938066e-01f, 7.45113134e-01f, 9.96578991e-01f, 8.26458037e-02f, -6.53643608e-01f, -7.56802499e-01f, 3.01137596e-01f, 9.53580678e-01f,
  9.21060979e-01f, 3.89418334e-01f, 9.92010653e-01f, 1.26154065e-01f, 9.99200106e-01f, 3.99893373e-02f, 9.99920011e-01f, 1.26487734e-02f,
  -9.87339258e-01f, -1.58622667e-01f, 9.21462357e-01f, 3.88467699e-01f, -5.74824035e-01f, -8.18277061e-01f, 2.70837069e-01f, 9.62625206e-01f,
  9.17120814e-01f, 3.98609310e-01f, 9.91606772e-01f, 1.29290432e-01f, 9.99159634e-01f, 4.09885161e-02f, 9.99915957e-01f, 1.29649751e-02f,
  -3.99985313e-01f, -9.16521549e-01f, 7.54965365e-01f, 6.55764699e-01f, -4.90260571e-01f, -8.71575892e-01f, 2.40265876e-01f, 9.70707119e-01f,
  9.13088918e-01f, 4.07760441e-01f, 9.91192937e-01f, 1.32425532e-01f, 9.99118149e-01f, 4.19876575e-02f, 9.99911785e-01f, 1.32811759e-02f,
  5.55113316e-01f, -8.31774771e-01f, 5.13598442e-01f, 8.58030677e-01f, -4.00799006e-01f, -9.16166008e-01f, 2.09454417e-01f, 9.77818429e-01f,
  9.08965766e-01f, 4.16870773e-01f, 9.90769207e-01f, 1.35559291e-01f, 9.99075651e-01f, 4.29867506e-02f, 9.99907553e-01f, 1.35973748e-02f,
  9.99843299e-01f, 1.77019257e-02f, 2.21298173e-01f, 9.75206196e-01f, -3.07332784e-01f, -9.51602101e-01f, 1.78433523e-01f, 9.83951986e-01f,
  9.04751658e-01f, 4.25939471e-01f, 9.90335584e-01f, 1.38691694e-01f, 9.99032140e-01f, 4.39858064e-02f, 9.99903202e-01f, 1.39135728e-02f,
  5.25321960e-01f, 8.50903511e-01f, -9.29481089e-02f, 9.95670974e-01f, -2.10795805e-01f, -9.77530122e-01f, 1.47234216e-01f, 9.89101648e-01f,
  9.00447130e-01f, 4.34965521e-01f, 9.89892066e-01f, 1.41822711e-01f, 9.98987675e-01f, 4.49848175e-02f, 9.99898732e-01f, 1.42297689e-02f,
  -4.32177931e-01f, 9.01788354e-01f, -3.97976756e-01f, 9.17395473e-01f, -1.12152621e-01f, -9.93690968e-01f, 1.15887694e-01f, 9.93262351e-01f,
  8.96052480e-01f, 4.43948090e-01f, 9.89438653e-01f, 1.44952312e-01f, 9.98942196e-01f, 4.59837839e-02f, 9.99894202e-01f, 1.45459641e-02f,
  -9.92335498e-01f, 1.23573124e-01f, -6.63538277e-01f, 7.48142362e-01f, -1.23883775e-02f, -9.99923289e-01f, 8.44252855e-02f, 9.96429801e-01f,
  8.91568303e-01f, 4.52886283e-01f, 9.88975346e-01f, 1.48080453e-01f, 9.98895705e-01f, 4.69827019e-02f, 9.99889553e-01f, 1.48621574e-02f,
  -6.40144348e-01f, -7.68254638e-01f, -8.63296509e-01f, 5.04697084e-01f, 8.74991715e-02f, -9.96164620e-01f, 5.28784581e-02f, 9.98600960e-01f,
  8.86994898e-01f, 4.61779177e-01f, 9.88502085e-01f, 1.51207119e-01f, 9.98848200e-01f, 4.79815714e-02f, 9.99884784e-01f, 1.51783489e-02f,
  3.00592542e-01f, -9.53752637e-01f, -9.77442741e-01f, 2.11200655e-01f, 1.86512470e-01f, -9.82452571e-01f, 2.12787576e-02f, 9.99773562e-01f,
  8.82332861e-01f, 4.70625877e-01f, 9.88018990e-01f, 1.54332280e-01f, 9.98799741e-01f, 4.89803962e-02f, 9.99879956e-01f, 1.54945394e-02f,
  9.64965999e-01f, -2.62374848e-01f, -9.94656444e-01f, -1.03240460e-01f, 2.83662200e-01f, -9.58924294e-01f, -1.03422189e-02f, 9.99946535e-01f,
  8.77582550e-01f, 4.79425550e-01f, 9.87526000e-01f, 1.57455891e-01f, 9.98750269e-01f, 4.99791689e-02f, 9.99875009e-01f, 1.58107281e-02f,
  7.42154181e-01f, 6.70229197e-01f, -9.13230121e-01f, -4.07444149e-01f, 3.77977669e-01f, -9.25814748e-01f, -4.19528559e-02f, 9.99119580e-01f,
  8.72744501e-01f, 4.88177240e-01f, 9.87023175e-01f, 1.60577938e-01f, 9.98699784e-01f, 5.09778969e-02f, 9.99869943e-01f, 1.61269177e-02f,
  -1.62990779e-01f, 9.86627579e-01f, -7.41239965e-01f, -6.71240151e-01f, 4.68516916e-01f, -8.83454502e-01f, -7.35215396e-02f, 9.97293651e-01f,
  8.67819190e-01f, 4.96880114e-01f, 9.86510456e-01f, 1.63698375e-01f, 9.98648286e-01f, 5.19765690e-02f, 9.99864817e-01f, 1.64431017e-02f,
  -9.18282807e-01f, 3.95925164e-01f, -4.95741814e-01f, -8.68469954e-01f, 5.54374516e-01f, -8.32267344e-01f, -1.05016708e-01f, 9.94470477e-01f,
  8.62807095e-01f, 5.05533338e-01f, 9.85987842e-01f, 1.66817173e-01f, 9.98595834e-01f, 5.29751927e-02f, 9.99859571e-01f, 1.67592876e-02f,
  -8.29309821e-01f, -5.58789074e-01f, -2.01079622e-01f, -9.79574919e-01f, 6.34692967e-01f, -7.72764444e-01f, -1.36406869e-01f, 9.90652919e-01f,
  8.57708693e-01f, 5.14135957e-01f, 9.85455394e-01f, 1.69934288e-01f, 9.98542368e-01f, 5.39737605e-02f, 9.99854207e-01f, 1.70754679e-02f,
  2.21267566e-02f, -9.99755144e-01f, 1.13521777e-01f, -9.93535519e-01f, 7.08669782e-01f, -7.05540299e-01f, -1.67660639e-01f, 9.85844791e-01f,
  8.52524519e-01f, 5.22687256e-01f, 9.84913111e-01f, 1.73049718e-01f, 9.98487890e-01f, 5.49722798e-02f, 9.99848783e-01f, 1.73916500e-02f,
  8.53220105e-01f, -5.21551013e-01f, 4.16867077e-01f, -9.08967435e-01f, 7.75565803e-01f, -6.31266713e-01f, -1.98746875e-01f, 9.80050862e-01f,
  8.47255111e-01f, 5.31186223e-01f, 9.84360933e-01f, 1.76163420e-01f, 9.98432398e-01f, 5.59707358e-02f, 9.99843180e-01f, 1.77078284e-02f,
  8.99866819e-01f, 4.36164767e-01f, 6.78870201e-01f, -7.34258294e-01f, 8.34712923e-01f, -5.50685287e-01f, -2.29634270e-01f, 9.73276973e-01f,
  8.41901004e-01f, 5.39632022e-01f, 9.83798921e-01f, 1.79275364e-01f, 9.98375952e-01f, 5.69691435e-02f, 9.99837577e-01f, 1.80240069e-02f,
  1.19180135e-01f, 9.92872655e-01f, 8.73550534e-01f, -4.86733496e-01f, 8.85519624e-01f, -4.64602023e-01f, -2.60292053e-01f, 9.65529919e-01f,
  8.36462677e-01f, 5.48023939e-01f, 9.83227074e-01f, 1.82385504e-01f, 9.98318493e-01f, 5.79674877e-02f, 9.99831796e-01f, 1.83401816e-02f,
  -7.71080196e-01f, 6.36738002e-01f, 9.81602073e-01f, -1.90938011e-01f, 9.27478492e-01f, -3.73876572e-01f, -2.90689558e-01f, 9.56817448e-01f,
  8.30940723e-01f, 5.56361020e-01f, 9.82645452e-01f, 1.85493827e-01f, 9.98260021e-01f, 5.89657798e-02f, 9.99825954e-01f, 1.86563563e-02f,
  -9.52412963e-01f, -3.04810613e-01f, 9.92308319e-01f, 1.23790950e-01f, 9.60170269e-01f, -2.79415488e-01f, -3.20796400e-01f, 9.47148204e-01f,
  8.25335622e-01f, 5.64642429e-01f, 9.82053936e-01f, 1.88600287e-01f, 9.98200536e-01f, 5.99640086e-02f, 9.99819994e-01f, 1.89725272e-02f,
  -2.58101642e-01f, -9.66117799e-01f, 9.04607594e-01f, 4.26245421e-01f, 9.83268440e-01f, -1.82162598e-01f, -3.50582451e-01f, 9.36531842e-01f,
  8.19648027e-01f, 5.72867453e-01f, 9.81452644e-01f, 1.91704854e-01f, 9.98140097e-01f, 6.09621815e-02f, 9.99813974e-01f, 1.92886982e-02f,
  6.73507154e-01f, -7.39180684e-01f, 7.27198064e-01f, 6.86427653e-01f, 9.96542096e-01f, -8.30891207e-02f, -3.80017966e-01f, 9.24979091e-01f,
  8.13878477e-01f, 5.81035137e-01f, 9.80841517e-01f, 1.94807529e-01f, 9.98078644e-01f, 6.19602874e-02f, 9.99807835e-01f, 1.96048655e-02f,
  9.85896587e-01f, 1.67355701e-01f, 4.77671444e-01f, 8.78538549e-01f, 9.99858618e-01f, 1.68140903e-02f, -4.09073502e-01f, 9.12501454e-01f,
  8.08027506e-01f, 5.89144766e-01f, 9.80220556e-01f, 1.97908238e-01f, 9.98016179e-01f, 6.29583374e-02f, 9.99801576e-01f, 1.99210308e-02f,
};
__device__ const float TAB_S[2048] = {
  1.00000000e+00f, 0.00000000e+00f, 1.00000000e+00f, 0.00000000e+00f, 1.00000000e+00f, 0.00000000e+00f, 1.00000000e+00f, 0.00000000e+00f,
  1.00000000e+00f, 0.00000000e+00f, 1.00000000e+00f, 0.00000000e+00f, 1.00000000e+00f, 0.00000000e+00f, 1.00000000e+00f, 0.00000000e+00f,
  1.00000000e+00f, 0.00000000e+00f, 1.00000000e+00f, 0.00000000e+00f, 1.00000000e+00f, 0.00000000e+00f, 1.00000000e+00f, 0.00000000e+00f,
  1.00000000e+00f, 0.00000000e+00f, 1.00000000e+00f, 0.00000000e+00f, 1.00000000e+00f, 0.00000000e+00f, 1.00000000e+00f, 0.00000000e+00f,
  5.40302277e-01f, 8.41470957e-01f, 8.46009135e-01f, 5.33168435e-01f, 9.50415254e-01f, 3.10983598e-01f, 9.84230220e-01f, 1.76892191e-01f,
  9.95004177e-01f, 9.98334214e-02f, 9.98419285e-01f, 5.62044978e-02f, 9.99500036e-01f, 3.16175036e-02f, 9.99841869e-01f, 1.77818574e-02f,
  9.99949992e-01f, 9.99983307e-03f, 9.99984205e-01f, 5.62338345e-03f, 9.99994993e-01f, 3.16227227e-03f, 9.99998391e-01f, 1.77827850e-03f,
  9.99999523e-01f, 9.99999931e-04f, 9.99999821e-01f, 5.62341243e-04f, 9.99999940e-01f, 3.16227757e-04f, 1.00000000e+00f, 1.77827940e-04f,
  -4.16146845e-01f, 9.09297407e-01f, 4.31462824e-01f, 9.02130723e-01f, 8.06578398e-01f, 5.91127098e-01f, 9.37418282e-01f, 3.48205268e-01f,
  9.80066597e-01f, 1.98669329e-01f, 9.93682086e-01f, 1.12231314e-01f, 9.98000681e-01f, 6.32033944e-02f, 9.99367595e-01f, 3.55580896e-02f,
  9.99800026e-01f, 1.99986659e-02f, 9.99936759e-01f, 1.12465890e-02f, 9.99979973e-01f, 6.32451288e-03f, 9.99993682e-01f, 3.55655141e-03f,
  9.99997973e-01f, 1.99999870e-03f, 9.99999344e-01f, 1.12468237e-03f, 9.99999821e-01f, 6.32455456e-04f, 9.99999940e-01f, 3.55655880e-04f,
  -9.89992499e-01f, 1.41120002e-01f, -1.15966164e-01f, 9.93253171e-01f, 5.82753658e-01f, 8.12648892e-01f, 8.61040652e-01f, 5.08536100e-01f,
  9.55336511e-01f, 2.95520216e-01f, 9.85803485e-01f, 1.67903304e-01f, 9.95503366e-01f, 9.47260857e-02f, 9.98577297e-01f, 5.33230826e-02f,
  9.99550045e-01f, 2.99954992e-02f, 9.99857724e-01f, 1.68694388e-02f, 9.99954998e-01f, 9.48669016e-03f, 9.99985754e-01f, 5.33481315e-03f,
  9.99995530e-01f, 2.99999560e-03f, 9.99998569e-01f, 1.68702309e-03f, 9.99999523e-01f, 9.48683126e-04f, 9.99999881e-01f, 5.33483806e-04f,
  -6.53643608e-01f, -7.56802499e-01f, -6.27679706e-01f, 7.78471708e-01f, 3.01137477e-01f, 9.53580737e-01f, 7.57506192e-01f, 6.52827978e-01f,
  9.21060979e-01f, 3.89418334e-01f, 9.74808276e-01f, 2.23044485e-01f, 9.92010653e-01f, 1.26154065e-01f, 9.97471273e-01f, 7.10712075e-02f,
  9.99200106e-01f, 3.99893336e-02f, 9.99747038e-01f, 2.24917568e-02f, 9.99920011e-01f, 1.26487734e-02f, 9.99974728e-01f, 7.11305765e-03f,
  9.99992013e-01f, 3.99998948e-03f, 9.99997497e-01f, 2.24936334e-03f, 9.99999225e-01f, 1.26491068e-03f, 9.99999762e-01f, 7.11311703e-04f,
  2.83662200e-01f, -9.58924294e-01f, -9.46079254e-01f, 3.23935270e-01f, -1.03423381e-02f, 9.99946535e-01f, 6.30080283e-01f, 7.76529968e-01f,
  8.77582550e-01f, 4.79425550e-01f, 9.60731268e-01f, 2.77480543e-01f, 9.87526000e-01f, 1.57455876e-01f, 9.96049762e-01f, 8.87968615e-02f,
  9.98750269e-01f, 4.99791652e-02f, 9.99604762e-01f, 2.81133614e-02f, 9.99875009e-01f, 1.58107281e-02f, 9.99960482e-01f, 8.89127981e-03f,
  9.99987483e-01f, 4.99997940e-03f, 9.99996066e-01f, 2.81170290e-03f, 9.99998748e-01f, 1.58113812e-03f, 9.99999583e-01f, 8.89139599e-04f,
  9.60170269e-01f, -2.79415488e-01f, -9.73103702e-01f, -2.30367512e-01f, -3.20796400e-01f, 9.47148204e-01f, 4.82782036e-01f, 8.75740528e-01f,
  8.25335622e-01f, 5.64642489e-01f, 9.43616986e-01f, 3.31039310e-01f, 9.82053936e-01f, 1.88600272e-01f, 9.94313300e-01f, 1.06494442e-01f,
  9.98200536e-01f, 5.99640049e-02f, 9.99430835e-01f, 3.37340795e-02f, 9.99819994e-01f, 1.89725272e-02f, 9.99943078e-01f, 1.06694745e-02f,
  9.99981999e-01f, 5.99996420e-03f, 9.99994338e-01f, 3.37404152e-03f, 9.99998212e-01f, 1.89736532e-03f, 9.99999404e-01f, 1.06696738e-03f,
  7.53902256e-01f, 6.56986594e-01f, -7.00429797e-01f, -7.13721275e-01f, -5.99437475e-01f, 8.00421596e-01f, 3.20257008e-01f, 9.47330713e-01f,
  7.64842212e-01f, 6.44217670e-01f, 9.23519433e-01f, 3.83551568e-01f, 9.75599885e-01f, 2.19556093e-01f, 9.92262423e-01f, 1.24158338e-01f,
  9.97551024e-01f, 6.99428469e-02f, 9.99225318e-01f, 3.93537246e-02f, 9.99755025e-01f, 2.21341345e-02f, 9.99922514e-01f, 1.24476347e-02f,
  9.99975502e-01f, 6.99994294e-03f, 9.99992251e-01f, 3.93637875e-03f, 9.99997556e-01f, 2.21359241e-03f, 9.99999225e-01f, 1.24479528e-03f,
  -1.45500034e-01f, 9.89358246e-01f, -2.12036446e-01f, -9.77261782e-01f, -8.18632424e-01f, 5.74317753e-01f, 1.47631213e-01f, 9.89042461e-01f,
  6.96706712e-01f, 7.17356086e-01f, 9.00502324e-01f, 4.34851229e-01f, 9.68170285e-01f, 2.50292331e-01f, 9.89897788e-01f, 1.41782969e-01f,
  9.96801734e-01f, 7.99146891e-02f, 9.98988271e-01f, 4.49721329e-02f, 9.99680042e-01f, 2.52955221e-02f, 9.99898791e-01f, 1.42257558e-02f,
  9.99967992e-01f, 7.99991470e-03f, 9.99989867e-01f, 4.49871505e-03f, 9.99996781e-01f, 2.52981926e-03f, 9.99998987e-01f, 1.42262306e-03f,
  -9.11130250e-01f, 4.12118495e-01f, 3.41660261e-01f, -9.39823508e-01f, -9.56644177e-01f, 2.91259229e-01f, -2.96507962e-02f, 9.99560297e-01f,
  6.21609926e-01f, 7.83326924e-01f, 8.74638259e-01f, 4.84776139e-01f, 9.59772646e-01f, 2.80778319e-01f, 9.87220109e-01f, 1.59362778e-01f,
  9.95952725e-01f, 8.98785442e-02f, 9.98719573e-01f, 5.05891182e-02f, 9.99595046e-01f, 2.84566563e-02f, 9.99871910e-01f, 1.60038304e-02f,
  9.99959528e-01f, 8.99987947e-03f, 9.99987185e-01f, 5.06105041e-03f, 9.99995947e-01f, 2.84604589e-03f, 9.99998748e-01f, 1.60045072e-03f,
  -8.39071512e-01f, -5.44021130e-01f, 7.90131867e-01f, -6.12936914e-01f, -9.99786079e-01f, -2.06835698e-02f, -2.05997631e-01f, 9.78552461e-01f,
  5.40302277e-01f, 8.41470957e-01f, 8.46009135e-01f, 5.33168435e-01f, 9.50415313e-01f, 3.10983568e-01f, 9.84230220e-01f, 1.76892191e-01f,
  9.95004177e-01f, 9.98334140e-02f, 9.98419285e-01f, 5.62044978e-02f, 9.99500036e-01f, 3.16175036e-02f, 9.99841869e-01f, 1.77818574e-02f,
  9.99949992e-01f, 9.99983400e-03f, 9.99984205e-01f, 5.62338345e-03f, 9.99994993e-01f, 3.16227227e-03f, 9.99998391e-01f, 1.77827850e-03f,
  4.42569796e-03f, -9.99990225e-01f, 9.95257378e-01f, -9.72764567e-02f, -9.43779767e-01f, -3.30574960e-01f, -3.75847399e-01f, 9.26681578e-01f,
  4.53596085e-01f, 8.91207397e-01f, 8.14705312e-01f, 5.79875171e-01f, 9.40107584e-01f, 3.40877861e-01f, 9.80929136e-01f, 1.94365650e-01f,
  9.93956089e-01f, 1.09778300e-01f, 9.98087406e-01f, 6.18181042e-02f, 9.99395072e-01f, 3.47780399e-02f, 9.99808669e-01f, 1.95598267e-02f,
  9.99939501e-01f, 1.09997792e-02f, 9.99980867e-01f, 6.18571462e-03f, 9.99993920e-01f, 3.47849843e-03f, 9.99998093e-01f, 1.95610616e-03f,
  8.43853951e-01f, -5.36572933e-01f, 8.93861592e-01f, 4.48342979e-01f, -7.94179380e-01f, -6.07683420e-01f, -5.33843040e-01f, 8.45583618e-01f,
  3.62357706e-01f, 9.32039082e-01f, 7.80825913e-01f, 6.24748647e-01f, 9.28859890e-01f, 3.70431304e-01f, 9.77317870e-01f, 2.11777672e-01f,
  9.92808640e-01f, 1.19712204e-01f, 9.97723997e-01f, 6.74297586e-02f, 9.99280095e-01f, 3.79382223e-02f, 9.99772310e-01f, 2.13377345e-02f,
  9.99927998e-01f, 1.19997123e-02f, 9.99977231e-01f, 6.74804440e-03f, 9.99992788e-01f, 3.79472389e-03f, 9.99997735e-01f, 2.13393359e-03f,
  9.07446802e-01f, 4.20167029e-01f, 5.17172873e-01f, 8.55880976e-01f, -5.65820515e-01f, -8.24528456e-01f, -6.75001681e-01f, 7.37816215e-01f,
  2.67498761e-01f, 9.63558197e-01f, 7.44477987e-01f, 6.67647004e-01f, 9.16683376e-01f, 3.99614304e-01f, 9.73397553e-01f, 2.29122713e-01f,
  9.91561890e-01f, 1.29634142e-01f, 9.97329056e-01f, 7.30392784e-02f, 9.99155104e-01f, 4.10980321e-02f, 9.99732792e-01f, 2.31155735e-02f,
  9.99915481e-01f, 1.29996343e-02f, 9.99973297e-01f, 7.31037185e-03f, 9.99991536e-01f, 4.11094911e-03f, 9.99997318e-01f, 2.31176103e-03f,
  1.36737213e-01f, 9.90607381e-01f, -1.87961515e-02f, 9.99823332e-01f, -2.81349480e-01f, -9.59605396e-01f, -7.94870913e-01f, 6.06778562e-01f,
  1.69967160e-01f, 9.85449731e-01f, 7.05776393e-01f, 7.08434701e-01f, 9.03590262e-01f, 4.28397775e-01f, 9.69169438e-01f, 2.46395305e-01f,
  9.90216017e-01f, 1.39543116e-01f, 9.96902585e-01f, 7.86464810e-02f, 9.99020159e-01f, 4.42574248e-02f, 9.99690115e-01f, 2.48933397e-02f,
  9.99902010e-01f, 1.39995432e-02f, 9.99969006e-01f, 7.87269697e-03f, 9.99990225e-01f, 4.42717411e-03f, 9.99996901e-01f, 2.48958869e-03f,
  -7.59687901e-01f, 6.50287867e-01f, -5.48975468e-01f, 8.35838437e-01f, 3.10223512e-02f, -9.99518692e-01f, -8.89670432e-01f, 4.56603259e-01f,
  7.07371980e-02f, 9.97494996e-01f, 6.64843500e-01f, 7.46982634e-01f, 8.89593601e-01f, 4.56752867e-01f, 9.64634836e-01f, 2.63589978e-01f,
  9.88771081e-01f, 1.49438128e-01f, 9.96444523e-01f, 8.42512026e-02f, 9.98875201e-01f, 4.74163815e-02f, 9.99644279e-01f, 2.66710296e-02f,
  9.99887526e-01f, 1.49994381e-02f, 9.99964416e-01f, 8.43502022e-03f, 9.99988735e-01f, 4.74339863e-03f, 9.99996424e-01f, 2.66741589e-03f,
  -9.57659483e-01f, -2.87903309e-01f, -9.10081089e-01f, 4.14430231e-01f, 3.40318173e-01f, -9.40310359e-01f, -9.56410050e-01f, 2.92027086e-01f,
  -2.91995462e-02f, 9.99573588e-01f, 6.21808827e-01f, 7.83169091e-01f, 8.74707460e-01f, 4.84651238e-01f, 9.59795177e-01f, 2.80701309e-01f,
  9.87227261e-01f, 1.59318209e-01f, 9.95954990e-01f, 8.98532644e-02f, 9.98720288e-01f, 5.05748577e-02f, 9.99595284e-01f, 2.84486320e-02f,
  9.99872029e-01f, 1.59993190e-02f, 9.99959528e-01f, 8.99733976e-03f, 9.99987185e-01f, 5.05962269e-03f, 9.99995947e-01f, 2.84524332e-03f,
  -2.75163352e-01f, -9.61397469e-01f, -9.90897954e-01f, -1.34615138e-01f, 6.15864813e-01f, -7.87851870e-01f, -9.92985010e-01f, 1.18240520e-01f,
  -1.28844544e-01f, 9.91664827e-01f, 5.76808274e-01f, 8.16879570e-01f, 8.58946681e-01f, 5.12064993e-01f, 9.54652011e-01f, 2.97723860e-01f,
  9.85584795e-01f, 1.69182345e-01f, 9.95433986e-01f, 9.54524800e-02f, 9.98555362e-01f, 5.37328273e-02f, 9.99543071e-01f, 3.02261449e-02f,
  9.99855518e-01f, 1.69991814e-02f, 9.99954283e-01f, 9.55965649e-03f, 9.99985576e-01f, 5.37584582e-03f, 9.99995410e-01f, 3.02307028e-03f,
  6.60316706e-01f, -7.50987232e-01f, -7.66536534e-01f, -6.42200708e-01f, 8.30336154e-01f, -5.57262897e-01f, -9.98241663e-01f, -5.92755191e-02f,
  -2.27202162e-01f, 9.73847628e-01f, 5.29984176e-01f, 8.48007560e-01f, 8.42327058e-01f, 5.38966715e-01f, 9.49207008e-01f, 3.14652264e-01f,
  9.83843684e-01f, 1.79029569e-01f, 9.94881511e-01f, 1.01048686e-01f, 9.98380423e-01f, 5.68902642e-02f, 9.99487758e-01f, 3.20035629e-02f,
  9.99837995e-01f, 1.79990288e-02f, 9.99948800e-01f, 1.01219704e-02f, 9.99983788e-01f, 5.69206895e-03f, 9.99994874e-01f, 3.20089748e-03f,
  9.88704622e-01f, 1.49877205e-01f, -3.06095392e-01f, -9.52000856e-01f, 9.62463796e-01f, -2.71410108e-01f, -9.72014248e-01f, -2.34921798e-01f,
  -3.23289543e-01f, 9.46300089e-01f, 4.81484592e-01f, 8.76454532e-01f, 8.24865162e-01f, 5.65329552e-01f, 9.43461835e-01f, 3.31481189e-01f,
  9.82004225e-01f, 1.88858896e-01f, 9.94297504e-01f, 1.06641680e-01f, 9.98195529e-01f, 6.00471310e-02f, 9.99429286e-01f, 3.37808803e-02f,
  9.99819517e-01f, 1.89988576e-02f, 9.99942899e-01f, 1.06842816e-02f, 9.99981940e-01f, 6.00829115e-03f, 9.99994278e-01f, 3.37872445e-03f,
  4.08082068e-01f, 9.12945271e-01f, 2.48616725e-01f, -9.68601942e-01f, 9.99144375e-01f, 4.13582884e-02f, -9.15129960e-01f, -4.03158993e-01f,
  -4.16146845e-01f, 9.09297407e-01f, 4.31462824e-01f, 9.02130723e-01f, 8.06578457e-01f, 5.91127038e-01f, 9.37418282e-01f, 3.48205268e-01f,
  9.80066597e-01f, 1.98669314e-01f, 9.93682086e-01f, 1.12231314e-01f, 9.98000681e-01f, 6.32033944e-02f, 9.99367595e-01f, 3.55580896e-02f,
  9.99800026e-01f, 1.99986678e-02f, 9.99936759e-01f, 1.12465890e-02f, 9.99979973e-01f, 6.32451288e-03f, 9.99993682e-01f, 3.55655141e-03f,
  -5.47729254e-01f, 8.36655617e-01f, 7.26760268e-01f, -6.86891198e-01f, 9.36740458e-01f, 3.50024760e-01f, -8.29382956e-01f, -5.58680534e-01f,
  -5.04846215e-01f, 8.63209307e-01f, 3.80077004e-01f, 9.24954832e-01f, 7.87485182e-01f, 6.16333544e-01f, 9.31078374e-01f, 3.64819258e-01f,
  9.78030920e-01f, 2.08459899e-01f, 9.93035257e-01f, 1.17817394e-01f, 9.97795820e-01f, 6.63590282e-02f, 9.99302804e-01f, 3.73351872e-02f,
  9.99779522e-01f, 2.09984574e-02f, 9.99930263e-01f, 1.18088927e-02f, 9.99977946e-01f, 6.64073415e-03f, 9.99993026e-01f, 3.73437814e-03f,
  -9.99960840e-01f, -8.85130931e-03f, 9.81074572e-01f, -1.93630233e-01f, 7.81440377e-01f, 6.23979926e-01f, -7.17477441e-01f, -6.96581721e-01f,
  -5.88501155e-01f, 8.08496356e-01f, 3.27489585e-01f, 9.44854796e-01f, 7.67604589e-01f, 6.40923738e-01f, 9.24443960e-01f, 3.81317884e-01f,
  9.75897431e-01f, 2.18229622e-01f, 9.92357016e-01f, 1.23399742e-01f, 9.97581005e-01f, 6.95140064e-02f, 9.99234855e-01f, 3.91121693e-02f,
  9.99758005e-01f, 2.19982266e-02f, 9.99923468e-01f, 1.23711927e-02f, 9.99975801e-01f, 6.95695449e-03f, 9.99992371e-01f, 3.91220488e-03f,
  -5.32833040e-01f, -8.46220434e-01f, 9.33235765e-01f, 3.59264523e-01f, 5.48645258e-01f, 8.36055279e-01f, -5.82943261e-01f, -8.12512875e-01f,
  -6.66275978e-01f, 7.45705247e-01f, 2.73866832e-01f, 9.61767614e-01f, 7.46956408e-01f, 6.64873064e-01f, 9.17517304e-01f, 3.97695929e-01f,
  9.73666370e-01f, 2.27977514e-01f, 9.91647422e-01f, 1.28978193e-01f, 9.97356176e-01f, 7.26682767e-02f, 9.99163687e-01f, 4.08890247e-02f,
  9.99735534e-01f, 2.29979735e-02f, 9.99916375e-01f, 1.29334899e-02f, 9.99973536e-01f, 7.27317436e-03f, 9.99991655e-01f, 4.09003161e-03f,
  4.24179018e-01f, -9.05578375e-01f, 5.97977161e-01f, 8.01513135e-01f, 2.61441678e-01f, 9.65219259e-01f, -4.30023283e-01f, -9.02817786e-01f,
  -7.37393796e-01f, 6.75463140e-01f, 2.19378278e-01f, 9.75639880e-01f, 7.25561321e-01f, 6.88157499e-01f, 9.10300434e-01f, 4.13948208e-01f,
  9.71337974e-01f, 2.37702623e-01f, 9.90906477e-01f, 1.34552568e-01f, 9.97121394e-01f, 7.58218244e-02f, 9.99089420e-01f, 4.26657498e-02f,
  9.99711990e-01f, 2.39976961e-02f, 9.99908924e-01f, 1.34957815e-02f, 9.99971211e-01f, 7.58939330e-03f, 9.99990880e-01f, 4.26785741e-03f,
  9.91202831e-01f, -1.32351756e-01f, 7.85522610e-02f, 9.96909976e-01f, -5.16893305e-02f, 9.98663187e-01f, -2.63540596e-01f, -9.64648306e-01f,
  -8.01143587e-01f, 5.98472118e-01f, 1.64196163e-01f, 9.86427724e-01f, 7.03440726e-01f, 7.10753918e-01f, 9.02795732e-01f, 4.30069596e-01f,
  9.68912423e-01f, 2.47403964e-01f, 9.90134120e-01f, 1.40122697e-01f, 9.96876657e-01f, 7.89746121e-02f, 9.99011934e-01f, 4.44423407e-02f,
  9.99687493e-01f, 2.49973964e-02f, 9.99901175e-01f, 1.40580693e-02f, 9.99968767e-01f, 7.90561177e-03f, 9.99990106e-01f, 4.44568414e-03f,
  6.46919310e-01f, 7.62558460e-01f, -4.65064496e-01f, 8.85276794e-01f, -3.59694332e-01f, 9.33070183e-01f, -8.87455046e-02f, -9.96054351e-01f,
  -8.56888831e-01f, 5.15501261e-01f, 1.08494945e-01f, 9.94096994e-01f, 6.80616796e-01f, 7.32639611e-01f, 8.95005584e-01f, 4.46054995e-01f,
  9.66389954e-01f, 2.57080555e-01f, 9.89330530e-01f, 1.45688385e-01f, 9.96621907e-01f, 8.21266174e-02f, 9.98931348e-01f, 4.62187938e-02f,
  9.99662042e-01f, 2.59970706e-02f, 9.99893129e-01f, 1.46203535e-02f, 9.99966204e-01f, 8.22182931e-03f, 9.99989331e-01f, 4.62350994e-03f,
  -2.92138815e-01f, 9.56375957e-01f, -8.65450621e-01f, 5.00994205e-01f, -6.32028639e-01f, 7.74945021e-01f, 8.88481140e-02f, -9.96045172e-01f,
  -9.04072165e-01f, 4.27379847e-01f, 5.24506159e-02f, 9.98623490e-01f, 6.57112300e-01f, 7.53792703e-01f, 8.86932373e-01f, 4.61899310e-01f,
  9.63770926e-01f, 2.66731411e-01f, 9.88495648e-01f, 1.51249468e-01f, 9.96357203e-01f, 8.52777958e-02f, 9.98847544e-01f, 4.79951017e-02f,
  9.99635518e-01f, 2.69967206e-02f, 9.99884725e-01f, 1.51826320e-02f, 9.99963522e-01f, 8.53804592e-03f, 9.99988496e-01f, 4.80133574e-03f,
  -9.62605894e-01f, 2.70905793e-01f, -9.99293387e-01f, -3.75856608e-02f, -8.41684937e-01f, 5.39968967e-01f, 2.63639510e-01f, -9.64621305e-01f,
  -9.42222297e-01f, 3.34988207e-01f, -3.75941908e-03f, 9.99992907e-01f, 6.32950664e-01f, 7.74192095e-01f, 8.78578722e-01f, 4.77597594e-01f,
  9.61055458e-01f, 2.76355654e-01f, 9.87629473e-01f, 1.56805754e-01f, 9.96082544e-01f, 8.84281173e-02f, 9.98760641e-01f, 4.97712530e-02f,
  9.99608040e-01f, 2.79963426e-02f, 9.99876022e-01f, 1.57449059e-02f, 9.99960780e-01f, 8.85426160e-03f, 9.99987602e-01f, 4.97916201e-03f,
  -7.48057544e-01f, -6.63633883e-01f, -8.25371623e-01f, -5.64589798e-01f, -9.67871487e-01f, 2.51445323e-01f, 4.30115849e-01f, -9.02773678e-01f,
  -9.70958173e-01f, 2.39249229e-01f, -5.99575676e-02f, 9.98200953e-01f, 6.08156204e-01f, 7.93817401e-01f, 8.69947195e-01f, 4.93144840e-01f,
  9.58243906e-01f, 2.85952210e-01f, 9.86732066e-01f, 1.62357092e-01f, 9.95797932e-01f, 9.15775672e-02f, 9.98670578e-01f, 5.15472479e-02f,
  9.99579549e-01f, 2.89959367e-02f, 9.99867022e-01f, 1.63071752e-02f, 9.99957979e-01f, 9.17047635e-03f, 9.99986708e-01f, 5.15698735e-03f,
  1.54251456e-01f, -9.88031626e-01f, -3.97251874e-01f, -9.17709649e-01f, -9.98075247e-01f, -6.20148405e-02f, 5.83026946e-01f, -8.12452853e-01f,
  -9.89992499e-01f, 1.41120002e-01f, -1.15966164e-01f, 9.93253171e-01f, 5.82753658e-01f, 8.12648892e-01f, 8.61040652e-01f, 5.08536100e-01f,
  9.55336511e-01f, 2.95520186e-01f, 9.85803485e-01f, 1.67903304e-01f, 9.95503366e-01f, 9.47260931e-02f, 9.98577297e-01f, 5.33230826e-02f,
  9.99550045e-01f, 2.99955010e-02f, 9.99857724e-01f, 1.68694388e-02f, 9.99954998e-01f, 9.48669016e-03f, 9.99985754e-01f, 5.33481315e-03f,
  9.14742351e-01f, -4.04037654e-01f, 1.53215483e-01f, -9.88192797e-01f, -9.29300308e-01f, -3.69325012e-01f, 7.17549205e-01f, -6.96507812e-01f,
  -9.99135137e-01f, 4.15805206e-02f, -1.71608135e-01f, 9.85165298e-01f, 5.56768358e-01f, 8.30667794e-01f, 8.51861775e-01f, 5.23766637e-01f,
  9.52333570e-01f, 3.05058628e-01f, 9.84843671e-01f, 1.73444211e-01f, 9.95198846e-01f, 9.78736654e-02f, 9.98480916e-01f, 5.50987460e-02f,
  9.99519527e-01f, 3.09950355e-02f, 9.99848068e-01f, 1.74316969e-02f, 9.99951959e-01f, 9.80290305e-03f, 9.99984801e-01f, 5.51263802e-03f,
  8.34223390e-01f, 5.51426709e-01f, 6.56495154e-01f, -7.54330218e-01f, -7.68367112e-01f, -6.40009403e-01f, 8.29440355e-01f, -5.58595300e-01f,
  -9.98294771e-01f, -5.83741926e-02f, -2.26707578e-01f, 9.73962843e-01f, 5.30226350e-01f, 8.47856104e-01f, 8.42413545e-01f, 5.38831532e-01f,
  9.49235439e-01f, 3.14566553e-01f, 9.83852804e-01f, 1.78979620e-01f, 9.94884372e-01f, 1.01020269e-01f, 9.98381376e-01f, 5.68742342e-02f,
  9.99488056e-01f, 3.19945402e-02f, 9.99838114e-01f, 1.79939512e-02f, 9.99948800e-01f, 1.01191159e-02f, 9.99983788e-01f, 5.69046335e-03f,
  -1.32767474e-02f, 9.99911845e-01f, 9.57586050e-01f, -2.88147390e-01f, -5.31235278e-01f, -8.47224355e-01f, 9.15171385e-01f, -4.03064936e-01f,
  -9.87479806e-01f, -1.57745644e-01f, -2.81090319e-01f, 9.59681332e-01f, 5.03154159e-01f, 8.64196658e-01f, 8.32698941e-01f, 5.53726017e-01f,
  9.46042359e-01f, 3.24043006e-01f, 9.82830763e-01f, 1.84509367e-01f, 9.94559944e-01f, 1.04165860e-01f, 9.98278618e-01f, 5.86495437e-02f,
  9.99455571e-01f, 3.29940096e-02f, 9.99827802e-01f, 1.85561981e-02f, 9.99945521e-01f, 1.04353270e-02f, 9.99982774e-01f, 5.86828869e-03f,
  -8.48570287e-01f, 5.29082716e-01f, 9.63757515e-01f, 2.66779721e-01f, -2.41421118e-01f, -9.70420420e-01f, 9.72038329e-01f, -2.34822124e-01f,
  -9.66798186e-01f, -2.55541205e-01f, -3.34584385e-01f, 9.42365825e-01f, 4.75578904e-01f, 8.79673064e-01f, 8.22721004e-01f, 5.68445385e-01f,
  9.42754686e-01f, 3.33487093e-01f, 9.81777668e-01f, 1.90033287e-01f, 9.94225562e-01f, 1.07310407e-01f, 9.98172760e-01f, 6.04246669e-02f,
  9.99422073e-01f, 3.39934528e-02f, 9.99817252e-01f, 1.91184394e-02f, 9.99942183e-01f, 1.07515370e-02f, 9.99981701e-01f, 6.04611309e-03f,
  -9.03692186e-01f, -4.28182662e-01f, 6.73110247e-01f, 7.39542127e-01f, 7.23346695e-02f, -9.97380435e-01f, 9.98247743e-01f, -5.91726787e-02f,
  -9.36456680e-01f, -3.50783229e-01f, -3.87020677e-01f, 9.22071040e-01f, 4.47528064e-01f, 8.94269884e-01f, 8.12482953e-01f, 5.82984984e-01f,
  9.39372718e-01f, 3.42897803e-01f, 9.80693519e-01f, 1.95551202e-01f, 9.93881226e-01f, 1.10453881e-01f, 9.98063743e-01f, 6.21996038e-02f,
  9.99387562e-01f, 3.49928550e-02f, 9.99806345e-01f, 1.96806751e-02f, 9.99938726e-01f, 1.10677453e-02f, 9.99980628e-01f, 6.22393796e-03f,
  -1.27963692e-01f, -9.91778851e-01f, 1.75156534e-01f, 9.84540582e-01f, 3.78916174e-01f, -9.25431013e-01f, 9.92972851e-01f, 1.18342586e-01f,
  -8.96758378e-01f, -4.42520559e-01f, -4.38233554e-01f, 8.98861170e-01f, 4.19029742e-01f, 9.07972515e-01f, 8.01987886e-01f, 5.97340286e-01f,
  9.35896814e-01f, 3.52274209e-01f, 9.79578316e-01f, 2.01062918e-01f, 9.93526995e-01f, 1.13596253e-01f, 9.97951567e-01f, 6.39743358e-02f,
  9.99352098e-01f, 3.59922275e-02f, 9.99795079e-01f, 2.02429052e-02f, 9.99935210e-01f, 1.13839535e-02f, 9.99979496e-01f, 6.40176190e-03f,
  7.65414059e-01f, -6.43538117e-01f, -3.76742303e-01f, 9.26318109e-01f, 6.47921681e-01f, -7.61706948e-01f, 9.56380010e-01f, 2.92125374e-01f,
  -8.48100007e-01f, -5.29836178e-01f, -4.88060862e-01f, 8.72809589e-01f, 3.90112430e-01f, 9.20767248e-01f, 7.91239262e-01f, 6.11506701e-01f,
  9.32327330e-01f, 3.61615449e-01f, 9.78432178e-01f, 2.06568271e-01f, 9.93162811e-01f, 1.16737492e-01f, 9.97836173e-01f, 6.57488778e-02f,
  9.99315560e-01f, 3.69915590e-02f, 9.99783576e-01f, 2.08051261e-02f, 9.99931574e-01f, 1.17001599e-02f, 9.99978364e-01f, 6.57958630e-03f,
  9.55073655e-01f, 2.96368569e-01f, -8.12611222e-01f, 5.82806170e-01f, 8.52673113e-01f, -5.22444785e-01f, 8.89623463e-01f, 4.56694692e-01f,
  -7.90967762e-01f, -6.11857831e-01f, -5.36345184e-01f, 8.43998730e-01f, 3.60805035e-01f, 9.32641268e-01f, 7.80240417e-01f, 6.25479698e-01f,
  9.28664625e-01f, 3.70920479e-01f, 9.77255106e-01f, 2.12067112e-01f, 9.92788672e-01f, 1.19877554e-01f, 9.97717679e-01f, 6.75232038e-02f,
  9.99278069e-01f, 3.79908569e-02f, 9.99771714e-01f, 2.13673431e-02f, 9.99927819e-01f, 1.20163653e-02f, 9.99977171e-01f, 6.75741071e-03f,
  2.66642928e-01f, 9.63795364e-01f, -9.98210371e-01f, 5.98003156e-02f, 9.72865343e-01f, -2.31372014e-01f, 7.94808388e-01f, 6.06860459e-01f,
  -7.25932240e-01f, -6.87766254e-01f, -5.82933903e-01f, 8.12519610e-01f, 3.31136853e-01f, 9.43582714e-01f, 7.68994927e-01f, 6.39254928e-01f,
  9.24909055e-01f, 3.80188406e-01f, 9.76047099e-01f, 2.17559248e-01f, 9.92404640e-01f, 1.23016424e-01f, 9.97596025e-01f, 6.92973137e-02f,
  9.99239624e-01f, 3.89901139e-02f, 9.99759495e-01f, 2.19295528e-02f, 9.99923944e-01f, 1.23325698e-02f, 9.99975979e-01f, 6.93523418e-03f,
  -6.66938066e-01f, 7.45113134e-01f, -8.76379430e-01f, -4.81621295e-01f, 9.96578991e-01f, 8.26458037e-02f, 6.74925625e-01f, 7.37885714e-01f,
  -6.53643608e-01f, -7.56802499e-01f, -6.27679706e-01f, 7.78471708e-01f, 3.01137596e-01f, 9.53580678e-01f, 7.57506192e-01f, 6.52827978e-01f,
  9.21060979e-01f, 3.89418334e-01f, 9.74808276e-01f, 2.23044485e-01f, 9.92010653e-01f, 1.26154065e-01f, 9.97471273e-01f, 7.10712075e-02f,
  9.99200106e-01f, 3.99893373e-02f, 9.99747038e-01f, 2.24917568e-02f, 9.99920011e-01f, 1.26487734e-02f, 9.99974728e-01f, 7.11305765e-03f,
  -9.87339258e-01f, -1.58622667e-01f, -4.84639406e-01f, -8.74714017e-01f, 9.21462357e-01f, 3.88467699e-01f, 5.33756077e-01f, 8.45638454e-01f,
  -5.74824035e-01f, -8.18277061e-01f, -6.70441091e-01f, 7.41962790e-01f, 2.70837069e-01f, 9.62625206e-01f, 7.45777905e-01f, 6.66194677e-01f,
  9.17120814e-01f, 3.98609310e-01f, 9.73538578e-01f, 2.28522688e-01f, 9.91606772e-01f, 1.29290432e-01f, 9.97343302e-01f, 7.28448778e-02f,
  9.99159634e-01f, 4.09885161e-02f, 9.99734223e-01f, 2.30539497e-02f, 9.99915957e-01f, 1.29649751e-02f, 9.99973416e-01f, 7.29088066e-03f,
  -3.99985313e-01f, -9.16521549e-01f, 5.63609414e-02f, -9.98410463e-01f, 7.54965365e-01f, 6.55764699e-01f, 3.75752151e-01f, 9.26720202e-01f,
  -4.90260571e-01f, -8.71575892e-01f, -7.11082935e-01f, 7.03108132e-01f, 2.40265876e-01f, 9.70707119e-01f, 7.33813822e-01f, 6.79350674e-01f,
  9.13088918e-01f, 4.07760441e-01f, 9.72238123e-01f, 2.33993664e-01f, 9.91192937e-01f, 1.32425532e-01f, 9.97212172e-01f, 7.46183172e-02f,
  9.99118149e-01f, 4.19876575e-02f, 9.99721110e-01f, 2.36161388e-02f, 9.99911785e-01f, 1.32811759e-02f, 9.99972105e-01f, 7.46870413e-03f,
  5.55113316e-01f, -8.31774771e-01f, 5.80003142e-01f, -8.14614236e-01f, 5.13598442e-01f, 8.58030677e-01f, 2.05897167e-01f, 9.78573620e-01f,
  -4.00799006e-01f, -9.16166008e-01f, -7.49476731e-01f, 6.62030637e-01f, 2.09454417e-01f, 9.77818429e-01f, 7.21617639e-01f, 6.92291796e-01f,
  9.08965766e-01f, 4.16870773e-01f, 9.70906913e-01f, 2.39457220e-01f, 9.90769207e-01f, 1.35559291e-01f, 9.97077882e-01f, 7.63915181e-02f,
  9.99075651e-01f, 4.29867506e-02f, 9.99707639e-01f, 2.41783205e-02f, 9.99907553e-01f, 1.35973748e-02f, 9.99970794e-01f, 7.64652714e-03f,
  9.99843299e-01f, 1.77019257e-02f, 9.25014675e-01f, -3.79931390e-01f, 2.21298173e-01f, 9.75206196e-01f, 2.95478199e-02f, 9.99563396e-01f,
  -3.07332784e-01f, -9.51602101e-01f, -7.85501122e-01f, 6.18860185e-01f, 1.78433523e-01f, 9.83951986e-01f, 7.09193349e-01f, 7.05014050e-01f,
  9.04751658e-01f, 4.25939471e-01f, 9.69545007e-01f, 2.44913206e-01f, 9.90335584e-01f, 1.38691694e-01f, 9.96940494e-01f, 7.81644881e-02f,
  9.99032140e-01f, 4.39858064e-02f, 9.99693930e-01f, 2.47404929e-02f, 9.99903202e-01f, 1.39135728e-02f, 9.99969363e-01f, 7.82434922e-03f,
  5.25321960e-01f, 8.50903511e-01f, 9.85138178e-01f, 1.71763569e-01f, -9.29481089e-02f, 9.95670974e-01f, -1.47732988e-01f, 9.89027262e-01f,
  -2.10795805e-01f, -9.77530122e-01f, -8.19042206e-01f, 5.73733270e-01f, 1.47234216e-01f, 9.89101648e-01f, 6.96544766e-01f, 7.17513323e-01f,
  9.00447130e-01f, 4.34965521e-01f, 9.68152404e-01f, 2.50361472e-01f, 9.89892066e-01f, 1.41822711e-01f, 9.96799886e-01f, 7.99371973e-02f,
  9.98987675e-01f, 4.49848175e-02f, 9.99679863e-01f, 2.53026579e-02f, 9.99898732e-01f, 1.42297689e-02f, 9.99967992e-01f, 8.00217129e-03f,
  -4.32177931e-01f, 9.01788354e-01f, 7.41858006e-01f, 6.70557022e-01f, -3.97976756e-01f, 9.17395473e-01f, -3.20354372e-01f, 9.47297752e-01f,
  -1.12152621e-01f, -9.93690968e-01f, -8.49993885e-01f, 5.26792526e-01f, 1.15887694e-01f, 9.93262351e-01f, 6.83675885e-01f, 7.29785740e-01f,
  8.96052480e-01f, 4.43948090e-01f, 9.66729224e-01f, 2.55801797e-01f, 9.89438653e-01f, 1.44952312e-01f, 9.96656179e-01f, 8.17096606e-02f,
  9.98942196e-01f, 4.59837839e-02f, 9.99665439e-01f, 2.58648153e-02f, 9.99894202e-01f, 1.45459641e-02f, 9.99966562e-01f, 8.17999430e-03f,
  -9.92335498e-01f, 1.23573124e-01f, 2.70098448e-01f, 9.62832689e-01f, -6.63538277e-01f, 7.48142362e-01f, -4.82871950e-01f, 8.75690997e-01f,
  -1.23883775e-02f, -9.99923289e-01f, -8.78258407e-01f, 4.78186339e-01f, 8.44252855e-02f, 9.96429801e-01f, 6.70590878e-01f, 7.41827428e-01f,
  8.91568303e-01f, 4.52886283e-01f, 9.65275466e-01f, 2.61234075e-01f, 9.88975346e-01f, 1.48080453e-01f, 9.96509314e-01f, 8.34818557e-02f,
  9.98895705e-01f, 4.69827019e-02f, 9.99650776e-01f, 2.64269635e-02f, 9.99889553e-01f, 1.48621574e-02f, 9.99965072e-01f, 8.35781638e-03f,
  -6.40144348e-01f, -7.68254638e-01f, -2.84846604e-01f, 9.58573103e-01f, -8.63296509e-01f, 5.04697084e-01f, -6.30159974e-01f, 7.76465356e-01f,
  8.74991715e-02f, -9.96164620e-01f, -9.03746367e-01f, 4.28068399e-01f, 5.28784581e-02f, 9.98600960e-01f, 6.57293737e-01f, 7.53634512e-01f,
  8.86994898e-01f, 4.61779177e-01f, 9.63791192e-01f, 2.66658038e-01f, 9.88502085e-01f, 1.51207119e-01f, 9.96359289e-01f, 8.52537975e-02f,
  9.98848200e-01f, 4.79815714e-02f, 9.99635756e-01f, 2.69891042e-02f, 9.99884784e-01f, 1.51783489e-02f, 9.99963582e-01f, 8.53563752e-03f,
  3.00592542e-01f, -9.53752637e-01f, -7.52063990e-01f, 6.59090102e-01f, -9.77442741e-01f, 2.11200655e-01f, -7.57573068e-01f, 6.52750373e-01f,
  1.86512470e-01f, -9.82452571e-01f, -9.26377118e-01f, 3.76597136e-01f, 2.12787576e-02f, 9.99773562e-01f, 6.43788815e-01f, 7.65203178e-01f,
  8.82332861e-01f, 4.70625877e-01f, 9.62276459e-01f, 2.72073567e-01f, 9.88018990e-01f, 1.54332280e-01f, 9.96206105e-01f, 8.70254710e-02f,
  9.98799741e-01f, 4.89803962e-02f, 9.99620378e-01f, 2.75512375e-02f, 9.99879956e-01f, 1.54945394e-02f, 9.99962032e-01f, 8.71345960e-03f,
  9.64965999e-01f, -2.62374848e-01f, -9.87659097e-01f, 1.56619072e-01f, -9.94656444e-01f, -1.03240460e-01f, -8.61092687e-01f, 5.08447945e-01f,
  2.83662200e-01f, -9.58924294e-01f, -9.46079254e-01f, 3.23935270e-01f, -1.03422189e-02f, 9.99946535e-01f, 6.30080283e-01f, 7.76529968e-01f,
  8.77582550e-01f, 4.79425550e-01f, 9.60731268e-01f, 2.77480543e-01f, 9.87526000e-01f, 1.57455891e-01f, 9.96049762e-01f, 8.87968615e-02f,
  9.98750269e-01f, 4.99791689e-02f, 9.99604762e-01f, 2.81133596e-02f, 9.99875009e-01f, 1.58107281e-02f, 9.99960482e-01f, 8.89127981e-03f,
  7.42154181e-01f, 6.70229197e-01f, -9.19073522e-01f, -3.94086063e-01f, -9.13230121e-01f, -4.07444149e-01f, -9.37454224e-01f, 3.48108500e-01f,
  3.77977669e-01f, -9.25814748e-01f, -9.62790370e-01f, 2.70249337e-01f, -4.19528559e-02f, 9.99119580e-01f, 6.16172493e-01f, 7.87611187e-01f,
  8.72744501e-01f, 4.88177240e-01f, 9.59155679e-01f, 2.82878697e-01f, 9.87023175e-01f, 1.60577938e-01f, 9.95890260e-01f, 9.05679762e-02f,
  9.98699784e-01f, 5.09778969e-02f, 9.99588788e-01f, 2.86754742e-02f, 9.99869943e-01f, 1.61269177e-02f, 9.99958873e-01f, 9.06910095e-03f,
  -1.62990779e-01f, 9.86627579e-01f, -5.67430019e-01f, -8.23421597e-01f, -7.41239965e-01f, -6.71240151e-01f, -9.84248459e-01f, 1.76790684e-01f,
  4.68516916e-01f, -8.83454502e-01f, -9.76457715e-01f, 2.15709001e-01f, -7.35215396e-02f, 9.97293651e-01f, 6.02069914e-01f, 7.98443377e-01f,
  8.67819190e-01f, 4.96880114e-01f, 9.57549810e-01f, 2.88267940e-01f, 9.86510456e-01f, 1.63698375e-01f, 9.95727658e-01f, 9.23388004e-02f,
  9.98648286e-01f, 5.19765690e-02f, 9.99572515e-01f, 2.92375814e-02f, 9.99864817e-01f, 1.64431017e-02f, 9.99957263e-01f, 9.24692024e-03f,
  -9.18282807e-01f, 3.95925164e-01f, -4.10281904e-02f, -9.99157965e-01f, -4.95741814e-01f, -8.68469954e-01f, -1.00000000e+00f, -1.03020677e-04f,
  5.54374516e-01f, -8.32267344e-01f, -9.87038016e-01f, 1.60486728e-01f, -1.05016708e-01f, 9.94470477e-01f, 5.87776959e-01f, 8.09023023e-01f,
  8.62807095e-01f, 5.05533338e-01f, 9.55913603e-01f, 2.93648034e-01f, 9.85987842e-01f, 1.66817173e-01f, 9.95561838e-01f, 9.41093415e-02f,
  9.98595834e-01f, 5.29751927e-02f, 9.99555886e-01f, 2.97996756e-02f, 9.99859571e-01f, 1.67592876e-02f, 9.99955595e-01f, 9.42474138e-03f,
  -8.29309821e-01f, -5.58789074e-01f, 4.98009592e-01f, -8.67171526e-01f, -2.01079622e-01f, -9.79574919e-01f, -9.84212041e-01f, -1.76993474e-01f,
  6.34692967e-01f, -7.72764444e-01f, -9.94497895e-01f, 1.04756832e-01f, -1.36406869e-01f, 9.90652919e-01f, 5.73298037e-01f, 8.19346905e-01f,
  8.57708693e-01f, 5.14135957e-01f, 9.54247177e-01f, 2.99018890e-01f, 9.85455394e-01f, 1.69934288e-01f, 9.95392919e-01f, 9.58795771e-02f,
  9.98542368e-01f, 5.39737605e-02f, 9.99538958e-01f, 3.03617641e-02f, 9.99854207e-01f, 1.70754679e-02f, 9.99953866e-01f, 9.60256159e-03f,
  2.21267566e-02f, -9.99755144e-01f, 8.83669317e-01f, -4.68111664e-01f, 1.13521777e-01f, -9.93535519e-01f, -9.37382519e-01f, -3.48301649e-01f,
  7.08669782e-01f, -7.05540299e-01f, -9.98813629e-01f, 4.86960001e-02f, -1.67660639e-01f, 9.85844791e-01f, 5.58637917e-01f, 8.29411685e-01f,
  8.52524519e-01f, 5.22687256e-01f, 9.52550590e-01f, 3.04380238e-01f, 9.84913111e-01f, 1.73049718e-01f, 9.95220840e-01f, 9.76495072e-02f,
  9.98487890e-01f, 5.49722798e-02f, 9.99521732e-01f, 3.09238415e-02f, 9.99848783e-01f, 1.73916500e-02f, 9.99952197e-01f, 9.78038087e-03f,
  8.53220105e-01f, -5.21551013e-01f, 9.97174621e-01f, 7.51182064e-02f, 4.16867077e-01f, -9.08967435e-01f, -8.60988438e-01f, -5.08624554e-01f,
  7.75565803e-01f, -6.31266713e-01f, -9.99971747e-01f, -7.51878507e-03f, -1.98746875e-01f, 9.80050862e-01f, 5.43801069e-01f, 8.39214146e-01f,
  8.47255111e-01f, 5.31186223e-01f, 9.50823903e-01f, 3.09731960e-01f, 9.84360933e-01f, 1.76163420e-01f, 9.95045662e-01f, 9.94191393e-02f,
  9.98432398e-01f, 5.59707358e-02f, 9.99504209e-01f, 3.14859077e-02f, 9.99843180e-01f, 1.77078284e-02f, 9.99950409e-01f, 9.95820016e-03f,
  8.99866819e-01f, 4.36164767e-01f, 8.03569078e-01f, 5.95211506e-01f, 6.78870201e-01f, -7.34258294e-01f, -7.57439196e-01f, -6.52905703e-01f,
  8.34712923e-01f, -5.50685287e-01f, -9.97968495e-01f, -6.37097955e-02f, -2.29634270e-01f, 9.73276973e-01f, 5.28792322e-01f, 8.48751247e-01f,
  8.41901004e-01f, 5.39632022e-01f, 9.49067116e-01f, 3.15073937e-01f, 9.83798921e-01f, 1.79275364e-01f, 9.94867265e-01f, 1.01188451e-01f,
  9.98375952e-01f, 5.69691435e-02f, 9.99486327e-01f, 3.20479684e-02f, 9.99837577e-01f, 1.80240069e-02f, 9.99948621e-01f, 1.01360194e-02f,
  1.19180135e-01f, 9.92872655e-01f, 3.62476677e-01f, 9.31992829e-01f, 8.73550534e-01f, -4.86733496e-01f, -6.30000710e-01f, -7.76594579e-01f,
  8.85519624e-01f, -4.64602023e-01f, -9.92810190e-01f, -1.19699396e-01f, -2.60292053e-01f, 9.65529919e-01f, 5.13616323e-01f, 8.58020008e-01f,
  8.36462677e-01f, 5.48023939e-01f, 9.47280347e-01f, 3.20405900e-01f, 9.83227074e-01f, 1.82385504e-01f, 9.94685769e-01f, 1.02957435e-01f,
  9.98318493e-01f, 5.79674877e-02f, 9.99468148e-01f, 3.26100141e-02f, 9.99831796e-01f, 1.83401816e-02f, 9.99946833e-01f, 1.03138378e-02f,
  -7.71080196e-01f, 6.36738002e-01f, -1.90249100e-01f, 9.81735826e-01f, 9.81602073e-01f, -1.90938011e-01f, -4.82692331e-01f, -8.75790000e-01f,
  9.27478492e-01f, -3.73876572e-01f, -9.84513164e-01f, -1.75310582e-01f, -2.90689558e-01f, 9.56817448e-01f, 4.98277903e-01f, 8.67017388e-01f,
  8.30940723e-01f, 5.56361020e-01f, 9.45463598e-01f, 3.25727791e-01f, 9.82645452e-01f, 1.85493827e-01f, 9.94501114e-01f, 1.04726106e-01f,
  9.98260021e-01f, 5.89657798e-02f, 9.99449670e-01f, 3.31720486e-02f, 9.99825954e-01f, 1.86563563e-02f, 9.99944985e-01f, 1.04916561e-02f,
  -9.52412963e-01f, -3.04810613e-01f, -6.84381902e-01f, 7.29123712e-01f, 9.92308319e-01f, 1.23790950e-01f, -3.20159167e-01f, -9.47363734e-01f,
  9.60170269e-01f, -2.79415488e-01f, -9.73103702e-01f, -2.30367512e-01f, -3.20796400e-01f, 9.47148204e-01f, 4.82782036e-01f, 8.75740528e-01f,
  8.25335622e-01f, 5.64642429e-01f, 9.43616986e-01f, 3.31039310e-01f, 9.82053936e-01f, 1.88600287e-01f, 9.94313300e-01f, 1.06494442e-01f,
  9.98200536e-01f, 5.99640086e-02f, 9.99430835e-01f, 3.37340795e-02f, 9.99819994e-01f, 1.89725272e-02f, 9.99943078e-01f, 1.06694745e-02f,
  -2.58101642e-01f, -9.66117799e-01f, -9.67739642e-01f, 2.51952261e-01f, 9.04607594e-01f, 4.26245421e-01f, -1.47529200e-01f, -9.89057720e-01f,
  9.83268440e-01f, -1.82162598e-01f, -9.58617806e-01f, -2.84696162e-01f, -3.50582451e-01f, 9.36531842e-01f, 4.67133403e-01f, 8.84186864e-01f,
  8.19648027e-01f, 5.72867453e-01f, 9.41740453e-01f, 3.36340427e-01f, 9.81452644e-01f, 1.91704854e-01f, 9.94122326e-01f, 1.08262435e-01f,
  9.98140097e-01f, 6.09621815e-02f, 9.99411702e-01f, 3.42960916e-02f, 9.99813974e-01f, 1.92886982e-02f, 9.99941170e-01f, 1.08472919e-02f,
  6.73507154e-01f, -7.39180684e-01f, -9.53050017e-01f, -3.02812874e-01f, 7.27198064e-01f, 6.86427653e-01f, 2.97537707e-02f, -9.99557257e-01f,
  9.96542096e-01f, -8.30891207e-02f, -9.41101313e-01f, -3.38124752e-01f, -3.80017966e-01f, 9.24979091e-01f, 4.51337039e-01f, 8.92353535e-01f,
  8.13878477e-01f, 5.81035137e-01f, 9.39834237e-01f, 3.41630876e-01f, 9.80841517e-01f, 1.94807529e-01f, 9.93928254e-01f, 1.10030092e-01f,
  9.98078644e-01f, 6.19602874e-02f, 9.99392271e-01f, 3.48580964e-02f, 9.99807835e-01f, 1.96048655e-02f, 9.99939203e-01f, 1.10251084e-02f,
  9.85896587e-01f, 1.67355701e-01f, -6.44837022e-01f, -7.64320076e-01f, 4.77671444e-01f, 8.78538549e-01f, 2.06098333e-01f, -9.78531301e-01f,
  9.99858618e-01f, 1.68140903e-02f, -9.20609534e-01f, -3.90484393e-01f, -4.09073502e-01f, 9.12501454e-01f, 4.35397953e-01f, 9.00238097e-01f,
  8.08027506e-01f, 5.89144766e-01f, 9.37898219e-01f, 3.46910536e-01f, 9.80220556e-01f, 1.97908238e-01f, 9.93731022e-01f, 1.11797392e-01f,
  9.98016179e-01f, 6.29583374e-02f, 9.99372482e-01f, 3.54200937e-02f, 9.99801576e-01f, 1.99210308e-02f, 9.99937236e-01f, 1.12029258e-02f,
};

constexpr int T_ALL = 36864, T_CTX = 4096;
constexpr int NLAYER = 4;
constexpr float EPS = 1e-6f;
constexpr int LK_LAT = 4352;

struct Params {
  const float* x_prompt; const float* x_sample; const float* cache_ckv; const float* cache_krope;
  const float* cache_k; const float* cache_v; const float* state; const float* c; const float* c_ctx;
  const float* w_mod; const float* b_mod; const float* g_norm; const float* w_in; const float* conv_w; const float* conv_b;
  const float* lru_wa; const float* lru_ba; const float* lru_wi; const float* lru_bi; const float* lru_lam;
  const float* q_norm; const float* w_uq; const float* kv_norm; const float* w_ukv; const float* sink;
  const float* w_br_rnn; const float* w_br_mla; const float* w_br_swa; const float* w_out; const float* final_norm;
  float* out; char* ws;
};

constexpr size_t AL(size_t x) { return (x + 255) & ~(size_t)255; }
constexpr size_t O_WINA = 0;
constexpr size_t O_WINB = O_WINA + AL((size_t)2560 * 1024 * 2);
constexpr size_t O_WLRU = O_WINB + AL((size_t)5120 * 1024 * 2);
constexpr size_t O_WUQ = O_WLRU + AL((size_t)4096 * 128 * 2);
constexpr size_t O_WUKVG = O_WUQ + AL((size_t)768 * 384 * 2);
constexpr size_t O_WUKVR = O_WUKVG + AL((size_t)1024 * 256 * 2);
constexpr size_t O_WBRR = O_WUKVR + AL((size_t)1024 * 256 * 2);
constexpr size_t O_WBRM = O_WBRR + AL((size_t)1024 * 1024 * 2);
constexpr size_t O_WBRS = O_WBRM + AL((size_t)1024 * 512 * 2);
constexpr size_t O_WOUT = O_WBRS + AL((size_t)1024 * 512 * 2);
constexpr size_t O_MOD = O_WOUT + AL((size_t)1024 * 1024 * 2);
constexpr size_t O_H = O_MOD + AL((size_t)4 * 9 * 3072 * 4);
constexpr size_t O_XR = O_H + AL((size_t)T_ALL * 1024 * 2);
constexpr size_t O_CQ = O_XR + AL((size_t)T_ALL * 1024 * 2);
constexpr size_t O_CKV = O_CQ + AL((size_t)T_ALL * 384 * 2);
constexpr size_t O_CKVC = O_CKV + AL((size_t)T_ALL * 256 * 2);
constexpr size_t O_KRL = O_CKVC + AL((size_t)2048 * 256 * 2);
constexpr size_t O_KRC = O_KRL + AL((size_t)8 * LK_LAT * 32 * 2);
constexpr size_t O_QS = O_KRC + AL((size_t)16 * 256 * 32 * 2);
constexpr size_t O_KS = O_QS + AL((size_t)T_ALL * 512 * 2);
constexpr size_t O_KSC = O_KS + AL((size_t)T_ALL * 128 * 2);
constexpr size_t O_VTSL = O_KSC + AL((size_t)8 * 256 * 128 * 2);
constexpr size_t O_VTSC = O_VTSL + AL((size_t)8 * 2 * 64 * 4096 * 2);
constexpr size_t O_VTSCC = O_VTSC + AL((size_t)16 * 2 * 64 * 256 * 2);
constexpr size_t O_Q = O_VTSCC + AL((size_t)8 * 2 * 64 * 256 * 2);
constexpr size_t O_KNL = O_Q + AL((size_t)T_ALL * 768 * 2);
constexpr size_t O_KNC = O_KNL + AL((size_t)8 * 8 * LK_LAT * 64 * 2);
constexpr size_t O_VTL = O_KNC + AL((size_t)16 * 8 * 256 * 64 * 2);
constexpr size_t O_VTC = O_VTL + AL((size_t)8 * 8 * 64 * LK_LAT * 2);
constexpr size_t O_YRNN = O_VTC + AL((size_t)16 * 8 * 64 * 256 * 2);
static_assert(O_YRNN - O_KS >= (size_t)2 * T_ALL * 1024 * 2, "merge-gate buffers do not fit");
constexpr size_t O_SUM = O_YRNN + AL((size_t)T_ALL * 1024 * 2);
constexpr size_t O_BAR = O_SUM + AL((size_t)8 * 8 * 2 * 16 * 256 * 4);
constexpr size_t BAR_BYTES = 16384;
constexpr size_t O_W2 = O_BAR + BAR_BYTES;
constexpr size_t WS_NEED = O_W2 + O_MOD;

constexpr size_t OUT_CKV = (size_t)T_ALL * 1024;
constexpr size_t OUT_KROPE = OUT_CKV + (size_t)16 * 4 * 256 * 256;
constexpr size_t OUT_SK = OUT_KROPE + (size_t)16 * 4 * 256 * 32;
constexpr size_t OUT_SV = OUT_SK + (size_t)16 * 4 * 256 * 128;
constexpr size_t OUT_RG = OUT_SV + (size_t)16 * 4 * 256 * 128;

#define SB() __builtin_amdgcn_sched_barrier(0)
#define MB() asm volatile("" ::: "memory")
DI int tid() { int t = threadIdx.x; asm volatile("" : "+v"(t)); return t; }
DI int xcd_map(int base) {
  const int g = gridDim.x;
  if (g & 7) return base + blockIdx.x;
  return base + (blockIdx.x & 7) * (g >> 3) + (blockIdx.x >> 3);
}
#define LANEVARS const int t = tid(), lane = t & 63, w = t >> 6, wr = w >> 1, wc = w & 1; const int c16 = lane & 15, g4 = lane >> 4; (void)wr; (void)wc; (void)c16; (void)g4;
DI float bf2f(u16 v) { return __uint_as_float(((unsigned)v) << 16); }
DI unsigned pack2(float a, float b) {
  f2_t v = {a, b};
  bf2_t r = __builtin_convertvector(v, bf2_t);
  return __builtin_bit_cast(unsigned, r);
}
DI u16 f2bf(float a) { return (u16)(pack2(a, 0.f) & 0xffffu); }
DI float sigmoidf_(float x) { return __builtin_amdgcn_rcpf(1.f + __expf(-x)); }
DI float wave_sum(float v) {
#pragma unroll
  for (int o = 32; o > 0; o >>= 1) v += __shfl_xor(v, o);
  return v;
}
DI int perm32(int p) { return (p & 7) | ((p & 8) << 1) | ((p & 16) >> 1); }
DI const float* xin_row(const Params& p, int l, int row) {
  if (l == 0) return row < T_CTX ? p.x_prompt + (size_t)row * 1024 : p.x_sample + (size_t)(row - T_CTX) * 1024;
  return p.out + (size_t)row * 1024;
}
template <class T> DI T* wsp(const Params& p, size_t off) { return (T*)(p.ws + off); }
DI u16* wsw(const Params& p, int l, size_t off) { return (u16*)(p.ws + ((l & 1) ? O_W2 : 0) + off); }

template <int NJ, bool SWAP = false>
DI void gemm_tile_t(const u16* A, int lda, const u16* B, int ldb, int K,
                    f32x4 (&acc)[4][NJ], char* smem) {
  const int t = tid(), lane = t & 63, w = t >> 6, wr = w >> 1, wc = w & 1;
  const int lr = t >> 3, slot = t & 7;
  const int c16 = lane & 15, g4 = lane >> 4;
  const int gch = slot ^ ((lr >> 1) & 7);
  const u16* ap = A + (size_t)lr * lda + gch * 8;
  const u16* bp = B + (size_t)lr * ldb + gch * 8;
  char* sdst = smem + t * 16;
#define DMA16(gp, lp) __builtin_amdgcn_global_load_lds((const unsigned*)(gp), (unsigned*)(lp), 16, 0, 0)
#define STAGE(base, ko) { DMA16(ap + (ko), (base)); DMA16(ap + (size_t)32 * lda + (ko), (base) + 4096); \
    DMA16(ap + (size_t)64 * lda + (ko), (base) + 8192); DMA16(ap + (size_t)96 * lda + (ko), (base) + 12288); \
    DMA16(bp + (ko), (base) + 16384); DMA16(bp + (size_t)32 * ldb + (ko), (base) + 16384 + 4096); \
    if (NJ > 2) { DMA16(bp + (size_t)64 * ldb + (ko), (base) + 16384 + 8192); DMA16(bp + (size_t)96 * ldb + (ko), (base) + 16384 + 12288); } }
  const int nk = K >> 6;
  const int arow = (wr * 64 + c16) * 128, brow = (wc * (16 * NJ) + c16) * 128;
  const int sw = (c16 >> 1) & 7;
  int kk = 0;
  STAGE(sdst, kk * 64)
  __syncthreads();
  for (int kt = 0; kt < nk; ++kt) {
    char* cur = smem + (kt & 1) * 32768;
    kk = (kk + 1 == nk) ? 0 : kk + 1;
    if (kt + 1 < nk) { char* nxt = sdst + ((kt + 1) & 1) * 32768; STAGE(nxt, kk * 64) }
#pragma unroll
    for (int ks = 0; ks < 2; ++ks) {
      bf16x8 af[4], bfr[NJ];
      const int ch = ((ks * 4 + g4) ^ sw) << 4;
#pragma unroll
      for (int i = 0; i < 4; ++i) af[i] = *(const bf16x8*)(cur + arow + i * 2048 + ch);
#pragma unroll
      for (int i = 0; i < NJ; ++i) bfr[i] = *(const bf16x8*)(cur + 16384 + brow + i * 2048 + ch);
#pragma unroll
      for (int i = 0; i < 4; ++i)
#pragma unroll
        for (int j = 0; j < NJ; ++j)
          acc[i][j] = SWAP ? __builtin_amdgcn_mfma_f32_16x16x32_bf16(bfr[j], af[i], acc[i][j], 0, 0, 0)
                           : __builtin_amdgcn_mfma_f32_16x16x32_bf16(af[i], bfr[j], acc[i][j], 0, 0, 0);
    }
    SB();
    __syncthreads();
  }
#undef STAGE
#undef DMA16
}
DI void gemm_tile(const u16* A, int lda, const u16* B, int ldb, int K,
                  f32x4 (&acc)[4][4], char* smem) {
  gemm_tile_t<4>(A, lda, B, ldb, K, acc, smem);
}
DI void gemm_tile_T(const u16* A, int lda, const u16* B, int ldb, int K,
                    f32x4 (&acc)[4][4], char* smem) {
  gemm_tile_t<4, true>(A, lda, B, ldb, K, acc, smem);
}
DI void zero_acc(f32x4 (&acc)[4][4]) {
#pragma unroll
  for (int i = 0; i < 4; ++i)
#pragma unroll
    for (int j = 0; j < 4; ++j) acc[i][j] = f32x4{0.f, 0.f, 0.f, 0.f};
}

struct TokTile { int g0; int is_ctx; int b; int p0; };
DI TokTile tok_tile(int mt) {
  TokTile r; r.g0 = mt * 128;
  if (r.g0 < T_CTX) { r.is_ctx = 1; r.b = r.g0 >> 8; r.p0 = r.g0 & 255; }
  else { r.is_ctx = 0; r.b = (r.g0 - T_CTX) >> 12; r.p0 = (r.g0 - T_CTX) & 4095; }
  return r;
}

DI void phase_mod(const Params& p, char* smem) {
  float* s_silu = (float*)smem;
  float* s_part = (float*)(smem + 36864);
  float* MOD = wsp<float>(p, O_MOD);
  const int t = tid();
  for (int i = t; i < 9 * 1024; i += 256) {
    float v = (i < 8192) ? p.c[i] : p.c_ctx[i - 8192];
    s_silu[i] = v * sigmoidf_(v);
  }
  __syncthreads();
  const int kg = t >> 6, cl = t & 63;
  for (int u = blockIdx.x; u < 4 * 48; u += gridDim.x) {
    const int l = u / 48, cb = u % 48;
    const int n = cb * 64 + cl;
    float acc[9];
#pragma unroll
    for (int ci = 0; ci < 9; ++ci) acc[ci] = 0.f;
    const float* wp = p.w_mod + ((size_t)l * 1024 + kg * 256) * 3072 + n;
    for (int k = 0; k < 256; ++k) {
      float wv = wp[(size_t)k * 3072];
#pragma unroll
      for (int ci = 0; ci < 9; ++ci) acc[ci] += s_silu[ci * 1024 + kg * 256 + k] * wv;
    }
#pragma unroll
    for (int ci = 0; ci < 9; ++ci) s_part[(kg * 9 + ci) * 64 + cl] = acc[ci];
    __syncthreads();
    for (int idx = t; idx < 9 * 64; idx += 256) {
      int ci = idx >> 6, c2 = idx & 63;
      float s = s_part[(0 * 9 + ci) * 64 + c2] + s_part[(1 * 9 + ci) * 64 + c2] + s_part[(2 * 9 + ci) * 64 + c2] +
                s_part[(3 * 9 + ci) * 64 + c2];
      MOD[((size_t)l * 9 + ci) * 3072 + cb * 64 + c2] = s + p.b_mod[l * 3072 + cb * 64 + c2];
    }
    __syncthreads();
  }
}

template <class F> DI void conv_job(u16* dst, int N, int K, F src) {
  const int total = N * (K >> 3);
  for (int idx = blockIdx.x * 256 + tid(); idx < total; idx += gridDim.x * 256) {
    const int n = idx % N, kb = idx / N;
    float v[8];
#pragma unroll
    for (int j = 0; j < 8; ++j) v[j] = src(kb * 8 + j, n);
    uint4 o;
    o.x = pack2(v[0], v[1]); o.y = pack2(v[2], v[3]); o.z = pack2(v[4], v[5]); o.w = pack2(v[6], v[7]);
    *(uint4*)(dst + (size_t)n * K + kb * 8) = o;
  }
}

DI void convert_weights(const Params& p, int l) {
  {
    const float* win = p.w_in + (size_t)l * 1024 * 7584;
    conv_job(wsw(p, l, O_WINA), 2560, 1024, [&](int k, int n) -> float {
      int col;
      if (n < 1024) col = n;
      else if (n < 1408) col = 2048 + (n - 1024);
      else if (n < 1664) col = 2432 + (n - 1408);
      else if (n < 1792) { int pp = n - 1664; col = pp < 32 ? 2688 + perm32(pp) : -1; }
      else if (n < 2304) col = 3232 + (n - 1792);
      else if (n < 2432) col = 3744 + (n - 2304);
      else col = 3872 + (n - 2432);
      return col < 0 ? 0.f : win[(size_t)k * 7584 + col];
    });
    conv_job(wsw(p, l, O_WINB), 5120, 1024, [&](int k, int n) -> float {
      int col;
      if (n < 1024) col = 1024 + n;
      else if (n < 1536) col = 2720 + (n - 1024);
      else if (n < 2048) col = 4000 + (n - 1536);
      else col = 4512 + (n - 2048);
      return win[(size_t)k * 7584 + col];
    });
    const float* wa = p.lru_wa + (size_t)l * 2 * 8 * 128 * 128;
    const float* wi = p.lru_wi + (size_t)l * 2 * 8 * 128 * 128;
    conv_job(wsw(p, l, O_WLRU), 4096, 128, [&](int k, int n) -> float {
      int db = n >> 8, nn = n & 255;
      return nn < 128 ? wa[((size_t)db * 128 + k) * 128 + nn] : wi[((size_t)db * 128 + k) * 128 + (nn - 128)];
    });
    const float* wuq = p.w_uq + (size_t)l * 384 * 768;
    const float* gq = p.q_norm + l * 384;
    conv_job(wsw(p, l, O_WUQ), 768, 384, [&](int k, int n) -> float {
      int col;
      if (n < 512) col = (n >> 6) * 96 + (n & 63);
      else { int hh = (n - 512) >> 5, pp = (n - 512) & 31; col = hh * 96 + 64 + perm32(pp); }
      return gq[k] * wuq[(size_t)k * 768 + col];
    });
    const float* wukv = p.w_ukv + (size_t)l * 256 * 1024;
    const float* gkv = p.kv_norm + l * 256;
    conv_job(wsw(p, l, O_WUKVG), 1024, 256, [&](int k, int n) -> float { return gkv[k] * wukv[(size_t)k * 1024 + n]; });
    conv_job(wsw(p, l, O_WUKVR), 1024, 256, [&](int k, int n) -> float { return wukv[(size_t)k * 1024 + n]; });
    const float* w1 = p.w_br_rnn + (size_t)l * 1024 * 1024;
    conv_job(wsw(p, l, O_WBRR), 1024, 1024, [&](int k, int n) -> float { return w1[(size_t)k * 1024 + n]; });
    const float* w2 = p.w_br_mla + (size_t)l * 512 * 1024;
    conv_job(wsw(p, l, O_WBRM), 1024, 512, [&](int k, int n) -> float { return w2[(size_t)k * 1024 + n]; });
    const float* w3 = p.w_br_swa + (size_t)l * 512 * 1024;
    conv_job(wsw(p, l, O_WBRS), 1024, 512, [&](int k, int n) -> float { return w3[(size_t)k * 1024 + n]; });
    const float* w4 = p.w_out + (size_t)l * 1024 * 1024;
    conv_job(wsw(p, l, O_WOUT), 1024, 1024, [&](int k, int n) -> float { return w4[(size_t)k * 1024 + n]; });
  }
}

DI void phase_prep(const Params& p, int l) {
  const int t = tid(), lane = t & 63, w = t >> 6;
  const float* MOD = wsp<float>(p, O_MOD) + (size_t)l * 9 * 3072;
  u16* H = wsp<u16>(p, O_H);
  for (int row = blockIdx.x * 4 + w; row < T_ALL; row += gridDim.x * 4) {
    const float* x = xin_row(p, l, row);
    const int ci = row < T_CTX ? 8 : ((row - T_CTX) >> 12);
    const float* md = MOD + ci * 3072;
    float4 v[4];
    float ss = 0.f;
#pragma unroll
    for (int i = 0; i < 4; ++i) {
      v[i] = *(const float4*)(x + i * 256 + lane * 4);
      ss += v[i].x * v[i].x + v[i].y * v[i].y + v[i].z * v[i].z + v[i].w * v[i].w;
    }
    ss = wave_sum(ss);
    const float rs = rsqrtf(ss * (1.f / 1024.f) + EPS);
#pragma unroll
    for (int i = 0; i < 4; ++i) {
      const int c = i * 256 + lane * 4;
      const float4 g = *(const float4*)(p.g_norm + l * 1024 + c);
      const float4 sh = *(const float4*)(md + c);
      const float4 sc = *(const float4*)(md + 1024 + c);
      float h0 = v[i].x * rs * g.x * (1.f + sc.x) + sh.x;
      float h1 = v[i].y * rs * g.y * (1.f + sc.y) + sh.y;
      float h2 = v[i].z * rs * g.z * (1.f + sc.z) + sh.z;
      float h3 = v[i].w * rs * g.w * (1.f + sc.w) + sh.w;
      uint2 o; o.x = pack2(h0, h1); o.y = pack2(h2, h3);
      *(uint2*)(H + (size_t)row * 1024 + c) = o;
    }
  }
  {
    const int gt = blockIdx.x * 256 + t, gs = gridDim.x * 256;
    u16* ckvc = wsp<u16>(p, O_CKVC);
    for (int i = gt; i < 2048 * 256; i += gs) {
      int r = i >> 8, k = i & 255, b = r >> 8, pos = r & 255;
      ckvc[i] = f2bf(p.cache_ckv[(((size_t)b * 4 + l) * 256 + pos) * 256 + k]);
    }
    u16* krl = wsp<u16>(p, O_KRL);
    for (int i = gt; i < 8 * 256 * 32; i += gs) {
      int pp = i & 31, pos = (i >> 5) & 255, b = i >> 13;
      krl[((size_t)b * LK_LAT + pos) * 32 + pp] = f2bf(p.cache_krope[(((size_t)b * 4 + l) * 256 + pos) * 32 + perm32(pp)]);
    }
    u16* ksc = wsp<u16>(p, O_KSC);
    for (int i = gt; i < 8 * 256 * 128; i += gs) {
      int c = i & 127, pos = (i >> 7) & 255, b = i >> 15;
      ksc[i] = f2bf(p.cache_k[(((size_t)b * 4 + l) * 256 + pos) * 128 + c]);
    }
    u16* vtc = wsp<u16>(p, O_VTSCC);
    for (int i = gt; i < 8 * 2 * 64 * 256; i += gs) {
      int pos = i & 255, dv = (i >> 8) & 63, kvh = (i >> 14) & 1, b = i >> 15;
      vtc[i] = f2bf(p.cache_v[(((size_t)b * 4 + l) * 256 + pos) * 128 + kvh * 64 + dv]);
    }
  }
}

DI void phase_gemmA(const Params& p, int l, char* smem) {
  const u16* H = wsp<u16>(p, O_H);
  const u16* W = wsw(p, l, O_WINA);
  for (int base = 0; base < 288 * 20; base += gridDim.x) {
    const int tile = xcd_map(base);
    if (tile >= 288 * 20) continue;
    const int sb = tile >> 5, jj = tile & 31;
    const int mt = (sb / 5) * 8 + (jj >> 2), nt = (sb % 5) * 4 + (jj & 3);
    const TokTile tt = tok_tile(mt);
    f32x4 acc[4][4];
    zero_acc(acc);
    gemm_tile(H + (size_t)tt.g0 * 1024, 1024, W + (size_t)nt * 128 * 1024, 1024, 1024, acc, smem);
    LANEVARS
    if (nt < 13) {
      u16* dst; int ld, cb;
      if (nt < 8) { dst = wsp<u16>(p, O_XR); ld = 1024; cb = nt * 128; }
      else if (nt < 11) { dst = wsp<u16>(p, O_CQ); ld = 384; cb = (nt - 8) * 128; }
      else { dst = wsp<u16>(p, O_CKV); ld = 256; cb = (nt - 11) * 128; }
#pragma unroll
      for (int i = 0; i < 4; ++i)
#pragma unroll
        for (int j = 0; j < 4; ++j)
#pragma unroll
          for (int e = 0; e < 4; ++e) {
            const int g = tt.g0 + wr * 64 + i * 16 + g4 * 4 + e;
            dst[(size_t)g * ld + cb + wc * 64 + j * 16 + c16] = f2bf(acc[i][j][e]);
            if (e == 3 && j == 3) SB();
          }
    } else if (nt == 13) {
      if (wc == 0) {
#pragma unroll
        for (int i = 0; i < 4; ++i)
#pragma unroll
          for (int e = 0; e < 4; ++e) {
            SB();
            const int r = wr * 64 + i * 16 + g4 * 4 + e;
            const int pos = tt.p0 + r;
            float x1 = acc[i][0][e], x2 = acc[i][1][e];
            if (tt.is_ctx) {
              u16* kr = wsp<u16>(p, O_KRC) + ((size_t)tt.b * 256 + pos) * 32;
              kr[c16] = f2bf(x1); kr[c16 + 16] = f2bf(x2);
              float* o = p.out + OUT_KROPE + (((size_t)tt.b * 4 + l) * 256 + pos) * 32;
              o[perm32(c16)] = x1; o[perm32(c16 + 16)] = x2;
            } else {
              const int pv = (c16 >= 8) ? (pos & 63) : (pos >> 6);
              const float cs = TAB_M[(pv * 8 + (c16 & 7)) * 2], sn = TAB_M[(pv * 8 + (c16 & 7)) * 2 + 1];
              u16* kr = wsp<u16>(p, O_KRL) + ((size_t)tt.b * LK_LAT + 256 + pos) * 32;
              kr[c16] = f2bf(x1 * cs - x2 * sn); kr[c16 + 16] = f2bf(x2 * cs + x1 * sn);
            }
          }
      }
    } else if (nt < 19) {
      const bool isk = (nt == 18);
      u16* dst = isk ? wsp<u16>(p, O_KS) : wsp<u16>(p, O_QS);
      const int ld = isk ? 128 : 512;
      const int cb = isk ? wc * 64 : ((nt - 14) * 2 + wc) * 64;
#pragma unroll
      for (int i = 0; i < 4; ++i)
#pragma unroll
        for (int e = 0; e < 4; ++e) {
          SB();
          const int r = wr * 64 + i * 16 + g4 * 4 + e;
          const int pos = tt.p0 + r, g = tt.g0 + r;
          float v0 = acc[i][0][e], v1 = acc[i][1][e], v2 = acc[i][2][e], v3 = acc[i][3][e];
          if (!tt.is_ctx) {
            const int pr = pos >> 6, pc = pos & 63;
            const float c0 = TAB_S[(pr * 16 + c16) * 2], s0 = TAB_S[(pr * 16 + c16) * 2 + 1];
            const float c1 = TAB_S[(pc * 16 + c16) * 2], s1 = TAB_S[(pc * 16 + c16) * 2 + 1];
            float a0 = v0 * c0 - v1 * s0, a1 = v1 * c0 + v0 * s0;
            float a2 = v2 * c1 - v3 * s1, a3 = v3 * c1 + v2 * s1;
            v0 = a0; v1 = a1; v2 = a2; v3 = a3;
          } else if (isk) {
            float* o = p.out + OUT_SK + (((size_t)tt.b * 4 + l) * 256 + pos) * 128 + cb + c16;
            o[0] = v0; o[16] = v1; o[32] = v2; o[48] = v3;
          }
          u16* d = dst + (size_t)g * ld + cb + c16;
          d[0] = f2bf(v0); d[16] = f2bf(v1); d[32] = f2bf(v2); d[48] = f2bf(v3);
        }
    } else {
      u16* vt = tt.is_ctx ? wsp<u16>(p, O_VTSC) : wsp<u16>(p, O_VTSL);
      const int L = tt.is_ctx ? 256 : 4096;
#pragma unroll
      for (int i = 0; i < 4; ++i)
#pragma unroll
        for (int j = 0; j < 4; ++j) {
          SB();
          const int r = wr * 64 + i * 16 + g4 * 4;
          const int pos = tt.p0 + r, dv = j * 16 + c16;
          uint2 o; o.x = pack2(acc[i][j][0], acc[i][j][1]); o.y = pack2(acc[i][j][2], acc[i][j][3]);
          *(uint2*)(vt + (((size_t)tt.b * 2 + wc) * 64 + dv) * L + pos) = o;
          if (tt.is_ctx) {
#pragma unroll
            for (int e = 0; e < 4; ++e)
              p.out[OUT_SV + (((size_t)tt.b * 4 + l) * 256 + pos + e) * 128 + wc * 64 + dv] = acc[i][j][e];
          }
        }
    }
  }
}

DI void row_scales(const u16* A, int K, float* s_rs) {
  const int t = tid(), row = t >> 1, half = t & 1;
  const u16* ap = A + (size_t)row * K + half * (K >> 1);
  float ss = 0.f;
  for (int c = 0; c < (K >> 4); ++c) {
    uint4 v = *(const uint4*)(ap + c * 8);
    unsigned wv[4] = {v.x, v.y, v.z, v.w};
#pragma unroll
    for (int q = 0; q < 4; ++q) {
      float a = __uint_as_float(wv[q] << 16), b = __uint_as_float(wv[q] & 0xffff0000u);
      ss += a * a + b * b;
    }
  }
  ss += __shfl_xor(ss, 1);
  if (half == 0) s_rs[row] = rsqrtf(ss / (float)K + EPS);
}

template <int MODE> DI void scan_seg(const Params& p, int l, int seq, int blk, int d, int seg, char* smem);
DI void phase_qkv(const Params& p, int l, char* smem) {
  float* s_rs = (float*)(smem + 65536);
  constexpr int NQ = 288 * 6, NKV = 304 * 8, NS1 = 2048;
  for (int base = 0; base < NS1 + NQ + NKV; base += gridDim.x) {
    const int tile0 = xcd_map(base);
    if (tile0 >= NS1 + NQ + NKV) continue;
    if (tile0 < NS1) {
      scan_seg<0>(p, l, 16 + (tile0 >> 8), (tile0 >> 5) & 7, (tile0 >> 4) & 1, tile0 & 15, smem);
#if PROBE == 4
      scan_seg<0>(p, l, 16 + (tile0 >> 8), (tile0 >> 5) & 7, (tile0 >> 4) & 1, tile0 & 15, smem);
#endif
      continue;
    }
    const int tile = tile0 - NS1;
    f32x4 acc[4][4];
    zero_acc(acc);
    if (tile < NQ) {
      const int mt = tile / 6, nt = tile % 6;
      const TokTile tt = tok_tile(mt);
      const u16* A = wsp<u16>(p, O_CQ) + (size_t)tt.g0 * 384;
      row_scales(A, 384, s_rs);
      gemm_tile(A, 384, wsw(p, l, O_WUQ) + (size_t)nt * 128 * 384, 384, 384, acc, smem);
      LANEVARS
      u16* Q = wsp<u16>(p, O_Q);
#pragma unroll
      for (int i = 0; i < 4; ++i)
#pragma unroll
        for (int e = 0; e < 4; ++e) {
          SB();
          const int r = wr * 64 + i * 16 + g4 * 4 + e;
          const int pos = tt.p0 + r, g = tt.g0 + r;
          const float rs = s_rs[r];
          float v0 = acc[i][0][e] * rs, v1 = acc[i][1][e] * rs, v2 = acc[i][2][e] * rs, v3 = acc[i][3][e] * rs;
          if (nt >= 4 && !tt.is_ctx) {
            const int pv = (c16 >= 8) ? (pos & 63) : (pos >> 6);
            const float cs = TAB_M[(pv * 8 + (c16 & 7)) * 2], sn = TAB_M[(pv * 8 + (c16 & 7)) * 2 + 1];
            float a0 = v0 * cs - v1 * sn, a1 = v1 * cs + v0 * sn;
            float a2 = v2 * cs - v3 * sn, a3 = v3 * cs + v2 * sn;
            v0 = a0; v1 = a1; v2 = a2; v3 = a3;
          }
          u16* d = Q + (size_t)g * 768 + nt * 128 + wc * 64 + c16;
          d[0] = f2bf(v0); d[16] = f2bf(v1); d[32] = f2bf(v2); d[48] = f2bf(v3);
        }
    } else {
      const int t2 = tile - NQ;
      const int mt = t2 >> 3, hd = t2 & 7;
      const u16* A; const u16* Wt; int is_ctx, seq, kp0;
      if (mt < 288) {
        const TokTile tt = tok_tile(mt);
        A = wsp<u16>(p, O_CKV) + (size_t)tt.g0 * 256;
        Wt = wsw(p, l, O_WUKVG);
        row_scales(A, 256, s_rs);
        is_ctx = tt.is_ctx; seq = tt.b; kp0 = tt.is_ctx ? tt.p0 : 256 + tt.p0;
        if (tt.is_ctx && hd == 0) {
          __syncthreads();
          const float* gkv = p.kv_norm + l * 256;
          for (int idx = tid(); idx < 128 * 256; idx += 256) {
            const int r = idx >> 8, k = idx & 255;
            p.out[OUT_CKV + (((size_t)tt.b * 4 + l) * 256 + tt.p0 + r) * 256 + k] = bf2f(A[(size_t)r * 256 + k]) * s_rs[r] * gkv[k];
          }
        }
      } else {
        const int row0 = (mt - 288) * 128;
        A = wsp<u16>(p, O_CKVC) + (size_t)row0 * 256;
        Wt = wsw(p, l, O_WUKVR);
        { const int t1 = tid(); if (t1 < 128) s_rs[t1] = 1.f; }
        is_ctx = 0; seq = row0 >> 8; kp0 = row0 & 255;
      }
      gemm_tile(A, 256, Wt + (size_t)hd * 128 * 256, 256, 256, acc, smem);
      LANEVARS
      const int Lk = is_ctx ? 256 : LK_LAT;
      if (wc == 0) {
        u16* Kn = (is_ctx ? wsp<u16>(p, O_KNC) : wsp<u16>(p, O_KNL)) + ((size_t)seq * 8 + hd) * Lk * 64;
#pragma unroll
        for (int i = 0; i < 4; ++i)
#pragma unroll
          for (int j = 0; j < 4; ++j)
#pragma unroll
            for (int e = 0; e < 4; ++e) {
              const int r = wr * 64 + i * 16 + g4 * 4 + e;
              Kn[(size_t)(kp0 + r) * 64 + j * 16 + c16] = f2bf(acc[i][j][e] * s_rs[r]);
              if (e == 3) SB();
            }
      } else {
        u16* Vt = (is_ctx ? wsp<u16>(p, O_VTC) : wsp<u16>(p, O_VTL)) + ((size_t)seq * 8 + hd) * 64 * Lk;
#pragma unroll
        for (int i = 0; i < 4; ++i)
#pragma unroll
          for (int j = 0; j < 4; ++j) {
            SB();
            const int r = wr * 64 + i * 16 + g4 * 4;
            uint2 o;
            o.x = pack2(acc[i][j][0] * s_rs[r], acc[i][j][1] * s_rs[r + 1]);
            o.y = pack2(acc[i][j][2] * s_rs[r + 2], acc[i][j][3] * s_rs[r + 3]);
            *(uint2*)(Vt + (size_t)(j * 16 + c16) * Lk + kp0 + r) = o;
          }
      }
    }
    __syncthreads();
  }
}

template <int NS> DI void attn_gload(const int t, const u16* k0, int k0s, const u16* k1, const u16* vt, int vts,
                                     uint4& rk0, uint4& rk1, uint4& rk2, uint4& rv0, uint4& rv1) {
  if (NS == 6) {
    { const int c = t, key = c / 12, ch = c % 12;
      rk0 = (ch < 8) ? *(const uint4*)(k0 + (size_t)key * k0s + ch * 8) : *(const uint4*)(k1 + (size_t)key * 32 + (ch - 8) * 8); }
    { const int c = t + 256, key = c / 12, ch = c % 12;
      rk1 = (ch < 8) ? *(const uint4*)(k0 + (size_t)key * k0s + ch * 8) : *(const uint4*)(k1 + (size_t)key * 32 + (ch - 8) * 8); }
    { const int c = t + 512, key = c / 12, ch = c % 12;
      rk2 = (ch < 8) ? *(const uint4*)(k0 + (size_t)key * k0s + ch * 8) : *(const uint4*)(k1 + (size_t)key * 32 + (ch - 8) * 8); }
  } else {
    { const int c = t, key = c >> 3, ch = c & 7; rk0 = *(const uint4*)(k0 + (size_t)key * k0s + ch * 8); }
    { const int c = t + 256, key = c >> 3, ch = c & 7; rk1 = *(const uint4*)(k0 + (size_t)key * k0s + ch * 8); }
  }
  { const int c = t, dv = c >> 3, ch = c & 7; rv0 = *(const uint4*)(vt + (size_t)dv * vts + ch * 8); }
  { const int c = t + 256, dv = c >> 3, ch = c & 7; rv1 = *(const uint4*)(vt + (size_t)dv * vts + ch * 8); }
}
template <int NS> DI void attn_sstore(const int t, char* smem, const uint4& rk0, const uint4& rk1, const uint4& rk2, const uint4& rv0, const uint4& rv1) {
  constexpr int KSTR = (NS == 6) ? 208 : 144;
  if (NS == 6) {
    { const int c = t, key = c / 12, ch = c % 12; *(uint4*)(smem + key * KSTR + ch * 16) = rk0; }
    { const int c = t + 256, key = c / 12, ch = c % 12; *(uint4*)(smem + key * KSTR + ch * 16) = rk1; }
    { const int c = t + 512, key = c / 12, ch = c % 12; *(uint4*)(smem + key * KSTR + ch * 16) = rk2; }
  } else {
    { const int c = t, key = c >> 3, ch = c & 7; *(uint4*)(smem + key * KSTR + ch * 16) = rk0; }
    { const int c = t + 256, key = c >> 3, ch = c & 7; *(uint4*)(smem + key * KSTR + ch * 16) = rk1; }
  }
  { const int c = t, dv = c >> 3, ch = c & 7; char* d = smem + 13312 + dv * 136 + ch * 16;
    *(uint2*)d = uint2{rv0.x, rv0.y}; *(uint2*)(d + 8) = uint2{rv0.z, rv0.w}; }
  { const int c = t + 256, dv = c >> 3, ch = c & 7; char* d = smem + 13312 + dv * 136 + ch * 16;
    *(uint2*)d = uint2{rv1.x, rv1.y}; *(uint2*)(d + 8) = uint2{rv1.z, rv1.w}; }
}

#define PACK8(S, s2) __builtin_bit_cast(bf16x8, uint4{pack2(S[8 * (s2)], S[8 * (s2) + 1]), pack2(S[8 * (s2) + 2], S[8 * (s2) + 3]), \
                                                        pack2(S[8 * (s2) + 4], S[8 * (s2) + 5]), pack2(S[8 * (s2) + 6], S[8 * (s2) + 7])})

template <int NS>
DI void attn_item(const u16* kA, int kAs, const u16* krA, const u16* vtA, int vtAs, int nA, int kposA, int maskA,
                  const u16* kB, int kBs, const u16* vtB, int vtBs, int nB,
                  const u16* qa, const u16* qb, float sc2, float m0, float l0, int qpos, u16* yrow, char* smem) {
  constexpr int KSTR = (NS == 6) ? 208 : 144;
  const int tt_ = tid();
  const int lane = tt_ & 63;
  const int r32 = lane & 31, hh = lane >> 5;
  bf16x8 qf0, qf1, qf2, qf3, qf4, qf5;
  qf0 = *(const bf16x8*)(qa + 0 + 8 * hh); qf1 = *(const bf16x8*)(qa + 16 + 8 * hh);
  qf2 = *(const bf16x8*)(qa + 32 + 8 * hh); qf3 = *(const bf16x8*)(qa + 48 + 8 * hh);
  if (NS == 6) { qf4 = *(const bf16x8*)(qb + 0 + 8 * hh); qf5 = *(const bf16x8*)(qb + 16 + 8 * hh); }
  else { qf4 = qf0; qf5 = qf0; }
#define QSCALE(qf) { uint4 u_ = __builtin_bit_cast(uint4, qf); \
    u_.x = pack2(__uint_as_float(u_.x << 16) * sc2, __uint_as_float(u_.x & 0xffff0000u) * sc2); \
    u_.y = pack2(__uint_as_float(u_.y << 16) * sc2, __uint_as_float(u_.y & 0xffff0000u) * sc2); \
    u_.z = pack2(__uint_as_float(u_.z << 16) * sc2, __uint_as_float(u_.z & 0xffff0000u) * sc2); \
    u_.w = pack2(__uint_as_float(u_.w << 16) * sc2, __uint_as_float(u_.w & 0xffff0000u) * sc2); \
    qf = __builtin_bit_cast(bf16x8, u_); }
  QSCALE(qf0) QSCALE(qf1) QSCALE(qf2) QSCALE(qf3)
  if (NS == 6) { QSCALE(qf4) QSCALE(qf5) }
#undef QSCALE
  f32x16 O0, O1;
#pragma unroll
  for (int e = 0; e < 16; ++e) { O0[e] = 0.f; O1[e] = 0.f; }
  float m_run = m0, l_run = l0;
  uint4 rk0, rk1, rk2, rv0, rv1;
  rk2 = uint4{0, 0, 0, 0};
  const int ntiles = nA + nB;
#define TILE_GLOAD(jn) { if ((jn) < nA) attn_gload<NS>(tt_, kA + (size_t)(jn) * 64 * kAs, kAs, krA + (size_t)(jn) * 64 * 32, vtA + (jn) * 64, vtAs, rk0, rk1, rk2, rv0, rv1); \
    else { const int jb_ = (jn) - nA; attn_gload<NS>(tt_, kB + (size_t)jb_ * 64 * kBs, kBs, nullptr, vtB + jb_ * 64, vtBs, rk0, rk1, rk2, rv0, rv1); } }
  constexpr int STG = 22528;
  TILE_GLOAD(0)
  attn_sstore<NS>(tt_, smem, rk0, rk1, rk2, rv0, rv1);
  if (ntiles > 1) TILE_GLOAD(1)
  __syncthreads();
  for (int j = 0; j < ntiles; ++j) {
    char* sbase = smem + (j & 1) * STG;
    const int kpos = kposA + 64 * j;
    const bool masked = maskA && (j < nA);
    MB();
    f32x16 S0, S1;
#pragma unroll
    for (int e = 0; e < 16; ++e) { S0[e] = 0.f; S1[e] = 0.f; }
    const char* ka0 = sbase + r32 * KSTR + 16 * hh;
    const char* ka1 = sbase + (32 + r32) * KSTR + 16 * hh;
#define QK_STEP(s, qf) { bf16x8 a0 = *(const bf16x8*)(ka0 + 32 * (s)); bf16x8 a1 = *(const bf16x8*)(ka1 + 32 * (s)); \
      S0 = __builtin_amdgcn_mfma_f32_32x32x16_bf16(a0, qf, S0, 0, 0, 0); S1 = __builtin_amdgcn_mfma_f32_32x32x16_bf16(a1, qf, S1, 0, 0, 0); }
    QK_STEP(0, qf0) QK_STEP(1, qf1) QK_STEP(2, qf2) QK_STEP(3, qf3)
    if (NS == 6) { QK_STEP(4, qf4) QK_STEP(5, qf5) }
    SB();
    float mx = m_run;
#pragma unroll
    for (int e = 0; e < 16; ++e) {
      float v0 = S0[e], v1 = S1[e];
      if (masked) {
        const int kp = kpos + (e & 3) + 8 * (e >> 2) + 4 * hh;
        int d0 = qpos - kp; d0 = d0 < 0 ? -d0 : d0;
        int d1 = qpos - (kp + 32); d1 = d1 < 0 ? -d1 : d1;
        if (d0 > 128) v0 = -1e30f;
        if (d1 > 128) v1 = -1e30f;
      }
      S0[e] = v0; S1[e] = v1;
      mx = fmaxf(mx, fmaxf(v0, v1));
    }
    mx = fmaxf(mx, __shfl_xor(mx, 32));
    const float alpha = __builtin_amdgcn_exp2f(m_run - mx);
    m_run = mx;
    const f2_t m2 = {mx, mx};
    f2_t rs2 = {0.f, 0.f};
#pragma unroll
    for (int e = 0; e < 16; e += 2) {
      const f2_t d0 = f2_t{S0[e], S0[e + 1]} - m2, d1 = f2_t{S1[e], S1[e + 1]} - m2;
      const f2_t p0 = {__builtin_amdgcn_exp2f(d0.x), __builtin_amdgcn_exp2f(d0.y)};
      const f2_t p1 = {__builtin_amdgcn_exp2f(d1.x), __builtin_amdgcn_exp2f(d1.y)};
      S0[e] = p0.x; S0[e + 1] = p0.y; S1[e] = p1.x; S1[e + 1] = p1.y;
      rs2 += p0 + p1;
    }
    float rsum = rs2.x + rs2.y;
    rsum += __shfl_xor(rsum, 32);
    l_run = l_run * alpha + rsum;
#pragma unroll
    for (int e = 0; e < 16; ++e) { O0[e] *= alpha; O1[e] *= alpha; }
    const char* sv0 = sbase + 13312 + r32 * 136 + 8 * hh;
    const char* sv1 = sv0 + 32 * 136;
#define PV_STEP(pb, ka) { \
      { uint2 lo = *(const uint2*)(sv0 + (ka) * 2), hi = *(const uint2*)(sv0 + (ka) * 2 + 16); \
        bf16x8 va = __builtin_bit_cast(bf16x8, uint4{lo.x, lo.y, hi.x, hi.y}); O0 = __builtin_amdgcn_mfma_f32_32x32x16_bf16(va, pb, O0, 0, 0, 0); } \
      { uint2 lo = *(const uint2*)(sv1 + (ka) * 2), hi = *(const uint2*)(sv1 + (ka) * 2 + 16); \
        bf16x8 va = __builtin_bit_cast(bf16x8, uint4{lo.x, lo.y, hi.x, hi.y}); O1 = __builtin_amdgcn_mfma_f32_32x32x16_bf16(va, pb, O1, 0, 0, 0); } }
    SB();
    { bf16x8 pb = PACK8(S0, 0); PV_STEP(pb, 0) }
    { bf16x8 pb = PACK8(S0, 1); PV_STEP(pb, 16) }
    SB();
    { bf16x8 pb = PACK8(S1, 0); PV_STEP(pb, 32) }
    { bf16x8 pb = PACK8(S1, 1); PV_STEP(pb, 48) }
    SB();
    if (j + 1 < ntiles) {
      attn_sstore<NS>(tt_, smem + ((j + 1) & 1) * STG, rk0, rk1, rk2, rv0, rv1);
      if (j + 2 < ntiles) TILE_GLOAD(j + 2)
    }
    __syncthreads();
  }
#undef TILE_GLOAD
  const float inv = 1.f / l_run;
#pragma unroll
  for (int e4 = 0; e4 < 4; ++e4) {
    uint2 o;
    o.x = pack2(O0[4 * e4] * inv, O0[4 * e4 + 1] * inv); o.y = pack2(O0[4 * e4 + 2] * inv, O0[4 * e4 + 3] * inv);
    *(uint2*)(yrow + 8 * e4 + 4 * hh) = o;
    o.x = pack2(O1[4 * e4] * inv, O1[4 * e4 + 1] * inv); o.y = pack2(O1[4 * e4 + 2] * inv, O1[4 * e4 + 3] * inv);
    *(uint2*)(yrow + 32 + 8 * e4 + 4 * hh) = o;
  }
}

template <int MODE>
DI void scan_seg(const Params& p, int l, int seq, int blk, int d, int seg, char* smem) {
  const int t = tid(), lane = t & 63, w = t >> 6;
  const int c16 = lane & 15, g4 = lane >> 4;
  const bool is_ctx = seq < 16;
  const int b = is_ctx ? seq : seq - 16;
  const int L = is_ctx ? 256 : 4096;
  const int gbase = is_ctx ? b * 256 : T_CTX + b * 4096;
  const u16* XR = wsp<u16>(p, O_XR);
  u16* Y = wsp<u16>(p, O_YRNN);
  float* SUM = wsp<float>(p, O_SUM);
  char* sXc = smem;
  float* sA = (float*)(smem + 8704);
  float* sU = (float*)(smem + 8704 + 16384);
  const int cch = t & 127, th = t >> 7;
  const int chg = blk * 128 + cch;
  const float w0 = p.conv_w[(l * 4 + 0) * 1024 + chg], w1 = p.conv_w[(l * 4 + 1) * 1024 + chg];
  const float w2 = p.conv_w[(l * 4 + 2) * 1024 + chg], w3 = p.conv_w[(l * 4 + 3) * 1024 + chg];
  const float cb = p.conv_b[l * 1024 + chg];
  bf16x8 bw[4][4];
  {
    const u16* WL = wsw(p, l, O_WLRU) + (size_t)(d * 8 + blk) * 256 * 128 + (size_t)(32 * w + c16) * 128 + g4 * 8;
#pragma unroll
    for (int nf = 0; nf < 4; ++nf)
#pragma unroll
      for (int ks = 0; ks < 4; ++ks)
        bw[nf][ks] = *(const bf16x8*)(WL + (size_t)((nf & 1) * 16 + (nf >> 1) * 128) * 128 + ks * 32);
  }
  float ba[2], bi[2], cl[2];
#pragma unroll
  for (int jn = 0; jn < 2; ++jn) {
    const int ch = (l * 2 + d) * 1024 + blk * 128 + 32 * w + 16 * jn + c16;
    ba[jn] = p.lru_ba[ch]; bi[jn] = p.lru_bi[ch];
    cl[jn] = -8.f * log1pf(__expf(-p.lru_lam[ch]));
  }
  float h = 0.f, P = 1.f;
  if (MODE == 1 && !is_ctx && t < 128) {
    h = p.state[(((size_t)b * 4 + l) * 2 + d) * 1024 + blk * 128 + t];
    const float* sm = SUM + ((size_t)((b * 8 + blk) * 2 + d) * 16) * 256 + t;
    float Pv[16], Hv[16];
#pragma unroll
    for (int s2 = 0; s2 < 16; ++s2) { Pv[s2] = sm[s2 * 256]; Hv[s2] = sm[s2 * 256 + 128]; }
    if (d == 0) {
#pragma unroll
      for (int s2 = 0; s2 < 16; ++s2) if (s2 < seg) h = Pv[s2] * h + Hv[s2];
    } else {
#pragma unroll
      for (int s2 = 15; s2 >= 0; --s2) if (s2 > seg) h = Pv[s2] * h + Hv[s2];
    }
  }
#define X19(F) F(0) F(1) F(2) F(3) F(4) F(5) F(6) F(7) F(8) F(9) F(10) F(11) F(12) F(13) F(14) F(15) F(16) F(17) F(18)
#define XDECL(q) u16 xr##q = 0;
#define XLOAD(q) { const int pos = tcn + th * 16 - 1 + (q); xr##q = (pos >= 0 && pos < L) ? XR[(size_t)(gbase + pos) * 1024 + chg] : (u16)0; }
#define XCVT(q) xv[q] = bf2f(xr##q);
  X19(XDECL)
  { const int tcn = seg * 256 + (d == 0 ? 0 : 7) * 32; X19(XLOAD) }
  for (int ci = 0; ci < 8; ++ci) {
    const int tc0 = seg * 256 + (d == 0 ? ci : 7 - ci) * 32;
    {
      float xv[19];
      X19(XCVT)
#pragma unroll
      for (int q = 0; q < 16; ++q) {
        float xc = cb + w0 * xv[q] + w1 * xv[q + 1] + w2 * xv[q + 2] + w3 * xv[q + 3];
        *(u16*)(sXc + (th * 16 + q) * 272 + cch * 2) = f2bf(xc);
      }
    }
    unsigned yold0 = 0, yold1 = 0, yold2 = 0, yold3 = 0, yold4 = 0, yold5 = 0, yold6 = 0, yold7 = 0;
    {
      const int cn = ci < 7 ? ci + 1 : ci;
      const int tcn = seg * 256 + (d == 0 ? cn : 7 - cn) * 32;
      X19(XLOAD)
      if (MODE == 1 && d == 1) {
        const unsigned* yb = (const unsigned*)(Y + (size_t)(gbase + tc0 + (t >> 6)) * 1024 + blk * 128 + (t & 63) * 2);
        yold0 = yb[0]; yold1 = yb[4 * 512]; yold2 = yb[8 * 512]; yold3 = yb[12 * 512];
        yold4 = yb[16 * 512]; yold5 = yb[20 * 512]; yold6 = yb[24 * 512]; yold7 = yb[28 * 512];
      }
    }
    MB();
    __syncthreads();
    f32x4 aR[2][2], aI[2][2];
#pragma unroll
    for (int im = 0; im < 2; ++im)
#pragma unroll
      for (int jn = 0; jn < 2; ++jn) { aR[im][jn] = f32x4{0.f, 0.f, 0.f, 0.f}; aI[im][jn] = f32x4{0.f, 0.f, 0.f, 0.f}; }
#pragma unroll
    for (int ks = 0; ks < 4; ++ks)
#pragma unroll
      for (int im = 0; im < 2; ++im) {
        bf16x8 af = *(const bf16x8*)(sXc + (16 * im + c16) * 272 + (ks * 32 + g4 * 8) * 2);
#pragma unroll
        for (int jn = 0; jn < 2; ++jn) {
          aR[im][jn] = __builtin_amdgcn_mfma_f32_16x16x32_bf16(af, bw[jn][ks], aR[im][jn], 0, 0, 0);
          aI[im][jn] = __builtin_amdgcn_mfma_f32_16x16x32_bf16(af, bw[2 + jn][ks], aI[im][jn], 0, 0, 0);
        }
      }
#pragma unroll
    for (int im = 0; im < 2; ++im)
#pragma unroll
      for (int jn = 0; jn < 2; ++jn)
#pragma unroll
        for (int e = 0; e < 4; ++e) {
          const int tt = 16 * im + 4 * g4 + e, c = 32 * w + 16 * jn + c16;
          const float r = sigmoidf_(aR[im][jn][e] + ba[jn]);
          const float ig = sigmoidf_(aI[im][jn][e] + bi[jn]);
          const float a = __expf(cl[jn] * r);
          const float xc = bf2f(*(const u16*)(sXc + tt * 272 + c * 2));
          const float u = __builtin_amdgcn_sqrtf(fmaxf(1.f - a * a, 0.f)) * ig * xc;
          sA[tt * 128 + c] = a; sU[tt * 128 + c] = u;
        }
    __syncthreads();
    if (t < 128) {
      if (d == 0) {
#pragma unroll 8
        for (int s = 0; s < 32; ++s) {
          const float a = sA[s * 128 + t];
          h = a * h + sU[s * 128 + t];
          if (MODE == 0) P *= a; else sU[s * 128 + t] = h;
        }
      } else {
#pragma unroll 8
        for (int s = 31; s >= 0; --s) {
          const float a = sA[s * 128 + t];
          h = a * h + sU[s * 128 + t];
          if (MODE == 0) P *= a; else sU[s * 128 + t] = h;
        }
      }
    }
    __syncthreads();
    if (MODE == 1) {
      const int c2 = (t & 63) * 2;
      unsigned* yb = (unsigned*)(Y + (size_t)(gbase + tc0 + (t >> 6)) * 1024 + blk * 128 + c2);
      const float* su = sU + (t >> 6) * 128 + c2;
#define YOUT(i, yo) { float h0 = su[(4 * (i)) * 128], h1 = su[(4 * (i)) * 128 + 1]; \
        if (d == 1) { h0 += __uint_as_float((yo) << 16); h1 += __uint_as_float((yo) & 0xffff0000u); } \
        yb[(size_t)(4 * (i)) * 512] = pack2(h0, h1); }
      YOUT(0, yold0) YOUT(1, yold1) YOUT(2, yold2) YOUT(3, yold3) YOUT(4, yold4) YOUT(5, yold5) YOUT(6, yold6) YOUT(7, yold7)
#undef YOUT
    }
  }
#undef X19
#undef XDECL
#undef XLOAD
#undef XCVT
  if (MODE == 0) {
    if (t < 128) {
      float* sm = SUM + ((size_t)(((b * 8 + blk) * 2 + d) * 16 + seg)) * 256 + t;
      sm[0] = P; sm[128] = h;
    }
  } else if (is_ctx && t < 128) {
    p.out[OUT_RG + (((size_t)b * 4 + l) * 2 + d) * 1024 + blk * 128 + t] = h;
  }
  __syncthreads();
}

DI void phase_mix(const Params& p, int l, char* smem) {
  constexpr float LOG2E = 1.4426950408889634f;
  constexpr int N0 = 1024, N1 = N0 + 2048, N2 = N1 + 2048, N3 = N2 + 128, N4 = N3 + 256, N5 = N4 + 256;
  for (int base = 0; base < N5; base += gridDim.x) {
    const int vit = xcd_map(base);
    if (vit >= N5) continue;
    const int it = vit < N0 ? vit : (vit < N0 + 128 ? N2 + (vit - N0) : (vit < N3 ? vit - 128 : vit));
    const int t = tid(), lane = t & 63, w = t >> 6;
    const int r32 = lane & 31;
    if (it < N0 || (it >= N2 && it < N3)) {
      int seq, blk, seg;
      if (it < N0) { seg = it & 15; blk = (it >> 4) & 7; seq = 16 + (it >> 7); }
      else { const int i = it - N2; seg = 0; blk = i & 7; seq = i >> 3; }
      scan_seg<1>(p, l, seq, blk, 0, seg, smem);
      scan_seg<1>(p, l, seq, blk, 1, seg, smem);
#if PROBE == 4
      scan_seg<1>(p, l, seq, blk, 0, seg, smem);
      scan_seg<1>(p, l, seq, blk, 1, seg, smem);
#endif
    } else if (it < N1 || (it >= N3 && it < N4)) {
      const bool lat = it < N1;
      int b, h, qb;
      if (lat) { const int i = it - N0; qb = i & 31; h = (i >> 5) & 7; b = i >> 8; }
      else { const int i = it - N3; qb = i & 1; h = (i >> 1) & 7; b = i >> 4; }
      const int Lk = lat ? LK_LAT : 256;
      const int gq = (lat ? T_CTX + b * 4096 : b * 256) + qb * 128 + w * 32 + r32;
      const u16* Kn = (lat ? wsp<u16>(p, O_KNL) : wsp<u16>(p, O_KNC)) + ((size_t)b * 8 + h) * Lk * 64;
      const u16* Kr = (lat ? wsp<u16>(p, O_KRL) : wsp<u16>(p, O_KRC)) + (size_t)b * Lk * 32;
      const u16* Vt = (lat ? wsp<u16>(p, O_VTL) : wsp<u16>(p, O_VTC)) + ((size_t)b * 8 + h) * 64 * Lk;
      const u16* Q = wsp<u16>(p, O_Q) + (size_t)gq * 768;
      u16* yrow = wsp<u16>(p, O_CQ) + (size_t)gq * 512 + h * 64;
      attn_item<6>(Kn, 64, Kr, Vt, Lk, Lk >> 6, 0, 0, nullptr, 0, nullptr, 0, 0,
                   Q + h * 64, Q + 512 + h * 32, 0.10206207261596577f * LOG2E, -1e30f, 0.f, 0, yrow, smem);
#if PROBE == 5
      __syncthreads();
      attn_item<6>(Kn, 64, Kr, Vt, Lk, Lk >> 6, 0, 0, nullptr, 0, nullptr, 0, 0,
                   Q + h * 64, Q + 512 + h * 32, 0.10206207261596577f * LOG2E, -1e30f, 0.f, 0, yrow, smem);
#endif
    } else {
      const bool lat = it < N2;
      int b, h, qb;
      if (lat) { const int i = it - N1; qb = i & 31; h = (i >> 5) & 7; b = i >> 8; }
      else { const int i = it - N4; qb = i & 1; h = (i >> 1) & 7; b = i >> 4; }
      const int kvh = h >> 2;
      const int gseq = lat ? T_CTX + b * 4096 : b * 256;
      const int qpos = qb * 128 + w * 32 + r32;
      const int gq = gseq + qpos;
      u16* qrow = wsp<u16>(p, O_QS) + (size_t)gq * 512 + h * 64;
      const float sink2 = p.sink[l * 8 + h] * LOG2E;
      const int t0 = qb * 128;
      int jlo = 0, jhi = 6;
      if (t0 == 0) jlo = 2;
      if (t0 + 128 >= 4096) jhi = 4;
      const int ks0 = lat ? t0 - 128 + 64 * jlo : 0;
      const int nA = lat ? jhi - jlo : 4;
      const u16* KS = wsp<u16>(p, O_KS) + (size_t)(gseq + ks0) * 128 + kvh * 64;
      const u16* VT = lat ? wsp<u16>(p, O_VTSL) + ((size_t)b * 2 + kvh) * 64 * 4096 + ks0
                          : wsp<u16>(p, O_VTSC) + ((size_t)b * 2 + kvh) * 64 * 256;
      const u16* KC = wsp<u16>(p, O_KSC) + (size_t)b * 256 * 128 + kvh * 64;
      const u16* VC = wsp<u16>(p, O_VTSCC) + ((size_t)b * 2 + kvh) * 64 * 256;
      attn_item<4>(KS, 128, nullptr, VT, lat ? 4096 : 256, nA, ks0, lat ? 1 : 0, KC, 128, VC, 256, lat ? 4 : 0,
                   qrow, nullptr, 0.125f * LOG2E, sink2, 1.f, qpos, qrow, smem);
    }
    __syncthreads();
  }
}

DI void phase_gate(const Params& p, int l, char* smem) {
  const u16* H = wsp<u16>(p, O_H);
  const u16* W = wsw(p, l, O_WINB);
  for (int base = 0; base < 288 * 40; base += gridDim.x) {
    const int tile = xcd_map(base);
    if (tile >= 288 * 40) continue;
    const int sb = tile >> 6, jj = tile & 63;
    const int mt = (sb / 5) * 8 + (jj >> 3), nt = (sb % 5) * 8 + (jj & 7);
    const int g0 = mt * 128;
    f32x4 acc[4][4];
    zero_acc(acc);
    gemm_tile_T(H + (size_t)g0 * 1024, 1024, W + (size_t)nt * 128 * 1024, 1024, 1024, acc, smem);
    LANEVARS
    if (nt < 16) {
      u16* dst; int ld, cb;
      if (nt < 8) { dst = wsp<u16>(p, O_YRNN); ld = 1024; cb = nt * 128; }
      else if (nt < 12) { dst = wsp<u16>(p, O_CQ); ld = 512; cb = (nt - 8) * 128; }
      else { dst = wsp<u16>(p, O_QS); ld = 512; cb = (nt - 12) * 128; }
#pragma unroll
      for (int i = 0; i < 4; ++i)
#pragma unroll
        for (int j = 0; j < 4; ++j) {
          const int g = g0 + wr * 64 + i * 16 + c16;
          uint2* d = (uint2*)(dst + (size_t)g * ld + cb + wc * 64 + j * 16 + g4 * 4);
          const uint2 y = *d;
          const float g0v = acc[i][j][0], g1v = acc[i][j][1], g2v = acc[i][j][2], g3v = acc[i][j][3];
          uint2 o;
          o.x = pack2(__uint_as_float(y.x << 16) * g0v * sigmoidf_(g0v), __uint_as_float(y.x & 0xffff0000u) * g1v * sigmoidf_(g1v));
          o.y = pack2(__uint_as_float(y.y << 16) * g2v * sigmoidf_(g2v), __uint_as_float(y.y & 0xffff0000u) * g3v * sigmoidf_(g3v));
          *d = o;
          SB();
        }
    } else {
      const int br = (nt - 16) >> 3, cb = ((nt - 16) & 7) * 128;
      u16* dst = br == 0 ? wsp<u16>(p, O_XR) : wsp<u16>(p, O_KS) + (size_t)(br - 1) * T_ALL * 1024;
#pragma unroll
      for (int i = 0; i < 4; ++i)
#pragma unroll
        for (int j = 0; j < 4; ++j) {
          const int g = g0 + wr * 64 + i * 16 + c16;
          uint2 o;
          o.x = pack2(sigmoidf_(acc[i][j][0]), sigmoidf_(acc[i][j][1]));
          o.y = pack2(sigmoidf_(acc[i][j][2]), sigmoidf_(acc[i][j][3]));
          *(uint2*)(dst + (size_t)g * 1024 + cb + wc * 64 + j * 16 + g4 * 4) = o;
          SB();
        }
    }
  }
}

DI void phase_merge(const Params& p, int l, char* smem) {
  u16* U = wsp<u16>(p, O_H);
  for (int base = 0; base < 288 * 8; base += gridDim.x) {
    const int tile = xcd_map(base);
    if (tile >= 288 * 8) continue;
    const int mt = tile >> 3, nt = tile & 7;
    const int g0 = mt * 128;
    unsigned up[4][4][2];
#pragma unroll
    for (int i = 0; i < 4; ++i)
#pragma unroll
      for (int j = 0; j < 4; ++j) { up[i][j][0] = 0u; up[i][j][1] = 0u; }
    for (int br = 0; br < 3; ++br) {
      f32x4 acc[4][4];
      zero_acc(acc);
      const u16* Z; const u16* WT; int kz; const u16* M;
      if (br == 0) { Z = wsp<u16>(p, O_YRNN) + (size_t)g0 * 1024; WT = wsw(p, l, O_WBRR) + (size_t)nt * 128 * 1024; kz = 1024; M = wsp<u16>(p, O_XR); }
      else if (br == 1) { Z = wsp<u16>(p, O_CQ) + (size_t)g0 * 512; WT = wsw(p, l, O_WBRM) + (size_t)nt * 128 * 512; kz = 512; M = wsp<u16>(p, O_KS); }
      else { Z = wsp<u16>(p, O_QS) + (size_t)g0 * 512; WT = wsw(p, l, O_WBRS) + (size_t)nt * 128 * 512; kz = 512; M = wsp<u16>(p, O_KS) + (size_t)T_ALL * 1024; }
      gemm_tile_T(Z, kz, WT, kz, kz, acc, smem);
      LANEVARS
#pragma unroll
      for (int i = 0; i < 4; ++i)
#pragma unroll
        for (int j = 0; j < 4; ++j) {
          const int g = g0 + wr * 64 + i * 16 + c16;
          const uint2 mv = *(const uint2*)(M + (size_t)g * 1024 + nt * 128 + wc * 64 + j * 16 + g4 * 4);
          const float u0 = __uint_as_float(up[i][j][0] << 16) + __uint_as_float(mv.x << 16) * acc[i][j][0];
          const float u1 = __uint_as_float(up[i][j][0] & 0xffff0000u) + __uint_as_float(mv.x & 0xffff0000u) * acc[i][j][1];
          const float u2 = __uint_as_float(up[i][j][1] << 16) + __uint_as_float(mv.y << 16) * acc[i][j][2];
          const float u3 = __uint_as_float(up[i][j][1] & 0xffff0000u) + __uint_as_float(mv.y & 0xffff0000u) * acc[i][j][3];
          up[i][j][0] = pack2(u0, u1); up[i][j][1] = pack2(u2, u3);
          SB();
        }
    }
    LANEVARS
#pragma unroll
    for (int i = 0; i < 4; ++i)
#pragma unroll
      for (int j = 0; j < 4; ++j) {
        const int g = g0 + wr * 64 + i * 16 + c16;
        *(uint2*)(U + (size_t)g * 1024 + nt * 128 + wc * 64 + j * 16 + g4 * 4) = uint2{up[i][j][0], up[i][j][1]};
      }
  }
}

DI void phase_out(const Params& p, int l, char* smem) {
  const u16* U = wsp<u16>(p, O_H);
  const u16* W = wsw(p, l, O_WOUT);
  const float* MOD = wsp<float>(p, O_MOD) + (size_t)l * 9 * 3072;
  for (int base = 0; base < 288 * 8; base += gridDim.x) {
    const int tile = xcd_map(base);
    if (tile >= 288 * 8) continue;
    const int mt = tile >> 3, nt = tile & 7;
    const int g0 = mt * 128;
    const int ci = g0 < T_CTX ? 8 : ((g0 - T_CTX) >> 12);
    f32x4 acc[4][4];
    zero_acc(acc);
    gemm_tile_T(U + (size_t)g0 * 1024, 1024, W + (size_t)nt * 128 * 1024, 1024, 1024, acc, smem);
    LANEVARS
#pragma unroll
    for (int j = 0; j < 4; ++j) {
      const int col = nt * 128 + wc * 64 + j * 16 + g4 * 4;
      const float4 gt = *(const float4*)(MOD + ci * 3072 + 2048 + col);
#pragma unroll
      for (int i = 0; i < 4; ++i) {
        const int g = g0 + wr * 64 + i * 16 + c16;
        const float4 xo = *(const float4*)(xin_row(p, l, g) + col);
        float4 r;
        r.x = xo.x + gt.x * acc[i][j][0]; r.y = xo.y + gt.y * acc[i][j][1];
        r.z = xo.z + gt.z * acc[i][j][2]; r.w = xo.w + gt.w * acc[i][j][3];
        *(float4*)(p.out + (size_t)g * 1024 + col) = r;
        SB();
      }
    }
  }
}

DI void phase_final(const Params& p) {
  const int t = tid(), lane = t & 63, w = t >> 6;
  for (int row = blockIdx.x * 4 + w; row < T_ALL; row += gridDim.x * 4) {
    float* x = p.out + (size_t)row * 1024;
    float4 v[4];
    float ss = 0.f;
#pragma unroll
    for (int i = 0; i < 4; ++i) {
      v[i] = *(const float4*)(x + i * 256 + lane * 4);
      ss += v[i].x * v[i].x + v[i].y * v[i].y + v[i].z * v[i].z + v[i].w * v[i].w;
    }
    ss = wave_sum(ss);
    const float rs = rsqrtf(ss * (1.f / 1024.f) + EPS);
#pragma unroll
    for (int i = 0; i < 4; ++i) {
      const int c = i * 256 + lane * 4;
      const float4 g = *(const float4*)(p.final_norm + c);
      float4 o = {v[i].x * rs * g.x, v[i].y * rs * g.y, v[i].z * rs * g.z, v[i].w * rs * g.w};
      *(float4*)(x + c) = o;
    }
  }
}

constexpr int NPHASE_PER_LAYER = 7;
DI void run_phase(const Params& p, int ph, char* smem) {
  if (ph == 0) { phase_mod(p, smem); return; }
  if (ph == 1 + NLAYER * NPHASE_PER_LAYER) { phase_final(p); return; }
  const int l = (ph - 1) / NPHASE_PER_LAYER, s = (ph - 1) % NPHASE_PER_LAYER;
  switch (s) {
    case 0: phase_prep(p, l); break;
    case 1: phase_gemmA(p, l, smem); break;
    case 2: phase_qkv(p, l, smem); break;
    case 3: phase_mix(p, l, smem); break;
    case 4: phase_gate(p, l, smem); break;
    case 5: phase_merge(p, l, smem); break;
    default: phase_out(p, l, smem); break;
  }
}
constexpr int NPHASE = 2 + NLAYER * NPHASE_PER_LAYER;

#if MEGA
DI Params launder(const Params& p) {
  size_t z = 0;
  asm volatile("" : "+s"(z));
  Params q = p; q.ws = p.ws + z; q.out = p.out + z;
  return q;
}
struct XBar { unsigned* base; unsigned xcc; unsigned nloc; unsigned nx; };
#define XB_CENSUS(j) (64 * (j))
#define XB_XSUB(j) (1024 + 64 * (j))
#define XB_XGEN(j) (2048 + 64 * (j))
#define XB_TOP 3072
#define XB_TOPGEN 3136
DI unsigned xb_ld(unsigned* p) { return __hip_atomic_load(p, __ATOMIC_RELAXED, __HIP_MEMORY_SCOPE_AGENT); }
DI unsigned xb_add(unsigned* p, unsigned v) { return __hip_atomic_fetch_add(p, v, __ATOMIC_RELAXED, __HIP_MEMORY_SCOPE_AGENT); }
DI void xbar_post(XBar& xb, unsigned* base) {
  xb.base = base; xb.nloc = 0; xb.nx = 0;
  xb.xcc = (unsigned)__builtin_amdgcn_s_getreg((3 << 11) | 20) & 0xFu;
  if (threadIdx.x == 0) xb_add(&base[XB_CENSUS(xb.xcc)], 1u);
}
DI void xbar_census(XBar& xb) {
  if (threadIdx.x == 0) {
    unsigned nx = 0;
    for (int j = 0; j < 16; ++j) nx += xb_ld(&xb.base[XB_CENSUS(j)]) ? 1u : 0u;
    xb.nx = nx; xb.nloc = xb_ld(&xb.base[XB_CENSUS(xb.xcc)]);
  }
}
DI void xbar_sync(const XBar& xb) {
  asm volatile("s_waitcnt vmcnt(0)" ::: "memory");
  __syncthreads();
  if (threadIdx.x == 0) {
    unsigned* bar = xb.base;
    const unsigned old = xb_add(&bar[XB_XSUB(xb.xcc)], 1u);
    const unsigned gen = old / xb.nloc;
    if (old + 1u == (gen + 1u) * xb.nloc) {
      __builtin_amdgcn_fence(__ATOMIC_RELEASE, "agent");
      asm volatile("s_waitcnt vmcnt(0)" ::: "memory");
      const unsigned og = xb_add(&bar[XB_TOP], 1u);
      const unsigned tg = og / xb.nx;
      if (og + 1u == (tg + 1u) * xb.nx) xb_add(&bar[XB_TOPGEN], 1u);
      else { unsigned sp = 0; while (xb_ld(&bar[XB_TOPGEN]) == tg) { __builtin_amdgcn_s_sleep(1); if (++sp > (1u << 22)) break; } }
      __builtin_amdgcn_fence(__ATOMIC_ACQUIRE, "agent");
      xb_add(&bar[XB_XGEN(xb.xcc)], 1u);
      asm volatile("s_waitcnt vmcnt(0)" ::: "memory");
    } else {
      unsigned sp = 0;
      while (xb_ld(&bar[XB_XGEN(xb.xcc)]) == gen) { __builtin_amdgcn_s_sleep(1); if (++sp > (1u << 22)) break; }
      __builtin_amdgcn_fence(__ATOMIC_ACQUIRE, "agent");
      asm volatile("s_waitcnt vmcnt(0)" ::: "memory");
    }
  }
  __syncthreads();
}
#define GSYNC() xbar_sync(xb)
__global__ void __launch_bounds__(256, 2) mega_kernel(Params p) {
  __shared__ __attribute__((aligned(16))) char smem[66048];
  cg::grid_group grid = cg::this_grid();
  XBar xb;
  xbar_post(xb, (unsigned*)(p.ws + O_BAR));
  phase_mod(launder(p), smem);
  convert_weights(launder(p), 0);
  grid.sync();
  xbar_census(xb);
  for (int l = 0; l < NLAYER; ++l) {
    phase_prep(launder(p), l);
    GSYNC();
#if PROBE == 1
    phase_prep(launder(p), l);
    GSYNC();
#endif
    phase_gemmA(launder(p), l, smem);
    GSYNC();
#if PROBE == 2
    phase_gemmA(launder(p), l, smem);
    GSYNC();
#endif
    phase_qkv(launder(p), l, smem);
    GSYNC();
    phase_mix(launder(p), l, smem);
    if (l + 1 < NLAYER) convert_weights(launder(p), l + 1);
    GSYNC();
    phase_gate(launder(p), l, smem);
    GSYNC();
    phase_merge(launder(p), l, smem);
    GSYNC();
#if PROBE == 3
    phase_merge(launder(p), l, smem);
    GSYNC();
#endif
    phase_out(launder(p), l, smem);
    GSYNC();
  }
  phase_final(launder(p));
}

#else
__global__ void __launch_bounds__(256, 2) phase_kernel(Params p, int ph) {
  __shared__ __attribute__((aligned(16))) char smem[66048];
  run_phase(p, ph, smem);
}

#endif
extern "C" void kernel_launch(void* const* d_in, const int* in_sizes, int n_in, void* d_out, int out_size, void* d_ws,
                              size_t ws_size, hipStream_t stream) {
  Params p{};
  const float** pp = (const float**)&p;
  for (int i = 0; i < 30; ++i) pp[i] = (const float*)d_in[i];
  p.out = (float*)d_out;
  p.ws = (char*)d_ws;
  if (ws_size < WS_NEED) fprintf(stderr, "workspace too small: %zu < %zu\n", ws_size, (size_t)WS_NEED);
#if MEGA
  static int grid_blocks = 0;
  if (!grid_blocks) {
    int dev = 0, cus = 0, per_cu = 0;
    hipGetDevice(&dev);
    hipDeviceGetAttribute(&cus, hipDeviceAttributeMultiprocessorCount, dev);
    hipOccupancyMaxActiveBlocksPerMultiprocessor(&per_cu, mega_kernel, 256, 0);
    if (per_cu > 2) per_cu = 2;
    grid_blocks = cus * per_cu;
  }
  (void)hipMemsetAsync((char*)d_ws + O_BAR, 0, BAR_BYTES, stream);
  void* args[] = {&p};
  hipError_t e = hipLaunchCooperativeKernel((void*)mega_kernel, dim3(grid_blocks), dim3(256), args, 0, stream);
  if (e != hipSuccess) fprintf(stderr, "cooperative launch failed: %s (grid %d)\n", hipGetErrorString(e), grid_blocks);
#else
  for (int ph = 0; ph < NPHASE; ++ph) phase_kernel<<<512, 256, 0, stream>>>(p, ph);
#endif
}
```
